# Optimizing an MI355X kernel written in HIP

```python
import math
import jax, jax.numpy as jnp
from jax import lax
import numpy as np

D_MODEL = 1024
BATCH = 2
SEQ = 8192
DEPTH = 2

N_MIXERS = 2
N_HEADS = 16
HEAD_DIM = D_MODEL // N_HEADS
MOBA_BLOCK = 256
MOBA_TOPK = 3
MOBA_QCHUNK = 64
DIL_GROUPS = ((128, 1), (512, 4), (2048, 16))
N_DIL_GROUPS = len(DIL_GROUPS)
DIL_BLOCK = 128
DIL_PAD = math.lcm(*[d * DIL_BLOCK for _, d in DIL_GROUPS])
N_EXPERTS = 256
TOP_K = 8
N_GROUPS = 8
TOPK_GROUPS = 4
D_EXPERT = 256
ROUTED_SCALE = 2.5
DISPATCH_BLOCK = 128
DN_ALPHA = (2 * DEPTH) ** 0.25
DN_BETA = (8 * DEPTH) ** -0.25
LN_EPS = 1e-5
NEG = -1e30

kernel_name = "hybrid_moba_dilated_moe_deepnorm"


def alibi_slopes():
    return 2.0 ** (-8.0 * jnp.arange(1, N_HEADS + 1, dtype=jnp.float32) / N_HEADS)


def layer_norm(x, g, b):
    xf = x.astype(jnp.float32)
    mu = xf.mean(-1, keepdims=True)
    var = jnp.square(xf - mu).mean(-1, keepdims=True)
    y = (xf - mu) * lax.rsqrt(var + LN_EPS) * g.astype(jnp.float32) + b.astype(jnp.float32)
    return y.astype(x.dtype)


def moba_attention(q, k, v, slopes):
    bsz, nh, s, dh = q.shape
    s_pad = -(-s // MOBA_BLOCK) * MOBA_BLOCK
    padw = ((0, 0), (0, 0), (0, s_pad - s), (0, 0))
    q, k, v = jnp.pad(q, padw), jnp.pad(k, padw), jnp.pad(v, padw)
    nb = s_pad // MOBA_BLOCK
    kb = k.reshape(bsz, nh, nb, MOBA_BLOCK, dh)
    vb = v.reshape(bsz, nh, nb, MOBA_BLOCK, dh)
    scale = dh ** -0.5
    k_mean = kb.mean(axis=3)
    gate = jnp.einsum('bhsd,bhnd->bhsn', q, k_mean).astype(jnp.float32)
    q_blk = jnp.arange(s_pad) // MOBA_BLOCK
    past = jnp.arange(nb)[None, :] < q_blk[:, None]
    gate = jnp.where(past, gate, NEG)
    n_sel = min(MOBA_TOPK, nb)
    _, sel = lax.top_k(gate, n_sel)
    sel_valid = jnp.arange(n_sel)[None, :] < q_blk[:, None]

    c = MOBA_QCHUNK
    nc = s_pad // c
    qc = q.reshape(bsz, nh, nc, c, dh).transpose(2, 0, 1, 3, 4)
    selc = sel.reshape(bsz, nh, nc, c, n_sel).transpose(2, 0, 1, 3, 4)
    validc = sel_valid.reshape(nc, c, n_sel)
    gather_blocks = jax.vmap(jax.vmap(lambda blocks, ix: blocks[ix]))

    def chunk_fn(args):
        ci, q_c, sel_c, valid_c = args
        t = ci * c + jnp.arange(c)
        k_sel = gather_blocks(kb, sel_c)
        v_sel = gather_blocks(vb, sel_c)
        s_pos = sel_c[..., None] * MOBA_BLOCK + jnp.arange(MOBA_BLOCK)
        l_sel = (jnp.einsum('bhcd,bhcjnd->bhcjn', q_c, k_sel).astype(jnp.float32) * scale
                 - slopes[:, None, None, None] * (t[:, None, None] - s_pos))
        l_sel = jnp.where(valid_c[None, None, :, :, None], l_sel, NEG)
        own = (ci * c) // MOBA_BLOCK
        k_own = lax.dynamic_index_in_dim(kb, own, axis=2, keepdims=False)
        v_own = lax.dynamic_index_in_dim(vb, own, axis=2, keepdims=False)
        dist = t[:, None] - (own * MOBA_BLOCK + jnp.arange(MOBA_BLOCK))[None, :]
        l_own = (jnp.einsum('bhcd,bhnd->bhcn', q_c, k_own).astype(jnp.float32) * scale
                 - slopes[:, None, None] * dist)
        l_own = jnp.where(dist >= 0, l_own, NEG)
        n_sel_keys = n_sel * MOBA_BLOCK
        logits = jnp.concatenate([l_sel.reshape(bsz, nh, c, n_sel_keys), l_own], axis=-1)
        p = jax.nn.softmax(logits, axis=-1).astype(v.dtype)
        p_sel = p[..., :n_sel_keys].reshape(bsz, nh, c, n_sel, MOBA_BLOCK)
        return (jnp.einsum('bhcjn,bhcjnd->bhcd', p_sel, v_sel)
                + jnp.einsum('bhcn,bhnd->bhcd', p[..., n_sel_keys:], v_own))

    out = lax.map(chunk_fn, (jnp.arange(nc), qc, selc, validc))
    out = out.transpose(1, 2, 0, 3, 4).reshape(bsz, nh, s_pad, dh)
    return out[:, :, :s]


def dilated_group_attention(q, k, v, slopes, window, dil):
    bsz, nh, s, dh = q.shape
    steps_max = window // dil
    L = s // dil
    nbk = L // DIL_BLOCK

    def to_blocks(tns):
        return tns.reshape(bsz, nh, L, dil, dh).transpose(0, 1, 3, 2, 4).reshape(
            bsz, nh, dil, nbk, DIL_BLOCK, dh)

    qb, kb, vb = to_blocks(q), to_blocks(k), to_blocks(v)
    padw = ((0, 0), (0, 0), (0, 0), (1, 0), (0, 0), (0, 0))
    k_band = jnp.concatenate([jnp.pad(kb, padw)[:, :, :, :-1], kb], axis=4)
    v_band = jnp.concatenate([jnp.pad(vb, padw)[:, :, :, :-1], vb], axis=4)
    j_k = jnp.arange(2 * DIL_BLOCK) - DIL_BLOCK
    steps = jnp.arange(DIL_BLOCK)[:, None] - j_k[None, :]
    key_sub = jnp.arange(nbk)[:, None] * DIL_BLOCK + j_k[None, :]
    mask = (steps >= 0) & (steps <= steps_max) & (key_sub[:, None, :] >= 0)
    logits = (jnp.einsum('bhrnqd,bhrnkd->bhrnqk', qb, k_band).astype(jnp.float32) * dh ** -0.5
              - slopes[:, None, None, None, None] * (steps * dil))
    logits = jnp.where(mask, logits, NEG)
    m = logits.max(-1, keepdims=True)
    e = jnp.exp(logits - m)
    den = e.sum(-1, keepdims=True)
    o = jnp.einsum('bhrnqk,bhrnkd->bhrnqd', (e / den).astype(v.dtype), v_band)
    lse = (m + jnp.log(den))[..., 0]
    o = o.reshape(bsz, nh, dil, L, dh).transpose(0, 1, 3, 2, 4).reshape(bsz, nh, s, dh)
    lse = lse.reshape(bsz, nh, dil, L).transpose(0, 1, 3, 2).reshape(bsz, nh, s)
    return o, lse


def moba_mixer(x, w_qkv, slopes):
    bsz, s, _ = x.shape
    qkv = (x @ w_qkv).reshape(bsz, s, 3, N_HEADS, HEAD_DIM)
    q, k, v = (qkv[:, :, j].transpose(0, 2, 1, 3) for j in range(3))
    o = moba_attention(q, k, v, slopes)
    return o.transpose(0, 2, 1, 3).reshape(bsz, s, N_HEADS * HEAD_DIM)


def dilated_mixer(x, w_qkv, slopes):
    bsz, s, _ = x.shape
    s_pad = -(-s // DIL_PAD) * DIL_PAD
    qkv = (x @ w_qkv).reshape(bsz, s, N_DIL_GROUPS, 3, N_HEADS, HEAD_DIM)
    qkv = jnp.pad(qkv, ((0, 0), (0, s_pad - s), (0, 0), (0, 0), (0, 0), (0, 0)))
    outs, lses = [], []
    for g, (window, dil) in enumerate(DIL_GROUPS):
        q, k, v = (qkv[:, :, g, j].transpose(0, 2, 1, 3) for j in range(3))
        o, lse = dilated_group_attention(q, k, v, slopes, window, dil)
        outs.append(o)
        lses.append(lse)
    wts = jax.nn.softmax(jnp.stack(lses, axis=0), axis=0)
    o = jnp.einsum('gbhs,gbhsd->bhsd', wts.astype(x.dtype), jnp.stack(outs, axis=0))
    return o[:, :, :s].transpose(0, 2, 1, 3).reshape(bsz, s, N_HEADS * HEAD_DIM)


def moe(x, w_router, router_bias, we_gate, we_up, we_down, ws_gate, ws_up, ws_down):
    bsz, s, d = x.shape
    T = bsz * s
    xt = x.reshape(T, d)
    scores = jax.nn.sigmoid((xt @ w_router).astype(jnp.float32))
    choice = scores + router_bias.astype(jnp.float32)
    grp = choice.reshape(T, N_GROUPS, N_EXPERTS // N_GROUPS)
    grp_score = lax.top_k(grp, 2)[0].sum(-1)
    _, top_grp = lax.top_k(grp_score, TOPK_GROUPS)
    grp_mask = jnp.any(top_grp[..., None] == jnp.arange(N_GROUPS), axis=1)
    choice = jnp.where(jnp.repeat(grp_mask, N_EXPERTS // N_GROUPS, axis=1), choice, NEG)
    _, top_e = lax.top_k(choice, TOP_K)
    w = jnp.take_along_axis(scores, top_e, axis=1)
    w = w / w.sum(-1, keepdims=True) * ROUTED_SCALE
    A = T * TOP_K
    bt = DISPATCH_BLOCK
    flat_e = top_e.reshape(A)
    flat_t = jnp.arange(A) // TOP_K
    flat_w = w.reshape(A)
    order = jnp.argsort(flat_e)
    e_sorted, t_sorted, w_sorted = flat_e[order], flat_t[order], flat_w[order]
    counts = jnp.bincount(flat_e, length=N_EXPERTS)
    starts = jnp.cumsum(counts) - counts
    pcounts = (counts + bt - 1) // bt * bt
    pends = jnp.cumsum(pcounts)
    pstarts = pends - pcounts
    dest = pstarts[e_sorted] + jnp.arange(A) - starts[e_sorted]
    n_blocks = (A + N_EXPERTS * (bt - 1) + bt - 1) // bt
    P = n_blocks * bt
    slot_t = jnp.full((P,), T, jnp.int32).at[dest].set(t_sorted)
    slot_w = jnp.zeros((P,), w.dtype).at[dest].set(w_sorted)
    block_e = jnp.minimum(jnp.searchsorted(pends, jnp.arange(n_blocks) * bt, side='right'),
                          N_EXPERTS - 1)
    x_pad = jnp.concatenate([xt, jnp.zeros((1, d), xt.dtype)], axis=0)

    def expert_block(args):
        e, tok, wt = args
        xb = x_pad[tok]
        h = jax.nn.silu(xb @ we_gate[e]) * (xb @ we_up[e])
        return (h @ we_down[e]) * wt[:, None].astype(xb.dtype)

    y = lax.map(expert_block, (block_e, slot_t.reshape(n_blocks, bt), slot_w.reshape(n_blocks, bt)))
    routed = jax.ops.segment_sum(y.reshape(P, d), slot_t, num_segments=T + 1)[:T]
    shared = (jax.nn.silu(xt @ ws_gate) * (xt @ ws_up)) @ ws_down
    return (routed + shared).reshape(bsz, s, d)


def setup_inputs(seed: int = 0) -> dict:
    key = jax.random.key(seed)
    ks = jax.random.split(key, 16)
    D, E, F = D_MODEL, N_EXPERTS, D_EXPERT
    n_a = (DEPTH + N_MIXERS - 1) // N_MIXERS
    n_b = DEPTH // N_MIXERS
    std = D ** -0.5
    qkv_scale = jnp.array([1.0, 1.0, DN_BETA], jnp.float32)[:, None]
    x = jax.random.normal(ks[0], (BATCH, SEQ, D), jnp.float32)
    w_qkv_a = (jax.random.normal(ks[1], (n_a, D, 3, D)) * std * qkv_scale).reshape(n_a, D, 3 * D)
    w_qkv_b = (jax.random.normal(ks[2], (n_b, D, N_DIL_GROUPS, 3, D)) * std * qkv_scale).reshape(
        n_b, D, N_DIL_GROUPS * 3 * D)
    w_o = jax.random.normal(ks[3], (DEPTH, D, D)) * std * DN_BETA
    ln_mix_g = 1.0 + 0.02 * jax.random.normal(ks[4], (DEPTH, D))
    ln_mix_b = 0.02 * jax.random.normal(ks[5], (DEPTH, D))
    w_router = jax.random.normal(ks[6], (DEPTH, D, E)) * std
    router_bias = 0.01 * jax.random.normal(ks[7], (DEPTH, E))
    we_gate = jax.random.normal(ks[8], (DEPTH, E, D, F)) * std
    we_up = jax.random.normal(ks[9], (DEPTH, E, D, F)) * std
    we_down = jax.random.normal(ks[10], (DEPTH, E, F, D)) * (F ** -0.5) * DN_BETA
    ws_gate = jax.random.normal(ks[11], (DEPTH, D, F)) * std
    ws_up = jax.random.normal(ks[12], (DEPTH, D, F)) * std
    ws_down = jax.random.normal(ks[13], (DEPTH, F, D)) * (F ** -0.5) * DN_BETA
    ln_ffn_g = 1.0 + 0.02 * jax.random.normal(ks[14], (DEPTH, D))
    ln_ffn_b = 0.02 * jax.random.normal(ks[15], (DEPTH, D))
    return {"x": x, "w_qkv_a": w_qkv_a, "w_qkv_b": w_qkv_b, "w_o": w_o,
            "ln_mix_g": ln_mix_g, "ln_mix_b": ln_mix_b, "w_router": w_router,
            "router_bias": router_bias, "we_gate": we_gate, "we_up": we_up,
            "we_down": we_down, "ws_gate": ws_gate, "ws_up": ws_up, "ws_down": ws_down,
            "ln_ffn_g": ln_ffn_g, "ln_ffn_b": ln_ffn_b}


def reference(x, w_qkv_a, w_qkv_b, w_o, ln_mix_g, ln_mix_b, w_router, router_bias,
              we_gate, we_up, we_down, ws_gate, ws_up, ws_down, ln_ffn_g, ln_ffn_b):
    slopes = alibi_slopes()
    for i in range(DEPTH):
        if i % N_MIXERS == 0:
            mix = moba_mixer(x, w_qkv_a[i // N_MIXERS], slopes)
        else:
            mix = dilated_mixer(x, w_qkv_b[i // N_MIXERS], slopes)
        x = layer_norm(DN_ALPHA * x + mix @ w_o[i], ln_mix_g[i], ln_mix_b[i])
        f = moe(x, w_router[i], router_bias[i], we_gate[i], we_up[i], we_down[i],
                ws_gate[i], ws_up[i], ws_down[i])
        x = layer_norm(DN_ALPHA * x + f, ln_ffn_g[i], ln_ffn_b[i])
    return x
```

```cpp
#include <hip/hip_runtime.h>
#include <hip/hip_bf16.h>
#include <stdint.h>
#include <stdio.h>

#ifndef MK_ONE_LAUNCH
#define MK_ONE_LAUNCH 0
#endif

#ifndef PHMASK
#define PHMASK 0x7FF
#endif
#define PHK(k) ((PHMASK >> (k)) & 1)
#define LAS __attribute__((address_space(3)))
typedef __attribute__((ext_vector_type(8))) short bf16x8;
typedef __attribute__((ext_vector_type(16))) float f32x16;
typedef __attribute__((ext_vector_type(4))) float f32x4;
typedef __attribute__((ext_vector_type(4))) unsigned u32x4;
typedef __attribute__((ext_vector_type(2))) unsigned u32x2;
typedef unsigned short u16;

constexpr int D = 1024, BATCH = 2, SEQ = 8192, T = BATCH * SEQ, NH = 16, HD = 64;
constexpr int NE = 256, TOPK = 8, DF = 256;
constexpr int A_TOT = T * TOPK;
constexpr int MOBA_BLK = 256, MOBA_NB = SEQ / MOBA_BLK;
constexpr float DN_ALPHA = 1.4142135623730951f;
constexpr float LN_EPS = 1e-5f;
constexpr float LOG2E = 1.4426950408889634f;
constexpr float LN2 = 0.6931471805599453f;
constexpr float NEGV = -1e30f;
constexpr int NTHR = 512;

constexpr size_t al256(size_t x) { return (x + 255) & ~(size_t)255; }
constexpr size_t WS_CTL = 0;
constexpr size_t CTL_BYTES = 65536;
constexpr size_t CTL_CNT_OFF = 32768;
constexpr size_t WS_XB = WS_CTL + CTL_BYTES;
constexpr size_t WS_X1 = WS_XB + al256((size_t)T * D * 2);
constexpr size_t WS_X2 = WS_X1 + al256((size_t)T * D * 4);
constexpr size_t WS_YPRE = WS_X2 + al256((size_t)T * D * 4);
constexpr size_t WS_QKV = WS_YPRE + al256((size_t)T * D * 4);
constexpr size_t WS_VT = WS_QKV + al256((size_t)T * 9216 * 2);
constexpr size_t WS_KM = WS_VT + al256((size_t)3 * T * D * 2);
constexpr size_t WS_AO = WS_KM + al256((size_t)BATCH * NH * MOBA_NB * HD * 4);
constexpr size_t WS_OG = WS_AO + al256((size_t)T * D * 2);
constexpr size_t WS_LSE = WS_OG + al256((size_t)3 * T * D * 2);
constexpr size_t WS_TOPW = WS_LSE + al256((size_t)3 * T * NH * 4);
constexpr size_t WS_LIST = WS_TOPW + al256((size_t)T * TOPK * 4);
constexpr size_t WS_HB = WS_LIST + al256((size_t)NE * T * 4);
constexpr size_t WS_YB = WS_HB + al256((size_t)(A_TOT + T) * DF * 2);
constexpr size_t WS_END = WS_YB + al256((size_t)(A_TOT + T) * D * 2);

constexpr int LDP = 40;
constexpr int STAGE_BYTES = 2 * 256 * LDP * 2;
constexpr int LDS_ROWID = 2 * STAGE_BYTES;
constexpr int LDS_ROWW = LDS_ROWID + 1024;
constexpr int XS_PITCH = 1028;
constexpr int LDS_BYTES = 32 * XS_PITCH * 4 + 1024;
constexpr int LDS_BAR = 32 * XS_PITCH * 4;

#define XB_TMO      128
#define XB_XCNT(j)  (256  + 64 * (j))
#define XB_XSUB(j)  (1280 + 64 * (j))
#define XB_XGEN(j)  (2304 + 64 * (j))
#define XB_TOP      3328
#define XB_TOPGEN   3392
#define XCD_BAR_WORDS 3456
#define XB_SPIN_CAP (1u << 18)
__device__ __forceinline__ unsigned xb_ld(unsigned* p)              { return __hip_atomic_load(p, __ATOMIC_RELAXED, __HIP_MEMORY_SCOPE_AGENT); }
__device__ __forceinline__ unsigned xb_add(unsigned* p, unsigned v) { return __hip_atomic_fetch_add(p, v, __ATOMIC_RELAXED, __HIP_MEMORY_SCOPE_AGENT); }
__device__ __forceinline__ unsigned xb_xcc_id() { return (unsigned)__builtin_amdgcn_s_getreg((3 << 11) | 20) & 0xFu; }
#define XB_SPIN(cond, bar) do { unsigned _sp = 0; while (cond) { __builtin_amdgcn_s_sleep(1); \
    if ((++_sp & 255u) == 0u) { if (xb_ld(&(bar)[XB_TMO])) break; if (_sp > XB_SPIN_CAP) { atomicAdd(&(bar)[XB_TMO], 1u); break; } } } } while (0)
struct XcdBarrier { unsigned* bar; unsigned x; volatile LAS unsigned* st; };
__device__ __forceinline__ XcdBarrier xcd_barrier_post(unsigned* bar, volatile LAS unsigned* st) {
    XcdBarrier b; b.bar = bar; b.x = xb_xcc_id(); b.st = st;
    if (threadIdx.x == 0) (void)xb_add(&bar[XB_XCNT(b.x)], 1u);
    return b;
}
__device__ __forceinline__ void xcd_barrier_complete(unsigned* bar, unsigned x, unsigned& nloc, unsigned& nx) {
    const unsigned G = gridDim.x * gridDim.y * gridDim.z;
    unsigned sum, cnt, mine, sp = 0u;
    for (;;) {
        sum = 0u; cnt = 0u; mine = 0u;
#pragma unroll
        for (unsigned j = 0; j < 16; ++j) { const unsigned c = xb_ld(&bar[XB_XCNT(j)]); sum += c; cnt += (c > 0u) ? 1u : 0u; mine = (j == x) ? c : mine; }
        if (sum == G) break;
        __builtin_amdgcn_s_sleep(1);
        if ((++sp & 255u) == 0u) { if (xb_ld(&bar[XB_TMO])) break; if (sp > XB_SPIN_CAP) { atomicAdd(&bar[XB_TMO], 1u); break; } }
    }
    nloc = mine > 0u ? mine : 1u; nx = cnt > 0u ? cnt : 1u;
}
__device__ __forceinline__ void xcd_barrier(const XcdBarrier& b) {
    asm volatile("s_waitcnt vmcnt(0)" ::: "memory");
    __syncthreads();
    if (threadIdx.x == 0) {
        unsigned* bar = b.bar;
        __builtin_amdgcn_s_waitcnt(0);
        unsigned nloc = b.st[0], nx = b.st[1];
        if (nloc == 0u) { xcd_barrier_complete(bar, b.x, nloc, nx); b.st[0] = nloc; b.st[1] = nx; }
        const unsigned old = xb_add(&bar[XB_XSUB(b.x)], 1u);
        const unsigned gen = old / nloc;
        if (old + 1u == (gen + 1u) * nloc) {
            __builtin_amdgcn_fence(__ATOMIC_RELEASE, "agent");
            asm volatile("s_waitcnt vmcnt(0)" ::: "memory");
            const unsigned og = xb_add(&bar[XB_TOP], 1u);
            const unsigned tg = og / nx;
            if (og + 1u == (tg + 1u) * nx) xb_add(&bar[XB_TOPGEN], 1u);
            else XB_SPIN(xb_ld(&bar[XB_TOPGEN]) == tg, bar);
            __builtin_amdgcn_fence(__ATOMIC_ACQUIRE, "agent");
            xb_add(&bar[XB_XGEN(b.x)], 1u);
            asm volatile("s_waitcnt vmcnt(0)" ::: "memory");
        } else {
            XB_SPIN(xb_ld(&bar[XB_XGEN(b.x)]) == gen, bar);
            __builtin_amdgcn_fence(__ATOMIC_ACQUIRE, "agent");
            asm volatile("s_waitcnt vmcnt(0)" ::: "memory");
        }
    }
    __syncthreads();
}

typedef __attribute__((ext_vector_type(2))) __bf16 bf16x2_t;
typedef __attribute__((ext_vector_type(2))) float f32x2_t;
__device__ __forceinline__ unsigned cvtpk(float lo, float hi) { f32x2_t f; f[0] = lo; f[1] = hi; return __builtin_bit_cast(unsigned, __builtin_convertvector(f, bf16x2_t)); }
__device__ __forceinline__ float bf2f(unsigned v16) { return __uint_as_float(v16 << 16); }
__device__ __forceinline__ int crow(int r, int hi) { return (r & 3) + 8 * (r >> 2) + 4 * hi; }
#define MFMA_BF16(a, b, c) __builtin_amdgcn_mfma_f32_32x32x16_bf16(a, b, c, 0, 0, 0)
__device__ __forceinline__ float wave_sum(float v) {
#pragma unroll
    for (int o = 32; o >= 1; o >>= 1) v += __shfl_xor(v, o);
    return v;
}

struct Args {
    const float* in[16];
    float* out;
    unsigned char* ws;
    int ph_lo, ph_hi;
};

#define GEMM_CORE(K_, PA0, PA1, PB, LDB)                                                                                                   \
    {                                                                                                                                      \
        const int g_tid = tid, g_lane = lane, g_wave = wave, g_r32 = r32, g_hi = hi;                   \
        const int g_wm = g_wave >> 2, g_wn = g_wave & 3, g_kc = g_tid & 3, g_kq = g_lane >> 3, g_n4 = g_lane & 7;                           \
        const u16* g_pa0 = (PA0); const u16* g_pa1 = (PA1);                                                                                \
        const size_t g_ldb = (size_t)(LDB);                                                                                                \
        const float* g_pb = (PB) + (size_t)(g_kq * 4) * g_ldb + g_n4 * 4;                                                                  \
        const int g_nk = (K_) / 32;                                                                                                        \
        u32x4 g_ra0, g_ra1; f32x4 g_rb0, g_rb1, g_rb2, g_rb3;                                                                              \
        const u32x4 g_z = {0u, 0u, 0u, 0u};                                                                                                \
        _Pragma("unroll") for (int mb = 0; mb < 4; ++mb) { _Pragma("unroll") for (int nb = 0; nb < 2; ++nb) { _Pragma("unroll") for (int r = 0; r < 16; ++r) acc[mb][nb][r] = 0.f; } } \
        g_ra0 = g_pa0 ? *(const u32x4*)(g_pa0 + g_kc * 8) : g_z; g_ra1 = g_pa1 ? *(const u32x4*)(g_pa1 + g_kc * 8) : g_z;                 \
        g_rb0 = *(const f32x4*)(g_pb); g_rb1 = *(const f32x4*)(g_pb + g_ldb); g_rb2 = *(const f32x4*)(g_pb + 2 * g_ldb); g_rb3 = *(const f32x4*)(g_pb + 3 * g_ldb); \
        _Pragma("unroll 1") for (int kt = 0; kt < g_nk; ++kt) {                                                                            \
            LAS char* As = lds + (kt & 1) * STAGE_BYTES; LAS char* Bs = As + 256 * LDP * 2;                                                \
            *(LAS u32x4*)(As + ((g_tid >> 2) * LDP + g_kc * 8) * 2) = g_ra0;                                                               \
            *(LAS u32x4*)(As + (((g_tid >> 2) + 128) * LDP + g_kc * 8) * 2) = g_ra1;                                                       \
            _Pragma("unroll") for (int i = 0; i < 4; ++i) {                                                                                \
                u32x2 w; w[0] = cvtpk(g_rb0[i], g_rb1[i]); w[1] = cvtpk(g_rb2[i], g_rb3[i]);                                               \
                *(LAS u32x2*)(Bs + ((g_wave * 32 + i * 8 + g_n4) * LDP + g_kq * 4) * 2) = w;                                               \
            }                                                                                                                              \
            __syncthreads();                                                                                                               \
            if (kt + 1 < g_nk) {                                                                                                           \
                const int ko = (kt + 1) * 32;                                                                                              \
                g_ra0 = g_pa0 ? *(const u32x4*)(g_pa0 + ko + g_kc * 8) : g_z; g_ra1 = g_pa1 ? *(const u32x4*)(g_pa1 + ko + g_kc * 8) : g_z; \
                const float* pbk = g_pb + (size_t)ko * g_ldb;                                                                              \
                g_rb0 = *(const f32x4*)(pbk); g_rb1 = *(const f32x4*)(pbk + g_ldb); g_rb2 = *(const f32x4*)(pbk + 2 * g_ldb); g_rb3 = *(const f32x4*)(pbk + 3 * g_ldb); \
            }                                                                                                                              \
            _Pragma("unroll") for (int s = 0; s < 2; ++s) {                                                                                \
                bf16x8 af[4], bfr[2];                                                                                                      \
                _Pragma("unroll") for (int mb = 0; mb < 4; ++mb) af[mb] = *(LAS bf16x8*)(As + ((g_wm * 128 + mb * 32 + g_r32) * LDP + s * 16 + g_hi * 8) * 2); \
                _Pragma("unroll") for (int nb = 0; nb < 2; ++nb) bfr[nb] = *(LAS bf16x8*)(Bs + (((g_wn * 2 + nb) * 32 + g_r32) * LDP + s * 16 + g_hi * 8) * 2); \
                _Pragma("unroll") for (int mb = 0; mb < 4; ++mb) { _Pragma("unroll") for (int nb = 0; nb < 2; ++nb) acc[mb][nb] = MFMA_BF16(af[mb], bfr[nb], acc[mb][nb]); } \
            }                                                                                                                              \
        }                                                                                                                                  \
        __syncthreads();                                                                                                                   \
    }

struct AttnSt { float m, l; f32x16 o0, o1; };

__device__ __forceinline__ void attn_step(AttnSt& st, const bf16x8 (&qf)[4], const u16* krow, const u16* vt, size_t vt_dstride, const float (&bias)[16], unsigned okmask) {
    bf16x8 kf[4];
#pragma unroll
    for (int d0 = 0; d0 < 4; ++d0) kf[d0] = *(const bf16x8*)(krow + d0 * 16);
    f32x16 p;
#pragma unroll
    for (int r = 0; r < 16; ++r) p[r] = 0.f;
#pragma unroll
    for (int d0 = 0; d0 < 4; ++d0) p = MFMA_BF16(kf[d0], qf[d0], p);
    constexpr float C2 = 0.125f * LOG2E;
    float mx = NEGV;
#pragma unroll
    for (int r = 0; r < 16; ++r) { float s = ((okmask >> r) & 1u) ? __builtin_fmaf(p[r], C2, bias[r]) : NEGV; p[r] = s; mx = fmaxf(mx, s); }
    mx = fmaxf(mx, __shfl_xor(mx, 32));
    const float mnew = fmaxf(st.m, mx);
    const float alpha = __builtin_amdgcn_exp2f(st.m - mnew);
    st.m = mnew;
    float ls = 0.f;
#pragma unroll
    for (int r = 0; r < 16; ++r) { p[r] = __builtin_amdgcn_exp2f(p[r] - mnew); ls += p[r]; }
    st.l = st.l * alpha + ls;
#pragma unroll
    for (int r = 0; r < 16; ++r) { st.o0[r] *= alpha; st.o1[r] *= alpha; }
    union { bf16x8 v; unsigned u[4]; } pb0, pb1;
#pragma unroll
    for (int j = 0; j < 4; ++j) { pb0.u[j] = cvtpk(p[2 * j], p[2 * j + 1]); pb1.u[j] = cvtpk(p[8 + 2 * j], p[8 + 2 * j + 1]); }
    union { bf16x8 v; u32x2 h[2]; } va;
    const u16* vt1 = vt + 32 * vt_dstride;
    va.h[0] = *(const u32x2*)(vt);      va.h[1] = *(const u32x2*)(vt + 8);   st.o0 = MFMA_BF16(va.v, pb0.v, st.o0);
    va.h[0] = *(const u32x2*)(vt + 16); va.h[1] = *(const u32x2*)(vt + 24);  st.o0 = MFMA_BF16(va.v, pb1.v, st.o0);
    va.h[0] = *(const u32x2*)(vt1);      va.h[1] = *(const u32x2*)(vt1 + 8);  st.o1 = MFMA_BF16(va.v, pb0.v, st.o1);
    va.h[0] = *(const u32x2*)(vt1 + 16); va.h[1] = *(const u32x2*)(vt1 + 24); st.o1 = MFMA_BF16(va.v, pb1.v, st.o1);
}

__device__ __forceinline__ void top3_insert(float v, int i, float& v0, int& i0, float& v1, int& i1, float& v2, int& i2) {
    const bool b0 = (v > v0) || (v == v0 && i < i0);
    const bool b1 = (v > v1) || (v == v1 && i < i1);
    const bool b2 = (v > v2) || (v == v2 && i < i2);
    const float nv2 = b1 ? v1 : (b2 ? v : v2); const int ni2 = b1 ? i1 : (b2 ? i : i2);
    const float nv1 = b0 ? v0 : (b1 ? v : v1); const int ni1 = b0 ? i0 : (b1 ? i : i1);
    const float nv0 = b0 ? v : v0;             const int ni0 = b0 ? i : i0;
    v0 = nv0; i0 = ni0; v1 = nv1; i1 = ni1; v2 = nv2; i2 = ni2;
}

__device__ __forceinline__ void ln_row(float (&v)[16], const float* __restrict__ g, const float* __restrict__ b, int lane) {
    float s = 0.f;
#pragma unroll
    for (int i = 0; i < 16; ++i) s += v[i];
    const float mu = wave_sum(s) * (1.f / D);
    float q = 0.f;
#pragma unroll
    for (int i = 0; i < 16; ++i) { const float d = v[i] - mu; q += d * d; }
    const float rstd = rsqrtf(wave_sum(q) * (1.f / D) + LN_EPS);
#pragma unroll
    for (int j = 0; j < 4; ++j) {
        const f32x4 gg = *(const f32x4*)(g + j * 256 + lane * 4), bb = *(const f32x4*)(b + j * 256 + lane * 4);
#pragma unroll
        for (int c = 0; c < 4; ++c) v[j * 4 + c] = (v[j * 4 + c] - mu) * rstd * gg[c] + bb[c];
    }
}

constexpr int N_PHASES = 19;

#define P_x_in (args.in[0])
#define P_xb ((u16*)(ws + WS_XB))
#define P_x1 ((float*)(ws + WS_X1))
#define P_x2 ((float*)(ws + WS_X2))
#define P_ypre ((float*)(ws + WS_YPRE))
#define P_qkv ((u16*)(ws + WS_QKV))
#define P_vT ((u16*)(ws + WS_VT))
#define P_kmean ((float*)(ws + WS_KM))
#define P_ao ((u16*)(ws + WS_AO))
#define P_og ((u16*)(ws + WS_OG))
#define P_lse ((float*)(ws + WS_LSE))
#define P_topw ((float*)(ws + WS_TOPW))
#define P_list ((int*)(ws + WS_LIST))
#define P_hb ((u16*)(ws + WS_HB))
#define P_yb ((u16*)(ws + WS_YB))
#define P_cnt_all ((int*)(ws + WS_CTL + CTL_CNT_OFF))
__global__ void __launch_bounds__(NTHR, 2) fwd(Args args) {
    extern __shared__ __attribute__((aligned(16))) unsigned char lds_raw[];
    LAS char* lds = (LAS char*)lds_raw;
    const int G = gridDim.x, bid = blockIdx.x;
    unsigned char* const ws = args.ws;
    const int lo = args.ph_lo, hi_ph = args.ph_hi;
#define IN(k) (lo <= (k) && (k) < hi_ph)
#define PH_BEGIN int tid = threadIdx.x; asm volatile("" : "+v"(tid)); const int lane = tid & 63, r32 = lane & 31, hi = lane >> 5; const int wave = __builtin_amdgcn_readfirstlane(tid >> 6); (void)lane; (void)r32; (void)hi; (void)wave

#if MK_ONE_LAUNCH
    if (threadIdx.x < 4) ((LAS unsigned*)(lds + LDS_BAR))[threadIdx.x] = 0u;
    __syncthreads();
    XcdBarrier bar = xcd_barrier_post((unsigned*)(ws + WS_CTL), (volatile LAS unsigned*)(lds + LDS_BAR));
#define GRID_BAR() xcd_barrier(bar)
#else
#define GRID_BAR() do { } while (0)
#endif
#define SEAM(k) do { if (IN(k) && IN((k) + 1)) GRID_BAR(); } while (0)

    if (IN(0) && PHK(0)) {
            PH_BEGIN;
        for (size_t i = (size_t)bid * NTHR + tid; i < (size_t)T * D / 4; i += (size_t)G * NTHR) {
            const f32x4 v = *(const f32x4*)(P_x_in + i * 4);
            u32x2 w; w[0] = cvtpk(v[0], v[1]); w[1] = cvtpk(v[2], v[3]);
            *(u32x2*)(P_xb + i * 4) = w;
        }
    }
    SEAM(0);

    for (int L = 0; L < 2; ++L) {
        const int pb = 1 + 9 * L;
        const int NQ = L == 0 ? 3072 : 9216;
        const float* wqkv = L == 0 ? args.in[1] : args.in[2];
        const float* wo = args.in[3] + (size_t)L * D * D;
        const float* xres = L == 0 ? P_x_in : P_x2;
        int* cnt = P_cnt_all + L * NE;

        if (IN(pb + 0) && PHK(1)) {
            PH_BEGIN;
            const int nitems = 64 * (NQ / 256);
            for (int it = bid; it < nitems; it += G) {
                const int mt = it & 63, nt = it >> 6;
                f32x16 acc[4][2];
                GEMM_CORE(D, P_xb + (size_t)(mt * 256 + (tid >> 2)) * D, P_xb + (size_t)(mt * 256 + (tid >> 2) + 128) * D,
                          wqkv + nt * 256 + wave * 32, NQ)
                const int wm = wave >> 2, wn = wave & 3;
                int rb = mt * 256 + wm * 128 + 4 * hi; asm volatile("" : "+v"(rb));
#pragma unroll
                for (int nb = 0; nb < 2; ++nb) {
                    const int col = nt * 256 + (wn * 2 + nb) * 32 + 4 * (r32 & 7) + (r32 >> 3);
                    const int grp = col / 3072, cc = col - grp * 3072, j = cc >> 10, c = cc & 1023, h = c >> 6, d = c & 63;
                    const int dil = grp == 0 ? 1 : (grp == 1 ? 4 : 16);
#pragma unroll
                    for (int mb = 0; mb < 4; ++mb) {
#pragma unroll
                        for (int rq = 0; rq < 4; ++rq) {
                            const int row0 = rb + mb * 32 + 8 * rq;
                            if (j < 2) {
#pragma unroll
                                for (int i = 0; i < 4; ++i) P_qkv[(size_t)(row0 + i) * NQ + col] = (u16)cvtpk(acc[mb][nb][4 * rq + i], 0.f);
                            } else {
                                const int b = row0 / SEQ, t0 = row0 - b * SEQ;
                                u16* vrow = P_vT + (size_t)grp * T * D + ((size_t)(b * NH + h) * HD + d) * SEQ;
                                if (dil == 1) {
                                    u32x2 w; w[0] = cvtpk(acc[mb][nb][4 * rq], acc[mb][nb][4 * rq + 1]); w[1] = cvtpk(acc[mb][nb][4 * rq + 2], acc[mb][nb][4 * rq + 3]);
                                    *(u32x2*)(vrow + t0) = w;
                                } else {
#pragma unroll
                                    for (int i = 0; i < 4; ++i) { const int p = t0 + i; vrow[(p % dil) * (SEQ / dil) + p / dil] = (u16)cvtpk(acc[mb][nb][4 * rq + i], 0.f); }
                                }
                            }
                        }
                    }
                }
            }
        }
        SEAM(pb + 0);

        if (L == 0) {
            if (IN(pb + 1) && PHK(2)) {
            PH_BEGIN;
                LAS float* red = (LAS float*)lds;
                for (int it = bid; it < BATCH * NH * MOBA_NB; it += G) {
                    const int j = it & 31, h = (it >> 5) & 15, b = it >> 9;
                    const int d = tid & 63, part = tid >> 6;
                    const u16* kp = P_qkv + (size_t)(b * SEQ + j * MOBA_BLK + part * 32) * 3072 + 1024 + h * 64 + d;
                    float s = 0.f;
                    for (int k = 0; k < 32; ++k) s += bf2f(kp[(size_t)k * 3072]);
                    red[part * 64 + d] = s;
                    __syncthreads();
                    if (tid < 64) {
                        float tot = 0.f;
#pragma unroll
                        for (int p8 = 0; p8 < 8; ++p8) tot += red[p8 * 64 + tid];
                        P_kmean[(size_t)it * 64 + tid] = tot * (1.f / MOBA_BLK);
                    }
                    __syncthreads();
                }
            }
            SEAM(pb + 1);
        }

        if (L == 0) {
            if (IN(pb + 2) && PHK(3)) {
            PH_BEGIN;
                for (int it = bid; it < BATCH * NH * MOBA_NB; it += G) {
                    const int rnd = it >> 8, w8 = it & 255, a8 = w8 >> 5, bh = w8 & 31;
                    const int qb = rnd == 0 ? 31 - a8 : (rnd == 1 ? 16 + a8 : (rnd == 2 ? 15 - a8 : a8));
                    const int b = bh >> 4, h = bh & 15;
                    const float slope2 = exp2f(-0.5f * (float)(h + 1)) * LOG2E;
                    const int tq = qb * MOBA_BLK + wave * 32 + r32;
                    const u16* qrow = P_qkv + (size_t)(b * SEQ + tq) * 3072 + h * 64 + hi * 8;
                    bf16x8 qf[4];
#pragma unroll
                    for (int d0 = 0; d0 < 4; ++d0) qf[d0] = *(const bf16x8*)(qrow + d0 * 16);
                    unsigned selmask = 0u;
                    if (qb > 0) {
                        const float* km = P_kmean + ((size_t)(b * NH + h) * MOBA_NB + r32) * 64 + hi * 8;
                        f32x16 gt;
#pragma unroll
                        for (int r = 0; r < 16; ++r) gt[r] = 0.f;
#pragma unroll
                        for (int d0 = 0; d0 < 4; ++d0) {
                            const f32x4 k0 = *(const f32x4*)(km + d0 * 16), k1 = *(const f32x4*)(km + d0 * 16 + 4);
                            union { bf16x8 v; unsigned u[4]; } kf;
                            kf.u[0] = cvtpk(k0[0], k0[1]); kf.u[1] = cvtpk(k0[2], k0[3]); kf.u[2] = cvtpk(k1[0], k1[1]); kf.u[3] = cvtpk(k1[2], k1[3]);
                            gt = MFMA_BF16(kf.v, qf[d0], gt);
                        }
                        float v0 = -INFINITY, v1 = -INFINITY, v2 = -INFINITY; int i0 = 99, i1 = 99, i2 = 99;
#pragma unroll
                        for (int r = 0; r < 16; ++r) { const int jb = crow(r, hi); if (jb < qb) top3_insert(gt[r], jb, v0, i0, v1, i1, v2, i2); }
                        const float ov0 = __shfl_xor(v0, 32), ov1 = __shfl_xor(v1, 32), ov2 = __shfl_xor(v2, 32);
                        const int oi0 = __shfl_xor(i0, 32), oi1 = __shfl_xor(i1, 32), oi2 = __shfl_xor(i2, 32);
                        top3_insert(ov0, oi0, v0, i0, v1, i1, v2, i2); top3_insert(ov1, oi1, v0, i0, v1, i1, v2, i2); top3_insert(ov2, oi2, v0, i0, v1, i1, v2, i2);
                        if (i0 < 32) selmask |= 1u << i0;
                        if (i1 < 32) selmask |= 1u << i1;
                        if (i2 < 32) selmask |= 1u << i2;
                    }
                    unsigned om = selmask;
#pragma unroll
                    for (int o = 32; o >= 1; o >>= 1) om |= __shfl_xor(om, o);
                    om = __builtin_amdgcn_readfirstlane(om);
                    AttnSt st; st.m = NEGV; st.l = 0.f;
#pragma unroll
                    for (int r = 0; r < 16; ++r) { st.o0[r] = 0.f; st.o1[r] = 0.f; }
                    const u16* kbase = P_qkv + (size_t)(b * SEQ) * 3072 + 1024 + h * 64 + hi * 8;
                    const u16* vtb = P_vT + ((size_t)(b * NH + h) * HD + r32) * SEQ + 4 * hi;
                    for (int kt = 0; kt <= wave; ++kt) {
                        const int k0 = qb * MOBA_BLK + kt * 32;
                        float bias[16]; unsigned okm = 0u;
#pragma unroll
                        for (int r = 0; r < 16; ++r) { const int dist = tq - (k0 + crow(r, hi)); bias[r] = -slope2 * (float)dist; okm |= (dist >= 0 ? 1u : 0u) << r; }
                        attn_step(st, qf, kbase + (size_t)(k0 + r32) * 3072, vtb + k0, SEQ, bias, okm);
                    }
                    for (int jb = 0; jb < qb; ++jb) {
                        if (!((om >> jb) & 1u)) continue;
                        const unsigned okm = ((selmask >> jb) & 1u) ? 0xFFFFu : 0u;
                        for (int kt = 0; kt < 8; ++kt) {
                            const int k0 = jb * MOBA_BLK + kt * 32;
                            float bias[16];
#pragma unroll
                            for (int r = 0; r < 16; ++r) bias[r] = -slope2 * (float)(tq - (k0 + crow(r, hi)));
                            attn_step(st, qf, kbase + (size_t)(k0 + r32) * 3072, vtb + k0, SEQ, bias, okm);
                        }
                    }
                    const float inv = 1.f / (st.l + __shfl_xor(st.l, 32));
                    u16* orow = P_ao + (size_t)(b * SEQ + tq) * D + h * 64;
#pragma unroll
                    for (int rq = 0; rq < 4; ++rq) {
                        u32x2 w; w[0] = cvtpk(st.o0[4 * rq] * inv, st.o0[4 * rq + 1] * inv); w[1] = cvtpk(st.o0[4 * rq + 2] * inv, st.o0[4 * rq + 3] * inv);
                        *(u32x2*)(orow + 8 * rq + 4 * hi) = w;
                        w[0] = cvtpk(st.o1[4 * rq] * inv, st.o1[4 * rq + 1] * inv); w[1] = cvtpk(st.o1[4 * rq + 2] * inv, st.o1[4 * rq + 3] * inv);
                        *(u32x2*)(orow + 32 + 8 * rq + 4 * hi) = w;
                    }
                }
            }
        } else {
            if (IN(pb + 2) && PHK(4)) {
            PH_BEGIN;
                for (int it = bid; it < BATCH * NH * 3 * 32; it += G) {
                    const int ch = it & 31, grp = (it >> 5) % 3, bh = it / 96, b = bh >> 4, h = bh & 15;
                    const int dil = grp == 0 ? 1 : (grp == 1 ? 4 : 16), Ls = SEQ / dil;
                    const float slope2 = exp2f(-0.5f * (float)(h + 1)) * LOG2E * (float)dil;
                    const int u0 = ch * 256 + wave * 32, res = u0 / Ls, i0 = u0 - res * Ls;
                    const int iq = i0 + r32, pq = iq * dil + res;
                    const u16* qrow = P_qkv + (size_t)(b * SEQ + pq) * 9216 + grp * 3072 + h * 64 + hi * 8;
                    bf16x8 qf[4];
#pragma unroll
                    for (int d0 = 0; d0 < 4; ++d0) qf[d0] = *(const bf16x8*)(qrow + d0 * 16);
                    AttnSt st; st.m = NEGV; st.l = 0.f;
#pragma unroll
                    for (int r = 0; r < 16; ++r) { st.o0[r] = 0.f; st.o1[r] = 0.f; }
                    const u16* kbase = P_qkv + (size_t)(b * SEQ) * 9216 + grp * 3072 + 1024 + h * 64 + hi * 8;
                    const u16* vtb = P_vT + (size_t)grp * T * D + ((size_t)(b * NH + h) * HD + r32) * SEQ + (size_t)res * Ls + 4 * hi;
                    for (int kt = 4; kt >= 0; --kt) {
                        const int k0 = i0 - 128 + kt * 32;
                        if (k0 < 0) continue;
                        float bias[16]; unsigned okm = 0u;
#pragma unroll
                        for (int r = 0; r < 16; ++r) { const int steps = iq - (k0 + crow(r, hi)); bias[r] = -slope2 * (float)steps; okm |= ((steps >= 0 && steps <= 128) ? 1u : 0u) << r; }
                        attn_step(st, qf, kbase + (size_t)((k0 + r32) * dil + res) * 9216, vtb + k0, SEQ, bias, okm);
                    }
                    const float lt = st.l + __shfl_xor(st.l, 32);
                    const float inv = 1.f / lt;
                    u16* orow = P_og + (size_t)grp * T * D + (size_t)(b * SEQ + pq) * D + h * 64;
#pragma unroll
                    for (int rq = 0; rq < 4; ++rq) {
                        u32x2 w; w[0] = cvtpk(st.o0[4 * rq] * inv, st.o0[4 * rq + 1] * inv); w[1] = cvtpk(st.o0[4 * rq + 2] * inv, st.o0[4 * rq + 3] * inv);
                        *(u32x2*)(orow + 8 * rq + 4 * hi) = w;
                        w[0] = cvtpk(st.o1[4 * rq] * inv, st.o1[4 * rq + 1] * inv); w[1] = cvtpk(st.o1[4 * rq + 2] * inv, st.o1[4 * rq + 3] * inv);
                        *(u32x2*)(orow + 32 + 8 * rq + 4 * hi) = w;
                    }
                    if (hi == 0) P_lse[((size_t)grp * T + (b * SEQ + pq)) * NH + h] = st.m * LN2 + logf(lt);
                }
            }
        }
        SEAM(pb + 2);

        if (L == 1) {
            if (IN(pb + 3) && PHK(5)) {
            PH_BEGIN;
                for (size_t i = (size_t)bid * NTHR + tid; i < (size_t)T * NH * 8; i += (size_t)G * NTHR) {
                    const size_t row = i >> 7; const int h = (int)(i >> 3) & 15, d8 = (int)i & 7;
                    const float l0 = P_lse[(0 * (size_t)T + row) * NH + h], l1 = P_lse[(1 * (size_t)T + row) * NH + h], l2 = P_lse[(2 * (size_t)T + row) * NH + h];
                    const float mx = fmaxf(l0, fmaxf(l1, l2));
                    float w0 = expf(l0 - mx), w1 = expf(l1 - mx), w2 = expf(l2 - mx);
                    const float inv = 1.f / (w0 + w1 + w2); w0 *= inv; w1 *= inv; w2 *= inv;
                    const size_t off = row * D + h * 64 + d8 * 8;
                    const u32x4 a0 = *(const u32x4*)(P_og + off), a1 = *(const u32x4*)(P_og + (size_t)T * D + off), a2 = *(const u32x4*)(P_og + 2 * (size_t)T * D + off);
                    u32x4 o;
#pragma unroll
                    for (int c = 0; c < 4; ++c) {
                        const float lo_ = w0 * bf2f(a0[c] & 0xFFFFu) + w1 * bf2f(a1[c] & 0xFFFFu) + w2 * bf2f(a2[c] & 0xFFFFu);
                        const float hi_ = w0 * bf2f(a0[c] >> 16) + w1 * bf2f(a1[c] >> 16) + w2 * bf2f(a2[c] >> 16);
                        o[c] = cvtpk(lo_, hi_);
                    }
                    *(u32x4*)(P_ao + off) = o;
                }
            }
            SEAM(pb + 3);
        }

        if (IN(pb + 4) && PHK(6)) {
            PH_BEGIN;
            for (int it = bid; it < 64 * 4; it += G) {
                const int mt = it & 63, nt = it >> 6;
                f32x16 acc[4][2];
                GEMM_CORE(D, P_ao + (size_t)(mt * 256 + (tid >> 2)) * D, P_ao + (size_t)(mt * 256 + (tid >> 2) + 128) * D,
                          wo + nt * 256 + wave * 32, D)
                const int wm = wave >> 2, wn = wave & 3;
                int rb = mt * 256 + wm * 128 + 4 * hi; asm volatile("" : "+v"(rb));
#pragma unroll
                for (int nb = 0; nb < 2; ++nb) {
                    const int col = nt * 256 + (wn * 2 + nb) * 32 + 4 * (r32 & 7) + (r32 >> 3);
                    const float* xr = xres + (size_t)rb * D + col; float* yp = P_ypre + (size_t)rb * D + col;
#pragma unroll
                    for (int mb = 0; mb < 4; ++mb) {
#pragma unroll
                        for (int r = 0; r < 16; ++r) {
                            const int o = (mb * 32 + (r & 3) + 8 * (r >> 2)) * D;
                            yp[o] = DN_ALPHA * xr[o] + acc[mb][nb][r];
                        }
                        asm volatile("" ::: "memory");
                    }
                }
            }
        }
        SEAM(pb + 4);

        if (IN(pb + 5) && PHK(7)) {
            PH_BEGIN;
            const float* lng = args.in[4] + L * D; const float* lnb = args.in[5] + L * D;
            const float* wr = args.in[6] + (size_t)L * D * NE; const float* rbias = args.in[7] + L * NE;
            LAS float* xs = (LAS float*)lds;
            for (int it = bid; it < T / 32; it += G) {
#pragma unroll 1
                for (int rr = 0; rr < 4; ++rr) {
                    const int lr = wave * 4 + rr; const size_t row = (size_t)it * 32 + lr;
                    float v[16];
#pragma unroll
                    for (int j = 0; j < 4; ++j) { const f32x4 t4 = *(const f32x4*)(P_ypre + row * D + j * 256 + lane * 4); v[j * 4] = t4[0]; v[j * 4 + 1] = t4[1]; v[j * 4 + 2] = t4[2]; v[j * 4 + 3] = t4[3]; }
                    ln_row(v, lng, lnb, lane);
#pragma unroll
                    for (int j = 0; j < 4; ++j) {
                        f32x4 t4; t4[0] = v[j * 4]; t4[1] = v[j * 4 + 1]; t4[2] = v[j * 4 + 2]; t4[3] = v[j * 4 + 3];
                        *(f32x4*)(P_x1 + row * D + j * 256 + lane * 4) = t4;
                        *(LAS f32x4*)(xs + lr * XS_PITCH + j * 256 + lane * 4) = t4;
                        u32x2 w; w[0] = cvtpk(t4[0], t4[1]); w[1] = cvtpk(t4[2], t4[3]);
                        *(u32x2*)(P_xb + row * D + j * 256 + lane * 4) = w;
                    }
                }
                __syncthreads();
                f32x16 lg;
#pragma unroll
                for (int r = 0; r < 16; ++r) lg[r] = 0.f;
                {
                    const LAS float* ap = xs + r32 * XS_PITCH + hi;
                    const float* bp = wr + (size_t)hi * NE + wave * 32 + r32;
#pragma unroll 8
                    for (int k = 0; k < D; k += 2) lg = __builtin_amdgcn_mfma_f32_32x32x2f32(ap[k], bp[(size_t)k * NE], lg, 0, 0, 0);
                }
                __syncthreads();
                LAS float* lgs = (LAS float*)lds;
#pragma unroll
                for (int r = 0; r < 16; ++r) lgs[crow(r, hi) * 257 + wave * 32 + r32] = lg[r];
                __syncthreads();
#pragma unroll 1
                for (int rr = 0; rr < 4; ++rr) {
                    const int lr = wave * 4 + rr; const int tok = it * 32 + lr;
                    float sc[4], ch[4];
#pragma unroll
                    for (int j = 0; j < 4; ++j) { const int e = lane + 64 * j; sc[j] = 1.f / (1.f + expf(-lgs[lr * 257 + e])); ch[j] = sc[j] + rbias[e]; }
                    float gsel[8], gmine[4];
#pragma unroll
                    for (int j = 0; j < 4; ++j) {
                        float m1 = ch[j];
#pragma unroll
                        for (int o = 16; o >= 1; o >>= 1) m1 = fmaxf(m1, __shfl_xor(m1, o));
                        const unsigned long long bal = __ballot(ch[j] == m1);
                        const unsigned half = (unsigned)(hi ? (bal >> 32) : (bal & 0xFFFFFFFFull));
                        const int first = __builtin_ctz(half);
                        float m2 = (r32 == first) ? -INFINITY : ch[j];
#pragma unroll
                        for (int o = 16; o >= 1; o >>= 1) m2 = fmaxf(m2, __shfl_xor(m2, o));
                        const float mine = m1 + m2, other = __shfl_xor(mine, 32);
                        gsel[2 * j] = hi ? other : mine; gsel[2 * j + 1] = hi ? mine : other; gmine[j] = mine;
                    }
                    bool gok[4];
#pragma unroll
                    for (int j = 0; j < 4; ++j) {
                        const float mygs = gmine[j];
                        const int myg = 2 * j + hi;
                        int rank = 0;
#pragma unroll
                        for (int g2 = 0; g2 < 8; ++g2) rank += ((gsel[g2] > mygs) || (gsel[g2] == mygs && g2 < myg)) ? 1 : 0;
                        gok[j] = rank < 4;
                    }
                    float cv[4];
#pragma unroll
                    for (int j = 0; j < 4; ++j) cv[j] = gok[j] ? ch[j] : NEGV;
                    float wsel = 0.f; int esel = 0; float wsum = 0.f;
#pragma unroll 1
                    for (int k = 0; k < TOPK; ++k) {
                        float bv = cv[0]; int be = lane;
#pragma unroll
                        for (int j = 1; j < 4; ++j) if (cv[j] > bv) { bv = cv[j]; be = lane + 64 * j; }
#pragma unroll
                        for (int o = 32; o >= 1; o >>= 1) {
                            const float ov = __shfl_xor(bv, o); const int oe = __shfl_xor(be, o);
                            if (ov > bv || (ov == bv && oe < be)) { bv = ov; be = oe; }
                        }
                        const int jl = be >> 6, ll = be & 63;
                        float smine = sc[0];
                        smine = jl == 1 ? sc[1] : smine; smine = jl == 2 ? sc[2] : smine; smine = jl == 3 ? sc[3] : smine;
                        const float sw = __shfl(smine, ll);
#pragma unroll
                        for (int j = 0; j < 4; ++j) cv[j] = (lane == ll && jl == j) ? -INFINITY : cv[j];
                        wsum += sw;
                        if (lane == k) { wsel = sw; esel = be; }
                    }
                    if (lane < TOPK) {
                        const int a = tok * TOPK + lane;
                        P_topw[a] = wsel / wsum * 2.5f;
                        const int pos = atomicAdd(&cnt[esel], 1);
                        P_list[(size_t)esel * T + pos] = a;
                    }
                }
                __syncthreads();
            }
        }
        SEAM(pb + 5);

        if (IN(pb + 6) && PHK(8)) {
            PH_BEGIN;
            const float* weg = args.in[8] + (size_t)L * NE * D * DF; const float* weu = args.in[9] + (size_t)L * NE * D * DF;
            const float* wsg = args.in[11] + (size_t)L * D * DF; const float* wsu = args.in[12] + (size_t)L * D * DF;
            LAS int* rowid = (LAS int*)(lds + LDS_ROWID);
            for (int e = bid; e < NE + 64; e += G) {
                const bool shared = e >= NE;
                const int n = shared ? 256 : cnt[e];
                const int nrt = (n + 255) >> 8;
                const float* wg_ = shared ? wsg : weg + (size_t)e * D * DF;
                const float* wu_ = shared ? wsu : weu + (size_t)e * D * DF;
                for (int rt = 0; rt < nrt; ++rt) {
                    if (tid < 256) {
                        const int idx = rt * 256 + tid;
                        rowid[tid] = shared ? (A_TOT + (e - NE) * 256 + tid) : (idx < n ? P_list[(size_t)e * T + idx] : -1);
                    }
                    __syncthreads();
                    const int va0 = rowid[tid >> 2], va1 = rowid[(tid >> 2) + 128];
                    const u16* pa0 = va0 < 0 ? nullptr : P_xb + (size_t)(va0 < A_TOT ? (va0 >> 3) : (va0 - A_TOT)) * D;
                    const u16* pa1 = va1 < 0 ? nullptr : P_xb + (size_t)(va1 < A_TOT ? (va1 >> 3) : (va1 - A_TOT)) * D;
#pragma unroll 1
                    for (int fc = 0; fc < 2; ++fc) {
                        f32x16 acc[4][2];
                        const float* pbseg = ((wave & 1) ? wu_ : wg_) + fc * 128 + (wave >> 1) * 32;
                        GEMM_CORE(D, pa0, pa1, pbseg, DF)
                        const int wm = wave >> 2, wn = wave & 3;
                        const int f = fc * 128 + wn * 32 + 4 * (r32 & 7) + (r32 >> 3);
                        int rbase = wm * 128 + 4 * hi; asm volatile("" : "+v"(rbase));
#pragma unroll
                        for (int mb = 0; mb < 4; ++mb) {
#pragma unroll
                            for (int r = 0; r < 16; ++r) {
                                const int va = rowid[rbase + mb * 32 + (r & 3) + 8 * (r >> 2)];
                                if (va >= 0) {
                                    const float gt = acc[mb][0][r], up = acc[mb][1][r];
                                    const float hval = gt / (1.f + expf(-gt)) * up;
                                    P_hb[(size_t)va * DF + f] = (u16)cvtpk(hval, 0.f);
                                }
                            }
                            asm volatile("" ::: "memory");
                        }
                    }
                    __syncthreads();
                }
            }
        }
        SEAM(pb + 6);

        if (IN(pb + 7) && PHK(9)) {
            PH_BEGIN;
            const float* wed = args.in[10] + (size_t)L * NE * DF * D; const float* wsd = args.in[13] + (size_t)L * DF * D;
            LAS int* rowid = (LAS int*)(lds + LDS_ROWID);
            LAS float* roww = (LAS float*)(lds + LDS_ROWW);
            for (int e = bid; e < NE + 64; e += G) {
                const bool shared = e >= NE;
                const int n = shared ? 256 : cnt[e];
                const int nrt = (n + 255) >> 8;
                const float* wd_ = shared ? wsd : wed + (size_t)e * DF * D;
                for (int rt = 0; rt < nrt; ++rt) {
                    if (tid < 256) {
                        const int idx = rt * 256 + tid;
                        const int va = shared ? (A_TOT + (e - NE) * 256 + tid) : (idx < n ? P_list[(size_t)e * T + idx] : -1);
                        rowid[tid] = va;
                        roww[tid] = (va >= 0 && va < A_TOT) ? P_topw[va] : 1.f;
                    }
                    __syncthreads();
                    const int va0 = rowid[tid >> 2], va1 = rowid[(tid >> 2) + 128];
                    const u16* pa0 = va0 < 0 ? nullptr : P_hb + (size_t)va0 * DF;
                    const u16* pa1 = va1 < 0 ? nullptr : P_hb + (size_t)va1 * DF;
#pragma unroll 1
                    for (int nt = 0; nt < 4; ++nt) {
                        f32x16 acc[4][2];
                        GEMM_CORE(DF, pa0, pa1, wd_ + nt * 256 + wave * 32, D)
                        const int wm = wave >> 2, wn = wave & 3;
                        int rbase = wm * 128 + 4 * hi; asm volatile("" : "+v"(rbase));
#pragma unroll
                        for (int nb = 0; nb < 2; ++nb) {
                            const int col = nt * 256 + (wn * 2 + nb) * 32 + 4 * (r32 & 7) + (r32 >> 3);
#pragma unroll
                            for (int mb = 0; mb < 4; ++mb) {
#pragma unroll
                                for (int r = 0; r < 16; ++r) {
                                    const int lrow = rbase + mb * 32 + (r & 3) + 8 * (r >> 2);
                                    const int va = rowid[lrow];
                                    if (va >= 0) P_yb[(size_t)va * D + col] = (u16)cvtpk(acc[mb][nb][r] * roww[lrow], 0.f);
                                }
                                asm volatile("" ::: "memory");
                            }
                        }
                    }
                    __syncthreads();
                }
            }
        }
        SEAM(pb + 7);

        if (IN(pb + 8) && PHK(10)) {
            PH_BEGIN;
            const float* lng = args.in[14] + L * D; const float* lnb = args.in[15] + L * D;
            float* dst = L == 0 ? P_x2 : args.out;
            for (int row = bid * 8 + wave; row < T; row += G * 8) {
                float v[16];
#pragma unroll
                for (int j = 0; j < 4; ++j) { const f32x4 t4 = *(const f32x4*)(P_x1 + (size_t)row * D + j * 256 + lane * 4); v[j * 4] = DN_ALPHA * t4[0]; v[j * 4 + 1] = DN_ALPHA * t4[1]; v[j * 4 + 2] = DN_ALPHA * t4[2]; v[j * 4 + 3] = DN_ALPHA * t4[3]; }
#pragma unroll 1
                for (int k = 0; k < TOPK + 1; ++k) {
                    const size_t va = k < TOPK ? (size_t)row * TOPK + k : (size_t)A_TOT + row;
#pragma unroll
                    for (int j = 0; j < 4; ++j) {
                        const u32x2 w = *(const u32x2*)(P_yb + va * D + j * 256 + lane * 4);
                        v[j * 4] += bf2f(w[0] & 0xFFFFu); v[j * 4 + 1] += bf2f(w[0] >> 16); v[j * 4 + 2] += bf2f(w[1] & 0xFFFFu); v[j * 4 + 3] += bf2f(w[1] >> 16);
                    }
                }
                ln_row(v, lng, lnb, lane);
#pragma unroll
                for (int j = 0; j < 4; ++j) {
                    f32x4 t4; t4[0] = v[j * 4]; t4[1] = v[j * 4 + 1]; t4[2] = v[j * 4 + 2]; t4[3] = v[j * 4 + 3];
                    *(f32x4*)(dst + (size_t)row * D + j * 256 + lane * 4) = t4;
                    if (L == 0) { u32x2 w; w[0] = cvtpk(t4[0], t4[1]); w[1] = cvtpk(t4[2], t4[3]); *(u32x2*)(P_xb + (size_t)row * D + j * 256 + lane * 4) = w; }
                }
            }
        }
        if (L == 0) SEAM(pb + 8);
    }
}

extern "C" void kernel_launch(void* const* d_in, const int* in_sizes, int n_in, void* d_out, int out_size, void* d_ws, size_t ws_size, hipStream_t stream) {
    static int grid = 0;
    if (grid == 0) {
        if (n_in != 16 || out_size != T * D || ws_size < WS_END) { fprintf(stderr, "kernel_launch: unexpected problem (n_in %d out %d ws %zu need %zu)\n", n_in, out_size, ws_size, (size_t)WS_END); grid = -1; return; }
        int dev = 0, cus = 0, per_cu = 0;
        if (hipGetDevice(&dev) != hipSuccess || hipDeviceGetAttribute(&cus, hipDeviceAttributeMultiprocessorCount, dev) != hipSuccess) { grid = -1; return; }
        if (hipFuncSetAttribute((const void*)fwd, hipFuncAttributeMaxDynamicSharedMemorySize, LDS_BYTES) != hipSuccess) { fprintf(stderr, "kernel_launch: hipFuncSetAttribute failed\n"); grid = -1; return; }
        if (hipOccupancyMaxActiveBlocksPerMultiprocessor(&per_cu, (const void*)fwd, NTHR, LDS_BYTES) != hipSuccess || per_cu < 1) { fprintf(stderr, "kernel_launch: occupancy query says %d\n", per_cu); (void)hipGetLastError(); per_cu = 1; }
        grid = cus;
    }
    if (grid < 0) return;
    (void)hipMemsetAsync((char*)d_ws + WS_CTL, 0, CTL_BYTES, stream);
    Args a{};
    for (int i = 0; i < 16; ++i) a.in[i] = (const float*)d_in[i];
    a.out = (float*)d_out; a.ws = (unsigned char*)d_ws;
#if MK_ONE_LAUNCH
    a.ph_lo = 0; a.ph_hi = N_PHASES;
    hipLaunchKernelGGL(fwd, dim3(grid), dim3(NTHR), LDS_BYTES, stream, a);
#else
    for (int ph = 0; ph < N_PHASES; ++ph) {
        if (ph == 4 || ph == 11) continue;
        a.ph_lo = ph; a.ph_hi = ph + 1;
        hipLaunchKernelGGL(fwd, dim3(grid), dim3(NTHR), LDS_BYTES, stream, a);
    }
#endif
}
```

```cpp
#include <hip/hip_runtime.h>
#include <hip/hip_bf16.h>
#include <stdint.h>
#include <stdio.h>

#ifndef MK_ONE_LAUNCH
#define MK_ONE_LAUNCH 1
#endif

#ifndef PHMASK
#define PHMASK 0x7FF
#endif
#define PHK(k) ((PHMASK >> (k)) & 1)
#define LAS __attribute__((address_space(3)))
typedef __attribute__((ext_vector_type(8))) short bf16x8;
typedef __attribute__((ext_vector_type(16))) float f32x16;
typedef __attribute__((ext_vector_type(4))) float f32x4;
typedef __attribute__((ext_vector_type(4))) unsigned u32x4;
typedef __attribute__((ext_vector_type(2))) unsigned u32x2;
typedef unsigned short u16;

constexpr int D = 1024, BATCH = 2, SEQ = 8192, T = BATCH * SEQ, NH = 16, HD = 64;
constexpr int NE = 256, TOPK = 8, DF = 256;
constexpr int A_TOT = T * TOPK;
constexpr int MOBA_BLK = 256, MOBA_NB = SEQ / MOBA_BLK;
constexpr float DN_ALPHA = 1.4142135623730951f;
constexpr float LN_EPS = 1e-5f;
constexpr float LOG2E = 1.4426950408889634f;
constexpr float LN2 = 0.6931471805599453f;
constexpr float NEGV = -1e30f;
constexpr int NTHR = 512;

constexpr size_t al256(size_t x) { return (x + 255) & ~(size_t)255; }
constexpr size_t WS_CTL = 0;
constexpr size_t CTL_BYTES = 65536;
constexpr size_t CTL_CNT_OFF = 32768;
constexpr size_t WS_XB = WS_CTL + CTL_BYTES;
constexpr size_t WS_X1 = WS_XB + al256((size_t)T * D * 2);
constexpr size_t WS_X2 = WS_X1 + al256((size_t)T * D * 4);
constexpr size_t WS_YPRE = WS_X2 + al256((size_t)T * D * 4);
constexpr size_t WS_QKV = WS_YPRE + al256((size_t)T * D * 4);
constexpr size_t WS_VT = WS_QKV + al256((size_t)T * 9216 * 2);
constexpr size_t WS_KM = WS_VT + al256((size_t)3 * T * D * 2);
constexpr size_t WS_AO = WS_KM + al256((size_t)BATCH * NH * MOBA_NB * HD * 4);
constexpr size_t WS_OG = WS_AO + al256((size_t)T * D * 2);
constexpr size_t WS_LSE = WS_OG + al256((size_t)3 * T * D * 2);
constexpr size_t WS_TOPW = WS_LSE + al256((size_t)3 * T * NH * 4);
constexpr size_t WS_LIST = WS_TOPW + al256((size_t)T * TOPK * 4);
constexpr size_t WS_HB = WS_LIST + al256((size_t)NE * T * 4);
constexpr size_t WS_YB = WS_HB + al256((size_t)(A_TOT + T) * DF * 2);
constexpr size_t WS_END = WS_YB + al256((size_t)(A_TOT + T) * D * 2);

constexpr int LDP = 40;
constexpr int STAGE_BYTES = 2 * 256 * LDP * 2;
constexpr int LDS_ROWID = 2 * STAGE_BYTES;
constexpr int LDS_ROWW = LDS_ROWID + 1024;
constexpr int XS_PITCH = 1028;
constexpr int LDS_BYTES = 32 * XS_PITCH * 4 + 1024;
constexpr int LDS_BAR = 32 * XS_PITCH * 4;

#define XB_TMO      128
#define XB_XCNT(j)  (256  + 64 * (j))
#define XB_XSUB(j)  (1280 + 64 * (j))
#define XB_XGEN(j)  (2304 + 64 * (j))
#define XB_TOP      3328
#define XB_TOPGEN   3392
#define XCD_BAR_WORDS 3456
#define XB_SPIN_CAP (1u << 18)
__device__ __forceinline__ unsigned xb_ld(unsigned* p)              { return __hip_atomic_load(p, __ATOMIC_RELAXED, __HIP_MEMORY_SCOPE_AGENT); }
__device__ __forceinline__ unsigned xb_add(unsigned* p, unsigned v) { return __hip_atomic_fetch_add(p, v, __ATOMIC_RELAXED, __HIP_MEMORY_SCOPE_AGENT); }
__device__ __forceinline__ unsigned xb_xcc_id() { return (unsigned)__builtin_amdgcn_s_getreg((3 << 11) | 20) & 0xFu; }
#define XB_SPIN(cond, bar) do { unsigned _sp = 0; while (cond) { __builtin_amdgcn_s_sleep(1); \
    if ((++_sp & 255u) == 0u) { if (xb_ld(&(bar)[XB_TMO])) break; if (_sp > XB_SPIN_CAP) { atomicAdd(&(bar)[XB_TMO], 1u); break; } } } } while (0)
struct XcdBarrier { unsigned* bar; unsigned x; volatile LAS unsigned* st; };
__device__ __forceinline__ XcdBarrier xcd_barrier_post(unsigned* bar, volatile LAS unsigned* st) {
    XcdBarrier b; b.bar = bar; b.x = xb_xcc_id(); b.st = st;
    if (threadIdx.x == 0) (void)xb_add(&bar[XB_XCNT(b.x)], 1u);
    return b;
}
__device__ __forceinline__ void xcd_barrier_complete(unsigned* bar, unsigned x, unsigned& nloc, unsigned& nx) {
    const unsigned G = gridDim.x * gridDim.y * gridDim.z;
    unsigned sum, cnt, mine, sp = 0u;
    for (;;) {
        sum = 0u; cnt = 0u; mine = 0u;
#pragma unroll
        for (unsigned j = 0; j < 16; ++j) { const unsigned c = xb_ld(&bar[XB_XCNT(j)]); sum += c; cnt += (c > 0u) ? 1u : 0u; mine = (j == x) ? c : mine; }
        if (sum == G) break;
        __builtin_amdgcn_s_sleep(1);
        if ((++sp & 255u) == 0u) { if (xb_ld(&bar[XB_TMO])) break; if (sp > XB_SPIN_CAP) { atomicAdd(&bar[XB_TMO], 1u); break; } }
    }
    nloc = mine > 0u ? mine : 1u; nx = cnt > 0u ? cnt : 1u;
}
__device__ __forceinline__ void xcd_barrier(const XcdBarrier& b) {
    asm volatile("s_waitcnt vmcnt(0)" ::: "memory");
    __syncthreads();
    if (threadIdx.x == 0) {
        unsigned* bar = b.bar;
        __builtin_amdgcn_s_waitcnt(0);
        unsigned nloc = b.st[0], nx = b.st[1];
        if (nloc == 0u) { xcd_barrier_complete(bar, b.x, nloc, nx); b.st[0] = nloc; b.st[1] = nx; }
        const unsigned old = xb_add(&bar[XB_XSUB(b.x)], 1u);
        const unsigned gen = old / nloc;
        if (old + 1u == (gen + 1u) * nloc) {
            __builtin_amdgcn_fence(__ATOMIC_RELEASE, "agent");
            asm volatile("s_waitcnt vmcnt(0)" ::: "memory");
            const unsigned og = xb_add(&bar[XB_TOP], 1u);
            const unsigned tg = og / nx;
            if (og + 1u == (tg + 1u) * nx) xb_add(&bar[XB_TOPGEN], 1u);
            else XB_SPIN(xb_ld(&bar[XB_TOPGEN]) == tg, bar);
            __builtin_amdgcn_fence(__ATOMIC_ACQUIRE, "agent");
            xb_add(&bar[XB_XGEN(b.x)], 1u);
            asm volatile("s_waitcnt vmcnt(0)" ::: "memory");
        } else {
            XB_SPIN(xb_ld(&bar[XB_XGEN(b.x)]) == gen, bar);
            __builtin_amdgcn_fence(__ATOMIC_ACQUIRE, "agent");
            asm volatile("s_waitcnt vmcnt(0)" ::: "memory");
        }
    }
    __syncthreads();
}

typedef __attribute__((ext_vector_type(2))) __bf16 bf16x2_t;
typedef __attribute__((ext_vector_type(2))) float f32x2_t;
__device__ __forceinline__ unsigned cvtpk(float lo, float hi) { f32x2_t f; f[0] = lo; f[1] = hi; return __builtin_bit_cast(unsigned, __builtin_convertvector(f, bf16x2_t)); }
__device__ __forceinline__ float bf2f(unsigned v16) { return __uint_as_float(v16 << 16); }
__device__ __forceinline__ int crow(int r, int hi) { return (r & 3) + 8 * (r >> 2) + 4 * hi; }
#define MFMA_BF16(a, b, c) __builtin_amdgcn_mfma_f32_32x32x16_bf16(a, b, c, 0, 0, 0)
__device__ __forceinline__ float wave_sum(float v) {
#pragma unroll
    for (int o = 32; o >= 1; o >>= 1) v += __shfl_xor(v, o);
    return v;
}

struct Args {
    const float* in[16];
    float* out;
    unsigned char* ws;
    int ph_lo, ph_hi;
};

#define GEMM_CORE(K_, PA0, PA1, PB, LDB)                                                                                                   \
    {                                                                                                                                      \
        const int g_tid = tid, g_lane = lane, g_wave = wave, g_r32 = r32, g_hi = hi;                   \
        const int g_wm = g_wave >> 2, g_wn = g_wave & 3, g_kc = g_tid & 3, g_kq = g_lane >> 3, g_n4 = g_lane & 7;                           \
        const u16* g_pa0 = (PA0); const u16* g_pa1 = (PA1);                                                                                \
        const size_t g_ldb = (size_t)(LDB);                                                                                                \
        const float* g_pb = (PB) + (size_t)(g_kq * 4) * g_ldb + g_n4 * 4;                                                                  \
        const int g_nk = (K_) / 32;                                                                                                        \
        u32x4 g_ra0, g_ra1; f32x4 g_rb0, g_rb1, g_rb2, g_rb3;                                                                              \
        const u32x4 g_z = {0u, 0u, 0u, 0u};                                                                                                \
        _Pragma("unroll") for (int mb = 0; mb < 4; ++mb) { _Pragma("unroll") for (int nb = 0; nb < 2; ++nb) { _Pragma("unroll") for (int r = 0; r < 16; ++r) acc[mb][nb][r] = 0.f; } } \
        g_ra0 = g_pa0 ? *(const u32x4*)(g_pa0 + g_kc * 8) : g_z; g_ra1 = g_pa1 ? *(const u32x4*)(g_pa1 + g_kc * 8) : g_z;                 \
        g_rb0 = *(const f32x4*)(g_pb); g_rb1 = *(const f32x4*)(g_pb + g_ldb); g_rb2 = *(const f32x4*)(g_pb + 2 * g_ldb); g_rb3 = *(const f32x4*)(g_pb + 3 * g_ldb); \
        _Pragma("unroll 1") for (int kt = 0; kt < g_nk; ++kt) {                                                                            \
            LAS char* As = lds + (kt & 1) * STAGE_BYTES; LAS char* Bs = As + 256 * LDP * 2;                                                \
            *(LAS u32x4*)(As + ((g_tid >> 2) * LDP + g_kc * 8) * 2) = g_ra0;                                                               \
            *(LAS u32x4*)(As + (((g_tid >> 2) + 128) * LDP + g_kc * 8) * 2) = g_ra1;                                                       \
            _Pragma("unroll") for (int i = 0; i < 4; ++i) {                                                                                \
                u32x2 w; w[0] = cvtpk(g_rb0[i], g_rb1[i]); w[1] = cvtpk(g_rb2[i], g_rb3[i]);                                               \
                *(LAS u32x2*)(Bs + ((g_wave * 32 + i * 8 + g_n4) * LDP + g_kq * 4) * 2) = w;                                               \
            }                                                                                                                              \
            __syncthreads();                                                                                                               \
            if (kt + 1 < g_nk) {                                                                                                           \
                const int ko = (kt + 1) * 32;                                                                                              \
                g_ra0 = g_pa0 ? *(const u32x4*)(g_pa0 + ko + g_kc * 8) : g_z; g_ra1 = g_pa1 ? *(const u32x4*)(g_pa1 + ko + g_kc * 8) : g_z; \
                const float* pbk = g_pb + (size_t)ko * g_ldb;                                                                              \
                g_rb0 = *(const f32x4*)(pbk); g_rb1 = *(const f32x4*)(pbk + g_ldb); g_rb2 = *(const f32x4*)(pbk + 2 * g_ldb); g_rb3 = *(const f32x4*)(pbk + 3 * g_ldb); \
            }                                                                                                                              \
            _Pragma("unroll") for (int s = 0; s < 2; ++s) {                                                                                \
                bf16x8 af[4], bfr[2];                                                                                                      \
                _Pragma("unroll") for (int mb = 0; mb < 4; ++mb) af[mb] = *(LAS bf16x8*)(As + ((g_wm * 128 + mb * 32 + g_r32) * LDP + s * 16 + g_hi * 8) * 2); \
                _Pragma("unroll") for (int nb = 0; nb < 2; ++nb) bfr[nb] = *(LAS bf16x8*)(Bs + (((g_wn * 2 + nb) * 32 + g_r32) * LDP + s * 16 + g_hi * 8) * 2); \
                _Pragma("unroll") for (int mb = 0; mb < 4; ++mb) { _Pragma("unroll") for (int nb = 0; nb < 2; ++nb) acc[mb][nb] = MFMA_BF16(af[mb], bfr[nb], acc[mb][nb]); } \
            }                                                                                                                              \
        }                                                                                                                                  \
        __syncthreads();                                                                                                                   \
    }

struct AttnSt { float m, l; f32x16 o0, o1; };

__device__ __forceinline__ void attn_step(AttnSt& st, const bf16x8 (&qf)[4], const u16* krow, const u16* vt, size_t vt_dstride, const float (&bias)[16], unsigned okmask) {
    bf16x8 kf[4];
#pragma unroll
    for (int d0 = 0; d0 < 4; ++d0) kf[d0] = *(const bf16x8*)(krow + d0 * 16);
    f32x16 p;
#pragma unroll
    for (int r = 0; r < 16; ++r) p[r] = 0.f;
#pragma unroll
    for (int d0 = 0; d0 < 4; ++d0) p = MFMA_BF16(kf[d0], qf[d0], p);
    constexpr float C2 = 0.125f * LOG2E;
    float mx = NEGV;
#pragma unroll
    for (int r = 0; r < 16; ++r) { float s = ((okmask >> r) & 1u) ? __builtin_fmaf(p[r], C2, bias[r]) : NEGV; p[r] = s; mx = fmaxf(mx, s); }
    mx = fmaxf(mx, __shfl_xor(mx, 32));
    const float mnew = fmaxf(st.m, mx);
    const float alpha = __builtin_amdgcn_exp2f(st.m - mnew);
    st.m = mnew;
    float ls = 0.f;
#pragma unroll
    for (int r = 0; r < 16; ++r) { p[r] = __builtin_amdgcn_exp2f(p[r] - mnew); ls += p[r]; }
    st.l = st.l * alpha + ls;
#pragma unroll
    for (int r = 0; r < 16; ++r) { st.o0[r] *= alpha; st.o1[r] *= alpha; }
    union { bf16x8 v; unsigned u[4]; } pb0, pb1;
#pragma unroll
    for (int j = 0; j < 4; ++j) { pb0.u[j] = cvtpk(p[2 * j], p[2 * j + 1]); pb1.u[j] = cvtpk(p[8 + 2 * j], p[8 + 2 * j + 1]); }
    union { bf16x8 v; u32x2 h[2]; } va;
    const u16* vt1 = vt + 32 * vt_dstride;
    va.h[0] = *(const u32x2*)(vt);      va.h[1] = *(const u32x2*)(vt + 8);   st.o0 = MFMA_BF16(va.v, pb0.v, st.o0);
    va.h[0] = *(const u32x2*)(vt + 16); va.h[1] = *(const u32x2*)(vt + 24);  st.o0 = MFMA_BF16(va.v, pb1.v, st.o0);
    va.h[0] = *(const u32x2*)(vt1);      va.h[1] = *(const u32x2*)(vt1 + 8);  st.o1 = MFMA_BF16(va.v, pb0.v, st.o1);
    va.h[0] = *(const u32x2*)(vt1 + 16); va.h[1] = *(const u32x2*)(vt1 + 24); st.o1 = MFMA_BF16(va.v, pb1.v, st.o1);
}

__device__ __forceinline__ void top3_insert(float v, int i, float& v0, int& i0, float& v1, int& i1, float& v2, int& i2) {
    const bool b0 = (v > v0) || (v == v0 && i < i0);
    const bool b1 = (v > v1) || (v == v1 && i < i1);
    const bool b2 = (v > v2) || (v == v2 && i < i2);
    const float nv2 = b1 ? v1 : (b2 ? v : v2); const int ni2 = b1 ? i1 : (b2 ? i : i2);
    const float nv1 = b0 ? v0 : (b1 ? v : v1); const int ni1 = b0 ? i0 : (b1 ? i : i1);
    const float nv0 = b0 ? v : v0;             const int ni0 = b0 ? i : i0;
    v0 = nv0; i0 = ni0; v1 = nv1; i1 = ni1; v2 = nv2; i2 = ni2;
}

__device__ __forceinline__ void ln_row(float (&v)[16], const float* __restrict__ g, const float* __restrict__ b, int lane) {
    float s = 0.f;
#pragma unroll
    for (int i = 0; i < 16; ++i) s += v[i];
    const float mu = wave_sum(s) * (1.f / D);
    float q = 0.f;
#pragma unroll
    for (int i = 0; i < 16; ++i) { const float d = v[i] - mu; q += d * d; }
    const float rstd = rsqrtf(wave_sum(q) * (1.f / D) + LN_EPS);
#pragma unroll
    for (int j = 0; j < 4; ++j) {
        const f32x4 gg = *(const f32x4*)(g + j * 256 + lane * 4), bb = *(const f32x4*)(b + j * 256 + lane * 4);
#pragma unroll
        for (int c = 0; c < 4; ++c) v[j * 4 + c] = (v[j * 4 + c] - mu) * rstd * gg[c] + bb[c];
    }
}

constexpr int N_PHASES = 19;

#define P_x_in (args.in[0])
#define P_xb ((u16*)(ws + WS_XB))
#define P_x1 ((float*)(ws + WS_X1))
#define P_x2 ((float*)(ws + WS_X2))
#define P_ypre ((float*)(ws + WS_YPRE))
#define P_qkv ((u16*)(ws + WS_QKV))
#define P_vT ((u16*)(ws + WS_VT))
#define P_kmean ((float*)(ws + WS_KM))
#define P_ao ((u16*)(ws + WS_AO))
#define P_og ((u16*)(ws + WS_OG))
#define P_lse ((float*)(ws + WS_LSE))
#define P_topw ((float*)(ws + WS_TOPW))
#define P_list ((int*)(ws + WS_LIST))
#define P_hb ((u16*)(ws + WS_HB))
#define P_yb ((u16*)(ws + WS_YB))
#define P_cnt_all ((int*)(ws + WS_CTL + CTL_CNT_OFF))
__global__ void __launch_bounds__(NTHR, 2) fwd(Args args) {
    extern __shared__ __attribute__((aligned(16))) unsigned char lds_raw[];
    LAS char* lds = (LAS char*)lds_raw;
    const int G = gridDim.x, bid = blockIdx.x;
    unsigned char* const ws = args.ws;
    const int lo = args.ph_lo, hi_ph = args.ph_hi;
#define IN(k) (lo <= (k) && (k) < hi_ph)
#define PH_BEGIN int tid = threadIdx.x; asm volatile("" : "+v"(tid)); const int lane = tid & 63, r32 = lane & 31, hi = lane >> 5; const int wave = __builtin_amdgcn_readfirstlane(tid >> 6); (void)lane; (void)r32; (void)hi; (void)wave

#if MK_ONE_LAUNCH
    if (threadIdx.x < 4) ((LAS unsigned*)(lds + LDS_BAR))[threadIdx.x] = 0u;
    __syncthreads();
    XcdBarrier bar = xcd_barrier_post((unsigned*)(ws + WS_CTL), (volatile LAS unsigned*)(lds + LDS_BAR));
#define GRID_BAR() xcd_barrier(bar)
#else
#define GRID_BAR() do { } while (0)
#endif
#define SEAM(k) do { if (IN(k) && IN((k) + 1)) GRID_BAR(); } while (0)

    if (IN(0) && PHK(0)) {
            PH_BEGIN;
        for (size_t i = (size_t)bid * NTHR + tid; i < (size_t)T * D / 4; i += (size_t)G * NTHR) {
            const f32x4 v = *(const f32x4*)(P_x_in + i * 4);
            u32x2 w; w[0] = cvtpk(v[0], v[1]); w[1] = cvtpk(v[2], v[3]);
            *(u32x2*)(P_xb + i * 4) = w;
        }
    }
    SEAM(0);

    for (int L = 0; L < 2; ++L) {
        const int pb = 1 + 9 * L;
        const int NQ = L == 0 ? 3072 : 9216;
        const float* wqkv = L == 0 ? args.in[1] : args.in[2];
        const float* wo = args.in[3] + (size_t)L * D * D;
        const float* xres = L == 0 ? P_x_in : P_x2;
        int* cnt = P_cnt_all + L * NE;

        if (IN(pb + 0) && PHK(1)) {
            PH_BEGIN;
            const int nitems = 64 * (NQ / 256);
            for (int it = bid; it < nitems; it += G) {
                const int mt = it & 63, nt = it >> 6;
                f32x16 acc[4][2];
                GEMM_CORE(D, P_xb + (size_t)(mt * 256 + (tid >> 2)) * D, P_xb + (size_t)(mt * 256 + (tid >> 2) + 128) * D,
                          wqkv + nt * 256 + wave * 32, NQ)
                const int wm = wave >> 2, wn = wave & 3;
                int rb = mt * 256 + wm * 128 + 4 * hi; asm volatile("" : "+v"(rb));
#pragma unroll
                for (int nb = 0; nb < 2; ++nb) {
                    const int col = nt * 256 + (wn * 2 + nb) * 32 + 4 * (r32 & 7) + (r32 >> 3);
                    const int grp = col / 3072, cc = col - grp * 3072, j = cc >> 10, c = cc & 1023, h = c >> 6, d = c & 63;
                    const int dil = grp == 0 ? 1 : (grp == 1 ? 4 : 16);
#pragma unroll
                    for (int mb = 0; mb < 4; ++mb) {
#pragma unroll
                        for (int rq = 0; rq < 4; ++rq) {
                            const int row0 = rb + mb * 32 + 8 * rq;
                            if (j < 2) {
#pragma unroll
                                for (int i = 0; i < 4; ++i) P_qkv[(size_t)(row0 + i) * NQ + col] = (u16)cvtpk(acc[mb][nb][4 * rq + i], 0.f);
                            } else {
                                const int b = row0 / SEQ, t0 = row0 - b * SEQ;
                                u16* vrow = P_vT + (size_t)grp * T * D + ((size_t)(b * NH + h) * HD + d) * SEQ;
                                if (dil == 1) {
                                    u32x2 w; w[0] = cvtpk(acc[mb][nb][4 * rq], acc[mb][nb][4 * rq + 1]); w[1] = cvtpk(acc[mb][nb][4 * rq + 2], acc[mb][nb][4 * rq + 3]);
                                    *(u32x2*)(vrow + t0) = w;
                                } else {
#pragma unroll
                                    for (int i = 0; i < 4; ++i) { const int p = t0 + i; vrow[(p % dil) * (SEQ / dil) + p / dil] = (u16)cvtpk(acc[mb][nb][4 * rq + i], 0.f); }
                                }
                            }
                        }
                    }
                }
            }
        }
        SEAM(pb + 0);

        if (L == 0) {
            if (IN(pb + 1) && PHK(2)) {
            PH_BEGIN;
                LAS float* red = (LAS float*)lds;
                for (int it = bid; it < BATCH * NH * MOBA_NB; it += G) {
                    const int j = it & 31, h = (it >> 5) & 15, b = it >> 9;
                    const int d = tid & 63, part = tid >> 6;
                    const u16* kp = P_qkv + (size_t)(b * SEQ + j * MOBA_BLK + part * 32) * 3072 + 1024 + h * 64 + d;
                    float s = 0.f;
                    for (int k = 0; k < 32; ++k) s += bf2f(kp[(size_t)k * 3072]);
                    red[part * 64 + d] = s;
                    __syncthreads();
                    if (tid < 64) {
                        float tot = 0.f;
#pragma unroll
                        for (int p8 = 0; p8 < 8; ++p8) tot += red[p8 * 64 + tid];
                        P_kmean[(size_t)it * 64 + tid] = tot * (1.f / MOBA_BLK);
                    }
                    __syncthreads();
                }
            }
            SEAM(pb + 1);
        }

        if (L == 0) {
            if (IN(pb + 2) && PHK(3)) {
            PH_BEGIN;
                for (int it = bid; it < BATCH * NH * MOBA_NB; it += G) {
                    const int rnd = it >> 8, w8 = it & 255, a8 = w8 >> 5, bh = w8 & 31;
                    const int qb = rnd == 0 ? 31 - a8 : (rnd == 1 ? 16 + a8 : (rnd == 2 ? 15 - a8 : a8));
                    const int b = bh >> 4, h = bh & 15;
                    const float slope2 = exp2f(-0.5f * (float)(h + 1)) * LOG2E;
                    const int tq = qb * MOBA_BLK + wave * 32 + r32;
                    const u16* qrow = P_qkv + (size_t)(b * SEQ + tq) * 3072 + h * 64 + hi * 8;
                    bf16x8 qf[4];
#pragma unroll
                    for (int d0 = 0; d0 < 4; ++d0) qf[d0] = *(const bf16x8*)(qrow + d0 * 16);
                    unsigned selmask = 0u;
                    if (qb > 0) {
                        const float* km = P_kmean + ((size_t)(b * NH + h) * MOBA_NB + r32) * 64 + hi * 8;
                        f32x16 gt;
#pragma unroll
                        for (int r = 0; r < 16; ++r) gt[r] = 0.f;
#pragma unroll
                        for (int d0 = 0; d0 < 4; ++d0) {
                            const f32x4 k0 = *(const f32x4*)(km + d0 * 16), k1 = *(const f32x4*)(km + d0 * 16 + 4);
                            union { bf16x8 v; unsigned u[4]; } kf;
                            kf.u[0] = cvtpk(k0[0], k0[1]); kf.u[1] = cvtpk(k0[2], k0[3]); kf.u[2] = cvtpk(k1[0], k1[1]); kf.u[3] = cvtpk(k1[2], k1[3]);
                            gt = MFMA_BF16(kf.v, qf[d0], gt);
                        }
                        float v0 = -INFINITY, v1 = -INFINITY, v2 = -INFINITY; int i0 = 99, i1 = 99, i2 = 99;
#pragma unroll
                        for (int r = 0; r < 16; ++r) { const int jb = crow(r, hi); if (jb < qb) top3_insert(gt[r], jb, v0, i0, v1, i1, v2, i2); }
                        const float ov0 = __shfl_xor(v0, 32), ov1 = __shfl_xor(v1, 32), ov2 = __shfl_xor(v2, 32);
                        const int oi0 = __shfl_xor(i0, 32), oi1 = __shfl_xor(i1, 32), oi2 = __shfl_xor(i2, 32);
                        top3_insert(ov0, oi0, v0, i0, v1, i1, v2, i2); top3_insert(ov1, oi1, v0, i0, v1, i1, v2, i2); top3_insert(ov2, oi2, v0, i0, v1, i1, v2, i2);
                        if (i0 < 32) selmask |= 1u << i0;
                        if (i1 < 32) selmask |= 1u << i1;
                        if (i2 < 32) selmask |= 1u << i2;
                    }
                    unsigned om = selmask;
#pragma unroll
                    for (int o = 32; o >= 1; o >>= 1) om |= __shfl_xor(om, o);
                    om = __builtin_amdgcn_readfirstlane(om);
                    AttnSt st; st.m = NEGV; st.l = 0.f;
#pragma unroll
                    for (int r = 0; r < 16; ++r) { st.o0[r] = 0.f; st.o1[r] = 0.f; }
                    const u16* kbase = P_qkv + (size_t)(b * SEQ) * 3072 + 1024 + h * 64 + hi * 8;
                    const u16* vtb = P_vT + ((size_t)(b * NH + h) * HD + r32) * SEQ + 4 * hi;
                    for (int kt = 0; kt <= wave; ++kt) {
                        const int k0 = qb * MOBA_BLK + kt * 32;
                        float bias[16]; unsigned okm = 0u;
#pragma unroll
                        for (int r = 0; r < 16; ++r) { const int dist = tq - (k0 + crow(r, hi)); bias[r] = -slope2 * (float)dist; okm |= (dist >= 0 ? 1u : 0u) << r; }
                        attn_step(st, qf, kbase + (size_t)(k0 + r32) * 3072, vtb + k0, SEQ, bias, okm);
                    }
                    for (int jb = 0; jb < qb; ++jb) {
                        if (!((om >> jb) & 1u)) continue;
                        const unsigned okm = ((selmask >> jb) & 1u) ? 0xFFFFu : 0u;
                        for (int kt = 0; kt < 8; ++kt) {
                            const int k0 = jb * MOBA_BLK + kt * 32;
                            float bias[16];
#pragma unroll
                            for (int r = 0; r < 16; ++r) bias[r] = -slope2 * (float)(tq - (k0 + crow(r, hi)));
                            attn_step(st, qf, kbase + (size_t)(k0 + r32) * 3072, vtb + k0, SEQ, bias, okm);
                        }
                    }
                    const float inv = 1.f / (st.l + __shfl_xor(st.l, 32));
                    u16* orow = P_ao + (size_t)(b * SEQ + tq) * D + h * 64;
#pragma unroll
                    for (int rq = 0; rq < 4; ++rq) {
                        u32x2 w; w[0] = cvtpk(st.o0[4 * rq] * inv, st.o0[4 * rq + 1] * inv); w[1] = cvtpk(st.o0[4 * rq + 2] * inv, st.o0[4 * rq + 3] * inv);
                        *(u32x2*)(orow + 8 * rq + 4 * hi) = w;
                        w[0] = cvtpk(st.o1[4 * rq] * inv, st.o1[4 * rq + 1] * inv); w[1] = cvtpk(st.o1[4 * rq + 2] * inv, st.o1[4 * rq + 3] * inv);
                        *(u32x2*)(orow + 32 + 8 * rq + 4 * hi) = w;
                    }
                }
            }
        } else {
            if (IN(pb + 2) && PHK(4)) {
            PH_BEGIN;
                for (int it = bid; it < BATCH * NH * 3 * 32; it += G) {
                    const int ch = it & 31, grp = (it >> 5) % 3, bh = it / 96, b = bh >> 4, h = bh & 15;
                    const int dil = grp == 0 ? 1 : (grp == 1 ? 4 : 16), Ls = SEQ / dil;
                    const float slope2 = exp2f(-0.5f * (float)(h + 1)) * LOG2E * (float)dil;
                    const int u0 = ch * 256 + wave * 32, res = u0 / Ls, i0 = u0 - res * Ls;
                    const int iq = i0 + r32, pq = iq * dil + res;
                    const u16* qrow = P_qkv + (size_t)(b * SEQ + pq) * 9216 + grp * 3072 + h * 64 + hi * 8;
                    bf16x8 qf[4];
#pragma unroll
                    for (int d0 = 0; d0 < 4; ++d0) qf[d0] = *(const bf16x8*)(qrow + d0 * 16);
                    AttnSt st; st.m = NEGV; st.l = 0.f;
#pragma unroll
                    for (int r = 0; r < 16; ++r) { st.o0[r] = 0.f; st.o1[r] = 0.f; }
                    const u16* kbase = P_qkv + (size_t)(b * SEQ) * 9216 + grp * 3072 + 1024 + h * 64 + hi * 8;
                    const u16* vtb = P_vT + (size_t)grp * T * D + ((size_t)(b * NH + h) * HD + r32) * SEQ + (size_t)res * Ls + 4 * hi;
                    for (int kt = 4; kt >= 0; --kt) {
                        const int k0 = i0 - 128 + kt * 32;
                        if (k0 < 0) continue;
                        float bias[16]; unsigned okm = 0u;
#pragma unroll
                        for (int r = 0; r < 16; ++r) { const int steps = iq - (k0 + crow(r, hi)); bias[r] = -slope2 * (float)steps; okm |= ((steps >= 0 && steps <= 128) ? 1u : 0u) << r; }
                        attn_step(st, qf, kbase + (size_t)((k0 + r32) * dil + res) * 9216, vtb + k0, SEQ, bias, okm);
                    }
                    const float lt = st.l + __shfl_xor(st.l, 32);
                    const float inv = 1.f / lt;
                    u16* orow = P_og + (size_t)grp * T * D + (size_t)(b * SEQ + pq) * D + h * 64;
#pragma unroll
                    for (int rq = 0; rq < 4; ++rq) {
                        u32x2 w; w[0] = cvtpk(st.o0[4 * rq] * inv, st.o0[4 * rq + 1] * inv); w[1] = cvtpk(st.o0[4 * rq + 2] * inv, st.o0[4 * rq + 3] * inv);
                        *(u32x2*)(orow + 8 * rq + 4 * hi) = w;
                        w[0] = cvtpk(st.o1[4 * rq] * inv, st.o1[4 * rq + 1] * inv); w[1] = cvtpk(st.o1[4 * rq + 2] * inv, st.o1[4 * rq + 3] * inv);
                        *(u32x2*)(orow + 32 + 8 * rq + 4 * hi) = w;
                    }
                    if (hi == 0) P_lse[((size_t)grp * T + (b * SEQ + pq)) * NH + h] = st.m * LN2 + logf(lt);
                }
            }
        }
        SEAM(pb + 2);

        if (L == 1) {
            if (IN(pb + 3) && PHK(5)) {
            PH_BEGIN;
                for (size_t i = (size_t)bid * NTHR + tid; i < (size_t)T * NH * 8; i += (size_t)G * NTHR) {
                    const size_t row = i >> 7; const int h = (int)(i >> 3) & 15, d8 = (int)i & 7;
                    const float l0 = P_lse[(0 * (size_t)T + row) * NH + h], l1 = P_lse[(1 * (size_t)T + row) * NH + h], l2 = P_lse[(2 * (size_t)T + row) * NH + h];
                    const float mx = fmaxf(l0, fmaxf(l1, l2));
                    float w0 = expf(l0 - mx), w1 = expf(l1 - mx), w2 = expf(l2 - mx);
                    const float inv = 1.f / (w0 + w1 + w2); w0 *= inv; w1 *= inv; w2 *= inv;
                    const size_t off = row * D + h * 64 + d8 * 8;
                    const u32x4 a0 = *(const u32x4*)(P_og + off), a1 = *(const u32x4*)(P_og + (size_t)T * D + off), a2 = *(const u32x4*)(P_og + 2 * (size_t)T * D + off);
                    u32x4 o;
#pragma unroll
                    for (int c = 0; c < 4; ++c) {
                        const float lo_ = w0 * bf2f(a0[c] & 0xFFFFu) + w1 * bf2f(a1[c] & 0xFFFFu) + w2 * bf2f(a2[c] & 0xFFFFu);
                        const float hi_ = w0 * bf2f(a0[c] >> 16) + w1 * bf2f(a1[c] >> 16) + w2 * bf2f(a2[c] >> 16);
                        o[c] = cvtpk(lo_, hi_);
                    }
                    *(u32x4*)(P_ao + off) = o;
                }
            }
            SEAM(pb + 3);
        }

        if (IN(pb + 4) && PHK(6)) {
            PH_BEGIN;
            for (int it = bid; it < 64 * 4; it += G) {
                const int mt = it & 63, nt = it >> 6;
                f32x16 acc[4][2];
                GEMM_CORE(D, P_ao + (size_t)(mt * 256 + (tid >> 2)) * D, P_ao + (size_t)(mt * 256 + (tid >> 2) + 128) * D,
                          wo + nt * 256 + wave * 32, D)
                const int wm = wave >> 2, wn = wave & 3;
                int rb = mt * 256 + wm * 128 + 4 * hi; asm volatile("" : "+v"(rb));
#pragma unroll
                for (int nb = 0; nb < 2; ++nb) {
                    const int col = nt * 256 + (wn * 2 + nb) * 32 + 4 * (r32 & 7) + (r32 >> 3);
                    const float* xr = xres + (size_t)rb * D + col; float* yp = P_ypre + (size_t)rb * D + col;
#pragma unroll
                    for (int mb = 0; mb < 4; ++mb) {
#pragma unroll
                        for (int r = 0; r < 16; ++r) {
                            const int o = (mb * 32 + (r & 3) + 8 * (r >> 2)) * D;
                            yp[o] = DN_ALPHA * xr[o] + acc[mb][nb][r];
                        }
                        asm volatile("" ::: "memory");
                    }
                }
            }
        }
        SEAM(pb + 4);

        if (IN(pb + 5) && PHK(7)) {
            PH_BEGIN;
            const float* lng = args.in[4] + L * D; const float* lnb = args.in[5] + L * D;
            const float* wr = args.in[6] + (size_t)L * D * NE; const float* rbias = args.in[7] + L * NE;
            LAS float* xs = (LAS float*)lds;
            for (int it = bid; it < T / 32; it += G) {
#pragma unroll 1
                for (int rr = 0; rr < 4; ++rr) {
                    const int lr = wave * 4 + rr; const size_t row = (size_t)it * 32 + lr;
                    float v[16];
#pragma unroll
                    for (int j = 0; j < 4; ++j) { const f32x4 t4 = *(const f32x4*)(P_ypre + row * D + j * 256 + lane * 4); v[j * 4] = t4[0]; v[j * 4 + 1] = t4[1]; v[j * 4 + 2] = t4[2]; v[j * 4 + 3] = t4[3]; }
                    ln_row(v, lng, lnb, lane);
#pragma unroll
                    for (int j = 0; j < 4; ++j) {
                        f32x4 t4; t4[0] = v[j * 4]; t4[1] = v[j * 4 + 1]; t4[2] = v[j * 4 + 2]; t4[3] = v[j * 4 + 3];
                        *(f32x4*)(P_x1 + row * D + j * 256 + lane * 4) = t4;
                        *(LAS f32x4*)(xs + lr * XS_PITCH + j * 256 + lane * 4) = t4;
                        u32x2 w; w[0] = cvtpk(t4[0], t4[1]); w[1] = cvtpk(t4[2], t4[3]);
                        *(u32x2*)(P_xb + row * D + j * 256 + lane * 4) = w;
                    }
                }
                __syncthreads();
                f32x16 lg;
#pragma unroll
                for (int r = 0; r < 16; ++r) lg[r] = 0.f;
                {
                    const LAS float* ap = xs + r32 * XS_PITCH + hi;
                    const float* bp = wr + (size_t)hi * NE + wave * 32 + r32;
#pragma unroll 8
                    for (int k = 0; k < D; k += 2) lg = __builtin_amdgcn_mfma_f32_32x32x2f32(ap[k], bp[(size_t)k * NE], lg, 0, 0, 0);
                }
                __syncthreads();
                LAS float* lgs = (LAS float*)lds;
#pragma unroll
                for (int r = 0; r < 16; ++r) lgs[crow(r, hi) * 257 + wave * 32 + r32] = lg[r];
                __syncthreads();
#pragma unroll 1
                for (int rr = 0; rr < 4; ++rr) {
                    const int lr = wave * 4 + rr; const int tok = it * 32 + lr;
                    float sc[4], ch[4];
#pragma unroll
                    for (int j = 0; j < 4; ++j) { const int e = lane + 64 * j; sc[j] = 1.f / (1.f + expf(-lgs[lr * 257 + e])); ch[j] = sc[j] + rbias[e]; }
                    float gsel[8], gmine[4];
#pragma unroll
                    for (int j = 0; j < 4; ++j) {
                        float m1 = ch[j];
#pragma unroll
                        for (int o = 16; o >= 1; o >>= 1) m1 = fmaxf(m1, __shfl_xor(m1, o));
                        const unsigned long long bal = __ballot(ch[j] == m1);
                        const unsigned half = (unsigned)(hi ? (bal >> 32) : (bal & 0xFFFFFFFFull));
                        const int first = __builtin_ctz(half);
                        float m2 = (r32 == first) ? -INFINITY : ch[j];
#pragma unroll
                        for (int o = 16; o >= 1; o >>= 1) m2 = fmaxf(m2, __shfl_xor(m2, o));
                        const float mine = m1 + m2, other = __shfl_xor(mine, 32);
                        gsel[2 * j] = hi ? other : mine; gsel[2 * j + 1] = hi ? mine : other; gmine[j] = mine;
                    }
                    bool gok[4];
#pragma unroll
                    for (int j = 0; j < 4; ++j) {
                        const float mygs = gmine[j];
                        const int myg = 2 * j + hi;
                        int rank = 0;
#pragma unroll
                        for (int g2 = 0; g2 < 8; ++g2) rank += ((gsel[g2] > mygs) || (gsel[g2] == mygs && g2 < myg)) ? 1 : 0;
                        gok[j] = rank < 4;
                    }
                    float cv[4];
#pragma unroll
                    for (int j = 0; j < 4; ++j) cv[j] = gok[j] ? ch[j] : NEGV;
                    float wsel = 0.f; int esel = 0; float wsum = 0.f;
#pragma unroll 1
                    for (int k = 0; k < TOPK; ++k) {
                        float bv = cv[0]; int be = lane;
#pragma unroll
                        for (int j = 1; j < 4; ++j) if (cv[j] > bv) { bv = cv[j]; be = lane + 64 * j; }
#pragma unroll
                        for (int o = 32; o >= 1; o >>= 1) {
                            const float ov = __shfl_xor(bv, o); const int oe = __shfl_xor(be, o);
                            if (ov > bv || (ov == bv && oe < be)) { bv = ov; be = oe; }
                        }
                        const int jl = be >> 6, ll = be & 63;
                        float smine = sc[0];
                        smine = jl == 1 ? sc[1] : smine; smine = jl == 2 ? sc[2] : smine; smine = jl == 3 ? sc[3] : smine;
                        const float sw = __shfl(smine, ll);
#pragma unroll
                        for (int j = 0; j < 4; ++j) cv[j] = (lane == ll && jl == j) ? -INFINITY : cv[j];
                        wsum += sw;
                        if (lane == k) { wsel = sw; esel = be; }
                    }
                    if (lane < TOPK) {
                        const int a = tok * TOPK + lane;
                        P_topw[a] = wsel / wsum * 2.5f;
                        const int pos = atomicAdd(&cnt[esel], 1);
                        P_list[(size_t)esel * T + pos] = a;
                    }
                }
                __syncthreads();
            }
        }
        SEAM(pb + 5);

        if (IN(pb + 6) && PHK(8)) {
            PH_BEGIN;
            const float* weg = args.in[8] + (size_t)L * NE * D * DF; const float* weu = args.in[9] + (size_t)L * NE * D * DF;
            const float* wsg = args.in[11] + (size_t)L * D * DF; const float* wsu = args.in[12] + (size_t)L * D * DF;
            LAS int* rowid = (LAS int*)(lds + LDS_ROWID);
            for (int e = bid; e < NE + 64; e += G) {
                const bool shared = e >= NE;
                const int n = shared ? 256 : cnt[e];
                const int nrt = (n + 255) >> 8;
                const float* wg_ = shared ? wsg : weg + (size_t)e * D * DF;
                const float* wu_ = shared ? wsu : weu + (size_t)e * D * DF;
                for (int rt = 0; rt < nrt; ++rt) {
                    if (tid < 256) {
                        const int idx = rt * 256 + tid;
                        rowid[tid] = shared ? (A_TOT + (e - NE) * 256 + tid) : (idx < n ? P_list[(size_t)e * T + idx] : -1);
                    }
                    __syncthreads();
                    const int va0 = rowid[tid >> 2], va1 = rowid[(tid >> 2) + 128];
                    const u16* pa0 = va0 < 0 ? nullptr : P_xb + (size_t)(va0 < A_TOT ? (va0 >> 3) : (va0 - A_TOT)) * D;
                    const u16* pa1 = va1 < 0 ? nullptr : P_xb + (size_t)(va1 < A_TOT ? (va1 >> 3) : (va1 - A_TOT)) * D;
#pragma unroll 1
                    for (int fc = 0; fc < 2; ++fc) {
                        f32x16 acc[4][2];
                        const float* pbseg = ((wave & 1) ? wu_ : wg_) + fc * 128 + (wave >> 1) * 32;
                        GEMM_CORE(D, pa0, pa1, pbseg, DF)
                        const int wm = wave >> 2, wn = wave & 3;
                        const int f = fc * 128 + wn * 32 + 4 * (r32 & 7) + (r32 >> 3);
                        int rbase = wm * 128 + 4 * hi; asm volatile("" : "+v"(rbase));
#pragma unroll
                        for (int mb = 0; mb < 4; ++mb) {
#pragma unroll
                            for (int r = 0; r < 16; ++r) {
                                const int va = rowid[rbase + mb * 32 + (r & 3) + 8 * (r >> 2)];
                                if (va >= 0) {
                                    const float gt = acc[mb][0][r], up = acc[mb][1][r];
                                    const float hval = gt / (1.f + expf(-gt)) * up;
                                    P_hb[(size_t)va * DF + f] = (u16)cvtpk(hval, 0.f);
                                }
                            }
                            asm volatile("" ::: "memory");
                        }
                    }
                    __syncthreads();
                }
            }
        }
        SEAM(pb + 6);

        if (IN(pb + 7) && PHK(9)) {
            PH_BEGIN;
            const float* wed = args.in[10] + (size_t)L * NE * DF * D; const float* wsd = args.in[13] + (size_t)L * DF * D;
            LAS int* rowid = (LAS int*)(lds + LDS_ROWID);
            LAS float* roww = (LAS float*)(lds + LDS_ROWW);
            for (int e = bid; e < NE + 64; e += G) {
                const bool shared = e >= NE;
                const int n = shared ? 256 : cnt[e];
                const int nrt = (n + 255) >> 8;
                const float* wd_ = shared ? wsd : wed + (size_t)e * DF * D;
                for (int rt = 0; rt < nrt; ++rt) {
                    if (tid < 256) {
                        const int idx = rt * 256 + tid;
                        const int va = shared ? (A_TOT + (e - NE) * 256 + tid) : (idx < n ? P_list[(size_t)e * T + idx] : -1);
                        rowid[tid] = va;
                        roww[tid] = (va >= 0 && va < A_TOT) ? P_topw[va] : 1.f;
                    }
                    __syncthreads();
                    const int va0 = rowid[tid >> 2], va1 = rowid[(tid >> 2) + 128];
                    const u16* pa0 = va0 < 0 ? nullptr : P_hb + (size_t)va0 * DF;
                    const u16* pa1 = va1 < 0 ? nullptr : P_hb + (size_t)va1 * DF;
#pragma unroll 1
                    for (int nt = 0; nt < 4; ++nt) {
                        f32x16 acc[4][2];
                        GEMM_CORE(DF, pa0, pa1, wd_ + nt * 256 + wave * 32, D)
                        const int wm = wave >> 2, wn = wave & 3;
                        int rbase = wm * 128 + 4 * hi; asm volatile("" : "+v"(rbase));
#pragma unroll
                        for (int nb = 0; nb < 2; ++nb) {
                            const int col = nt * 256 + (wn * 2 + nb) * 32 + 4 * (r32 & 7) + (r32 >> 3);
#pragma unroll
                            for (int mb = 0; mb < 4; ++mb) {
#pragma unroll
                                for (int r = 0; r < 16; ++r) {
                                    const int lrow = rbase + mb * 32 + (r & 3) + 8 * (r >> 2);
                                    const int va = rowid[lrow];
                                    if (va >= 0) P_yb[(size_t)va * D + col] = (u16)cvtpk(acc[mb][nb][r] * roww[lrow], 0.f);
                                }
                                asm volatile("" ::: "memory");
                            }
                        }
                    }
                    __syncthreads();
                }
            }
        }
        SEAM(pb + 7);

        if (IN(pb + 8) && PHK(10)) {
            PH_BEGIN;
            const float* lng = args.in[14] + L * D; const float* lnb = args.in[15] + L * D;
            float* dst = L == 0 ? P_x2 : args.out;
            for (int row = bid * 8 + wave; row < T; row += G * 8) {
                float v[16];
#pragma unroll
                for (int j = 0; j < 4; ++j) { const f32x4 t4 = *(const f32x4*)(P_x1 + (size_t)row * D + j * 256 + lane * 4); v[j * 4] = DN_ALPHA * t4[0]; v[j * 4 + 1] = DN_ALPHA * t4[1]; v[j * 4 + 2] = DN_ALPHA * t4[2]; v[j * 4 + 3] = DN_ALPHA * t4[3]; }
#pragma unroll 1
                for (int k = 0; k < TOPK + 1; ++k) {
                    const size_t va = k < TOPK ? (size_t)row * TOPK + k : (size_t)A_TOT + row;
#pragma unroll
                    for (int j = 0; j < 4; ++j) {
                        const u32x2 w = *(const u32x2*)(P_yb + va * D + j * 256 + lane * 4);
                        v[j * 4] += bf2f(w[0] & 0xFFFFu); v[j * 4 + 1] += bf2f(w[0] >> 16); v[j * 4 + 2] += bf2f(w[1] & 0xFFFFu); v[j * 4 + 3] += bf2f(w[1] >> 16);
                    }
                }
                ln_row(v, lng, lnb, lane);
#pragma unroll
                for (int j = 0; j < 4; ++j) {
                    f32x4 t4; t4[0] = v[j * 4]; t4[1] = v[j * 4 + 1]; t4[2] = v[j * 4 + 2]; t4[3] = v[j * 4 + 3];
                    *(f32x4*)(dst + (size_t)row * D + j * 256 + lane * 4) = t4;
                    if (L == 0) { u32x2 w; w[0] = cvtpk(t4[0], t4[1]); w[1] = cvtpk(t4[2], t4[3]); *(u32x2*)(P_xb + (size_t)row * D + j * 256 + lane * 4) = w; }
                }
            }
        }
        if (L == 0) SEAM(pb + 8);
    }
}

extern "C" void kernel_launch(void* const* d_in, const int* in_sizes, int n_in, void* d_out, int out_size, void* d_ws, size_t ws_size, hipStream_t stream) {
    static int grid = 0;
    if (grid == 0) {
        if (n_in != 16 || out_size != T * D || ws_size < WS_END) { fprintf(stderr, "kernel_launch: unexpected problem (n_in %d out %d ws %zu need %zu)\n", n_in, out_size, ws_size, (size_t)WS_END); grid = -1; return; }
        int dev = 0, cus = 0, per_cu = 0;
        if (hipGetDevice(&dev) != hipSuccess || hipDeviceGetAttribute(&cus, hipDeviceAttributeMultiprocessorCount, dev) != hipSuccess) { grid = -1; return; }
        if (hipFuncSetAttribute((const void*)fwd, hipFuncAttributeMaxDynamicSharedMemorySize, LDS_BYTES) != hipSuccess) { fprintf(stderr, "kernel_launch: hipFuncSetAttribute failed\n"); grid = -1; return; }
        if (hipOccupancyMaxActiveBlocksPerMultiprocessor(&per_cu, (const void*)fwd, NTHR, LDS_BYTES) != hipSuccess || per_cu < 1) { fprintf(stderr, "kernel_launch: occupancy query says %d\n", per_cu); (void)hipGetLastError(); per_cu = 1; }
        grid = cus;
    }
    if (grid < 0) return;
    (void)hipMemsetAsync((char*)d_ws + WS_CTL, 0, CTL_BYTES, stream);
    Args a{};
    for (int i = 0; i < 16; ++i) a.in[i] = (const float*)d_in[i];
    a.out = (float*)d_out; a.ws = (unsigned char*)d_ws;
#if MK_ONE_LAUNCH
    a.ph_lo = 0; a.ph_hi = N_PHASES;
    hipLaunchKernelGGL(fwd, dim3(grid), dim3(NTHR), LDS_BYTES, stream, a);
#else
    for (int ph = 0; ph < N_PHASES; ++ph) {
        if (ph == 4 || ph == 11) continue;
        a.ph_lo = ph; a.ph_hi = ph + 1;
        hipLaunchKernelGGL(fwd, dim3(grid), dim3(NTHR), LDS_BYTES, stream, a);
    }
#endif
}
```

```cpp
#include <hip/hip_runtime.h>
#include <hip/hip_bf16.h>
#include <stdint.h>
#include <stdio.h>

#ifndef MK_ONE_LAUNCH
#define MK_ONE_LAUNCH 1
#endif

#ifndef PHMASK
#define PHMASK 0x1FFF
#endif
#define PHK(k) ((PHMASK >> (k)) & 1)
#ifndef REPEAT_KIND
#define REPEAT_KIND -1
#endif
#define REPS(k) ((k) == REPEAT_KIND ? 2 : 1)
#define LAS __attribute__((address_space(3)))
typedef __attribute__((ext_vector_type(8))) short bf16x8;
typedef __attribute__((ext_vector_type(16))) float f32x16;
typedef __attribute__((ext_vector_type(4))) float f32x4;
typedef __attribute__((ext_vector_type(4))) unsigned u32x4;
typedef __attribute__((ext_vector_type(2))) unsigned u32x2;
typedef unsigned short u16;

constexpr int D = 1024, BATCH = 2, SEQ = 8192, T = BATCH * SEQ, NH = 16, HD = 64;
constexpr int NE = 256, TOPK = 8, DF = 256;
constexpr int A_TOT = T * TOPK;
constexpr int MOBA_BLK = 256, MOBA_NB = SEQ / MOBA_BLK;
constexpr float DN_ALPHA = 1.4142135623730951f;
constexpr float LN_EPS = 1e-5f;
constexpr float LOG2E = 1.4426950408889634f;
constexpr float LN2 = 0.6931471805599453f;
constexpr float NEGV = -1e30f;
constexpr int NTHR = 512;

constexpr size_t al256(size_t x) { return (x + 255) & ~(size_t)255; }
constexpr size_t WS_CTL = 0;
constexpr size_t CTL_BYTES = 65536;
constexpr size_t CTL_CNT_OFF = 32768;
constexpr size_t WS_XB = WS_CTL + CTL_BYTES;
constexpr size_t WS_X1 = WS_XB + al256((size_t)T * D * 2);
constexpr size_t WS_X2 = WS_X1 + al256((size_t)T * D * 4);
constexpr size_t WS_YPRE = WS_X2 + al256((size_t)T * D * 4);
constexpr size_t WS_QKV = WS_YPRE + al256((size_t)T * D * 4);
constexpr size_t WS_VT = WS_QKV + al256((size_t)T * 9216 * 2);
constexpr size_t WS_KM = WS_VT + al256((size_t)3 * T * D * 2);
constexpr size_t WS_AO = WS_KM + al256((size_t)BATCH * NH * MOBA_NB * HD * 4);
constexpr size_t WS_OG = WS_AO + al256((size_t)T * D * 2);
constexpr size_t WS_LSE = WS_OG + al256((size_t)3 * T * D * 2);
constexpr size_t WS_TOPW = WS_LSE + al256((size_t)3 * T * NH * 4);
constexpr size_t WS_LIST = WS_TOPW + al256((size_t)T * TOPK * 4);
constexpr size_t WS_HB = WS_LIST + al256((size_t)NE * T * 4);
constexpr size_t WS_YB = WS_HB + al256((size_t)(A_TOT + T + 1) * DF * 2);
constexpr size_t WS_END = WS_YB + al256((size_t)(A_TOT + T + 1) * D * 2);
constexpr int TRASH_VA = A_TOT + T;
constexpr size_t WS_SELM = WS_END;
constexpr size_t WS_PART = WS_SELM + al256((size_t)T * NH * 4);
constexpr size_t WS_PLSE = WS_PART + al256((size_t)T * NH * 4 * 64 * 2);
constexpr size_t WS_END2 = WS_PLSE + al256((size_t)T * NH * 4 * 4);

constexpr int LDP = 40;
constexpr int STAGE_BYTES = 2 * 256 * LDP * 2;
constexpr int LDS_ROWID = 2 * STAGE_BYTES;
constexpr int LDS_ROWW = LDS_ROWID + 1024;
constexpr int XS_PITCH = 1028;
constexpr int LDS_BYTES = 32 * XS_PITCH * 4 + 1024;
constexpr int LDS_BAR = 32 * XS_PITCH * 4;

#define XB_TMO      128
#define XB_XCNT(j)  (256  + 64 * (j))
#define XB_XSUB(j)  (1280 + 64 * (j))
#define XB_XGEN(j)  (2304 + 64 * (j))
#define XB_TOP      3328
#define XB_TOPGEN   3392
#define XCD_BAR_WORDS 3456
#define XB_SPIN_CAP (1u << 18)
__device__ __forceinline__ unsigned xb_ld(unsigned* p)              { return __hip_atomic_load(p, __ATOMIC_RELAXED, __HIP_MEMORY_SCOPE_AGENT); }
__device__ __forceinline__ unsigned xb_add(unsigned* p, unsigned v) { return __hip_atomic_fetch_add(p, v, __ATOMIC_RELAXED, __HIP_MEMORY_SCOPE_AGENT); }
__device__ __forceinline__ unsigned xb_xcc_id() { return (unsigned)__builtin_amdgcn_s_getreg((3 << 11) | 20) & 0xFu; }
#define XB_SPIN(cond, bar) do { unsigned _sp = 0; while (cond) { __builtin_amdgcn_s_sleep(1); \
    if ((++_sp & 255u) == 0u) { if (xb_ld(&(bar)[XB_TMO])) break; if (_sp > XB_SPIN_CAP) { atomicAdd(&(bar)[XB_TMO], 1u); break; } } } } while (0)
struct XcdBarrier { unsigned* bar; unsigned x; volatile LAS unsigned* st; };
__device__ __forceinline__ XcdBarrier xcd_barrier_post(unsigned* bar, volatile LAS unsigned* st) {
    XcdBarrier b; b.bar = bar; b.x = xb_xcc_id(); b.st = st;
    if (threadIdx.x == 0) (void)xb_add(&bar[XB_XCNT(b.x)], 1u);
    return b;
}
__device__ __forceinline__ void xcd_barrier_complete(unsigned* bar, unsigned x, unsigned& nloc, unsigned& nx) {
    const unsigned G = gridDim.x * gridDim.y * gridDim.z;
    unsigned sum, cnt, mine, sp = 0u;
    for (;;) {
        sum = 0u; cnt = 0u; mine = 0u;
#pragma unroll
        for (unsigned j = 0; j < 16; ++j) { const unsigned c = xb_ld(&bar[XB_XCNT(j)]); sum += c; cnt += (c > 0u) ? 1u : 0u; mine = (j == x) ? c : mine; }
        if (sum == G) break;
        __builtin_amdgcn_s_sleep(1);
        if ((++sp & 255u) == 0u) { if (xb_ld(&bar[XB_TMO])) break; if (sp > XB_SPIN_CAP) { atomicAdd(&bar[XB_TMO], 1u); break; } }
    }
    nloc = mine > 0u ? mine : 1u; nx = cnt > 0u ? cnt : 1u;
}
__device__ __forceinline__ void xcd_barrier(const XcdBarrier& b) {
    asm volatile("s_waitcnt vmcnt(0)" ::: "memory");
    __syncthreads();
    if (threadIdx.x == 0) {
        unsigned* bar = b.bar;
        __builtin_amdgcn_s_waitcnt(0);
        unsigned nloc = b.st[0], nx = b.st[1];
        if (nloc == 0u) { xcd_barrier_complete(bar, b.x, nloc, nx); b.st[0] = nloc; b.st[1] = nx; }
        const unsigned old = xb_add(&bar[XB_XSUB(b.x)], 1u);
        const unsigned gen = old / nloc;
        if (old + 1u == (gen + 1u) * nloc) {
            __builtin_amdgcn_fence(__ATOMIC_RELEASE, "agent");
            asm volatile("s_waitcnt vmcnt(0)" ::: "memory");
            const unsigned og = xb_add(&bar[XB_TOP], 1u);
            const unsigned tg = og / nx;
            if (og + 1u == (tg + 1u) * nx) xb_add(&bar[XB_TOPGEN], 1u);
            else XB_SPIN(xb_ld(&bar[XB_TOPGEN]) == tg, bar);
            __builtin_amdgcn_fence(__ATOMIC_ACQUIRE, "agent");
            xb_add(&bar[XB_XGEN(b.x)], 1u);
            asm volatile("s_waitcnt vmcnt(0)" ::: "memory");
        } else {
            XB_SPIN(xb_ld(&bar[XB_XGEN(b.x)]) == gen, bar);
            __builtin_amdgcn_fence(__ATOMIC_ACQUIRE, "agent");
            asm volatile("s_waitcnt vmcnt(0)" ::: "memory");
        }
    }
    __syncthreads();
}

typedef __attribute__((ext_vector_type(2))) __bf16 bf16x2_t;
typedef __attribute__((ext_vector_type(2))) float f32x2_t;
__device__ __forceinline__ unsigned cvtpk(float lo, float hi) { f32x2_t f; f[0] = lo; f[1] = hi; return __builtin_bit_cast(unsigned, __builtin_convertvector(f, bf16x2_t)); }
__device__ __forceinline__ float bf2f(unsigned v16) { return __uint_as_float(v16 << 16); }
__device__ __forceinline__ int crow(int r, int hi) { return (r & 3) + 8 * (r >> 2) + 4 * hi; }
#define MFMA_BF16(a, b, c) __builtin_amdgcn_mfma_f32_32x32x16_bf16(a, b, c, 0, 0, 0)
__device__ __forceinline__ float wave_sum(float v) {
#pragma unroll
    for (int o = 32; o >= 1; o >>= 1) v += __shfl_xor(v, o);
    return v;
}

struct Args {
    const float* in[16];
    float* out;
    unsigned char* ws;
    int ph_lo, ph_hi;
};

#define GEMM_CORE(K_, PA0, PA1, PB, LDB)                                                                                                   \
    {                                                                                                                                      \
        const int g_tid = tid, g_lane = lane, g_wave = wave, g_r32 = r32, g_hi = hi;                   \
        const int g_wm = g_wave >> 2, g_wn = g_wave & 3, g_kc = g_tid & 3, g_kq = g_lane >> 3, g_n4 = g_lane & 7;                           \
        const u16* g_pa0 = (PA0); const u16* g_pa1 = (PA1);                                                                                \
        const size_t g_ldb = (size_t)(LDB);                                                                                                \
        const float* g_pb = (PB) + (size_t)(g_kq * 4) * g_ldb + g_n4 * 4;                                                                  \
        const int g_nk = (K_) / 32;                                                                                                        \
        u32x4 g_ra0, g_ra1; f32x4 g_rb0, g_rb1, g_rb2, g_rb3;                                                                              \
        const u32x4 g_z = {0u, 0u, 0u, 0u};                                                                                                \
        _Pragma("unroll") for (int mb = 0; mb < 4; ++mb) { _Pragma("unroll") for (int nb = 0; nb < 2; ++nb) { _Pragma("unroll") for (int r = 0; r < 16; ++r) acc[mb][nb][r] = 0.f; } } \
        g_ra0 = g_pa0 ? *(const u32x4*)(g_pa0 + g_kc * 8) : g_z; g_ra1 = g_pa1 ? *(const u32x4*)(g_pa1 + g_kc * 8) : g_z;                 \
        g_rb0 = *(const f32x4*)(g_pb); g_rb1 = *(const f32x4*)(g_pb + g_ldb); g_rb2 = *(const f32x4*)(g_pb + 2 * g_ldb); g_rb3 = *(const f32x4*)(g_pb + 3 * g_ldb); \
        _Pragma("unroll 1") for (int kt = 0; kt < g_nk; ++kt) {                                                                            \
            LAS char* As = lds + (kt & 1) * STAGE_BYTES; LAS char* Bs = As + 256 * LDP * 2;                                                \
            *(LAS u32x4*)(As + ((g_tid >> 2) * LDP + g_kc * 8) * 2) = g_ra0;                                                               \
            *(LAS u32x4*)(As + (((g_tid >> 2) + 128) * LDP + g_kc * 8) * 2) = g_ra1;                                                       \
            _Pragma("unroll") for (int i = 0; i < 4; ++i) {                                                                                \
                u32x2 w; w[0] = cvtpk(g_rb0[i], g_rb1[i]); w[1] = cvtpk(g_rb2[i], g_rb3[i]);                                               \
                *(LAS u32x2*)(Bs + ((g_wave * 32 + i * 8 + g_n4) * LDP + g_kq * 4) * 2) = w;                                               \
            }                                                                                                                              \
            __syncthreads();                                                                                                               \
            if (kt + 1 < g_nk) {                                                                                                           \
                const int ko = (kt + 1) * 32;                                                                                              \
                g_ra0 = g_pa0 ? *(const u32x4*)(g_pa0 + ko + g_kc * 8) : g_z; g_ra1 = g_pa1 ? *(const u32x4*)(g_pa1 + ko + g_kc * 8) : g_z; \
                const float* pbk = g_pb + (size_t)ko * g_ldb;                                                                              \
                g_rb0 = *(const f32x4*)(pbk); g_rb1 = *(const f32x4*)(pbk + g_ldb); g_rb2 = *(const f32x4*)(pbk + 2 * g_ldb); g_rb3 = *(const f32x4*)(pbk + 3 * g_ldb); \
            }                                                                                                                              \
            _Pragma("unroll") for (int s = 0; s < 2; ++s) {                                                                                \
                bf16x8 af[4], bfr[2];                                                                                                      \
                _Pragma("unroll") for (int mb = 0; mb < 4; ++mb) af[mb] = *(LAS bf16x8*)(As + ((g_wm * 128 + mb * 32 + g_r32) * LDP + s * 16 + g_hi * 8) * 2); \
                _Pragma("unroll") for (int nb = 0; nb < 2; ++nb) bfr[nb] = *(LAS bf16x8*)(Bs + (((g_wn * 2 + nb) * 32 + g_r32) * LDP + s * 16 + g_hi * 8) * 2); \
                _Pragma("unroll") for (int mb = 0; mb < 4; ++mb) { _Pragma("unroll") for (int nb = 0; nb < 2; ++nb) acc[mb][nb] = MFMA_BF16(af[mb], bfr[nb], acc[mb][nb]); } \
            }                                                                                                                              \
        }                                                                                                                                  \
        __syncthreads();                                                                                                                   \
    }

struct AttnSt { float m, l; f32x16 o0, o1; };

struct AttnFr { bf16x8 k[4]; bf16x8 v[4]; };
__device__ __forceinline__ void attn_load(AttnFr& f, const u16* krow, const u16* vt, size_t vt_dstride) {
#pragma unroll
    for (int d0 = 0; d0 < 4; ++d0) f.k[d0] = *(const bf16x8*)(krow + d0 * 16);
    const u16* vt1 = vt + 32 * vt_dstride;
    union { bf16x8 v; u32x2 h[2]; } va;
    va.h[0] = *(const u32x2*)(vt);       va.h[1] = *(const u32x2*)(vt + 8);   f.v[0] = va.v;
    va.h[0] = *(const u32x2*)(vt + 16);  va.h[1] = *(const u32x2*)(vt + 24);  f.v[1] = va.v;
    va.h[0] = *(const u32x2*)(vt1);      va.h[1] = *(const u32x2*)(vt1 + 8);  f.v[2] = va.v;
    va.h[0] = *(const u32x2*)(vt1 + 16); va.h[1] = *(const u32x2*)(vt1 + 24); f.v[3] = va.v;
}
__device__ __forceinline__ void attn_compute(AttnSt& st, const bf16x8 (&qf)[4], const AttnFr& f, int dist0, float bslope, int dlo, int dhi, int hi) {
    f32x16 p;
#pragma unroll
    for (int r = 0; r < 16; ++r) p[r] = 0.f;
#pragma unroll
    for (int d0 = 0; d0 < 4; ++d0) p = MFMA_BF16(f.k[d0], qf[d0], p);
    constexpr float C2 = 0.125f * LOG2E;
    float mx = NEGV;
#pragma unroll
    for (int r = 0; r < 16; ++r) {
        const int dist = dist0 - ((r & 3) + 8 * (r >> 2));
        const float sc = __builtin_fmaf(p[r], C2, -bslope * (float)dist);
        const float s_ = (dist >= dlo && dist <= dhi) ? sc : NEGV;
        p[r] = s_; mx = fmaxf(mx, s_);
    }
    mx = fmaxf(mx, __shfl_xor(mx, 32));
    const float mnew = fmaxf(st.m, mx);
    const float alpha = __builtin_amdgcn_exp2f(st.m - mnew);
    st.m = mnew;
    float ls = 0.f;
#pragma unroll
    for (int r = 0; r < 16; ++r) { p[r] = __builtin_amdgcn_exp2f(p[r] - mnew); ls += p[r]; }
    st.l = st.l * alpha + ls;
#pragma unroll
    for (int r = 0; r < 16; ++r) { st.o0[r] *= alpha; st.o1[r] *= alpha; }
    union { bf16x8 v; unsigned u[4]; } pb0, pb1;
#pragma unroll
    for (int j = 0; j < 4; ++j) { pb0.u[j] = cvtpk(p[2 * j], p[2 * j + 1]); pb1.u[j] = cvtpk(p[8 + 2 * j], p[8 + 2 * j + 1]); }
    st.o0 = MFMA_BF16(f.v[0], pb0.v, st.o0);
    st.o0 = MFMA_BF16(f.v[1], pb1.v, st.o0);
    st.o1 = MFMA_BF16(f.v[2], pb0.v, st.o1);
    st.o1 = MFMA_BF16(f.v[3], pb1.v, st.o1);
    (void)hi;
}

__device__ __forceinline__ void top3_insert(float v, int i, float& v0, int& i0, float& v1, int& i1, float& v2, int& i2) {
    const bool b0 = (v > v0) || (v == v0 && i < i0);
    const bool b1 = (v > v1) || (v == v1 && i < i1);
    const bool b2 = (v > v2) || (v == v2 && i < i2);
    const float nv2 = b1 ? v1 : (b2 ? v : v2); const int ni2 = b1 ? i1 : (b2 ? i : i2);
    const float nv1 = b0 ? v0 : (b1 ? v : v1); const int ni1 = b0 ? i0 : (b1 ? i : i1);
    const float nv0 = b0 ? v : v0;             const int ni0 = b0 ? i : i0;
    v0 = nv0; i0 = ni0; v1 = nv1; i1 = ni1; v2 = nv2; i2 = ni2;
}

__device__ __forceinline__ void ln_row(float (&v)[16], const float* __restrict__ g, const float* __restrict__ b, int lane) {
    float s = 0.f;
#pragma unroll
    for (int i = 0; i < 16; ++i) s += v[i];
    const float mu = wave_sum(s) * (1.f / D);
    float q = 0.f;
#pragma unroll
    for (int i = 0; i < 16; ++i) { const float d = v[i] - mu; q += d * d; }
    const float rstd = rsqrtf(wave_sum(q) * (1.f / D) + LN_EPS);
#pragma unroll
    for (int j = 0; j < 4; ++j) {
        const f32x4 gg = *(const f32x4*)(g + j * 256 + lane * 4), bb = *(const f32x4*)(b + j * 256 + lane * 4);
#pragma unroll
        for (int c = 0; c < 4; ++c) v[j * 4 + c] = (v[j * 4 + c] - mu) * rstd * gg[c] + bb[c];
    }
}

constexpr int N_PHASES = 21;

#define P_x_in CTX_IN(0)
#define P_xb ((u16*)(ws + WS_XB))
#define P_x1 ((float*)(ws + WS_X1))
#define P_x2 ((float*)(ws + WS_X2))
#define P_ypre ((float*)(ws + WS_YPRE))
#define P_qkv ((u16*)(ws + WS_QKV))
#define P_vT ((u16*)(ws + WS_VT))
#define P_kmean ((float*)(ws + WS_KM))
#define P_ao ((u16*)(ws + WS_AO))
#define P_og ((u16*)(ws + WS_OG))
#define P_lse ((float*)(ws + WS_LSE))
#define P_topw ((float*)(ws + WS_TOPW))
#define P_list ((int*)(ws + WS_LIST))
#define P_hb ((u16*)(ws + WS_HB))
#define P_yb ((u16*)(ws + WS_YB))
#define P_cnt_all ((int*)(ws + WS_CTL + CTL_CNT_OFF))
#define P_selm ((unsigned*)(ws + WS_SELM))
#define P_part ((u16*)(ws + WS_PART))
#define P_plse ((float*)(ws + WS_PLSE))
#define PH_BEGIN int tid = threadIdx.x; asm volatile("" : "+v"(tid)); const int lane = tid & 63, r32 = lane & 31, hi = lane >> 5; const int wave = __builtin_amdgcn_readfirstlane(tid >> 6); (void)lane; (void)r32; (void)hi; (void)wave
constexpr int LDS_CTX = LDS_BAR + 16;
__device__ __forceinline__ uint64_t ctx_ld(int i) {
    extern __shared__ __attribute__((aligned(16))) unsigned char lds_raw[];
    const LAS unsigned* q = (const LAS unsigned*)((LAS char*)lds_raw + LDS_CTX) + 2 * i;
    const unsigned lo = __builtin_amdgcn_readfirstlane(q[0]), hi = __builtin_amdgcn_readfirstlane(q[1]);
    return ((uint64_t)hi << 32) | lo;
}
typedef __attribute__((address_space(1))) unsigned char gbyte;
#define AS_GLOBAL(T, u64v) ((T*)(gbyte*)(u64v))
#define CTX_IN(i) AS_GLOBAL(const float, ctx_ld(i))
#define PH_FN_BEGIN \
    extern __shared__ __attribute__((aligned(16))) unsigned char lds_raw[]; \
    LAS char* lds = (LAS char*)lds_raw; (void)lds; \
    const int G = gridDim.x, bid = blockIdx.x; (void)G; (void)bid; \
    unsigned char* const ws = AS_GLOBAL(unsigned char, ctx_ld(17)); (void)ws; \
    const int NQ = L == 0 ? 3072 : 9216; (void)NQ; \
    int* cnt = P_cnt_all + L * NE; (void)cnt;
__device__ __forceinline__ void ph_p0(int L, int rep_) {
    PH_FN_BEGIN
    (void)rep_;

            PH_BEGIN;
        for (size_t i = (size_t)bid * NTHR + tid; i < (size_t)T * D / 4; i += (size_t)G * NTHR) {
            const f32x4 v = *(const f32x4*)(P_x_in + i * 4);
            u32x2 w; w[0] = cvtpk(v[0], v[1]); w[1] = cvtpk(v[2], v[3]);
            *(u32x2*)(P_xb + i * 4) = w;
        }

}

__device__ __forceinline__ void ph_qkv(int L, int rep_) {
    PH_FN_BEGIN
    (void)rep_;

            PH_BEGIN;
            const int nitems = 64 * (NQ / 256);
            for (int it = bid; it < nitems; it += G) {
                const int mt = it & 63, nt = it >> 6;
                f32x16 acc[4][2];
                GEMM_CORE(D, P_xb + (size_t)(mt * 256 + (tid >> 2)) * D, P_xb + (size_t)(mt * 256 + (tid >> 2) + 128) * D,
                          (L == 0 ? CTX_IN(1) : CTX_IN(2)) + nt * 256 + wave * 32, NQ)
                const int wm = wave >> 2, wn = wave & 3;
                int rb = mt * 256 + wm * 128 + 4 * hi; asm volatile("" : "+v"(rb));
                u16* qkvp = P_qkv;
#pragma unroll
                for (int nb = 0; nb < 2; ++nb) {
                    const int col = nt * 256 + (wn * 2 + nb) * 32 + 4 * (r32 & 7) + (r32 >> 3);
                    const int grp = col / 3072, cc = col - grp * 3072, j = cc >> 10, c = cc & 1023, h = c >> 6, d = c & 63;
                    const int dil = grp == 0 ? 1 : (grp == 1 ? 4 : 16);
#pragma unroll
                    for (int mb = 0; mb < 4; ++mb) {
#pragma unroll
                        for (int rq = 0; rq < 4; ++rq) {
                            const int row0 = rb + mb * 32 + 8 * rq;
                            if (j < 2) {
#pragma unroll
                                for (int i = 0; i < 4; ++i) qkvp[(unsigned)((row0 + i) * NQ + col)] = (u16)cvtpk(acc[mb][nb][4 * rq + i], 0.f);
                            } else {
                                const int b = row0 / SEQ, t0 = row0 - b * SEQ;
                                u16* vrow = P_vT + (size_t)grp * T * D + ((size_t)(b * NH + h) * HD + d) * SEQ;
                                if (dil == 1) {
                                    u32x2 w; w[0] = cvtpk(acc[mb][nb][4 * rq], acc[mb][nb][4 * rq + 1]); w[1] = cvtpk(acc[mb][nb][4 * rq + 2], acc[mb][nb][4 * rq + 3]);
                                    *(u32x2*)(vrow + t0) = w;
                                } else {
#pragma unroll
                                    for (int i = 0; i < 4; ++i) { const int p = t0 + i; vrow[(p % dil) * (SEQ / dil) + p / dil] = (u16)cvtpk(acc[mb][nb][4 * rq + i], 0.f); }
                                }
                            }
                        }
                    }
                }
            }

}

__device__ __forceinline__ void ph_kmean(int L, int rep_) {
    PH_FN_BEGIN
    (void)rep_;

            PH_BEGIN;
                LAS float* red = (LAS float*)lds;
                for (int it = bid; it < BATCH * NH * MOBA_NB; it += G) {
                    const int j = it & 31, h = (it >> 5) & 15, b = it >> 9;
                    const int d = tid & 63, part = tid >> 6;
                    const u16* kp = P_qkv + (size_t)(b * SEQ + j * MOBA_BLK + part * 32) * 3072 + 1024 + h * 64 + d;
                    float s = 0.f;
                    for (int k = 0; k < 32; ++k) s += bf2f(kp[(size_t)k * 3072]);
                    red[part * 64 + d] = s;
                    __syncthreads();
                    if (tid < 64) {
                        float tot = 0.f;
#pragma unroll
                        for (int p8 = 0; p8 < 8; ++p8) tot += red[p8 * 64 + tid];
                        P_kmean[(size_t)it * 64 + tid] = tot * (1.f / MOBA_BLK);
                    }
                    __syncthreads();
                }

}

__device__ __forceinline__ void ph_gate(int L, int rep_) {
    PH_FN_BEGIN
    (void)rep_;
    PH_BEGIN;
    for (int it = bid; it < BATCH * NH * MOBA_NB; it += G) {
        const int qb = it & 31, bh = it >> 5, b = bh >> 4, h = bh & 15;
        const int tq = qb * MOBA_BLK + wave * 32 + r32;
        const u16* qrow = P_qkv + (size_t)(b * SEQ + tq) * 3072 + h * 64 + hi * 8;
        bf16x8 qf[4];
#pragma unroll
        for (int d0 = 0; d0 < 4; ++d0) qf[d0] = *(const bf16x8*)(qrow + d0 * 16);
        unsigned selmask = 0u;
        if (qb > 0) {
            const float* km = P_kmean + ((size_t)(b * NH + h) * MOBA_NB + r32) * 64 + hi * 8;
            f32x16 gt;
#pragma unroll
            for (int r = 0; r < 16; ++r) gt[r] = 0.f;
#pragma unroll
            for (int d0 = 0; d0 < 4; ++d0) {
                const f32x4 k0 = *(const f32x4*)(km + d0 * 16), k1 = *(const f32x4*)(km + d0 * 16 + 4);
                union { bf16x8 v; unsigned u[4]; } kf;
                kf.u[0] = cvtpk(k0[0], k0[1]); kf.u[1] = cvtpk(k0[2], k0[3]); kf.u[2] = cvtpk(k1[0], k1[1]); kf.u[3] = cvtpk(k1[2], k1[3]);
                gt = MFMA_BF16(kf.v, qf[d0], gt);
            }
            float v0 = -INFINITY, v1 = -INFINITY, v2 = -INFINITY; int i0 = 99, i1 = 99, i2 = 99;
#pragma unroll
            for (int r = 0; r < 16; ++r) { const int jb = crow(r, hi); const float gv = jb < qb ? gt[r] : -INFINITY; top3_insert(gv, jb < qb ? jb : 99, v0, i0, v1, i1, v2, i2); }
            const float ov0 = __shfl_xor(v0, 32), ov1 = __shfl_xor(v1, 32), ov2 = __shfl_xor(v2, 32);
            const int oi0 = __shfl_xor(i0, 32), oi1 = __shfl_xor(i1, 32), oi2 = __shfl_xor(i2, 32);
            top3_insert(ov0, oi0, v0, i0, v1, i1, v2, i2); top3_insert(ov1, oi1, v0, i0, v1, i1, v2, i2); top3_insert(ov2, oi2, v0, i0, v1, i1, v2, i2);
            if (i0 < 32) selmask |= 1u << i0;
            if (i1 < 32) selmask |= 1u << i1;
            if (i2 < 32) selmask |= 1u << i2;
        }
        if (hi == 0) P_selm[(size_t)bh * SEQ + tq] = selmask;
    }
}

constexpr int MB_KP = 72;
constexpr int MB_VP = 260;
constexpr int MB_LDS_K = 0;
constexpr int MB_LDS_V = 256 * MB_KP * 2;
constexpr int MB_LDS_LIST = MB_LDS_V + 64 * MB_VP * 2;
constexpr int MB_LDS_CTR = MB_LDS_LIST + 8192 * 2;
__device__ __forceinline__ void ph_moba(int L, int rep_) {
    PH_FN_BEGIN
    (void)rep_;
    PH_BEGIN;
    LAS char* Ks = lds + MB_LDS_K; LAS char* Vs = lds + MB_LDS_V;
    LAS u16* qlist = (LAS u16*)(lds + MB_LDS_LIST); LAS int* ctr = (LAS int*)(lds + MB_LDS_CTR);
    for (int it = bid; it < BATCH * NH * MOBA_NB; it += G) {
        const int rnd = it >> 8, w8 = it & 255, a8 = w8 >> 5, bh = w8 & 31;
        const int j = rnd == 0 ? a8 : (rnd == 1 ? 15 - a8 : (rnd == 2 ? 16 + a8 : 31 - a8));
        const int b = bh >> 4, h = bh & 15;
        const float slope2 = exp2f(-0.5f * (float)(h + 1)) * LOG2E;
        if (tid == 0) { ctr[0] = 0; ctr[1] = 0; }
        {
            const u16* kg = P_qkv + (size_t)(b * SEQ + j * MOBA_BLK) * 3072 + 1024 + h * 64;
#pragma unroll
            for (int i = 0; i < 4; ++i) { const int c = tid + i * 512, row = c >> 3, ch = c & 7; *(LAS u32x4*)(Ks + (row * MB_KP + ch * 8) * 2) = *(const u32x4*)(kg + (size_t)row * 3072 + ch * 8); }
            const u16* vg = P_vT + (size_t)(b * NH + h) * HD * SEQ + j * MOBA_BLK;
#pragma unroll
            for (int i = 0; i < 4; ++i) {
                const int c = tid + i * 512, d = c >> 5, ch = c & 31;
                const u32x4 v = *(const u32x4*)(vg + (size_t)d * SEQ + ch * 8);
                u32x2 w0, w1; w0[0] = v[0]; w0[1] = v[1]; w1[0] = v[2]; w1[1] = v[3];
                *(LAS u32x2*)(Vs + (d * MB_VP + ch * 8) * 2) = w0; *(LAS u32x2*)(Vs + (d * MB_VP + ch * 8 + 4) * 2) = w1;
            }
        }
        __syncthreads();
        {
            const unsigned* sm = P_selm + (size_t)bh * SEQ;
            for (int t0 = (j + 1) * MOBA_BLK; t0 < SEQ; t0 += 512) {
                const int t = t0 + tid;
                const bool sel = (t < SEQ) && ((sm[t < SEQ ? t : 0] >> j) & 1u);
                const unsigned long long bal = __ballot(sel);
                const int total = __popcll(bal);
                int wb = 0;
                if (lane == 0 && total) wb = atomicAdd((int*)&ctr[0], total);
                wb = __shfl(wb, 0);
                if (sel) qlist[wb + __popcll(bal & ((1ull << lane) - 1ull))] = (u16)t;
            }
        }
        __syncthreads();
        const int nq = ctr[0];
        const int ntiles = 8 + ((nq + 31) >> 5);
        for (;;) {
            int ti = 0;
            if (lane == 0) ti = atomicAdd((int*)&ctr[1], 1);
            ti = __shfl(ti, 0);
            if (ti >= ntiles) break;
            const bool own = ti < 8;
            const int wq = 7 - ti;
            const int li = (ti - 8) * 32 + r32;
            const bool valid = own || li < nq;
            const int tq = own ? j * MOBA_BLK + wq * 32 + r32 : (int)qlist[li < nq ? li : nq - 1];
            const int nsteps = own ? wq + 1 : 8;
            const u16* qrow = P_qkv + (size_t)(b * SEQ + tq) * 3072 + h * 64 + hi * 8;
            bf16x8 qf[4];
#pragma unroll
            for (int d0 = 0; d0 < 4; ++d0) qf[d0] = *(const bf16x8*)(qrow + d0 * 16);
            int slot = 3;
            if (!own) slot = __popc(P_selm[(size_t)bh * SEQ + tq] & ((1u << j) - 1u));
            AttnSt st; st.m = NEGV; st.l = 0.f;
#pragma unroll
            for (int r = 0; r < 16; ++r) { st.o0[r] = 0.f; st.o1[r] = 0.f; }
            const int dlo = own ? 0 : -0x40000000;
            for (int kt = 0; kt < nsteps; ++kt) {
                AttnFr f;
#pragma unroll
                for (int d0 = 0; d0 < 4; ++d0) f.k[d0] = *(LAS bf16x8*)(Ks + ((kt * 32 + r32) * MB_KP + d0 * 16 + hi * 8) * 2);
#pragma unroll
                for (int q4 = 0; q4 < 4; ++q4) {
                    union { bf16x8 v; u32x2 hh[2]; } va;
                    LAS char* vp = Vs + (((q4 >> 1) * 32 + r32) * MB_VP + kt * 32 + (q4 & 1) * 16 + 4 * hi) * 2;
                    va.hh[0] = *(LAS u32x2*)(vp); va.hh[1] = *(LAS u32x2*)(vp + 16);
                    f.v[q4] = va.v;
                }
                attn_compute(st, qf, f, tq - (j * MOBA_BLK + kt * 32) - 4 * hi, slope2, dlo, 0x7fffffff, hi);
            }
            const float lt = st.l + __shfl_xor(st.l, 32);
            const float inv = 1.f / lt;
            if (valid) {
                const size_t pi = ((size_t)(b * SEQ + tq) * NH + h) * 4 + slot;
                u16* orow = P_part + pi * 64;
#pragma unroll
                for (int rq = 0; rq < 4; ++rq) {
                    u32x2 w; w[0] = cvtpk(st.o0[4 * rq] * inv, st.o0[4 * rq + 1] * inv); w[1] = cvtpk(st.o0[4 * rq + 2] * inv, st.o0[4 * rq + 3] * inv);
                    *(u32x2*)(orow + 8 * rq + 4 * hi) = w;
                    w[0] = cvtpk(st.o1[4 * rq] * inv, st.o1[4 * rq + 1] * inv); w[1] = cvtpk(st.o1[4 * rq + 2] * inv, st.o1[4 * rq + 3] * inv);
                    *(u32x2*)(orow + 32 + 8 * rq + 4 * hi) = w;
                }
                if (hi == 0) P_plse[pi] = st.m * LN2 + logf(lt);
            }
        }
        __syncthreads();
    }
}

__device__ __forceinline__ void ph_mobamerge(int L, int rep_) {
    PH_FN_BEGIN
    (void)rep_;
    PH_BEGIN;
    for (size_t i = (size_t)bid * NTHR + tid; i < (size_t)T * NH * 8; i += (size_t)G * NTHR) {
        const size_t row = i >> 7; const int h = (int)(i >> 3) & 15, d8 = (int)i & 7;
        const int qb = (int)(row & (SEQ - 1)) >> 8;
        const int nsel = qb < 3 ? qb : 3;
        const size_t pi = (row * NH + h) * 4;
        float l[4], w[4];
        float mx = -INFINITY;
#pragma unroll
        for (int sidx = 0; sidx < 4; ++sidx) { const bool ok = sidx == 3 || sidx < nsel; l[sidx] = ok ? P_plse[pi + sidx] : -INFINITY; mx = fmaxf(mx, l[sidx]); }
        float ws_ = 0.f;
#pragma unroll
        for (int sidx = 0; sidx < 4; ++sidx) { w[sidx] = (sidx == 3 || sidx < nsel) ? expf(l[sidx] - mx) : 0.f; ws_ += w[sidx]; }
        const float inv = 1.f / ws_;
        float acc8[8];
#pragma unroll
        for (int c = 0; c < 8; ++c) acc8[c] = 0.f;
#pragma unroll
        for (int sidx = 0; sidx < 4; ++sidx) {
            if (sidx == 3 || sidx < nsel) {
                const u32x4 a = *(const u32x4*)(P_part + (pi + sidx) * 64 + d8 * 8);
                const float ww = w[sidx] * inv;
#pragma unroll
                for (int c = 0; c < 4; ++c) { acc8[2 * c] += ww * bf2f(a[c] & 0xFFFFu); acc8[2 * c + 1] += ww * bf2f(a[c] >> 16); }
            }
        }
        u32x4 o;
#pragma unroll
        for (int c = 0; c < 4; ++c) o[c] = cvtpk(acc8[2 * c], acc8[2 * c + 1]);
        *(u32x4*)(P_ao + row * D + h * 64 + d8 * 8) = o;
    }
}

__device__ __forceinline__ void ph_dil(int L, int rep_) {
    PH_FN_BEGIN
    (void)rep_;
            PH_BEGIN;
                for (int it = bid; it < BATCH * NH * 3 * 32; it += G) {
                    const int ch = it & 31, grp = (it >> 5) % 3, bh = it / 96, b = bh >> 4, h = bh & 15;
                    const int dil = grp == 0 ? 1 : (grp == 1 ? 4 : 16), Ls = SEQ / dil;
                    const float slope2 = exp2f(-0.5f * (float)(h + 1)) * LOG2E * (float)dil;
                    const int u0 = ch * 256 + wave * 32, res = u0 / Ls, i0 = u0 - res * Ls;
                    const int iq = i0 + r32, pq = iq * dil + res;
                    const u16* qrow = P_qkv + (size_t)(b * SEQ + pq) * 9216 + grp * 3072 + h * 64 + hi * 8;
                    bf16x8 qf[4];
#pragma unroll
                    for (int d0 = 0; d0 < 4; ++d0) qf[d0] = *(const bf16x8*)(qrow + d0 * 16);
                    AttnSt st; st.m = NEGV; st.l = 0.f;
#pragma unroll
                    for (int r = 0; r < 16; ++r) { st.o0[r] = 0.f; st.o1[r] = 0.f; }
                    const u16* kbase = P_qkv + (size_t)(b * SEQ) * 9216 + grp * 3072 + 1024 + h * 64 + hi * 8;
                    const u16* vtb = P_vT + (size_t)grp * T * D + ((size_t)(b * NH + h) * HD + r32) * SEQ + (size_t)res * Ls + 4 * hi;
                    {
                        const int ktmin = (i0 >= 128) ? 0 : (128 - i0) >> 5;
                        AttnFr fa, fb;
                        { const int k1 = i0 - 128 + 4 * 32; attn_load(fa, kbase + (size_t)((k1 + r32) * dil + res) * 9216, vtb + k1, SEQ); }
#define DIL_STEP(FR, FN) { \
                            { const int k1 = i0 - 128 + (kt > ktmin ? kt - 1 : kt) * 32; attn_load(FN, kbase + (size_t)((k1 + r32) * dil + res) * 9216, vtb + k1, SEQ); } \
                            const int k0 = i0 - 128 + kt * 32; \
                            attn_compute(st, qf, FR, iq - k0 - 4 * hi, slope2, 0, 128, hi); }
                        for (int kt = 4; kt >= ktmin; --kt) {
                            DIL_STEP(fa, fb)
                            if (--kt < ktmin) break;
                            DIL_STEP(fb, fa)
                        }
                    }
                    const float lt = st.l + __shfl_xor(st.l, 32);
                    const float inv = 1.f / lt;
                    u16* orow = P_og + (size_t)grp * T * D + (size_t)(b * SEQ + pq) * D + h * 64;
#pragma unroll
                    for (int rq = 0; rq < 4; ++rq) {
                        u32x2 w; w[0] = cvtpk(st.o0[4 * rq] * inv, st.o0[4 * rq + 1] * inv); w[1] = cvtpk(st.o0[4 * rq + 2] * inv, st.o0[4 * rq + 3] * inv);
                        *(u32x2*)(orow + 8 * rq + 4 * hi) = w;
                        w[0] = cvtpk(st.o1[4 * rq] * inv, st.o1[4 * rq + 1] * inv); w[1] = cvtpk(st.o1[4 * rq + 2] * inv, st.o1[4 * rq + 3] * inv);
                        *(u32x2*)(orow + 32 + 8 * rq + 4 * hi) = w;
                    }
                    if (hi == 0) P_lse[((size_t)grp * T + (b * SEQ + pq)) * NH + h] = st.m * LN2 + logf(lt);
                }

}

__device__ __forceinline__ void ph_merge(int L, int rep_) {
    PH_FN_BEGIN
    (void)rep_;

            PH_BEGIN;
                for (size_t i = (size_t)bid * NTHR + tid; i < (size_t)T * NH * 8; i += (size_t)G * NTHR) {
                    const size_t row = i >> 7; const int h = (int)(i >> 3) & 15, d8 = (int)i & 7;
                    const float l0 = P_lse[(0 * (size_t)T + row) * NH + h], l1 = P_lse[(1 * (size_t)T + row) * NH + h], l2 = P_lse[(2 * (size_t)T + row) * NH + h];
                    const float mx = fmaxf(l0, fmaxf(l1, l2));
                    float w0 = expf(l0 - mx), w1 = expf(l1 - mx), w2 = expf(l2 - mx);
                    const float inv = 1.f / (w0 + w1 + w2); w0 *= inv; w1 *= inv; w2 *= inv;
                    const size_t off = row * D + h * 64 + d8 * 8;
                    const u32x4 a0 = *(const u32x4*)(P_og + off), a1 = *(const u32x4*)(P_og + (size_t)T * D + off), a2 = *(const u32x4*)(P_og + 2 * (size_t)T * D + off);
                    u32x4 o;
#pragma unroll
                    for (int c = 0; c < 4; ++c) {
                        const float lo_ = w0 * bf2f(a0[c] & 0xFFFFu) + w1 * bf2f(a1[c] & 0xFFFFu) + w2 * bf2f(a2[c] & 0xFFFFu);
                        const float hi_ = w0 * bf2f(a0[c] >> 16) + w1 * bf2f(a1[c] >> 16) + w2 * bf2f(a2[c] >> 16);
                        o[c] = cvtpk(lo_, hi_);
                    }
                    *(u32x4*)(P_ao + off) = o;
                }

}

__device__ __forceinline__ void ph_wo(int L, int rep_) {
    PH_FN_BEGIN
    (void)rep_;

            PH_BEGIN;
            for (int it = bid; it < 64 * 4; it += G) {
                const int mt = it & 63, nt = it >> 6;
                f32x16 acc[4][2];
                GEMM_CORE(D, P_ao + (size_t)(mt * 256 + (tid >> 2)) * D, P_ao + (size_t)(mt * 256 + (tid >> 2) + 128) * D,
                          (CTX_IN(3) + (size_t)L * D * D) + nt * 256 + wave * 32, D)
                const int wm = wave >> 2, wn = wave & 3;
                int rb = mt * 256 + wm * 128 + 4 * hi; asm volatile("" : "+v"(rb));
#pragma unroll
                for (int nb = 0; nb < 2; ++nb) {
                    const int col = nt * 256 + (wn * 2 + nb) * 32 + 4 * (r32 & 7) + (r32 >> 3);
                    const float* xr = (L == 0 ? CTX_IN(0) : P_x2) + (size_t)rb * D + col; float* yp = P_ypre + (size_t)rb * D + col;
#pragma unroll
                    for (int mb = 0; mb < 4; ++mb) {
#pragma unroll
                        for (int r = 0; r < 16; ++r) {
                            const int o = (mb * 32 + (r & 3) + 8 * (r >> 2)) * D;
                            yp[o] = DN_ALPHA * xr[o] + acc[mb][nb][r];
                        }
                        asm volatile("" ::: "memory");
                    }
                }
            }

}

__device__ __forceinline__ void ph_router(int L, int rep_) {
    PH_FN_BEGIN
    (void)rep_;

            PH_BEGIN;
            const float* lng = CTX_IN(4) + L * D; const float* lnb = CTX_IN(5) + L * D;
            const float* wr = CTX_IN(6) + (size_t)L * D * NE; const float* rbias = CTX_IN(7) + L * NE;
            LAS float* xs = (LAS float*)lds;
            for (int it = bid; it < T / 32; it += G) {
#pragma unroll 1
                for (int rr = 0; rr < 4; ++rr) {
                    const int lr = wave * 4 + rr; const size_t row = (size_t)it * 32 + lr;
                    float v[16];
#pragma unroll
                    for (int j = 0; j < 4; ++j) { const f32x4 t4 = *(const f32x4*)(P_ypre + row * D + j * 256 + lane * 4); v[j * 4] = t4[0]; v[j * 4 + 1] = t4[1]; v[j * 4 + 2] = t4[2]; v[j * 4 + 3] = t4[3]; }
                    ln_row(v, lng, lnb, lane);
#pragma unroll
                    for (int j = 0; j < 4; ++j) {
                        f32x4 t4; t4[0] = v[j * 4]; t4[1] = v[j * 4 + 1]; t4[2] = v[j * 4 + 2]; t4[3] = v[j * 4 + 3];
                        *(f32x4*)(P_x1 + row * D + j * 256 + lane * 4) = t4;
                        *(LAS f32x4*)(xs + lr * XS_PITCH + j * 256 + lane * 4) = t4;
                        u32x2 w; w[0] = cvtpk(t4[0], t4[1]); w[1] = cvtpk(t4[2], t4[3]);
                        *(u32x2*)(P_xb + row * D + j * 256 + lane * 4) = w;
                    }
                }
                __syncthreads();
                f32x16 lg;
#pragma unroll
                for (int r = 0; r < 16; ++r) lg[r] = 0.f;
                {
                    const LAS float* ap = xs + r32 * XS_PITCH + hi;
                    const float* bp = wr + (size_t)hi * NE + wave * 32 + r32;
                    float bva[32], bvb[32];
#pragma unroll
                    for (int j = 0; j < 32; ++j) bva[j] = bp[(size_t)(2 * j) * NE];
#pragma unroll 1
                    for (int k0 = 0; k0 < D; k0 += 128) {
#pragma unroll
                        for (int j = 0; j < 32; ++j) bvb[j] = bp[(size_t)(k0 + 64 + 2 * j) * NE];
#pragma unroll
                        for (int j = 0; j < 32; ++j) lg = __builtin_amdgcn_mfma_f32_32x32x2f32(ap[k0 + 2 * j], bva[j], lg, 0, 0, 0);
                        if (k0 + 128 < D) {
#pragma unroll
                            for (int j = 0; j < 32; ++j) bva[j] = bp[(size_t)(k0 + 128 + 2 * j) * NE];
                        }
#pragma unroll
                        for (int j = 0; j < 32; ++j) lg = __builtin_amdgcn_mfma_f32_32x32x2f32(ap[k0 + 64 + 2 * j], bvb[j], lg, 0, 0, 0);
                    }
                }
                __syncthreads();
                LAS float* lgs = (LAS float*)lds;
#pragma unroll
                for (int r = 0; r < 16; ++r) lgs[crow(r, hi) * 257 + wave * 32 + r32] = lg[r];
                __syncthreads();
#pragma unroll 1
                for (int rr = 0; rr < 4; ++rr) {
                    const int lr = wave * 4 + rr; const int tok = it * 32 + lr;
                    float sc[4], ch[4];
#pragma unroll
                    for (int j = 0; j < 4; ++j) { const int e = lane + 64 * j; sc[j] = 1.f / (1.f + expf(-lgs[lr * 257 + e])); ch[j] = sc[j] + rbias[e]; }
                    float gsel[8], gmine[4];
#pragma unroll
                    for (int j = 0; j < 4; ++j) {
                        float m1 = ch[j];
#pragma unroll
                        for (int o = 16; o >= 1; o >>= 1) m1 = fmaxf(m1, __shfl_xor(m1, o));
                        const unsigned long long bal = __ballot(ch[j] == m1);
                        const unsigned half = (unsigned)(hi ? (bal >> 32) : (bal & 0xFFFFFFFFull));
                        const int first = __builtin_ctz(half);
                        float m2 = (r32 == first) ? -INFINITY : ch[j];
#pragma unroll
                        for (int o = 16; o >= 1; o >>= 1) m2 = fmaxf(m2, __shfl_xor(m2, o));
                        const float mine = m1 + m2, other = __shfl_xor(mine, 32);
                        gsel[2 * j] = hi ? other : mine; gsel[2 * j + 1] = hi ? mine : other; gmine[j] = mine;
                    }
                    bool gok[4];
#pragma unroll
                    for (int j = 0; j < 4; ++j) {
                        const float mygs = gmine[j];
                        const int myg = 2 * j + hi;
                        int rank = 0;
#pragma unroll
                        for (int g2 = 0; g2 < 8; ++g2) rank += ((gsel[g2] > mygs) || (gsel[g2] == mygs && g2 < myg)) ? 1 : 0;
                        gok[j] = rank < 4;
                    }
                    float cv[4];
#pragma unroll
                    for (int j = 0; j < 4; ++j) cv[j] = gok[j] ? ch[j] : NEGV;
                    float wsel = 0.f; int esel = 0; float wsum = 0.f;
#pragma unroll 1
                    for (int k = 0; k < TOPK; ++k) {
                        float bv = cv[0]; int be = lane;
#pragma unroll
                        for (int j = 1; j < 4; ++j) if (cv[j] > bv) { bv = cv[j]; be = lane + 64 * j; }
#pragma unroll
                        for (int o = 32; o >= 1; o >>= 1) {
                            const float ov = __shfl_xor(bv, o); const int oe = __shfl_xor(be, o);
                            if (ov > bv || (ov == bv && oe < be)) { bv = ov; be = oe; }
                        }
                        const int jl = be >> 6, ll = be & 63;
                        float smine = sc[0];
                        smine = jl == 1 ? sc[1] : smine; smine = jl == 2 ? sc[2] : smine; smine = jl == 3 ? sc[3] : smine;
                        const float sw = __shfl(smine, ll);
#pragma unroll
                        for (int j = 0; j < 4; ++j) cv[j] = (lane == ll && jl == j) ? -INFINITY : cv[j];
                        wsum += sw;
                        if (lane == k) { wsel = sw; esel = be; }
                    }
                    if (lane < TOPK) {
                        const int a = tok * TOPK + lane;
                        P_topw[a] = wsel / wsum * 2.5f;
                        if (rep_ == 0) {
                            const int pos = atomicAdd(&cnt[esel], 1);
                            P_list[(size_t)esel * T + pos] = a;
                        }
                    }
                }
                __syncthreads();
            }

}

__device__ __forceinline__ void ph_gateup(int L, int rep_) {
    PH_FN_BEGIN
    (void)rep_;

            PH_BEGIN;
            const float* weg = CTX_IN(8) + (size_t)L * NE * D * DF; const float* weu = CTX_IN(9) + (size_t)L * NE * D * DF;
            const float* wsg = CTX_IN(11) + (size_t)L * D * DF; const float* wsu = CTX_IN(12) + (size_t)L * D * DF;
            LAS int* rowid = (LAS int*)(lds + LDS_ROWID);
            for (int e = bid; e < NE + 64; e += G) {
                const bool shared = e >= NE;
                const int n = shared ? 256 : cnt[e];
                const int nrt = (n + 255) >> 8;
                const float* wg_ = shared ? wsg : weg + (size_t)e * D * DF;
                const float* wu_ = shared ? wsu : weu + (size_t)e * D * DF;
                for (int rt = 0; rt < nrt; ++rt) {
                    if (tid < 256) {
                        const int idx = rt * 256 + tid;
                        rowid[tid] = shared ? (A_TOT + (e - NE) * 256 + tid) : (idx < n ? P_list[(size_t)e * T + idx] : TRASH_VA);
                    }
                    __syncthreads();
                    const int va0 = rowid[tid >> 2], va1 = rowid[(tid >> 2) + 128];
                    const u16* pa0 = va0 == TRASH_VA ? nullptr : P_xb + (size_t)(va0 < A_TOT ? (va0 >> 3) : (va0 - A_TOT)) * D;
                    const u16* pa1 = va1 == TRASH_VA ? nullptr : P_xb + (size_t)(va1 < A_TOT ? (va1 >> 3) : (va1 - A_TOT)) * D;
#pragma unroll 1
                    for (int fc = 0; fc < 2; ++fc) {
                        f32x16 acc[4][2];
                        const float* pbseg = ((wave & 1) ? wu_ : wg_) + fc * 128 + (wave >> 1) * 32;
                        GEMM_CORE(D, pa0, pa1, pbseg, DF)
                        const int wm = wave >> 2, wn = wave & 3;
                        const unsigned f = fc * 128 + wn * 32 + 4 * (r32 & 7) + (r32 >> 3);
                        int rbase = wm * 128 + 4 * hi; asm volatile("" : "+v"(rbase));
                        u16* hbp = P_hb;
#pragma unroll
                        for (int mb = 0; mb < 4; ++mb) {
#pragma unroll
                            for (int r = 0; r < 16; ++r) {
                                const unsigned va = (unsigned)rowid[rbase + mb * 32 + (r & 3) + 8 * (r >> 2)];
                                const float gt = acc[mb][0][r], up = acc[mb][1][r];
                                const float hval = gt / (1.f + __expf(-gt)) * up;
                                hbp[va * DF + f] = (u16)cvtpk(hval, 0.f);
                            }
                            asm volatile("" ::: "memory");
                        }
                    }
                    __syncthreads();
                }
            }

}

__device__ __forceinline__ void ph_down(int L, int rep_) {
    PH_FN_BEGIN
    (void)rep_;

            PH_BEGIN;
            const float* wed = CTX_IN(10) + (size_t)L * NE * DF * D; const float* wsd = CTX_IN(13) + (size_t)L * DF * D;
            LAS int* rowid = (LAS int*)(lds + LDS_ROWID);
            LAS float* roww = (LAS float*)(lds + LDS_ROWW);
            for (int e = bid; e < NE + 64; e += G) {
                const bool shared = e >= NE;
                const int n = shared ? 256 : cnt[e];
                const int nrt = (n + 255) >> 8;
                const float* wd_ = shared ? wsd : wed + (size_t)e * DF * D;
                for (int rt = 0; rt < nrt; ++rt) {
                    if (tid < 256) {
                        const int idx = rt * 256 + tid;
                        const int va = shared ? (A_TOT + (e - NE) * 256 + tid) : (idx < n ? P_list[(size_t)e * T + idx] : TRASH_VA);
                        rowid[tid] = va;
                        roww[tid] = va < A_TOT ? P_topw[va] : 1.f;
                    }
                    __syncthreads();
                    const int va0 = rowid[tid >> 2], va1 = rowid[(tid >> 2) + 128];
                    const u16* pa0 = va0 == TRASH_VA ? nullptr : P_hb + (size_t)va0 * DF;
                    const u16* pa1 = va1 == TRASH_VA ? nullptr : P_hb + (size_t)va1 * DF;
#pragma unroll 1
                    for (int nt = 0; nt < 4; ++nt) {
                        f32x16 acc[4][2];
                        GEMM_CORE(DF, pa0, pa1, wd_ + nt * 256 + wave * 32, D)
                        const int wm = wave >> 2, wn = wave & 3;
                        int rbase = wm * 128 + 4 * hi; asm volatile("" : "+v"(rbase));
                        const unsigned col = nt * 256 + wn * 64 + 4 * (r32 & 7) + (r32 >> 3);
                        u16* ybp = P_yb;
#pragma unroll
                        for (int mb = 0; mb < 4; ++mb) {
#pragma unroll
                            for (int r = 0; r < 16; ++r) {
                                const int lrow = rbase + mb * 32 + (r & 3) + 8 * (r >> 2);
                                const unsigned va = (unsigned)rowid[lrow]; const float w = roww[lrow];
                                ybp[va * D + col] = (u16)cvtpk(acc[mb][0][r] * w, 0.f);
                                ybp[va * D + col + 32] = (u16)cvtpk(acc[mb][1][r] * w, 0.f);
                            }
                            asm volatile("" ::: "memory");
                        }
                    }
                    __syncthreads();
                }
            }

}

__device__ __forceinline__ void ph_combine(int L, int rep_) {
    PH_FN_BEGIN
    (void)rep_;

            PH_BEGIN;
            const float* lng = CTX_IN(14) + L * D; const float* lnb = CTX_IN(15) + L * D;
            float* dst = L == 0 ? P_x2 : AS_GLOBAL(float, ctx_ld(16));
            for (int row = bid * 8 + wave; row < T; row += G * 8) {
                float v[16];
#pragma unroll
                for (int j = 0; j < 4; ++j) { const f32x4 t4 = *(const f32x4*)(P_x1 + (size_t)row * D + j * 256 + lane * 4); v[j * 4] = DN_ALPHA * t4[0]; v[j * 4 + 1] = DN_ALPHA * t4[1]; v[j * 4 + 2] = DN_ALPHA * t4[2]; v[j * 4 + 3] = DN_ALPHA * t4[3]; }
#pragma unroll 1
                for (int k = 0; k < TOPK + 1; ++k) {
                    const size_t va = k < TOPK ? (size_t)row * TOPK + k : (size_t)A_TOT + row;
#pragma unroll
                    for (int j = 0; j < 4; ++j) {
                        const u32x2 w = *(const u32x2*)(P_yb + va * D + j * 256 + lane * 4);
                        v[j * 4] += bf2f(w[0] & 0xFFFFu); v[j * 4 + 1] += bf2f(w[0] >> 16); v[j * 4 + 2] += bf2f(w[1] & 0xFFFFu); v[j * 4 + 3] += bf2f(w[1] >> 16);
                    }
                }
                ln_row(v, lng, lnb, lane);
#pragma unroll
                for (int j = 0; j < 4; ++j) {
                    f32x4 t4; t4[0] = v[j * 4]; t4[1] = v[j * 4 + 1]; t4[2] = v[j * 4 + 2]; t4[3] = v[j * 4 + 3];
                    *(f32x4*)(dst + (size_t)row * D + j * 256 + lane * 4) = t4;
                    if (L == 0) { u32x2 w; w[0] = cvtpk(t4[0], t4[1]); w[1] = cvtpk(t4[2], t4[3]); *(u32x2*)(P_xb + (size_t)row * D + j * 256 + lane * 4) = w; }
                }
            }

}

__global__ void __launch_bounds__(NTHR, 2) fwd(Args args) {
    extern __shared__ __attribute__((aligned(16))) unsigned char lds_raw[];
    LAS char* lds = (LAS char*)lds_raw;
    unsigned char* const ws = args.ws;
    const int lo = args.ph_lo, hi_ph = args.ph_hi;
    if (threadIdx.x < 18) {
        const uint64_t v = threadIdx.x < 16 ? (uint64_t)args.in[threadIdx.x] : (threadIdx.x == 16 ? (uint64_t)args.out : (uint64_t)args.ws);
        ((LAS uint64_t*)(lds + LDS_CTX))[threadIdx.x] = v;
    }
    __syncthreads();
#define IN(k) (lo <= (k) && (k) < hi_ph)

#if MK_ONE_LAUNCH
    if (threadIdx.x < 4) ((LAS unsigned*)(lds + LDS_BAR))[threadIdx.x] = 0u;
    __syncthreads();
    XcdBarrier bar = xcd_barrier_post((unsigned*)(ws + WS_CTL), (volatile LAS unsigned*)(lds + LDS_BAR));
#define GRID_BAR() xcd_barrier(bar)
#else
#define GRID_BAR() do { } while (0)
#endif
#define SEAM(k) do { if (IN(k) && IN((k) + 1)) GRID_BAR(); } while (0)

    for (int rep_ = 0; rep_ < ((IN(0) && PHK(0)) ? REPS(0) : 0); ++rep_) { ph_p0(0, rep_); }
    SEAM(0);

    for (int L = 0; L < 2; ++L) {
        const int pb = 1 + 10 * L;
        for (int rep_ = 0; rep_ < ((IN(pb + 0) && PHK(1)) ? REPS(1) : 0); ++rep_) { ph_qkv(L, rep_); }
        SEAM(pb + 0);

        if (L == 0) {
            for (int rep_ = 0; rep_ < ((IN(pb + 1) && PHK(2)) ? REPS(2) : 0); ++rep_) { ph_kmean(L, rep_); }
            SEAM(pb + 1);
            for (int rep_ = 0; rep_ < ((IN(pb + 2) && PHK(11)) ? REPS(11) : 0); ++rep_) { ph_gate(L, rep_); }
            SEAM(pb + 2);
        }

        if (L == 0) {
            for (int rep_ = 0; rep_ < ((IN(pb + 3) && PHK(3)) ? REPS(3) : 0); ++rep_) { ph_moba(L, rep_); }
            SEAM(pb + 3);
            for (int rep_ = 0; rep_ < ((IN(pb + 4) && PHK(12)) ? REPS(12) : 0); ++rep_) { ph_mobamerge(L, rep_); }
        } else {
            for (int rep_ = 0; rep_ < ((IN(pb + 3) && PHK(4)) ? REPS(4) : 0); ++rep_) { ph_dil(L, rep_); }
            SEAM(pb + 3);
            for (int rep_ = 0; rep_ < ((IN(pb + 4) && PHK(5)) ? REPS(5) : 0); ++rep_) { ph_merge(L, rep_); }
        }
        SEAM(pb + 4);

        for (int rep_ = 0; rep_ < ((IN(pb + 5) && PHK(6)) ? REPS(6) : 0); ++rep_) { ph_wo(L, rep_); }
        SEAM(pb + 5);

        for (int rep_ = 0; rep_ < ((IN(pb + 6) && PHK(7)) ? REPS(7) : 0); ++rep_) { ph_router(L, rep_); }
        SEAM(pb + 6);

        for (int rep_ = 0; rep_ < ((IN(pb + 7) && PHK(8)) ? REPS(8) : 0); ++rep_) { ph_gateup(L, rep_); }
        SEAM(pb + 7);

        for (int rep_ = 0; rep_ < ((IN(pb + 8) && PHK(9)) ? REPS(9) : 0); ++rep_) { ph_down(L, rep_); }
        SEAM(pb + 8);

        for (int rep_ = 0; rep_ < ((IN(pb + 9) && PHK(10)) ? REPS(10) : 0); ++rep_) { ph_combine(L, rep_); }
        if (L == 0) SEAM(pb + 9);
    }
}

extern "C" void kernel_launch(void* const* d_in, const int* in_sizes, int n_in, void* d_out, int out_size, void* d_ws, size_t ws_size, hipStream_t stream) {
    static int grid = 0;
    if (grid == 0) {
        if (n_in != 16 || out_size != T * D || ws_size < WS_END2) { fprintf(stderr, "kernel_launch: unexpected problem (n_in %d out %d ws %zu need %zu)\n", n_in, out_size, ws_size, (size_t)WS_END2); grid = -1; return; }
        int dev = 0, cus = 0, per_cu = 0;
        if (hipGetDevice(&dev) != hipSuccess || hipDeviceGetAttribute(&cus, hipDeviceAttributeMultiprocessorCount, dev) != hipSuccess) { grid = -1; return; }
        if (hipFuncSetAttribute((const void*)fwd, hipFuncAttributeMaxDynamicSharedMemorySize, LDS_BYTES) != hipSuccess) { fprintf(stderr, "kernel_launch: hipFuncSetAttribute failed\n"); grid = -1; return; }
        if (hipOccupancyMaxActiveBlocksPerMultiprocessor(&per_cu, (const void*)fwd, NTHR, LDS_BYTES) != hipSuccess || per_cu < 1) { fprintf(stderr, "kernel_launch: occupancy query says %d\n", per_cu); (void)hipGetLastError(); per_cu = 1; }
        grid = cus;
    }
    if (grid < 0) return;
    (void)hipMemsetAsync((char*)d_ws + WS_CTL, 0, CTL_BYTES, stream);
    Args a{};
    for (int i = 0; i < 16; ++i) a.in[i] = (const float*)d_in[i];
    a.out = (float*)d_out; a.ws = (unsigned char*)d_ws;
#if MK_ONE_LAUNCH
    a.ph_lo = 0; a.ph_hi = N_PHASES;
    hipLaunchKernelGGL(fwd, dim3(grid), dim3(NTHR), LDS_BYTES, stream, a);
#else
    for (int ph = 0; ph < N_PHASES; ++ph) {
        if (ph == 12 || ph == 13) continue;
        a.ph_lo = ph; a.ph_hi = ph + 1;
        hipLaunchKernelGGL(fwd, dim3(grid), dim3(NTHR), LDS_BYTES, stream, a);
    }
#endif
}
```

```cpp
#include <hip/hip_runtime.h>
#include <hip/hip_bf16.h>
#include <stdint.h>
#include <stdio.h>

#ifndef MK_ONE_LAUNCH
#define MK_ONE_LAUNCH 1
#endif

#ifndef PHMASK
#define PHMASK 0x1FFF
#endif
#define PHK(k) ((PHMASK >> (k)) & 1)
#ifndef REPEAT_KIND
#define REPEAT_KIND -1
#endif
#define REPS(k) ((k) == REPEAT_KIND ? 2 : 1)
#define LAS __attribute__((address_space(3)))
typedef __attribute__((ext_vector_type(8))) short bf16x8;
typedef __attribute__((ext_vector_type(16))) float f32x16;
typedef __attribute__((ext_vector_type(4))) float f32x4;
typedef __attribute__((ext_vector_type(4))) unsigned u32x4;
typedef __attribute__((ext_vector_type(2))) unsigned u32x2;
typedef unsigned short u16;

constexpr int D = 1024, BATCH = 2, SEQ = 8192, T = BATCH * SEQ, NH = 16, HD = 64;
constexpr int NE = 256, TOPK = 8, DF = 256;
constexpr int A_TOT = T * TOPK;
constexpr int MOBA_BLK = 256, MOBA_NB = SEQ / MOBA_BLK;
constexpr float DN_ALPHA = 1.4142135623730951f;
constexpr float LN_EPS = 1e-5f;
constexpr float LOG2E = 1.4426950408889634f;
constexpr float LN2 = 0.6931471805599453f;
constexpr float NEGV = -1e30f;
constexpr int NTHR = 512;

constexpr size_t al256(size_t x) { return (x + 255) & ~(size_t)255; }
constexpr size_t WS_CTL = 0;
constexpr size_t CTL_BYTES = 65536;
constexpr size_t CTL_CNT_OFF = 32768;
constexpr size_t WS_XB = WS_CTL + CTL_BYTES;
constexpr size_t WS_X1 = WS_XB + al256((size_t)T * D * 2);
constexpr size_t WS_X2 = WS_X1 + al256((size_t)T * D * 4);
constexpr size_t WS_YPRE = WS_X2 + al256((size_t)T * D * 4);
constexpr size_t WS_QKV = WS_YPRE + al256((size_t)T * D * 4);
constexpr size_t WS_VT = WS_QKV + al256((size_t)T * 9216 * 2);
constexpr size_t WS_KM = WS_VT + al256((size_t)3 * T * D * 2);
constexpr size_t WS_AO = WS_KM + al256((size_t)BATCH * NH * MOBA_NB * HD * 4);
constexpr size_t WS_OG = WS_AO + al256((size_t)T * D * 2);
constexpr size_t WS_LSE = WS_OG + al256((size_t)3 * T * D * 2);
constexpr size_t WS_TOPW = WS_LSE + al256((size_t)3 * T * NH * 4);
constexpr size_t WS_LIST = WS_TOPW + al256((size_t)T * TOPK * 4);
constexpr size_t WS_HB = WS_LIST + al256((size_t)NE * T * 4);
constexpr size_t WS_YB = WS_HB + al256((size_t)(A_TOT + T + 1) * DF * 2);
constexpr size_t WS_END = WS_YB + al256((size_t)(A_TOT + T + 1) * D * 2);
constexpr int TRASH_VA = A_TOT + T;
constexpr size_t WS_SELM = WS_END;
constexpr size_t WS_PART = WS_SELM + al256((size_t)T * NH * 4);
constexpr size_t WS_PLSE = WS_PART + al256((size_t)T * NH * 4 * 64 * 2);
constexpr size_t WS_WQK0 = WS_PLSE + al256((size_t)T * NH * 4 * 4);
constexpr size_t WS_WV0 = WS_WQK0 + (size_t)2048 * 1024 * 2;
constexpr size_t WS_WQK1 = WS_WV0 + (size_t)1024 * 1024 * 2;
constexpr size_t WS_WV1 = WS_WQK1 + (size_t)6144 * 1024 * 2;
constexpr size_t WS_WO = WS_WV1 + (size_t)3072 * 1024 * 2;
constexpr size_t WS_WSGU = WS_WO + (size_t)2 * 1024 * 1024 * 2;
constexpr size_t WS_WSD = WS_WSGU + (size_t)2 * 512 * 1024 * 2;
constexpr size_t WS_END2 = WS_WSD + (size_t)2 * 1024 * 256 * 2;

constexpr int LDP = 40;
constexpr int STAGE_BYTES = 2 * 256 * LDP * 2;
constexpr int LDS_ROWID = 2 * STAGE_BYTES;
constexpr int LDS_ROWW = LDS_ROWID + 1024;
constexpr int XS_PITCH = 1028;
constexpr int LDS_BYTES = 32 * XS_PITCH * 4 + 1024;
constexpr int LDS_BAR = 32 * XS_PITCH * 4;

#define XB_TMO      128
#define XB_XCNT(j)  (256  + 64 * (j))
#define XB_XSUB(j)  (1280 + 64 * (j))
#define XB_XGEN(j)  (2304 + 64 * (j))
#define XB_TOP      3328
#define XB_TOPGEN   3392
#define XCD_BAR_WORDS 3456
#define XB_SPIN_CAP (1u << 18)
__device__ __forceinline__ unsigned xb_ld(unsigned* p)              { return __hip_atomic_load(p, __ATOMIC_RELAXED, __HIP_MEMORY_SCOPE_AGENT); }
__device__ __forceinline__ unsigned xb_add(unsigned* p, unsigned v) { return __hip_atomic_fetch_add(p, v, __ATOMIC_RELAXED, __HIP_MEMORY_SCOPE_AGENT); }
__device__ __forceinline__ unsigned xb_xcc_id() { return (unsigned)__builtin_amdgcn_s_getreg((3 << 11) | 20) & 0xFu; }
#define XB_SPIN(cond, bar) do { unsigned _sp = 0; while (cond) { __builtin_amdgcn_s_sleep(1); \
    if ((++_sp & 255u) == 0u) { if (xb_ld(&(bar)[XB_TMO])) break; if (_sp > XB_SPIN_CAP) { atomicAdd(&(bar)[XB_TMO], 1u); break; } } } } while (0)
struct XcdBarrier { unsigned* bar; unsigned x; volatile LAS unsigned* st; };
__device__ __forceinline__ XcdBarrier xcd_barrier_post(unsigned* bar, volatile LAS unsigned* st) {
    XcdBarrier b; b.bar = bar; b.x = xb_xcc_id(); b.st = st;
    if (threadIdx.x == 0) (void)xb_add(&bar[XB_XCNT(b.x)], 1u);
    return b;
}
__device__ __forceinline__ void xcd_barrier_complete(unsigned* bar, unsigned x, unsigned& nloc, unsigned& nx) {
    const unsigned G = gridDim.x * gridDim.y * gridDim.z;
    unsigned sum, cnt, mine, sp = 0u;
    for (;;) {
        sum = 0u; cnt = 0u; mine = 0u;
#pragma unroll
        for (unsigned j = 0; j < 16; ++j) { const unsigned c = xb_ld(&bar[XB_XCNT(j)]); sum += c; cnt += (c > 0u) ? 1u : 0u; mine = (j == x) ? c : mine; }
        if (sum == G) break;
        __builtin_amdgcn_s_sleep(1);
        if ((++sp & 255u) == 0u) { if (xb_ld(&bar[XB_TMO])) break; if (sp > XB_SPIN_CAP) { atomicAdd(&bar[XB_TMO], 1u); break; } }
    }
    nloc = mine > 0u ? mine : 1u; nx = cnt > 0u ? cnt : 1u;
}
__device__ __forceinline__ void xcd_barrier(const XcdBarrier& b) {
    asm volatile("s_waitcnt vmcnt(0)" ::: "memory");
    __syncthreads();
    if (threadIdx.x == 0) {
        unsigned* bar = b.bar;
        __builtin_amdgcn_s_waitcnt(0);
        unsigned nloc = b.st[0], nx = b.st[1];
        if (nloc == 0u) { xcd_barrier_complete(bar, b.x, nloc, nx); b.st[0] = nloc; b.st[1] = nx; }
        const unsigned old = xb_add(&bar[XB_XSUB(b.x)], 1u);
        const unsigned gen = old / nloc;
        if (old + 1u == (gen + 1u) * nloc) {
            __builtin_amdgcn_fence(__ATOMIC_RELEASE, "agent");
            asm volatile("s_waitcnt vmcnt(0)" ::: "memory");
            const unsigned og = xb_add(&bar[XB_TOP], 1u);
            const unsigned tg = og / nx;
            if (og + 1u == (tg + 1u) * nx) xb_add(&bar[XB_TOPGEN], 1u);
            else XB_SPIN(xb_ld(&bar[XB_TOPGEN]) == tg, bar);
            __builtin_amdgcn_fence(__ATOMIC_ACQUIRE, "agent");
            xb_add(&bar[XB_XGEN(b.x)], 1u);
            asm volatile("s_waitcnt vmcnt(0)" ::: "memory");
        } else {
            XB_SPIN(xb_ld(&bar[XB_XGEN(b.x)]) == gen, bar);
            __builtin_amdgcn_fence(__ATOMIC_ACQUIRE, "agent");
            asm volatile("s_waitcnt vmcnt(0)" ::: "memory");
        }
    }
    __syncthreads();
}

typedef __attribute__((ext_vector_type(2))) __bf16 bf16x2_t;
typedef __attribute__((ext_vector_type(2))) float f32x2_t;
__device__ __forceinline__ unsigned cvtpk(float lo, float hi) { f32x2_t f; f[0] = lo; f[1] = hi; return __builtin_bit_cast(unsigned, __builtin_convertvector(f, bf16x2_t)); }
__device__ __forceinline__ float bf2f(unsigned v16) { return __uint_as_float(v16 << 16); }
__device__ __forceinline__ int crow(int r, int hi) { return (r & 3) + 8 * (r >> 2) + 4 * hi; }
#define MFMA_BF16(a, b, c) __builtin_amdgcn_mfma_f32_32x32x16_bf16(a, b, c, 0, 0, 0)
__device__ __forceinline__ float wave_sum(float v) {
#pragma unroll
    for (int o = 32; o >= 1; o >>= 1) v += __shfl_xor(v, o);
    return v;
}

namespace pg8 {
#define PG8_LAS __attribute__((address_space(3)))
typedef unsigned short bf16_t;
typedef short bf16x8 __attribute__((ext_vector_type(8)));
typedef float f32x4 __attribute__((ext_vector_type(4)));
typedef unsigned u32x4 __attribute__((ext_vector_type(4)));
constexpr int BM = 256, BK = 64, HALF = 128, HTB = HALF * BK * 2  , STAGE_BYTES = 8 * HTB, NXCD = 8, WGM = 8;

__host__ __device__ __forceinline__ int lds_byte(int r, int c) { const int st = (r >> 4) * 2 + (c >> 5), rr = r & 15, cc = c & 31, ob = rr * 64 + cc * 2; return st * 1024 + (ob ^ (((ob >> 9) & 1) << 5)); }
__host__ __device__ __forceinline__ void stage_rc(int b, int& R, int& C) { const int st = b / 1024, sb = b % 1024, swz = sb ^ (((sb >> 9) & 1) << 5); R = (st >> 1) * 16 + swz / 64; C = (st & 1) * 32 + (swz % 64) / 2; }
__host__ __device__ __forceinline__ int perm32(int rho) { const int n = rho >> 4, i = rho & 15; return 8 * (i >> 2) + 4 * n + (i & 3); }

struct Unit { int pm, pn; };
struct Gemm { const bf16_t* A; const bf16_t* Bt; int M, N, K; };

struct StaticOrder {
    int nM, nN, nwg, G, c;
    __host__ __device__ void init(int M, int N, int G_, int c_) { nM = M / BM; nN = N / BM; nwg = nM * nN; G = G_; c = c_; }
    __host__ __device__ bool next(int i, Unit& u) const {
        const long L = (long)i * G + c; if (L >= nwg) return false;
        int wgid = (int)L; { const int q = nwg / NXCD, r = nwg % NXCD, xcd = wgid % NXCD, off = wgid / NXCD; wgid = (xcd < r ? xcd * (q + 1) : r * (q + 1) + (xcd - r) * q) + off; }
        const int nig = WGM * nN, gid = wgid / nig, fm = gid * WGM, gsz = (nM - fm) < WGM ? (nM - fm) : WGM;
        u.pm = fm + ((wgid % nig) % gsz); u.pn = (wgid % nig) / gsz; return true;
    }
    __device__ __forceinline__ void a_ready(const Unit&) const {}
    __device__ __forceinline__ void done(const Unit&) const {}
};

template <class Epi, class Sched, bool SWAP = false, bool STAMP = false>
__device__ __forceinline__ void gemm_phase(PG8_LAS unsigned char* lds, const Gemm g, const Sched& S, const Epi& E, unsigned long long* stamps) {
    const int tid = threadIdx.x, wid = __builtin_amdgcn_readfirstlane(tid >> 6), lane = tid & 63, wr = wid >> 2, wc = wid & 3, fr = lane & 15, fq = lane >> 4;
    const int K = g.K, nt = K / BK;
    int ts_lo = 0, ts_hi = 0, nts = 0; const unsigned long long rt_entry = STAMP ? (unsigned long long)wall_clock64() : 0ull;
#define PG8_STAMP() do { if (STAMP && wid == 0 && nts < 64) { const unsigned long long _c = (unsigned long long)clock64(); \
        ts_lo = (lane == nts) ? (int)(unsigned)_c : ts_lo; ts_hi = (lane == nts) ? (int)(unsigned)(_c >> 32) : ts_hi; ++nts; } } while (0)
    PG8_STAMP();
    unsigned voffA[2], voffB[2];
#pragma unroll
    for (int i = 0; i < 2; ++i) { int R, C; stage_rc(tid * 16 + i * 8192, R, C); const int Rb = Epi::PERM ? ((R & ~31) + perm32(R & 31)) : R;
        voffA[i] = (unsigned)(R * K + C) * 2u; voffB[i] = (unsigned)(Rb * K + C) * 2u; }
    const size_t kstep = (size_t)(BK * 2);
    const size_t hstep = (size_t)HALF * K * 2;
    const size_t tstep = 2 * hstep;
    const unsigned ldsw = (unsigned)wid * 1024u;
    const int aoff = lds_byte(wr * 64 + fr, fq * 8), boff = lds_byte(wc * 32 + fr, fq * 8);
#define PG8_SA(b, h) (((b) * 2 + (h)) * HTB)
#define PG8_SB(b, h) ((4 + (b) * 2 + (h)) * HTB)
#define PG8_STAGE(bufoff, gbase, voff) do { _Pragma("unroll") for (int _i = 0; _i < 2; ++_i) \
        __builtin_amdgcn_global_load_lds((const unsigned*)((const char*)(gbase) + (voff)[_i]), (PG8_LAS unsigned*)(lds + (bufoff) + ldsw + _i * 8192), 16, 0, 0); } while (0)
#define PG8_LDA(dst, b, h) do { _Pragma("unroll") for (int m = 0; m < 4; ++m) _Pragma("unroll") for (int k = 0; k < 2; ++k) dst[m][k] = *(const PG8_LAS bf16x8*)(lds + PG8_SA(b, h) + aoff + m * 2048 + k * 1024); } while (0)
#define PG8_LDB(dst, b, h) do { _Pragma("unroll") for (int n = 0; n < 2; ++n) _Pragma("unroll") for (int k = 0; k < 2; ++k) dst[n][k] = *(const PG8_LAS bf16x8*)(lds + PG8_SB(b, h) + boff + n * 2048 + k * 1024); } while (0)
#define PG8_MMA(ai, bj, At, Bt) do { __builtin_amdgcn_s_setprio(1); _Pragma("unroll") for (int m = 0; m < 4; ++m) _Pragma("unroll") for (int n = 0; n < 2; ++n) _Pragma("unroll") for (int k = 0; k < 2; ++k) \
        acc[ai][bj][m][n] = SWAP ? __builtin_amdgcn_mfma_f32_16x16x32_bf16(At[m][k], Bt[n][k], acc[ai][bj][m][n], 0, 0, 0) : __builtin_amdgcn_mfma_f32_16x16x32_bf16(Bt[n][k], At[m][k], acc[ai][bj][m][n], 0, 0, 0); __builtin_amdgcn_s_setprio(0); } while (0)
#define PG8_WAIT_V(n) asm volatile("s_waitcnt vmcnt(" #n ")" ::: "memory")
#define PG8_WAIT_L(n) asm volatile("s_waitcnt lgkmcnt(" #n ")" ::: "memory")
#define PG8_BAR __builtin_amdgcn_s_barrier()
#define PG8_SCHED __builtin_amdgcn_sched_barrier(0)
    Unit cur, nxt; int ui = 0;
    if (!S.next(0, cur)) return;
    f32x4 acc[2][2][4][2];
#pragma unroll
    for (int a = 0; a < 2; ++a)
#pragma unroll
        for (int b = 0; b < 2; ++b)
#pragma unroll
            for (int m = 0; m < 4; ++m)
#pragma unroll
                for (int n = 0; n < 2; ++n) acc[a][b][m][n] = (f32x4){0.f, 0.f, 0.f, 0.f};
    bf16x8 At[4][2], B0[2][2], B1[2][2];
    const char* cA = (const char*)g.A + (size_t)cur.pm * tstep; const char* cB = (const char*)g.Bt + (size_t)cur.pn * tstep;
    S.a_ready(cur);
    PG8_STAGE(PG8_SB(0, 0), cB, voffB); PG8_STAGE(PG8_SA(0, 0), cA, voffA); PG8_STAGE(PG8_SB(0, 1), cB + hstep, voffB); PG8_STAGE(PG8_SA(0, 1), cA + hstep, voffA);
    if (wr == 1) PG8_BAR;
    PG8_WAIT_V(4); PG8_BAR;
    PG8_STAGE(PG8_SB(1, 0), cB + kstep, voffB); PG8_STAGE(PG8_SA(1, 0), cA + kstep, voffA); PG8_STAGE(PG8_SB(1, 1), cB + hstep + kstep, voffB);
    PG8_WAIT_V(6); PG8_BAR;
    PG8_STAMP();
    for (;;) {
        const bool has_next = S.next(ui + 1, nxt);
        const char* nA = has_next ? (const char*)g.A + (size_t)nxt.pm * tstep : cA; const char* nB = has_next ? (const char*)g.Bt + (size_t)nxt.pn * tstep : cB;
        for (int t = 0; t < nt; t += 2) {
            const bool last = (t == nt - 2);
            const char* a1 = cA + (size_t)(t + 1) * kstep;
            const char* a2 = last ? nA : cA + (size_t)(t + 2) * kstep; const char* b2 = last ? nB : cB + (size_t)(t + 2) * kstep;
            const char* a3 = a2 + kstep; const char* b3 = b2 + kstep;
            if (last && has_next) S.a_ready(nxt);
            PG8_LDB(B0, 0, 0); PG8_SCHED; PG8_LDA(At, 0, 0); PG8_STAGE(PG8_SA(1, 1), a1 + hstep, voffA);
            PG8_WAIT_L(8); PG8_BAR; PG8_WAIT_L(0); PG8_MMA(0, 0, At, B0); PG8_BAR; PG8_SCHED;
            PG8_LDB(B1, 0, 1); PG8_STAGE(PG8_SB(0, 0), b2, voffB);
            PG8_BAR; PG8_WAIT_L(0); PG8_MMA(0, 1, At, B1); PG8_BAR;
            PG8_LDA(At, 0, 1); PG8_STAGE(PG8_SA(0, 0), a2, voffA);
            PG8_BAR; PG8_WAIT_L(0); PG8_MMA(1, 0, At, B0); PG8_BAR; PG8_SCHED;
            PG8_STAGE(PG8_SB(0, 1), b2 + hstep, voffB);
            PG8_WAIT_V(6); PG8_BAR; PG8_MMA(1, 1, At, B1); PG8_BAR;
            PG8_LDB(B0, 1, 0); PG8_SCHED; PG8_LDA(At, 1, 0); PG8_STAGE(PG8_SA(0, 1), a2 + hstep, voffA);
            PG8_WAIT_L(8); PG8_BAR; PG8_WAIT_L(0); PG8_MMA(0, 0, At, B0); PG8_BAR; PG8_SCHED;
            PG8_LDB(B1, 1, 1); PG8_STAGE(PG8_SB(1, 0), b3, voffB);
            PG8_BAR; PG8_WAIT_L(0); PG8_MMA(0, 1, At, B1); PG8_BAR;
            PG8_LDA(At, 1, 1); PG8_STAGE(PG8_SA(1, 0), a3, voffA);
            PG8_BAR; PG8_WAIT_L(0); PG8_MMA(1, 0, At, B0); PG8_BAR; PG8_SCHED;
            PG8_STAGE(PG8_SB(1, 1), b3 + hstep, voffB);
            PG8_WAIT_V(6); PG8_BAR; PG8_MMA(1, 1, At, B1); PG8_BAR;
        }
        PG8_STAMP();
        if constexpr (!Epi::AFTER_DRAIN) { E(acc, cur, wr, wc, fr, fq); S.done(cur); }
        PG8_STAMP();
        if (!has_next) break;
#pragma unroll
        for (int a = 0; a < 2; ++a)
#pragma unroll
            for (int b = 0; b < 2; ++b)
#pragma unroll
                for (int m = 0; m < 4; ++m)
#pragma unroll
                    for (int n = 0; n < 2; ++n) acc[a][b][m][n] = (f32x4){0.f, 0.f, 0.f, 0.f};
        cur = nxt; cA = nA; cB = nB; ++ui;
    }
    PG8_WAIT_V(0);
    if (wr == 0) PG8_BAR;
    PG8_BAR;
    if constexpr (Epi::AFTER_DRAIN) { E.fused(acc, cur, wr, wc, fr, fq, lds, wid, lane); S.done(cur); }
    PG8_STAMP();
    if (STAMP && wid == 0) { stamps[lane] = lane < nts ? (((unsigned long long)(unsigned)ts_hi << 32) | (unsigned)ts_lo) : 0ull;
        if (lane == 62) stamps[62] = rt_entry; if (lane == 63) stamps[63] = (unsigned long long)wall_clock64(); }
#undef PG8_STAMP
#undef PG8_SA
#undef PG8_SB
#undef PG8_STAGE
#undef PG8_LDA
#undef PG8_LDB
#undef PG8_MMA
#undef PG8_WAIT_V
#undef PG8_WAIT_L
#undef PG8_BAR
#undef PG8_SCHED
}
}

struct EpiQK {
    static constexpr bool PERM = true, AFTER_DRAIN = false;
    u16* O; int ldc;
    __device__ __forceinline__ void operator()(const pg8::f32x4 (&acc)[2][2][4][2], const pg8::Unit& u, int wr, int wc, int fr, int fq) const {
        const int colt = u.pn * 256, g = colt >> 11, col0 = g * 3072 + (colt & 2047) + wc * 32 + 8 * fq, row0 = u.pm * 256 + wr * 64 + fr;
#pragma unroll
        for (int ai = 0; ai < 2; ++ai)
#pragma unroll
            for (int m = 0; m < 4; ++m) { u16* rowp = O + (size_t)(row0 + ai * 128 + m * 16) * ldc + col0;
#pragma unroll
                for (int bj = 0; bj < 2; ++bj) { const pg8::f32x4 v0 = acc[ai][bj][m][0], v1 = acc[ai][bj][m][1];
                    u32x4 w; w[0] = cvtpk(v0[0], v0[1]); w[1] = cvtpk(v0[2], v0[3]); w[2] = cvtpk(v1[0], v1[1]); w[3] = cvtpk(v1[2], v1[3]);
                    *(u32x4*)(rowp + bj * 128) = w; } }
    }
};
struct EpiV {
    static constexpr bool PERM = false, AFTER_DRAIN = false;
    u16* VT; int layer;
    __device__ __forceinline__ void operator()(const pg8::f32x4 (&acc)[2][2][4][2], const pg8::Unit& u, int wr, int wc, int fr, int fq) const {
        const int colt = u.pn * 256, grp = colt >> 10;
        const int dil = (layer == 0 || grp == 0) ? 1 : (grp == 1 ? 4 : 16);
        const int rowb = u.pm * 256 + wr * 64 + 4 * fq;
#pragma unroll
        for (int bj = 0; bj < 2; ++bj)
#pragma unroll
            for (int n = 0; n < 2; ++n) {
                const int c = (colt & 1023) + bj * 128 + wc * 32 + n * 16 + fr, h = c >> 6, d = c & 63;
#pragma unroll
                for (int ai = 0; ai < 2; ++ai)
#pragma unroll
                    for (int m = 0; m < 4; ++m) {
                        const int r0 = rowb + ai * 128 + m * 16, b = r0 >> 13, t0 = r0 & (SEQ - 1);
                        u16* vrow = VT + (size_t)grp * T * D + ((size_t)(b * NH + h) * HD + d) * SEQ;
                        const pg8::f32x4 v = acc[ai][bj][m][n];
                        if (dil == 1) { u32x2 w; w[0] = cvtpk(v[0], v[1]); w[1] = cvtpk(v[2], v[3]); *(u32x2*)(vrow + t0) = w; }
                        else {
#pragma unroll
                            for (int i = 0; i < 4; ++i) { const int pp = t0 + i; vrow[(pp % dil) * (SEQ / dil) + pp / dil] = (u16)cvtpk(v[i], 0.f); }
                        }
                    }
            }
    }
};
struct EpiWo {
    static constexpr bool PERM = false, AFTER_DRAIN = false;
    float* Y; const float* X;
    __device__ __forceinline__ void operator()(const pg8::f32x4 (&acc)[2][2][4][2], const pg8::Unit& u, int wr, int wc, int fr, int fq) const {
        const int row0 = u.pm * 256 + wr * 64 + fr, col0 = u.pn * 256 + wc * 32 + 4 * fq;
#pragma unroll
        for (int ai = 0; ai < 2; ++ai)
#pragma unroll
            for (int m = 0; m < 4; ++m) { const size_t ro = (size_t)(row0 + ai * 128 + m * 16) * D + col0;
#pragma unroll
                for (int bj = 0; bj < 2; ++bj)
#pragma unroll
                    for (int n = 0; n < 2; ++n) { const pg8::f32x4 x = *(const pg8::f32x4*)(X + ro + bj * 128 + n * 16); *(pg8::f32x4*)(Y + ro + bj * 128 + n * 16) = x * DN_ALPHA + acc[ai][bj][m][n]; } }
    }
};
struct EpiSGU {
    static constexpr bool PERM = true, AFTER_DRAIN = false;
    u16* H;
    __device__ __forceinline__ void operator()(const pg8::f32x4 (&acc)[2][2][4][2], const pg8::Unit& u, int wr, int wc, int fr, int fq) const {
        const int row0 = u.pm * 256 + wr * 64 + fr, f0 = u.pn * 128 + wc * 32 + 8 * fq;
#pragma unroll
        for (int ai = 0; ai < 2; ++ai)
#pragma unroll
            for (int m = 0; m < 4; ++m) {
                float hv[8];
#pragma unroll
                for (int n = 0; n < 2; ++n)
#pragma unroll
                    for (int i = 0; i < 4; ++i) { const float gt = acc[ai][0][m][n][i], up = acc[ai][1][m][n][i]; hv[n * 4 + i] = gt / (1.f + __expf(-gt)) * up; }
                u32x4 w; w[0] = cvtpk(hv[0], hv[1]); w[1] = cvtpk(hv[2], hv[3]); w[2] = cvtpk(hv[4], hv[5]); w[3] = cvtpk(hv[6], hv[7]);
                *(u32x4*)(H + (size_t)(A_TOT + row0 + ai * 128 + m * 16) * DF + f0) = w;
            }
    }
};
struct EpiSD {
    static constexpr bool PERM = true, AFTER_DRAIN = false;
    u16* Y;
    __device__ __forceinline__ void operator()(const pg8::f32x4 (&acc)[2][2][4][2], const pg8::Unit& u, int wr, int wc, int fr, int fq) const {
        const int row0 = u.pm * 256 + wr * 64 + fr, col0 = u.pn * 256 + wc * 32 + 8 * fq;
#pragma unroll
        for (int ai = 0; ai < 2; ++ai)
#pragma unroll
            for (int m = 0; m < 4; ++m) { u16* rowp = Y + (size_t)(A_TOT + row0 + ai * 128 + m * 16) * D + col0;
#pragma unroll
                for (int bj = 0; bj < 2; ++bj) { const pg8::f32x4 v0 = acc[ai][bj][m][0], v1 = acc[ai][bj][m][1];
                    u32x4 w; w[0] = cvtpk(v0[0], v0[1]); w[1] = cvtpk(v0[2], v0[3]); w[2] = cvtpk(v1[0], v1[1]); w[3] = cvtpk(v1[2], v1[3]);
                    *(u32x4*)(rowp + bj * 128) = w; } }
    }
};

struct Args {
    const float* in[16];
    float* out;
    unsigned char* ws;
    int ph_lo, ph_hi;
};

#define GEMM_CORE(K_, PA0, PA1, PB, LDB)                                                                                                   \
    {                                                                                                                                      \
        const int g_tid = tid, g_lane = lane, g_wave = wave, g_r32 = r32, g_hi = hi;                   \
        const int g_wm = g_wave >> 2, g_wn = g_wave & 3, g_kc = g_tid & 3, g_kq = g_lane >> 3, g_n4 = g_lane & 7;                           \
        const u16* g_pa0 = (PA0); const u16* g_pa1 = (PA1);                                                                                \
        const size_t g_ldb = (size_t)(LDB);                                                                                                \
        const float* g_pb = (PB) + (size_t)(g_kq * 4) * g_ldb + g_n4 * 4;                                                                  \
        const int g_nk = (K_) / 32;                                                                                                        \
        u32x4 g_ra0, g_ra1; f32x4 g_rb0, g_rb1, g_rb2, g_rb3;                                                                              \
        const u32x4 g_z = {0u, 0u, 0u, 0u};                                                                                                \
        _Pragma("unroll") for (int mb = 0; mb < 4; ++mb) { _Pragma("unroll") for (int nb = 0; nb < 2; ++nb) { _Pragma("unroll") for (int r = 0; r < 16; ++r) acc[mb][nb][r] = 0.f; } } \
        g_ra0 = g_pa0 ? *(const u32x4*)(g_pa0 + g_kc * 8) : g_z; g_ra1 = g_pa1 ? *(const u32x4*)(g_pa1 + g_kc * 8) : g_z;                 \
        g_rb0 = *(const f32x4*)(g_pb); g_rb1 = *(const f32x4*)(g_pb + g_ldb); g_rb2 = *(const f32x4*)(g_pb + 2 * g_ldb); g_rb3 = *(const f32x4*)(g_pb + 3 * g_ldb); \
        _Pragma("unroll 1") for (int kt = 0; kt < g_nk; ++kt) {                                                                            \
            LAS char* As = lds + (kt & 1) * STAGE_BYTES; LAS char* Bs = As + 256 * LDP * 2;                                                \
            *(LAS u32x4*)(As + ((g_tid >> 2) * LDP + g_kc * 8) * 2) = g_ra0;                                                               \
            *(LAS u32x4*)(As + (((g_tid >> 2) + 128) * LDP + g_kc * 8) * 2) = g_ra1;                                                       \
            _Pragma("unroll") for (int i = 0; i < 4; ++i) {                                                                                \
                u32x2 w; w[0] = cvtpk(g_rb0[i], g_rb1[i]); w[1] = cvtpk(g_rb2[i], g_rb3[i]);                                               \
                *(LAS u32x2*)(Bs + ((g_wave * 32 + i * 8 + g_n4) * LDP + g_kq * 4) * 2) = w;                                               \
            }                                                                                                                              \
            __syncthreads();                                                                                                               \
            if (kt + 1 < g_nk) {                                                                                                           \
                const int ko = (kt + 1) * 32;                                                                                              \
                g_ra0 = g_pa0 ? *(const u32x4*)(g_pa0 + ko + g_kc * 8) : g_z; g_ra1 = g_pa1 ? *(const u32x4*)(g_pa1 + ko + g_kc * 8) : g_z; \
                const float* pbk = g_pb + (size_t)ko * g_ldb;                                                                              \
                g_rb0 = *(const f32x4*)(pbk); g_rb1 = *(const f32x4*)(pbk + g_ldb); g_rb2 = *(const f32x4*)(pbk + 2 * g_ldb); g_rb3 = *(const f32x4*)(pbk + 3 * g_ldb); \
            }                                                                                                                              \
            _Pragma("unroll") for (int s = 0; s < 2; ++s) {                                                                                \
                bf16x8 af[4], bfr[2];                                                                                                      \
                _Pragma("unroll") for (int mb = 0; mb < 4; ++mb) af[mb] = *(LAS bf16x8*)(As + ((g_wm * 128 + mb * 32 + g_r32) * LDP + s * 16 + g_hi * 8) * 2); \
                _Pragma("unroll") for (int nb = 0; nb < 2; ++nb) bfr[nb] = *(LAS bf16x8*)(Bs + (((g_wn * 2 + nb) * 32 + g_r32) * LDP + s * 16 + g_hi * 8) * 2); \
                _Pragma("unroll") for (int mb = 0; mb < 4; ++mb) { _Pragma("unroll") for (int nb = 0; nb < 2; ++nb) acc[mb][nb] = MFMA_BF16(af[mb], bfr[nb], acc[mb][nb]); } \
            }                                                                                                                              \
        }                                                                                                                                  \
        __syncthreads();                                                                                                                   \
    }

struct AttnSt { float m, l; f32x16 o0, o1; };

struct AttnFr { bf16x8 k[4]; bf16x8 v[4]; };
__device__ __forceinline__ void attn_load(AttnFr& f, const u16* krow, const u16* vt, size_t vt_dstride) {
#pragma unroll
    for (int d0 = 0; d0 < 4; ++d0) f.k[d0] = *(const bf16x8*)(krow + d0 * 16);
    const u16* vt1 = vt + 32 * vt_dstride;
    union { bf16x8 v; u32x2 h[2]; } va;
    va.h[0] = *(const u32x2*)(vt);       va.h[1] = *(const u32x2*)(vt + 8);   f.v[0] = va.v;
    va.h[0] = *(const u32x2*)(vt + 16);  va.h[1] = *(const u32x2*)(vt + 24);  f.v[1] = va.v;
    va.h[0] = *(const u32x2*)(vt1);      va.h[1] = *(const u32x2*)(vt1 + 8);  f.v[2] = va.v;
    va.h[0] = *(const u32x2*)(vt1 + 16); va.h[1] = *(const u32x2*)(vt1 + 24); f.v[3] = va.v;
}
__device__ __forceinline__ void attn_compute(AttnSt& st, const bf16x8 (&qf)[4], const AttnFr& f, int dist0, float bslope, int dlo, int dhi, int hi) {
    f32x16 p;
#pragma unroll
    for (int r = 0; r < 16; ++r) p[r] = 0.f;
#pragma unroll
    for (int d0 = 0; d0 < 4; ++d0) p = MFMA_BF16(f.k[d0], qf[d0], p);
    constexpr float C2 = 0.125f * LOG2E;
    float mx = NEGV;
#pragma unroll
    for (int r = 0; r < 16; ++r) {
        const int dist = dist0 - ((r & 3) + 8 * (r >> 2));
        const float sc = __builtin_fmaf(p[r], C2, -bslope * (float)dist);
        const float s_ = (dist >= dlo && dist <= dhi) ? sc : NEGV;
        p[r] = s_; mx = fmaxf(mx, s_);
    }
    mx = fmaxf(mx, __shfl_xor(mx, 32));
    const float mnew = fmaxf(st.m, mx);
    const float alpha = __builtin_amdgcn_exp2f(st.m - mnew);
    st.m = mnew;
    float ls = 0.f;
#pragma unroll
    for (int r = 0; r < 16; ++r) { p[r] = __builtin_amdgcn_exp2f(p[r] - mnew); ls += p[r]; }
    st.l = st.l * alpha + ls;
#pragma unroll
    for (int r = 0; r < 16; ++r) { st.o0[r] *= alpha; st.o1[r] *= alpha; }
    union { bf16x8 v; unsigned u[4]; } pb0, pb1;
#pragma unroll
    for (int j = 0; j < 4; ++j) { pb0.u[j] = cvtpk(p[2 * j], p[2 * j + 1]); pb1.u[j] = cvtpk(p[8 + 2 * j], p[8 + 2 * j + 1]); }
    st.o0 = MFMA_BF16(f.v[0], pb0.v, st.o0);
    st.o0 = MFMA_BF16(f.v[1], pb1.v, st.o0);
    st.o1 = MFMA_BF16(f.v[2], pb0.v, st.o1);
    st.o1 = MFMA_BF16(f.v[3], pb1.v, st.o1);
    (void)hi;
}

__device__ __forceinline__ void top3_insert(float v, int i, float& v0, int& i0, float& v1, int& i1, float& v2, int& i2) {
    const bool b0 = (v > v0) || (v == v0 && i < i0);
    const bool b1 = (v > v1) || (v == v1 && i < i1);
    const bool b2 = (v > v2) || (v == v2 && i < i2);
    const float nv2 = b1 ? v1 : (b2 ? v : v2); const int ni2 = b1 ? i1 : (b2 ? i : i2);
    const float nv1 = b0 ? v0 : (b1 ? v : v1); const int ni1 = b0 ? i0 : (b1 ? i : i1);
    const float nv0 = b0 ? v : v0;             const int ni0 = b0 ? i : i0;
    v0 = nv0; i0 = ni0; v1 = nv1; i1 = ni1; v2 = nv2; i2 = ni2;
}

__device__ __forceinline__ void ln_row(float (&v)[16], const float* __restrict__ g, const float* __restrict__ b, int lane) {
    float s = 0.f;
#pragma unroll
    for (int i = 0; i < 16; ++i) s += v[i];
    const float mu = wave_sum(s) * (1.f / D);
    float q = 0.f;
#pragma unroll
    for (int i = 0; i < 16; ++i) { const float d = v[i] - mu; q += d * d; }
    const float rstd = rsqrtf(wave_sum(q) * (1.f / D) + LN_EPS);
#pragma unroll
    for (int j = 0; j < 4; ++j) {
        const f32x4 gg = *(const f32x4*)(g + j * 256 + lane * 4), bb = *(const f32x4*)(b + j * 256 + lane * 4);
#pragma unroll
        for (int c = 0; c < 4; ++c) v[j * 4 + c] = (v[j * 4 + c] - mu) * rstd * gg[c] + bb[c];
    }
}

constexpr int N_PHASES = 21;

#define P_x_in CTX_IN(0)
#define P_xb ((u16*)(ws + WS_XB))
#define P_x1 ((float*)(ws + WS_X1))
#define P_x2 ((float*)(ws + WS_X2))
#define P_ypre ((float*)(ws + WS_YPRE))
#define P_qkv ((u16*)(ws + WS_QKV))
#define P_vT ((u16*)(ws + WS_VT))
#define P_kmean ((float*)(ws + WS_KM))
#define P_ao ((u16*)(ws + WS_AO))
#define P_og ((u16*)(ws + WS_OG))
#define P_lse ((float*)(ws + WS_LSE))
#define P_topw ((float*)(ws + WS_TOPW))
#define P_list ((int*)(ws + WS_LIST))
#define P_hb ((u16*)(ws + WS_HB))
#define P_yb ((u16*)(ws + WS_YB))
#define P_cnt_all ((int*)(ws + WS_CTL + CTL_CNT_OFF))
#define P_selm ((unsigned*)(ws + WS_SELM))
#define P_part ((u16*)(ws + WS_PART))
#define P_plse ((float*)(ws + WS_PLSE))
#define PH_BEGIN int tid = threadIdx.x; asm volatile("" : "+v"(tid)); const int lane = tid & 63, r32 = lane & 31, hi = lane >> 5; const int wave = __builtin_amdgcn_readfirstlane(tid >> 6); (void)lane; (void)r32; (void)hi; (void)wave
constexpr int LDS_CTX = LDS_BAR + 16;
__device__ __forceinline__ uint64_t ctx_ld(int i) {
    extern __shared__ __attribute__((aligned(16))) unsigned char lds_raw[];
    const LAS unsigned* q = (const LAS unsigned*)((LAS char*)lds_raw + LDS_CTX) + 2 * i;
    const unsigned lo = __builtin_amdgcn_readfirstlane(q[0]), hi = __builtin_amdgcn_readfirstlane(q[1]);
    return ((uint64_t)hi << 32) | lo;
}
typedef __attribute__((address_space(1))) unsigned char gbyte;
#define AS_GLOBAL(T, u64v) ((T*)(gbyte*)(u64v))
#define CTX_IN(i) AS_GLOBAL(const float, ctx_ld(i))
#define PH_FN_BEGIN \
    extern __shared__ __attribute__((aligned(16))) unsigned char lds_raw[]; \
    LAS char* lds = (LAS char*)lds_raw; (void)lds; \
    const int G = gridDim.x, bid = blockIdx.x; (void)G; (void)bid; \
    unsigned char* const ws = AS_GLOBAL(unsigned char, ctx_ld(17)); (void)ws; \
    const int NQ = L == 0 ? 3072 : 9216; (void)NQ; \
    int* cnt = P_cnt_all + L * NE; (void)cnt;
__device__ __forceinline__ void ph_p0(int L, int rep_) {
    PH_FN_BEGIN
    (void)rep_;
    PH_BEGIN;
    for (size_t i = (size_t)bid * NTHR + tid; i < (size_t)T * D / 4; i += (size_t)G * NTHR) {
        const f32x4 v = *(const f32x4*)(P_x_in + i * 4);
        u32x2 w; w[0] = cvtpk(v[0], v[1]); w[1] = cvtpk(v[2], v[3]);
        *(u32x2*)(P_xb + i * 4) = w;
    }
    LAS float* tl = (LAS float*)lds;
    for (int it = bid; it < 3968; it += G) {
        int seg, kt;
        if (it < 3840) { seg = it >> 4; kt = it & 15; } else { seg = 240 + ((it - 3840) >> 2); kt = (it - 3840) & 3; }
        const float* src; int ld; u16* dst; int Kd = 1024;
        if (seg < 48) { const int col = 64 * seg; src = CTX_IN(1) + col; ld = 3072; dst = col < 2048 ? (u16*)(ws + WS_WQK0) + (size_t)col * 1024 : (u16*)(ws + WS_WV0) + (size_t)(col - 2048) * 1024; }
        else if (seg < 192) { const int col = 64 * (seg - 48), g = col / 3072, w = col - g * 3072; src = CTX_IN(2) + col; ld = 9216;
            dst = w < 2048 ? (u16*)(ws + WS_WQK1) + (size_t)(g * 2048 + w) * 1024 : (u16*)(ws + WS_WV1) + (size_t)(g * 1024 + w - 2048) * 1024; }
        else if (seg < 224) { const int s2 = seg - 192, l2 = s2 >> 4, col = 64 * (s2 & 15); src = CTX_IN(3) + (size_t)l2 * D * D + col; ld = 1024; dst = (u16*)(ws + WS_WO) + (size_t)l2 * D * D + (size_t)col * 1024; }
        else if (seg < 240) { const int s2 = seg - 224, l2 = s2 >> 3, i8 = s2 & 7, un = i8 >> 2, q = i8 & 3;
            src = (q < 2 ? CTX_IN(11) : CTX_IN(12)) + (size_t)l2 * D * DF + un * 128 + 64 * (q & 1); ld = 256; dst = (u16*)(ws + WS_WSGU) + (size_t)l2 * 512 * 1024 + (size_t)(64 * i8) * 1024; }
        else { const int s2 = seg - 240, l2 = s2 >> 4, col = 64 * (s2 & 15); src = CTX_IN(13) + (size_t)l2 * DF * D + col; ld = 1024; Kd = 256; dst = (u16*)(ws + WS_WSD) + (size_t)l2 * D * DF + (size_t)col * 256; }
        {
            const int kr = tid >> 4, c4 = tid & 15;
#pragma unroll
            for (int i = 0; i < 2; ++i) {
                const f32x4 v = *(const f32x4*)(src + (size_t)(kt * 64 + kr + 32 * i) * ld + 4 * c4);
#pragma unroll
                for (int jj = 0; jj < 4; ++jj) tl[(kr + 32 * i) * 65 + 4 * c4 + jj] = v[jj];
            }
        }
        __syncthreads();
        {
            const int row = tid >> 3, kc = tid & 7;
            float f[8];
#pragma unroll
            for (int jj = 0; jj < 8; ++jj) f[jj] = tl[(8 * kc + jj) * 65 + row];
            u32x4 w; w[0] = cvtpk(f[0], f[1]); w[1] = cvtpk(f[2], f[3]); w[2] = cvtpk(f[4], f[5]); w[3] = cvtpk(f[6], f[7]);
            *(u32x4*)(dst + (size_t)row * Kd + kt * 64 + 8 * kc) = w;
        }
        __syncthreads();
    }
}

__device__ __forceinline__ void ph_qkv(int L, int rep_) {
    PH_FN_BEGIN
    (void)rep_;
    {
        const pg8::Gemm g{P_xb, (const u16*)(ws + (L == 0 ? WS_WQK0 : WS_WQK1)), T, L == 0 ? 2048 : 6144, D};
        pg8::StaticOrder S; S.init(g.M, g.N, G, bid);
        const EpiQK E{P_qkv, NQ};
        pg8::gemm_phase<EpiQK, pg8::StaticOrder, false>((PG8_LAS unsigned char*)lds, g, S, E, nullptr);
    }
    {
        const pg8::Gemm g{P_xb, (const u16*)(ws + (L == 0 ? WS_WV0 : WS_WV1)), T, L == 0 ? 1024 : 3072, D};
        pg8::StaticOrder S; S.init(g.M, g.N, G, bid);
        const EpiV E{P_vT, L};
        pg8::gemm_phase<EpiV, pg8::StaticOrder, true>((PG8_LAS unsigned char*)lds, g, S, E, nullptr);
    }
}

__device__ __forceinline__ void ph_kmean(int L, int rep_) {
    PH_FN_BEGIN
    (void)rep_;

            PH_BEGIN;
                LAS float* red = (LAS float*)lds;
                for (int it = bid; it < BATCH * NH * MOBA_NB; it += G) {
                    const int j = it & 31, h = (it >> 5) & 15, b = it >> 9;
                    const int d = tid & 63, part = tid >> 6;
                    const u16* kp = P_qkv + (size_t)(b * SEQ + j * MOBA_BLK + part * 32) * 3072 + 1024 + h * 64 + d;
                    float s = 0.f;
                    for (int k = 0; k < 32; ++k) s += bf2f(kp[(size_t)k * 3072]);
                    red[part * 64 + d] = s;
                    __syncthreads();
                    if (tid < 64) {
                        float tot = 0.f;
#pragma unroll
                        for (int p8 = 0; p8 < 8; ++p8) tot += red[p8 * 64 + tid];
                        P_kmean[(size_t)it * 64 + tid] = tot * (1.f / MOBA_BLK);
                    }
                    __syncthreads();
                }

}

__device__ __forceinline__ void ph_gate(int L, int rep_) {
    PH_FN_BEGIN
    (void)rep_;
    PH_BEGIN;
    for (int it = bid; it < BATCH * NH * MOBA_NB; it += G) {
        const int qb = it & 31, bh = it >> 5, b = bh >> 4, h = bh & 15;
        const int tq = qb * MOBA_BLK + wave * 32 + r32;
        const u16* qrow = P_qkv + (size_t)(b * SEQ + tq) * 3072 + h * 64 + hi * 8;
        bf16x8 qf[4];
#pragma unroll
        for (int d0 = 0; d0 < 4; ++d0) qf[d0] = *(const bf16x8*)(qrow + d0 * 16);
        unsigned selmask = 0u;
        if (qb > 0) {
            const float* km = P_kmean + ((size_t)(b * NH + h) * MOBA_NB + r32) * 64 + hi * 8;
            f32x16 gt;
#pragma unroll
            for (int r = 0; r < 16; ++r) gt[r] = 0.f;
#pragma unroll
            for (int d0 = 0; d0 < 4; ++d0) {
                const f32x4 k0 = *(const f32x4*)(km + d0 * 16), k1 = *(const f32x4*)(km + d0 * 16 + 4);
                union { bf16x8 v; unsigned u[4]; } kf;
                kf.u[0] = cvtpk(k0[0], k0[1]); kf.u[1] = cvtpk(k0[2], k0[3]); kf.u[2] = cvtpk(k1[0], k1[1]); kf.u[3] = cvtpk(k1[2], k1[3]);
                gt = MFMA_BF16(kf.v, qf[d0], gt);
            }
            float v0 = -INFINITY, v1 = -INFINITY, v2 = -INFINITY; int i0 = 99, i1 = 99, i2 = 99;
#pragma unroll
            for (int r = 0; r < 16; ++r) { const int jb = crow(r, hi); const float gv = jb < qb ? gt[r] : -INFINITY; top3_insert(gv, jb < qb ? jb : 99, v0, i0, v1, i1, v2, i2); }
            const float ov0 = __shfl_xor(v0, 32), ov1 = __shfl_xor(v1, 32), ov2 = __shfl_xor(v2, 32);
            const int oi0 = __shfl_xor(i0, 32), oi1 = __shfl_xor(i1, 32), oi2 = __shfl_xor(i2, 32);
            top3_insert(ov0, oi0, v0, i0, v1, i1, v2, i2); top3_insert(ov1, oi1, v0, i0, v1, i1, v2, i2); top3_insert(ov2, oi2, v0, i0, v1, i1, v2, i2);
            if (i0 < 32) selmask |= 1u << i0;
            if (i1 < 32) selmask |= 1u << i1;
            if (i2 < 32) selmask |= 1u << i2;
        }
        if (hi == 0) P_selm[(size_t)bh * SEQ + tq] = selmask;
    }
}

constexpr int MB_KP = 72;
constexpr int MB_VP = 260;
constexpr int MB_LDS_K = 0;
constexpr int MB_LDS_V = 256 * MB_KP * 2;
constexpr int MB_LDS_LIST = MB_LDS_V + 64 * MB_VP * 2;
constexpr int MB_LDS_CTR = MB_LDS_LIST + 8192 * 2;
__device__ __forceinline__ void ph_moba(int L, int rep_) {
    PH_FN_BEGIN
    (void)rep_;
    PH_BEGIN;
    LAS char* Ks = lds + MB_LDS_K; LAS char* Vs = lds + MB_LDS_V;
    LAS u16* qlist = (LAS u16*)(lds + MB_LDS_LIST); LAS int* ctr = (LAS int*)(lds + MB_LDS_CTR);
    for (int it = bid; it < BATCH * NH * MOBA_NB; it += G) {
        const int rnd = it >> 8, w8 = it & 255, a8 = w8 >> 5, bh = w8 & 31;
        const int j = rnd == 0 ? a8 : (rnd == 1 ? 15 - a8 : (rnd == 2 ? 16 + a8 : 31 - a8));
        const int b = bh >> 4, h = bh & 15;
        const float slope2 = exp2f(-0.5f * (float)(h + 1)) * LOG2E;
        if (tid == 0) { ctr[0] = 0; ctr[1] = 0; }
        {
            const u16* kg = P_qkv + (size_t)(b * SEQ + j * MOBA_BLK) * 3072 + 1024 + h * 64;
#pragma unroll
            for (int i = 0; i < 4; ++i) { const int c = tid + i * 512, row = c >> 3, ch = c & 7; *(LAS u32x4*)(Ks + (row * MB_KP + ch * 8) * 2) = *(const u32x4*)(kg + (size_t)row * 3072 + ch * 8); }
            const u16* vg = P_vT + (size_t)(b * NH + h) * HD * SEQ + j * MOBA_BLK;
#pragma unroll
            for (int i = 0; i < 4; ++i) {
                const int c = tid + i * 512, d = c >> 5, ch = c & 31;
                const u32x4 v = *(const u32x4*)(vg + (size_t)d * SEQ + ch * 8);
                u32x2 w0, w1; w0[0] = v[0]; w0[1] = v[1]; w1[0] = v[2]; w1[1] = v[3];
                *(LAS u32x2*)(Vs + (d * MB_VP + ch * 8) * 2) = w0; *(LAS u32x2*)(Vs + (d * MB_VP + ch * 8 + 4) * 2) = w1;
            }
        }
        __syncthreads();
        {
            const unsigned* sm = P_selm + (size_t)bh * SEQ;
            for (int t0 = (j + 1) * MOBA_BLK; t0 < SEQ; t0 += 512) {
                const int t = t0 + tid;
                const bool sel = (t < SEQ) && ((sm[t < SEQ ? t : 0] >> j) & 1u);
                const unsigned long long bal = __ballot(sel);
                const int total = __popcll(bal);
                int wb = 0;
                if (lane == 0 && total) wb = atomicAdd((int*)&ctr[0], total);
                wb = __shfl(wb, 0);
                if (sel) qlist[wb + __popcll(bal & ((1ull << lane) - 1ull))] = (u16)t;
            }
        }
        __syncthreads();
        const int nq = ctr[0];
        const int ntiles = 8 + ((nq + 31) >> 5);
        for (;;) {
            int ti = 0;
            if (lane == 0) ti = atomicAdd((int*)&ctr[1], 1);
            ti = __shfl(ti, 0);
            if (ti >= ntiles) break;
            const bool own = ti < 8;
            const int wq = 7 - ti;
            const int li = (ti - 8) * 32 + r32;
            const bool valid = own || li < nq;
            const int tq = own ? j * MOBA_BLK + wq * 32 + r32 : (int)qlist[li < nq ? li : nq - 1];
            const int nsteps = own ? wq + 1 : 8;
            const u16* qrow = P_qkv + (size_t)(b * SEQ + tq) * 3072 + h * 64 + hi * 8;
            bf16x8 qf[4];
#pragma unroll
            for (int d0 = 0; d0 < 4; ++d0) qf[d0] = *(const bf16x8*)(qrow + d0 * 16);
            int slot = 3;
            if (!own) slot = __popc(P_selm[(size_t)bh * SEQ + tq] & ((1u << j) - 1u));
            AttnSt st; st.m = NEGV; st.l = 0.f;
#pragma unroll
            for (int r = 0; r < 16; ++r) { st.o0[r] = 0.f; st.o1[r] = 0.f; }
            const int dlo = own ? 0 : -0x40000000;
            for (int kt = 0; kt < nsteps; ++kt) {
                AttnFr f;
#pragma unroll
                for (int d0 = 0; d0 < 4; ++d0) f.k[d0] = *(LAS bf16x8*)(Ks + ((kt * 32 + r32) * MB_KP + d0 * 16 + hi * 8) * 2);
#pragma unroll
                for (int q4 = 0; q4 < 4; ++q4) {
                    union { bf16x8 v; u32x2 hh[2]; } va;
                    LAS char* vp = Vs + (((q4 >> 1) * 32 + r32) * MB_VP + kt * 32 + (q4 & 1) * 16 + 4 * hi) * 2;
                    va.hh[0] = *(LAS u32x2*)(vp); va.hh[1] = *(LAS u32x2*)(vp + 16);
                    f.v[q4] = va.v;
                }
                attn_compute(st, qf, f, tq - (j * MOBA_BLK + kt * 32) - 4 * hi, slope2, dlo, 0x7fffffff, hi);
            }
            const float lt = st.l + __shfl_xor(st.l, 32);
            const float inv = 1.f / lt;
            if (valid) {
                const size_t pi = ((size_t)(b * SEQ + tq) * NH + h) * 4 + slot;
                u16* orow = P_part + pi * 64;
#pragma unroll
                for (int rq = 0; rq < 4; ++rq) {
                    u32x2 w; w[0] = cvtpk(st.o0[4 * rq] * inv, st.o0[4 * rq + 1] * inv); w[1] = cvtpk(st.o0[4 * rq + 2] * inv, st.o0[4 * rq + 3] * inv);
                    *(u32x2*)(orow + 8 * rq + 4 * hi) = w;
                    w[0] = cvtpk(st.o1[4 * rq] * inv, st.o1[4 * rq + 1] * inv); w[1] = cvtpk(st.o1[4 * rq + 2] * inv, st.o1[4 * rq + 3] * inv);
                    *(u32x2*)(orow + 32 + 8 * rq + 4 * hi) = w;
                }
                if (hi == 0) P_plse[pi] = st.m * LN2 + logf(lt);
            }
        }
        __syncthreads();
    }
}

__device__ __forceinline__ void ph_mobamerge(int L, int rep_) {
    PH_FN_BEGIN
    (void)rep_;
    PH_BEGIN;
    for (size_t i = (size_t)bid * NTHR + tid; i < (size_t)T * NH * 8; i += (size_t)G * NTHR) {
        const size_t row = i >> 7; const int h = (int)(i >> 3) & 15, d8 = (int)i & 7;
        const int qb = (int)(row & (SEQ - 1)) >> 8;
        const int nsel = qb < 3 ? qb : 3;
        const size_t pi = (row * NH + h) * 4;
        float l[4], w[4];
        float mx = -INFINITY;
#pragma unroll
        for (int sidx = 0; sidx < 4; ++sidx) { const bool ok = sidx == 3 || sidx < nsel; l[sidx] = ok ? P_plse[pi + sidx] : -INFINITY; mx = fmaxf(mx, l[sidx]); }
        float ws_ = 0.f;
#pragma unroll
        for (int sidx = 0; sidx < 4; ++sidx) { w[sidx] = (sidx == 3 || sidx < nsel) ? expf(l[sidx] - mx) : 0.f; ws_ += w[sidx]; }
        const float inv = 1.f / ws_;
        float acc8[8];
#pragma unroll
        for (int c = 0; c < 8; ++c) acc8[c] = 0.f;
#pragma unroll
        for (int sidx = 0; sidx < 4; ++sidx) {
            if (sidx == 3 || sidx < nsel) {
                const u32x4 a = *(const u32x4*)(P_part + (pi + sidx) * 64 + d8 * 8);
                const float ww = w[sidx] * inv;
#pragma unroll
                for (int c = 0; c < 4; ++c) { acc8[2 * c] += ww * bf2f(a[c] & 0xFFFFu); acc8[2 * c + 1] += ww * bf2f(a[c] >> 16); }
            }
        }
        u32x4 o;
#pragma unroll
        for (int c = 0; c < 4; ++c) o[c] = cvtpk(acc8[2 * c], acc8[2 * c + 1]);
        *(u32x4*)(P_ao + row * D + h * 64 + d8 * 8) = o;
    }
}

__device__ __forceinline__ void ph_dil(int L, int rep_) {
    PH_FN_BEGIN
    (void)rep_;
            PH_BEGIN;
                for (int it = bid; it < BATCH * NH * 3 * 32; it += G) {
                    const int ch = it & 31, grp = (it >> 5) % 3, bh = it / 96, b = bh >> 4, h = bh & 15;
                    const int dil = grp == 0 ? 1 : (grp == 1 ? 4 : 16), Ls = SEQ / dil;
                    const float slope2 = exp2f(-0.5f * (float)(h + 1)) * LOG2E * (float)dil;
                    const int u0 = ch * 256 + wave * 32, res = u0 / Ls, i0 = u0 - res * Ls;
                    const int iq = i0 + r32, pq = iq * dil + res;
                    const u16* qrow = P_qkv + (size_t)(b * SEQ + pq) * 9216 + grp * 3072 + h * 64 + hi * 8;
                    bf16x8 qf[4];
#pragma unroll
                    for (int d0 = 0; d0 < 4; ++d0) qf[d0] = *(const bf16x8*)(qrow + d0 * 16);
                    AttnSt st; st.m = NEGV; st.l = 0.f;
#pragma unroll
                    for (int r = 0; r < 16; ++r) { st.o0[r] = 0.f; st.o1[r] = 0.f; }
                    const u16* kbase = P_qkv + (size_t)(b * SEQ) * 9216 + grp * 3072 + 1024 + h * 64 + hi * 8;
                    const u16* vtb = P_vT + (size_t)grp * T * D + ((size_t)(b * NH + h) * HD + r32) * SEQ + (size_t)res * Ls + 4 * hi;
                    {
                        const int ktmin = (i0 >= 128) ? 0 : (128 - i0) >> 5;
                        AttnFr fa, fb;
                        { const int k1 = i0 - 128 + 4 * 32; attn_load(fa, kbase + (size_t)((k1 + r32) * dil + res) * 9216, vtb + k1, SEQ); }
#define DIL_STEP(FR, FN) { \
                            { const int k1 = i0 - 128 + (kt > ktmin ? kt - 1 : kt) * 32; attn_load(FN, kbase + (size_t)((k1 + r32) * dil + res) * 9216, vtb + k1, SEQ); } \
                            const int k0 = i0 - 128 + kt * 32; \
                            attn_compute(st, qf, FR, iq - k0 - 4 * hi, slope2, 0, 128, hi); }
                        for (int kt = 4; kt >= ktmin; --kt) {
                            DIL_STEP(fa, fb)
                            if (--kt < ktmin) break;
                            DIL_STEP(fb, fa)
                        }
                    }
                    const float lt = st.l + __shfl_xor(st.l, 32);
                    const float inv = 1.f / lt;
                    u16* orow = P_og + (size_t)grp * T * D + (size_t)(b * SEQ + pq) * D + h * 64;
#pragma unroll
                    for (int rq = 0; rq < 4; ++rq) {
                        u32x2 w; w[0] = cvtpk(st.o0[4 * rq] * inv, st.o0[4 * rq + 1] * inv); w[1] = cvtpk(st.o0[4 * rq + 2] * inv, st.o0[4 * rq + 3] * inv);
                        *(u32x2*)(orow + 8 * rq + 4 * hi) = w;
                        w[0] = cvtpk(st.o1[4 * rq] * inv, st.o1[4 * rq + 1] * inv); w[1] = cvtpk(st.o1[4 * rq + 2] * inv, st.o1[4 * rq + 3] * inv);
                        *(u32x2*)(orow + 32 + 8 * rq + 4 * hi) = w;
                    }
                    if (hi == 0) P_lse[((size_t)grp * T + (b * SEQ + pq)) * NH + h] = st.m * LN2 + logf(lt);
                }

}

__device__ __forceinline__ void ph_merge(int L, int rep_) {
    PH_FN_BEGIN
    (void)rep_;

            PH_BEGIN;
                for (size_t i = (size_t)bid * NTHR + tid; i < (size_t)T * NH * 8; i += (size_t)G * NTHR) {
                    const size_t row = i >> 7; const int h = (int)(i >> 3) & 15, d8 = (int)i & 7;
                    const float l0 = P_lse[(0 * (size_t)T + row) * NH + h], l1 = P_lse[(1 * (size_t)T + row) * NH + h], l2 = P_lse[(2 * (size_t)T + row) * NH + h];
                    const float mx = fmaxf(l0, fmaxf(l1, l2));
                    float w0 = expf(l0 - mx), w1 = expf(l1 - mx), w2 = expf(l2 - mx);
                    const float inv = 1.f / (w0 + w1 + w2); w0 *= inv; w1 *= inv; w2 *= inv;
                    const size_t off = row * D + h * 64 + d8 * 8;
                    const u32x4 a0 = *(const u32x4*)(P_og + off), a1 = *(const u32x4*)(P_og + (size_t)T * D + off), a2 = *(const u32x4*)(P_og + 2 * (size_t)T * D + off);
                    u32x4 o;
#pragma unroll
                    for (int c = 0; c < 4; ++c) {
                        const float lo_ = w0 * bf2f(a0[c] & 0xFFFFu) + w1 * bf2f(a1[c] & 0xFFFFu) + w2 * bf2f(a2[c] & 0xFFFFu);
                        const float hi_ = w0 * bf2f(a0[c] >> 16) + w1 * bf2f(a1[c] >> 16) + w2 * bf2f(a2[c] >> 16);
                        o[c] = cvtpk(lo_, hi_);
                    }
                    *(u32x4*)(P_ao + off) = o;
                }

}

__device__ __forceinline__ void ph_wo(int L, int rep_) {
    PH_FN_BEGIN
    (void)rep_;
    const pg8::Gemm g{P_ao, (const u16*)(ws + WS_WO) + (size_t)L * D * D, T, D, D};
    pg8::StaticOrder S; S.init(g.M, g.N, G, bid);
    const EpiWo E{P_ypre, L == 0 ? CTX_IN(0) : (const float*)P_x2};
    pg8::gemm_phase<EpiWo, pg8::StaticOrder, false>((PG8_LAS unsigned char*)lds, g, S, E, nullptr);
}

__device__ __forceinline__ void ph_router(int L, int rep_) {
    PH_FN_BEGIN
    (void)rep_;

            PH_BEGIN;
            const float* lng = CTX_IN(4) + L * D; const float* lnb = CTX_IN(5) + L * D;
            const float* wr = CTX_IN(6) + (size_t)L * D * NE; const float* rbias = CTX_IN(7) + L * NE;
            LAS float* xs = (LAS float*)lds;
            for (int it = bid; it < T / 32; it += G) {
#pragma unroll 1
                for (int rr = 0; rr < 4; ++rr) {
                    const int lr = wave * 4 + rr; const size_t row = (size_t)it * 32 + lr;
                    float v[16];
#pragma unroll
                    for (int j = 0; j < 4; ++j) { const f32x4 t4 = *(const f32x4*)(P_ypre + row * D + j * 256 + lane * 4); v[j * 4] = t4[0]; v[j * 4 + 1] = t4[1]; v[j * 4 + 2] = t4[2]; v[j * 4 + 3] = t4[3]; }
                    ln_row(v, lng, lnb, lane);
#pragma unroll
                    for (int j = 0; j < 4; ++j) {
                        f32x4 t4; t4[0] = v[j * 4]; t4[1] = v[j * 4 + 1]; t4[2] = v[j * 4 + 2]; t4[3] = v[j * 4 + 3];
                        *(f32x4*)(P_x1 + row * D + j * 256 + lane * 4) = t4;
                        *(LAS f32x4*)(xs + lr * XS_PITCH + j * 256 + lane * 4) = t4;
                        u32x2 w; w[0] = cvtpk(t4[0], t4[1]); w[1] = cvtpk(t4[2], t4[3]);
                        *(u32x2*)(P_xb + row * D + j * 256 + lane * 4) = w;
                    }
                }
                __syncthreads();
                f32x16 lg;
#pragma unroll
                for (int r = 0; r < 16; ++r) lg[r] = 0.f;
                {
                    const LAS float* ap = xs + r32 * XS_PITCH + hi;
                    const float* bp = wr + (size_t)hi * NE + wave * 32 + r32;
                    float bva[32], bvb[32];
#pragma unroll
                    for (int j = 0; j < 32; ++j) bva[j] = bp[(size_t)(2 * j) * NE];
#pragma unroll 1
                    for (int k0 = 0; k0 < D; k0 += 128) {
#pragma unroll
                        for (int j = 0; j < 32; ++j) bvb[j] = bp[(size_t)(k0 + 64 + 2 * j) * NE];
#pragma unroll
                        for (int j = 0; j < 32; ++j) lg = __builtin_amdgcn_mfma_f32_32x32x2f32(ap[k0 + 2 * j], bva[j], lg, 0, 0, 0);
                        if (k0 + 128 < D) {
#pragma unroll
                            for (int j = 0; j < 32; ++j) bva[j] = bp[(size_t)(k0 + 128 + 2 * j) * NE];
                        }
#pragma unroll
                        for (int j = 0; j < 32; ++j) lg = __builtin_amdgcn_mfma_f32_32x32x2f32(ap[k0 + 64 + 2 * j], bvb[j], lg, 0, 0, 0);
                    }
                }
                __syncthreads();
                LAS float* lgs = (LAS float*)lds;
#pragma unroll
                for (int r = 0; r < 16; ++r) lgs[crow(r, hi) * 257 + wave * 32 + r32] = lg[r];
                __syncthreads();
#pragma unroll 1
                for (int rr = 0; rr < 4; ++rr) {
                    const int lr = wave * 4 + rr; const int tok = it * 32 + lr;
                    float sc[4], ch[4];
#pragma unroll
                    for (int j = 0; j < 4; ++j) { const int e = lane + 64 * j; sc[j] = 1.f / (1.f + expf(-lgs[lr * 257 + e])); ch[j] = sc[j] + rbias[e]; }
                    float gsel[8], gmine[4];
#pragma unroll
                    for (int j = 0; j < 4; ++j) {
                        float m1 = ch[j];
#pragma unroll
                        for (int o = 16; o >= 1; o >>= 1) m1 = fmaxf(m1, __shfl_xor(m1, o));
                        const unsigned long long bal = __ballot(ch[j] == m1);
                        const unsigned half = (unsigned)(hi ? (bal >> 32) : (bal & 0xFFFFFFFFull));
                        const int first = __builtin_ctz(half);
                        float m2 = (r32 == first) ? -INFINITY : ch[j];
#pragma unroll
                        for (int o = 16; o >= 1; o >>= 1) m2 = fmaxf(m2, __shfl_xor(m2, o));
                        const float mine = m1 + m2, other = __shfl_xor(mine, 32);
                        gsel[2 * j] = hi ? other : mine; gsel[2 * j + 1] = hi ? mine : other; gmine[j] = mine;
                    }
                    bool gok[4];
#pragma unroll
                    for (int j = 0; j < 4; ++j) {
                        const float mygs = gmine[j];
                        const int myg = 2 * j + hi;
                        int rank = 0;
#pragma unroll
                        for (int g2 = 0; g2 < 8; ++g2) rank += ((gsel[g2] > mygs) || (gsel[g2] == mygs && g2 < myg)) ? 1 : 0;
                        gok[j] = rank < 4;
                    }
                    float cv[4];
#pragma unroll
                    for (int j = 0; j < 4; ++j) cv[j] = gok[j] ? ch[j] : NEGV;
                    float wsel = 0.f; int esel = 0; float wsum = 0.f;
#pragma unroll 1
                    for (int k = 0; k < TOPK; ++k) {
                        float bv = cv[0]; int be = lane;
#pragma unroll
                        for (int j = 1; j < 4; ++j) if (cv[j] > bv) { bv = cv[j]; be = lane + 64 * j; }
#pragma unroll
                        for (int o = 32; o >= 1; o >>= 1) {
                            const float ov = __shfl_xor(bv, o); const int oe = __shfl_xor(be, o);
                            if (ov > bv || (ov == bv && oe < be)) { bv = ov; be = oe; }
                        }
                        const int jl = be >> 6, ll = be & 63;
                        float smine = sc[0];
                        smine = jl == 1 ? sc[1] : smine; smine = jl == 2 ? sc[2] : smine; smine = jl == 3 ? sc[3] : smine;
                        const float sw = __shfl(smine, ll);
#pragma unroll
                        for (int j = 0; j < 4; ++j) cv[j] = (lane == ll && jl == j) ? -INFINITY : cv[j];
                        wsum += sw;
                        if (lane == k) { wsel = sw; esel = be; }
                    }
                    if (lane < TOPK) {
                        const int a = tok * TOPK + lane;
                        P_topw[a] = wsel / wsum * 2.5f;
                        if (rep_ == 0) {
                            const int pos = atomicAdd(&cnt[esel], 1);
                            P_list[(size_t)esel * T + pos] = a;
                        }
                    }
                }
                __syncthreads();
            }

}

__device__ __forceinline__ void ph_gateup(int L, int rep_) {
    PH_FN_BEGIN
    (void)rep_;

            PH_BEGIN;
            const float* weg = CTX_IN(8) + (size_t)L * NE * D * DF; const float* weu = CTX_IN(9) + (size_t)L * NE * D * DF;
            LAS int* rowid = (LAS int*)(lds + LDS_ROWID);
            for (int e = bid; e < NE; e += G) {
                const int n = cnt[e];
                const int nrt = (n + 255) >> 8;
                const float* wg_ = weg + (size_t)e * D * DF;
                const float* wu_ = weu + (size_t)e * D * DF;
                for (int rt = 0; rt < nrt; ++rt) {
                    if (tid < 256) {
                        const int idx = rt * 256 + tid;
                        rowid[tid] = idx < n ? P_list[(size_t)e * T + idx] : TRASH_VA;
                    }
                    __syncthreads();
                    const int va0 = rowid[tid >> 2], va1 = rowid[(tid >> 2) + 128];
                    const u16* pa0 = va0 == TRASH_VA ? nullptr : P_xb + (size_t)(va0 >> 3) * D;
                    const u16* pa1 = va1 == TRASH_VA ? nullptr : P_xb + (size_t)(va1 >> 3) * D;
#pragma unroll 1
                    for (int fc = 0; fc < 2; ++fc) {
                        f32x16 acc[4][2];
                        const float* pbseg = ((wave & 1) ? wu_ : wg_) + fc * 128 + (wave >> 1) * 32;
                        GEMM_CORE(D, pa0, pa1, pbseg, DF)
                        const int wm = wave >> 2, wn = wave & 3;
                        const unsigned f = fc * 128 + wn * 32 + 4 * (r32 & 7) + (r32 >> 3);
                        int rbase = wm * 128 + 4 * hi; asm volatile("" : "+v"(rbase));
                        u16* hbp = P_hb;
#pragma unroll
                        for (int mb = 0; mb < 4; ++mb) {
#pragma unroll
                            for (int r = 0; r < 16; ++r) {
                                const unsigned va = (unsigned)rowid[rbase + mb * 32 + (r & 3) + 8 * (r >> 2)];
                                const float gt = acc[mb][0][r], up = acc[mb][1][r];
                                const float hval = gt / (1.f + __expf(-gt)) * up;
                                hbp[va * DF + f] = (u16)cvtpk(hval, 0.f);
                            }
                            asm volatile("" ::: "memory");
                        }
                    }
                    __syncthreads();
                }
            }

    {
        const pg8::Gemm g{P_xb, (const u16*)(ws + WS_WSGU) + (size_t)L * 512 * 1024, T, 512, D};
        pg8::StaticOrder S; S.init(g.M, g.N, G, (bid + 128) % G);
        const EpiSGU E{P_hb};
        pg8::gemm_phase<EpiSGU, pg8::StaticOrder, false>((PG8_LAS unsigned char*)lds, g, S, E, nullptr);
    }
}

__device__ __forceinline__ void ph_down(int L, int rep_) {
    PH_FN_BEGIN
    (void)rep_;

            PH_BEGIN;
            const float* wed = CTX_IN(10) + (size_t)L * NE * DF * D;
            LAS int* rowid = (LAS int*)(lds + LDS_ROWID);
            LAS float* roww = (LAS float*)(lds + LDS_ROWW);
            for (int e = bid; e < NE; e += G) {
                const int n = cnt[e];
                const int nrt = (n + 255) >> 8;
                const float* wd_ = wed + (size_t)e * DF * D;
                for (int rt = 0; rt < nrt; ++rt) {
                    if (tid < 256) {
                        const int idx = rt * 256 + tid;
                        const int va = idx < n ? P_list[(size_t)e * T + idx] : TRASH_VA;
                        rowid[tid] = va;
                        roww[tid] = va < A_TOT ? P_topw[va] : 1.f;
                    }
                    __syncthreads();
                    const int va0 = rowid[tid >> 2], va1 = rowid[(tid >> 2) + 128];
                    const u16* pa0 = va0 == TRASH_VA ? nullptr : P_hb + (size_t)va0 * DF;
                    const u16* pa1 = va1 == TRASH_VA ? nullptr : P_hb + (size_t)va1 * DF;
#pragma unroll 1
                    for (int nt = 0; nt < 4; ++nt) {
                        f32x16 acc[4][2];
                        GEMM_CORE(DF, pa0, pa1, wd_ + nt * 256 + wave * 32, D)
                        const int wm = wave >> 2, wn = wave & 3;
                        int rbase = wm * 128 + 4 * hi; asm volatile("" : "+v"(rbase));
                        const unsigned col = nt * 256 + wn * 64 + 4 * (r32 & 7) + (r32 >> 3);
                        u16* ybp = P_yb;
#pragma unroll
                        for (int mb = 0; mb < 4; ++mb) {
#pragma unroll
                            for (int r = 0; r < 16; ++r) {
                                const int lrow = rbase + mb * 32 + (r & 3) + 8 * (r >> 2);
                                const unsigned va = (unsigned)rowid[lrow]; const float w = roww[lrow];
                                ybp[va * D + col] = (u16)cvtpk(acc[mb][0][r] * w, 0.f);
                                ybp[va * D + col + 32] = (u16)cvtpk(acc[mb][1][r] * w, 0.f);
                            }
                            asm volatile("" ::: "memory");
                        }
                    }
                    __syncthreads();
                }
            }

    {
        const pg8::Gemm g{P_hb + (size_t)A_TOT * DF, (const u16*)(ws + WS_WSD) + (size_t)L * D * DF, T, D, DF};
        pg8::StaticOrder S; S.init(g.M, g.N, G, bid);
        const EpiSD E{P_yb};
        pg8::gemm_phase<EpiSD, pg8::StaticOrder, false>((PG8_LAS unsigned char*)lds, g, S, E, nullptr);
    }
}

__device__ __forceinline__ void ph_combine(int L, int rep_) {
    PH_FN_BEGIN
    (void)rep_;

            PH_BEGIN;
            const float* lng = CTX_IN(14) + L * D; const float* lnb = CTX_IN(15) + L * D;
            float* dst = L == 0 ? P_x2 : AS_GLOBAL(float, ctx_ld(16));
            for (int row = bid * 8 + wave; row < T; row += G * 8) {
                float v[16];
#pragma unroll
                for (int j = 0; j < 4; ++j) { const f32x4 t4 = *(const f32x4*)(P_x1 + (size_t)row * D + j * 256 + lane * 4); v[j * 4] = DN_ALPHA * t4[0]; v[j * 4 + 1] = DN_ALPHA * t4[1]; v[j * 4 + 2] = DN_ALPHA * t4[2]; v[j * 4 + 3] = DN_ALPHA * t4[3]; }
#pragma unroll 1
                for (int k = 0; k < TOPK + 1; ++k) {
                    const size_t va = k < TOPK ? (size_t)row * TOPK + k : (size_t)A_TOT + row;
#pragma unroll
                    for (int j = 0; j < 4; ++j) {
                        const u32x2 w = *(const u32x2*)(P_yb + va * D + j * 256 + lane * 4);
                        v[j * 4] += bf2f(w[0] & 0xFFFFu); v[j * 4 + 1] += bf2f(w[0] >> 16); v[j * 4 + 2] += bf2f(w[1] & 0xFFFFu); v[j * 4 + 3] += bf2f(w[1] >> 16);
                    }
                }
                ln_row(v, lng, lnb, lane);
#pragma unroll
                for (int j = 0; j < 4; ++j) {
                    f32x4 t4; t4[0] = v[j * 4]; t4[1] = v[j * 4 + 1]; t4[2] = v[j * 4 + 2]; t4[3] = v[j * 4 + 3];
                    *(f32x4*)(dst + (size_t)row * D + j * 256 + lane * 4) = t4;
                    if (L == 0) { u32x2 w; w[0] = cvtpk(t4[0], t4[1]); w[1] = cvtpk(t4[2], t4[3]); *(u32x2*)(P_xb + (size_t)row * D + j * 256 + lane * 4) = w; }
                }
            }

}

__global__ void __launch_bounds__(NTHR, 2) fwd(Args args) {
    extern __shared__ __attribute__((aligned(16))) unsigned char lds_raw[];
    LAS char* lds = (LAS char*)lds_raw;
    unsigned char* const ws = args.ws;
    const int lo = args.ph_lo, hi_ph = args.ph_hi;
    if (threadIdx.x < 18) {
        const uint64_t v = threadIdx.x < 16 ? (uint64_t)args.in[threadIdx.x] : (threadIdx.x == 16 ? (uint64_t)args.out : (uint64_t)args.ws);
        ((LAS uint64_t*)(lds + LDS_CTX))[threadIdx.x] = v;
    }
    __syncthreads();
#define IN(k) (lo <= (k) && (k) < hi_ph)

#if MK_ONE_LAUNCH
    if (threadIdx.x < 4) ((LAS unsigned*)(lds + LDS_BAR))[threadIdx.x] = 0u;
    __syncthreads();
    XcdBarrier bar = xcd_barrier_post((unsigned*)(ws + WS_CTL), (volatile LAS unsigned*)(lds + LDS_BAR));
#define GRID_BAR() xcd_barrier(bar)
#else
#define GRID_BAR() do { } while (0)
#endif
#define SEAM(k) do { if (IN(k) && IN((k) + 1)) GRID_BAR(); } while (0)

    for (int rep_ = 0; rep_ < ((IN(0) && PHK(0)) ? REPS(0) : 0); ++rep_) { ph_p0(0, rep_); }
    SEAM(0);

    for (int L = 0; L < 2; ++L) {
        const int pb = 1 + 10 * L;
        for (int rep_ = 0; rep_ < ((IN(pb + 0) && PHK(1)) ? REPS(1) : 0); ++rep_) { ph_qkv(L, rep_); }
        SEAM(pb + 0);

        if (L == 0) {
            for (int rep_ = 0; rep_ < ((IN(pb + 1) && PHK(2)) ? REPS(2) : 0); ++rep_) { ph_kmean(L, rep_); }
            SEAM(pb + 1);
            for (int rep_ = 0; rep_ < ((IN(pb + 2) && PHK(11)) ? REPS(11) : 0); ++rep_) { ph_gate(L, rep_); }
            SEAM(pb + 2);
        }

        if (L == 0) {
            for (int rep_ = 0; rep_ < ((IN(pb + 3) && PHK(3)) ? REPS(3) : 0); ++rep_) { ph_moba(L, rep_); }
            SEAM(pb + 3);
            for (int rep_ = 0; rep_ < ((IN(pb + 4) && PHK(12)) ? REPS(12) : 0); ++rep_) { ph_mobamerge(L, rep_); }
        } else {
            for (int rep_ = 0; rep_ < ((IN(pb + 3) && PHK(4)) ? REPS(4) : 0); ++rep_) { ph_dil(L, rep_); }
            SEAM(pb + 3);
            for (int rep_ = 0; rep_ < ((IN(pb + 4) && PHK(5)) ? REPS(5) : 0); ++rep_) { ph_merge(L, rep_); }
        }
        SEAM(pb + 4);

        for (int rep_ = 0; rep_ < ((IN(pb + 5) && PHK(6)) ? REPS(6) : 0); ++rep_) { ph_wo(L, rep_); }
        SEAM(pb + 5);

        for (int rep_ = 0; rep_ < ((IN(pb + 6) && PHK(7)) ? REPS(7) : 0); ++rep_) { ph_router(L, rep_); }
        SEAM(pb + 6);

        for (int rep_ = 0; rep_ < ((IN(pb + 7) && PHK(8)) ? REPS(8) : 0); ++rep_) { ph_gateup(L, rep_); }
        SEAM(pb + 7);

        for (int rep_ = 0; rep_ < ((IN(pb + 8) && PHK(9)) ? REPS(9) : 0); ++rep_) { ph_down(L, rep_); }
        SEAM(pb + 8);

        for (int rep_ = 0; rep_ < ((IN(pb + 9) && PHK(10)) ? REPS(10) : 0); ++rep_) { ph_combine(L, rep_); }
        if (L == 0) SEAM(pb + 9);
    }
}

extern "C" void kernel_launch(void* const* d_in, const int* in_sizes, int n_in, void* d_out, int out_size, void* d_ws, size_t ws_size, hipStream_t stream) {
    static int grid = 0;
    if (grid == 0) {
        if (n_in != 16 || out_size != T * D || ws_size < WS_END2) { fprintf(stderr, "kernel_launch: unexpected problem (n_in %d out %d ws %zu need %zu)\n", n_in, out_size, ws_size, (size_t)WS_END2); grid = -1; return; }
        int dev = 0, cus = 0, per_cu = 0;
        if (hipGetDevice(&dev) != hipSuccess || hipDeviceGetAttribute(&cus, hipDeviceAttributeMultiprocessorCount, dev) != hipSuccess) { grid = -1; return; }
        if (hipFuncSetAttribute((const void*)fwd, hipFuncAttributeMaxDynamicSharedMemorySize, LDS_BYTES) != hipSuccess) { fprintf(stderr, "kernel_launch: hipFuncSetAttribute failed\n"); grid = -1; return; }
        if (hipOccupancyMaxActiveBlocksPerMultiprocessor(&per_cu, (const void*)fwd, NTHR, LDS_BYTES) != hipSuccess || per_cu < 1) { fprintf(stderr, "kernel_launch: occupancy query says %d\n", per_cu); (void)hipGetLastError(); per_cu = 1; }
        grid = cus;
    }
    if (grid < 0) return;
    (void)hipMemsetAsync((char*)d_ws + WS_CTL, 0, CTL_BYTES, stream);
    Args a{};
    for (int i = 0; i < 16; ++i) a.in[i] = (const float*)d_in[i];
    a.out = (float*)d_out; a.ws = (unsigned char*)d_ws;
#if MK_ONE_LAUNCH
    a.ph_lo = 0; a.ph_hi = N_PHASES;
    hipLaunchKernelGGL(fwd, dim3(grid), dim3(NTHR), LDS_BYTES, stream, a);
#else
    for (int ph = 0; ph < N_PHASES; ++ph) {
        if (ph == 12 || ph == 13) continue;
        a.ph_lo = ph; a.ph_hi = ph + 1;
        hipLaunchKernelGGL(fwd, dim3(grid), dim3(NTHR), LDS_BYTES, stream, a);
    }
#endif
}
```

```cpp
#include <hip/hip_runtime.h>
#include <hip/hip_bf16.h>
#include <stdint.h>
#include <stdio.h>

#ifndef MK_ONE_LAUNCH
#define MK_ONE_LAUNCH 1
#endif

#ifndef PHMASK
#define PHMASK 0x1FFF
#endif
#define PHK(k) ((PHMASK >> (k)) & 1)
#ifndef REPEAT_KIND
#define REPEAT_KIND -1
#endif
#define REPS(k) ((k) == REPEAT_KIND ? 2 : 1)
#define LAS __attribute__((address_space(3)))
typedef __attribute__((ext_vector_type(8))) short bf16x8;
typedef __attribute__((ext_vector_type(16))) float f32x16;
typedef __attribute__((ext_vector_type(4))) float f32x4;
typedef __attribute__((ext_vector_type(4))) unsigned u32x4;
typedef __attribute__((ext_vector_type(2))) unsigned u32x2;
typedef unsigned short u16;

constexpr int D = 1024, BATCH = 2, SEQ = 8192, T = BATCH * SEQ, NH = 16, HD = 64;
constexpr int NE = 256, TOPK = 8, DF = 256;
constexpr int A_TOT = T * TOPK;
constexpr int MOBA_BLK = 256, MOBA_NB = SEQ / MOBA_BLK;
constexpr float DN_ALPHA = 1.4142135623730951f;
constexpr float LN_EPS = 1e-5f;
constexpr float LOG2E = 1.4426950408889634f;
constexpr float LN2 = 0.6931471805599453f;
constexpr float NEGV = -1e30f;
constexpr int NTHR = 512;

constexpr size_t al256(size_t x) { return (x + 255) & ~(size_t)255; }
constexpr size_t WS_CTL = 0;
constexpr size_t CTL_BYTES = 65536;
constexpr size_t CTL_CNT_OFF = 32768;
constexpr size_t WS_XB = WS_CTL + CTL_BYTES;
constexpr size_t WS_X1 = WS_XB + al256((size_t)T * D * 2);
constexpr size_t WS_X2 = WS_X1 + al256((size_t)T * D * 4);
constexpr size_t WS_YPRE = WS_X2 + al256((size_t)T * D * 4);
constexpr size_t WS_QKV = WS_YPRE + al256((size_t)T * D * 4);
constexpr size_t WS_VT = WS_QKV + al256((size_t)T * 9216 * 2);
constexpr size_t WS_KM = WS_VT + al256((size_t)3 * T * D * 2);
constexpr size_t WS_AO = WS_KM + al256((size_t)BATCH * NH * MOBA_NB * HD * 4);
constexpr size_t WS_OG = WS_AO + al256((size_t)T * D * 2);
constexpr size_t WS_LSE = WS_OG + al256((size_t)3 * T * D * 2);
constexpr size_t WS_TOPW = WS_LSE + al256((size_t)3 * T * NH * 4);
constexpr size_t WS_LIST = WS_TOPW + al256((size_t)T * TOPK * 4);
constexpr size_t WS_HB = WS_LIST + al256((size_t)NE * T * 4);
constexpr size_t WS_YB = WS_HB + al256((size_t)(A_TOT + T + 1) * DF * 2);
constexpr size_t WS_END = WS_YB + al256((size_t)(A_TOT + T + 1) * D * 2);
constexpr int TRASH_VA = A_TOT + T;
constexpr size_t WS_SELM = WS_END;
constexpr size_t WS_PART = WS_SELM + al256((size_t)T * NH * 4);
constexpr size_t WS_PLSE = WS_PART + al256((size_t)T * NH * 4 * 64 * 2);
constexpr size_t WS_WQK0 = WS_PLSE + al256((size_t)T * NH * 4 * 4);
constexpr size_t WS_WV0 = WS_WQK0 + (size_t)2048 * 1024 * 2;
constexpr size_t WS_WQK1 = WS_WV0 + (size_t)1024 * 1024 * 2;
constexpr size_t WS_WV1 = WS_WQK1 + (size_t)6144 * 1024 * 2;
constexpr size_t WS_WO = WS_WV1 + (size_t)3072 * 1024 * 2;
constexpr size_t WS_WSGU = WS_WO + (size_t)2 * 1024 * 1024 * 2;
constexpr size_t WS_WSD = WS_WSGU + (size_t)2 * 512 * 1024 * 2;
constexpr size_t WS_END2 = WS_WSD + (size_t)2 * 1024 * 256 * 2;

constexpr int LDP = 40;
constexpr int STAGE_BYTES = 2 * 256 * LDP * 2;
constexpr int LDS_ROWID = 2 * STAGE_BYTES;
constexpr int LDS_ROWW = LDS_ROWID + 1024;
constexpr int XS_PITCH = 1028;
constexpr int LDS_BYTES = 163840;
constexpr int LDS_BAR = 161792;

#define XB_TMO      128
#define XB_XCNT(j)  (256  + 64 * (j))
#define XB_XSUB(j)  (1280 + 64 * (j))
#define XB_XGEN(j)  (2304 + 64 * (j))
#define XB_TOP      3328
#define XB_TOPGEN   3392
#define XCD_BAR_WORDS 3456
#define XB_SPIN_CAP (1u << 18)
__device__ __forceinline__ unsigned xb_ld(unsigned* p)              { return __hip_atomic_load(p, __ATOMIC_RELAXED, __HIP_MEMORY_SCOPE_AGENT); }
__device__ __forceinline__ unsigned xb_add(unsigned* p, unsigned v) { return __hip_atomic_fetch_add(p, v, __ATOMIC_RELAXED, __HIP_MEMORY_SCOPE_AGENT); }
__device__ __forceinline__ unsigned xb_xcc_id() { return (unsigned)__builtin_amdgcn_s_getreg((3 << 11) | 20) & 0xFu; }
#define XB_SPIN(cond, bar) do { unsigned _sp = 0; while (cond) { __builtin_amdgcn_s_sleep(1); \
    if ((++_sp & 255u) == 0u) { if (xb_ld(&(bar)[XB_TMO])) break; if (_sp > XB_SPIN_CAP) { atomicAdd(&(bar)[XB_TMO], 1u); break; } } } } while (0)
struct XcdBarrier { unsigned* bar; unsigned x; volatile LAS unsigned* st; };
__device__ __forceinline__ XcdBarrier xcd_barrier_post(unsigned* bar, volatile LAS unsigned* st) {
    XcdBarrier b; b.bar = bar; b.x = xb_xcc_id(); b.st = st;
    if (threadIdx.x == 0) (void)xb_add(&bar[XB_XCNT(b.x)], 1u);
    return b;
}
__device__ __forceinline__ void xcd_barrier_complete(unsigned* bar, unsigned x, unsigned& nloc, unsigned& nx) {
    const unsigned G = gridDim.x * gridDim.y * gridDim.z;
    unsigned sum, cnt, mine, sp = 0u;
    for (;;) {
        sum = 0u; cnt = 0u; mine = 0u;
#pragma unroll
        for (unsigned j = 0; j < 16; ++j) { const unsigned c = xb_ld(&bar[XB_XCNT(j)]); sum += c; cnt += (c > 0u) ? 1u : 0u; mine = (j == x) ? c : mine; }
        if (sum == G) break;
        __builtin_amdgcn_s_sleep(1);
        if ((++sp & 255u) == 0u) { if (xb_ld(&bar[XB_TMO])) break; if (sp > XB_SPIN_CAP) { atomicAdd(&bar[XB_TMO], 1u); break; } }
    }
    nloc = mine > 0u ? mine : 1u; nx = cnt > 0u ? cnt : 1u;
}
__device__ __forceinline__ void xcd_barrier(const XcdBarrier& b) {
    asm volatile("s_waitcnt vmcnt(0)" ::: "memory");
    __syncthreads();
    if (threadIdx.x == 0) {
        unsigned* bar = b.bar;
        __builtin_amdgcn_s_waitcnt(0);
        unsigned nloc = b.st[0], nx = b.st[1];
        if (nloc == 0u) { xcd_barrier_complete(bar, b.x, nloc, nx); b.st[0] = nloc; b.st[1] = nx; }
        const unsigned old = xb_add(&bar[XB_XSUB(b.x)], 1u);
        const unsigned gen = old / nloc;
        if (old + 1u == (gen + 1u) * nloc) {
            __builtin_amdgcn_fence(__ATOMIC_RELEASE, "agent");
            asm volatile("s_waitcnt vmcnt(0)" ::: "memory");
            const unsigned og = xb_add(&bar[XB_TOP], 1u);
            const unsigned tg = og / nx;
            if (og + 1u == (tg + 1u) * nx) xb_add(&bar[XB_TOPGEN], 1u);
            else XB_SPIN(xb_ld(&bar[XB_TOPGEN]) == tg, bar);
            __builtin_amdgcn_fence(__ATOMIC_ACQUIRE, "agent");
            xb_add(&bar[XB_XGEN(b.x)], 1u);
            asm volatile("s_waitcnt vmcnt(0)" ::: "memory");
        } else {
            XB_SPIN(xb_ld(&bar[XB_XGEN(b.x)]) == gen, bar);
            __builtin_amdgcn_fence(__ATOMIC_ACQUIRE, "agent");
            asm volatile("s_waitcnt vmcnt(0)" ::: "memory");
        }
    }
    __syncthreads();
}

typedef __attribute__((ext_vector_type(2))) __bf16 bf16x2_t;
typedef __attribute__((ext_vector_type(2))) float f32x2_t;
__device__ __forceinline__ unsigned cvtpk(float lo, float hi) { f32x2_t f; f[0] = lo; f[1] = hi; return __builtin_bit_cast(unsigned, __builtin_convertvector(f, bf16x2_t)); }
__device__ __forceinline__ float bf2f(unsigned v16) { return __uint_as_float(v16 << 16); }
__device__ __forceinline__ int crow(int r, int hi) { return (r & 3) + 8 * (r >> 2) + 4 * hi; }
#define MFMA_BF16(a, b, c) __builtin_amdgcn_mfma_f32_32x32x16_bf16(a, b, c, 0, 0, 0)
__device__ __forceinline__ float wave_sum(float v) {
#pragma unroll
    for (int o = 32; o >= 1; o >>= 1) v += __shfl_xor(v, o);
    return v;
}

namespace pg8 {
#define PG8_LAS __attribute__((address_space(3)))
typedef unsigned short bf16_t;
typedef short bf16x8 __attribute__((ext_vector_type(8)));
typedef float f32x4 __attribute__((ext_vector_type(4)));
typedef unsigned u32x4 __attribute__((ext_vector_type(4)));
constexpr int BM = 256, BK = 64, HALF = 128, HTB = HALF * BK * 2  , STAGE_BYTES = 8 * HTB, NXCD = 8, WGM = 8;

__host__ __device__ __forceinline__ int lds_byte(int r, int c) { const int st = (r >> 4) * 2 + (c >> 5), rr = r & 15, cc = c & 31, ob = rr * 64 + cc * 2; return st * 1024 + (ob ^ (((ob >> 9) & 1) << 5)); }
__host__ __device__ __forceinline__ void stage_rc(int b, int& R, int& C) { const int st = b / 1024, sb = b % 1024, swz = sb ^ (((sb >> 9) & 1) << 5); R = (st >> 1) * 16 + swz / 64; C = (st & 1) * 32 + (swz % 64) / 2; }
__host__ __device__ __forceinline__ int perm32(int rho) { const int n = rho >> 4, i = rho & 15; return 8 * (i >> 2) + 4 * n + (i & 3); }

struct Unit { int pm, pn; };
struct Gemm { const bf16_t* A; const bf16_t* Bt; int M, N, K; };

struct StaticOrder {
    int nM, nN, nwg, G, c;
    __host__ __device__ void init(int M, int N, int G_, int c_) { nM = M / BM; nN = N / BM; nwg = nM * nN; G = G_; c = c_; }
    __host__ __device__ bool next(int i, Unit& u) const {
        const long L = (long)i * G + c; if (L >= nwg) return false;
        int wgid = (int)L; { const int q = nwg / NXCD, r = nwg % NXCD, xcd = wgid % NXCD, off = wgid / NXCD; wgid = (xcd < r ? xcd * (q + 1) : r * (q + 1) + (xcd - r) * q) + off; }
        const int nig = WGM * nN, gid = wgid / nig, fm = gid * WGM, gsz = (nM - fm) < WGM ? (nM - fm) : WGM;
        u.pm = fm + ((wgid % nig) % gsz); u.pn = (wgid % nig) / gsz; return true;
    }
    __device__ __forceinline__ void a_ready(const Unit&) const {}
    __device__ __forceinline__ void done(const Unit&) const {}
};

template <class Epi, class Sched, bool SWAP = false, bool STAMP = false>
__device__ __forceinline__ void gemm_phase(PG8_LAS unsigned char* lds, const Gemm g, const Sched& S, const Epi& E, unsigned long long* stamps) {
    int tid_ = threadIdx.x; asm volatile("" : "+v"(tid_));
    const int tid = tid_, wid = __builtin_amdgcn_readfirstlane(tid >> 6), lane = tid & 63, wr = wid >> 2, wc = wid & 3, fr = lane & 15, fq = lane >> 4;
    const int K = g.K, nt = K / BK;
    int ts_lo = 0, ts_hi = 0, nts = 0; const unsigned long long rt_entry = STAMP ? (unsigned long long)wall_clock64() : 0ull;
#define PG8_STAMP() do { if (STAMP && wid == 0 && nts < 64) { const unsigned long long _c = (unsigned long long)clock64(); \
        ts_lo = (lane == nts) ? (int)(unsigned)_c : ts_lo; ts_hi = (lane == nts) ? (int)(unsigned)(_c >> 32) : ts_hi; ++nts; } } while (0)
    PG8_STAMP();
    unsigned voffA[2], voffB[2];
#pragma unroll
    for (int i = 0; i < 2; ++i) { int R, C; stage_rc(tid * 16 + i * 8192, R, C); const int Rb = Epi::PERM ? ((R & ~31) + perm32(R & 31)) : R;
        voffA[i] = (unsigned)(R * K + C) * 2u; voffB[i] = (unsigned)(Rb * K + C) * 2u; }
    const size_t kstep = (size_t)(BK * 2);
    const size_t hstep = (size_t)HALF * K * 2;
    const size_t tstep = 2 * hstep;
    const unsigned ldsw = (unsigned)wid * 1024u;
    const int aoff = lds_byte(wr * 64 + fr, fq * 8), boff = lds_byte(wc * 32 + fr, fq * 8);
#define PG8_SA(b, h) (((b) * 2 + (h)) * HTB)
#define PG8_SB(b, h) ((4 + (b) * 2 + (h)) * HTB)
#define PG8_STAGE(bufoff, gbase, voff) do { _Pragma("unroll") for (int _i = 0; _i < 2; ++_i) \
        __builtin_amdgcn_global_load_lds((const unsigned*)((const char*)(gbase) + (voff)[_i]), (PG8_LAS unsigned*)(lds + (bufoff) + ldsw + _i * 8192), 16, 0, 0); } while (0)
#define PG8_LDA(dst, b, h) do { _Pragma("unroll") for (int m = 0; m < 4; ++m) _Pragma("unroll") for (int k = 0; k < 2; ++k) dst[m][k] = *(const PG8_LAS bf16x8*)(lds + PG8_SA(b, h) + aoff + m * 2048 + k * 1024); } while (0)
#define PG8_LDB(dst, b, h) do { _Pragma("unroll") for (int n = 0; n < 2; ++n) _Pragma("unroll") for (int k = 0; k < 2; ++k) dst[n][k] = *(const PG8_LAS bf16x8*)(lds + PG8_SB(b, h) + boff + n * 2048 + k * 1024); } while (0)
#define PG8_MMA(ai, bj, At, Bt) do { __builtin_amdgcn_s_setprio(1); _Pragma("unroll") for (int m = 0; m < 4; ++m) _Pragma("unroll") for (int n = 0; n < 2; ++n) _Pragma("unroll") for (int k = 0; k < 2; ++k) \
        acc[ai][bj][m][n] = SWAP ? __builtin_amdgcn_mfma_f32_16x16x32_bf16(At[m][k], Bt[n][k], acc[ai][bj][m][n], 0, 0, 0) : __builtin_amdgcn_mfma_f32_16x16x32_bf16(Bt[n][k], At[m][k], acc[ai][bj][m][n], 0, 0, 0); __builtin_amdgcn_s_setprio(0); } while (0)
#define PG8_WAIT_V(n) asm volatile("s_waitcnt vmcnt(" #n ")" ::: "memory")
#define PG8_WAIT_L(n) asm volatile("s_waitcnt lgkmcnt(" #n ")" ::: "memory")
#define PG8_BAR __builtin_amdgcn_s_barrier()
#define PG8_SCHED __builtin_amdgcn_sched_barrier(0)
    Unit cur, nxt; int ui = 0;
    if (!S.next(0, cur)) return;
    f32x4 acc[2][2][4][2];
#pragma unroll
    for (int a = 0; a < 2; ++a)
#pragma unroll
        for (int b = 0; b < 2; ++b)
#pragma unroll
            for (int m = 0; m < 4; ++m)
#pragma unroll
                for (int n = 0; n < 2; ++n) acc[a][b][m][n] = (f32x4){0.f, 0.f, 0.f, 0.f};
    bf16x8 At[4][2], B0[2][2], B1[2][2];
    const char* cA = (const char*)g.A + (size_t)cur.pm * tstep; const char* cB = (const char*)g.Bt + (size_t)cur.pn * tstep;
    S.a_ready(cur);
    PG8_STAGE(PG8_SB(0, 0), cB, voffB); PG8_STAGE(PG8_SA(0, 0), cA, voffA); PG8_STAGE(PG8_SB(0, 1), cB + hstep, voffB); PG8_STAGE(PG8_SA(0, 1), cA + hstep, voffA);
    if (wr == 1) PG8_BAR;
    PG8_WAIT_V(4); PG8_BAR;
    PG8_STAGE(PG8_SB(1, 0), cB + kstep, voffB); PG8_STAGE(PG8_SA(1, 0), cA + kstep, voffA); PG8_STAGE(PG8_SB(1, 1), cB + hstep + kstep, voffB);
    PG8_WAIT_V(6); PG8_BAR;
    PG8_STAMP();
    for (;;) {
        const bool has_next = S.next(ui + 1, nxt);
        const char* nA = has_next ? (const char*)g.A + (size_t)nxt.pm * tstep : cA; const char* nB = has_next ? (const char*)g.Bt + (size_t)nxt.pn * tstep : cB;
        for (int t = 0; t < nt; t += 2) {
            const bool last = (t == nt - 2);
            const char* a1 = cA + (size_t)(t + 1) * kstep;
            const char* a2 = last ? nA : cA + (size_t)(t + 2) * kstep; const char* b2 = last ? nB : cB + (size_t)(t + 2) * kstep;
            const char* a3 = a2 + kstep; const char* b3 = b2 + kstep;
            if (last && has_next) S.a_ready(nxt);
            PG8_LDB(B0, 0, 0); PG8_SCHED; PG8_LDA(At, 0, 0); PG8_STAGE(PG8_SA(1, 1), a1 + hstep, voffA);
            PG8_WAIT_L(8); PG8_BAR; PG8_WAIT_L(0); PG8_MMA(0, 0, At, B0); PG8_BAR; PG8_SCHED;
            PG8_LDB(B1, 0, 1); PG8_STAGE(PG8_SB(0, 0), b2, voffB);
            PG8_BAR; PG8_WAIT_L(0); PG8_MMA(0, 1, At, B1); PG8_BAR;
            PG8_LDA(At, 0, 1); PG8_STAGE(PG8_SA(0, 0), a2, voffA);
            PG8_BAR; PG8_WAIT_L(0); PG8_MMA(1, 0, At, B0); PG8_BAR; PG8_SCHED;
            PG8_STAGE(PG8_SB(0, 1), b2 + hstep, voffB);
            PG8_WAIT_V(6); PG8_BAR; PG8_MMA(1, 1, At, B1); PG8_BAR;
            PG8_LDB(B0, 1, 0); PG8_SCHED; PG8_LDA(At, 1, 0); PG8_STAGE(PG8_SA(0, 1), a2 + hstep, voffA);
            PG8_WAIT_L(8); PG8_BAR; PG8_WAIT_L(0); PG8_MMA(0, 0, At, B0); PG8_BAR; PG8_SCHED;
            PG8_LDB(B1, 1, 1); PG8_STAGE(PG8_SB(1, 0), b3, voffB);
            PG8_BAR; PG8_WAIT_L(0); PG8_MMA(0, 1, At, B1); PG8_BAR;
            PG8_LDA(At, 1, 1); PG8_STAGE(PG8_SA(1, 0), a3, voffA);
            PG8_BAR; PG8_WAIT_L(0); PG8_MMA(1, 0, At, B0); PG8_BAR; PG8_SCHED;
            PG8_STAGE(PG8_SB(1, 1), b3 + hstep, voffB);
            PG8_WAIT_V(6); PG8_BAR; PG8_MMA(1, 1, At, B1); PG8_BAR;
        }
        PG8_STAMP();
        if constexpr (!Epi::AFTER_DRAIN) { E(acc, cur, wr, wc, fr, fq); S.done(cur); }
        PG8_STAMP();
        if (!has_next) break;
#pragma unroll
        for (int a = 0; a < 2; ++a)
#pragma unroll
            for (int b = 0; b < 2; ++b)
#pragma unroll
                for (int m = 0; m < 4; ++m)
#pragma unroll
                    for (int n = 0; n < 2; ++n) acc[a][b][m][n] = (f32x4){0.f, 0.f, 0.f, 0.f};
        cur = nxt; cA = nA; cB = nB; ++ui;
    }
    PG8_WAIT_V(0);
    if (wr == 0) PG8_BAR;
    PG8_BAR;
    if constexpr (Epi::AFTER_DRAIN) { E.fused(acc, cur, wr, wc, fr, fq, lds, wid, lane); S.done(cur); }
    PG8_STAMP();
    if (STAMP && wid == 0) { stamps[lane] = lane < nts ? (((unsigned long long)(unsigned)ts_hi << 32) | (unsigned)ts_lo) : 0ull;
        if (lane == 62) stamps[62] = rt_entry; if (lane == 63) stamps[63] = (unsigned long long)wall_clock64(); }
#undef PG8_STAMP
#undef PG8_SA
#undef PG8_SB
#undef PG8_STAGE
#undef PG8_LDA
#undef PG8_LDB
#undef PG8_MMA
#undef PG8_WAIT_V
#undef PG8_WAIT_L
#undef PG8_BAR
#undef PG8_SCHED
}
}

struct EpiQK {
    static constexpr bool PERM = true, AFTER_DRAIN = false;
    u16* O; int ldc;
    __device__ __forceinline__ void operator()(const pg8::f32x4 (&acc)[2][2][4][2], const pg8::Unit& u, int wr, int wc, int fr, int fq) const {
        const int colt = u.pn * 256, g = colt >> 11, col0 = g * 3072 + (colt & 2047) + wc * 32 + 8 * fq, row0 = u.pm * 256 + wr * 64 + fr;
#pragma unroll
        for (int ai = 0; ai < 2; ++ai)
#pragma unroll
            for (int m = 0; m < 4; ++m) { u16* rowp = O + (size_t)(row0 + ai * 128 + m * 16) * ldc + col0;
#pragma unroll
                for (int bj = 0; bj < 2; ++bj) { const pg8::f32x4 v0 = acc[ai][bj][m][0], v1 = acc[ai][bj][m][1];
                    u32x4 w; w[0] = cvtpk(v0[0], v0[1]); w[1] = cvtpk(v0[2], v0[3]); w[2] = cvtpk(v1[0], v1[1]); w[3] = cvtpk(v1[2], v1[3]);
                    *(u32x4*)(rowp + bj * 128) = w; } }
    }
};
struct EpiV {
    static constexpr bool PERM = false, AFTER_DRAIN = false;
    u16* VT; int layer;
    __device__ __forceinline__ void operator()(const pg8::f32x4 (&acc)[2][2][4][2], const pg8::Unit& u, int wr, int wc, int fr, int fq) const {
        const int colt = u.pn * 256, grp = colt >> 10;
        const int dil = (layer == 0 || grp == 0) ? 1 : (grp == 1 ? 4 : 16);
        const int rowb = u.pm * 256 + wr * 64 + 4 * fq;
#pragma unroll
        for (int bj = 0; bj < 2; ++bj)
#pragma unroll
            for (int n = 0; n < 2; ++n) {
                const int c = (colt & 1023) + bj * 128 + wc * 32 + n * 16 + fr, h = c >> 6, d = c & 63;
#pragma unroll
                for (int ai = 0; ai < 2; ++ai)
#pragma unroll
                    for (int m = 0; m < 4; ++m) {
                        const int r0 = rowb + ai * 128 + m * 16, b = r0 >> 13, t0 = r0 & (SEQ - 1);
                        u16* vrow = VT + (size_t)grp * T * D + ((size_t)(b * NH + h) * HD + d) * SEQ;
                        const pg8::f32x4 v = acc[ai][bj][m][n];
                        if (dil == 1) { u32x2 w; w[0] = cvtpk(v[0], v[1]); w[1] = cvtpk(v[2], v[3]); *(u32x2*)(vrow + t0) = w; }
                        else {
#pragma unroll
                            for (int i = 0; i < 4; ++i) { const int pp = t0 + i; vrow[(pp % dil) * (SEQ / dil) + pp / dil] = (u16)cvtpk(v[i], 0.f); }
                        }
                    }
            }
    }
};
struct EpiWo {
    static constexpr bool PERM = false, AFTER_DRAIN = false;
    float* Y; const float* X;
    __device__ __forceinline__ void operator()(const pg8::f32x4 (&acc)[2][2][4][2], const pg8::Unit& u, int wr, int wc, int fr, int fq) const {
        const int row0 = u.pm * 256 + wr * 64 + fr, col0 = u.pn * 256 + wc * 32 + 4 * fq;
#pragma unroll
        for (int ai = 0; ai < 2; ++ai)
#pragma unroll
            for (int m = 0; m < 4; ++m) { const size_t ro = (size_t)(row0 + ai * 128 + m * 16) * D + col0;
#pragma unroll
                for (int bj = 0; bj < 2; ++bj)
#pragma unroll
                    for (int n = 0; n < 2; ++n) { const pg8::f32x4 x = *(const pg8::f32x4*)(X + ro + bj * 128 + n * 16); *(pg8::f32x4*)(Y + ro + bj * 128 + n * 16) = x * DN_ALPHA + acc[ai][bj][m][n]; } }
    }
};
struct EpiSGU {
    static constexpr bool PERM = true, AFTER_DRAIN = false;
    u16* H;
    __device__ __forceinline__ void operator()(const pg8::f32x4 (&acc)[2][2][4][2], const pg8::Unit& u, int wr, int wc, int fr, int fq) const {
        const int row0 = u.pm * 256 + wr * 64 + fr, f0 = u.pn * 128 + wc * 32 + 8 * fq;
#pragma unroll
        for (int ai = 0; ai < 2; ++ai)
#pragma unroll
            for (int m = 0; m < 4; ++m) {
                float hv[8];
#pragma unroll
                for (int n = 0; n < 2; ++n)
#pragma unroll
                    for (int i = 0; i < 4; ++i) { const float gt = acc[ai][0][m][n][i], up = acc[ai][1][m][n][i]; hv[n * 4 + i] = gt / (1.f + __expf(-gt)) * up; }
                u32x4 w; w[0] = cvtpk(hv[0], hv[1]); w[1] = cvtpk(hv[2], hv[3]); w[2] = cvtpk(hv[4], hv[5]); w[3] = cvtpk(hv[6], hv[7]);
                *(u32x4*)(H + (size_t)(A_TOT + row0 + ai * 128 + m * 16) * DF + f0) = w;
            }
    }
};
struct EpiSD {
    static constexpr bool PERM = true, AFTER_DRAIN = false;
    u16* Y;
    __device__ __forceinline__ void operator()(const pg8::f32x4 (&acc)[2][2][4][2], const pg8::Unit& u, int wr, int wc, int fr, int fq) const {
        const int row0 = u.pm * 256 + wr * 64 + fr, col0 = u.pn * 256 + wc * 32 + 8 * fq;
#pragma unroll
        for (int ai = 0; ai < 2; ++ai)
#pragma unroll
            for (int m = 0; m < 4; ++m) { u16* rowp = Y + (size_t)(A_TOT + row0 + ai * 128 + m * 16) * D + col0;
#pragma unroll
                for (int bj = 0; bj < 2; ++bj) { const pg8::f32x4 v0 = acc[ai][bj][m][0], v1 = acc[ai][bj][m][1];
                    u32x4 w; w[0] = cvtpk(v0[0], v0[1]); w[1] = cvtpk(v0[2], v0[3]); w[2] = cvtpk(v1[0], v1[1]); w[3] = cvtpk(v1[2], v1[3]);
                    *(u32x4*)(rowp + bj * 128) = w; } }
    }
};

struct Args {
    const float* in[16];
    float* out;
    unsigned char* ws;
    int ph_lo, ph_hi;
};

#define GEMM_CORE(K_, PA0, PA1, PB, LDB)                                                                                                   \
    {                                                                                                                                      \
        const int g_tid = tid, g_lane = lane, g_wave = wave, g_r32 = r32, g_hi = hi;                   \
        const int g_wm = g_wave >> 2, g_wn = g_wave & 3, g_kc = g_tid & 3, g_kq = g_lane >> 3, g_n4 = g_lane & 7;                           \
        const u16* g_pa0 = (PA0); const u16* g_pa1 = (PA1);                                                                                \
        const size_t g_ldb = (size_t)(LDB);                                                                                                \
        const float* g_pb = (PB) + (size_t)(g_kq * 4) * g_ldb + g_n4 * 4;                                                                  \
        const int g_nk = (K_) / 32;                                                                                                        \
        u32x4 g_ra0, g_ra1; f32x4 g_rb0, g_rb1, g_rb2, g_rb3;                                                                              \
        const u32x4 g_z = {0u, 0u, 0u, 0u};                                                                                                \
        _Pragma("unroll") for (int mb = 0; mb < 4; ++mb) { _Pragma("unroll") for (int nb = 0; nb < 2; ++nb) { _Pragma("unroll") for (int r = 0; r < 16; ++r) acc[mb][nb][r] = 0.f; } } \
        g_ra0 = g_pa0 ? *(const u32x4*)(g_pa0 + g_kc * 8) : g_z; g_ra1 = g_pa1 ? *(const u32x4*)(g_pa1 + g_kc * 8) : g_z;                 \
        g_rb0 = *(const f32x4*)(g_pb); g_rb1 = *(const f32x4*)(g_pb + g_ldb); g_rb2 = *(const f32x4*)(g_pb + 2 * g_ldb); g_rb3 = *(const f32x4*)(g_pb + 3 * g_ldb); \
        _Pragma("unroll 1") for (int kt = 0; kt < g_nk; ++kt) {                                                                            \
            LAS char* As = lds + (kt & 1) * STAGE_BYTES; LAS char* Bs = As + 256 * LDP * 2;                                                \
            *(LAS u32x4*)(As + ((g_tid >> 2) * LDP + g_kc * 8) * 2) = g_ra0;                                                               \
            *(LAS u32x4*)(As + (((g_tid >> 2) + 128) * LDP + g_kc * 8) * 2) = g_ra1;                                                       \
            _Pragma("unroll") for (int i = 0; i < 4; ++i) {                                                                                \
                u32x2 w; w[0] = cvtpk(g_rb0[i], g_rb1[i]); w[1] = cvtpk(g_rb2[i], g_rb3[i]);                                               \
                *(LAS u32x2*)(Bs + ((g_wave * 32 + i * 8 + g_n4) * LDP + g_kq * 4) * 2) = w;                                               \
            }                                                                                                                              \
            __syncthreads();                                                                                                               \
            if (kt + 1 < g_nk) {                                                                                                           \
                const int ko = (kt + 1) * 32;                                                                                              \
                g_ra0 = g_pa0 ? *(const u32x4*)(g_pa0 + ko + g_kc * 8) : g_z; g_ra1 = g_pa1 ? *(const u32x4*)(g_pa1 + ko + g_kc * 8) : g_z; \
                const float* pbk = g_pb + (size_t)ko * g_ldb;                                                                              \
                g_rb0 = *(const f32x4*)(pbk); g_rb1 = *(const f32x4*)(pbk + g_ldb); g_rb2 = *(const f32x4*)(pbk + 2 * g_ldb); g_rb3 = *(const f32x4*)(pbk + 3 * g_ldb); \
            }                                                                                                                              \
            _Pragma("unroll") for (int s = 0; s < 2; ++s) {                                                                                \
                bf16x8 af[4], bfr[2];                                                                                                      \
                _Pragma("unroll") for (int mb = 0; mb < 4; ++mb) af[mb] = *(LAS bf16x8*)(As + ((g_wm * 128 + mb * 32 + g_r32) * LDP + s * 16 + g_hi * 8) * 2); \
                _Pragma("unroll") for (int nb = 0; nb < 2; ++nb) bfr[nb] = *(LAS bf16x8*)(Bs + (((g_wn * 2 + nb) * 32 + g_r32) * LDP + s * 16 + g_hi * 8) * 2); \
                _Pragma("unroll") for (int mb = 0; mb < 4; ++mb) { _Pragma("unroll") for (int nb = 0; nb < 2; ++nb) acc[mb][nb] = MFMA_BF16(af[mb], bfr[nb], acc[mb][nb]); } \
            }                                                                                                                              \
        }                                                                                                                                  \
        __syncthreads();                                                                                                                   \
    }

struct AttnSt { float m, l; f32x16 o0, o1; };

struct AttnFr { bf16x8 k[4]; bf16x8 v[4]; };
__device__ __forceinline__ void attn_load(AttnFr& f, const u16* krow, const u16* vt, size_t vt_dstride) {
#pragma unroll
    for (int d0 = 0; d0 < 4; ++d0) f.k[d0] = *(const bf16x8*)(krow + d0 * 16);
    const u16* vt1 = vt + 32 * vt_dstride;
    union { bf16x8 v; u32x2 h[2]; } va;
    va.h[0] = *(const u32x2*)(vt);       va.h[1] = *(const u32x2*)(vt + 8);   f.v[0] = va.v;
    va.h[0] = *(const u32x2*)(vt + 16);  va.h[1] = *(const u32x2*)(vt + 24);  f.v[1] = va.v;
    va.h[0] = *(const u32x2*)(vt1);      va.h[1] = *(const u32x2*)(vt1 + 8);  f.v[2] = va.v;
    va.h[0] = *(const u32x2*)(vt1 + 16); va.h[1] = *(const u32x2*)(vt1 + 24); f.v[3] = va.v;
}
__device__ __forceinline__ void attn_compute(AttnSt& st, const bf16x8 (&qf)[4], const AttnFr& f, int dist0, float bslope, int dlo, int dhi, int hi) {
    f32x16 p;
#pragma unroll
    for (int r = 0; r < 16; ++r) p[r] = 0.f;
#pragma unroll
    for (int d0 = 0; d0 < 4; ++d0) p = MFMA_BF16(f.k[d0], qf[d0], p);
    constexpr float C2 = 0.125f * LOG2E;
    float mx = NEGV;
#pragma unroll
    for (int r = 0; r < 16; ++r) {
        const int dist = dist0 - ((r & 3) + 8 * (r >> 2));
        const float sc = __builtin_fmaf(p[r], C2, -bslope * (float)dist);
        const float s_ = (dist >= dlo && dist <= dhi) ? sc : NEGV;
        p[r] = s_; mx = fmaxf(mx, s_);
    }
    mx = fmaxf(mx, __shfl_xor(mx, 32));
    const float mnew = fmaxf(st.m, mx);
    const float alpha = __builtin_amdgcn_exp2f(st.m - mnew);
    st.m = mnew;
    float ls = 0.f;
#pragma unroll
    for (int r = 0; r < 16; ++r) { p[r] = __builtin_amdgcn_exp2f(p[r] - mnew); ls += p[r]; }
    st.l = st.l * alpha + ls;
#pragma unroll
    for (int r = 0; r < 16; ++r) { st.o0[r] *= alpha; st.o1[r] *= alpha; }
    union { bf16x8 v; unsigned u[4]; } pb0, pb1;
#pragma unroll
    for (int j = 0; j < 4; ++j) { pb0.u[j] = cvtpk(p[2 * j], p[2 * j + 1]); pb1.u[j] = cvtpk(p[8 + 2 * j], p[8 + 2 * j + 1]); }
    st.o0 = MFMA_BF16(f.v[0], pb0.v, st.o0);
    st.o0 = MFMA_BF16(f.v[1], pb1.v, st.o0);
    st.o1 = MFMA_BF16(f.v[2], pb0.v, st.o1);
    st.o1 = MFMA_BF16(f.v[3], pb1.v, st.o1);
    (void)hi;
}

__device__ __forceinline__ void top3_insert(float v, int i, float& v0, int& i0, float& v1, int& i1, float& v2, int& i2) {
    const bool b0 = (v > v0) || (v == v0 && i < i0);
    const bool b1 = (v > v1) || (v == v1 && i < i1);
    const bool b2 = (v > v2) || (v == v2 && i < i2);
    const float nv2 = b1 ? v1 : (b2 ? v : v2); const int ni2 = b1 ? i1 : (b2 ? i : i2);
    const float nv1 = b0 ? v0 : (b1 ? v : v1); const int ni1 = b0 ? i0 : (b1 ? i : i1);
    const float nv0 = b0 ? v : v0;             const int ni0 = b0 ? i : i0;
    v0 = nv0; i0 = ni0; v1 = nv1; i1 = ni1; v2 = nv2; i2 = ni2;
}

__device__ __forceinline__ void ln_row(float (&v)[16], const float* __restrict__ g, const float* __restrict__ b, int lane) {
    float s = 0.f;
#pragma unroll
    for (int i = 0; i < 16; ++i) s += v[i];
    const float mu = wave_sum(s) * (1.f / D);
    float q = 0.f;
#pragma unroll
    for (int i = 0; i < 16; ++i) { const float d = v[i] - mu; q += d * d; }
    const float rstd = rsqrtf(wave_sum(q) * (1.f / D) + LN_EPS);
#pragma unroll
    for (int j = 0; j < 4; ++j) {
        const f32x4 gg = *(const f32x4*)(g + j * 256 + lane * 4), bb = *(const f32x4*)(b + j * 256 + lane * 4);
#pragma unroll
        for (int c = 0; c < 4; ++c) v[j * 4 + c] = (v[j * 4 + c] - mu) * rstd * gg[c] + bb[c];
    }
}

constexpr int MOE_BP = 72;
constexpr int MOE_BSTAGE = 128 * MOE_BP * 2;
constexpr int MOE_LDS_VA = 3 * MOE_BSTAGE;
constexpr int MOE_LDS_W = MOE_LDS_VA + 4096;
template <bool DOWN>
__device__ __forceinline__ void moe_expert(LAS char* lds, const int tid, const int lane, const int wave, const int r32, const int hi,
                                           const u16* __restrict__ abase, const float* __restrict__ w0, const float* __restrict__ w1, const int ng  , u16* __restrict__ outp) {
    constexpr int KT = DOWN ? 4 : 16, NP = DOWN ? 8 : 4, LDB = DOWN ? 1024 : 256, APITCH = DOWN ? 256 : 1024, PSTEP = DOWN ? 128 : 64;
    LAS int* rowva = (LAS int*)(lds + MOE_LDS_VA); LAS float* roww = (LAS float*)(lds + MOE_LDS_W);
    const int nst = (ng + 511) >> 9;
    const int nsteps = NP * nst * KT;
    unsigned aoff[2];
#define MOE_AOFF(ST_) { _Pragma("unroll") for (int a = 0; a < 2; ++a) { const int va_ = rowva[(ST_) * 512 + wave * 64 + a * 32 + r32]; \
        const int srow_ = DOWN ? va_ : (va_ == TRASH_VA ? 0 : (va_ >> 3)); aoff[a] = (unsigned)srow_ * (APITCH * 2) + hi * 64; } }
    const int seg = wave >> 1, n4 = lane & 7, kp = (wave & 1) * 16 + (lane >> 3);
    const char* wbase = (const char*)(DOWN ? (w0 + seg * 32) : (((seg < 2) ? w0 : w1) + (seg & 1) * 32));
    const unsigned boff = (unsigned)(4 * n4 + 2 * kp * LDB) * 4u;
    f32x16 acc[2][4];
#pragma unroll
    for (int a = 0; a < 2; ++a)
#pragma unroll
        for (int c = 0; c < 4; ++c)
#pragma unroll
            for (int r = 0; r < 16; ++r) acc[a][c][r] = 0.f;
    bf16x8 fa[2][4];
    f32x4 rb0[4], rb1[4];
#define MOE_DEC(S_) const int s2_ = (S_) < nsteps ? (S_) : 0; const int ps_ = s2_ / (nst * KT); const int rm_ = s2_ - ps_ * (nst * KT); const int stt_ = rm_ / KT; const int kt_ = rm_ - stt_ * KT;
#define MOE_LOADB(S_, RB) { MOE_DEC(S_) (void)stt_; \
        const char* wp_ = wbase + (size_t)(ps_ * PSTEP + kt_ * 64 * LDB) * 4 + boff; \
        RB[0] = *(const f32x4*)(wp_); RB[1] = *(const f32x4*)(wp_ + LDB * 4); RB[2] = *(const f32x4*)(wp_ + 16 * LDB * 4); RB[3] = *(const f32x4*)(wp_ + 17 * LDB * 4); }
#define MOE_WRITEB(STG, RB) { LAS char* Bs_ = lds + (STG) * MOE_BSTAGE; \
        _Pragma("unroll") for (int i = 0; i < 4; ++i) { LAS unsigned* q_ = (LAS unsigned*)(Bs_ + ((seg * 32 + i * 8 + n4) * MOE_BP + 2 * kp) * 2); q_[0] = cvtpk(RB[0][i], RB[1][i]); q_[8] = cvtpk(RB[2][i], RB[3][i]); } }
#define MOE_COMPUTE(STG, DO_MFMA) { LAS char* Bs_ = lds + (STG) * MOE_BSTAGE; \
        _Pragma("unroll") for (int u = 0; u < 4; ++u) { \
            bf16x8 bfr[4]; \
            if (DO_MFMA) { _Pragma("unroll") for (int c = 0; c < 4; ++c) bfr[c] = *(LAS bf16x8*)(Bs_ + ((c * 32 + r32) * MOE_BP + hi * 32 + u * 8) * 2); } \
            _Pragma("unroll") for (int a = 0; a < 2; ++a) { \
                if (DO_MFMA) { _Pragma("unroll") for (int c = 0; c < 4; ++c) acc[a][c] = MFMA_BF16(bfr[c], fa[a][u], acc[a][c]); } \
                fa[a][u] = *(const bf16x8*)(ab_n + aoff[a] + u * 16); \
            } \
        } }
#define MOE_NEXTA(S_) MOE_DEC(S_) (void)ps_; \
        if (stt_ != st_loaded) { MOE_AOFF(stt_) st_loaded = stt_; } \
        const char* ab_n = (const char*)abase + kt_ * 128;
    int st_loaded = 0;
    MOE_AOFF(0)
    { const char* ab0 = (const char*)abase;
#pragma unroll
      for (int a = 0; a < 2; ++a)
#pragma unroll
          for (int u = 0; u < 4; ++u) fa[a][u] = *(const bf16x8*)(ab0 + aoff[a] + u * 16); }
    MOE_LOADB(0, rb0)
    MOE_LOADB(1, rb1)
    MOE_WRITEB(0, rb0)
    MOE_LOADB(2, rb0)
    int stg = 0;
#pragma unroll 1
    for (int sidx = 0; sidx < nsteps; sidx += 2) {
        const int ps = sidx / (nst * KT); const int rm = sidx - ps * (nst * KT); const int stt = rm / KT; const int kt = rm - stt * KT;
        const bool wv = (wave * 64) < (ng - stt * 512);
        const int stg1 = stg == 2 ? 0 : stg + 1, stg2 = stg1 == 2 ? 0 : stg1 + 1;
        __syncthreads();
        MOE_WRITEB(stg1, rb1)
        MOE_LOADB(sidx + 3, rb1)
        { MOE_NEXTA(sidx + 1)
          if (wv) MOE_COMPUTE(stg, true) else MOE_COMPUTE(stg, false) }
        __syncthreads();
        MOE_WRITEB(stg2, rb0)
        MOE_LOADB(sidx + 4, rb0)
        { MOE_NEXTA(sidx + 2)
          if (wv) MOE_COMPUTE(stg1, true) else MOE_COMPUTE(stg1, false) }
        stg = stg2;
        if (kt == KT - 2) {
            if (wv) {
                const int nrows = ng - stt * 512;
#pragma unroll
                for (int a = 0; a < 2; ++a) {
                    if (a == 0 || (wave * 64 + 32) < nrows) {
                        const int lrow = stt * 512 + wave * 64 + a * 32 + r32;
                        const unsigned va = (unsigned)rowva[lrow];
                        if (DOWN) {
                            const float w = roww[lrow];
#pragma unroll
                            for (int c = 0; c < 4; ++c) {
                                u32x4 q0, q1;
#pragma unroll
                                for (int jj = 0; jj < 4; ++jj) {
                                    const int j0 = 2 * jj, j1 = 2 * jj + 1, j2 = 8 + 2 * jj, j3 = 9 + 2 * jj;
                                    q0[jj] = cvtpk(acc[a][c][(j0 >> 2) + 4 * (j0 & 3)] * w, acc[a][c][(j1 >> 2) + 4 * (j1 & 3)] * w);
                                    q1[jj] = cvtpk(acc[a][c][(j2 >> 2) + 4 * (j2 & 3)] * w, acc[a][c][(j3 >> 2) + 4 * (j3 & 3)] * w);
                                }
                                u16* o = outp + (size_t)va * D + ps * 128 + c * 32 + 16 * hi;
                                *(u32x4*)o = q0; *(u32x4*)(o + 8) = q1;
                            }
                        } else {
#pragma unroll
                            for (int c = 0; c < 2; ++c) {
                                float hv[16];
#pragma unroll
                                for (int j = 0; j < 16; ++j) { const int r = (j >> 2) + 4 * (j & 3); const float gt = acc[a][c][r], up = acc[a][c + 2][r]; hv[j] = gt / (1.f + __expf(-gt)) * up; }
                                u32x4 q0, q1;
#pragma unroll
                                for (int jj = 0; jj < 4; ++jj) { q0[jj] = cvtpk(hv[2 * jj], hv[2 * jj + 1]); q1[jj] = cvtpk(hv[8 + 2 * jj], hv[9 + 2 * jj]); }
                                u16* o = outp + (size_t)va * DF + ps * 64 + c * 32 + 16 * hi;
                                *(u32x4*)o = q0; *(u32x4*)(o + 8) = q1;
                            }
                        }
                    }
                }
#pragma unroll
                for (int a = 0; a < 2; ++a)
#pragma unroll
                    for (int c = 0; c < 4; ++c)
#pragma unroll
                        for (int r = 0; r < 16; ++r) acc[a][c][r] = 0.f;
            }
        }
    }
    __syncthreads();
#undef MOE_AOFF
#undef MOE_DEC
#undef MOE_LOADB
#undef MOE_WRITEB
#undef MOE_COMPUTE
#undef MOE_NEXTA
}

constexpr int N_PHASES = 21;

#define P_x_in CTX_IN(0)
#define P_xb ((u16*)(ws + WS_XB))
#define P_x1 ((float*)(ws + WS_X1))
#define P_x2 ((float*)(ws + WS_X2))
#define P_ypre ((float*)(ws + WS_YPRE))
#define P_qkv ((u16*)(ws + WS_QKV))
#define P_vT ((u16*)(ws + WS_VT))
#define P_kmean ((float*)(ws + WS_KM))
#define P_ao ((u16*)(ws + WS_AO))
#define P_og ((u16*)(ws + WS_OG))
#define P_lse ((float*)(ws + WS_LSE))
#define P_topw ((float*)(ws + WS_TOPW))
#define P_list ((int*)(ws + WS_LIST))
#define P_hb ((u16*)(ws + WS_HB))
#define P_yb ((u16*)(ws + WS_YB))
#define P_cnt_all ((int*)(ws + WS_CTL + CTL_CNT_OFF))
#define P_selm ((unsigned*)(ws + WS_SELM))
#define P_part ((u16*)(ws + WS_PART))
#define P_plse ((float*)(ws + WS_PLSE))
#define PH_BEGIN int tid = threadIdx.x; asm volatile("" : "+v"(tid)); const int lane = tid & 63, r32 = lane & 31, hi = lane >> 5; const int wave = __builtin_amdgcn_readfirstlane(tid >> 6); (void)lane; (void)r32; (void)hi; (void)wave
constexpr int LDS_CTX = LDS_BAR + 16;
__device__ __forceinline__ uint64_t ctx_ld(int i) {
    extern __shared__ __attribute__((aligned(16))) unsigned char lds_raw[];
    const LAS unsigned* q = (const LAS unsigned*)((LAS char*)lds_raw + LDS_CTX) + 2 * i;
    const unsigned lo = __builtin_amdgcn_readfirstlane(q[0]), hi = __builtin_amdgcn_readfirstlane(q[1]);
    return ((uint64_t)hi << 32) | lo;
}
typedef __attribute__((address_space(1))) unsigned char gbyte;
#define AS_GLOBAL(T, u64v) ((T*)(gbyte*)(u64v))
#define CTX_IN(i) AS_GLOBAL(const float, ctx_ld(i))
#define PH_FN_BEGIN \
    extern __shared__ __attribute__((aligned(16))) unsigned char lds_raw[]; \
    LAS char* lds = (LAS char*)lds_raw; (void)lds; \
    const int G = gridDim.x, bid = blockIdx.x; (void)G; (void)bid; \
    unsigned char* const ws = AS_GLOBAL(unsigned char, ctx_ld(17)); (void)ws; \
    const int NQ = L == 0 ? 3072 : 9216; (void)NQ; \
    int* cnt = P_cnt_all + L * NE; (void)cnt;
__device__ __forceinline__ void ph_p0(int L, int rep_) {
    PH_FN_BEGIN
    (void)rep_;
    PH_BEGIN;
    for (size_t i = (size_t)bid * NTHR + tid; i < (size_t)T * D / 4; i += (size_t)G * NTHR) {
        const f32x4 v = *(const f32x4*)(P_x_in + i * 4);
        u32x2 w; w[0] = cvtpk(v[0], v[1]); w[1] = cvtpk(v[2], v[3]);
        *(u32x2*)(P_xb + i * 4) = w;
    }
    LAS float* tl = (LAS float*)lds;
    for (int it = bid; it < 3968; it += G) {
        int seg, kt;
        if (it < 3840) { seg = it >> 4; kt = it & 15; } else { seg = 240 + ((it - 3840) >> 2); kt = (it - 3840) & 3; }
        const float* src; int ld; u16* dst; int Kd = 1024;
        if (seg < 48) { const int col = 64 * seg; src = CTX_IN(1) + col; ld = 3072; dst = col < 2048 ? (u16*)(ws + WS_WQK0) + (size_t)col * 1024 : (u16*)(ws + WS_WV0) + (size_t)(col - 2048) * 1024; }
        else if (seg < 192) { const int col = 64 * (seg - 48), g = col / 3072, w = col - g * 3072; src = CTX_IN(2) + col; ld = 9216;
            dst = w < 2048 ? (u16*)(ws + WS_WQK1) + (size_t)(g * 2048 + w) * 1024 : (u16*)(ws + WS_WV1) + (size_t)(g * 1024 + w - 2048) * 1024; }
        else if (seg < 224) { const int s2 = seg - 192, l2 = s2 >> 4, col = 64 * (s2 & 15); src = CTX_IN(3) + (size_t)l2 * D * D + col; ld = 1024; dst = (u16*)(ws + WS_WO) + (size_t)l2 * D * D + (size_t)col * 1024; }
        else if (seg < 240) { const int s2 = seg - 224, l2 = s2 >> 3, i8 = s2 & 7, un = i8 >> 2, q = i8 & 3;
            src = (q < 2 ? CTX_IN(11) : CTX_IN(12)) + (size_t)l2 * D * DF + un * 128 + 64 * (q & 1); ld = 256; dst = (u16*)(ws + WS_WSGU) + (size_t)l2 * 512 * 1024 + (size_t)(64 * i8) * 1024; }
        else { const int s2 = seg - 240, l2 = s2 >> 4, col = 64 * (s2 & 15); src = CTX_IN(13) + (size_t)l2 * DF * D + col; ld = 1024; Kd = 256; dst = (u16*)(ws + WS_WSD) + (size_t)l2 * D * DF + (size_t)col * 256; }
        {
            const int kr = tid >> 4, c4 = tid & 15;
#pragma unroll
            for (int i = 0; i < 2; ++i) {
                const f32x4 v = *(const f32x4*)(src + (size_t)(kt * 64 + kr + 32 * i) * ld + 4 * c4);
#pragma unroll
                for (int jj = 0; jj < 4; ++jj) tl[(kr + 32 * i) * 65 + 4 * c4 + jj] = v[jj];
            }
        }
        __syncthreads();
        {
            const int row = tid >> 3, kc = tid & 7;
            float f[8];
#pragma unroll
            for (int jj = 0; jj < 8; ++jj) f[jj] = tl[(8 * kc + jj) * 65 + row];
            u32x4 w; w[0] = cvtpk(f[0], f[1]); w[1] = cvtpk(f[2], f[3]); w[2] = cvtpk(f[4], f[5]); w[3] = cvtpk(f[6], f[7]);
            *(u32x4*)(dst + (size_t)row * Kd + kt * 64 + 8 * kc) = w;
        }
        __syncthreads();
    }
}

__device__ __forceinline__ void ph_qkv(int L, int rep_) {
    PH_FN_BEGIN
    (void)rep_;
    {
        const pg8::Gemm g{P_xb, (const u16*)(ws + (L == 0 ? WS_WQK0 : WS_WQK1)), T, L == 0 ? 2048 : 6144, D};
        pg8::StaticOrder S; S.init(g.M, g.N, G, bid);
        const EpiQK E{P_qkv, NQ};
        pg8::gemm_phase<EpiQK, pg8::StaticOrder, false>((PG8_LAS unsigned char*)lds, g, S, E, nullptr);
    }
    {
        const pg8::Gemm g{P_xb, (const u16*)(ws + (L == 0 ? WS_WV0 : WS_WV1)), T, L == 0 ? 1024 : 3072, D};
        pg8::StaticOrder S; S.init(g.M, g.N, G, bid);
        const EpiV E{P_vT, L};
        pg8::gemm_phase<EpiV, pg8::StaticOrder, true>((PG8_LAS unsigned char*)lds, g, S, E, nullptr);
    }
}

__device__ __forceinline__ void ph_kmean(int L, int rep_) {
    PH_FN_BEGIN
    (void)rep_;

            PH_BEGIN;
                LAS float* red = (LAS float*)lds;
                for (int it = bid; it < BATCH * NH * MOBA_NB; it += G) {
                    const int j = it & 31, h = (it >> 5) & 15, b = it >> 9;
                    const int d = tid & 63, part = tid >> 6;
                    const u16* kp = P_qkv + (size_t)(b * SEQ + j * MOBA_BLK + part * 32) * 3072 + 1024 + h * 64 + d;
                    float s = 0.f;
                    for (int k = 0; k < 32; ++k) s += bf2f(kp[(size_t)k * 3072]);
                    red[part * 64 + d] = s;
                    __syncthreads();
                    if (tid < 64) {
                        float tot = 0.f;
#pragma unroll
                        for (int p8 = 0; p8 < 8; ++p8) tot += red[p8 * 64 + tid];
                        P_kmean[(size_t)it * 64 + tid] = tot * (1.f / MOBA_BLK);
                    }
                    __syncthreads();
                }

}

__device__ __forceinline__ void ph_gate(int L, int rep_) {
    PH_FN_BEGIN
    (void)rep_;
    PH_BEGIN;
    for (int it = bid; it < BATCH * NH * MOBA_NB; it += G) {
        const int qb = it & 31, bh = it >> 5, b = bh >> 4, h = bh & 15;
        const int tq = qb * MOBA_BLK + wave * 32 + r32;
        const u16* qrow = P_qkv + (size_t)(b * SEQ + tq) * 3072 + h * 64 + hi * 8;
        bf16x8 qf[4];
#pragma unroll
        for (int d0 = 0; d0 < 4; ++d0) qf[d0] = *(const bf16x8*)(qrow + d0 * 16);
        unsigned selmask = 0u;
        if (qb > 0) {
            const float* km = P_kmean + ((size_t)(b * NH + h) * MOBA_NB + r32) * 64 + hi * 8;
            f32x16 gt;
#pragma unroll
            for (int r = 0; r < 16; ++r) gt[r] = 0.f;
#pragma unroll
            for (int d0 = 0; d0 < 4; ++d0) {
                const f32x4 k0 = *(const f32x4*)(km + d0 * 16), k1 = *(const f32x4*)(km + d0 * 16 + 4);
                union { bf16x8 v; unsigned u[4]; } kf;
                kf.u[0] = cvtpk(k0[0], k0[1]); kf.u[1] = cvtpk(k0[2], k0[3]); kf.u[2] = cvtpk(k1[0], k1[1]); kf.u[3] = cvtpk(k1[2], k1[3]);
                gt = MFMA_BF16(kf.v, qf[d0], gt);
            }
            float v0 = -INFINITY, v1 = -INFINITY, v2 = -INFINITY; int i0 = 99, i1 = 99, i2 = 99;
#pragma unroll
            for (int r = 0; r < 16; ++r) { const int jb = crow(r, hi); const float gv = jb < qb ? gt[r] : -INFINITY; top3_insert(gv, jb < qb ? jb : 99, v0, i0, v1, i1, v2, i2); }
            const float ov0 = __shfl_xor(v0, 32), ov1 = __shfl_xor(v1, 32), ov2 = __shfl_xor(v2, 32);
            const int oi0 = __shfl_xor(i0, 32), oi1 = __shfl_xor(i1, 32), oi2 = __shfl_xor(i2, 32);
            top3_insert(ov0, oi0, v0, i0, v1, i1, v2, i2); top3_insert(ov1, oi1, v0, i0, v1, i1, v2, i2); top3_insert(ov2, oi2, v0, i0, v1, i1, v2, i2);
            if (i0 < 32) selmask |= 1u << i0;
            if (i1 < 32) selmask |= 1u << i1;
            if (i2 < 32) selmask |= 1u << i2;
        }
        if (hi == 0) P_selm[(size_t)bh * SEQ + tq] = selmask;
    }
}

constexpr int MB_KP = 72;
constexpr int MB_VP = 260;
constexpr int MB_LDS_K = 0;
constexpr int MB_LDS_V = 256 * MB_KP * 2;
constexpr int MB_LDS_LIST = MB_LDS_V + 64 * MB_VP * 2;
constexpr int MB_LDS_CTR = MB_LDS_LIST + 8192 * 2;
__device__ __forceinline__ void ph_moba(int L, int rep_) {
    PH_FN_BEGIN
    (void)rep_;
    PH_BEGIN;
    LAS char* Ks = lds + MB_LDS_K; LAS char* Vs = lds + MB_LDS_V;
    LAS u16* qlist = (LAS u16*)(lds + MB_LDS_LIST); LAS int* ctr = (LAS int*)(lds + MB_LDS_CTR);
    for (int it = bid; it < BATCH * NH * MOBA_NB; it += G) {
        const int rnd = it >> 8, w8 = it & 255, a8 = w8 >> 5, bh = w8 & 31;
        const int j = rnd == 0 ? a8 : (rnd == 1 ? 15 - a8 : (rnd == 2 ? 16 + a8 : 31 - a8));
        const int b = bh >> 4, h = bh & 15;
        const float slope2 = exp2f(-0.5f * (float)(h + 1)) * LOG2E;
        if (tid == 0) { int z0 = 0; asm volatile("" : "+v"(z0)); ctr[0] = z0; ctr[1] = z0; }
        {
            const u16* kg = P_qkv + (size_t)(b * SEQ + j * MOBA_BLK) * 3072 + 1024 + h * 64;
#pragma unroll
            for (int i = 0; i < 4; ++i) { const int c = tid + i * 512, row = c >> 3, ch = c & 7; *(LAS u32x4*)(Ks + (row * MB_KP + ch * 8) * 2) = *(const u32x4*)(kg + (size_t)row * 3072 + ch * 8); }
            const u16* vg = P_vT + (size_t)(b * NH + h) * HD * SEQ + j * MOBA_BLK;
#pragma unroll
            for (int i = 0; i < 4; ++i) {
                const int c = tid + i * 512, d = c >> 5, ch = c & 31;
                const u32x4 v = *(const u32x4*)(vg + (size_t)d * SEQ + ch * 8);
                u32x2 w0, w1; w0[0] = v[0]; w0[1] = v[1]; w1[0] = v[2]; w1[1] = v[3];
                *(LAS u32x2*)(Vs + (d * MB_VP + ch * 8) * 2) = w0; *(LAS u32x2*)(Vs + (d * MB_VP + ch * 8 + 4) * 2) = w1;
            }
        }
        __syncthreads();
        {
            const unsigned* sm = P_selm + (size_t)bh * SEQ;
            for (int t0 = (j + 1) * MOBA_BLK; t0 < SEQ; t0 += 512) {
                const int t = t0 + tid;
                const bool sel = (t < SEQ) && ((sm[t < SEQ ? t : 0] >> j) & 1u);
                const unsigned long long bal = __ballot(sel);
                const int total = __popcll(bal);
                int wb = 0;
                if (lane == 0 && total) wb = atomicAdd((int*)&ctr[0], total);
                wb = __shfl(wb, 0);
                if (sel) qlist[wb + __popcll(bal & ((1ull << lane) - 1ull))] = (u16)t;
            }
        }
        __syncthreads();
        const int nq = ctr[0];
        const int ntiles = 8 + ((nq + 31) >> 5);
        for (;;) {
            int ti = 0;
            if (lane == 0) ti = atomicAdd((int*)&ctr[1], 1);
            ti = __shfl(ti, 0);
            if (ti >= ntiles) break;
            const bool own = ti < 8;
            const int wq = 7 - ti;
            const int li = (ti - 8) * 32 + r32;
            const bool valid = own || li < nq;
            const int tq = own ? j * MOBA_BLK + wq * 32 + r32 : (int)qlist[li < nq ? li : nq - 1];
            const int nsteps = own ? wq + 1 : 8;
            const u16* qrow = P_qkv + (size_t)(b * SEQ + tq) * 3072 + h * 64 + hi * 8;
            bf16x8 qf[4];
#pragma unroll
            for (int d0 = 0; d0 < 4; ++d0) qf[d0] = *(const bf16x8*)(qrow + d0 * 16);
            int slot = 3;
            if (!own) slot = __popc(P_selm[(size_t)bh * SEQ + tq] & ((1u << j) - 1u));
            AttnSt st; st.m = NEGV; st.l = 0.f;
#pragma unroll
            for (int r = 0; r < 16; ++r) { st.o0[r] = 0.f; st.o1[r] = 0.f; }
            const int dlo = own ? 0 : -0x40000000;
            for (int kt = 0; kt < nsteps; ++kt) {
                AttnFr f;
#pragma unroll
                for (int d0 = 0; d0 < 4; ++d0) f.k[d0] = *(LAS bf16x8*)(Ks + ((kt * 32 + r32) * MB_KP + d0 * 16 + hi * 8) * 2);
#pragma unroll
                for (int q4 = 0; q4 < 4; ++q4) {
                    union { bf16x8 v; u32x2 hh[2]; } va;
                    LAS char* vp = Vs + (((q4 >> 1) * 32 + r32) * MB_VP + kt * 32 + (q4 & 1) * 16 + 4 * hi) * 2;
                    va.hh[0] = *(LAS u32x2*)(vp); va.hh[1] = *(LAS u32x2*)(vp + 16);
                    f.v[q4] = va.v;
                }
                attn_compute(st, qf, f, tq - (j * MOBA_BLK + kt * 32) - 4 * hi, slope2, dlo, 0x7fffffff, hi);
            }
            const float lt = st.l + __shfl_xor(st.l, 32);
            const float inv = 1.f / lt;
            if (valid) {
                const size_t pi = ((size_t)(b * SEQ + tq) * NH + h) * 4 + slot;
                u16* orow = P_part + pi * 64;
#pragma unroll
                for (int rq = 0; rq < 4; ++rq) {
                    u32x2 w; w[0] = cvtpk(st.o0[4 * rq] * inv, st.o0[4 * rq + 1] * inv); w[1] = cvtpk(st.o0[4 * rq + 2] * inv, st.o0[4 * rq + 3] * inv);
                    *(u32x2*)(orow + 8 * rq + 4 * hi) = w;
                    w[0] = cvtpk(st.o1[4 * rq] * inv, st.o1[4 * rq + 1] * inv); w[1] = cvtpk(st.o1[4 * rq + 2] * inv, st.o1[4 * rq + 3] * inv);
                    *(u32x2*)(orow + 32 + 8 * rq + 4 * hi) = w;
                }
                if (hi == 0) P_plse[pi] = st.m * LN2 + logf(lt);
            }
        }
        __syncthreads();
    }
}

__device__ __forceinline__ void ph_mobamerge(int L, int rep_) {
    PH_FN_BEGIN
    (void)rep_;
    PH_BEGIN;
    for (size_t i = (size_t)bid * NTHR + tid; i < (size_t)T * NH * 8; i += (size_t)G * NTHR) {
        const size_t row = i >> 7; const int h = (int)(i >> 3) & 15, d8 = (int)i & 7;
        const int qb = (int)(row & (SEQ - 1)) >> 8;
        const int nsel = qb < 3 ? qb : 3;
        const size_t pi = (row * NH + h) * 4;
        float l[4], w[4];
        float mx = -INFINITY;
#pragma unroll
        for (int sidx = 0; sidx < 4; ++sidx) { const bool ok = sidx == 3 || sidx < nsel; l[sidx] = ok ? P_plse[pi + sidx] : -INFINITY; mx = fmaxf(mx, l[sidx]); }
        float ws_ = 0.f;
#pragma unroll
        for (int sidx = 0; sidx < 4; ++sidx) { w[sidx] = (sidx == 3 || sidx < nsel) ? expf(l[sidx] - mx) : 0.f; ws_ += w[sidx]; }
        const float inv = 1.f / ws_;
        float acc8[8];
#pragma unroll
        for (int c = 0; c < 8; ++c) acc8[c] = 0.f;
#pragma unroll
        for (int sidx = 0; sidx < 4; ++sidx) {
            if (sidx == 3 || sidx < nsel) {
                const u32x4 a = *(const u32x4*)(P_part + (pi + sidx) * 64 + d8 * 8);
                const float ww = w[sidx] * inv;
#pragma unroll
                for (int c = 0; c < 4; ++c) { acc8[2 * c] += ww * bf2f(a[c] & 0xFFFFu); acc8[2 * c + 1] += ww * bf2f(a[c] >> 16); }
            }
        }
        u32x4 o;
#pragma unroll
        for (int c = 0; c < 4; ++c) o[c] = cvtpk(acc8[2 * c], acc8[2 * c + 1]);
        *(u32x4*)(P_ao + row * D + h * 64 + d8 * 8) = o;
    }
}

__device__ __forceinline__ void ph_dil(int L, int rep_) {
    PH_FN_BEGIN
    (void)rep_;
            PH_BEGIN;
                for (int it = bid; it < BATCH * NH * 3 * 32; it += G) {
                    const int ch = it & 31, grp = (it >> 5) % 3, bh = it / 96, b = bh >> 4, h = bh & 15;
                    const int dil = grp == 0 ? 1 : (grp == 1 ? 4 : 16), Ls = SEQ / dil;
                    const float slope2 = exp2f(-0.5f * (float)(h + 1)) * LOG2E * (float)dil;
                    const int u0 = ch * 256 + wave * 32, res = u0 / Ls, i0 = u0 - res * Ls;
                    const int iq = i0 + r32, pq = iq * dil + res;
                    const u16* qrow = P_qkv + (size_t)(b * SEQ + pq) * 9216 + grp * 3072 + h * 64 + hi * 8;
                    bf16x8 qf[4];
#pragma unroll
                    for (int d0 = 0; d0 < 4; ++d0) qf[d0] = *(const bf16x8*)(qrow + d0 * 16);
                    AttnSt st; st.m = NEGV; st.l = 0.f;
#pragma unroll
                    for (int r = 0; r < 16; ++r) { st.o0[r] = 0.f; st.o1[r] = 0.f; }
                    const u16* kbase = P_qkv + (size_t)(b * SEQ) * 9216 + grp * 3072 + 1024 + h * 64 + hi * 8;
                    const u16* vtb = P_vT + (size_t)grp * T * D + ((size_t)(b * NH + h) * HD + r32) * SEQ + (size_t)res * Ls + 4 * hi;
                    {
                        const int ktmin = (i0 >= 128) ? 0 : (128 - i0) >> 5;
                        AttnFr fa, fb;
                        { const int k1 = i0 - 128 + 4 * 32; attn_load(fa, kbase + (size_t)((k1 + r32) * dil + res) * 9216, vtb + k1, SEQ); }
#define DIL_STEP(FR, FN) { \
                            { const int k1 = i0 - 128 + (kt > ktmin ? kt - 1 : kt) * 32; attn_load(FN, kbase + (size_t)((k1 + r32) * dil + res) * 9216, vtb + k1, SEQ); } \
                            const int k0 = i0 - 128 + kt * 32; \
                            attn_compute(st, qf, FR, iq - k0 - 4 * hi, slope2, 0, 128, hi); }
                        for (int kt = 4; kt >= ktmin; --kt) {
                            DIL_STEP(fa, fb)
                            if (--kt < ktmin) break;
                            DIL_STEP(fb, fa)
                        }
                    }
                    const float lt = st.l + __shfl_xor(st.l, 32);
                    const float inv = 1.f / lt;
                    u16* orow = P_og + (size_t)grp * T * D + (size_t)(b * SEQ + pq) * D + h * 64;
#pragma unroll
                    for (int rq = 0; rq < 4; ++rq) {
                        u32x2 w; w[0] = cvtpk(st.o0[4 * rq] * inv, st.o0[4 * rq + 1] * inv); w[1] = cvtpk(st.o0[4 * rq + 2] * inv, st.o0[4 * rq + 3] * inv);
                        *(u32x2*)(orow + 8 * rq + 4 * hi) = w;
                        w[0] = cvtpk(st.o1[4 * rq] * inv, st.o1[4 * rq + 1] * inv); w[1] = cvtpk(st.o1[4 * rq + 2] * inv, st.o1[4 * rq + 3] * inv);
                        *(u32x2*)(orow + 32 + 8 * rq + 4 * hi) = w;
                    }
                    if (hi == 0) P_lse[((size_t)grp * T + (b * SEQ + pq)) * NH + h] = st.m * LN2 + logf(lt);
                }

}

__device__ __forceinline__ void ph_merge(int L, int rep_) {
    PH_FN_BEGIN
    (void)rep_;

            PH_BEGIN;
                for (size_t i = (size_t)bid * NTHR + tid; i < (size_t)T * NH * 8; i += (size_t)G * NTHR) {
                    const size_t row = i >> 7; const int h = (int)(i >> 3) & 15, d8 = (int)i & 7;
                    const float l0 = P_lse[(0 * (size_t)T + row) * NH + h], l1 = P_lse[(1 * (size_t)T + row) * NH + h], l2 = P_lse[(2 * (size_t)T + row) * NH + h];
                    const float mx = fmaxf(l0, fmaxf(l1, l2));
                    float w0 = expf(l0 - mx), w1 = expf(l1 - mx), w2 = expf(l2 - mx);
                    const float inv = 1.f / (w0 + w1 + w2); w0 *= inv; w1 *= inv; w2 *= inv;
                    const size_t off = row * D + h * 64 + d8 * 8;
                    const u32x4 a0 = *(const u32x4*)(P_og + off), a1 = *(const u32x4*)(P_og + (size_t)T * D + off), a2 = *(const u32x4*)(P_og + 2 * (size_t)T * D + off);
                    u32x4 o;
#pragma unroll
                    for (int c = 0; c < 4; ++c) {
                        const float lo_ = w0 * bf2f(a0[c] & 0xFFFFu) + w1 * bf2f(a1[c] & 0xFFFFu) + w2 * bf2f(a2[c] & 0xFFFFu);
                        const float hi_ = w0 * bf2f(a0[c] >> 16) + w1 * bf2f(a1[c] >> 16) + w2 * bf2f(a2[c] >> 16);
                        o[c] = cvtpk(lo_, hi_);
                    }
                    *(u32x4*)(P_ao + off) = o;
                }

}

__device__ __forceinline__ void ph_wo(int L, int rep_) {
    PH_FN_BEGIN
    (void)rep_;
    const pg8::Gemm g{P_ao, (const u16*)(ws + WS_WO) + (size_t)L * D * D, T, D, D};
    pg8::StaticOrder S; S.init(g.M, g.N, G, bid);
    const EpiWo E{P_ypre, L == 0 ? CTX_IN(0) : (const float*)P_x2};
    pg8::gemm_phase<EpiWo, pg8::StaticOrder, false>((PG8_LAS unsigned char*)lds, g, S, E, nullptr);
}

__device__ __forceinline__ void ph_router(int L, int rep_) {
    PH_FN_BEGIN
    (void)rep_;

            PH_BEGIN;
            const float* lng = CTX_IN(4) + L * D; const float* lnb = CTX_IN(5) + L * D;
            const float* wr = CTX_IN(6) + (size_t)L * D * NE; const float* rbias = CTX_IN(7) + L * NE;
            LAS float* xs = (LAS float*)lds;
            for (int it = bid; it < T / 32; it += G) {
#pragma unroll 1
                for (int rr = 0; rr < 4; ++rr) {
                    const int lr = wave * 4 + rr; const size_t row = (size_t)it * 32 + lr;
                    float v[16];
#pragma unroll
                    for (int j = 0; j < 4; ++j) { const f32x4 t4 = *(const f32x4*)(P_ypre + row * D + j * 256 + lane * 4); v[j * 4] = t4[0]; v[j * 4 + 1] = t4[1]; v[j * 4 + 2] = t4[2]; v[j * 4 + 3] = t4[3]; }
                    ln_row(v, lng, lnb, lane);
#pragma unroll
                    for (int j = 0; j < 4; ++j) {
                        f32x4 t4; t4[0] = v[j * 4]; t4[1] = v[j * 4 + 1]; t4[2] = v[j * 4 + 2]; t4[3] = v[j * 4 + 3];
                        *(f32x4*)(P_x1 + row * D + j * 256 + lane * 4) = t4;
                        *(LAS f32x4*)(xs + lr * XS_PITCH + j * 256 + lane * 4) = t4;
                        u32x2 w; w[0] = cvtpk(t4[0], t4[1]); w[1] = cvtpk(t4[2], t4[3]);
                        *(u32x2*)(P_xb + row * D + j * 256 + lane * 4) = w;
                    }
                }
                __syncthreads();
                f32x16 lg;
#pragma unroll
                for (int r = 0; r < 16; ++r) lg[r] = 0.f;
                {
                    const LAS float* ap = xs + r32 * XS_PITCH + hi;
                    const float* bp = wr + (size_t)hi * NE + wave * 32 + r32;
                    float bva[32], bvb[32];
#pragma unroll
                    for (int j = 0; j < 32; ++j) bva[j] = bp[(size_t)(2 * j) * NE];
#pragma unroll 1
                    for (int k0 = 0; k0 < D; k0 += 128) {
#pragma unroll
                        for (int j = 0; j < 32; ++j) bvb[j] = bp[(size_t)(k0 + 64 + 2 * j) * NE];
#pragma unroll
                        for (int j = 0; j < 32; ++j) lg = __builtin_amdgcn_mfma_f32_32x32x2f32(ap[k0 + 2 * j], bva[j], lg, 0, 0, 0);
                        if (k0 + 128 < D) {
#pragma unroll
                            for (int j = 0; j < 32; ++j) bva[j] = bp[(size_t)(k0 + 128 + 2 * j) * NE];
                        }
#pragma unroll
                        for (int j = 0; j < 32; ++j) lg = __builtin_amdgcn_mfma_f32_32x32x2f32(ap[k0 + 64 + 2 * j], bvb[j], lg, 0, 0, 0);
                    }
                }
                __syncthreads();
                LAS float* lgs = (LAS float*)lds;
#pragma unroll
                for (int r = 0; r < 16; ++r) lgs[crow(r, hi) * 257 + wave * 32 + r32] = lg[r];
                __syncthreads();
#pragma unroll 1
                for (int rr = 0; rr < 4; ++rr) {
                    const int lr = wave * 4 + rr; const int tok = it * 32 + lr;
                    float sc[4], ch[4];
#pragma unroll
                    for (int j = 0; j < 4; ++j) { const int e = lane + 64 * j; sc[j] = 1.f / (1.f + expf(-lgs[lr * 257 + e])); ch[j] = sc[j] + rbias[e]; }
                    float gsel[8], gmine[4];
#pragma unroll
                    for (int j = 0; j < 4; ++j) {
                        float m1 = ch[j];
#pragma unroll
                        for (int o = 16; o >= 1; o >>= 1) m1 = fmaxf(m1, __shfl_xor(m1, o));
                        const unsigned long long bal = __ballot(ch[j] == m1);
                        const unsigned half = (unsigned)(hi ? (bal >> 32) : (bal & 0xFFFFFFFFull));
                        const int first = __builtin_ctz(half);
                        float m2 = (r32 == first) ? -INFINITY : ch[j];
#pragma unroll
                        for (int o = 16; o >= 1; o >>= 1) m2 = fmaxf(m2, __shfl_xor(m2, o));
                        const float mine = m1 + m2, other = __shfl_xor(mine, 32);
                        gsel[2 * j] = hi ? other : mine; gsel[2 * j + 1] = hi ? mine : other; gmine[j] = mine;
                    }
                    bool gok[4];
#pragma unroll
                    for (int j = 0; j < 4; ++j) {
                        const float mygs = gmine[j];
                        const int myg = 2 * j + hi;
                        int rank = 0;
#pragma unroll
                        for (int g2 = 0; g2 < 8; ++g2) rank += ((gsel[g2] > mygs) || (gsel[g2] == mygs && g2 < myg)) ? 1 : 0;
                        gok[j] = rank < 4;
                    }
                    float cv[4];
#pragma unroll
                    for (int j = 0; j < 4; ++j) cv[j] = gok[j] ? ch[j] : NEGV;
                    float wsel = 0.f; int esel = 0; float wsum = 0.f;
#pragma unroll 1
                    for (int k = 0; k < TOPK; ++k) {
                        float bv = cv[0]; int be = lane;
#pragma unroll
                        for (int j = 1; j < 4; ++j) if (cv[j] > bv) { bv = cv[j]; be = lane + 64 * j; }
#pragma unroll
                        for (int o = 32; o >= 1; o >>= 1) {
                            const float ov = __shfl_xor(bv, o); const int oe = __shfl_xor(be, o);
                            if (ov > bv || (ov == bv && oe < be)) { bv = ov; be = oe; }
                        }
                        const int jl = be >> 6, ll = be & 63;
                        float smine = sc[0];
                        smine = jl == 1 ? sc[1] : smine; smine = jl == 2 ? sc[2] : smine; smine = jl == 3 ? sc[3] : smine;
                        const float sw = __shfl(smine, ll);
#pragma unroll
                        for (int j = 0; j < 4; ++j) cv[j] = (lane == ll && jl == j) ? -INFINITY : cv[j];
                        wsum += sw;
                        if (lane == k) { wsel = sw; esel = be; }
                    }
                    if (lane < TOPK) {
                        const int a = tok * TOPK + lane;
                        P_topw[a] = wsel / wsum * 2.5f;
                        if (rep_ == 0) {
                            const int pos = atomicAdd(&cnt[esel], 1);
                            P_list[(size_t)esel * T + pos] = a;
                        }
                    }
                }
                __syncthreads();
            }

}

__device__ __forceinline__ void ph_gateup(int L, int rep_) {
    PH_FN_BEGIN
    (void)rep_;
    {
        PH_BEGIN;
        const float* weg = CTX_IN(8) + (size_t)L * NE * D * DF; const float* weu = CTX_IN(9) + (size_t)L * NE * D * DF;
        LAS int* rowva = (LAS int*)(lds + MOE_LDS_VA);
        for (int e = bid; e < NE; e += G) {
            const int n = cnt[e];
            for (int r0 = 0; r0 < n; r0 += 1024) {
#pragma unroll
                for (int i = 0; i < 2; ++i) { const int idx = r0 + i * 512 + tid; rowva[i * 512 + tid] = idx < n ? P_list[(size_t)e * T + idx] : TRASH_VA; }
                __syncthreads();
                moe_expert<false>(lds, tid, lane, wave, r32, hi, P_xb, weg + (size_t)e * D * DF, weu + (size_t)e * D * DF, (n - r0) < 1024 ? (n - r0) : 1024, P_hb);
            }
        }
    }
    {
        const pg8::Gemm g{P_xb, (const u16*)(ws + WS_WSGU) + (size_t)L * 512 * 1024, T, 512, D};
        pg8::StaticOrder S; S.init(g.M, g.N, G, (bid + 128) % G);
        const EpiSGU E{P_hb};
        pg8::gemm_phase<EpiSGU, pg8::StaticOrder, false>((PG8_LAS unsigned char*)lds, g, S, E, nullptr);
    }
}

__device__ __forceinline__ void ph_down(int L, int rep_) {
    PH_FN_BEGIN
    (void)rep_;
    {
        PH_BEGIN;
        const float* wed = CTX_IN(10) + (size_t)L * NE * DF * D;
        LAS int* rowva = (LAS int*)(lds + MOE_LDS_VA); LAS float* roww = (LAS float*)(lds + MOE_LDS_W);
        for (int e = bid; e < NE; e += G) {
            const int n = cnt[e];
            for (int r0 = 0; r0 < n; r0 += 1024) {
#pragma unroll
                for (int i = 0; i < 2; ++i) { const int idx = r0 + i * 512 + tid; const int va = idx < n ? P_list[(size_t)e * T + idx] : TRASH_VA; rowva[i * 512 + tid] = va; roww[i * 512 + tid] = va < A_TOT ? P_topw[va] : 0.f; }
                __syncthreads();
                moe_expert<true>(lds, tid, lane, wave, r32, hi, P_hb, wed + (size_t)e * DF * D, nullptr, (n - r0) < 1024 ? (n - r0) : 1024, P_yb);
            }
        }
    }
    {
        const pg8::Gemm g{P_hb + (size_t)A_TOT * DF, (const u16*)(ws + WS_WSD) + (size_t)L * D * DF, T, D, DF};
        pg8::StaticOrder S; S.init(g.M, g.N, G, bid);
        const EpiSD E{P_yb};
        pg8::gemm_phase<EpiSD, pg8::StaticOrder, false>((PG8_LAS unsigned char*)lds, g, S, E, nullptr);
    }
}

__device__ __forceinline__ void ph_combine(int L, int rep_) {
    PH_FN_BEGIN
    (void)rep_;

            PH_BEGIN;
            const float* lng = CTX_IN(14) + L * D; const float* lnb = CTX_IN(15) + L * D;
            float* dst = L == 0 ? P_x2 : AS_GLOBAL(float, ctx_ld(16));
            for (int row = bid * 8 + wave; row < T; row += G * 8) {
                float v[16];
#pragma unroll
                for (int j = 0; j < 4; ++j) { const f32x4 t4 = *(const f32x4*)(P_x1 + (size_t)row * D + j * 256 + lane * 4); v[j * 4] = DN_ALPHA * t4[0]; v[j * 4 + 1] = DN_ALPHA * t4[1]; v[j * 4 + 2] = DN_ALPHA * t4[2]; v[j * 4 + 3] = DN_ALPHA * t4[3]; }
#pragma unroll 1
                for (int k = 0; k < TOPK + 1; ++k) {
                    const size_t va = k < TOPK ? (size_t)row * TOPK + k : (size_t)A_TOT + row;
#pragma unroll
                    for (int j = 0; j < 4; ++j) {
                        const u32x2 w = *(const u32x2*)(P_yb + va * D + j * 256 + lane * 4);
                        v[j * 4] += bf2f(w[0] & 0xFFFFu); v[j * 4 + 1] += bf2f(w[0] >> 16); v[j * 4 + 2] += bf2f(w[1] & 0xFFFFu); v[j * 4 + 3] += bf2f(w[1] >> 16);
                    }
                }
                ln_row(v, lng, lnb, lane);
#pragma unroll
                for (int j = 0; j < 4; ++j) {
                    f32x4 t4; t4[0] = v[j * 4]; t4[1] = v[j * 4 + 1]; t4[2] = v[j * 4 + 2]; t4[3] = v[j * 4 + 3];
                    *(f32x4*)(dst + (size_t)row * D + j * 256 + lane * 4) = t4;
                    if (L == 0) { u32x2 w; w[0] = cvtpk(t4[0], t4[1]); w[1] = cvtpk(t4[2], t4[3]); *(u32x2*)(P_xb + (size_t)row * D + j * 256 + lane * 4) = w; }
                }
            }

}

__global__ void __launch_bounds__(NTHR, 2) fwd(Args args) {
    extern __shared__ __attribute__((aligned(16))) unsigned char lds_raw[];
    LAS char* lds = (LAS char*)lds_raw;
    unsigned char* const ws = args.ws;
    const int lo = args.ph_lo, hi_ph = args.ph_hi;
    if (threadIdx.x < 18) {
        const uint64_t v = threadIdx.x < 16 ? (uint64_t)args.in[threadIdx.x] : (threadIdx.x == 16 ? (uint64_t)args.out : (uint64_t)args.ws);
        ((LAS uint64_t*)(lds + LDS_CTX))[threadIdx.x] = v;
    }
    __syncthreads();
#define IN(k) (lo <= (k) && (k) < hi_ph)

#if MK_ONE_LAUNCH
    if (threadIdx.x < 4) ((LAS unsigned*)(lds + LDS_BAR))[threadIdx.x] = 0u;
    __syncthreads();
    XcdBarrier bar = xcd_barrier_post((unsigned*)(ws + WS_CTL), (volatile LAS unsigned*)(lds + LDS_BAR));
#define GRID_BAR() xcd_barrier(bar)
#else
#define GRID_BAR() do { } while (0)
#endif
#define SEAM(k) do { if (IN(k) && IN((k) + 1)) GRID_BAR(); } while (0)

    for (int rep_ = 0; rep_ < ((IN(0) && PHK(0)) ? REPS(0) : 0); ++rep_) { ph_p0(0, rep_); }
    SEAM(0);

    for (int L = 0; L < 2; ++L) {
        const int pb = 1 + 10 * L;
        for (int rep_ = 0; rep_ < ((IN(pb + 0) && PHK(1)) ? REPS(1) : 0); ++rep_) { ph_qkv(L, rep_); }
        SEAM(pb + 0);

        if (L == 0) {
            for (int rep_ = 0; rep_ < ((IN(pb + 1) && PHK(2)) ? REPS(2) : 0); ++rep_) { ph_kmean(L, rep_); }
            SEAM(pb + 1);
            for (int rep_ = 0; rep_ < ((IN(pb + 2) && PHK(11)) ? REPS(11) : 0); ++rep_) { ph_gate(L, rep_); }
            SEAM(pb + 2);
        }

        if (L == 0) {
            for (int rep_ = 0; rep_ < ((IN(pb + 3) && PHK(3)) ? REPS(3) : 0); ++rep_) { ph_moba(L, rep_); }
            SEAM(pb + 3);
            for (int rep_ = 0; rep_ < ((IN(pb + 4) && PHK(12)) ? REPS(12) : 0); ++rep_) { ph_mobamerge(L, rep_); }
        } else {
            for (int rep_ = 0; rep_ < ((IN(pb + 3) && PHK(4)) ? REPS(4) : 0); ++rep_) { ph_dil(L, rep_); }
            SEAM(pb + 3);
            for (int rep_ = 0; rep_ < ((IN(pb + 4) && PHK(5)) ? REPS(5) : 0); ++rep_) { ph_merge(L, rep_); }
        }
        SEAM(pb + 4);

        for (int rep_ = 0; rep_ < ((IN(pb + 5) && PHK(6)) ? REPS(6) : 0); ++rep_) { ph_wo(L, rep_); }
        SEAM(pb + 5);

        for (int rep_ = 0; rep_ < ((IN(pb + 6) && PHK(7)) ? REPS(7) : 0); ++rep_) { ph_router(L, rep_); }
        SEAM(pb + 6);

        for (int rep_ = 0; rep_ < ((IN(pb + 7) && PHK(8)) ? REPS(8) : 0); ++rep_) { ph_gateup(L, rep_); }
        SEAM(pb + 7);

        for (int rep_ = 0; rep_ < ((IN(pb + 8) && PHK(9)) ? REPS(9) : 0); ++rep_) { ph_down(L, rep_); }
        SEAM(pb + 8);

        for (int rep_ = 0; rep_ < ((IN(pb + 9) && PHK(10)) ? REPS(10) : 0); ++rep_) { ph_combine(L, rep_); }
        if (L == 0) SEAM(pb + 9);
    }
}

extern "C" void kernel_launch(void* const* d_in, const int* in_sizes, int n_in, void* d_out, int out_size, void* d_ws, size_t ws_size, hipStream_t stream) {
    static int grid = 0;
    if (grid == 0) {
        if (n_in != 16 || out_size != T * D || ws_size < WS_END2) { fprintf(stderr, "kernel_launch: unexpected problem (n_in %d out %d ws %zu need %zu)\n", n_in, out_size, ws_size, (size_t)WS_END2); grid = -1; return; }
        int dev = 0, cus = 0, per_cu = 0;
        if (hipGetDevice(&dev) != hipSuccess || hipDeviceGetAttribute(&cus, hipDeviceAttributeMultiprocessorCount, dev) != hipSuccess) { grid = -1; return; }
        if (hipFuncSetAttribute((const void*)fwd, hipFuncAttributeMaxDynamicSharedMemorySize, LDS_BYTES) != hipSuccess) { fprintf(stderr, "kernel_launch: hipFuncSetAttribute failed\n"); grid = -1; return; }
        if (hipOccupancyMaxActiveBlocksPerMultiprocessor(&per_cu, (const void*)fwd, NTHR, LDS_BYTES) != hipSuccess || per_cu < 1) { fprintf(stderr, "kernel_launch: occupancy query says %d\n", per_cu); (void)hipGetLastError(); per_cu = 1; }
        grid = cus;
    }
    if (grid < 0) return;
    (void)hipMemsetAsync((char*)d_ws + WS_CTL, 0, CTL_BYTES, stream);
    Args a{};
    for (int i = 0; i < 16; ++i) a.in[i] = (const float*)d_in[i];
    a.out = (float*)d_out; a.ws = (unsigned char*)d_ws;
#if MK_ONE_LAUNCH
    a.ph_lo = 0; a.ph_hi = N_PHASES;
    hipLaunchKernelGGL(fwd, dim3(grid), dim3(NTHR), LDS_BYTES, stream, a);
#else
    for (int ph = 0; ph < N_PHASES; ++ph) {
        if (ph == 12 || ph == 13) continue;
        a.ph_lo = ph; a.ph_hi = ph + 1;
        hipLaunchKernelGGL(fwd, dim3(grid), dim3(NTHR), LDS_BYTES, stream, a);
    }
#endif
}
```

```cpp
#include <hip/hip_runtime.h>
#include <hip/hip_bf16.h>
#include <stdint.h>
#include <stdio.h>

#ifndef MK_ONE_LAUNCH
#define MK_ONE_LAUNCH 1
#endif

#ifndef PHMASK
#define PHMASK 0x1FFF
#endif
#define PHK(k) ((PHMASK >> (k)) & 1)
#ifndef REPEAT_KIND
#define REPEAT_KIND -1
#endif
#define REPS(k) ((k) == REPEAT_KIND ? 2 : 1)
#define LAS __attribute__((address_space(3)))
typedef __attribute__((ext_vector_type(8))) short bf16x8;
typedef __attribute__((ext_vector_type(16))) float f32x16;
typedef __attribute__((ext_vector_type(4))) float f32x4;
typedef __attribute__((ext_vector_type(4))) unsigned u32x4;
typedef __attribute__((ext_vector_type(2))) unsigned u32x2;
typedef unsigned short u16;

constexpr int D = 1024, BATCH = 2, SEQ = 8192, T = BATCH * SEQ, NH = 16, HD = 64;
constexpr int NE = 256, TOPK = 8, DF = 256;
constexpr int A_TOT = T * TOPK;
constexpr int MOBA_BLK = 256, MOBA_NB = SEQ / MOBA_BLK;
constexpr float DN_ALPHA = 1.4142135623730951f;
constexpr float LN_EPS = 1e-5f;
constexpr float LOG2E = 1.4426950408889634f;
constexpr float LN2 = 0.6931471805599453f;
constexpr float NEGV = -1e30f;
constexpr int NTHR = 512;

constexpr size_t al256(size_t x) { return (x + 255) & ~(size_t)255; }
constexpr size_t WS_CTL = 0;
constexpr size_t CTL_BYTES = 65536;
constexpr size_t CTL_CNT_OFF = 32768;
constexpr size_t WS_XB = WS_CTL + CTL_BYTES;
constexpr size_t WS_X1 = WS_XB + al256((size_t)T * D * 2);
constexpr size_t WS_X2 = WS_X1 + al256((size_t)T * D * 4);
constexpr size_t WS_YPRE = WS_X2 + al256((size_t)T * D * 4);
constexpr size_t WS_QKV = WS_YPRE + al256((size_t)T * D * 4);
constexpr size_t WS_VT = WS_QKV + al256((size_t)T * 9216 * 2);
constexpr size_t WS_KM = WS_VT + al256((size_t)3 * T * D * 2);
constexpr size_t WS_AO = WS_KM + al256((size_t)BATCH * NH * MOBA_NB * HD * 4);
constexpr size_t WS_OG = WS_AO + al256((size_t)T * D * 2);
constexpr size_t WS_LSE = WS_OG + al256((size_t)3 * T * D * 2);
constexpr size_t WS_TOPW = WS_LSE + al256((size_t)3 * T * NH * 4);
constexpr size_t WS_LIST = WS_TOPW + al256((size_t)T * TOPK * 4);
constexpr size_t WS_HB = WS_LIST + al256((size_t)NE * T * 4);
constexpr size_t WS_YB = WS_HB + al256((size_t)(A_TOT + T + 1) * DF * 2);
constexpr size_t WS_END = WS_YB + al256((size_t)(A_TOT + T + 1) * D * 2);
constexpr int TRASH_VA = A_TOT + T;
constexpr size_t WS_SELM = WS_END;
constexpr size_t WS_PART = WS_SELM + al256((size_t)T * NH * 4);
constexpr size_t WS_PLSE = WS_PART + al256((size_t)T * NH * 4 * 64 * 2);
constexpr size_t WS_WQK0 = WS_PLSE + al256((size_t)T * NH * 4 * 4);
constexpr size_t WS_WV0 = WS_WQK0 + (size_t)2048 * 1024 * 2;
constexpr size_t WS_WQK1 = WS_WV0 + (size_t)1024 * 1024 * 2;
constexpr size_t WS_WV1 = WS_WQK1 + (size_t)6144 * 1024 * 2;
constexpr size_t WS_WO = WS_WV1 + (size_t)3072 * 1024 * 2;
constexpr size_t WS_WSGU = WS_WO + (size_t)2 * 1024 * 1024 * 2;
constexpr size_t WS_WSD = WS_WSGU + (size_t)2 * 512 * 1024 * 2;
constexpr size_t WS_WRH = WS_WSD + (size_t)2 * 1024 * 256 * 2;
constexpr size_t WS_WRL = WS_WRH + (size_t)2 * 256 * 1024 * 2;
constexpr size_t WS_END2 = WS_WRL + (size_t)2 * 256 * 1024 * 2;

constexpr int LDP = 40;
constexpr int STAGE_BYTES = 2 * 256 * LDP * 2;
constexpr int LDS_ROWID = 2 * STAGE_BYTES;
constexpr int LDS_ROWW = LDS_ROWID + 1024;
constexpr int XS_PITCH = 1028;
constexpr int LDS_BYTES = 163840;
constexpr int LDS_BAR = 161792;

#define XB_TMO      128
#define XB_XCNT(j)  (256  + 64 * (j))
#define XB_XSUB(j)  (1280 + 64 * (j))
#define XB_XGEN(j)  (2304 + 64 * (j))
#define XB_TOP      3328
#define XB_TOPGEN   3392
#define XCD_BAR_WORDS 3456
#define XB_SPIN_CAP (1u << 18)
__device__ __forceinline__ unsigned xb_ld(unsigned* p)              { return __hip_atomic_load(p, __ATOMIC_RELAXED, __HIP_MEMORY_SCOPE_AGENT); }
__device__ __forceinline__ unsigned xb_add(unsigned* p, unsigned v) { return __hip_atomic_fetch_add(p, v, __ATOMIC_RELAXED, __HIP_MEMORY_SCOPE_AGENT); }
__device__ __forceinline__ unsigned xb_xcc_id() { return (unsigned)__builtin_amdgcn_s_getreg((3 << 11) | 20) & 0xFu; }
#define XB_SPIN(cond, bar) do { unsigned _sp = 0; while (cond) { __builtin_amdgcn_s_sleep(1); \
    if ((++_sp & 255u) == 0u) { if (xb_ld(&(bar)[XB_TMO])) break; if (_sp > XB_SPIN_CAP) { atomicAdd(&(bar)[XB_TMO], 1u); break; } } } } while (0)
struct XcdBarrier { unsigned* bar; unsigned x; volatile LAS unsigned* st; };
__device__ __forceinline__ XcdBarrier xcd_barrier_post(unsigned* bar, volatile LAS unsigned* st) {
    XcdBarrier b; b.bar = bar; b.x = xb_xcc_id(); b.st = st;
    if (threadIdx.x == 0) (void)xb_add(&bar[XB_XCNT(b.x)], 1u);
    return b;
}
__device__ __forceinline__ void xcd_barrier_complete(unsigned* bar, unsigned x, unsigned& nloc, unsigned& nx) {
    const unsigned G = gridDim.x * gridDim.y * gridDim.z;
    unsigned sum, cnt, mine, sp = 0u;
    for (;;) {
        sum = 0u; cnt = 0u; mine = 0u;
#pragma unroll
        for (unsigned j = 0; j < 16; ++j) { const unsigned c = xb_ld(&bar[XB_XCNT(j)]); sum += c; cnt += (c > 0u) ? 1u : 0u; mine = (j == x) ? c : mine; }
        if (sum == G) break;
        __builtin_amdgcn_s_sleep(1);
        if ((++sp & 255u) == 0u) { if (xb_ld(&bar[XB_TMO])) break; if (sp > XB_SPIN_CAP) { atomicAdd(&bar[XB_TMO], 1u); break; } }
    }
    nloc = mine > 0u ? mine : 1u; nx = cnt > 0u ? cnt : 1u;
}
__device__ __forceinline__ void xcd_barrier(const XcdBarrier& b) {
    asm volatile("s_waitcnt vmcnt(0)" ::: "memory");
    __syncthreads();
    if (threadIdx.x == 0) {
        unsigned* bar = b.bar;
        __builtin_amdgcn_s_waitcnt(0);
        unsigned nloc = b.st[0], nx = b.st[1];
        if (nloc == 0u) { xcd_barrier_complete(bar, b.x, nloc, nx); b.st[0] = nloc; b.st[1] = nx; }
        const unsigned old = xb_add(&bar[XB_XSUB(b.x)], 1u);
        const unsigned gen = old / nloc;
        if (old + 1u == (gen + 1u) * nloc) {
            __builtin_amdgcn_fence(__ATOMIC_RELEASE, "agent");
            asm volatile("s_waitcnt vmcnt(0)" ::: "memory");
            const unsigned og = xb_add(&bar[XB_TOP], 1u);
            const unsigned tg = og / nx;
            if (og + 1u == (tg + 1u) * nx) xb_add(&bar[XB_TOPGEN], 1u);
            else XB_SPIN(xb_ld(&bar[XB_TOPGEN]) == tg, bar);
            __builtin_amdgcn_fence(__ATOMIC_ACQUIRE, "agent");
            xb_add(&bar[XB_XGEN(b.x)], 1u);
            asm volatile("s_waitcnt vmcnt(0)" ::: "memory");
        } else {
            XB_SPIN(xb_ld(&bar[XB_XGEN(b.x)]) == gen, bar);
            __builtin_amdgcn_fence(__ATOMIC_ACQUIRE, "agent");
            asm volatile("s_waitcnt vmcnt(0)" ::: "memory");
        }
    }
    __syncthreads();
}

typedef __attribute__((ext_vector_type(2))) __bf16 bf16x2_t;
typedef __attribute__((ext_vector_type(2))) float f32x2_t;
__device__ __forceinline__ unsigned cvtpk(float lo, float hi) { f32x2_t f; f[0] = lo; f[1] = hi; return __builtin_bit_cast(unsigned, __builtin_convertvector(f, bf16x2_t)); }
__device__ __forceinline__ float bf2f(unsigned v16) { return __uint_as_float(v16 << 16); }
__device__ __forceinline__ int crow(int r, int hi) { return (r & 3) + 8 * (r >> 2) + 4 * hi; }
#define MFMA_BF16(a, b, c) __builtin_amdgcn_mfma_f32_32x32x16_bf16(a, b, c, 0, 0, 0)
__device__ __forceinline__ float wave_sum(float v) {
#pragma unroll
    for (int o = 32; o >= 1; o >>= 1) v += __shfl_xor(v, o);
    return v;
}

namespace pg8 {
#define PG8_LAS __attribute__((address_space(3)))
typedef unsigned short bf16_t;
typedef short bf16x8 __attribute__((ext_vector_type(8)));
typedef float f32x4 __attribute__((ext_vector_type(4)));
typedef unsigned u32x4 __attribute__((ext_vector_type(4)));
constexpr int BM = 256, BK = 64, HALF = 128, HTB = HALF * BK * 2  , STAGE_BYTES = 8 * HTB, NXCD = 8, WGM = 8;

__host__ __device__ __forceinline__ int lds_byte(int r, int c) { const int st = (r >> 4) * 2 + (c >> 5), rr = r & 15, cc = c & 31, ob = rr * 64 + cc * 2; return st * 1024 + (ob ^ (((ob >> 9) & 1) << 5)); }
__host__ __device__ __forceinline__ void stage_rc(int b, int& R, int& C) { const int st = b / 1024, sb = b % 1024, swz = sb ^ (((sb >> 9) & 1) << 5); R = (st >> 1) * 16 + swz / 64; C = (st & 1) * 32 + (swz % 64) / 2; }
__host__ __device__ __forceinline__ int perm32(int rho) { const int n = rho >> 4, i = rho & 15; return 8 * (i >> 2) + 4 * n + (i & 3); }

struct Unit { int pm, pn; };
struct Gemm { const bf16_t* A; const bf16_t* Bt; int M, N, K; };

struct StaticOrder {
    int nM, nN, nwg, G, c;
    __host__ __device__ void init(int M, int N, int G_, int c_) { nM = M / BM; nN = N / BM; nwg = nM * nN; G = G_; c = c_; }
    __host__ __device__ bool next(int i, Unit& u) const {
        const long L = (long)i * G + c; if (L >= nwg) return false;
        int wgid = (int)L; { const int q = nwg / NXCD, r = nwg % NXCD, xcd = wgid % NXCD, off = wgid / NXCD; wgid = (xcd < r ? xcd * (q + 1) : r * (q + 1) + (xcd - r) * q) + off; }
        const int nig = WGM * nN, gid = wgid / nig, fm = gid * WGM, gsz = (nM - fm) < WGM ? (nM - fm) : WGM;
        u.pm = fm + ((wgid % nig) % gsz); u.pn = (wgid % nig) / gsz; return true;
    }
    __device__ __forceinline__ void a_ready(const Unit&) const {}
    __device__ __forceinline__ void done(const Unit&) const {}
};

template <class Epi, class Sched, bool SWAP = false, bool STAMP = false>
__device__ __forceinline__ void gemm_phase(PG8_LAS unsigned char* lds, const Gemm g, const Sched& S, const Epi& E, unsigned long long* stamps) {
    int tid_ = threadIdx.x; asm volatile("" : "+v"(tid_));
    const int tid = tid_, wid = __builtin_amdgcn_readfirstlane(tid >> 6), lane = tid & 63, wr = wid >> 2, wc = wid & 3, fr = lane & 15, fq = lane >> 4;
    const int K = g.K, nt = K / BK;
    int ts_lo = 0, ts_hi = 0, nts = 0; const unsigned long long rt_entry = STAMP ? (unsigned long long)wall_clock64() : 0ull;
#define PG8_STAMP() do { if (STAMP && wid == 0 && nts < 64) { const unsigned long long _c = (unsigned long long)clock64(); \
        ts_lo = (lane == nts) ? (int)(unsigned)_c : ts_lo; ts_hi = (lane == nts) ? (int)(unsigned)(_c >> 32) : ts_hi; ++nts; } } while (0)
    PG8_STAMP();
    unsigned voffA[2], voffB[2];
#pragma unroll
    for (int i = 0; i < 2; ++i) { int R, C; stage_rc(tid * 16 + i * 8192, R, C); const int Rb = Epi::PERM ? ((R & ~31) + perm32(R & 31)) : R;
        voffA[i] = (unsigned)(R * K + C) * 2u; voffB[i] = (unsigned)(Rb * K + C) * 2u; }
    const size_t kstep = (size_t)(BK * 2);
    const size_t hstep = (size_t)HALF * K * 2;
    const size_t tstep = 2 * hstep;
    const unsigned ldsw = (unsigned)wid * 1024u;
    const int aoff = lds_byte(wr * 64 + fr, fq * 8), boff = lds_byte(wc * 32 + fr, fq * 8);
#define PG8_SA(b, h) (((b) * 2 + (h)) * HTB)
#define PG8_SB(b, h) ((4 + (b) * 2 + (h)) * HTB)
#define PG8_STAGE(bufoff, gbase, voff) do { _Pragma("unroll") for (int _i = 0; _i < 2; ++_i) \
        __builtin_amdgcn_global_load_lds((const unsigned*)((const char*)(gbase) + (voff)[_i]), (PG8_LAS unsigned*)(lds + (bufoff) + ldsw + _i * 8192), 16, 0, 0); } while (0)
#define PG8_LDA(dst, b, h) do { _Pragma("unroll") for (int m = 0; m < 4; ++m) _Pragma("unroll") for (int k = 0; k < 2; ++k) dst[m][k] = *(const PG8_LAS bf16x8*)(lds + PG8_SA(b, h) + aoff + m * 2048 + k * 1024); } while (0)
#define PG8_LDB(dst, b, h) do { _Pragma("unroll") for (int n = 0; n < 2; ++n) _Pragma("unroll") for (int k = 0; k < 2; ++k) dst[n][k] = *(const PG8_LAS bf16x8*)(lds + PG8_SB(b, h) + boff + n * 2048 + k * 1024); } while (0)
#define PG8_MMA(ai, bj, At, Bt) do { __builtin_amdgcn_s_setprio(1); _Pragma("unroll") for (int m = 0; m < 4; ++m) _Pragma("unroll") for (int n = 0; n < 2; ++n) _Pragma("unroll") for (int k = 0; k < 2; ++k) \
        acc[ai][bj][m][n] = SWAP ? __builtin_amdgcn_mfma_f32_16x16x32_bf16(At[m][k], Bt[n][k], acc[ai][bj][m][n], 0, 0, 0) : __builtin_amdgcn_mfma_f32_16x16x32_bf16(Bt[n][k], At[m][k], acc[ai][bj][m][n], 0, 0, 0); __builtin_amdgcn_s_setprio(0); } while (0)
#define PG8_WAIT_V(n) asm volatile("s_waitcnt vmcnt(" #n ")" ::: "memory")
#define PG8_WAIT_L(n) asm volatile("s_waitcnt lgkmcnt(" #n ")" ::: "memory")
#define PG8_BAR __builtin_amdgcn_s_barrier()
#define PG8_SCHED __builtin_amdgcn_sched_barrier(0)
    Unit cur, nxt; int ui = 0;
    if (!S.next(0, cur)) return;
    f32x4 acc[2][2][4][2];
#pragma unroll
    for (int a = 0; a < 2; ++a)
#pragma unroll
        for (int b = 0; b < 2; ++b)
#pragma unroll
            for (int m = 0; m < 4; ++m)
#pragma unroll
                for (int n = 0; n < 2; ++n) acc[a][b][m][n] = (f32x4){0.f, 0.f, 0.f, 0.f};
    bf16x8 At[4][2], B0[2][2], B1[2][2];
    const char* cA = (const char*)g.A + (size_t)cur.pm * tstep; const char* cB = (const char*)g.Bt + (size_t)cur.pn * tstep;
    S.a_ready(cur);
    PG8_STAGE(PG8_SB(0, 0), cB, voffB); PG8_STAGE(PG8_SA(0, 0), cA, voffA); PG8_STAGE(PG8_SB(0, 1), cB + hstep, voffB); PG8_STAGE(PG8_SA(0, 1), cA + hstep, voffA);
    if (wr == 1) PG8_BAR;
    PG8_WAIT_V(4); PG8_BAR;
    PG8_STAGE(PG8_SB(1, 0), cB + kstep, voffB); PG8_STAGE(PG8_SA(1, 0), cA + kstep, voffA); PG8_STAGE(PG8_SB(1, 1), cB + hstep + kstep, voffB);
    PG8_WAIT_V(6); PG8_BAR;
    PG8_STAMP();
    for (;;) {
        const bool has_next = S.next(ui + 1, nxt);
        const char* nA = has_next ? (const char*)g.A + (size_t)nxt.pm * tstep : cA; const char* nB = has_next ? (const char*)g.Bt + (size_t)nxt.pn * tstep : cB;
        for (int t = 0; t < nt; t += 2) {
            const bool last = (t == nt - 2);
            const char* a1 = cA + (size_t)(t + 1) * kstep;
            const char* a2 = last ? nA : cA + (size_t)(t + 2) * kstep; const char* b2 = last ? nB : cB + (size_t)(t + 2) * kstep;
            const char* a3 = a2 + kstep; const char* b3 = b2 + kstep;
            if (last && has_next) S.a_ready(nxt);
            PG8_LDB(B0, 0, 0); PG8_SCHED; PG8_LDA(At, 0, 0); PG8_STAGE(PG8_SA(1, 1), a1 + hstep, voffA);
            PG8_WAIT_L(8); PG8_BAR; PG8_WAIT_L(0); PG8_MMA(0, 0, At, B0); PG8_BAR; PG8_SCHED;
            PG8_LDB(B1, 0, 1); PG8_STAGE(PG8_SB(0, 0), b2, voffB);
            PG8_BAR; PG8_WAIT_L(0); PG8_MMA(0, 1, At, B1); PG8_BAR;
            PG8_LDA(At, 0, 1); PG8_STAGE(PG8_SA(0, 0), a2, voffA);
            PG8_BAR; PG8_WAIT_L(0); PG8_MMA(1, 0, At, B0); PG8_BAR; PG8_SCHED;
            PG8_STAGE(PG8_SB(0, 1), b2 + hstep, voffB);
            PG8_WAIT_V(6); PG8_BAR; PG8_MMA(1, 1, At, B1); PG8_BAR;
            PG8_LDB(B0, 1, 0); PG8_SCHED; PG8_LDA(At, 1, 0); PG8_STAGE(PG8_SA(0, 1), a2 + hstep, voffA);
            PG8_WAIT_L(8); PG8_BAR; PG8_WAIT_L(0); PG8_MMA(0, 0, At, B0); PG8_BAR; PG8_SCHED;
            PG8_LDB(B1, 1, 1); PG8_STAGE(PG8_SB(1, 0), b3, voffB);
            PG8_BAR; PG8_WAIT_L(0); PG8_MMA(0, 1, At, B1); PG8_BAR;
            PG8_LDA(At, 1, 1); PG8_STAGE(PG8_SA(1, 0), a3, voffA);
            PG8_BAR; PG8_WAIT_L(0); PG8_MMA(1, 0, At, B0); PG8_BAR; PG8_SCHED;
            PG8_STAGE(PG8_SB(1, 1), b3 + hstep, voffB);
            PG8_WAIT_V(6); PG8_BAR; PG8_MMA(1, 1, At, B1); PG8_BAR;
        }
        PG8_STAMP();
        if constexpr (!Epi::AFTER_DRAIN) { E(acc, cur, wr, wc, fr, fq); S.done(cur); }
        PG8_STAMP();
        if (!has_next) break;
#pragma unroll
        for (int a = 0; a < 2; ++a)
#pragma unroll
            for (int b = 0; b < 2; ++b)
#pragma unroll
                for (int m = 0; m < 4; ++m)
#pragma unroll
                    for (int n = 0; n < 2; ++n) acc[a][b][m][n] = (f32x4){0.f, 0.f, 0.f, 0.f};
        cur = nxt; cA = nA; cB = nB; ++ui;
    }
    PG8_WAIT_V(0);
    if (wr == 0) PG8_BAR;
    PG8_BAR;
    if constexpr (Epi::AFTER_DRAIN) { E.fused(acc, cur, wr, wc, fr, fq, lds, wid, lane); S.done(cur); }
    PG8_STAMP();
    if (STAMP && wid == 0) { stamps[lane] = lane < nts ? (((unsigned long long)(unsigned)ts_hi << 32) | (unsigned)ts_lo) : 0ull;
        if (lane == 62) stamps[62] = rt_entry; if (lane == 63) stamps[63] = (unsigned long long)wall_clock64(); }
#undef PG8_STAMP
#undef PG8_SA
#undef PG8_SB
#undef PG8_STAGE
#undef PG8_LDA
#undef PG8_LDB
#undef PG8_MMA
#undef PG8_WAIT_V
#undef PG8_WAIT_L
#undef PG8_BAR
#undef PG8_SCHED
}
}

struct EpiQK {
    static constexpr bool PERM = true, AFTER_DRAIN = false;
    u16* O; int ldc;
    __device__ __forceinline__ void operator()(const pg8::f32x4 (&acc)[2][2][4][2], const pg8::Unit& u, int wr, int wc, int fr, int fq) const {
        const int colt = u.pn * 256, g = colt >> 11, col0 = g * 3072 + (colt & 2047) + wc * 32 + 8 * fq, row0 = u.pm * 256 + wr * 64 + fr;
#pragma unroll
        for (int ai = 0; ai < 2; ++ai)
#pragma unroll
            for (int m = 0; m < 4; ++m) { u16* rowp = O + (size_t)(row0 + ai * 128 + m * 16) * ldc + col0;
#pragma unroll
                for (int bj = 0; bj < 2; ++bj) { const pg8::f32x4 v0 = acc[ai][bj][m][0], v1 = acc[ai][bj][m][1];
                    u32x4 w; w[0] = cvtpk(v0[0], v0[1]); w[1] = cvtpk(v0[2], v0[3]); w[2] = cvtpk(v1[0], v1[1]); w[3] = cvtpk(v1[2], v1[3]);
                    *(u32x4*)(rowp + bj * 128) = w; } }
    }
};
struct EpiV {
    static constexpr bool PERM = false, AFTER_DRAIN = false;
    u16* VT; int layer;
    __device__ __forceinline__ void operator()(const pg8::f32x4 (&acc)[2][2][4][2], const pg8::Unit& u, int wr, int wc, int fr, int fq) const {
        const int colt = u.pn * 256, grp = colt >> 10;
        const int dil = (layer == 0 || grp == 0) ? 1 : (grp == 1 ? 4 : 16);
        const int rowb = u.pm * 256 + wr * 64 + 4 * fq;
#pragma unroll
        for (int bj = 0; bj < 2; ++bj)
#pragma unroll
            for (int n = 0; n < 2; ++n) {
                const int c = (colt & 1023) + bj * 128 + wc * 32 + n * 16 + fr, h = c >> 6, d = c & 63;
#pragma unroll
                for (int ai = 0; ai < 2; ++ai)
#pragma unroll
                    for (int m = 0; m < 4; ++m) {
                        const int r0 = rowb + ai * 128 + m * 16, b = r0 >> 13, t0 = r0 & (SEQ - 1);
                        u16* vrow = VT + (size_t)grp * T * D + ((size_t)(b * NH + h) * HD + d) * SEQ;
                        const pg8::f32x4 v = acc[ai][bj][m][n];
                        if (dil == 1) { u32x2 w; w[0] = cvtpk(v[0], v[1]); w[1] = cvtpk(v[2], v[3]); *(u32x2*)(vrow + t0) = w; }
                        else {
#pragma unroll
                            for (int i = 0; i < 4; ++i) { const int pp = t0 + i; vrow[(pp % dil) * (SEQ / dil) + pp / dil] = (u16)cvtpk(v[i], 0.f); }
                        }
                    }
            }
    }
};
struct EpiWo {
    static constexpr bool PERM = false, AFTER_DRAIN = false;
    float* Y; const float* X;
    __device__ __forceinline__ void operator()(const pg8::f32x4 (&acc)[2][2][4][2], const pg8::Unit& u, int wr, int wc, int fr, int fq) const {
        const int row0 = u.pm * 256 + wr * 64 + fr, col0 = u.pn * 256 + wc * 32 + 4 * fq;
#pragma unroll
        for (int ai = 0; ai < 2; ++ai)
#pragma unroll
            for (int m = 0; m < 4; ++m) { const size_t ro = (size_t)(row0 + ai * 128 + m * 16) * D + col0;
#pragma unroll
                for (int bj = 0; bj < 2; ++bj)
#pragma unroll
                    for (int n = 0; n < 2; ++n) { const pg8::f32x4 x = *(const pg8::f32x4*)(X + ro + bj * 128 + n * 16); *(pg8::f32x4*)(Y + ro + bj * 128 + n * 16) = x * DN_ALPHA + acc[ai][bj][m][n]; } }
    }
};
struct EpiSGU {
    static constexpr bool PERM = true, AFTER_DRAIN = false;
    u16* H;
    __device__ __forceinline__ void operator()(const pg8::f32x4 (&acc)[2][2][4][2], const pg8::Unit& u, int wr, int wc, int fr, int fq) const {
        const int row0 = u.pm * 256 + wr * 64 + fr, f0 = u.pn * 128 + wc * 32 + 8 * fq;
#pragma unroll
        for (int ai = 0; ai < 2; ++ai)
#pragma unroll
            for (int m = 0; m < 4; ++m) {
                float hv[8];
#pragma unroll
                for (int n = 0; n < 2; ++n)
#pragma unroll
                    for (int i = 0; i < 4; ++i) { const float gt = acc[ai][0][m][n][i], up = acc[ai][1][m][n][i]; hv[n * 4 + i] = gt / (1.f + __expf(-gt)) * up; }
                u32x4 w; w[0] = cvtpk(hv[0], hv[1]); w[1] = cvtpk(hv[2], hv[3]); w[2] = cvtpk(hv[4], hv[5]); w[3] = cvtpk(hv[6], hv[7]);
                *(u32x4*)(H + (size_t)(A_TOT + row0 + ai * 128 + m * 16) * DF + f0) = w;
            }
    }
};
struct EpiSD {
    static constexpr bool PERM = true, AFTER_DRAIN = false;
    u16* Y;
    __device__ __forceinline__ void operator()(const pg8::f32x4 (&acc)[2][2][4][2], const pg8::Unit& u, int wr, int wc, int fr, int fq) const {
        const int row0 = u.pm * 256 + wr * 64 + fr, col0 = u.pn * 256 + wc * 32 + 8 * fq;
#pragma unroll
        for (int ai = 0; ai < 2; ++ai)
#pragma unroll
            for (int m = 0; m < 4; ++m) { u16* rowp = Y + (size_t)(A_TOT + row0 + ai * 128 + m * 16) * D + col0;
#pragma unroll
                for (int bj = 0; bj < 2; ++bj) { const pg8::f32x4 v0 = acc[ai][bj][m][0], v1 = acc[ai][bj][m][1];
                    u32x4 w; w[0] = cvtpk(v0[0], v0[1]); w[1] = cvtpk(v0[2], v0[3]); w[2] = cvtpk(v1[0], v1[1]); w[3] = cvtpk(v1[2], v1[3]);
                    *(u32x4*)(rowp + bj * 128) = w; } }
    }
};

struct Args {
    const float* in[16];
    float* out;
    unsigned char* ws;
    int ph_lo, ph_hi;
};

#define GEMM_CORE(K_, PA0, PA1, PB, LDB)                                                                                                   \
    {                                                                                                                                      \
        const int g_tid = tid, g_lane = lane, g_wave = wave, g_r32 = r32, g_hi = hi;                   \
        const int g_wm = g_wave >> 2, g_wn = g_wave & 3, g_kc = g_tid & 3, g_kq = g_lane >> 3, g_n4 = g_lane & 7;                           \
        const u16* g_pa0 = (PA0); const u16* g_pa1 = (PA1);                                                                                \
        const size_t g_ldb = (size_t)(LDB);                                                                                                \
        const float* g_pb = (PB) + (size_t)(g_kq * 4) * g_ldb + g_n4 * 4;                                                                  \
        const int g_nk = (K_) / 32;                                                                                                        \
        u32x4 g_ra0, g_ra1; f32x4 g_rb0, g_rb1, g_rb2, g_rb3;                                                                              \
        const u32x4 g_z = {0u, 0u, 0u, 0u};                                                                                                \
        _Pragma("unroll") for (int mb = 0; mb < 4; ++mb) { _Pragma("unroll") for (int nb = 0; nb < 2; ++nb) { _Pragma("unroll") for (int r = 0; r < 16; ++r) acc[mb][nb][r] = 0.f; } } \
        g_ra0 = g_pa0 ? *(const u32x4*)(g_pa0 + g_kc * 8) : g_z; g_ra1 = g_pa1 ? *(const u32x4*)(g_pa1 + g_kc * 8) : g_z;                 \
        g_rb0 = *(const f32x4*)(g_pb); g_rb1 = *(const f32x4*)(g_pb + g_ldb); g_rb2 = *(const f32x4*)(g_pb + 2 * g_ldb); g_rb3 = *(const f32x4*)(g_pb + 3 * g_ldb); \
        _Pragma("unroll 1") for (int kt = 0; kt < g_nk; ++kt) {                                                                            \
            LAS char* As = lds + (kt & 1) * STAGE_BYTES; LAS char* Bs = As + 256 * LDP * 2;                                                \
            *(LAS u32x4*)(As + ((g_tid >> 2) * LDP + g_kc * 8) * 2) = g_ra0;                                                               \
            *(LAS u32x4*)(As + (((g_tid >> 2) + 128) * LDP + g_kc * 8) * 2) = g_ra1;                                                       \
            _Pragma("unroll") for (int i = 0; i < 4; ++i) {                                                                                \
                u32x2 w; w[0] = cvtpk(g_rb0[i], g_rb1[i]); w[1] = cvtpk(g_rb2[i], g_rb3[i]);                                               \
                *(LAS u32x2*)(Bs + ((g_wave * 32 + i * 8 + g_n4) * LDP + g_kq * 4) * 2) = w;                                               \
            }                                                                                                                              \
            __syncthreads();                                                                                                               \
            if (kt + 1 < g_nk) {                                                                                                           \
                const int ko = (kt + 1) * 32;                                                                                              \
                g_ra0 = g_pa0 ? *(const u32x4*)(g_pa0 + ko + g_kc * 8) : g_z; g_ra1 = g_pa1 ? *(const u32x4*)(g_pa1 + ko + g_kc * 8) : g_z; \
                const float* pbk = g_pb + (size_t)ko * g_ldb;                                                                              \
                g_rb0 = *(const f32x4*)(pbk); g_rb1 = *(const f32x4*)(pbk + g_ldb); g_rb2 = *(const f32x4*)(pbk + 2 * g_ldb); g_rb3 = *(const f32x4*)(pbk + 3 * g_ldb); \
            }                                                                                                                              \
            _Pragma("unroll") for (int s = 0; s < 2; ++s) {                                                                                \
                bf16x8 af[4], bfr[2];                                                                                                      \
                _Pragma("unroll") for (int mb = 0; mb < 4; ++mb) af[mb] = *(LAS bf16x8*)(As + ((g_wm * 128 + mb * 32 + g_r32) * LDP + s * 16 + g_hi * 8) * 2); \
                _Pragma("unroll") for (int nb = 0; nb < 2; ++nb) bfr[nb] = *(LAS bf16x8*)(Bs + (((g_wn * 2 + nb) * 32 + g_r32) * LDP + s * 16 + g_hi * 8) * 2); \
                _Pragma("unroll") for (int mb = 0; mb < 4; ++mb) { _Pragma("unroll") for (int nb = 0; nb < 2; ++nb) acc[mb][nb] = MFMA_BF16(af[mb], bfr[nb], acc[mb][nb]); } \
            }                                                                                                                              \
        }                                                                                                                                  \
        __syncthreads();                                                                                                                   \
    }

struct AttnSt { float m, l; f32x16 o0, o1; };

struct AttnFr { bf16x8 k[4]; bf16x8 v[4]; };
__device__ __forceinline__ void attn_load(AttnFr& f, const u16* krow, const u16* vt, size_t vt_dstride) {
#pragma unroll
    for (int d0 = 0; d0 < 4; ++d0) f.k[d0] = *(const bf16x8*)(krow + d0 * 16);
    const u16* vt1 = vt + 32 * vt_dstride;
    union { bf16x8 v; u32x2 h[2]; } va;
    va.h[0] = *(const u32x2*)(vt);       va.h[1] = *(const u32x2*)(vt + 8);   f.v[0] = va.v;
    va.h[0] = *(const u32x2*)(vt + 16);  va.h[1] = *(const u32x2*)(vt + 24);  f.v[1] = va.v;
    va.h[0] = *(const u32x2*)(vt1);      va.h[1] = *(const u32x2*)(vt1 + 8);  f.v[2] = va.v;
    va.h[0] = *(const u32x2*)(vt1 + 16); va.h[1] = *(const u32x2*)(vt1 + 24); f.v[3] = va.v;
}
__device__ __forceinline__ void attn_compute(AttnSt& st, const bf16x8 (&qf)[4], const AttnFr& f, int dist0, float bslope, int dlo, int dhi, int hi) {
    f32x16 p;
#pragma unroll
    for (int r = 0; r < 16; ++r) p[r] = 0.f;
#pragma unroll
    for (int d0 = 0; d0 < 4; ++d0) p = MFMA_BF16(f.k[d0], qf[d0], p);
    constexpr float C2 = 0.125f * LOG2E;
    float mx = NEGV;
#pragma unroll
    for (int r = 0; r < 16; ++r) {
        const int dist = dist0 - ((r & 3) + 8 * (r >> 2));
        const float sc = __builtin_fmaf(p[r], C2, -bslope * (float)dist);
        const float s_ = (dist >= dlo && dist <= dhi) ? sc : NEGV;
        p[r] = s_; mx = fmaxf(mx, s_);
    }
    mx = fmaxf(mx, __shfl_xor(mx, 32));
    const float mnew = fmaxf(st.m, mx);
    const float alpha = __builtin_amdgcn_exp2f(st.m - mnew);
    st.m = mnew;
    float ls = 0.f;
#pragma unroll
    for (int r = 0; r < 16; ++r) { p[r] = __builtin_amdgcn_exp2f(p[r] - mnew); ls += p[r]; }
    st.l = st.l * alpha + ls;
#pragma unroll
    for (int r = 0; r < 16; ++r) { st.o0[r] *= alpha; st.o1[r] *= alpha; }
    union { bf16x8 v; unsigned u[4]; } pb0, pb1;
#pragma unroll
    for (int j = 0; j < 4; ++j) { pb0.u[j] = cvtpk(p[2 * j], p[2 * j + 1]); pb1.u[j] = cvtpk(p[8 + 2 * j], p[8 + 2 * j + 1]); }
    st.o0 = MFMA_BF16(f.v[0], pb0.v, st.o0);
    st.o0 = MFMA_BF16(f.v[1], pb1.v, st.o0);
    st.o1 = MFMA_BF16(f.v[2], pb0.v, st.o1);
    st.o1 = MFMA_BF16(f.v[3], pb1.v, st.o1);
    (void)hi;
}

__device__ __forceinline__ void top3_insert(float v, int i, float& v0, int& i0, float& v1, int& i1, float& v2, int& i2) {
    const bool b0 = (v > v0) || (v == v0 && i < i0);
    const bool b1 = (v > v1) || (v == v1 && i < i1);
    const bool b2 = (v > v2) || (v == v2 && i < i2);
    const float nv2 = b1 ? v1 : (b2 ? v : v2); const int ni2 = b1 ? i1 : (b2 ? i : i2);
    const float nv1 = b0 ? v0 : (b1 ? v : v1); const int ni1 = b0 ? i0 : (b1 ? i : i1);
    const float nv0 = b0 ? v : v0;             const int ni0 = b0 ? i : i0;
    v0 = nv0; i0 = ni0; v1 = nv1; i1 = ni1; v2 = nv2; i2 = ni2;
}

__device__ __forceinline__ void ln_row(float (&v)[16], const float* __restrict__ g, const float* __restrict__ b, int lane) {
    float s = 0.f;
#pragma unroll
    for (int i = 0; i < 16; ++i) s += v[i];
    const float mu = wave_sum(s) * (1.f / D);
    float q = 0.f;
#pragma unroll
    for (int i = 0; i < 16; ++i) { const float d = v[i] - mu; q += d * d; }
    const float rstd = rsqrtf(wave_sum(q) * (1.f / D) + LN_EPS);
#pragma unroll
    for (int j = 0; j < 4; ++j) {
        const f32x4 gg = *(const f32x4*)(g + j * 256 + lane * 4), bb = *(const f32x4*)(b + j * 256 + lane * 4);
#pragma unroll
        for (int c = 0; c < 4; ++c) v[j * 4 + c] = (v[j * 4 + c] - mu) * rstd * gg[c] + bb[c];
    }
}

constexpr int MOE_BP = 72;
constexpr int MOE_BSTAGE = 128 * MOE_BP * 2;
constexpr int MOE_LDS_VA = 3 * MOE_BSTAGE;
constexpr int MOE_LDS_W = MOE_LDS_VA + 4096;
template <bool DOWN>
__device__ __forceinline__ void moe_expert(LAS char* lds, const int tid, const int lane, const int wave, const int r32, const int hi,
                                           const u16* __restrict__ abase, const float* __restrict__ w0, const float* __restrict__ w1, const int ng  , u16* __restrict__ outp) {
    constexpr int KT = DOWN ? 4 : 16, NP = DOWN ? 8 : 4, LDB = DOWN ? 1024 : 256, APITCH = DOWN ? 256 : 1024, PSTEP = DOWN ? 128 : 64;
    LAS int* rowva = (LAS int*)(lds + MOE_LDS_VA); LAS float* roww = (LAS float*)(lds + MOE_LDS_W);
    const int nst = (ng + 511) >> 9;
    const int nsteps = NP * nst * KT;
    unsigned aoff[2];
#define MOE_AOFF(ST_) { _Pragma("unroll") for (int a = 0; a < 2; ++a) { const int va_ = rowva[(ST_) * 512 + wave * 64 + a * 32 + r32]; \
        const int srow_ = DOWN ? va_ : (va_ == TRASH_VA ? 0 : (va_ >> 3)); aoff[a] = (unsigned)srow_ * (APITCH * 2) + hi * 64; } }
    const int seg = wave >> 1, n4 = lane & 7, kp = (wave & 1) * 16 + (lane >> 3);
    const char* wbase = (const char*)(DOWN ? (w0 + seg * 32) : (((seg < 2) ? w0 : w1) + (seg & 1) * 32));
    const unsigned boff = (unsigned)(4 * n4 + 2 * kp * LDB) * 4u;
    f32x16 acc[2][4];
#pragma unroll
    for (int a = 0; a < 2; ++a)
#pragma unroll
        for (int c = 0; c < 4; ++c)
#pragma unroll
            for (int r = 0; r < 16; ++r) acc[a][c][r] = 0.f;
    bf16x8 fa[2][4];
    f32x4 rb0[4], rb1[4];
#define MOE_DEC(S_) const int s2_ = (S_) < nsteps ? (S_) : 0; const int ps_ = s2_ / (nst * KT); const int rm_ = s2_ - ps_ * (nst * KT); const int stt_ = rm_ / KT; const int kt_ = rm_ - stt_ * KT;
#define MOE_LOADB(S_, RB) { MOE_DEC(S_) (void)stt_; \
        const char* wp_ = wbase + (size_t)(ps_ * PSTEP + kt_ * 64 * LDB) * 4 + boff; \
        RB[0] = *(const f32x4*)(wp_); RB[1] = *(const f32x4*)(wp_ + LDB * 4); RB[2] = *(const f32x4*)(wp_ + 16 * LDB * 4); RB[3] = *(const f32x4*)(wp_ + 17 * LDB * 4); }
#define MOE_WRITEB(STG, RB) { LAS char* Bs_ = lds + (STG) * MOE_BSTAGE; \
        _Pragma("unroll") for (int i = 0; i < 4; ++i) { LAS unsigned* q_ = (LAS unsigned*)(Bs_ + ((seg * 32 + i * 8 + n4) * MOE_BP + 2 * kp) * 2); q_[0] = cvtpk(RB[0][i], RB[1][i]); q_[8] = cvtpk(RB[2][i], RB[3][i]); } }
#define MOE_COMPUTE(STG, DO_MFMA) { LAS char* Bs_ = lds + (STG) * MOE_BSTAGE; \
        _Pragma("unroll") for (int u = 0; u < 4; ++u) { \
            bf16x8 bfr[4]; \
            if (DO_MFMA) { _Pragma("unroll") for (int c = 0; c < 4; ++c) bfr[c] = *(LAS bf16x8*)(Bs_ + ((c * 32 + r32) * MOE_BP + hi * 32 + u * 8) * 2); } \
            _Pragma("unroll") for (int a = 0; a < 2; ++a) { \
                if (DO_MFMA) { _Pragma("unroll") for (int c = 0; c < 4; ++c) acc[a][c] = MFMA_BF16(bfr[c], fa[a][u], acc[a][c]); } \
                fa[a][u] = *(const bf16x8*)(ab_n + aoff[a] + u * 16); \
            } \
        } }
#define MOE_NEXTA(S_) MOE_DEC(S_) (void)ps_; \
        if (stt_ != st_loaded) { MOE_AOFF(stt_) st_loaded = stt_; } \
        const char* ab_n = (const char*)abase + kt_ * 128;
    int st_loaded = 0;
    MOE_AOFF(0)
    { const char* ab0 = (const char*)abase;
#pragma unroll
      for (int a = 0; a < 2; ++a)
#pragma unroll
          for (int u = 0; u < 4; ++u) fa[a][u] = *(const bf16x8*)(ab0 + aoff[a] + u * 16); }
    MOE_LOADB(0, rb0)
    MOE_LOADB(1, rb1)
    MOE_WRITEB(0, rb0)
    MOE_LOADB(2, rb0)
    int stg = 0;
#pragma unroll 1
    for (int sidx = 0; sidx < nsteps; sidx += 2) {
        const int ps = sidx / (nst * KT); const int rm = sidx - ps * (nst * KT); const int stt = rm / KT; const int kt = rm - stt * KT;
        const bool wv = (wave * 64) < (ng - stt * 512);
        const int stg1 = stg == 2 ? 0 : stg + 1, stg2 = stg1 == 2 ? 0 : stg1 + 1;
        __syncthreads();
        MOE_WRITEB(stg1, rb1)
        MOE_LOADB(sidx + 3, rb1)
        { MOE_NEXTA(sidx + 1)
          if (wv) MOE_COMPUTE(stg, true) else MOE_COMPUTE(stg, false) }
        __syncthreads();
        MOE_WRITEB(stg2, rb0)
        MOE_LOADB(sidx + 4, rb0)
        { MOE_NEXTA(sidx + 2)
          if (wv) MOE_COMPUTE(stg1, true) else MOE_COMPUTE(stg1, false) }
        stg = stg2;
        if (kt == KT - 2) {
            if (wv) {
                const int nrows = ng - stt * 512;
#pragma unroll
                for (int a = 0; a < 2; ++a) {
                    if (a == 0 || (wave * 64 + 32) < nrows) {
                        const int lrow = stt * 512 + wave * 64 + a * 32 + r32;
                        const unsigned va = (unsigned)rowva[lrow];
                        if (DOWN) {
                            const float w = roww[lrow];
#pragma unroll
                            for (int c = 0; c < 4; ++c) {
                                u32x4 q0, q1;
#pragma unroll
                                for (int jj = 0; jj < 4; ++jj) {
                                    const int j0 = 2 * jj, j1 = 2 * jj + 1, j2 = 8 + 2 * jj, j3 = 9 + 2 * jj;
                                    q0[jj] = cvtpk(acc[a][c][(j0 >> 2) + 4 * (j0 & 3)] * w, acc[a][c][(j1 >> 2) + 4 * (j1 & 3)] * w);
                                    q1[jj] = cvtpk(acc[a][c][(j2 >> 2) + 4 * (j2 & 3)] * w, acc[a][c][(j3 >> 2) + 4 * (j3 & 3)] * w);
                                }
                                u16* o = outp + (size_t)va * D + ps * 128 + c * 32 + 16 * hi;
                                *(u32x4*)o = q0; *(u32x4*)(o + 8) = q1;
                            }
                        } else {
#pragma unroll
                            for (int c = 0; c < 2; ++c) {
                                float hv[16];
#pragma unroll
                                for (int j = 0; j < 16; ++j) { const int r = (j >> 2) + 4 * (j & 3); const float gt = acc[a][c][r], up = acc[a][c + 2][r]; hv[j] = gt / (1.f + __expf(-gt)) * up; }
                                u32x4 q0, q1;
#pragma unroll
                                for (int jj = 0; jj < 4; ++jj) { q0[jj] = cvtpk(hv[2 * jj], hv[2 * jj + 1]); q1[jj] = cvtpk(hv[8 + 2 * jj], hv[9 + 2 * jj]); }
                                u16* o = outp + (size_t)va * DF + ps * 64 + c * 32 + 16 * hi;
                                *(u32x4*)o = q0; *(u32x4*)(o + 8) = q1;
                            }
                        }
                    }
                }
#pragma unroll
                for (int a = 0; a < 2; ++a)
#pragma unroll
                    for (int c = 0; c < 4; ++c)
#pragma unroll
                        for (int r = 0; r < 16; ++r) acc[a][c][r] = 0.f;
            }
        }
    }
    __syncthreads();
#undef MOE_AOFF
#undef MOE_DEC
#undef MOE_LOADB
#undef MOE_WRITEB
#undef MOE_COMPUTE
#undef MOE_NEXTA
}

constexpr int N_PHASES = 21;

#define P_x_in CTX_IN(0)
#define P_xb ((u16*)(ws + WS_XB))
#define P_x1 ((float*)(ws + WS_X1))
#define P_x2 ((float*)(ws + WS_X2))
#define P_ypre ((float*)(ws + WS_YPRE))
#define P_qkv ((u16*)(ws + WS_QKV))
#define P_vT ((u16*)(ws + WS_VT))
#define P_kmean ((float*)(ws + WS_KM))
#define P_ao ((u16*)(ws + WS_AO))
#define P_og ((u16*)(ws + WS_OG))
#define P_lse ((float*)(ws + WS_LSE))
#define P_topw ((float*)(ws + WS_TOPW))
#define P_list ((int*)(ws + WS_LIST))
#define P_hb ((u16*)(ws + WS_HB))
#define P_yb ((u16*)(ws + WS_YB))
#define P_cnt_all ((int*)(ws + WS_CTL + CTL_CNT_OFF))
#define P_selm ((unsigned*)(ws + WS_SELM))
#define P_part ((u16*)(ws + WS_PART))
#define P_plse ((float*)(ws + WS_PLSE))
#define PH_BEGIN int tid = threadIdx.x; asm volatile("" : "+v"(tid)); const int lane = tid & 63, r32 = lane & 31, hi = lane >> 5; const int wave = __builtin_amdgcn_readfirstlane(tid >> 6); (void)lane; (void)r32; (void)hi; (void)wave
constexpr int LDS_CTX = LDS_BAR + 16;
__device__ __forceinline__ uint64_t ctx_ld(int i) {
    extern __shared__ __attribute__((aligned(16))) unsigned char lds_raw[];
    const LAS unsigned* q = (const LAS unsigned*)((LAS char*)lds_raw + LDS_CTX) + 2 * i;
    const unsigned lo = __builtin_amdgcn_readfirstlane(q[0]), hi = __builtin_amdgcn_readfirstlane(q[1]);
    return ((uint64_t)hi << 32) | lo;
}
typedef __attribute__((address_space(1))) unsigned char gbyte;
#define AS_GLOBAL(T, u64v) ((T*)(gbyte*)(u64v))
#define CTX_IN(i) AS_GLOBAL(const float, ctx_ld(i))
#define PH_FN_BEGIN \
    extern __shared__ __attribute__((aligned(16))) unsigned char lds_raw[]; \
    LAS char* lds = (LAS char*)lds_raw; (void)lds; \
    const int G = gridDim.x, bid = blockIdx.x; (void)G; (void)bid; \
    unsigned char* const ws = AS_GLOBAL(unsigned char, ctx_ld(17)); (void)ws; \
    const int NQ = L == 0 ? 3072 : 9216; (void)NQ; \
    int* cnt = P_cnt_all + L * NE; (void)cnt;
__device__ __forceinline__ void ph_p0(int L, int rep_) {
    PH_FN_BEGIN
    (void)rep_;
    PH_BEGIN;
    for (size_t i = (size_t)bid * NTHR + tid; i < (size_t)T * D / 4; i += (size_t)G * NTHR) {
        const f32x4 v = *(const f32x4*)(P_x_in + i * 4);
        u32x2 w; w[0] = cvtpk(v[0], v[1]); w[1] = cvtpk(v[2], v[3]);
        *(u32x2*)(P_xb + i * 4) = w;
    }
    LAS float* tl = (LAS float*)lds;
    for (int it = bid; it < 3968 + 128; it += G) {
        int seg, kt;
        if (it < 3840) { seg = it >> 4; kt = it & 15; } else if (it < 3968) { seg = 240 + ((it - 3840) >> 2); kt = (it - 3840) & 3; } else { seg = 272 + ((it - 3968) >> 4); kt = (it - 3968) & 15; }
        const float* src; int ld; u16* dst; int Kd = 1024; u16* dst_lo = nullptr;
        if (seg < 48) { const int col = 64 * seg; src = CTX_IN(1) + col; ld = 3072; dst = col < 2048 ? (u16*)(ws + WS_WQK0) + (size_t)col * 1024 : (u16*)(ws + WS_WV0) + (size_t)(col - 2048) * 1024; }
        else if (seg < 192) { const int col = 64 * (seg - 48), g = col / 3072, w = col - g * 3072; src = CTX_IN(2) + col; ld = 9216;
            dst = w < 2048 ? (u16*)(ws + WS_WQK1) + (size_t)(g * 2048 + w) * 1024 : (u16*)(ws + WS_WV1) + (size_t)(g * 1024 + w - 2048) * 1024; }
        else if (seg < 224) { const int s2 = seg - 192, l2 = s2 >> 4, col = 64 * (s2 & 15); src = CTX_IN(3) + (size_t)l2 * D * D + col; ld = 1024; dst = (u16*)(ws + WS_WO) + (size_t)l2 * D * D + (size_t)col * 1024; }
        else if (seg < 240) { const int s2 = seg - 224, l2 = s2 >> 3, i8 = s2 & 7, un = i8 >> 2, q = i8 & 3;
            src = (q < 2 ? CTX_IN(11) : CTX_IN(12)) + (size_t)l2 * D * DF + un * 128 + 64 * (q & 1); ld = 256; dst = (u16*)(ws + WS_WSGU) + (size_t)l2 * 512 * 1024 + (size_t)(64 * i8) * 1024; }
        else if (seg < 272) { const int s2 = seg - 240, l2 = s2 >> 4, col = 64 * (s2 & 15); src = CTX_IN(13) + (size_t)l2 * DF * D + col; ld = 1024; Kd = 256; dst = (u16*)(ws + WS_WSD) + (size_t)l2 * D * DF + (size_t)col * 256; }
        else { const int s2 = seg - 272, l2 = s2 >> 2, col = 64 * (s2 & 3); src = CTX_IN(6) + (size_t)l2 * D * NE + col; ld = 256; dst = (u16*)(ws + WS_WRH) + (size_t)l2 * NE * D + (size_t)col * 1024; dst_lo = (u16*)(ws + WS_WRL) + (size_t)l2 * NE * D + (size_t)col * 1024; }
        {
            const int kr = tid >> 4, c4 = tid & 15;
#pragma unroll
            for (int i = 0; i < 2; ++i) {
                const f32x4 v = *(const f32x4*)(src + (size_t)(kt * 64 + kr + 32 * i) * ld + 4 * c4);
#pragma unroll
                for (int jj = 0; jj < 4; ++jj) tl[(kr + 32 * i) * 65 + 4 * c4 + jj] = v[jj];
            }
        }
        __syncthreads();
        {
            const int row = tid >> 3, kc = tid & 7;
            float f[8];
#pragma unroll
            for (int jj = 0; jj < 8; ++jj) f[jj] = tl[(8 * kc + jj) * 65 + row];
            u32x4 w; w[0] = cvtpk(f[0], f[1]); w[1] = cvtpk(f[2], f[3]); w[2] = cvtpk(f[4], f[5]); w[3] = cvtpk(f[6], f[7]);
            *(u32x4*)(dst + (size_t)row * Kd + kt * 64 + 8 * kc) = w;
            if (dst_lo) {
                u32x4 wl;
#pragma unroll
                for (int jj = 0; jj < 4; ++jj) wl[jj] = cvtpk(f[2 * jj] - bf2f(w[jj] & 0xFFFFu), f[2 * jj + 1] - bf2f(w[jj] >> 16));
                *(u32x4*)(dst_lo + (size_t)row * Kd + kt * 64 + 8 * kc) = wl;
            }
        }
        __syncthreads();
    }
}

__device__ __forceinline__ void ph_qkv(int L, int rep_) {
    PH_FN_BEGIN
    (void)rep_;
    {
        const pg8::Gemm g{P_xb, (const u16*)(ws + (L == 0 ? WS_WQK0 : WS_WQK1)), T, L == 0 ? 2048 : 6144, D};
        pg8::StaticOrder S; S.init(g.M, g.N, G, bid);
        const EpiQK E{P_qkv, NQ};
        pg8::gemm_phase<EpiQK, pg8::StaticOrder, false>((PG8_LAS unsigned char*)lds, g, S, E, nullptr);
    }
    {
        const pg8::Gemm g{P_xb, (const u16*)(ws + (L == 0 ? WS_WV0 : WS_WV1)), T, L == 0 ? 1024 : 3072, D};
        pg8::StaticOrder S; S.init(g.M, g.N, G, bid);
        const EpiV E{P_vT, L};
        pg8::gemm_phase<EpiV, pg8::StaticOrder, true>((PG8_LAS unsigned char*)lds, g, S, E, nullptr);
    }
}

__device__ __forceinline__ void ph_kmean(int L, int rep_) {
    PH_FN_BEGIN
    (void)rep_;

            PH_BEGIN;
                LAS float* red = (LAS float*)lds;
                for (int it = bid; it < BATCH * NH * MOBA_NB; it += G) {
                    const int j = it & 31, h = (it >> 5) & 15, b = it >> 9;
                    const int d = tid & 63, part = tid >> 6;
                    const u16* kp = P_qkv + (size_t)(b * SEQ + j * MOBA_BLK + part * 32) * 3072 + 1024 + h * 64 + d;
                    float s = 0.f;
                    for (int k = 0; k < 32; ++k) s += bf2f(kp[(size_t)k * 3072]);
                    red[part * 64 + d] = s;
                    __syncthreads();
                    if (tid < 64) {
                        float tot = 0.f;
#pragma unroll
                        for (int p8 = 0; p8 < 8; ++p8) tot += red[p8 * 64 + tid];
                        P_kmean[(size_t)it * 64 + tid] = tot * (1.f / MOBA_BLK);
                    }
                    __syncthreads();
                }

}

__device__ __forceinline__ void ph_gate(int L, int rep_) {
    PH_FN_BEGIN
    (void)rep_;
    PH_BEGIN;
    for (int it = bid; it < BATCH * NH * MOBA_NB; it += G) {
        const int qb = it & 31, bh = it >> 5, b = bh >> 4, h = bh & 15;
        const int tq = qb * MOBA_BLK + wave * 32 + r32;
        const u16* qrow = P_qkv + (size_t)(b * SEQ + tq) * 3072 + h * 64 + hi * 8;
        bf16x8 qf[4];
#pragma unroll
        for (int d0 = 0; d0 < 4; ++d0) qf[d0] = *(const bf16x8*)(qrow + d0 * 16);
        unsigned selmask = 0u;
        if (qb > 0) {
            const float* km = P_kmean + ((size_t)(b * NH + h) * MOBA_NB + r32) * 64 + hi * 8;
            f32x16 gt;
#pragma unroll
            for (int r = 0; r < 16; ++r) gt[r] = 0.f;
#pragma unroll
            for (int d0 = 0; d0 < 4; ++d0) {
                const f32x4 k0 = *(const f32x4*)(km + d0 * 16), k1 = *(const f32x4*)(km + d0 * 16 + 4);
                union { bf16x8 v; unsigned u[4]; } kf;
                kf.u[0] = cvtpk(k0[0], k0[1]); kf.u[1] = cvtpk(k0[2], k0[3]); kf.u[2] = cvtpk(k1[0], k1[1]); kf.u[3] = cvtpk(k1[2], k1[3]);
                gt = MFMA_BF16(kf.v, qf[d0], gt);
            }
            float v0 = -INFINITY, v1 = -INFINITY, v2 = -INFINITY; int i0 = 99, i1 = 99, i2 = 99;
#pragma unroll
            for (int r = 0; r < 16; ++r) { const int jb = crow(r, hi); const float gv = jb < qb ? gt[r] : -INFINITY; top3_insert(gv, jb < qb ? jb : 99, v0, i0, v1, i1, v2, i2); }
            const float ov0 = __shfl_xor(v0, 32), ov1 = __shfl_xor(v1, 32), ov2 = __shfl_xor(v2, 32);
            const int oi0 = __shfl_xor(i0, 32), oi1 = __shfl_xor(i1, 32), oi2 = __shfl_xor(i2, 32);
            top3_insert(ov0, oi0, v0, i0, v1, i1, v2, i2); top3_insert(ov1, oi1, v0, i0, v1, i1, v2, i2); top3_insert(ov2, oi2, v0, i0, v1, i1, v2, i2);
            if (i0 < 32) selmask |= 1u << i0;
            if (i1 < 32) selmask |= 1u << i1;
            if (i2 < 32) selmask |= 1u << i2;
        }
        if (hi == 0) P_selm[(size_t)bh * SEQ + tq] = selmask;
    }
}

constexpr int MB_KP = 72;
constexpr int MB_VP = 260;
constexpr int MB_LDS_K = 0;
constexpr int MB_LDS_V = 256 * MB_KP * 2;
constexpr int MB_LDS_LIST = MB_LDS_V + 64 * MB_VP * 2;
constexpr int MB_LDS_CTR = MB_LDS_LIST + 8192 * 2;
__device__ __forceinline__ void ph_moba(int L, int rep_) {
    PH_FN_BEGIN
    (void)rep_;
    PH_BEGIN;
    LAS char* Ks = lds + MB_LDS_K; LAS char* Vs = lds + MB_LDS_V;
    LAS u16* qlist = (LAS u16*)(lds + MB_LDS_LIST); LAS int* ctr = (LAS int*)(lds + MB_LDS_CTR);
    for (int it = bid; it < BATCH * NH * MOBA_NB; it += G) {
        const int rnd = it >> 8, w8 = it & 255, a8 = w8 >> 5, bh = w8 & 31;
        const int j = rnd == 0 ? a8 : (rnd == 1 ? 15 - a8 : (rnd == 2 ? 16 + a8 : 31 - a8));
        const int b = bh >> 4, h = bh & 15;
        const float slope2 = exp2f(-0.5f * (float)(h + 1)) * LOG2E;
        if (tid == 0) { int z0 = 0; asm volatile("" : "+v"(z0)); ctr[0] = z0; ctr[1] = z0; }
        {
            const u16* kg = P_qkv + (size_t)(b * SEQ + j * MOBA_BLK) * 3072 + 1024 + h * 64;
#pragma unroll
            for (int i = 0; i < 4; ++i) { const int c = tid + i * 512, row = c >> 3, ch = c & 7; *(LAS u32x4*)(Ks + (row * MB_KP + ch * 8) * 2) = *(const u32x4*)(kg + (size_t)row * 3072 + ch * 8); }
            const u16* vg = P_vT + (size_t)(b * NH + h) * HD * SEQ + j * MOBA_BLK;
#pragma unroll
            for (int i = 0; i < 4; ++i) {
                const int c = tid + i * 512, d = c >> 5, ch = c & 31;
                const u32x4 v = *(const u32x4*)(vg + (size_t)d * SEQ + ch * 8);
                u32x2 w0, w1; w0[0] = v[0]; w0[1] = v[1]; w1[0] = v[2]; w1[1] = v[3];
                *(LAS u32x2*)(Vs + (d * MB_VP + ch * 8) * 2) = w0; *(LAS u32x2*)(Vs + (d * MB_VP + ch * 8 + 4) * 2) = w1;
            }
        }
        __syncthreads();
        {
            const unsigned* sm = P_selm + (size_t)bh * SEQ;
            for (int t0 = (j + 1) * MOBA_BLK; t0 < SEQ; t0 += 512) {
                const int t = t0 + tid;
                const bool sel = (t < SEQ) && ((sm[t < SEQ ? t : 0] >> j) & 1u);
                const unsigned long long bal = __ballot(sel);
                const int total = __popcll(bal);
                int wb = 0;
                if (lane == 0 && total) wb = atomicAdd((int*)&ctr[0], total);
                wb = __shfl(wb, 0);
                if (sel) qlist[wb + __popcll(bal & ((1ull << lane) - 1ull))] = (u16)t;
            }
        }
        __syncthreads();
        const int nq = ctr[0];
        const int ntiles = 8 + ((nq + 31) >> 5);
        for (;;) {
            int ti = 0;
            if (lane == 0) ti = atomicAdd((int*)&ctr[1], 1);
            ti = __shfl(ti, 0);
            if (ti >= ntiles) break;
            const bool own = ti < 8;
            const int wq = 7 - ti;
            const int li = (ti - 8) * 32 + r32;
            const bool valid = own || li < nq;
            const int tq = own ? j * MOBA_BLK + wq * 32 + r32 : (int)qlist[li < nq ? li : nq - 1];
            const int nsteps = own ? wq + 1 : 8;
            const u16* qrow = P_qkv + (size_t)(b * SEQ + tq) * 3072 + h * 64 + hi * 8;
            bf16x8 qf[4];
#pragma unroll
            for (int d0 = 0; d0 < 4; ++d0) qf[d0] = *(const bf16x8*)(qrow + d0 * 16);
            int slot = 3;
            if (!own) slot = __popc(P_selm[(size_t)bh * SEQ + tq] & ((1u << j) - 1u));
            AttnSt st; st.m = NEGV; st.l = 0.f;
#pragma unroll
            for (int r = 0; r < 16; ++r) { st.o0[r] = 0.f; st.o1[r] = 0.f; }
            const int dlo = own ? 0 : -0x40000000;
            for (int kt = 0; kt < nsteps; ++kt) {
                AttnFr f;
#pragma unroll
                for (int d0 = 0; d0 < 4; ++d0) f.k[d0] = *(LAS bf16x8*)(Ks + ((kt * 32 + r32) * MB_KP + d0 * 16 + hi * 8) * 2);
#pragma unroll
                for (int q4 = 0; q4 < 4; ++q4) {
                    union { bf16x8 v; u32x2 hh[2]; } va;
                    LAS char* vp = Vs + (((q4 >> 1) * 32 + r32) * MB_VP + kt * 32 + (q4 & 1) * 16 + 4 * hi) * 2;
                    va.hh[0] = *(LAS u32x2*)(vp); va.hh[1] = *(LAS u32x2*)(vp + 16);
                    f.v[q4] = va.v;
                }
                attn_compute(st, qf, f, tq - (j * MOBA_BLK + kt * 32) - 4 * hi, slope2, dlo, 0x7fffffff, hi);
            }
            const float lt = st.l + __shfl_xor(st.l, 32);
            const float inv = 1.f / lt;
            if (valid) {
                const size_t pi = ((size_t)(b * SEQ + tq) * NH + h) * 4 + slot;
                u16* orow = P_part + pi * 64;
#pragma unroll
                for (int rq = 0; rq < 4; ++rq) {
                    u32x2 w; w[0] = cvtpk(st.o0[4 * rq] * inv, st.o0[4 * rq + 1] * inv); w[1] = cvtpk(st.o0[4 * rq + 2] * inv, st.o0[4 * rq + 3] * inv);
                    *(u32x2*)(orow + 8 * rq + 4 * hi) = w;
                    w[0] = cvtpk(st.o1[4 * rq] * inv, st.o1[4 * rq + 1] * inv); w[1] = cvtpk(st.o1[4 * rq + 2] * inv, st.o1[4 * rq + 3] * inv);
                    *(u32x2*)(orow + 32 + 8 * rq + 4 * hi) = w;
                }
                if (hi == 0) P_plse[pi] = st.m * LN2 + logf(lt);
            }
        }
        __syncthreads();
    }
}

__device__ __forceinline__ void ph_mobamerge(int L, int rep_) {
    PH_FN_BEGIN
    (void)rep_;
    PH_BEGIN;
    for (size_t i = (size_t)bid * NTHR + tid; i < (size_t)T * NH * 8; i += (size_t)G * NTHR) {
        const size_t row = i >> 7; const int h = (int)(i >> 3) & 15, d8 = (int)i & 7;
        const int qb = (int)(row & (SEQ - 1)) >> 8;
        const int nsel = qb < 3 ? qb : 3;
        const size_t pi = (row * NH + h) * 4;
        float l[4], w[4];
        float mx = -INFINITY;
#pragma unroll
        for (int sidx = 0; sidx < 4; ++sidx) { const bool ok = sidx == 3 || sidx < nsel; l[sidx] = ok ? P_plse[pi + sidx] : -INFINITY; mx = fmaxf(mx, l[sidx]); }
        float ws_ = 0.f;
#pragma unroll
        for (int sidx = 0; sidx < 4; ++sidx) { w[sidx] = (sidx == 3 || sidx < nsel) ? expf(l[sidx] - mx) : 0.f; ws_ += w[sidx]; }
        const float inv = 1.f / ws_;
        float acc8[8];
#pragma unroll
        for (int c = 0; c < 8; ++c) acc8[c] = 0.f;
#pragma unroll
        for (int sidx = 0; sidx < 4; ++sidx) {
            if (sidx == 3 || sidx < nsel) {
                const u32x4 a = *(const u32x4*)(P_part + (pi + sidx) * 64 + d8 * 8);
                const float ww = w[sidx] * inv;
#pragma unroll
                for (int c = 0; c < 4; ++c) { acc8[2 * c] += ww * bf2f(a[c] & 0xFFFFu); acc8[2 * c + 1] += ww * bf2f(a[c] >> 16); }
            }
        }
        u32x4 o;
#pragma unroll
        for (int c = 0; c < 4; ++c) o[c] = cvtpk(acc8[2 * c], acc8[2 * c + 1]);
        *(u32x4*)(P_ao + row * D + h * 64 + d8 * 8) = o;
    }
}

__device__ __forceinline__ void ph_dil(int L, int rep_) {
    PH_FN_BEGIN
    (void)rep_;
            PH_BEGIN;
                for (int it = bid; it < BATCH * NH * 3 * 32; it += G) {
                    const int ch = it & 31, grp = (it >> 5) % 3, bh = it / 96, b = bh >> 4, h = bh & 15;
                    const int dil = grp == 0 ? 1 : (grp == 1 ? 4 : 16), Ls = SEQ / dil;
                    const float slope2 = exp2f(-0.5f * (float)(h + 1)) * LOG2E * (float)dil;
                    const int u0 = ch * 256 + wave * 32, res = u0 / Ls, i0 = u0 - res * Ls;
                    const int iq = i0 + r32, pq = iq * dil + res;
                    const u16* qrow = P_qkv + (size_t)(b * SEQ + pq) * 9216 + grp * 3072 + h * 64 + hi * 8;
                    bf16x8 qf[4];
#pragma unroll
                    for (int d0 = 0; d0 < 4; ++d0) qf[d0] = *(const bf16x8*)(qrow + d0 * 16);
                    AttnSt st; st.m = NEGV; st.l = 0.f;
#pragma unroll
                    for (int r = 0; r < 16; ++r) { st.o0[r] = 0.f; st.o1[r] = 0.f; }
                    const u16* kbase = P_qkv + (size_t)(b * SEQ) * 9216 + grp * 3072 + 1024 + h * 64 + hi * 8;
                    const u16* vtb = P_vT + (size_t)grp * T * D + ((size_t)(b * NH + h) * HD + r32) * SEQ + (size_t)res * Ls + 4 * hi;
                    {
                        const int ktmin = (i0 >= 128) ? 0 : (128 - i0) >> 5;
                        AttnFr fa, fb;
                        { const int k1 = i0 - 128 + 4 * 32; attn_load(fa, kbase + (size_t)((k1 + r32) * dil + res) * 9216, vtb + k1, SEQ); }
#define DIL_STEP(FR, FN) { \
                            { const int k1 = i0 - 128 + (kt > ktmin ? kt - 1 : kt) * 32; attn_load(FN, kbase + (size_t)((k1 + r32) * dil + res) * 9216, vtb + k1, SEQ); } \
                            const int k0 = i0 - 128 + kt * 32; \
                            attn_compute(st, qf, FR, iq - k0 - 4 * hi, slope2, 0, 128, hi); }
                        for (int kt = 4; kt >= ktmin; --kt) {
                            DIL_STEP(fa, fb)
                            if (--kt < ktmin) break;
                            DIL_STEP(fb, fa)
                        }
                    }
                    const float lt = st.l + __shfl_xor(st.l, 32);
                    const float inv = 1.f / lt;
                    u16* orow = P_og + (size_t)grp * T * D + (size_t)(b * SEQ + pq) * D + h * 64;
#pragma unroll
                    for (int rq = 0; rq < 4; ++rq) {
                        u32x2 w; w[0] = cvtpk(st.o0[4 * rq] * inv, st.o0[4 * rq + 1] * inv); w[1] = cvtpk(st.o0[4 * rq + 2] * inv, st.o0[4 * rq + 3] * inv);
                        *(u32x2*)(orow + 8 * rq + 4 * hi) = w;
                        w[0] = cvtpk(st.o1[4 * rq] * inv, st.o1[4 * rq + 1] * inv); w[1] = cvtpk(st.o1[4 * rq + 2] * inv, st.o1[4 * rq + 3] * inv);
                        *(u32x2*)(orow + 32 + 8 * rq + 4 * hi) = w;
                    }
                    if (hi == 0) P_lse[((size_t)grp * T + (b * SEQ + pq)) * NH + h] = st.m * LN2 + logf(lt);
                }

}

__device__ __forceinline__ void ph_merge(int L, int rep_) {
    PH_FN_BEGIN
    (void)rep_;

            PH_BEGIN;
                for (size_t i = (size_t)bid * NTHR + tid; i < (size_t)T * NH * 8; i += (size_t)G * NTHR) {
                    const size_t row = i >> 7; const int h = (int)(i >> 3) & 15, d8 = (int)i & 7;
                    const float l0 = P_lse[(0 * (size_t)T + row) * NH + h], l1 = P_lse[(1 * (size_t)T + row) * NH + h], l2 = P_lse[(2 * (size_t)T + row) * NH + h];
                    const float mx = fmaxf(l0, fmaxf(l1, l2));
                    float w0 = expf(l0 - mx), w1 = expf(l1 - mx), w2 = expf(l2 - mx);
                    const float inv = 1.f / (w0 + w1 + w2); w0 *= inv; w1 *= inv; w2 *= inv;
                    const size_t off = row * D + h * 64 + d8 * 8;
                    const u32x4 a0 = *(const u32x4*)(P_og + off), a1 = *(const u32x4*)(P_og + (size_t)T * D + off), a2 = *(const u32x4*)(P_og + 2 * (size_t)T * D + off);
                    u32x4 o;
#pragma unroll
                    for (int c = 0; c < 4; ++c) {
                        const float lo_ = w0 * bf2f(a0[c] & 0xFFFFu) + w1 * bf2f(a1[c] & 0xFFFFu) + w2 * bf2f(a2[c] & 0xFFFFu);
                        const float hi_ = w0 * bf2f(a0[c] >> 16) + w1 * bf2f(a1[c] >> 16) + w2 * bf2f(a2[c] >> 16);
                        o[c] = cvtpk(lo_, hi_);
                    }
                    *(u32x4*)(P_ao + off) = o;
                }

}

__device__ __forceinline__ void ph_wo(int L, int rep_) {
    PH_FN_BEGIN
    (void)rep_;
    const pg8::Gemm g{P_ao, (const u16*)(ws + WS_WO) + (size_t)L * D * D, T, D, D};
    pg8::StaticOrder S; S.init(g.M, g.N, G, bid);
    const EpiWo E{P_ypre, L == 0 ? CTX_IN(0) : (const float*)P_x2};
    pg8::gemm_phase<EpiWo, pg8::StaticOrder, false>((PG8_LAS unsigned char*)lds, g, S, E, nullptr);
}

__device__ __forceinline__ void ph_router(int L, int rep_) {
    PH_FN_BEGIN
    (void)rep_;

            PH_BEGIN;
            const float* lng = CTX_IN(4) + L * D; const float* lnb = CTX_IN(5) + L * D;
            const float* rbias = CTX_IN(7) + L * NE;
            const u16* wrh = (const u16*)(ws + WS_WRH) + (size_t)L * NE * D; const u16* wrl = (const u16*)(ws + WS_WRL) + (size_t)L * NE * D;
            constexpr int AP = 2064;
            LAS char* ahi = lds; LAS char* alo = lds + 32 * AP;
            for (int it = bid; it < T / 32; it += G) {
#pragma unroll 1
                for (int rr = 0; rr < 4; ++rr) {
                    const int lr = wave * 4 + rr; const size_t row = (size_t)it * 32 + lr;
                    float v[16];
#pragma unroll
                    for (int j = 0; j < 4; ++j) { const f32x4 t4 = *(const f32x4*)(P_ypre + row * D + j * 256 + lane * 4); v[j * 4] = t4[0]; v[j * 4 + 1] = t4[1]; v[j * 4 + 2] = t4[2]; v[j * 4 + 3] = t4[3]; }
                    ln_row(v, lng, lnb, lane);
#pragma unroll
                    for (int j = 0; j < 4; ++j) {
                        f32x4 t4; t4[0] = v[j * 4]; t4[1] = v[j * 4 + 1]; t4[2] = v[j * 4 + 2]; t4[3] = v[j * 4 + 3];
                        *(f32x4*)(P_x1 + row * D + j * 256 + lane * 4) = t4;
                        u32x2 w; w[0] = cvtpk(t4[0], t4[1]); w[1] = cvtpk(t4[2], t4[3]);
                        *(u32x2*)(P_xb + row * D + j * 256 + lane * 4) = w;
                        u32x2 wl; wl[0] = cvtpk(t4[0] - bf2f(w[0] & 0xFFFFu), t4[1] - bf2f(w[0] >> 16)); wl[1] = cvtpk(t4[2] - bf2f(w[1] & 0xFFFFu), t4[3] - bf2f(w[1] >> 16));
                        *(LAS u32x2*)(ahi + lr * AP + (j * 256 + lane * 4) * 2) = w;
                        *(LAS u32x2*)(alo + lr * AP + (j * 256 + lane * 4) * 2) = wl;
                    }
                }
                __syncthreads();
                f32x16 lg;
#pragma unroll
                for (int r = 0; r < 16; ++r) lg[r] = 0.f;
                {
                    const LAS char* ah = ahi + r32 * AP + hi * 16; const LAS char* al = alo + r32 * AP + hi * 16;
                    const u16* bh = wrh + (size_t)(wave * 32 + r32) * D + hi * 8; const u16* bl = wrl + (size_t)(wave * 32 + r32) * D + hi * 8;
                    bf16x8 bha[8], bla[8], bhb[8], blb[8];
#pragma unroll
                    for (int j = 0; j < 8; ++j) { bha[j] = *(const bf16x8*)(bh + j * 16); bla[j] = *(const bf16x8*)(bl + j * 16); }
#pragma unroll 1
                    for (int k0 = 0; k0 < D; k0 += 256) {
#pragma unroll
                        for (int j = 0; j < 8; ++j) { bhb[j] = *(const bf16x8*)(bh + k0 + 128 + j * 16); blb[j] = *(const bf16x8*)(bl + k0 + 128 + j * 16); }
#pragma unroll
                        for (int j = 0; j < 8; ++j) {
                            const bf16x8 xh = *(const LAS bf16x8*)(ah + (k0 + j * 16) * 2), xl = *(const LAS bf16x8*)(al + (k0 + j * 16) * 2);
                            lg = MFMA_BF16(xh, bha[j], lg); lg = MFMA_BF16(xl, bha[j], lg); lg = MFMA_BF16(xh, bla[j], lg);
                        }
                        { const int kn = (k0 + 256 < D) ? k0 + 256 : 0;
#pragma unroll
                          for (int j = 0; j < 8; ++j) { bha[j] = *(const bf16x8*)(bh + kn + j * 16); bla[j] = *(const bf16x8*)(bl + kn + j * 16); } }
#pragma unroll
                        for (int j = 0; j < 8; ++j) {
                            const bf16x8 xh = *(const LAS bf16x8*)(ah + (k0 + 128 + j * 16) * 2), xl = *(const LAS bf16x8*)(al + (k0 + 128 + j * 16) * 2);
                            lg = MFMA_BF16(xh, bhb[j], lg); lg = MFMA_BF16(xl, bhb[j], lg); lg = MFMA_BF16(xh, blb[j], lg);
                        }
                    }
                }
                __syncthreads();
                LAS float* lgs = (LAS float*)lds;
#pragma unroll
                for (int r = 0; r < 16; ++r) lgs[crow(r, hi) * 257 + wave * 32 + r32] = lg[r];
                __syncthreads();
#pragma unroll 1
                for (int rr = 0; rr < 4; ++rr) {
                    const int lr = wave * 4 + rr; const int tok = it * 32 + lr;
                    float sc[4], ch[4];
#pragma unroll
                    for (int j = 0; j < 4; ++j) { const int e = lane + 64 * j; sc[j] = 1.f / (1.f + expf(-lgs[lr * 257 + e])); ch[j] = sc[j] + rbias[e]; }
                    float gsel[8], gmine[4];
#pragma unroll
                    for (int j = 0; j < 4; ++j) {
                        float m1 = ch[j];
#pragma unroll
                        for (int o = 16; o >= 1; o >>= 1) m1 = fmaxf(m1, __shfl_xor(m1, o));
                        const unsigned long long bal = __ballot(ch[j] == m1);
                        const unsigned half = (unsigned)(hi ? (bal >> 32) : (bal & 0xFFFFFFFFull));
                        const int first = __builtin_ctz(half);
                        float m2 = (r32 == first) ? -INFINITY : ch[j];
#pragma unroll
                        for (int o = 16; o >= 1; o >>= 1) m2 = fmaxf(m2, __shfl_xor(m2, o));
                        const float mine = m1 + m2, other = __shfl_xor(mine, 32);
                        gsel[2 * j] = hi ? other : mine; gsel[2 * j + 1] = hi ? mine : other; gmine[j] = mine;
                    }
                    bool gok[4];
#pragma unroll
                    for (int j = 0; j < 4; ++j) {
                        const float mygs = gmine[j];
                        const int myg = 2 * j + hi;
                        int rank = 0;
#pragma unroll
                        for (int g2 = 0; g2 < 8; ++g2) rank += ((gsel[g2] > mygs) || (gsel[g2] == mygs && g2 < myg)) ? 1 : 0;
                        gok[j] = rank < 4;
                    }
                    float cv[4];
#pragma unroll
                    for (int j = 0; j < 4; ++j) cv[j] = gok[j] ? ch[j] : NEGV;
                    float wsel = 0.f; int esel = 0; float wsum = 0.f;
#pragma unroll 1
                    for (int k = 0; k < TOPK; ++k) {
                        float bv = cv[0]; int be = lane;
#pragma unroll
                        for (int j = 1; j < 4; ++j) if (cv[j] > bv) { bv = cv[j]; be = lane + 64 * j; }
#pragma unroll
                        for (int o = 32; o >= 1; o >>= 1) {
                            const float ov = __shfl_xor(bv, o); const int oe = __shfl_xor(be, o);
                            if (ov > bv || (ov == bv && oe < be)) { bv = ov; be = oe; }
                        }
                        const int jl = be >> 6, ll = be & 63;
                        float smine = sc[0];
                        smine = jl == 1 ? sc[1] : smine; smine = jl == 2 ? sc[2] : smine; smine = jl == 3 ? sc[3] : smine;
                        const float sw = __shfl(smine, ll);
#pragma unroll
                        for (int j = 0; j < 4; ++j) cv[j] = (lane == ll && jl == j) ? -INFINITY : cv[j];
                        wsum += sw;
                        if (lane == k) { wsel = sw; esel = be; }
                    }
                    if (lane < TOPK) {
                        const int a = tok * TOPK + lane;
                        P_topw[a] = wsel / wsum * 2.5f;
                        if (rep_ == 0) {
                            const int pos = atomicAdd(&cnt[esel], 1);
                            P_list[(size_t)esel * T + pos] = a;
                        }
                    }
                }
                __syncthreads();
            }

}

__device__ __forceinline__ void ph_gateup(int L, int rep_) {
    PH_FN_BEGIN
    (void)rep_;
    {
        PH_BEGIN;
        const float* weg = CTX_IN(8) + (size_t)L * NE * D * DF; const float* weu = CTX_IN(9) + (size_t)L * NE * D * DF;
        LAS int* rowva = (LAS int*)(lds + MOE_LDS_VA);
        for (int e = bid; e < NE; e += G) {
            const int n = cnt[e];
            for (int r0 = 0; r0 < n; r0 += 1024) {
#pragma unroll
                for (int i = 0; i < 2; ++i) { const int idx = r0 + i * 512 + tid; rowva[i * 512 + tid] = idx < n ? P_list[(size_t)e * T + idx] : TRASH_VA; }
                __syncthreads();
                moe_expert<false>(lds, tid, lane, wave, r32, hi, P_xb, weg + (size_t)e * D * DF, weu + (size_t)e * D * DF, (n - r0) < 1024 ? (n - r0) : 1024, P_hb);
            }
        }
    }
    {
        const pg8::Gemm g{P_xb, (const u16*)(ws + WS_WSGU) + (size_t)L * 512 * 1024, T, 512, D};
        pg8::StaticOrder S; S.init(g.M, g.N, G, (bid + 128) % G);
        const EpiSGU E{P_hb};
        pg8::gemm_phase<EpiSGU, pg8::StaticOrder, false>((PG8_LAS unsigned char*)lds, g, S, E, nullptr);
    }
}

__device__ __forceinline__ void ph_down(int L, int rep_) {
    PH_FN_BEGIN
    (void)rep_;
    {
        PH_BEGIN;
        const float* wed = CTX_IN(10) + (size_t)L * NE * DF * D;
        LAS int* rowva = (LAS int*)(lds + MOE_LDS_VA); LAS float* roww = (LAS float*)(lds + MOE_LDS_W);
        for (int e = bid; e < NE; e += G) {
            const int n = cnt[e];
            for (int r0 = 0; r0 < n; r0 += 1024) {
#pragma unroll
                for (int i = 0; i < 2; ++i) { const int idx = r0 + i * 512 + tid; const int va = idx < n ? P_list[(size_t)e * T + idx] : TRASH_VA; rowva[i * 512 + tid] = va; roww[i * 512 + tid] = va < A_TOT ? P_topw[va] : 0.f; }
                __syncthreads();
                moe_expert<true>(lds, tid, lane, wave, r32, hi, P_hb, wed + (size_t)e * DF * D, nullptr, (n - r0) < 1024 ? (n - r0) : 1024, P_yb);
            }
        }
    }
    {
        const pg8::Gemm g{P_hb + (size_t)A_TOT * DF, (const u16*)(ws + WS_WSD) + (size_t)L * D * DF, T, D, DF};
        pg8::StaticOrder S; S.init(g.M, g.N, G, bid);
        const EpiSD E{P_yb};
        pg8::gemm_phase<EpiSD, pg8::StaticOrder, false>((PG8_LAS unsigned char*)lds, g, S, E, nullptr);
    }
}

__device__ __forceinline__ void ph_combine(int L, int rep_) {
    PH_FN_BEGIN
    (void)rep_;
    PH_BEGIN;
    const float* lng = CTX_IN(14) + L * D; const float* lnb = CTX_IN(15) + L * D;
    float* dst = L == 0 ? P_x2 : AS_GLOBAL(float, ctx_ld(16));
    for (int row = bid * 8 + wave; row < T; row += G * 8) {
        u32x4 yv[TOPK + 1][2];
#pragma unroll
        for (int k = 0; k < TOPK + 1; ++k) {
            const size_t va = k < TOPK ? (size_t)row * TOPK + k : (size_t)A_TOT + row;
#pragma unroll
            for (int j = 0; j < 2; ++j) yv[k][j] = *(const u32x4*)(P_yb + va * D + j * 512 + lane * 8);
        }
        float v[16];
#pragma unroll
        for (int j = 0; j < 2; ++j) {
            const f32x4 t0 = *(const f32x4*)(P_x1 + (size_t)row * D + j * 512 + lane * 8), t1 = *(const f32x4*)(P_x1 + (size_t)row * D + j * 512 + lane * 8 + 4);
#pragma unroll
            for (int c = 0; c < 4; ++c) { v[j * 8 + c] = DN_ALPHA * t0[c]; v[j * 8 + 4 + c] = DN_ALPHA * t1[c]; }
        }
#pragma unroll
        for (int k = 0; k < TOPK + 1; ++k)
#pragma unroll
            for (int j = 0; j < 2; ++j)
#pragma unroll
                for (int c = 0; c < 4; ++c) { v[j * 8 + 2 * c] += bf2f(yv[k][j][c] & 0xFFFFu); v[j * 8 + 2 * c + 1] += bf2f(yv[k][j][c] >> 16); }
        float sm = 0.f;
#pragma unroll
        for (int i = 0; i < 16; ++i) sm += v[i];
        const float mu = wave_sum(sm) * (1.f / D);
        float q = 0.f;
#pragma unroll
        for (int i = 0; i < 16; ++i) { const float d = v[i] - mu; q += d * d; }
        const float rstd = rsqrtf(wave_sum(q) * (1.f / D) + LN_EPS);
#pragma unroll
        for (int j = 0; j < 2; ++j) {
            const f32x4 g0 = *(const f32x4*)(lng + j * 512 + lane * 8), g1 = *(const f32x4*)(lng + j * 512 + lane * 8 + 4);
            const f32x4 b0 = *(const f32x4*)(lnb + j * 512 + lane * 8), b1 = *(const f32x4*)(lnb + j * 512 + lane * 8 + 4);
            f32x4 o0, o1;
#pragma unroll
            for (int c = 0; c < 4; ++c) { o0[c] = (v[j * 8 + c] - mu) * rstd * g0[c] + b0[c]; o1[c] = (v[j * 8 + 4 + c] - mu) * rstd * g1[c] + b1[c]; }
            *(f32x4*)(dst + (size_t)row * D + j * 512 + lane * 8) = o0; *(f32x4*)(dst + (size_t)row * D + j * 512 + lane * 8 + 4) = o1;
            if (L == 0) { u32x4 w; w[0] = cvtpk(o0[0], o0[1]); w[1] = cvtpk(o0[2], o0[3]); w[2] = cvtpk(o1[0], o1[1]); w[3] = cvtpk(o1[2], o1[3]); *(u32x4*)(P_xb + (size_t)row * D + j * 512 + lane * 8) = w; }
        }
    }
}

__global__ void __launch_bounds__(NTHR, 2) fwd(Args args) {
    extern __shared__ __attribute__((aligned(16))) unsigned char lds_raw[];
    LAS char* lds = (LAS char*)lds_raw;
    unsigned char* const ws = args.ws;
    const int lo = args.ph_lo, hi_ph = args.ph_hi;
    if (threadIdx.x < 18) {
        const uint64_t v = threadIdx.x < 16 ? (uint64_t)args.in[threadIdx.x] : (threadIdx.x == 16 ? (uint64_t)args.out : (uint64_t)args.ws);
        ((LAS uint64_t*)(lds + LDS_CTX))[threadIdx.x] = v;
    }
    __syncthreads();
#define IN(k) (lo <= (k) && (k) < hi_ph)

#if MK_ONE_LAUNCH
    if (threadIdx.x < 4) ((LAS unsigned*)(lds + LDS_BAR))[threadIdx.x] = 0u;
    __syncthreads();
    XcdBarrier bar = xcd_barrier_post((unsigned*)(ws + WS_CTL), (volatile LAS unsigned*)(lds + LDS_BAR));
#define GRID_BAR() xcd_barrier(bar)
#else
#define GRID_BAR() do { } while (0)
#endif
#define SEAM(k) do { if (IN(k) && IN((k) + 1)) GRID_BAR(); } while (0)

    for (int rep_ = 0; rep_ < ((IN(0) && PHK(0)) ? REPS(0) : 0); ++rep_) { ph_p0(0, rep_); }
    SEAM(0);

    for (int L = 0; L < 2; ++L) {
        const int pb = 1 + 10 * L;
        for (int rep_ = 0; rep_ < ((IN(pb + 0) && PHK(1)) ? REPS(1) : 0); ++rep_) { ph_qkv(L, rep_); }
        SEAM(pb + 0);

        if (L == 0) {
            for (int rep_ = 0; rep_ < ((IN(pb + 1) && PHK(2)) ? REPS(2) : 0); ++rep_) { ph_kmean(L, rep_); }
            SEAM(pb + 1);
            for (int rep_ = 0; rep_ < ((IN(pb + 2) && PHK(11)) ? REPS(11) : 0); ++rep_) { ph_gate(L, rep_); }
            SEAM(pb + 2);
        }

        if (L == 0) {
            for (int rep_ = 0; rep_ < ((IN(pb + 3) && PHK(3)) ? REPS(3) : 0); ++rep_) { ph_moba(L, rep_); }
            SEAM(pb + 3);
            for (int rep_ = 0; rep_ < ((IN(pb + 4) && PHK(12)) ? REPS(12) : 0); ++rep_) { ph_mobamerge(L, rep_); }
        } else {
            for (int rep_ = 0; rep_ < ((IN(pb + 3) && PHK(4)) ? REPS(4) : 0); ++rep_) { ph_dil(L, rep_); }
            SEAM(pb + 3);
            for (int rep_ = 0; rep_ < ((IN(pb + 4) && PHK(5)) ? REPS(5) : 0); ++rep_) { ph_merge(L, rep_); }
        }
        SEAM(pb + 4);

        for (int rep_ = 0; rep_ < ((IN(pb + 5) && PHK(6)) ? REPS(6) : 0); ++rep_) { ph_wo(L, rep_); }
        SEAM(pb + 5);

        for (int rep_ = 0; rep_ < ((IN(pb + 6) && PHK(7)) ? REPS(7) : 0); ++rep_) { ph_router(L, rep_); }
        SEAM(pb + 6);

        for (int rep_ = 0; rep_ < ((IN(pb + 7) && PHK(8)) ? REPS(8) : 0); ++rep_) { ph_gateup(L, rep_); }
        SEAM(pb + 7);

        for (int rep_ = 0; rep_ < ((IN(pb + 8) && PHK(9)) ? REPS(9) : 0); ++rep_) { ph_down(L, rep_); }
        SEAM(pb + 8);

        for (int rep_ = 0; rep_ < ((IN(pb + 9) && PHK(10)) ? REPS(10) : 0); ++rep_) { ph_combine(L, rep_); }
        if (L == 0) SEAM(pb + 9);
    }
}

extern "C" void kernel_launch(void* const* d_in, const int* in_sizes, int n_in, void* d_out, int out_size, void* d_ws, size_t ws_size, hipStream_t stream) {
    static int grid = 0;
    if (grid == 0) {
        if (n_in != 16 || out_size != T * D || ws_size < WS_END2) { fprintf(stderr, "kernel_launch: unexpected problem (n_in %d out %d ws %zu need %zu)\n", n_in, out_size, ws_size, (size_t)WS_END2); grid = -1; return; }
        int dev = 0, cus = 0, per_cu = 0;
        if (hipGetDevice(&dev) != hipSuccess || hipDeviceGetAttribute(&cus, hipDeviceAttributeMultiprocessorCount, dev) != hipSuccess) { grid = -1; return; }
        if (hipFuncSetAttribute((const void*)fwd, hipFuncAttributeMaxDynamicSharedMemorySize, LDS_BYTES) != hipSuccess) { fprintf(stderr, "kernel_launch: hipFuncSetAttribute failed\n"); grid = -1; return; }
        if (hipOccupancyMaxActiveBlocksPerMultiprocessor(&per_cu, (const void*)fwd, NTHR, LDS_BYTES) != hipSuccess || per_cu < 1) { fprintf(stderr, "kernel_launch: occupancy query says %d\n", per_cu); (void)hipGetLastError(); per_cu = 1; }
        grid = cus;
    }
    if (grid < 0) return;
    (void)hipMemsetAsync((char*)d_ws + WS_CTL, 0, CTL_BYTES, stream);
    Args a{};
    for (int i = 0; i < 16; ++i) a.in[i] = (const float*)d_in[i];
    a.out = (float*)d_out; a.ws = (unsigned char*)d_ws;
#if MK_ONE_LAUNCH
    a.ph_lo = 0; a.ph_hi = N_PHASES;
    hipLaunchKernelGGL(fwd, dim3(grid), dim3(NTHR), LDS_BYTES, stream, a);
#else
    for (int ph = 0; ph < N_PHASES; ++ph) {
        if (ph == 12 || ph == 13) continue;
        a.ph_lo = ph; a.ph_hi = ph + 1;
        hipLaunchKernelGGL(fwd, dim3(grid), dim3(NTHR), LDS_BYTES, stream, a);
    }
#endif
}
```

```cpp
#include <hip/hip_runtime.h>
#include <hip/hip_bf16.h>
#include <stdint.h>
#include <stdio.h>

#ifndef MK_ONE_LAUNCH
#define MK_ONE_LAUNCH 1
#endif

#ifndef PHMASK
#define PHMASK 0x1FFF
#endif
#define PHK(k) ((PHMASK >> (k)) & 1)
#ifndef REPEAT_KIND
#define REPEAT_KIND -1
#endif
#define REPS(k) ((k) == REPEAT_KIND ? 2 : 1)
#define LAS __attribute__((address_space(3)))
typedef __attribute__((ext_vector_type(8))) short bf16x8;
typedef __attribute__((ext_vector_type(16))) float f32x16;
typedef __attribute__((ext_vector_type(4))) float f32x4;
typedef __attribute__((ext_vector_type(4))) unsigned u32x4;
typedef __attribute__((ext_vector_type(2))) unsigned u32x2;
typedef unsigned short u16;

constexpr int D = 1024, BATCH = 2, SEQ = 8192, T = BATCH * SEQ, NH = 16, HD = 64;
constexpr int NE = 256, TOPK = 8, DF = 256;
constexpr int A_TOT = T * TOPK;
constexpr int MOBA_BLK = 256, MOBA_NB = SEQ / MOBA_BLK;
constexpr float DN_ALPHA = 1.4142135623730951f;
constexpr float LN_EPS = 1e-5f;
constexpr float LOG2E = 1.4426950408889634f;
constexpr float LN2 = 0.6931471805599453f;
constexpr float NEGV = -1e30f;
constexpr int NTHR = 512;

constexpr size_t al256(size_t x) { return (x + 255) & ~(size_t)255; }
constexpr size_t WS_CTL = 0;
constexpr size_t CTL_BYTES = 65536;
constexpr size_t CTL_CNT_OFF = 32768;
constexpr size_t WS_XB = WS_CTL + CTL_BYTES;
constexpr size_t WS_X1 = WS_XB + al256((size_t)T * D * 2);
constexpr size_t WS_X2 = WS_X1 + al256((size_t)T * D * 4);
constexpr size_t WS_YPRE = WS_X2 + al256((size_t)T * D * 4);
constexpr size_t WS_QKV = WS_YPRE + al256((size_t)T * D * 4);
constexpr size_t WS_VT = WS_QKV + al256((size_t)T * 9216 * 2);
constexpr size_t WS_KM = WS_VT + al256((size_t)3 * T * D * 2);
constexpr size_t WS_AO = WS_KM + al256((size_t)BATCH * NH * MOBA_NB * HD * 4);
constexpr size_t WS_OG = WS_AO + al256((size_t)T * D * 2);
constexpr size_t WS_LSE = WS_OG + al256((size_t)3 * T * D * 2);
constexpr size_t WS_TOPW = WS_LSE + al256((size_t)3 * T * NH * 4);
constexpr size_t WS_LIST = WS_TOPW + al256((size_t)T * TOPK * 4);
constexpr size_t WS_HB = WS_LIST + al256((size_t)NE * T * 4);
constexpr size_t WS_YB = WS_HB + al256((size_t)(A_TOT + T + 1) * DF * 2);
constexpr size_t WS_END = WS_YB + al256((size_t)(A_TOT + T + 1) * D * 2);
constexpr int TRASH_VA = A_TOT + T;
constexpr size_t WS_SELM = WS_END;
constexpr size_t WS_PART = WS_SELM + al256((size_t)T * NH * 4);
constexpr size_t WS_PLSE = WS_PART + al256((size_t)T * NH * 4 * 64 * 2);
constexpr size_t WS_WQK0 = WS_PLSE + al256((size_t)T * NH * 4 * 4);
constexpr size_t WS_WV0 = WS_WQK0 + (size_t)2048 * 1024 * 2;
constexpr size_t WS_WQK1 = WS_WV0 + (size_t)1024 * 1024 * 2;
constexpr size_t WS_WV1 = WS_WQK1 + (size_t)6144 * 1024 * 2;
constexpr size_t WS_WO = WS_WV1 + (size_t)3072 * 1024 * 2;
constexpr size_t WS_WSGU = WS_WO + (size_t)2 * 1024 * 1024 * 2;
constexpr size_t WS_WSD = WS_WSGU + (size_t)2 * 512 * 1024 * 2;
constexpr size_t WS_XB8 = WS_WSD + (size_t)2 * 1024 * 256 * 2;
constexpr size_t WS_HBS = WS_XB8 + (size_t)T * D;
constexpr size_t WS_WRH = WS_HBS + (size_t)T * DF * 2;
constexpr size_t WS_WRL = WS_WRH + (size_t)2 * 256 * 1024 * 2;
constexpr size_t WS_END2 = WS_WRL + (size_t)2 * 256 * 1024 * 2;

constexpr int LDP = 40;
constexpr int STAGE_BYTES = 2 * 256 * LDP * 2;
constexpr int LDS_ROWID = 2 * STAGE_BYTES;
constexpr int LDS_ROWW = LDS_ROWID + 1024;
constexpr int XS_PITCH = 1028;
constexpr int LDS_BYTES = 163840;
constexpr int LDS_BAR = 161792;

#define XB_TMO      128
#define XB_XCNT(j)  (256  + 64 * (j))
#define XB_XSUB(j)  (1280 + 64 * (j))
#define XB_XGEN(j)  (2304 + 64 * (j))
#define XB_TOP      3328
#define XB_TOPGEN   3392
#define XCD_BAR_WORDS 3456
#define XB_SPIN_CAP (1u << 18)
__device__ __forceinline__ unsigned xb_ld(unsigned* p)              { return __hip_atomic_load(p, __ATOMIC_RELAXED, __HIP_MEMORY_SCOPE_AGENT); }
__device__ __forceinline__ unsigned xb_add(unsigned* p, unsigned v) { return __hip_atomic_fetch_add(p, v, __ATOMIC_RELAXED, __HIP_MEMORY_SCOPE_AGENT); }
__device__ __forceinline__ unsigned xb_xcc_id() { return (unsigned)__builtin_amdgcn_s_getreg((3 << 11) | 20) & 0xFu; }
#define XB_SPIN(cond, bar) do { unsigned _sp = 0; while (cond) { __builtin_amdgcn_s_sleep(1); \
    if ((++_sp & 255u) == 0u) { if (xb_ld(&(bar)[XB_TMO])) break; if (_sp > XB_SPIN_CAP) { atomicAdd(&(bar)[XB_TMO], 1u); break; } } } } while (0)
struct XcdBarrier { unsigned* bar; unsigned x; volatile LAS unsigned* st; };
__device__ __forceinline__ XcdBarrier xcd_barrier_post(unsigned* bar, volatile LAS unsigned* st) {
    XcdBarrier b; b.bar = bar; b.x = xb_xcc_id(); b.st = st;
    if (threadIdx.x == 0) (void)xb_add(&bar[XB_XCNT(b.x)], 1u);
    return b;
}
__device__ __forceinline__ void xcd_barrier_complete(unsigned* bar, unsigned x, unsigned& nloc, unsigned& nx) {
    const unsigned G = gridDim.x * gridDim.y * gridDim.z;
    unsigned sum, cnt, mine, sp = 0u;
    for (;;) {
        sum = 0u; cnt = 0u; mine = 0u;
#pragma unroll
        for (unsigned j = 0; j < 16; ++j) { const unsigned c = xb_ld(&bar[XB_XCNT(j)]); sum += c; cnt += (c > 0u) ? 1u : 0u; mine = (j == x) ? c : mine; }
        if (sum == G) break;
        __builtin_amdgcn_s_sleep(1);
        if ((++sp & 255u) == 0u) { if (xb_ld(&bar[XB_TMO])) break; if (sp > XB_SPIN_CAP) { atomicAdd(&bar[XB_TMO], 1u); break; } }
    }
    nloc = mine > 0u ? mine : 1u; nx = cnt > 0u ? cnt : 1u;
}
__device__ __forceinline__ void xcd_barrier(const XcdBarrier& b) {
    asm volatile("s_waitcnt vmcnt(0)" ::: "memory");
    __syncthreads();
    if (threadIdx.x == 0) {
        unsigned* bar = b.bar;
        __builtin_amdgcn_s_waitcnt(0);
        unsigned nloc = b.st[0], nx = b.st[1];
        if (nloc == 0u) { xcd_barrier_complete(bar, b.x, nloc, nx); b.st[0] = nloc; b.st[1] = nx; }
        const unsigned old = xb_add(&bar[XB_XSUB(b.x)], 1u);
        const unsigned gen = old / nloc;
        if (old + 1u == (gen + 1u) * nloc) {
            __builtin_amdgcn_fence(__ATOMIC_RELEASE, "agent");
            asm volatile("s_waitcnt vmcnt(0)" ::: "memory");
            const unsigned og = xb_add(&bar[XB_TOP], 1u);
            const unsigned tg = og / nx;
            if (og + 1u == (tg + 1u) * nx) xb_add(&bar[XB_TOPGEN], 1u);
            else XB_SPIN(xb_ld(&bar[XB_TOPGEN]) == tg, bar);
            __builtin_amdgcn_fence(__ATOMIC_ACQUIRE, "agent");
            xb_add(&bar[XB_XGEN(b.x)], 1u);
            asm volatile("s_waitcnt vmcnt(0)" ::: "memory");
        } else {
            XB_SPIN(xb_ld(&bar[XB_XGEN(b.x)]) == gen, bar);
            __builtin_amdgcn_fence(__ATOMIC_ACQUIRE, "agent");
            asm volatile("s_waitcnt vmcnt(0)" ::: "memory");
        }
    }
    __syncthreads();
}

typedef __attribute__((ext_vector_type(2))) __bf16 bf16x2_t;
typedef __attribute__((ext_vector_type(2))) float f32x2_t;
__device__ __forceinline__ unsigned cvtpk(float lo, float hi) { f32x2_t f; f[0] = lo; f[1] = hi; return __builtin_bit_cast(unsigned, __builtin_convertvector(f, bf16x2_t)); }
__device__ __forceinline__ float bf2f(unsigned v16) { return __uint_as_float(v16 << 16); }
__device__ __forceinline__ int crow(int r, int hi) { return (r & 3) + 8 * (r >> 2) + 4 * hi; }
#define MFMA_BF16(a, b, c) __builtin_amdgcn_mfma_f32_32x32x16_bf16(a, b, c, 0, 0, 0)
__device__ __forceinline__ float wave_sum(float v) {
    v += __int_as_float(__builtin_amdgcn_update_dpp(0, __float_as_int(v), 0xB1, 0xF, 0xF, true));
    v += __int_as_float(__builtin_amdgcn_update_dpp(0, __float_as_int(v), 0x4E, 0xF, 0xF, true));
    v += __int_as_float(__builtin_amdgcn_update_dpp(0, __float_as_int(v), 0x141, 0xF, 0xF, true));
    v += __int_as_float(__builtin_amdgcn_update_dpp(0, __float_as_int(v), 0x140, 0xF, 0xF, true));
    const int vi = __float_as_int(v);
    return (__int_as_float(__builtin_amdgcn_readlane(vi, 0)) + __int_as_float(__builtin_amdgcn_readlane(vi, 16))) + (__int_as_float(__builtin_amdgcn_readlane(vi, 32)) + __int_as_float(__builtin_amdgcn_readlane(vi, 48)));
}

namespace pg8 {
#define PG8_LAS __attribute__((address_space(3)))
typedef unsigned short bf16_t;
typedef short bf16x8 __attribute__((ext_vector_type(8)));
typedef float f32x4 __attribute__((ext_vector_type(4)));
typedef unsigned u32x4 __attribute__((ext_vector_type(4)));
constexpr int BM = 256, BK = 64, HALF = 128, HTB = HALF * BK * 2  , STAGE_BYTES = 8 * HTB, NXCD = 8, WGM = 8;

__host__ __device__ __forceinline__ int lds_byte(int r, int c) { const int st = (r >> 4) * 2 + (c >> 5), rr = r & 15, cc = c & 31, ob = rr * 64 + cc * 2; return st * 1024 + (ob ^ (((ob >> 9) & 1) << 5)); }
__host__ __device__ __forceinline__ void stage_rc(int b, int& R, int& C) { const int st = b / 1024, sb = b % 1024, swz = sb ^ (((sb >> 9) & 1) << 5); R = (st >> 1) * 16 + swz / 64; C = (st & 1) * 32 + (swz % 64) / 2; }
__host__ __device__ __forceinline__ int perm32(int rho) { const int n = rho >> 4, i = rho & 15; return 8 * (i >> 2) + 4 * n + (i & 3); }

struct Unit { int pm, pn; };
struct Gemm { const bf16_t* A; const bf16_t* Bt; int M, N, K; };

struct StaticOrder {
    int nM, nN, nwg, G, c;
    __host__ __device__ void init(int M, int N, int G_, int c_) { nM = M / BM; nN = N / BM; nwg = nM * nN; G = G_; c = c_; }
    __host__ __device__ bool next(int i, Unit& u) const {
        const long L = (long)i * G + c; if (L >= nwg) return false;
        int wgid = (int)L; { const int q = nwg / NXCD, r = nwg % NXCD, xcd = wgid % NXCD, off = wgid / NXCD; wgid = (xcd < r ? xcd * (q + 1) : r * (q + 1) + (xcd - r) * q) + off; }
        const int nig = WGM * nN, gid = wgid / nig, fm = gid * WGM, gsz = (nM - fm) < WGM ? (nM - fm) : WGM;
        u.pm = fm + ((wgid % nig) % gsz); u.pn = (wgid % nig) / gsz; return true;
    }
    __device__ __forceinline__ void a_ready(const Unit&) const {}
    __device__ __forceinline__ void done(const Unit&) const {}
};

template <class Epi, class Sched, bool SWAP = false, bool STAMP = false>
__device__ __forceinline__ void gemm_phase(PG8_LAS unsigned char* lds, const Gemm g, const Sched& S, const Epi& E, unsigned long long* stamps) {
    int tid_ = threadIdx.x; asm volatile("" : "+v"(tid_));
    const int tid = tid_, wid = __builtin_amdgcn_readfirstlane(tid >> 6), lane = tid & 63, wr = wid >> 2, wc = wid & 3, fr = lane & 15, fq = lane >> 4;
    const int K = g.K, nt = K / BK;
    int ts_lo = 0, ts_hi = 0, nts = 0; const unsigned long long rt_entry = STAMP ? (unsigned long long)wall_clock64() : 0ull;
#define PG8_STAMP() do { if (STAMP && wid == 0 && nts < 64) { const unsigned long long _c = (unsigned long long)clock64(); \
        ts_lo = (lane == nts) ? (int)(unsigned)_c : ts_lo; ts_hi = (lane == nts) ? (int)(unsigned)(_c >> 32) : ts_hi; ++nts; } } while (0)
    PG8_STAMP();
    unsigned voffA[2], voffB[2];
#pragma unroll
    for (int i = 0; i < 2; ++i) { int R, C; stage_rc(tid * 16 + i * 8192, R, C); const int Rb = Epi::PERM ? ((R & ~31) + perm32(R & 31)) : R;
        voffA[i] = (unsigned)(R * K + C) * 2u; voffB[i] = (unsigned)(Rb * K + C) * 2u; }
    const size_t kstep = (size_t)(BK * 2);
    const size_t hstep = (size_t)HALF * K * 2;
    const size_t tstep = 2 * hstep;
    const unsigned ldsw = (unsigned)wid * 1024u;
    const int aoff = lds_byte(wr * 64 + fr, fq * 8), boff = lds_byte(wc * 32 + fr, fq * 8);
#define PG8_SA(b, h) (((b) * 2 + (h)) * HTB)
#define PG8_SB(b, h) ((4 + (b) * 2 + (h)) * HTB)
#define PG8_STAGE(bufoff, gbase, voff) do { _Pragma("unroll") for (int _i = 0; _i < 2; ++_i) \
        __builtin_amdgcn_global_load_lds((const unsigned*)((const char*)(gbase) + (voff)[_i]), (PG8_LAS unsigned*)(lds + (bufoff) + ldsw + _i * 8192), 16, 0, 0); } while (0)
#define PG8_LDA(dst, b, h) do { _Pragma("unroll") for (int m = 0; m < 4; ++m) _Pragma("unroll") for (int k = 0; k < 2; ++k) dst[m][k] = *(const PG8_LAS bf16x8*)(lds + PG8_SA(b, h) + aoff + m * 2048 + k * 1024); } while (0)
#define PG8_LDB(dst, b, h) do { _Pragma("unroll") for (int n = 0; n < 2; ++n) _Pragma("unroll") for (int k = 0; k < 2; ++k) dst[n][k] = *(const PG8_LAS bf16x8*)(lds + PG8_SB(b, h) + boff + n * 2048 + k * 1024); } while (0)
#define PG8_MMA(ai, bj, At, Bt) do { __builtin_amdgcn_s_setprio(1); _Pragma("unroll") for (int m = 0; m < 4; ++m) _Pragma("unroll") for (int n = 0; n < 2; ++n) _Pragma("unroll") for (int k = 0; k < 2; ++k) \
        acc[ai][bj][m][n] = SWAP ? __builtin_amdgcn_mfma_f32_16x16x32_bf16(At[m][k], Bt[n][k], acc[ai][bj][m][n], 0, 0, 0) : __builtin_amdgcn_mfma_f32_16x16x32_bf16(Bt[n][k], At[m][k], acc[ai][bj][m][n], 0, 0, 0); __builtin_amdgcn_s_setprio(0); } while (0)
#define PG8_WAIT_V(n) asm volatile("s_waitcnt vmcnt(" #n ")" ::: "memory")
#define PG8_WAIT_L(n) asm volatile("s_waitcnt lgkmcnt(" #n ")" ::: "memory")
#define PG8_BAR __builtin_amdgcn_s_barrier()
#define PG8_SCHED __builtin_amdgcn_sched_barrier(0)
    Unit cur, nxt; int ui = 0;
    if (!S.next(0, cur)) return;
    f32x4 acc[2][2][4][2];
#pragma unroll
    for (int a = 0; a < 2; ++a)
#pragma unroll
        for (int b = 0; b < 2; ++b)
#pragma unroll
            for (int m = 0; m < 4; ++m)
#pragma unroll
                for (int n = 0; n < 2; ++n) acc[a][b][m][n] = (f32x4){0.f, 0.f, 0.f, 0.f};
    bf16x8 At[4][2], B0[2][2], B1[2][2];
    const char* cA = (const char*)g.A + (size_t)cur.pm * tstep; const char* cB = (const char*)g.Bt + (size_t)cur.pn * tstep;
    S.a_ready(cur);
    PG8_STAGE(PG8_SB(0, 0), cB, voffB); PG8_STAGE(PG8_SA(0, 0), cA, voffA); PG8_STAGE(PG8_SB(0, 1), cB + hstep, voffB); PG8_STAGE(PG8_SA(0, 1), cA + hstep, voffA);
    if (wr == 1) PG8_BAR;
    PG8_WAIT_V(4); PG8_BAR;
    PG8_STAGE(PG8_SB(1, 0), cB + kstep, voffB); PG8_STAGE(PG8_SA(1, 0), cA + kstep, voffA); PG8_STAGE(PG8_SB(1, 1), cB + hstep + kstep, voffB);
    PG8_WAIT_V(6); PG8_BAR;
    PG8_STAMP();
    for (;;) {
        const bool has_next = S.next(ui + 1, nxt);
        const char* nA = has_next ? (const char*)g.A + (size_t)nxt.pm * tstep : cA; const char* nB = has_next ? (const char*)g.Bt + (size_t)nxt.pn * tstep : cB;
        for (int t = 0; t < nt; t += 2) {
            const bool last = (t == nt - 2);
            const char* a1 = cA + (size_t)(t + 1) * kstep;
            const char* a2 = last ? nA : cA + (size_t)(t + 2) * kstep; const char* b2 = last ? nB : cB + (size_t)(t + 2) * kstep;
            const char* a3 = a2 + kstep; const char* b3 = b2 + kstep;
            if (last && has_next) S.a_ready(nxt);
            PG8_LDB(B0, 0, 0); PG8_SCHED; PG8_LDA(At, 0, 0); PG8_STAGE(PG8_SA(1, 1), a1 + hstep, voffA);
            PG8_WAIT_L(8); PG8_BAR; PG8_WAIT_L(0); PG8_MMA(0, 0, At, B0); PG8_BAR; PG8_SCHED;
            PG8_LDB(B1, 0, 1); PG8_STAGE(PG8_SB(0, 0), b2, voffB);
            PG8_BAR; PG8_WAIT_L(0); PG8_MMA(0, 1, At, B1); PG8_BAR;
            PG8_LDA(At, 0, 1); PG8_STAGE(PG8_SA(0, 0), a2, voffA);
            PG8_BAR; PG8_WAIT_L(0); PG8_MMA(1, 0, At, B0); PG8_BAR; PG8_SCHED;
            PG8_STAGE(PG8_SB(0, 1), b2 + hstep, voffB);
            PG8_WAIT_V(6); PG8_BAR; PG8_MMA(1, 1, At, B1); PG8_BAR;
            PG8_LDB(B0, 1, 0); PG8_SCHED; PG8_LDA(At, 1, 0); PG8_STAGE(PG8_SA(0, 1), a2 + hstep, voffA);
            PG8_WAIT_L(8); PG8_BAR; PG8_WAIT_L(0); PG8_MMA(0, 0, At, B0); PG8_BAR; PG8_SCHED;
            PG8_LDB(B1, 1, 1); PG8_STAGE(PG8_SB(1, 0), b3, voffB);
            PG8_BAR; PG8_WAIT_L(0); PG8_MMA(0, 1, At, B1); PG8_BAR;
            PG8_LDA(At, 1, 1); PG8_STAGE(PG8_SA(1, 0), a3, voffA);
            PG8_BAR; PG8_WAIT_L(0); PG8_MMA(1, 0, At, B0); PG8_BAR; PG8_SCHED;
            PG8_STAGE(PG8_SB(1, 1), b3 + hstep, voffB);
            PG8_WAIT_V(6); PG8_BAR; PG8_MMA(1, 1, At, B1); PG8_BAR;
        }
        PG8_STAMP();
        if constexpr (!Epi::AFTER_DRAIN) { E(acc, cur, wr, wc, fr, fq); S.done(cur); }
        PG8_STAMP();
        if (!has_next) break;
#pragma unroll
        for (int a = 0; a < 2; ++a)
#pragma unroll
            for (int b = 0; b < 2; ++b)
#pragma unroll
                for (int m = 0; m < 4; ++m)
#pragma unroll
                    for (int n = 0; n < 2; ++n) acc[a][b][m][n] = (f32x4){0.f, 0.f, 0.f, 0.f};
        cur = nxt; cA = nA; cB = nB; ++ui;
    }
    PG8_WAIT_V(0);
    if (wr == 0) PG8_BAR;
    PG8_BAR;
    if constexpr (Epi::AFTER_DRAIN) { E.fused(acc, cur, wr, wc, fr, fq, lds, wid, lane); S.done(cur); }
    PG8_STAMP();
    if (STAMP && wid == 0) { stamps[lane] = lane < nts ? (((unsigned long long)(unsigned)ts_hi << 32) | (unsigned)ts_lo) : 0ull;
        if (lane == 62) stamps[62] = rt_entry; if (lane == 63) stamps[63] = (unsigned long long)wall_clock64(); }
#undef PG8_STAMP
#undef PG8_SA
#undef PG8_SB
#undef PG8_STAGE
#undef PG8_LDA
#undef PG8_LDB
#undef PG8_MMA
#undef PG8_WAIT_V
#undef PG8_WAIT_L
#undef PG8_BAR
#undef PG8_SCHED
}
}

struct EpiQK {
    static constexpr bool PERM = true, AFTER_DRAIN = false;
    u16* O; int ldc;
    __device__ __forceinline__ void operator()(const pg8::f32x4 (&acc)[2][2][4][2], const pg8::Unit& u, int wr, int wc, int fr, int fq) const {
        const int colt = u.pn * 256, g = colt >> 11, col0 = g * 3072 + (colt & 2047) + wc * 32 + 8 * fq, row0 = u.pm * 256 + wr * 64 + fr;
#pragma unroll
        for (int ai = 0; ai < 2; ++ai)
#pragma unroll
            for (int m = 0; m < 4; ++m) { u16* rowp = O + (size_t)(row0 + ai * 128 + m * 16) * ldc + col0;
#pragma unroll
                for (int bj = 0; bj < 2; ++bj) { const pg8::f32x4 v0 = acc[ai][bj][m][0], v1 = acc[ai][bj][m][1];
                    u32x4 w; w[0] = cvtpk(v0[0], v0[1]); w[1] = cvtpk(v0[2], v0[3]); w[2] = cvtpk(v1[0], v1[1]); w[3] = cvtpk(v1[2], v1[3]);
                    *(u32x4*)(rowp + bj * 128) = w; } }
    }
};
struct EpiV {
    static constexpr bool PERM = false, AFTER_DRAIN = false;
    u16* VT; int layer;
    __device__ __forceinline__ void operator()(const pg8::f32x4 (&acc)[2][2][4][2], const pg8::Unit& u, int wr, int wc, int fr, int fq) const {
        const int colt = u.pn * 256, grp = colt >> 10;
        const int dil = (layer == 0 || grp == 0) ? 1 : (grp == 1 ? 4 : 16);
        const int rowb = u.pm * 256 + wr * 64 + 4 * fq;
#pragma unroll
        for (int bj = 0; bj < 2; ++bj)
#pragma unroll
            for (int n = 0; n < 2; ++n) {
                const int c = (colt & 1023) + bj * 128 + wc * 32 + n * 16 + fr, h = c >> 6, d = c & 63;
#pragma unroll
                for (int ai = 0; ai < 2; ++ai)
#pragma unroll
                    for (int m = 0; m < 4; ++m) {
                        const int r0 = rowb + ai * 128 + m * 16, b = r0 >> 13, t0 = r0 & (SEQ - 1);
                        u16* vrow = VT + (size_t)grp * T * D + ((size_t)(b * NH + h) * HD + d) * SEQ;
                        const pg8::f32x4 v = acc[ai][bj][m][n];
                        if (dil == 1) { u32x2 w; w[0] = cvtpk(v[0], v[1]); w[1] = cvtpk(v[2], v[3]); *(u32x2*)(vrow + t0) = w; }
                        else {
#pragma unroll
                            for (int i = 0; i < 4; ++i) { const int pp = t0 + i; vrow[(pp % dil) * (SEQ / dil) + pp / dil] = (u16)cvtpk(v[i], 0.f); }
                        }
                    }
            }
    }
};
struct EpiWo {
    static constexpr bool PERM = false, AFTER_DRAIN = false;
    float* Y; const float* X;
    __device__ __forceinline__ void operator()(const pg8::f32x4 (&acc)[2][2][4][2], const pg8::Unit& u, int wr, int wc, int fr, int fq) const {
        const int row0 = u.pm * 256 + wr * 64 + fr, col0 = u.pn * 256 + wc * 32 + 4 * fq;
#pragma unroll
        for (int ai = 0; ai < 2; ++ai)
#pragma unroll
            for (int m = 0; m < 4; ++m) { const size_t ro = (size_t)(row0 + ai * 128 + m * 16) * D + col0;
#pragma unroll
                for (int bj = 0; bj < 2; ++bj)
#pragma unroll
                    for (int n = 0; n < 2; ++n) { const pg8::f32x4 x = *(const pg8::f32x4*)(X + ro + bj * 128 + n * 16); *(pg8::f32x4*)(Y + ro + bj * 128 + n * 16) = x * DN_ALPHA + acc[ai][bj][m][n]; } }
    }
};
struct EpiSGU {
    static constexpr bool PERM = true, AFTER_DRAIN = false;
    u16* H;
    __device__ __forceinline__ void operator()(const pg8::f32x4 (&acc)[2][2][4][2], const pg8::Unit& u, int wr, int wc, int fr, int fq) const {
        const int row0 = u.pm * 256 + wr * 64 + fr, f0 = u.pn * 128 + wc * 32 + 8 * fq;
#pragma unroll
        for (int ai = 0; ai < 2; ++ai)
#pragma unroll
            for (int m = 0; m < 4; ++m) {
                float hv[8];
#pragma unroll
                for (int n = 0; n < 2; ++n)
#pragma unroll
                    for (int i = 0; i < 4; ++i) { const float gt = acc[ai][0][m][n][i], up = acc[ai][1][m][n][i]; hv[n * 4 + i] = gt / (1.f + __expf(-gt)) * up; }
                u32x4 w; w[0] = cvtpk(hv[0], hv[1]); w[1] = cvtpk(hv[2], hv[3]); w[2] = cvtpk(hv[4], hv[5]); w[3] = cvtpk(hv[6], hv[7]);
                *(u32x4*)(H + (size_t)(row0 + ai * 128 + m * 16) * DF + f0) = w;
            }
    }
};
struct EpiSD {
    static constexpr bool PERM = true, AFTER_DRAIN = false;
    u16* Y;
    __device__ __forceinline__ void operator()(const pg8::f32x4 (&acc)[2][2][4][2], const pg8::Unit& u, int wr, int wc, int fr, int fq) const {
        const int row0 = u.pm * 256 + wr * 64 + fr, col0 = u.pn * 256 + wc * 32 + 8 * fq;
#pragma unroll
        for (int ai = 0; ai < 2; ++ai)
#pragma unroll
            for (int m = 0; m < 4; ++m) { u16* rowp = Y + (size_t)(A_TOT + row0 + ai * 128 + m * 16) * D + col0;
#pragma unroll
                for (int bj = 0; bj < 2; ++bj) { const pg8::f32x4 v0 = acc[ai][bj][m][0], v1 = acc[ai][bj][m][1];
                    u32x4 w; w[0] = cvtpk(v0[0], v0[1]); w[1] = cvtpk(v0[2], v0[3]); w[2] = cvtpk(v1[0], v1[1]); w[3] = cvtpk(v1[2], v1[3]);
                    *(u32x4*)(rowp + bj * 128) = w; } }
    }
};

struct Args {
    const float* in[16];
    float* out;
    unsigned char* ws;
    int ph_lo, ph_hi;
};

#define GEMM_CORE(K_, PA0, PA1, PB, LDB)                                                                                                   \
    {                                                                                                                                      \
        const int g_tid = tid, g_lane = lane, g_wave = wave, g_r32 = r32, g_hi = hi;                   \
        const int g_wm = g_wave >> 2, g_wn = g_wave & 3, g_kc = g_tid & 3, g_kq = g_lane >> 3, g_n4 = g_lane & 7;                           \
        const u16* g_pa0 = (PA0); const u16* g_pa1 = (PA1);                                                                                \
        const size_t g_ldb = (size_t)(LDB);                                                                                                \
        const float* g_pb = (PB) + (size_t)(g_kq * 4) * g_ldb + g_n4 * 4;                                                                  \
        const int g_nk = (K_) / 32;                                                                                                        \
        u32x4 g_ra0, g_ra1; f32x4 g_rb0, g_rb1, g_rb2, g_rb3;                                                                              \
        const u32x4 g_z = {0u, 0u, 0u, 0u};                                                                                                \
        _Pragma("unroll") for (int mb = 0; mb < 4; ++mb) { _Pragma("unroll") for (int nb = 0; nb < 2; ++nb) { _Pragma("unroll") for (int r = 0; r < 16; ++r) acc[mb][nb][r] = 0.f; } } \
        g_ra0 = g_pa0 ? *(const u32x4*)(g_pa0 + g_kc * 8) : g_z; g_ra1 = g_pa1 ? *(const u32x4*)(g_pa1 + g_kc * 8) : g_z;                 \
        g_rb0 = *(const f32x4*)(g_pb); g_rb1 = *(const f32x4*)(g_pb + g_ldb); g_rb2 = *(const f32x4*)(g_pb + 2 * g_ldb); g_rb3 = *(const f32x4*)(g_pb + 3 * g_ldb); \
        _Pragma("unroll 1") for (int kt = 0; kt < g_nk; ++kt) {                                                                            \
            LAS char* As = lds + (kt & 1) * STAGE_BYTES; LAS char* Bs = As + 256 * LDP * 2;                                                \
            *(LAS u32x4*)(As + ((g_tid >> 2) * LDP + g_kc * 8) * 2) = g_ra0;                                                               \
            *(LAS u32x4*)(As + (((g_tid >> 2) + 128) * LDP + g_kc * 8) * 2) = g_ra1;                                                       \
            _Pragma("unroll") for (int i = 0; i < 4; ++i) {                                                                                \
                u32x2 w; w[0] = cvtpk(g_rb0[i], g_rb1[i]); w[1] = cvtpk(g_rb2[i], g_rb3[i]);                                               \
                *(LAS u32x2*)(Bs + ((g_wave * 32 + i * 8 + g_n4) * LDP + g_kq * 4) * 2) = w;                                               \
            }                                                                                                                              \
            __syncthreads();                                                                                                               \
            if (kt + 1 < g_nk) {                                                                                                           \
                const int ko = (kt + 1) * 32;                                                                                              \
                g_ra0 = g_pa0 ? *(const u32x4*)(g_pa0 + ko + g_kc * 8) : g_z; g_ra1 = g_pa1 ? *(const u32x4*)(g_pa1 + ko + g_kc * 8) : g_z; \
                const float* pbk = g_pb + (size_t)ko * g_ldb;                                                                              \
                g_rb0 = *(const f32x4*)(pbk); g_rb1 = *(const f32x4*)(pbk + g_ldb); g_rb2 = *(const f32x4*)(pbk + 2 * g_ldb); g_rb3 = *(const f32x4*)(pbk + 3 * g_ldb); \
            }                                                                                                                              \
            _Pragma("unroll") for (int s = 0; s < 2; ++s) {                                                                                \
                bf16x8 af[4], bfr[2];                                                                                                      \
                _Pragma("unroll") for (int mb = 0; mb < 4; ++mb) af[mb] = *(LAS bf16x8*)(As + ((g_wm * 128 + mb * 32 + g_r32) * LDP + s * 16 + g_hi * 8) * 2); \
                _Pragma("unroll") for (int nb = 0; nb < 2; ++nb) bfr[nb] = *(LAS bf16x8*)(Bs + (((g_wn * 2 + nb) * 32 + g_r32) * LDP + s * 16 + g_hi * 8) * 2); \
                _Pragma("unroll") for (int mb = 0; mb < 4; ++mb) { _Pragma("unroll") for (int nb = 0; nb < 2; ++nb) acc[mb][nb] = MFMA_BF16(af[mb], bfr[nb], acc[mb][nb]); } \
            }                                                                                                                              \
        }                                                                                                                                  \
        __syncthreads();                                                                                                                   \
    }

struct AttnSt { float m, l; f32x16 o0, o1; };

struct AttnFr { bf16x8 k[4]; bf16x8 v[4]; };
__device__ __forceinline__ void attn_load(AttnFr& f, const u16* krow, const u16* vt, size_t vt_dstride) {
#pragma unroll
    for (int d0 = 0; d0 < 4; ++d0) f.k[d0] = *(const bf16x8*)(krow + d0 * 16);
    const u16* vt1 = vt + 32 * vt_dstride;
    union { bf16x8 v; u32x2 h[2]; } va;
    va.h[0] = *(const u32x2*)(vt);       va.h[1] = *(const u32x2*)(vt + 8);   f.v[0] = va.v;
    va.h[0] = *(const u32x2*)(vt + 16);  va.h[1] = *(const u32x2*)(vt + 24);  f.v[1] = va.v;
    va.h[0] = *(const u32x2*)(vt1);      va.h[1] = *(const u32x2*)(vt1 + 8);  f.v[2] = va.v;
    va.h[0] = *(const u32x2*)(vt1 + 16); va.h[1] = *(const u32x2*)(vt1 + 24); f.v[3] = va.v;
}
__device__ __forceinline__ void attn_compute(AttnSt& st, const bf16x8 (&qf)[4], const AttnFr& f, int dist0, float bslope, int dlo, int dhi, int hi) {
    f32x16 p;
#pragma unroll
    for (int r = 0; r < 16; ++r) p[r] = 0.f;
#pragma unroll
    for (int d0 = 0; d0 < 4; ++d0) p = MFMA_BF16(f.k[d0], qf[d0], p);
    constexpr float C2 = 0.125f * LOG2E;
    float mx = NEGV;
#pragma unroll
    for (int r = 0; r < 16; ++r) {
        const int dist = dist0 - ((r & 3) + 8 * (r >> 2));
        const float sc = __builtin_fmaf(p[r], C2, -bslope * (float)dist);
        const float s_ = (dist >= dlo && dist <= dhi) ? sc : NEGV;
        p[r] = s_; mx = fmaxf(mx, s_);
    }
    mx = fmaxf(mx, __shfl_xor(mx, 32));
    const float mnew = fmaxf(st.m, mx);
    const float alpha = __builtin_amdgcn_exp2f(st.m - mnew);
    st.m = mnew;
    float ls = 0.f;
#pragma unroll
    for (int r = 0; r < 16; ++r) { p[r] = __builtin_amdgcn_exp2f(p[r] - mnew); ls += p[r]; }
    st.l = st.l * alpha + ls;
#pragma unroll
    for (int r = 0; r < 16; ++r) { st.o0[r] *= alpha; st.o1[r] *= alpha; }
    union { bf16x8 v; unsigned u[4]; } pb0, pb1;
#pragma unroll
    for (int j = 0; j < 4; ++j) { pb0.u[j] = cvtpk(p[2 * j], p[2 * j + 1]); pb1.u[j] = cvtpk(p[8 + 2 * j], p[8 + 2 * j + 1]); }
    st.o0 = MFMA_BF16(f.v[0], pb0.v, st.o0);
    st.o0 = MFMA_BF16(f.v[1], pb1.v, st.o0);
    st.o1 = MFMA_BF16(f.v[2], pb0.v, st.o1);
    st.o1 = MFMA_BF16(f.v[3], pb1.v, st.o1);
    (void)hi;
}

__device__ __forceinline__ float dpp_rowmax(float v) {
    v = fmaxf(v, __int_as_float(__builtin_amdgcn_update_dpp(0, __float_as_int(v), 0xB1, 0xF, 0xF, true)));
    v = fmaxf(v, __int_as_float(__builtin_amdgcn_update_dpp(0, __float_as_int(v), 0x4E, 0xF, 0xF, true)));
    v = fmaxf(v, __int_as_float(__builtin_amdgcn_update_dpp(0, __float_as_int(v), 0x141, 0xF, 0xF, true)));
    v = fmaxf(v, __int_as_float(__builtin_amdgcn_update_dpp(0, __float_as_int(v), 0x140, 0xF, 0xF, true)));
    return v;
}
__device__ __forceinline__ int dpp_rowmin_i(int v) {
    v = min(v, __builtin_amdgcn_update_dpp(0, v, 0xB1, 0xF, 0xF, true));
    v = min(v, __builtin_amdgcn_update_dpp(0, v, 0x4E, 0xF, 0xF, true));
    v = min(v, __builtin_amdgcn_update_dpp(0, v, 0x141, 0xF, 0xF, true));
    v = min(v, __builtin_amdgcn_update_dpp(0, v, 0x140, 0xF, 0xF, true));
    return v;
}
__device__ __forceinline__ float rl_f(float v, int l) { return __int_as_float(__builtin_amdgcn_readlane(__float_as_int(v), l)); }

__device__ __forceinline__ void top3_insert(float v, int i, float& v0, int& i0, float& v1, int& i1, float& v2, int& i2) {
    const bool b0 = (v > v0) || (v == v0 && i < i0);
    const bool b1 = (v > v1) || (v == v1 && i < i1);
    const bool b2 = (v > v2) || (v == v2 && i < i2);
    const float nv2 = b1 ? v1 : (b2 ? v : v2); const int ni2 = b1 ? i1 : (b2 ? i : i2);
    const float nv1 = b0 ? v0 : (b1 ? v : v1); const int ni1 = b0 ? i0 : (b1 ? i : i1);
    const float nv0 = b0 ? v : v0;             const int ni0 = b0 ? i : i0;
    v0 = nv0; i0 = ni0; v1 = nv1; i1 = ni1; v2 = nv2; i2 = ni2;
}

__device__ __forceinline__ void ln_row(float (&v)[16], const float* __restrict__ g, const float* __restrict__ b, int lane) {
    float s = 0.f;
#pragma unroll
    for (int i = 0; i < 16; ++i) s += v[i];
    const float mu = wave_sum(s) * (1.f / D);
    float q = 0.f;
#pragma unroll
    for (int i = 0; i < 16; ++i) { const float d = v[i] - mu; q += d * d; }
    const float rstd = rsqrtf(wave_sum(q) * (1.f / D) + LN_EPS);
#pragma unroll
    for (int j = 0; j < 4; ++j) {
        const f32x4 gg = *(const f32x4*)(g + j * 256 + lane * 4), bb = *(const f32x4*)(b + j * 256 + lane * 4);
#pragma unroll
        for (int c = 0; c < 4; ++c) v[j * 4 + c] = (v[j * 4 + c] - mu) * rstd * gg[c] + bb[c];
    }
}

typedef __attribute__((ext_vector_type(2))) float f32x2_;
__device__ __forceinline__ bf16x8 fp8x8_to_bf16(unsigned lo, unsigned hi_) {
    const f32x2_ a = __builtin_amdgcn_cvt_pk_f32_fp8((int)lo, false), b = __builtin_amdgcn_cvt_pk_f32_fp8((int)lo, true);
    const f32x2_ c = __builtin_amdgcn_cvt_pk_f32_fp8((int)hi_, false), d = __builtin_amdgcn_cvt_pk_f32_fp8((int)hi_, true);
    union { bf16x8 v; unsigned u[4]; } r;
    r.u[0] = cvtpk(a[0], a[1]); r.u[1] = cvtpk(b[0], b[1]); r.u[2] = cvtpk(c[0], c[1]); r.u[3] = cvtpk(d[0], d[1]);
    return r.v;
}
__device__ __forceinline__ unsigned pack_fp8x4(float a, float b, float c, float d) { int p = __builtin_amdgcn_cvt_pk_fp8_f32(a, b, 0, false); return (unsigned)__builtin_amdgcn_cvt_pk_fp8_f32(c, d, p, true); }

constexpr int MOE_BP = 72;
constexpr int MOE_BSTAGE = 128 * MOE_BP * 2;
constexpr int MOE_LDS_VA = 3 * MOE_BSTAGE;
constexpr int MOE_LDS_W = MOE_LDS_VA + 4096;
template <bool DOWN>
__device__ __forceinline__ void moe_expert(LAS char* lds, const int tid, const int lane, const int wave, const int r32, const int hi,
                                           const unsigned char* __restrict__ abase  , const float* __restrict__ w0, const float* __restrict__ w1, const int ng  , void* __restrict__ outv) {
    constexpr int KT = DOWN ? 4 : 16, NP = DOWN ? 8 : 4, LDB = DOWN ? 1024 : 256, APITCH = DOWN ? 256 : 1024  , PSTEP = DOWN ? 128 : 64;
    LAS int* rowva = (LAS int*)(lds + MOE_LDS_VA); LAS float* roww = (LAS float*)(lds + MOE_LDS_W);
    const int nst = (ng + 511) >> 9;
    const int nsteps = NP * nst * KT;
    unsigned aoff[2];
#define MOE_AOFF(ST_) { _Pragma("unroll") for (int a = 0; a < 2; ++a) { const int va_ = rowva[(ST_) * 512 + wave * 64 + a * 32 + r32]; \
        const int srow_ = DOWN ? va_ : (va_ == TRASH_VA ? 0 : (va_ >> 3)); aoff[a] = (unsigned)srow_ * APITCH + hi * 32; } }
    const int seg = wave >> 1, n4 = lane & 7, kp = (wave & 1) * 16 + (lane >> 3);
    const char* wbase = (const char*)(DOWN ? (w0 + seg * 32) : (((seg < 2) ? w0 : w1) + (seg & 1) * 32));
    const unsigned boff = (unsigned)(4 * n4 + 2 * kp * LDB) * 4u;
    f32x16 acc[2][4];
#pragma unroll
    for (int a = 0; a < 2; ++a)
#pragma unroll
        for (int c = 0; c < 4; ++c)
#pragma unroll
            for (int r = 0; r < 16; ++r) acc[a][c][r] = 0.f;
    u32x4 fa8[2][2];
    f32x4 rb0[4], rb1[4];
#define MOE_DEC(S_) const int s2_ = (S_) < nsteps ? (S_) : 0; const int ps_ = s2_ / (nst * KT); const int rm_ = s2_ - ps_ * (nst * KT); const int stt_ = rm_ / KT; const int kt_ = rm_ - stt_ * KT;
#define MOE_LOADB(S_, RB) { MOE_DEC(S_) (void)stt_; \
        const char* wp_ = wbase + (size_t)(ps_ * PSTEP + kt_ * 64 * LDB) * 4 + boff; \
        RB[0] = *(const f32x4*)(wp_); RB[1] = *(const f32x4*)(wp_ + LDB * 4); RB[2] = *(const f32x4*)(wp_ + 16 * LDB * 4); RB[3] = *(const f32x4*)(wp_ + 17 * LDB * 4); }
#define MOE_WRITEB(STG, RB) { LAS char* Bs_ = lds + (STG) * MOE_BSTAGE; \
        _Pragma("unroll") for (int i = 0; i < 4; ++i) { LAS unsigned* q_ = (LAS unsigned*)(Bs_ + ((seg * 32 + i * 8 + n4) * MOE_BP + 2 * kp) * 2); q_[0] = cvtpk(RB[0][i], RB[1][i]); q_[8] = cvtpk(RB[2][i], RB[3][i]); } }
#define MOE_COMPUTE(STG, DO_MFMA) { LAS char* Bs_ = lds + (STG) * MOE_BSTAGE; \
        _Pragma("unroll") for (int u = 0; u < 4; ++u) { \
            bf16x8 bfr[4]; \
            if (DO_MFMA) { _Pragma("unroll") for (int c = 0; c < 4; ++c) bfr[c] = *(LAS bf16x8*)(Bs_ + ((c * 32 + r32) * MOE_BP + hi * 32 + u * 8) * 2); } \
            _Pragma("unroll") for (int a = 0; a < 2; ++a) { \
                if (DO_MFMA) { const bf16x8 af_ = fp8x8_to_bf16(fa8[a][u >> 1][(u & 1) * 2], fa8[a][u >> 1][(u & 1) * 2 + 1]); \
                    _Pragma("unroll") for (int c = 0; c < 4; ++c) acc[a][c] = MFMA_BF16(bfr[c], af_, acc[a][c]); } \
                if (u & 1) fa8[a][u >> 1] = *(const u32x4*)(ab_n + aoff[a] + (u >> 1) * 16); \
            } \
        } }
#define MOE_NEXTA(S_) MOE_DEC(S_) (void)ps_; \
        if (stt_ != st_loaded) { MOE_AOFF(stt_) st_loaded = stt_; } \
        const char* ab_n = (const char*)abase + kt_ * 64;
    int st_loaded = 0;
    MOE_AOFF(0)
    { const char* ab0 = (const char*)abase;
#pragma unroll
      for (int a = 0; a < 2; ++a)
#pragma unroll
          for (int h2 = 0; h2 < 2; ++h2) fa8[a][h2] = *(const u32x4*)(ab0 + aoff[a] + h2 * 16); }
    MOE_LOADB(0, rb0)
    MOE_LOADB(1, rb1)
    MOE_WRITEB(0, rb0)
    MOE_LOADB(2, rb0)
    int stg = 0;
#pragma unroll 1
    for (int sidx = 0; sidx < nsteps; sidx += 2) {
        const int ps = sidx / (nst * KT); const int rm = sidx - ps * (nst * KT); const int stt = rm / KT; const int kt = rm - stt * KT;
        const bool wv = (wave * 64) < (ng - stt * 512);
        const int stg1 = stg == 2 ? 0 : stg + 1, stg2 = stg1 == 2 ? 0 : stg1 + 1;
        __syncthreads();
        MOE_WRITEB(stg1, rb1)
        MOE_LOADB(sidx + 3, rb1)
        { MOE_NEXTA(sidx + 1)
          if (wv) MOE_COMPUTE(stg, true) else MOE_COMPUTE(stg, false) }
        __syncthreads();
        MOE_WRITEB(stg2, rb0)
        MOE_LOADB(sidx + 4, rb0)
        { MOE_NEXTA(sidx + 2)
          if (wv) MOE_COMPUTE(stg1, true) else MOE_COMPUTE(stg1, false) }
        stg = stg2;
        if (kt == KT - 2) {
            if (wv) {
                const int nrows = ng - stt * 512;
#pragma unroll
                for (int a = 0; a < 2; ++a) {
                    if (a == 0 || (wave * 64 + 32) < nrows) {
                        const int lrow = stt * 512 + wave * 64 + a * 32 + r32;
                        const unsigned va = (unsigned)rowva[lrow];
                        if (DOWN) {
                            const float w = roww[lrow];
#pragma unroll
                            for (int c = 0; c < 4; ++c) {
                                u32x4 q0, q1;
#pragma unroll
                                for (int jj = 0; jj < 4; ++jj) {
                                    const int j0 = 2 * jj, j1 = 2 * jj + 1, j2 = 8 + 2 * jj, j3 = 9 + 2 * jj;
                                    q0[jj] = cvtpk(acc[a][c][(j0 >> 2) + 4 * (j0 & 3)] * w, acc[a][c][(j1 >> 2) + 4 * (j1 & 3)] * w);
                                    q1[jj] = cvtpk(acc[a][c][(j2 >> 2) + 4 * (j2 & 3)] * w, acc[a][c][(j3 >> 2) + 4 * (j3 & 3)] * w);
                                }
                                u16* o = (u16*)outv + (size_t)va * D + ps * 128 + c * 32 + 16 * hi;
                                *(u32x4*)o = q0; *(u32x4*)(o + 8) = q1;
                            }
                        } else {
#pragma unroll
                            for (int c = 0; c < 2; ++c) {
                                float hv[16];
#pragma unroll
                                for (int j = 0; j < 16; ++j) { const int r = (j >> 2) + 4 * (j & 3); const float gt = acc[a][c][r], up = acc[a][c + 2][r]; hv[j] = gt / (1.f + __expf(-gt)) * up; }
                                u32x4 q;
#pragma unroll
                                for (int jj = 0; jj < 4; ++jj) q[jj] = pack_fp8x4(hv[4 * jj], hv[4 * jj + 1], hv[4 * jj + 2], hv[4 * jj + 3]);
                                *(u32x4*)((unsigned char*)outv + (size_t)va * DF + ps * 64 + c * 32 + 16 * hi) = q;
                            }
                        }
                    }
                }
#pragma unroll
                for (int a = 0; a < 2; ++a)
#pragma unroll
                    for (int c = 0; c < 4; ++c)
#pragma unroll
                        for (int r = 0; r < 16; ++r) acc[a][c][r] = 0.f;
            }
        }
    }
    __syncthreads();
#undef MOE_AOFF
#undef MOE_DEC
#undef MOE_LOADB
#undef MOE_WRITEB
#undef MOE_COMPUTE
#undef MOE_NEXTA
}

constexpr int N_PHASES = 21;

#define P_x_in CTX_IN(0)
#define P_xb ((u16*)(ws + WS_XB))
#define P_x1 ((float*)(ws + WS_X1))
#define P_x2 ((float*)(ws + WS_X2))
#define P_ypre ((float*)(ws + WS_YPRE))
#define P_qkv ((u16*)(ws + WS_QKV))
#define P_vT ((u16*)(ws + WS_VT))
#define P_kmean ((float*)(ws + WS_KM))
#define P_ao ((u16*)(ws + WS_AO))
#define P_og ((u16*)(ws + WS_OG))
#define P_lse ((float*)(ws + WS_LSE))
#define P_topw ((float*)(ws + WS_TOPW))
#define P_list ((int*)(ws + WS_LIST))
#define P_hb ((u16*)(ws + WS_HB))
#define P_yb ((u16*)(ws + WS_YB))
#define P_cnt_all ((int*)(ws + WS_CTL + CTL_CNT_OFF))
#define P_xb8 ((unsigned char*)(ws + WS_XB8))
#define P_hbs ((u16*)(ws + WS_HBS))
#define P_selm ((unsigned*)(ws + WS_SELM))
#define P_part ((u16*)(ws + WS_PART))
#define P_plse ((float*)(ws + WS_PLSE))
#define PH_BEGIN int tid = threadIdx.x; asm volatile("" : "+v"(tid)); const int lane = tid & 63, r32 = lane & 31, hi = lane >> 5; const int wave = __builtin_amdgcn_readfirstlane(tid >> 6); (void)lane; (void)r32; (void)hi; (void)wave
constexpr int LDS_CTX = LDS_BAR + 16;
__device__ __forceinline__ uint64_t ctx_ld(int i) {
    extern __shared__ __attribute__((aligned(16))) unsigned char lds_raw[];
    const LAS unsigned* q = (const LAS unsigned*)((LAS char*)lds_raw + LDS_CTX) + 2 * i;
    const unsigned lo = __builtin_amdgcn_readfirstlane(q[0]), hi = __builtin_amdgcn_readfirstlane(q[1]);
    return ((uint64_t)hi << 32) | lo;
}
typedef __attribute__((address_space(1))) unsigned char gbyte;
#define AS_GLOBAL(T, u64v) ((T*)(gbyte*)(u64v))
#define CTX_IN(i) AS_GLOBAL(const float, ctx_ld(i))
#define PH_FN_BEGIN \
    extern __shared__ __attribute__((aligned(16))) unsigned char lds_raw[]; \
    LAS char* lds = (LAS char*)lds_raw; (void)lds; \
    const int G = gridDim.x, bid = blockIdx.x; (void)G; (void)bid; \
    unsigned char* const ws = AS_GLOBAL(unsigned char, ctx_ld(17)); (void)ws; \
    const int NQ = L == 0 ? 3072 : 9216; (void)NQ; \
    int* cnt = P_cnt_all + L * NE; (void)cnt;
__device__ __forceinline__ void ph_p0(int L, int rep_) {
    PH_FN_BEGIN
    (void)rep_;
    PH_BEGIN;
    for (size_t i = (size_t)bid * NTHR + tid; i < (size_t)T * D / 4; i += (size_t)G * NTHR) {
        const f32x4 v = *(const f32x4*)(P_x_in + i * 4);
        u32x2 w; w[0] = cvtpk(v[0], v[1]); w[1] = cvtpk(v[2], v[3]);
        *(u32x2*)(P_xb + i * 4) = w;
    }
    LAS float* tl = (LAS float*)lds;
    for (int it = bid; it < 3968 + 128; it += G) {
        int seg, kt;
        if (it < 3840) { seg = it >> 4; kt = it & 15; } else if (it < 3968) { seg = 240 + ((it - 3840) >> 2); kt = (it - 3840) & 3; } else { seg = 272 + ((it - 3968) >> 4); kt = (it - 3968) & 15; }
        const float* src; int ld; u16* dst; int Kd = 1024; u16* dst_lo = nullptr;
        if (seg < 48) { const int col = 64 * seg; src = CTX_IN(1) + col; ld = 3072; dst = col < 2048 ? (u16*)(ws + WS_WQK0) + (size_t)col * 1024 : (u16*)(ws + WS_WV0) + (size_t)(col - 2048) * 1024; }
        else if (seg < 192) { const int col = 64 * (seg - 48), g = col / 3072, w = col - g * 3072; src = CTX_IN(2) + col; ld = 9216;
            dst = w < 2048 ? (u16*)(ws + WS_WQK1) + (size_t)(g * 2048 + w) * 1024 : (u16*)(ws + WS_WV1) + (size_t)(g * 1024 + w - 2048) * 1024; }
        else if (seg < 224) { const int s2 = seg - 192, l2 = s2 >> 4, col = 64 * (s2 & 15); src = CTX_IN(3) + (size_t)l2 * D * D + col; ld = 1024; dst = (u16*)(ws + WS_WO) + (size_t)l2 * D * D + (size_t)col * 1024; }
        else if (seg < 240) { const int s2 = seg - 224, l2 = s2 >> 3, i8 = s2 & 7, un = i8 >> 2, q = i8 & 3;
            src = (q < 2 ? CTX_IN(11) : CTX_IN(12)) + (size_t)l2 * D * DF + un * 128 + 64 * (q & 1); ld = 256; dst = (u16*)(ws + WS_WSGU) + (size_t)l2 * 512 * 1024 + (size_t)(64 * i8) * 1024; }
        else if (seg < 272) { const int s2 = seg - 240, l2 = s2 >> 4, col = 64 * (s2 & 15); src = CTX_IN(13) + (size_t)l2 * DF * D + col; ld = 1024; Kd = 256; dst = (u16*)(ws + WS_WSD) + (size_t)l2 * D * DF + (size_t)col * 256; }
        else { const int s2 = seg - 272, l2 = s2 >> 2, col = 64 * (s2 & 3); src = CTX_IN(6) + (size_t)l2 * D * NE + col; ld = 256; dst = (u16*)(ws + WS_WRH) + (size_t)l2 * NE * D + (size_t)col * 1024; dst_lo = (u16*)(ws + WS_WRL) + (size_t)l2 * NE * D + (size_t)col * 1024; }
        {
            const int kr = tid >> 4, c4 = tid & 15;
#pragma unroll
            for (int i = 0; i < 2; ++i) {
                const f32x4 v = *(const f32x4*)(src + (size_t)(kt * 64 + kr + 32 * i) * ld + 4 * c4);
#pragma unroll
                for (int jj = 0; jj < 4; ++jj) tl[(kr + 32 * i) * 65 + 4 * c4 + jj] = v[jj];
            }
        }
        __syncthreads();
        {
            const int row = tid >> 3, kc = tid & 7;
            float f[8];
#pragma unroll
            for (int jj = 0; jj < 8; ++jj) f[jj] = tl[(8 * kc + jj) * 65 + row];
            u32x4 w; w[0] = cvtpk(f[0], f[1]); w[1] = cvtpk(f[2], f[3]); w[2] = cvtpk(f[4], f[5]); w[3] = cvtpk(f[6], f[7]);
            *(u32x4*)(dst + (size_t)row * Kd + kt * 64 + 8 * kc) = w;
            if (dst_lo) {
                u32x4 wl;
#pragma unroll
                for (int jj = 0; jj < 4; ++jj) wl[jj] = cvtpk(f[2 * jj] - bf2f(w[jj] & 0xFFFFu), f[2 * jj + 1] - bf2f(w[jj] >> 16));
                *(u32x4*)(dst_lo + (size_t)row * Kd + kt * 64 + 8 * kc) = wl;
            }
        }
        __syncthreads();
    }
}

__device__ __forceinline__ void ph_qkv(int L, int rep_) {
    PH_FN_BEGIN
    (void)rep_;
    {
        const pg8::Gemm g{P_xb, (const u16*)(ws + (L == 0 ? WS_WQK0 : WS_WQK1)), T, L == 0 ? 2048 : 6144, D};
        pg8::StaticOrder S; S.init(g.M, g.N, G, bid);
        const EpiQK E{P_qkv, NQ};
        pg8::gemm_phase<EpiQK, pg8::StaticOrder, false>((PG8_LAS unsigned char*)lds, g, S, E, nullptr);
    }
    {
        const pg8::Gemm g{P_xb, (const u16*)(ws + (L == 0 ? WS_WV0 : WS_WV1)), T, L == 0 ? 1024 : 3072, D};
        pg8::StaticOrder S; S.init(g.M, g.N, G, bid);
        const EpiV E{P_vT, L};
        pg8::gemm_phase<EpiV, pg8::StaticOrder, true>((PG8_LAS unsigned char*)lds, g, S, E, nullptr);
    }
}

__device__ __forceinline__ void ph_kmean(int L, int rep_) {
    PH_FN_BEGIN
    (void)rep_;

            PH_BEGIN;
                LAS float* red = (LAS float*)lds;
                for (int it = bid; it < BATCH * NH * MOBA_NB; it += G) {
                    const int j = it & 31, h = (it >> 5) & 15, b = it >> 9;
                    const int d = tid & 63, part = tid >> 6;
                    const u16* kp = P_qkv + (size_t)(b * SEQ + j * MOBA_BLK + part * 32) * 3072 + 1024 + h * 64 + d;
                    float s = 0.f;
                    for (int k = 0; k < 32; ++k) s += bf2f(kp[(size_t)k * 3072]);
                    red[part * 64 + d] = s;
                    __syncthreads();
                    if (tid < 64) {
                        float tot = 0.f;
#pragma unroll
                        for (int p8 = 0; p8 < 8; ++p8) tot += red[p8 * 64 + tid];
                        P_kmean[(size_t)it * 64 + tid] = tot * (1.f / MOBA_BLK);
                    }
                    __syncthreads();
                }

}

__device__ __forceinline__ void ph_gate(int L, int rep_) {
    PH_FN_BEGIN
    (void)rep_;
    PH_BEGIN;
    for (int it = bid; it < BATCH * NH * MOBA_NB; it += G) {
        const int qb = it & 31, bh = it >> 5, b = bh >> 4, h = bh & 15;
        const int tq = qb * MOBA_BLK + wave * 32 + r32;
        const u16* qrow = P_qkv + (size_t)(b * SEQ + tq) * 3072 + h * 64 + hi * 8;
        bf16x8 qf[4];
#pragma unroll
        for (int d0 = 0; d0 < 4; ++d0) qf[d0] = *(const bf16x8*)(qrow + d0 * 16);
        unsigned selmask = 0u;
        if (qb > 0) {
            const float* km = P_kmean + ((size_t)(b * NH + h) * MOBA_NB + r32) * 64 + hi * 8;
            f32x16 gt;
#pragma unroll
            for (int r = 0; r < 16; ++r) gt[r] = 0.f;
#pragma unroll
            for (int d0 = 0; d0 < 4; ++d0) {
                const f32x4 k0 = *(const f32x4*)(km + d0 * 16), k1 = *(const f32x4*)(km + d0 * 16 + 4);
                union { bf16x8 v; unsigned u[4]; } kf;
                kf.u[0] = cvtpk(k0[0], k0[1]); kf.u[1] = cvtpk(k0[2], k0[3]); kf.u[2] = cvtpk(k1[0], k1[1]); kf.u[3] = cvtpk(k1[2], k1[3]);
                gt = MFMA_BF16(kf.v, qf[d0], gt);
            }
            float v0 = -INFINITY, v1 = -INFINITY, v2 = -INFINITY; int i0 = 99, i1 = 99, i2 = 99;
#pragma unroll
            for (int r = 0; r < 16; ++r) { const int jb = crow(r, hi); const float gv = jb < qb ? gt[r] : -INFINITY; top3_insert(gv, jb < qb ? jb : 99, v0, i0, v1, i1, v2, i2); }
            const float ov0 = __shfl_xor(v0, 32), ov1 = __shfl_xor(v1, 32), ov2 = __shfl_xor(v2, 32);
            const int oi0 = __shfl_xor(i0, 32), oi1 = __shfl_xor(i1, 32), oi2 = __shfl_xor(i2, 32);
            top3_insert(ov0, oi0, v0, i0, v1, i1, v2, i2); top3_insert(ov1, oi1, v0, i0, v1, i1, v2, i2); top3_insert(ov2, oi2, v0, i0, v1, i1, v2, i2);
            if (i0 < 32) selmask |= 1u << i0;
            if (i1 < 32) selmask |= 1u << i1;
            if (i2 < 32) selmask |= 1u << i2;
        }
        if (hi == 0) P_selm[(size_t)bh * SEQ + tq] = selmask;
    }
}

constexpr int MB_KP = 72;
constexpr int MB_VP = 260;
constexpr int MB_LDS_K = 0;
constexpr int MB_LDS_V = 256 * MB_KP * 2;
constexpr int MB_LDS_LIST = MB_LDS_V + 64 * MB_VP * 2;
constexpr int MB_LDS_CTR = MB_LDS_LIST + 8192 * 2;
__device__ __forceinline__ void ph_moba(int L, int rep_) {
    PH_FN_BEGIN
    (void)rep_;
    PH_BEGIN;
    LAS char* Ks = lds + MB_LDS_K; LAS char* Vs = lds + MB_LDS_V;
    LAS u16* qlist = (LAS u16*)(lds + MB_LDS_LIST); LAS int* ctr = (LAS int*)(lds + MB_LDS_CTR);
    for (int it = bid; it < BATCH * NH * MOBA_NB; it += G) {
        const int rnd = it >> 8, w8 = it & 255, a8 = w8 >> 5, bh = w8 & 31;
        const int j = rnd == 0 ? a8 : (rnd == 1 ? 15 - a8 : (rnd == 2 ? 16 + a8 : 31 - a8));
        const int b = bh >> 4, h = bh & 15;
        const float slope2 = exp2f(-0.5f * (float)(h + 1)) * LOG2E;
        if (tid == 0) { int z0 = 0; asm volatile("" : "+v"(z0)); ctr[0] = z0; ctr[1] = z0; }
        {
            const u16* kg = P_qkv + (size_t)(b * SEQ + j * MOBA_BLK) * 3072 + 1024 + h * 64;
#pragma unroll
            for (int i = 0; i < 4; ++i) { const int c = tid + i * 512, row = c >> 3, ch = c & 7; *(LAS u32x4*)(Ks + (row * MB_KP + ch * 8) * 2) = *(const u32x4*)(kg + (size_t)row * 3072 + ch * 8); }
            const u16* vg = P_vT + (size_t)(b * NH + h) * HD * SEQ + j * MOBA_BLK;
#pragma unroll
            for (int i = 0; i < 4; ++i) {
                const int c = tid + i * 512, d = c >> 5, ch = c & 31;
                const u32x4 v = *(const u32x4*)(vg + (size_t)d * SEQ + ch * 8);
                u32x2 w0, w1; w0[0] = v[0]; w0[1] = v[1]; w1[0] = v[2]; w1[1] = v[3];
                *(LAS u32x2*)(Vs + (d * MB_VP + ch * 8) * 2) = w0; *(LAS u32x2*)(Vs + (d * MB_VP + ch * 8 + 4) * 2) = w1;
            }
        }
        __syncthreads();
        {
            const unsigned* sm = P_selm + (size_t)bh * SEQ;
            for (int t0 = (j + 1) * MOBA_BLK; t0 < SEQ; t0 += 512) {
                const int t = t0 + tid;
                const bool sel = (t < SEQ) && ((sm[t < SEQ ? t : 0] >> j) & 1u);
                const unsigned long long bal = __ballot(sel);
                const int total = __popcll(bal);
                int wb = 0;
                if (lane == 0 && total) wb = atomicAdd((int*)&ctr[0], total);
                wb = __shfl(wb, 0);
                if (sel) qlist[wb + __popcll(bal & ((1ull << lane) - 1ull))] = (u16)t;
            }
        }
        __syncthreads();
        const int nq = ctr[0];
        const int ntiles = 8 + ((nq + 31) >> 5);
        for (;;) {
            int ti = 0;
            if (lane == 0) ti = atomicAdd((int*)&ctr[1], 1);
            ti = __shfl(ti, 0);
            if (ti >= ntiles) break;
            const bool own = ti < 8;
            const int wq = 7 - ti;
            const int li = (ti - 8) * 32 + r32;
            const bool valid = own || li < nq;
            const int tq = own ? j * MOBA_BLK + wq * 32 + r32 : (int)qlist[li < nq ? li : nq - 1];
            const int nsteps = own ? wq + 1 : 8;
            const u16* qrow = P_qkv + (size_t)(b * SEQ + tq) * 3072 + h * 64 + hi * 8;
            bf16x8 qf[4];
#pragma unroll
            for (int d0 = 0; d0 < 4; ++d0) qf[d0] = *(const bf16x8*)(qrow + d0 * 16);
            int slot = 3;
            if (!own) slot = __popc(P_selm[(size_t)bh * SEQ + tq] & ((1u << j) - 1u));
            AttnSt st; st.m = NEGV; st.l = 0.f;
#pragma unroll
            for (int r = 0; r < 16; ++r) { st.o0[r] = 0.f; st.o1[r] = 0.f; }
            const int dlo = own ? 0 : -0x40000000;
            for (int kt = 0; kt < nsteps; ++kt) {
                AttnFr f;
#pragma unroll
                for (int d0 = 0; d0 < 4; ++d0) f.k[d0] = *(LAS bf16x8*)(Ks + ((kt * 32 + r32) * MB_KP + d0 * 16 + hi * 8) * 2);
#pragma unroll
                for (int q4 = 0; q4 < 4; ++q4) {
                    union { bf16x8 v; u32x2 hh[2]; } va;
                    LAS char* vp = Vs + (((q4 >> 1) * 32 + r32) * MB_VP + kt * 32 + (q4 & 1) * 16 + 4 * hi) * 2;
                    va.hh[0] = *(LAS u32x2*)(vp); va.hh[1] = *(LAS u32x2*)(vp + 16);
                    f.v[q4] = va.v;
                }
                attn_compute(st, qf, f, tq - (j * MOBA_BLK + kt * 32) - 4 * hi, slope2, dlo, 0x7fffffff, hi);
            }
            const float lt = st.l + __shfl_xor(st.l, 32);
            const float inv = 1.f / lt;
            if (valid) {
                const size_t pi = ((size_t)(b * SEQ + tq) * NH + h) * 4 + slot;
                u16* orow = P_part + pi * 64;
#pragma unroll
                for (int rq = 0; rq < 4; ++rq) {
                    u32x2 w; w[0] = cvtpk(st.o0[4 * rq] * inv, st.o0[4 * rq + 1] * inv); w[1] = cvtpk(st.o0[4 * rq + 2] * inv, st.o0[4 * rq + 3] * inv);
                    *(u32x2*)(orow + 8 * rq + 4 * hi) = w;
                    w[0] = cvtpk(st.o1[4 * rq] * inv, st.o1[4 * rq + 1] * inv); w[1] = cvtpk(st.o1[4 * rq + 2] * inv, st.o1[4 * rq + 3] * inv);
                    *(u32x2*)(orow + 32 + 8 * rq + 4 * hi) = w;
                }
                if (hi == 0) P_plse[pi] = st.m * LN2 + logf(lt);
            }
        }
        __syncthreads();
    }
}

__device__ __forceinline__ void ph_mobamerge(int L, int rep_) {
    PH_FN_BEGIN
    (void)rep_;
    PH_BEGIN;
    for (size_t i = (size_t)bid * NTHR + tid; i < (size_t)T * NH * 8; i += (size_t)G * NTHR) {
        const size_t row = i >> 7; const int h = (int)(i >> 3) & 15, d8 = (int)i & 7;
        const int qb = (int)(row & (SEQ - 1)) >> 8;
        const int nsel = qb < 3 ? qb : 3;
        const size_t pi = (row * NH + h) * 4;
        float l[4], w[4];
        float mx = -INFINITY;
#pragma unroll
        for (int sidx = 0; sidx < 4; ++sidx) { const bool ok = sidx == 3 || sidx < nsel; l[sidx] = ok ? P_plse[pi + sidx] : -INFINITY; mx = fmaxf(mx, l[sidx]); }
        float ws_ = 0.f;
#pragma unroll
        for (int sidx = 0; sidx < 4; ++sidx) { w[sidx] = (sidx == 3 || sidx < nsel) ? expf(l[sidx] - mx) : 0.f; ws_ += w[sidx]; }
        const float inv = 1.f / ws_;
        float acc8[8];
#pragma unroll
        for (int c = 0; c < 8; ++c) acc8[c] = 0.f;
#pragma unroll
        for (int sidx = 0; sidx < 4; ++sidx) {
            if (sidx == 3 || sidx < nsel) {
                const u32x4 a = *(const u32x4*)(P_part + (pi + sidx) * 64 + d8 * 8);
                const float ww = w[sidx] * inv;
#pragma unroll
                for (int c = 0; c < 4; ++c) { acc8[2 * c] += ww * bf2f(a[c] & 0xFFFFu); acc8[2 * c + 1] += ww * bf2f(a[c] >> 16); }
            }
        }
        u32x4 o;
#pragma unroll
        for (int c = 0; c < 4; ++c) o[c] = cvtpk(acc8[2 * c], acc8[2 * c + 1]);
        *(u32x4*)(P_ao + row * D + h * 64 + d8 * 8) = o;
    }
}

constexpr int DL_KP = 72, DL_VP = 388;
constexpr int DL_LDS_K = 0, DL_LDS_V = 384 * DL_KP * 2;
__device__ __forceinline__ void ph_dil(int L, int rep_) {
    PH_FN_BEGIN
    (void)rep_;
    PH_BEGIN;
    LAS char* Ks = lds + DL_LDS_K; LAS char* Vs = lds + DL_LDS_V;
    for (int it = bid; it < BATCH * NH * 3 * 32; it += G) {
        const int ch = it & 31, grp = (it >> 5) % 3, bh = it / 96, b = bh >> 4, h = bh & 15;
        const int dil = grp == 0 ? 1 : (grp == 1 ? 4 : 16), Ls = SEQ / dil;
        const float slope2 = exp2f(-0.5f * (float)(h + 1)) * LOG2E * (float)dil;
        const int uc = ch * 256, res = uc / Ls, c0 = uc - res * Ls;
        const int kb0 = c0 - 128;
        {
            const u16* kg = P_qkv + (size_t)(b * SEQ) * 9216 + grp * 3072 + 1024 + h * 64;
#pragma unroll
            for (int i = 0; i < 6; ++i) {
                const int c = tid + i * 512, row = c >> 3, chk = c & 7, ks = kb0 + row;
                if (ks >= 0) *(LAS u32x4*)(Ks + (row * DL_KP + chk * 8) * 2) = *(const u32x4*)(kg + (size_t)(ks * dil + res) * 9216 + chk * 8);
            }
            const u16* vg = P_vT + (size_t)grp * T * D + (size_t)(b * NH + h) * HD * SEQ + (size_t)res * Ls;
#pragma unroll
            for (int i = 0; i < 6; ++i) {
                const int c = tid + i * 512, d = c / 48, chk = c - d * 48, ks = kb0 + chk * 8;
                if (ks >= 0) {
                    const u32x4 v = *(const u32x4*)(vg + (size_t)d * SEQ + ks);
                    u32x2 w0, w1; w0[0] = v[0]; w0[1] = v[1]; w1[0] = v[2]; w1[1] = v[3];
                    *(LAS u32x2*)(Vs + (d * DL_VP + chk * 8) * 2) = w0; *(LAS u32x2*)(Vs + (d * DL_VP + chk * 8 + 4) * 2) = w1;
                }
            }
        }
        __syncthreads();
        const int i0 = c0 + wave * 32, iq = i0 + r32, pq = iq * dil + res;
        const u16* qrow = P_qkv + (size_t)(b * SEQ + pq) * 9216 + grp * 3072 + h * 64 + hi * 8;
        bf16x8 qf[4];
#pragma unroll
        for (int d0 = 0; d0 < 4; ++d0) qf[d0] = *(const bf16x8*)(qrow + d0 * 16);
        AttnSt st; st.m = NEGV; st.l = 0.f;
#pragma unroll
        for (int r = 0; r < 16; ++r) { st.o0[r] = 0.f; st.o1[r] = 0.f; }
        const int ktmin = (i0 >= 128) ? 0 : (128 - i0) >> 5;
        for (int kt = 4; kt >= ktmin; --kt) {
            const int lrow0 = (wave + kt) * 32;
            AttnFr f;
#pragma unroll
            for (int d0 = 0; d0 < 4; ++d0) f.k[d0] = *(LAS bf16x8*)(Ks + ((lrow0 + r32) * DL_KP + d0 * 16 + hi * 8) * 2);
#pragma unroll
            for (int q4 = 0; q4 < 4; ++q4) {
                union { bf16x8 v; u32x2 hh[2]; } va;
                LAS char* vp = Vs + (((q4 >> 1) * 32 + r32) * DL_VP + lrow0 + (q4 & 1) * 16 + 4 * hi) * 2;
                va.hh[0] = *(LAS u32x2*)(vp); va.hh[1] = *(LAS u32x2*)(vp + 16);
                f.v[q4] = va.v;
            }
            const int k0 = i0 - 128 + kt * 32;
            attn_compute(st, qf, f, iq - k0 - 4 * hi, slope2, 0, 128, hi);
        }
        const float lt = st.l + __shfl_xor(st.l, 32);
        const float inv = 1.f / lt;
        u16* orow = P_og + (size_t)grp * T * D + (size_t)(b * SEQ + pq) * D + h * 64;
#pragma unroll
        for (int rq = 0; rq < 4; ++rq) {
            u32x2 w; w[0] = cvtpk(st.o0[4 * rq] * inv, st.o0[4 * rq + 1] * inv); w[1] = cvtpk(st.o0[4 * rq + 2] * inv, st.o0[4 * rq + 3] * inv);
            *(u32x2*)(orow + 8 * rq + 4 * hi) = w;
            w[0] = cvtpk(st.o1[4 * rq] * inv, st.o1[4 * rq + 1] * inv); w[1] = cvtpk(st.o1[4 * rq + 2] * inv, st.o1[4 * rq + 3] * inv);
            *(u32x2*)(orow + 32 + 8 * rq + 4 * hi) = w;
        }
        if (hi == 0) P_lse[((size_t)grp * T + (b * SEQ + pq)) * NH + h] = st.m * LN2 + logf(lt);
        __syncthreads();
    }
}

__device__ __forceinline__ void ph_merge(int L, int rep_) {
    PH_FN_BEGIN
    (void)rep_;

            PH_BEGIN;
                for (size_t i = (size_t)bid * NTHR + tid; i < (size_t)T * NH * 8; i += (size_t)G * NTHR) {
                    const size_t row = i >> 7; const int h = (int)(i >> 3) & 15, d8 = (int)i & 7;
                    const float l0 = P_lse[(0 * (size_t)T + row) * NH + h], l1 = P_lse[(1 * (size_t)T + row) * NH + h], l2 = P_lse[(2 * (size_t)T + row) * NH + h];
                    const float mx = fmaxf(l0, fmaxf(l1, l2));
                    float w0 = expf(l0 - mx), w1 = expf(l1 - mx), w2 = expf(l2 - mx);
                    const float inv = 1.f / (w0 + w1 + w2); w0 *= inv; w1 *= inv; w2 *= inv;
                    const size_t off = row * D + h * 64 + d8 * 8;
                    const u32x4 a0 = *(const u32x4*)(P_og + off), a1 = *(const u32x4*)(P_og + (size_t)T * D + off), a2 = *(const u32x4*)(P_og + 2 * (size_t)T * D + off);
                    u32x4 o;
#pragma unroll
                    for (int c = 0; c < 4; ++c) {
                        const float lo_ = w0 * bf2f(a0[c] & 0xFFFFu) + w1 * bf2f(a1[c] & 0xFFFFu) + w2 * bf2f(a2[c] & 0xFFFFu);
                        const float hi_ = w0 * bf2f(a0[c] >> 16) + w1 * bf2f(a1[c] >> 16) + w2 * bf2f(a2[c] >> 16);
                        o[c] = cvtpk(lo_, hi_);
                    }
                    *(u32x4*)(P_ao + off) = o;
                }

}

__device__ __forceinline__ void ph_wo(int L, int rep_) {
    PH_FN_BEGIN
    (void)rep_;
    const pg8::Gemm g{P_ao, (const u16*)(ws + WS_WO) + (size_t)L * D * D, T, D, D};
    pg8::StaticOrder S; S.init(g.M, g.N, G, bid);
    const EpiWo E{P_ypre, L == 0 ? CTX_IN(0) : (const float*)P_x2};
    pg8::gemm_phase<EpiWo, pg8::StaticOrder, false>((PG8_LAS unsigned char*)lds, g, S, E, nullptr);
}

__device__ __forceinline__ void ph_router(int L, int rep_) {
    PH_FN_BEGIN
    (void)rep_;

            PH_BEGIN;
            const float* lng = CTX_IN(4) + L * D; const float* lnb = CTX_IN(5) + L * D;
            const float* rbias = CTX_IN(7) + L * NE;
            const u16* wrh = (const u16*)(ws + WS_WRH) + (size_t)L * NE * D; const u16* wrl = (const u16*)(ws + WS_WRL) + (size_t)L * NE * D;
            constexpr int AP = 2064;
            LAS char* ahi = lds; LAS char* alo = lds + 32 * AP;
            for (int it = bid; it < T / 32; it += G) {
                {
                    f32x4 yv[4][4];
#pragma unroll
                    for (int rr = 0; rr < 4; ++rr)
#pragma unroll
                        for (int j = 0; j < 4; ++j) yv[rr][j] = *(const f32x4*)(P_ypre + ((size_t)it * 32 + wave * 4 + rr) * D + j * 256 + lane * 4);
#pragma unroll
                    for (int rr = 0; rr < 4; ++rr) {
                        const int lr = wave * 4 + rr; const size_t row = (size_t)it * 32 + lr;
                        float v[16];
#pragma unroll
                        for (int j = 0; j < 4; ++j) { v[j * 4] = yv[rr][j][0]; v[j * 4 + 1] = yv[rr][j][1]; v[j * 4 + 2] = yv[rr][j][2]; v[j * 4 + 3] = yv[rr][j][3]; }
                        ln_row(v, lng, lnb, lane);
#pragma unroll
                        for (int j = 0; j < 4; ++j) {
                            f32x4 t4; t4[0] = v[j * 4]; t4[1] = v[j * 4 + 1]; t4[2] = v[j * 4 + 2]; t4[3] = v[j * 4 + 3];
                            *(f32x4*)(P_x1 + row * D + j * 256 + lane * 4) = t4;
                            u32x2 w; w[0] = cvtpk(t4[0], t4[1]); w[1] = cvtpk(t4[2], t4[3]);
                            *(u32x2*)(P_xb + row * D + j * 256 + lane * 4) = w;
                            *(unsigned*)(P_xb8 + row * D + j * 256 + lane * 4) = pack_fp8x4(t4[0], t4[1], t4[2], t4[3]);
                            u32x2 wl; wl[0] = cvtpk(t4[0] - bf2f(w[0] & 0xFFFFu), t4[1] - bf2f(w[0] >> 16)); wl[1] = cvtpk(t4[2] - bf2f(w[1] & 0xFFFFu), t4[3] - bf2f(w[1] >> 16));
                            *(LAS u32x2*)(ahi + lr * AP + (j * 256 + lane * 4) * 2) = w;
                            *(LAS u32x2*)(alo + lr * AP + (j * 256 + lane * 4) * 2) = wl;
                        }
                    }
                }
                __syncthreads();
                f32x16 lg;
#pragma unroll
                for (int r = 0; r < 16; ++r) lg[r] = 0.f;
                {
                    const LAS char* ah = ahi + r32 * AP + hi * 16; const LAS char* al = alo + r32 * AP + hi * 16;
                    const u16* bh = wrh + (size_t)(wave * 32 + r32) * D + hi * 8; const u16* bl = wrl + (size_t)(wave * 32 + r32) * D + hi * 8;
                    bf16x8 bha[8], bla[8], bhb[8], blb[8];
#pragma unroll
                    for (int j = 0; j < 8; ++j) { bha[j] = *(const bf16x8*)(bh + j * 16); bla[j] = *(const bf16x8*)(bl + j * 16); }
#pragma unroll 1
                    for (int k0 = 0; k0 < D; k0 += 256) {
#pragma unroll
                        for (int j = 0; j < 8; ++j) { bhb[j] = *(const bf16x8*)(bh + k0 + 128 + j * 16); blb[j] = *(const bf16x8*)(bl + k0 + 128 + j * 16); }
#pragma unroll
                        for (int j = 0; j < 8; ++j) {
                            const bf16x8 xh = *(const LAS bf16x8*)(ah + (k0 + j * 16) * 2), xl = *(const LAS bf16x8*)(al + (k0 + j * 16) * 2);
                            lg = MFMA_BF16(xh, bha[j], lg); lg = MFMA_BF16(xl, bha[j], lg); lg = MFMA_BF16(xh, bla[j], lg);
                        }
                        { const int kn = (k0 + 256 < D) ? k0 + 256 : 0;
#pragma unroll
                          for (int j = 0; j < 8; ++j) { bha[j] = *(const bf16x8*)(bh + kn + j * 16); bla[j] = *(const bf16x8*)(bl + kn + j * 16); } }
#pragma unroll
                        for (int j = 0; j < 8; ++j) {
                            const bf16x8 xh = *(const LAS bf16x8*)(ah + (k0 + 128 + j * 16) * 2), xl = *(const LAS bf16x8*)(al + (k0 + 128 + j * 16) * 2);
                            lg = MFMA_BF16(xh, bhb[j], lg); lg = MFMA_BF16(xl, bhb[j], lg); lg = MFMA_BF16(xh, blb[j], lg);
                        }
                    }
                }
                __syncthreads();
                LAS float* lgs = (LAS float*)lds;
#pragma unroll
                for (int r = 0; r < 16; ++r) lgs[crow(r, hi) * 257 + wave * 32 + r32] = lg[r];
                __syncthreads();
#pragma unroll 1
                for (int rr = 0; rr < 4; ++rr) {
                    const int lr = wave * 4 + rr; const int tok = it * 32 + lr;
                    float sc[4], ch[4];
#pragma unroll
                    for (int j = 0; j < 4; ++j) { const int e = lane + 64 * j; sc[j] = 1.f / (1.f + expf(-lgs[lr * 257 + e])); ch[j] = sc[j] + rbias[e]; }
                    float gsel[8];
#pragma unroll
                    for (int j = 0; j < 4; ++j) {
                        const float rm = dpp_rowmax(ch[j]);
                        const float m1a = fmaxf(rl_f(rm, 0), rl_f(rm, 16)), m1b = fmaxf(rl_f(rm, 32), rl_f(rm, 48));
                        const unsigned long long bal = __ballot(ch[j] == (hi ? m1b : m1a));
                        const int fa_ = __builtin_ctz((unsigned)(bal & 0xFFFFFFFFull)), fb_ = 32 + __builtin_ctz((unsigned)(bal >> 32));
                        const float c2 = (lane == fa_ || lane == fb_) ? -INFINITY : ch[j];
                        const float rm2 = dpp_rowmax(c2);
                        gsel[2 * j] = m1a + fmaxf(rl_f(rm2, 0), rl_f(rm2, 16));
                        gsel[2 * j + 1] = m1b + fmaxf(rl_f(rm2, 32), rl_f(rm2, 48));
                    }
                    float cv[4];
#pragma unroll
                    for (int j = 0; j < 4; ++j) {
                        int ra_ = 0, rb_ = 0;
#pragma unroll
                        for (int g2 = 0; g2 < 8; ++g2) {
                            ra_ += ((gsel[g2] > gsel[2 * j]) || (gsel[g2] == gsel[2 * j] && g2 < 2 * j)) ? 1 : 0;
                            rb_ += ((gsel[g2] > gsel[2 * j + 1]) || (gsel[g2] == gsel[2 * j + 1] && g2 < 2 * j + 1)) ? 1 : 0;
                        }
                        cv[j] = ((hi ? rb_ : ra_) < 4) ? ch[j] : NEGV;
                    }
                    float wsel = 0.f; int esel = 0; float wsum = 0.f;
#pragma unroll 1
                    for (int k = 0; k < TOPK; ++k) {
                        float bv = cv[0]; int be = lane;
#pragma unroll
                        for (int j = 1; j < 4; ++j) if (cv[j] > bv) { bv = cv[j]; be = lane + 64 * j; }
                        const float rm = dpp_rowmax(bv);
                        const float mval = fmaxf(fmaxf(rl_f(rm, 0), rl_f(rm, 16)), fmaxf(rl_f(rm, 32), rl_f(rm, 48)));
                        const int ri = dpp_rowmin_i(bv == mval ? be : 0x7fffffff);
                        const int e = min(min(__builtin_amdgcn_readlane(ri, 0), __builtin_amdgcn_readlane(ri, 16)), min(__builtin_amdgcn_readlane(ri, 32), __builtin_amdgcn_readlane(ri, 48)));
                        const int jl = e >> 6, ll = e & 63;
                        float smine = sc[0];
                        smine = jl == 1 ? sc[1] : smine; smine = jl == 2 ? sc[2] : smine; smine = jl == 3 ? sc[3] : smine;
                        const float sw = rl_f(smine, ll);
#pragma unroll
                        for (int j = 0; j < 4; ++j) cv[j] = (lane == ll && jl == j) ? -INFINITY : cv[j];
                        wsum += sw;
                        if (lane == k) { wsel = sw; esel = e; }
                    }
                    if (lane < TOPK) {
                        const int a = tok * TOPK + lane;
                        P_topw[a] = wsel / wsum * 2.5f;
                        if (rep_ == 0) {
                            const int pos = atomicAdd(&cnt[esel], 1);
                            P_list[(size_t)esel * T + pos] = a;
                        }
                    }
                }
                __syncthreads();
            }

}

__device__ __forceinline__ void ph_gateup(int L, int rep_) {
    PH_FN_BEGIN
    (void)rep_;
    {
        PH_BEGIN;
        const float* weg = CTX_IN(8) + (size_t)L * NE * D * DF; const float* weu = CTX_IN(9) + (size_t)L * NE * D * DF;
        LAS int* rowva = (LAS int*)(lds + MOE_LDS_VA);
        for (int e = bid; e < NE; e += G) {
            const int n = cnt[e];
            for (int r0 = 0; r0 < n; r0 += 1024) {
#pragma unroll
                for (int i = 0; i < 2; ++i) { const int idx = r0 + i * 512 + tid; rowva[i * 512 + tid] = idx < n ? P_list[(size_t)e * T + idx] : TRASH_VA; }
                __syncthreads();
                moe_expert<false>(lds, tid, lane, wave, r32, hi, P_xb8, weg + (size_t)e * D * DF, weu + (size_t)e * D * DF, (n - r0) < 1024 ? (n - r0) : 1024, (void*)P_hb);
            }
        }
    }
    {
        const pg8::Gemm g{P_xb, (const u16*)(ws + WS_WSGU) + (size_t)L * 512 * 1024, T, 512, D};
        pg8::StaticOrder S; S.init(g.M, g.N, G, (bid + 128) % G);
        const EpiSGU E{P_hbs};
        pg8::gemm_phase<EpiSGU, pg8::StaticOrder, false>((PG8_LAS unsigned char*)lds, g, S, E, nullptr);
    }
}

__device__ __forceinline__ void ph_down(int L, int rep_) {
    PH_FN_BEGIN
    (void)rep_;
    {
        PH_BEGIN;
        const float* wed = CTX_IN(10) + (size_t)L * NE * DF * D;
        LAS int* rowva = (LAS int*)(lds + MOE_LDS_VA); LAS float* roww = (LAS float*)(lds + MOE_LDS_W);
        for (int e = bid; e < NE; e += G) {
            const int n = cnt[e];
            for (int r0 = 0; r0 < n; r0 += 1024) {
#pragma unroll
                for (int i = 0; i < 2; ++i) { const int idx = r0 + i * 512 + tid; const int va = idx < n ? P_list[(size_t)e * T + idx] : TRASH_VA; rowva[i * 512 + tid] = va; roww[i * 512 + tid] = va < A_TOT ? P_topw[va] : 0.f; }
                __syncthreads();
                moe_expert<true>(lds, tid, lane, wave, r32, hi, (const unsigned char*)P_hb, wed + (size_t)e * DF * D, nullptr, (n - r0) < 1024 ? (n - r0) : 1024, (void*)P_yb);
            }
        }
    }
    {
        const pg8::Gemm g{P_hbs, (const u16*)(ws + WS_WSD) + (size_t)L * D * DF, T, D, DF};
        pg8::StaticOrder S; S.init(g.M, g.N, G, bid);
        const EpiSD E{P_yb};
        pg8::gemm_phase<EpiSD, pg8::StaticOrder, false>((PG8_LAS unsigned char*)lds, g, S, E, nullptr);
    }
}

__device__ __forceinline__ void ph_combine(int L, int rep_) {
    PH_FN_BEGIN
    (void)rep_;
    PH_BEGIN;
    const float* lng = CTX_IN(14) + L * D; const float* lnb = CTX_IN(15) + L * D;
    float* dst = L == 0 ? P_x2 : AS_GLOBAL(float, ctx_ld(16));
    for (int row = bid * 8 + wave; row < T; row += G * 8) {
        u32x4 yv[TOPK + 1][2];
#pragma unroll
        for (int k = 0; k < TOPK + 1; ++k) {
            const size_t va = k < TOPK ? (size_t)row * TOPK + k : (size_t)A_TOT + row;
#pragma unroll
            for (int j = 0; j < 2; ++j) yv[k][j] = *(const u32x4*)(P_yb + va * D + j * 512 + lane * 8);
        }
        float v[16];
#pragma unroll
        for (int j = 0; j < 2; ++j) {
            const f32x4 t0 = *(const f32x4*)(P_x1 + (size_t)row * D + j * 512 + lane * 8), t1 = *(const f32x4*)(P_x1 + (size_t)row * D + j * 512 + lane * 8 + 4);
#pragma unroll
            for (int c = 0; c < 4; ++c) { v[j * 8 + c] = DN_ALPHA * t0[c]; v[j * 8 + 4 + c] = DN_ALPHA * t1[c]; }
        }
#pragma unroll
        for (int k = 0; k < TOPK + 1; ++k)
#pragma unroll
            for (int j = 0; j < 2; ++j)
#pragma unroll
                for (int c = 0; c < 4; ++c) { v[j * 8 + 2 * c] += bf2f(yv[k][j][c] & 0xFFFFu); v[j * 8 + 2 * c + 1] += bf2f(yv[k][j][c] >> 16); }
        float sm = 0.f;
#pragma unroll
        for (int i = 0; i < 16; ++i) sm += v[i];
        const float mu = wave_sum(sm) * (1.f / D);
        float q = 0.f;
#pragma unroll
        for (int i = 0; i < 16; ++i) { const float d = v[i] - mu; q += d * d; }
        const float rstd = rsqrtf(wave_sum(q) * (1.f / D) + LN_EPS);
#pragma unroll
        for (int j = 0; j < 2; ++j) {
            const f32x4 g0 = *(const f32x4*)(lng + j * 512 + lane * 8), g1 = *(const f32x4*)(lng + j * 512 + lane * 8 + 4);
            const f32x4 b0 = *(const f32x4*)(lnb + j * 512 + lane * 8), b1 = *(const f32x4*)(lnb + j * 512 + lane * 8 + 4);
            f32x4 o0, o1;
#pragma unroll
            for (int c = 0; c < 4; ++c) { o0[c] = (v[j * 8 + c] - mu) * rstd * g0[c] + b0[c]; o1[c] = (v[j * 8 + 4 + c] - mu) * rstd * g1[c] + b1[c]; }
            *(f32x4*)(dst + (size_t)row * D + j * 512 + lane * 8) = o0; *(f32x4*)(dst + (size_t)row * D + j * 512 + lane * 8 + 4) = o1;
            if (L == 0) { u32x4 w; w[0] = cvtpk(o0[0], o0[1]); w[1] = cvtpk(o0[2], o0[3]); w[2] = cvtpk(o1[0], o1[1]); w[3] = cvtpk(o1[2], o1[3]); *(u32x4*)(P_xb + (size_t)row * D + j * 512 + lane * 8) = w; }
        }
    }
}

__global__ void __launch_bounds__(NTHR, 2) fwd(Args args) {
    extern __shared__ __attribute__((aligned(16))) unsigned char lds_raw[];
    LAS char* lds = (LAS char*)lds_raw;
    unsigned char* const ws = args.ws;
    const int lo = args.ph_lo, hi_ph = args.ph_hi;
    if (threadIdx.x < 18) {
        const uint64_t v = threadIdx.x < 16 ? (uint64_t)args.in[threadIdx.x] : (threadIdx.x == 16 ? (uint64_t)args.out : (uint64_t)args.ws);
        ((LAS uint64_t*)(lds + LDS_CTX))[threadIdx.x] = v;
    }
    __syncthreads();
#define IN(k) (lo <= (k) && (k) < hi_ph)

#if MK_ONE_LAUNCH
    if (threadIdx.x < 4) ((LAS unsigned*)(lds + LDS_BAR))[threadIdx.x] = 0u;
    __syncthreads();
    XcdBarrier bar = xcd_barrier_post((unsigned*)(ws + WS_CTL), (volatile LAS unsigned*)(lds + LDS_BAR));
#define GRID_BAR() xcd_barrier(bar)
#else
#define GRID_BAR() do { } while (0)
#endif
#define SEAM(k) do { if (IN(k) && IN((k) + 1)) GRID_BAR(); } while (0)

    for (int rep_ = 0; rep_ < ((IN(0) && PHK(0)) ? REPS(0) : 0); ++rep_) { ph_p0(0, rep_); }
    SEAM(0);

    for (int L = 0; L < 2; ++L) {
        const int pb = 1 + 10 * L;
        for (int rep_ = 0; rep_ < ((IN(pb + 0) && PHK(1)) ? REPS(1) : 0); ++rep_) { ph_qkv(L, rep_); }
        SEAM(pb + 0);

        if (L == 0) {
            for (int rep_ = 0; rep_ < ((IN(pb + 1) && PHK(2)) ? REPS(2) : 0); ++rep_) { ph_kmean(L, rep_); }
            SEAM(pb + 1);
            for (int rep_ = 0; rep_ < ((IN(pb + 2) && PHK(11)) ? REPS(11) : 0); ++rep_) { ph_gate(L, rep_); }
            SEAM(pb + 2);
        }

        if (L == 0) {
            for (int rep_ = 0; rep_ < ((IN(pb + 3) && PHK(3)) ? REPS(3) : 0); ++rep_) { ph_moba(L, rep_); }
            SEAM(pb + 3);
            for (int rep_ = 0; rep_ < ((IN(pb + 4) && PHK(12)) ? REPS(12) : 0); ++rep_) { ph_mobamerge(L, rep_); }
        } else {
            for (int rep_ = 0; rep_ < ((IN(pb + 3) && PHK(4)) ? REPS(4) : 0); ++rep_) { ph_dil(L, rep_); }
            SEAM(pb + 3);
            for (int rep_ = 0; rep_ < ((IN(pb + 4) && PHK(5)) ? REPS(5) : 0); ++rep_) { ph_merge(L, rep_); }
        }
        SEAM(pb + 4);

        for (int rep_ = 0; rep_ < ((IN(pb + 5) && PHK(6)) ? REPS(6) : 0); ++rep_) { ph_wo(L, rep_); }
        SEAM(pb + 5);

        for (int rep_ = 0; rep_ < ((IN(pb + 6) && PHK(7)) ? REPS(7) : 0); ++rep_) { ph_router(L, rep_); }
        SEAM(pb + 6);

        for (int rep_ = 0; rep_ < ((IN(pb + 7) && PHK(8)) ? REPS(8) : 0); ++rep_) { ph_gateup(L, rep_); }
        SEAM(pb + 7);

        for (int rep_ = 0; rep_ < ((IN(pb + 8) && PHK(9)) ? REPS(9) : 0); ++rep_) { ph_down(L, rep_); }
        SEAM(pb + 8);

        for (int rep_ = 0; rep_ < ((IN(pb + 9) && PHK(10)) ? REPS(10) : 0); ++rep_) { ph_combine(L, rep_); }
        if (L == 0) SEAM(pb + 9);
    }
}

extern "C" void kernel_launch(void* const* d_in, const int* in_sizes, int n_in, void* d_out, int out_size, void* d_ws, size_t ws_size, hipStream_t stream) {
    static int grid = 0;
    if (grid == 0) {
        if (n_in != 16 || out_size != T * D || ws_size < WS_END2) { fprintf(stderr, "kernel_launch: unexpected problem (n_in %d out %d ws %zu need %zu)\n", n_in, out_size, ws_size, (size_t)WS_END2); grid = -1; return; }
        int dev = 0, cus = 0, per_cu = 0;
        if (hipGetDevice(&dev) != hipSuccess || hipDeviceGetAttribute(&cus, hipDeviceAttributeMultiprocessorCount, dev) != hipSuccess) { grid = -1; return; }
        if (hipFuncSetAttribute((const void*)fwd, hipFuncAttributeMaxDynamicSharedMemorySize, LDS_BYTES) != hipSuccess) { fprintf(stderr, "kernel_launch: hipFuncSetAttribute failed\n"); grid = -1; return; }
        if (hipOccupancyMaxActiveBlocksPerMultiprocessor(&per_cu, (const void*)fwd, NTHR, LDS_BYTES) != hipSuccess || per_cu < 1) { fprintf(stderr, "kernel_launch: occupancy query says %d\n", per_cu); (void)hipGetLastError(); per_cu = 1; }
        grid = cus;
    }
    if (grid < 0) return;
    (void)hipMemsetAsync((char*)d_ws + WS_CTL, 0, CTL_BYTES, stream);
    Args a{};
    for (int i = 0; i < 16; ++i) a.in[i] = (const float*)d_in[i];
    a.out = (float*)d_out; a.ws = (unsigned char*)d_ws;
#if MK_ONE_LAUNCH
    a.ph_lo = 0; a.ph_hi = N_PHASES;
    hipLaunchKernelGGL(fwd, dim3(grid), dim3(NTHR), LDS_BYTES, stream, a);
#else
    for (int ph = 0; ph < N_PHASES; ++ph) {
        if (ph == 12 || ph == 13) continue;
        a.ph_lo = ph; a.ph_hi = ph + 1;
        hipLaunchKernelGGL(fwd, dim3(grid), dim3(NTHR), LDS_BYTES, stream, a);
    }
#endif
}
```

```cpp
#include <hip/hip_runtime.h>
#include <hip/hip_bf16.h>
#include <stdint.h>
#include <stdio.h>

#ifndef MK_ONE_LAUNCH
#define MK_ONE_LAUNCH 1
#endif

#ifndef PHMASK
#define PHMASK 0x1FFF
#endif
#define PHK(k) ((PHMASK >> (k)) & 1)
#ifndef REPEAT_KIND
#define REPEAT_KIND -1
#endif
#define REPS(k) ((k) == REPEAT_KIND ? 2 : 1)
#define LAS __attribute__((address_space(3)))
typedef __attribute__((ext_vector_type(8))) short bf16x8;
typedef __attribute__((ext_vector_type(16))) float f32x16;
typedef __attribute__((ext_vector_type(4))) float f32x4;
typedef __attribute__((ext_vector_type(4))) unsigned u32x4;
typedef __attribute__((ext_vector_type(2))) unsigned u32x2;
typedef unsigned short u16;

constexpr int D = 1024, BATCH = 2, SEQ = 8192, T = BATCH * SEQ, NH = 16, HD = 64;
constexpr int NE = 256, TOPK = 8, DF = 256;
constexpr int A_TOT = T * TOPK;
constexpr int MOBA_BLK = 256, MOBA_NB = SEQ / MOBA_BLK;
constexpr float DN_ALPHA = 1.4142135623730951f;
constexpr float LN_EPS = 1e-5f;
constexpr float LOG2E = 1.4426950408889634f;
constexpr float LN2 = 0.6931471805599453f;
constexpr float NEGV = -1e30f;
constexpr int NTHR = 512;

constexpr size_t al256(size_t x) { return (x + 255) & ~(size_t)255; }
constexpr size_t WS_CTL = 0;
constexpr size_t CTL_BYTES = 65536;
constexpr size_t CTL_CNT_OFF = 32768;
constexpr size_t WS_XB = WS_CTL + CTL_BYTES;
constexpr size_t WS_X1 = WS_XB + al256((size_t)T * D * 2);
constexpr size_t WS_X2 = WS_X1 + al256((size_t)T * D * 4);
constexpr size_t WS_YPRE = WS_X2 + al256((size_t)T * D * 4);
constexpr size_t WS_QKV = WS_YPRE + al256((size_t)T * D * 4);
constexpr size_t WS_VT = WS_QKV + al256((size_t)T * 9216 * 2);
constexpr size_t WS_KM = WS_VT + al256((size_t)3 * T * D * 2);
constexpr size_t WS_AO = WS_KM + al256((size_t)BATCH * NH * MOBA_NB * HD * 4);
constexpr size_t WS_OG = WS_AO + al256((size_t)T * D * 2);
constexpr size_t WS_LSE = WS_OG + al256((size_t)3 * T * D * 2);
constexpr size_t WS_TOPW = WS_LSE + al256((size_t)3 * T * NH * 4);
constexpr size_t WS_LIST = WS_TOPW + al256((size_t)T * TOPK * 4);
constexpr size_t WS_HB = WS_LIST + al256((size_t)NE * T * 4);
constexpr size_t WS_YB = WS_HB + al256((size_t)(A_TOT + T + 1) * DF * 2);
constexpr size_t WS_END = WS_YB + al256((size_t)(A_TOT + T + 1) * D * 2);
constexpr int TRASH_VA = A_TOT + T;
constexpr size_t WS_SELM = WS_END;
constexpr size_t WS_PART = WS_SELM + al256((size_t)T * NH * 4);
constexpr size_t WS_PLSE = WS_PART + al256((size_t)T * NH * 4 * 64 * 2);
constexpr size_t WS_WQK0 = WS_PLSE + al256((size_t)T * NH * 4 * 4);
constexpr size_t WS_WV0 = WS_WQK0 + (size_t)2048 * 1024 * 2;
constexpr size_t WS_WQK1 = WS_WV0 + (size_t)1024 * 1024 * 2;
constexpr size_t WS_WV1 = WS_WQK1 + (size_t)6144 * 1024 * 2;
constexpr size_t WS_WO = WS_WV1 + (size_t)3072 * 1024 * 2;
constexpr size_t WS_WSGU = WS_WO + (size_t)2 * 1024 * 1024 * 2;
constexpr size_t WS_WSD = WS_WSGU + (size_t)2 * 512 * 1024 * 2;
constexpr size_t WS_XB8 = WS_WSD + (size_t)2 * 1024 * 256 * 2;
constexpr size_t WS_HBS = WS_XB8 + (size_t)T * D;
constexpr size_t WS_WRH = WS_HBS + (size_t)T * DF * 2;
constexpr size_t WS_WRL = WS_WRH + (size_t)2 * 256 * 1024 * 2;
constexpr size_t WS_END2 = WS_WRL + (size_t)2 * 256 * 1024 * 2;

constexpr int LDP = 40;
constexpr int STAGE_BYTES = 2 * 256 * LDP * 2;
constexpr int LDS_ROWID = 2 * STAGE_BYTES;
constexpr int LDS_ROWW = LDS_ROWID + 1024;
constexpr int XS_PITCH = 1028;
constexpr int LDS_BYTES = 163840;
constexpr int LDS_BAR = 161792;

#define XB_TMO      128
#define XB_XCNT(j)  (256  + 64 * (j))
#define XB_XSUB(j)  (1280 + 64 * (j))
#define XB_XGEN(j)  (2304 + 64 * (j))
#define XB_TOP      3328
#define XB_TOPGEN   3392
#define XCD_BAR_WORDS 3456
#define XB_SPIN_CAP (1u << 18)
__device__ __forceinline__ unsigned xb_ld(unsigned* p)              { return __hip_atomic_load(p, __ATOMIC_RELAXED, __HIP_MEMORY_SCOPE_AGENT); }
__device__ __forceinline__ unsigned xb_add(unsigned* p, unsigned v) { return __hip_atomic_fetch_add(p, v, __ATOMIC_RELAXED, __HIP_MEMORY_SCOPE_AGENT); }
__device__ __forceinline__ unsigned xb_xcc_id() { return (unsigned)__builtin_amdgcn_s_getreg((3 << 11) | 20) & 0xFu; }
#define XB_SPIN(cond, bar) do { unsigned _sp = 0; while (cond) { __builtin_amdgcn_s_sleep(1); \
    if ((++_sp & 255u) == 0u) { if (xb_ld(&(bar)[XB_TMO])) break; if (_sp > XB_SPIN_CAP) { atomicAdd(&(bar)[XB_TMO], 1u); break; } } } } while (0)
struct XcdBarrier { unsigned* bar; unsigned x; volatile LAS unsigned* st; };
__device__ __forceinline__ XcdBarrier xcd_barrier_post(unsigned* bar, volatile LAS unsigned* st) {
    XcdBarrier b; b.bar = bar; b.x = xb_xcc_id(); b.st = st;
    if (threadIdx.x == 0) (void)xb_add(&bar[XB_XCNT(b.x)], 1u);
    return b;
}
__device__ __forceinline__ void xcd_barrier_complete(unsigned* bar, unsigned x, unsigned& nloc, unsigned& nx) {
    const unsigned G = gridDim.x * gridDim.y * gridDim.z;
    unsigned sum, cnt, mine, sp = 0u;
    for (;;) {
        sum = 0u; cnt = 0u; mine = 0u;
#pragma unroll
        for (unsigned j = 0; j < 16; ++j) { const unsigned c = xb_ld(&bar[XB_XCNT(j)]); sum += c; cnt += (c > 0u) ? 1u : 0u; mine = (j == x) ? c : mine; }
        if (sum == G) break;
        __builtin_amdgcn_s_sleep(1);
        if ((++sp & 255u) == 0u) { if (xb_ld(&bar[XB_TMO])) break; if (sp > XB_SPIN_CAP) { atomicAdd(&bar[XB_TMO], 1u); break; } }
    }
    nloc = mine > 0u ? mine : 1u; nx = cnt > 0u ? cnt : 1u;
}
__device__ __forceinline__ void xcd_barrier(const XcdBarrier& b) {
    asm volatile("s_waitcnt vmcnt(0)" ::: "memory");
    __syncthreads();
    if (threadIdx.x == 0) {
        unsigned* bar = b.bar;
        __builtin_amdgcn_s_waitcnt(0);
        unsigned nloc = b.st[0], nx = b.st[1];
        if (nloc == 0u) { xcd_barrier_complete(bar, b.x, nloc, nx); b.st[0] = nloc; b.st[1] = nx; }
        const unsigned old = xb_add(&bar[XB_XSUB(b.x)], 1u);
        const unsigned gen = old / nloc;
        if (old + 1u == (gen + 1u) * nloc) {
            __builtin_amdgcn_fence(__ATOMIC_RELEASE, "agent");
            asm volatile("s_waitcnt vmcnt(0)" ::: "memory");
            const unsigned og = xb_add(&bar[XB_TOP], 1u);
            const unsigned tg = og / nx;
            if (og + 1u == (tg + 1u) * nx) xb_add(&bar[XB_TOPGEN], 1u);
            else XB_SPIN(xb_ld(&bar[XB_TOPGEN]) == tg, bar);
            __builtin_amdgcn_fence(__ATOMIC_ACQUIRE, "agent");
            xb_add(&bar[XB_XGEN(b.x)], 1u);
            asm volatile("s_waitcnt vmcnt(0)" ::: "memory");
        } else {
            XB_SPIN(xb_ld(&bar[XB_XGEN(b.x)]) == gen, bar);
            __builtin_amdgcn_fence(__ATOMIC_ACQUIRE, "agent");
            asm volatile("s_waitcnt vmcnt(0)" ::: "memory");
        }
    }
    __syncthreads();
}

typedef __attribute__((ext_vector_type(2))) __bf16 bf16x2_t;
typedef __attribute__((ext_vector_type(2))) float f32x2_t;
__device__ __forceinline__ unsigned cvtpk(float lo, float hi) { f32x2_t f; f[0] = lo; f[1] = hi; return __builtin_bit_cast(unsigned, __builtin_convertvector(f, bf16x2_t)); }
__device__ __forceinline__ float bf2f(unsigned v16) { return __uint_as_float(v16 << 16); }
__device__ __forceinline__ int crow(int r, int hi) { return (r & 3) + 8 * (r >> 2) + 4 * hi; }
#define MFMA_BF16(a, b, c) __builtin_amdgcn_mfma_f32_32x32x16_bf16(a, b, c, 0, 0, 0)
__device__ __forceinline__ float wave_sum(float v) {
    v += __int_as_float(__builtin_amdgcn_update_dpp(0, __float_as_int(v), 0xB1, 0xF, 0xF, true));
    v += __int_as_float(__builtin_amdgcn_update_dpp(0, __float_as_int(v), 0x4E, 0xF, 0xF, true));
    v += __int_as_float(__builtin_amdgcn_update_dpp(0, __float_as_int(v), 0x141, 0xF, 0xF, true));
    v += __int_as_float(__builtin_amdgcn_update_dpp(0, __float_as_int(v), 0x140, 0xF, 0xF, true));
    const int vi = __float_as_int(v);
    return (__int_as_float(__builtin_amdgcn_readlane(vi, 0)) + __int_as_float(__builtin_amdgcn_readlane(vi, 16))) + (__int_as_float(__builtin_amdgcn_readlane(vi, 32)) + __int_as_float(__builtin_amdgcn_readlane(vi, 48)));
}

namespace pg8 {
#define PG8_LAS __attribute__((address_space(3)))
typedef unsigned short bf16_t;
typedef short bf16x8 __attribute__((ext_vector_type(8)));
typedef float f32x4 __attribute__((ext_vector_type(4)));
typedef unsigned u32x4 __attribute__((ext_vector_type(4)));
constexpr int BM = 256, BK = 64, HALF = 128, HTB = HALF * BK * 2  , STAGE_BYTES = 8 * HTB, NXCD = 8, WGM = 8;

__host__ __device__ __forceinline__ int lds_byte(int r, int c) { const int st = (r >> 4) * 2 + (c >> 5), rr = r & 15, cc = c & 31, ob = rr * 64 + cc * 2; return st * 1024 + (ob ^ (((ob >> 9) & 1) << 5)); }
__host__ __device__ __forceinline__ void stage_rc(int b, int& R, int& C) { const int st = b / 1024, sb = b % 1024, swz = sb ^ (((sb >> 9) & 1) << 5); R = (st >> 1) * 16 + swz / 64; C = (st & 1) * 32 + (swz % 64) / 2; }
__host__ __device__ __forceinline__ int perm32(int rho) { const int n = rho >> 4, i = rho & 15; return 8 * (i >> 2) + 4 * n + (i & 3); }

struct Unit { int pm, pn; };
struct Gemm { const bf16_t* A; const bf16_t* Bt; int M, N, K; };
struct FixedOrder {
    int pm, pn;
    __device__ __forceinline__ bool next(int i, Unit& u) const { if (i != 0) return false; u.pm = pm; u.pn = pn; return true; }
    __device__ __forceinline__ void a_ready(const Unit&) const {}
    __device__ __forceinline__ void done(const Unit&) const {}
};

struct StaticOrder {
    int nM, nN, nwg, G, c;
    __host__ __device__ void init(int M, int N, int G_, int c_) { nM = M / BM; nN = N / BM; nwg = nM * nN; G = G_; c = c_; }
    __host__ __device__ bool next(int i, Unit& u) const {
        const long L = (long)i * G + c; if (L >= nwg) return false;
        int wgid = (int)L; { const int q = nwg / NXCD, r = nwg % NXCD, xcd = wgid % NXCD, off = wgid / NXCD; wgid = (xcd < r ? xcd * (q + 1) : r * (q + 1) + (xcd - r) * q) + off; }
        const int nig = WGM * nN, gid = wgid / nig, fm = gid * WGM, gsz = (nM - fm) < WGM ? (nM - fm) : WGM;
        u.pm = fm + ((wgid % nig) % gsz); u.pn = (wgid % nig) / gsz; return true;
    }
    __device__ __forceinline__ void a_ready(const Unit&) const {}
    __device__ __forceinline__ void done(const Unit&) const {}
};

template <class Epi, class Sched, bool SWAP = false, bool STAMP = false>
__device__ __forceinline__ void gemm_phase(PG8_LAS unsigned char* lds, const Gemm g, const Sched& S, const Epi& E, unsigned long long* stamps) {
    int tid_ = threadIdx.x; asm volatile("" : "+v"(tid_));
    const int tid = tid_, wid = __builtin_amdgcn_readfirstlane(tid >> 6), lane = tid & 63, wr = wid >> 2, wc = wid & 3, fr = lane & 15, fq = lane >> 4;
    const int K = g.K, nt = K / BK;
    int ts_lo = 0, ts_hi = 0, nts = 0; const unsigned long long rt_entry = STAMP ? (unsigned long long)wall_clock64() : 0ull;
#define PG8_STAMP() do { if (STAMP && wid == 0 && nts < 64) { const unsigned long long _c = (unsigned long long)clock64(); \
        ts_lo = (lane == nts) ? (int)(unsigned)_c : ts_lo; ts_hi = (lane == nts) ? (int)(unsigned)(_c >> 32) : ts_hi; ++nts; } } while (0)
    PG8_STAMP();
    unsigned voffA[2], voffB[2];
#pragma unroll
    for (int i = 0; i < 2; ++i) { int R, C; stage_rc(tid * 16 + i * 8192, R, C); const int Rb = Epi::PERM ? ((R & ~31) + perm32(R & 31)) : R;
        voffA[i] = (unsigned)(R * K + C) * 2u; voffB[i] = (unsigned)(Rb * K + C) * 2u; }
    const size_t kstep = (size_t)(BK * 2);
    const size_t hstep = (size_t)HALF * K * 2;
    const size_t tstep = 2 * hstep;
    const unsigned ldsw = (unsigned)wid * 1024u;
    const int aoff = lds_byte(wr * 64 + fr, fq * 8), boff = lds_byte(wc * 32 + fr, fq * 8);
#define PG8_SA(b, h) (((b) * 2 + (h)) * HTB)
#define PG8_SB(b, h) ((4 + (b) * 2 + (h)) * HTB)
#define PG8_STAGE(bufoff, gbase, voff) do { _Pragma("unroll") for (int _i = 0; _i < 2; ++_i) \
        __builtin_amdgcn_global_load_lds((const unsigned*)((const char*)(gbase) + (voff)[_i]), (PG8_LAS unsigned*)(lds + (bufoff) + ldsw + _i * 8192), 16, 0, 0); } while (0)
#define PG8_LDA(dst, b, h) do { _Pragma("unroll") for (int m = 0; m < 4; ++m) _Pragma("unroll") for (int k = 0; k < 2; ++k) dst[m][k] = *(const PG8_LAS bf16x8*)(lds + PG8_SA(b, h) + aoff + m * 2048 + k * 1024); } while (0)
#define PG8_LDB(dst, b, h) do { _Pragma("unroll") for (int n = 0; n < 2; ++n) _Pragma("unroll") for (int k = 0; k < 2; ++k) dst[n][k] = *(const PG8_LAS bf16x8*)(lds + PG8_SB(b, h) + boff + n * 2048 + k * 1024); } while (0)
#define PG8_MMA(ai, bj, At, Bt) do { __builtin_amdgcn_s_setprio(1); _Pragma("unroll") for (int m = 0; m < 4; ++m) _Pragma("unroll") for (int n = 0; n < 2; ++n) _Pragma("unroll") for (int k = 0; k < 2; ++k) \
        acc[ai][bj][m][n] = SWAP ? __builtin_amdgcn_mfma_f32_16x16x32_bf16(At[m][k], Bt[n][k], acc[ai][bj][m][n], 0, 0, 0) : __builtin_amdgcn_mfma_f32_16x16x32_bf16(Bt[n][k], At[m][k], acc[ai][bj][m][n], 0, 0, 0); __builtin_amdgcn_s_setprio(0); } while (0)
#define PG8_WAIT_V(n) asm volatile("s_waitcnt vmcnt(" #n ")" ::: "memory")
#define PG8_WAIT_L(n) asm volatile("s_waitcnt lgkmcnt(" #n ")" ::: "memory")
#define PG8_BAR __builtin_amdgcn_s_barrier()
#define PG8_SCHED __builtin_amdgcn_sched_barrier(0)
    Unit cur, nxt; int ui = 0;
    if (!S.next(0, cur)) return;
    f32x4 acc[2][2][4][2];
#pragma unroll
    for (int a = 0; a < 2; ++a)
#pragma unroll
        for (int b = 0; b < 2; ++b)
#pragma unroll
            for (int m = 0; m < 4; ++m)
#pragma unroll
                for (int n = 0; n < 2; ++n) acc[a][b][m][n] = (f32x4){0.f, 0.f, 0.f, 0.f};
    bf16x8 At[4][2], B0[2][2], B1[2][2];
    const char* cA = (const char*)g.A + (size_t)cur.pm * tstep; const char* cB = (const char*)g.Bt + (size_t)cur.pn * tstep;
    S.a_ready(cur);
    PG8_STAGE(PG8_SB(0, 0), cB, voffB); PG8_STAGE(PG8_SA(0, 0), cA, voffA); PG8_STAGE(PG8_SB(0, 1), cB + hstep, voffB); PG8_STAGE(PG8_SA(0, 1), cA + hstep, voffA);
    if (wr == 1) PG8_BAR;
    PG8_WAIT_V(4); PG8_BAR;
    PG8_STAGE(PG8_SB(1, 0), cB + kstep, voffB); PG8_STAGE(PG8_SA(1, 0), cA + kstep, voffA); PG8_STAGE(PG8_SB(1, 1), cB + hstep + kstep, voffB);
    PG8_WAIT_V(6); PG8_BAR;
    PG8_STAMP();
    for (;;) {
        const bool has_next = S.next(ui + 1, nxt);
        const char* nA = has_next ? (const char*)g.A + (size_t)nxt.pm * tstep : cA; const char* nB = has_next ? (const char*)g.Bt + (size_t)nxt.pn * tstep : cB;
        for (int t = 0; t < nt; t += 2) {
            const bool last = (t == nt - 2);
            const char* a1 = cA + (size_t)(t + 1) * kstep;
            const char* a2 = last ? nA : cA + (size_t)(t + 2) * kstep; const char* b2 = last ? nB : cB + (size_t)(t + 2) * kstep;
            const char* a3 = a2 + kstep; const char* b3 = b2 + kstep;
            if (last && has_next) S.a_ready(nxt);
            PG8_LDB(B0, 0, 0); PG8_SCHED; PG8_LDA(At, 0, 0); PG8_STAGE(PG8_SA(1, 1), a1 + hstep, voffA);
            PG8_WAIT_L(8); PG8_BAR; PG8_WAIT_L(0); PG8_MMA(0, 0, At, B0); PG8_BAR; PG8_SCHED;
            PG8_LDB(B1, 0, 1); PG8_STAGE(PG8_SB(0, 0), b2, voffB);
            PG8_BAR; PG8_WAIT_L(0); PG8_MMA(0, 1, At, B1); PG8_BAR;
            PG8_LDA(At, 0, 1); PG8_STAGE(PG8_SA(0, 0), a2, voffA);
            PG8_BAR; PG8_WAIT_L(0); PG8_MMA(1, 0, At, B0); PG8_BAR; PG8_SCHED;
            PG8_STAGE(PG8_SB(0, 1), b2 + hstep, voffB);
            PG8_WAIT_V(6); PG8_BAR; PG8_MMA(1, 1, At, B1); PG8_BAR;
            PG8_LDB(B0, 1, 0); PG8_SCHED; PG8_LDA(At, 1, 0); PG8_STAGE(PG8_SA(0, 1), a2 + hstep, voffA);
            PG8_WAIT_L(8); PG8_BAR; PG8_WAIT_L(0); PG8_MMA(0, 0, At, B0); PG8_BAR; PG8_SCHED;
            PG8_LDB(B1, 1, 1); PG8_STAGE(PG8_SB(1, 0), b3, voffB);
            PG8_BAR; PG8_WAIT_L(0); PG8_MMA(0, 1, At, B1); PG8_BAR;
            PG8_LDA(At, 1, 1); PG8_STAGE(PG8_SA(1, 0), a3, voffA);
            PG8_BAR; PG8_WAIT_L(0); PG8_MMA(1, 0, At, B0); PG8_BAR; PG8_SCHED;
            PG8_STAGE(PG8_SB(1, 1), b3 + hstep, voffB);
            PG8_WAIT_V(6); PG8_BAR; PG8_MMA(1, 1, At, B1); PG8_BAR;
        }
        PG8_STAMP();
        if constexpr (!Epi::AFTER_DRAIN) { E(acc, cur, wr, wc, fr, fq); S.done(cur); }
        PG8_STAMP();
        if (!has_next) break;
#pragma unroll
        for (int a = 0; a < 2; ++a)
#pragma unroll
            for (int b = 0; b < 2; ++b)
#pragma unroll
                for (int m = 0; m < 4; ++m)
#pragma unroll
                    for (int n = 0; n < 2; ++n) acc[a][b][m][n] = (f32x4){0.f, 0.f, 0.f, 0.f};
        cur = nxt; cA = nA; cB = nB; ++ui;
    }
    PG8_WAIT_V(0);
    if (wr == 0) PG8_BAR;
    PG8_BAR;
    if constexpr (Epi::AFTER_DRAIN) { E.fused(acc, cur, wr, wc, fr, fq, lds, wid, lane); S.done(cur); }
    PG8_STAMP();
    if (STAMP && wid == 0) { stamps[lane] = lane < nts ? (((unsigned long long)(unsigned)ts_hi << 32) | (unsigned)ts_lo) : 0ull;
        if (lane == 62) stamps[62] = rt_entry; if (lane == 63) stamps[63] = (unsigned long long)wall_clock64(); }
#undef PG8_STAMP
#undef PG8_SA
#undef PG8_SB
#undef PG8_STAGE
#undef PG8_LDA
#undef PG8_LDB
#undef PG8_MMA
#undef PG8_WAIT_V
#undef PG8_WAIT_L
#undef PG8_BAR
#undef PG8_SCHED
}
}

struct EpiQK {
    static constexpr bool PERM = true, AFTER_DRAIN = false;
    u16* O; int ldc;
    __device__ __forceinline__ void operator()(const pg8::f32x4 (&acc)[2][2][4][2], const pg8::Unit& u, int wr, int wc, int fr, int fq) const {
        const int col0 = u.pn * 256 + wc * 32 + 8 * fq, row0 = u.pm * 256 + wr * 64 + fr;
#pragma unroll
        for (int ai = 0; ai < 2; ++ai)
#pragma unroll
            for (int m = 0; m < 4; ++m) { u16* rowp = O + (size_t)(row0 + ai * 128 + m * 16) * ldc + col0;
#pragma unroll
                for (int bj = 0; bj < 2; ++bj) { const pg8::f32x4 v0 = acc[ai][bj][m][0], v1 = acc[ai][bj][m][1];
                    u32x4 w; w[0] = cvtpk(v0[0], v0[1]); w[1] = cvtpk(v0[2], v0[3]); w[2] = cvtpk(v1[0], v1[1]); w[3] = cvtpk(v1[2], v1[3]);
                    *(u32x4*)(rowp + bj * 128) = w; } }
    }
};
struct EpiV {
    static constexpr bool PERM = false, AFTER_DRAIN = false;
    u16* VT; int layer;
    __device__ __forceinline__ void operator()(const pg8::f32x4 (&acc)[2][2][4][2], const pg8::Unit& u, int wr, int wc, int fr, int fq) const {
        const int colt = u.pn * 256, grp = colt >> 10;
        const int dil = (layer == 0 || grp == 0) ? 1 : (grp == 1 ? 4 : 16);
        const int rowb = u.pm * 256 + wr * 64 + 4 * fq;
#pragma unroll
        for (int bj = 0; bj < 2; ++bj)
#pragma unroll
            for (int n = 0; n < 2; ++n) {
                const int c = (colt & 1023) + bj * 128 + wc * 32 + n * 16 + fr, h = c >> 6, d = c & 63;
#pragma unroll
                for (int ai = 0; ai < 2; ++ai)
#pragma unroll
                    for (int m = 0; m < 4; ++m) {
                        const int r0 = rowb + ai * 128 + m * 16, b = r0 >> 13, t0 = r0 & (SEQ - 1);
                        u16* vrow = VT + (size_t)grp * T * D + ((size_t)(b * NH + h) * HD + d) * SEQ;
                        const pg8::f32x4 v = acc[ai][bj][m][n];
                        if (dil == 1) { u32x2 w; w[0] = cvtpk(v[0], v[1]); w[1] = cvtpk(v[2], v[3]); *(u32x2*)(vrow + t0) = w; }
                        else {
#pragma unroll
                            for (int i = 0; i < 4; ++i) { const int pp = t0 + i; vrow[(pp % dil) * (SEQ / dil) + pp / dil] = (u16)cvtpk(v[i], 0.f); }
                        }
                    }
            }
    }
};
struct EpiWo {
    static constexpr bool PERM = false, AFTER_DRAIN = false;
    float* Y; const float* X;
    __device__ __forceinline__ void operator()(const pg8::f32x4 (&acc)[2][2][4][2], const pg8::Unit& u, int wr, int wc, int fr, int fq) const {
        const int row0 = u.pm * 256 + wr * 64 + fr, col0 = u.pn * 256 + wc * 32 + 4 * fq;
#pragma unroll
        for (int ai = 0; ai < 2; ++ai)
#pragma unroll
            for (int m = 0; m < 4; ++m) { const size_t ro = (size_t)(row0 + ai * 128 + m * 16) * D + col0;
#pragma unroll
                for (int bj = 0; bj < 2; ++bj)
#pragma unroll
                    for (int n = 0; n < 2; ++n) { const pg8::f32x4 x = *(const pg8::f32x4*)(X + ro + bj * 128 + n * 16); *(pg8::f32x4*)(Y + ro + bj * 128 + n * 16) = x * DN_ALPHA + acc[ai][bj][m][n]; } }
    }
};
struct EpiSGU {
    static constexpr bool PERM = true, AFTER_DRAIN = false;
    u16* H;
    __device__ __forceinline__ void operator()(const pg8::f32x4 (&acc)[2][2][4][2], const pg8::Unit& u, int wr, int wc, int fr, int fq) const {
        const int row0 = u.pm * 256 + wr * 64 + fr, f0 = u.pn * 128 + wc * 32 + 8 * fq;
#pragma unroll
        for (int ai = 0; ai < 2; ++ai)
#pragma unroll
            for (int m = 0; m < 4; ++m) {
                float hv[8];
#pragma unroll
                for (int n = 0; n < 2; ++n)
#pragma unroll
                    for (int i = 0; i < 4; ++i) { const float gt = acc[ai][0][m][n][i], up = acc[ai][1][m][n][i]; hv[n * 4 + i] = gt / (1.f + __expf(-gt)) * up; }
                u32x4 w; w[0] = cvtpk(hv[0], hv[1]); w[1] = cvtpk(hv[2], hv[3]); w[2] = cvtpk(hv[4], hv[5]); w[3] = cvtpk(hv[6], hv[7]);
                *(u32x4*)(H + (size_t)(row0 + ai * 128 + m * 16) * DF + f0) = w;
            }
    }
};
struct EpiSD {
    static constexpr bool PERM = true, AFTER_DRAIN = false;
    u16* Y;
    __device__ __forceinline__ void operator()(const pg8::f32x4 (&acc)[2][2][4][2], const pg8::Unit& u, int wr, int wc, int fr, int fq) const {
        const int row0 = u.pm * 256 + wr * 64 + fr, col0 = u.pn * 256 + wc * 32 + 8 * fq;
#pragma unroll
        for (int ai = 0; ai < 2; ++ai)
#pragma unroll
            for (int m = 0; m < 4; ++m) { u16* rowp = Y + (size_t)(A_TOT + row0 + ai * 128 + m * 16) * D + col0;
#pragma unroll
                for (int bj = 0; bj < 2; ++bj) { const pg8::f32x4 v0 = acc[ai][bj][m][0], v1 = acc[ai][bj][m][1];
                    u32x4 w; w[0] = cvtpk(v0[0], v0[1]); w[1] = cvtpk(v0[2], v0[3]); w[2] = cvtpk(v1[0], v1[1]); w[3] = cvtpk(v1[2], v1[3]);
                    *(u32x4*)(rowp + bj * 128) = w; } }
    }
};

struct Args {
    const float* in[16];
    float* out;
    unsigned char* ws;
    int ph_lo, ph_hi;
};

#define GEMM_CORE(K_, PA0, PA1, PB, LDB)                                                                                                   \
    {                                                                                                                                      \
        const int g_tid = tid, g_lane = lane, g_wave = wave, g_r32 = r32, g_hi = hi;                   \
        const int g_wm = g_wave >> 2, g_wn = g_wave & 3, g_kc = g_tid & 3, g_kq = g_lane >> 3, g_n4 = g_lane & 7;                           \
        const u16* g_pa0 = (PA0); const u16* g_pa1 = (PA1);                                                                                \
        const size_t g_ldb = (size_t)(LDB);                                                                                                \
        const float* g_pb = (PB) + (size_t)(g_kq * 4) * g_ldb + g_n4 * 4;                                                                  \
        const int g_nk = (K_) / 32;                                                                                                        \
        u32x4 g_ra0, g_ra1; f32x4 g_rb0, g_rb1, g_rb2, g_rb3;                                                                              \
        const u32x4 g_z = {0u, 0u, 0u, 0u};                                                                                                \
        _Pragma("unroll") for (int mb = 0; mb < 4; ++mb) { _Pragma("unroll") for (int nb = 0; nb < 2; ++nb) { _Pragma("unroll") for (int r = 0; r < 16; ++r) acc[mb][nb][r] = 0.f; } } \
        g_ra0 = g_pa0 ? *(const u32x4*)(g_pa0 + g_kc * 8) : g_z; g_ra1 = g_pa1 ? *(const u32x4*)(g_pa1 + g_kc * 8) : g_z;                 \
        g_rb0 = *(const f32x4*)(g_pb); g_rb1 = *(const f32x4*)(g_pb + g_ldb); g_rb2 = *(const f32x4*)(g_pb + 2 * g_ldb); g_rb3 = *(const f32x4*)(g_pb + 3 * g_ldb); \
        _Pragma("unroll 1") for (int kt = 0; kt < g_nk; ++kt) {                                                                            \
            LAS char* As = lds + (kt & 1) * STAGE_BYTES; LAS char* Bs = As + 256 * LDP * 2;                                                \
            *(LAS u32x4*)(As + ((g_tid >> 2) * LDP + g_kc * 8) * 2) = g_ra0;                                                               \
            *(LAS u32x4*)(As + (((g_tid >> 2) + 128) * LDP + g_kc * 8) * 2) = g_ra1;                                                       \
            _Pragma("unroll") for (int i = 0; i < 4; ++i) {                                                                                \
                u32x2 w; w[0] = cvtpk(g_rb0[i], g_rb1[i]); w[1] = cvtpk(g_rb2[i], g_rb3[i]);                                               \
                *(LAS u32x2*)(Bs + ((g_wave * 32 + i * 8 + g_n4) * LDP + g_kq * 4) * 2) = w;                                               \
            }                                                                                                                              \
            __syncthreads();                                                                                                               \
            if (kt + 1 < g_nk) {                                                                                                           \
                const int ko = (kt + 1) * 32;                                                                                              \
                g_ra0 = g_pa0 ? *(const u32x4*)(g_pa0 + ko + g_kc * 8) : g_z; g_ra1 = g_pa1 ? *(const u32x4*)(g_pa1 + ko + g_kc * 8) : g_z; \
                const float* pbk = g_pb + (size_t)ko * g_ldb;                                                                              \
                g_rb0 = *(const f32x4*)(pbk); g_rb1 = *(const f32x4*)(pbk + g_ldb); g_rb2 = *(const f32x4*)(pbk + 2 * g_ldb); g_rb3 = *(const f32x4*)(pbk + 3 * g_ldb); \
            }                                                                                                                              \
            _Pragma("unroll") for (int s = 0; s < 2; ++s) {                                                                                \
                bf16x8 af[4], bfr[2];                                                                                                      \
                _Pragma("unroll") for (int mb = 0; mb < 4; ++mb) af[mb] = *(LAS bf16x8*)(As + ((g_wm * 128 + mb * 32 + g_r32) * LDP + s * 16 + g_hi * 8) * 2); \
                _Pragma("unroll") for (int nb = 0; nb < 2; ++nb) bfr[nb] = *(LAS bf16x8*)(Bs + (((g_wn * 2 + nb) * 32 + g_r32) * LDP + s * 16 + g_hi * 8) * 2); \
                _Pragma("unroll") for (int mb = 0; mb < 4; ++mb) { _Pragma("unroll") for (int nb = 0; nb < 2; ++nb) acc[mb][nb] = MFMA_BF16(af[mb], bfr[nb], acc[mb][nb]); } \
            }                                                                                                                              \
        }                                                                                                                                  \
        __syncthreads();                                                                                                                   \
    }

struct AttnSt { float m, l; f32x16 o0, o1; };

struct AttnFr { bf16x8 k[4]; bf16x8 v[4]; };
__device__ __forceinline__ void attn_load(AttnFr& f, const u16* krow, const u16* vt, size_t vt_dstride) {
#pragma unroll
    for (int d0 = 0; d0 < 4; ++d0) f.k[d0] = *(const bf16x8*)(krow + d0 * 16);
    const u16* vt1 = vt + 32 * vt_dstride;
    union { bf16x8 v; u32x2 h[2]; } va;
    va.h[0] = *(const u32x2*)(vt);       va.h[1] = *(const u32x2*)(vt + 8);   f.v[0] = va.v;
    va.h[0] = *(const u32x2*)(vt + 16);  va.h[1] = *(const u32x2*)(vt + 24);  f.v[1] = va.v;
    va.h[0] = *(const u32x2*)(vt1);      va.h[1] = *(const u32x2*)(vt1 + 8);  f.v[2] = va.v;
    va.h[0] = *(const u32x2*)(vt1 + 16); va.h[1] = *(const u32x2*)(vt1 + 24); f.v[3] = va.v;
}
__device__ __forceinline__ void attn_compute(AttnSt& st, const bf16x8 (&qf)[4], const AttnFr& f, int dist0, float bslope, int dlo, int dhi, int hi) {
    f32x16 p;
#pragma unroll
    for (int r = 0; r < 16; ++r) p[r] = 0.f;
#pragma unroll
    for (int d0 = 0; d0 < 4; ++d0) p = MFMA_BF16(f.k[d0], qf[d0], p);
    constexpr float C2 = 0.125f * LOG2E;
    float mx = NEGV;
#pragma unroll
    for (int r = 0; r < 16; ++r) {
        const int dist = dist0 - ((r & 3) + 8 * (r >> 2));
        const float sc = __builtin_fmaf(p[r], C2, -bslope * (float)dist);
        const float s_ = (dist >= dlo && dist <= dhi) ? sc : NEGV;
        p[r] = s_; mx = fmaxf(mx, s_);
    }
    mx = fmaxf(mx, __shfl_xor(mx, 32));
    const float mnew = fmaxf(st.m, mx);
    const float alpha = __builtin_amdgcn_exp2f(st.m - mnew);
    st.m = mnew;
    float ls = 0.f;
#pragma unroll
    for (int r = 0; r < 16; ++r) { p[r] = __builtin_amdgcn_exp2f(p[r] - mnew); ls += p[r]; }
    st.l = st.l * alpha + ls;
#pragma unroll
    for (int r = 0; r < 16; ++r) { st.o0[r] *= alpha; st.o1[r] *= alpha; }
    union { bf16x8 v; unsigned u[4]; } pb0, pb1;
#pragma unroll
    for (int j = 0; j < 4; ++j) { pb0.u[j] = cvtpk(p[2 * j], p[2 * j + 1]); pb1.u[j] = cvtpk(p[8 + 2 * j], p[8 + 2 * j + 1]); }
    st.o0 = MFMA_BF16(f.v[0], pb0.v, st.o0);
    st.o0 = MFMA_BF16(f.v[1], pb1.v, st.o0);
    st.o1 = MFMA_BF16(f.v[2], pb0.v, st.o1);
    st.o1 = MFMA_BF16(f.v[3], pb1.v, st.o1);
    (void)hi;
}

__device__ __forceinline__ float dpp_rowmax(float v) {
    v = fmaxf(v, __int_as_float(__builtin_amdgcn_update_dpp(0, __float_as_int(v), 0xB1, 0xF, 0xF, true)));
    v = fmaxf(v, __int_as_float(__builtin_amdgcn_update_dpp(0, __float_as_int(v), 0x4E, 0xF, 0xF, true)));
    v = fmaxf(v, __int_as_float(__builtin_amdgcn_update_dpp(0, __float_as_int(v), 0x141, 0xF, 0xF, true)));
    v = fmaxf(v, __int_as_float(__builtin_amdgcn_update_dpp(0, __float_as_int(v), 0x140, 0xF, 0xF, true)));
    return v;
}
__device__ __forceinline__ int dpp_rowmin_i(int v) {
    v = min(v, __builtin_amdgcn_update_dpp(0, v, 0xB1, 0xF, 0xF, true));
    v = min(v, __builtin_amdgcn_update_dpp(0, v, 0x4E, 0xF, 0xF, true));
    v = min(v, __builtin_amdgcn_update_dpp(0, v, 0x141, 0xF, 0xF, true));
    v = min(v, __builtin_amdgcn_update_dpp(0, v, 0x140, 0xF, 0xF, true));
    return v;
}
__device__ __forceinline__ float rl_f(float v, int l) { return __int_as_float(__builtin_amdgcn_readlane(__float_as_int(v), l)); }

__device__ __forceinline__ void top3_insert(float v, int i, float& v0, int& i0, float& v1, int& i1, float& v2, int& i2) {
    const bool b0 = (v > v0) || (v == v0 && i < i0);
    const bool b1 = (v > v1) || (v == v1 && i < i1);
    const bool b2 = (v > v2) || (v == v2 && i < i2);
    const float nv2 = b1 ? v1 : (b2 ? v : v2); const int ni2 = b1 ? i1 : (b2 ? i : i2);
    const float nv1 = b0 ? v0 : (b1 ? v : v1); const int ni1 = b0 ? i0 : (b1 ? i : i1);
    const float nv0 = b0 ? v : v0;             const int ni0 = b0 ? i : i0;
    v0 = nv0; i0 = ni0; v1 = nv1; i1 = ni1; v2 = nv2; i2 = ni2;
}

__device__ __forceinline__ void ln_row(float (&v)[16], const float* __restrict__ g, const float* __restrict__ b, int lane) {
    float s = 0.f;
#pragma unroll
    for (int i = 0; i < 16; ++i) s += v[i];
    const float mu = wave_sum(s) * (1.f / D);
    float q = 0.f;
#pragma unroll
    for (int i = 0; i < 16; ++i) { const float d = v[i] - mu; q += d * d; }
    const float rstd = rsqrtf(wave_sum(q) * (1.f / D) + LN_EPS);
#pragma unroll
    for (int j = 0; j < 4; ++j) {
        const f32x4 gg = *(const f32x4*)(g + j * 256 + lane * 4), bb = *(const f32x4*)(b + j * 256 + lane * 4);
#pragma unroll
        for (int c = 0; c < 4; ++c) v[j * 4 + c] = (v[j * 4 + c] - mu) * rstd * gg[c] + bb[c];
    }
}

typedef __attribute__((ext_vector_type(2))) float f32x2_;
__device__ __forceinline__ bf16x8 fp8x8_to_bf16(unsigned lo, unsigned hi_) {
    const f32x2_ a = __builtin_amdgcn_cvt_pk_f32_fp8((int)lo, false), b = __builtin_amdgcn_cvt_pk_f32_fp8((int)lo, true);
    const f32x2_ c = __builtin_amdgcn_cvt_pk_f32_fp8((int)hi_, false), d = __builtin_amdgcn_cvt_pk_f32_fp8((int)hi_, true);
    union { bf16x8 v; unsigned u[4]; } r;
    r.u[0] = cvtpk(a[0], a[1]); r.u[1] = cvtpk(b[0], b[1]); r.u[2] = cvtpk(c[0], c[1]); r.u[3] = cvtpk(d[0], d[1]);
    return r.v;
}
__device__ __forceinline__ unsigned pack_fp8x4(float a, float b, float c, float d) { int p = __builtin_amdgcn_cvt_pk_fp8_f32(a, b, 0, false); return (unsigned)__builtin_amdgcn_cvt_pk_fp8_f32(c, d, p, true); }

constexpr int MOE_BP = 72;
constexpr int MOE_BSTAGE = 128 * MOE_BP * 2;
constexpr int MOE_LDS_VA = 3 * MOE_BSTAGE;
constexpr int MOE_LDS_W = MOE_LDS_VA + 4096;
template <bool DOWN>
__device__ __forceinline__ void moe_expert(LAS char* lds, const int tid, const int lane, const int wave, const int r32, const int hi,
                                           const unsigned char* __restrict__ abase  , const float* __restrict__ w0, const float* __restrict__ w1, const int ng  , void* __restrict__ outv) {
    constexpr int KT = DOWN ? 4 : 16, NP = DOWN ? 8 : 4, LDB = DOWN ? 1024 : 256, APITCH = DOWN ? 256 : 1024  , PSTEP = DOWN ? 128 : 64;
    LAS int* rowva = (LAS int*)(lds + MOE_LDS_VA); LAS float* roww = (LAS float*)(lds + MOE_LDS_W);
    const int nst = (ng + 511) >> 9;
    const int nsteps = NP * nst * KT;
    unsigned aoff[2];
#define MOE_AOFF(ST_) { _Pragma("unroll") for (int a = 0; a < 2; ++a) { const int va_ = rowva[(ST_) * 512 + wave * 64 + a * 32 + r32]; \
        const int srow_ = DOWN ? va_ : (va_ == TRASH_VA ? 0 : (va_ >> 3)); aoff[a] = (unsigned)srow_ * APITCH + hi * 32; } }
    const int seg = wave >> 1, n4 = lane & 7, kp = (wave & 1) * 16 + (lane >> 3);
    const char* wbase = (const char*)(DOWN ? (w0 + seg * 32) : (((seg < 2) ? w0 : w1) + (seg & 1) * 32));
    const unsigned boff = (unsigned)(4 * n4 + 2 * kp * LDB) * 4u;
    f32x16 acc[2][4];
#pragma unroll
    for (int a = 0; a < 2; ++a)
#pragma unroll
        for (int c = 0; c < 4; ++c)
#pragma unroll
            for (int r = 0; r < 16; ++r) acc[a][c][r] = 0.f;
    u32x4 fa8[2][2];
    f32x4 rb0[4], rb1[4];
#define MOE_DEC(S_) const int s2_ = (S_) < nsteps ? (S_) : 0; const int ps_ = s2_ / (nst * KT); const int rm_ = s2_ - ps_ * (nst * KT); const int stt_ = rm_ / KT; const int kt_ = rm_ - stt_ * KT;
#define MOE_LOADB(S_, RB) { MOE_DEC(S_) (void)stt_; \
        const char* wp_ = wbase + (size_t)(ps_ * PSTEP + kt_ * 64 * LDB) * 4 + boff; \
        RB[0] = *(const f32x4*)(wp_); RB[1] = *(const f32x4*)(wp_ + LDB * 4); RB[2] = *(const f32x4*)(wp_ + 16 * LDB * 4); RB[3] = *(const f32x4*)(wp_ + 17 * LDB * 4); }
#define MOE_WRITEB(STG, RB) { LAS char* Bs_ = lds + (STG) * MOE_BSTAGE; \
        _Pragma("unroll") for (int i = 0; i < 4; ++i) { LAS unsigned* q_ = (LAS unsigned*)(Bs_ + ((seg * 32 + i * 8 + n4) * MOE_BP + 2 * kp) * 2); q_[0] = cvtpk(RB[0][i], RB[1][i]); q_[8] = cvtpk(RB[2][i], RB[3][i]); } }
#define MOE_COMPUTE(STG, DO_MFMA) { LAS char* Bs_ = lds + (STG) * MOE_BSTAGE; \
        _Pragma("unroll") for (int u = 0; u < 4; ++u) { \
            bf16x8 bfr[4]; \
            if (DO_MFMA) { _Pragma("unroll") for (int c = 0; c < 4; ++c) bfr[c] = *(LAS bf16x8*)(Bs_ + ((c * 32 + r32) * MOE_BP + hi * 32 + u * 8) * 2); } \
            _Pragma("unroll") for (int a = 0; a < 2; ++a) { \
                if (DO_MFMA) { const bf16x8 af_ = fp8x8_to_bf16(fa8[a][u >> 1][(u & 1) * 2], fa8[a][u >> 1][(u & 1) * 2 + 1]); \
                    _Pragma("unroll") for (int c = 0; c < 4; ++c) acc[a][c] = MFMA_BF16(bfr[c], af_, acc[a][c]); } \
                if (u & 1) fa8[a][u >> 1] = *(const u32x4*)(ab_n + aoff[a] + (u >> 1) * 16); \
            } \
        } }
#define MOE_NEXTA(S_) MOE_DEC(S_) (void)ps_; \
        if (stt_ != st_loaded) { MOE_AOFF(stt_) st_loaded = stt_; } \
        const char* ab_n = (const char*)abase + kt_ * 64;
    int st_loaded = 0;
    MOE_AOFF(0)
    { const char* ab0 = (const char*)abase;
#pragma unroll
      for (int a = 0; a < 2; ++a)
#pragma unroll
          for (int h2 = 0; h2 < 2; ++h2) fa8[a][h2] = *(const u32x4*)(ab0 + aoff[a] + h2 * 16); }
    MOE_LOADB(0, rb0)
    MOE_LOADB(1, rb1)
    MOE_WRITEB(0, rb0)
    MOE_LOADB(2, rb0)
    int stg = 0;
#pragma unroll 1
    for (int sidx = 0; sidx < nsteps; sidx += 2) {
        const int ps = sidx / (nst * KT); const int rm = sidx - ps * (nst * KT); const int stt = rm / KT; const int kt = rm - stt * KT;
        const bool wv = (wave * 64) < (ng - stt * 512);
        const int stg1 = stg == 2 ? 0 : stg + 1, stg2 = stg1 == 2 ? 0 : stg1 + 1;
        __syncthreads();
        MOE_WRITEB(stg1, rb1)
        MOE_LOADB(sidx + 3, rb1)
        { MOE_NEXTA(sidx + 1)
          if (wv) MOE_COMPUTE(stg, true) else MOE_COMPUTE(stg, false) }
        __syncthreads();
        MOE_WRITEB(stg2, rb0)
        MOE_LOADB(sidx + 4, rb0)
        { MOE_NEXTA(sidx + 2)
          if (wv) MOE_COMPUTE(stg1, true) else MOE_COMPUTE(stg1, false) }
        stg = stg2;
        if (kt == KT - 2) {
            if (wv) {
                const int nrows = ng - stt * 512;
#pragma unroll
                for (int a = 0; a < 2; ++a) {
                    if (a == 0 || (wave * 64 + 32) < nrows) {
                        const int lrow = stt * 512 + wave * 64 + a * 32 + r32;
                        const unsigned va = (unsigned)rowva[lrow];
                        if (DOWN) {
                            const float w = roww[lrow];
#pragma unroll
                            for (int c = 0; c < 4; ++c) {
                                u32x4 q0, q1;
#pragma unroll
                                for (int jj = 0; jj < 4; ++jj) {
                                    const int j0 = 2 * jj, j1 = 2 * jj + 1, j2 = 8 + 2 * jj, j3 = 9 + 2 * jj;
                                    q0[jj] = cvtpk(acc[a][c][(j0 >> 2) + 4 * (j0 & 3)] * w, acc[a][c][(j1 >> 2) + 4 * (j1 & 3)] * w);
                                    q1[jj] = cvtpk(acc[a][c][(j2 >> 2) + 4 * (j2 & 3)] * w, acc[a][c][(j3 >> 2) + 4 * (j3 & 3)] * w);
                                }
                                u16* o = (u16*)outv + (size_t)va * D + ps * 128 + c * 32 + 16 * hi;
                                *(u32x4*)o = q0; *(u32x4*)(o + 8) = q1;
                            }
                        } else {
#pragma unroll
                            for (int c = 0; c < 2; ++c) {
                                float hv[16];
#pragma unroll
                                for (int j = 0; j < 16; ++j) { const int r = (j >> 2) + 4 * (j & 3); const float gt = acc[a][c][r], up = acc[a][c + 2][r]; hv[j] = gt / (1.f + __expf(-gt)) * up; }
                                u32x4 q;
#pragma unroll
                                for (int jj = 0; jj < 4; ++jj) q[jj] = pack_fp8x4(hv[4 * jj], hv[4 * jj + 1], hv[4 * jj + 2], hv[4 * jj + 3]);
                                *(u32x4*)((unsigned char*)outv + (size_t)va * DF + ps * 64 + c * 32 + 16 * hi) = q;
                            }
                        }
                    }
                }
#pragma unroll
                for (int a = 0; a < 2; ++a)
#pragma unroll
                    for (int c = 0; c < 4; ++c)
#pragma unroll
                        for (int r = 0; r < 16; ++r) acc[a][c][r] = 0.f;
            }
        }
    }
    __syncthreads();
#undef MOE_AOFF
#undef MOE_DEC
#undef MOE_LOADB
#undef MOE_WRITEB
#undef MOE_COMPUTE
#undef MOE_NEXTA
}

constexpr int N_PHASES = 21;

#define P_x_in CTX_IN(0)
#define P_xb ((u16*)(ws + WS_XB))
#define P_x1 ((float*)(ws + WS_X1))
#define P_x2 ((float*)(ws + WS_X2))
#define P_ypre ((float*)(ws + WS_YPRE))
#define P_qkv ((u16*)(ws + WS_QKV))
#define P_vT ((u16*)(ws + WS_VT))
#define P_kmean ((float*)(ws + WS_KM))
#define P_ao ((u16*)(ws + WS_AO))
#define P_og ((u16*)(ws + WS_OG))
#define P_lse ((float*)(ws + WS_LSE))
#define P_topw ((float*)(ws + WS_TOPW))
#define P_list ((int*)(ws + WS_LIST))
#define P_hb ((u16*)(ws + WS_HB))
#define P_yb ((u16*)(ws + WS_YB))
#define P_cnt_all ((int*)(ws + WS_CTL + CTL_CNT_OFF))
#define P_xb8 ((unsigned char*)(ws + WS_XB8))
#define P_hbs ((u16*)(ws + WS_HBS))
#define P_selm ((unsigned*)(ws + WS_SELM))
#define P_part ((u16*)(ws + WS_PART))
#define P_plse ((float*)(ws + WS_PLSE))
#define PH_BEGIN int tid = threadIdx.x; asm volatile("" : "+v"(tid)); const int lane = tid & 63, r32 = lane & 31, hi = lane >> 5; const int wave = __builtin_amdgcn_readfirstlane(tid >> 6); (void)lane; (void)r32; (void)hi; (void)wave
constexpr int LDS_CTX = LDS_BAR + 16;
__device__ __forceinline__ uint64_t ctx_ld(int i) {
    extern __shared__ __attribute__((aligned(16))) unsigned char lds_raw[];
    const LAS unsigned* q = (const LAS unsigned*)((LAS char*)lds_raw + LDS_CTX) + 2 * i;
    const unsigned lo = __builtin_amdgcn_readfirstlane(q[0]), hi = __builtin_amdgcn_readfirstlane(q[1]);
    return ((uint64_t)hi << 32) | lo;
}
typedef __attribute__((address_space(1))) unsigned char gbyte;
#define AS_GLOBAL(T, u64v) ((T*)(gbyte*)(u64v))
#define CTX_IN(i) AS_GLOBAL(const float, ctx_ld(i))
#define PH_FN_BEGIN \
    extern __shared__ __attribute__((aligned(16))) unsigned char lds_raw[]; \
    LAS char* lds = (LAS char*)lds_raw; (void)lds; \
    const int G = gridDim.x, bid = blockIdx.x; (void)G; (void)bid; \
    unsigned char* const ws = AS_GLOBAL(unsigned char, ctx_ld(17)); (void)ws; \
    const int NQ = L == 0 ? 3072 : 9216; (void)NQ; \
    int* cnt = P_cnt_all + L * NE; (void)cnt;
__device__ __forceinline__ void ph_p0(int L, int rep_) {
    PH_FN_BEGIN
    (void)rep_;
    PH_BEGIN;
    for (size_t i = (size_t)bid * NTHR + tid; i < (size_t)T * D / 4; i += (size_t)G * NTHR) {
        const f32x4 v = *(const f32x4*)(P_x_in + i * 4);
        u32x2 w; w[0] = cvtpk(v[0], v[1]); w[1] = cvtpk(v[2], v[3]);
        *(u32x2*)(P_xb + i * 4) = w;
    }
    LAS float* tl = (LAS float*)lds;
    for (int it = bid; it < 3968 + 128; it += G) {
        int seg, kt;
        if (it < 3840) { seg = it >> 4; kt = it & 15; } else if (it < 3968) { seg = 240 + ((it - 3840) >> 2); kt = (it - 3840) & 3; } else { seg = 272 + ((it - 3968) >> 4); kt = (it - 3968) & 15; }
        const float* src; int ld; u16* dst; int Kd = 1024; u16* dst_lo = nullptr;
        if (seg < 48) { const int col = 64 * seg; src = CTX_IN(1) + col; ld = 3072; dst = (u16*)(ws + WS_WQK0) + (size_t)col * 1024; }
        else if (seg < 192) { const int col = 64 * (seg - 48); src = CTX_IN(2) + col; ld = 9216; dst = (u16*)(ws + WS_WQK1) + (size_t)col * 1024; }
        else if (seg < 224) { const int s2 = seg - 192, l2 = s2 >> 4, col = 64 * (s2 & 15); src = CTX_IN(3) + (size_t)l2 * D * D + col; ld = 1024; dst = (u16*)(ws + WS_WO) + (size_t)l2 * D * D + (size_t)col * 1024; }
        else if (seg < 240) { const int s2 = seg - 224, l2 = s2 >> 3, i8 = s2 & 7, un = i8 >> 2, q = i8 & 3;
            src = (q < 2 ? CTX_IN(11) : CTX_IN(12)) + (size_t)l2 * D * DF + un * 128 + 64 * (q & 1); ld = 256; dst = (u16*)(ws + WS_WSGU) + (size_t)l2 * 512 * 1024 + (size_t)(64 * i8) * 1024; }
        else if (seg < 272) { const int s2 = seg - 240, l2 = s2 >> 4, col = 64 * (s2 & 15); src = CTX_IN(13) + (size_t)l2 * DF * D + col; ld = 1024; Kd = 256; dst = (u16*)(ws + WS_WSD) + (size_t)l2 * D * DF + (size_t)col * 256; }
        else { const int s2 = seg - 272, l2 = s2 >> 2, col = 64 * (s2 & 3); src = CTX_IN(6) + (size_t)l2 * D * NE + col; ld = 256; dst = (u16*)(ws + WS_WRH) + (size_t)l2 * NE * D + (size_t)col * 1024; dst_lo = (u16*)(ws + WS_WRL) + (size_t)l2 * NE * D + (size_t)col * 1024; }
        {
            const int kr = tid >> 4, c4 = tid & 15;
#pragma unroll
            for (int i = 0; i < 2; ++i) {
                const f32x4 v = *(const f32x4*)(src + (size_t)(kt * 64 + kr + 32 * i) * ld + 4 * c4);
#pragma unroll
                for (int jj = 0; jj < 4; ++jj) tl[(kr + 32 * i) * 65 + 4 * c4 + jj] = v[jj];
            }
        }
        __syncthreads();
        {
            const int row = tid >> 3, kc = tid & 7;
            float f[8];
#pragma unroll
            for (int jj = 0; jj < 8; ++jj) f[jj] = tl[(8 * kc + jj) * 65 + row];
            u32x4 w; w[0] = cvtpk(f[0], f[1]); w[1] = cvtpk(f[2], f[3]); w[2] = cvtpk(f[4], f[5]); w[3] = cvtpk(f[6], f[7]);
            *(u32x4*)(dst + (size_t)row * Kd + kt * 64 + 8 * kc) = w;
            if (dst_lo) {
                u32x4 wl;
#pragma unroll
                for (int jj = 0; jj < 4; ++jj) wl[jj] = cvtpk(f[2 * jj] - bf2f(w[jj] & 0xFFFFu), f[2 * jj + 1] - bf2f(w[jj] >> 16));
                *(u32x4*)(dst_lo + (size_t)row * Kd + kt * 64 + 8 * kc) = wl;
            }
        }
        __syncthreads();
    }
}

__device__ __forceinline__ void ph_qkv(int L, int rep_) {
    PH_FN_BEGIN
    (void)rep_;
    const pg8::Gemm g{P_xb, (const u16*)(ws + (L == 0 ? WS_WQK0 : WS_WQK1)), T, NQ, D};
    pg8::StaticOrder S; S.init(g.M, g.N, G, bid);
    const EpiQK E{P_qkv, NQ};
    pg8::gemm_phase<EpiQK, pg8::StaticOrder, false>((PG8_LAS unsigned char*)lds, g, S, E, nullptr);
}

__device__ __forceinline__ void ph_kmean(int L, int rep_) {
    PH_FN_BEGIN
    (void)rep_;
    PH_BEGIN;
    LAS float* red = (LAS float*)lds;
    for (int it = bid; it < BATCH * NH * MOBA_NB; it += G) {
        const int j = it & 31, h = (it >> 5) & 15, b = it >> 9;
        const int kg_ = tid >> 3, ch = tid & 7;
        const u16* kp = P_qkv + (size_t)(b * SEQ + j * MOBA_BLK + kg_) * 3072 + 1024 + h * 64 + ch * 8;
        float sm[8];
#pragma unroll
        for (int e2 = 0; e2 < 8; ++e2) sm[e2] = 0.f;
#pragma unroll
        for (int i = 0; i < 4; ++i) {
            const u32x4 v = *(const u32x4*)(kp + (size_t)(64 * i) * 3072);
#pragma unroll
            for (int e2 = 0; e2 < 4; ++e2) { sm[2 * e2] += bf2f(v[e2] & 0xFFFFu); sm[2 * e2 + 1] += bf2f(v[e2] >> 16); }
        }
#pragma unroll
        for (int e2 = 0; e2 < 8; ++e2) red[kg_ * 65 + ch * 8 + e2] = sm[e2];
        __syncthreads();
        if (tid < 64) {
            float tot = 0.f;
#pragma unroll 8
            for (int q = 0; q < 64; ++q) tot += red[q * 65 + tid];
            P_kmean[(size_t)it * 64 + tid] = tot * (1.f / MOBA_BLK);
        }
        __syncthreads();
    }
}

__device__ __forceinline__ void ph_gate(int L, int rep_) {
    PH_FN_BEGIN
    (void)rep_;
    PH_BEGIN;
    for (int it = bid; it < BATCH * NH * MOBA_NB; it += G) {
        const int qb = it & 31, bh = it >> 5, b = bh >> 4, h = bh & 15;
        const int tq = qb * MOBA_BLK + wave * 32 + r32;
        const u16* qrow = P_qkv + (size_t)(b * SEQ + tq) * 3072 + h * 64 + hi * 8;
        bf16x8 qf[4];
#pragma unroll
        for (int d0 = 0; d0 < 4; ++d0) qf[d0] = *(const bf16x8*)(qrow + d0 * 16);
        unsigned selmask = 0u;
        if (qb > 0) {
            const float* km = P_kmean + ((size_t)(b * NH + h) * MOBA_NB + r32) * 64 + hi * 8;
            f32x16 gt;
#pragma unroll
            for (int r = 0; r < 16; ++r) gt[r] = 0.f;
#pragma unroll
            for (int d0 = 0; d0 < 4; ++d0) {
                const f32x4 k0 = *(const f32x4*)(km + d0 * 16), k1 = *(const f32x4*)(km + d0 * 16 + 4);
                union { bf16x8 v; unsigned u[4]; } kf;
                kf.u[0] = cvtpk(k0[0], k0[1]); kf.u[1] = cvtpk(k0[2], k0[3]); kf.u[2] = cvtpk(k1[0], k1[1]); kf.u[3] = cvtpk(k1[2], k1[3]);
                gt = MFMA_BF16(kf.v, qf[d0], gt);
            }
            float v0 = -INFINITY, v1 = -INFINITY, v2 = -INFINITY; int i0 = 99, i1 = 99, i2 = 99;
#pragma unroll
            for (int r = 0; r < 16; ++r) { const int jb = crow(r, hi); const float gv = jb < qb ? gt[r] : -INFINITY; top3_insert(gv, jb < qb ? jb : 99, v0, i0, v1, i1, v2, i2); }
            const float ov0 = __shfl_xor(v0, 32), ov1 = __shfl_xor(v1, 32), ov2 = __shfl_xor(v2, 32);
            const int oi0 = __shfl_xor(i0, 32), oi1 = __shfl_xor(i1, 32), oi2 = __shfl_xor(i2, 32);
            top3_insert(ov0, oi0, v0, i0, v1, i1, v2, i2); top3_insert(ov1, oi1, v0, i0, v1, i1, v2, i2); top3_insert(ov2, oi2, v0, i0, v1, i1, v2, i2);
            if (i0 < 32) selmask |= 1u << i0;
            if (i1 < 32) selmask |= 1u << i1;
            if (i2 < 32) selmask |= 1u << i2;
        }
        if (hi == 0) P_selm[(size_t)bh * SEQ + tq] = selmask;
    }
}

constexpr int MB_KP = 72;
constexpr int MB_VP = 260;
constexpr int MB_LDS_K = 0;
constexpr int MB_LDS_V = 256 * MB_KP * 2;
constexpr int MB_LDS_LIST = MB_LDS_V + 64 * MB_VP * 2;
constexpr int MB_LDS_CTR = MB_LDS_LIST + 8192 * 2;
__device__ __forceinline__ void ph_moba(int L, int rep_) {
    PH_FN_BEGIN
    (void)rep_;
    PH_BEGIN;
    LAS char* Ks = lds + MB_LDS_K; LAS char* Vs = lds + MB_LDS_V;
    LAS u16* qlist = (LAS u16*)(lds + MB_LDS_LIST); LAS int* ctr = (LAS int*)(lds + MB_LDS_CTR);
    for (int it = bid; it < BATCH * NH * MOBA_NB; it += G) {
        const int rnd = it >> 8, w8 = it & 255, a8 = w8 >> 5, bh = w8 & 31;
        const int j = rnd == 0 ? a8 : (rnd == 1 ? 15 - a8 : (rnd == 2 ? 16 + a8 : 31 - a8));
        const int b = bh >> 4, h = bh & 15;
        const float slope2 = exp2f(-0.5f * (float)(h + 1)) * LOG2E;
        if (tid == 0) { int z0 = 0; asm volatile("" : "+v"(z0)); ctr[0] = z0; ctr[1] = z0; }
        {
            const u16* kg = P_qkv + (size_t)(b * SEQ + j * MOBA_BLK) * 3072 + 1024 + h * 64;
#pragma unroll
            for (int i = 0; i < 4; ++i) { const int c = tid + i * 512, row = c >> 3, ch = c & 7; *(LAS u32x4*)(Ks + (row * MB_KP + ch * 8) * 2) = *(const u32x4*)(kg + (size_t)row * 3072 + ch * 8); }
            const u16* vg = P_qkv + (size_t)(b * SEQ + j * MOBA_BLK) * 3072 + 2048 + h * 64;
#pragma unroll
            for (int i = 0; i < 4; ++i) {
                const int c = tid + i * 512, key = c >> 3, ch = c & 7;
                const u32x4 v = *(const u32x4*)(vg + (size_t)key * 3072 + ch * 8);
#pragma unroll
                for (int e2 = 0; e2 < 4; ++e2) {
                    *(LAS u16*)(Vs + ((ch * 8 + 2 * e2) * MB_VP + key) * 2) = (u16)(v[e2] & 0xFFFFu);
                    *(LAS u16*)(Vs + ((ch * 8 + 2 * e2 + 1) * MB_VP + key) * 2) = (u16)(v[e2] >> 16);
                }
            }
        }
        __syncthreads();
        {
            const unsigned* sm = P_selm + (size_t)bh * SEQ;
            for (int t0 = (j + 1) * MOBA_BLK; t0 < SEQ; t0 += 512) {
                const int t = t0 + tid;
                const bool sel = (t < SEQ) && ((sm[t < SEQ ? t : 0] >> j) & 1u);
                const unsigned long long bal = __ballot(sel);
                const int total = __popcll(bal);
                int wb = 0;
                if (lane == 0 && total) wb = atomicAdd((int*)&ctr[0], total);
                wb = __shfl(wb, 0);
                if (sel) qlist[wb + __popcll(bal & ((1ull << lane) - 1ull))] = (u16)t;
            }
        }
        __syncthreads();
        const int nq = ctr[0];
        const int ntiles = 8 + ((nq + 31) >> 5);
        for (;;) {
            int ti = 0;
            if (lane == 0) ti = atomicAdd((int*)&ctr[1], 1);
            ti = __shfl(ti, 0);
            if (ti >= ntiles) break;
            const bool own = ti < 8;
            const int wq = 7 - ti;
            const int li = (ti - 8) * 32 + r32;
            const bool valid = own || li < nq;
            const int tq = own ? j * MOBA_BLK + wq * 32 + r32 : (int)qlist[li < nq ? li : nq - 1];
            const int nsteps = own ? wq + 1 : 8;
            const u16* qrow = P_qkv + (size_t)(b * SEQ + tq) * 3072 + h * 64 + hi * 8;
            bf16x8 qf[4];
#pragma unroll
            for (int d0 = 0; d0 < 4; ++d0) qf[d0] = *(const bf16x8*)(qrow + d0 * 16);
            int slot = 3;
            if (!own) slot = __popc(P_selm[(size_t)bh * SEQ + tq] & ((1u << j) - 1u));
            AttnSt st; st.m = NEGV; st.l = 0.f;
#pragma unroll
            for (int r = 0; r < 16; ++r) { st.o0[r] = 0.f; st.o1[r] = 0.f; }
            const int dlo = own ? 0 : -0x40000000;
            for (int kt = 0; kt < nsteps; ++kt) {
                AttnFr f;
#pragma unroll
                for (int d0 = 0; d0 < 4; ++d0) f.k[d0] = *(LAS bf16x8*)(Ks + ((kt * 32 + r32) * MB_KP + d0 * 16 + hi * 8) * 2);
#pragma unroll
                for (int q4 = 0; q4 < 4; ++q4) {
                    union { bf16x8 v; u32x2 hh[2]; } va;
                    LAS char* vp = Vs + (((q4 >> 1) * 32 + r32) * MB_VP + kt * 32 + (q4 & 1) * 16 + 4 * hi) * 2;
                    va.hh[0] = *(LAS u32x2*)(vp); va.hh[1] = *(LAS u32x2*)(vp + 16);
                    f.v[q4] = va.v;
                }
                attn_compute(st, qf, f, tq - (j * MOBA_BLK + kt * 32) - 4 * hi, slope2, dlo, 0x7fffffff, hi);
            }
            const float lt = st.l + __shfl_xor(st.l, 32);
            const float inv = 1.f / lt;
            if (valid) {
                const size_t pi = ((size_t)(b * SEQ + tq) * NH + h) * 4 + slot;
                u16* orow = P_part + pi * 64;
#pragma unroll
                for (int rq = 0; rq < 4; ++rq) {
                    u32x2 w; w[0] = cvtpk(st.o0[4 * rq] * inv, st.o0[4 * rq + 1] * inv); w[1] = cvtpk(st.o0[4 * rq + 2] * inv, st.o0[4 * rq + 3] * inv);
                    *(u32x2*)(orow + 8 * rq + 4 * hi) = w;
                    w[0] = cvtpk(st.o1[4 * rq] * inv, st.o1[4 * rq + 1] * inv); w[1] = cvtpk(st.o1[4 * rq + 2] * inv, st.o1[4 * rq + 3] * inv);
                    *(u32x2*)(orow + 32 + 8 * rq + 4 * hi) = w;
                }
                if (hi == 0) P_plse[pi] = st.m * LN2 + logf(lt);
            }
        }
        __syncthreads();
    }
}

__device__ __forceinline__ void ph_mobamerge(int L, int rep_) {
    PH_FN_BEGIN
    (void)rep_;
    PH_BEGIN;
    for (size_t i = (size_t)bid * NTHR + tid; i < (size_t)T * NH * 8; i += (size_t)G * NTHR) {
        const size_t row = i >> 7; const int h = (int)(i >> 3) & 15, d8 = (int)i & 7;
        const int qb = (int)(row & (SEQ - 1)) >> 8;
        const int nsel = qb < 3 ? qb : 3;
        const size_t pi = (row * NH + h) * 4;
        float l[4], w[4];
        float mx = -INFINITY;
#pragma unroll
        for (int sidx = 0; sidx < 4; ++sidx) { const bool ok = sidx == 3 || sidx < nsel; l[sidx] = ok ? P_plse[pi + sidx] : -INFINITY; mx = fmaxf(mx, l[sidx]); }
        float ws_ = 0.f;
#pragma unroll
        for (int sidx = 0; sidx < 4; ++sidx) { w[sidx] = (sidx == 3 || sidx < nsel) ? expf(l[sidx] - mx) : 0.f; ws_ += w[sidx]; }
        const float inv = 1.f / ws_;
        float acc8[8];
#pragma unroll
        for (int c = 0; c < 8; ++c) acc8[c] = 0.f;
#pragma unroll
        for (int sidx = 0; sidx < 4; ++sidx) {
            if (sidx == 3 || sidx < nsel) {
                const u32x4 a = *(const u32x4*)(P_part + (pi + sidx) * 64 + d8 * 8);
                const float ww = w[sidx] * inv;
#pragma unroll
                for (int c = 0; c < 4; ++c) { acc8[2 * c] += ww * bf2f(a[c] & 0xFFFFu); acc8[2 * c + 1] += ww * bf2f(a[c] >> 16); }
            }
        }
        u32x4 o;
#pragma unroll
        for (int c = 0; c < 4; ++c) o[c] = cvtpk(acc8[2 * c], acc8[2 * c + 1]);
        *(u32x4*)(P_ao + row * D + h * 64 + d8 * 8) = o;
    }
}

constexpr int DL_KP = 72, DL_VP = 388;
constexpr int DL_LDS_K = 0, DL_LDS_V = 384 * DL_KP * 2;
__device__ __forceinline__ void ph_dil(int L, int rep_) {
    PH_FN_BEGIN
    (void)rep_;
    PH_BEGIN;
    LAS char* Ks = lds + DL_LDS_K; LAS char* Vs = lds + DL_LDS_V;
    for (int it = bid; it < BATCH * NH * 3 * 32; it += G) {
        const int ch = it & 31, grp = (it >> 5) % 3, bh = it / 96, b = bh >> 4, h = bh & 15;
        const int dil = grp == 0 ? 1 : (grp == 1 ? 4 : 16), Ls = SEQ / dil;
        const float slope2 = exp2f(-0.5f * (float)(h + 1)) * LOG2E * (float)dil;
        const int uc = ch * 256, res = uc / Ls, c0 = uc - res * Ls;
        const int kb0 = c0 - 128;
        {
            const u16* kg = P_qkv + (size_t)(b * SEQ) * 9216 + grp * 3072 + 1024 + h * 64;
#pragma unroll
            for (int i = 0; i < 6; ++i) {
                const int c = tid + i * 512, row = c >> 3, chk = c & 7, ks = kb0 + row;
                if (ks >= 0) *(LAS u32x4*)(Ks + (row * DL_KP + chk * 8) * 2) = *(const u32x4*)(kg + (size_t)(ks * dil + res) * 9216 + chk * 8);
            }
            const u16* vg = P_qkv + (size_t)(b * SEQ) * 9216 + grp * 3072 + 2048 + h * 64;
#pragma unroll
            for (int i = 0; i < 6; ++i) {
                const int c = tid + i * 512, row = c >> 3, chk = c & 7, ks = kb0 + row;
                if (ks >= 0) {
                    const u32x4 v = *(const u32x4*)(vg + (size_t)(ks * dil + res) * 9216 + chk * 8);
#pragma unroll
                    for (int e2 = 0; e2 < 4; ++e2) {
                        *(LAS u16*)(Vs + ((chk * 8 + 2 * e2) * DL_VP + row) * 2) = (u16)(v[e2] & 0xFFFFu);
                        *(LAS u16*)(Vs + ((chk * 8 + 2 * e2 + 1) * DL_VP + row) * 2) = (u16)(v[e2] >> 16);
                    }
                }
            }
        }
        __syncthreads();
        const int i0 = c0 + wave * 32, iq = i0 + r32, pq = iq * dil + res;
        const u16* qrow = P_qkv + (size_t)(b * SEQ + pq) * 9216 + grp * 3072 + h * 64 + hi * 8;
        bf16x8 qf[4];
#pragma unroll
        for (int d0 = 0; d0 < 4; ++d0) qf[d0] = *(const bf16x8*)(qrow + d0 * 16);
        AttnSt st; st.m = NEGV; st.l = 0.f;
#pragma unroll
        for (int r = 0; r < 16; ++r) { st.o0[r] = 0.f; st.o1[r] = 0.f; }
        const int ktmin = (i0 >= 128) ? 0 : (128 - i0) >> 5;
        for (int kt = 4; kt >= ktmin; --kt) {
            const int lrow0 = (wave + kt) * 32;
            AttnFr f;
#pragma unroll
            for (int d0 = 0; d0 < 4; ++d0) f.k[d0] = *(LAS bf16x8*)(Ks + ((lrow0 + r32) * DL_KP + d0 * 16 + hi * 8) * 2);
#pragma unroll
            for (int q4 = 0; q4 < 4; ++q4) {
                union { bf16x8 v; u32x2 hh[2]; } va;
                LAS char* vp = Vs + (((q4 >> 1) * 32 + r32) * DL_VP + lrow0 + (q4 & 1) * 16 + 4 * hi) * 2;
                va.hh[0] = *(LAS u32x2*)(vp); va.hh[1] = *(LAS u32x2*)(vp + 16);
                f.v[q4] = va.v;
            }
            const int k0 = i0 - 128 + kt * 32;
            attn_compute(st, qf, f, iq - k0 - 4 * hi, slope2, 0, 128, hi);
        }
        const float lt = st.l + __shfl_xor(st.l, 32);
        const float inv = 1.f / lt;
        u16* orow = P_og + (size_t)grp * T * D + (size_t)(b * SEQ + pq) * D + h * 64;
#pragma unroll
        for (int rq = 0; rq < 4; ++rq) {
            u32x2 w; w[0] = cvtpk(st.o0[4 * rq] * inv, st.o0[4 * rq + 1] * inv); w[1] = cvtpk(st.o0[4 * rq + 2] * inv, st.o0[4 * rq + 3] * inv);
            *(u32x2*)(orow + 8 * rq + 4 * hi) = w;
            w[0] = cvtpk(st.o1[4 * rq] * inv, st.o1[4 * rq + 1] * inv); w[1] = cvtpk(st.o1[4 * rq + 2] * inv, st.o1[4 * rq + 3] * inv);
            *(u32x2*)(orow + 32 + 8 * rq + 4 * hi) = w;
        }
        if (hi == 0) P_lse[((size_t)grp * T + (b * SEQ + pq)) * NH + h] = st.m * LN2 + logf(lt);
        __syncthreads();
    }
}

__device__ __forceinline__ void ph_merge(int L, int rep_) {
    PH_FN_BEGIN
    (void)rep_;

            PH_BEGIN;
                for (size_t i = (size_t)bid * NTHR + tid; i < (size_t)T * NH * 8; i += (size_t)G * NTHR) {
                    const size_t row = i >> 7; const int h = (int)(i >> 3) & 15, d8 = (int)i & 7;
                    const float l0 = P_lse[(0 * (size_t)T + row) * NH + h], l1 = P_lse[(1 * (size_t)T + row) * NH + h], l2 = P_lse[(2 * (size_t)T + row) * NH + h];
                    const float mx = fmaxf(l0, fmaxf(l1, l2));
                    float w0 = expf(l0 - mx), w1 = expf(l1 - mx), w2 = expf(l2 - mx);
                    const float inv = 1.f / (w0 + w1 + w2); w0 *= inv; w1 *= inv; w2 *= inv;
                    const size_t off = row * D + h * 64 + d8 * 8;
                    const u32x4 a0 = *(const u32x4*)(P_og + off), a1 = *(const u32x4*)(P_og + (size_t)T * D + off), a2 = *(const u32x4*)(P_og + 2 * (size_t)T * D + off);
                    u32x4 o;
#pragma unroll
                    for (int c = 0; c < 4; ++c) {
                        const float lo_ = w0 * bf2f(a0[c] & 0xFFFFu) + w1 * bf2f(a1[c] & 0xFFFFu) + w2 * bf2f(a2[c] & 0xFFFFu);
                        const float hi_ = w0 * bf2f(a0[c] >> 16) + w1 * bf2f(a1[c] >> 16) + w2 * bf2f(a2[c] >> 16);
                        o[c] = cvtpk(lo_, hi_);
                    }
                    *(u32x4*)(P_ao + off) = o;
                }

}

__device__ __forceinline__ void ph_wo(int L, int rep_) {
    PH_FN_BEGIN
    (void)rep_;
    const pg8::Gemm g{P_ao, (const u16*)(ws + WS_WO) + (size_t)L * D * D, T, D, D};
    pg8::StaticOrder S; S.init(g.M, g.N, G, bid);
    const EpiWo E{P_ypre, L == 0 ? CTX_IN(0) : (const float*)P_x2};
    pg8::gemm_phase<EpiWo, pg8::StaticOrder, false>((PG8_LAS unsigned char*)lds, g, S, E, nullptr);
}

__device__ __forceinline__ void ph_router(int L, int rep_) {
    PH_FN_BEGIN
    (void)rep_;

            PH_BEGIN;
            const float* lng = CTX_IN(4) + L * D; const float* lnb = CTX_IN(5) + L * D;
            const float* rbias = CTX_IN(7) + L * NE;
            const u16* wrh = (const u16*)(ws + WS_WRH) + (size_t)L * NE * D; const u16* wrl = (const u16*)(ws + WS_WRL) + (size_t)L * NE * D;
            constexpr int AP = 2064;
            LAS char* ahi = lds; LAS char* alo = lds + 32 * AP;
            for (int it = bid; it < T / 32; it += G) {
                {
                    f32x4 yv[4][4];
#pragma unroll
                    for (int rr = 0; rr < 4; ++rr)
#pragma unroll
                        for (int j = 0; j < 4; ++j) yv[rr][j] = *(const f32x4*)(P_ypre + ((size_t)it * 32 + wave * 4 + rr) * D + j * 256 + lane * 4);
#pragma unroll
                    for (int rr = 0; rr < 4; ++rr) {
                        const int lr = wave * 4 + rr; const size_t row = (size_t)it * 32 + lr;
                        float v[16];
#pragma unroll
                        for (int j = 0; j < 4; ++j) { v[j * 4] = yv[rr][j][0]; v[j * 4 + 1] = yv[rr][j][1]; v[j * 4 + 2] = yv[rr][j][2]; v[j * 4 + 3] = yv[rr][j][3]; }
                        ln_row(v, lng, lnb, lane);
#pragma unroll
                        for (int j = 0; j < 4; ++j) {
                            f32x4 t4; t4[0] = v[j * 4]; t4[1] = v[j * 4 + 1]; t4[2] = v[j * 4 + 2]; t4[3] = v[j * 4 + 3];
                            *(f32x4*)(P_x1 + row * D + j * 256 + lane * 4) = t4;
                            u32x2 w; w[0] = cvtpk(t4[0], t4[1]); w[1] = cvtpk(t4[2], t4[3]);
                            *(u32x2*)(P_xb + row * D + j * 256 + lane * 4) = w;
                            *(unsigned*)(P_xb8 + row * D + j * 256 + lane * 4) = pack_fp8x4(t4[0], t4[1], t4[2], t4[3]);
                            u32x2 wl; wl[0] = cvtpk(t4[0] - bf2f(w[0] & 0xFFFFu), t4[1] - bf2f(w[0] >> 16)); wl[1] = cvtpk(t4[2] - bf2f(w[1] & 0xFFFFu), t4[3] - bf2f(w[1] >> 16));
                            *(LAS u32x2*)(ahi + lr * AP + (j * 256 + lane * 4) * 2) = w;
                            *(LAS u32x2*)(alo + lr * AP + (j * 256 + lane * 4) * 2) = wl;
                        }
                    }
                }
                __syncthreads();
                f32x16 lg;
#pragma unroll
                for (int r = 0; r < 16; ++r) lg[r] = 0.f;
                {
                    const LAS char* ah = ahi + r32 * AP + hi * 16; const LAS char* al = alo + r32 * AP + hi * 16;
                    const u16* bh = wrh + (size_t)(wave * 32 + r32) * D + hi * 8; const u16* bl = wrl + (size_t)(wave * 32 + r32) * D + hi * 8;
                    bf16x8 bha[8], bla[8], bhb[8], blb[8];
#pragma unroll
                    for (int j = 0; j < 8; ++j) { bha[j] = *(const bf16x8*)(bh + j * 16); bla[j] = *(const bf16x8*)(bl + j * 16); }
#pragma unroll 1
                    for (int k0 = 0; k0 < D; k0 += 256) {
#pragma unroll
                        for (int j = 0; j < 8; ++j) { bhb[j] = *(const bf16x8*)(bh + k0 + 128 + j * 16); blb[j] = *(const bf16x8*)(bl + k0 + 128 + j * 16); }
#pragma unroll
                        for (int j = 0; j < 8; ++j) {
                            const bf16x8 xh = *(const LAS bf16x8*)(ah + (k0 + j * 16) * 2), xl = *(const LAS bf16x8*)(al + (k0 + j * 16) * 2);
                            lg = MFMA_BF16(xh, bha[j], lg); lg = MFMA_BF16(xl, bha[j], lg); lg = MFMA_BF16(xh, bla[j], lg);
                        }
                        { const int kn = (k0 + 256 < D) ? k0 + 256 : 0;
#pragma unroll
                          for (int j = 0; j < 8; ++j) { bha[j] = *(const bf16x8*)(bh + kn + j * 16); bla[j] = *(const bf16x8*)(bl + kn + j * 16); } }
#pragma unroll
                        for (int j = 0; j < 8; ++j) {
                            const bf16x8 xh = *(const LAS bf16x8*)(ah + (k0 + 128 + j * 16) * 2), xl = *(const LAS bf16x8*)(al + (k0 + 128 + j * 16) * 2);
                            lg = MFMA_BF16(xh, bhb[j], lg); lg = MFMA_BF16(xl, bhb[j], lg); lg = MFMA_BF16(xh, blb[j], lg);
                        }
                    }
                }
                __syncthreads();
                LAS float* lgs = (LAS float*)lds;
#pragma unroll
                for (int r = 0; r < 16; ++r) lgs[crow(r, hi) * 257 + wave * 32 + r32] = lg[r];
                __syncthreads();
#pragma unroll 1
                for (int rr = 0; rr < 4; ++rr) {
                    const int lr = wave * 4 + rr; const int tok = it * 32 + lr;
                    float sc[4], ch[4];
#pragma unroll
                    for (int j = 0; j < 4; ++j) { const int e = lane + 64 * j; sc[j] = 1.f / (1.f + expf(-lgs[lr * 257 + e])); ch[j] = sc[j] + rbias[e]; }
                    float gsel[8];
#pragma unroll
                    for (int j = 0; j < 4; ++j) {
                        const float rm = dpp_rowmax(ch[j]);
                        const float m1a = fmaxf(rl_f(rm, 0), rl_f(rm, 16)), m1b = fmaxf(rl_f(rm, 32), rl_f(rm, 48));
                        const unsigned long long bal = __ballot(ch[j] == (hi ? m1b : m1a));
                        const int fa_ = __builtin_ctz((unsigned)(bal & 0xFFFFFFFFull)), fb_ = 32 + __builtin_ctz((unsigned)(bal >> 32));
                        const float c2 = (lane == fa_ || lane == fb_) ? -INFINITY : ch[j];
                        const float rm2 = dpp_rowmax(c2);
                        gsel[2 * j] = m1a + fmaxf(rl_f(rm2, 0), rl_f(rm2, 16));
                        gsel[2 * j + 1] = m1b + fmaxf(rl_f(rm2, 32), rl_f(rm2, 48));
                    }
                    float cv[4];
#pragma unroll
                    for (int j = 0; j < 4; ++j) {
                        int ra_ = 0, rb_ = 0;
#pragma unroll
                        for (int g2 = 0; g2 < 8; ++g2) {
                            ra_ += ((gsel[g2] > gsel[2 * j]) || (gsel[g2] == gsel[2 * j] && g2 < 2 * j)) ? 1 : 0;
                            rb_ += ((gsel[g2] > gsel[2 * j + 1]) || (gsel[g2] == gsel[2 * j + 1] && g2 < 2 * j + 1)) ? 1 : 0;
                        }
                        cv[j] = ((hi ? rb_ : ra_) < 4) ? ch[j] : NEGV;
                    }
                    float wsel = 0.f; int esel = 0; float wsum = 0.f;
#pragma unroll 1
                    for (int k = 0; k < TOPK; ++k) {
                        float bv = cv[0]; int be = lane;
#pragma unroll
                        for (int j = 1; j < 4; ++j) if (cv[j] > bv) { bv = cv[j]; be = lane + 64 * j; }
                        const float rm = dpp_rowmax(bv);
                        const float mval = fmaxf(fmaxf(rl_f(rm, 0), rl_f(rm, 16)), fmaxf(rl_f(rm, 32), rl_f(rm, 48)));
                        const int ri = dpp_rowmin_i(bv == mval ? be : 0x7fffffff);
                        const int e = min(min(__builtin_amdgcn_readlane(ri, 0), __builtin_amdgcn_readlane(ri, 16)), min(__builtin_amdgcn_readlane(ri, 32), __builtin_amdgcn_readlane(ri, 48)));
                        const int jl = e >> 6, ll = e & 63;
                        float smine = sc[0];
                        smine = jl == 1 ? sc[1] : smine; smine = jl == 2 ? sc[2] : smine; smine = jl == 3 ? sc[3] : smine;
                        const float sw = rl_f(smine, ll);
#pragma unroll
                        for (int j = 0; j < 4; ++j) cv[j] = (lane == ll && jl == j) ? -INFINITY : cv[j];
                        wsum += sw;
                        if (lane == k) { wsel = sw; esel = e; }
                    }
                    if (lane < TOPK) {
                        const int a = tok * TOPK + lane;
                        P_topw[a] = wsel / wsum * 2.5f;
                        if (rep_ == 0) {
                            const int pos = atomicAdd(&cnt[esel], 1);
                            P_list[(size_t)esel * T + pos] = a;
                        }
                    }
                }
                __syncthreads();
            }

}

__device__ __forceinline__ void ph_gateup(int L, int rep_) {
    PH_FN_BEGIN
    (void)rep_;
    {
        PH_BEGIN;
        const float* weg = CTX_IN(8) + (size_t)L * NE * D * DF; const float* weu = CTX_IN(9) + (size_t)L * NE * D * DF;
        LAS int* rowva = (LAS int*)(lds + MOE_LDS_VA);
        for (int e = bid; e < NE; e += G) {
            const int n = cnt[e];
            for (int r0 = 0; r0 < n; r0 += 1024) {
#pragma unroll
                for (int i = 0; i < 2; ++i) { const int idx = r0 + i * 512 + tid; rowva[i * 512 + tid] = idx < n ? P_list[(size_t)e * T + idx] : TRASH_VA; }
                __syncthreads();
                moe_expert<false>(lds, tid, lane, wave, r32, hi, P_xb8, weg + (size_t)e * D * DF, weu + (size_t)e * D * DF, (n - r0) < 1024 ? (n - r0) : 1024, (void*)P_hb);
            }
        }
    }
    {
        PH_BEGIN;
        const pg8::Gemm g{P_xb, (const u16*)(ws + WS_WSGU) + (size_t)L * 512 * 1024, T, 512, D};
        const EpiSGU E{P_hbs};
        int* qctr = (int*)(ws + WS_CTL + CTL_CNT_OFF + 4096) + (L * 4 + 2 * (rep_ & 1)) * 64;
        LAS int* slot = (LAS int*)(lds + 140000);
        for (;;) {
            __syncthreads();
            if (tid == 0) *slot = atomicAdd(qctr, 1);
            __syncthreads();
            const int un = *slot;
            if (un >= 128) break;
            const pg8::FixedOrder S{un & 63, un >> 6};
            pg8::gemm_phase<EpiSGU, pg8::FixedOrder, false>((PG8_LAS unsigned char*)lds, g, S, E, nullptr);
        }
    }
}

__device__ __forceinline__ void ph_down(int L, int rep_) {
    PH_FN_BEGIN
    (void)rep_;
    {
        PH_BEGIN;
        const float* wed = CTX_IN(10) + (size_t)L * NE * DF * D;
        LAS int* rowva = (LAS int*)(lds + MOE_LDS_VA); LAS float* roww = (LAS float*)(lds + MOE_LDS_W);
        for (int e = bid; e < NE; e += G) {
            const int n = cnt[e];
            for (int r0 = 0; r0 < n; r0 += 1024) {
#pragma unroll
                for (int i = 0; i < 2; ++i) { const int idx = r0 + i * 512 + tid; const int va = idx < n ? P_list[(size_t)e * T + idx] : TRASH_VA; rowva[i * 512 + tid] = va; roww[i * 512 + tid] = va < A_TOT ? P_topw[va] : 0.f; }
                __syncthreads();
                moe_expert<true>(lds, tid, lane, wave, r32, hi, (const unsigned char*)P_hb, wed + (size_t)e * DF * D, nullptr, (n - r0) < 1024 ? (n - r0) : 1024, (void*)P_yb);
            }
        }
    }
    {
        PH_BEGIN;
        const pg8::Gemm g{P_hbs, (const u16*)(ws + WS_WSD) + (size_t)L * D * DF, T, D, DF};
        const EpiSD E{P_yb};
        int* qctr = (int*)(ws + WS_CTL + CTL_CNT_OFF + 4096) + (L * 4 + 1 + 2 * (rep_ & 1)) * 64;
        LAS int* slot = (LAS int*)(lds + 140000);
        for (;;) {
            __syncthreads();
            if (tid == 0) *slot = atomicAdd(qctr, 1);
            __syncthreads();
            const int un = *slot;
            if (un >= 256) break;
            const pg8::FixedOrder S{un & 63, un >> 6};
            pg8::gemm_phase<EpiSD, pg8::FixedOrder, false>((PG8_LAS unsigned char*)lds, g, S, E, nullptr);
        }
    }
}

__device__ __forceinline__ void ph_combine(int L, int rep_) {
    PH_FN_BEGIN
    (void)rep_;
    PH_BEGIN;
    const float* lng = CTX_IN(14) + L * D; const float* lnb = CTX_IN(15) + L * D;
    float* dst = L == 0 ? P_x2 : AS_GLOBAL(float, ctx_ld(16));
    for (int row = bid * 8 + wave; row < T; row += G * 8) {
        u32x4 yv[TOPK + 1][2];
#pragma unroll
        for (int k = 0; k < TOPK + 1; ++k) {
            const size_t va = k < TOPK ? (size_t)row * TOPK + k : (size_t)A_TOT + row;
#pragma unroll
            for (int j = 0; j < 2; ++j) yv[k][j] = *(const u32x4*)(P_yb + va * D + j * 512 + lane * 8);
        }
        float v[16];
#pragma unroll
        for (int j = 0; j < 2; ++j) {
            const f32x4 t0 = *(const f32x4*)(P_x1 + (size_t)row * D + j * 512 + lane * 8), t1 = *(const f32x4*)(P_x1 + (size_t)row * D + j * 512 + lane * 8 + 4);
#pragma unroll
            for (int c = 0; c < 4; ++c) { v[j * 8 + c] = DN_ALPHA * t0[c]; v[j * 8 + 4 + c] = DN_ALPHA * t1[c]; }
        }
#pragma unroll
        for (int k = 0; k < TOPK + 1; ++k)
#pragma unroll
            for (int j = 0; j < 2; ++j)
#pragma unroll
                for (int c = 0; c < 4; ++c) { v[j * 8 + 2 * c] += bf2f(yv[k][j][c] & 0xFFFFu); v[j * 8 + 2 * c + 1] += bf2f(yv[k][j][c] >> 16); }
        float sm = 0.f;
#pragma unroll
        for (int i = 0; i < 16; ++i) sm += v[i];
        const float mu = wave_sum(sm) * (1.f / D);
        float q = 0.f;
#pragma unroll
        for (int i = 0; i < 16; ++i) { const float d = v[i] - mu; q += d * d; }
        const float rstd = rsqrtf(wave_sum(q) * (1.f / D) + LN_EPS);
#pragma unroll
        for (int j = 0; j < 2; ++j) {
            const f32x4 g0 = *(const f32x4*)(lng + j * 512 + lane * 8), g1 = *(const f32x4*)(lng + j * 512 + lane * 8 + 4);
            const f32x4 b0 = *(const f32x4*)(lnb + j * 512 + lane * 8), b1 = *(const f32x4*)(lnb + j * 512 + lane * 8 + 4);
            f32x4 o0, o1;
#pragma unroll
            for (int c = 0; c < 4; ++c) { o0[c] = (v[j * 8 + c] - mu) * rstd * g0[c] + b0[c]; o1[c] = (v[j * 8 + 4 + c] - mu) * rstd * g1[c] + b1[c]; }
            *(f32x4*)(dst + (size_t)row * D + j * 512 + lane * 8) = o0; *(f32x4*)(dst + (size_t)row * D + j * 512 + lane * 8 + 4) = o1;
            if (L == 0) { u32x4 w; w[0] = cvtpk(o0[0], o0[1]); w[1] = cvtpk(o0[2], o0[3]); w[2] = cvtpk(o1[0], o1[1]); w[3] = cvtpk(o1[2], o1[3]); *(u32x4*)(P_xb + (size_t)row * D + j * 512 + lane * 8) = w; }
        }
    }
}

__global__ void __launch_bounds__(NTHR, 2) fwd(Args args) {
    extern __shared__ __attribute__((aligned(16))) unsigned char lds_raw[];
    LAS char* lds = (LAS char*)lds_raw;
    unsigned char* const ws = args.ws;
    const int lo = args.ph_lo, hi_ph = args.ph_hi;
    if (threadIdx.x < 18) {
        const uint64_t v = threadIdx.x < 16 ? (uint64_t)args.in[threadIdx.x] : (threadIdx.x == 16 ? (uint64_t)args.out : (uint64_t)args.ws);
        ((LAS uint64_t*)(lds + LDS_CTX))[threadIdx.x] = v;
    }
    __syncthreads();
#define IN(k) (lo <= (k) && (k) < hi_ph)

#if MK_ONE_LAUNCH
    if (threadIdx.x < 4) ((LAS unsigned*)(lds + LDS_BAR))[threadIdx.x] = 0u;
    __syncthreads();
    XcdBarrier bar = xcd_barrier_post((unsigned*)(ws + WS_CTL), (volatile LAS unsigned*)(lds + LDS_BAR));
#define GRID_BAR() xcd_barrier(bar)
#else
#define GRID_BAR() do { } while (0)
#endif
#define SEAM(k) do { if (IN(k) && IN((k) + 1)) GRID_BAR(); } while (0)

    for (int rep_ = 0; rep_ < ((IN(0) && PHK(0)) ? REPS(0) : 0); ++rep_) { ph_p0(0, rep_); }
    SEAM(0);

    for (int L = 0; L < 2; ++L) {
        const int pb = 1 + 10 * L;
        for (int rep_ = 0; rep_ < ((IN(pb + 0) && PHK(1)) ? REPS(1) : 0); ++rep_) { ph_qkv(L, rep_); }
        SEAM(pb + 0);

        if (L == 0) {
            for (int rep_ = 0; rep_ < ((IN(pb + 1) && PHK(2)) ? REPS(2) : 0); ++rep_) { ph_kmean(L, rep_); }
            SEAM(pb + 1);
            for (int rep_ = 0; rep_ < ((IN(pb + 2) && PHK(11)) ? REPS(11) : 0); ++rep_) { ph_gate(L, rep_); }
            SEAM(pb + 2);
        }

        if (L == 0) {
            for (int rep_ = 0; rep_ < ((IN(pb + 3) && PHK(3)) ? REPS(3) : 0); ++rep_) { ph_moba(L, rep_); }
            SEAM(pb + 3);
            for (int rep_ = 0; rep_ < ((IN(pb + 4) && PHK(12)) ? REPS(12) : 0); ++rep_) { ph_mobamerge(L, rep_); }
        } else {
            for (int rep_ = 0; rep_ < ((IN(pb + 3) && PHK(4)) ? REPS(4) : 0); ++rep_) { ph_dil(L, rep_); }
            SEAM(pb + 3);
            for (int rep_ = 0; rep_ < ((IN(pb + 4) && PHK(5)) ? REPS(5) : 0); ++rep_) { ph_merge(L, rep_); }
        }
        SEAM(pb + 4);

        for (int rep_ = 0; rep_ < ((IN(pb + 5) && PHK(6)) ? REPS(6) : 0); ++rep_) { ph_wo(L, rep_); }
        SEAM(pb + 5);

        for (int rep_ = 0; rep_ < ((IN(pb + 6) && PHK(7)) ? REPS(7) : 0); ++rep_) { ph_router(L, rep_); }
        SEAM(pb + 6);

        for (int rep_ = 0; rep_ < ((IN(pb + 7) && PHK(8)) ? REPS(8) : 0); ++rep_) { ph_gateup(L, rep_); }
        SEAM(pb + 7);

        for (int rep_ = 0; rep_ < ((IN(pb + 8) && PHK(9)) ? REPS(9) : 0); ++rep_) { ph_down(L, rep_); }
        SEAM(pb + 8);

        for (int rep_ = 0; rep_ < ((IN(pb + 9) && PHK(10)) ? REPS(10) : 0); ++rep_) { ph_combine(L, rep_); }
        if (L == 0) SEAM(pb + 9);
    }
}

extern "C" void kernel_launch(void* const* d_in, const int* in_sizes, int n_in, void* d_out, int out_size, void* d_ws, size_t ws_size, hipStream_t stream) {
    static int grid = 0;
    if (grid == 0) {
        if (n_in != 16 || out_size != T * D || ws_size < WS_END2) { fprintf(stderr, "kernel_launch: unexpected problem (n_in %d out %d ws %zu need %zu)\n", n_in, out_size, ws_size, (size_t)WS_END2); grid = -1; return; }
        int dev = 0, cus = 0, per_cu = 0;
        if (hipGetDevice(&dev) != hipSuccess || hipDeviceGetAttribute(&cus, hipDeviceAttributeMultiprocessorCount, dev) != hipSuccess) { grid = -1; return; }
        if (hipFuncSetAttribute((const void*)fwd, hipFuncAttributeMaxDynamicSharedMemorySize, LDS_BYTES) != hipSuccess) { fprintf(stderr, "kernel_launch: hipFuncSetAttribute failed\n"); grid = -1; return; }
        if (hipOccupancyMaxActiveBlocksPerMultiprocessor(&per_cu, (const void*)fwd, NTHR, LDS_BYTES) != hipSuccess || per_cu < 1) { fprintf(stderr, "kernel_launch: occupancy query says %d\n", per_cu); (void)hipGetLastError(); per_cu = 1; }
        grid = cus;
    }
    if (grid < 0) return;
    (void)hipMemsetAsync((char*)d_ws + WS_CTL, 0, CTL_BYTES, stream);
    Args a{};
    for (int i = 0; i < 16; ++i) a.in[i] = (const float*)d_in[i];
    a.out = (float*)d_out; a.ws = (unsigned char*)d_ws;
#if MK_ONE_LAUNCH
    a.ph_lo = 0; a.ph_hi = N_PHASES;
    hipLaunchKernelGGL(fwd, dim3(grid), dim3(NTHR), LDS_BYTES, stream, a);
#else
    for (int ph = 0; ph < N_PHASES; ++ph) {
        if (ph == 12 || ph == 13) continue;
        a.ph_lo = ph; a.ph_hi = ph + 1;
        hipLaunchKernelGGL(fwd, dim3(grid), dim3(NTHR), LDS_BYTES, stream, a);
    }
#endif
}
```

```cpp
#include <hip/hip_runtime.h>
#include <hip/hip_bf16.h>
#include <stdint.h>
#include <stdio.h>

#ifndef MK_ONE_LAUNCH
#define MK_ONE_LAUNCH 1
#endif

#ifndef PHMASK
#define PHMASK 0x1FFF
#endif
#define PHK(k) ((PHMASK >> (k)) & 1)
#ifndef REPEAT_KIND
#define REPEAT_KIND -1
#endif
#define REPS(k) ((k) == REPEAT_KIND ? 2 : 1)
#define LAS __attribute__((address_space(3)))
typedef __attribute__((ext_vector_type(8))) short bf16x8;
typedef __attribute__((ext_vector_type(16))) float f32x16;
typedef __attribute__((ext_vector_type(4))) float f32x4;
typedef __attribute__((ext_vector_type(4))) unsigned u32x4;
typedef __attribute__((ext_vector_type(2))) unsigned u32x2;
typedef unsigned short u16;

constexpr int D = 1024, BATCH = 2, SEQ = 8192, T = BATCH * SEQ, NH = 16, HD = 64;
constexpr int NE = 256, TOPK = 8, DF = 256;
constexpr int A_TOT = T * TOPK;
constexpr int MOBA_BLK = 256, MOBA_NB = SEQ / MOBA_BLK;
constexpr float DN_ALPHA = 1.4142135623730951f;
constexpr float LN_EPS = 1e-5f;
constexpr float LOG2E = 1.4426950408889634f;
constexpr float LN2 = 0.6931471805599453f;
constexpr float NEGV = -1e30f;
constexpr int NTHR = 512;

constexpr size_t al256(size_t x) { return (x + 255) & ~(size_t)255; }
constexpr size_t WS_CTL = 0;
constexpr size_t CTL_BYTES = 65536;
constexpr size_t CTL_CNT_OFF = 32768;
constexpr size_t WS_XB = WS_CTL + CTL_BYTES;
constexpr size_t WS_X1 = WS_XB + al256((size_t)T * D * 2);
constexpr size_t WS_X2 = WS_X1 + al256((size_t)T * D * 4);
constexpr size_t WS_YPRE = WS_X2 + al256((size_t)T * D * 4);
constexpr size_t WS_QKV = WS_YPRE + al256((size_t)T * D * 4);
constexpr size_t WS_VT = WS_QKV + al256((size_t)T * 9216 * 2);
constexpr size_t WS_KM = WS_VT + al256((size_t)3 * T * D * 2);
constexpr size_t WS_AO = WS_KM + al256((size_t)BATCH * NH * MOBA_NB * HD * 4);
constexpr size_t WS_OG = WS_AO + al256((size_t)T * D * 2);
constexpr size_t WS_LSE = WS_OG + al256((size_t)3 * T * D * 2);
constexpr size_t WS_TOPW = WS_LSE + al256((size_t)3 * T * NH * 4);
constexpr size_t WS_LIST = WS_TOPW + al256((size_t)T * TOPK * 4);
constexpr size_t WS_HB = WS_LIST + al256((size_t)NE * T * 4);
constexpr size_t WS_YB = WS_HB + al256((size_t)(A_TOT + T + 1) * DF * 2);
constexpr size_t WS_END = WS_YB + al256((size_t)(A_TOT + T + 1) * D * 2);
constexpr int TRASH_VA = A_TOT + T;
constexpr size_t WS_SELM = WS_END;
constexpr size_t WS_PART = WS_SELM + al256((size_t)T * NH * 4);
constexpr size_t WS_PLSE = WS_PART + al256((size_t)T * NH * 4 * 64 * 2);
constexpr size_t WS_WQK0 = WS_PLSE + al256((size_t)T * NH * 4 * 4);
constexpr size_t WS_WV0 = WS_WQK0 + (size_t)2048 * 1024 * 2;
constexpr size_t WS_WQK1 = WS_WV0 + (size_t)1024 * 1024 * 2;
constexpr size_t WS_WV1 = WS_WQK1 + (size_t)6144 * 1024 * 2;
constexpr size_t WS_WO = WS_WV1 + (size_t)3072 * 1024 * 2;
constexpr size_t WS_WSGU = WS_WO + (size_t)2 * 1024 * 1024 * 2;
constexpr size_t WS_WSD = WS_WSGU + (size_t)2 * 512 * 1024 * 2;
constexpr size_t WS_XB8 = WS_WSD + (size_t)2 * 1024 * 256 * 2;
constexpr size_t WS_HBS = WS_XB8 + (size_t)T * D;
constexpr size_t WS_WRH = WS_HBS + (size_t)T * DF * 2;
constexpr size_t WS_WRL = WS_WRH + (size_t)2 * 256 * 1024 * 2;
constexpr size_t WS_END2 = WS_WRL + (size_t)2 * 256 * 1024 * 2;

constexpr int LDP = 40;
constexpr int STAGE_BYTES = 2 * 256 * LDP * 2;
constexpr int LDS_ROWID = 2 * STAGE_BYTES;
constexpr int LDS_ROWW = LDS_ROWID + 1024;
constexpr int XS_PITCH = 1028;
constexpr int LDS_BYTES = 163840;
constexpr int LDS_BAR = 161792;

__device__ __forceinline__ int lane_id_() { int l; asm volatile("v_mbcnt_lo_u32_b32 %0, -1, 0\n\tv_mbcnt_hi_u32_b32 %0, -1, %0" : "=v"(l)); return l; }
__device__ __forceinline__ float shxf(float v, int m, int lane) { return __int_as_float(__builtin_amdgcn_ds_bpermute((lane ^ m) << 2, __float_as_int(v))); }
__device__ __forceinline__ int shxi(int v, int m, int lane) { return __builtin_amdgcn_ds_bpermute((lane ^ m) << 2, v); }
#define XB_TMO      128
#define XB_XCNT(j)  (256  + 64 * (j))
#define XB_XSUB(j)  (1280 + 64 * (j))
#define XB_XGEN(j)  (2304 + 64 * (j))
#define XB_TOP      3328
#define XB_TOPGEN   3392
#define XCD_BAR_WORDS 3456
#define XB_SPIN_CAP (1u << 18)
__device__ __forceinline__ unsigned xb_ld(unsigned* p)              { return __hip_atomic_load(p, __ATOMIC_RELAXED, __HIP_MEMORY_SCOPE_AGENT); }
__device__ __forceinline__ unsigned xb_add(unsigned* p, unsigned v) { return __hip_atomic_fetch_add(p, v, __ATOMIC_RELAXED, __HIP_MEMORY_SCOPE_AGENT); }
__device__ __forceinline__ unsigned xb_xcc_id() { return (unsigned)__builtin_amdgcn_s_getreg((3 << 11) | 20) & 0xFu; }
#define XB_SPIN(cond, bar) do { unsigned _sp = 0; while (cond) { __builtin_amdgcn_s_sleep(1); \
    if ((++_sp & 255u) == 0u) { if (xb_ld(&(bar)[XB_TMO])) break; if (_sp > XB_SPIN_CAP) { atomicAdd(&(bar)[XB_TMO], 1u); break; } } } } while (0)
struct XcdBarrier { unsigned* bar; unsigned x; volatile LAS unsigned* st; };
__device__ __forceinline__ XcdBarrier xcd_barrier_post(unsigned* bar, volatile LAS unsigned* st, const bool leader) {
    XcdBarrier b; b.bar = bar; b.x = xb_xcc_id(); b.st = st;
    if (leader) (void)xb_add(&bar[XB_XCNT(b.x)], 1u);
    return b;
}
__device__ __forceinline__ void xcd_barrier_complete(unsigned* bar, unsigned x, unsigned& nloc, unsigned& nx) {
    const unsigned G = gridDim.x * gridDim.y * gridDim.z;
    unsigned sum, cnt, mine, sp = 0u;
    for (;;) {
        sum = 0u; cnt = 0u; mine = 0u;
#pragma unroll
        for (unsigned j = 0; j < 16; ++j) { const unsigned c = xb_ld(&bar[XB_XCNT(j)]); sum += c; cnt += (c > 0u) ? 1u : 0u; mine = (j == x) ? c : mine; }
        if (sum == G) break;
        __builtin_amdgcn_s_sleep(1);
        if ((++sp & 255u) == 0u) { if (xb_ld(&bar[XB_TMO])) break; if (sp > XB_SPIN_CAP) { atomicAdd(&bar[XB_TMO], 1u); break; } }
    }
    nloc = mine > 0u ? mine : 1u; nx = cnt > 0u ? cnt : 1u;
}
__device__ __forceinline__ void xcd_barrier(const XcdBarrier& b, const bool leader) {
    asm volatile("s_waitcnt vmcnt(0)" ::: "memory");
    __syncthreads();
    if (leader) {
        unsigned* bar = b.bar;
        __builtin_amdgcn_s_waitcnt(0);
        unsigned nloc = b.st[0], nx = b.st[1];
        if (nloc == 0u) { xcd_barrier_complete(bar, b.x, nloc, nx); b.st[0] = nloc; b.st[1] = nx; }
        const unsigned old = xb_add(&bar[XB_XSUB(b.x)], 1u);
        const unsigned gen = old / nloc;
        if (old + 1u == (gen + 1u) * nloc) {
            __builtin_amdgcn_fence(__ATOMIC_RELEASE, "agent");
            asm volatile("s_waitcnt vmcnt(0)" ::: "memory");
            const unsigned og = xb_add(&bar[XB_TOP], 1u);
            const unsigned tg = og / nx;
            if (og + 1u == (tg + 1u) * nx) xb_add(&bar[XB_TOPGEN], 1u);
            else XB_SPIN(xb_ld(&bar[XB_TOPGEN]) == tg, bar);
            __builtin_amdgcn_fence(__ATOMIC_ACQUIRE, "agent");
            xb_add(&bar[XB_XGEN(b.x)], 1u);
            asm volatile("s_waitcnt vmcnt(0)" ::: "memory");
        } else {
            XB_SPIN(xb_ld(&bar[XB_XGEN(b.x)]) == gen, bar);
            __builtin_amdgcn_fence(__ATOMIC_ACQUIRE, "agent");
            asm volatile("s_waitcnt vmcnt(0)" ::: "memory");
        }
    }
    __syncthreads();
}

typedef __attribute__((ext_vector_type(2))) __bf16 bf16x2_t;
typedef __attribute__((ext_vector_type(2))) float f32x2_t;
__device__ __forceinline__ unsigned cvtpk(float lo, float hi) { f32x2_t f; f[0] = lo; f[1] = hi; return __builtin_bit_cast(unsigned, __builtin_convertvector(f, bf16x2_t)); }
__device__ __forceinline__ float bf2f(unsigned v16) { return __uint_as_float(v16 << 16); }
__device__ __forceinline__ int crow(int r, int hi) { return (r & 3) + 8 * (r >> 2) + 4 * hi; }
#define MFMA_BF16(a, b, c) __builtin_amdgcn_mfma_f32_32x32x16_bf16(a, b, c, 0, 0, 0)
__device__ __forceinline__ float wave_sum(float v) {
    v += __int_as_float(__builtin_amdgcn_update_dpp(0, __float_as_int(v), 0xB1, 0xF, 0xF, true));
    v += __int_as_float(__builtin_amdgcn_update_dpp(0, __float_as_int(v), 0x4E, 0xF, 0xF, true));
    v += __int_as_float(__builtin_amdgcn_update_dpp(0, __float_as_int(v), 0x141, 0xF, 0xF, true));
    v += __int_as_float(__builtin_amdgcn_update_dpp(0, __float_as_int(v), 0x140, 0xF, 0xF, true));
    const int vi = __float_as_int(v);
    return (__int_as_float(__builtin_amdgcn_readlane(vi, 0)) + __int_as_float(__builtin_amdgcn_readlane(vi, 16))) + (__int_as_float(__builtin_amdgcn_readlane(vi, 32)) + __int_as_float(__builtin_amdgcn_readlane(vi, 48)));
}

namespace pg8 {
#define PG8_LAS __attribute__((address_space(3)))
typedef unsigned short bf16_t;
typedef short bf16x8 __attribute__((ext_vector_type(8)));
typedef float f32x4 __attribute__((ext_vector_type(4)));
typedef unsigned u32x4 __attribute__((ext_vector_type(4)));
constexpr int BM = 256, BK = 64, HALF = 128, HTB = HALF * BK * 2  , STAGE_BYTES = 8 * HTB, NXCD = 8, WGM = 8;

__host__ __device__ __forceinline__ int lds_byte(int r, int c) { const int st = (r >> 4) * 2 + (c >> 5), rr = r & 15, cc = c & 31, ob = rr * 64 + cc * 2; return st * 1024 + (ob ^ (((ob >> 9) & 1) << 5)); }
__host__ __device__ __forceinline__ void stage_rc(int b, int& R, int& C) { const int st = b / 1024, sb = b % 1024, swz = sb ^ (((sb >> 9) & 1) << 5); R = (st >> 1) * 16 + swz / 64; C = (st & 1) * 32 + (swz % 64) / 2; }
__host__ __device__ __forceinline__ int perm32(int rho) { const int n = rho >> 4, i = rho & 15; return 8 * (i >> 2) + 4 * n + (i & 3); }

struct Unit { int pm, pn; };
struct Gemm { const bf16_t* A; const bf16_t* Bt; int M, N, K; };
struct FixedOrder {
    int pm, pn;
    __device__ __forceinline__ bool next(int i, Unit& u) const { if (i != 0) return false; u.pm = pm; u.pn = pn; return true; }
    __device__ __forceinline__ void a_ready(const Unit&) const {}
    __device__ __forceinline__ void done(const Unit&) const {}
};

struct StaticOrder {
    int nM, nN, nwg, G, c;
    __host__ __device__ void init(int M, int N, int G_, int c_) { nM = M / BM; nN = N / BM; nwg = nM * nN; G = G_; c = c_; }
    __host__ __device__ bool next(int i, Unit& u) const {
        const long L = (long)i * G + c; if (L >= nwg) return false;
        int wgid = (int)L; { const int q = nwg / NXCD, r = nwg % NXCD, xcd = wgid % NXCD, off = wgid / NXCD; wgid = (xcd < r ? xcd * (q + 1) : r * (q + 1) + (xcd - r) * q) + off; }
        const int nig = WGM * nN, gid = wgid / nig, fm = gid * WGM, gsz = (nM - fm) < WGM ? (nM - fm) : WGM;
        u.pm = fm + ((wgid % nig) % gsz); u.pn = (wgid % nig) / gsz; return true;
    }
    __device__ __forceinline__ void a_ready(const Unit&) const {}
    __device__ __forceinline__ void done(const Unit&) const {}
};

template <class Epi, class Sched, bool SWAP = false, bool STAMP = false>
__device__ __forceinline__ void gemm_phase(PG8_LAS unsigned char* lds, const Gemm g, const Sched& S, const Epi& E, unsigned long long* stamps, const int tid_in) {
    int tid_ = tid_in; asm volatile("" : "+v"(tid_));
    const int tid = tid_, wid = __builtin_amdgcn_readfirstlane(tid >> 6), lane = tid & 63, wr = wid >> 2, wc = wid & 3, fr = lane & 15, fq = lane >> 4;
    const int K = g.K, nt = K / BK;
    int ts_lo = 0, ts_hi = 0, nts = 0; const unsigned long long rt_entry = STAMP ? (unsigned long long)wall_clock64() : 0ull;
#define PG8_STAMP() do { if (STAMP && wid == 0 && nts < 64) { const unsigned long long _c = (unsigned long long)clock64(); \
        ts_lo = (lane == nts) ? (int)(unsigned)_c : ts_lo; ts_hi = (lane == nts) ? (int)(unsigned)(_c >> 32) : ts_hi; ++nts; } } while (0)
    PG8_STAMP();
    unsigned voffA[2], voffB[2];
#pragma unroll
    for (int i = 0; i < 2; ++i) { int R, C; stage_rc(tid * 16 + i * 8192, R, C); const int Rb = Epi::PERM ? ((R & ~31) + perm32(R & 31)) : R;
        voffA[i] = (unsigned)(R * K + C) * 2u; voffB[i] = (unsigned)(Rb * K + C) * 2u; }
    const size_t kstep = (size_t)(BK * 2);
    const size_t hstep = (size_t)HALF * K * 2;
    const size_t tstep = 2 * hstep;
    const unsigned ldsw = (unsigned)wid * 1024u;
    const int aoff = lds_byte(wr * 64 + fr, fq * 8), boff = lds_byte(wc * 32 + fr, fq * 8);
#define PG8_SA(b, h) (((b) * 2 + (h)) * HTB)
#define PG8_SB(b, h) ((4 + (b) * 2 + (h)) * HTB)
#define PG8_STAGE(bufoff, gbase, voff) do { _Pragma("unroll") for (int _i = 0; _i < 2; ++_i) \
        __builtin_amdgcn_global_load_lds((const unsigned*)((const char*)(gbase) + (voff)[_i]), (PG8_LAS unsigned*)(lds + (bufoff) + ldsw + _i * 8192), 16, 0, 0); } while (0)
#define PG8_LDA(dst, b, h) do { _Pragma("unroll") for (int m = 0; m < 4; ++m) _Pragma("unroll") for (int k = 0; k < 2; ++k) dst[m][k] = *(const PG8_LAS bf16x8*)(lds + PG8_SA(b, h) + aoff + m * 2048 + k * 1024); } while (0)
#define PG8_LDB(dst, b, h) do { _Pragma("unroll") for (int n = 0; n < 2; ++n) _Pragma("unroll") for (int k = 0; k < 2; ++k) dst[n][k] = *(const PG8_LAS bf16x8*)(lds + PG8_SB(b, h) + boff + n * 2048 + k * 1024); } while (0)
#define PG8_MMA(ai, bj, At, Bt) do { __builtin_amdgcn_s_setprio(1); _Pragma("unroll") for (int m = 0; m < 4; ++m) _Pragma("unroll") for (int n = 0; n < 2; ++n) _Pragma("unroll") for (int k = 0; k < 2; ++k) \
        acc[ai][bj][m][n] = SWAP ? __builtin_amdgcn_mfma_f32_16x16x32_bf16(At[m][k], Bt[n][k], acc[ai][bj][m][n], 0, 0, 0) : __builtin_amdgcn_mfma_f32_16x16x32_bf16(Bt[n][k], At[m][k], acc[ai][bj][m][n], 0, 0, 0); __builtin_amdgcn_s_setprio(0); } while (0)
#define PG8_WAIT_V(n) asm volatile("s_waitcnt vmcnt(" #n ")" ::: "memory")
#define PG8_WAIT_L(n) asm volatile("s_waitcnt lgkmcnt(" #n ")" ::: "memory")
#define PG8_BAR __builtin_amdgcn_s_barrier()
#define PG8_SCHED __builtin_amdgcn_sched_barrier(0)
    Unit cur, nxt; int ui = 0;
    if (!S.next(0, cur)) return;
    f32x4 acc[2][2][4][2];
#pragma unroll
    for (int a = 0; a < 2; ++a)
#pragma unroll
        for (int b = 0; b < 2; ++b)
#pragma unroll
            for (int m = 0; m < 4; ++m)
#pragma unroll
                for (int n = 0; n < 2; ++n) acc[a][b][m][n] = (f32x4){0.f, 0.f, 0.f, 0.f};
    bf16x8 At[4][2], B0[2][2], B1[2][2];
    const char* cA = (const char*)g.A + (size_t)cur.pm * tstep; const char* cB = (const char*)g.Bt + (size_t)cur.pn * tstep;
    S.a_ready(cur);
    PG8_STAGE(PG8_SB(0, 0), cB, voffB); PG8_STAGE(PG8_SA(0, 0), cA, voffA); PG8_STAGE(PG8_SB(0, 1), cB + hstep, voffB); PG8_STAGE(PG8_SA(0, 1), cA + hstep, voffA);
    if (wr == 1) PG8_BAR;
    PG8_WAIT_V(4); PG8_BAR;
    PG8_STAGE(PG8_SB(1, 0), cB + kstep, voffB); PG8_STAGE(PG8_SA(1, 0), cA + kstep, voffA); PG8_STAGE(PG8_SB(1, 1), cB + hstep + kstep, voffB);
    PG8_WAIT_V(6); PG8_BAR;
    PG8_STAMP();
    for (;;) {
        const bool has_next = S.next(ui + 1, nxt);
        const char* nA = has_next ? (const char*)g.A + (size_t)nxt.pm * tstep : cA; const char* nB = has_next ? (const char*)g.Bt + (size_t)nxt.pn * tstep : cB;
        for (int t = 0; t < nt; t += 2) {
            const bool last = (t == nt - 2);
            const char* a1 = cA + (size_t)(t + 1) * kstep;
            const char* a2 = last ? nA : cA + (size_t)(t + 2) * kstep; const char* b2 = last ? nB : cB + (size_t)(t + 2) * kstep;
            const char* a3 = a2 + kstep; const char* b3 = b2 + kstep;
            if (last && has_next) S.a_ready(nxt);
            PG8_LDB(B0, 0, 0); PG8_SCHED; PG8_LDA(At, 0, 0); PG8_STAGE(PG8_SA(1, 1), a1 + hstep, voffA);
            PG8_WAIT_L(8); PG8_BAR; PG8_WAIT_L(0); PG8_MMA(0, 0, At, B0); PG8_BAR; PG8_SCHED;
            PG8_LDB(B1, 0, 1); PG8_STAGE(PG8_SB(0, 0), b2, voffB);
            PG8_BAR; PG8_WAIT_L(0); PG8_MMA(0, 1, At, B1); PG8_BAR;
            PG8_LDA(At, 0, 1); PG8_STAGE(PG8_SA(0, 0), a2, voffA);
            PG8_BAR; PG8_WAIT_L(0); PG8_MMA(1, 0, At, B0); PG8_BAR; PG8_SCHED;
            PG8_STAGE(PG8_SB(0, 1), b2 + hstep, voffB);
            PG8_WAIT_V(6); PG8_BAR; PG8_MMA(1, 1, At, B1); PG8_BAR;
            PG8_LDB(B0, 1, 0); PG8_SCHED; PG8_LDA(At, 1, 0); PG8_STAGE(PG8_SA(0, 1), a2 + hstep, voffA);
            PG8_WAIT_L(8); PG8_BAR; PG8_WAIT_L(0); PG8_MMA(0, 0, At, B0); PG8_BAR; PG8_SCHED;
            PG8_LDB(B1, 1, 1); PG8_STAGE(PG8_SB(1, 0), b3, voffB);
            PG8_BAR; PG8_WAIT_L(0); PG8_MMA(0, 1, At, B1); PG8_BAR;
            PG8_LDA(At, 1, 1); PG8_STAGE(PG8_SA(1, 0), a3, voffA);
            PG8_BAR; PG8_WAIT_L(0); PG8_MMA(1, 0, At, B0); PG8_BAR; PG8_SCHED;
            PG8_STAGE(PG8_SB(1, 1), b3 + hstep, voffB);
            PG8_WAIT_V(6); PG8_BAR; PG8_MMA(1, 1, At, B1); PG8_BAR;
        }
        PG8_STAMP();
        if constexpr (!Epi::AFTER_DRAIN) { E(acc, cur, wr, wc, fr, fq); S.done(cur); }
        PG8_STAMP();
        if (!has_next) break;
#pragma unroll
        for (int a = 0; a < 2; ++a)
#pragma unroll
            for (int b = 0; b < 2; ++b)
#pragma unroll
                for (int m = 0; m < 4; ++m)
#pragma unroll
                    for (int n = 0; n < 2; ++n) acc[a][b][m][n] = (f32x4){0.f, 0.f, 0.f, 0.f};
        cur = nxt; cA = nA; cB = nB; ++ui;
    }
    PG8_WAIT_V(0);
    if (wr == 0) PG8_BAR;
    PG8_BAR;
    if constexpr (Epi::AFTER_DRAIN) { E.fused(acc, cur, wr, wc, fr, fq, lds, wid, lane); S.done(cur); }
    PG8_STAMP();
    if (STAMP && wid == 0) { stamps[lane] = lane < nts ? (((unsigned long long)(unsigned)ts_hi << 32) | (unsigned)ts_lo) : 0ull;
        if (lane == 62) stamps[62] = rt_entry; if (lane == 63) stamps[63] = (unsigned long long)wall_clock64(); }
#undef PG8_STAMP
#undef PG8_SA
#undef PG8_SB
#undef PG8_STAGE
#undef PG8_LDA
#undef PG8_LDB
#undef PG8_MMA
#undef PG8_WAIT_V
#undef PG8_WAIT_L
#undef PG8_BAR
#undef PG8_SCHED
}
}

struct EpiQK {
    static constexpr bool PERM = true, AFTER_DRAIN = false;
    u16* O; int ldc;
    __device__ __forceinline__ void operator()(const pg8::f32x4 (&acc)[2][2][4][2], const pg8::Unit& u, int wr, int wc, int fr, int fq) const {
        const int col0 = u.pn * 256 + wc * 32 + 8 * fq, row0 = u.pm * 256 + wr * 64 + fr;
#pragma unroll
        for (int ai = 0; ai < 2; ++ai)
#pragma unroll
            for (int m = 0; m < 4; ++m) { u16* rowp = O + (size_t)(row0 + ai * 128 + m * 16) * ldc + col0;
#pragma unroll
                for (int bj = 0; bj < 2; ++bj) { const pg8::f32x4 v0 = acc[ai][bj][m][0], v1 = acc[ai][bj][m][1];
                    u32x4 w; w[0] = cvtpk(v0[0], v0[1]); w[1] = cvtpk(v0[2], v0[3]); w[2] = cvtpk(v1[0], v1[1]); w[3] = cvtpk(v1[2], v1[3]);
                    *(u32x4*)(rowp + bj * 128) = w; } }
    }
};
struct EpiV {
    static constexpr bool PERM = false, AFTER_DRAIN = false;
    u16* VT; int layer;
    __device__ __forceinline__ void operator()(const pg8::f32x4 (&acc)[2][2][4][2], const pg8::Unit& u, int wr, int wc, int fr, int fq) const {
        const int colt = u.pn * 256, grp = colt >> 10;
        const int dil = (layer == 0 || grp == 0) ? 1 : (grp == 1 ? 4 : 16);
        const int rowb = u.pm * 256 + wr * 64 + 4 * fq;
#pragma unroll
        for (int bj = 0; bj < 2; ++bj)
#pragma unroll
            for (int n = 0; n < 2; ++n) {
                const int c = (colt & 1023) + bj * 128 + wc * 32 + n * 16 + fr, h = c >> 6, d = c & 63;
#pragma unroll
                for (int ai = 0; ai < 2; ++ai)
#pragma unroll
                    for (int m = 0; m < 4; ++m) {
                        const int r0 = rowb + ai * 128 + m * 16, b = r0 >> 13, t0 = r0 & (SEQ - 1);
                        u16* vrow = VT + (size_t)grp * T * D + ((size_t)(b * NH + h) * HD + d) * SEQ;
                        const pg8::f32x4 v = acc[ai][bj][m][n];
                        if (dil == 1) { u32x2 w; w[0] = cvtpk(v[0], v[1]); w[1] = cvtpk(v[2], v[3]); *(u32x2*)(vrow + t0) = w; }
                        else {
#pragma unroll
                            for (int i = 0; i < 4; ++i) { const int pp = t0 + i; vrow[(pp % dil) * (SEQ / dil) + pp / dil] = (u16)cvtpk(v[i], 0.f); }
                        }
                    }
            }
    }
};
struct EpiWo {
    static constexpr bool PERM = false, AFTER_DRAIN = false;
    float* Y; const float* X;
    __device__ __forceinline__ void operator()(const pg8::f32x4 (&acc)[2][2][4][2], const pg8::Unit& u, int wr, int wc, int fr, int fq) const {
        const int row0 = u.pm * 256 + wr * 64 + fr, col0 = u.pn * 256 + wc * 32 + 4 * fq;
#pragma unroll
        for (int ai = 0; ai < 2; ++ai)
#pragma unroll
            for (int m = 0; m < 4; ++m) { const size_t ro = (size_t)(row0 + ai * 128 + m * 16) * D + col0;
#pragma unroll
                for (int bj = 0; bj < 2; ++bj)
#pragma unroll
                    for (int n = 0; n < 2; ++n) { const pg8::f32x4 x = *(const pg8::f32x4*)(X + ro + bj * 128 + n * 16); *(pg8::f32x4*)(Y + ro + bj * 128 + n * 16) = x * DN_ALPHA + acc[ai][bj][m][n]; } }
    }
};
struct EpiSGU {
    static constexpr bool PERM = true, AFTER_DRAIN = false;
    u16* H;
    __device__ __forceinline__ void operator()(const pg8::f32x4 (&acc)[2][2][4][2], const pg8::Unit& u, int wr, int wc, int fr, int fq) const {
        const int row0 = u.pm * 256 + wr * 64 + fr, f0 = u.pn * 128 + wc * 32 + 8 * fq;
#pragma unroll
        for (int ai = 0; ai < 2; ++ai)
#pragma unroll
            for (int m = 0; m < 4; ++m) {
                float hv[8];
#pragma unroll
                for (int n = 0; n < 2; ++n)
#pragma unroll
                    for (int i = 0; i < 4; ++i) { const float gt = acc[ai][0][m][n][i], up = acc[ai][1][m][n][i]; hv[n * 4 + i] = gt / (1.f + __expf(-gt)) * up; }
                u32x4 w; w[0] = cvtpk(hv[0], hv[1]); w[1] = cvtpk(hv[2], hv[3]); w[2] = cvtpk(hv[4], hv[5]); w[3] = cvtpk(hv[6], hv[7]);
                *(u32x4*)(H + (size_t)(row0 + ai * 128 + m * 16) * DF + f0) = w;
            }
    }
};
struct EpiSD {
    static constexpr bool PERM = true, AFTER_DRAIN = false;
    u16* Y;
    __device__ __forceinline__ void operator()(const pg8::f32x4 (&acc)[2][2][4][2], const pg8::Unit& u, int wr, int wc, int fr, int fq) const {
        const int row0 = u.pm * 256 + wr * 64 + fr, col0 = u.pn * 256 + wc * 32 + 8 * fq;
#pragma unroll
        for (int ai = 0; ai < 2; ++ai)
#pragma unroll
            for (int m = 0; m < 4; ++m) { u16* rowp = Y + (size_t)(A_TOT + row0 + ai * 128 + m * 16) * D + col0;
#pragma unroll
                for (int bj = 0; bj < 2; ++bj) { const pg8::f32x4 v0 = acc[ai][bj][m][0], v1 = acc[ai][bj][m][1];
                    u32x4 w; w[0] = cvtpk(v0[0], v0[1]); w[1] = cvtpk(v0[2], v0[3]); w[2] = cvtpk(v1[0], v1[1]); w[3] = cvtpk(v1[2], v1[3]);
                    *(u32x4*)(rowp + bj * 128) = w; } }
    }
};

struct Args {
    const float* in[16];
    float* out;
    unsigned char* ws;
    int ph_lo, ph_hi;
};

#define GEMM_CORE(K_, PA0, PA1, PB, LDB)                                                                                                   \
    {                                                                                                                                      \
        const int g_tid = tid, g_lane = lane, g_wave = wave, g_r32 = r32, g_hi = hi;                   \
        const int g_wm = g_wave >> 2, g_wn = g_wave & 3, g_kc = g_tid & 3, g_kq = g_lane >> 3, g_n4 = g_lane & 7;                           \
        const u16* g_pa0 = (PA0); const u16* g_pa1 = (PA1);                                                                                \
        const size_t g_ldb = (size_t)(LDB);                                                                                                \
        const float* g_pb = (PB) + (size_t)(g_kq * 4) * g_ldb + g_n4 * 4;                                                                  \
        const int g_nk = (K_) / 32;                                                                                                        \
        u32x4 g_ra0, g_ra1; f32x4 g_rb0, g_rb1, g_rb2, g_rb3;                                                                              \
        const u32x4 g_z = {0u, 0u, 0u, 0u};                                                                                                \
        _Pragma("unroll") for (int mb = 0; mb < 4; ++mb) { _Pragma("unroll") for (int nb = 0; nb < 2; ++nb) { _Pragma("unroll") for (int r = 0; r < 16; ++r) acc[mb][nb][r] = 0.f; } } \
        g_ra0 = g_pa0 ? *(const u32x4*)(g_pa0 + g_kc * 8) : g_z; g_ra1 = g_pa1 ? *(const u32x4*)(g_pa1 + g_kc * 8) : g_z;                 \
        g_rb0 = *(const f32x4*)(g_pb); g_rb1 = *(const f32x4*)(g_pb + g_ldb); g_rb2 = *(const f32x4*)(g_pb + 2 * g_ldb); g_rb3 = *(const f32x4*)(g_pb + 3 * g_ldb); \
        _Pragma("unroll 1") for (int kt = 0; kt < g_nk; ++kt) {                                                                            \
            LAS char* As = lds + (kt & 1) * STAGE_BYTES; LAS char* Bs = As + 256 * LDP * 2;                                                \
            *(LAS u32x4*)(As + ((g_tid >> 2) * LDP + g_kc * 8) * 2) = g_ra0;                                                               \
            *(LAS u32x4*)(As + (((g_tid >> 2) + 128) * LDP + g_kc * 8) * 2) = g_ra1;                                                       \
            _Pragma("unroll") for (int i = 0; i < 4; ++i) {                                                                                \
                u32x2 w; w[0] = cvtpk(g_rb0[i], g_rb1[i]); w[1] = cvtpk(g_rb2[i], g_rb3[i]);                                               \
                *(LAS u32x2*)(Bs + ((g_wave * 32 + i * 8 + g_n4) * LDP + g_kq * 4) * 2) = w;                                               \
            }                                                                                                                              \
            __syncthreads();                                                                                                               \
            if (kt + 1 < g_nk) {                                                                                                           \
                const int ko = (kt + 1) * 32;                                                                                              \
                g_ra0 = g_pa0 ? *(const u32x4*)(g_pa0 + ko + g_kc * 8) : g_z; g_ra1 = g_pa1 ? *(const u32x4*)(g_pa1 + ko + g_kc * 8) : g_z; \
                const float* pbk = g_pb + (size_t)ko * g_ldb;                                                                              \
                g_rb0 = *(const f32x4*)(pbk); g_rb1 = *(const f32x4*)(pbk + g_ldb); g_rb2 = *(const f32x4*)(pbk + 2 * g_ldb); g_rb3 = *(const f32x4*)(pbk + 3 * g_ldb); \
            }                                                                                                                              \
            _Pragma("unroll") for (int s = 0; s < 2; ++s) {                                                                                \
                bf16x8 af[4], bfr[2];                                                                                                      \
                _Pragma("unroll") for (int mb = 0; mb < 4; ++mb) af[mb] = *(LAS bf16x8*)(As + ((g_wm * 128 + mb * 32 + g_r32) * LDP + s * 16 + g_hi * 8) * 2); \
                _Pragma("unroll") for (int nb = 0; nb < 2; ++nb) bfr[nb] = *(LAS bf16x8*)(Bs + (((g_wn * 2 + nb) * 32 + g_r32) * LDP + s * 16 + g_hi * 8) * 2); \
                _Pragma("unroll") for (int mb = 0; mb < 4; ++mb) { _Pragma("unroll") for (int nb = 0; nb < 2; ++nb) acc[mb][nb] = MFMA_BF16(af[mb], bfr[nb], acc[mb][nb]); } \
            }                                                                                                                              \
        }                                                                                                                                  \
        __syncthreads();                                                                                                                   \
    }

struct AttnSt { float m, l; f32x16 o0, o1; };

struct AttnFr { bf16x8 k[4]; bf16x8 v[4]; };
__device__ __forceinline__ void attn_load(AttnFr& f, const u16* krow, const u16* vt, size_t vt_dstride) {
#pragma unroll
    for (int d0 = 0; d0 < 4; ++d0) f.k[d0] = *(const bf16x8*)(krow + d0 * 16);
    const u16* vt1 = vt + 32 * vt_dstride;
    union { bf16x8 v; u32x2 h[2]; } va;
    va.h[0] = *(const u32x2*)(vt);       va.h[1] = *(const u32x2*)(vt + 8);   f.v[0] = va.v;
    va.h[0] = *(const u32x2*)(vt + 16);  va.h[1] = *(const u32x2*)(vt + 24);  f.v[1] = va.v;
    va.h[0] = *(const u32x2*)(vt1);      va.h[1] = *(const u32x2*)(vt1 + 8);  f.v[2] = va.v;
    va.h[0] = *(const u32x2*)(vt1 + 16); va.h[1] = *(const u32x2*)(vt1 + 24); f.v[3] = va.v;
}
__device__ __forceinline__ void attn_compute(AttnSt& st, const bf16x8 (&qf)[4], const AttnFr& f, int dist0, float bslope, int dlo, int dhi, int hi, int lane) {
    f32x16 p;
#pragma unroll
    for (int r = 0; r < 16; ++r) p[r] = 0.f;
#pragma unroll
    for (int d0 = 0; d0 < 4; ++d0) p = MFMA_BF16(f.k[d0], qf[d0], p);
    constexpr float C2 = 0.125f * LOG2E;
    float mx = NEGV;
#pragma unroll
    for (int r = 0; r < 16; ++r) {
        const int dist = dist0 - ((r & 3) + 8 * (r >> 2));
        const float sc = __builtin_fmaf(p[r], C2, -bslope * (float)dist);
        const float s_ = (dist >= dlo && dist <= dhi) ? sc : NEGV;
        p[r] = s_; mx = fmaxf(mx, s_);
    }
    mx = fmaxf(mx, shxf(mx, 32, lane));
    const float mnew = fmaxf(st.m, mx);
    const float alpha = __builtin_amdgcn_exp2f(st.m - mnew);
    st.m = mnew;
    float ls = 0.f;
#pragma unroll
    for (int r = 0; r < 16; ++r) { p[r] = __builtin_amdgcn_exp2f(p[r] - mnew); ls += p[r]; }
    st.l = st.l * alpha + ls;
#pragma unroll
    for (int r = 0; r < 16; ++r) { st.o0[r] *= alpha; st.o1[r] *= alpha; }
    union { bf16x8 v; unsigned u[4]; } pb0, pb1;
#pragma unroll
    for (int j = 0; j < 4; ++j) { pb0.u[j] = cvtpk(p[2 * j], p[2 * j + 1]); pb1.u[j] = cvtpk(p[8 + 2 * j], p[8 + 2 * j + 1]); }
    st.o0 = MFMA_BF16(f.v[0], pb0.v, st.o0);
    st.o0 = MFMA_BF16(f.v[1], pb1.v, st.o0);
    st.o1 = MFMA_BF16(f.v[2], pb0.v, st.o1);
    st.o1 = MFMA_BF16(f.v[3], pb1.v, st.o1);
    (void)hi;
}

__device__ __forceinline__ float dpp_rowmax(float v) {
    v = fmaxf(v, __int_as_float(__builtin_amdgcn_update_dpp(0, __float_as_int(v), 0xB1, 0xF, 0xF, true)));
    v = fmaxf(v, __int_as_float(__builtin_amdgcn_update_dpp(0, __float_as_int(v), 0x4E, 0xF, 0xF, true)));
    v = fmaxf(v, __int_as_float(__builtin_amdgcn_update_dpp(0, __float_as_int(v), 0x141, 0xF, 0xF, true)));
    v = fmaxf(v, __int_as_float(__builtin_amdgcn_update_dpp(0, __float_as_int(v), 0x140, 0xF, 0xF, true)));
    return v;
}
__device__ __forceinline__ int dpp_rowmin_i(int v) {
    v = min(v, __builtin_amdgcn_update_dpp(0, v, 0xB1, 0xF, 0xF, true));
    v = min(v, __builtin_amdgcn_update_dpp(0, v, 0x4E, 0xF, 0xF, true));
    v = min(v, __builtin_amdgcn_update_dpp(0, v, 0x141, 0xF, 0xF, true));
    v = min(v, __builtin_amdgcn_update_dpp(0, v, 0x140, 0xF, 0xF, true));
    return v;
}
__device__ __forceinline__ float rl_f(float v, int l) { return __int_as_float(__builtin_amdgcn_readlane(__float_as_int(v), l)); }

__device__ __forceinline__ void top3_insert(float v, int i, float& v0, int& i0, float& v1, int& i1, float& v2, int& i2) {
    const bool b0 = (v > v0) || (v == v0 && i < i0);
    const bool b1 = (v > v1) || (v == v1 && i < i1);
    const bool b2 = (v > v2) || (v == v2 && i < i2);
    const float nv2 = b1 ? v1 : (b2 ? v : v2); const int ni2 = b1 ? i1 : (b2 ? i : i2);
    const float nv1 = b0 ? v0 : (b1 ? v : v1); const int ni1 = b0 ? i0 : (b1 ? i : i1);
    const float nv0 = b0 ? v : v0;             const int ni0 = b0 ? i : i0;
    v0 = nv0; i0 = ni0; v1 = nv1; i1 = ni1; v2 = nv2; i2 = ni2;
}

__device__ __forceinline__ void ln_row(float (&v)[16], const float* __restrict__ g, const float* __restrict__ b, int lane) {
    float s = 0.f;
#pragma unroll
    for (int i = 0; i < 16; ++i) s += v[i];
    const float mu = wave_sum(s) * (1.f / D);
    float q = 0.f;
#pragma unroll
    for (int i = 0; i < 16; ++i) { const float d = v[i] - mu; q += d * d; }
    const float rstd = rsqrtf(wave_sum(q) * (1.f / D) + LN_EPS);
#pragma unroll
    for (int j = 0; j < 4; ++j) {
        const f32x4 gg = *(const f32x4*)(g + j * 256 + lane * 4), bb = *(const f32x4*)(b + j * 256 + lane * 4);
#pragma unroll
        for (int c = 0; c < 4; ++c) v[j * 4 + c] = (v[j * 4 + c] - mu) * rstd * gg[c] + bb[c];
    }
}

typedef __attribute__((ext_vector_type(2))) float f32x2_;
__device__ __forceinline__ bf16x8 fp8x8_to_bf16(unsigned lo, unsigned hi_) {
    const f32x2_ a = __builtin_amdgcn_cvt_pk_f32_fp8((int)lo, false), b = __builtin_amdgcn_cvt_pk_f32_fp8((int)lo, true);
    const f32x2_ c = __builtin_amdgcn_cvt_pk_f32_fp8((int)hi_, false), d = __builtin_amdgcn_cvt_pk_f32_fp8((int)hi_, true);
    union { bf16x8 v; unsigned u[4]; } r;
    r.u[0] = cvtpk(a[0], a[1]); r.u[1] = cvtpk(b[0], b[1]); r.u[2] = cvtpk(c[0], c[1]); r.u[3] = cvtpk(d[0], d[1]);
    return r.v;
}
__device__ __forceinline__ unsigned pack_fp8x4(float a, float b, float c, float d) { int p = __builtin_amdgcn_cvt_pk_fp8_f32(a, b, 0, false); return (unsigned)__builtin_amdgcn_cvt_pk_fp8_f32(c, d, p, true); }

constexpr int MOE_BP = 72;
constexpr int MOE_BSTAGE = 128 * MOE_BP * 2;
constexpr int MOE_LDS_VA = 3 * MOE_BSTAGE;
constexpr int MOE_LDS_W = MOE_LDS_VA + 4096;
template <bool DOWN>
__device__ __forceinline__ void moe_expert(LAS char* lds, const int tid, const int lane, const int wave, const int r32, const int hi,
                                           const unsigned char* __restrict__ abase  , const float* __restrict__ w0, const float* __restrict__ w1, const int ng  , void* __restrict__ outv,
                                           const int pass0, const int npass_, const int st0, const int nstl  ) {
    constexpr int KT = DOWN ? 4 : 16, NP = DOWN ? 8 : 4, LDB = DOWN ? 1024 : 256, APITCH = DOWN ? 256 : 1024  , PSTEP = DOWN ? 128 : 64;
    LAS int* rowva = (LAS int*)(lds + MOE_LDS_VA); LAS float* roww = (LAS float*)(lds + MOE_LDS_W);
    const int nst = nstl;
    const int nsteps = npass_ * nst * KT; (void)NP;
    unsigned aoff[2];
#define MOE_AOFF(ST_) { _Pragma("unroll") for (int a = 0; a < 2; ++a) { const int va_ = rowva[(ST_) * 512 + wave * 64 + a * 32 + r32]; \
        const int srow_ = DOWN ? va_ : (va_ == TRASH_VA ? 0 : (va_ >> 3)); aoff[a] = (unsigned)srow_ * APITCH + hi * 32; } }
    const int seg = wave >> 1, n4 = lane & 7, kp = (wave & 1) * 16 + (lane >> 3);
    const char* wbase = (const char*)(DOWN ? (w0 + seg * 32) : (((seg < 2) ? w0 : w1) + (seg & 1) * 32));
    const unsigned boff = (unsigned)(4 * n4 + 2 * kp * LDB) * 4u;
    f32x16 acc[2][4];
#pragma unroll
    for (int a = 0; a < 2; ++a)
#pragma unroll
        for (int c = 0; c < 4; ++c)
#pragma unroll
            for (int r = 0; r < 16; ++r) acc[a][c][r] = 0.f;
    u32x4 fa8[2][2];
    f32x4 rb0[4], rb1[4];
#define MOE_DEC(S_) const int s2_ = (S_) < nsteps ? (S_) : 0; const int pl_ = s2_ / (nst * KT); const int rm_ = s2_ - pl_ * (nst * KT); const int sl_ = rm_ / KT; const int kt_ = rm_ - sl_ * KT; const int ps_ = pass0 + pl_; const int stt_ = st0 + sl_;
#define MOE_LOADB(S_, RB) { MOE_DEC(S_) (void)stt_; \
        const char* wp_ = wbase + (size_t)(ps_ * PSTEP + kt_ * 64 * LDB) * 4 + boff; \
        RB[0] = *(const f32x4*)(wp_); RB[1] = *(const f32x4*)(wp_ + LDB * 4); RB[2] = *(const f32x4*)(wp_ + 16 * LDB * 4); RB[3] = *(const f32x4*)(wp_ + 17 * LDB * 4); }
#define MOE_WRITEB(STG, RB) { LAS char* Bs_ = lds + (STG) * MOE_BSTAGE; \
        _Pragma("unroll") for (int i = 0; i < 4; ++i) { LAS unsigned* q_ = (LAS unsigned*)(Bs_ + ((seg * 32 + i * 8 + n4) * MOE_BP + 2 * kp) * 2); q_[0] = cvtpk(RB[0][i], RB[1][i]); q_[8] = cvtpk(RB[2][i], RB[3][i]); } }
#define MOE_COMPUTE(STG, DO_MFMA) { LAS char* Bs_ = lds + (STG) * MOE_BSTAGE; \
        _Pragma("unroll") for (int u = 0; u < 4; ++u) { \
            bf16x8 bfr[4]; \
            if (DO_MFMA) { _Pragma("unroll") for (int c = 0; c < 4; ++c) bfr[c] = *(LAS bf16x8*)(Bs_ + ((c * 32 + r32) * MOE_BP + hi * 32 + u * 8) * 2); } \
            _Pragma("unroll") for (int a = 0; a < 2; ++a) { \
                if (DO_MFMA) { const bf16x8 af_ = fp8x8_to_bf16(fa8[a][u >> 1][(u & 1) * 2], fa8[a][u >> 1][(u & 1) * 2 + 1]); \
                    _Pragma("unroll") for (int c = 0; c < 4; ++c) acc[a][c] = MFMA_BF16(bfr[c], af_, acc[a][c]); } \
                if (u & 1) fa8[a][u >> 1] = *(const u32x4*)(ab_n + aoff[a] + (u >> 1) * 16); \
            } \
        } }
#define MOE_NEXTA(S_) MOE_DEC(S_) (void)ps_; \
        if (stt_ != st_loaded) { MOE_AOFF(stt_) st_loaded = stt_; } \
        const char* ab_n = (const char*)abase + kt_ * 64;
    int st_loaded = st0;
    MOE_AOFF(st0)
    { const char* ab0 = (const char*)abase;
#pragma unroll
      for (int a = 0; a < 2; ++a)
#pragma unroll
          for (int h2 = 0; h2 < 2; ++h2) fa8[a][h2] = *(const u32x4*)(ab0 + aoff[a] + h2 * 16); }
    MOE_LOADB(0, rb0)
    MOE_LOADB(1, rb1)
    MOE_WRITEB(0, rb0)
    MOE_LOADB(2, rb0)
    int stg = 0;
#pragma unroll 1
    for (int sidx = 0; sidx < nsteps; sidx += 2) {
        const int pl = sidx / (nst * KT); const int rm = sidx - pl * (nst * KT); const int sl = rm / KT; const int kt = rm - sl * KT; const int ps = pass0 + pl, stt = st0 + sl;
        const bool wv = (wave * 64) < (ng - stt * 512);
        const int stg1 = stg == 2 ? 0 : stg + 1, stg2 = stg1 == 2 ? 0 : stg1 + 1;
        __syncthreads();
        MOE_WRITEB(stg1, rb1)
        MOE_LOADB(sidx + 3, rb1)
        { MOE_NEXTA(sidx + 1)
          if (wv) MOE_COMPUTE(stg, true) else MOE_COMPUTE(stg, false) }
        __syncthreads();
        MOE_WRITEB(stg2, rb0)
        MOE_LOADB(sidx + 4, rb0)
        { MOE_NEXTA(sidx + 2)
          if (wv) MOE_COMPUTE(stg1, true) else MOE_COMPUTE(stg1, false) }
        stg = stg2;
        if (kt == KT - 2) {
            if (wv) {
                const int nrows = ng - stt * 512;
#pragma unroll
                for (int a = 0; a < 2; ++a) {
                    if (a == 0 || (wave * 64 + 32) < nrows) {
                        const int lrow = stt * 512 + wave * 64 + a * 32 + r32;
                        const unsigned va = (unsigned)rowva[lrow];
                        if (DOWN) {
                            const float w = roww[lrow];
#pragma unroll
                            for (int c = 0; c < 4; ++c) {
                                u32x4 q0, q1;
#pragma unroll
                                for (int jj = 0; jj < 4; ++jj) {
                                    const int j0 = 2 * jj, j1 = 2 * jj + 1, j2 = 8 + 2 * jj, j3 = 9 + 2 * jj;
                                    q0[jj] = cvtpk(acc[a][c][(j0 >> 2) + 4 * (j0 & 3)] * w, acc[a][c][(j1 >> 2) + 4 * (j1 & 3)] * w);
                                    q1[jj] = cvtpk(acc[a][c][(j2 >> 2) + 4 * (j2 & 3)] * w, acc[a][c][(j3 >> 2) + 4 * (j3 & 3)] * w);
                                }
                                u16* o = (u16*)outv + (size_t)va * D + ps * 128 + c * 32 + 16 * hi;
                                *(u32x4*)o = q0; *(u32x4*)(o + 8) = q1;
                            }
                        } else {
#pragma unroll
                            for (int c = 0; c < 2; ++c) {
                                float hv[16];
#pragma unroll
                                for (int j = 0; j < 16; ++j) { const int r = (j >> 2) + 4 * (j & 3); const float gt = acc[a][c][r], up = acc[a][c + 2][r]; hv[j] = gt / (1.f + __expf(-gt)) * up; }
                                u32x4 q;
#pragma unroll
                                for (int jj = 0; jj < 4; ++jj) q[jj] = pack_fp8x4(hv[4 * jj], hv[4 * jj + 1], hv[4 * jj + 2], hv[4 * jj + 3]);
                                *(u32x4*)((unsigned char*)outv + (size_t)va * DF + ps * 64 + c * 32 + 16 * hi) = q;
                            }
                        }
                    }
                }
#pragma unroll
                for (int a = 0; a < 2; ++a)
#pragma unroll
                    for (int c = 0; c < 4; ++c)
#pragma unroll
                        for (int r = 0; r < 16; ++r) acc[a][c][r] = 0.f;
            }
        }
    }
    __syncthreads();
#undef MOE_AOFF
#undef MOE_DEC
#undef MOE_LOADB
#undef MOE_WRITEB
#undef MOE_COMPUTE
#undef MOE_NEXTA
}

constexpr int N_PHASES = 21;

#define P_x_in CTX_IN(0)
#define P_xb ((u16*)(ws + WS_XB))
#define P_x1 ((float*)(ws + WS_X1))
#define P_x2 ((float*)(ws + WS_X2))
#define P_ypre ((float*)(ws + WS_YPRE))
#define P_qkv ((u16*)(ws + WS_QKV))
#define P_vT ((u16*)(ws + WS_VT))
#define P_kmean ((float*)(ws + WS_KM))
#define P_ao ((u16*)(ws + WS_AO))
#define P_og ((u16*)(ws + WS_OG))
#define P_lse ((float*)(ws + WS_LSE))
#define P_topw ((float*)(ws + WS_TOPW))
#define P_list ((int*)(ws + WS_LIST))
#define P_hb ((u16*)(ws + WS_HB))
#define P_yb ((u16*)(ws + WS_YB))
#define P_cnt_all ((int*)(ws + WS_CTL + CTL_CNT_OFF))
#define P_xb8 ((unsigned char*)(ws + WS_XB8))
#define P_hbs ((u16*)(ws + WS_HBS))
#define P_selm ((unsigned*)(ws + WS_SELM))
#define P_part ((u16*)(ws + WS_PART))
#define P_plse ((float*)(ws + WS_PLSE))
#define PH_BEGIN int tid = wave_s_ * 64 + lane_id_(); asm volatile("" : "+v"(tid)); const int lane = tid & 63, r32 = lane & 31, hi = lane >> 5; const int wave = __builtin_amdgcn_readfirstlane(tid >> 6); (void)lane; (void)r32; (void)hi; (void)wave
constexpr int LDS_CTX = LDS_BAR + 16;
__device__ __forceinline__ uint64_t ctx_ld(int i) {
    extern __shared__ __attribute__((aligned(16))) unsigned char lds_raw[];
    const LAS unsigned* q = (const LAS unsigned*)((LAS char*)lds_raw + LDS_CTX) + 2 * i;
    const unsigned lo = __builtin_amdgcn_readfirstlane(q[0]), hi = __builtin_amdgcn_readfirstlane(q[1]);
    return ((uint64_t)hi << 32) | lo;
}
typedef __attribute__((address_space(1))) unsigned char gbyte;
#define AS_GLOBAL(T, u64v) ((T*)(gbyte*)(u64v))
#define CTX_IN(i) AS_GLOBAL(const float, ctx_ld(i))
#define PH_FN_BEGIN \
    extern __shared__ __attribute__((aligned(16))) unsigned char lds_raw[]; \
    LAS char* lds = (LAS char*)lds_raw; (void)lds; \
    const int G = gridDim.x, bid = blockIdx.x; (void)G; (void)bid; \
    unsigned char* const ws = AS_GLOBAL(unsigned char, ctx_ld(17)); (void)ws; \
    const int NQ = L == 0 ? 3072 : 9216; (void)NQ; \
    int* cnt = P_cnt_all + L * NE; (void)cnt;
__device__ __forceinline__ void ph_p0(int L, int rep_, const int wave_s_) {
    PH_FN_BEGIN
    (void)rep_;
    PH_BEGIN;
    for (size_t i = (size_t)bid * NTHR + tid; i < (size_t)T * D / 4; i += (size_t)G * NTHR) {
        const f32x4 v = *(const f32x4*)(P_x_in + i * 4);
        u32x2 w; w[0] = cvtpk(v[0], v[1]); w[1] = cvtpk(v[2], v[3]);
        *(u32x2*)(P_xb + i * 4) = w;
    }
    LAS float* tl = (LAS float*)lds;
    for (int it = bid; it < 3968 + 128; it += G) {
        int seg, kt;
        if (it < 3840) { seg = it >> 4; kt = it & 15; } else if (it < 3968) { seg = 240 + ((it - 3840) >> 2); kt = (it - 3840) & 3; } else { seg = 272 + ((it - 3968) >> 4); kt = (it - 3968) & 15; }
        const float* src; int ld; u16* dst; int Kd = 1024; u16* dst_lo = nullptr;
        if (seg < 48) { const int col = 64 * seg; src = CTX_IN(1) + col; ld = 3072; dst = (u16*)(ws + WS_WQK0) + (size_t)col * 1024; }
        else if (seg < 192) { const int col = 64 * (seg - 48); src = CTX_IN(2) + col; ld = 9216; dst = (u16*)(ws + WS_WQK1) + (size_t)col * 1024; }
        else if (seg < 224) { const int s2 = seg - 192, l2 = s2 >> 4, col = 64 * (s2 & 15); src = CTX_IN(3) + (size_t)l2 * D * D + col; ld = 1024; dst = (u16*)(ws + WS_WO) + (size_t)l2 * D * D + (size_t)col * 1024; }
        else if (seg < 240) { const int s2 = seg - 224, l2 = s2 >> 3, i8 = s2 & 7, un = i8 >> 2, q = i8 & 3;
            src = (q < 2 ? CTX_IN(11) : CTX_IN(12)) + (size_t)l2 * D * DF + un * 128 + 64 * (q & 1); ld = 256; dst = (u16*)(ws + WS_WSGU) + (size_t)l2 * 512 * 1024 + (size_t)(64 * i8) * 1024; }
        else if (seg < 272) { const int s2 = seg - 240, l2 = s2 >> 4, col = 64 * (s2 & 15); src = CTX_IN(13) + (size_t)l2 * DF * D + col; ld = 1024; Kd = 256; dst = (u16*)(ws + WS_WSD) + (size_t)l2 * D * DF + (size_t)col * 256; }
        else { const int s2 = seg - 272, l2 = s2 >> 2, col = 64 * (s2 & 3); src = CTX_IN(6) + (size_t)l2 * D * NE + col; ld = 256; dst = (u16*)(ws + WS_WRH) + (size_t)l2 * NE * D + (size_t)col * 1024; dst_lo = (u16*)(ws + WS_WRL) + (size_t)l2 * NE * D + (size_t)col * 1024; }
        {
            const int kr = tid >> 4, c4 = tid & 15;
#pragma unroll
            for (int i = 0; i < 2; ++i) {
                const f32x4 v = *(const f32x4*)(src + (size_t)(kt * 64 + kr + 32 * i) * ld + 4 * c4);
#pragma unroll
                for (int jj = 0; jj < 4; ++jj) tl[(kr + 32 * i) * 65 + 4 * c4 + jj] = v[jj];
            }
        }
        __syncthreads();
        {
            const int row = tid >> 3, kc = tid & 7;
            float f[8];
#pragma unroll
            for (int jj = 0; jj < 8; ++jj) f[jj] = tl[(8 * kc + jj) * 65 + row];
            u32x4 w; w[0] = cvtpk(f[0], f[1]); w[1] = cvtpk(f[2], f[3]); w[2] = cvtpk(f[4], f[5]); w[3] = cvtpk(f[6], f[7]);
            *(u32x4*)(dst + (size_t)row * Kd + kt * 64 + 8 * kc) = w;
            if (dst_lo) {
                u32x4 wl;
#pragma unroll
                for (int jj = 0; jj < 4; ++jj) wl[jj] = cvtpk(f[2 * jj] - bf2f(w[jj] & 0xFFFFu), f[2 * jj + 1] - bf2f(w[jj] >> 16));
                *(u32x4*)(dst_lo + (size_t)row * Kd + kt * 64 + 8 * kc) = wl;
            }
        }
        __syncthreads();
    }
}

__device__ __forceinline__ void ph_qkv(int L, int rep_, const int wave_s_) {
    PH_FN_BEGIN
    (void)rep_;
    const pg8::Gemm g{P_xb, (const u16*)(ws + (L == 0 ? WS_WQK0 : WS_WQK1)), T, NQ, D};
    pg8::StaticOrder S; S.init(g.M, g.N, G, bid);
    const EpiQK E{P_qkv, NQ};
    pg8::gemm_phase<EpiQK, pg8::StaticOrder, false>((PG8_LAS unsigned char*)lds, g, S, E, nullptr, wave_s_ * 64 + lane_id_());
}

__device__ __forceinline__ void ph_kmean(int L, int rep_, const int wave_s_) {
    PH_FN_BEGIN
    (void)rep_;
    PH_BEGIN;
    LAS float* red = (LAS float*)lds;
    for (int it = bid; it < BATCH * NH * MOBA_NB; it += G) {
        const int j = it & 31, h = (it >> 5) & 15, b = it >> 9;
        const int kg_ = tid >> 3, ch = tid & 7;
        const u16* kp = P_qkv + (size_t)(b * SEQ + j * MOBA_BLK + kg_) * 3072 + 1024 + h * 64 + ch * 8;
        float sm[8];
#pragma unroll
        for (int e2 = 0; e2 < 8; ++e2) sm[e2] = 0.f;
#pragma unroll
        for (int i = 0; i < 4; ++i) {
            const u32x4 v = *(const u32x4*)(kp + (size_t)(64 * i) * 3072);
#pragma unroll
            for (int e2 = 0; e2 < 4; ++e2) { sm[2 * e2] += bf2f(v[e2] & 0xFFFFu); sm[2 * e2 + 1] += bf2f(v[e2] >> 16); }
        }
#pragma unroll
        for (int e2 = 0; e2 < 8; ++e2) red[kg_ * 65 + ch * 8 + e2] = sm[e2];
        __syncthreads();
        if (tid < 64) {
            float tot = 0.f;
#pragma unroll 8
            for (int q = 0; q < 64; ++q) tot += red[q * 65 + tid];
            P_kmean[(size_t)it * 64 + tid] = tot * (1.f / MOBA_BLK);
        }
        __syncthreads();
    }
}

__device__ __forceinline__ void ph_gate(int L, int rep_, const int wave_s_) {
    PH_FN_BEGIN
    (void)rep_;
    PH_BEGIN;
    for (int it = bid; it < BATCH * NH * MOBA_NB; it += G) {
        const int qb = it & 31, bh = it >> 5, b = bh >> 4, h = bh & 15;
        const int tq = qb * MOBA_BLK + wave * 32 + r32;
        const u16* qrow = P_qkv + (size_t)(b * SEQ + tq) * 3072 + h * 64 + hi * 8;
        bf16x8 qf[4];
#pragma unroll
        for (int d0 = 0; d0 < 4; ++d0) qf[d0] = *(const bf16x8*)(qrow + d0 * 16);
        unsigned selmask = 0u;
        if (qb > 0) {
            const float* km = P_kmean + ((size_t)(b * NH + h) * MOBA_NB + r32) * 64 + hi * 8;
            f32x16 gt;
#pragma unroll
            for (int r = 0; r < 16; ++r) gt[r] = 0.f;
#pragma unroll
            for (int d0 = 0; d0 < 4; ++d0) {
                const f32x4 k0 = *(const f32x4*)(km + d0 * 16), k1 = *(const f32x4*)(km + d0 * 16 + 4);
                union { bf16x8 v; unsigned u[4]; } kf;
                kf.u[0] = cvtpk(k0[0], k0[1]); kf.u[1] = cvtpk(k0[2], k0[3]); kf.u[2] = cvtpk(k1[0], k1[1]); kf.u[3] = cvtpk(k1[2], k1[3]);
                gt = MFMA_BF16(kf.v, qf[d0], gt);
            }
            float v0 = -INFINITY, v1 = -INFINITY, v2 = -INFINITY; int i0 = 99, i1 = 99, i2 = 99;
#pragma unroll
            for (int r = 0; r < 16; ++r) { const int jb = crow(r, hi); const float gv = jb < qb ? gt[r] : -INFINITY; top3_insert(gv, jb < qb ? jb : 99, v0, i0, v1, i1, v2, i2); }
            const float ov0 = shxf(v0, 32, lane), ov1 = shxf(v1, 32, lane), ov2 = shxf(v2, 32, lane);
            const int oi0 = shxi(i0, 32, lane), oi1 = shxi(i1, 32, lane), oi2 = shxi(i2, 32, lane);
            top3_insert(ov0, oi0, v0, i0, v1, i1, v2, i2); top3_insert(ov1, oi1, v0, i0, v1, i1, v2, i2); top3_insert(ov2, oi2, v0, i0, v1, i1, v2, i2);
            if (i0 < 32) selmask |= 1u << i0;
            if (i1 < 32) selmask |= 1u << i1;
            if (i2 < 32) selmask |= 1u << i2;
        }
        if (hi == 0) P_selm[(size_t)bh * SEQ + tq] = selmask;
    }
}

constexpr int MB_KP = 72;
constexpr int MB_VP = 260;
constexpr int MB_LDS_K = 0;
constexpr int MB_LDS_V = 256 * MB_KP * 2;
constexpr int MB_LDS_LIST = MB_LDS_V + 64 * MB_VP * 2;
constexpr int MB_LDS_CTR = MB_LDS_LIST + 8192 * 2;
__device__ __forceinline__ void ph_moba(int L, int rep_, const int wave_s_) {
    PH_FN_BEGIN
    (void)rep_;
    PH_BEGIN;
    LAS char* Ks = lds + MB_LDS_K; LAS char* Vs = lds + MB_LDS_V;
    LAS u16* qlist = (LAS u16*)(lds + MB_LDS_LIST); LAS int* ctr = (LAS int*)(lds + MB_LDS_CTR);
    for (int it = bid; it < BATCH * NH * MOBA_NB; it += G) {
        const int rnd = it >> 8, w8 = it & 255, a8 = w8 >> 5, bh = w8 & 31;
        const int j = rnd == 0 ? a8 : (rnd == 1 ? 15 - a8 : (rnd == 2 ? 16 + a8 : 31 - a8));
        const int b = bh >> 4, h = bh & 15;
        const float slope2 = exp2f(-0.5f * (float)(h + 1)) * LOG2E;
        if (tid == 0) { int z0 = 0; asm volatile("" : "+v"(z0)); ctr[0] = z0; ctr[1] = z0; }
        {
            const u16* kg = P_qkv + (size_t)(b * SEQ + j * MOBA_BLK) * 3072 + 1024 + h * 64;
#pragma unroll
            for (int i = 0; i < 4; ++i) { const int c = tid + i * 512, row = c >> 3, ch = c & 7; *(LAS u32x4*)(Ks + (row * MB_KP + ch * 8) * 2) = *(const u32x4*)(kg + (size_t)row * 3072 + ch * 8); }
            const u16* vg = P_qkv + (size_t)(b * SEQ + j * MOBA_BLK) * 3072 + 2048 + h * 64;
#pragma unroll
            for (int i = 0; i < 4; ++i) {
                const int c = tid + i * 512, key = c >> 3, ch = c & 7;
                const u32x4 v = *(const u32x4*)(vg + (size_t)key * 3072 + ch * 8);
#pragma unroll
                for (int e2 = 0; e2 < 4; ++e2) {
                    *(LAS u16*)(Vs + ((ch * 8 + 2 * e2) * MB_VP + key) * 2) = (u16)(v[e2] & 0xFFFFu);
                    *(LAS u16*)(Vs + ((ch * 8 + 2 * e2 + 1) * MB_VP + key) * 2) = (u16)(v[e2] >> 16);
                }
            }
        }
        __syncthreads();
        {
            const unsigned* sm = P_selm + (size_t)bh * SEQ;
            for (int t0 = (j + 1) * MOBA_BLK; t0 < SEQ; t0 += 512) {
                const int t = t0 + tid;
                const bool sel = (t < SEQ) && ((sm[t < SEQ ? t : 0] >> j) & 1u);
                const unsigned long long bal = __ballot(sel);
                const int total = __popcll(bal);
                int wb = 0;
                if (lane == 0 && total) wb = atomicAdd((int*)&ctr[0], total);
                wb = __builtin_amdgcn_readfirstlane(wb);
                if (sel) qlist[wb + __popcll(bal & ((1ull << lane) - 1ull))] = (u16)t;
            }
        }
        __syncthreads();
        const int nq = ctr[0];
        const int ntiles = 8 + ((nq + 31) >> 5);
        for (;;) {
            int ti = 0;
            if (lane == 0) ti = atomicAdd((int*)&ctr[1], 1);
            ti = __builtin_amdgcn_readfirstlane(ti);
            if (ti >= ntiles) break;
            const bool own = ti < 8;
            const int wq = 7 - ti;
            const int li = (ti - 8) * 32 + r32;
            const bool valid = own || li < nq;
            const int tq = own ? j * MOBA_BLK + wq * 32 + r32 : (int)qlist[li < nq ? li : nq - 1];
            const int nsteps = own ? wq + 1 : 8;
            const u16* qrow = P_qkv + (size_t)(b * SEQ + tq) * 3072 + h * 64 + hi * 8;
            bf16x8 qf[4];
#pragma unroll
            for (int d0 = 0; d0 < 4; ++d0) qf[d0] = *(const bf16x8*)(qrow + d0 * 16);
            int slot = 3;
            if (!own) slot = __popc(P_selm[(size_t)bh * SEQ + tq] & ((1u << j) - 1u));
            AttnSt st; st.m = NEGV; st.l = 0.f;
#pragma unroll
            for (int r = 0; r < 16; ++r) { st.o0[r] = 0.f; st.o1[r] = 0.f; }
            const int dlo = own ? 0 : -0x40000000;
            for (int kt = 0; kt < nsteps; ++kt) {
                AttnFr f;
#pragma unroll
                for (int d0 = 0; d0 < 4; ++d0) f.k[d0] = *(LAS bf16x8*)(Ks + ((kt * 32 + r32) * MB_KP + d0 * 16 + hi * 8) * 2);
#pragma unroll
                for (int q4 = 0; q4 < 4; ++q4) {
                    union { bf16x8 v; u32x2 hh[2]; } va;
                    LAS char* vp = Vs + (((q4 >> 1) * 32 + r32) * MB_VP + kt * 32 + (q4 & 1) * 16 + 4 * hi) * 2;
                    va.hh[0] = *(LAS u32x2*)(vp); va.hh[1] = *(LAS u32x2*)(vp + 16);
                    f.v[q4] = va.v;
                }
                attn_compute(st, qf, f, tq - (j * MOBA_BLK + kt * 32) - 4 * hi, slope2, dlo, 0x7fffffff, hi, lane);
            }
            const float lt = st.l + shxf(st.l, 32, lane);
            const float inv = 1.f / lt;
            if (valid) {
                const size_t pi = ((size_t)(b * SEQ + tq) * NH + h) * 4 + slot;
                u16* orow = P_part + pi * 64;
#pragma unroll
                for (int rq = 0; rq < 4; ++rq) {
                    u32x2 w; w[0] = cvtpk(st.o0[4 * rq] * inv, st.o0[4 * rq + 1] * inv); w[1] = cvtpk(st.o0[4 * rq + 2] * inv, st.o0[4 * rq + 3] * inv);
                    *(u32x2*)(orow + 8 * rq + 4 * hi) = w;
                    w[0] = cvtpk(st.o1[4 * rq] * inv, st.o1[4 * rq + 1] * inv); w[1] = cvtpk(st.o1[4 * rq + 2] * inv, st.o1[4 * rq + 3] * inv);
                    *(u32x2*)(orow + 32 + 8 * rq + 4 * hi) = w;
                }
                if (hi == 0) P_plse[pi] = st.m * LN2 + logf(lt);
            }
        }
        __syncthreads();
    }
}

__device__ __forceinline__ void ph_mobamerge(int L, int rep_, const int wave_s_) {
    PH_FN_BEGIN
    (void)rep_;
    PH_BEGIN;
    for (size_t i = (size_t)bid * NTHR + tid; i < (size_t)T * NH * 8; i += (size_t)G * NTHR) {
        const size_t row = i >> 7; const int h = (int)(i >> 3) & 15, d8 = (int)i & 7;
        const int qb = (int)(row & (SEQ - 1)) >> 8;
        const int nsel = qb < 3 ? qb : 3;
        const size_t pi = (row * NH + h) * 4;
        float l[4], w[4];
        float mx = -INFINITY;
#pragma unroll
        for (int sidx = 0; sidx < 4; ++sidx) { const bool ok = sidx == 3 || sidx < nsel; l[sidx] = ok ? P_plse[pi + sidx] : -INFINITY; mx = fmaxf(mx, l[sidx]); }
        float ws_ = 0.f;
#pragma unroll
        for (int sidx = 0; sidx < 4; ++sidx) { w[sidx] = (sidx == 3 || sidx < nsel) ? expf(l[sidx] - mx) : 0.f; ws_ += w[sidx]; }
        const float inv = 1.f / ws_;
        float acc8[8];
#pragma unroll
        for (int c = 0; c < 8; ++c) acc8[c] = 0.f;
#pragma unroll
        for (int sidx = 0; sidx < 4; ++sidx) {
            if (sidx == 3 || sidx < nsel) {
                const u32x4 a = *(const u32x4*)(P_part + (pi + sidx) * 64 + d8 * 8);
                const float ww = w[sidx] * inv;
#pragma unroll
                for (int c = 0; c < 4; ++c) { acc8[2 * c] += ww * bf2f(a[c] & 0xFFFFu); acc8[2 * c + 1] += ww * bf2f(a[c] >> 16); }
            }
        }
        u32x4 o;
#pragma unroll
        for (int c = 0; c < 4; ++c) o[c] = cvtpk(acc8[2 * c], acc8[2 * c + 1]);
        *(u32x4*)(P_ao + row * D + h * 64 + d8 * 8) = o;
    }
}

constexpr int DL_KP = 72, DL_VP = 388;
constexpr int DL_LDS_K = 0, DL_LDS_V = 384 * DL_KP * 2;
__device__ __forceinline__ void ph_dil(int L, int rep_, const int wave_s_) {
    PH_FN_BEGIN
    (void)rep_;
    PH_BEGIN;
    LAS char* Ks = lds + DL_LDS_K; LAS char* Vs = lds + DL_LDS_V;
    for (int it = bid; it < BATCH * NH * 3 * 32; it += G) {
        const int ch = it & 31, grp = (it >> 5) % 3, bh = it / 96, b = bh >> 4, h = bh & 15;
        const int dil = grp == 0 ? 1 : (grp == 1 ? 4 : 16), Ls = SEQ / dil;
        const float slope2 = exp2f(-0.5f * (float)(h + 1)) * LOG2E * (float)dil;
        const int uc = ch * 256, res = uc / Ls, c0 = uc - res * Ls;
        const int kb0 = c0 - 128;
        {
            const u16* kg = P_qkv + (size_t)(b * SEQ) * 9216 + grp * 3072 + 1024 + h * 64;
#pragma unroll
            for (int i = 0; i < 6; ++i) {
                const int c = tid + i * 512, row = c >> 3, chk = c & 7, ks = kb0 + row;
                if (ks >= 0) *(LAS u32x4*)(Ks + (row * DL_KP + chk * 8) * 2) = *(const u32x4*)(kg + (size_t)(ks * dil + res) * 9216 + chk * 8);
            }
            const u16* vg = P_qkv + (size_t)(b * SEQ) * 9216 + grp * 3072 + 2048 + h * 64;
#pragma unroll
            for (int i = 0; i < 6; ++i) {
                const int c = tid + i * 512, row = c >> 3, chk = c & 7, ks = kb0 + row;
                if (ks >= 0) {
                    const u32x4 v = *(const u32x4*)(vg + (size_t)(ks * dil + res) * 9216 + chk * 8);
#pragma unroll
                    for (int e2 = 0; e2 < 4; ++e2) {
                        *(LAS u16*)(Vs + ((chk * 8 + 2 * e2) * DL_VP + row) * 2) = (u16)(v[e2] & 0xFFFFu);
                        *(LAS u16*)(Vs + ((chk * 8 + 2 * e2 + 1) * DL_VP + row) * 2) = (u16)(v[e2] >> 16);
                    }
                }
            }
        }
        __syncthreads();
        const int i0 = c0 + wave * 32, iq = i0 + r32, pq = iq * dil + res;
        const u16* qrow = P_qkv + (size_t)(b * SEQ + pq) * 9216 + grp * 3072 + h * 64 + hi * 8;
        bf16x8 qf[4];
#pragma unroll
        for (int d0 = 0; d0 < 4; ++d0) qf[d0] = *(const bf16x8*)(qrow + d0 * 16);
        AttnSt st; st.m = NEGV; st.l = 0.f;
#pragma unroll
        for (int r = 0; r < 16; ++r) { st.o0[r] = 0.f; st.o1[r] = 0.f; }
        const int ktmin = (i0 >= 128) ? 0 : (128 - i0) >> 5;
        for (int kt = 4; kt >= ktmin; --kt) {
            const int lrow0 = (wave + kt) * 32;
            AttnFr f;
#pragma unroll
            for (int d0 = 0; d0 < 4; ++d0) f.k[d0] = *(LAS bf16x8*)(Ks + ((lrow0 + r32) * DL_KP + d0 * 16 + hi * 8) * 2);
#pragma unroll
            for (int q4 = 0; q4 < 4; ++q4) {
                union { bf16x8 v; u32x2 hh[2]; } va;
                LAS char* vp = Vs + (((q4 >> 1) * 32 + r32) * DL_VP + lrow0 + (q4 & 1) * 16 + 4 * hi) * 2;
                va.hh[0] = *(LAS u32x2*)(vp); va.hh[1] = *(LAS u32x2*)(vp + 16);
                f.v[q4] = va.v;
            }
            const int k0 = i0 - 128 + kt * 32;
            attn_compute(st, qf, f, iq - k0 - 4 * hi, slope2, 0, 128, hi, lane);
        }
        const float lt = st.l + shxf(st.l, 32, lane);
        const float inv = 1.f / lt;
        u16* orow = P_og + (size_t)grp * T * D + (size_t)(b * SEQ + pq) * D + h * 64;
#pragma unroll
        for (int rq = 0; rq < 4; ++rq) {
            u32x2 w; w[0] = cvtpk(st.o0[4 * rq] * inv, st.o0[4 * rq + 1] * inv); w[1] = cvtpk(st.o0[4 * rq + 2] * inv, st.o0[4 * rq + 3] * inv);
            *(u32x2*)(orow + 8 * rq + 4 * hi) = w;
            w[0] = cvtpk(st.o1[4 * rq] * inv, st.o1[4 * rq + 1] * inv); w[1] = cvtpk(st.o1[4 * rq + 2] * inv, st.o1[4 * rq + 3] * inv);
            *(u32x2*)(orow + 32 + 8 * rq + 4 * hi) = w;
        }
        if (hi == 0) P_lse[((size_t)grp * T + (b * SEQ + pq)) * NH + h] = st.m * LN2 + logf(lt);
        __syncthreads();
    }
}

__device__ __forceinline__ void ph_merge(int L, int rep_, const int wave_s_) {
    PH_FN_BEGIN
    (void)rep_;

            PH_BEGIN;
                for (size_t i = (size_t)bid * NTHR + tid; i < (size_t)T * NH * 8; i += (size_t)G * NTHR) {
                    const size_t row = i >> 7; const int h = (int)(i >> 3) & 15, d8 = (int)i & 7;
                    const float l0 = P_lse[(0 * (size_t)T + row) * NH + h], l1 = P_lse[(1 * (size_t)T + row) * NH + h], l2 = P_lse[(2 * (size_t)T + row) * NH + h];
                    const float mx = fmaxf(l0, fmaxf(l1, l2));
                    float w0 = expf(l0 - mx), w1 = expf(l1 - mx), w2 = expf(l2 - mx);
                    const float inv = 1.f / (w0 + w1 + w2); w0 *= inv; w1 *= inv; w2 *= inv;
                    const size_t off = row * D + h * 64 + d8 * 8;
                    const u32x4 a0 = *(const u32x4*)(P_og + off), a1 = *(const u32x4*)(P_og + (size_t)T * D + off), a2 = *(const u32x4*)(P_og + 2 * (size_t)T * D + off);
                    u32x4 o;
#pragma unroll
                    for (int c = 0; c < 4; ++c) {
                        const float lo_ = w0 * bf2f(a0[c] & 0xFFFFu) + w1 * bf2f(a1[c] & 0xFFFFu) + w2 * bf2f(a2[c] & 0xFFFFu);
                        const float hi_ = w0 * bf2f(a0[c] >> 16) + w1 * bf2f(a1[c] >> 16) + w2 * bf2f(a2[c] >> 16);
                        o[c] = cvtpk(lo_, hi_);
                    }
                    *(u32x4*)(P_ao + off) = o;
                }

}

__device__ __forceinline__ void ph_wo(int L, int rep_, const int wave_s_) {
    PH_FN_BEGIN
    (void)rep_;
    const pg8::Gemm g{P_ao, (const u16*)(ws + WS_WO) + (size_t)L * D * D, T, D, D};
    pg8::StaticOrder S; S.init(g.M, g.N, G, bid);
    const EpiWo E{P_ypre, L == 0 ? CTX_IN(0) : (const float*)P_x2};
    pg8::gemm_phase<EpiWo, pg8::StaticOrder, false>((PG8_LAS unsigned char*)lds, g, S, E, nullptr, wave_s_ * 64 + lane_id_());
}

__device__ __forceinline__ void ph_router(int L, int rep_, const int wave_s_) {
    PH_FN_BEGIN
    (void)rep_;

            PH_BEGIN;
            const float* lng = CTX_IN(4) + L * D; const float* lnb = CTX_IN(5) + L * D;
            const float* rbias = CTX_IN(7) + L * NE;
            const u16* wrh = (const u16*)(ws + WS_WRH) + (size_t)L * NE * D; const u16* wrl = (const u16*)(ws + WS_WRL) + (size_t)L * NE * D;
            constexpr int AP = 2064;
            LAS char* ahi = lds; LAS char* alo = lds + 32 * AP;
            for (int it = bid; it < T / 32; it += G) {
                {
                    f32x4 yv[4][4];
#pragma unroll
                    for (int rr = 0; rr < 4; ++rr)
#pragma unroll
                        for (int j = 0; j < 4; ++j) yv[rr][j] = *(const f32x4*)(P_ypre + ((size_t)it * 32 + wave * 4 + rr) * D + j * 256 + lane * 4);
#pragma unroll
                    for (int rr = 0; rr < 4; ++rr) {
                        const int lr = wave * 4 + rr; const size_t row = (size_t)it * 32 + lr;
                        float v[16];
#pragma unroll
                        for (int j = 0; j < 4; ++j) { v[j * 4] = yv[rr][j][0]; v[j * 4 + 1] = yv[rr][j][1]; v[j * 4 + 2] = yv[rr][j][2]; v[j * 4 + 3] = yv[rr][j][3]; }
                        ln_row(v, lng, lnb, lane);
#pragma unroll
                        for (int j = 0; j < 4; ++j) {
                            f32x4 t4; t4[0] = v[j * 4]; t4[1] = v[j * 4 + 1]; t4[2] = v[j * 4 + 2]; t4[3] = v[j * 4 + 3];
                            *(f32x4*)(P_x1 + row * D + j * 256 + lane * 4) = t4;
                            u32x2 w; w[0] = cvtpk(t4[0], t4[1]); w[1] = cvtpk(t4[2], t4[3]);
                            *(u32x2*)(P_xb + row * D + j * 256 + lane * 4) = w;
                            *(unsigned*)(P_xb8 + row * D + j * 256 + lane * 4) = pack_fp8x4(t4[0], t4[1], t4[2], t4[3]);
                            u32x2 wl; wl[0] = cvtpk(t4[0] - bf2f(w[0] & 0xFFFFu), t4[1] - bf2f(w[0] >> 16)); wl[1] = cvtpk(t4[2] - bf2f(w[1] & 0xFFFFu), t4[3] - bf2f(w[1] >> 16));
                            *(LAS u32x2*)(ahi + lr * AP + (j * 256 + lane * 4) * 2) = w;
                            *(LAS u32x2*)(alo + lr * AP + (j * 256 + lane * 4) * 2) = wl;
                        }
                    }
                }
                __syncthreads();
                f32x16 lg;
#pragma unroll
                for (int r = 0; r < 16; ++r) lg[r] = 0.f;
                {
                    const LAS char* ah = ahi + r32 * AP + hi * 16; const LAS char* al = alo + r32 * AP + hi * 16;
                    const u16* bh = wrh + (size_t)(wave * 32 + r32) * D + hi * 8; const u16* bl = wrl + (size_t)(wave * 32 + r32) * D + hi * 8;
                    bf16x8 bha[8], bla[8], bhb[8], blb[8];
#pragma unroll
                    for (int j = 0; j < 8; ++j) { bha[j] = *(const bf16x8*)(bh + j * 16); bla[j] = *(const bf16x8*)(bl + j * 16); }
#pragma unroll 1
                    for (int k0 = 0; k0 < D; k0 += 256) {
#pragma unroll
                        for (int j = 0; j < 8; ++j) { bhb[j] = *(const bf16x8*)(bh + k0 + 128 + j * 16); blb[j] = *(const bf16x8*)(bl + k0 + 128 + j * 16); }
#pragma unroll
                        for (int j = 0; j < 8; ++j) {
                            const bf16x8 xh = *(const LAS bf16x8*)(ah + (k0 + j * 16) * 2), xl = *(const LAS bf16x8*)(al + (k0 + j * 16) * 2);
                            lg = MFMA_BF16(xh, bha[j], lg); lg = MFMA_BF16(xl, bha[j], lg); lg = MFMA_BF16(xh, bla[j], lg);
                        }
                        { const int kn = (k0 + 256 < D) ? k0 + 256 : 0;
#pragma unroll
                          for (int j = 0; j < 8; ++j) { bha[j] = *(const bf16x8*)(bh + kn + j * 16); bla[j] = *(const bf16x8*)(bl + kn + j * 16); } }
#pragma unroll
                        for (int j = 0; j < 8; ++j) {
                            const bf16x8 xh = *(const LAS bf16x8*)(ah + (k0 + 128 + j * 16) * 2), xl = *(const LAS bf16x8*)(al + (k0 + 128 + j * 16) * 2);
                            lg = MFMA_BF16(xh, bhb[j], lg); lg = MFMA_BF16(xl, bhb[j], lg); lg = MFMA_BF16(xh, blb[j], lg);
                        }
                    }
                }
                __syncthreads();
                LAS float* lgs = (LAS float*)lds;
#pragma unroll
                for (int r = 0; r < 16; ++r) lgs[crow(r, hi) * 257 + wave * 32 + r32] = lg[r];
                __syncthreads();
#pragma unroll 1
                for (int rr = 0; rr < 4; ++rr) {
                    const int lr = wave * 4 + rr; const int tok = it * 32 + lr;
                    float sc[4], ch[4];
#pragma unroll
                    for (int j = 0; j < 4; ++j) { const int e = lane + 64 * j; sc[j] = 1.f / (1.f + expf(-lgs[lr * 257 + e])); ch[j] = sc[j] + rbias[e]; }
                    float gsel[8];
#pragma unroll
                    for (int j = 0; j < 4; ++j) {
                        const float rm = dpp_rowmax(ch[j]);
                        const float m1a = fmaxf(rl_f(rm, 0), rl_f(rm, 16)), m1b = fmaxf(rl_f(rm, 32), rl_f(rm, 48));
                        const unsigned long long bal = __ballot(ch[j] == (hi ? m1b : m1a));
                        const int fa_ = __builtin_ctz((unsigned)(bal & 0xFFFFFFFFull)), fb_ = 32 + __builtin_ctz((unsigned)(bal >> 32));
                        const float c2 = (lane == fa_ || lane == fb_) ? -INFINITY : ch[j];
                        const float rm2 = dpp_rowmax(c2);
                        gsel[2 * j] = m1a + fmaxf(rl_f(rm2, 0), rl_f(rm2, 16));
                        gsel[2 * j + 1] = m1b + fmaxf(rl_f(rm2, 32), rl_f(rm2, 48));
                    }
                    float cv[4];
#pragma unroll
                    for (int j = 0; j < 4; ++j) {
                        int ra_ = 0, rb_ = 0;
#pragma unroll
                        for (int g2 = 0; g2 < 8; ++g2) {
                            ra_ += ((gsel[g2] > gsel[2 * j]) || (gsel[g2] == gsel[2 * j] && g2 < 2 * j)) ? 1 : 0;
                            rb_ += ((gsel[g2] > gsel[2 * j + 1]) || (gsel[g2] == gsel[2 * j + 1] && g2 < 2 * j + 1)) ? 1 : 0;
                        }
                        cv[j] = ((hi ? rb_ : ra_) < 4) ? ch[j] : NEGV;
                    }
                    float wsel = 0.f; int esel = 0; float wsum = 0.f;
#pragma unroll 1
                    for (int k = 0; k < TOPK; ++k) {
                        float bv = cv[0]; int be = lane;
#pragma unroll
                        for (int j = 1; j < 4; ++j) if (cv[j] > bv) { bv = cv[j]; be = lane + 64 * j; }
                        const float rm = dpp_rowmax(bv);
                        const float mval = fmaxf(fmaxf(rl_f(rm, 0), rl_f(rm, 16)), fmaxf(rl_f(rm, 32), rl_f(rm, 48)));
                        const int ri = dpp_rowmin_i(bv == mval ? be : 0x7fffffff);
                        const int e = min(min(__builtin_amdgcn_readlane(ri, 0), __builtin_amdgcn_readlane(ri, 16)), min(__builtin_amdgcn_readlane(ri, 32), __builtin_amdgcn_readlane(ri, 48)));
                        const int jl = e >> 6, ll = e & 63;
                        float smine = sc[0];
                        smine = jl == 1 ? sc[1] : smine; smine = jl == 2 ? sc[2] : smine; smine = jl == 3 ? sc[3] : smine;
                        const float sw = rl_f(smine, ll);
#pragma unroll
                        for (int j = 0; j < 4; ++j) cv[j] = (lane == ll && jl == j) ? -INFINITY : cv[j];
                        wsum += sw;
                        if (lane == k) { wsel = sw; esel = e; }
                    }
                    if (lane < TOPK) {
                        const int a = tok * TOPK + lane;
                        P_topw[a] = wsel / wsum * 2.5f;
                        if (rep_ == 0) {
                            const int pos = atomicAdd(&cnt[esel], 1);
                            P_list[(size_t)esel * T + pos] = a;
                        }
                    }
                }
                __syncthreads();
            }

}

__device__ __forceinline__ void ph_gateup(int L, int rep_, const int wave_s_) {
    PH_FN_BEGIN
    (void)rep_;
    {
        PH_BEGIN;
        const float* weg = CTX_IN(8) + (size_t)L * NE * D * DF; const float* weu = CTX_IN(9) + (size_t)L * NE * D * DF;
        LAS int* rowva = (LAS int*)(lds + MOE_LDS_VA);
        {
            int* octr = (int*)(ws + WS_CTL + CTL_CNT_OFF + 8192) + (L * 4 + 2 * (rep_ & 1)) * 64;
            LAS int* slot = (LAS int*)(lds + 140000);
            for (;;) {
                __syncthreads();
                if (tid == 0) { int q; do { q = atomicAdd(octr, 1); } while (q >= NE && q < NE * 5 && cnt[(q - NE) >> 2] <= 512); *slot = q; }
                __syncthreads();
                const int q = *slot;
                if (q >= NE * 5) break;
                const bool ovf = q >= NE;
                const int e = ovf ? (q - NE) >> 2 : q, pz = ovf ? (q - NE) & 3 : 0, npz = ovf ? 1 : 4, st0 = ovf ? 1 : 0, n = cnt[e];
                for (int r0 = 0; r0 < n; r0 += 1024) {
                    if (ovf && n - r0 <= 512) break;
#pragma unroll
                    for (int i = 0; i < 2; ++i) { const int idx = r0 + i * 512 + tid; rowva[i * 512 + tid] = idx < n ? P_list[(size_t)e * T + idx] : TRASH_VA; }
                    __syncthreads();
                    moe_expert<false>(lds, tid, lane, wave, r32, hi, P_xb8, weg + (size_t)e * D * DF, weu + (size_t)e * D * DF, (n - r0) < 1024 ? (n - r0) : 1024, (void*)P_hb, pz, npz, st0, 1);
                }
            }
        }
    }
    {
        PH_BEGIN;
        const pg8::Gemm g{P_xb, (const u16*)(ws + WS_WSGU) + (size_t)L * 512 * 1024, T, 512, D};
        const EpiSGU E{P_hbs};
        int* qctr = (int*)(ws + WS_CTL + CTL_CNT_OFF + 4096) + (L * 4 + 2 * (rep_ & 1)) * 64;
        LAS int* slot = (LAS int*)(lds + 140000);
        for (;;) {
            __syncthreads();
            if (tid == 0) *slot = atomicAdd(qctr, 1);
            __syncthreads();
            const int un = *slot;
            if (un >= 128) break;
            const pg8::FixedOrder S{un & 63, un >> 6};
            pg8::gemm_phase<EpiSGU, pg8::FixedOrder, false>((PG8_LAS unsigned char*)lds, g, S, E, nullptr, wave_s_ * 64 + lane_id_());
        }
    }
}

__device__ __forceinline__ void ph_down(int L, int rep_, const int wave_s_) {
    PH_FN_BEGIN
    (void)rep_;
    {
        PH_BEGIN;
        const float* wed = CTX_IN(10) + (size_t)L * NE * DF * D;
        LAS int* rowva = (LAS int*)(lds + MOE_LDS_VA); LAS float* roww = (LAS float*)(lds + MOE_LDS_W);
        {
            int* octr = (int*)(ws + WS_CTL + CTL_CNT_OFF + 8192) + (L * 4 + 1 + 2 * (rep_ & 1)) * 64;
            LAS int* slot = (LAS int*)(lds + 140000);
            for (;;) {
                __syncthreads();
                if (tid == 0) { int q; do { q = atomicAdd(octr, 1); } while (q >= NE && q < NE * 5 && cnt[(q - NE) >> 2] <= 512); *slot = q; }
                __syncthreads();
                const int q = *slot;
                if (q >= NE * 5) break;
                const bool ovf = q >= NE;
                const int e = ovf ? (q - NE) >> 2 : q, pz = ovf ? ((q - NE) & 3) * 2 : 0, npz = ovf ? 2 : 8, st0 = ovf ? 1 : 0, n = cnt[e];
                for (int r0 = 0; r0 < n; r0 += 1024) {
                    if (ovf && n - r0 <= 512) break;
#pragma unroll
                    for (int i = 0; i < 2; ++i) { const int idx = r0 + i * 512 + tid; const int va = idx < n ? P_list[(size_t)e * T + idx] : TRASH_VA; rowva[i * 512 + tid] = va; roww[i * 512 + tid] = va < A_TOT ? P_topw[va] : 0.f; }
                    __syncthreads();
                    moe_expert<true>(lds, tid, lane, wave, r32, hi, (const unsigned char*)P_hb, wed + (size_t)e * DF * D, nullptr, (n - r0) < 1024 ? (n - r0) : 1024, (void*)P_yb, pz, npz, st0, 1);
                }
            }
        }
    }
    {
        PH_BEGIN;
        const pg8::Gemm g{P_hbs, (const u16*)(ws + WS_WSD) + (size_t)L * D * DF, T, D, DF};
        const EpiSD E{P_yb};
        int* qctr = (int*)(ws + WS_CTL + CTL_CNT_OFF + 4096) + (L * 4 + 1 + 2 * (rep_ & 1)) * 64;
        LAS int* slot = (LAS int*)(lds + 140000);
        for (;;) {
            __syncthreads();
            if (tid == 0) *slot = atomicAdd(qctr, 1);
            __syncthreads();
            const int un = *slot;
            if (un >= 256) break;
            const pg8::FixedOrder S{un & 63, un >> 6};
            pg8::gemm_phase<EpiSD, pg8::FixedOrder, false>((PG8_LAS unsigned char*)lds, g, S, E, nullptr, wave_s_ * 64 + lane_id_());
        }
    }
}

__device__ __forceinline__ void ph_combine(int L, int rep_, const int wave_s_) {
    PH_FN_BEGIN
    (void)rep_;
    PH_BEGIN;
    const float* lng = CTX_IN(14) + L * D; const float* lnb = CTX_IN(15) + L * D;
    float* dst = L == 0 ? P_x2 : AS_GLOBAL(float, ctx_ld(16));
    for (int row = bid * 8 + wave; row < T; row += G * 8) {
        u32x4 yv[TOPK + 1][2];
#pragma unroll
        for (int k = 0; k < TOPK + 1; ++k) {
            const size_t va = k < TOPK ? (size_t)row * TOPK + k : (size_t)A_TOT + row;
#pragma unroll
            for (int j = 0; j < 2; ++j) yv[k][j] = *(const u32x4*)(P_yb + va * D + j * 512 + lane * 8);
        }
        float v[16];
#pragma unroll
        for (int j = 0; j < 2; ++j) {
            const f32x4 t0 = *(const f32x4*)(P_x1 + (size_t)row * D + j * 512 + lane * 8), t1 = *(const f32x4*)(P_x1 + (size_t)row * D + j * 512 + lane * 8 + 4);
#pragma unroll
            for (int c = 0; c < 4; ++c) { v[j * 8 + c] = DN_ALPHA * t0[c]; v[j * 8 + 4 + c] = DN_ALPHA * t1[c]; }
        }
#pragma unroll
        for (int k = 0; k < TOPK + 1; ++k)
#pragma unroll
            for (int j = 0; j < 2; ++j)
#pragma unroll
                for (int c = 0; c < 4; ++c) { v[j * 8 + 2 * c] += bf2f(yv[k][j][c] & 0xFFFFu); v[j * 8 + 2 * c + 1] += bf2f(yv[k][j][c] >> 16); }
        float sm = 0.f;
#pragma unroll
        for (int i = 0; i < 16; ++i) sm += v[i];
        const float mu = wave_sum(sm) * (1.f / D);
        float q = 0.f;
#pragma unroll
        for (int i = 0; i < 16; ++i) { const float d = v[i] - mu; q += d * d; }
        const float rstd = rsqrtf(wave_sum(q) * (1.f / D) + LN_EPS);
#pragma unroll
        for (int j = 0; j < 2; ++j) {
            const f32x4 g0 = *(const f32x4*)(lng + j * 512 + lane * 8), g1 = *(const f32x4*)(lng + j * 512 + lane * 8 + 4);
            const f32x4 b0 = *(const f32x4*)(lnb + j * 512 + lane * 8), b1 = *(const f32x4*)(lnb + j * 512 + lane * 8 + 4);
            f32x4 o0, o1;
#pragma unroll
            for (int c = 0; c < 4; ++c) { o0[c] = (v[j * 8 + c] - mu) * rstd * g0[c] + b0[c]; o1[c] = (v[j * 8 + 4 + c] - mu) * rstd * g1[c] + b1[c]; }
            *(f32x4*)(dst + (size_t)row * D + j * 512 + lane * 8) = o0; *(f32x4*)(dst + (size_t)row * D + j * 512 + lane * 8 + 4) = o1;
            if (L == 0) { u32x4 w; w[0] = cvtpk(o0[0], o0[1]); w[1] = cvtpk(o0[2], o0[3]); w[2] = cvtpk(o1[0], o1[1]); w[3] = cvtpk(o1[2], o1[3]); *(u32x4*)(P_xb + (size_t)row * D + j * 512 + lane * 8) = w; }
        }
    }
}

__global__ void __launch_bounds__(NTHR, 2) fwd(Args args) {
    extern __shared__ __attribute__((aligned(16))) unsigned char lds_raw[];
    LAS char* lds = (LAS char*)lds_raw;
    unsigned char* const ws = args.ws;
    const int lo = args.ph_lo, hi_ph = args.ph_hi;
    const int wave_s_ = __builtin_amdgcn_readfirstlane(threadIdx.x >> 6);
    if (threadIdx.x < 18) {
        const uint64_t v = threadIdx.x < 16 ? (uint64_t)args.in[threadIdx.x] : (threadIdx.x == 16 ? (uint64_t)args.out : (uint64_t)args.ws);
        ((LAS uint64_t*)(lds + LDS_CTX))[threadIdx.x] = v;
    }
    __syncthreads();
#define IN(k) (lo <= (k) && (k) < hi_ph)

#if MK_ONE_LAUNCH
    if (threadIdx.x < 4) ((LAS unsigned*)(lds + LDS_BAR))[threadIdx.x] = 0u;
    __syncthreads();
    XcdBarrier bar = xcd_barrier_post((unsigned*)(ws + WS_CTL), (volatile LAS unsigned*)(lds + LDS_BAR), wave_s_ == 0 && lane_id_() == 0);
#define GRID_BAR() xcd_barrier(bar, wave_s_ == 0 && lane_id_() == 0)
#else
#define GRID_BAR() do { } while (0)
#endif
#define SEAM(k) do { if (IN(k) && IN((k) + 1)) GRID_BAR(); } while (0)

    for (int rep_ = 0; rep_ < ((IN(0) && PHK(0)) ? REPS(0) : 0); ++rep_) { ph_p0(0, rep_, wave_s_); }
    SEAM(0);

    for (int L = 0; L < 2; ++L) {
        const int pb = 1 + 10 * L;
        for (int rep_ = 0; rep_ < ((IN(pb + 0) && PHK(1)) ? REPS(1) : 0); ++rep_) { ph_qkv(L, rep_, wave_s_); }
        SEAM(pb + 0);

        if (L == 0) {
            for (int rep_ = 0; rep_ < ((IN(pb + 1) && PHK(2)) ? REPS(2) : 0); ++rep_) { ph_kmean(L, rep_, wave_s_); }
            SEAM(pb + 1);
            for (int rep_ = 0; rep_ < ((IN(pb + 2) && PHK(11)) ? REPS(11) : 0); ++rep_) { ph_gate(L, rep_, wave_s_); }
            SEAM(pb + 2);
        }

        if (L == 0) {
            for (int rep_ = 0; rep_ < ((IN(pb + 3) && PHK(3)) ? REPS(3) : 0); ++rep_) { ph_moba(L, rep_, wave_s_); }
            SEAM(pb + 3);
            for (int rep_ = 0; rep_ < ((IN(pb + 4) && PHK(12)) ? REPS(12) : 0); ++rep_) { ph_mobamerge(L, rep_, wave_s_); }
        } else {
            for (int rep_ = 0; rep_ < ((IN(pb + 3) && PHK(4)) ? REPS(4) : 0); ++rep_) { ph_dil(L, rep_, wave_s_); }
            SEAM(pb + 3);
            for (int rep_ = 0; rep_ < ((IN(pb + 4) && PHK(5)) ? REPS(5) : 0); ++rep_) { ph_merge(L, rep_, wave_s_); }
        }
        SEAM(pb + 4);

        for (int rep_ = 0; rep_ < ((IN(pb + 5) && PHK(6)) ? REPS(6) : 0); ++rep_) { ph_wo(L, rep_, wave_s_); }
        SEAM(pb + 5);

        for (int rep_ = 0; rep_ < ((IN(pb + 6) && PHK(7)) ? REPS(7) : 0); ++rep_) { ph_router(L, rep_, wave_s_); }
        SEAM(pb + 6);

        for (int rep_ = 0; rep_ < ((IN(pb + 7) && PHK(8)) ? REPS(8) : 0); ++rep_) { ph_gateup(L, rep_, wave_s_); }
        SEAM(pb + 7);

        for (int rep_ = 0; rep_ < ((IN(pb + 8) && PHK(9)) ? REPS(9) : 0); ++rep_) { ph_down(L, rep_, wave_s_); }
        SEAM(pb + 8);

        for (int rep_ = 0; rep_ < ((IN(pb + 9) && PHK(10)) ? REPS(10) : 0); ++rep_) { ph_combine(L, rep_, wave_s_); }
        if (L == 0) SEAM(pb + 9);
    }
}

extern "C" void kernel_launch(void* const* d_in, const int* in_sizes, int n_in, void* d_out, int out_size, void* d_ws, size_t ws_size, hipStream_t stream) {
    static int grid = 0;
    if (grid == 0) {
        if (n_in != 16 || out_size != T * D || ws_size < WS_END2) { fprintf(stderr, "kernel_launch: unexpected problem (n_in %d out %d ws %zu need %zu)\n", n_in, out_size, ws_size, (size_t)WS_END2); grid = -1; return; }
        int dev = 0, cus = 0, per_cu = 0;
        if (hipGetDevice(&dev) != hipSuccess || hipDeviceGetAttribute(&cus, hipDeviceAttributeMultiprocessorCount, dev) != hipSuccess) { grid = -1; return; }
        if (hipFuncSetAttribute((const void*)fwd, hipFuncAttributeMaxDynamicSharedMemorySize, LDS_BYTES) != hipSuccess) { fprintf(stderr, "kernel_launch: hipFuncSetAttribute failed\n"); grid = -1; return; }
        if (hipOccupancyMaxActiveBlocksPerMultiprocessor(&per_cu, (const void*)fwd, NTHR, LDS_BYTES) != hipSuccess || per_cu < 1) { fprintf(stderr, "kernel_launch: occupancy query says %d\n", per_cu); (void)hipGetLastError(); per_cu = 1; }
        grid = cus;
    }
    if (grid < 0) return;
    (void)hipMemsetAsync((char*)d_ws + WS_CTL, 0, CTL_BYTES, stream);
    Args a{};
    for (int i = 0; i < 16; ++i) a.in[i] = (const float*)d_in[i];
    a.out = (float*)d_out; a.ws = (unsigned char*)d_ws;
#if MK_ONE_LAUNCH
    a.ph_lo = 0; a.ph_hi = N_PHASES;
    hipLaunchKernelGGL(fwd, dim3(grid), dim3(NTHR), LDS_BYTES, stream, a);
#else
    for (int ph = 0; ph < N_PHASES; ++ph) {
        if (ph == 12 || ph == 13) continue;
        a.ph_lo = ph; a.ph_hi = ph + 1;
        hipLaunchKernelGGL(fwd, dim3(grid), dim3(NTHR), LDS_BYTES, stream, a);
    }
#endif
}
```

```cpp
#include <hip/hip_runtime.h>
#include <hip/hip_bf16.h>
#include <stdint.h>
#include <stdio.h>

#ifndef MK_ONE_LAUNCH
#define MK_ONE_LAUNCH 1
#endif

#ifndef PHMASK
#define PHMASK 0x1FFF
#endif
#define PHK(k) ((PHMASK >> (k)) & 1)
#ifndef REPEAT_KIND
#define REPEAT_KIND -1
#endif
#define REPS(k) ((k) == REPEAT_KIND ? 2 : 1)
#define LAS __attribute__((address_space(3)))
typedef __attribute__((ext_vector_type(8))) short bf16x8;
typedef __attribute__((ext_vector_type(16))) float f32x16;
typedef __attribute__((ext_vector_type(4))) float f32x4;
typedef __attribute__((ext_vector_type(4))) unsigned u32x4;
typedef __attribute__((ext_vector_type(2))) unsigned u32x2;
typedef unsigned short u16;

constexpr int D = 1024, BATCH = 2, SEQ = 8192, T = BATCH * SEQ, NH = 16, HD = 64;
constexpr int NE = 256, TOPK = 8, DF = 256;
constexpr int A_TOT = T * TOPK;
constexpr int MOBA_BLK = 256, MOBA_NB = SEQ / MOBA_BLK;
constexpr float DN_ALPHA = 1.4142135623730951f;
constexpr float LN_EPS = 1e-5f;
constexpr float LOG2E = 1.4426950408889634f;
constexpr float LN2 = 0.6931471805599453f;
constexpr float NEGV = -1e30f;
constexpr int NTHR = 512;

constexpr size_t al256(size_t x) { return (x + 255) & ~(size_t)255; }
constexpr size_t WS_CTL = 0;
constexpr size_t CTL_BYTES = 65536;
constexpr size_t CTL_CNT_OFF = 32768;
constexpr size_t WS_XB = WS_CTL + CTL_BYTES;
constexpr size_t WS_X1 = WS_XB + al256((size_t)T * D * 2);
constexpr size_t WS_X2 = WS_X1 + al256((size_t)T * D * 4);
constexpr size_t WS_YPRE = WS_X2 + al256((size_t)T * D * 4);
constexpr size_t WS_QKV = WS_YPRE + al256((size_t)T * D * 4);
constexpr size_t WS_VT = WS_QKV + al256((size_t)T * 9216 * 2);
constexpr size_t WS_KM = WS_VT + al256((size_t)3 * T * D * 2);
constexpr size_t WS_AO = WS_KM + al256((size_t)BATCH * NH * MOBA_NB * HD * 4);
constexpr size_t WS_OG = WS_AO + al256((size_t)T * D * 2);
constexpr size_t WS_LSE = WS_OG + al256((size_t)3 * T * D * 2);
constexpr size_t WS_TOPW = WS_LSE + al256((size_t)3 * T * NH * 4);
constexpr size_t WS_LIST = WS_TOPW + al256((size_t)T * TOPK * 4);
constexpr size_t WS_HB = WS_LIST + al256((size_t)NE * T * 4);
constexpr size_t WS_YB = WS_HB + al256((size_t)(A_TOT + T + 1) * DF * 2);
constexpr size_t WS_END = WS_YB + al256((size_t)(A_TOT + T + 1) * D * 2);
constexpr int TRASH_VA = A_TOT + T;
constexpr size_t WS_SELM = WS_END;
constexpr size_t WS_PART = WS_SELM + al256((size_t)T * NH * 4);
constexpr size_t WS_PLSE = WS_PART + al256((size_t)T * NH * 4 * 64 * 2);
constexpr size_t WS_WQK0 = WS_PLSE + al256((size_t)T * NH * 4 * 4);
constexpr size_t WS_WV0 = WS_WQK0 + (size_t)2048 * 1024 * 2;
constexpr size_t WS_WQK1 = WS_WV0 + (size_t)1024 * 1024 * 2;
constexpr size_t WS_WV1 = WS_WQK1 + (size_t)6144 * 1024 * 2;
constexpr size_t WS_WO = WS_WV1 + (size_t)3072 * 1024 * 2;
constexpr size_t WS_WSGU = WS_WO + (size_t)2 * 1024 * 1024 * 2;
constexpr size_t WS_WSD = WS_WSGU + (size_t)2 * 512 * 1024 * 2;
constexpr size_t WS_XB8 = WS_WSD + (size_t)2 * 1024 * 256 * 2;
constexpr size_t WS_HBS = WS_XB8 + (size_t)T * D;
constexpr size_t WS_WRH = WS_HBS + (size_t)T * DF * 2;
constexpr size_t WS_WRL = WS_WRH + (size_t)2 * 256 * 1024 * 2;
constexpr size_t WS_END2 = WS_WRL + (size_t)2 * 256 * 1024 * 2;

constexpr int LDP = 40;
constexpr int STAGE_BYTES = 2 * 256 * LDP * 2;
constexpr int LDS_ROWID = 2 * STAGE_BYTES;
constexpr int LDS_ROWW = LDS_ROWID + 1024;
constexpr int XS_PITCH = 1028;
constexpr int LDS_BYTES = 163840;
constexpr int LDS_BAR = 161792;

__device__ __forceinline__ int lane_id_() { int l; asm volatile("v_mbcnt_lo_u32_b32 %0, -1, 0\n\tv_mbcnt_hi_u32_b32 %0, -1, %0" : "=v"(l)); return l; }
__device__ __forceinline__ float shxf(float v, int m, int lane) { return __int_as_float(__builtin_amdgcn_ds_bpermute((lane ^ m) << 2, __float_as_int(v))); }
__device__ __forceinline__ int shxi(int v, int m, int lane) { return __builtin_amdgcn_ds_bpermute((lane ^ m) << 2, v); }
#define XB_TMO      128
#define XB_XCNT(j)  (256  + 64 * (j))
#define XB_XSUB(j)  (1280 + 64 * (j))
#define XB_XGEN(j)  (2304 + 64 * (j))
#define XB_TOP      3328
#define XB_TOPGEN   3392
#define XCD_BAR_WORDS 3456
#define XB_SPIN_CAP (1u << 18)
__device__ __forceinline__ unsigned xb_ld(unsigned* p)              { return __hip_atomic_load(p, __ATOMIC_RELAXED, __HIP_MEMORY_SCOPE_AGENT); }
__device__ __forceinline__ unsigned xb_add(unsigned* p, unsigned v) { return __hip_atomic_fetch_add(p, v, __ATOMIC_RELAXED, __HIP_MEMORY_SCOPE_AGENT); }
__device__ __forceinline__ unsigned xb_xcc_id() { return (unsigned)__builtin_amdgcn_s_getreg((3 << 11) | 20) & 0xFu; }
#define XB_SPIN(cond, bar) do { unsigned _sp = 0; while (cond) { __builtin_amdgcn_s_sleep(1); \
    if ((++_sp & 255u) == 0u) { if (xb_ld(&(bar)[XB_TMO])) break; if (_sp > XB_SPIN_CAP) { atomicAdd(&(bar)[XB_TMO], 1u); break; } } } } while (0)
struct XcdBarrier { unsigned* bar; unsigned x; volatile LAS unsigned* st; };
__device__ __forceinline__ XcdBarrier xcd_barrier_post(unsigned* bar, volatile LAS unsigned* st, const bool leader) {
    XcdBarrier b; b.bar = bar; b.x = xb_xcc_id(); b.st = st;
    if (leader) (void)xb_add(&bar[XB_XCNT(b.x)], 1u);
    return b;
}
__device__ __forceinline__ void xcd_barrier_complete(unsigned* bar, unsigned x, unsigned& nloc, unsigned& nx) {
    const unsigned G = gridDim.x * gridDim.y * gridDim.z;
    unsigned sum, cnt, mine, sp = 0u;
    for (;;) {
        sum = 0u; cnt = 0u; mine = 0u;
#pragma unroll
        for (unsigned j = 0; j < 16; ++j) { const unsigned c = xb_ld(&bar[XB_XCNT(j)]); sum += c; cnt += (c > 0u) ? 1u : 0u; mine = (j == x) ? c : mine; }
        if (sum == G) break;
        __builtin_amdgcn_s_sleep(1);
        if ((++sp & 255u) == 0u) { if (xb_ld(&bar[XB_TMO])) break; if (sp > XB_SPIN_CAP) { atomicAdd(&bar[XB_TMO], 1u); break; } }
    }
    nloc = mine > 0u ? mine : 1u; nx = cnt > 0u ? cnt : 1u;
}
__device__ __forceinline__ void xcd_barrier(const XcdBarrier& b, const bool leader) {
    asm volatile("s_waitcnt vmcnt(0)" ::: "memory");
    __syncthreads();
    if (leader) {
        unsigned* bar = b.bar;
        __builtin_amdgcn_s_waitcnt(0);
        unsigned nloc = b.st[0], nx = b.st[1];
        if (nloc == 0u) { xcd_barrier_complete(bar, b.x, nloc, nx); b.st[0] = nloc; b.st[1] = nx; }
        const unsigned old = xb_add(&bar[XB_XSUB(b.x)], 1u);
        const unsigned gen = old / nloc;
        if (old + 1u == (gen + 1u) * nloc) {
            __builtin_amdgcn_fence(__ATOMIC_RELEASE, "agent");
            asm volatile("s_waitcnt vmcnt(0)" ::: "memory");
            const unsigned og = xb_add(&bar[XB_TOP], 1u);
            const unsigned tg = og / nx;
            if (og + 1u == (tg + 1u) * nx) xb_add(&bar[XB_TOPGEN], 1u);
            else XB_SPIN(xb_ld(&bar[XB_TOPGEN]) == tg, bar);
            __builtin_amdgcn_fence(__ATOMIC_ACQUIRE, "agent");
            xb_add(&bar[XB_XGEN(b.x)], 1u);
            asm volatile("s_waitcnt vmcnt(0)" ::: "memory");
        } else {
            XB_SPIN(xb_ld(&bar[XB_XGEN(b.x)]) == gen, bar);
            __builtin_amdgcn_fence(__ATOMIC_ACQUIRE, "agent");
            asm volatile("s_waitcnt vmcnt(0)" ::: "memory");
        }
    }
    __syncthreads();
}

typedef __attribute__((ext_vector_type(2))) __bf16 bf16x2_t;
typedef __attribute__((ext_vector_type(2))) float f32x2_t;
__device__ __forceinline__ unsigned cvtpk(float lo, float hi) { f32x2_t f; f[0] = lo; f[1] = hi; return __builtin_bit_cast(unsigned, __builtin_convertvector(f, bf16x2_t)); }
__device__ __forceinline__ float bf2f(unsigned v16) { return __uint_as_float(v16 << 16); }
__device__ __forceinline__ int crow(int r, int hi) { return (r & 3) + 8 * (r >> 2) + 4 * hi; }
#define MFMA_BF16(a, b, c) __builtin_amdgcn_mfma_f32_32x32x16_bf16(a, b, c, 0, 0, 0)
__device__ __forceinline__ float wave_sum(float v) {
    v += __int_as_float(__builtin_amdgcn_update_dpp(0, __float_as_int(v), 0xB1, 0xF, 0xF, true));
    v += __int_as_float(__builtin_amdgcn_update_dpp(0, __float_as_int(v), 0x4E, 0xF, 0xF, true));
    v += __int_as_float(__builtin_amdgcn_update_dpp(0, __float_as_int(v), 0x141, 0xF, 0xF, true));
    v += __int_as_float(__builtin_amdgcn_update_dpp(0, __float_as_int(v), 0x140, 0xF, 0xF, true));
    const int vi = __float_as_int(v);
    return (__int_as_float(__builtin_amdgcn_readlane(vi, 0)) + __int_as_float(__builtin_amdgcn_readlane(vi, 16))) + (__int_as_float(__builtin_amdgcn_readlane(vi, 32)) + __int_as_float(__builtin_amdgcn_readlane(vi, 48)));
}

namespace pg8 {
#define PG8_LAS __attribute__((address_space(3)))
typedef unsigned short bf16_t;
typedef short bf16x8 __attribute__((ext_vector_type(8)));
typedef float f32x4 __attribute__((ext_vector_type(4)));
typedef unsigned u32x4 __attribute__((ext_vector_type(4)));
constexpr int BM = 256, BK = 64, HALF = 128, HTB = HALF * BK * 2  , STAGE_BYTES = 8 * HTB, NXCD = 8, WGM = 8;

__host__ __device__ __forceinline__ int lds_byte(int r, int c) { const int st = (r >> 4) * 2 + (c >> 5), rr = r & 15, cc = c & 31, ob = rr * 64 + cc * 2; return st * 1024 + (ob ^ (((ob >> 9) & 1) << 5)); }
__host__ __device__ __forceinline__ void stage_rc(int b, int& R, int& C) { const int st = b / 1024, sb = b % 1024, swz = sb ^ (((sb >> 9) & 1) << 5); R = (st >> 1) * 16 + swz / 64; C = (st & 1) * 32 + (swz % 64) / 2; }
__host__ __device__ __forceinline__ int perm32(int rho) { const int n = rho >> 4, i = rho & 15; return 8 * (i >> 2) + 4 * n + (i & 3); }

struct Unit { int pm, pn; };
struct Gemm { const bf16_t* A; const bf16_t* Bt; int M, N, K; };
struct FixedOrder {
    int pm, pn;
    __device__ __forceinline__ bool next(int i, Unit& u) const { if (i != 0) return false; u.pm = pm; u.pn = pn; return true; }
    __device__ __forceinline__ void a_ready(const Unit&) const {}
    __device__ __forceinline__ void done(const Unit&) const {}
};

struct StaticOrder {
    int nM, nN, nwg, G, c;
    __host__ __device__ void init(int M, int N, int G_, int c_) { nM = M / BM; nN = N / BM; nwg = nM * nN; G = G_; c = c_; }
    __host__ __device__ bool next(int i, Unit& u) const {
        const long L = (long)i * G + c; if (L >= nwg) return false;
        int wgid = (int)L; { const int q = nwg / NXCD, r = nwg % NXCD, xcd = wgid % NXCD, off = wgid / NXCD; wgid = (xcd < r ? xcd * (q + 1) : r * (q + 1) + (xcd - r) * q) + off; }
        const int nig = WGM * nN, gid = wgid / nig, fm = gid * WGM, gsz = (nM - fm) < WGM ? (nM - fm) : WGM;
        u.pm = fm + ((wgid % nig) % gsz); u.pn = (wgid % nig) / gsz; return true;
    }
    __device__ __forceinline__ void a_ready(const Unit&) const {}
    __device__ __forceinline__ void done(const Unit&) const {}
};

template <class Epi, class Sched, bool SWAP = false, bool STAMP = false>
__device__ __forceinline__ void gemm_phase(PG8_LAS unsigned char* lds, const Gemm g, const Sched& S, const Epi& E, unsigned long long* stamps, const int tid_in) {
    int tid_ = tid_in; asm volatile("" : "+v"(tid_));
    const int tid = tid_, wid = __builtin_amdgcn_readfirstlane(tid >> 6), lane = tid & 63, wr = wid >> 2, wc = wid & 3, fr = lane & 15, fq = lane >> 4;
    const int K = g.K, nt = K / BK;
    int ts_lo = 0, ts_hi = 0, nts = 0; const unsigned long long rt_entry = STAMP ? (unsigned long long)wall_clock64() : 0ull;
#define PG8_STAMP() do { if (STAMP && wid == 0 && nts < 64) { const unsigned long long _c = (unsigned long long)clock64(); \
        ts_lo = (lane == nts) ? (int)(unsigned)_c : ts_lo; ts_hi = (lane == nts) ? (int)(unsigned)(_c >> 32) : ts_hi; ++nts; } } while (0)
    PG8_STAMP();
    unsigned voffA[2], voffB[2];
#pragma unroll
    for (int i = 0; i < 2; ++i) { int R, C; stage_rc(tid * 16 + i * 8192, R, C); const int Rb = Epi::PERM ? ((R & ~31) + perm32(R & 31)) : R;
        voffA[i] = (unsigned)(R * K + C) * 2u; voffB[i] = (unsigned)(Rb * K + C) * 2u; }
    const size_t kstep = (size_t)(BK * 2);
    const size_t hstep = (size_t)HALF * K * 2;
    const size_t tstep = 2 * hstep;
    const unsigned ldsw = (unsigned)wid * 1024u;
    const int aoff = lds_byte(wr * 64 + fr, fq * 8), boff = lds_byte(wc * 32 + fr, fq * 8);
#define PG8_SA(b, h) (((b) * 2 + (h)) * HTB)
#define PG8_SB(b, h) ((4 + (b) * 2 + (h)) * HTB)
#define PG8_STAGE(bufoff, gbase, voff) do { _Pragma("unroll") for (int _i = 0; _i < 2; ++_i) \
        __builtin_amdgcn_global_load_lds((const unsigned*)((const char*)(gbase) + (voff)[_i]), (PG8_LAS unsigned*)(lds + (bufoff) + ldsw + _i * 8192), 16, 0, 0); } while (0)
#define PG8_LDA(dst, b, h) do { _Pragma("unroll") for (int m = 0; m < 4; ++m) _Pragma("unroll") for (int k = 0; k < 2; ++k) dst[m][k] = *(const PG8_LAS bf16x8*)(lds + PG8_SA(b, h) + aoff + m * 2048 + k * 1024); } while (0)
#define PG8_LDB(dst, b, h) do { _Pragma("unroll") for (int n = 0; n < 2; ++n) _Pragma("unroll") for (int k = 0; k < 2; ++k) dst[n][k] = *(const PG8_LAS bf16x8*)(lds + PG8_SB(b, h) + boff + n * 2048 + k * 1024); } while (0)
#define PG8_MMA(ai, bj, At, Bt) do { __builtin_amdgcn_s_setprio(1); _Pragma("unroll") for (int m = 0; m < 4; ++m) _Pragma("unroll") for (int n = 0; n < 2; ++n) _Pragma("unroll") for (int k = 0; k < 2; ++k) \
        acc[ai][bj][m][n] = SWAP ? __builtin_amdgcn_mfma_f32_16x16x32_bf16(At[m][k], Bt[n][k], acc[ai][bj][m][n], 0, 0, 0) : __builtin_amdgcn_mfma_f32_16x16x32_bf16(Bt[n][k], At[m][k], acc[ai][bj][m][n], 0, 0, 0); __builtin_amdgcn_s_setprio(0); } while (0)
#define PG8_WAIT_V(n) asm volatile("s_waitcnt vmcnt(" #n ")" ::: "memory")
#define PG8_WAIT_L(n) asm volatile("s_waitcnt lgkmcnt(" #n ")" ::: "memory")
#define PG8_BAR __builtin_amdgcn_s_barrier()
#define PG8_SCHED __builtin_amdgcn_sched_barrier(0)
    Unit cur, nxt; int ui = 0;
    if (!S.next(0, cur)) return;
    f32x4 acc[2][2][4][2];
#pragma unroll
    for (int a = 0; a < 2; ++a)
#pragma unroll
        for (int b = 0; b < 2; ++b)
#pragma unroll
            for (int m = 0; m < 4; ++m)
#pragma unroll
                for (int n = 0; n < 2; ++n) acc[a][b][m][n] = (f32x4){0.f, 0.f, 0.f, 0.f};
    bf16x8 At[4][2], B0[2][2], B1[2][2];
    const char* cA = (const char*)g.A + (size_t)cur.pm * tstep; const char* cB = (const char*)g.Bt + (size_t)cur.pn * tstep;
    S.a_ready(cur);
    PG8_STAGE(PG8_SB(0, 0), cB, voffB); PG8_STAGE(PG8_SA(0, 0), cA, voffA); PG8_STAGE(PG8_SB(0, 1), cB + hstep, voffB); PG8_STAGE(PG8_SA(0, 1), cA + hstep, voffA);
    if (wr == 1) PG8_BAR;
    PG8_WAIT_V(4); PG8_BAR;
    PG8_STAGE(PG8_SB(1, 0), cB + kstep, voffB); PG8_STAGE(PG8_SA(1, 0), cA + kstep, voffA); PG8_STAGE(PG8_SB(1, 1), cB + hstep + kstep, voffB);
    PG8_WAIT_V(6); PG8_BAR;
    PG8_STAMP();
    for (;;) {
        const bool has_next = S.next(ui + 1, nxt);
        const char* nA = has_next ? (const char*)g.A + (size_t)nxt.pm * tstep : cA; const char* nB = has_next ? (const char*)g.Bt + (size_t)nxt.pn * tstep : cB;
        for (int t = 0; t < nt; t += 2) {
            const bool last = (t == nt - 2);
            const char* a1 = cA + (size_t)(t + 1) * kstep;
            const char* a2 = last ? nA : cA + (size_t)(t + 2) * kstep; const char* b2 = last ? nB : cB + (size_t)(t + 2) * kstep;
            const char* a3 = a2 + kstep; const char* b3 = b2 + kstep;
            if (last && has_next) S.a_ready(nxt);
            PG8_LDB(B0, 0, 0); PG8_SCHED; PG8_LDA(At, 0, 0); PG8_STAGE(PG8_SA(1, 1), a1 + hstep, voffA);
            PG8_WAIT_L(8); PG8_BAR; PG8_WAIT_L(0); PG8_MMA(0, 0, At, B0); PG8_BAR; PG8_SCHED;
            PG8_LDB(B1, 0, 1); PG8_STAGE(PG8_SB(0, 0), b2, voffB);
            PG8_BAR; PG8_WAIT_L(0); PG8_MMA(0, 1, At, B1); PG8_BAR;
            PG8_LDA(At, 0, 1); PG8_STAGE(PG8_SA(0, 0), a2, voffA);
            PG8_BAR; PG8_WAIT_L(0); PG8_MMA(1, 0, At, B0); PG8_BAR; PG8_SCHED;
            PG8_STAGE(PG8_SB(0, 1), b2 + hstep, voffB);
            PG8_WAIT_V(6); PG8_BAR; PG8_MMA(1, 1, At, B1); PG8_BAR;
            PG8_LDB(B0, 1, 0); PG8_SCHED; PG8_LDA(At, 1, 0); PG8_STAGE(PG8_SA(0, 1), a2 + hstep, voffA);
            PG8_WAIT_L(8); PG8_BAR; PG8_WAIT_L(0); PG8_MMA(0, 0, At, B0); PG8_BAR; PG8_SCHED;
            PG8_LDB(B1, 1, 1); PG8_STAGE(PG8_SB(1, 0), b3, voffB);
            PG8_BAR; PG8_WAIT_L(0); PG8_MMA(0, 1, At, B1); PG8_BAR;
            PG8_LDA(At, 1, 1); PG8_STAGE(PG8_SA(1, 0), a3, voffA);
            PG8_BAR; PG8_WAIT_L(0); PG8_MMA(1, 0, At, B0); PG8_BAR; PG8_SCHED;
            PG8_STAGE(PG8_SB(1, 1), b3 + hstep, voffB);
            PG8_WAIT_V(6); PG8_BAR; PG8_MMA(1, 1, At, B1); PG8_BAR;
        }
        PG8_STAMP();
        if constexpr (!Epi::AFTER_DRAIN) { E(acc, cur, wr, wc, fr, fq); S.done(cur); }
        PG8_STAMP();
        if (!has_next) break;
#pragma unroll
        for (int a = 0; a < 2; ++a)
#pragma unroll
            for (int b = 0; b < 2; ++b)
#pragma unroll
                for (int m = 0; m < 4; ++m)
#pragma unroll
                    for (int n = 0; n < 2; ++n) acc[a][b][m][n] = (f32x4){0.f, 0.f, 0.f, 0.f};
        cur = nxt; cA = nA; cB = nB; ++ui;
    }
    PG8_WAIT_V(0);
    if (wr == 0) PG8_BAR;
    PG8_BAR;
    if constexpr (Epi::AFTER_DRAIN) { E.fused(acc, cur, wr, wc, fr, fq, lds, wid, lane); S.done(cur); }
    PG8_STAMP();
    if (STAMP && wid == 0) { stamps[lane] = lane < nts ? (((unsigned long long)(unsigned)ts_hi << 32) | (unsigned)ts_lo) : 0ull;
        if (lane == 62) stamps[62] = rt_entry; if (lane == 63) stamps[63] = (unsigned long long)wall_clock64(); }
#undef PG8_STAMP
#undef PG8_SA
#undef PG8_SB
#undef PG8_STAGE
#undef PG8_LDA
#undef PG8_LDB
#undef PG8_MMA
#undef PG8_WAIT_V
#undef PG8_WAIT_L
#undef PG8_BAR
#undef PG8_SCHED
}
}

struct EpiQK {
    static constexpr bool PERM = true, AFTER_DRAIN = false;
    u16* O; int ldc;
    __device__ __forceinline__ void operator()(const pg8::f32x4 (&acc)[2][2][4][2], const pg8::Unit& u, int wr, int wc, int fr, int fq) const {
        const int col0 = u.pn * 256 + wc * 32 + 8 * fq, row0 = u.pm * 256 + wr * 64 + fr;
#pragma unroll
        for (int ai = 0; ai < 2; ++ai)
#pragma unroll
            for (int m = 0; m < 4; ++m) { u16* rowp = O + (size_t)(row0 + ai * 128 + m * 16) * ldc + col0;
#pragma unroll
                for (int bj = 0; bj < 2; ++bj) { const pg8::f32x4 v0 = acc[ai][bj][m][0], v1 = acc[ai][bj][m][1];
                    u32x4 w; w[0] = cvtpk(v0[0], v0[1]); w[1] = cvtpk(v0[2], v0[3]); w[2] = cvtpk(v1[0], v1[1]); w[3] = cvtpk(v1[2], v1[3]);
                    *(u32x4*)(rowp + bj * 128) = w; } }
    }
};
struct EpiV {
    static constexpr bool PERM = false, AFTER_DRAIN = false;
    u16* VT; int layer;
    __device__ __forceinline__ void operator()(const pg8::f32x4 (&acc)[2][2][4][2], const pg8::Unit& u, int wr, int wc, int fr, int fq) const {
        const int colt = u.pn * 256, grp = colt >> 10;
        const int dil = (layer == 0 || grp == 0) ? 1 : (grp == 1 ? 4 : 16);
        const int rowb = u.pm * 256 + wr * 64 + 4 * fq;
#pragma unroll
        for (int bj = 0; bj < 2; ++bj)
#pragma unroll
            for (int n = 0; n < 2; ++n) {
                const int c = (colt & 1023) + bj * 128 + wc * 32 + n * 16 + fr, h = c >> 6, d = c & 63;
#pragma unroll
                for (int ai = 0; ai < 2; ++ai)
#pragma unroll
                    for (int m = 0; m < 4; ++m) {
                        const int r0 = rowb + ai * 128 + m * 16, b = r0 >> 13, t0 = r0 & (SEQ - 1);
                        u16* vrow = VT + (size_t)grp * T * D + ((size_t)(b * NH + h) * HD + d) * SEQ;
                        const pg8::f32x4 v = acc[ai][bj][m][n];
                        if (dil == 1) { u32x2 w; w[0] = cvtpk(v[0], v[1]); w[1] = cvtpk(v[2], v[3]); *(u32x2*)(vrow + t0) = w; }
                        else {
#pragma unroll
                            for (int i = 0; i < 4; ++i) { const int pp = t0 + i; vrow[(pp % dil) * (SEQ / dil) + pp / dil] = (u16)cvtpk(v[i], 0.f); }
                        }
                    }
            }
    }
};
struct EpiWo {
    static constexpr bool PERM = false, AFTER_DRAIN = false;
    float* Y; const float* X;
    __device__ __forceinline__ void operator()(const pg8::f32x4 (&acc)[2][2][4][2], const pg8::Unit& u, int wr, int wc, int fr, int fq) const {
        const int row0 = u.pm * 256 + wr * 64 + fr, col0 = u.pn * 256 + wc * 32 + 4 * fq;
#pragma unroll
        for (int ai = 0; ai < 2; ++ai)
#pragma unroll
            for (int m = 0; m < 4; ++m) { const size_t ro = (size_t)(row0 + ai * 128 + m * 16) * D + col0;
#pragma unroll
                for (int bj = 0; bj < 2; ++bj)
#pragma unroll
                    for (int n = 0; n < 2; ++n) { const pg8::f32x4 x = *(const pg8::f32x4*)(X + ro + bj * 128 + n * 16); *(pg8::f32x4*)(Y + ro + bj * 128 + n * 16) = x * DN_ALPHA + acc[ai][bj][m][n]; } }
    }
};
struct EpiSGU {
    static constexpr bool PERM = true, AFTER_DRAIN = false;
    u16* H;
    __device__ __forceinline__ void operator()(const pg8::f32x4 (&acc)[2][2][4][2], const pg8::Unit& u, int wr, int wc, int fr, int fq) const {
        const int row0 = u.pm * 256 + wr * 64 + fr, f0 = u.pn * 128 + wc * 32 + 8 * fq;
#pragma unroll
        for (int ai = 0; ai < 2; ++ai)
#pragma unroll
            for (int m = 0; m < 4; ++m) {
                float hv[8];
#pragma unroll
                for (int n = 0; n < 2; ++n)
#pragma unroll
                    for (int i = 0; i < 4; ++i) { const float gt = acc[ai][0][m][n][i], up = acc[ai][1][m][n][i]; hv[n * 4 + i] = gt / (1.f + __expf(-gt)) * up; }
                u32x4 w; w[0] = cvtpk(hv[0], hv[1]); w[1] = cvtpk(hv[2], hv[3]); w[2] = cvtpk(hv[4], hv[5]); w[3] = cvtpk(hv[6], hv[7]);
                *(u32x4*)(H + (size_t)(row0 + ai * 128 + m * 16) * DF + f0) = w;
            }
    }
};
struct EpiSD {
    static constexpr bool PERM = true, AFTER_DRAIN = false;
    u16* Y;
    __device__ __forceinline__ void operator()(const pg8::f32x4 (&acc)[2][2][4][2], const pg8::Unit& u, int wr, int wc, int fr, int fq) const {
        const int row0 = u.pm * 256 + wr * 64 + fr, col0 = u.pn * 256 + wc * 32 + 8 * fq;
#pragma unroll
        for (int ai = 0; ai < 2; ++ai)
#pragma unroll
            for (int m = 0; m < 4; ++m) { u16* rowp = Y + (size_t)(A_TOT + row0 + ai * 128 + m * 16) * D + col0;
#pragma unroll
                for (int bj = 0; bj < 2; ++bj) { const pg8::f32x4 v0 = acc[ai][bj][m][0], v1 = acc[ai][bj][m][1];
                    u32x4 w; w[0] = cvtpk(v0[0], v0[1]); w[1] = cvtpk(v0[2], v0[3]); w[2] = cvtpk(v1[0], v1[1]); w[3] = cvtpk(v1[2], v1[3]);
                    *(u32x4*)(rowp + bj * 128) = w; } }
    }
};

struct Args {
    const float* in[16];
    float* out;
    unsigned char* ws;
    int ph_lo, ph_hi;
};

#define GEMM_CORE(K_, PA0, PA1, PB, LDB)                                                                                                   \
    {                                                                                                                                      \
        const int g_tid = tid, g_lane = lane, g_wave = wave, g_r32 = r32, g_hi = hi;                   \
        const int g_wm = g_wave >> 2, g_wn = g_wave & 3, g_kc = g_tid & 3, g_kq = g_lane >> 3, g_n4 = g_lane & 7;                           \
        const u16* g_pa0 = (PA0); const u16* g_pa1 = (PA1);                                                                                \
        const size_t g_ldb = (size_t)(LDB);                                                                                                \
        const float* g_pb = (PB) + (size_t)(g_kq * 4) * g_ldb + g_n4 * 4;                                                                  \
        const int g_nk = (K_) / 32;                                                                                                        \
        u32x4 g_ra0, g_ra1; f32x4 g_rb0, g_rb1, g_rb2, g_rb3;                                                                              \
        const u32x4 g_z = {0u, 0u, 0u, 0u};                                                                                                \
        _Pragma("unroll") for (int mb = 0; mb < 4; ++mb) { _Pragma("unroll") for (int nb = 0; nb < 2; ++nb) { _Pragma("unroll") for (int r = 0; r < 16; ++r) acc[mb][nb][r] = 0.f; } } \
        g_ra0 = g_pa0 ? *(const u32x4*)(g_pa0 + g_kc * 8) : g_z; g_ra1 = g_pa1 ? *(const u32x4*)(g_pa1 + g_kc * 8) : g_z;                 \
        g_rb0 = *(const f32x4*)(g_pb); g_rb1 = *(const f32x4*)(g_pb + g_ldb); g_rb2 = *(const f32x4*)(g_pb + 2 * g_ldb); g_rb3 = *(const f32x4*)(g_pb + 3 * g_ldb); \
        _Pragma("unroll 1") for (int kt = 0; kt < g_nk; ++kt) {                                                                            \
            LAS char* As = lds + (kt & 1) * STAGE_BYTES; LAS char* Bs = As + 256 * LDP * 2;                                                \
            *(LAS u32x4*)(As + ((g_tid >> 2) * LDP + g_kc * 8) * 2) = g_ra0;                                                               \
            *(LAS u32x4*)(As + (((g_tid >> 2) + 128) * LDP + g_kc * 8) * 2) = g_ra1;                                                       \
            _Pragma("unroll") for (int i = 0; i < 4; ++i) {                                                                                \
                u32x2 w; w[0] = cvtpk(g_rb0[i], g_rb1[i]); w[1] = cvtpk(g_rb2[i], g_rb3[i]);                                               \
                *(LAS u32x2*)(Bs + ((g_wave * 32 + i * 8 + g_n4) * LDP + g_kq * 4) * 2) = w;                                               \
            }                                                                                                                              \
            __syncthreads();                                                                                                               \
            if (kt + 1 < g_nk) {                                                                                                           \
                const int ko = (kt + 1) * 32;                                                                                              \
                g_ra0 = g_pa0 ? *(const u32x4*)(g_pa0 + ko + g_kc * 8) : g_z; g_ra1 = g_pa1 ? *(const u32x4*)(g_pa1 + ko + g_kc * 8) : g_z; \
                const float* pbk = g_pb + (size_t)ko * g_ldb;                                                                              \
                g_rb0 = *(const f32x4*)(pbk); g_rb1 = *(const f32x4*)(pbk + g_ldb); g_rb2 = *(const f32x4*)(pbk + 2 * g_ldb); g_rb3 = *(const f32x4*)(pbk + 3 * g_ldb); \
            }                                                                                                                              \
            _Pragma("unroll") for (int s = 0; s < 2; ++s) {                                                                                \
                bf16x8 af[4], bfr[2];                                                                                                      \
                _Pragma("unroll") for (int mb = 0; mb < 4; ++mb) af[mb] = *(LAS bf16x8*)(As + ((g_wm * 128 + mb * 32 + g_r32) * LDP + s * 16 + g_hi * 8) * 2); \
                _Pragma("unroll") for (int nb = 0; nb < 2; ++nb) bfr[nb] = *(LAS bf16x8*)(Bs + (((g_wn * 2 + nb) * 32 + g_r32) * LDP + s * 16 + g_hi * 8) * 2); \
                _Pragma("unroll") for (int mb = 0; mb < 4; ++mb) { _Pragma("unroll") for (int nb = 0; nb < 2; ++nb) acc[mb][nb] = MFMA_BF16(af[mb], bfr[nb], acc[mb][nb]); } \
            }                                                                                                                              \
        }                                                                                                                                  \
        __syncthreads();                                                                                                                   \
    }

struct AttnSt { float m, l; f32x16 o0, o1; };

struct AttnFr { bf16x8 k[4]; bf16x8 v[4]; };
__device__ __forceinline__ void attn_load(AttnFr& f, const u16* krow, const u16* vt, size_t vt_dstride) {
#pragma unroll
    for (int d0 = 0; d0 < 4; ++d0) f.k[d0] = *(const bf16x8*)(krow + d0 * 16);
    const u16* vt1 = vt + 32 * vt_dstride;
    union { bf16x8 v; u32x2 h[2]; } va;
    va.h[0] = *(const u32x2*)(vt);       va.h[1] = *(const u32x2*)(vt + 8);   f.v[0] = va.v;
    va.h[0] = *(const u32x2*)(vt + 16);  va.h[1] = *(const u32x2*)(vt + 24);  f.v[1] = va.v;
    va.h[0] = *(const u32x2*)(vt1);      va.h[1] = *(const u32x2*)(vt1 + 8);  f.v[2] = va.v;
    va.h[0] = *(const u32x2*)(vt1 + 16); va.h[1] = *(const u32x2*)(vt1 + 24); f.v[3] = va.v;
}
__device__ __forceinline__ void attn_compute(AttnSt& st, const bf16x8 (&qf)[4], const AttnFr& f, int dist0, float bslope, int dlo, int dhi, int hi, int lane) {
    f32x16 p;
#pragma unroll
    for (int r = 0; r < 16; ++r) p[r] = 0.f;
#pragma unroll
    for (int d0 = 0; d0 < 4; ++d0) p = MFMA_BF16(f.k[d0], qf[d0], p);
    constexpr float C2 = 0.125f * LOG2E;
    float mx = NEGV;
#pragma unroll
    for (int r = 0; r < 16; ++r) {
        const int dist = dist0 - ((r & 3) + 8 * (r >> 2));
        const float sc = __builtin_fmaf(p[r], C2, -bslope * (float)dist);
        const float s_ = (dist >= dlo && dist <= dhi) ? sc : NEGV;
        p[r] = s_; mx = fmaxf(mx, s_);
    }
    mx = fmaxf(mx, shxf(mx, 32, lane));
    const float mnew = fmaxf(st.m, mx);
    const float alpha = __builtin_amdgcn_exp2f(st.m - mnew);
    st.m = mnew;
    float ls = 0.f;
#pragma unroll
    for (int r = 0; r < 16; ++r) { p[r] = __builtin_amdgcn_exp2f(p[r] - mnew); ls += p[r]; }
    st.l = st.l * alpha + ls;
#pragma unroll
    for (int r = 0; r < 16; ++r) { st.o0[r] *= alpha; st.o1[r] *= alpha; }
    union { bf16x8 v; unsigned u[4]; } pb0, pb1;
#pragma unroll
    for (int j = 0; j < 4; ++j) { pb0.u[j] = cvtpk(p[2 * j], p[2 * j + 1]); pb1.u[j] = cvtpk(p[8 + 2 * j], p[8 + 2 * j + 1]); }
    st.o0 = MFMA_BF16(f.v[0], pb0.v, st.o0);
    st.o0 = MFMA_BF16(f.v[1], pb1.v, st.o0);
    st.o1 = MFMA_BF16(f.v[2], pb0.v, st.o1);
    st.o1 = MFMA_BF16(f.v[3], pb1.v, st.o1);
    (void)hi;
}

__device__ __forceinline__ float dpp_rowmax(float v) {
    v = fmaxf(v, __int_as_float(__builtin_amdgcn_update_dpp(0, __float_as_int(v), 0xB1, 0xF, 0xF, true)));
    v = fmaxf(v, __int_as_float(__builtin_amdgcn_update_dpp(0, __float_as_int(v), 0x4E, 0xF, 0xF, true)));
    v = fmaxf(v, __int_as_float(__builtin_amdgcn_update_dpp(0, __float_as_int(v), 0x141, 0xF, 0xF, true)));
    v = fmaxf(v, __int_as_float(__builtin_amdgcn_update_dpp(0, __float_as_int(v), 0x140, 0xF, 0xF, true)));
    return v;
}
__device__ __forceinline__ int dpp_rowmin_i(int v) {
    v = min(v, __builtin_amdgcn_update_dpp(0, v, 0xB1, 0xF, 0xF, true));
    v = min(v, __builtin_amdgcn_update_dpp(0, v, 0x4E, 0xF, 0xF, true));
    v = min(v, __builtin_amdgcn_update_dpp(0, v, 0x141, 0xF, 0xF, true));
    v = min(v, __builtin_amdgcn_update_dpp(0, v, 0x140, 0xF, 0xF, true));
    return v;
}
__device__ __forceinline__ float rl_f(float v, int l) { return __int_as_float(__builtin_amdgcn_readlane(__float_as_int(v), l)); }

__device__ __forceinline__ void top3_insert(float v, int i, float& v0, int& i0, float& v1, int& i1, float& v2, int& i2) {
    const bool b0 = (v > v0) || (v == v0 && i < i0);
    const bool b1 = (v > v1) || (v == v1 && i < i1);
    const bool b2 = (v > v2) || (v == v2 && i < i2);
    const float nv2 = b1 ? v1 : (b2 ? v : v2); const int ni2 = b1 ? i1 : (b2 ? i : i2);
    const float nv1 = b0 ? v0 : (b1 ? v : v1); const int ni1 = b0 ? i0 : (b1 ? i : i1);
    const float nv0 = b0 ? v : v0;             const int ni0 = b0 ? i : i0;
    v0 = nv0; i0 = ni0; v1 = nv1; i1 = ni1; v2 = nv2; i2 = ni2;
}

__device__ __forceinline__ void ln_row(float (&v)[16], const float* __restrict__ g, const float* __restrict__ b, int lane) {
    float s = 0.f;
#pragma unroll
    for (int i = 0; i < 16; ++i) s += v[i];
    const float mu = wave_sum(s) * (1.f / D);
    float q = 0.f;
#pragma unroll
    for (int i = 0; i < 16; ++i) { const float d = v[i] - mu; q += d * d; }
    const float rstd = rsqrtf(wave_sum(q) * (1.f / D) + LN_EPS);
#pragma unroll
    for (int j = 0; j < 4; ++j) {
        const f32x4 gg = *(const f32x4*)(g + j * 256 + lane * 4), bb = *(const f32x4*)(b + j * 256 + lane * 4);
#pragma unroll
        for (int c = 0; c < 4; ++c) v[j * 4 + c] = (v[j * 4 + c] - mu) * rstd * gg[c] + bb[c];
    }
}

typedef __attribute__((ext_vector_type(2))) float f32x2_;
__device__ __forceinline__ bf16x8 fp8x8_to_bf16(unsigned lo, unsigned hi_) {
    const f32x2_ a = __builtin_amdgcn_cvt_pk_f32_fp8((int)lo, false), b = __builtin_amdgcn_cvt_pk_f32_fp8((int)lo, true);
    const f32x2_ c = __builtin_amdgcn_cvt_pk_f32_fp8((int)hi_, false), d = __builtin_amdgcn_cvt_pk_f32_fp8((int)hi_, true);
    union { bf16x8 v; unsigned u[4]; } r;
    r.u[0] = cvtpk(a[0], a[1]); r.u[1] = cvtpk(b[0], b[1]); r.u[2] = cvtpk(c[0], c[1]); r.u[3] = cvtpk(d[0], d[1]);
    return r.v;
}
__device__ __forceinline__ unsigned pack_fp8x4(float a, float b, float c, float d) { int p = __builtin_amdgcn_cvt_pk_fp8_f32(a, b, 0, false); return (unsigned)__builtin_amdgcn_cvt_pk_fp8_f32(c, d, p, true); }

constexpr int MOE_BP = 72;
constexpr int MOE_BSTAGE = 128 * MOE_BP * 2;
constexpr int MOE_LDS_VA = 3 * MOE_BSTAGE;
constexpr int MOE_LDS_W = MOE_LDS_VA + 4096;
template <bool DOWN>
__device__ __forceinline__ void moe_expert(LAS char* lds, const int tid, const int lane, const int wave, const int r32, const int hi,
                                           const unsigned char* __restrict__ abase  , const float* __restrict__ w0, const float* __restrict__ w1, const int ng  , void* __restrict__ outv,
                                           const int pass0, const int npass_, const int st0, const int nstl  ) {
    constexpr int KT = DOWN ? 4 : 16, NP = DOWN ? 8 : 4, LDB = DOWN ? 1024 : 256, APITCH = DOWN ? 256 : 1024  , PSTEP = DOWN ? 128 : 64;
    LAS int* rowva = (LAS int*)(lds + MOE_LDS_VA); LAS float* roww = (LAS float*)(lds + MOE_LDS_W);
    const int nst = nstl;
    const int nsteps = npass_ * nst * KT; (void)NP;
    unsigned aoff[2];
#define MOE_AOFF(ST_) { _Pragma("unroll") for (int a = 0; a < 2; ++a) { const int va_ = rowva[(ST_) * 512 + wave * 64 + a * 32 + r32]; \
        const int srow_ = DOWN ? va_ : (va_ == TRASH_VA ? 0 : (va_ >> 3)); aoff[a] = (unsigned)srow_ * APITCH + hi * 32; } }
    const int seg = wave >> 1, n4 = lane & 7, kp = (wave & 1) * 16 + (lane >> 3);
    const char* wbase = (const char*)(DOWN ? (w0 + seg * 32) : (((seg < 2) ? w0 : w1) + (seg & 1) * 32));
    const unsigned boff = (unsigned)(4 * n4 + 2 * kp * LDB) * 4u;
    f32x16 acc[2][4];
#pragma unroll
    for (int a = 0; a < 2; ++a)
#pragma unroll
        for (int c = 0; c < 4; ++c)
#pragma unroll
            for (int r = 0; r < 16; ++r) acc[a][c][r] = 0.f;
    u32x4 fa8[2][2];
    f32x4 rb0[4], rb1[4];
#define MOE_DEC(S_) const int s2_ = (S_) < nsteps ? (S_) : 0; const int pl_ = s2_ / (nst * KT); const int rm_ = s2_ - pl_ * (nst * KT); const int sl_ = rm_ / KT; const int kt_ = rm_ - sl_ * KT; const int ps_ = pass0 + pl_; const int stt_ = st0 + sl_;
#define MOE_LOADB(S_, RB) { MOE_DEC(S_) (void)stt_; \
        const char* wp_ = wbase + (size_t)(ps_ * PSTEP + kt_ * 64 * LDB) * 4 + boff; \
        RB[0] = *(const f32x4*)(wp_); RB[1] = *(const f32x4*)(wp_ + LDB * 4); RB[2] = *(const f32x4*)(wp_ + 16 * LDB * 4); RB[3] = *(const f32x4*)(wp_ + 17 * LDB * 4); }
#define MOE_WRITEB(STG, RB) { LAS char* Bs_ = lds + (STG) * MOE_BSTAGE; \
        _Pragma("unroll") for (int i = 0; i < 4; ++i) { LAS unsigned* q_ = (LAS unsigned*)(Bs_ + ((seg * 32 + i * 8 + n4) * MOE_BP + 2 * kp) * 2); q_[0] = cvtpk(RB[0][i], RB[1][i]); q_[8] = cvtpk(RB[2][i], RB[3][i]); } }
#define MOE_COMPUTE(STG, DO_MFMA) { LAS char* Bs_ = lds + (STG) * MOE_BSTAGE; \
        _Pragma("unroll") for (int u = 0; u < 4; ++u) { \
            bf16x8 bfr[4]; \
            if (DO_MFMA) { _Pragma("unroll") for (int c = 0; c < 4; ++c) bfr[c] = *(LAS bf16x8*)(Bs_ + ((c * 32 + r32) * MOE_BP + hi * 32 + u * 8) * 2); } \
            _Pragma("unroll") for (int a = 0; a < 2; ++a) { \
                if (DO_MFMA) { const bf16x8 af_ = fp8x8_to_bf16(fa8[a][u >> 1][(u & 1) * 2], fa8[a][u >> 1][(u & 1) * 2 + 1]); \
                    _Pragma("unroll") for (int c = 0; c < 4; ++c) acc[a][c] = MFMA_BF16(bfr[c], af_, acc[a][c]); } \
                if (u & 1) fa8[a][u >> 1] = *(const u32x4*)(ab_n + aoff[a] + (u >> 1) * 16); \
            } \
        } }
#define MOE_NEXTA(S_) MOE_DEC(S_) (void)ps_; \
        if (stt_ != st_loaded) { MOE_AOFF(stt_) st_loaded = stt_; } \
        const char* ab_n = (const char*)abase + kt_ * 64;
    int st_loaded = st0;
    MOE_AOFF(st0)
    { const char* ab0 = (const char*)abase;
#pragma unroll
      for (int a = 0; a < 2; ++a)
#pragma unroll
          for (int h2 = 0; h2 < 2; ++h2) fa8[a][h2] = *(const u32x4*)(ab0 + aoff[a] + h2 * 16); }
    MOE_LOADB(0, rb0)
    MOE_LOADB(1, rb1)
    MOE_WRITEB(0, rb0)
    MOE_LOADB(2, rb0)
    int stg = 0;
#pragma unroll 1
    for (int sidx = 0; sidx < nsteps; sidx += 2) {
        const int pl = sidx / (nst * KT); const int rm = sidx - pl * (nst * KT); const int sl = rm / KT; const int kt = rm - sl * KT; const int ps = pass0 + pl, stt = st0 + sl;
        const bool wv = (wave * 64) < (ng - stt * 512);
        const int stg1 = stg == 2 ? 0 : stg + 1, stg2 = stg1 == 2 ? 0 : stg1 + 1;
        __syncthreads();
        MOE_WRITEB(stg1, rb1)
        MOE_LOADB(sidx + 3, rb1)
        { MOE_NEXTA(sidx + 1)
          if (wv) MOE_COMPUTE(stg, true) else MOE_COMPUTE(stg, false) }
        __syncthreads();
        MOE_WRITEB(stg2, rb0)
        MOE_LOADB(sidx + 4, rb0)
        { MOE_NEXTA(sidx + 2)
          if (wv) MOE_COMPUTE(stg1, true) else MOE_COMPUTE(stg1, false) }
        stg = stg2;
        if (kt == KT - 2) {
            if (wv) {
                const int nrows = ng - stt * 512;
#pragma unroll
                for (int a = 0; a < 2; ++a) {
                    if (a == 0 || (wave * 64 + 32) < nrows) {
                        const int lrow = stt * 512 + wave * 64 + a * 32 + r32;
                        const unsigned va = (unsigned)rowva[lrow];
                        if (DOWN) {
                            const float w = roww[lrow];
#pragma unroll
                            for (int c = 0; c < 4; ++c) {
                                u32x4 q0, q1;
#pragma unroll
                                for (int jj = 0; jj < 4; ++jj) {
                                    const int j0 = 2 * jj, j1 = 2 * jj + 1, j2 = 8 + 2 * jj, j3 = 9 + 2 * jj;
                                    q0[jj] = cvtpk(acc[a][c][(j0 >> 2) + 4 * (j0 & 3)] * w, acc[a][c][(j1 >> 2) + 4 * (j1 & 3)] * w);
                                    q1[jj] = cvtpk(acc[a][c][(j2 >> 2) + 4 * (j2 & 3)] * w, acc[a][c][(j3 >> 2) + 4 * (j3 & 3)] * w);
                                }
                                u16* o = (u16*)outv + (size_t)va * D + ps * 128 + c * 32 + 16 * hi;
                                *(u32x4*)o = q0; *(u32x4*)(o + 8) = q1;
                            }
                        } else {
#pragma unroll
                            for (int c = 0; c < 2; ++c) {
                                float hv[16];
#pragma unroll
                                for (int j = 0; j < 16; ++j) { const int r = (j >> 2) + 4 * (j & 3); const float gt = acc[a][c][r], up = acc[a][c + 2][r]; hv[j] = gt / (1.f + __expf(-gt)) * up; }
                                u32x4 q;
#pragma unroll
                                for (int jj = 0; jj < 4; ++jj) q[jj] = pack_fp8x4(hv[4 * jj], hv[4 * jj + 1], hv[4 * jj + 2], hv[4 * jj + 3]);
                                *(u32x4*)((unsigned char*)outv + (size_t)va * DF + ps * 64 + c * 32 + 16 * hi) = q;
                            }
                        }
                    }
                }
#pragma unroll
                for (int a = 0; a < 2; ++a)
#pragma unroll
                    for (int c = 0; c < 4; ++c)
#pragma unroll
                        for (int r = 0; r < 16; ++r) acc[a][c][r] = 0.f;
            }
        }
    }
    __syncthreads();
#undef MOE_AOFF
#undef MOE_DEC
#undef MOE_LOADB
#undef MOE_WRITEB
#undef MOE_COMPUTE
#undef MOE_NEXTA
}

constexpr int N_PHASES = 21;

#define P_x_in CTX_IN(0)
#define P_xb ((u16*)(ws + WS_XB))
#define P_x1 ((float*)(ws + WS_X1))
#define P_x2 ((float*)(ws + WS_X2))
#define P_ypre ((float*)(ws + WS_YPRE))
#define P_qkv ((u16*)(ws + WS_QKV))
#define P_vT ((u16*)(ws + WS_VT))
#define P_kmean ((float*)(ws + WS_KM))
#define P_ao ((u16*)(ws + WS_AO))
#define P_og ((u16*)(ws + WS_OG))
#define P_lse ((float*)(ws + WS_LSE))
#define P_topw ((float*)(ws + WS_TOPW))
#define P_list ((int*)(ws + WS_LIST))
#define P_hb ((u16*)(ws + WS_HB))
#define P_yb ((u16*)(ws + WS_YB))
#define P_cnt_all ((int*)(ws + WS_CTL + CTL_CNT_OFF))
#define P_xb8 ((unsigned char*)(ws + WS_XB8))
#define P_hbs ((u16*)(ws + WS_HBS))
#define P_selm ((unsigned*)(ws + WS_SELM))
#define P_part ((u16*)(ws + WS_PART))
#define P_plse ((float*)(ws + WS_PLSE))
#define PH_BEGIN int tid = wave_s_ * 64 + lane_id_(); asm volatile("" : "+v"(tid)); const int lane = tid & 63, r32 = lane & 31, hi = lane >> 5; const int wave = __builtin_amdgcn_readfirstlane(tid >> 6); (void)lane; (void)r32; (void)hi; (void)wave
constexpr int LDS_CTX = LDS_BAR + 16;
__device__ __forceinline__ uint64_t ctx_ld(int i) {
    extern __shared__ __attribute__((aligned(16))) unsigned char lds_raw[];
    const LAS unsigned* q = (const LAS unsigned*)((LAS char*)lds_raw + LDS_CTX) + 2 * i;
    const unsigned lo = __builtin_amdgcn_readfirstlane(q[0]), hi = __builtin_amdgcn_readfirstlane(q[1]);
    return ((uint64_t)hi << 32) | lo;
}
typedef __attribute__((address_space(1))) unsigned char gbyte;
#define AS_GLOBAL(T, u64v) ((T*)(gbyte*)(u64v))
#define CTX_IN(i) AS_GLOBAL(const float, ctx_ld(i))
#define PH_FN_BEGIN \
    extern __shared__ __attribute__((aligned(16))) unsigned char lds_raw[]; \
    LAS char* lds = (LAS char*)lds_raw; (void)lds; \
    const int G = gridDim.x, bid = blockIdx.x; (void)G; (void)bid; \
    unsigned char* const ws = AS_GLOBAL(unsigned char, ctx_ld(17)); (void)ws; \
    const int NQ = L == 0 ? 3072 : 9216; (void)NQ; \
    int* cnt = P_cnt_all + L * NE; (void)cnt;
__device__ __forceinline__ void ph_p0(int L, int rep_, const int wave_s_) {
    PH_FN_BEGIN
    (void)rep_;
    PH_BEGIN;
    for (size_t i = (size_t)bid * NTHR + tid; i < (size_t)T * D / 4; i += (size_t)G * NTHR) {
        const f32x4 v = *(const f32x4*)(P_x_in + i * 4);
        u32x2 w; w[0] = cvtpk(v[0], v[1]); w[1] = cvtpk(v[2], v[3]);
        *(u32x2*)(P_xb + i * 4) = w;
    }
    LAS float* tl = (LAS float*)lds;
    for (int it = bid; it < 3968 + 128; it += G) {
        int seg, kt;
        if (it < 3840) { seg = it >> 4; kt = it & 15; } else if (it < 3968) { seg = 240 + ((it - 3840) >> 2); kt = (it - 3840) & 3; } else { seg = 272 + ((it - 3968) >> 4); kt = (it - 3968) & 15; }
        const float* src; int ld; u16* dst; int Kd = 1024; u16* dst_lo = nullptr;
        if (seg < 48) { const int col = 64 * seg; src = CTX_IN(1) + col; ld = 3072; dst = (u16*)(ws + WS_WQK0) + (size_t)col * 1024; }
        else if (seg < 192) { const int col = 64 * (seg - 48); src = CTX_IN(2) + col; ld = 9216; dst = (u16*)(ws + WS_WQK1) + (size_t)col * 1024; }
        else if (seg < 224) { const int s2 = seg - 192, l2 = s2 >> 4, col = 64 * (s2 & 15); src = CTX_IN(3) + (size_t)l2 * D * D + col; ld = 1024; dst = (u16*)(ws + WS_WO) + (size_t)l2 * D * D + (size_t)col * 1024; }
        else if (seg < 240) { const int s2 = seg - 224, l2 = s2 >> 3, i8 = s2 & 7, un = i8 >> 2, q = i8 & 3;
            src = (q < 2 ? CTX_IN(11) : CTX_IN(12)) + (size_t)l2 * D * DF + un * 128 + 64 * (q & 1); ld = 256; dst = (u16*)(ws + WS_WSGU) + (size_t)l2 * 512 * 1024 + (size_t)(64 * i8) * 1024; }
        else if (seg < 272) { const int s2 = seg - 240, l2 = s2 >> 4, col = 64 * (s2 & 15); src = CTX_IN(13) + (size_t)l2 * DF * D + col; ld = 1024; Kd = 256; dst = (u16*)(ws + WS_WSD) + (size_t)l2 * D * DF + (size_t)col * 256; }
        else { const int s2 = seg - 272, l2 = s2 >> 2, col = 64 * (s2 & 3); src = CTX_IN(6) + (size_t)l2 * D * NE + col; ld = 256; dst = (u16*)(ws + WS_WRH) + (size_t)l2 * NE * D + (size_t)col * 1024; dst_lo = (u16*)(ws + WS_WRL) + (size_t)l2 * NE * D + (size_t)col * 1024; }
        {
            const int kr = tid >> 4, c4 = tid & 15;
#pragma unroll
            for (int i = 0; i < 2; ++i) {
                const f32x4 v = *(const f32x4*)(src + (size_t)(kt * 64 + kr + 32 * i) * ld + 4 * c4);
#pragma unroll
                for (int jj = 0; jj < 4; ++jj) tl[(kr + 32 * i) * 65 + 4 * c4 + jj] = v[jj];
            }
        }
        __syncthreads();
        {
            const int row = tid >> 3, kc = tid & 7;
            float f[8];
#pragma unroll
            for (int jj = 0; jj < 8; ++jj) f[jj] = tl[(8 * kc + jj) * 65 + row];
            u32x4 w; w[0] = cvtpk(f[0], f[1]); w[1] = cvtpk(f[2], f[3]); w[2] = cvtpk(f[4], f[5]); w[3] = cvtpk(f[6], f[7]);
            *(u32x4*)(dst + (size_t)row * Kd + kt * 64 + 8 * kc) = w;
            if (dst_lo) {
                u32x4 wl;
#pragma unroll
                for (int jj = 0; jj < 4; ++jj) wl[jj] = cvtpk(f[2 * jj] - bf2f(w[jj] & 0xFFFFu), f[2 * jj + 1] - bf2f(w[jj] >> 16));
                *(u32x4*)(dst_lo + (size_t)row * Kd + kt * 64 + 8 * kc) = wl;
            }
        }
        __syncthreads();
    }
}

__device__ __forceinline__ void ph_qkv(int L, int rep_, const int wave_s_) {
    PH_FN_BEGIN
    (void)rep_;
    const pg8::Gemm g{P_xb, (const u16*)(ws + (L == 0 ? WS_WQK0 : WS_WQK1)), T, NQ, D};
    pg8::StaticOrder S; S.init(g.M, g.N, G, bid);
    const EpiQK E{P_qkv, NQ};
    pg8::gemm_phase<EpiQK, pg8::StaticOrder, false>((PG8_LAS unsigned char*)lds, g, S, E, nullptr, wave_s_ * 64 + lane_id_());
}

__device__ __forceinline__ void ph_kmean(int L, int rep_, const int wave_s_) {
    PH_FN_BEGIN
    (void)rep_;
    PH_BEGIN;
    LAS float* red = (LAS float*)lds;
    for (int it = bid; it < BATCH * NH * MOBA_NB; it += G) {
        const int j = it & 31, h = (it >> 5) & 15, b = it >> 9;
        const int kg_ = tid >> 3, ch = tid & 7;
        const u16* kp = P_qkv + (size_t)(b * SEQ + j * MOBA_BLK + kg_) * 3072 + 1024 + h * 64 + ch * 8;
        float sm[8];
#pragma unroll
        for (int e2 = 0; e2 < 8; ++e2) sm[e2] = 0.f;
#pragma unroll
        for (int i = 0; i < 4; ++i) {
            const u32x4 v = *(const u32x4*)(kp + (size_t)(64 * i) * 3072);
#pragma unroll
            for (int e2 = 0; e2 < 4; ++e2) { sm[2 * e2] += bf2f(v[e2] & 0xFFFFu); sm[2 * e2 + 1] += bf2f(v[e2] >> 16); }
        }
#pragma unroll
        for (int e2 = 0; e2 < 8; ++e2) red[kg_ * 65 + ch * 8 + e2] = sm[e2];
        __syncthreads();
        if (tid < 64) {
            float tot = 0.f;
#pragma unroll 8
            for (int q = 0; q < 64; ++q) tot += red[q * 65 + tid];
            P_kmean[(size_t)it * 64 + tid] = tot * (1.f / MOBA_BLK);
        }
        __syncthreads();
    }
}

__device__ __forceinline__ void ph_gate(int L, int rep_, const int wave_s_) {
    PH_FN_BEGIN
    (void)rep_;
    PH_BEGIN;
    for (int it = bid; it < BATCH * NH * MOBA_NB; it += G) {
        const int qb = it & 31, bh = it >> 5, b = bh >> 4, h = bh & 15;
        const int tq = qb * MOBA_BLK + wave * 32 + r32;
        const u16* qrow = P_qkv + (size_t)(b * SEQ + tq) * 3072 + h * 64 + hi * 8;
        bf16x8 qf[4];
#pragma unroll
        for (int d0 = 0; d0 < 4; ++d0) qf[d0] = *(const bf16x8*)(qrow + d0 * 16);
        unsigned selmask = 0u;
        if (qb > 0) {
            const float* km = P_kmean + ((size_t)(b * NH + h) * MOBA_NB + r32) * 64 + hi * 8;
            f32x16 gt;
#pragma unroll
            for (int r = 0; r < 16; ++r) gt[r] = 0.f;
#pragma unroll
            for (int d0 = 0; d0 < 4; ++d0) {
                const f32x4 k0 = *(const f32x4*)(km + d0 * 16), k1 = *(const f32x4*)(km + d0 * 16 + 4);
                union { bf16x8 v; unsigned u[4]; } kf;
                kf.u[0] = cvtpk(k0[0], k0[1]); kf.u[1] = cvtpk(k0[2], k0[3]); kf.u[2] = cvtpk(k1[0], k1[1]); kf.u[3] = cvtpk(k1[2], k1[3]);
                gt = MFMA_BF16(kf.v, qf[d0], gt);
            }
            float v0 = -INFINITY, v1 = -INFINITY, v2 = -INFINITY; int i0 = 99, i1 = 99, i2 = 99;
#pragma unroll
            for (int r = 0; r < 16; ++r) { const int jb = crow(r, hi); const float gv = jb < qb ? gt[r] : -INFINITY; top3_insert(gv, jb < qb ? jb : 99, v0, i0, v1, i1, v2, i2); }
            const float ov0 = shxf(v0, 32, lane), ov1 = shxf(v1, 32, lane), ov2 = shxf(v2, 32, lane);
            const int oi0 = shxi(i0, 32, lane), oi1 = shxi(i1, 32, lane), oi2 = shxi(i2, 32, lane);
            top3_insert(ov0, oi0, v0, i0, v1, i1, v2, i2); top3_insert(ov1, oi1, v0, i0, v1, i1, v2, i2); top3_insert(ov2, oi2, v0, i0, v1, i1, v2, i2);
            if (i0 < 32) selmask |= 1u << i0;
            if (i1 < 32) selmask |= 1u << i1;
            if (i2 < 32) selmask |= 1u << i2;
        }
        if (hi == 0) P_selm[(size_t)bh * SEQ + tq] = selmask;
    }
}

constexpr int MB_KP = 72;
constexpr int MB_VP = 260;
constexpr int MB_LDS_K = 0;
constexpr int MB_LDS_V = 256 * MB_KP * 2;
constexpr int MB_LDS_LIST = MB_LDS_V + 64 * MB_VP * 2;
constexpr int MB_LDS_CTR = MB_LDS_LIST + 8192 * 2;
__device__ __forceinline__ void ph_moba(int L, int rep_, const int wave_s_) {
    PH_FN_BEGIN
    (void)rep_;
    PH_BEGIN;
    LAS char* Ks = lds + MB_LDS_K; LAS char* Vs = lds + MB_LDS_V;
    LAS u16* qlist = (LAS u16*)(lds + MB_LDS_LIST); LAS int* ctr = (LAS int*)(lds + MB_LDS_CTR);
    for (int it = bid; it < BATCH * NH * MOBA_NB; it += G) {
        const int rnd = it >> 8, w8 = it & 255, a8 = w8 >> 5, bh = w8 & 31;
        const int j = rnd == 0 ? a8 : (rnd == 1 ? 15 - a8 : (rnd == 2 ? 16 + a8 : 31 - a8));
        const int b = bh >> 4, h = bh & 15;
        const float slope2 = exp2f(-0.5f * (float)(h + 1)) * LOG2E;
        if (tid == 0) { int z0 = 0; asm volatile("" : "+v"(z0)); ctr[0] = z0; ctr[1] = z0; }
        {
            const u16* kg = P_qkv + (size_t)(b * SEQ + j * MOBA_BLK) * 3072 + 1024 + h * 64;
#pragma unroll
            for (int i = 0; i < 4; ++i) { const int c = tid + i * 512, row = c >> 3, ch = c & 7; *(LAS u32x4*)(Ks + (row * MB_KP + ch * 8) * 2) = *(const u32x4*)(kg + (size_t)row * 3072 + ch * 8); }
            const u16* vg = P_qkv + (size_t)(b * SEQ + j * MOBA_BLK) * 3072 + 2048 + h * 64;
#pragma unroll
            for (int i = 0; i < 4; ++i) {
                const int c = tid + i * 512, key = c >> 3, ch = c & 7;
                const u32x4 v = *(const u32x4*)(vg + (size_t)key * 3072 + ch * 8);
#pragma unroll
                for (int e2 = 0; e2 < 4; ++e2) {
                    *(LAS u16*)(Vs + ((ch * 8 + 2 * e2) * MB_VP + key) * 2) = (u16)(v[e2] & 0xFFFFu);
                    *(LAS u16*)(Vs + ((ch * 8 + 2 * e2 + 1) * MB_VP + key) * 2) = (u16)(v[e2] >> 16);
                }
            }
        }
        __syncthreads();
        {
            const unsigned* sm = P_selm + (size_t)bh * SEQ;
            for (int t0 = (j + 1) * MOBA_BLK; t0 < SEQ; t0 += 512) {
                const int t = t0 + tid;
                const bool sel = (t < SEQ) && ((sm[t < SEQ ? t : 0] >> j) & 1u);
                const unsigned long long bal = __ballot(sel);
                const int total = __popcll(bal);
                int wb = 0;
                if (lane == 0 && total) wb = atomicAdd((int*)&ctr[0], total);
                wb = __builtin_amdgcn_readfirstlane(wb);
                if (sel) qlist[wb + __popcll(bal & ((1ull << lane) - 1ull))] = (u16)t;
            }
        }
        __syncthreads();
        const int nq = ctr[0];
        const int ntiles = 8 + ((nq + 31) >> 5);
        for (;;) {
            int ti = 0;
            if (lane == 0) ti = atomicAdd((int*)&ctr[1], 1);
            ti = __builtin_amdgcn_readfirstlane(ti);
            if (ti >= ntiles) break;
            const bool own = ti < 8;
            const int wq = 7 - ti;
            const int li = (ti - 8) * 32 + r32;
            const bool valid = own || li < nq;
            const int tq = own ? j * MOBA_BLK + wq * 32 + r32 : (int)qlist[li < nq ? li : nq - 1];
            const int nsteps = own ? wq + 1 : 8;
            const u16* qrow = P_qkv + (size_t)(b * SEQ + tq) * 3072 + h * 64 + hi * 8;
            bf16x8 qf[4];
#pragma unroll
            for (int d0 = 0; d0 < 4; ++d0) qf[d0] = *(const bf16x8*)(qrow + d0 * 16);
            int slot = 3;
            if (!own) slot = __popc(P_selm[(size_t)bh * SEQ + tq] & ((1u << j) - 1u));
            AttnSt st; st.m = NEGV; st.l = 0.f;
#pragma unroll
            for (int r = 0; r < 16; ++r) { st.o0[r] = 0.f; st.o1[r] = 0.f; }
            const int dlo = own ? 0 : -0x40000000;
            for (int kt = 0; kt < nsteps; ++kt) {
                AttnFr f;
#pragma unroll
                for (int d0 = 0; d0 < 4; ++d0) f.k[d0] = *(LAS bf16x8*)(Ks + ((kt * 32 + r32) * MB_KP + d0 * 16 + hi * 8) * 2);
#pragma unroll
                for (int q4 = 0; q4 < 4; ++q4) {
                    union { bf16x8 v; u32x2 hh[2]; } va;
                    LAS char* vp = Vs + (((q4 >> 1) * 32 + r32) * MB_VP + kt * 32 + (q4 & 1) * 16 + 4 * hi) * 2;
                    va.hh[0] = *(LAS u32x2*)(vp); va.hh[1] = *(LAS u32x2*)(vp + 16);
                    f.v[q4] = va.v;
                }
                attn_compute(st, qf, f, tq - (j * MOBA_BLK + kt * 32) - 4 * hi, slope2, dlo, 0x7fffffff, hi, lane);
            }
            const float lt = st.l + shxf(st.l, 32, lane);
            const float inv = 1.f / lt;
            if (valid) {
                const size_t pi = ((size_t)(b * SEQ + tq) * NH + h) * 4 + slot;
                u16* orow = P_part + pi * 64;
#pragma unroll
                for (int rq = 0; rq < 4; ++rq) {
                    u32x2 w; w[0] = cvtpk(st.o0[4 * rq] * inv, st.o0[4 * rq + 1] * inv); w[1] = cvtpk(st.o0[4 * rq + 2] * inv, st.o0[4 * rq + 3] * inv);
                    *(u32x2*)(orow + 8 * rq + 4 * hi) = w;
                    w[0] = cvtpk(st.o1[4 * rq] * inv, st.o1[4 * rq + 1] * inv); w[1] = cvtpk(st.o1[4 * rq + 2] * inv, st.o1[4 * rq + 3] * inv);
                    *(u32x2*)(orow + 32 + 8 * rq + 4 * hi) = w;
                }
                if (hi == 0) P_plse[pi] = st.m * LN2 + logf(lt);
            }
        }
        __syncthreads();
    }
}

__device__ __forceinline__ void ph_mobamerge(int L, int rep_, const int wave_s_) {
    PH_FN_BEGIN
    (void)rep_;
    PH_BEGIN;
    for (size_t i = (size_t)bid * NTHR + tid; i < (size_t)T * NH * 8; i += (size_t)G * NTHR) {
        const size_t row = i >> 7; const int h = (int)(i >> 3) & 15, d8 = (int)i & 7;
        const int qb = (int)(row & (SEQ - 1)) >> 8;
        const int nsel = qb < 3 ? qb : 3;
        const size_t pi = (row * NH + h) * 4;
        float l[4], w[4];
        float mx = -INFINITY;
#pragma unroll
        for (int sidx = 0; sidx < 4; ++sidx) { const bool ok = sidx == 3 || sidx < nsel; l[sidx] = ok ? P_plse[pi + sidx] : -INFINITY; mx = fmaxf(mx, l[sidx]); }
        float ws_ = 0.f;
#pragma unroll
        for (int sidx = 0; sidx < 4; ++sidx) { w[sidx] = (sidx == 3 || sidx < nsel) ? expf(l[sidx] - mx) : 0.f; ws_ += w[sidx]; }
        const float inv = 1.f / ws_;
        float acc8[8];
#pragma unroll
        for (int c = 0; c < 8; ++c) acc8[c] = 0.f;
#pragma unroll
        for (int sidx = 0; sidx < 4; ++sidx) {
            if (sidx == 3 || sidx < nsel) {
                const u32x4 a = *(const u32x4*)(P_part + (pi + sidx) * 64 + d8 * 8);
                const float ww = w[sidx] * inv;
#pragma unroll
                for (int c = 0; c < 4; ++c) { acc8[2 * c] += ww * bf2f(a[c] & 0xFFFFu); acc8[2 * c + 1] += ww * bf2f(a[c] >> 16); }
            }
        }
        u32x4 o;
#pragma unroll
        for (int c = 0; c < 4; ++c) o[c] = cvtpk(acc8[2 * c], acc8[2 * c + 1]);
        *(u32x4*)(P_ao + row * D + h * 64 + d8 * 8) = o;
    }
}

constexpr int DL_KP = 72, DL_VP = 388;
constexpr int DL_LDS_K = 0, DL_LDS_V = 384 * DL_KP * 2;
__device__ __forceinline__ void ph_dil(int L, int rep_, const int wave_s_) {
    PH_FN_BEGIN
    (void)rep_;
    PH_BEGIN;
    LAS char* Ks = lds + DL_LDS_K; LAS char* Vs = lds + DL_LDS_V;
    for (int it = bid; it < BATCH * NH * 3 * 32; it += G) {
        const int ch = it & 31, grp = (it >> 5) % 3, bh = it / 96, b = bh >> 4, h = bh & 15;
        const int dil = grp == 0 ? 1 : (grp == 1 ? 4 : 16), Ls = SEQ / dil;
        const float slope2 = exp2f(-0.5f * (float)(h + 1)) * LOG2E * (float)dil;
        const int uc = ch * 256, res = uc / Ls, c0 = uc - res * Ls;
        const int kb0 = c0 - 128;
        {
            const u16* kg = P_qkv + (size_t)(b * SEQ) * 9216 + grp * 3072 + 1024 + h * 64;
#pragma unroll
            for (int i = 0; i < 6; ++i) {
                const int c = tid + i * 512, row = c >> 3, chk = c & 7, ks = kb0 + row;
                if (ks >= 0) *(LAS u32x4*)(Ks + (row * DL_KP + chk * 8) * 2) = *(const u32x4*)(kg + (size_t)(ks * dil + res) * 9216 + chk * 8);
            }
            const u16* vg = P_qkv + (size_t)(b * SEQ) * 9216 + grp * 3072 + 2048 + h * 64;
#pragma unroll
            for (int i = 0; i < 6; ++i) {
                const int c = tid + i * 512, row = c >> 3, chk = c & 7, ks = kb0 + row;
                if (ks >= 0) {
                    const u32x4 v = *(const u32x4*)(vg + (size_t)(ks * dil + res) * 9216 + chk * 8);
#pragma unroll
                    for (int e2 = 0; e2 < 4; ++e2) {
                        *(LAS u16*)(Vs + ((chk * 8 + 2 * e2) * DL_VP + row) * 2) = (u16)(v[e2] & 0xFFFFu);
                        *(LAS u16*)(Vs + ((chk * 8 + 2 * e2 + 1) * DL_VP + row) * 2) = (u16)(v[e2] >> 16);
                    }
                }
            }
        }
        const int i0 = c0 + wave * 32, iq = i0 + r32, pq = iq * dil + res;
        const u16* qrow = P_qkv + (size_t)(b * SEQ + pq) * 9216 + grp * 3072 + h * 64 + hi * 8;
        bf16x8 qf[4];
#pragma unroll
        for (int d0 = 0; d0 < 4; ++d0) qf[d0] = *(const bf16x8*)(qrow + d0 * 16);
        __syncthreads();
        AttnSt st; st.m = NEGV; st.l = 0.f;
#pragma unroll
        for (int r = 0; r < 16; ++r) { st.o0[r] = 0.f; st.o1[r] = 0.f; }
        const int ktmin = (i0 >= 128) ? 0 : (128 - i0) >> 5;
        for (int kt = 4; kt >= ktmin; --kt) {
            const int lrow0 = (wave + kt) * 32;
            AttnFr f;
#pragma unroll
            for (int d0 = 0; d0 < 4; ++d0) f.k[d0] = *(LAS bf16x8*)(Ks + ((lrow0 + r32) * DL_KP + d0 * 16 + hi * 8) * 2);
#pragma unroll
            for (int q4 = 0; q4 < 4; ++q4) {
                union { bf16x8 v; u32x2 hh[2]; } va;
                LAS char* vp = Vs + (((q4 >> 1) * 32 + r32) * DL_VP + lrow0 + (q4 & 1) * 16 + 4 * hi) * 2;
                va.hh[0] = *(LAS u32x2*)(vp); va.hh[1] = *(LAS u32x2*)(vp + 16);
                f.v[q4] = va.v;
            }
            const int k0 = i0 - 128 + kt * 32;
            attn_compute(st, qf, f, iq - k0 - 4 * hi, slope2, 0, 128, hi, lane);
        }
        const float lt = st.l + shxf(st.l, 32, lane);
        const float inv = 1.f / lt;
        u16* orow = P_og + (size_t)grp * T * D + (size_t)(b * SEQ + pq) * D + h * 64;
#pragma unroll
        for (int rq = 0; rq < 4; ++rq) {
            u32x2 w; w[0] = cvtpk(st.o0[4 * rq] * inv, st.o0[4 * rq + 1] * inv); w[1] = cvtpk(st.o0[4 * rq + 2] * inv, st.o0[4 * rq + 3] * inv);
            *(u32x2*)(orow + 8 * rq + 4 * hi) = w;
            w[0] = cvtpk(st.o1[4 * rq] * inv, st.o1[4 * rq + 1] * inv); w[1] = cvtpk(st.o1[4 * rq + 2] * inv, st.o1[4 * rq + 3] * inv);
            *(u32x2*)(orow + 32 + 8 * rq + 4 * hi) = w;
        }
        if (hi == 0) P_lse[((size_t)grp * T + (b * SEQ + pq)) * NH + h] = st.m * LN2 + logf(lt);
        __syncthreads();
    }
}

__device__ __forceinline__ void ph_merge(int L, int rep_, const int wave_s_) {
    PH_FN_BEGIN
    (void)rep_;

            PH_BEGIN;
                for (size_t i = (size_t)bid * NTHR + tid; i < (size_t)T * NH * 8; i += (size_t)G * NTHR) {
                    const size_t row = i >> 7; const int h = (int)(i >> 3) & 15, d8 = (int)i & 7;
                    const float l0 = P_lse[(0 * (size_t)T + row) * NH + h], l1 = P_lse[(1 * (size_t)T + row) * NH + h], l2 = P_lse[(2 * (size_t)T + row) * NH + h];
                    const float mx = fmaxf(l0, fmaxf(l1, l2));
                    float w0 = expf(l0 - mx), w1 = expf(l1 - mx), w2 = expf(l2 - mx);
                    const float inv = 1.f / (w0 + w1 + w2); w0 *= inv; w1 *= inv; w2 *= inv;
                    const size_t off = row * D + h * 64 + d8 * 8;
                    const u32x4 a0 = *(const u32x4*)(P_og + off), a1 = *(const u32x4*)(P_og + (size_t)T * D + off), a2 = *(const u32x4*)(P_og + 2 * (size_t)T * D + off);
                    u32x4 o;
#pragma unroll
                    for (int c = 0; c < 4; ++c) {
                        const float lo_ = w0 * bf2f(a0[c] & 0xFFFFu) + w1 * bf2f(a1[c] & 0xFFFFu) + w2 * bf2f(a2[c] & 0xFFFFu);
                        const float hi_ = w0 * bf2f(a0[c] >> 16) + w1 * bf2f(a1[c] >> 16) + w2 * bf2f(a2[c] >> 16);
                        o[c] = cvtpk(lo_, hi_);
                    }
                    *(u32x4*)(P_ao + off) = o;
                }

}

__device__ __forceinline__ void ph_wo(int L, int rep_, const int wave_s_) {
    PH_FN_BEGIN
    (void)rep_;
    const pg8::Gemm g{P_ao, (const u16*)(ws + WS_WO) + (size_t)L * D * D, T, D, D};
    pg8::StaticOrder S; S.init(g.M, g.N, G, bid);
    const EpiWo E{P_ypre, L == 0 ? CTX_IN(0) : (const float*)P_x2};
    pg8::gemm_phase<EpiWo, pg8::StaticOrder, false>((PG8_LAS unsigned char*)lds, g, S, E, nullptr, wave_s_ * 64 + lane_id_());
}

__device__ __forceinline__ void ph_router(int L, int rep_, const int wave_s_) {
    PH_FN_BEGIN
    (void)rep_;

            PH_BEGIN;
            const float* lng = CTX_IN(4) + L * D; const float* lnb = CTX_IN(5) + L * D;
            const float* rbias = CTX_IN(7) + L * NE;
            const u16* wrh = (const u16*)(ws + WS_WRH) + (size_t)L * NE * D; const u16* wrl = (const u16*)(ws + WS_WRL) + (size_t)L * NE * D;
            constexpr int AP = 2064;
            LAS char* ahi = lds; LAS char* alo = lds + 32 * AP;
            for (int it = bid; it < T / 32; it += G) {
                {
                    f32x4 yv[4][4];
#pragma unroll
                    for (int rr = 0; rr < 4; ++rr)
#pragma unroll
                        for (int j = 0; j < 4; ++j) yv[rr][j] = *(const f32x4*)(P_ypre + ((size_t)it * 32 + wave * 4 + rr) * D + j * 256 + lane * 4);
#pragma unroll
                    for (int rr = 0; rr < 4; ++rr) {
                        const int lr = wave * 4 + rr; const size_t row = (size_t)it * 32 + lr;
                        float v[16];
#pragma unroll
                        for (int j = 0; j < 4; ++j) { v[j * 4] = yv[rr][j][0]; v[j * 4 + 1] = yv[rr][j][1]; v[j * 4 + 2] = yv[rr][j][2]; v[j * 4 + 3] = yv[rr][j][3]; }
                        ln_row(v, lng, lnb, lane);
#pragma unroll
                        for (int j = 0; j < 4; ++j) {
                            f32x4 t4; t4[0] = v[j * 4]; t4[1] = v[j * 4 + 1]; t4[2] = v[j * 4 + 2]; t4[3] = v[j * 4 + 3];
                            *(f32x4*)(P_x1 + row * D + j * 256 + lane * 4) = t4;
                            u32x2 w; w[0] = cvtpk(t4[0], t4[1]); w[1] = cvtpk(t4[2], t4[3]);
                            *(u32x2*)(P_xb + row * D + j * 256 + lane * 4) = w;
                            *(unsigned*)(P_xb8 + row * D + j * 256 + lane * 4) = pack_fp8x4(t4[0], t4[1], t4[2], t4[3]);
                            u32x2 wl; wl[0] = cvtpk(t4[0] - bf2f(w[0] & 0xFFFFu), t4[1] - bf2f(w[0] >> 16)); wl[1] = cvtpk(t4[2] - bf2f(w[1] & 0xFFFFu), t4[3] - bf2f(w[1] >> 16));
                            *(LAS u32x2*)(ahi + lr * AP + (j * 256 + lane * 4) * 2) = w;
                            *(LAS u32x2*)(alo + lr * AP + (j * 256 + lane * 4) * 2) = wl;
                        }
                    }
                }
                __syncthreads();
                f32x16 lg;
#pragma unroll
                for (int r = 0; r < 16; ++r) lg[r] = 0.f;
                {
                    const LAS char* ah = ahi + r32 * AP + hi * 16; const LAS char* al = alo + r32 * AP + hi * 16;
                    const u16* bh = wrh + (size_t)(wave * 32 + r32) * D + hi * 8; const u16* bl = wrl + (size_t)(wave * 32 + r32) * D + hi * 8;
                    bf16x8 bha[8], bla[8], bhb[8], blb[8];
#pragma unroll
                    for (int j = 0; j < 8; ++j) { bha[j] = *(const bf16x8*)(bh + j * 16); bla[j] = *(const bf16x8*)(bl + j * 16); }
#pragma unroll 1
                    for (int k0 = 0; k0 < D; k0 += 256) {
#pragma unroll
                        for (int j = 0; j < 8; ++j) { bhb[j] = *(const bf16x8*)(bh + k0 + 128 + j * 16); blb[j] = *(const bf16x8*)(bl + k0 + 128 + j * 16); }
#pragma unroll
                        for (int j = 0; j < 8; ++j) {
                            const bf16x8 xh = *(const LAS bf16x8*)(ah + (k0 + j * 16) * 2), xl = *(const LAS bf16x8*)(al + (k0 + j * 16) * 2);
                            lg = MFMA_BF16(xh, bha[j], lg); lg = MFMA_BF16(xl, bha[j], lg); lg = MFMA_BF16(xh, bla[j], lg);
                        }
                        { const int kn = (k0 + 256 < D) ? k0 + 256 : 0;
#pragma unroll
                          for (int j = 0; j < 8; ++j) { bha[j] = *(const bf16x8*)(bh + kn + j * 16); bla[j] = *(const bf16x8*)(bl + kn + j * 16); } }
#pragma unroll
                        for (int j = 0; j < 8; ++j) {
                            const bf16x8 xh = *(const LAS bf16x8*)(ah + (k0 + 128 + j * 16) * 2), xl = *(const LAS bf16x8*)(al + (k0 + 128 + j * 16) * 2);
                            lg = MFMA_BF16(xh, bhb[j], lg); lg = MFMA_BF16(xl, bhb[j], lg); lg = MFMA_BF16(xh, blb[j], lg);
                        }
                    }
                }
                __syncthreads();
                LAS float* lgs = (LAS float*)lds;
#pragma unroll
                for (int r = 0; r < 16; ++r) lgs[crow(r, hi) * 257 + wave * 32 + r32] = lg[r];
                __syncthreads();
#pragma unroll 1
                for (int rr = 0; rr < 4; ++rr) {
                    const int lr = wave * 4 + rr; const int tok = it * 32 + lr;
                    float sc[4], ch[4];
#pragma unroll
                    for (int j = 0; j < 4; ++j) { const int e = lane + 64 * j; sc[j] = 1.f / (1.f + expf(-lgs[lr * 257 + e])); ch[j] = sc[j] + rbias[e]; }
                    float gsel[8];
#pragma unroll
                    for (int j = 0; j < 4; ++j) {
                        const float rm = dpp_rowmax(ch[j]);
                        const float m1a = fmaxf(rl_f(rm, 0), rl_f(rm, 16)), m1b = fmaxf(rl_f(rm, 32), rl_f(rm, 48));
                        const unsigned long long bal = __ballot(ch[j] == (hi ? m1b : m1a));
                        const int fa_ = __builtin_ctz((unsigned)(bal & 0xFFFFFFFFull)), fb_ = 32 + __builtin_ctz((unsigned)(bal >> 32));
                        const float c2 = (lane == fa_ || lane == fb_) ? -INFINITY : ch[j];
                        const float rm2 = dpp_rowmax(c2);
                        gsel[2 * j] = m1a + fmaxf(rl_f(rm2, 0), rl_f(rm2, 16));
                        gsel[2 * j + 1] = m1b + fmaxf(rl_f(rm2, 32), rl_f(rm2, 48));
                    }
                    float cv[4];
#pragma unroll
                    for (int j = 0; j < 4; ++j) {
                        int ra_ = 0, rb_ = 0;
#pragma unroll
                        for (int g2 = 0; g2 < 8; ++g2) {
                            ra_ += ((gsel[g2] > gsel[2 * j]) || (gsel[g2] == gsel[2 * j] && g2 < 2 * j)) ? 1 : 0;
                            rb_ += ((gsel[g2] > gsel[2 * j + 1]) || (gsel[g2] == gsel[2 * j + 1] && g2 < 2 * j + 1)) ? 1 : 0;
                        }
                        cv[j] = ((hi ? rb_ : ra_) < 4) ? ch[j] : NEGV;
                    }
                    float wsel = 0.f; int esel = 0; float wsum = 0.f;
#pragma unroll 1
                    for (int k = 0; k < TOPK; ++k) {
                        float bv = cv[0]; int be = lane;
#pragma unroll
                        for (int j = 1; j < 4; ++j) if (cv[j] > bv) { bv = cv[j]; be = lane + 64 * j; }
                        const float rm = dpp_rowmax(bv);
                        const float mval = fmaxf(fmaxf(rl_f(rm, 0), rl_f(rm, 16)), fmaxf(rl_f(rm, 32), rl_f(rm, 48)));
                        const int ri = dpp_rowmin_i(bv == mval ? be : 0x7fffffff);
                        const int e = min(min(__builtin_amdgcn_readlane(ri, 0), __builtin_amdgcn_readlane(ri, 16)), min(__builtin_amdgcn_readlane(ri, 32), __builtin_amdgcn_readlane(ri, 48)));
                        const int jl = e >> 6, ll = e & 63;
                        float smine = sc[0];
                        smine = jl == 1 ? sc[1] : smine; smine = jl == 2 ? sc[2] : smine; smine = jl == 3 ? sc[3] : smine;
                        const float sw = rl_f(smine, ll);
#pragma unroll
                        for (int j = 0; j < 4; ++j) cv[j] = (lane == ll && jl == j) ? -INFINITY : cv[j];
                        wsum += sw;
                        if (lane == k) { wsel = sw; esel = e; }
                    }
                    if (lane < TOPK) {
                        const int a = tok * TOPK + lane;
                        P_topw[a] = wsel / wsum * 2.5f;
                        if (rep_ == 0) {
                            const int pos = atomicAdd(&cnt[esel], 1);
                            P_list[(size_t)esel * T + pos] = a;
                        }
                    }
                }
                __syncthreads();
            }

}

__device__ __forceinline__ void ph_gateup(int L, int rep_, const int wave_s_) {
    PH_FN_BEGIN
    (void)rep_;
    {
        PH_BEGIN;
        const float* weg = CTX_IN(8) + (size_t)L * NE * D * DF; const float* weu = CTX_IN(9) + (size_t)L * NE * D * DF;
        LAS int* rowva = (LAS int*)(lds + MOE_LDS_VA);
        {
            int* octr = (int*)(ws + WS_CTL + CTL_CNT_OFF + 8192) + (L * 4 + 2 * (rep_ & 1)) * 64;
            LAS int* slot = (LAS int*)(lds + 140000);
            for (;;) {
                __syncthreads();
                if (tid == 0) { int q; do { q = atomicAdd(octr, 1); } while (q >= NE && q < NE * 5 && cnt[(q - NE) >> 2] <= 512); *slot = q; }
                __syncthreads();
                const int q = *slot;
                if (q >= NE * 5) break;
                const bool ovf = q >= NE;
                const int e = ovf ? (q - NE) >> 2 : q, pz = ovf ? (q - NE) & 3 : 0, npz = ovf ? 1 : 4, st0 = ovf ? 1 : 0, n = cnt[e];
                for (int r0 = 0; r0 < n; r0 += 1024) {
                    if (ovf && n - r0 <= 512) break;
#pragma unroll
                    for (int i = 0; i < 2; ++i) { const int idx = r0 + i * 512 + tid; rowva[i * 512 + tid] = idx < n ? P_list[(size_t)e * T + idx] : TRASH_VA; }
                    __syncthreads();
                    moe_expert<false>(lds, tid, lane, wave, r32, hi, P_xb8, weg + (size_t)e * D * DF, weu + (size_t)e * D * DF, (n - r0) < 1024 ? (n - r0) : 1024, (void*)P_hb, pz, npz, st0, 1);
                }
            }
        }
    }
    {
        PH_BEGIN;
        const pg8::Gemm g{P_xb, (const u16*)(ws + WS_WSGU) + (size_t)L * 512 * 1024, T, 512, D};
        const EpiSGU E{P_hbs};
        int* qctr = (int*)(ws + WS_CTL + CTL_CNT_OFF + 4096) + (L * 4 + 2 * (rep_ & 1)) * 64;
        LAS int* slot = (LAS int*)(lds + 140000);
        for (;;) {
            __syncthreads();
            if (tid == 0) *slot = atomicAdd(qctr, 1);
            __syncthreads();
            const int un = *slot;
            if (un >= 128) break;
            const pg8::FixedOrder S{un & 63, un >> 6};
            pg8::gemm_phase<EpiSGU, pg8::FixedOrder, false>((PG8_LAS unsigned char*)lds, g, S, E, nullptr, wave_s_ * 64 + lane_id_());
        }
    }
}

__device__ __forceinline__ void ph_down(int L, int rep_, const int wave_s_) {
    PH_FN_BEGIN
    (void)rep_;
    {
        PH_BEGIN;
        const float* wed = CTX_IN(10) + (size_t)L * NE * DF * D;
        LAS int* rowva = (LAS int*)(lds + MOE_LDS_VA); LAS float* roww = (LAS float*)(lds + MOE_LDS_W);
        {
            int* octr = (int*)(ws + WS_CTL + CTL_CNT_OFF + 8192) + (L * 4 + 1 + 2 * (rep_ & 1)) * 64;
            LAS int* slot = (LAS int*)(lds + 140000);
            for (;;) {
                __syncthreads();
                if (tid == 0) { int q; do { q = atomicAdd(octr, 1); } while (q >= NE && q < NE * 5 && cnt[(q - NE) >> 2] <= 512); *slot = q; }
                __syncthreads();
                const int q = *slot;
                if (q >= NE * 5) break;
                const bool ovf = q >= NE;
                const int e = ovf ? (q - NE) >> 2 : q, pz = ovf ? ((q - NE) & 3) * 2 : 0, npz = ovf ? 2 : 8, st0 = ovf ? 1 : 0, n = cnt[e];
                for (int r0 = 0; r0 < n; r0 += 1024) {
                    if (ovf && n - r0 <= 512) break;
#pragma unroll
                    for (int i = 0; i < 2; ++i) { const int idx = r0 + i * 512 + tid; const int va = idx < n ? P_list[(size_t)e * T + idx] : TRASH_VA; rowva[i * 512 + tid] = va; roww[i * 512 + tid] = va < A_TOT ? P_topw[va] : 0.f; }
                    __syncthreads();
                    moe_expert<true>(lds, tid, lane, wave, r32, hi, (const unsigned char*)P_hb, wed + (size_t)e * DF * D, nullptr, (n - r0) < 1024 ? (n - r0) : 1024, (void*)P_yb, pz, npz, st0, 1);
                }
            }
        }
    }
    {
        PH_BEGIN;
        const pg8::Gemm g{P_hbs, (const u16*)(ws + WS_WSD) + (size_t)L * D * DF, T, D, DF};
        const EpiSD E{P_yb};
        int* qctr = (int*)(ws + WS_CTL + CTL_CNT_OFF + 4096) + (L * 4 + 1 + 2 * (rep_ & 1)) * 64;
        LAS int* slot = (LAS int*)(lds + 140000);
        for (;;) {
            __syncthreads();
            if (tid == 0) *slot = atomicAdd(qctr, 1);
            __syncthreads();
            const int un = *slot;
            if (un >= 256) break;
            const pg8::FixedOrder S{un & 63, un >> 6};
            pg8::gemm_phase<EpiSD, pg8::FixedOrder, false>((PG8_LAS unsigned char*)lds, g, S, E, nullptr, wave_s_ * 64 + lane_id_());
        }
    }
}

__device__ __forceinline__ void ph_combine(int L, int rep_, const int wave_s_) {
    PH_FN_BEGIN
    (void)rep_;
    PH_BEGIN;
    const float* lng = CTX_IN(14) + L * D; const float* lnb = CTX_IN(15) + L * D;
    float* dst = L == 0 ? P_x2 : AS_GLOBAL(float, ctx_ld(16));
    for (int row = bid * 8 + wave; row < T; row += G * 8) {
        u32x4 yv[TOPK + 1][2];
#pragma unroll
        for (int k = 0; k < TOPK + 1; ++k) {
            const size_t va = k < TOPK ? (size_t)row * TOPK + k : (size_t)A_TOT + row;
#pragma unroll
            for (int j = 0; j < 2; ++j) yv[k][j] = *(const u32x4*)(P_yb + va * D + j * 512 + lane * 8);
        }
        float v[16];
#pragma unroll
        for (int j = 0; j < 2; ++j) {
            const f32x4 t0 = *(const f32x4*)(P_x1 + (size_t)row * D + j * 512 + lane * 8), t1 = *(const f32x4*)(P_x1 + (size_t)row * D + j * 512 + lane * 8 + 4);
#pragma unroll
            for (int c = 0; c < 4; ++c) { v[j * 8 + c] = DN_ALPHA * t0[c]; v[j * 8 + 4 + c] = DN_ALPHA * t1[c]; }
        }
#pragma unroll
        for (int k = 0; k < TOPK + 1; ++k)
#pragma unroll
            for (int j = 0; j < 2; ++j)
#pragma unroll
                for (int c = 0; c < 4; ++c) { v[j * 8 + 2 * c] += bf2f(yv[k][j][c] & 0xFFFFu); v[j * 8 + 2 * c + 1] += bf2f(yv[k][j][c] >> 16); }
        float sm = 0.f;
#pragma unroll
        for (int i = 0; i < 16; ++i) sm += v[i];
        const float mu = wave_sum(sm) * (1.f / D);
        float q = 0.f;
#pragma unroll
        for (int i = 0; i < 16; ++i) { const float d = v[i] - mu; q += d * d; }
        const float rstd = rsqrtf(wave_sum(q) * (1.f / D) + LN_EPS);
#pragma unroll
        for (int j = 0; j < 2; ++j) {
            const f32x4 g0 = *(const f32x4*)(lng + j * 512 + lane * 8), g1 = *(const f32x4*)(lng + j * 512 + lane * 8 + 4);
            const f32x4 b0 = *(const f32x4*)(lnb + j * 512 + lane * 8), b1 = *(const f32x4*)(lnb + j * 512 + lane * 8 + 4);
            f32x4 o0, o1;
#pragma unroll
            for (int c = 0; c < 4; ++c) { o0[c] = (v[j * 8 + c] - mu) * rstd * g0[c] + b0[c]; o1[c] = (v[j * 8 + 4 + c] - mu) * rstd * g1[c] + b1[c]; }
            *(f32x4*)(dst + (size_t)row * D + j * 512 + lane * 8) = o0; *(f32x4*)(dst + (size_t)row * D + j * 512 + lane * 8 + 4) = o1;
            if (L == 0) { u32x4 w; w[0] = cvtpk(o0[0], o0[1]); w[1] = cvtpk(o0[2], o0[3]); w[2] = cvtpk(o1[0], o1[1]); w[3] = cvtpk(o1[2], o1[3]); *(u32x4*)(P_xb + (size_t)row * D + j * 512 + lane * 8) = w; }
        }
    }
}

__global__ void __launch_bounds__(NTHR, 2) fwd(Args args) {
    extern __shared__ __attribute__((aligned(16))) unsigned char lds_raw[];
    LAS char* lds = (LAS char*)lds_raw;
    unsigned char* const ws = args.ws;
    const int lo = args.ph_lo, hi_ph = args.ph_hi;
    const int wave_s_ = __builtin_amdgcn_readfirstlane(threadIdx.x >> 6);
    if (threadIdx.x < 18) {
        const uint64_t v = threadIdx.x < 16 ? (uint64_t)args.in[threadIdx.x] : (threadIdx.x == 16 ? (uint64_t)args.out : (uint64_t)args.ws);
        ((LAS uint64_t*)(lds + LDS_CTX))[threadIdx.x] = v;
    }
    __syncthreads();
#define IN(k) (lo <= (k) && (k) < hi_ph)

#if MK_ONE_LAUNCH
    if (threadIdx.x < 4) ((LAS unsigned*)(lds + LDS_BAR))[threadIdx.x] = 0u;
    __syncthreads();
    XcdBarrier bar = xcd_barrier_post((unsigned*)(ws + WS_CTL), (volatile LAS unsigned*)(lds + LDS_BAR), wave_s_ == 0 && lane_id_() == 0);
#define GRID_BAR() xcd_barrier(bar, wave_s_ == 0 && lane_id_() == 0)
#else
#define GRID_BAR() do { } while (0)
#endif
#define SEAM(k) do { if (IN(k) && IN((k) + 1)) GRID_BAR(); } while (0)

    for (int rep_ = 0; rep_ < ((IN(0) && PHK(0)) ? REPS(0) : 0); ++rep_) { ph_p0(0, rep_, wave_s_); }
    SEAM(0);

    for (int L = 0; L < 2; ++L) {
        const int pb = 1 + 10 * L;
        for (int rep_ = 0; rep_ < ((IN(pb + 0) && PHK(1)) ? REPS(1) : 0); ++rep_) { ph_qkv(L, rep_, wave_s_); }
        SEAM(pb + 0);

        if (L == 0) {
            for (int rep_ = 0; rep_ < ((IN(pb + 1) && PHK(2)) ? REPS(2) : 0); ++rep_) { ph_kmean(L, rep_, wave_s_); }
            SEAM(pb + 1);
            for (int rep_ = 0; rep_ < ((IN(pb + 2) && PHK(11)) ? REPS(11) : 0); ++rep_) { ph_gate(L, rep_, wave_s_); }
            SEAM(pb + 2);
        }

        if (L == 0) {
            for (int rep_ = 0; rep_ < ((IN(pb + 3) && PHK(3)) ? REPS(3) : 0); ++rep_) { ph_moba(L, rep_, wave_s_); }
            SEAM(pb + 3);
            for (int rep_ = 0; rep_ < ((IN(pb + 4) && PHK(12)) ? REPS(12) : 0); ++rep_) { ph_mobamerge(L, rep_, wave_s_); }
        } else {
            for (int rep_ = 0; rep_ < ((IN(pb + 3) && PHK(4)) ? REPS(4) : 0); ++rep_) { ph_dil(L, rep_, wave_s_); }
            SEAM(pb + 3);
            for (int rep_ = 0; rep_ < ((IN(pb + 4) && PHK(5)) ? REPS(5) : 0); ++rep_) { ph_merge(L, rep_, wave_s_); }
        }
        SEAM(pb + 4);

        for (int rep_ = 0; rep_ < ((IN(pb + 5) && PHK(6)) ? REPS(6) : 0); ++rep_) { ph_wo(L, rep_, wave_s_); }
        SEAM(pb + 5);

        for (int rep_ = 0; rep_ < ((IN(pb + 6) && PHK(7)) ? REPS(7) : 0); ++rep_) { ph_router(L, rep_, wave_s_); }
        SEAM(pb + 6);

        for (int rep_ = 0; rep_ < ((IN(pb + 7) && PHK(8)) ? REPS(8) : 0); ++rep_) { ph_gateup(L, rep_, wave_s_); }
        SEAM(pb + 7);

        for (int rep_ = 0; rep_ < ((IN(pb + 8) && PHK(9)) ? REPS(9) : 0); ++rep_) { ph_down(L, rep_, wave_s_); }
        SEAM(pb + 8);

        for (int rep_ = 0; rep_ < ((IN(pb + 9) && PHK(10)) ? REPS(10) : 0); ++rep_) { ph_combine(L, rep_, wave_s_); }
        if (L == 0) SEAM(pb + 9);
    }
}

extern "C" void kernel_launch(void* const* d_in, const int* in_sizes, int n_in, void* d_out, int out_size, void* d_ws, size_t ws_size, hipStream_t stream) {
    static int grid = 0;
    if (grid == 0) {
        if (n_in != 16 || out_size != T * D || ws_size < WS_END2) { fprintf(stderr, "kernel_launch: unexpected problem (n_in %d out %d ws %zu need %zu)\n", n_in, out_size, ws_size, (size_t)WS_END2); grid = -1; return; }
        int dev = 0, cus = 0, per_cu = 0;
        if (hipGetDevice(&dev) != hipSuccess || hipDeviceGetAttribute(&cus, hipDeviceAttributeMultiprocessorCount, dev) != hipSuccess) { grid = -1; return; }
        if (hipFuncSetAttribute((const void*)fwd, hipFuncAttributeMaxDynamicSharedMemorySize, LDS_BYTES) != hipSuccess) { fprintf(stderr, "kernel_launch: hipFuncSetAttribute failed\n"); grid = -1; return; }
        if (hipOccupancyMaxActiveBlocksPerMultiprocessor(&per_cu, (const void*)fwd, NTHR, LDS_BYTES) != hipSuccess || per_cu < 1) { fprintf(stderr, "kernel_launch: occupancy query says %d\n", per_cu); (void)hipGetLastError(); per_cu = 1; }
        grid = cus;
    }
    if (grid < 0) return;
    (void)hipMemsetAsync((char*)d_ws + WS_CTL, 0, CTL_BYTES, stream);
    Args a{};
    for (int i = 0; i < 16; ++i) a.in[i] = (const float*)d_in[i];
    a.out = (float*)d_out; a.ws = (unsigned char*)d_ws;
#if MK_ONE_LAUNCH
    a.ph_lo = 0; a.ph_hi = N_PHASES;
    hipLaunchKernelGGL(fwd, dim3(grid), dim3(NTHR), LDS_BYTES, stream, a);
#else
    for (int ph = 0; ph < N_PHASES; ++ph) {
        if (ph == 12 || ph == 13) continue;
        a.ph_lo = ph; a.ph_hi = ph + 1;
        hipLaunchKernelGGL(fwd, dim3(grid), dim3(NTHR), LDS_BYTES, stream, a);
    }
#endif
}
```

```cpp
#include <hip/hip_runtime.h>
#include <hip/hip_bf16.h>
#include <stdint.h>
#include <stdio.h>

#ifndef MK_ONE_LAUNCH
#define MK_ONE_LAUNCH 1
#endif

#ifndef PHMASK
#define PHMASK 0x1FFF
#endif
#define PHK(k) ((PHMASK >> (k)) & 1)
#ifndef REPEAT_KIND
#define REPEAT_KIND -1
#endif
#define REPS(k) ((k) == REPEAT_KIND ? 2 : 1)
#define LAS __attribute__((address_space(3)))
typedef __attribute__((ext_vector_type(8))) short bf16x8;
typedef __attribute__((ext_vector_type(16))) float f32x16;
typedef __attribute__((ext_vector_type(4))) float f32x4;
typedef __attribute__((ext_vector_type(4))) unsigned u32x4;
typedef __attribute__((ext_vector_type(2))) unsigned u32x2;
typedef unsigned short u16;

constexpr int D = 1024, BATCH = 2, SEQ = 8192, T = BATCH * SEQ, NH = 16, HD = 64;
constexpr int NE = 256, TOPK = 8, DF = 256;
constexpr int A_TOT = T * TOPK;
constexpr int MOBA_BLK = 256, MOBA_NB = SEQ / MOBA_BLK;
constexpr float DN_ALPHA = 1.4142135623730951f;
constexpr float LN_EPS = 1e-5f;
constexpr float LOG2E = 1.4426950408889634f;
constexpr float LN2 = 0.6931471805599453f;
constexpr float NEGV = -1e30f;
constexpr int NTHR = 512;

constexpr size_t al256(size_t x) { return (x + 255) & ~(size_t)255; }
constexpr size_t WS_CTL = 0;
constexpr size_t CTL_BYTES = 65536;
constexpr size_t CTL_CNT_OFF = 32768;
constexpr size_t WS_XB = WS_CTL + CTL_BYTES;
constexpr size_t WS_X1 = WS_XB + al256((size_t)T * D * 2);
constexpr size_t WS_X2 = WS_X1 + al256((size_t)T * D * 4);
constexpr size_t WS_YPRE = WS_X2 + al256((size_t)T * D * 4);
constexpr size_t WS_QKV = WS_YPRE + al256((size_t)T * D * 4);
constexpr size_t WS_VT = WS_QKV + al256((size_t)T * 9216 * 2);
constexpr size_t WS_KM = WS_VT + al256((size_t)3 * T * D * 2);
constexpr size_t WS_AO = WS_KM + al256((size_t)BATCH * NH * MOBA_NB * HD * 4);
constexpr size_t WS_OG = WS_AO + al256((size_t)T * D * 2);
constexpr size_t WS_LSE = WS_OG + al256((size_t)3 * T * D * 2);
constexpr size_t WS_TOPW = WS_LSE + al256((size_t)3 * T * NH * 4);
constexpr size_t WS_LIST = WS_TOPW + al256((size_t)T * TOPK * 4);
constexpr size_t WS_HB = WS_LIST + al256((size_t)NE * T * 4);
constexpr size_t WS_YB = WS_HB + al256((size_t)(A_TOT + T + 1) * DF * 2);
constexpr size_t WS_END = WS_YB + al256((size_t)(A_TOT + T + 1) * D * 2);
constexpr int TRASH_VA = A_TOT + T;
constexpr size_t WS_SELM = WS_END;
constexpr size_t WS_PART = WS_SELM + al256((size_t)T * NH * 4);
constexpr size_t WS_PLSE = WS_PART + al256((size_t)T * NH * 4 * 64 * 2);
constexpr size_t WS_WQK0 = WS_PLSE + al256((size_t)T * NH * 4 * 4);
constexpr size_t WS_WV0 = WS_WQK0 + (size_t)2048 * 1024 * 2;
constexpr size_t WS_WQK1 = WS_WV0 + (size_t)1024 * 1024 * 2;
constexpr size_t WS_WV1 = WS_WQK1 + (size_t)6144 * 1024 * 2;
constexpr size_t WS_WO = WS_WV1 + (size_t)3072 * 1024 * 2;
constexpr size_t WS_WSGU = WS_WO + (size_t)2 * 1024 * 1024 * 2;
constexpr size_t WS_WSD = WS_WSGU + (size_t)2 * 512 * 1024 * 2;
constexpr size_t WS_XB8 = WS_WSD + (size_t)2 * 1024 * 256 * 2;
constexpr size_t WS_HBS = WS_XB8 + (size_t)T * D;
constexpr size_t WS_WRH = WS_HBS + (size_t)T * DF * 2;
constexpr size_t WS_WRL = WS_WRH + (size_t)2 * 256 * 1024 * 2;
constexpr size_t WS_END2 = WS_WRL + (size_t)2 * 256 * 1024 * 2;

constexpr int LDP = 40;
constexpr int STAGE_BYTES = 2 * 256 * LDP * 2;
constexpr int LDS_ROWID = 2 * STAGE_BYTES;
constexpr int LDS_ROWW = LDS_ROWID + 1024;
constexpr int XS_PITCH = 1028;
constexpr int LDS_BYTES = 163840;
constexpr int LDS_BAR = 161792;

__device__ __forceinline__ int lane_id_() { int l; asm volatile("v_mbcnt_lo_u32_b32 %0, -1, 0\n\tv_mbcnt_hi_u32_b32 %0, -1, %0" : "=v"(l)); return l; }
__device__ __forceinline__ float shxf(float v, int m, int lane) { return __int_as_float(__builtin_amdgcn_ds_bpermute((lane ^ m) << 2, __float_as_int(v))); }
__device__ __forceinline__ int shxi(int v, int m, int lane) { return __builtin_amdgcn_ds_bpermute((lane ^ m) << 2, v); }
#define XB_TMO      128
#define XB_XCNT(j)  (256  + 64 * (j))
#define XB_XSUB(j)  (1280 + 64 * (j))
#define XB_XGEN(j)  (2304 + 64 * (j))
#define XB_TOP      3328
#define XB_TOPGEN   3392
#define XCD_BAR_WORDS 3456
#define XB_SPIN_CAP (1u << 18)
__device__ __forceinline__ unsigned xb_ld(unsigned* p)              { return __hip_atomic_load(p, __ATOMIC_RELAXED, __HIP_MEMORY_SCOPE_AGENT); }
__device__ __forceinline__ unsigned xb_add(unsigned* p, unsigned v) { return __hip_atomic_fetch_add(p, v, __ATOMIC_RELAXED, __HIP_MEMORY_SCOPE_AGENT); }
__device__ __forceinline__ unsigned xb_xcc_id() { return (unsigned)__builtin_amdgcn_s_getreg((3 << 11) | 20) & 0xFu; }
#define XB_SPIN(cond, bar) do { unsigned _sp = 0; while (cond) { __builtin_amdgcn_s_sleep(1); \
    if ((++_sp & 255u) == 0u) { if (xb_ld(&(bar)[XB_TMO])) break; if (_sp > XB_SPIN_CAP) { atomicAdd(&(bar)[XB_TMO], 1u); break; } } } } while (0)
struct XcdBarrier { unsigned* bar; unsigned x; volatile LAS unsigned* st; };
__device__ __forceinline__ XcdBarrier xcd_barrier_post(unsigned* bar, volatile LAS unsigned* st, const bool leader) {
    XcdBarrier b; b.bar = bar; b.x = xb_xcc_id(); b.st = st;
    if (leader) (void)xb_add(&bar[XB_XCNT(b.x)], 1u);
    return b;
}
__device__ __forceinline__ void xcd_barrier_complete(unsigned* bar, unsigned x, unsigned& nloc, unsigned& nx) {
    const unsigned G = gridDim.x * gridDim.y * gridDim.z;
    unsigned sum, cnt, mine, sp = 0u;
    for (;;) {
        sum = 0u; cnt = 0u; mine = 0u;
#pragma unroll
        for (unsigned j = 0; j < 16; ++j) { const unsigned c = xb_ld(&bar[XB_XCNT(j)]); sum += c; cnt += (c > 0u) ? 1u : 0u; mine = (j == x) ? c : mine; }
        if (sum == G) break;
        __builtin_amdgcn_s_sleep(1);
        if ((++sp & 255u) == 0u) { if (xb_ld(&bar[XB_TMO])) break; if (sp > XB_SPIN_CAP) { atomicAdd(&bar[XB_TMO], 1u); break; } }
    }
    nloc = mine > 0u ? mine : 1u; nx = cnt > 0u ? cnt : 1u;
}
__device__ __forceinline__ void xcd_barrier(const XcdBarrier& b, const bool leader) {
    asm volatile("s_waitcnt vmcnt(0)" ::: "memory");
    __syncthreads();
    if (leader) {
        unsigned* bar = b.bar;
        __builtin_amdgcn_s_waitcnt(0);
        unsigned nloc = b.st[0], nx = b.st[1];
        if (nloc == 0u) { xcd_barrier_complete(bar, b.x, nloc, nx); b.st[0] = nloc; b.st[1] = nx; }
        const unsigned old = xb_add(&bar[XB_XSUB(b.x)], 1u);
        const unsigned gen = old / nloc;
        if (old + 1u == (gen + 1u) * nloc) {
            __builtin_amdgcn_fence(__ATOMIC_RELEASE, "agent");
            asm volatile("s_waitcnt vmcnt(0)" ::: "memory");
            const unsigned og = xb_add(&bar[XB_TOP], 1u);
            const unsigned tg = og / nx;
            if (og + 1u == (tg + 1u) * nx) xb_add(&bar[XB_TOPGEN], 1u);
            else XB_SPIN(xb_ld(&bar[XB_TOPGEN]) == tg, bar);
            __builtin_amdgcn_fence(__ATOMIC_ACQUIRE, "agent");
            xb_add(&bar[XB_XGEN(b.x)], 1u);
            asm volatile("s_waitcnt vmcnt(0)" ::: "memory");
        } else {
            XB_SPIN(xb_ld(&bar[XB_XGEN(b.x)]) == gen, bar);
            __builtin_amdgcn_fence(__ATOMIC_ACQUIRE, "agent");
            asm volatile("s_waitcnt vmcnt(0)" ::: "memory");
        }
    }
    __syncthreads();
}

typedef __attribute__((ext_vector_type(2))) __bf16 bf16x2_t;
typedef __attribute__((ext_vector_type(2))) float f32x2_t;
__device__ __forceinline__ unsigned cvtpk(float lo, float hi) { f32x2_t f; f[0] = lo; f[1] = hi; return __builtin_bit_cast(unsigned, __builtin_convertvector(f, bf16x2_t)); }
__device__ __forceinline__ float bf2f(unsigned v16) { return __uint_as_float(v16 << 16); }
__device__ __forceinline__ int crow(int r, int hi) { return (r & 3) + 8 * (r >> 2) + 4 * hi; }
#define MFMA_BF16(a, b, c) __builtin_amdgcn_mfma_f32_32x32x16_bf16(a, b, c, 0, 0, 0)
__device__ __forceinline__ float wave_sum(float v) {
    v += __int_as_float(__builtin_amdgcn_update_dpp(0, __float_as_int(v), 0xB1, 0xF, 0xF, true));
    v += __int_as_float(__builtin_amdgcn_update_dpp(0, __float_as_int(v), 0x4E, 0xF, 0xF, true));
    v += __int_as_float(__builtin_amdgcn_update_dpp(0, __float_as_int(v), 0x141, 0xF, 0xF, true));
    v += __int_as_float(__builtin_amdgcn_update_dpp(0, __float_as_int(v), 0x140, 0xF, 0xF, true));
    const int vi = __float_as_int(v);
    return (__int_as_float(__builtin_amdgcn_readlane(vi, 0)) + __int_as_float(__builtin_amdgcn_readlane(vi, 16))) + (__int_as_float(__builtin_amdgcn_readlane(vi, 32)) + __int_as_float(__builtin_amdgcn_readlane(vi, 48)));
}

namespace pg8 {
#define PG8_LAS __attribute__((address_space(3)))
typedef unsigned short bf16_t;
typedef short bf16x8 __attribute__((ext_vector_type(8)));
typedef float f32x4 __attribute__((ext_vector_type(4)));
typedef unsigned u32x4 __attribute__((ext_vector_type(4)));
constexpr int BM = 256, BK = 64, HALF = 128, HTB = HALF * BK * 2  , STAGE_BYTES = 8 * HTB, NXCD = 8, WGM = 8;

__host__ __device__ __forceinline__ int lds_byte(int r, int c) { const int st = (r >> 4) * 2 + (c >> 5), rr = r & 15, cc = c & 31, ob = rr * 64 + cc * 2; return st * 1024 + (ob ^ (((ob >> 9) & 1) << 5)); }
__host__ __device__ __forceinline__ void stage_rc(int b, int& R, int& C) { const int st = b / 1024, sb = b % 1024, swz = sb ^ (((sb >> 9) & 1) << 5); R = (st >> 1) * 16 + swz / 64; C = (st & 1) * 32 + (swz % 64) / 2; }
__host__ __device__ __forceinline__ int perm32(int rho) { const int n = rho >> 4, i = rho & 15; return 8 * (i >> 2) + 4 * n + (i & 3); }

struct Unit { int pm, pn; };
struct Gemm { const bf16_t* A; const bf16_t* Bt; int M, N, K; };
struct FixedOrder {
    int pm, pn;
    __device__ __forceinline__ bool next(int i, Unit& u) const { if (i != 0) return false; u.pm = pm; u.pn = pn; return true; }
    __device__ __forceinline__ void a_ready(const Unit&) const {}
    __device__ __forceinline__ void done(const Unit&) const {}
};

struct StaticOrder {
    int nM, nN, nwg, G, c;
    __host__ __device__ void init(int M, int N, int G_, int c_) { nM = M / BM; nN = N / BM; nwg = nM * nN; G = G_; c = c_; }
    __host__ __device__ bool next(int i, Unit& u) const {
        const long L = (long)i * G + c; if (L >= nwg) return false;
        int wgid = (int)L; { const int q = nwg / NXCD, r = nwg % NXCD, xcd = wgid % NXCD, off = wgid / NXCD; wgid = (xcd < r ? xcd * (q + 1) : r * (q + 1) + (xcd - r) * q) + off; }
        const int nig = WGM * nN, gid = wgid / nig, fm = gid * WGM, gsz = (nM - fm) < WGM ? (nM - fm) : WGM;
        u.pm = fm + ((wgid % nig) % gsz); u.pn = (wgid % nig) / gsz; return true;
    }
    __device__ __forceinline__ void a_ready(const Unit&) const {}
    __device__ __forceinline__ void done(const Unit&) const {}
};

template <class Epi, class Sched, bool SWAP = false, bool STAMP = false>
__device__ __forceinline__ void gemm_phase(PG8_LAS unsigned char* lds, const Gemm g, const Sched& S, const Epi& E, unsigned long long* stamps, const int tid_in) {
    int tid_ = tid_in; asm volatile("" : "+v"(tid_));
    const int tid = tid_, wid = __builtin_amdgcn_readfirstlane(tid >> 6), lane = tid & 63, wr = wid >> 2, wc = wid & 3, fr = lane & 15, fq = lane >> 4;
    const int K = g.K, nt = K / BK;
    int ts_lo = 0, ts_hi = 0, nts = 0; const unsigned long long rt_entry = STAMP ? (unsigned long long)wall_clock64() : 0ull;
#define PG8_STAMP() do { if (STAMP && wid == 0 && nts < 64) { const unsigned long long _c = (unsigned long long)clock64(); \
        ts_lo = (lane == nts) ? (int)(unsigned)_c : ts_lo; ts_hi = (lane == nts) ? (int)(unsigned)(_c >> 32) : ts_hi; ++nts; } } while (0)
    PG8_STAMP();
    unsigned voffA[2], voffB[2];
#pragma unroll
    for (int i = 0; i < 2; ++i) { int R, C; stage_rc(tid * 16 + i * 8192, R, C); const int Rb = Epi::PERM ? ((R & ~31) + perm32(R & 31)) : R;
        voffA[i] = (unsigned)(R * K + C) * 2u; voffB[i] = (unsigned)(Rb * K + C) * 2u; }
    const size_t kstep = (size_t)(BK * 2);
    const size_t hstep = (size_t)HALF * K * 2;
    const size_t tstep = 2 * hstep;
    const unsigned ldsw = (unsigned)wid * 1024u;
    const int aoff = lds_byte(wr * 64 + fr, fq * 8), boff = lds_byte(wc * 32 + fr, fq * 8);
#define PG8_SA(b, h) (((b) * 2 + (h)) * HTB)
#define PG8_SB(b, h) ((4 + (b) * 2 + (h)) * HTB)
#define PG8_STAGE(bufoff, gbase, voff) do { _Pragma("unroll") for (int _i = 0; _i < 2; ++_i) \
        __builtin_amdgcn_global_load_lds((const unsigned*)((const char*)(gbase) + (voff)[_i]), (PG8_LAS unsigned*)(lds + (bufoff) + ldsw + _i * 8192), 16, 0, 0); } while (0)
#define PG8_LDA(dst, b, h) do { _Pragma("unroll") for (int m = 0; m < 4; ++m) _Pragma("unroll") for (int k = 0; k < 2; ++k) dst[m][k] = *(const PG8_LAS bf16x8*)(lds + PG8_SA(b, h) + aoff + m * 2048 + k * 1024); } while (0)
#define PG8_LDB(dst, b, h) do { _Pragma("unroll") for (int n = 0; n < 2; ++n) _Pragma("unroll") for (int k = 0; k < 2; ++k) dst[n][k] = *(const PG8_LAS bf16x8*)(lds + PG8_SB(b, h) + boff + n * 2048 + k * 1024); } while (0)
#define PG8_MMA(ai, bj, At, Bt) do { __builtin_amdgcn_s_setprio(1); _Pragma("unroll") for (int m = 0; m < 4; ++m) _Pragma("unroll") for (int n = 0; n < 2; ++n) _Pragma("unroll") for (int k = 0; k < 2; ++k) \
        acc[ai][bj][m][n] = SWAP ? __builtin_amdgcn_mfma_f32_16x16x32_bf16(At[m][k], Bt[n][k], acc[ai][bj][m][n], 0, 0, 0) : __builtin_amdgcn_mfma_f32_16x16x32_bf16(Bt[n][k], At[m][k], acc[ai][bj][m][n], 0, 0, 0); __builtin_amdgcn_s_setprio(0); } while (0)
#define PG8_WAIT_V(n) asm volatile("s_waitcnt vmcnt(" #n ")" ::: "memory")
#define PG8_WAIT_L(n) asm volatile("s_waitcnt lgkmcnt(" #n ")" ::: "memory")
#define PG8_BAR __builtin_amdgcn_s_barrier()
#define PG8_SCHED __builtin_amdgcn_sched_barrier(0)
    Unit cur, nxt; int ui = 0;
    if (!S.next(0, cur)) return;
    f32x4 acc[2][2][4][2];
#pragma unroll
    for (int a = 0; a < 2; ++a)
#pragma unroll
        for (int b = 0; b < 2; ++b)
#pragma unroll
            for (int m = 0; m < 4; ++m)
#pragma unroll
                for (int n = 0; n < 2; ++n) acc[a][b][m][n] = (f32x4){0.f, 0.f, 0.f, 0.f};
    bf16x8 At[4][2], B0[2][2], B1[2][2];
    const char* cA = (const char*)g.A + (size_t)cur.pm * tstep; const char* cB = (const char*)g.Bt + (size_t)cur.pn * tstep;
    S.a_ready(cur);
    PG8_STAGE(PG8_SB(0, 0), cB, voffB); PG8_STAGE(PG8_SA(0, 0), cA, voffA); PG8_STAGE(PG8_SB(0, 1), cB + hstep, voffB); PG8_STAGE(PG8_SA(0, 1), cA + hstep, voffA);
    if (wr == 1) PG8_BAR;
    PG8_WAIT_V(4); PG8_BAR;
    PG8_STAGE(PG8_SB(1, 0), cB + kstep, voffB); PG8_STAGE(PG8_SA(1, 0), cA + kstep, voffA); PG8_STAGE(PG8_SB(1, 1), cB + hstep + kstep, voffB);
    PG8_WAIT_V(6); PG8_BAR;
    PG8_STAMP();
    for (;;) {
        const bool has_next = S.next(ui + 1, nxt);
        const char* nA = has_next ? (const char*)g.A + (size_t)nxt.pm * tstep : cA; const char* nB = has_next ? (const char*)g.Bt + (size_t)nxt.pn * tstep : cB;
        for (int t = 0; t < nt; t += 2) {
            const bool last = (t == nt - 2);
            const char* a1 = cA + (size_t)(t + 1) * kstep;
            const char* a2 = last ? nA : cA + (size_t)(t + 2) * kstep; const char* b2 = last ? nB : cB + (size_t)(t + 2) * kstep;
            const char* a3 = a2 + kstep; const char* b3 = b2 + kstep;
            if (last && has_next) S.a_ready(nxt);
            PG8_LDB(B0, 0, 0); PG8_SCHED; PG8_LDA(At, 0, 0); PG8_STAGE(PG8_SA(1, 1), a1 + hstep, voffA);
            PG8_WAIT_L(8); PG8_BAR; PG8_WAIT_L(0); PG8_MMA(0, 0, At, B0); PG8_BAR; PG8_SCHED;
            PG8_LDB(B1, 0, 1); PG8_STAGE(PG8_SB(0, 0), b2, voffB);
            PG8_BAR; PG8_WAIT_L(0); PG8_MMA(0, 1, At, B1); PG8_BAR;
            PG8_LDA(At, 0, 1); PG8_STAGE(PG8_SA(0, 0), a2, voffA);
            PG8_BAR; PG8_WAIT_L(0); PG8_MMA(1, 0, At, B0); PG8_BAR; PG8_SCHED;
            PG8_STAGE(PG8_SB(0, 1), b2 + hstep, voffB);
            PG8_WAIT_V(6); PG8_BAR; PG8_MMA(1, 1, At, B1); PG8_BAR;
            PG8_LDB(B0, 1, 0); PG8_SCHED; PG8_LDA(At, 1, 0); PG8_STAGE(PG8_SA(0, 1), a2 + hstep, voffA);
            PG8_WAIT_L(8); PG8_BAR; PG8_WAIT_L(0); PG8_MMA(0, 0, At, B0); PG8_BAR; PG8_SCHED;
            PG8_LDB(B1, 1, 1); PG8_STAGE(PG8_SB(1, 0), b3, voffB);
            PG8_BAR; PG8_WAIT_L(0); PG8_MMA(0, 1, At, B1); PG8_BAR;
            PG8_LDA(At, 1, 1); PG8_STAGE(PG8_SA(1, 0), a3, voffA);
            PG8_BAR; PG8_WAIT_L(0); PG8_MMA(1, 0, At, B0); PG8_BAR; PG8_SCHED;
            PG8_STAGE(PG8_SB(1, 1), b3 + hstep, voffB);
            PG8_WAIT_V(6); PG8_BAR; PG8_MMA(1, 1, At, B1); PG8_BAR;
        }
        PG8_STAMP();
        if constexpr (!Epi::AFTER_DRAIN) { E(acc, cur, wr, wc, fr, fq); S.done(cur); }
        PG8_STAMP();
        if (!has_next) break;
#pragma unroll
        for (int a = 0; a < 2; ++a)
#pragma unroll
            for (int b = 0; b < 2; ++b)
#pragma unroll
                for (int m = 0; m < 4; ++m)
#pragma unroll
                    for (int n = 0; n < 2; ++n) acc[a][b][m][n] = (f32x4){0.f, 0.f, 0.f, 0.f};
        cur = nxt; cA = nA; cB = nB; ++ui;
    }
    PG8_WAIT_V(0);
    if (wr == 0) PG8_BAR;
    PG8_BAR;
    if constexpr (Epi::AFTER_DRAIN) { E.fused(acc, cur, wr, wc, fr, fq, lds, wid, lane); S.done(cur); }
    PG8_STAMP();
    if (STAMP && wid == 0) { stamps[lane] = lane < nts ? (((unsigned long long)(unsigned)ts_hi << 32) | (unsigned)ts_lo) : 0ull;
        if (lane == 62) stamps[62] = rt_entry; if (lane == 63) stamps[63] = (unsigned long long)wall_clock64(); }
#undef PG8_STAMP
#undef PG8_SA
#undef PG8_SB
#undef PG8_STAGE
#undef PG8_LDA
#undef PG8_LDB
#undef PG8_MMA
#undef PG8_WAIT_V
#undef PG8_WAIT_L
#undef PG8_BAR
#undef PG8_SCHED
}
}

struct EpiQK {
    static constexpr bool PERM = true, AFTER_DRAIN = false;
    u16* O; int ldc;
    __device__ __forceinline__ void operator()(const pg8::f32x4 (&acc)[2][2][4][2], const pg8::Unit& u, int wr, int wc, int fr, int fq) const {
        const int col0 = u.pn * 256 + wc * 32 + 8 * fq, row0 = u.pm * 256 + wr * 64 + fr;
#pragma unroll
        for (int ai = 0; ai < 2; ++ai)
#pragma unroll
            for (int m = 0; m < 4; ++m) { u16* rowp = O + (size_t)(row0 + ai * 128 + m * 16) * ldc + col0;
#pragma unroll
                for (int bj = 0; bj < 2; ++bj) { const pg8::f32x4 v0 = acc[ai][bj][m][0], v1 = acc[ai][bj][m][1];
                    u32x4 w; w[0] = cvtpk(v0[0], v0[1]); w[1] = cvtpk(v0[2], v0[3]); w[2] = cvtpk(v1[0], v1[1]); w[3] = cvtpk(v1[2], v1[3]);
                    *(u32x4*)(rowp + bj * 128) = w; } }
    }
};
struct EpiV {
    static constexpr bool PERM = false, AFTER_DRAIN = false;
    u16* VT; int layer;
    __device__ __forceinline__ void operator()(const pg8::f32x4 (&acc)[2][2][4][2], const pg8::Unit& u, int wr, int wc, int fr, int fq) const {
        const int colt = u.pn * 256, grp = colt >> 10;
        const int dil = (layer == 0 || grp == 0) ? 1 : (grp == 1 ? 4 : 16);
        const int rowb = u.pm * 256 + wr * 64 + 4 * fq;
#pragma unroll
        for (int bj = 0; bj < 2; ++bj)
#pragma unroll
            for (int n = 0; n < 2; ++n) {
                const int c = (colt & 1023) + bj * 128 + wc * 32 + n * 16 + fr, h = c >> 6, d = c & 63;
#pragma unroll
                for (int ai = 0; ai < 2; ++ai)
#pragma unroll
                    for (int m = 0; m < 4; ++m) {
                        const int r0 = rowb + ai * 128 + m * 16, b = r0 >> 13, t0 = r0 & (SEQ - 1);
                        u16* vrow = VT + (size_t)grp * T * D + ((size_t)(b * NH + h) * HD + d) * SEQ;
                        const pg8::f32x4 v = acc[ai][bj][m][n];
                        if (dil == 1) { u32x2 w; w[0] = cvtpk(v[0], v[1]); w[1] = cvtpk(v[2], v[3]); *(u32x2*)(vrow + t0) = w; }
                        else {
#pragma unroll
                            for (int i = 0; i < 4; ++i) { const int pp = t0 + i; vrow[(pp % dil) * (SEQ / dil) + pp / dil] = (u16)cvtpk(v[i], 0.f); }
                        }
                    }
            }
    }
};
struct EpiWo {
    static constexpr bool PERM = false, AFTER_DRAIN = false;
    float* Y; const float* X;
    __device__ __forceinline__ void operator()(const pg8::f32x4 (&acc)[2][2][4][2], const pg8::Unit& u, int wr, int wc, int fr, int fq) const {
        const int row0 = u.pm * 256 + wr * 64 + fr, col0 = u.pn * 256 + wc * 32 + 4 * fq;
#pragma unroll
        for (int ai = 0; ai < 2; ++ai)
#pragma unroll
            for (int m = 0; m < 4; ++m) { const size_t ro = (size_t)(row0 + ai * 128 + m * 16) * D + col0;
#pragma unroll
                for (int bj = 0; bj < 2; ++bj)
#pragma unroll
                    for (int n = 0; n < 2; ++n) { const pg8::f32x4 x = *(const pg8::f32x4*)(X + ro + bj * 128 + n * 16); *(pg8::f32x4*)(Y + ro + bj * 128 + n * 16) = x * DN_ALPHA + acc[ai][bj][m][n]; } }
    }
};
struct EpiSGU {
    static constexpr bool PERM = true, AFTER_DRAIN = false;
    u16* H;
    __device__ __forceinline__ void operator()(const pg8::f32x4 (&acc)[2][2][4][2], const pg8::Unit& u, int wr, int wc, int fr, int fq) const {
        const int row0 = u.pm * 256 + wr * 64 + fr, f0 = u.pn * 128 + wc * 32 + 8 * fq;
#pragma unroll
        for (int ai = 0; ai < 2; ++ai)
#pragma unroll
            for (int m = 0; m < 4; ++m) {
                float hv[8];
#pragma unroll
                for (int n = 0; n < 2; ++n)
#pragma unroll
                    for (int i = 0; i < 4; ++i) { const float gt = acc[ai][0][m][n][i], up = acc[ai][1][m][n][i]; hv[n * 4 + i] = gt / (1.f + __expf(-gt)) * up; }
                u32x4 w; w[0] = cvtpk(hv[0], hv[1]); w[1] = cvtpk(hv[2], hv[3]); w[2] = cvtpk(hv[4], hv[5]); w[3] = cvtpk(hv[6], hv[7]);
                *(u32x4*)(H + (size_t)(row0 + ai * 128 + m * 16) * DF + f0) = w;
            }
    }
};
struct EpiSD {
    static constexpr bool PERM = true, AFTER_DRAIN = false;
    u16* Y;
    __device__ __forceinline__ void operator()(const pg8::f32x4 (&acc)[2][2][4][2], const pg8::Unit& u, int wr, int wc, int fr, int fq) const {
        const int row0 = u.pm * 256 + wr * 64 + fr, col0 = u.pn * 256 + wc * 32 + 8 * fq;
#pragma unroll
        for (int ai = 0; ai < 2; ++ai)
#pragma unroll
            for (int m = 0; m < 4; ++m) { u16* rowp = Y + (size_t)(A_TOT + row0 + ai * 128 + m * 16) * D + col0;
#pragma unroll
                for (int bj = 0; bj < 2; ++bj) { const pg8::f32x4 v0 = acc[ai][bj][m][0], v1 = acc[ai][bj][m][1];
                    u32x4 w; w[0] = cvtpk(v0[0], v0[1]); w[1] = cvtpk(v0[2], v0[3]); w[2] = cvtpk(v1[0], v1[1]); w[3] = cvtpk(v1[2], v1[3]);
                    *(u32x4*)(rowp + bj * 128) = w; } }
    }
};

struct Args {
    const float* in[16];
    float* out;
    unsigned char* ws;
    int ph_lo, ph_hi;
};

#define GEMM_CORE(K_, PA0, PA1, PB, LDB)                                                                                                   \
    {                                                                                                                                      \
        const int g_tid = tid, g_lane = lane, g_wave = wave, g_r32 = r32, g_hi = hi;                   \
        const int g_wm = g_wave >> 2, g_wn = g_wave & 3, g_kc = g_tid & 3, g_kq = g_lane >> 3, g_n4 = g_lane & 7;                           \
        const u16* g_pa0 = (PA0); const u16* g_pa1 = (PA1);                                                                                \
        const size_t g_ldb = (size_t)(LDB);                                                                                                \
        const float* g_pb = (PB) + (size_t)(g_kq * 4) * g_ldb + g_n4 * 4;                                                                  \
        const int g_nk = (K_) / 32;                                                                                                        \
        u32x4 g_ra0, g_ra1; f32x4 g_rb0, g_rb1, g_rb2, g_rb3;                                                                              \
        const u32x4 g_z = {0u, 0u, 0u, 0u};                                                                                                \
        _Pragma("unroll") for (int mb = 0; mb < 4; ++mb) { _Pragma("unroll") for (int nb = 0; nb < 2; ++nb) { _Pragma("unroll") for (int r = 0; r < 16; ++r) acc[mb][nb][r] = 0.f; } } \
        g_ra0 = g_pa0 ? *(const u32x4*)(g_pa0 + g_kc * 8) : g_z; g_ra1 = g_pa1 ? *(const u32x4*)(g_pa1 + g_kc * 8) : g_z;                 \
        g_rb0 = *(const f32x4*)(g_pb); g_rb1 = *(const f32x4*)(g_pb + g_ldb); g_rb2 = *(const f32x4*)(g_pb + 2 * g_ldb); g_rb3 = *(const f32x4*)(g_pb + 3 * g_ldb); \
        _Pragma("unroll 1") for (int kt = 0; kt < g_nk; ++kt) {                                                                            \
            LAS char* As = lds + (kt & 1) * STAGE_BYTES; LAS char* Bs = As + 256 * LDP * 2;                                                \
            *(LAS u32x4*)(As + ((g_tid >> 2) * LDP + g_kc * 8) * 2) = g_ra0;                                                               \
            *(LAS u32x4*)(As + (((g_tid >> 2) + 128) * LDP + g_kc * 8) * 2) = g_ra1;                                                       \
            _Pragma("unroll") for (int i = 0; i < 4; ++i) {                                                                                \
                u32x2 w; w[0] = cvtpk(g_rb0[i], g_rb1[i]); w[1] = cvtpk(g_rb2[i], g_rb3[i]);                                               \
                *(LAS u32x2*)(Bs + ((g_wave * 32 + i * 8 + g_n4) * LDP + g_kq * 4) * 2) = w;                                               \
            }                                                                                                                              \
            __syncthreads();                                                                                                               \
            if (kt + 1 < g_nk) {                                                                                                           \
                const int ko = (kt + 1) * 32;                                                                                              \
                g_ra0 = g_pa0 ? *(const u32x4*)(g_pa0 + ko + g_kc * 8) : g_z; g_ra1 = g_pa1 ? *(const u32x4*)(g_pa1 + ko + g_kc * 8) : g_z; \
                const float* pbk = g_pb + (size_t)ko * g_ldb;                                                                              \
                g_rb0 = *(const f32x4*)(pbk); g_rb1 = *(const f32x4*)(pbk + g_ldb); g_rb2 = *(const f32x4*)(pbk + 2 * g_ldb); g_rb3 = *(const f32x4*)(pbk + 3 * g_ldb); \
            }                                                                                                                              \
            _Pragma("unroll") for (int s = 0; s < 2; ++s) {                                                                                \
                bf16x8 af[4], bfr[2];                                                                                                      \
                _Pragma("unroll") for (int mb = 0; mb < 4; ++mb) af[mb] = *(LAS bf16x8*)(As + ((g_wm * 128 + mb * 32 + g_r32) * LDP + s * 16 + g_hi * 8) * 2); \
                _Pragma("unroll") for (int nb = 0; nb < 2; ++nb) bfr[nb] = *(LAS bf16x8*)(Bs + (((g_wn * 2 + nb) * 32 + g_r32) * LDP + s * 16 + g_hi * 8) * 2); \
                _Pragma("unroll") for (int mb = 0; mb < 4; ++mb) { _Pragma("unroll") for (int nb = 0; nb < 2; ++nb) acc[mb][nb] = MFMA_BF16(af[mb], bfr[nb], acc[mb][nb]); } \
            }                                                                                                                              \
        }                                                                                                                                  \
        __syncthreads();                                                                                                                   \
    }

struct AttnSt { float m, l; f32x16 o0, o1; };

struct AttnFr { bf16x8 k[4]; bf16x8 v[4]; };
__device__ __forceinline__ void attn_load(AttnFr& f, const u16* krow, const u16* vt, size_t vt_dstride) {
#pragma unroll
    for (int d0 = 0; d0 < 4; ++d0) f.k[d0] = *(const bf16x8*)(krow + d0 * 16);
    const u16* vt1 = vt + 32 * vt_dstride;
    union { bf16x8 v; u32x2 h[2]; } va;
    va.h[0] = *(const u32x2*)(vt);       va.h[1] = *(const u32x2*)(vt + 8);   f.v[0] = va.v;
    va.h[0] = *(const u32x2*)(vt + 16);  va.h[1] = *(const u32x2*)(vt + 24);  f.v[1] = va.v;
    va.h[0] = *(const u32x2*)(vt1);      va.h[1] = *(const u32x2*)(vt1 + 8);  f.v[2] = va.v;
    va.h[0] = *(const u32x2*)(vt1 + 16); va.h[1] = *(const u32x2*)(vt1 + 24); f.v[3] = va.v;
}
__device__ __forceinline__ void attn_compute(AttnSt& st, const bf16x8 (&qf)[4], const AttnFr& f, int dist0, float bslope, int dlo, int dhi, int hi, int lane) {
    f32x16 p;
#pragma unroll
    for (int r = 0; r < 16; ++r) p[r] = 0.f;
#pragma unroll
    for (int d0 = 0; d0 < 4; ++d0) p = MFMA_BF16(f.k[d0], qf[d0], p);
    constexpr float C2 = 0.125f * LOG2E;
    float mx = NEGV;
#pragma unroll
    for (int r = 0; r < 16; ++r) {
        const int dist = dist0 - ((r & 3) + 8 * (r >> 2));
        const float sc = __builtin_fmaf(p[r], C2, -bslope * (float)dist);
        const float s_ = (dist >= dlo && dist <= dhi) ? sc : NEGV;
        p[r] = s_; mx = fmaxf(mx, s_);
    }
    mx = fmaxf(mx, shxf(mx, 32, lane));
    const float mnew = fmaxf(st.m, mx);
    const float alpha = __builtin_amdgcn_exp2f(st.m - mnew);
    st.m = mnew;
    float ls = 0.f;
#pragma unroll
    for (int r = 0; r < 16; ++r) { p[r] = __builtin_amdgcn_exp2f(p[r] - mnew); ls += p[r]; }
    st.l = st.l * alpha + ls;
#pragma unroll
    for (int r = 0; r < 16; ++r) { st.o0[r] *= alpha; st.o1[r] *= alpha; }
    union { bf16x8 v; unsigned u[4]; } pb0, pb1;
#pragma unroll
    for (int j = 0; j < 4; ++j) { pb0.u[j] = cvtpk(p[2 * j], p[2 * j + 1]); pb1.u[j] = cvtpk(p[8 + 2 * j], p[8 + 2 * j + 1]); }
    st.o0 = MFMA_BF16(f.v[0], pb0.v, st.o0);
    st.o0 = MFMA_BF16(f.v[1], pb1.v, st.o0);
    st.o1 = MFMA_BF16(f.v[2], pb0.v, st.o1);
    st.o1 = MFMA_BF16(f.v[3], pb1.v, st.o1);
    (void)hi;
}

__device__ __forceinline__ float dpp_rowmax(float v) {
    v = fmaxf(v, __int_as_float(__builtin_amdgcn_update_dpp(0, __float_as_int(v), 0xB1, 0xF, 0xF, true)));
    v = fmaxf(v, __int_as_float(__builtin_amdgcn_update_dpp(0, __float_as_int(v), 0x4E, 0xF, 0xF, true)));
    v = fmaxf(v, __int_as_float(__builtin_amdgcn_update_dpp(0, __float_as_int(v), 0x141, 0xF, 0xF, true)));
    v = fmaxf(v, __int_as_float(__builtin_amdgcn_update_dpp(0, __float_as_int(v), 0x140, 0xF, 0xF, true)));
    return v;
}
__device__ __forceinline__ int dpp_rowmin_i(int v) {
    v = min(v, __builtin_amdgcn_update_dpp(0, v, 0xB1, 0xF, 0xF, true));
    v = min(v, __builtin_amdgcn_update_dpp(0, v, 0x4E, 0xF, 0xF, true));
    v = min(v, __builtin_amdgcn_update_dpp(0, v, 0x141, 0xF, 0xF, true));
    v = min(v, __builtin_amdgcn_update_dpp(0, v, 0x140, 0xF, 0xF, true));
    return v;
}
__device__ __forceinline__ float rl_f(float v, int l) { return __int_as_float(__builtin_amdgcn_readlane(__float_as_int(v), l)); }

__device__ __forceinline__ void top3_insert(float v, int i, float& v0, int& i0, float& v1, int& i1, float& v2, int& i2) {
    const bool b0 = (v > v0) || (v == v0 && i < i0);
    const bool b1 = (v > v1) || (v == v1 && i < i1);
    const bool b2 = (v > v2) || (v == v2 && i < i2);
    const float nv2 = b1 ? v1 : (b2 ? v : v2); const int ni2 = b1 ? i1 : (b2 ? i : i2);
    const float nv1 = b0 ? v0 : (b1 ? v : v1); const int ni1 = b0 ? i0 : (b1 ? i : i1);
    const float nv0 = b0 ? v : v0;             const int ni0 = b0 ? i : i0;
    v0 = nv0; i0 = ni0; v1 = nv1; i1 = ni1; v2 = nv2; i2 = ni2;
}

__device__ __forceinline__ void ln_row(float (&v)[16], const float* __restrict__ g, const float* __restrict__ b, int lane) {
    float s = 0.f;
#pragma unroll
    for (int i = 0; i < 16; ++i) s += v[i];
    const float mu = wave_sum(s) * (1.f / D);
    float q = 0.f;
#pragma unroll
    for (int i = 0; i < 16; ++i) { const float d = v[i] - mu; q += d * d; }
    const float rstd = rsqrtf(wave_sum(q) * (1.f / D) + LN_EPS);
#pragma unroll
    for (int j = 0; j < 4; ++j) {
        const f32x4 gg = *(const f32x4*)(g + j * 256 + lane * 4), bb = *(const f32x4*)(b + j * 256 + lane * 4);
#pragma unroll
        for (int c = 0; c < 4; ++c) v[j * 4 + c] = (v[j * 4 + c] - mu) * rstd * gg[c] + bb[c];
    }
}

typedef __attribute__((ext_vector_type(2))) float f32x2_;
__device__ __forceinline__ bf16x8 fp8x8_to_bf16(unsigned lo, unsigned hi_) {
    const f32x2_ a = __builtin_amdgcn_cvt_pk_f32_fp8((int)lo, false), b = __builtin_amdgcn_cvt_pk_f32_fp8((int)lo, true);
    const f32x2_ c = __builtin_amdgcn_cvt_pk_f32_fp8((int)hi_, false), d = __builtin_amdgcn_cvt_pk_f32_fp8((int)hi_, true);
    union { bf16x8 v; unsigned u[4]; } r;
    r.u[0] = cvtpk(a[0], a[1]); r.u[1] = cvtpk(b[0], b[1]); r.u[2] = cvtpk(c[0], c[1]); r.u[3] = cvtpk(d[0], d[1]);
    return r.v;
}
__device__ __forceinline__ unsigned pack_fp8x4(float a, float b, float c, float d) { int p = __builtin_amdgcn_cvt_pk_fp8_f32(a, b, 0, false); return (unsigned)__builtin_amdgcn_cvt_pk_fp8_f32(c, d, p, true); }

constexpr int MOE_BP = 72;
constexpr int MOE_BSTAGE = 128 * MOE_BP * 2;
constexpr int MOE_LDS_VA = 3 * MOE_BSTAGE;
constexpr int MOE_LDS_W = MOE_LDS_VA + 4096;
template <bool DOWN>
__device__ __forceinline__ void moe_expert(LAS char* lds, const int tid, const int lane, const int wave, const int r32, const int hi,
                                           const unsigned char* __restrict__ abase  , const float* __restrict__ w0, const float* __restrict__ w1, const int ng  , void* __restrict__ outv,
                                           const int pass0, const int npass_, const int st0, const int nstl  , const bool y8 = false  ) {
    constexpr int KT = DOWN ? 4 : 16, NP = DOWN ? 8 : 4, LDB = DOWN ? 1024 : 256, APITCH = DOWN ? 256 : 1024  , PSTEP = DOWN ? 128 : 64;
    LAS int* rowva = (LAS int*)(lds + MOE_LDS_VA); LAS float* roww = (LAS float*)(lds + MOE_LDS_W);
    const int nst = nstl;
    const int nsteps = npass_ * nst * KT; (void)NP;
    unsigned aoff[2];
#define MOE_AOFF(ST_) { _Pragma("unroll") for (int a = 0; a < 2; ++a) { const int va_ = rowva[(ST_) * 512 + wave * 64 + a * 32 + r32]; \
        const int srow_ = DOWN ? va_ : (va_ == TRASH_VA ? 0 : (va_ >> 3)); aoff[a] = (unsigned)srow_ * APITCH + hi * 32; } }
    const int seg = wave >> 1, n4 = lane & 7, kp = (wave & 1) * 16 + (lane >> 3);
    const char* wbase = (const char*)(DOWN ? (w0 + seg * 32) : (((seg < 2) ? w0 : w1) + (seg & 1) * 32));
    const unsigned boff = (unsigned)(4 * n4 + 2 * kp * LDB) * 4u;
    f32x16 acc[2][4];
#pragma unroll
    for (int a = 0; a < 2; ++a)
#pragma unroll
        for (int c = 0; c < 4; ++c)
#pragma unroll
            for (int r = 0; r < 16; ++r) acc[a][c][r] = 0.f;
    u32x4 fa8[2][2];
    f32x4 rb0[4], rb1[4];
#define MOE_DEC(S_) const int s2_ = (S_) < nsteps ? (S_) : 0; const int pl_ = s2_ / (nst * KT); const int rm_ = s2_ - pl_ * (nst * KT); const int sl_ = rm_ / KT; const int kt_ = rm_ - sl_ * KT; const int ps_ = pass0 + pl_; const int stt_ = st0 + sl_;
#define MOE_LOADB(S_, RB) { MOE_DEC(S_) (void)stt_; \
        const char* wp_ = wbase + (size_t)(ps_ * PSTEP + kt_ * 64 * LDB) * 4 + boff; \
        RB[0] = *(const f32x4*)(wp_); RB[1] = *(const f32x4*)(wp_ + LDB * 4); RB[2] = *(const f32x4*)(wp_ + 16 * LDB * 4); RB[3] = *(const f32x4*)(wp_ + 17 * LDB * 4); }
#define MOE_WRITEB(STG, RB) { LAS char* Bs_ = lds + (STG) * MOE_BSTAGE; \
        _Pragma("unroll") for (int i = 0; i < 4; ++i) { LAS unsigned* q_ = (LAS unsigned*)(Bs_ + ((seg * 32 + i * 8 + n4) * MOE_BP + 2 * kp) * 2); q_[0] = cvtpk(RB[0][i], RB[1][i]); q_[8] = cvtpk(RB[2][i], RB[3][i]); } }
#define MOE_COMPUTE(STG, DO_MFMA) { LAS char* Bs_ = lds + (STG) * MOE_BSTAGE; \
        _Pragma("unroll") for (int u = 0; u < 4; ++u) { \
            bf16x8 bfr[4]; \
            if (DO_MFMA) { _Pragma("unroll") for (int c = 0; c < 4; ++c) bfr[c] = *(LAS bf16x8*)(Bs_ + ((c * 32 + r32) * MOE_BP + hi * 32 + u * 8) * 2); } \
            _Pragma("unroll") for (int a = 0; a < 2; ++a) { \
                if (DO_MFMA) { const bf16x8 af_ = fp8x8_to_bf16(fa8[a][u >> 1][(u & 1) * 2], fa8[a][u >> 1][(u & 1) * 2 + 1]); \
                    _Pragma("unroll") for (int c = 0; c < 4; ++c) acc[a][c] = MFMA_BF16(bfr[c], af_, acc[a][c]); } \
                if (u & 1) fa8[a][u >> 1] = *(const u32x4*)(ab_n + aoff[a] + (u >> 1) * 16); \
            } \
        } }
#define MOE_NEXTA(S_) MOE_DEC(S_) (void)ps_; \
        if (stt_ != st_loaded) { MOE_AOFF(stt_) st_loaded = stt_; } \
        const char* ab_n = (const char*)abase + kt_ * 64;
    int st_loaded = st0;
    MOE_AOFF(st0)
    { const char* ab0 = (const char*)abase;
#pragma unroll
      for (int a = 0; a < 2; ++a)
#pragma unroll
          for (int h2 = 0; h2 < 2; ++h2) fa8[a][h2] = *(const u32x4*)(ab0 + aoff[a] + h2 * 16); }
    MOE_LOADB(0, rb0)
    MOE_LOADB(1, rb1)
    MOE_WRITEB(0, rb0)
    MOE_LOADB(2, rb0)
    int stg = 0;
#pragma unroll 1
    for (int sidx = 0; sidx < nsteps; sidx += 2) {
        const int pl = sidx / (nst * KT); const int rm = sidx - pl * (nst * KT); const int sl = rm / KT; const int kt = rm - sl * KT; const int ps = pass0 + pl, stt = st0 + sl;
        const bool wv = (wave * 64) < (ng - stt * 512);
        const int stg1 = stg == 2 ? 0 : stg + 1, stg2 = stg1 == 2 ? 0 : stg1 + 1;
        __syncthreads();
        MOE_WRITEB(stg1, rb1)
        MOE_LOADB(sidx + 3, rb1)
        { MOE_NEXTA(sidx + 1)
          if (wv) MOE_COMPUTE(stg, true) else MOE_COMPUTE(stg, false) }
        __syncthreads();
        MOE_WRITEB(stg2, rb0)
        MOE_LOADB(sidx + 4, rb0)
        { MOE_NEXTA(sidx + 2)
          if (wv) MOE_COMPUTE(stg1, true) else MOE_COMPUTE(stg1, false) }
        stg = stg2;
        if (kt == KT - 2) {
            if (wv) {
                const int nrows = ng - stt * 512;
#pragma unroll
                for (int a = 0; a < 2; ++a) {
                    if (a == 0 || (wave * 64 + 32) < nrows) {
                        const int lrow = stt * 512 + wave * 64 + a * 32 + r32;
                        const unsigned va = (unsigned)rowva[lrow];
                        if (DOWN) {
                            const float w = roww[lrow];
#pragma unroll
                            for (int c = 0; c < 4; ++c) {
                                float yv_[16];
#pragma unroll
                                for (int j = 0; j < 16; ++j) yv_[j] = acc[a][c][(j >> 2) + 4 * (j & 3)] * w;
                                if (y8) {
                                    u32x4 q8;
#pragma unroll
                                    for (int jj = 0; jj < 4; ++jj) q8[jj] = pack_fp8x4(yv_[4 * jj], yv_[4 * jj + 1], yv_[4 * jj + 2], yv_[4 * jj + 3]);
                                    *(u32x4*)((unsigned char*)outv + (size_t)va * D + ps * 128 + c * 32 + 16 * hi) = q8;
                                } else {
                                    u32x4 q0, q1;
#pragma unroll
                                    for (int jj = 0; jj < 4; ++jj) { q0[jj] = cvtpk(yv_[2 * jj], yv_[2 * jj + 1]); q1[jj] = cvtpk(yv_[8 + 2 * jj], yv_[9 + 2 * jj]); }
                                    u16* o = (u16*)outv + (size_t)va * D + ps * 128 + c * 32 + 16 * hi;
                                    *(u32x4*)o = q0; *(u32x4*)(o + 8) = q1;
                                }
                            }
                        } else {
#pragma unroll
                            for (int c = 0; c < 2; ++c) {
                                float hv[16];
#pragma unroll
                                for (int j = 0; j < 16; ++j) { const int r = (j >> 2) + 4 * (j & 3); const float gt = acc[a][c][r], up = acc[a][c + 2][r]; hv[j] = gt / (1.f + __expf(-gt)) * up; }
                                u32x4 q;
#pragma unroll
                                for (int jj = 0; jj < 4; ++jj) q[jj] = pack_fp8x4(hv[4 * jj], hv[4 * jj + 1], hv[4 * jj + 2], hv[4 * jj + 3]);
                                *(u32x4*)((unsigned char*)outv + (size_t)va * DF + ps * 64 + c * 32 + 16 * hi) = q;
                            }
                        }
                    }
                }
#pragma unroll
                for (int a = 0; a < 2; ++a)
#pragma unroll
                    for (int c = 0; c < 4; ++c)
#pragma unroll
                        for (int r = 0; r < 16; ++r) acc[a][c][r] = 0.f;
            }
        }
    }
    __syncthreads();
#undef MOE_AOFF
#undef MOE_DEC
#undef MOE_LOADB
#undef MOE_WRITEB
#undef MOE_COMPUTE
#undef MOE_NEXTA
}

constexpr int N_PHASES = 21;

#define P_x_in CTX_IN(0)
#define P_xb ((u16*)(ws + WS_XB))
#define P_x1 ((float*)(ws + WS_X1))
#define P_x2 ((float*)(ws + WS_X2))
#define P_ypre ((float*)(ws + WS_YPRE))
#define P_qkv ((u16*)(ws + WS_QKV))
#define P_vT ((u16*)(ws + WS_VT))
#define P_kmean ((float*)(ws + WS_KM))
#define P_ao ((u16*)(ws + WS_AO))
#define P_og ((u16*)(ws + WS_OG))
#define P_lse ((float*)(ws + WS_LSE))
#define P_topw ((float*)(ws + WS_TOPW))
#define P_list ((int*)(ws + WS_LIST))
#define P_hb ((u16*)(ws + WS_HB))
#define P_yb ((u16*)(ws + WS_YB))
#define P_cnt_all ((int*)(ws + WS_CTL + CTL_CNT_OFF))
#define P_xb8 ((unsigned char*)(ws + WS_XB8))
#define P_hbs ((u16*)(ws + WS_HBS))
#define P_selm ((unsigned*)(ws + WS_SELM))
#define P_part ((u16*)(ws + WS_PART))
#define P_plse ((float*)(ws + WS_PLSE))
#define PH_BEGIN int tid = wave_s_ * 64 + lane_id_(); asm volatile("" : "+v"(tid)); const int lane = tid & 63, r32 = lane & 31, hi = lane >> 5; const int wave = __builtin_amdgcn_readfirstlane(tid >> 6); (void)lane; (void)r32; (void)hi; (void)wave
constexpr int LDS_CTX = LDS_BAR + 16;
__device__ __forceinline__ uint64_t ctx_ld(int i) {
    extern __shared__ __attribute__((aligned(16))) unsigned char lds_raw[];
    const LAS unsigned* q = (const LAS unsigned*)((LAS char*)lds_raw + LDS_CTX) + 2 * i;
    const unsigned lo = __builtin_amdgcn_readfirstlane(q[0]), hi = __builtin_amdgcn_readfirstlane(q[1]);
    return ((uint64_t)hi << 32) | lo;
}
typedef __attribute__((address_space(1))) unsigned char gbyte;
#define AS_GLOBAL(T, u64v) ((T*)(gbyte*)(u64v))
#define CTX_IN(i) AS_GLOBAL(const float, ctx_ld(i))
#define PH_FN_BEGIN \
    extern __shared__ __attribute__((aligned(16))) unsigned char lds_raw[]; \
    LAS char* lds = (LAS char*)lds_raw; (void)lds; \
    const int G = gridDim.x, bid = blockIdx.x; (void)G; (void)bid; \
    unsigned char* const ws = AS_GLOBAL(unsigned char, ctx_ld(17)); (void)ws; \
    const int NQ = L == 0 ? 3072 : 9216; (void)NQ; \
    int* cnt = P_cnt_all + L * NE; (void)cnt;
__device__ __forceinline__ void ph_p0(int L, int rep_, const int wave_s_) {
    PH_FN_BEGIN
    (void)rep_;
    PH_BEGIN;
    for (size_t i = (size_t)bid * NTHR + tid; i < (size_t)T * D / 4; i += (size_t)G * NTHR) {
        const f32x4 v = *(const f32x4*)(P_x_in + i * 4);
        u32x2 w; w[0] = cvtpk(v[0], v[1]); w[1] = cvtpk(v[2], v[3]);
        *(u32x2*)(P_xb + i * 4) = w;
    }
    LAS float* tl = (LAS float*)lds;
    for (int it = bid; it < 3968 + 128; it += G) {
        int seg, kt;
        if (it < 3840) { seg = it >> 4; kt = it & 15; } else if (it < 3968) { seg = 240 + ((it - 3840) >> 2); kt = (it - 3840) & 3; } else { seg = 272 + ((it - 3968) >> 4); kt = (it - 3968) & 15; }
        const float* src; int ld; u16* dst; int Kd = 1024; u16* dst_lo = nullptr;
        if (seg < 48) { const int col = 64 * seg; src = CTX_IN(1) + col; ld = 3072; dst = (u16*)(ws + WS_WQK0) + (size_t)col * 1024; }
        else if (seg < 192) { const int col = 64 * (seg - 48); src = CTX_IN(2) + col; ld = 9216; dst = (u16*)(ws + WS_WQK1) + (size_t)col * 1024; }
        else if (seg < 224) { const int s2 = seg - 192, l2 = s2 >> 4, col = 64 * (s2 & 15); src = CTX_IN(3) + (size_t)l2 * D * D + col; ld = 1024; dst = (u16*)(ws + WS_WO) + (size_t)l2 * D * D + (size_t)col * 1024; }
        else if (seg < 240) { const int s2 = seg - 224, l2 = s2 >> 3, i8 = s2 & 7, un = i8 >> 2, q = i8 & 3;
            src = (q < 2 ? CTX_IN(11) : CTX_IN(12)) + (size_t)l2 * D * DF + un * 128 + 64 * (q & 1); ld = 256; dst = (u16*)(ws + WS_WSGU) + (size_t)l2 * 512 * 1024 + (size_t)(64 * i8) * 1024; }
        else if (seg < 272) { const int s2 = seg - 240, l2 = s2 >> 4, col = 64 * (s2 & 15); src = CTX_IN(13) + (size_t)l2 * DF * D + col; ld = 1024; Kd = 256; dst = (u16*)(ws + WS_WSD) + (size_t)l2 * D * DF + (size_t)col * 256; }
        else { const int s2 = seg - 272, l2 = s2 >> 2, col = 64 * (s2 & 3); src = CTX_IN(6) + (size_t)l2 * D * NE + col; ld = 256; dst = (u16*)(ws + WS_WRH) + (size_t)l2 * NE * D + (size_t)col * 1024; dst_lo = (u16*)(ws + WS_WRL) + (size_t)l2 * NE * D + (size_t)col * 1024; }
        {
            const int kr = tid >> 4, c4 = tid & 15;
#pragma unroll
            for (int i = 0; i < 2; ++i) {
                const f32x4 v = *(const f32x4*)(src + (size_t)(kt * 64 + kr + 32 * i) * ld + 4 * c4);
#pragma unroll
                for (int jj = 0; jj < 4; ++jj) tl[(kr + 32 * i) * 65 + 4 * c4 + jj] = v[jj];
            }
        }
        __syncthreads();
        {
            const int row = tid >> 3, kc = tid & 7;
            float f[8];
#pragma unroll
            for (int jj = 0; jj < 8; ++jj) f[jj] = tl[(8 * kc + jj) * 65 + row];
            u32x4 w; w[0] = cvtpk(f[0], f[1]); w[1] = cvtpk(f[2], f[3]); w[2] = cvtpk(f[4], f[5]); w[3] = cvtpk(f[6], f[7]);
            *(u32x4*)(dst + (size_t)row * Kd + kt * 64 + 8 * kc) = w;
            if (dst_lo) {
                u32x4 wl;
#pragma unroll
                for (int jj = 0; jj < 4; ++jj) wl[jj] = cvtpk(f[2 * jj] - bf2f(w[jj] & 0xFFFFu), f[2 * jj + 1] - bf2f(w[jj] >> 16));
                *(u32x4*)(dst_lo + (size_t)row * Kd + kt * 64 + 8 * kc) = wl;
            }
        }
        __syncthreads();
    }
}

__device__ __forceinline__ void ph_qkv(int L, int rep_, const int wave_s_) {
    PH_FN_BEGIN
    (void)rep_;
    const pg8::Gemm g{P_xb, (const u16*)(ws + (L == 0 ? WS_WQK0 : WS_WQK1)), T, NQ, D};
    pg8::StaticOrder S; S.init(g.M, g.N, G, bid);
    const EpiQK E{P_qkv, NQ};
    pg8::gemm_phase<EpiQK, pg8::StaticOrder, false>((PG8_LAS unsigned char*)lds, g, S, E, nullptr, wave_s_ * 64 + lane_id_());
}

__device__ __forceinline__ void ph_kmean(int L, int rep_, const int wave_s_) {
    PH_FN_BEGIN
    (void)rep_;
    PH_BEGIN;
    LAS float* red = (LAS float*)lds;
    for (int it = bid; it < BATCH * NH * MOBA_NB; it += G) {
        const int j = it & 31, h = (it >> 5) & 15, b = it >> 9;
        const int kg_ = tid >> 3, ch = tid & 7;
        const u16* kp = P_qkv + (size_t)(b * SEQ + j * MOBA_BLK + kg_) * 3072 + 1024 + h * 64 + ch * 8;
        float sm[8];
#pragma unroll
        for (int e2 = 0; e2 < 8; ++e2) sm[e2] = 0.f;
#pragma unroll
        for (int i = 0; i < 4; ++i) {
            const u32x4 v = *(const u32x4*)(kp + (size_t)(64 * i) * 3072);
#pragma unroll
            for (int e2 = 0; e2 < 4; ++e2) { sm[2 * e2] += bf2f(v[e2] & 0xFFFFu); sm[2 * e2 + 1] += bf2f(v[e2] >> 16); }
        }
#pragma unroll
        for (int e2 = 0; e2 < 8; ++e2) red[kg_ * 65 + ch * 8 + e2] = sm[e2];
        __syncthreads();
        if (tid < 64) {
            float tot = 0.f;
#pragma unroll 8
            for (int q = 0; q < 64; ++q) tot += red[q * 65 + tid];
            P_kmean[(size_t)it * 64 + tid] = tot * (1.f / MOBA_BLK);
        }
        __syncthreads();
    }
}

__device__ __forceinline__ void ph_gate(int L, int rep_, const int wave_s_) {
    PH_FN_BEGIN
    (void)rep_;
    PH_BEGIN;
    for (int it = bid; it < BATCH * NH * MOBA_NB; it += G) {
        const int qb = it & 31, bh = it >> 5, b = bh >> 4, h = bh & 15;
        const int tq = qb * MOBA_BLK + wave * 32 + r32;
        const u16* qrow = P_qkv + (size_t)(b * SEQ + tq) * 3072 + h * 64 + hi * 8;
        bf16x8 qf[4];
#pragma unroll
        for (int d0 = 0; d0 < 4; ++d0) qf[d0] = *(const bf16x8*)(qrow + d0 * 16);
        unsigned selmask = 0u;
        if (qb > 0) {
            const float* km = P_kmean + ((size_t)(b * NH + h) * MOBA_NB + r32) * 64 + hi * 8;
            f32x16 gt;
#pragma unroll
            for (int r = 0; r < 16; ++r) gt[r] = 0.f;
#pragma unroll
            for (int d0 = 0; d0 < 4; ++d0) {
                const f32x4 k0 = *(const f32x4*)(km + d0 * 16), k1 = *(const f32x4*)(km + d0 * 16 + 4);
                union { bf16x8 v; unsigned u[4]; } kf;
                kf.u[0] = cvtpk(k0[0], k0[1]); kf.u[1] = cvtpk(k0[2], k0[3]); kf.u[2] = cvtpk(k1[0], k1[1]); kf.u[3] = cvtpk(k1[2], k1[3]);
                gt = MFMA_BF16(kf.v, qf[d0], gt);
            }
            float v0 = -INFINITY, v1 = -INFINITY, v2 = -INFINITY; int i0 = 99, i1 = 99, i2 = 99;
#pragma unroll
            for (int r = 0; r < 16; ++r) { const int jb = crow(r, hi); const float gv = jb < qb ? gt[r] : -INFINITY; top3_insert(gv, jb < qb ? jb : 99, v0, i0, v1, i1, v2, i2); }
            const float ov0 = shxf(v0, 32, lane), ov1 = shxf(v1, 32, lane), ov2 = shxf(v2, 32, lane);
            const int oi0 = shxi(i0, 32, lane), oi1 = shxi(i1, 32, lane), oi2 = shxi(i2, 32, lane);
            top3_insert(ov0, oi0, v0, i0, v1, i1, v2, i2); top3_insert(ov1, oi1, v0, i0, v1, i1, v2, i2); top3_insert(ov2, oi2, v0, i0, v1, i1, v2, i2);
            if (i0 < 32) selmask |= 1u << i0;
            if (i1 < 32) selmask |= 1u << i1;
            if (i2 < 32) selmask |= 1u << i2;
        }
        if (hi == 0) P_selm[(size_t)bh * SEQ + tq] = selmask;
    }
}

constexpr int MB_KP = 72;
constexpr int MB_VP = 260;
constexpr int MB_LDS_K = 0;
constexpr int MB_LDS_V = 256 * MB_KP * 2;
constexpr int MB_LDS_LIST = MB_LDS_V + 64 * MB_VP * 2;
constexpr int MB_LDS_CTR = MB_LDS_LIST + 8192 * 2;
__device__ __forceinline__ void ph_moba(int L, int rep_, const int wave_s_) {
    PH_FN_BEGIN
    (void)rep_;
    PH_BEGIN;
    LAS char* Ks = lds + MB_LDS_K; LAS char* Vs = lds + MB_LDS_V;
    LAS u16* qlist = (LAS u16*)(lds + MB_LDS_LIST); LAS int* ctr = (LAS int*)(lds + MB_LDS_CTR);
    for (int it = bid; it < BATCH * NH * MOBA_NB; it += G) {
        const int rnd = it >> 8, w8 = it & 255, a8 = w8 >> 5, bh = w8 & 31;
        const int j = rnd == 0 ? a8 : (rnd == 1 ? 15 - a8 : (rnd == 2 ? 16 + a8 : 31 - a8));
        const int b = bh >> 4, h = bh & 15;
        const float slope2 = exp2f(-0.5f * (float)(h + 1)) * LOG2E;
        if (tid == 0) { int z0 = 0; asm volatile("" : "+v"(z0)); ctr[0] = z0; ctr[1] = z0; }
        {
            const u16* kg = P_qkv + (size_t)(b * SEQ + j * MOBA_BLK) * 3072 + 1024 + h * 64;
#pragma unroll
            for (int i = 0; i < 4; ++i) { const int c = tid + i * 512, row = c >> 3, ch = c & 7; *(LAS u32x4*)(Ks + (row * MB_KP + ch * 8) * 2) = *(const u32x4*)(kg + (size_t)row * 3072 + ch * 8); }
            const u16* vg = P_qkv + (size_t)(b * SEQ + j * MOBA_BLK) * 3072 + 2048 + h * 64;
#pragma unroll
            for (int i = 0; i < 4; ++i) {
                const int c = tid + i * 512, key = c >> 3, ch = c & 7;
                const u32x4 v = *(const u32x4*)(vg + (size_t)key * 3072 + ch * 8);
#pragma unroll
                for (int e2 = 0; e2 < 4; ++e2) {
                    *(LAS u16*)(Vs + ((ch * 8 + 2 * e2) * MB_VP + key) * 2) = (u16)(v[e2] & 0xFFFFu);
                    *(LAS u16*)(Vs + ((ch * 8 + 2 * e2 + 1) * MB_VP + key) * 2) = (u16)(v[e2] >> 16);
                }
            }
        }
        __syncthreads();
        {
            const unsigned* sm = P_selm + (size_t)bh * SEQ;
            for (int t0 = (j + 1) * MOBA_BLK; t0 < SEQ; t0 += 512) {
                const int t = t0 + tid;
                const bool sel = (t < SEQ) && ((sm[t < SEQ ? t : 0] >> j) & 1u);
                const unsigned long long bal = __ballot(sel);
                const int total = __popcll(bal);
                int wb = 0;
                if (lane == 0 && total) wb = atomicAdd((int*)&ctr[0], total);
                wb = __builtin_amdgcn_readfirstlane(wb);
                if (sel) qlist[wb + __popcll(bal & ((1ull << lane) - 1ull))] = (u16)t;
            }
        }
        __syncthreads();
        const int nq = ctr[0];
        const int ntiles = 8 + ((nq + 31) >> 5);
        for (;;) {
            int ti = 0;
            if (lane == 0) ti = atomicAdd((int*)&ctr[1], 1);
            ti = __builtin_amdgcn_readfirstlane(ti);
            if (ti >= ntiles) break;
            const bool own = ti < 8;
            const int wq = 7 - ti;
            const int li = (ti - 8) * 32 + r32;
            const bool valid = own || li < nq;
            const int tq = own ? j * MOBA_BLK + wq * 32 + r32 : (int)qlist[li < nq ? li : nq - 1];
            const int nsteps = own ? wq + 1 : 8;
            const u16* qrow = P_qkv + (size_t)(b * SEQ + tq) * 3072 + h * 64 + hi * 8;
            bf16x8 qf[4];
#pragma unroll
            for (int d0 = 0; d0 < 4; ++d0) qf[d0] = *(const bf16x8*)(qrow + d0 * 16);
            int slot = 3;
            if (!own) slot = __popc(P_selm[(size_t)bh * SEQ + tq] & ((1u << j) - 1u));
            AttnSt st; st.m = NEGV; st.l = 0.f;
#pragma unroll
            for (int r = 0; r < 16; ++r) { st.o0[r] = 0.f; st.o1[r] = 0.f; }
            const int dlo = own ? 0 : -0x40000000;
            for (int kt = 0; kt < nsteps; ++kt) {
                AttnFr f;
#pragma unroll
                for (int d0 = 0; d0 < 4; ++d0) f.k[d0] = *(LAS bf16x8*)(Ks + ((kt * 32 + r32) * MB_KP + d0 * 16 + hi * 8) * 2);
#pragma unroll
                for (int q4 = 0; q4 < 4; ++q4) {
                    union { bf16x8 v; u32x2 hh[2]; } va;
                    LAS char* vp = Vs + (((q4 >> 1) * 32 + r32) * MB_VP + kt * 32 + (q4 & 1) * 16 + 4 * hi) * 2;
                    va.hh[0] = *(LAS u32x2*)(vp); va.hh[1] = *(LAS u32x2*)(vp + 16);
                    f.v[q4] = va.v;
                }
                attn_compute(st, qf, f, tq - (j * MOBA_BLK + kt * 32) - 4 * hi, slope2, dlo, 0x7fffffff, hi, lane);
            }
            const float lt = st.l + shxf(st.l, 32, lane);
            const float inv = 1.f / lt;
            if (valid) {
                const size_t pi = ((size_t)(b * SEQ + tq) * NH + h) * 4 + slot;
                u16* orow = P_part + pi * 64;
#pragma unroll
                for (int rq = 0; rq < 4; ++rq) {
                    u32x2 w; w[0] = cvtpk(st.o0[4 * rq] * inv, st.o0[4 * rq + 1] * inv); w[1] = cvtpk(st.o0[4 * rq + 2] * inv, st.o0[4 * rq + 3] * inv);
                    *(u32x2*)(orow + 8 * rq + 4 * hi) = w;
                    w[0] = cvtpk(st.o1[4 * rq] * inv, st.o1[4 * rq + 1] * inv); w[1] = cvtpk(st.o1[4 * rq + 2] * inv, st.o1[4 * rq + 3] * inv);
                    *(u32x2*)(orow + 32 + 8 * rq + 4 * hi) = w;
                }
                if (hi == 0) P_plse[pi] = st.m * LN2 + logf(lt);
            }
        }
        __syncthreads();
    }
}

__device__ __forceinline__ void ph_mobamerge(int L, int rep_, const int wave_s_) {
    PH_FN_BEGIN
    (void)rep_;
    PH_BEGIN;
    for (size_t i = (size_t)bid * NTHR + tid; i < (size_t)T * NH * 8; i += (size_t)G * NTHR) {
        const size_t row = i >> 7; const int h = (int)(i >> 3) & 15, d8 = (int)i & 7;
        const int qb = (int)(row & (SEQ - 1)) >> 8;
        const int nsel = qb < 3 ? qb : 3;
        const size_t pi = (row * NH + h) * 4;
        float l[4], w[4];
        float mx = -INFINITY;
#pragma unroll
        for (int sidx = 0; sidx < 4; ++sidx) { const bool ok = sidx == 3 || sidx < nsel; l[sidx] = ok ? P_plse[pi + sidx] : -INFINITY; mx = fmaxf(mx, l[sidx]); }
        float ws_ = 0.f;
#pragma unroll
        for (int sidx = 0; sidx < 4; ++sidx) { w[sidx] = (sidx == 3 || sidx < nsel) ? expf(l[sidx] - mx) : 0.f; ws_ += w[sidx]; }
        const float inv = 1.f / ws_;
        float acc8[8];
#pragma unroll
        for (int c = 0; c < 8; ++c) acc8[c] = 0.f;
#pragma unroll
        for (int sidx = 0; sidx < 4; ++sidx) {
            if (sidx == 3 || sidx < nsel) {
                const u32x4 a = *(const u32x4*)(P_part + (pi + sidx) * 64 + d8 * 8);
                const float ww = w[sidx] * inv;
#pragma unroll
                for (int c = 0; c < 4; ++c) { acc8[2 * c] += ww * bf2f(a[c] & 0xFFFFu); acc8[2 * c + 1] += ww * bf2f(a[c] >> 16); }
            }
        }
        u32x4 o;
#pragma unroll
        for (int c = 0; c < 4; ++c) o[c] = cvtpk(acc8[2 * c], acc8[2 * c + 1]);
        *(u32x4*)(P_ao + row * D + h * 64 + d8 * 8) = o;
    }
}

constexpr int DL_KP = 72, DL_VP = 388;
constexpr int DL_LDS_K = 0, DL_LDS_V = 384 * DL_KP * 2;
__device__ __forceinline__ void ph_dil(int L, int rep_, const int wave_s_) {
    PH_FN_BEGIN
    (void)rep_;
    PH_BEGIN;
    LAS char* Ks = lds + DL_LDS_K; LAS char* Vs = lds + DL_LDS_V;
    for (int it = bid; it < BATCH * NH * 3 * 32; it += G) {
        const int ch = it & 31, grp = (it >> 5) % 3, bh = it / 96, b = bh >> 4, h = bh & 15;
        const int dil = grp == 0 ? 1 : (grp == 1 ? 4 : 16), Ls = SEQ / dil;
        const float slope2 = exp2f(-0.5f * (float)(h + 1)) * LOG2E * (float)dil;
        const int uc = ch * 256, res = uc / Ls, c0 = uc - res * Ls;
        const int kb0 = c0 - 128;
        {
            const u16* kg = P_qkv + (size_t)(b * SEQ) * 9216 + grp * 3072 + 1024 + h * 64;
#pragma unroll
            for (int i = 0; i < 6; ++i) {
                const int c = tid + i * 512, row = c >> 3, chk = c & 7, ks = kb0 + row;
                if (ks >= 0) *(LAS u32x4*)(Ks + (row * DL_KP + chk * 8) * 2) = *(const u32x4*)(kg + (size_t)(ks * dil + res) * 9216 + chk * 8);
            }
            const u16* vg = P_qkv + (size_t)(b * SEQ) * 9216 + grp * 3072 + 2048 + h * 64;
#pragma unroll
            for (int i = 0; i < 6; ++i) {
                const int c = tid + i * 512, row = c >> 3, chk = c & 7, ks = kb0 + row;
                if (ks >= 0) {
                    const u32x4 v = *(const u32x4*)(vg + (size_t)(ks * dil + res) * 9216 + chk * 8);
#pragma unroll
                    for (int e2 = 0; e2 < 4; ++e2) {
                        *(LAS u16*)(Vs + ((chk * 8 + 2 * e2) * DL_VP + row) * 2) = (u16)(v[e2] & 0xFFFFu);
                        *(LAS u16*)(Vs + ((chk * 8 + 2 * e2 + 1) * DL_VP + row) * 2) = (u16)(v[e2] >> 16);
                    }
                }
            }
        }
        const int i0 = c0 + wave * 32, iq = i0 + r32, pq = iq * dil + res;
        const u16* qrow = P_qkv + (size_t)(b * SEQ + pq) * 9216 + grp * 3072 + h * 64 + hi * 8;
        bf16x8 qf[4];
#pragma unroll
        for (int d0 = 0; d0 < 4; ++d0) qf[d0] = *(const bf16x8*)(qrow + d0 * 16);
        __syncthreads();
        AttnSt st; st.m = NEGV; st.l = 0.f;
#pragma unroll
        for (int r = 0; r < 16; ++r) { st.o0[r] = 0.f; st.o1[r] = 0.f; }
        const int ktmin = (i0 >= 128) ? 0 : (128 - i0) >> 5;
        for (int kt = 4; kt >= ktmin; --kt) {
            const int lrow0 = (wave + kt) * 32;
            AttnFr f;
#pragma unroll
            for (int d0 = 0; d0 < 4; ++d0) f.k[d0] = *(LAS bf16x8*)(Ks + ((lrow0 + r32) * DL_KP + d0 * 16 + hi * 8) * 2);
#pragma unroll
            for (int q4 = 0; q4 < 4; ++q4) {
                union { bf16x8 v; u32x2 hh[2]; } va;
                LAS char* vp = Vs + (((q4 >> 1) * 32 + r32) * DL_VP + lrow0 + (q4 & 1) * 16 + 4 * hi) * 2;
                va.hh[0] = *(LAS u32x2*)(vp); va.hh[1] = *(LAS u32x2*)(vp + 16);
                f.v[q4] = va.v;
            }
            const int k0 = i0 - 128 + kt * 32;
            attn_compute(st, qf, f, iq - k0 - 4 * hi, slope2, 0, 128, hi, lane);
        }
        const float lt = st.l + shxf(st.l, 32, lane);
        const float inv = 1.f / lt;
        u16* orow = P_og + (size_t)grp * T * D + (size_t)(b * SEQ + pq) * D + h * 64;
#pragma unroll
        for (int rq = 0; rq < 4; ++rq) {
            u32x2 w; w[0] = cvtpk(st.o0[4 * rq] * inv, st.o0[4 * rq + 1] * inv); w[1] = cvtpk(st.o0[4 * rq + 2] * inv, st.o0[4 * rq + 3] * inv);
            *(u32x2*)(orow + 8 * rq + 4 * hi) = w;
            w[0] = cvtpk(st.o1[4 * rq] * inv, st.o1[4 * rq + 1] * inv); w[1] = cvtpk(st.o1[4 * rq + 2] * inv, st.o1[4 * rq + 3] * inv);
            *(u32x2*)(orow + 32 + 8 * rq + 4 * hi) = w;
        }
        if (hi == 0) P_lse[((size_t)grp * T + (b * SEQ + pq)) * NH + h] = st.m * LN2 + logf(lt);
        __syncthreads();
    }
}

__device__ __forceinline__ void ph_merge(int L, int rep_, const int wave_s_) {
    PH_FN_BEGIN
    (void)rep_;

            PH_BEGIN;
                for (size_t i = (size_t)bid * NTHR + tid; i < (size_t)T * NH * 8; i += (size_t)G * NTHR) {
                    const size_t row = i >> 7; const int h = (int)(i >> 3) & 15, d8 = (int)i & 7;
                    const float l0 = P_lse[(0 * (size_t)T + row) * NH + h], l1 = P_lse[(1 * (size_t)T + row) * NH + h], l2 = P_lse[(2 * (size_t)T + row) * NH + h];
                    const float mx = fmaxf(l0, fmaxf(l1, l2));
                    float w0 = expf(l0 - mx), w1 = expf(l1 - mx), w2 = expf(l2 - mx);
                    const float inv = 1.f / (w0 + w1 + w2); w0 *= inv; w1 *= inv; w2 *= inv;
                    const size_t off = row * D + h * 64 + d8 * 8;
                    const u32x4 a0 = *(const u32x4*)(P_og + off), a1 = *(const u32x4*)(P_og + (size_t)T * D + off), a2 = *(const u32x4*)(P_og + 2 * (size_t)T * D + off);
                    u32x4 o;
#pragma unroll
                    for (int c = 0; c < 4; ++c) {
                        const float lo_ = w0 * bf2f(a0[c] & 0xFFFFu) + w1 * bf2f(a1[c] & 0xFFFFu) + w2 * bf2f(a2[c] & 0xFFFFu);
                        const float hi_ = w0 * bf2f(a0[c] >> 16) + w1 * bf2f(a1[c] >> 16) + w2 * bf2f(a2[c] >> 16);
                        o[c] = cvtpk(lo_, hi_);
                    }
                    *(u32x4*)(P_ao + off) = o;
                }

}

__device__ __forceinline__ void ph_wo(int L, int rep_, const int wave_s_) {
    PH_FN_BEGIN
    (void)rep_;
    const pg8::Gemm g{P_ao, (const u16*)(ws + WS_WO) + (size_t)L * D * D, T, D, D};
    pg8::StaticOrder S; S.init(g.M, g.N, G, bid);
    const EpiWo E{P_ypre, L == 0 ? CTX_IN(0) : (const float*)P_x2};
    pg8::gemm_phase<EpiWo, pg8::StaticOrder, false>((PG8_LAS unsigned char*)lds, g, S, E, nullptr, wave_s_ * 64 + lane_id_());
}

__device__ __forceinline__ void ph_router(int L, int rep_, const int wave_s_) {
    PH_FN_BEGIN
    (void)rep_;

            PH_BEGIN;
            const float* lng = CTX_IN(4) + L * D; const float* lnb = CTX_IN(5) + L * D;
            const float* rbias = CTX_IN(7) + L * NE;
            const u16* wrh = (const u16*)(ws + WS_WRH) + (size_t)L * NE * D; const u16* wrl = (const u16*)(ws + WS_WRL) + (size_t)L * NE * D;
            constexpr int AP = 2064;
            LAS char* ahi = lds; LAS char* alo = lds + 32 * AP;
            for (int it = bid; it < T / 32; it += G) {
                {
                    f32x4 yv[4][4];
#pragma unroll
                    for (int rr = 0; rr < 4; ++rr)
#pragma unroll
                        for (int j = 0; j < 4; ++j) yv[rr][j] = *(const f32x4*)(P_ypre + ((size_t)it * 32 + wave * 4 + rr) * D + j * 256 + lane * 4);
#pragma unroll
                    for (int rr = 0; rr < 4; ++rr) {
                        const int lr = wave * 4 + rr; const size_t row = (size_t)it * 32 + lr;
                        float v[16];
#pragma unroll
                        for (int j = 0; j < 4; ++j) { v[j * 4] = yv[rr][j][0]; v[j * 4 + 1] = yv[rr][j][1]; v[j * 4 + 2] = yv[rr][j][2]; v[j * 4 + 3] = yv[rr][j][3]; }
                        ln_row(v, lng, lnb, lane);
#pragma unroll
                        for (int j = 0; j < 4; ++j) {
                            f32x4 t4; t4[0] = v[j * 4]; t4[1] = v[j * 4 + 1]; t4[2] = v[j * 4 + 2]; t4[3] = v[j * 4 + 3];
                            *(f32x4*)(P_x1 + row * D + j * 256 + lane * 4) = t4;
                            u32x2 w; w[0] = cvtpk(t4[0], t4[1]); w[1] = cvtpk(t4[2], t4[3]);
                            *(u32x2*)(P_xb + row * D + j * 256 + lane * 4) = w;
                            *(unsigned*)(P_xb8 + row * D + j * 256 + lane * 4) = pack_fp8x4(t4[0], t4[1], t4[2], t4[3]);
                            u32x2 wl; wl[0] = cvtpk(t4[0] - bf2f(w[0] & 0xFFFFu), t4[1] - bf2f(w[0] >> 16)); wl[1] = cvtpk(t4[2] - bf2f(w[1] & 0xFFFFu), t4[3] - bf2f(w[1] >> 16));
                            *(LAS u32x2*)(ahi + lr * AP + (j * 256 + lane * 4) * 2) = w;
                            *(LAS u32x2*)(alo + lr * AP + (j * 256 + lane * 4) * 2) = wl;
                        }
                    }
                }
                __syncthreads();
                f32x16 lg;
#pragma unroll
                for (int r = 0; r < 16; ++r) lg[r] = 0.f;
                {
                    const LAS char* ah = ahi + r32 * AP + hi * 16; const LAS char* al = alo + r32 * AP + hi * 16;
                    const u16* bh = wrh + (size_t)(wave * 32 + r32) * D + hi * 8; const u16* bl = wrl + (size_t)(wave * 32 + r32) * D + hi * 8;
                    bf16x8 bha[8], bla[8], bhb[8], blb[8];
#pragma unroll
                    for (int j = 0; j < 8; ++j) { bha[j] = *(const bf16x8*)(bh + j * 16); bla[j] = *(const bf16x8*)(bl + j * 16); }
#pragma unroll 1
                    for (int k0 = 0; k0 < D; k0 += 256) {
#pragma unroll
                        for (int j = 0; j < 8; ++j) { bhb[j] = *(const bf16x8*)(bh + k0 + 128 + j * 16); blb[j] = *(const bf16x8*)(bl + k0 + 128 + j * 16); }
#pragma unroll
                        for (int j = 0; j < 8; ++j) {
                            const bf16x8 xh = *(const LAS bf16x8*)(ah + (k0 + j * 16) * 2), xl = *(const LAS bf16x8*)(al + (k0 + j * 16) * 2);
                            lg = MFMA_BF16(xh, bha[j], lg); lg = MFMA_BF16(xl, bha[j], lg); lg = MFMA_BF16(xh, bla[j], lg);
                        }
                        { const int kn = (k0 + 256 < D) ? k0 + 256 : 0;
#pragma unroll
                          for (int j = 0; j < 8; ++j) { bha[j] = *(const bf16x8*)(bh + kn + j * 16); bla[j] = *(const bf16x8*)(bl + kn + j * 16); } }
#pragma unroll
                        for (int j = 0; j < 8; ++j) {
                            const bf16x8 xh = *(const LAS bf16x8*)(ah + (k0 + 128 + j * 16) * 2), xl = *(const LAS bf16x8*)(al + (k0 + 128 + j * 16) * 2);
                            lg = MFMA_BF16(xh, bhb[j], lg); lg = MFMA_BF16(xl, bhb[j], lg); lg = MFMA_BF16(xh, blb[j], lg);
                        }
                    }
                }
                __syncthreads();
                LAS float* lgs = (LAS float*)lds;
#pragma unroll
                for (int r = 0; r < 16; ++r) lgs[crow(r, hi) * 257 + wave * 32 + r32] = lg[r];
                __syncthreads();
#pragma unroll 1
                for (int rr = 0; rr < 4; ++rr) {
                    const int lr = wave * 4 + rr; const int tok = it * 32 + lr;
                    float sc[4], ch[4];
#pragma unroll
                    for (int j = 0; j < 4; ++j) { const int e = lane + 64 * j; sc[j] = 1.f / (1.f + expf(-lgs[lr * 257 + e])); ch[j] = sc[j] + rbias[e]; }
                    float gsel[8];
#pragma unroll
                    for (int j = 0; j < 4; ++j) {
                        const float rm = dpp_rowmax(ch[j]);
                        const float m1a = fmaxf(rl_f(rm, 0), rl_f(rm, 16)), m1b = fmaxf(rl_f(rm, 32), rl_f(rm, 48));
                        const unsigned long long bal = __ballot(ch[j] == (hi ? m1b : m1a));
                        const int fa_ = __builtin_ctz((unsigned)(bal & 0xFFFFFFFFull)), fb_ = 32 + __builtin_ctz((unsigned)(bal >> 32));
                        const float c2 = (lane == fa_ || lane == fb_) ? -INFINITY : ch[j];
                        const float rm2 = dpp_rowmax(c2);
                        gsel[2 * j] = m1a + fmaxf(rl_f(rm2, 0), rl_f(rm2, 16));
                        gsel[2 * j + 1] = m1b + fmaxf(rl_f(rm2, 32), rl_f(rm2, 48));
                    }
                    float cv[4];
#pragma unroll
                    for (int j = 0; j < 4; ++j) {
                        int ra_ = 0, rb_ = 0;
#pragma unroll
                        for (int g2 = 0; g2 < 8; ++g2) {
                            ra_ += ((gsel[g2] > gsel[2 * j]) || (gsel[g2] == gsel[2 * j] && g2 < 2 * j)) ? 1 : 0;
                            rb_ += ((gsel[g2] > gsel[2 * j + 1]) || (gsel[g2] == gsel[2 * j + 1] && g2 < 2 * j + 1)) ? 1 : 0;
                        }
                        cv[j] = ((hi ? rb_ : ra_) < 4) ? ch[j] : NEGV;
                    }
                    float wsel = 0.f; int esel = 0; float wsum = 0.f;
#pragma unroll 1
                    for (int k = 0; k < TOPK; ++k) {
                        float bv = cv[0]; int be = lane;
#pragma unroll
                        for (int j = 1; j < 4; ++j) if (cv[j] > bv) { bv = cv[j]; be = lane + 64 * j; }
                        const float rm = dpp_rowmax(bv);
                        const float mval = fmaxf(fmaxf(rl_f(rm, 0), rl_f(rm, 16)), fmaxf(rl_f(rm, 32), rl_f(rm, 48)));
                        const int ri = dpp_rowmin_i(bv == mval ? be : 0x7fffffff);
                        const int e = min(min(__builtin_amdgcn_readlane(ri, 0), __builtin_amdgcn_readlane(ri, 16)), min(__builtin_amdgcn_readlane(ri, 32), __builtin_amdgcn_readlane(ri, 48)));
                        const int jl = e >> 6, ll = e & 63;
                        float smine = sc[0];
                        smine = jl == 1 ? sc[1] : smine; smine = jl == 2 ? sc[2] : smine; smine = jl == 3 ? sc[3] : smine;
                        const float sw = rl_f(smine, ll);
#pragma unroll
                        for (int j = 0; j < 4; ++j) cv[j] = (lane == ll && jl == j) ? -INFINITY : cv[j];
                        wsum += sw;
                        if (lane == k) { wsel = sw; esel = e; }
                    }
                    if (lane < TOPK) {
                        const int a = tok * TOPK + lane;
                        P_topw[a] = wsel / wsum * 2.5f;
                        if (rep_ == 0) {
                            const int pos = atomicAdd(&cnt[esel], 1);
                            P_list[(size_t)esel * T + pos] = a;
                        }
                    }
                }
                __syncthreads();
            }

}

__device__ __forceinline__ void ph_gateup(int L, int rep_, const int wave_s_) {
    PH_FN_BEGIN
    (void)rep_;
    {
        PH_BEGIN;
        const float* weg = CTX_IN(8) + (size_t)L * NE * D * DF; const float* weu = CTX_IN(9) + (size_t)L * NE * D * DF;
        LAS int* rowva = (LAS int*)(lds + MOE_LDS_VA);
        {
            int* octr = (int*)(ws + WS_CTL + CTL_CNT_OFF + 8192) + (L * 4 + 2 * (rep_ & 1)) * 64;
            LAS int* slot = (LAS int*)(lds + 140000);
            for (;;) {
                __syncthreads();
                if (tid == 0) { int q; do { q = atomicAdd(octr, 1); } while (q >= NE && q < NE * 5 && cnt[(q - NE) >> 2] <= 512); *slot = q; }
                __syncthreads();
                const int q = *slot;
                if (q >= NE * 5) break;
                const bool ovf = q >= NE;
                const int e = ovf ? (q - NE) >> 2 : q, pz = ovf ? (q - NE) & 3 : 0, npz = ovf ? 1 : 4, st0 = ovf ? 1 : 0, n = cnt[e];
                for (int r0 = 0; r0 < n; r0 += 1024) {
                    if (ovf && n - r0 <= 512) break;
#pragma unroll
                    for (int i = 0; i < 2; ++i) { int t_ = tid; asm volatile("" : "+v"(t_)); const int idx = r0 + i * 512 + t_; rowva[i * 512 + t_] = idx < n ? P_list[(size_t)e * T + idx] : TRASH_VA; }
                    __syncthreads();
                    moe_expert<false>(lds, tid, lane, wave, r32, hi, P_xb8, weg + (size_t)e * D * DF, weu + (size_t)e * D * DF, (n - r0) < 1024 ? (n - r0) : 1024, (void*)P_hb, pz, npz, st0, 1);
                }
            }
        }
    }
    {
        PH_BEGIN;
        const pg8::Gemm g{P_xb, (const u16*)(ws + WS_WSGU) + (size_t)L * 512 * 1024, T, 512, D};
        const EpiSGU E{P_hbs};
        int* qctr = (int*)(ws + WS_CTL + CTL_CNT_OFF + 4096) + (L * 4 + 2 * (rep_ & 1)) * 64;
        LAS int* slot = (LAS int*)(lds + 140000);
        for (;;) {
            __syncthreads();
            if (tid == 0) *slot = atomicAdd(qctr, 1);
            __syncthreads();
            const int un = *slot;
            if (un >= 128) break;
            const pg8::FixedOrder S{un & 63, un >> 6};
            pg8::gemm_phase<EpiSGU, pg8::FixedOrder, false>((PG8_LAS unsigned char*)lds, g, S, E, nullptr, wave_s_ * 64 + lane_id_());
        }
    }
}

__device__ __forceinline__ void ph_down(int L, int rep_, const int wave_s_) {
    PH_FN_BEGIN
    (void)rep_;
    {
        PH_BEGIN;
        const float* wed = CTX_IN(10) + (size_t)L * NE * DF * D;
        LAS int* rowva = (LAS int*)(lds + MOE_LDS_VA); LAS float* roww = (LAS float*)(lds + MOE_LDS_W);
        {
            int* octr = (int*)(ws + WS_CTL + CTL_CNT_OFF + 8192) + (L * 4 + 1 + 2 * (rep_ & 1)) * 64;
            LAS int* slot = (LAS int*)(lds + 140000);
            for (;;) {
                __syncthreads();
                if (tid == 0) { int q; do { q = atomicAdd(octr, 1); } while (q >= NE && q < NE * 5 && cnt[(q - NE) >> 2] <= 512); *slot = q; }
                __syncthreads();
                const int q = *slot;
                if (q >= NE * 5) break;
                const bool ovf = q >= NE;
                const int e = ovf ? (q - NE) >> 2 : q, pz = ovf ? ((q - NE) & 3) * 2 : 0, npz = ovf ? 2 : 8, st0 = ovf ? 1 : 0, n = cnt[e];
                for (int r0 = 0; r0 < n; r0 += 1024) {
                    if (ovf && n - r0 <= 512) break;
#pragma unroll
                    for (int i = 0; i < 2; ++i) { int t_ = tid; asm volatile("" : "+v"(t_)); const int idx = r0 + i * 512 + t_; const int va = idx < n ? P_list[(size_t)e * T + idx] : TRASH_VA; rowva[i * 512 + t_] = va; roww[i * 512 + t_] = va < A_TOT ? P_topw[va] : 0.f; }
                    __syncthreads();
                    moe_expert<true>(lds, tid, lane, wave, r32, hi, (const unsigned char*)P_hb, wed + (size_t)e * DF * D, nullptr, (n - r0) < 1024 ? (n - r0) : 1024, (void*)P_yb, pz, npz, st0, 1, L == 1);
                }
            }
        }
    }
    {
        PH_BEGIN;
        const pg8::Gemm g{P_hbs, (const u16*)(ws + WS_WSD) + (size_t)L * D * DF, T, D, DF};
        const EpiSD E{P_yb};
        int* qctr = (int*)(ws + WS_CTL + CTL_CNT_OFF + 4096) + (L * 4 + 1 + 2 * (rep_ & 1)) * 64;
        LAS int* slot = (LAS int*)(lds + 140000);
        for (;;) {
            __syncthreads();
            if (tid == 0) *slot = atomicAdd(qctr, 1);
            __syncthreads();
            const int un = *slot;
            if (un >= 256) break;
            const pg8::FixedOrder S{un & 63, un >> 6};
            pg8::gemm_phase<EpiSD, pg8::FixedOrder, false>((PG8_LAS unsigned char*)lds, g, S, E, nullptr, wave_s_ * 64 + lane_id_());
        }
    }
}

__device__ __forceinline__ void ph_combine(int L, int rep_, const int wave_s_) {
    PH_FN_BEGIN
    (void)rep_;
    PH_BEGIN;
    const float* lng = CTX_IN(14) + L * D; const float* lnb = CTX_IN(15) + L * D;
    float* dst = L == 0 ? P_x2 : AS_GLOBAL(float, ctx_ld(16));
    for (int row = bid * 8 + wave; row < T; row += G * 8) {
        u32x4 yv[TOPK + 1][2];
#pragma unroll
        for (int k = 0; k < TOPK + 1; ++k) {
            const size_t va = k < TOPK ? (size_t)row * TOPK + k : (size_t)A_TOT + row;
            if (L == 1 && k < TOPK) {
#pragma unroll
                for (int j = 0; j < 2; ++j) { const u32x2 w8 = *(const u32x2*)((const unsigned char*)P_yb + va * D + j * 512 + lane * 8); yv[k][j][0] = w8[0]; yv[k][j][1] = w8[1]; yv[k][j][2] = 0u; yv[k][j][3] = 0u; }
            } else {
#pragma unroll
                for (int j = 0; j < 2; ++j) yv[k][j] = *(const u32x4*)(P_yb + va * D + j * 512 + lane * 8);
            }
        }
        float v[16];
#pragma unroll
        for (int j = 0; j < 2; ++j) {
            const f32x4 t0 = *(const f32x4*)(P_x1 + (size_t)row * D + j * 512 + lane * 8), t1 = *(const f32x4*)(P_x1 + (size_t)row * D + j * 512 + lane * 8 + 4);
#pragma unroll
            for (int c = 0; c < 4; ++c) { v[j * 8 + c] = DN_ALPHA * t0[c]; v[j * 8 + 4 + c] = DN_ALPHA * t1[c]; }
        }
#pragma unroll
        for (int k = 0; k < TOPK + 1; ++k)
#pragma unroll
            for (int j = 0; j < 2; ++j) {
                if (L == 1 && k < TOPK) {
#pragma unroll
                    for (int c = 0; c < 2; ++c) {
                        const f32x2_ lo2 = __builtin_amdgcn_cvt_pk_f32_fp8((int)yv[k][j][c], false), hi2 = __builtin_amdgcn_cvt_pk_f32_fp8((int)yv[k][j][c], true);
                        v[j * 8 + 4 * c] += lo2[0]; v[j * 8 + 4 * c + 1] += lo2[1]; v[j * 8 + 4 * c + 2] += hi2[0]; v[j * 8 + 4 * c + 3] += hi2[1];
                    }
                } else {
#pragma unroll
                    for (int c = 0; c < 4; ++c) { v[j * 8 + 2 * c] += bf2f(yv[k][j][c] & 0xFFFFu); v[j * 8 + 2 * c + 1] += bf2f(yv[k][j][c] >> 16); }
                }
            }
        float sm = 0.f;
#pragma unroll
        for (int i = 0; i < 16; ++i) sm += v[i];
        const float mu = wave_sum(sm) * (1.f / D);
        float q = 0.f;
#pragma unroll
        for (int i = 0; i < 16; ++i) { const float d = v[i] - mu; q += d * d; }
        const float rstd = rsqrtf(wave_sum(q) * (1.f / D) + LN_EPS);
#pragma unroll
        for (int j = 0; j < 2; ++j) {
            const f32x4 g0 = *(const f32x4*)(lng + j * 512 + lane * 8), g1 = *(const f32x4*)(lng + j * 512 + lane * 8 + 4);
            const f32x4 b0 = *(const f32x4*)(lnb + j * 512 + lane * 8), b1 = *(const f32x4*)(lnb + j * 512 + lane * 8 + 4);
            f32x4 o0, o1;
#pragma unroll
            for (int c = 0; c < 4; ++c) { o0[c] = (v[j * 8 + c] - mu) * rstd * g0[c] + b0[c]; o1[c] = (v[j * 8 + 4 + c] - mu) * rstd * g1[c] + b1[c]; }
            *(f32x4*)(dst + (size_t)row * D + j * 512 + lane * 8) = o0; *(f32x4*)(dst + (size_t)row * D + j * 512 + lane * 8 + 4) = o1;
            if (L == 0) { u32x4 w; w[0] = cvtpk(o0[0], o0[1]); w[1] = cvtpk(o0[2], o0[3]); w[2] = cvtpk(o1[0], o1[1]); w[3] = cvtpk(o1[2], o1[3]); *(u32x4*)(P_xb + (size_t)row * D + j * 512 + lane * 8) = w; }
        }
    }
}

__global__ void __launch_bounds__(NTHR, 2) fwd(Args args) {
    extern __shared__ __attribute__((aligned(16))) unsigned char lds_raw[];
    LAS char* lds = (LAS char*)lds_raw;
    unsigned char* const ws = args.ws;
    const int lo = args.ph_lo, hi_ph = args.ph_hi;
    const int wave_s_ = __builtin_amdgcn_readfirstlane(threadIdx.x >> 6);
    if (threadIdx.x < 18) {
        const uint64_t v = threadIdx.x < 16 ? (uint64_t)args.in[threadIdx.x] : (threadIdx.x == 16 ? (uint64_t)args.out : (uint64_t)args.ws);
        ((LAS uint64_t*)(lds + LDS_CTX))[threadIdx.x] = v;
    }
    __syncthreads();
#define IN(k) (lo <= (k) && (k) < hi_ph)

#if MK_ONE_LAUNCH
    if (threadIdx.x < 4) ((LAS unsigned*)(lds + LDS_BAR))[threadIdx.x] = 0u;
    __syncthreads();
    XcdBarrier bar = xcd_barrier_post((unsigned*)(ws + WS_CTL), (volatile LAS unsigned*)(lds + LDS_BAR), wave_s_ == 0 && lane_id_() == 0);
#define GRID_BAR() xcd_barrier(bar, wave_s_ == 0 && lane_id_() == 0)
#else
#define GRID_BAR() do { } while (0)
#endif
#define SEAM(k) do { if (IN(k) && IN((k) + 1)) GRID_BAR(); } while (0)

    for (int rep_ = 0; rep_ < ((IN(0) && PHK(0)) ? REPS(0) : 0); ++rep_) { ph_p0(0, rep_, wave_s_); }
    SEAM(0);

    for (int L = 0; L < 2; ++L) {
        const int pb = 1 + 10 * L;
        for (int rep_ = 0; rep_ < ((IN(pb + 0) && PHK(1)) ? REPS(1) : 0); ++rep_) { ph_qkv(L, rep_, wave_s_); }
        SEAM(pb + 0);

        if (L == 0) {
            for (int rep_ = 0; rep_ < ((IN(pb + 1) && PHK(2)) ? REPS(2) : 0); ++rep_) { ph_kmean(L, rep_, wave_s_); }
            SEAM(pb + 1);
            for (int rep_ = 0; rep_ < ((IN(pb + 2) && PHK(11)) ? REPS(11) : 0); ++rep_) { ph_gate(L, rep_, wave_s_); }
            SEAM(pb + 2);
        }

        if (L == 0) {
            for (int rep_ = 0; rep_ < ((IN(pb + 3) && PHK(3)) ? REPS(3) : 0); ++rep_) { ph_moba(L, rep_, wave_s_); }
            SEAM(pb + 3);
            for (int rep_ = 0; rep_ < ((IN(pb + 4) && PHK(12)) ? REPS(12) : 0); ++rep_) { ph_mobamerge(L, rep_, wave_s_); }
        } else {
            for (int rep_ = 0; rep_ < ((IN(pb + 3) && PHK(4)) ? REPS(4) : 0); ++rep_) { ph_dil(L, rep_, wave_s_); }
            SEAM(pb + 3);
            for (int rep_ = 0; rep_ < ((IN(pb + 4) && PHK(5)) ? REPS(5) : 0); ++rep_) { ph_merge(L, rep_, wave_s_); }
        }
        SEAM(pb + 4);

        for (int rep_ = 0; rep_ < ((IN(pb + 5) && PHK(6)) ? REPS(6) : 0); ++rep_) { ph_wo(L, rep_, wave_s_); }
        SEAM(pb + 5);

        for (int rep_ = 0; rep_ < ((IN(pb + 6) && PHK(7)) ? REPS(7) : 0); ++rep_) { ph_router(L, rep_, wave_s_); }
        SEAM(pb + 6);

        for (int rep_ = 0; rep_ < ((IN(pb + 7) && PHK(8)) ? REPS(8) : 0); ++rep_) { ph_gateup(L, rep_, wave_s_); }
        SEAM(pb + 7);

        for (int rep_ = 0; rep_ < ((IN(pb + 8) && PHK(9)) ? REPS(9) : 0); ++rep_) { ph_down(L, rep_, wave_s_); }
        SEAM(pb + 8);

        for (int rep_ = 0; rep_ < ((IN(pb + 9) && PHK(10)) ? REPS(10) : 0); ++rep_) { ph_combine(L, rep_, wave_s_); }
        if (L == 0) SEAM(pb + 9);
    }
}

extern "C" void kernel_launch(void* const* d_in, const int* in_sizes, int n_in, void* d_out, int out_size, void* d_ws, size_t ws_size, hipStream_t stream) {
    static int grid = 0;
    if (grid == 0) {
        if (n_in != 16 || out_size != T * D || ws_size < WS_END2) { fprintf(stderr, "kernel_launch: unexpected problem (n_in %d out %d ws %zu need %zu)\n", n_in, out_size, ws_size, (size_t)WS_END2); grid = -1; return; }
        int dev = 0, cus = 0, per_cu = 0;
        if (hipGetDevice(&dev) != hipSuccess || hipDeviceGetAttribute(&cus, hipDeviceAttributeMultiprocessorCount, dev) != hipSuccess) { grid = -1; return; }
        if (hipFuncSetAttribute((const void*)fwd, hipFuncAttributeMaxDynamicSharedMemorySize, LDS_BYTES) != hipSuccess) { fprintf(stderr, "kernel_launch: hipFuncSetAttribute failed\n"); grid = -1; return; }
        if (hipOccupancyMaxActiveBlocksPerMultiprocessor(&per_cu, (const void*)fwd, NTHR, LDS_BYTES) != hipSuccess || per_cu < 1) { fprintf(stderr, "kernel_launch: occupancy query says %d\n", per_cu); (void)hipGetLastError(); per_cu = 1; }
        grid = cus;
    }
    if (grid < 0) return;
    (void)hipMemsetAsync((char*)d_ws + WS_CTL, 0, CTL_BYTES, stream);
    Args a{};
    for (int i = 0; i < 16; ++i) a.in[i] = (const float*)d_in[i];
    a.out = (float*)d_out; a.ws = (unsigned char*)d_ws;
#if MK_ONE_LAUNCH
    a.ph_lo = 0; a.ph_hi = N_PHASES;
    hipLaunchKernelGGL(fwd, dim3(grid), dim3(NTHR), LDS_BYTES, stream, a);
#else
    for (int ph = 0; ph < N_PHASES; ++ph) {
        if (ph == 12 || ph == 13) continue;
        a.ph_lo = ph; a.ph_hi = ph + 1;
        hipLaunchKernelGGL(fwd, dim3(grid), dim3(NTHR), LDS_BYTES, stream, a);
    }
#endif
}
```

```cpp
#include <hip/hip_runtime.h>
#include <hip/hip_bf16.h>
#include <stdint.h>
#include <stdio.h>

#ifndef MK_ONE_LAUNCH
#define MK_ONE_LAUNCH 1
#endif

#ifndef PHMASK
#define PHMASK 0x1FFF
#endif
#define PHK(k) ((PHMASK >> (k)) & 1)
#ifndef REPEAT_KIND
#define REPEAT_KIND -1
#endif
#define REPS(k) ((k) == REPEAT_KIND ? 2 : 1)
#define LAS __attribute__((address_space(3)))
typedef __attribute__((ext_vector_type(8))) short bf16x8;
typedef __attribute__((ext_vector_type(16))) float f32x16;
typedef __attribute__((ext_vector_type(4))) float f32x4;
typedef __attribute__((ext_vector_type(4))) unsigned u32x4;
typedef __attribute__((ext_vector_type(2))) unsigned u32x2;
typedef unsigned short u16;

constexpr int D = 1024, BATCH = 2, SEQ = 8192, T = BATCH * SEQ, NH = 16, HD = 64;
constexpr int NE = 256, TOPK = 8, DF = 256;
constexpr int A_TOT = T * TOPK;
constexpr int MOBA_BLK = 256, MOBA_NB = SEQ / MOBA_BLK;
constexpr float DN_ALPHA = 1.4142135623730951f;
constexpr float LN_EPS = 1e-5f;
constexpr float LOG2E = 1.4426950408889634f;
constexpr float LN2 = 0.6931471805599453f;
constexpr float NEGV = -1e30f;
constexpr int NTHR = 512;

constexpr size_t al256(size_t x) { return (x + 255) & ~(size_t)255; }
constexpr size_t WS_CTL = 0;
constexpr size_t CTL_BYTES = 65536;
constexpr size_t CTL_CNT_OFF = 32768;
constexpr size_t WS_XB = WS_CTL + CTL_BYTES;
constexpr size_t WS_X1 = WS_XB + al256((size_t)T * D * 2);
constexpr size_t WS_X2 = WS_X1 + al256((size_t)T * D * 4);
constexpr size_t WS_YPRE = WS_X2 + al256((size_t)T * D * 4);
constexpr size_t WS_QKV = WS_YPRE + al256((size_t)T * D * 4);
constexpr size_t WS_VT = WS_QKV + al256((size_t)T * 9216 * 2);
constexpr size_t WS_KM = WS_VT + al256((size_t)3 * T * D * 2);
constexpr size_t WS_AO = WS_KM + al256((size_t)BATCH * NH * MOBA_NB * HD * 4);
constexpr size_t WS_OG = WS_AO + al256((size_t)T * D * 2);
constexpr size_t WS_LSE = WS_OG + al256((size_t)3 * T * D * 2);
constexpr size_t WS_TOPW = WS_LSE + al256((size_t)3 * T * NH * 4);
constexpr size_t WS_LIST = WS_TOPW + al256((size_t)T * TOPK * 4);
constexpr size_t WS_HB = WS_LIST + al256((size_t)NE * T * 4);
constexpr size_t WS_YB = WS_HB + al256((size_t)(A_TOT + T + 1) * DF * 2);
constexpr size_t WS_END = WS_YB + al256((size_t)(A_TOT + T + 1) * D * 2);
constexpr int TRASH_VA = A_TOT + T;
constexpr size_t WS_SELM = WS_END;
constexpr size_t WS_PART = WS_SELM + al256((size_t)T * NH * 4);
constexpr size_t WS_PLSE = WS_PART + al256((size_t)T * NH * 4 * 64 * 2);
constexpr size_t WS_WQK0 = WS_PLSE + al256((size_t)T * NH * 4 * 4);
constexpr size_t WS_WV0 = WS_WQK0 + (size_t)2048 * 1024 * 2;
constexpr size_t WS_WQK1 = WS_WV0 + (size_t)1024 * 1024 * 2;
constexpr size_t WS_WV1 = WS_WQK1 + (size_t)6144 * 1024 * 2;
constexpr size_t WS_WO = WS_WV1 + (size_t)3072 * 1024 * 2;
constexpr size_t WS_WSGU = WS_WO + (size_t)2 * 1024 * 1024 * 2;
constexpr size_t WS_WSD = WS_WSGU + (size_t)2 * 512 * 1024 * 2;
constexpr size_t WS_XB8 = WS_WSD + (size_t)2 * 1024 * 256 * 2;
constexpr size_t WS_HBS = WS_XB8 + (size_t)T * D;
constexpr size_t WS_WRH = WS_HBS + (size_t)T * DF * 2;
constexpr size_t WS_WRL = WS_WRH + (size_t)2 * 256 * 1024 * 2;
constexpr size_t WS_END2 = WS_WRL + (size_t)2 * 256 * 1024 * 2;

constexpr int LDP = 40;
constexpr int STAGE_BYTES = 2 * 256 * LDP * 2;
constexpr int LDS_ROWID = 2 * STAGE_BYTES;
constexpr int LDS_ROWW = LDS_ROWID + 1024;
constexpr int XS_PITCH = 1028;
constexpr int LDS_BYTES = 163840;
constexpr int LDS_BAR = 161792;

__device__ __forceinline__ int lane_id_() { int l; asm volatile("v_mbcnt_lo_u32_b32 %0, -1, 0\n\tv_mbcnt_hi_u32_b32 %0, -1, %0" : "=v"(l)); return l; }
__device__ __forceinline__ float shxf(float v, int m, int lane) { return __int_as_float(__builtin_amdgcn_ds_bpermute((lane ^ m) << 2, __float_as_int(v))); }
__device__ __forceinline__ int shxi(int v, int m, int lane) { return __builtin_amdgcn_ds_bpermute((lane ^ m) << 2, v); }
#define XB_TMO      128
#define XB_XCNT(j)  (256  + 64 * (j))
#define XB_XSUB(j)  (1280 + 64 * (j))
#define XB_XGEN(j)  (2304 + 64 * (j))
#define XB_TOP      3328
#define XB_TOPGEN   3392
#define XCD_BAR_WORDS 3456
#define XB_SPIN_CAP (1u << 18)
__device__ __forceinline__ unsigned xb_ld(unsigned* p)              { return __hip_atomic_load(p, __ATOMIC_RELAXED, __HIP_MEMORY_SCOPE_AGENT); }
__device__ __forceinline__ unsigned xb_add(unsigned* p, unsigned v) { return __hip_atomic_fetch_add(p, v, __ATOMIC_RELAXED, __HIP_MEMORY_SCOPE_AGENT); }
__device__ __forceinline__ unsigned xb_xcc_id() { return (unsigned)__builtin_amdgcn_s_getreg((3 << 11) | 20) & 0xFu; }
#define XB_SPIN(cond, bar) do { unsigned _sp = 0; while (cond) { __builtin_amdgcn_s_sleep(1); \
    if ((++_sp & 255u) == 0u) { if (xb_ld(&(bar)[XB_TMO])) break; if (_sp > XB_SPIN_CAP) { atomicAdd(&(bar)[XB_TMO], 1u); break; } } } } while (0)
struct XcdBarrier { unsigned* bar; unsigned x; volatile LAS unsigned* st; };
__device__ __forceinline__ XcdBarrier xcd_barrier_post(unsigned* bar, volatile LAS unsigned* st, const bool leader) {
    XcdBarrier b; b.bar = bar; b.x = xb_xcc_id(); b.st = st;
    if (leader) (void)xb_add(&bar[XB_XCNT(b.x)], 1u);
    return b;
}
__device__ __forceinline__ void xcd_barrier_complete(unsigned* bar, unsigned x, unsigned& nloc, unsigned& nx) {
    const unsigned G = gridDim.x * gridDim.y * gridDim.z;
    unsigned sum, cnt, mine, sp = 0u;
    for (;;) {
        sum = 0u; cnt = 0u; mine = 0u;
#pragma unroll
        for (unsigned j = 0; j < 16; ++j) { const unsigned c = xb_ld(&bar[XB_XCNT(j)]); sum += c; cnt += (c > 0u) ? 1u : 0u; mine = (j == x) ? c : mine; }
        if (sum == G) break;
        __builtin_amdgcn_s_sleep(1);
        if ((++sp & 255u) == 0u) { if (xb_ld(&bar[XB_TMO])) break; if (sp > XB_SPIN_CAP) { atomicAdd(&bar[XB_TMO], 1u); break; } }
    }
    nloc = mine > 0u ? mine : 1u; nx = cnt > 0u ? cnt : 1u;
}
__device__ __forceinline__ void xcd_barrier(const XcdBarrier& b, const bool leader) {
    asm volatile("s_waitcnt vmcnt(0)" ::: "memory");
    __syncthreads();
    if (leader) {
        unsigned* bar = b.bar;
        __builtin_amdgcn_s_waitcnt(0);
        unsigned nloc = b.st[0], nx = b.st[1];
        if (nloc == 0u) { xcd_barrier_complete(bar, b.x, nloc, nx); b.st[0] = nloc; b.st[1] = nx; }
        const unsigned old = xb_add(&bar[XB_XSUB(b.x)], 1u);
        const unsigned gen = old / nloc;
        if (old + 1u == (gen + 1u) * nloc) {
            __builtin_amdgcn_fence(__ATOMIC_RELEASE, "agent");
            asm volatile("s_waitcnt vmcnt(0)" ::: "memory");
            const unsigned og = xb_add(&bar[XB_TOP], 1u);
            const unsigned tg = og / nx;
            if (og + 1u == (tg + 1u) * nx) xb_add(&bar[XB_TOPGEN], 1u);
            else XB_SPIN(xb_ld(&bar[XB_TOPGEN]) == tg, bar);
            __builtin_amdgcn_fence(__ATOMIC_ACQUIRE, "agent");
            xb_add(&bar[XB_XGEN(b.x)], 1u);
            asm volatile("s_waitcnt vmcnt(0)" ::: "memory");
        } else {
            XB_SPIN(xb_ld(&bar[XB_XGEN(b.x)]) == gen, bar);
            __builtin_amdgcn_fence(__ATOMIC_ACQUIRE, "agent");
            asm volatile("s_waitcnt vmcnt(0)" ::: "memory");
        }
    }
    __syncthreads();
}

typedef __attribute__((ext_vector_type(2))) __bf16 bf16x2_t;
typedef __attribute__((ext_vector_type(2))) float f32x2_t;
__device__ __forceinline__ unsigned cvtpk(float lo, float hi) { f32x2_t f; f[0] = lo; f[1] = hi; return __builtin_bit_cast(unsigned, __builtin_convertvector(f, bf16x2_t)); }
__device__ __forceinline__ float bf2f(unsigned v16) { return __uint_as_float(v16 << 16); }
__device__ __forceinline__ int crow(int r, int hi) { return (r & 3) + 8 * (r >> 2) + 4 * hi; }
#define MFMA_BF16(a, b, c) __builtin_amdgcn_mfma_f32_32x32x16_bf16(a, b, c, 0, 0, 0)
__device__ __forceinline__ float wave_sum(float v) {
    v += __int_as_float(__builtin_amdgcn_update_dpp(0, __float_as_int(v), 0xB1, 0xF, 0xF, true));
    v += __int_as_float(__builtin_amdgcn_update_dpp(0, __float_as_int(v), 0x4E, 0xF, 0xF, true));
    v += __int_as_float(__builtin_amdgcn_update_dpp(0, __float_as_int(v), 0x141, 0xF, 0xF, true));
    v += __int_as_float(__builtin_amdgcn_update_dpp(0, __float_as_int(v), 0x140, 0xF, 0xF, true));
    const int vi = __float_as_int(v);
    return (__int_as_float(__builtin_amdgcn_readlane(vi, 0)) + __int_as_float(__builtin_amdgcn_readlane(vi, 16))) + (__int_as_float(__builtin_amdgcn_readlane(vi, 32)) + __int_as_float(__builtin_amdgcn_readlane(vi, 48)));
}

namespace pg8 {
#define PG8_LAS __attribute__((address_space(3)))
typedef unsigned short bf16_t;
typedef short bf16x8 __attribute__((ext_vector_type(8)));
typedef float f32x4 __attribute__((ext_vector_type(4)));
typedef unsigned u32x4 __attribute__((ext_vector_type(4)));
constexpr int BM = 256, BK = 64, HALF = 128, HTB = HALF * BK * 2  , STAGE_BYTES = 8 * HTB, NXCD = 8, WGM = 8;

__host__ __device__ __forceinline__ int lds_byte(int r, int c) { const int st = (r >> 4) * 2 + (c >> 5), rr = r & 15, cc = c & 31, ob = rr * 64 + cc * 2; return st * 1024 + (ob ^ (((ob >> 9) & 1) << 5)); }
__host__ __device__ __forceinline__ void stage_rc(int b, int& R, int& C) { const int st = b / 1024, sb = b % 1024, swz = sb ^ (((sb >> 9) & 1) << 5); R = (st >> 1) * 16 + swz / 64; C = (st & 1) * 32 + (swz % 64) / 2; }
__host__ __device__ __forceinline__ int perm32(int rho) { const int n = rho >> 4, i = rho & 15; return 8 * (i >> 2) + 4 * n + (i & 3); }

struct Unit { int pm, pn; };
struct Gemm { const bf16_t* A; const bf16_t* Bt; int M, N, K; };
struct FixedOrder {
    int pm, pn;
    __device__ __forceinline__ bool next(int i, Unit& u) const { if (i != 0) return false; u.pm = pm; u.pn = pn; return true; }
    __device__ __forceinline__ void a_ready(const Unit&) const {}
    __device__ __forceinline__ void done(const Unit&) const {}
};

struct StaticOrder {
    int nM, nN, nwg, G, c;
    __host__ __device__ void init(int M, int N, int G_, int c_) { nM = M / BM; nN = N / BM; nwg = nM * nN; G = G_; c = c_; }
    __host__ __device__ bool next(int i, Unit& u) const {
        const long L = (long)i * G + c; if (L >= nwg) return false;
        int wgid = (int)L; { const int q = nwg / NXCD, r = nwg % NXCD, xcd = wgid % NXCD, off = wgid / NXCD; wgid = (xcd < r ? xcd * (q + 1) : r * (q + 1) + (xcd - r) * q) + off; }
        const int nig = WGM * nN, gid = wgid / nig, fm = gid * WGM, gsz = (nM - fm) < WGM ? (nM - fm) : WGM;
        u.pm = fm + ((wgid % nig) % gsz); u.pn = (wgid % nig) / gsz; return true;
    }
    __device__ __forceinline__ void a_ready(const Unit&) const {}
    __device__ __forceinline__ void done(const Unit&) const {}
};

template <class Epi, class Sched, bool SWAP = false, bool STAMP = false>
__device__ __forceinline__ void gemm_phase(PG8_LAS unsigned char* lds, const Gemm g, const Sched& S, const Epi& E, unsigned long long* stamps, const int tid_in) {
    int tid_ = tid_in; asm volatile("" : "+v"(tid_));
    const int tid = tid_, wid = __builtin_amdgcn_readfirstlane(tid >> 6), lane = tid & 63, wr = wid >> 2, wc = wid & 3, fr = lane & 15, fq = lane >> 4;
    const int K = g.K, nt = K / BK;
    int ts_lo = 0, ts_hi = 0, nts = 0; const unsigned long long rt_entry = STAMP ? (unsigned long long)wall_clock64() : 0ull;
#define PG8_STAMP() do { if (STAMP && wid == 0 && nts < 64) { const unsigned long long _c = (unsigned long long)clock64(); \
        ts_lo = (lane == nts) ? (int)(unsigned)_c : ts_lo; ts_hi = (lane == nts) ? (int)(unsigned)(_c >> 32) : ts_hi; ++nts; } } while (0)
    PG8_STAMP();
    unsigned voffA[2], voffB[2];
#pragma unroll
    for (int i = 0; i < 2; ++i) { int R, C; stage_rc(tid * 16 + i * 8192, R, C); const int Rb = Epi::PERM ? ((R & ~31) + perm32(R & 31)) : R;
        voffA[i] = (unsigned)(R * K + C) * 2u; voffB[i] = (unsigned)(Rb * K + C) * 2u; }
    const size_t kstep = (size_t)(BK * 2);
    const size_t hstep = (size_t)HALF * K * 2;
    const size_t tstep = 2 * hstep;
    const unsigned ldsw = (unsigned)wid * 1024u;
    const int aoff = lds_byte(wr * 64 + fr, fq * 8), boff = lds_byte(wc * 32 + fr, fq * 8);
#define PG8_SA(b, h) (((b) * 2 + (h)) * HTB)
#define PG8_SB(b, h) ((4 + (b) * 2 + (h)) * HTB)
#define PG8_STAGE(bufoff, gbase, voff) do { _Pragma("unroll") for (int _i = 0; _i < 2; ++_i) \
        __builtin_amdgcn_global_load_lds((const unsigned*)((const char*)(gbase) + (voff)[_i]), (PG8_LAS unsigned*)(lds + (bufoff) + ldsw + _i * 8192), 16, 0, 0); } while (0)
#define PG8_LDA(dst, b, h) do { _Pragma("unroll") for (int m = 0; m < 4; ++m) _Pragma("unroll") for (int k = 0; k < 2; ++k) dst[m][k] = *(const PG8_LAS bf16x8*)(lds + PG8_SA(b, h) + aoff + m * 2048 + k * 1024); } while (0)
#define PG8_LDB(dst, b, h) do { _Pragma("unroll") for (int n = 0; n < 2; ++n) _Pragma("unroll") for (int k = 0; k < 2; ++k) dst[n][k] = *(const PG8_LAS bf16x8*)(lds + PG8_SB(b, h) + boff + n * 2048 + k * 1024); } while (0)
#define PG8_MMA(ai, bj, At, Bt) do { __builtin_amdgcn_s_setprio(1); _Pragma("unroll") for (int m = 0; m < 4; ++m) _Pragma("unroll") for (int n = 0; n < 2; ++n) _Pragma("unroll") for (int k = 0; k < 2; ++k) \
        acc[ai][bj][m][n] = SWAP ? __builtin_amdgcn_mfma_f32_16x16x32_bf16(At[m][k], Bt[n][k], acc[ai][bj][m][n], 0, 0, 0) : __builtin_amdgcn_mfma_f32_16x16x32_bf16(Bt[n][k], At[m][k], acc[ai][bj][m][n], 0, 0, 0); __builtin_amdgcn_s_setprio(0); } while (0)
#define PG8_WAIT_V(n) asm volatile("s_waitcnt vmcnt(" #n ")" ::: "memory")
#define PG8_WAIT_L(n) asm volatile("s_waitcnt lgkmcnt(" #n ")" ::: "memory")
#define PG8_BAR __builtin_amdgcn_s_barrier()
#define PG8_SCHED __builtin_amdgcn_sched_barrier(0)
    Unit cur, nxt; int ui = 0;
    if (!S.next(0, cur)) return;
    f32x4 acc[2][2][4][2];
#pragma unroll
    for (int a = 0; a < 2; ++a)
#pragma unroll
        for (int b = 0; b < 2; ++b)
#pragma unroll
            for (int m = 0; m < 4; ++m)
#pragma unroll
                for (int n = 0; n < 2; ++n) acc[a][b][m][n] = (f32x4){0.f, 0.f, 0.f, 0.f};
    bf16x8 At[4][2], B0[2][2], B1[2][2];
    const char* cA = (const char*)g.A + (size_t)cur.pm * tstep; const char* cB = (const char*)g.Bt + (size_t)cur.pn * tstep;
    S.a_ready(cur);
    PG8_STAGE(PG8_SB(0, 0), cB, voffB); PG8_STAGE(PG8_SA(0, 0), cA, voffA); PG8_STAGE(PG8_SB(0, 1), cB + hstep, voffB); PG8_STAGE(PG8_SA(0, 1), cA + hstep, voffA);
    if (wr == 1) PG8_BAR;
    PG8_WAIT_V(4); PG8_BAR;
    PG8_STAGE(PG8_SB(1, 0), cB + kstep, voffB); PG8_STAGE(PG8_SA(1, 0), cA + kstep, voffA); PG8_STAGE(PG8_SB(1, 1), cB + hstep + kstep, voffB);
    PG8_WAIT_V(6); PG8_BAR;
    PG8_STAMP();
    for (;;) {
        const bool has_next = S.next(ui + 1, nxt);
        const char* nA = has_next ? (const char*)g.A + (size_t)nxt.pm * tstep : cA; const char* nB = has_next ? (const char*)g.Bt + (size_t)nxt.pn * tstep : cB;
        for (int t = 0; t < nt; t += 2) {
            const bool last = (t == nt - 2);
            const char* a1 = cA + (size_t)(t + 1) * kstep;
            const char* a2 = last ? nA : cA + (size_t)(t + 2) * kstep; const char* b2 = last ? nB : cB + (size_t)(t + 2) * kstep;
            const char* a3 = a2 + kstep; const char* b3 = b2 + kstep;
            if (last && has_next) S.a_ready(nxt);
            PG8_LDB(B0, 0, 0); PG8_SCHED; PG8_LDA(At, 0, 0); PG8_STAGE(PG8_SA(1, 1), a1 + hstep, voffA);
            PG8_WAIT_L(8); PG8_BAR; PG8_WAIT_L(0); PG8_MMA(0, 0, At, B0); PG8_BAR; PG8_SCHED;
            PG8_LDB(B1, 0, 1); PG8_STAGE(PG8_SB(0, 0), b2, voffB);
            PG8_BAR; PG8_WAIT_L(0); PG8_MMA(0, 1, At, B1); PG8_BAR;
            PG8_LDA(At, 0, 1); PG8_STAGE(PG8_SA(0, 0), a2, voffA);
            PG8_BAR; PG8_WAIT_L(0); PG8_MMA(1, 0, At, B0); PG8_BAR; PG8_SCHED;
            PG8_STAGE(PG8_SB(0, 1), b2 + hstep, voffB);
            PG8_WAIT_V(6); PG8_BAR; PG8_MMA(1, 1, At, B1); PG8_BAR;
            PG8_LDB(B0, 1, 0); PG8_SCHED; PG8_LDA(At, 1, 0); PG8_STAGE(PG8_SA(0, 1), a2 + hstep, voffA);
            PG8_WAIT_L(8); PG8_BAR; PG8_WAIT_L(0); PG8_MMA(0, 0, At, B0); PG8_BAR; PG8_SCHED;
            PG8_LDB(B1, 1, 1); PG8_STAGE(PG8_SB(1, 0), b3, voffB);
            PG8_BAR; PG8_WAIT_L(0); PG8_MMA(0, 1, At, B1); PG8_BAR;
            PG8_LDA(At, 1, 1); PG8_STAGE(PG8_SA(1, 0), a3, voffA);
            PG8_BAR; PG8_WAIT_L(0); PG8_MMA(1, 0, At, B0); PG8_BAR; PG8_SCHED;
            PG8_STAGE(PG8_SB(1, 1), b3 + hstep, voffB);
            PG8_WAIT_V(6); PG8_BAR; PG8_MMA(1, 1, At, B1); PG8_BAR;
        }
        PG8_STAMP();
        if constexpr (!Epi::AFTER_DRAIN) { E(acc, cur, wr, wc, fr, fq); S.done(cur); }
        PG8_STAMP();
        if (!has_next) break;
#pragma unroll
        for (int a = 0; a < 2; ++a)
#pragma unroll
            for (int b = 0; b < 2; ++b)
#pragma unroll
                for (int m = 0; m < 4; ++m)
#pragma unroll
                    for (int n = 0; n < 2; ++n) acc[a][b][m][n] = (f32x4){0.f, 0.f, 0.f, 0.f};
        cur = nxt; cA = nA; cB = nB; ++ui;
    }
    PG8_WAIT_V(0);
    if (wr == 0) PG8_BAR;
    PG8_BAR;
    if constexpr (Epi::AFTER_DRAIN) { E.fused(acc, cur, wr, wc, fr, fq, lds, wid, lane); S.done(cur); }
    PG8_STAMP();
    if (STAMP && wid == 0) { stamps[lane] = lane < nts ? (((unsigned long long)(unsigned)ts_hi << 32) | (unsigned)ts_lo) : 0ull;
        if (lane == 62) stamps[62] = rt_entry; if (lane == 63) stamps[63] = (unsigned long long)wall_clock64(); }
#undef PG8_STAMP
#undef PG8_SA
#undef PG8_SB
#undef PG8_STAGE
#undef PG8_LDA
#undef PG8_LDB
#undef PG8_MMA
#undef PG8_WAIT_V
#undef PG8_WAIT_L
#undef PG8_BAR
#undef PG8_SCHED
}
}

struct EpiQK {
    static constexpr bool PERM = true, AFTER_DRAIN = false;
    u16* O; int ldc;
    __device__ __forceinline__ void operator()(const pg8::f32x4 (&acc)[2][2][4][2], const pg8::Unit& u, int wr, int wc, int fr, int fq) const {
        const int col0 = u.pn * 256 + wc * 32 + 8 * fq, row0 = u.pm * 256 + wr * 64 + fr;
#pragma unroll
        for (int ai = 0; ai < 2; ++ai)
#pragma unroll
            for (int m = 0; m < 4; ++m) { u16* rowp = O + (size_t)(row0 + ai * 128 + m * 16) * ldc + col0;
#pragma unroll
                for (int bj = 0; bj < 2; ++bj) { const pg8::f32x4 v0 = acc[ai][bj][m][0], v1 = acc[ai][bj][m][1];
                    u32x4 w; w[0] = cvtpk(v0[0], v0[1]); w[1] = cvtpk(v0[2], v0[3]); w[2] = cvtpk(v1[0], v1[1]); w[3] = cvtpk(v1[2], v1[3]);
                    *(u32x4*)(rowp + bj * 128) = w; } }
    }
};
struct EpiV {
    static constexpr bool PERM = false, AFTER_DRAIN = false;
    u16* VT; int layer;
    __device__ __forceinline__ void operator()(const pg8::f32x4 (&acc)[2][2][4][2], const pg8::Unit& u, int wr, int wc, int fr, int fq) const {
        const int colt = u.pn * 256, grp = colt >> 10;
        const int dil = (layer == 0 || grp == 0) ? 1 : (grp == 1 ? 4 : 16);
        const int rowb = u.pm * 256 + wr * 64 + 4 * fq;
#pragma unroll
        for (int bj = 0; bj < 2; ++bj)
#pragma unroll
            for (int n = 0; n < 2; ++n) {
                const int c = (colt & 1023) + bj * 128 + wc * 32 + n * 16 + fr, h = c >> 6, d = c & 63;
#pragma unroll
                for (int ai = 0; ai < 2; ++ai)
#pragma unroll
                    for (int m = 0; m < 4; ++m) {
                        const int r0 = rowb + ai * 128 + m * 16, b = r0 >> 13, t0 = r0 & (SEQ - 1);
                        u16* vrow = VT + (size_t)grp * T * D + ((size_t)(b * NH + h) * HD + d) * SEQ;
                        const pg8::f32x4 v = acc[ai][bj][m][n];
                        if (dil == 1) { u32x2 w; w[0] = cvtpk(v[0], v[1]); w[1] = cvtpk(v[2], v[3]); *(u32x2*)(vrow + t0) = w; }
                        else {
#pragma unroll
                            for (int i = 0; i < 4; ++i) { const int pp = t0 + i; vrow[(pp % dil) * (SEQ / dil) + pp / dil] = (u16)cvtpk(v[i], 0.f); }
                        }
                    }
            }
    }
};
struct EpiWo {
    static constexpr bool PERM = false, AFTER_DRAIN = false;
    float* Y; const float* X;
    __device__ __forceinline__ void operator()(const pg8::f32x4 (&acc)[2][2][4][2], const pg8::Unit& u, int wr, int wc, int fr, int fq) const {
        const int row0 = u.pm * 256 + wr * 64 + fr, col0 = u.pn * 256 + wc * 32 + 4 * fq;
#pragma unroll
        for (int ai = 0; ai < 2; ++ai)
#pragma unroll
            for (int m = 0; m < 4; ++m) { const size_t ro = (size_t)(row0 + ai * 128 + m * 16) * D + col0;
#pragma unroll
                for (int bj = 0; bj < 2; ++bj)
#pragma unroll
                    for (int n = 0; n < 2; ++n) { const pg8::f32x4 x = *(const pg8::f32x4*)(X + ro + bj * 128 + n * 16); *(pg8::f32x4*)(Y + ro + bj * 128 + n * 16) = x * DN_ALPHA + acc[ai][bj][m][n]; } }
    }
};
struct EpiSGU {
    static constexpr bool PERM = true, AFTER_DRAIN = false;
    u16* H;
    __device__ __forceinline__ void operator()(const pg8::f32x4 (&acc)[2][2][4][2], const pg8::Unit& u, int wr, int wc, int fr, int fq) const {
        const int row0 = u.pm * 256 + wr * 64 + fr, f0 = u.pn * 128 + wc * 32 + 8 * fq;
#pragma unroll
        for (int ai = 0; ai < 2; ++ai)
#pragma unroll
            for (int m = 0; m < 4; ++m) {
                float hv[8];
#pragma unroll
                for (int n = 0; n < 2; ++n)
#pragma unroll
                    for (int i = 0; i < 4; ++i) { const float gt = acc[ai][0][m][n][i], up = acc[ai][1][m][n][i]; hv[n * 4 + i] = gt / (1.f + __expf(-gt)) * up; }
                u32x4 w; w[0] = cvtpk(hv[0], hv[1]); w[1] = cvtpk(hv[2], hv[3]); w[2] = cvtpk(hv[4], hv[5]); w[3] = cvtpk(hv[6], hv[7]);
                *(u32x4*)(H + (size_t)(row0 + ai * 128 + m * 16) * DF + f0) = w;
            }
    }
};
struct EpiSD {
    static constexpr bool PERM = true, AFTER_DRAIN = false;
    u16* Y;
    __device__ __forceinline__ void operator()(const pg8::f32x4 (&acc)[2][2][4][2], const pg8::Unit& u, int wr, int wc, int fr, int fq) const {
        const int row0 = u.pm * 256 + wr * 64 + fr, col0 = u.pn * 256 + wc * 32 + 8 * fq;
#pragma unroll
        for (int ai = 0; ai < 2; ++ai)
#pragma unroll
            for (int m = 0; m < 4; ++m) { u16* rowp = Y + (size_t)(A_TOT + row0 + ai * 128 + m * 16) * D + col0;
#pragma unroll
                for (int bj = 0; bj < 2; ++bj) { const pg8::f32x4 v0 = acc[ai][bj][m][0], v1 = acc[ai][bj][m][1];
                    u32x4 w; w[0] = cvtpk(v0[0], v0[1]); w[1] = cvtpk(v0[2], v0[3]); w[2] = cvtpk(v1[0], v1[1]); w[3] = cvtpk(v1[2], v1[3]);
                    *(u32x4*)(rowp + bj * 128) = w; } }
    }
};

struct Args {
    const float* in[16];
    float* out;
    unsigned char* ws;
    int ph_lo, ph_hi;
};

#define GEMM_CORE(K_, PA0, PA1, PB, LDB)                                                                                                   \
    {                                                                                                                                      \
        const int g_tid = tid, g_lane = lane, g_wave = wave, g_r32 = r32, g_hi = hi;                   \
        const int g_wm = g_wave >> 2, g_wn = g_wave & 3, g_kc = g_tid & 3, g_kq = g_lane >> 3, g_n4 = g_lane & 7;                           \
        const u16* g_pa0 = (PA0); const u16* g_pa1 = (PA1);                                                                                \
        const size_t g_ldb = (size_t)(LDB);                                                                                                \
        const float* g_pb = (PB) + (size_t)(g_kq * 4) * g_ldb + g_n4 * 4;                                                                  \
        const int g_nk = (K_) / 32;                                                                                                        \
        u32x4 g_ra0, g_ra1; f32x4 g_rb0, g_rb1, g_rb2, g_rb3;                                                                              \
        const u32x4 g_z = {0u, 0u, 0u, 0u};                                                                                                \
        _Pragma("unroll") for (int mb = 0; mb < 4; ++mb) { _Pragma("unroll") for (int nb = 0; nb < 2; ++nb) { _Pragma("unroll") for (int r = 0; r < 16; ++r) acc[mb][nb][r] = 0.f; } } \
        g_ra0 = g_pa0 ? *(const u32x4*)(g_pa0 + g_kc * 8) : g_z; g_ra1 = g_pa1 ? *(const u32x4*)(g_pa1 + g_kc * 8) : g_z;                 \
        g_rb0 = *(const f32x4*)(g_pb); g_rb1 = *(const f32x4*)(g_pb + g_ldb); g_rb2 = *(const f32x4*)(g_pb + 2 * g_ldb); g_rb3 = *(const f32x4*)(g_pb + 3 * g_ldb); \
        _Pragma("unroll 1") for (int kt = 0; kt < g_nk; ++kt) {                                                                            \
            LAS char* As = lds + (kt & 1) * STAGE_BYTES; LAS char* Bs = As + 256 * LDP * 2;                                                \
            *(LAS u32x4*)(As + ((g_tid >> 2) * LDP + g_kc * 8) * 2) = g_ra0;                                                               \
            *(LAS u32x4*)(As + (((g_tid >> 2) + 128) * LDP + g_kc * 8) * 2) = g_ra1;                                                       \
            _Pragma("unroll") for (int i = 0; i < 4; ++i) {                                                                                \
                u32x2 w; w[0] = cvtpk(g_rb0[i], g_rb1[i]); w[1] = cvtpk(g_rb2[i], g_rb3[i]);                                               \
                *(LAS u32x2*)(Bs + ((g_wave * 32 + i * 8 + g_n4) * LDP + g_kq * 4) * 2) = w;                                               \
            }                                                                                                                              \
            __syncthreads();                                                                                                               \
            if (kt + 1 < g_nk) {                                                                                                           \
                const int ko = (kt + 1) * 32;                                                                                              \
                g_ra0 = g_pa0 ? *(const u32x4*)(g_pa0 + ko + g_kc * 8) : g_z; g_ra1 = g_pa1 ? *(const u32x4*)(g_pa1 + ko + g_kc * 8) : g_z; \
                const float* pbk = g_pb + (size_t)ko * g_ldb;                                                                              \
                g_rb0 = *(const f32x4*)(pbk); g_rb1 = *(const f32x4*)(pbk + g_ldb); g_rb2 = *(const f32x4*)(pbk + 2 * g_ldb); g_rb3 = *(const f32x4*)(pbk + 3 * g_ldb); \
            }                                                                                                                              \
            _Pragma("unroll") for (int s = 0; s < 2; ++s) {                                                                                \
                bf16x8 af[4], bfr[2];                                                                                                      \
                _Pragma("unroll") for (int mb = 0; mb < 4; ++mb) af[mb] = *(LAS bf16x8*)(As + ((g_wm * 128 + mb * 32 + g_r32) * LDP + s * 16 + g_hi * 8) * 2); \
                _Pragma("unroll") for (int nb = 0; nb < 2; ++nb) bfr[nb] = *(LAS bf16x8*)(Bs + (((g_wn * 2 + nb) * 32 + g_r32) * LDP + s * 16 + g_hi * 8) * 2); \
                _Pragma("unroll") for (int mb = 0; mb < 4; ++mb) { _Pragma("unroll") for (int nb = 0; nb < 2; ++nb) acc[mb][nb] = MFMA_BF16(af[mb], bfr[nb], acc[mb][nb]); } \
            }                                                                                                                              \
        }                                                                                                                                  \
        __syncthreads();                                                                                                                   \
    }

struct AttnSt { float m, l; f32x16 o0, o1; };

struct AttnFr { bf16x8 k[4]; bf16x8 v[4]; };
__device__ __forceinline__ void attn_load(AttnFr& f, const u16* krow, const u16* vt, size_t vt_dstride) {
#pragma unroll
    for (int d0 = 0; d0 < 4; ++d0) f.k[d0] = *(const bf16x8*)(krow + d0 * 16);
    const u16* vt1 = vt + 32 * vt_dstride;
    union { bf16x8 v; u32x2 h[2]; } va;
    va.h[0] = *(const u32x2*)(vt);       va.h[1] = *(const u32x2*)(vt + 8);   f.v[0] = va.v;
    va.h[0] = *(const u32x2*)(vt + 16);  va.h[1] = *(const u32x2*)(vt + 24);  f.v[1] = va.v;
    va.h[0] = *(const u32x2*)(vt1);      va.h[1] = *(const u32x2*)(vt1 + 8);  f.v[2] = va.v;
    va.h[0] = *(const u32x2*)(vt1 + 16); va.h[1] = *(const u32x2*)(vt1 + 24); f.v[3] = va.v;
}
__device__ __forceinline__ void attn_compute(AttnSt& st, const bf16x8 (&qf)[4], const AttnFr& f, int dist0, float bslope, int dlo, int dhi, int hi, int lane) {
    f32x16 p;
#pragma unroll
    for (int r = 0; r < 16; ++r) p[r] = 0.f;
#pragma unroll
    for (int d0 = 0; d0 < 4; ++d0) p = MFMA_BF16(f.k[d0], qf[d0], p);
    constexpr float C2 = 0.125f * LOG2E;
    float mx = NEGV;
#pragma unroll
    for (int r = 0; r < 16; ++r) {
        const int dist = dist0 - ((r & 3) + 8 * (r >> 2));
        const float sc = __builtin_fmaf(p[r], C2, -bslope * (float)dist);
        const float s_ = (dist >= dlo && dist <= dhi) ? sc : NEGV;
        p[r] = s_; mx = fmaxf(mx, s_);
    }
    mx = fmaxf(mx, shxf(mx, 32, lane));
    const float mnew = fmaxf(st.m, mx);
    const float alpha = __builtin_amdgcn_exp2f(st.m - mnew);
    st.m = mnew;
    float ls = 0.f;
#pragma unroll
    for (int r = 0; r < 16; ++r) { p[r] = __builtin_amdgcn_exp2f(p[r] - mnew); ls += p[r]; }
    st.l = st.l * alpha + ls;
#pragma unroll
    for (int r = 0; r < 16; ++r) { st.o0[r] *= alpha; st.o1[r] *= alpha; }
    union { bf16x8 v; unsigned u[4]; } pb0, pb1;
#pragma unroll
    for (int j = 0; j < 4; ++j) { pb0.u[j] = cvtpk(p[2 * j], p[2 * j + 1]); pb1.u[j] = cvtpk(p[8 + 2 * j], p[8 + 2 * j + 1]); }
    st.o0 = MFMA_BF16(f.v[0], pb0.v, st.o0);
    st.o0 = MFMA_BF16(f.v[1], pb1.v, st.o0);
    st.o1 = MFMA_BF16(f.v[2], pb0.v, st.o1);
    st.o1 = MFMA_BF16(f.v[3], pb1.v, st.o1);
    (void)hi;
}

__device__ __forceinline__ float dpp_rowmax(float v) {
    v = fmaxf(v, __int_as_float(__builtin_amdgcn_update_dpp(0, __float_as_int(v), 0xB1, 0xF, 0xF, true)));
    v = fmaxf(v, __int_as_float(__builtin_amdgcn_update_dpp(0, __float_as_int(v), 0x4E, 0xF, 0xF, true)));
    v = fmaxf(v, __int_as_float(__builtin_amdgcn_update_dpp(0, __float_as_int(v), 0x141, 0xF, 0xF, true)));
    v = fmaxf(v, __int_as_float(__builtin_amdgcn_update_dpp(0, __float_as_int(v), 0x140, 0xF, 0xF, true)));
    return v;
}
__device__ __forceinline__ int dpp_rowmin_i(int v) {
    v = min(v, __builtin_amdgcn_update_dpp(0, v, 0xB1, 0xF, 0xF, true));
    v = min(v, __builtin_amdgcn_update_dpp(0, v, 0x4E, 0xF, 0xF, true));
    v = min(v, __builtin_amdgcn_update_dpp(0, v, 0x141, 0xF, 0xF, true));
    v = min(v, __builtin_amdgcn_update_dpp(0, v, 0x140, 0xF, 0xF, true));
    return v;
}
__device__ __forceinline__ float rl_f(float v, int l) { return __int_as_float(__builtin_amdgcn_readlane(__float_as_int(v), l)); }

__device__ __forceinline__ void top3_insert(float v, int i, float& v0, int& i0, float& v1, int& i1, float& v2, int& i2) {
    const bool b0 = (v > v0) || (v == v0 && i < i0);
    const bool b1 = (v > v1) || (v == v1 && i < i1);
    const bool b2 = (v > v2) || (v == v2 && i < i2);
    const float nv2 = b1 ? v1 : (b2 ? v : v2); const int ni2 = b1 ? i1 : (b2 ? i : i2);
    const float nv1 = b0 ? v0 : (b1 ? v : v1); const int ni1 = b0 ? i0 : (b1 ? i : i1);
    const float nv0 = b0 ? v : v0;             const int ni0 = b0 ? i : i0;
    v0 = nv0; i0 = ni0; v1 = nv1; i1 = ni1; v2 = nv2; i2 = ni2;
}

__device__ __forceinline__ void ln_row(float (&v)[16], const float* __restrict__ g, const float* __restrict__ b, int lane) {
    float s = 0.f;
#pragma unroll
    for (int i = 0; i < 16; ++i) s += v[i];
    const float mu = wave_sum(s) * (1.f / D);
    float q = 0.f;
#pragma unroll
    for (int i = 0; i < 16; ++i) { const float d = v[i] - mu; q += d * d; }
    const float rstd = rsqrtf(wave_sum(q) * (1.f / D) + LN_EPS);
#pragma unroll
    for (int j = 0; j < 4; ++j) {
        const f32x4 gg = *(const f32x4*)(g + j * 256 + lane * 4), bb = *(const f32x4*)(b + j * 256 + lane * 4);
#pragma unroll
        for (int c = 0; c < 4; ++c) v[j * 4 + c] = (v[j * 4 + c] - mu) * rstd * gg[c] + bb[c];
    }
}

typedef __attribute__((ext_vector_type(2))) float f32x2_;
__device__ __forceinline__ bf16x8 fp8x8_to_bf16(unsigned lo, unsigned hi_) {
    const f32x2_ a = __builtin_amdgcn_cvt_pk_f32_fp8((int)lo, false), b = __builtin_amdgcn_cvt_pk_f32_fp8((int)lo, true);
    const f32x2_ c = __builtin_amdgcn_cvt_pk_f32_fp8((int)hi_, false), d = __builtin_amdgcn_cvt_pk_f32_fp8((int)hi_, true);
    union { bf16x8 v; unsigned u[4]; } r;
    r.u[0] = cvtpk(a[0], a[1]); r.u[1] = cvtpk(b[0], b[1]); r.u[2] = cvtpk(c[0], c[1]); r.u[3] = cvtpk(d[0], d[1]);
    return r.v;
}
__device__ __forceinline__ unsigned pack_fp8x4(float a, float b, float c, float d) { int p = __builtin_amdgcn_cvt_pk_fp8_f32(a, b, 0, false); return (unsigned)__builtin_amdgcn_cvt_pk_fp8_f32(c, d, p, true); }

constexpr int MOE_BP = 72;
constexpr int MOE_BSTAGE = 128 * MOE_BP * 2;
constexpr int MOE_LDS_VA = 3 * MOE_BSTAGE;
constexpr int MOE_LDS_W = MOE_LDS_VA + 4096;
template <bool DOWN>
__device__ __forceinline__ void moe_expert(LAS char* lds, const int tid, const int lane, const int wave, const int r32, const int hi,
                                           const unsigned char* __restrict__ abase  , const float* __restrict__ w0, const float* __restrict__ w1, const int ng  , void* __restrict__ outv,
                                           const int pass0, const int npass_, const int st0, const int nstl  , const bool y8 = false  ) {
    constexpr int KT = DOWN ? 4 : 16, NP = DOWN ? 8 : 4, LDB = DOWN ? 1024 : 256, APITCH = DOWN ? 256 : 1024  , PSTEP = DOWN ? 128 : 64;
    LAS int* rowva = (LAS int*)(lds + MOE_LDS_VA); LAS float* roww = (LAS float*)(lds + MOE_LDS_W);
    const int nst = nstl;
    const int nsteps = npass_ * nst * KT; (void)NP;
    unsigned aoff[2];
#define MOE_AOFF(ST_) { _Pragma("unroll") for (int a = 0; a < 2; ++a) { const int va_ = rowva[(ST_) * 512 + wave * 64 + a * 32 + r32]; \
        const int srow_ = DOWN ? va_ : (va_ == TRASH_VA ? 0 : (va_ >> 3)); aoff[a] = (unsigned)srow_ * APITCH + hi * 32; } }
    const int seg = wave >> 1, n4 = lane & 7, kp = (wave & 1) * 16 + (lane >> 3);
    const char* wbase = (const char*)(DOWN ? (w0 + seg * 32) : (((seg < 2) ? w0 : w1) + (seg & 1) * 32));
    unsigned boff = (unsigned)(4 * n4 + 2 * kp * LDB) * 4u; asm volatile("" : "+v"(boff));
    f32x16 acc[2][4];
#pragma unroll
    for (int a = 0; a < 2; ++a)
#pragma unroll
        for (int c = 0; c < 4; ++c)
#pragma unroll
            for (int r = 0; r < 16; ++r) acc[a][c][r] = 0.f;
    u32x4 fa8[2][2];
    f32x4 rb0[4], rb1[4];
#define MOE_DEC(S_) const int s2_ = (S_) < nsteps ? (S_) : 0; const int pl_ = s2_ / (nst * KT); const int rm_ = s2_ - pl_ * (nst * KT); const int sl_ = rm_ / KT; const int kt_ = rm_ - sl_ * KT; const int ps_ = pass0 + pl_; const int stt_ = st0 + sl_;
#define MOE_LOADB(S_, RB) { MOE_DEC(S_) (void)stt_; \
        const char* wp_ = wbase + (size_t)(ps_ * PSTEP + kt_ * 64 * LDB) * 4 + boff; \
        RB[0] = *(const f32x4*)(wp_); RB[1] = *(const f32x4*)(wp_ + LDB * 4); RB[2] = *(const f32x4*)(wp_ + 16 * LDB * 4); RB[3] = *(const f32x4*)(wp_ + 17 * LDB * 4); }
#define MOE_WRITEB(STG, RB) { LAS char* Bs_ = lds + (STG) * MOE_BSTAGE; \
        _Pragma("unroll") for (int i = 0; i < 4; ++i) { LAS unsigned* q_ = (LAS unsigned*)(Bs_ + ((seg * 32 + i * 8 + n4) * MOE_BP + 2 * kp) * 2); q_[0] = cvtpk(RB[0][i], RB[1][i]); q_[8] = cvtpk(RB[2][i], RB[3][i]); } }
#define MOE_COMPUTE(STG, DO_MFMA) { LAS char* Bs_ = lds + (STG) * MOE_BSTAGE; \
        _Pragma("unroll") for (int u = 0; u < 4; ++u) { \
            bf16x8 bfr[4]; \
            if (DO_MFMA) { _Pragma("unroll") for (int c = 0; c < 4; ++c) bfr[c] = *(LAS bf16x8*)(Bs_ + ((c * 32 + r32) * MOE_BP + hi * 32 + u * 8) * 2); } \
            _Pragma("unroll") for (int a = 0; a < 2; ++a) { \
                if (DO_MFMA) { const bf16x8 af_ = fp8x8_to_bf16(fa8[a][u >> 1][(u & 1) * 2], fa8[a][u >> 1][(u & 1) * 2 + 1]); \
                    _Pragma("unroll") for (int c = 0; c < 4; ++c) acc[a][c] = MFMA_BF16(bfr[c], af_, acc[a][c]); } \
                if (u & 1) fa8[a][u >> 1] = *(const u32x4*)(ab_n + aoff[a] + (u >> 1) * 16); \
            } \
        } }
#define MOE_NEXTA(S_) MOE_DEC(S_) (void)ps_; \
        if (stt_ != st_loaded) { MOE_AOFF(stt_) st_loaded = stt_; } \
        const char* ab_n = (const char*)abase + kt_ * 64;
    int st_loaded = st0;
    MOE_AOFF(st0)
    { const char* ab0 = (const char*)abase;
#pragma unroll
      for (int a = 0; a < 2; ++a)
#pragma unroll
          for (int h2 = 0; h2 < 2; ++h2) fa8[a][h2] = *(const u32x4*)(ab0 + aoff[a] + h2 * 16); }
    MOE_LOADB(0, rb0)
    MOE_LOADB(1, rb1)
    MOE_WRITEB(0, rb0)
    MOE_LOADB(2, rb0)
    int stg = 0;
#pragma unroll 1
    for (int sidx = 0; sidx < nsteps; sidx += 2) {
        const int pl = sidx / (nst * KT); const int rm = sidx - pl * (nst * KT); const int sl = rm / KT; const int kt = rm - sl * KT; const int ps = pass0 + pl, stt = st0 + sl;
        const bool wv = (wave * 64) < (ng - stt * 512);
        const int stg1 = stg == 2 ? 0 : stg + 1, stg2 = stg1 == 2 ? 0 : stg1 + 1;
        __syncthreads();
        MOE_WRITEB(stg1, rb1)
        MOE_LOADB(sidx + 3, rb1)
        { MOE_NEXTA(sidx + 1)
          if (wv) MOE_COMPUTE(stg, true) else MOE_COMPUTE(stg, false) }
        __syncthreads();
        MOE_WRITEB(stg2, rb0)
        MOE_LOADB(sidx + 4, rb0)
        { MOE_NEXTA(sidx + 2)
          if (wv) MOE_COMPUTE(stg1, true) else MOE_COMPUTE(stg1, false) }
        stg = stg2;
        if (kt == KT - 2) {
            if (wv) {
                const int nrows = ng - stt * 512;
#pragma unroll
                for (int a = 0; a < 2; ++a) {
                    if (a == 0 || (wave * 64 + 32) < nrows) {
                        const int lrow = stt * 512 + wave * 64 + a * 32 + r32;
                        const unsigned va = (unsigned)rowva[lrow];
                        if (DOWN) {
                            const float w = roww[lrow];
#pragma unroll
                            for (int c = 0; c < 4; ++c) {
                                float yv_[16];
#pragma unroll
                                for (int j = 0; j < 16; ++j) yv_[j] = acc[a][c][(j >> 2) + 4 * (j & 3)] * w;
                                if (y8) {
                                    u32x4 q8;
#pragma unroll
                                    for (int jj = 0; jj < 4; ++jj) q8[jj] = pack_fp8x4(yv_[4 * jj], yv_[4 * jj + 1], yv_[4 * jj + 2], yv_[4 * jj + 3]);
                                    *(u32x4*)((unsigned char*)outv + (size_t)va * D + ps * 128 + c * 32 + 16 * hi) = q8;
                                } else {
                                    u32x4 q0, q1;
#pragma unroll
                                    for (int jj = 0; jj < 4; ++jj) { q0[jj] = cvtpk(yv_[2 * jj], yv_[2 * jj + 1]); q1[jj] = cvtpk(yv_[8 + 2 * jj], yv_[9 + 2 * jj]); }
                                    u16* o = (u16*)outv + (size_t)va * D + ps * 128 + c * 32 + 16 * hi;
                                    *(u32x4*)o = q0; *(u32x4*)(o + 8) = q1;
                                }
                            }
                        } else {
#pragma unroll
                            for (int c = 0; c < 2; ++c) {
                                float hv[16];
#pragma unroll
                                for (int j = 0; j < 16; ++j) { const int r = (j >> 2) + 4 * (j & 3); const float gt = acc[a][c][r], up = acc[a][c + 2][r]; hv[j] = gt / (1.f + __expf(-gt)) * up; }
                                u32x4 q;
#pragma unroll
                                for (int jj = 0; jj < 4; ++jj) q[jj] = pack_fp8x4(hv[4 * jj], hv[4 * jj + 1], hv[4 * jj + 2], hv[4 * jj + 3]);
                                *(u32x4*)((unsigned char*)outv + (size_t)va * DF + ps * 64 + c * 32 + 16 * hi) = q;
                            }
                        }
                    }
                }
#pragma unroll
                for (int a = 0; a < 2; ++a)
#pragma unroll
                    for (int c = 0; c < 4; ++c)
#pragma unroll
                        for (int r = 0; r < 16; ++r) acc[a][c][r] = 0.f;
            }
        }
    }
    __syncthreads();
#undef MOE_AOFF
#undef MOE_DEC
#undef MOE_LOADB
#undef MOE_WRITEB
#undef MOE_COMPUTE
#undef MOE_NEXTA
}

constexpr int N_PHASES = 21;

#define P_x_in CTX_IN(0)
#define P_xb ((u16*)(ws + WS_XB))
#define P_x1 ((float*)(ws + WS_X1))
#define P_x2 ((float*)(ws + WS_X2))
#define P_ypre ((float*)(ws + WS_YPRE))
#define P_qkv ((u16*)(ws + WS_QKV))
#define P_vT ((u16*)(ws + WS_VT))
#define P_kmean ((float*)(ws + WS_KM))
#define P_ao ((u16*)(ws + WS_AO))
#define P_og ((u16*)(ws + WS_OG))
#define P_lse ((float*)(ws + WS_LSE))
#define P_topw ((float*)(ws + WS_TOPW))
#define P_list ((int*)(ws + WS_LIST))
#define P_hb ((u16*)(ws + WS_HB))
#define P_yb ((u16*)(ws + WS_YB))
#define P_cnt_all ((int*)(ws + WS_CTL + CTL_CNT_OFF))
#define P_xb8 ((unsigned char*)(ws + WS_XB8))
#define P_hbs ((u16*)(ws + WS_HBS))
#define P_selm ((unsigned*)(ws + WS_SELM))
#define P_part ((u16*)(ws + WS_PART))
#define P_plse ((float*)(ws + WS_PLSE))
#define PH_BEGIN int tid = wave_s_ * 64 + lane_id_(); asm volatile("" : "+v"(tid)); const int lane = tid & 63, r32 = lane & 31, hi = lane >> 5; const int wave = __builtin_amdgcn_readfirstlane(tid >> 6); (void)lane; (void)r32; (void)hi; (void)wave
constexpr int LDS_CTX = LDS_BAR + 16;
__device__ __forceinline__ uint64_t ctx_ld(int i) {
    extern __shared__ __attribute__((aligned(16))) unsigned char lds_raw[];
    const LAS unsigned* q = (const LAS unsigned*)((LAS char*)lds_raw + LDS_CTX) + 2 * i;
    const unsigned lo = __builtin_amdgcn_readfirstlane(q[0]), hi = __builtin_amdgcn_readfirstlane(q[1]);
    return ((uint64_t)hi << 32) | lo;
}
typedef __attribute__((address_space(1))) unsigned char gbyte;
#define AS_GLOBAL(T, u64v) ((T*)(gbyte*)(u64v))
#define CTX_IN(i) AS_GLOBAL(const float, ctx_ld(i))
#define PH_FN_BEGIN \
    extern __shared__ __attribute__((aligned(16))) unsigned char lds_raw[]; \
    LAS char* lds = (LAS char*)lds_raw; (void)lds; \
    const int G = gridDim.x, bid = blockIdx.x; (void)G; (void)bid; \
    unsigned char* const ws = AS_GLOBAL(unsigned char, ctx_ld(17)); (void)ws; \
    const int NQ = L == 0 ? 3072 : 9216; (void)NQ; \
    int* cnt = P_cnt_all + L * NE; (void)cnt;
__device__ __forceinline__ void ph_p0(int L, int rep_, const int wave_s_) {
    PH_FN_BEGIN
    (void)rep_;
    PH_BEGIN;
    for (size_t i = (size_t)bid * NTHR + tid; i < (size_t)T * D / 4; i += (size_t)G * NTHR) {
        const f32x4 v = *(const f32x4*)(P_x_in + i * 4);
        u32x2 w; w[0] = cvtpk(v[0], v[1]); w[1] = cvtpk(v[2], v[3]);
        *(u32x2*)(P_xb + i * 4) = w;
    }
    LAS float* tl = (LAS float*)lds;
    for (int it = bid; it < 3968 + 128; it += G) {
        int seg, kt;
        if (it < 3840) { seg = it >> 4; kt = it & 15; } else if (it < 3968) { seg = 240 + ((it - 3840) >> 2); kt = (it - 3840) & 3; } else { seg = 272 + ((it - 3968) >> 4); kt = (it - 3968) & 15; }
        const float* src; int ld; u16* dst; int Kd = 1024; u16* dst_lo = nullptr;
        if (seg < 48) { const int col = 64 * seg; src = CTX_IN(1) + col; ld = 3072; dst = (u16*)(ws + WS_WQK0) + (size_t)col * 1024; }
        else if (seg < 192) { const int col = 64 * (seg - 48); src = CTX_IN(2) + col; ld = 9216; dst = (u16*)(ws + WS_WQK1) + (size_t)col * 1024; }
        else if (seg < 224) { const int s2 = seg - 192, l2 = s2 >> 4, col = 64 * (s2 & 15); src = CTX_IN(3) + (size_t)l2 * D * D + col; ld = 1024; dst = (u16*)(ws + WS_WO) + (size_t)l2 * D * D + (size_t)col * 1024; }
        else if (seg < 240) { const int s2 = seg - 224, l2 = s2 >> 3, i8 = s2 & 7, un = i8 >> 2, q = i8 & 3;
            src = (q < 2 ? CTX_IN(11) : CTX_IN(12)) + (size_t)l2 * D * DF + un * 128 + 64 * (q & 1); ld = 256; dst = (u16*)(ws + WS_WSGU) + (size_t)l2 * 512 * 1024 + (size_t)(64 * i8) * 1024; }
        else if (seg < 272) { const int s2 = seg - 240, l2 = s2 >> 4, col = 64 * (s2 & 15); src = CTX_IN(13) + (size_t)l2 * DF * D + col; ld = 1024; Kd = 256; dst = (u16*)(ws + WS_WSD) + (size_t)l2 * D * DF + (size_t)col * 256; }
        else { const int s2 = seg - 272, l2 = s2 >> 2, col = 64 * (s2 & 3); src = CTX_IN(6) + (size_t)l2 * D * NE + col; ld = 256; dst = (u16*)(ws + WS_WRH) + (size_t)l2 * NE * D + (size_t)col * 1024; dst_lo = (u16*)(ws + WS_WRL) + (size_t)l2 * NE * D + (size_t)col * 1024; }
        {
            const int kr = tid >> 4, c4 = tid & 15;
#pragma unroll
            for (int i = 0; i < 2; ++i) {
                const f32x4 v = *(const f32x4*)(src + (size_t)(kt * 64 + kr + 32 * i) * ld + 4 * c4);
#pragma unroll
                for (int jj = 0; jj < 4; ++jj) tl[(kr + 32 * i) * 65 + 4 * c4 + jj] = v[jj];
            }
        }
        __syncthreads();
        {
            const int row = tid >> 3, kc = tid & 7;
            float f[8];
#pragma unroll
            for (int jj = 0; jj < 8; ++jj) f[jj] = tl[(8 * kc + jj) * 65 + row];
            u32x4 w; w[0] = cvtpk(f[0], f[1]); w[1] = cvtpk(f[2], f[3]); w[2] = cvtpk(f[4], f[5]); w[3] = cvtpk(f[6], f[7]);
            *(u32x4*)(dst + (size_t)row * Kd + kt * 64 + 8 * kc) = w;
            if (dst_lo) {
                u32x4 wl;
#pragma unroll
                for (int jj = 0; jj < 4; ++jj) wl[jj] = cvtpk(f[2 * jj] - bf2f(w[jj] & 0xFFFFu), f[2 * jj + 1] - bf2f(w[jj] >> 16));
                *(u32x4*)(dst_lo + (size_t)row * Kd + kt * 64 + 8 * kc) = wl;
            }
        }
        __syncthreads();
    }
}

__device__ __forceinline__ void ph_qkv(int L, int rep_, const int wave_s_) {
    PH_FN_BEGIN
    (void)rep_;
    const pg8::Gemm g{P_xb, (const u16*)(ws + (L == 0 ? WS_WQK0 : WS_WQK1)), T, NQ, D};
    pg8::StaticOrder S; S.init(g.M, g.N, G, bid);
    const EpiQK E{P_qkv, NQ};
    pg8::gemm_phase<EpiQK, pg8::StaticOrder, false>((PG8_LAS unsigned char*)lds, g, S, E, nullptr, wave_s_ * 64 + lane_id_());
}

__device__ __forceinline__ void ph_kmean(int L, int rep_, const int wave_s_) {
    PH_FN_BEGIN
    (void)rep_;
    PH_BEGIN;
    LAS float* red = (LAS float*)lds;
    for (int it = bid; it < BATCH * NH * MOBA_NB; it += G) {
        const int j = it & 31, h = (it >> 5) & 15, b = it >> 9;
        const int kg_ = tid >> 3, ch = tid & 7;
        const u16* kp = P_qkv + (size_t)(b * SEQ + j * MOBA_BLK + kg_) * 3072 + 1024 + h * 64 + ch * 8;
        float sm[8];
#pragma unroll
        for (int e2 = 0; e2 < 8; ++e2) sm[e2] = 0.f;
#pragma unroll
        for (int i = 0; i < 4; ++i) {
            const u32x4 v = *(const u32x4*)(kp + (size_t)(64 * i) * 3072);
#pragma unroll
            for (int e2 = 0; e2 < 4; ++e2) { sm[2 * e2] += bf2f(v[e2] & 0xFFFFu); sm[2 * e2 + 1] += bf2f(v[e2] >> 16); }
        }
#pragma unroll
        for (int e2 = 0; e2 < 8; ++e2) red[kg_ * 65 + ch * 8 + e2] = sm[e2];
        __syncthreads();
        if (tid < 64) {
            float tot = 0.f;
#pragma unroll 8
            for (int q = 0; q < 64; ++q) tot += red[q * 65 + tid];
            P_kmean[(size_t)it * 64 + tid] = tot * (1.f / MOBA_BLK);
        }
        __syncthreads();
    }
}

__device__ __forceinline__ void ph_gate(int L, int rep_, const int wave_s_) {
    PH_FN_BEGIN
    (void)rep_;
    PH_BEGIN;
    for (int it = bid; it < BATCH * NH * MOBA_NB; it += G) {
        const int qb = it & 31, bh = it >> 5, b = bh >> 4, h = bh & 15;
        const int tq = qb * MOBA_BLK + wave * 32 + r32;
        const u16* qrow = P_qkv + (size_t)(b * SEQ + tq) * 3072 + h * 64 + hi * 8;
        bf16x8 qf[4];
#pragma unroll
        for (int d0 = 0; d0 < 4; ++d0) qf[d0] = *(const bf16x8*)(qrow + d0 * 16);
        unsigned selmask = 0u;
        if (qb > 0) {
            const float* km = P_kmean + ((size_t)(b * NH + h) * MOBA_NB + r32) * 64 + hi * 8;
            f32x16 gt;
#pragma unroll
            for (int r = 0; r < 16; ++r) gt[r] = 0.f;
#pragma unroll
            for (int d0 = 0; d0 < 4; ++d0) {
                const f32x4 k0 = *(const f32x4*)(km + d0 * 16), k1 = *(const f32x4*)(km + d0 * 16 + 4);
                union { bf16x8 v; unsigned u[4]; } kf;
                kf.u[0] = cvtpk(k0[0], k0[1]); kf.u[1] = cvtpk(k0[2], k0[3]); kf.u[2] = cvtpk(k1[0], k1[1]); kf.u[3] = cvtpk(k1[2], k1[3]);
                gt = MFMA_BF16(kf.v, qf[d0], gt);
            }
            float v0 = -INFINITY, v1 = -INFINITY, v2 = -INFINITY; int i0 = 99, i1 = 99, i2 = 99;
#pragma unroll
            for (int r = 0; r < 16; ++r) { const int jb = crow(r, hi); const float gv = jb < qb ? gt[r] : -INFINITY; top3_insert(gv, jb < qb ? jb : 99, v0, i0, v1, i1, v2, i2); }
            const float ov0 = shxf(v0, 32, lane), ov1 = shxf(v1, 32, lane), ov2 = shxf(v2, 32, lane);
            const int oi0 = shxi(i0, 32, lane), oi1 = shxi(i1, 32, lane), oi2 = shxi(i2, 32, lane);
            top3_insert(ov0, oi0, v0, i0, v1, i1, v2, i2); top3_insert(ov1, oi1, v0, i0, v1, i1, v2, i2); top3_insert(ov2, oi2, v0, i0, v1, i1, v2, i2);
            if (i0 < 32) selmask |= 1u << i0;
            if (i1 < 32) selmask |= 1u << i1;
            if (i2 < 32) selmask |= 1u << i2;
        }
        if (hi == 0) P_selm[(size_t)bh * SEQ + tq] = selmask;
    }
}

constexpr int MB_KP = 72;
constexpr int MB_VP = 260;
constexpr int MB_LDS_K = 0;
constexpr int MB_LDS_V = 256 * MB_KP * 2;
constexpr int MB_LDS_LIST = MB_LDS_V + 64 * MB_VP * 2;
constexpr int MB_LDS_CTR = MB_LDS_LIST + 8192 * 2;
__device__ __forceinline__ void ph_moba(int L, int rep_, const int wave_s_) {
    PH_FN_BEGIN
    (void)rep_;
    PH_BEGIN;
    LAS char* Ks = lds + MB_LDS_K; LAS char* Vs = lds + MB_LDS_V;
    LAS u16* qlist = (LAS u16*)(lds + MB_LDS_LIST); LAS int* ctr = (LAS int*)(lds + MB_LDS_CTR);
    for (int it = bid; it < BATCH * NH * MOBA_NB; it += G) {
        const int rnd = it >> 8, w8 = it & 255, a8 = w8 >> 5, bh = w8 & 31;
        const int j = rnd == 0 ? a8 : (rnd == 1 ? 15 - a8 : (rnd == 2 ? 16 + a8 : 31 - a8));
        const int b = bh >> 4, h = bh & 15;
        const float slope2 = exp2f(-0.5f * (float)(h + 1)) * LOG2E;
        if (tid == 0) { int z0 = 0; asm volatile("" : "+v"(z0)); ctr[0] = z0; ctr[1] = z0; }
        {
            const u16* kg = P_qkv + (size_t)(b * SEQ + j * MOBA_BLK) * 3072 + 1024 + h * 64;
#pragma unroll
            for (int i = 0; i < 4; ++i) { const int c = tid + i * 512, row = c >> 3, ch = c & 7; *(LAS u32x4*)(Ks + (row * MB_KP + ch * 8) * 2) = *(const u32x4*)(kg + (size_t)row * 3072 + ch * 8); }
            const u16* vg = P_qkv + (size_t)(b * SEQ + j * MOBA_BLK) * 3072 + 2048 + h * 64;
#pragma unroll
            for (int i = 0; i < 4; ++i) {
                const int c = tid + i * 512, key = c >> 3, ch = c & 7;
                const u32x4 v = *(const u32x4*)(vg + (size_t)key * 3072 + ch * 8);
#pragma unroll
                for (int e2 = 0; e2 < 4; ++e2) {
                    *(LAS u16*)(Vs + ((ch * 8 + 2 * e2) * MB_VP + key) * 2) = (u16)(v[e2] & 0xFFFFu);
                    *(LAS u16*)(Vs + ((ch * 8 + 2 * e2 + 1) * MB_VP + key) * 2) = (u16)(v[e2] >> 16);
                }
            }
        }
        __syncthreads();
        {
            const unsigned* sm = P_selm + (size_t)bh * SEQ;
            for (int t0 = (j + 1) * MOBA_BLK; t0 < SEQ; t0 += 512) {
                const int t = t0 + tid;
                const bool sel = (t < SEQ) && ((sm[t < SEQ ? t : 0] >> j) & 1u);
                const unsigned long long bal = __ballot(sel);
                const int total = __popcll(bal);
                int wb = 0;
                if (lane == 0 && total) wb = atomicAdd((int*)&ctr[0], total);
                wb = __builtin_amdgcn_readfirstlane(wb);
                if (sel) qlist[wb + __popcll(bal & ((1ull << lane) - 1ull))] = (u16)t;
            }
        }
        __syncthreads();
        const int nq = ctr[0];
        const int ntiles = 8 + ((nq + 31) >> 5);
        for (;;) {
            int ti = 0;
            if (lane == 0) ti = atomicAdd((int*)&ctr[1], 1);
            ti = __builtin_amdgcn_readfirstlane(ti);
            if (ti >= ntiles) break;
            const bool own = ti < 8;
            const int wq = 7 - ti;
            const int li = (ti - 8) * 32 + r32;
            const bool valid = own || li < nq;
            const int tq = own ? j * MOBA_BLK + wq * 32 + r32 : (int)qlist[li < nq ? li : nq - 1];
            const int nsteps = own ? wq + 1 : 8;
            const u16* qrow = P_qkv + (size_t)(b * SEQ + tq) * 3072 + h * 64 + hi * 8;
            bf16x8 qf[4];
#pragma unroll
            for (int d0 = 0; d0 < 4; ++d0) qf[d0] = *(const bf16x8*)(qrow + d0 * 16);
            int slot = 3;
            if (!own) slot = __popc(P_selm[(size_t)bh * SEQ + tq] & ((1u << j) - 1u));
            AttnSt st; st.m = NEGV; st.l = 0.f;
#pragma unroll
            for (int r = 0; r < 16; ++r) { st.o0[r] = 0.f; st.o1[r] = 0.f; }
            const int dlo = own ? 0 : -0x40000000;
            for (int kt = 0; kt < nsteps; ++kt) {
                AttnFr f;
#pragma unroll
                for (int d0 = 0; d0 < 4; ++d0) f.k[d0] = *(LAS bf16x8*)(Ks + ((kt * 32 + r32) * MB_KP + d0 * 16 + hi * 8) * 2);
#pragma unroll
                for (int q4 = 0; q4 < 4; ++q4) {
                    union { bf16x8 v; u32x2 hh[2]; } va;
                    LAS char* vp = Vs + (((q4 >> 1) * 32 + r32) * MB_VP + kt * 32 + (q4 & 1) * 16 + 4 * hi) * 2;
                    va.hh[0] = *(LAS u32x2*)(vp); va.hh[1] = *(LAS u32x2*)(vp + 16);
                    f.v[q4] = va.v;
                }
                attn_compute(st, qf, f, tq - (j * MOBA_BLK + kt * 32) - 4 * hi, slope2, dlo, 0x7fffffff, hi, lane);
            }
            const float lt = st.l + shxf(st.l, 32, lane);
            const float inv = 1.f / lt;
            if (valid) {
                const size_t pi = ((size_t)(b * SEQ + tq) * NH + h) * 4 + slot;
                u16* orow = P_part + pi * 64;
#pragma unroll
                for (int rq = 0; rq < 4; ++rq) {
                    u32x2 w; w[0] = cvtpk(st.o0[4 * rq] * inv, st.o0[4 * rq + 1] * inv); w[1] = cvtpk(st.o0[4 * rq + 2] * inv, st.o0[4 * rq + 3] * inv);
                    *(u32x2*)(orow + 8 * rq + 4 * hi) = w;
                    w[0] = cvtpk(st.o1[4 * rq] * inv, st.o1[4 * rq + 1] * inv); w[1] = cvtpk(st.o1[4 * rq + 2] * inv, st.o1[4 * rq + 3] * inv);
                    *(u32x2*)(orow + 32 + 8 * rq + 4 * hi) = w;
                }
                if (hi == 0) P_plse[pi] = st.m * LN2 + logf(lt);
            }
        }
        __syncthreads();
    }
}

__device__ __forceinline__ void ph_mobamerge(int L, int rep_, const int wave_s_) {
    PH_FN_BEGIN
    (void)rep_;
    PH_BEGIN;
    for (size_t i = (size_t)bid * NTHR + tid; i < (size_t)T * NH * 8; i += (size_t)G * NTHR) {
        const size_t row = i >> 7; const int h = (int)(i >> 3) & 15, d8 = (int)i & 7;
        const int qb = (int)(row & (SEQ - 1)) >> 8;
        const int nsel = qb < 3 ? qb : 3;
        const size_t pi = (row * NH + h) * 4;
        float l[4], w[4];
        float mx = -INFINITY;
#pragma unroll
        for (int sidx = 0; sidx < 4; ++sidx) { const bool ok = sidx == 3 || sidx < nsel; l[sidx] = ok ? P_plse[pi + sidx] : -INFINITY; mx = fmaxf(mx, l[sidx]); }
        float ws_ = 0.f;
#pragma unroll
        for (int sidx = 0; sidx < 4; ++sidx) { w[sidx] = (sidx == 3 || sidx < nsel) ? expf(l[sidx] - mx) : 0.f; ws_ += w[sidx]; }
        const float inv = 1.f / ws_;
        float acc8[8];
#pragma unroll
        for (int c = 0; c < 8; ++c) acc8[c] = 0.f;
#pragma unroll
        for (int sidx = 0; sidx < 4; ++sidx) {
            if (sidx == 3 || sidx < nsel) {
                const u32x4 a = *(const u32x4*)(P_part + (pi + sidx) * 64 + d8 * 8);
                const float ww = w[sidx] * inv;
#pragma unroll
                for (int c = 0; c < 4; ++c) { acc8[2 * c] += ww * bf2f(a[c] & 0xFFFFu); acc8[2 * c + 1] += ww * bf2f(a[c] >> 16); }
            }
        }
        u32x4 o;
#pragma unroll
        for (int c = 0; c < 4; ++c) o[c] = cvtpk(acc8[2 * c], acc8[2 * c + 1]);
        *(u32x4*)(P_ao + row * D + h * 64 + d8 * 8) = o;
    }
}

constexpr int DL_KP = 72, DL_VP = 388;
constexpr int DL_LDS_K = 0, DL_LDS_V = 384 * DL_KP * 2;
__device__ __forceinline__ void ph_dil(int L, int rep_, const int wave_s_) {
    PH_FN_BEGIN
    (void)rep_;
    PH_BEGIN;
    LAS char* Ks = lds + DL_LDS_K; LAS char* Vs = lds + DL_LDS_V;
    for (int it = bid; it < BATCH * NH * 3 * 32; it += G) {
        const int ch = it & 31, grp = (it >> 5) % 3, bh = it / 96, b = bh >> 4, h = bh & 15;
        const int dil = grp == 0 ? 1 : (grp == 1 ? 4 : 16), Ls = SEQ / dil;
        const float slope2 = exp2f(-0.5f * (float)(h + 1)) * LOG2E * (float)dil;
        const int uc = ch * 256, res = uc / Ls, c0 = uc - res * Ls;
        const int kb0 = c0 - 128;
        {
            const u16* kg = P_qkv + (size_t)(b * SEQ) * 9216 + grp * 3072 + 1024 + h * 64;
#pragma unroll
            for (int i = 0; i < 6; ++i) {
                const int c = tid + i * 512, row = c >> 3, chk = c & 7, ks = kb0 + row;
                if (ks >= 0) *(LAS u32x4*)(Ks + (row * DL_KP + chk * 8) * 2) = *(const u32x4*)(kg + (size_t)(ks * dil + res) * 9216 + chk * 8);
            }
            const u16* vg = P_qkv + (size_t)(b * SEQ) * 9216 + grp * 3072 + 2048 + h * 64;
#pragma unroll
            for (int i = 0; i < 6; ++i) {
                const int c = tid + i * 512, row = c >> 3, chk = c & 7, ks = kb0 + row;
                if (ks >= 0) {
                    const u32x4 v = *(const u32x4*)(vg + (size_t)(ks * dil + res) * 9216 + chk * 8);
#pragma unroll
                    for (int e2 = 0; e2 < 4; ++e2) {
                        *(LAS u16*)(Vs + ((chk * 8 + 2 * e2) * DL_VP + row) * 2) = (u16)(v[e2] & 0xFFFFu);
                        *(LAS u16*)(Vs + ((chk * 8 + 2 * e2 + 1) * DL_VP + row) * 2) = (u16)(v[e2] >> 16);
                    }
                }
            }
        }
        const int i0 = c0 + wave * 32, iq = i0 + r32, pq = iq * dil + res;
        const u16* qrow = P_qkv + (size_t)(b * SEQ + pq) * 9216 + grp * 3072 + h * 64 + hi * 8;
        bf16x8 qf[4];
#pragma unroll
        for (int d0 = 0; d0 < 4; ++d0) qf[d0] = *(const bf16x8*)(qrow + d0 * 16);
        __syncthreads();
        AttnSt st; st.m = NEGV; st.l = 0.f;
#pragma unroll
        for (int r = 0; r < 16; ++r) { st.o0[r] = 0.f; st.o1[r] = 0.f; }
        const int ktmin = (i0 >= 128) ? 0 : (128 - i0) >> 5;
        for (int kt = 4; kt >= ktmin; --kt) {
            const int lrow0 = (wave + kt) * 32;
            AttnFr f;
#pragma unroll
            for (int d0 = 0; d0 < 4; ++d0) f.k[d0] = *(LAS bf16x8*)(Ks + ((lrow0 + r32) * DL_KP + d0 * 16 + hi * 8) * 2);
#pragma unroll
            for (int q4 = 0; q4 < 4; ++q4) {
                union { bf16x8 v; u32x2 hh[2]; } va;
                LAS char* vp = Vs + (((q4 >> 1) * 32 + r32) * DL_VP + lrow0 + (q4 & 1) * 16 + 4 * hi) * 2;
                va.hh[0] = *(LAS u32x2*)(vp); va.hh[1] = *(LAS u32x2*)(vp + 16);
                f.v[q4] = va.v;
            }
            const int k0 = i0 - 128 + kt * 32;
            attn_compute(st, qf, f, iq - k0 - 4 * hi, slope2, 0, 128, hi, lane);
        }
        const float lt = st.l + shxf(st.l, 32, lane);
        const float inv = 1.f / lt;
        u16* orow = P_og + (size_t)grp * T * D + (size_t)(b * SEQ + pq) * D + h * 64;
#pragma unroll
        for (int rq = 0; rq < 4; ++rq) {
            u32x2 w; w[0] = cvtpk(st.o0[4 * rq] * inv, st.o0[4 * rq + 1] * inv); w[1] = cvtpk(st.o0[4 * rq + 2] * inv, st.o0[4 * rq + 3] * inv);
            *(u32x2*)(orow + 8 * rq + 4 * hi) = w;
            w[0] = cvtpk(st.o1[4 * rq] * inv, st.o1[4 * rq + 1] * inv); w[1] = cvtpk(st.o1[4 * rq + 2] * inv, st.o1[4 * rq + 3] * inv);
            *(u32x2*)(orow + 32 + 8 * rq + 4 * hi) = w;
        }
        if (hi == 0) P_lse[((size_t)grp * T + (b * SEQ + pq)) * NH + h] = st.m * LN2 + logf(lt);
        __syncthreads();
    }
}

__device__ __forceinline__ void ph_merge(int L, int rep_, const int wave_s_) {
    PH_FN_BEGIN
    (void)rep_;

            PH_BEGIN;
                for (size_t i = (size_t)bid * NTHR + tid; i < (size_t)T * NH * 8; i += (size_t)G * NTHR) {
                    const size_t row = i >> 7; const int h = (int)(i >> 3) & 15, d8 = (int)i & 7;
                    const float l0 = P_lse[(0 * (size_t)T + row) * NH + h], l1 = P_lse[(1 * (size_t)T + row) * NH + h], l2 = P_lse[(2 * (size_t)T + row) * NH + h];
                    const float mx = fmaxf(l0, fmaxf(l1, l2));
                    float w0 = expf(l0 - mx), w1 = expf(l1 - mx), w2 = expf(l2 - mx);
                    const float inv = 1.f / (w0 + w1 + w2); w0 *= inv; w1 *= inv; w2 *= inv;
                    const size_t off = row * D + h * 64 + d8 * 8;
                    const u32x4 a0 = *(const u32x4*)(P_og + off), a1 = *(const u32x4*)(P_og + (size_t)T * D + off), a2 = *(const u32x4*)(P_og + 2 * (size_t)T * D + off);
                    u32x4 o;
#pragma unroll
                    for (int c = 0; c < 4; ++c) {
                        const float lo_ = w0 * bf2f(a0[c] & 0xFFFFu) + w1 * bf2f(a1[c] & 0xFFFFu) + w2 * bf2f(a2[c] & 0xFFFFu);
                        const float hi_ = w0 * bf2f(a0[c] >> 16) + w1 * bf2f(a1[c] >> 16) + w2 * bf2f(a2[c] >> 16);
                        o[c] = cvtpk(lo_, hi_);
                    }
                    *(u32x4*)(P_ao + off) = o;
                }

}

__device__ __forceinline__ void ph_wo(int L, int rep_, const int wave_s_) {
    PH_FN_BEGIN
    (void)rep_;
    const pg8::Gemm g{P_ao, (const u16*)(ws + WS_WO) + (size_t)L * D * D, T, D, D};
    pg8::StaticOrder S; S.init(g.M, g.N, G, bid);
    const EpiWo E{P_ypre, L == 0 ? CTX_IN(0) : (const float*)P_x2};
    pg8::gemm_phase<EpiWo, pg8::StaticOrder, false>((PG8_LAS unsigned char*)lds, g, S, E, nullptr, wave_s_ * 64 + lane_id_());
}

constexpr int RT_P = 144;
constexpr int RT_LDS_AH = 0, RT_LDS_AL = 64 * RT_P;
constexpr int RT_LDS_BH = 2 * 64 * RT_P, RT_LDS_BL = RT_LDS_BH + 256 * RT_P;
constexpr int RT_LDS_ST = RT_LDS_BL + 256 * RT_P;
__device__ __forceinline__ void ph_router(int L, int rep_, const int wave_s_) {
    PH_FN_BEGIN
    (void)rep_;
    PH_BEGIN;
    const float* lng = CTX_IN(4) + L * D; const float* lnb = CTX_IN(5) + L * D;
    const float* rbias = CTX_IN(7) + L * NE;
    const u16* wrh = (const u16*)(ws + WS_WRH) + (size_t)L * NE * D; const u16* wrl = (const u16*)(ws + WS_WRL) + (size_t)L * NE * D;
    LAS float* stat = (LAS float*)(lds + RT_LDS_ST);
    for (int it = bid; it < T / 64; it += G) {
#pragma unroll 1
        for (int hb_ = 0; hb_ < 2; ++hb_) {
            f32x4 yv[4][4];
#pragma unroll
            for (int rr = 0; rr < 4; ++rr)
#pragma unroll
                for (int j = 0; j < 4; ++j) yv[rr][j] = *(const f32x4*)(P_ypre + ((size_t)it * 64 + wave * 8 + hb_ * 4 + rr) * D + j * 256 + lane * 4);
#pragma unroll
            for (int rr = 0; rr < 4; ++rr) {
                float sm = 0.f;
#pragma unroll
                for (int j = 0; j < 4; ++j) sm += (yv[rr][j][0] + yv[rr][j][1]) + (yv[rr][j][2] + yv[rr][j][3]);
                const float mu = wave_sum(sm) * (1.f / D);
                float q = 0.f;
#pragma unroll
                for (int j = 0; j < 4; ++j)
#pragma unroll
                    for (int c = 0; c < 4; ++c) { const float d_ = yv[rr][j][c] - mu; q += d_ * d_; }
                const float rstd = rsqrtf(wave_sum(q) * (1.f / D) + LN_EPS);
                if (lane == 0) { stat[wave * 8 + hb_ * 4 + rr] = mu; stat[64 + wave * 8 + hb_ * 4 + rr] = rstd; }
            }
        }
        __syncthreads();
        const int arow = tid >> 3, aq = tid & 7;
        const float amu = stat[arow], ars = stat[64 + arow];
        const float* yp = P_ypre + ((size_t)it * 64 + arow) * D + aq * 8;
        f32x4 ya0 = *(const f32x4*)(yp), ya1 = *(const f32x4*)(yp + 4);
        u32x4 bw[8];
#pragma unroll
        for (int i = 0; i < 8; ++i) { const int p_ = tid + 512 * (i & 3); bw[i] = *(const u32x4*)((i < 4 ? wrh : wrl) + (size_t)(p_ >> 3) * D + (p_ & 7) * 8); }
        f32x16 lg[2];
#pragma unroll
        for (int r = 0; r < 16; ++r) { lg[0][r] = 0.f; lg[1][r] = 0.f; }
#pragma unroll 1
        for (int kc = 0; kc < 16; ++kc) {
            const int k0 = kc * 64;
            {
                const f32x4 g0 = *(const f32x4*)(lng + k0 + aq * 8), g1 = *(const f32x4*)(lng + k0 + aq * 8 + 4);
                const f32x4 b0 = *(const f32x4*)(lnb + k0 + aq * 8), b1 = *(const f32x4*)(lnb + k0 + aq * 8 + 4);
                f32x4 x0, x1v;
#pragma unroll
                for (int c = 0; c < 4; ++c) { x0[c] = (ya0[c] - amu) * ars * g0[c] + b0[c]; x1v[c] = (ya1[c] - amu) * ars * g1[c] + b1[c]; }
                const size_t go = ((size_t)it * 64 + arow) * D + k0 + aq * 8;
                *(f32x4*)(P_x1 + go) = x0; *(f32x4*)(P_x1 + go + 4) = x1v;
                u32x4 wh; wh[0] = cvtpk(x0[0], x0[1]); wh[1] = cvtpk(x0[2], x0[3]); wh[2] = cvtpk(x1v[0], x1v[1]); wh[3] = cvtpk(x1v[2], x1v[3]);
                *(u32x4*)(P_xb + go) = wh;
                u32x2 w8; w8[0] = pack_fp8x4(x0[0], x0[1], x0[2], x0[3]); w8[1] = pack_fp8x4(x1v[0], x1v[1], x1v[2], x1v[3]);
                *(u32x2*)(P_xb8 + go) = w8;
                u32x4 wl;
                wl[0] = cvtpk(x0[0] - bf2f(wh[0] & 0xFFFFu), x0[1] - bf2f(wh[0] >> 16)); wl[1] = cvtpk(x0[2] - bf2f(wh[1] & 0xFFFFu), x0[3] - bf2f(wh[1] >> 16));
                wl[2] = cvtpk(x1v[0] - bf2f(wh[2] & 0xFFFFu), x1v[1] - bf2f(wh[2] >> 16)); wl[3] = cvtpk(x1v[2] - bf2f(wh[3] & 0xFFFFu), x1v[3] - bf2f(wh[3] >> 16));
                *(LAS u32x4*)(lds + RT_LDS_AH + arow * RT_P + aq * 16) = wh;
                *(LAS u32x4*)(lds + RT_LDS_AL + arow * RT_P + aq * 16) = wl;
#pragma unroll
                for (int i = 0; i < 8; ++i) { const int p_ = tid + 512 * (i & 3); *(LAS u32x4*)(lds + (i < 4 ? RT_LDS_BH : RT_LDS_BL) + (p_ >> 3) * RT_P + (p_ & 7) * 16) = bw[i]; }
            }
            __syncthreads();
            {
                const int kn = (kc + 1 < 16) ? k0 + 64 : 0;
                ya0 = *(const f32x4*)(yp + kn); ya1 = *(const f32x4*)(yp + kn + 4);
#pragma unroll
                for (int i = 0; i < 8; ++i) { const int p_ = tid + 512 * (i & 3); bw[i] = *(const u32x4*)((i < 4 ? wrh : wrl) + (size_t)(p_ >> 3) * D + kn + (p_ & 7) * 8); }
            }
#pragma unroll
            for (int sk = 0; sk < 4; ++sk) {
                const int ko = (sk * 16 + hi * 8) * 2;
                const bf16x8 bh_ = *(const LAS bf16x8*)(lds + RT_LDS_BH + (wave * 32 + r32) * RT_P + ko), bl_ = *(const LAS bf16x8*)(lds + RT_LDS_BL + (wave * 32 + r32) * RT_P + ko);
#pragma unroll
                for (int rb = 0; rb < 2; ++rb) {
                    const bf16x8 xh = *(const LAS bf16x8*)(lds + RT_LDS_AH + (rb * 32 + r32) * RT_P + ko), xl = *(const LAS bf16x8*)(lds + RT_LDS_AL + (rb * 32 + r32) * RT_P + ko);
                    lg[rb] = MFMA_BF16(xh, bh_, lg[rb]); lg[rb] = MFMA_BF16(xl, bh_, lg[rb]); lg[rb] = MFMA_BF16(xh, bl_, lg[rb]);
                }
            }
            __syncthreads();
        }
        LAS float* lgs = (LAS float*)lds;
#pragma unroll
        for (int rb = 0; rb < 2; ++rb)
#pragma unroll
            for (int r = 0; r < 16; ++r) lgs[(rb * 32 + crow(r, hi)) * 257 + wave * 32 + r32] = lg[rb][r];
        __syncthreads();
#pragma unroll 1
        for (int tg = 0; tg < 2; ++tg) {
            float sc[4][4], cv[4][4];
#pragma unroll
            for (int tt = 0; tt < 4; ++tt) {
                const int lr = wave * 8 + tg * 4 + tt;
#pragma unroll
                for (int j = 0; j < 4; ++j) { const int e = lane + 64 * j; sc[tt][j] = 1.f / (1.f + __expf(-lgs[lr * 257 + e])); cv[tt][j] = sc[tt][j] + rbias[e]; }
            }
            float gsel[4][8];
#pragma unroll
            for (int j = 0; j < 4; ++j) {
#pragma unroll
                for (int tt = 0; tt < 4; ++tt) {
                    const float rm = dpp_rowmax(cv[tt][j]);
                    const float m1a = fmaxf(rl_f(rm, 0), rl_f(rm, 16)), m1b = fmaxf(rl_f(rm, 32), rl_f(rm, 48));
                    const unsigned long long bal = __ballot(cv[tt][j] == (hi ? m1b : m1a));
                    const int fa_ = __builtin_ctz((unsigned)(bal & 0xFFFFFFFFull)), fb_ = 32 + __builtin_ctz((unsigned)(bal >> 32));
                    const float c2 = (lane == fa_ || lane == fb_) ? -INFINITY : cv[tt][j];
                    const float rm2 = dpp_rowmax(c2);
                    gsel[tt][2 * j] = m1a + fmaxf(rl_f(rm2, 0), rl_f(rm2, 16));
                    gsel[tt][2 * j + 1] = m1b + fmaxf(rl_f(rm2, 32), rl_f(rm2, 48));
                }
            }
#pragma unroll
            for (int tt = 0; tt < 4; ++tt)
#pragma unroll
                for (int j = 0; j < 4; ++j) {
                    int ra_ = 0, rb_ = 0;
#pragma unroll
                    for (int g2 = 0; g2 < 8; ++g2) {
                        ra_ += ((gsel[tt][g2] > gsel[tt][2 * j]) || (gsel[tt][g2] == gsel[tt][2 * j] && g2 < 2 * j)) ? 1 : 0;
                        rb_ += ((gsel[tt][g2] > gsel[tt][2 * j + 1]) || (gsel[tt][g2] == gsel[tt][2 * j + 1] && g2 < 2 * j + 1)) ? 1 : 0;
                    }
                    cv[tt][j] = ((hi ? rb_ : ra_) < 4) ? cv[tt][j] : NEGV;
                }
            float wsel[4], wsum[4]; int esel[4];
#pragma unroll
            for (int tt = 0; tt < 4; ++tt) { wsel[tt] = 0.f; wsum[tt] = 0.f; esel[tt] = 0; }
#pragma unroll 1
            for (int k = 0; k < TOPK; ++k) {
#pragma unroll
                for (int tt = 0; tt < 4; ++tt) {
                    float bv = cv[tt][0]; int be = lane;
#pragma unroll
                    for (int j = 1; j < 4; ++j) if (cv[tt][j] > bv) { bv = cv[tt][j]; be = lane + 64 * j; }
                    const float rm = dpp_rowmax(bv);
                    const float mval = fmaxf(fmaxf(rl_f(rm, 0), rl_f(rm, 16)), fmaxf(rl_f(rm, 32), rl_f(rm, 48)));
                    const int ri = dpp_rowmin_i(bv == mval ? be : 0x7fffffff);
                    const int e = min(min(__builtin_amdgcn_readlane(ri, 0), __builtin_amdgcn_readlane(ri, 16)), min(__builtin_amdgcn_readlane(ri, 32), __builtin_amdgcn_readlane(ri, 48)));
                    const int jl = e >> 6, ll = e & 63;
                    const float smine = ((jl == 0 ? sc[tt][0] : 0.f) + (jl == 1 ? sc[tt][1] : 0.f)) + ((jl == 2 ? sc[tt][2] : 0.f) + (jl == 3 ? sc[tt][3] : 0.f));
                    const float sw = rl_f(smine, ll);
#pragma unroll
                    for (int j = 0; j < 4; ++j) cv[tt][j] = (lane == ll && jl == j) ? -INFINITY : cv[tt][j];
                    wsum[tt] += sw;
                    if (lane == k) { wsel[tt] = sw; esel[tt] = e; }
                }
            }
#pragma unroll
            for (int tt = 0; tt < 4; ++tt) {
                if (lane < TOPK) {
                    const int tok = it * 64 + wave * 8 + tg * 4 + tt;
                    const int a = tok * TOPK + lane;
                    P_topw[a] = wsel[tt] / wsum[tt] * 2.5f;
                    if (rep_ == 0) {
                        const int pos = atomicAdd(&cnt[esel[tt]], 1);
                        P_list[(size_t)esel[tt] * T + pos] = a;
                    }
                }
            }
        }
        __syncthreads();
    }
}

__device__ __forceinline__ void ph_gateup(int L, int rep_, const int wave_s_) {
    PH_FN_BEGIN
    (void)rep_;
    {
        PH_BEGIN;
        const float* weg = CTX_IN(8) + (size_t)L * NE * D * DF; const float* weu = CTX_IN(9) + (size_t)L * NE * D * DF;
        LAS int* rowva = (LAS int*)(lds + MOE_LDS_VA);
        {
            int* octr = (int*)(ws + WS_CTL + CTL_CNT_OFF + 8192) + (L * 4 + 2 * (rep_ & 1)) * 64;
            LAS int* slot = (LAS int*)(lds + 140000);
            for (;;) {
                __syncthreads();
                if (tid == 0) { int q; do { q = atomicAdd(octr, 1); } while (q >= NE && q < NE * 5 && cnt[(q - NE) >> 2] <= 512); *slot = q; }
                __syncthreads();
                const int q = *slot;
                if (q >= NE * 5) break;
                const bool ovf = q >= NE;
                const int e = ovf ? (q - NE) >> 2 : q, pz = ovf ? (q - NE) & 3 : 0, npz = ovf ? 1 : 4, st0 = ovf ? 1 : 0, n = cnt[e];
                for (int r0 = 0; r0 < n; r0 += 1024) {
                    if (ovf && n - r0 <= 512) break;
#pragma unroll
                    for (int i = 0; i < 2; ++i) { int t_ = tid; asm volatile("" : "+v"(t_)); const int idx = r0 + i * 512 + t_; rowva[i * 512 + t_] = idx < n ? P_list[(size_t)e * T + idx] : TRASH_VA; }
                    __syncthreads();
                    moe_expert<false>(lds, tid, lane, wave, r32, hi, P_xb8, weg + (size_t)e * D * DF, weu + (size_t)e * D * DF, (n - r0) < 1024 ? (n - r0) : 1024, (void*)P_hb, pz, npz, st0, 1);
                }
            }
        }
    }
    {
        PH_BEGIN;
        const pg8::Gemm g{P_xb, (const u16*)(ws + WS_WSGU) + (size_t)L * 512 * 1024, T, 512, D};
        const EpiSGU E{P_hbs};
        int* qctr = (int*)(ws + WS_CTL + CTL_CNT_OFF + 4096) + (L * 4 + 2 * (rep_ & 1)) * 64;
        LAS int* slot = (LAS int*)(lds + 140000);
        for (;;) {
            __syncthreads();
            if (tid == 0) *slot = atomicAdd(qctr, 1);
            __syncthreads();
            const int un = *slot;
            if (un >= 128) break;
            const pg8::FixedOrder S{un & 63, un >> 6};
            pg8::gemm_phase<EpiSGU, pg8::FixedOrder, false>((PG8_LAS unsigned char*)lds, g, S, E, nullptr, wave_s_ * 64 + lane_id_());
        }
    }
}

__device__ __forceinline__ void ph_down(int L, int rep_, const int wave_s_) {
    PH_FN_BEGIN
    (void)rep_;
    {
        PH_BEGIN;
        const float* wed = CTX_IN(10) + (size_t)L * NE * DF * D;
        LAS int* rowva = (LAS int*)(lds + MOE_LDS_VA); LAS float* roww = (LAS float*)(lds + MOE_LDS_W);
        {
            int* octr = (int*)(ws + WS_CTL + CTL_CNT_OFF + 8192) + (L * 4 + 1 + 2 * (rep_ & 1)) * 64;
            LAS int* slot = (LAS int*)(lds + 140000);
            for (;;) {
                __syncthreads();
                if (tid == 0) { int q; do { q = atomicAdd(octr, 1); } while (q >= NE && q < NE * 5 && cnt[(q - NE) >> 2] <= 512); *slot = q; }
                __syncthreads();
                const int q = *slot;
                if (q >= NE * 5) break;
                const bool ovf = q >= NE;
                const int e = ovf ? (q - NE) >> 2 : q, pz = ovf ? ((q - NE) & 3) * 2 : 0, npz = ovf ? 2 : 8, st0 = ovf ? 1 : 0, n = cnt[e];
                for (int r0 = 0; r0 < n; r0 += 1024) {
                    if (ovf && n - r0 <= 512) break;
#pragma unroll
                    for (int i = 0; i < 2; ++i) { int t_ = tid; asm volatile("" : "+v"(t_)); const int idx = r0 + i * 512 + t_; const int va = idx < n ? P_list[(size_t)e * T + idx] : TRASH_VA; rowva[i * 512 + t_] = va; roww[i * 512 + t_] = va < A_TOT ? P_topw[va] : 0.f; }
                    __syncthreads();
                    moe_expert<true>(lds, tid, lane, wave, r32, hi, (const unsigned char*)P_hb, wed + (size_t)e * DF * D, nullptr, (n - r0) < 1024 ? (n - r0) : 1024, (void*)P_yb, pz, npz, st0, 1, L == 1);
                }
            }
        }
    }
    {
        PH_BEGIN;
        const pg8::Gemm g{P_hbs, (const u16*)(ws + WS_WSD) + (size_t)L * D * DF, T, D, DF};
        const EpiSD E{P_yb};
        int* qctr = (int*)(ws + WS_CTL + CTL_CNT_OFF + 4096) + (L * 4 + 1 + 2 * (rep_ & 1)) * 64;
        LAS int* slot = (LAS int*)(lds + 140000);
        for (;;) {
            __syncthreads();
            if (tid == 0) *slot = atomicAdd(qctr, 1);
            __syncthreads();
            const int un = *slot;
            if (un >= 256) break;
            const pg8::FixedOrder S{un & 63, un >> 6};
            pg8::gemm_phase<EpiSD, pg8::FixedOrder, false>((PG8_LAS unsigned char*)lds, g, S, E, nullptr, wave_s_ * 64 + lane_id_());
        }
    }
}

__device__ __forceinline__ void ph_combine(int L, int rep_, const int wave_s_) {
    PH_FN_BEGIN
    (void)rep_;
    PH_BEGIN;
    const float* lng = CTX_IN(14) + L * D; const float* lnb = CTX_IN(15) + L * D;
    float* dst = L == 0 ? P_x2 : AS_GLOBAL(float, ctx_ld(16));
    for (int row = bid * 8 + wave; row < T; row += G * 8) {
        u32x4 yv[TOPK + 1][2];
#pragma unroll
        for (int k = 0; k < TOPK + 1; ++k) {
            const size_t va = k < TOPK ? (size_t)row * TOPK + k : (size_t)A_TOT + row;
            if (L == 1 && k < TOPK) {
#pragma unroll
                for (int j = 0; j < 2; ++j) { const u32x2 w8 = *(const u32x2*)((const unsigned char*)P_yb + va * D + j * 512 + lane * 8); yv[k][j][0] = w8[0]; yv[k][j][1] = w8[1]; yv[k][j][2] = 0u; yv[k][j][3] = 0u; }
            } else {
#pragma unroll
                for (int j = 0; j < 2; ++j) yv[k][j] = *(const u32x4*)(P_yb + va * D + j * 512 + lane * 8);
            }
        }
        float v[16];
#pragma unroll
        for (int j = 0; j < 2; ++j) {
            const f32x4 t0 = *(const f32x4*)(P_x1 + (size_t)row * D + j * 512 + lane * 8), t1 = *(const f32x4*)(P_x1 + (size_t)row * D + j * 512 + lane * 8 + 4);
#pragma unroll
            for (int c = 0; c < 4; ++c) { v[j * 8 + c] = DN_ALPHA * t0[c]; v[j * 8 + 4 + c] = DN_ALPHA * t1[c]; }
        }
#pragma unroll
        for (int k = 0; k < TOPK + 1; ++k)
#pragma unroll
            for (int j = 0; j < 2; ++j) {
                if (L == 1 && k < TOPK) {
#pragma unroll
                    for (int c = 0; c < 2; ++c) {
                        const f32x2_ lo2 = __builtin_amdgcn_cvt_pk_f32_fp8((int)yv[k][j][c], false), hi2 = __builtin_amdgcn_cvt_pk_f32_fp8((int)yv[k][j][c], true);
                        v[j * 8 + 4 * c] += lo2[0]; v[j * 8 + 4 * c + 1] += lo2[1]; v[j * 8 + 4 * c + 2] += hi2[0]; v[j * 8 + 4 * c + 3] += hi2[1];
                    }
                } else {
#pragma unroll
                    for (int c = 0; c < 4; ++c) { v[j * 8 + 2 * c] += bf2f(yv[k][j][c] & 0xFFFFu); v[j * 8 + 2 * c + 1] += bf2f(yv[k][j][c] >> 16); }
                }
            }
        float sm = 0.f;
#pragma unroll
        for (int i = 0; i < 16; ++i) sm += v[i];
        const float mu = wave_sum(sm) * (1.f / D);
        float q = 0.f;
#pragma unroll
        for (int i = 0; i < 16; ++i) { const float d = v[i] - mu; q += d * d; }
        const float rstd = rsqrtf(wave_sum(q) * (1.f / D) + LN_EPS);
#pragma unroll
        for (int j = 0; j < 2; ++j) {
            const f32x4 g0 = *(const f32x4*)(lng + j * 512 + lane * 8), g1 = *(const f32x4*)(lng + j * 512 + lane * 8 + 4);
            const f32x4 b0 = *(const f32x4*)(lnb + j * 512 + lane * 8), b1 = *(const f32x4*)(lnb + j * 512 + lane * 8 + 4);
            f32x4 o0, o1;
#pragma unroll
            for (int c = 0; c < 4; ++c) { o0[c] = (v[j * 8 + c] - mu) * rstd * g0[c] + b0[c]; o1[c] = (v[j * 8 + 4 + c] - mu) * rstd * g1[c] + b1[c]; }
            *(f32x4*)(dst + (size_t)row * D + j * 512 + lane * 8) = o0; *(f32x4*)(dst + (size_t)row * D + j * 512 + lane * 8 + 4) = o1;
            if (L == 0) { u32x4 w; w[0] = cvtpk(o0[0], o0[1]); w[1] = cvtpk(o0[2], o0[3]); w[2] = cvtpk(o1[0], o1[1]); w[3] = cvtpk(o1[2], o1[3]); *(u32x4*)(P_xb + (size_t)row * D + j * 512 + lane * 8) = w; }
        }
    }
}

__global__ void __launch_bounds__(NTHR, 2) fwd(Args args) {
    extern __shared__ __attribute__((aligned(16))) unsigned char lds_raw[];
    LAS char* lds = (LAS char*)lds_raw;
    unsigned char* const ws = args.ws;
    const int lo = args.ph_lo, hi_ph = args.ph_hi;
    const int wave_s_ = __builtin_amdgcn_readfirstlane(threadIdx.x >> 6);
    if (threadIdx.x < 18) {
        const uint64_t v = threadIdx.x < 16 ? (uint64_t)args.in[threadIdx.x] : (threadIdx.x == 16 ? (uint64_t)args.out : (uint64_t)args.ws);
        ((LAS uint64_t*)(lds + LDS_CTX))[threadIdx.x] = v;
    }
    __syncthreads();
#define IN(k) (lo <= (k) && (k) < hi_ph)

#if MK_ONE_LAUNCH
    if (threadIdx.x < 4) ((LAS unsigned*)(lds + LDS_BAR))[threadIdx.x] = 0u;
    __syncthreads();
    XcdBarrier bar = xcd_barrier_post((unsigned*)(ws + WS_CTL), (volatile LAS unsigned*)(lds + LDS_BAR), wave_s_ == 0 && lane_id_() == 0);
#define GRID_BAR() xcd_barrier(bar, wave_s_ == 0 && lane_id_() == 0)
#else
#define GRID_BAR() do { } while (0)
#endif
#define SEAM(k) do { if (IN(k) && IN((k) + 1)) GRID_BAR(); } while (0)

    for (int rep_ = 0; rep_ < ((IN(0) && PHK(0)) ? REPS(0) : 0); ++rep_) { ph_p0(0, rep_, wave_s_); }
    SEAM(0);

    for (int L = 0; L < 2; ++L) {
        const int pb = 1 + 10 * L;
        for (int rep_ = 0; rep_ < ((IN(pb + 0) && PHK(1)) ? REPS(1) : 0); ++rep_) { ph_qkv(L, rep_, wave_s_); }
        SEAM(pb + 0);

        if (L == 0) {
            for (int rep_ = 0; rep_ < ((IN(pb + 1) && PHK(2)) ? REPS(2) : 0); ++rep_) { ph_kmean(L, rep_, wave_s_); }
            SEAM(pb + 1);
            for (int rep_ = 0; rep_ < ((IN(pb + 2) && PHK(11)) ? REPS(11) : 0); ++rep_) { ph_gate(L, rep_, wave_s_); }
            SEAM(pb + 2);
        }

        if (L == 0) {
            for (int rep_ = 0; rep_ < ((IN(pb + 3) && PHK(3)) ? REPS(3) : 0); ++rep_) { ph_moba(L, rep_, wave_s_); }
            SEAM(pb + 3);
            for (int rep_ = 0; rep_ < ((IN(pb + 4) && PHK(12)) ? REPS(12) : 0); ++rep_) { ph_mobamerge(L, rep_, wave_s_); }
        } else {
            for (int rep_ = 0; rep_ < ((IN(pb + 3) && PHK(4)) ? REPS(4) : 0); ++rep_) { ph_dil(L, rep_, wave_s_); }
            SEAM(pb + 3);
            for (int rep_ = 0; rep_ < ((IN(pb + 4) && PHK(5)) ? REPS(5) : 0); ++rep_) { ph_merge(L, rep_, wave_s_); }
        }
        SEAM(pb + 4);

        for (int rep_ = 0; rep_ < ((IN(pb + 5) && PHK(6)) ? REPS(6) : 0); ++rep_) { ph_wo(L, rep_, wave_s_); }
        SEAM(pb + 5);

        for (int rep_ = 0; rep_ < ((IN(pb + 6) && PHK(7)) ? REPS(7) : 0); ++rep_) { ph_router(L, rep_, wave_s_); }
        SEAM(pb + 6);

        for (int rep_ = 0; rep_ < ((IN(pb + 7) && PHK(8)) ? REPS(8) : 0); ++rep_) { ph_gateup(L, rep_, wave_s_); }
        SEAM(pb + 7);

        for (int rep_ = 0; rep_ < ((IN(pb + 8) && PHK(9)) ? REPS(9) : 0); ++rep_) { ph_down(L, rep_, wave_s_); }
        SEAM(pb + 8);

        for (int rep_ = 0; rep_ < ((IN(pb + 9) && PHK(10)) ? REPS(10) : 0); ++rep_) { ph_combine(L, rep_, wave_s_); }
        if (L == 0) SEAM(pb + 9);
    }
}

extern "C" void kernel_launch(void* const* d_in, const int* in_sizes, int n_in, void* d_out, int out_size, void* d_ws, size_t ws_size, hipStream_t stream) {
    static int grid = 0;
    if (grid == 0) {
        if (n_in != 16 || out_size != T * D || ws_size < WS_END2) { fprintf(stderr, "kernel_launch: unexpected problem (n_in %d out %d ws %zu need %zu)\n", n_in, out_size, ws_size, (size_t)WS_END2); grid = -1; return; }
        int dev = 0, cus = 0, per_cu = 0;
        if (hipGetDevice(&dev) != hipSuccess || hipDeviceGetAttribute(&cus, hipDeviceAttributeMultiprocessorCount, dev) != hipSuccess) { grid = -1; return; }
        if (hipFuncSetAttribute((const void*)fwd, hipFuncAttributeMaxDynamicSharedMemorySize, LDS_BYTES) != hipSuccess) { fprintf(stderr, "kernel_launch: hipFuncSetAttribute failed\n"); grid = -1; return; }
        if (hipOccupancyMaxActiveBlocksPerMultiprocessor(&per_cu, (const void*)fwd, NTHR, LDS_BYTES) != hipSuccess || per_cu < 1) { fprintf(stderr, "kernel_launch: occupancy query says %d\n", per_cu); (void)hipGetLastError(); per_cu = 1; }
        grid = cus;
    }
    if (grid < 0) return;
    (void)hipMemsetAsync((char*)d_ws + WS_CTL, 0, CTL_BYTES, stream);
    Args a{};
    for (int i = 0; i < 16; ++i) a.in[i] = (const float*)d_in[i];
    a.out = (float*)d_out; a.ws = (unsigned char*)d_ws;
#if MK_ONE_LAUNCH
    a.ph_lo = 0; a.ph_hi = N_PHASES;
    hipLaunchKernelGGL(fwd, dim3(grid), dim3(NTHR), LDS_BYTES, stream, a);
#else
    for (int ph = 0; ph < N_PHASES; ++ph) {
        if (ph == 12 || ph == 13) continue;
        a.ph_lo = ph; a.ph_hi = ph + 1;
        hipLaunchKernelGGL(fwd, dim3(grid), dim3(NTHR), LDS_BYTES, stream, a);
    }
#endif
}
```

```cpp
#include <hip/hip_runtime.h>
#include <hip/hip_bf16.h>
#include <stdint.h>
#include <stdio.h>

#ifndef MK_ONE_LAUNCH
#define MK_ONE_LAUNCH 1
#endif

#ifndef PHMASK
#define PHMASK 0x1FFF
#endif
#define PHK(k) ((PHMASK >> (k)) & 1)
#ifndef REPEAT_KIND
#define REPEAT_KIND -1
#endif
#define REPS(k) ((k) == REPEAT_KIND ? 2 : 1)
#define LAS __attribute__((address_space(3)))
typedef __attribute__((ext_vector_type(8))) short bf16x8;
typedef __attribute__((ext_vector_type(16))) float f32x16;
typedef __attribute__((ext_vector_type(4))) float f32x4;
typedef __attribute__((ext_vector_type(4))) unsigned u32x4;
typedef __attribute__((ext_vector_type(2))) unsigned u32x2;
typedef unsigned short u16;

constexpr int D = 1024, BATCH = 2, SEQ = 8192, T = BATCH * SEQ, NH = 16, HD = 64;
constexpr int NE = 256, TOPK = 8, DF = 256;
constexpr int A_TOT = T * TOPK;
constexpr int MOBA_BLK = 256, MOBA_NB = SEQ / MOBA_BLK;
constexpr float DN_ALPHA = 1.4142135623730951f;
constexpr float LN_EPS = 1e-5f;
constexpr float LOG2E = 1.4426950408889634f;
constexpr float LN2 = 0.6931471805599453f;
constexpr float NEGV = -1e30f;
constexpr int NTHR = 512;

constexpr size_t al256(size_t x) { return (x + 255) & ~(size_t)255; }
constexpr size_t WS_CTL = 0;
constexpr size_t CTL_BYTES = 131072;
constexpr size_t CTL_CNT_OFF = 32768;
constexpr size_t CTL_ECNT_OFF = 65536;
constexpr int CNT_STRIDE = 32;
constexpr size_t WS_XB = WS_CTL + CTL_BYTES;
constexpr size_t WS_X1 = WS_XB + al256((size_t)T * D * 2);
constexpr size_t WS_X2 = WS_X1 + al256((size_t)T * D * 4);
constexpr size_t WS_YPRE = WS_X2 + al256((size_t)T * D * 4);
constexpr size_t WS_QKV = WS_YPRE + al256((size_t)T * D * 4);
constexpr size_t WS_VT = WS_QKV + al256((size_t)T * 9216 * 2);
constexpr size_t WS_KM = WS_VT + al256((size_t)3 * T * D * 2);
constexpr size_t WS_AO = WS_KM + al256((size_t)BATCH * NH * MOBA_NB * HD * 4);
constexpr size_t WS_OG = WS_AO + al256((size_t)T * D * 2);
constexpr size_t WS_LSE = WS_OG + al256((size_t)3 * T * D * 2);
constexpr size_t WS_TOPW = WS_LSE + al256((size_t)3 * T * NH * 4);
constexpr size_t WS_LIST = WS_TOPW + al256((size_t)T * TOPK * 4);
constexpr size_t WS_HB = WS_LIST + al256((size_t)NE * T * 4);
constexpr size_t WS_YB = WS_HB + al256((size_t)(A_TOT + T + 1) * DF * 2);
constexpr size_t WS_END = WS_YB + al256((size_t)(A_TOT + T + 1) * D * 2);
constexpr int TRASH_VA = A_TOT + T;
constexpr size_t WS_SELM = WS_END;
constexpr size_t WS_PART = WS_SELM + al256((size_t)T * NH * 4);
constexpr size_t WS_PLSE = WS_PART + al256((size_t)T * NH * 4 * 64 * 2);
constexpr size_t WS_WQK0 = WS_PLSE + al256((size_t)T * NH * 4 * 4);
constexpr size_t WS_WV0 = WS_WQK0 + (size_t)2048 * 1024 * 2;
constexpr size_t WS_WQK1 = WS_WV0 + (size_t)1024 * 1024 * 2;
constexpr size_t WS_WV1 = WS_WQK1 + (size_t)6144 * 1024 * 2;
constexpr size_t WS_WO = WS_WV1 + (size_t)3072 * 1024 * 2;
constexpr size_t WS_WSGU = WS_WO + (size_t)2 * 1024 * 1024 * 2;
constexpr size_t WS_WSD = WS_WSGU + (size_t)2 * 512 * 1024 * 2;
constexpr size_t WS_XB8 = WS_WSD + (size_t)2 * 1024 * 256 * 2;
constexpr size_t WS_HBS = WS_XB8 + (size_t)T * D;
constexpr size_t WS_WRH = WS_HBS + (size_t)T * DF * 2;
constexpr size_t WS_WRL = WS_WRH + (size_t)2 * 256 * 1024 * 2;
constexpr size_t WS_END2 = WS_WRL + (size_t)2 * 256 * 1024 * 2;

constexpr int LDP = 40;
constexpr int STAGE_BYTES = 2 * 256 * LDP * 2;
constexpr int LDS_ROWID = 2 * STAGE_BYTES;
constexpr int LDS_ROWW = LDS_ROWID + 1024;
constexpr int XS_PITCH = 1028;
constexpr int LDS_BYTES = 163840;
constexpr int LDS_BAR = 161792;

__device__ __forceinline__ int lane_id_() { int l; asm volatile("v_mbcnt_lo_u32_b32 %0, -1, 0\n\tv_mbcnt_hi_u32_b32 %0, -1, %0" : "=v"(l)); return l; }
__device__ __forceinline__ float shxf(float v, int m, int lane) { return __int_as_float(__builtin_amdgcn_ds_bpermute((lane ^ m) << 2, __float_as_int(v))); }
__device__ __forceinline__ int shxi(int v, int m, int lane) { return __builtin_amdgcn_ds_bpermute((lane ^ m) << 2, v); }
#define XB_TMO      128
#define XB_XCNT(j)  (256  + 64 * (j))
#define XB_XSUB(j)  (1280 + 64 * (j))
#define XB_XGEN(j)  (2304 + 64 * (j))
#define XB_TOP      3328
#define XB_TOPGEN   3392
#define XCD_BAR_WORDS 3456
#define XB_SPIN_CAP (1u << 18)
__device__ __forceinline__ unsigned xb_ld(unsigned* p)              { return __hip_atomic_load(p, __ATOMIC_RELAXED, __HIP_MEMORY_SCOPE_AGENT); }
__device__ __forceinline__ unsigned xb_add(unsigned* p, unsigned v) { return __hip_atomic_fetch_add(p, v, __ATOMIC_RELAXED, __HIP_MEMORY_SCOPE_AGENT); }
__device__ __forceinline__ unsigned xb_xcc_id() { return (unsigned)__builtin_amdgcn_s_getreg((3 << 11) | 20) & 0xFu; }
#define XB_SPIN(cond, bar) do { unsigned _sp = 0; while (cond) { __builtin_amdgcn_s_sleep(1); \
    if ((++_sp & 255u) == 0u) { if (xb_ld(&(bar)[XB_TMO])) break; if (_sp > XB_SPIN_CAP) { atomicAdd(&(bar)[XB_TMO], 1u); break; } } } } while (0)
struct XcdBarrier { unsigned* bar; unsigned x; volatile LAS unsigned* st; };
__device__ __forceinline__ XcdBarrier xcd_barrier_post(unsigned* bar, volatile LAS unsigned* st, const bool leader) {
    XcdBarrier b; b.bar = bar; b.x = xb_xcc_id(); b.st = st;
    if (leader) (void)xb_add(&bar[XB_XCNT(b.x)], 1u);
    return b;
}
__device__ __forceinline__ void xcd_barrier_complete(unsigned* bar, unsigned x, unsigned& nloc, unsigned& nx) {
    const unsigned G = gridDim.x * gridDim.y * gridDim.z;
    unsigned sum, cnt, mine, sp = 0u;
    for (;;) {
        sum = 0u; cnt = 0u; mine = 0u;
#pragma unroll
        for (unsigned j = 0; j < 16; ++j) { const unsigned c = xb_ld(&bar[XB_XCNT(j)]); sum += c; cnt += (c > 0u) ? 1u : 0u; mine = (j == x) ? c : mine; }
        if (sum == G) break;
        __builtin_amdgcn_s_sleep(1);
        if ((++sp & 255u) == 0u) { if (xb_ld(&bar[XB_TMO])) break; if (sp > XB_SPIN_CAP) { atomicAdd(&bar[XB_TMO], 1u); break; } }
    }
    nloc = mine > 0u ? mine : 1u; nx = cnt > 0u ? cnt : 1u;
}
__device__ __forceinline__ void xcd_barrier(const XcdBarrier& b, const bool leader) {
    asm volatile("s_waitcnt vmcnt(0)" ::: "memory");
    __syncthreads();
    if (leader) {
        unsigned* bar = b.bar;
        __builtin_amdgcn_s_waitcnt(0);
        unsigned nloc = b.st[0], nx = b.st[1];
        if (nloc == 0u) { xcd_barrier_complete(bar, b.x, nloc, nx); b.st[0] = nloc; b.st[1] = nx; }
        const unsigned old = xb_add(&bar[XB_XSUB(b.x)], 1u);
        const unsigned gen = old / nloc;
        if (old + 1u == (gen + 1u) * nloc) {
            __builtin_amdgcn_fence(__ATOMIC_RELEASE, "agent");
            asm volatile("s_waitcnt vmcnt(0)" ::: "memory");
            const unsigned og = xb_add(&bar[XB_TOP], 1u);
            const unsigned tg = og / nx;
            if (og + 1u == (tg + 1u) * nx) xb_add(&bar[XB_TOPGEN], 1u);
            else XB_SPIN(xb_ld(&bar[XB_TOPGEN]) == tg, bar);
            __builtin_amdgcn_fence(__ATOMIC_ACQUIRE, "agent");
            xb_add(&bar[XB_XGEN(b.x)], 1u);
            asm volatile("s_waitcnt vmcnt(0)" ::: "memory");
        } else {
            XB_SPIN(xb_ld(&bar[XB_XGEN(b.x)]) == gen, bar);
            __builtin_amdgcn_fence(__ATOMIC_ACQUIRE, "agent");
            asm volatile("s_waitcnt vmcnt(0)" ::: "memory");
        }
    }
    __syncthreads();
}

typedef __attribute__((ext_vector_type(2))) __bf16 bf16x2_t;
typedef __attribute__((ext_vector_type(2))) float f32x2_t;
__device__ __forceinline__ unsigned cvtpk(float lo, float hi) { f32x2_t f; f[0] = lo; f[1] = hi; return __builtin_bit_cast(unsigned, __builtin_convertvector(f, bf16x2_t)); }
__device__ __forceinline__ float bf2f(unsigned v16) { return __uint_as_float(v16 << 16); }
__device__ __forceinline__ int crow(int r, int hi) { return (r & 3) + 8 * (r >> 2) + 4 * hi; }
#define MFMA_BF16(a, b, c) __builtin_amdgcn_mfma_f32_32x32x16_bf16(a, b, c, 0, 0, 0)
__device__ __forceinline__ float wave_sum(float v) {
    v += __int_as_float(__builtin_amdgcn_update_dpp(0, __float_as_int(v), 0xB1, 0xF, 0xF, true));
    v += __int_as_float(__builtin_amdgcn_update_dpp(0, __float_as_int(v), 0x4E, 0xF, 0xF, true));
    v += __int_as_float(__builtin_amdgcn_update_dpp(0, __float_as_int(v), 0x141, 0xF, 0xF, true));
    v += __int_as_float(__builtin_amdgcn_update_dpp(0, __float_as_int(v), 0x140, 0xF, 0xF, true));
    const int vi = __float_as_int(v);
    return (__int_as_float(__builtin_amdgcn_readlane(vi, 0)) + __int_as_float(__builtin_amdgcn_readlane(vi, 16))) + (__int_as_float(__builtin_amdgcn_readlane(vi, 32)) + __int_as_float(__builtin_amdgcn_readlane(vi, 48)));
}

namespace pg8 {
#define PG8_LAS __attribute__((address_space(3)))
typedef unsigned short bf16_t;
typedef short bf16x8 __attribute__((ext_vector_type(8)));
typedef float f32x4 __attribute__((ext_vector_type(4)));
typedef unsigned u32x4 __attribute__((ext_vector_type(4)));
constexpr int BM = 256, BK = 64, HALF = 128, HTB = HALF * BK * 2  , STAGE_BYTES = 8 * HTB, NXCD = 8, WGM = 8;

__host__ __device__ __forceinline__ int lds_byte(int r, int c) { const int st = (r >> 4) * 2 + (c >> 5), rr = r & 15, cc = c & 31, ob = rr * 64 + cc * 2; return st * 1024 + (ob ^ (((ob >> 9) & 1) << 5)); }
__host__ __device__ __forceinline__ void stage_rc(int b, int& R, int& C) { const int st = b / 1024, sb = b % 1024, swz = sb ^ (((sb >> 9) & 1) << 5); R = (st >> 1) * 16 + swz / 64; C = (st & 1) * 32 + (swz % 64) / 2; }
__host__ __device__ __forceinline__ int perm32(int rho) { const int n = rho >> 4, i = rho & 15; return 8 * (i >> 2) + 4 * n + (i & 3); }

struct Unit { int pm, pn; };
struct Gemm { const bf16_t* A; const bf16_t* Bt; int M, N, K; };
struct FixedOrder {
    int pm, pn;
    __device__ __forceinline__ bool next(int i, Unit& u) const { if (i != 0) return false; u.pm = pm; u.pn = pn; return true; }
    __device__ __forceinline__ void a_ready(const Unit&) const {}
    __device__ __forceinline__ void done(const Unit&) const {}
};

struct StaticOrder {
    int nM, nN, nwg, G, c;
    __host__ __device__ void init(int M, int N, int G_, int c_) { nM = M / BM; nN = N / BM; nwg = nM * nN; G = G_; c = c_; }
    __host__ __device__ bool next(int i, Unit& u) const {
        const long L = (long)i * G + c; if (L >= nwg) return false;
        int wgid = (int)L; { const int q = nwg / NXCD, r = nwg % NXCD, xcd = wgid % NXCD, off = wgid / NXCD; wgid = (xcd < r ? xcd * (q + 1) : r * (q + 1) + (xcd - r) * q) + off; }
        const int nig = WGM * nN, gid = wgid / nig, fm = gid * WGM, gsz = (nM - fm) < WGM ? (nM - fm) : WGM;
        u.pm = fm + ((wgid % nig) % gsz); u.pn = (wgid % nig) / gsz; return true;
    }
    __device__ __forceinline__ void a_ready(const Unit&) const {}
    __device__ __forceinline__ void done(const Unit&) const {}
};

template <class Epi, class Sched, bool SWAP = false, bool STAMP = false>
__device__ __forceinline__ void gemm_phase(PG8_LAS unsigned char* lds, const Gemm g, const Sched& S, const Epi& E, unsigned long long* stamps, const int tid_in) {
    int tid_ = tid_in; asm volatile("" : "+v"(tid_));
    const int tid = tid_, wid = __builtin_amdgcn_readfirstlane(tid >> 6), lane = tid & 63, wr = wid >> 2, wc = wid & 3, fr = lane & 15, fq = lane >> 4;
    const int K = g.K, nt = K / BK;
    int ts_lo = 0, ts_hi = 0, nts = 0; const unsigned long long rt_entry = STAMP ? (unsigned long long)wall_clock64() : 0ull;
#define PG8_STAMP() do { if (STAMP && wid == 0 && nts < 64) { const unsigned long long _c = (unsigned long long)clock64(); \
        ts_lo = (lane == nts) ? (int)(unsigned)_c : ts_lo; ts_hi = (lane == nts) ? (int)(unsigned)(_c >> 32) : ts_hi; ++nts; } } while (0)
    PG8_STAMP();
    unsigned voffA[2], voffB[2];
#pragma unroll
    for (int i = 0; i < 2; ++i) { int R, C; stage_rc(tid * 16 + i * 8192, R, C); const int Rb = Epi::PERM ? ((R & ~31) + perm32(R & 31)) : R;
        voffA[i] = (unsigned)(R * K + C) * 2u; voffB[i] = (unsigned)(Rb * K + C) * 2u; }
    const size_t kstep = (size_t)(BK * 2);
    const size_t hstep = (size_t)HALF * K * 2;
    const size_t tstep = 2 * hstep;
    const unsigned ldsw = (unsigned)wid * 1024u;
    const int aoff = lds_byte(wr * 64 + fr, fq * 8), boff = lds_byte(wc * 32 + fr, fq * 8);
#define PG8_SA(b, h) (((b) * 2 + (h)) * HTB)
#define PG8_SB(b, h) ((4 + (b) * 2 + (h)) * HTB)
#define PG8_STAGE(bufoff, gbase, voff) do { _Pragma("unroll") for (int _i = 0; _i < 2; ++_i) \
        __builtin_amdgcn_global_load_lds((const unsigned*)((const char*)(gbase) + (voff)[_i]), (PG8_LAS unsigned*)(lds + (bufoff) + ldsw + _i * 8192), 16, 0, 0); } while (0)
#define PG8_LDA(dst, b, h) do { _Pragma("unroll") for (int m = 0; m < 4; ++m) _Pragma("unroll") for (int k = 0; k < 2; ++k) dst[m][k] = *(const PG8_LAS bf16x8*)(lds + PG8_SA(b, h) + aoff + m * 2048 + k * 1024); } while (0)
#define PG8_LDB(dst, b, h) do { _Pragma("unroll") for (int n = 0; n < 2; ++n) _Pragma("unroll") for (int k = 0; k < 2; ++k) dst[n][k] = *(const PG8_LAS bf16x8*)(lds + PG8_SB(b, h) + boff + n * 2048 + k * 1024); } while (0)
#define PG8_MMA(ai, bj, At, Bt) do { __builtin_amdgcn_s_setprio(1); _Pragma("unroll") for (int m = 0; m < 4; ++m) _Pragma("unroll") for (int n = 0; n < 2; ++n) _Pragma("unroll") for (int k = 0; k < 2; ++k) \
        acc[ai][bj][m][n] = SWAP ? __builtin_amdgcn_mfma_f32_16x16x32_bf16(At[m][k], Bt[n][k], acc[ai][bj][m][n], 0, 0, 0) : __builtin_amdgcn_mfma_f32_16x16x32_bf16(Bt[n][k], At[m][k], acc[ai][bj][m][n], 0, 0, 0); __builtin_amdgcn_s_setprio(0); } while (0)
#define PG8_WAIT_V(n) asm volatile("s_waitcnt vmcnt(" #n ")" ::: "memory")
#define PG8_WAIT_L(n) asm volatile("s_waitcnt lgkmcnt(" #n ")" ::: "memory")
#define PG8_BAR __builtin_amdgcn_s_barrier()
#define PG8_SCHED __builtin_amdgcn_sched_barrier(0)
    Unit cur, nxt; int ui = 0;
    if (!S.next(0, cur)) return;
    f32x4 acc[2][2][4][2];
#pragma unroll
    for (int a = 0; a < 2; ++a)
#pragma unroll
        for (int b = 0; b < 2; ++b)
#pragma unroll
            for (int m = 0; m < 4; ++m)
#pragma unroll
                for (int n = 0; n < 2; ++n) acc[a][b][m][n] = (f32x4){0.f, 0.f, 0.f, 0.f};
    bf16x8 At[4][2], B0[2][2], B1[2][2];
    const char* cA = (const char*)g.A + (size_t)cur.pm * tstep; const char* cB = (const char*)g.Bt + (size_t)cur.pn * tstep;
    S.a_ready(cur);
    PG8_STAGE(PG8_SB(0, 0), cB, voffB); PG8_STAGE(PG8_SA(0, 0), cA, voffA); PG8_STAGE(PG8_SB(0, 1), cB + hstep, voffB); PG8_STAGE(PG8_SA(0, 1), cA + hstep, voffA);
    if (wr == 1) PG8_BAR;
    PG8_WAIT_V(4); PG8_BAR;
    PG8_STAGE(PG8_SB(1, 0), cB + kstep, voffB); PG8_STAGE(PG8_SA(1, 0), cA + kstep, voffA); PG8_STAGE(PG8_SB(1, 1), cB + hstep + kstep, voffB);
    PG8_WAIT_V(6); PG8_BAR;
    PG8_STAMP();
    for (;;) {
        const bool has_next = S.next(ui + 1, nxt);
        const char* nA = has_next ? (const char*)g.A + (size_t)nxt.pm * tstep : cA; const char* nB = has_next ? (const char*)g.Bt + (size_t)nxt.pn * tstep : cB;
        for (int t = 0; t < nt; t += 2) {
            const bool last = (t == nt - 2);
            const char* a1 = cA + (size_t)(t + 1) * kstep;
            const char* a2 = last ? nA : cA + (size_t)(t + 2) * kstep; const char* b2 = last ? nB : cB + (size_t)(t + 2) * kstep;
            const char* a3 = a2 + kstep; const char* b3 = b2 + kstep;
            if (last && has_next) S.a_ready(nxt);
            PG8_LDB(B0, 0, 0); PG8_SCHED; PG8_LDA(At, 0, 0); PG8_STAGE(PG8_SA(1, 1), a1 + hstep, voffA);
            PG8_WAIT_L(8); PG8_BAR; PG8_WAIT_L(0); PG8_MMA(0, 0, At, B0); PG8_BAR; PG8_SCHED;
            PG8_LDB(B1, 0, 1); PG8_STAGE(PG8_SB(0, 0), b2, voffB);
            PG8_BAR; PG8_WAIT_L(0); PG8_MMA(0, 1, At, B1); PG8_BAR;
            PG8_LDA(At, 0, 1); PG8_STAGE(PG8_SA(0, 0), a2, voffA);
            PG8_BAR; PG8_WAIT_L(0); PG8_MMA(1, 0, At, B0); PG8_BAR; PG8_SCHED;
            PG8_STAGE(PG8_SB(0, 1), b2 + hstep, voffB);
            PG8_WAIT_V(6); PG8_BAR; PG8_MMA(1, 1, At, B1); PG8_BAR;
            PG8_LDB(B0, 1, 0); PG8_SCHED; PG8_LDA(At, 1, 0); PG8_STAGE(PG8_SA(0, 1), a2 + hstep, voffA);
            PG8_WAIT_L(8); PG8_BAR; PG8_WAIT_L(0); PG8_MMA(0, 0, At, B0); PG8_BAR; PG8_SCHED;
            PG8_LDB(B1, 1, 1); PG8_STAGE(PG8_SB(1, 0), b3, voffB);
            PG8_BAR; PG8_WAIT_L(0); PG8_MMA(0, 1, At, B1); PG8_BAR;
            PG8_LDA(At, 1, 1); PG8_STAGE(PG8_SA(1, 0), a3, voffA);
            PG8_BAR; PG8_WAIT_L(0); PG8_MMA(1, 0, At, B0); PG8_BAR; PG8_SCHED;
            PG8_STAGE(PG8_SB(1, 1), b3 + hstep, voffB);
            PG8_WAIT_V(6); PG8_BAR; PG8_MMA(1, 1, At, B1); PG8_BAR;
        }
        PG8_STAMP();
        if constexpr (!Epi::AFTER_DRAIN) { E(acc, cur, wr, wc, fr, fq); S.done(cur); }
        PG8_STAMP();
        if (!has_next) break;
#pragma unroll
        for (int a = 0; a < 2; ++a)
#pragma unroll
            for (int b = 0; b < 2; ++b)
#pragma unroll
                for (int m = 0; m < 4; ++m)
#pragma unroll
                    for (int n = 0; n < 2; ++n) acc[a][b][m][n] = (f32x4){0.f, 0.f, 0.f, 0.f};
        cur = nxt; cA = nA; cB = nB; ++ui;
    }
    PG8_WAIT_V(0);
    if (wr == 0) PG8_BAR;
    PG8_BAR;
    if constexpr (Epi::AFTER_DRAIN) { E.fused(acc, cur, wr, wc, fr, fq, lds, wid, lane); S.done(cur); }
    PG8_STAMP();
    if (STAMP && wid == 0) { stamps[lane] = lane < nts ? (((unsigned long long)(unsigned)ts_hi << 32) | (unsigned)ts_lo) : 0ull;
        if (lane == 62) stamps[62] = rt_entry; if (lane == 63) stamps[63] = (unsigned long long)wall_clock64(); }
#undef PG8_STAMP
#undef PG8_SA
#undef PG8_SB
#undef PG8_STAGE
#undef PG8_LDA
#undef PG8_LDB
#undef PG8_MMA
#undef PG8_WAIT_V
#undef PG8_WAIT_L
#undef PG8_BAR
#undef PG8_SCHED
}
}

struct EpiQK {
    static constexpr bool PERM = true, AFTER_DRAIN = false;
    u16* O; int ldc;
    __device__ __forceinline__ void operator()(const pg8::f32x4 (&acc)[2][2][4][2], const pg8::Unit& u, int wr, int wc, int fr, int fq) const {
        const int col0 = u.pn * 256 + wc * 32 + 8 * fq, row0 = u.pm * 256 + wr * 64 + fr;
#pragma unroll
        for (int ai = 0; ai < 2; ++ai)
#pragma unroll
            for (int m = 0; m < 4; ++m) { u16* rowp = O + (size_t)(row0 + ai * 128 + m * 16) * ldc + col0;
#pragma unroll
                for (int bj = 0; bj < 2; ++bj) { const pg8::f32x4 v0 = acc[ai][bj][m][0], v1 = acc[ai][bj][m][1];
                    u32x4 w; w[0] = cvtpk(v0[0], v0[1]); w[1] = cvtpk(v0[2], v0[3]); w[2] = cvtpk(v1[0], v1[1]); w[3] = cvtpk(v1[2], v1[3]);
                    *(u32x4*)(rowp + bj * 128) = w; } }
    }
};
struct EpiV {
    static constexpr bool PERM = false, AFTER_DRAIN = false;
    u16* VT; int layer;
    __device__ __forceinline__ void operator()(const pg8::f32x4 (&acc)[2][2][4][2], const pg8::Unit& u, int wr, int wc, int fr, int fq) const {
        const int colt = u.pn * 256, grp = colt >> 10;
        const int dil = (layer == 0 || grp == 0) ? 1 : (grp == 1 ? 4 : 16);
        const int rowb = u.pm * 256 + wr * 64 + 4 * fq;
#pragma unroll
        for (int bj = 0; bj < 2; ++bj)
#pragma unroll
            for (int n = 0; n < 2; ++n) {
                const int c = (colt & 1023) + bj * 128 + wc * 32 + n * 16 + fr, h = c >> 6, d = c & 63;
#pragma unroll
                for (int ai = 0; ai < 2; ++ai)
#pragma unroll
                    for (int m = 0; m < 4; ++m) {
                        const int r0 = rowb + ai * 128 + m * 16, b = r0 >> 13, t0 = r0 & (SEQ - 1);
                        u16* vrow = VT + (size_t)grp * T * D + ((size_t)(b * NH + h) * HD + d) * SEQ;
                        const pg8::f32x4 v = acc[ai][bj][m][n];
                        if (dil == 1) { u32x2 w; w[0] = cvtpk(v[0], v[1]); w[1] = cvtpk(v[2], v[3]); *(u32x2*)(vrow + t0) = w; }
                        else {
#pragma unroll
                            for (int i = 0; i < 4; ++i) { const int pp = t0 + i; vrow[(pp % dil) * (SEQ / dil) + pp / dil] = (u16)cvtpk(v[i], 0.f); }
                        }
                    }
            }
    }
};
struct EpiWo {
    static constexpr bool PERM = false, AFTER_DRAIN = false;
    float* Y; const float* X;
    __device__ __forceinline__ void operator()(const pg8::f32x4 (&acc)[2][2][4][2], const pg8::Unit& u, int wr, int wc, int fr, int fq) const {
        const int row0 = u.pm * 256 + wr * 64 + fr, col0 = u.pn * 256 + wc * 32 + 4 * fq;
#pragma unroll
        for (int ai = 0; ai < 2; ++ai)
#pragma unroll
            for (int m = 0; m < 4; ++m) { const size_t ro = (size_t)(row0 + ai * 128 + m * 16) * D + col0;
#pragma unroll
                for (int bj = 0; bj < 2; ++bj)
#pragma unroll
                    for (int n = 0; n < 2; ++n) { const pg8::f32x4 x = *(const pg8::f32x4*)(X + ro + bj * 128 + n * 16); *(pg8::f32x4*)(Y + ro + bj * 128 + n * 16) = x * DN_ALPHA + acc[ai][bj][m][n]; } }
    }
};
struct EpiSGU {
    static constexpr bool PERM = true, AFTER_DRAIN = false;
    u16* H;
    __device__ __forceinline__ void operator()(const pg8::f32x4 (&acc)[2][2][4][2], const pg8::Unit& u, int wr, int wc, int fr, int fq) const {
        const int row0 = u.pm * 256 + wr * 64 + fr, f0 = u.pn * 128 + wc * 32 + 8 * fq;
#pragma unroll
        for (int ai = 0; ai < 2; ++ai)
#pragma unroll
            for (int m = 0; m < 4; ++m) {
                float hv[8];
#pragma unroll
                for (int n = 0; n < 2; ++n)
#pragma unroll
                    for (int i = 0; i < 4; ++i) { const float gt = acc[ai][0][m][n][i], up = acc[ai][1][m][n][i]; hv[n * 4 + i] = gt / (1.f + __expf(-gt)) * up; }
                u32x4 w; w[0] = cvtpk(hv[0], hv[1]); w[1] = cvtpk(hv[2], hv[3]); w[2] = cvtpk(hv[4], hv[5]); w[3] = cvtpk(hv[6], hv[7]);
                *(u32x4*)(H + (size_t)(row0 + ai * 128 + m * 16) * DF + f0) = w;
            }
    }
};
struct EpiSD {
    static constexpr bool PERM = true, AFTER_DRAIN = false;
    u16* Y;
    __device__ __forceinline__ void operator()(const pg8::f32x4 (&acc)[2][2][4][2], const pg8::Unit& u, int wr, int wc, int fr, int fq) const {
        const int row0 = u.pm * 256 + wr * 64 + fr, col0 = u.pn * 256 + wc * 32 + 8 * fq;
#pragma unroll
        for (int ai = 0; ai < 2; ++ai)
#pragma unroll
            for (int m = 0; m < 4; ++m) { u16* rowp = Y + (size_t)(A_TOT + row0 + ai * 128 + m * 16) * D + col0;
#pragma unroll
                for (int bj = 0; bj < 2; ++bj) { const pg8::f32x4 v0 = acc[ai][bj][m][0], v1 = acc[ai][bj][m][1];
                    u32x4 w; w[0] = cvtpk(v0[0], v0[1]); w[1] = cvtpk(v0[2], v0[3]); w[2] = cvtpk(v1[0], v1[1]); w[3] = cvtpk(v1[2], v1[3]);
                    *(u32x4*)(rowp + bj * 128) = w; } }
    }
};

struct Args {
    const float* in[16];
    float* out;
    unsigned char* ws;
    int ph_lo, ph_hi;
};

#define GEMM_CORE(K_, PA0, PA1, PB, LDB)                                                                                                   \
    {                                                                                                                                      \
        const int g_tid = tid, g_lane = lane, g_wave = wave, g_r32 = r32, g_hi = hi;                   \
        const int g_wm = g_wave >> 2, g_wn = g_wave & 3, g_kc = g_tid & 3, g_kq = g_lane >> 3, g_n4 = g_lane & 7;                           \
        const u16* g_pa0 = (PA0); const u16* g_pa1 = (PA1);                                                                                \
        const size_t g_ldb = (size_t)(LDB);                                                                                                \
        const float* g_pb = (PB) + (size_t)(g_kq * 4) * g_ldb + g_n4 * 4;                                                                  \
        const int g_nk = (K_) / 32;                                                                                                        \
        u32x4 g_ra0, g_ra1; f32x4 g_rb0, g_rb1, g_rb2, g_rb3;                                                                              \
        const u32x4 g_z = {0u, 0u, 0u, 0u};                                                                                                \
        _Pragma("unroll") for (int mb = 0; mb < 4; ++mb) { _Pragma("unroll") for (int nb = 0; nb < 2; ++nb) { _Pragma("unroll") for (int r = 0; r < 16; ++r) acc[mb][nb][r] = 0.f; } } \
        g_ra0 = g_pa0 ? *(const u32x4*)(g_pa0 + g_kc * 8) : g_z; g_ra1 = g_pa1 ? *(const u32x4*)(g_pa1 + g_kc * 8) : g_z;                 \
        g_rb0 = *(const f32x4*)(g_pb); g_rb1 = *(const f32x4*)(g_pb + g_ldb); g_rb2 = *(const f32x4*)(g_pb + 2 * g_ldb); g_rb3 = *(const f32x4*)(g_pb + 3 * g_ldb); \
        _Pragma("unroll 1") for (int kt = 0; kt < g_nk; ++kt) {                                                                            \
            LAS char* As = lds + (kt & 1) * STAGE_BYTES; LAS char* Bs = As + 256 * LDP * 2;                                                \
            *(LAS u32x4*)(As + ((g_tid >> 2) * LDP + g_kc * 8) * 2) = g_ra0;                                                               \
            *(LAS u32x4*)(As + (((g_tid >> 2) + 128) * LDP + g_kc * 8) * 2) = g_ra1;                                                       \
            _Pragma("unroll") for (int i = 0; i < 4; ++i) {                                                                                \
                u32x2 w; w[0] = cvtpk(g_rb0[i], g_rb1[i]); w[1] = cvtpk(g_rb2[i], g_rb3[i]);                                               \
                *(LAS u32x2*)(Bs + ((g_wave * 32 + i * 8 + g_n4) * LDP + g_kq * 4) * 2) = w;                                               \
            }                                                                                                                              \
            __syncthreads();                                                                                                               \
            if (kt + 1 < g_nk) {                                                                                                           \
                const int ko = (kt + 1) * 32;                                                                                              \
                g_ra0 = g_pa0 ? *(const u32x4*)(g_pa0 + ko + g_kc * 8) : g_z; g_ra1 = g_pa1 ? *(const u32x4*)(g_pa1 + ko + g_kc * 8) : g_z; \
                const float* pbk = g_pb + (size_t)ko * g_ldb;                                                                              \
                g_rb0 = *(const f32x4*)(pbk); g_rb1 = *(const f32x4*)(pbk + g_ldb); g_rb2 = *(const f32x4*)(pbk + 2 * g_ldb); g_rb3 = *(const f32x4*)(pbk + 3 * g_ldb); \
            }                                                                                                                              \
            _Pragma("unroll") for (int s = 0; s < 2; ++s) {                                                                                \
                bf16x8 af[4], bfr[2];                                                                                                      \
                _Pragma("unroll") for (int mb = 0; mb < 4; ++mb) af[mb] = *(LAS bf16x8*)(As + ((g_wm * 128 + mb * 32 + g_r32) * LDP + s * 16 + g_hi * 8) * 2); \
                _Pragma("unroll") for (int nb = 0; nb < 2; ++nb) bfr[nb] = *(LAS bf16x8*)(Bs + (((g_wn * 2 + nb) * 32 + g_r32) * LDP + s * 16 + g_hi * 8) * 2); \
                _Pragma("unroll") for (int mb = 0; mb < 4; ++mb) { _Pragma("unroll") for (int nb = 0; nb < 2; ++nb) acc[mb][nb] = MFMA_BF16(af[mb], bfr[nb], acc[mb][nb]); } \
            }                                                                                                                              \
        }                                                                                                                                  \
        __syncthreads();                                                                                                                   \
    }

struct AttnSt { float m, l; f32x16 o0, o1; };

struct AttnFr { bf16x8 k[4]; bf16x8 v[4]; };
__device__ __forceinline__ void attn_load(AttnFr& f, const u16* krow, const u16* vt, size_t vt_dstride) {
#pragma unroll
    for (int d0 = 0; d0 < 4; ++d0) f.k[d0] = *(const bf16x8*)(krow + d0 * 16);
    const u16* vt1 = vt + 32 * vt_dstride;
    union { bf16x8 v; u32x2 h[2]; } va;
    va.h[0] = *(const u32x2*)(vt);       va.h[1] = *(const u32x2*)(vt + 8);   f.v[0] = va.v;
    va.h[0] = *(const u32x2*)(vt + 16);  va.h[1] = *(const u32x2*)(vt + 24);  f.v[1] = va.v;
    va.h[0] = *(const u32x2*)(vt1);      va.h[1] = *(const u32x2*)(vt1 + 8);  f.v[2] = va.v;
    va.h[0] = *(const u32x2*)(vt1 + 16); va.h[1] = *(const u32x2*)(vt1 + 24); f.v[3] = va.v;
}
__device__ __forceinline__ void attn_compute(AttnSt& st, const bf16x8 (&qf)[4], const AttnFr& f, int dist0, float bslope, int dlo, int dhi, int hi, int lane) {
    f32x16 p;
#pragma unroll
    for (int r = 0; r < 16; ++r) p[r] = 0.f;
#pragma unroll
    for (int d0 = 0; d0 < 4; ++d0) p = MFMA_BF16(f.k[d0], qf[d0], p);
    constexpr float C2 = 0.125f * LOG2E;
    float mx = NEGV;
#pragma unroll
    for (int r = 0; r < 16; ++r) {
        const int dist = dist0 - ((r & 3) + 8 * (r >> 2));
        const float sc = __builtin_fmaf(p[r], C2, -bslope * (float)dist);
        const float s_ = (dist >= dlo && dist <= dhi) ? sc : NEGV;
        p[r] = s_; mx = fmaxf(mx, s_);
    }
    mx = fmaxf(mx, shxf(mx, 32, lane));
    const float mnew = fmaxf(st.m, mx);
    const float alpha = __builtin_amdgcn_exp2f(st.m - mnew);
    st.m = mnew;
    float ls = 0.f;
#pragma unroll
    for (int r = 0; r < 16; ++r) { p[r] = __builtin_amdgcn_exp2f(p[r] - mnew); ls += p[r]; }
    st.l = st.l * alpha + ls;
#pragma unroll
    for (int r = 0; r < 16; ++r) { st.o0[r] *= alpha; st.o1[r] *= alpha; }
    union { bf16x8 v; unsigned u[4]; } pb0, pb1;
#pragma unroll
    for (int j = 0; j < 4; ++j) { pb0.u[j] = cvtpk(p[2 * j], p[2 * j + 1]); pb1.u[j] = cvtpk(p[8 + 2 * j], p[8 + 2 * j + 1]); }
    st.o0 = MFMA_BF16(f.v[0], pb0.v, st.o0);
    st.o0 = MFMA_BF16(f.v[1], pb1.v, st.o0);
    st.o1 = MFMA_BF16(f.v[2], pb0.v, st.o1);
    st.o1 = MFMA_BF16(f.v[3], pb1.v, st.o1);
    (void)hi;
}

__device__ __forceinline__ float dpp_rowmax(float v) {
    v = fmaxf(v, __int_as_float(__builtin_amdgcn_update_dpp(0, __float_as_int(v), 0xB1, 0xF, 0xF, true)));
    v = fmaxf(v, __int_as_float(__builtin_amdgcn_update_dpp(0, __float_as_int(v), 0x4E, 0xF, 0xF, true)));
    v = fmaxf(v, __int_as_float(__builtin_amdgcn_update_dpp(0, __float_as_int(v), 0x141, 0xF, 0xF, true)));
    v = fmaxf(v, __int_as_float(__builtin_amdgcn_update_dpp(0, __float_as_int(v), 0x140, 0xF, 0xF, true)));
    return v;
}
__device__ __forceinline__ int dpp_rowmin_i(int v) {
    v = min(v, __builtin_amdgcn_update_dpp(0, v, 0xB1, 0xF, 0xF, true));
    v = min(v, __builtin_amdgcn_update_dpp(0, v, 0x4E, 0xF, 0xF, true));
    v = min(v, __builtin_amdgcn_update_dpp(0, v, 0x141, 0xF, 0xF, true));
    v = min(v, __builtin_amdgcn_update_dpp(0, v, 0x140, 0xF, 0xF, true));
    return v;
}
__device__ __forceinline__ float rl_f(float v, int l) { return __int_as_float(__builtin_amdgcn_readlane(__float_as_int(v), l)); }

__device__ __forceinline__ void top3_insert(float v, int i, float& v0, int& i0, float& v1, int& i1, float& v2, int& i2) {
    const bool b0 = (v > v0) || (v == v0 && i < i0);
    const bool b1 = (v > v1) || (v == v1 && i < i1);
    const bool b2 = (v > v2) || (v == v2 && i < i2);
    const float nv2 = b1 ? v1 : (b2 ? v : v2); const int ni2 = b1 ? i1 : (b2 ? i : i2);
    const float nv1 = b0 ? v0 : (b1 ? v : v1); const int ni1 = b0 ? i0 : (b1 ? i : i1);
    const float nv0 = b0 ? v : v0;             const int ni0 = b0 ? i : i0;
    v0 = nv0; i0 = ni0; v1 = nv1; i1 = ni1; v2 = nv2; i2 = ni2;
}

__device__ __forceinline__ void ln_row(float (&v)[16], const float* __restrict__ g, const float* __restrict__ b, int lane) {
    float s = 0.f;
#pragma unroll
    for (int i = 0; i < 16; ++i) s += v[i];
    const float mu = wave_sum(s) * (1.f / D);
    float q = 0.f;
#pragma unroll
    for (int i = 0; i < 16; ++i) { const float d = v[i] - mu; q += d * d; }
    const float rstd = rsqrtf(wave_sum(q) * (1.f / D) + LN_EPS);
#pragma unroll
    for (int j = 0; j < 4; ++j) {
        const f32x4 gg = *(const f32x4*)(g + j * 256 + lane * 4), bb = *(const f32x4*)(b + j * 256 + lane * 4);
#pragma unroll
        for (int c = 0; c < 4; ++c) v[j * 4 + c] = (v[j * 4 + c] - mu) * rstd * gg[c] + bb[c];
    }
}

typedef __attribute__((ext_vector_type(2))) float f32x2_;
__device__ __forceinline__ bf16x8 fp8x8_to_bf16(unsigned lo, unsigned hi_) {
    const f32x2_ a = __builtin_amdgcn_cvt_pk_f32_fp8((int)lo, false), b = __builtin_amdgcn_cvt_pk_f32_fp8((int)lo, true);
    const f32x2_ c = __builtin_amdgcn_cvt_pk_f32_fp8((int)hi_, false), d = __builtin_amdgcn_cvt_pk_f32_fp8((int)hi_, true);
    union { bf16x8 v; unsigned u[4]; } r;
    r.u[0] = cvtpk(a[0], a[1]); r.u[1] = cvtpk(b[0], b[1]); r.u[2] = cvtpk(c[0], c[1]); r.u[3] = cvtpk(d[0], d[1]);
    return r.v;
}
__device__ __forceinline__ unsigned pack_fp8x4(float a, float b, float c, float d) { int p = __builtin_amdgcn_cvt_pk_fp8_f32(a, b, 0, false); return (unsigned)__builtin_amdgcn_cvt_pk_fp8_f32(c, d, p, true); }

constexpr int MOE_BP = 72;
constexpr int MOE_BSTAGE = 128 * MOE_BP * 2;
constexpr int MOE_LDS_VA = 3 * MOE_BSTAGE;
constexpr int MOE_LDS_W = MOE_LDS_VA + 4096;
template <bool DOWN>
__device__ __forceinline__ void moe_expert(LAS char* lds, const int tid, const int lane, const int wave, const int r32, const int hi,
                                           const unsigned char* __restrict__ abase  , const float* __restrict__ w0, const float* __restrict__ w1, const int ng  , void* __restrict__ outv,
                                           const int pass0, const int npass_, const int st0, const int nstl  , const bool y8 = false  ) {
    constexpr int KT = DOWN ? 4 : 16, NP = DOWN ? 8 : 4, LDB = DOWN ? 1024 : 256, APITCH = DOWN ? 256 : 1024  , PSTEP = DOWN ? 128 : 64;
    LAS int* rowva = (LAS int*)(lds + MOE_LDS_VA); LAS float* roww = (LAS float*)(lds + MOE_LDS_W);
    const int nst = nstl;
    const int nsteps = npass_ * nst * KT; (void)NP;
    unsigned aoff[2];
#define MOE_AOFF(ST_) { _Pragma("unroll") for (int a = 0; a < 2; ++a) { const int va_ = rowva[(ST_) * 512 + wave * 64 + a * 32 + r32]; \
        const int srow_ = DOWN ? va_ : (va_ == TRASH_VA ? 0 : (va_ >> 3)); aoff[a] = (unsigned)srow_ * APITCH + hi * 32; } }
    const int seg = wave >> 1, n4 = lane & 7, kp = (wave & 1) * 16 + (lane >> 3);
    const char* wbase = (const char*)(DOWN ? (w0 + seg * 32) : (((seg < 2) ? w0 : w1) + (seg & 1) * 32));
    unsigned boff = (unsigned)(4 * n4 + 2 * kp * LDB) * 4u; asm volatile("" : "+v"(boff));
    f32x16 acc[2][4];
#pragma unroll
    for (int a = 0; a < 2; ++a)
#pragma unroll
        for (int c = 0; c < 4; ++c)
#pragma unroll
            for (int r = 0; r < 16; ++r) acc[a][c][r] = 0.f;
    u32x4 fa8[2][2];
    f32x4 rb0[4], rb1[4];
#define MOE_DEC(S_) const int s2_ = (S_) < nsteps ? (S_) : 0; const int pl_ = s2_ / (nst * KT); const int rm_ = s2_ - pl_ * (nst * KT); const int sl_ = rm_ / KT; const int kt_ = rm_ - sl_ * KT; const int ps_ = pass0 + pl_; const int stt_ = st0 + sl_;
#define MOE_LOADB(S_, RB) { MOE_DEC(S_) (void)stt_; \
        const char* wp_ = wbase + (size_t)(ps_ * PSTEP + kt_ * 64 * LDB) * 4 + boff; \
        RB[0] = *(const f32x4*)(wp_); RB[1] = *(const f32x4*)(wp_ + LDB * 4); RB[2] = *(const f32x4*)(wp_ + 16 * LDB * 4); RB[3] = *(const f32x4*)(wp_ + 17 * LDB * 4); }
#define MOE_WRITEB(STG, RB) { LAS char* Bs_ = lds + (STG) * MOE_BSTAGE; \
        _Pragma("unroll") for (int i = 0; i < 4; ++i) { LAS unsigned* q_ = (LAS unsigned*)(Bs_ + ((seg * 32 + i * 8 + n4) * MOE_BP + 2 * kp) * 2); q_[0] = cvtpk(RB[0][i], RB[1][i]); q_[8] = cvtpk(RB[2][i], RB[3][i]); } }
#define MOE_COMPUTE(STG, DO_MFMA) { LAS char* Bs_ = lds + (STG) * MOE_BSTAGE; \
        _Pragma("unroll") for (int u = 0; u < 4; ++u) { \
            bf16x8 bfr[4]; \
            if (DO_MFMA) { _Pragma("unroll") for (int c = 0; c < 4; ++c) bfr[c] = *(LAS bf16x8*)(Bs_ + ((c * 32 + r32) * MOE_BP + hi * 32 + u * 8) * 2); } \
            _Pragma("unroll") for (int a = 0; a < 2; ++a) { \
                if (DO_MFMA) { const bf16x8 af_ = fp8x8_to_bf16(fa8[a][u >> 1][(u & 1) * 2], fa8[a][u >> 1][(u & 1) * 2 + 1]); \
                    _Pragma("unroll") for (int c = 0; c < 4; ++c) acc[a][c] = MFMA_BF16(bfr[c], af_, acc[a][c]); } \
                if (u & 1) fa8[a][u >> 1] = *(const u32x4*)(ab_n + aoff[a] + (u >> 1) * 16); \
            } \
        } }
#define MOE_NEXTA(S_) MOE_DEC(S_) (void)ps_; \
        if (stt_ != st_loaded) { MOE_AOFF(stt_) st_loaded = stt_; } \
        const char* ab_n = (const char*)abase + kt_ * 64;
    int st_loaded = st0;
    MOE_AOFF(st0)
    { const char* ab0 = (const char*)abase;
#pragma unroll
      for (int a = 0; a < 2; ++a)
#pragma unroll
          for (int h2 = 0; h2 < 2; ++h2) fa8[a][h2] = *(const u32x4*)(ab0 + aoff[a] + h2 * 16); }
    MOE_LOADB(0, rb0)
    MOE_LOADB(1, rb1)
    MOE_WRITEB(0, rb0)
    MOE_LOADB(2, rb0)
    int stg = 0;
#pragma unroll 1
    for (int sidx = 0; sidx < nsteps; sidx += 2) {
        const int pl = sidx / (nst * KT); const int rm = sidx - pl * (nst * KT); const int sl = rm / KT; const int kt = rm - sl * KT; const int ps = pass0 + pl, stt = st0 + sl;
        const bool wv = (wave * 64) < (ng - stt * 512);
        const int stg1 = stg == 2 ? 0 : stg + 1, stg2 = stg1 == 2 ? 0 : stg1 + 1;
        __syncthreads();
        MOE_WRITEB(stg1, rb1)
        MOE_LOADB(sidx + 3, rb1)
        { MOE_NEXTA(sidx + 1)
          if (wv) MOE_COMPUTE(stg, true) else MOE_COMPUTE(stg, false) }
        __syncthreads();
        MOE_WRITEB(stg2, rb0)
        MOE_LOADB(sidx + 4, rb0)
        { MOE_NEXTA(sidx + 2)
          if (wv) MOE_COMPUTE(stg1, true) else MOE_COMPUTE(stg1, false) }
        stg = stg2;
        if (kt == KT - 2) {
            if (wv) {
                const int nrows = ng - stt * 512;
#pragma unroll
                for (int a = 0; a < 2; ++a) {
                    if (a == 0 || (wave * 64 + 32) < nrows) {
                        const int lrow = stt * 512 + wave * 64 + a * 32 + r32;
                        const unsigned va = (unsigned)rowva[lrow];
                        if (DOWN) {
                            const float w = roww[lrow];
#pragma unroll
                            for (int c = 0; c < 4; ++c) {
                                float yv_[16];
#pragma unroll
                                for (int j = 0; j < 16; ++j) yv_[j] = acc[a][c][(j >> 2) + 4 * (j & 3)] * w;
                                if (y8) {
                                    u32x4 q8;
#pragma unroll
                                    for (int jj = 0; jj < 4; ++jj) q8[jj] = pack_fp8x4(yv_[4 * jj], yv_[4 * jj + 1], yv_[4 * jj + 2], yv_[4 * jj + 3]);
                                    *(u32x4*)((unsigned char*)outv + (size_t)va * D + ps * 128 + c * 32 + 16 * hi) = q8;
                                } else {
                                    u32x4 q0, q1;
#pragma unroll
                                    for (int jj = 0; jj < 4; ++jj) { q0[jj] = cvtpk(yv_[2 * jj], yv_[2 * jj + 1]); q1[jj] = cvtpk(yv_[8 + 2 * jj], yv_[9 + 2 * jj]); }
                                    u16* o = (u16*)outv + (size_t)va * D + ps * 128 + c * 32 + 16 * hi;
                                    *(u32x4*)o = q0; *(u32x4*)(o + 8) = q1;
                                }
                            }
                        } else {
#pragma unroll
                            for (int c = 0; c < 2; ++c) {
                                float hv[16];
#pragma unroll
                                for (int j = 0; j < 16; ++j) { const int r = (j >> 2) + 4 * (j & 3); const float gt = acc[a][c][r], up = acc[a][c + 2][r]; hv[j] = gt / (1.f + __expf(-gt)) * up; }
                                u32x4 q;
#pragma unroll
                                for (int jj = 0; jj < 4; ++jj) q[jj] = pack_fp8x4(hv[4 * jj], hv[4 * jj + 1], hv[4 * jj + 2], hv[4 * jj + 3]);
                                *(u32x4*)((unsigned char*)outv + (size_t)va * DF + ps * 64 + c * 32 + 16 * hi) = q;
                            }
                        }
                    }
                }
#pragma unroll
                for (int a = 0; a < 2; ++a)
#pragma unroll
                    for (int c = 0; c < 4; ++c)
#pragma unroll
                        for (int r = 0; r < 16; ++r) acc[a][c][r] = 0.f;
            }
        }
    }
    __syncthreads();
#undef MOE_AOFF
#undef MOE_DEC
#undef MOE_LOADB
#undef MOE_WRITEB
#undef MOE_COMPUTE
#undef MOE_NEXTA
}

constexpr int N_PHASES = 21;

#define P_x_in CTX_IN(0)
#define P_xb ((u16*)(ws + WS_XB))
#define P_x1 ((float*)(ws + WS_X1))
#define P_x2 ((float*)(ws + WS_X2))
#define P_ypre ((float*)(ws + WS_YPRE))
#define P_qkv ((u16*)(ws + WS_QKV))
#define P_vT ((u16*)(ws + WS_VT))
#define P_kmean ((float*)(ws + WS_KM))
#define P_ao ((u16*)(ws + WS_AO))
#define P_og ((u16*)(ws + WS_OG))
#define P_lse ((float*)(ws + WS_LSE))
#define P_topw ((float*)(ws + WS_TOPW))
#define P_list ((int*)(ws + WS_LIST))
#define P_hb ((u16*)(ws + WS_HB))
#define P_yb ((u16*)(ws + WS_YB))
#define P_cnt_all ((int*)(ws + WS_CTL + CTL_ECNT_OFF))
#define P_xb8 ((unsigned char*)(ws + WS_XB8))
#define P_hbs ((u16*)(ws + WS_HBS))
#define P_selm ((unsigned*)(ws + WS_SELM))
#define P_part ((u16*)(ws + WS_PART))
#define P_plse ((float*)(ws + WS_PLSE))
#define PH_BEGIN int tid = wave_s_ * 64 + lane_id_(); asm volatile("" : "+v"(tid)); const int lane = tid & 63, r32 = lane & 31, hi = lane >> 5; const int wave = __builtin_amdgcn_readfirstlane(tid >> 6); (void)lane; (void)r32; (void)hi; (void)wave
constexpr int LDS_CTX = LDS_BAR + 16;
__device__ __forceinline__ uint64_t ctx_ld(int i) {
    extern __shared__ __attribute__((aligned(16))) unsigned char lds_raw[];
    const LAS unsigned* q = (const LAS unsigned*)((LAS char*)lds_raw + LDS_CTX) + 2 * i;
    const unsigned lo = __builtin_amdgcn_readfirstlane(q[0]), hi = __builtin_amdgcn_readfirstlane(q[1]);
    return ((uint64_t)hi << 32) | lo;
}
typedef __attribute__((address_space(1))) unsigned char gbyte;
#define AS_GLOBAL(T, u64v) ((T*)(gbyte*)(u64v))
#define CTX_IN(i) AS_GLOBAL(const float, ctx_ld(i))
#define PH_FN_BEGIN \
    extern __shared__ __attribute__((aligned(16))) unsigned char lds_raw[]; \
    LAS char* lds = (LAS char*)lds_raw; (void)lds; \
    const int G = gridDim.x, bid = blockIdx.x; (void)G; (void)bid; \
    unsigned char* const ws = AS_GLOBAL(unsigned char, ctx_ld(17)); (void)ws; \
    const int NQ = L == 0 ? 3072 : 9216; (void)NQ; \
    int* cnt = P_cnt_all + L * NE * CNT_STRIDE; (void)cnt;
__device__ __forceinline__ void ph_p0(int L, int rep_, const int wave_s_) {
    PH_FN_BEGIN
    (void)rep_;
    PH_BEGIN;
    for (size_t i = (size_t)bid * NTHR + tid; i < (size_t)T * D / 4; i += (size_t)G * NTHR) {
        const f32x4 v = *(const f32x4*)(P_x_in + i * 4);
        u32x2 w; w[0] = cvtpk(v[0], v[1]); w[1] = cvtpk(v[2], v[3]);
        *(u32x2*)(P_xb + i * 4) = w;
    }
    LAS float* tl = (LAS float*)lds;
    for (int it = bid; it < 3968 + 128; it += G) {
        int seg, kt;
        if (it < 3840) { seg = it >> 4; kt = it & 15; } else if (it < 3968) { seg = 240 + ((it - 3840) >> 2); kt = (it - 3840) & 3; } else { seg = 272 + ((it - 3968) >> 4); kt = (it - 3968) & 15; }
        const float* src; int ld; u16* dst; int Kd = 1024; u16* dst_lo = nullptr;
        if (seg < 48) { const int col = 64 * seg; src = CTX_IN(1) + col; ld = 3072; dst = (u16*)(ws + WS_WQK0) + (size_t)col * 1024; }
        else if (seg < 192) { const int col = 64 * (seg - 48); src = CTX_IN(2) + col; ld = 9216; dst = (u16*)(ws + WS_WQK1) + (size_t)col * 1024; }
        else if (seg < 224) { const int s2 = seg - 192, l2 = s2 >> 4, col = 64 * (s2 & 15); src = CTX_IN(3) + (size_t)l2 * D * D + col; ld = 1024; dst = (u16*)(ws + WS_WO) + (size_t)l2 * D * D + (size_t)col * 1024; }
        else if (seg < 240) { const int s2 = seg - 224, l2 = s2 >> 3, i8 = s2 & 7, un = i8 >> 2, q = i8 & 3;
            src = (q < 2 ? CTX_IN(11) : CTX_IN(12)) + (size_t)l2 * D * DF + un * 128 + 64 * (q & 1); ld = 256; dst = (u16*)(ws + WS_WSGU) + (size_t)l2 * 512 * 1024 + (size_t)(64 * i8) * 1024; }
        else if (seg < 272) { const int s2 = seg - 240, l2 = s2 >> 4, col = 64 * (s2 & 15); src = CTX_IN(13) + (size_t)l2 * DF * D + col; ld = 1024; Kd = 256; dst = (u16*)(ws + WS_WSD) + (size_t)l2 * D * DF + (size_t)col * 256; }
        else { const int s2 = seg - 272, l2 = s2 >> 2, col = 64 * (s2 & 3); src = CTX_IN(6) + (size_t)l2 * D * NE + col; ld = 256; dst = (u16*)(ws + WS_WRH) + (size_t)l2 * NE * D + (size_t)col * 1024; dst_lo = (u16*)(ws + WS_WRL) + (size_t)l2 * NE * D + (size_t)col * 1024; }
        {
            const int kr = tid >> 4, c4 = tid & 15;
#pragma unroll
            for (int i = 0; i < 2; ++i) {
                const f32x4 v = *(const f32x4*)(src + (size_t)(kt * 64 + kr + 32 * i) * ld + 4 * c4);
#pragma unroll
                for (int jj = 0; jj < 4; ++jj) tl[(kr + 32 * i) * 65 + 4 * c4 + jj] = v[jj];
            }
        }
        __syncthreads();
        {
            const int row = tid >> 3, kc = tid & 7;
            float f[8];
#pragma unroll
            for (int jj = 0; jj < 8; ++jj) f[jj] = tl[(8 * kc + jj) * 65 + row];
            u32x4 w; w[0] = cvtpk(f[0], f[1]); w[1] = cvtpk(f[2], f[3]); w[2] = cvtpk(f[4], f[5]); w[3] = cvtpk(f[6], f[7]);
            *(u32x4*)(dst + (size_t)row * Kd + kt * 64 + 8 * kc) = w;
            if (dst_lo) {
                u32x4 wl;
#pragma unroll
                for (int jj = 0; jj < 4; ++jj) wl[jj] = cvtpk(f[2 * jj] - bf2f(w[jj] & 0xFFFFu), f[2 * jj + 1] - bf2f(w[jj] >> 16));
                *(u32x4*)(dst_lo + (size_t)row * Kd + kt * 64 + 8 * kc) = wl;
            }
        }
        __syncthreads();
    }
}

__device__ __forceinline__ void ph_qkv(int L, int rep_, const int wave_s_) {
    PH_FN_BEGIN
    (void)rep_;
    const pg8::Gemm g{P_xb, (const u16*)(ws + (L == 0 ? WS_WQK0 : WS_WQK1)), T, NQ, D};
    pg8::StaticOrder S; S.init(g.M, g.N, G, bid);
    const EpiQK E{P_qkv, NQ};
    pg8::gemm_phase<EpiQK, pg8::StaticOrder, false>((PG8_LAS unsigned char*)lds, g, S, E, nullptr, wave_s_ * 64 + lane_id_());
}

__device__ __forceinline__ void ph_kmean(int L, int rep_, const int wave_s_) {
    PH_FN_BEGIN
    (void)rep_;
    PH_BEGIN;
    LAS float* red = (LAS float*)lds;
    for (int it = bid; it < BATCH * NH * MOBA_NB; it += G) {
        const int j = it & 31, h = (it >> 5) & 15, b = it >> 9;
        const int kg_ = tid >> 3, ch = tid & 7;
        const u16* kp = P_qkv + (size_t)(b * SEQ + j * MOBA_BLK + kg_) * 3072 + 1024 + h * 64 + ch * 8;
        float sm[8];
#pragma unroll
        for (int e2 = 0; e2 < 8; ++e2) sm[e2] = 0.f;
#pragma unroll
        for (int i = 0; i < 4; ++i) {
            const u32x4 v = *(const u32x4*)(kp + (size_t)(64 * i) * 3072);
#pragma unroll
            for (int e2 = 0; e2 < 4; ++e2) { sm[2 * e2] += bf2f(v[e2] & 0xFFFFu); sm[2 * e2 + 1] += bf2f(v[e2] >> 16); }
        }
#pragma unroll
        for (int e2 = 0; e2 < 8; ++e2) red[kg_ * 65 + ch * 8 + e2] = sm[e2];
        __syncthreads();
        if (tid < 64) {
            float tot = 0.f;
#pragma unroll 8
            for (int q = 0; q < 64; ++q) tot += red[q * 65 + tid];
            P_kmean[(size_t)it * 64 + tid] = tot * (1.f / MOBA_BLK);
        }
        __syncthreads();
    }
}

__device__ __forceinline__ void ph_gate(int L, int rep_, const int wave_s_) {
    PH_FN_BEGIN
    (void)rep_;
    PH_BEGIN;
    for (int it = bid; it < BATCH * NH * MOBA_NB; it += G) {
        const int qb = it & 31, bh = it >> 5, b = bh >> 4, h = bh & 15;
        const int tq = qb * MOBA_BLK + wave * 32 + r32;
        const u16* qrow = P_qkv + (size_t)(b * SEQ + tq) * 3072 + h * 64 + hi * 8;
        bf16x8 qf[4];
#pragma unroll
        for (int d0 = 0; d0 < 4; ++d0) qf[d0] = *(const bf16x8*)(qrow + d0 * 16);
        unsigned selmask = 0u;
        if (qb > 0) {
            const float* km = P_kmean + ((size_t)(b * NH + h) * MOBA_NB + r32) * 64 + hi * 8;
            f32x16 gt;
#pragma unroll
            for (int r = 0; r < 16; ++r) gt[r] = 0.f;
#pragma unroll
            for (int d0 = 0; d0 < 4; ++d0) {
                const f32x4 k0 = *(const f32x4*)(km + d0 * 16), k1 = *(const f32x4*)(km + d0 * 16 + 4);
                union { bf16x8 v; unsigned u[4]; } kf;
                kf.u[0] = cvtpk(k0[0], k0[1]); kf.u[1] = cvtpk(k0[2], k0[3]); kf.u[2] = cvtpk(k1[0], k1[1]); kf.u[3] = cvtpk(k1[2], k1[3]);
                gt = MFMA_BF16(kf.v, qf[d0], gt);
            }
            float v0 = -INFINITY, v1 = -INFINITY, v2 = -INFINITY; int i0 = 99, i1 = 99, i2 = 99;
#pragma unroll
            for (int r = 0; r < 16; ++r) { const int jb = crow(r, hi); const float gv = jb < qb ? gt[r] : -INFINITY; top3_insert(gv, jb < qb ? jb : 99, v0, i0, v1, i1, v2, i2); }
            const float ov0 = shxf(v0, 32, lane), ov1 = shxf(v1, 32, lane), ov2 = shxf(v2, 32, lane);
            const int oi0 = shxi(i0, 32, lane), oi1 = shxi(i1, 32, lane), oi2 = shxi(i2, 32, lane);
            top3_insert(ov0, oi0, v0, i0, v1, i1, v2, i2); top3_insert(ov1, oi1, v0, i0, v1, i1, v2, i2); top3_insert(ov2, oi2, v0, i0, v1, i1, v2, i2);
            if (i0 < 32) selmask |= 1u << i0;
            if (i1 < 32) selmask |= 1u << i1;
            if (i2 < 32) selmask |= 1u << i2;
        }
        if (hi == 0) P_selm[(size_t)bh * SEQ + tq] = selmask;
    }
}

constexpr int MB_KP = 72;
constexpr int MB_VP = 260;
constexpr int MB_LDS_K = 0;
constexpr int MB_LDS_V = 256 * MB_KP * 2;
constexpr int MB_LDS_LIST = MB_LDS_V + 64 * MB_VP * 2;
constexpr int MB_LDS_CTR = MB_LDS_LIST + 8192 * 2;
__device__ __forceinline__ void ph_moba(int L, int rep_, const int wave_s_) {
    PH_FN_BEGIN
    (void)rep_;
    PH_BEGIN;
    LAS char* Ks = lds + MB_LDS_K; LAS char* Vs = lds + MB_LDS_V;
    LAS u16* qlist = (LAS u16*)(lds + MB_LDS_LIST); LAS int* ctr = (LAS int*)(lds + MB_LDS_CTR);
    for (int it = bid; it < BATCH * NH * MOBA_NB; it += G) {
        const int rnd = it >> 8, w8 = it & 255, a8 = w8 >> 5, bh = w8 & 31;
        const int j = rnd == 0 ? a8 : (rnd == 1 ? 15 - a8 : (rnd == 2 ? 16 + a8 : 31 - a8));
        const int b = bh >> 4, h = bh & 15;
        const float slope2 = exp2f(-0.5f * (float)(h + 1)) * LOG2E;
        if (tid == 0) { int z0 = 0; asm volatile("" : "+v"(z0)); ctr[0] = z0; ctr[1] = z0; }
        {
            const u16* kg = P_qkv + (size_t)(b * SEQ + j * MOBA_BLK) * 3072 + 1024 + h * 64;
#pragma unroll
            for (int i = 0; i < 4; ++i) { const int c = tid + i * 512, row = c >> 3, ch = c & 7; *(LAS u32x4*)(Ks + (row * MB_KP + ch * 8) * 2) = *(const u32x4*)(kg + (size_t)row * 3072 + ch * 8); }
            const u16* vg = P_qkv + (size_t)(b * SEQ + j * MOBA_BLK) * 3072 + 2048 + h * 64;
#pragma unroll
            for (int i = 0; i < 4; ++i) {
                const int c = tid + i * 512, key = c >> 3, ch = c & 7;
                const u32x4 v = *(const u32x4*)(vg + (size_t)key * 3072 + ch * 8);
#pragma unroll
                for (int e2 = 0; e2 < 4; ++e2) {
                    *(LAS u16*)(Vs + ((ch * 8 + 2 * e2) * MB_VP + key) * 2) = (u16)(v[e2] & 0xFFFFu);
                    *(LAS u16*)(Vs + ((ch * 8 + 2 * e2 + 1) * MB_VP + key) * 2) = (u16)(v[e2] >> 16);
                }
            }
        }
        __syncthreads();
        {
            const unsigned* sm = P_selm + (size_t)bh * SEQ;
            for (int t0 = (j + 1) * MOBA_BLK; t0 < SEQ; t0 += 512) {
                const int t = t0 + tid;
                const bool sel = (t < SEQ) && ((sm[t < SEQ ? t : 0] >> j) & 1u);
                const unsigned long long bal = __ballot(sel);
                const int total = __popcll(bal);
                int wb = 0;
                if (lane == 0 && total) wb = atomicAdd((int*)&ctr[0], total);
                wb = __builtin_amdgcn_readfirstlane(wb);
                if (sel) qlist[wb + __popcll(bal & ((1ull << lane) - 1ull))] = (u16)t;
            }
        }
        __syncthreads();
        const int nq = ctr[0];
        const int ntiles = 8 + ((nq + 31) >> 5);
        for (;;) {
            int ti = 0;
            if (lane == 0) ti = atomicAdd((int*)&ctr[1], 1);
            ti = __builtin_amdgcn_readfirstlane(ti);
            if (ti >= ntiles) break;
            const bool own = ti < 8;
            const int wq = 7 - ti;
            const int li = (ti - 8) * 32 + r32;
            const bool valid = own || li < nq;
            const int tq = own ? j * MOBA_BLK + wq * 32 + r32 : (int)qlist[li < nq ? li : nq - 1];
            const int nsteps = own ? wq + 1 : 8;
            const u16* qrow = P_qkv + (size_t)(b * SEQ + tq) * 3072 + h * 64 + hi * 8;
            bf16x8 qf[4];
#pragma unroll
            for (int d0 = 0; d0 < 4; ++d0) qf[d0] = *(const bf16x8*)(qrow + d0 * 16);
            int slot = 3;
            if (!own) slot = __popc(P_selm[(size_t)bh * SEQ + tq] & ((1u << j) - 1u));
            AttnSt st; st.m = NEGV; st.l = 0.f;
#pragma unroll
            for (int r = 0; r < 16; ++r) { st.o0[r] = 0.f; st.o1[r] = 0.f; }
            const int dlo = own ? 0 : -0x40000000;
            for (int kt = 0; kt < nsteps; ++kt) {
                AttnFr f;
#pragma unroll
                for (int d0 = 0; d0 < 4; ++d0) f.k[d0] = *(LAS bf16x8*)(Ks + ((kt * 32 + r32) * MB_KP + d0 * 16 + hi * 8) * 2);
#pragma unroll
                for (int q4 = 0; q4 < 4; ++q4) {
                    union { bf16x8 v; u32x2 hh[2]; } va;
                    LAS char* vp = Vs + (((q4 >> 1) * 32 + r32) * MB_VP + kt * 32 + (q4 & 1) * 16 + 4 * hi) * 2;
                    va.hh[0] = *(LAS u32x2*)(vp); va.hh[1] = *(LAS u32x2*)(vp + 16);
                    f.v[q4] = va.v;
                }
                attn_compute(st, qf, f, tq - (j * MOBA_BLK + kt * 32) - 4 * hi, slope2, dlo, 0x7fffffff, hi, lane);
            }
            const float lt = st.l + shxf(st.l, 32, lane);
            const float inv = 1.f / lt;
            if (valid) {
                const size_t pi = ((size_t)(b * SEQ + tq) * NH + h) * 4 + slot;
                u16* orow = P_part + pi * 64;
#pragma unroll
                for (int rq = 0; rq < 4; ++rq) {
                    u32x2 w; w[0] = cvtpk(st.o0[4 * rq] * inv, st.o0[4 * rq + 1] * inv); w[1] = cvtpk(st.o0[4 * rq + 2] * inv, st.o0[4 * rq + 3] * inv);
                    *(u32x2*)(orow + 8 * rq + 4 * hi) = w;
                    w[0] = cvtpk(st.o1[4 * rq] * inv, st.o1[4 * rq + 1] * inv); w[1] = cvtpk(st.o1[4 * rq + 2] * inv, st.o1[4 * rq + 3] * inv);
                    *(u32x2*)(orow + 32 + 8 * rq + 4 * hi) = w;
                }
                if (hi == 0) P_plse[pi] = st.m * LN2 + logf(lt);
            }
        }
        __syncthreads();
    }
}

__device__ __forceinline__ void ph_mobamerge(int L, int rep_, const int wave_s_) {
    PH_FN_BEGIN
    (void)rep_;
    PH_BEGIN;
    for (size_t i = (size_t)bid * NTHR + tid; i < (size_t)T * NH * 8; i += (size_t)G * NTHR) {
        const size_t row = i >> 7; const int h = (int)(i >> 3) & 15, d8 = (int)i & 7;
        const int qb = (int)(row & (SEQ - 1)) >> 8;
        const int nsel = qb < 3 ? qb : 3;
        const size_t pi = (row * NH + h) * 4;
        float l[4], w[4];
        float mx = -INFINITY;
#pragma unroll
        for (int sidx = 0; sidx < 4; ++sidx) { const bool ok = sidx == 3 || sidx < nsel; l[sidx] = ok ? P_plse[pi + sidx] : -INFINITY; mx = fmaxf(mx, l[sidx]); }
        float ws_ = 0.f;
#pragma unroll
        for (int sidx = 0; sidx < 4; ++sidx) { w[sidx] = (sidx == 3 || sidx < nsel) ? expf(l[sidx] - mx) : 0.f; ws_ += w[sidx]; }
        const float inv = 1.f / ws_;
        float acc8[8];
#pragma unroll
        for (int c = 0; c < 8; ++c) acc8[c] = 0.f;
#pragma unroll
        for (int sidx = 0; sidx < 4; ++sidx) {
            if (sidx == 3 || sidx < nsel) {
                const u32x4 a = *(const u32x4*)(P_part + (pi + sidx) * 64 + d8 * 8);
                const float ww = w[sidx] * inv;
#pragma unroll
                for (int c = 0; c < 4; ++c) { acc8[2 * c] += ww * bf2f(a[c] & 0xFFFFu); acc8[2 * c + 1] += ww * bf2f(a[c] >> 16); }
            }
        }
        u32x4 o;
#pragma unroll
        for (int c = 0; c < 4; ++c) o[c] = cvtpk(acc8[2 * c], acc8[2 * c + 1]);
        *(u32x4*)(P_ao + row * D + h * 64 + d8 * 8) = o;
    }
}

constexpr int DL_KP = 72, DL_VP = 388;
constexpr int DL_LDS_K = 0, DL_LDS_V = 384 * DL_KP * 2;
__device__ __forceinline__ void ph_dil(int L, int rep_, const int wave_s_) {
    PH_FN_BEGIN
    (void)rep_;
    PH_BEGIN;
    LAS char* Ks = lds + DL_LDS_K; LAS char* Vs = lds + DL_LDS_V;
    for (int it = bid; it < BATCH * NH * 3 * 32; it += G) {
        const int ch = it & 31, grp = (it >> 5) % 3, bh = it / 96, b = bh >> 4, h = bh & 15;
        const int dil = grp == 0 ? 1 : (grp == 1 ? 4 : 16), Ls = SEQ / dil;
        const float slope2 = exp2f(-0.5f * (float)(h + 1)) * LOG2E * (float)dil;
        const int uc = ch * 256, res = uc / Ls, c0 = uc - res * Ls;
        const int kb0 = c0 - 128;
        {
            const u16* kg = P_qkv + (size_t)(b * SEQ) * 9216 + grp * 3072 + 1024 + h * 64;
#pragma unroll
            for (int i = 0; i < 6; ++i) {
                const int c = tid + i * 512, row = c >> 3, chk = c & 7, ks = kb0 + row;
                if (ks >= 0) *(LAS u32x4*)(Ks + (row * DL_KP + chk * 8) * 2) = *(const u32x4*)(kg + (size_t)(ks * dil + res) * 9216 + chk * 8);
            }
            const u16* vg = P_qkv + (size_t)(b * SEQ) * 9216 + grp * 3072 + 2048 + h * 64;
#pragma unroll
            for (int i = 0; i < 6; ++i) {
                const int c = tid + i * 512, row = c >> 3, chk = c & 7, ks = kb0 + row;
                if (ks >= 0) {
                    const u32x4 v = *(const u32x4*)(vg + (size_t)(ks * dil + res) * 9216 + chk * 8);
#pragma unroll
                    for (int e2 = 0; e2 < 4; ++e2) {
                        *(LAS u16*)(Vs + ((chk * 8 + 2 * e2) * DL_VP + row) * 2) = (u16)(v[e2] & 0xFFFFu);
                        *(LAS u16*)(Vs + ((chk * 8 + 2 * e2 + 1) * DL_VP + row) * 2) = (u16)(v[e2] >> 16);
                    }
                }
            }
        }
        const int i0 = c0 + wave * 32, iq = i0 + r32, pq = iq * dil + res;
        const u16* qrow = P_qkv + (size_t)(b * SEQ + pq) * 9216 + grp * 3072 + h * 64 + hi * 8;
        bf16x8 qf[4];
#pragma unroll
        for (int d0 = 0; d0 < 4; ++d0) qf[d0] = *(const bf16x8*)(qrow + d0 * 16);
        __syncthreads();
        AttnSt st; st.m = NEGV; st.l = 0.f;
#pragma unroll
        for (int r = 0; r < 16; ++r) { st.o0[r] = 0.f; st.o1[r] = 0.f; }
        const int ktmin = (i0 >= 128) ? 0 : (128 - i0) >> 5;
        for (int kt = 4; kt >= ktmin; --kt) {
            const int lrow0 = (wave + kt) * 32;
            AttnFr f;
#pragma unroll
            for (int d0 = 0; d0 < 4; ++d0) f.k[d0] = *(LAS bf16x8*)(Ks + ((lrow0 + r32) * DL_KP + d0 * 16 + hi * 8) * 2);
#pragma unroll
            for (int q4 = 0; q4 < 4; ++q4) {
                union { bf16x8 v; u32x2 hh[2]; } va;
                LAS char* vp = Vs + (((q4 >> 1) * 32 + r32) * DL_VP + lrow0 + (q4 & 1) * 16 + 4 * hi) * 2;
                va.hh[0] = *(LAS u32x2*)(vp); va.hh[1] = *(LAS u32x2*)(vp + 16);
                f.v[q4] = va.v;
            }
            const int k0 = i0 - 128 + kt * 32;
            attn_compute(st, qf, f, iq - k0 - 4 * hi, slope2, 0, 128, hi, lane);
        }
        const float lt = st.l + shxf(st.l, 32, lane);
        const float inv = 1.f / lt;
        u16* orow = P_og + (size_t)grp * T * D + (size_t)(b * SEQ + pq) * D + h * 64;
#pragma unroll
        for (int rq = 0; rq < 4; ++rq) {
            u32x2 w; w[0] = cvtpk(st.o0[4 * rq] * inv, st.o0[4 * rq + 1] * inv); w[1] = cvtpk(st.o0[4 * rq + 2] * inv, st.o0[4 * rq + 3] * inv);
            *(u32x2*)(orow + 8 * rq + 4 * hi) = w;
            w[0] = cvtpk(st.o1[4 * rq] * inv, st.o1[4 * rq + 1] * inv); w[1] = cvtpk(st.o1[4 * rq + 2] * inv, st.o1[4 * rq + 3] * inv);
            *(u32x2*)(orow + 32 + 8 * rq + 4 * hi) = w;
        }
        if (hi == 0) P_lse[((size_t)grp * T + (b * SEQ + pq)) * NH + h] = st.m * LN2 + logf(lt);
        __syncthreads();
    }
}

__device__ __forceinline__ void ph_merge(int L, int rep_, const int wave_s_) {
    PH_FN_BEGIN
    (void)rep_;

            PH_BEGIN;
                for (size_t i = (size_t)bid * NTHR + tid; i < (size_t)T * NH * 8; i += (size_t)G * NTHR) {
                    const size_t row = i >> 7; const int h = (int)(i >> 3) & 15, d8 = (int)i & 7;
                    const float l0 = P_lse[(0 * (size_t)T + row) * NH + h], l1 = P_lse[(1 * (size_t)T + row) * NH + h], l2 = P_lse[(2 * (size_t)T + row) * NH + h];
                    const float mx = fmaxf(l0, fmaxf(l1, l2));
                    float w0 = expf(l0 - mx), w1 = expf(l1 - mx), w2 = expf(l2 - mx);
                    const float inv = 1.f / (w0 + w1 + w2); w0 *= inv; w1 *= inv; w2 *= inv;
                    const size_t off = row * D + h * 64 + d8 * 8;
                    const u32x4 a0 = *(const u32x4*)(P_og + off), a1 = *(const u32x4*)(P_og + (size_t)T * D + off), a2 = *(const u32x4*)(P_og + 2 * (size_t)T * D + off);
                    u32x4 o;
#pragma unroll
                    for (int c = 0; c < 4; ++c) {
                        const float lo_ = w0 * bf2f(a0[c] & 0xFFFFu) + w1 * bf2f(a1[c] & 0xFFFFu) + w2 * bf2f(a2[c] & 0xFFFFu);
                        const float hi_ = w0 * bf2f(a0[c] >> 16) + w1 * bf2f(a1[c] >> 16) + w2 * bf2f(a2[c] >> 16);
                        o[c] = cvtpk(lo_, hi_);
                    }
                    *(u32x4*)(P_ao + off) = o;
                }

}

__device__ __forceinline__ void ph_wo(int L, int rep_, const int wave_s_) {
    PH_FN_BEGIN
    (void)rep_;
    const pg8::Gemm g{P_ao, (const u16*)(ws + WS_WO) + (size_t)L * D * D, T, D, D};
    pg8::StaticOrder S; S.init(g.M, g.N, G, bid);
    const EpiWo E{P_ypre, L == 0 ? CTX_IN(0) : (const float*)P_x2};
    pg8::gemm_phase<EpiWo, pg8::StaticOrder, false>((PG8_LAS unsigned char*)lds, g, S, E, nullptr, wave_s_ * 64 + lane_id_());
}

constexpr int RT_P = 144;
constexpr int RT_LDS_AH = 0, RT_LDS_AL = 64 * RT_P;
constexpr int RT_LDS_BH = 2 * 64 * RT_P, RT_LDS_BL = RT_LDS_BH + 256 * RT_P;
constexpr int RT_LDS_ST = RT_LDS_BL + 256 * RT_P;
__device__ __forceinline__ void ph_router(int L, int rep_, const int wave_s_) {
    PH_FN_BEGIN
    (void)rep_;
    PH_BEGIN;
    const float* lng = CTX_IN(4) + L * D; const float* lnb = CTX_IN(5) + L * D;
    const float* rbias = CTX_IN(7) + L * NE;
    const u16* wrh = (const u16*)(ws + WS_WRH) + (size_t)L * NE * D; const u16* wrl = (const u16*)(ws + WS_WRL) + (size_t)L * NE * D;
    LAS float* stat = (LAS float*)(lds + RT_LDS_ST);
    for (int it = bid; it < T / 64; it += G) {
#pragma unroll 1
        for (int hb_ = 0; hb_ < 2; ++hb_) {
            f32x4 yv[4][4];
#pragma unroll
            for (int rr = 0; rr < 4; ++rr)
#pragma unroll
                for (int j = 0; j < 4; ++j) yv[rr][j] = *(const f32x4*)(P_ypre + ((size_t)it * 64 + wave * 8 + hb_ * 4 + rr) * D + j * 256 + lane * 4);
#pragma unroll
            for (int rr = 0; rr < 4; ++rr) {
                float sm = 0.f;
#pragma unroll
                for (int j = 0; j < 4; ++j) sm += (yv[rr][j][0] + yv[rr][j][1]) + (yv[rr][j][2] + yv[rr][j][3]);
                const float mu = wave_sum(sm) * (1.f / D);
                float q = 0.f;
#pragma unroll
                for (int j = 0; j < 4; ++j)
#pragma unroll
                    for (int c = 0; c < 4; ++c) { const float d_ = yv[rr][j][c] - mu; q += d_ * d_; }
                const float rstd = rsqrtf(wave_sum(q) * (1.f / D) + LN_EPS);
                if (lane == 0) { stat[wave * 8 + hb_ * 4 + rr] = mu; stat[64 + wave * 8 + hb_ * 4 + rr] = rstd; }
            }
        }
        __syncthreads();
        const int arow = tid >> 3, aq = tid & 7;
        const float amu = stat[arow], ars = stat[64 + arow];
        const float* yp = P_ypre + ((size_t)it * 64 + arow) * D + aq * 8;
        f32x4 ya0 = *(const f32x4*)(yp), ya1 = *(const f32x4*)(yp + 4);
        u32x4 bw[8];
#pragma unroll
        for (int i = 0; i < 8; ++i) { const int p_ = tid + 512 * (i & 3); bw[i] = *(const u32x4*)((i < 4 ? wrh : wrl) + (size_t)(p_ >> 3) * D + (p_ & 7) * 8); }
        f32x16 lg[2];
#pragma unroll
        for (int r = 0; r < 16; ++r) { lg[0][r] = 0.f; lg[1][r] = 0.f; }
#pragma unroll 1
        for (int kc = 0; kc < 16; ++kc) {
            const int k0 = kc * 64;
            {
                const f32x4 g0 = *(const f32x4*)(lng + k0 + aq * 8), g1 = *(const f32x4*)(lng + k0 + aq * 8 + 4);
                const f32x4 b0 = *(const f32x4*)(lnb + k0 + aq * 8), b1 = *(const f32x4*)(lnb + k0 + aq * 8 + 4);
                f32x4 x0, x1v;
#pragma unroll
                for (int c = 0; c < 4; ++c) { x0[c] = (ya0[c] - amu) * ars * g0[c] + b0[c]; x1v[c] = (ya1[c] - amu) * ars * g1[c] + b1[c]; }
                const size_t go = ((size_t)it * 64 + arow) * D + k0 + aq * 8;
                *(f32x4*)(P_x1 + go) = x0; *(f32x4*)(P_x1 + go + 4) = x1v;
                u32x4 wh; wh[0] = cvtpk(x0[0], x0[1]); wh[1] = cvtpk(x0[2], x0[3]); wh[2] = cvtpk(x1v[0], x1v[1]); wh[3] = cvtpk(x1v[2], x1v[3]);
                *(u32x4*)(P_xb + go) = wh;
                u32x2 w8; w8[0] = pack_fp8x4(x0[0], x0[1], x0[2], x0[3]); w8[1] = pack_fp8x4(x1v[0], x1v[1], x1v[2], x1v[3]);
                *(u32x2*)(P_xb8 + go) = w8;
                u32x4 wl;
                wl[0] = cvtpk(x0[0] - bf2f(wh[0] & 0xFFFFu), x0[1] - bf2f(wh[0] >> 16)); wl[1] = cvtpk(x0[2] - bf2f(wh[1] & 0xFFFFu), x0[3] - bf2f(wh[1] >> 16));
                wl[2] = cvtpk(x1v[0] - bf2f(wh[2] & 0xFFFFu), x1v[1] - bf2f(wh[2] >> 16)); wl[3] = cvtpk(x1v[2] - bf2f(wh[3] & 0xFFFFu), x1v[3] - bf2f(wh[3] >> 16));
                *(LAS u32x4*)(lds + RT_LDS_AH + arow * RT_P + aq * 16) = wh;
                *(LAS u32x4*)(lds + RT_LDS_AL + arow * RT_P + aq * 16) = wl;
#pragma unroll
                for (int i = 0; i < 8; ++i) { const int p_ = tid + 512 * (i & 3); *(LAS u32x4*)(lds + (i < 4 ? RT_LDS_BH : RT_LDS_BL) + (p_ >> 3) * RT_P + (p_ & 7) * 16) = bw[i]; }
            }
            __syncthreads();
            {
                const int kn = (kc + 1 < 16) ? k0 + 64 : 0;
                ya0 = *(const f32x4*)(yp + kn); ya1 = *(const f32x4*)(yp + kn + 4);
#pragma unroll
                for (int i = 0; i < 8; ++i) { const int p_ = tid + 512 * (i & 3); bw[i] = *(const u32x4*)((i < 4 ? wrh : wrl) + (size_t)(p_ >> 3) * D + kn + (p_ & 7) * 8); }
            }
#pragma unroll
            for (int sk = 0; sk < 4; ++sk) {
                const int ko = (sk * 16 + hi * 8) * 2;
                const bf16x8 bh_ = *(const LAS bf16x8*)(lds + RT_LDS_BH + (wave * 32 + r32) * RT_P + ko), bl_ = *(const LAS bf16x8*)(lds + RT_LDS_BL + (wave * 32 + r32) * RT_P + ko);
#pragma unroll
                for (int rb = 0; rb < 2; ++rb) {
                    const bf16x8 xh = *(const LAS bf16x8*)(lds + RT_LDS_AH + (rb * 32 + r32) * RT_P + ko), xl = *(const LAS bf16x8*)(lds + RT_LDS_AL + (rb * 32 + r32) * RT_P + ko);
                    lg[rb] = MFMA_BF16(xh, bh_, lg[rb]); lg[rb] = MFMA_BF16(xl, bh_, lg[rb]); lg[rb] = MFMA_BF16(xh, bl_, lg[rb]);
                }
            }
            __syncthreads();
        }
        LAS float* lgs = (LAS float*)lds;
#pragma unroll
        for (int rb = 0; rb < 2; ++rb)
#pragma unroll
            for (int r = 0; r < 16; ++r) lgs[(rb * 32 + crow(r, hi)) * 257 + wave * 32 + r32] = lg[rb][r];
        __syncthreads();
#pragma unroll 1
        for (int tg = 0; tg < 2; ++tg) {
            float sc[4][4], cv[4][4];
#pragma unroll
            for (int tt = 0; tt < 4; ++tt) {
                const int lr = wave * 8 + tg * 4 + tt;
#pragma unroll
                for (int j = 0; j < 4; ++j) { const int e = lane + 64 * j; sc[tt][j] = 1.f / (1.f + __expf(-lgs[lr * 257 + e])); cv[tt][j] = sc[tt][j] + rbias[e]; }
            }
            float gsel[4][8];
#pragma unroll
            for (int j = 0; j < 4; ++j) {
#pragma unroll
                for (int tt = 0; tt < 4; ++tt) {
                    const float rm = dpp_rowmax(cv[tt][j]);
                    const float m1a = fmaxf(rl_f(rm, 0), rl_f(rm, 16)), m1b = fmaxf(rl_f(rm, 32), rl_f(rm, 48));
                    const unsigned long long bal = __ballot(cv[tt][j] == (hi ? m1b : m1a));
                    const int fa_ = __builtin_ctz((unsigned)(bal & 0xFFFFFFFFull)), fb_ = 32 + __builtin_ctz((unsigned)(bal >> 32));
                    const float c2 = (lane == fa_ || lane == fb_) ? -INFINITY : cv[tt][j];
                    const float rm2 = dpp_rowmax(c2);
                    gsel[tt][2 * j] = m1a + fmaxf(rl_f(rm2, 0), rl_f(rm2, 16));
                    gsel[tt][2 * j + 1] = m1b + fmaxf(rl_f(rm2, 32), rl_f(rm2, 48));
                }
            }
#pragma unroll
            for (int tt = 0; tt < 4; ++tt)
#pragma unroll
                for (int j = 0; j < 4; ++j) {
                    int ra_ = 0, rb_ = 0;
#pragma unroll
                    for (int g2 = 0; g2 < 8; ++g2) {
                        ra_ += ((gsel[tt][g2] > gsel[tt][2 * j]) || (gsel[tt][g2] == gsel[tt][2 * j] && g2 < 2 * j)) ? 1 : 0;
                        rb_ += ((gsel[tt][g2] > gsel[tt][2 * j + 1]) || (gsel[tt][g2] == gsel[tt][2 * j + 1] && g2 < 2 * j + 1)) ? 1 : 0;
                    }
                    cv[tt][j] = ((hi ? rb_ : ra_) < 4) ? cv[tt][j] : NEGV;
                }
            float wsel[4], wsum[4]; int esel[4];
#pragma unroll
            for (int tt = 0; tt < 4; ++tt) { wsel[tt] = 0.f; wsum[tt] = 0.f; esel[tt] = 0; }
#pragma unroll 1
            for (int k = 0; k < TOPK; ++k) {
#pragma unroll
                for (int tt = 0; tt < 4; ++tt) {
                    float bv = cv[tt][0]; int be = lane;
#pragma unroll
                    for (int j = 1; j < 4; ++j) if (cv[tt][j] > bv) { bv = cv[tt][j]; be = lane + 64 * j; }
                    const float rm = dpp_rowmax(bv);
                    const float mval = fmaxf(fmaxf(rl_f(rm, 0), rl_f(rm, 16)), fmaxf(rl_f(rm, 32), rl_f(rm, 48)));
                    const int ri = dpp_rowmin_i(bv == mval ? be : 0x7fffffff);
                    const int e = min(min(__builtin_amdgcn_readlane(ri, 0), __builtin_amdgcn_readlane(ri, 16)), min(__builtin_amdgcn_readlane(ri, 32), __builtin_amdgcn_readlane(ri, 48)));
                    const int jl = e >> 6, ll = e & 63;
                    const float smine = ((jl == 0 ? sc[tt][0] : 0.f) + (jl == 1 ? sc[tt][1] : 0.f)) + ((jl == 2 ? sc[tt][2] : 0.f) + (jl == 3 ? sc[tt][3] : 0.f));
                    const float sw = rl_f(smine, ll);
#pragma unroll
                    for (int j = 0; j < 4; ++j) cv[tt][j] = (lane == ll && jl == j) ? -INFINITY : cv[tt][j];
                    wsum[tt] += sw;
                    if (lane == k) { wsel[tt] = sw; esel[tt] = e; }
                }
            }
#pragma unroll
            for (int tt = 0; tt < 4; ++tt) {
                if (lane < TOPK) {
                    const int tok = it * 64 + wave * 8 + tg * 4 + tt;
                    const int a = tok * TOPK + lane;
                    P_topw[a] = wsel[tt] / wsum[tt] * 2.5f;
                    if (rep_ == 0) {
                        const int pos = atomicAdd(&cnt[esel[tt] * CNT_STRIDE], 1);
                        P_list[(size_t)esel[tt] * T + pos] = a;
                    }
                }
            }
        }
        __syncthreads();
    }
}

__device__ __forceinline__ void ph_gateup(int L, int rep_, const int wave_s_) {
    PH_FN_BEGIN
    (void)rep_;
    {
        PH_BEGIN;
        const float* weg = CTX_IN(8) + (size_t)L * NE * D * DF; const float* weu = CTX_IN(9) + (size_t)L * NE * D * DF;
        LAS int* rowva = (LAS int*)(lds + MOE_LDS_VA);
        {
            int* octr = (int*)(ws + WS_CTL + CTL_CNT_OFF + 8192) + (L * 4 + 2 * (rep_ & 1)) * 64;
            LAS int* slot = (LAS int*)(lds + 140000);
            for (;;) {
                __syncthreads();
                if (tid == 0) { int q; do { q = atomicAdd(octr, 1); } while (q >= NE && q < NE * 5 && cnt[((q - NE) >> 2) * CNT_STRIDE] <= 512); *slot = q; }
                __syncthreads();
                const int q = *slot;
                if (q >= NE * 5) break;
                const bool ovf = q >= NE;
                const int e = ovf ? (q - NE) >> 2 : q, pz = ovf ? (q - NE) & 3 : 0, npz = ovf ? 1 : 4, st0 = ovf ? 1 : 0, n = cnt[e * CNT_STRIDE];
                for (int r0 = 0; r0 < n; r0 += 1024) {
                    if (ovf && n - r0 <= 512) break;
#pragma unroll
                    for (int i = 0; i < 2; ++i) { int t_ = tid; asm volatile("" : "+v"(t_)); const int idx = r0 + i * 512 + t_; rowva[i * 512 + t_] = idx < n ? P_list[(size_t)e * T + idx] : TRASH_VA; }
                    __syncthreads();
                    moe_expert<false>(lds, tid, lane, wave, r32, hi, P_xb8, weg + (size_t)e * D * DF, weu + (size_t)e * D * DF, (n - r0) < 1024 ? (n - r0) : 1024, (void*)P_hb, pz, npz, st0, 1);
                }
            }
        }
    }
    {
        PH_BEGIN;
        const pg8::Gemm g{P_xb, (const u16*)(ws + WS_WSGU) + (size_t)L * 512 * 1024, T, 512, D};
        const EpiSGU E{P_hbs};
        int* qctr = (int*)(ws + WS_CTL + CTL_CNT_OFF + 4096) + (L * 4 + 2 * (rep_ & 1)) * 64;
        LAS int* slot = (LAS int*)(lds + 140000);
        for (;;) {
            __syncthreads();
            if (tid == 0) *slot = atomicAdd(qctr, 1);
            __syncthreads();
            const int un = *slot;
            if (un >= 128) break;
            const pg8::FixedOrder S{un & 63, un >> 6};
            pg8::gemm_phase<EpiSGU, pg8::FixedOrder, false>((PG8_LAS unsigned char*)lds, g, S, E, nullptr, wave_s_ * 64 + lane_id_());
        }
    }
}

__device__ __forceinline__ void ph_down(int L, int rep_, const int wave_s_) {
    PH_FN_BEGIN
    (void)rep_;
    {
        PH_BEGIN;
        const float* wed = CTX_IN(10) + (size_t)L * NE * DF * D;
        LAS int* rowva = (LAS int*)(lds + MOE_LDS_VA); LAS float* roww = (LAS float*)(lds + MOE_LDS_W);
        {
            int* octr = (int*)(ws + WS_CTL + CTL_CNT_OFF + 8192) + (L * 4 + 1 + 2 * (rep_ & 1)) * 64;
            LAS int* slot = (LAS int*)(lds + 140000);
            for (;;) {
                __syncthreads();
                if (tid == 0) { int q; do { q = atomicAdd(octr, 1); } while (q >= NE && q < NE * 5 && cnt[((q - NE) >> 2) * CNT_STRIDE] <= 512); *slot = q; }
                __syncthreads();
                const int q = *slot;
                if (q >= NE * 5) break;
                const bool ovf = q >= NE;
                const int e = ovf ? (q - NE) >> 2 : q, pz = ovf ? ((q - NE) & 3) * 2 : 0, npz = ovf ? 2 : 8, st0 = ovf ? 1 : 0, n = cnt[e * CNT_STRIDE];
                for (int r0 = 0; r0 < n; r0 += 1024) {
                    if (ovf && n - r0 <= 512) break;
#pragma unroll
                    for (int i = 0; i < 2; ++i) { int t_ = tid; asm volatile("" : "+v"(t_)); const int idx = r0 + i * 512 + t_; const int va = idx < n ? P_list[(size_t)e * T + idx] : TRASH_VA; rowva[i * 512 + t_] = va; roww[i * 512 + t_] = va < A_TOT ? P_topw[va] : 0.f; }
                    __syncthreads();
                    moe_expert<true>(lds, tid, lane, wave, r32, hi, (const unsigned char*)P_hb, wed + (size_t)e * DF * D, nullptr, (n - r0) < 1024 ? (n - r0) : 1024, (void*)P_yb, pz, npz, st0, 1, L == 1);
                }
            }
        }
    }
    {
        PH_BEGIN;
        const pg8::Gemm g{P_hbs, (const u16*)(ws + WS_WSD) + (size_t)L * D * DF, T, D, DF};
        const EpiSD E{P_yb};
        int* qctr = (int*)(ws + WS_CTL + CTL_CNT_OFF + 4096) + (L * 4 + 1 + 2 * (rep_ & 1)) * 64;
        LAS int* slot = (LAS int*)(lds + 140000);
        for (;;) {
            __syncthreads();
            if (tid == 0) *slot = atomicAdd(qctr, 1);
            __syncthreads();
            const int un = *slot;
            if (un >= 256) break;
            const pg8::FixedOrder S{un & 63, un >> 6};
            pg8::gemm_phase<EpiSD, pg8::FixedOrder, false>((PG8_LAS unsigned char*)lds, g, S, E, nullptr, wave_s_ * 64 + lane_id_());
        }
    }
}

__device__ __forceinline__ void ph_combine(int L, int rep_, const int wave_s_) {
    PH_FN_BEGIN
    (void)rep_;
    PH_BEGIN;
    const float* lng = CTX_IN(14) + L * D; const float* lnb = CTX_IN(15) + L * D;
    float* dst = L == 0 ? P_x2 : AS_GLOBAL(float, ctx_ld(16));
    for (int row = bid * 8 + wave; row < T; row += G * 8) {
        u32x4 yv[TOPK + 1][2];
#pragma unroll
        for (int k = 0; k < TOPK + 1; ++k) {
            const size_t va = k < TOPK ? (size_t)row * TOPK + k : (size_t)A_TOT + row;
            if (L == 1 && k < TOPK) {
#pragma unroll
                for (int j = 0; j < 2; ++j) { const u32x2 w8 = *(const u32x2*)((const unsigned char*)P_yb + va * D + j * 512 + lane * 8); yv[k][j][0] = w8[0]; yv[k][j][1] = w8[1]; yv[k][j][2] = 0u; yv[k][j][3] = 0u; }
            } else {
#pragma unroll
                for (int j = 0; j < 2; ++j) yv[k][j] = *(const u32x4*)(P_yb + va * D + j * 512 + lane * 8);
            }
        }
        float v[16];
#pragma unroll
        for (int j = 0; j < 2; ++j) {
            const f32x4 t0 = *(const f32x4*)(P_x1 + (size_t)row * D + j * 512 + lane * 8), t1 = *(const f32x4*)(P_x1 + (size_t)row * D + j * 512 + lane * 8 + 4);
#pragma unroll
            for (int c = 0; c < 4; ++c) { v[j * 8 + c] = DN_ALPHA * t0[c]; v[j * 8 + 4 + c] = DN_ALPHA * t1[c]; }
        }
#pragma unroll
        for (int k = 0; k < TOPK + 1; ++k)
#pragma unroll
            for (int j = 0; j < 2; ++j) {
                if (L == 1 && k < TOPK) {
#pragma unroll
                    for (int c = 0; c < 2; ++c) {
                        const f32x2_ lo2 = __builtin_amdgcn_cvt_pk_f32_fp8((int)yv[k][j][c], false), hi2 = __builtin_amdgcn_cvt_pk_f32_fp8((int)yv[k][j][c], true);
                        v[j * 8 + 4 * c] += lo2[0]; v[j * 8 + 4 * c + 1] += lo2[1]; v[j * 8 + 4 * c + 2] += hi2[0]; v[j * 8 + 4 * c + 3] += hi2[1];
                    }
                } else {
#pragma unroll
                    for (int c = 0; c < 4; ++c) { v[j * 8 + 2 * c] += bf2f(yv[k][j][c] & 0xFFFFu); v[j * 8 + 2 * c + 1] += bf2f(yv[k][j][c] >> 16); }
                }
            }
        float sm = 0.f;
#pragma unroll
        for (int i = 0; i < 16; ++i) sm += v[i];
        const float mu = wave_sum(sm) * (1.f / D);
        float q = 0.f;
#pragma unroll
        for (int i = 0; i < 16; ++i) { const float d = v[i] - mu; q += d * d; }
        const float rstd = rsqrtf(wave_sum(q) * (1.f / D) + LN_EPS);
#pragma unroll
        for (int j = 0; j < 2; ++j) {
            const f32x4 g0 = *(const f32x4*)(lng + j * 512 + lane * 8), g1 = *(const f32x4*)(lng + j * 512 + lane * 8 + 4);
            const f32x4 b0 = *(const f32x4*)(lnb + j * 512 + lane * 8), b1 = *(const f32x4*)(lnb + j * 512 + lane * 8 + 4);
            f32x4 o0, o1;
#pragma unroll
            for (int c = 0; c < 4; ++c) { o0[c] = (v[j * 8 + c] - mu) * rstd * g0[c] + b0[c]; o1[c] = (v[j * 8 + 4 + c] - mu) * rstd * g1[c] + b1[c]; }
            *(f32x4*)(dst + (size_t)row * D + j * 512 + lane * 8) = o0; *(f32x4*)(dst + (size_t)row * D + j * 512 + lane * 8 + 4) = o1;
            if (L == 0) { u32x4 w; w[0] = cvtpk(o0[0], o0[1]); w[1] = cvtpk(o0[2], o0[3]); w[2] = cvtpk(o1[0], o1[1]); w[3] = cvtpk(o1[2], o1[3]); *(u32x4*)(P_xb + (size_t)row * D + j * 512 + lane * 8) = w; }
        }
    }
}

__global__ void __launch_bounds__(NTHR, 2) fwd(Args args) {
    extern __shared__ __attribute__((aligned(16))) unsigned char lds_raw[];
    LAS char* lds = (LAS char*)lds_raw;
    unsigned char* const ws = args.ws;
    const int lo = args.ph_lo, hi_ph = args.ph_hi;
    const int wave_s_ = __builtin_amdgcn_readfirstlane(threadIdx.x >> 6);
    if (threadIdx.x < 18) {
        const uint64_t v = threadIdx.x < 16 ? (uint64_t)args.in[threadIdx.x] : (threadIdx.x == 16 ? (uint64_t)args.out : (uint64_t)args.ws);
        ((LAS uint64_t*)(lds + LDS_CTX))[threadIdx.x] = v;
    }
    __syncthreads();
#define IN(k) (lo <= (k) && (k) < hi_ph)

#if MK_ONE_LAUNCH
    if (threadIdx.x < 4) ((LAS unsigned*)(lds + LDS_BAR))[threadIdx.x] = 0u;
    __syncthreads();
    XcdBarrier bar = xcd_barrier_post((unsigned*)(ws + WS_CTL), (volatile LAS unsigned*)(lds + LDS_BAR), wave_s_ == 0 && lane_id_() == 0);
#define GRID_BAR() xcd_barrier(bar, wave_s_ == 0 && lane_id_() == 0)
#else
#define GRID_BAR() do { } while (0)
#endif
#define SEAM(k) do { if (IN(k) && IN((k) + 1)) GRID_BAR(); } while (0)

    for (int rep_ = 0; rep_ < ((IN(0) && PHK(0)) ? REPS(0) : 0); ++rep_) { ph_p0(0, rep_, wave_s_); }
    SEAM(0);

    for (int L = 0; L < 2; ++L) {
        const int pb = 1 + 10 * L;
        for (int rep_ = 0; rep_ < ((IN(pb + 0) && PHK(1)) ? REPS(1) : 0); ++rep_) { ph_qkv(L, rep_, wave_s_); }
        SEAM(pb + 0);

        if (L == 0) {
            for (int rep_ = 0; rep_ < ((IN(pb + 1) && PHK(2)) ? REPS(2) : 0); ++rep_) { ph_kmean(L, rep_, wave_s_); }
            SEAM(pb + 1);
            for (int rep_ = 0; rep_ < ((IN(pb + 2) && PHK(11)) ? REPS(11) : 0); ++rep_) { ph_gate(L, rep_, wave_s_); }
            SEAM(pb + 2);
        }

        if (L == 0) {
            for (int rep_ = 0; rep_ < ((IN(pb + 3) && PHK(3)) ? REPS(3) : 0); ++rep_) { ph_moba(L, rep_, wave_s_); }
            SEAM(pb + 3);
            for (int rep_ = 0; rep_ < ((IN(pb + 4) && PHK(12)) ? REPS(12) : 0); ++rep_) { ph_mobamerge(L, rep_, wave_s_); }
        } else {
            for (int rep_ = 0; rep_ < ((IN(pb + 3) && PHK(4)) ? REPS(4) : 0); ++rep_) { ph_dil(L, rep_, wave_s_); }
            SEAM(pb + 3);
            for (int rep_ = 0; rep_ < ((IN(pb + 4) && PHK(5)) ? REPS(5) : 0); ++rep_) { ph_merge(L, rep_, wave_s_); }
        }
        SEAM(pb + 4);

        for (int rep_ = 0; rep_ < ((IN(pb + 5) && PHK(6)) ? REPS(6) : 0); ++rep_) { ph_wo(L, rep_, wave_s_); }
        SEAM(pb + 5);

        for (int rep_ = 0; rep_ < ((IN(pb + 6) && PHK(7)) ? REPS(7) : 0); ++rep_) { ph_router(L, rep_, wave_s_); }
        SEAM(pb + 6);

        for (int rep_ = 0; rep_ < ((IN(pb + 7) && PHK(8)) ? REPS(8) : 0); ++rep_) { ph_gateup(L, rep_, wave_s_); }
        SEAM(pb + 7);

        for (int rep_ = 0; rep_ < ((IN(pb + 8) && PHK(9)) ? REPS(9) : 0); ++rep_) { ph_down(L, rep_, wave_s_); }
        SEAM(pb + 8);

        for (int rep_ = 0; rep_ < ((IN(pb + 9) && PHK(10)) ? REPS(10) : 0); ++rep_) { ph_combine(L, rep_, wave_s_); }
        if (L == 0) SEAM(pb + 9);
    }
}

extern "C" void kernel_launch(void* const* d_in, const int* in_sizes, int n_in, void* d_out, int out_size, void* d_ws, size_t ws_size, hipStream_t stream) {
    static int grid = 0;
    if (grid == 0) {
        if (n_in != 16 || out_size != T * D || ws_size < WS_END2) { fprintf(stderr, "kernel_launch: unexpected problem (n_in %d out %d ws %zu need %zu)\n", n_in, out_size, ws_size, (size_t)WS_END2); grid = -1; return; }
        int dev = 0, cus = 0, per_cu = 0;
        if (hipGetDevice(&dev) != hipSuccess || hipDeviceGetAttribute(&cus, hipDeviceAttributeMultiprocessorCount, dev) != hipSuccess) { grid = -1; return; }
        if (hipFuncSetAttribute((const void*)fwd, hipFuncAttributeMaxDynamicSharedMemorySize, LDS_BYTES) != hipSuccess) { fprintf(stderr, "kernel_launch: hipFuncSetAttribute failed\n"); grid = -1; return; }
        if (hipOccupancyMaxActiveBlocksPerMultiprocessor(&per_cu, (const void*)fwd, NTHR, LDS_BYTES) != hipSuccess || per_cu < 1) { fprintf(stderr, "kernel_launch: occupancy query says %d\n", per_cu); (void)hipGetLastError(); per_cu = 1; }
        grid = cus;
    }
    if (grid < 0) return;
    (void)hipMemsetAsync((char*)d_ws + WS_CTL, 0, CTL_BYTES, stream);
    Args a{};
    for (int i = 0; i < 16; ++i) a.in[i] = (const float*)d_in[i];
    a.out = (float*)d_out; a.ws = (unsigned char*)d_ws;
#if MK_ONE_LAUNCH
    a.ph_lo = 0; a.ph_hi = N_PHASES;
    hipLaunchKernelGGL(fwd, dim3(grid), dim3(NTHR), LDS_BYTES, stream, a);
#else
    for (int ph = 0; ph < N_PHASES; ++ph) {
        if (ph == 12 || ph == 13) continue;
        a.ph_lo = ph; a.ph_hi = ph + 1;
        hipLaunchKernelGGL(fwd, dim3(grid), dim3(NTHR), LDS_BYTES, stream, a);
    }
#endif
}
```

```cpp
#include <hip/hip_runtime.h>
#include <hip/hip_bf16.h>
#include <stdint.h>
#include <stdio.h>

#ifndef MK_ONE_LAUNCH
#define MK_ONE_LAUNCH 1
#endif

#ifndef PHMASK
#define PHMASK 0x1FFF
#endif
#define PHK(k) ((PHMASK >> (k)) & 1)
#ifndef REPEAT_KIND
#define REPEAT_KIND -1
#endif
#define REPS(k) ((k) == REPEAT_KIND ? 2 : 1)
#define LAS __attribute__((address_space(3)))
typedef __attribute__((ext_vector_type(8))) short bf16x8;
typedef __attribute__((ext_vector_type(16))) float f32x16;
typedef __attribute__((ext_vector_type(4))) float f32x4;
typedef __attribute__((ext_vector_type(4))) unsigned u32x4;
typedef __attribute__((ext_vector_type(2))) unsigned u32x2;
typedef unsigned short u16;

constexpr int D = 1024, BATCH = 2, SEQ = 8192, T = BATCH * SEQ, NH = 16, HD = 64;
constexpr int NE = 256, TOPK = 8, DF = 256;
constexpr int A_TOT = T * TOPK;
constexpr int MOBA_BLK = 256, MOBA_NB = SEQ / MOBA_BLK;
constexpr float DN_ALPHA = 1.4142135623730951f;
constexpr float LN_EPS = 1e-5f;
constexpr float LOG2E = 1.4426950408889634f;
constexpr float LN2 = 0.6931471805599453f;
constexpr float NEGV = -1e30f;
constexpr int NTHR = 512;

constexpr size_t al256(size_t x) { return (x + 255) & ~(size_t)255; }
constexpr size_t WS_CTL = 0;
constexpr size_t CTL_BYTES = 131072;
constexpr size_t CTL_CNT_OFF = 32768;
constexpr size_t CTL_ECNT_OFF = 65536;
constexpr int CNT_STRIDE = 32;
constexpr size_t WS_XB = WS_CTL + CTL_BYTES;
constexpr size_t WS_X1 = WS_XB + al256((size_t)T * D * 2);
constexpr size_t WS_X2 = WS_X1 + al256((size_t)T * D * 4);
constexpr size_t WS_YPRE = WS_X2 + al256((size_t)T * D * 4);
constexpr size_t WS_QKV = WS_YPRE + al256((size_t)T * D * 4);
constexpr size_t WS_VT = WS_QKV + al256((size_t)T * 9216 * 2);
constexpr size_t WS_KM = WS_VT + al256((size_t)3 * T * D * 2);
constexpr size_t WS_AO = WS_KM + al256((size_t)BATCH * NH * MOBA_NB * HD * 4);
constexpr size_t WS_OG = WS_AO + al256((size_t)T * D * 2);
constexpr size_t WS_LSE = WS_OG + al256((size_t)3 * T * D * 2);
constexpr size_t WS_TOPW = WS_LSE + al256((size_t)3 * T * NH * 4);
constexpr size_t WS_LIST = WS_TOPW + al256((size_t)T * TOPK * 4);
constexpr size_t WS_HB = WS_LIST + al256((size_t)NE * T * 4);
constexpr size_t WS_YB = WS_HB + al256((size_t)(A_TOT + T + 1) * DF * 2);
constexpr size_t WS_END = WS_YB + al256((size_t)(A_TOT + T + 1) * D * 2);
constexpr int TRASH_VA = A_TOT + T;
constexpr size_t WS_SELM = WS_END;
constexpr size_t WS_PART = WS_SELM + al256((size_t)T * NH * 4);
constexpr size_t WS_PLSE = WS_PART + al256((size_t)T * NH * 4 * 64 * 2);
constexpr size_t WS_WQK0 = WS_PLSE + al256((size_t)T * NH * 4 * 4);
constexpr size_t WS_WV0 = WS_WQK0 + (size_t)2048 * 1024 * 2;
constexpr size_t WS_WQK1 = WS_WV0 + (size_t)1024 * 1024 * 2;
constexpr size_t WS_WV1 = WS_WQK1 + (size_t)6144 * 1024 * 2;
constexpr size_t WS_WO = WS_WV1 + (size_t)3072 * 1024 * 2;
constexpr size_t WS_WSGU = WS_WO + (size_t)2 * 1024 * 1024 * 2;
constexpr size_t WS_WSD = WS_WSGU + (size_t)2 * 512 * 1024 * 2;
constexpr size_t WS_XB8 = WS_WSD + (size_t)2 * 1024 * 256 * 2;
constexpr size_t WS_HBS = WS_XB8 + (size_t)T * D;
constexpr size_t WS_WRH = WS_HBS + (size_t)T * DF * 2;
constexpr size_t WS_WRL = WS_WRH + (size_t)2 * 256 * 1024 * 2;
constexpr size_t WS_END2 = WS_WRL + (size_t)2 * 256 * 1024 * 2;

constexpr int LDP = 40;
constexpr int STAGE_BYTES = 2 * 256 * LDP * 2;
constexpr int LDS_ROWID = 2 * STAGE_BYTES;
constexpr int LDS_ROWW = LDS_ROWID + 1024;
constexpr int XS_PITCH = 1028;
constexpr int LDS_BYTES = 163840;
constexpr int LDS_BAR = 161792;

__device__ __forceinline__ int lane_id_() { int l; asm volatile("v_mbcnt_lo_u32_b32 %0, -1, 0\n\tv_mbcnt_hi_u32_b32 %0, -1, %0" : "=v"(l)); return l; }
__device__ __forceinline__ float shxf(float v, int m, int lane) { return __int_as_float(__builtin_amdgcn_ds_bpermute((lane ^ m) << 2, __float_as_int(v))); }
__device__ __forceinline__ int shxi(int v, int m, int lane) { return __builtin_amdgcn_ds_bpermute((lane ^ m) << 2, v); }
#define XB_TMO      128
#define XB_XCNT(j)  (256  + 64 * (j))
#define XB_XSUB(j)  (1280 + 64 * (j))
#define XB_XGEN(j)  (2304 + 64 * (j))
#define XB_TOP      3328
#define XB_TOPGEN   3392
#define XCD_BAR_WORDS 3456
#define XB_SPIN_CAP (1u << 18)
__device__ __forceinline__ unsigned xb_ld(unsigned* p)              { return __hip_atomic_load(p, __ATOMIC_RELAXED, __HIP_MEMORY_SCOPE_AGENT); }
__device__ __forceinline__ unsigned xb_add(unsigned* p, unsigned v) { return __hip_atomic_fetch_add(p, v, __ATOMIC_RELAXED, __HIP_MEMORY_SCOPE_AGENT); }
__device__ __forceinline__ unsigned xb_xcc_id() { return (unsigned)__builtin_amdgcn_s_getreg((3 << 11) | 20) & 0xFu; }
#define XB_SPIN(cond, bar) do { unsigned _sp = 0; while (cond) { __builtin_amdgcn_s_sleep(1); \
    if ((++_sp & 255u) == 0u) { if (xb_ld(&(bar)[XB_TMO])) break; if (_sp > XB_SPIN_CAP) { atomicAdd(&(bar)[XB_TMO], 1u); break; } } } } while (0)
struct XcdBarrier { unsigned* bar; unsigned x; volatile LAS unsigned* st; };
__device__ __forceinline__ XcdBarrier xcd_barrier_post(unsigned* bar, volatile LAS unsigned* st, const bool leader) {
    XcdBarrier b; b.bar = bar; b.x = xb_xcc_id(); b.st = st;
    if (leader) (void)xb_add(&bar[XB_XCNT(b.x)], 1u);
    return b;
}
__device__ __forceinline__ void xcd_barrier_complete(unsigned* bar, unsigned x, unsigned& nloc, unsigned& nx) {
    const unsigned G = gridDim.x * gridDim.y * gridDim.z;
    unsigned sum, cnt, mine, sp = 0u;
    for (;;) {
        sum = 0u; cnt = 0u; mine = 0u;
#pragma unroll
        for (unsigned j = 0; j < 16; ++j) { const unsigned c = xb_ld(&bar[XB_XCNT(j)]); sum += c; cnt += (c > 0u) ? 1u : 0u; mine = (j == x) ? c : mine; }
        if (sum == G) break;
        __builtin_amdgcn_s_sleep(1);
        if ((++sp & 255u) == 0u) { if (xb_ld(&bar[XB_TMO])) break; if (sp > XB_SPIN_CAP) { atomicAdd(&bar[XB_TMO], 1u); break; } }
    }
    nloc = mine > 0u ? mine : 1u; nx = cnt > 0u ? cnt : 1u;
}
__device__ __forceinline__ void xcd_barrier(const XcdBarrier& b, const bool leader) {
    asm volatile("s_waitcnt vmcnt(0)" ::: "memory");
    __syncthreads();
    if (leader) {
        unsigned* bar = b.bar;
        __builtin_amdgcn_s_waitcnt(0);
        unsigned nloc = b.st[0], nx = b.st[1];
        if (nloc == 0u) { xcd_barrier_complete(bar, b.x, nloc, nx); b.st[0] = nloc; b.st[1] = nx; }
        const unsigned old = xb_add(&bar[XB_XSUB(b.x)], 1u);
        const unsigned gen = old / nloc;
        if (old + 1u == (gen + 1u) * nloc) {
            __builtin_amdgcn_fence(__ATOMIC_RELEASE, "agent");
            asm volatile("s_waitcnt vmcnt(0)" ::: "memory");
            const unsigned og = xb_add(&bar[XB_TOP], 1u);
            const unsigned tg = og / nx;
            if (og + 1u == (tg + 1u) * nx) xb_add(&bar[XB_TOPGEN], 1u);
            else XB_SPIN(xb_ld(&bar[XB_TOPGEN]) == tg, bar);
            __builtin_amdgcn_fence(__ATOMIC_ACQUIRE, "agent");
            xb_add(&bar[XB_XGEN(b.x)], 1u);
            asm volatile("s_waitcnt vmcnt(0)" ::: "memory");
        } else {
            XB_SPIN(xb_ld(&bar[XB_XGEN(b.x)]) == gen, bar);
            __builtin_amdgcn_fence(__ATOMIC_ACQUIRE, "agent");
            asm volatile("s_waitcnt vmcnt(0)" ::: "memory");
        }
    }
    __syncthreads();
}

typedef __attribute__((ext_vector_type(2))) __bf16 bf16x2_t;
typedef __attribute__((ext_vector_type(2))) float f32x2_t;
__device__ __forceinline__ unsigned cvtpk(float lo, float hi) { f32x2_t f; f[0] = lo; f[1] = hi; return __builtin_bit_cast(unsigned, __builtin_convertvector(f, bf16x2_t)); }
__device__ __forceinline__ float bf2f(unsigned v16) { return __uint_as_float(v16 << 16); }
__device__ __forceinline__ int crow(int r, int hi) { return (r & 3) + 8 * (r >> 2) + 4 * hi; }
#define MFMA_BF16(a, b, c) __builtin_amdgcn_mfma_f32_32x32x16_bf16(a, b, c, 0, 0, 0)
__device__ __forceinline__ float wave_sum(float v) {
    v += __int_as_float(__builtin_amdgcn_update_dpp(0, __float_as_int(v), 0xB1, 0xF, 0xF, true));
    v += __int_as_float(__builtin_amdgcn_update_dpp(0, __float_as_int(v), 0x4E, 0xF, 0xF, true));
    v += __int_as_float(__builtin_amdgcn_update_dpp(0, __float_as_int(v), 0x141, 0xF, 0xF, true));
    v += __int_as_float(__builtin_amdgcn_update_dpp(0, __float_as_int(v), 0x140, 0xF, 0xF, true));
    const int vi = __float_as_int(v);
    return (__int_as_float(__builtin_amdgcn_readlane(vi, 0)) + __int_as_float(__builtin_amdgcn_readlane(vi, 16))) + (__int_as_float(__builtin_amdgcn_readlane(vi, 32)) + __int_as_float(__builtin_amdgcn_readlane(vi, 48)));
}

namespace pg8 {
#define PG8_LAS __attribute__((address_space(3)))
typedef unsigned short bf16_t;
typedef short bf16x8 __attribute__((ext_vector_type(8)));
typedef float f32x4 __attribute__((ext_vector_type(4)));
typedef unsigned u32x4 __attribute__((ext_vector_type(4)));
constexpr int BM = 256, BK = 64, HALF = 128, HTB = HALF * BK * 2  , STAGE_BYTES = 8 * HTB, NXCD = 8, WGM = 8;

__host__ __device__ __forceinline__ int lds_byte(int r, int c) { const int st = (r >> 4) * 2 + (c >> 5), rr = r & 15, cc = c & 31, ob = rr * 64 + cc * 2; return st * 1024 + (ob ^ (((ob >> 9) & 1) << 5)); }
__host__ __device__ __forceinline__ void stage_rc(int b, int& R, int& C) { const int st = b / 1024, sb = b % 1024, swz = sb ^ (((sb >> 9) & 1) << 5); R = (st >> 1) * 16 + swz / 64; C = (st & 1) * 32 + (swz % 64) / 2; }
__host__ __device__ __forceinline__ int perm32(int rho) { const int n = rho >> 4, i = rho & 15; return 8 * (i >> 2) + 4 * n + (i & 3); }

struct Unit { int pm, pn; };
struct Gemm { const bf16_t* A; const bf16_t* Bt; int M, N, K; };
struct FixedOrder {
    int pm, pn;
    __device__ __forceinline__ bool next(int i, Unit& u) const { if (i != 0) return false; u.pm = pm; u.pn = pn; return true; }
    __device__ __forceinline__ void a_ready(const Unit&) const {}
    __device__ __forceinline__ void done(const Unit&) const {}
};

struct StaticOrder {
    int nM, nN, nwg, G, c;
    __host__ __device__ void init(int M, int N, int G_, int c_) { nM = M / BM; nN = N / BM; nwg = nM * nN; G = G_; c = c_; }
    __host__ __device__ bool next(int i, Unit& u) const {
        const long L = (long)i * G + c; if (L >= nwg) return false;
        int wgid = (int)L; { const int q = nwg / NXCD, r = nwg % NXCD, xcd = wgid % NXCD, off = wgid / NXCD; wgid = (xcd < r ? xcd * (q + 1) : r * (q + 1) + (xcd - r) * q) + off; }
        const int nig = WGM * nN, gid = wgid / nig, fm = gid * WGM, gsz = (nM - fm) < WGM ? (nM - fm) : WGM;
        u.pm = fm + ((wgid % nig) % gsz); u.pn = (wgid % nig) / gsz; return true;
    }
    __device__ __forceinline__ void a_ready(const Unit&) const {}
    __device__ __forceinline__ void done(const Unit&) const {}
};

template <class Epi, class Sched, bool SWAP = false, bool STAMP = false>
__device__ __forceinline__ void gemm_phase(PG8_LAS unsigned char* lds, const Gemm g, const Sched& S, const Epi& E, unsigned long long* stamps, const int tid_in) {
    int tid_ = tid_in; asm volatile("" : "+v"(tid_));
    const int tid = tid_, wid = __builtin_amdgcn_readfirstlane(tid >> 6), lane = tid & 63, wr = wid >> 2, wc = wid & 3, fr = lane & 15, fq = lane >> 4;
    const int K = g.K, nt = K / BK;
    int ts_lo = 0, ts_hi = 0, nts = 0; const unsigned long long rt_entry = STAMP ? (unsigned long long)wall_clock64() : 0ull;
#define PG8_STAMP() do { if (STAMP && wid == 0 && nts < 64) { const unsigned long long _c = (unsigned long long)clock64(); \
        ts_lo = (lane == nts) ? (int)(unsigned)_c : ts_lo; ts_hi = (lane == nts) ? (int)(unsigned)(_c >> 32) : ts_hi; ++nts; } } while (0)
    PG8_STAMP();
    unsigned voffA[2], voffB[2];
#pragma unroll
    for (int i = 0; i < 2; ++i) { int R, C; stage_rc(tid * 16 + i * 8192, R, C); const int Rb = Epi::PERM ? ((R & ~31) + perm32(R & 31)) : R;
        voffA[i] = (unsigned)(R * K + C) * 2u; voffB[i] = (unsigned)(Rb * K + C) * 2u; }
    const size_t kstep = (size_t)(BK * 2);
    const size_t hstep = (size_t)HALF * K * 2;
    const size_t tstep = 2 * hstep;
    const unsigned ldsw = (unsigned)wid * 1024u;
    const int aoff = lds_byte(wr * 64 + fr, fq * 8), boff = lds_byte(wc * 32 + fr, fq * 8);
#define PG8_SA(b, h) (((b) * 2 + (h)) * HTB)
#define PG8_SB(b, h) ((4 + (b) * 2 + (h)) * HTB)
#define PG8_STAGE(bufoff, gbase, voff) do { _Pragma("unroll") for (int _i = 0; _i < 2; ++_i) \
        __builtin_amdgcn_global_load_lds((const unsigned*)((const char*)(gbase) + (voff)[_i]), (PG8_LAS unsigned*)(lds + (bufoff) + ldsw + _i * 8192), 16, 0, 0); } while (0)
#define PG8_LDA(dst, b, h) do { _Pragma("unroll") for (int m = 0; m < 4; ++m) _Pragma("unroll") for (int k = 0; k < 2; ++k) dst[m][k] = *(const PG8_LAS bf16x8*)(lds + PG8_SA(b, h) + aoff + m * 2048 + k * 1024); } while (0)
#define PG8_LDB(dst, b, h) do { _Pragma("unroll") for (int n = 0; n < 2; ++n) _Pragma("unroll") for (int k = 0; k < 2; ++k) dst[n][k] = *(const PG8_LAS bf16x8*)(lds + PG8_SB(b, h) + boff + n * 2048 + k * 1024); } while (0)
#define PG8_MMA(ai, bj, At, Bt) do { __builtin_amdgcn_s_setprio(1); _Pragma("unroll") for (int m = 0; m < 4; ++m) _Pragma("unroll") for (int n = 0; n < 2; ++n) _Pragma("unroll") for (int k = 0; k < 2; ++k) \
        acc[ai][bj][m][n] = SWAP ? __builtin_amdgcn_mfma_f32_16x16x32_bf16(At[m][k], Bt[n][k], acc[ai][bj][m][n], 0, 0, 0) : __builtin_amdgcn_mfma_f32_16x16x32_bf16(Bt[n][k], At[m][k], acc[ai][bj][m][n], 0, 0, 0); __builtin_amdgcn_s_setprio(0); } while (0)
#define PG8_WAIT_V(n) asm volatile("s_waitcnt vmcnt(" #n ")" ::: "memory")
#define PG8_WAIT_L(n) asm volatile("s_waitcnt lgkmcnt(" #n ")" ::: "memory")
#define PG8_BAR __builtin_amdgcn_s_barrier()
#define PG8_SCHED __builtin_amdgcn_sched_barrier(0)
    Unit cur, nxt; int ui = 0;
    if (!S.next(0, cur)) return;
    f32x4 acc[2][2][4][2];
#pragma unroll
    for (int a = 0; a < 2; ++a)
#pragma unroll
        for (int b = 0; b < 2; ++b)
#pragma unroll
            for (int m = 0; m < 4; ++m)
#pragma unroll
                for (int n = 0; n < 2; ++n) acc[a][b][m][n] = (f32x4){0.f, 0.f, 0.f, 0.f};
    bf16x8 At[4][2], B0[2][2], B1[2][2];
    const char* cA = (const char*)g.A + (size_t)cur.pm * tstep; const char* cB = (const char*)g.Bt + (size_t)cur.pn * tstep;
    S.a_ready(cur);
    PG8_STAGE(PG8_SB(0, 0), cB, voffB); PG8_STAGE(PG8_SA(0, 0), cA, voffA); PG8_STAGE(PG8_SB(0, 1), cB + hstep, voffB); PG8_STAGE(PG8_SA(0, 1), cA + hstep, voffA);
    if (wr == 1) PG8_BAR;
    PG8_WAIT_V(4); PG8_BAR;
    PG8_STAGE(PG8_SB(1, 0), cB + kstep, voffB); PG8_STAGE(PG8_SA(1, 0), cA + kstep, voffA); PG8_STAGE(PG8_SB(1, 1), cB + hstep + kstep, voffB);
    PG8_WAIT_V(6); PG8_BAR;
    PG8_STAMP();
    for (;;) {
        const bool has_next = S.next(ui + 1, nxt);
        const char* nA = has_next ? (const char*)g.A + (size_t)nxt.pm * tstep : cA; const char* nB = has_next ? (const char*)g.Bt + (size_t)nxt.pn * tstep : cB;
        for (int t = 0; t < nt; t += 2) {
            const bool last = (t == nt - 2);
            const char* a1 = cA + (size_t)(t + 1) * kstep;
            const char* a2 = last ? nA : cA + (size_t)(t + 2) * kstep; const char* b2 = last ? nB : cB + (size_t)(t + 2) * kstep;
            const char* a3 = a2 + kstep; const char* b3 = b2 + kstep;
            if (last && has_next) S.a_ready(nxt);
            PG8_LDB(B0, 0, 0); PG8_SCHED; PG8_LDA(At, 0, 0); PG8_STAGE(PG8_SA(1, 1), a1 + hstep, voffA);
            PG8_WAIT_L(8); PG8_BAR; PG8_WAIT_L(0); PG8_MMA(0, 0, At, B0); PG8_BAR; PG8_SCHED;
            PG8_LDB(B1, 0, 1); PG8_STAGE(PG8_SB(0, 0), b2, voffB);
            PG8_BAR; PG8_WAIT_L(0); PG8_MMA(0, 1, At, B1); PG8_BAR;
            PG8_LDA(At, 0, 1); PG8_STAGE(PG8_SA(0, 0), a2, voffA);
            PG8_BAR; PG8_WAIT_L(0); PG8_MMA(1, 0, At, B0); PG8_BAR; PG8_SCHED;
            PG8_STAGE(PG8_SB(0, 1), b2 + hstep, voffB);
            PG8_WAIT_V(6); PG8_BAR; PG8_MMA(1, 1, At, B1); PG8_BAR;
            PG8_LDB(B0, 1, 0); PG8_SCHED; PG8_LDA(At, 1, 0); PG8_STAGE(PG8_SA(0, 1), a2 + hstep, voffA);
            PG8_WAIT_L(8); PG8_BAR; PG8_WAIT_L(0); PG8_MMA(0, 0, At, B0); PG8_BAR; PG8_SCHED;
            PG8_LDB(B1, 1, 1); PG8_STAGE(PG8_SB(1, 0), b3, voffB);
            PG8_BAR; PG8_WAIT_L(0); PG8_MMA(0, 1, At, B1); PG8_BAR;
            PG8_LDA(At, 1, 1); PG8_STAGE(PG8_SA(1, 0), a3, voffA);
            PG8_BAR; PG8_WAIT_L(0); PG8_MMA(1, 0, At, B0); PG8_BAR; PG8_SCHED;
            PG8_STAGE(PG8_SB(1, 1), b3 + hstep, voffB);
            PG8_WAIT_V(6); PG8_BAR; PG8_MMA(1, 1, At, B1); PG8_BAR;
        }
        PG8_STAMP();
        if constexpr (!Epi::AFTER_DRAIN) { E(acc, cur, wr, wc, fr, fq); S.done(cur); }
        PG8_STAMP();
        if (!has_next) break;
#pragma unroll
        for (int a = 0; a < 2; ++a)
#pragma unroll
            for (int b = 0; b < 2; ++b)
#pragma unroll
                for (int m = 0; m < 4; ++m)
#pragma unroll
                    for (int n = 0; n < 2; ++n) acc[a][b][m][n] = (f32x4){0.f, 0.f, 0.f, 0.f};
        cur = nxt; cA = nA; cB = nB; ++ui;
    }
    PG8_WAIT_V(0);
    if (wr == 0) PG8_BAR;
    PG8_BAR;
    if constexpr (Epi::AFTER_DRAIN) { E.fused(acc, cur, wr, wc, fr, fq, lds, wid, lane); S.done(cur); }
    PG8_STAMP();
    if (STAMP && wid == 0) { stamps[lane] = lane < nts ? (((unsigned long long)(unsigned)ts_hi << 32) | (unsigned)ts_lo) : 0ull;
        if (lane == 62) stamps[62] = rt_entry; if (lane == 63) stamps[63] = (unsigned long long)wall_clock64(); }
#undef PG8_STAMP
#undef PG8_SA
#undef PG8_SB
#undef PG8_STAGE
#undef PG8_LDA
#undef PG8_LDB
#undef PG8_MMA
#undef PG8_WAIT_V
#undef PG8_WAIT_L
#undef PG8_BAR
#undef PG8_SCHED
}
}

struct EpiQK {
    static constexpr bool PERM = true, AFTER_DRAIN = false;
    u16* O; int ldc;
    __device__ __forceinline__ void operator()(const pg8::f32x4 (&acc)[2][2][4][2], const pg8::Unit& u, int wr, int wc, int fr, int fq) const {
        const int col0 = u.pn * 256 + wc * 32 + 8 * fq, row0 = u.pm * 256 + wr * 64 + fr;
#pragma unroll
        for (int ai = 0; ai < 2; ++ai)
#pragma unroll
            for (int m = 0; m < 4; ++m) { u16* rowp = O + (size_t)(row0 + ai * 128 + m * 16) * ldc + col0;
#pragma unroll
                for (int bj = 0; bj < 2; ++bj) { const pg8::f32x4 v0 = acc[ai][bj][m][0], v1 = acc[ai][bj][m][1];
                    u32x4 w; w[0] = cvtpk(v0[0], v0[1]); w[1] = cvtpk(v0[2], v0[3]); w[2] = cvtpk(v1[0], v1[1]); w[3] = cvtpk(v1[2], v1[3]);
                    *(u32x4*)(rowp + bj * 128) = w; } }
    }
};
struct EpiV {
    static constexpr bool PERM = false, AFTER_DRAIN = false;
    u16* VT; int layer;
    __device__ __forceinline__ void operator()(const pg8::f32x4 (&acc)[2][2][4][2], const pg8::Unit& u, int wr, int wc, int fr, int fq) const {
        const int colt = u.pn * 256, grp = colt >> 10;
        const int dil = (layer == 0 || grp == 0) ? 1 : (grp == 1 ? 4 : 16);
        const int rowb = u.pm * 256 + wr * 64 + 4 * fq;
#pragma unroll
        for (int bj = 0; bj < 2; ++bj)
#pragma unroll
            for (int n = 0; n < 2; ++n) {
                const int c = (colt & 1023) + bj * 128 + wc * 32 + n * 16 + fr, h = c >> 6, d = c & 63;
#pragma unroll
                for (int ai = 0; ai < 2; ++ai)
#pragma unroll
                    for (int m = 0; m < 4; ++m) {
                        const int r0 = rowb + ai * 128 + m * 16, b = r0 >> 13, t0 = r0 & (SEQ - 1);
                        u16* vrow = VT + (size_t)grp * T * D + ((size_t)(b * NH + h) * HD + d) * SEQ;
                        const pg8::f32x4 v = acc[ai][bj][m][n];
                        if (dil == 1) { u32x2 w; w[0] = cvtpk(v[0], v[1]); w[1] = cvtpk(v[2], v[3]); *(u32x2*)(vrow + t0) = w; }
                        else {
#pragma unroll
                            for (int i = 0; i < 4; ++i) { const int pp = t0 + i; vrow[(pp % dil) * (SEQ / dil) + pp / dil] = (u16)cvtpk(v[i], 0.f); }
                        }
                    }
            }
    }
};
struct EpiWo {
    static constexpr bool PERM = false, AFTER_DRAIN = false;
    float* Y; const float* X;
    __device__ __forceinline__ void operator()(const pg8::f32x4 (&acc)[2][2][4][2], const pg8::Unit& u, int wr, int wc, int fr, int fq) const {
        const int row0 = u.pm * 256 + wr * 64 + fr, col0 = u.pn * 256 + wc * 32 + 4 * fq;
#pragma unroll
        for (int ai = 0; ai < 2; ++ai)
#pragma unroll
            for (int m = 0; m < 4; ++m) { const size_t ro = (size_t)(row0 + ai * 128 + m * 16) * D + col0;
#pragma unroll
                for (int bj = 0; bj < 2; ++bj)
#pragma unroll
                    for (int n = 0; n < 2; ++n) { const pg8::f32x4 x = *(const pg8::f32x4*)(X + ro + bj * 128 + n * 16); *(pg8::f32x4*)(Y + ro + bj * 128 + n * 16) = x * DN_ALPHA + acc[ai][bj][m][n]; } }
    }
};
struct EpiSGU {
    static constexpr bool PERM = true, AFTER_DRAIN = false;
    u16* H;
    __device__ __forceinline__ void operator()(const pg8::f32x4 (&acc)[2][2][4][2], const pg8::Unit& u, int wr, int wc, int fr, int fq) const {
        const int row0 = u.pm * 256 + wr * 64 + fr, f0 = u.pn * 128 + wc * 32 + 8 * fq;
#pragma unroll
        for (int ai = 0; ai < 2; ++ai)
#pragma unroll
            for (int m = 0; m < 4; ++m) {
                float hv[8];
#pragma unroll
                for (int n = 0; n < 2; ++n)
#pragma unroll
                    for (int i = 0; i < 4; ++i) { const float gt = acc[ai][0][m][n][i], up = acc[ai][1][m][n][i]; hv[n * 4 + i] = gt / (1.f + __expf(-gt)) * up; }
                u32x4 w; w[0] = cvtpk(hv[0], hv[1]); w[1] = cvtpk(hv[2], hv[3]); w[2] = cvtpk(hv[4], hv[5]); w[3] = cvtpk(hv[6], hv[7]);
                *(u32x4*)(H + (size_t)(row0 + ai * 128 + m * 16) * DF + f0) = w;
            }
    }
};
struct EpiSD {
    static constexpr bool PERM = true, AFTER_DRAIN = false;
    u16* Y;
    __device__ __forceinline__ void operator()(const pg8::f32x4 (&acc)[2][2][4][2], const pg8::Unit& u, int wr, int wc, int fr, int fq) const {
        const int row0 = u.pm * 256 + wr * 64 + fr, col0 = u.pn * 256 + wc * 32 + 8 * fq;
#pragma unroll
        for (int ai = 0; ai < 2; ++ai)
#pragma unroll
            for (int m = 0; m < 4; ++m) { u16* rowp = Y + (size_t)(A_TOT + row0 + ai * 128 + m * 16) * D + col0;
#pragma unroll
                for (int bj = 0; bj < 2; ++bj) { const pg8::f32x4 v0 = acc[ai][bj][m][0], v1 = acc[ai][bj][m][1];
                    u32x4 w; w[0] = cvtpk(v0[0], v0[1]); w[1] = cvtpk(v0[2], v0[3]); w[2] = cvtpk(v1[0], v1[1]); w[3] = cvtpk(v1[2], v1[3]);
                    *(u32x4*)(rowp + bj * 128) = w; } }
    }
};

struct Args {
    const float* in[16];
    float* out;
    unsigned char* ws;
    int ph_lo, ph_hi;
};

#define GEMM_CORE(K_, PA0, PA1, PB, LDB)                                                                                                   \
    {                                                                                                                                      \
        const int g_tid = tid, g_lane = lane, g_wave = wave, g_r32 = r32, g_hi = hi;                   \
        const int g_wm = g_wave >> 2, g_wn = g_wave & 3, g_kc = g_tid & 3, g_kq = g_lane >> 3, g_n4 = g_lane & 7;                           \
        const u16* g_pa0 = (PA0); const u16* g_pa1 = (PA1);                                                                                \
        const size_t g_ldb = (size_t)(LDB);                                                                                                \
        const float* g_pb = (PB) + (size_t)(g_kq * 4) * g_ldb + g_n4 * 4;                                                                  \
        const int g_nk = (K_) / 32;                                                                                                        \
        u32x4 g_ra0, g_ra1; f32x4 g_rb0, g_rb1, g_rb2, g_rb3;                                                                              \
        const u32x4 g_z = {0u, 0u, 0u, 0u};                                                                                                \
        _Pragma("unroll") for (int mb = 0; mb < 4; ++mb) { _Pragma("unroll") for (int nb = 0; nb < 2; ++nb) { _Pragma("unroll") for (int r = 0; r < 16; ++r) acc[mb][nb][r] = 0.f; } } \
        g_ra0 = g_pa0 ? *(const u32x4*)(g_pa0 + g_kc * 8) : g_z; g_ra1 = g_pa1 ? *(const u32x4*)(g_pa1 + g_kc * 8) : g_z;                 \
        g_rb0 = *(const f32x4*)(g_pb); g_rb1 = *(const f32x4*)(g_pb + g_ldb); g_rb2 = *(const f32x4*)(g_pb + 2 * g_ldb); g_rb3 = *(const f32x4*)(g_pb + 3 * g_ldb); \
        _Pragma("unroll 1") for (int kt = 0; kt < g_nk; ++kt) {                                                                            \
            LAS char* As = lds + (kt & 1) * STAGE_BYTES; LAS char* Bs = As + 256 * LDP * 2;                                                \
            *(LAS u32x4*)(As + ((g_tid >> 2) * LDP + g_kc * 8) * 2) = g_ra0;                                                               \
            *(LAS u32x4*)(As + (((g_tid >> 2) + 128) * LDP + g_kc * 8) * 2) = g_ra1;                                                       \
            _Pragma("unroll") for (int i = 0; i < 4; ++i) {                                                                                \
                u32x2 w; w[0] = cvtpk(g_rb0[i], g_rb1[i]); w[1] = cvtpk(g_rb2[i], g_rb3[i]);                                               \
                *(LAS u32x2*)(Bs + ((g_wave * 32 + i * 8 + g_n4) * LDP + g_kq * 4) * 2) = w;                                               \
            }                                                                                                                              \
            __syncthreads();                                                                                                               \
            if (kt + 1 < g_nk) {                                                                                                           \
                const int ko = (kt + 1) * 32;                                                                                              \
                g_ra0 = g_pa0 ? *(const u32x4*)(g_pa0 + ko + g_kc * 8) : g_z; g_ra1 = g_pa1 ? *(const u32x4*)(g_pa1 + ko + g_kc * 8) : g_z; \
                const float* pbk = g_pb + (size_t)ko * g_ldb;                                                                              \
                g_rb0 = *(const f32x4*)(pbk); g_rb1 = *(const f32x4*)(pbk + g_ldb); g_rb2 = *(const f32x4*)(pbk + 2 * g_ldb); g_rb3 = *(const f32x4*)(pbk + 3 * g_ldb); \
            }                                                                                                                              \
            _Pragma("unroll") for (int s = 0; s < 2; ++s) {                                                                                \
                bf16x8 af[4], bfr[2];                                                                                                      \
                _Pragma("unroll") for (int mb = 0; mb < 4; ++mb) af[mb] = *(LAS bf16x8*)(As + ((g_wm * 128 + mb * 32 + g_r32) * LDP + s * 16 + g_hi * 8) * 2); \
                _Pragma("unroll") for (int nb = 0; nb < 2; ++nb) bfr[nb] = *(LAS bf16x8*)(Bs + (((g_wn * 2 + nb) * 32 + g_r32) * LDP + s * 16 + g_hi * 8) * 2); \
                _Pragma("unroll") for (int mb = 0; mb < 4; ++mb) { _Pragma("unroll") for (int nb = 0; nb < 2; ++nb) acc[mb][nb] = MFMA_BF16(af[mb], bfr[nb], acc[mb][nb]); } \
            }                                                                                                                              \
        }                                                                                                                                  \
        __syncthreads();                                                                                                                   \
    }

struct AttnSt { float m, l; f32x16 o0, o1; };

struct AttnFr { bf16x8 k[4]; bf16x8 v[4]; };
__device__ __forceinline__ void attn_load(AttnFr& f, const u16* krow, const u16* vt, size_t vt_dstride) {
#pragma unroll
    for (int d0 = 0; d0 < 4; ++d0) f.k[d0] = *(const bf16x8*)(krow + d0 * 16);
    const u16* vt1 = vt + 32 * vt_dstride;
    union { bf16x8 v; u32x2 h[2]; } va;
    va.h[0] = *(const u32x2*)(vt);       va.h[1] = *(const u32x2*)(vt + 8);   f.v[0] = va.v;
    va.h[0] = *(const u32x2*)(vt + 16);  va.h[1] = *(const u32x2*)(vt + 24);  f.v[1] = va.v;
    va.h[0] = *(const u32x2*)(vt1);      va.h[1] = *(const u32x2*)(vt1 + 8);  f.v[2] = va.v;
    va.h[0] = *(const u32x2*)(vt1 + 16); va.h[1] = *(const u32x2*)(vt1 + 24); f.v[3] = va.v;
}
__device__ __forceinline__ void attn_compute(AttnSt& st, const bf16x8 (&qf)[4], const AttnFr& f, int dist0, float bslope, int dlo, int dhi, int hi, int lane) {
    f32x16 p;
#pragma unroll
    for (int r = 0; r < 16; ++r) p[r] = 0.f;
#pragma unroll
    for (int d0 = 0; d0 < 4; ++d0) p = MFMA_BF16(f.k[d0], qf[d0], p);
    constexpr float C2 = 0.125f * LOG2E;
    float mx = NEGV;
#pragma unroll
    for (int r = 0; r < 16; ++r) {
        const int dist = dist0 - ((r & 3) + 8 * (r >> 2));
        const float sc = __builtin_fmaf(p[r], C2, -bslope * (float)dist);
        const float s_ = (dist >= dlo && dist <= dhi) ? sc : NEGV;
        p[r] = s_; mx = fmaxf(mx, s_);
    }
    mx = fmaxf(mx, shxf(mx, 32, lane));
    const float mnew = fmaxf(st.m, mx);
    const float alpha = __builtin_amdgcn_exp2f(st.m - mnew);
    st.m = mnew;
    float ls = 0.f;
#pragma unroll
    for (int r = 0; r < 16; ++r) { p[r] = __builtin_amdgcn_exp2f(p[r] - mnew); ls += p[r]; }
    st.l = st.l * alpha + ls;
#pragma unroll
    for (int r = 0; r < 16; ++r) { st.o0[r] *= alpha; st.o1[r] *= alpha; }
    union { bf16x8 v; unsigned u[4]; } pb0, pb1;
#pragma unroll
    for (int j = 0; j < 4; ++j) { pb0.u[j] = cvtpk(p[2 * j], p[2 * j + 1]); pb1.u[j] = cvtpk(p[8 + 2 * j], p[8 + 2 * j + 1]); }
    st.o0 = MFMA_BF16(f.v[0], pb0.v, st.o0);
    st.o0 = MFMA_BF16(f.v[1], pb1.v, st.o0);
    st.o1 = MFMA_BF16(f.v[2], pb0.v, st.o1);
    st.o1 = MFMA_BF16(f.v[3], pb1.v, st.o1);
    (void)hi;
}

__device__ __forceinline__ float dpp_rowmax(float v) {
    v = fmaxf(v, __int_as_float(__builtin_amdgcn_update_dpp(0, __float_as_int(v), 0xB1, 0xF, 0xF, true)));
    v = fmaxf(v, __int_as_float(__builtin_amdgcn_update_dpp(0, __float_as_int(v), 0x4E, 0xF, 0xF, true)));
    v = fmaxf(v, __int_as_float(__builtin_amdgcn_update_dpp(0, __float_as_int(v), 0x141, 0xF, 0xF, true)));
    v = fmaxf(v, __int_as_float(__builtin_amdgcn_update_dpp(0, __float_as_int(v), 0x140, 0xF, 0xF, true)));
    return v;
}
__device__ __forceinline__ int dpp_rowmin_i(int v) {
    v = min(v, __builtin_amdgcn_update_dpp(0, v, 0xB1, 0xF, 0xF, true));
    v = min(v, __builtin_amdgcn_update_dpp(0, v, 0x4E, 0xF, 0xF, true));
    v = min(v, __builtin_amdgcn_update_dpp(0, v, 0x141, 0xF, 0xF, true));
    v = min(v, __builtin_amdgcn_update_dpp(0, v, 0x140, 0xF, 0xF, true));
    return v;
}
__device__ __forceinline__ float rl_f(float v, int l) { return __int_as_float(__builtin_amdgcn_readlane(__float_as_int(v), l)); }

__device__ __forceinline__ void top3_insert(float v, int i, float& v0, int& i0, float& v1, int& i1, float& v2, int& i2) {
    const bool b0 = (v > v0) || (v == v0 && i < i0);
    const bool b1 = (v > v1) || (v == v1 && i < i1);
    const bool b2 = (v > v2) || (v == v2 && i < i2);
    const float nv2 = b1 ? v1 : (b2 ? v : v2); const int ni2 = b1 ? i1 : (b2 ? i : i2);
    const float nv1 = b0 ? v0 : (b1 ? v : v1); const int ni1 = b0 ? i0 : (b1 ? i : i1);
    const float nv0 = b0 ? v : v0;             const int ni0 = b0 ? i : i0;
    v0 = nv0; i0 = ni0; v1 = nv1; i1 = ni1; v2 = nv2; i2 = ni2;
}

__device__ __forceinline__ void ln_row(float (&v)[16], const float* __restrict__ g, const float* __restrict__ b, int lane) {
    float s = 0.f;
#pragma unroll
    for (int i = 0; i < 16; ++i) s += v[i];
    const float mu = wave_sum(s) * (1.f / D);
    float q = 0.f;
#pragma unroll
    for (int i = 0; i < 16; ++i) { const float d = v[i] - mu; q += d * d; }
    const float rstd = rsqrtf(wave_sum(q) * (1.f / D) + LN_EPS);
#pragma unroll
    for (int j = 0; j < 4; ++j) {
        const f32x4 gg = *(const f32x4*)(g + j * 256 + lane * 4), bb = *(const f32x4*)(b + j * 256 + lane * 4);
#pragma unroll
        for (int c = 0; c < 4; ++c) v[j * 4 + c] = (v[j * 4 + c] - mu) * rstd * gg[c] + bb[c];
    }
}

typedef __attribute__((ext_vector_type(2))) float f32x2_;
__device__ __forceinline__ bf16x8 fp8x8_to_bf16(unsigned lo, unsigned hi_) {
    const f32x2_ a = __builtin_amdgcn_cvt_pk_f32_fp8((int)lo, false), b = __builtin_amdgcn_cvt_pk_f32_fp8((int)lo, true);
    const f32x2_ c = __builtin_amdgcn_cvt_pk_f32_fp8((int)hi_, false), d = __builtin_amdgcn_cvt_pk_f32_fp8((int)hi_, true);
    union { bf16x8 v; unsigned u[4]; } r;
    r.u[0] = cvtpk(a[0], a[1]); r.u[1] = cvtpk(b[0], b[1]); r.u[2] = cvtpk(c[0], c[1]); r.u[3] = cvtpk(d[0], d[1]);
    return r.v;
}
__device__ __forceinline__ unsigned pack_fp8x4(float a, float b, float c, float d) { int p = __builtin_amdgcn_cvt_pk_fp8_f32(a, b, 0, false); return (unsigned)__builtin_amdgcn_cvt_pk_fp8_f32(c, d, p, true); }

constexpr float Y8_SCALE = 16.f;
constexpr int MOE_BP = 72;
constexpr int MOE_BSTAGE = 128 * MOE_BP * 2;
constexpr int MOE_LDS_VA = 3 * MOE_BSTAGE;
constexpr int MOE_LDS_W = MOE_LDS_VA + 4096;
template <bool DOWN>
__device__ __forceinline__ void moe_expert(LAS char* lds, const int tid, const int lane, const int wave, const int r32, const int hi,
                                           const unsigned char* __restrict__ abase  , const float* __restrict__ w0, const float* __restrict__ w1, const int ng  , void* __restrict__ outv,
                                           const int pass0, const int npass_, const int st0, const int nstl  , const bool y8 = false  ) {
    constexpr int KT = DOWN ? 4 : 16, NP = DOWN ? 8 : 4, LDB = DOWN ? 1024 : 256, APITCH = DOWN ? 256 : 1024  , PSTEP = DOWN ? 128 : 64;
    LAS int* rowva = (LAS int*)(lds + MOE_LDS_VA); LAS float* roww = (LAS float*)(lds + MOE_LDS_W);
    const int nst = nstl;
    const int nsteps = npass_ * nst * KT; (void)NP;
    unsigned aoff[2];
#define MOE_AOFF(ST_) { _Pragma("unroll") for (int a = 0; a < 2; ++a) { const int va_ = rowva[(ST_) * 512 + wave * 64 + a * 32 + r32]; \
        const int srow_ = DOWN ? va_ : (va_ == TRASH_VA ? 0 : (va_ >> 3)); aoff[a] = (unsigned)srow_ * APITCH + hi * 32; } }
    const int seg = wave >> 1, n4 = lane & 7, kp = (wave & 1) * 16 + (lane >> 3);
    const char* wbase = (const char*)(DOWN ? (w0 + seg * 32) : (((seg < 2) ? w0 : w1) + (seg & 1) * 32));
    unsigned boff = (unsigned)(4 * n4 + 2 * kp * LDB) * 4u; asm volatile("" : "+v"(boff));
    f32x16 acc[2][4];
#pragma unroll
    for (int a = 0; a < 2; ++a)
#pragma unroll
        for (int c = 0; c < 4; ++c)
#pragma unroll
            for (int r = 0; r < 16; ++r) acc[a][c][r] = 0.f;
    u32x4 fa8[2][2];
    f32x4 rb0[4], rb1[4];
#define MOE_DEC(S_) const int s2_ = (S_) < nsteps ? (S_) : 0; const int pl_ = s2_ / (nst * KT); const int rm_ = s2_ - pl_ * (nst * KT); const int sl_ = rm_ / KT; const int kt_ = rm_ - sl_ * KT; const int ps_ = pass0 + pl_; const int stt_ = st0 + sl_;
#define MOE_LOADB(S_, RB) { MOE_DEC(S_) (void)stt_; \
        const char* wp_ = wbase + (size_t)(ps_ * PSTEP + kt_ * 64 * LDB) * 4 + boff; \
        RB[0] = *(const f32x4*)(wp_); RB[1] = *(const f32x4*)(wp_ + LDB * 4); RB[2] = *(const f32x4*)(wp_ + 16 * LDB * 4); RB[3] = *(const f32x4*)(wp_ + 17 * LDB * 4); }
#define MOE_WRITEB(STG, RB) { LAS char* Bs_ = lds + (STG) * MOE_BSTAGE; \
        _Pragma("unroll") for (int i = 0; i < 4; ++i) { LAS unsigned* q_ = (LAS unsigned*)(Bs_ + ((seg * 32 + i * 8 + n4) * MOE_BP + 2 * kp) * 2); q_[0] = cvtpk(RB[0][i], RB[1][i]); q_[8] = cvtpk(RB[2][i], RB[3][i]); } }
#define MOE_COMPUTE(STG, DO_MFMA) { LAS char* Bs_ = lds + (STG) * MOE_BSTAGE; \
        _Pragma("unroll") for (int u = 0; u < 4; ++u) { \
            bf16x8 bfr[4]; \
            if (DO_MFMA) { _Pragma("unroll") for (int c = 0; c < 4; ++c) bfr[c] = *(LAS bf16x8*)(Bs_ + ((c * 32 + r32) * MOE_BP + hi * 32 + u * 8) * 2); } \
            _Pragma("unroll") for (int a = 0; a < 2; ++a) { \
                if (DO_MFMA) { const bf16x8 af_ = fp8x8_to_bf16(fa8[a][u >> 1][(u & 1) * 2], fa8[a][u >> 1][(u & 1) * 2 + 1]); \
                    _Pragma("unroll") for (int c = 0; c < 4; ++c) acc[a][c] = MFMA_BF16(bfr[c], af_, acc[a][c]); } \
                if (u & 1) fa8[a][u >> 1] = *(const u32x4*)(ab_n + aoff[a] + (u >> 1) * 16); \
            } \
        } }
#define MOE_NEXTA(S_) MOE_DEC(S_) (void)ps_; \
        if (stt_ != st_loaded) { MOE_AOFF(stt_) st_loaded = stt_; } \
        const char* ab_n = (const char*)abase + kt_ * 64;
    int st_loaded = st0;
    MOE_AOFF(st0)
    { const char* ab0 = (const char*)abase;
#pragma unroll
      for (int a = 0; a < 2; ++a)
#pragma unroll
          for (int h2 = 0; h2 < 2; ++h2) fa8[a][h2] = *(const u32x4*)(ab0 + aoff[a] + h2 * 16); }
    MOE_LOADB(0, rb0)
    MOE_LOADB(1, rb1)
    MOE_WRITEB(0, rb0)
    MOE_LOADB(2, rb0)
    int stg = 0;
#pragma unroll 1
    for (int sidx = 0; sidx < nsteps; sidx += 2) {
        const int pl = sidx / (nst * KT); const int rm = sidx - pl * (nst * KT); const int sl = rm / KT; const int kt = rm - sl * KT; const int ps = pass0 + pl, stt = st0 + sl;
        const bool wv = (wave * 64) < (ng - stt * 512);
        const int stg1 = stg == 2 ? 0 : stg + 1, stg2 = stg1 == 2 ? 0 : stg1 + 1;
        __syncthreads();
        MOE_WRITEB(stg1, rb1)
        MOE_LOADB(sidx + 3, rb1)
        { MOE_NEXTA(sidx + 1)
          if (wv) MOE_COMPUTE(stg, true) else MOE_COMPUTE(stg, false) }
        __syncthreads();
        MOE_WRITEB(stg2, rb0)
        MOE_LOADB(sidx + 4, rb0)
        { MOE_NEXTA(sidx + 2)
          if (wv) MOE_COMPUTE(stg1, true) else MOE_COMPUTE(stg1, false) }
        stg = stg2;
        if (kt == KT - 2) {
            if (wv) {
                const int nrows = ng - stt * 512;
#pragma unroll
                for (int a = 0; a < 2; ++a) {
                    if (a == 0 || (wave * 64 + 32) < nrows) {
                        const int lrow = stt * 512 + wave * 64 + a * 32 + r32;
                        const unsigned va = (unsigned)rowva[lrow];
                        if (DOWN) {
                            const float w = roww[lrow];
#pragma unroll
                            for (int c = 0; c < 4; ++c) {
                                float yv_[16];
#pragma unroll
                                for (int j = 0; j < 16; ++j) yv_[j] = acc[a][c][(j >> 2) + 4 * (j & 3)] * w;
                                if (y8) {
                                    u32x4 q8;
#pragma unroll
                                    for (int jj = 0; jj < 4; ++jj) q8[jj] = pack_fp8x4(yv_[4 * jj], yv_[4 * jj + 1], yv_[4 * jj + 2], yv_[4 * jj + 3]);
                                    *(u32x4*)((unsigned char*)outv + (size_t)va * D + ps * 128 + c * 32 + 16 * hi) = q8;
                                } else {
                                    u32x4 q0, q1;
#pragma unroll
                                    for (int jj = 0; jj < 4; ++jj) { q0[jj] = cvtpk(yv_[2 * jj], yv_[2 * jj + 1]); q1[jj] = cvtpk(yv_[8 + 2 * jj], yv_[9 + 2 * jj]); }
                                    u16* o = (u16*)outv + (size_t)va * D + ps * 128 + c * 32 + 16 * hi;
                                    *(u32x4*)o = q0; *(u32x4*)(o + 8) = q1;
                                }
                            }
                        } else {
#pragma unroll
                            for (int c = 0; c < 2; ++c) {
                                float hv[16];
#pragma unroll
                                for (int j = 0; j < 16; ++j) { const int r = (j >> 2) + 4 * (j & 3); const float gt = acc[a][c][r], up = acc[a][c + 2][r]; hv[j] = gt / (1.f + __expf(-gt)) * up; }
                                u32x4 q;
#pragma unroll
                                for (int jj = 0; jj < 4; ++jj) q[jj] = pack_fp8x4(hv[4 * jj], hv[4 * jj + 1], hv[4 * jj + 2], hv[4 * jj + 3]);
                                *(u32x4*)((unsigned char*)outv + (size_t)va * DF + ps * 64 + c * 32 + 16 * hi) = q;
                            }
                        }
                    }
                }
#pragma unroll
                for (int a = 0; a < 2; ++a)
#pragma unroll
                    for (int c = 0; c < 4; ++c)
#pragma unroll
                        for (int r = 0; r < 16; ++r) acc[a][c][r] = 0.f;
            }
        }
    }
    __syncthreads();
#undef MOE_AOFF
#undef MOE_DEC
#undef MOE_LOADB
#undef MOE_WRITEB
#undef MOE_COMPUTE
#undef MOE_NEXTA
}

constexpr int N_PHASES = 21;

#define P_x_in CTX_IN(0)
#define P_xb ((u16*)(ws + WS_XB))
#define P_x1 ((float*)(ws + WS_X1))
#define P_x2 ((float*)(ws + WS_X2))
#define P_ypre ((float*)(ws + WS_YPRE))
#define P_qkv ((u16*)(ws + WS_QKV))
#define P_vT ((u16*)(ws + WS_VT))
#define P_kmean ((float*)(ws + WS_KM))
#define P_ao ((u16*)(ws + WS_AO))
#define P_og ((u16*)(ws + WS_OG))
#define P_lse ((float*)(ws + WS_LSE))
#define P_topw ((float*)(ws + WS_TOPW))
#define P_list ((int*)(ws + WS_LIST))
#define P_hb ((u16*)(ws + WS_HB))
#define P_yb ((u16*)(ws + WS_YB))
#define P_cnt_all ((int*)(ws + WS_CTL + CTL_ECNT_OFF))
#define P_xb8 ((unsigned char*)(ws + WS_XB8))
#define P_hbs ((u16*)(ws + WS_HBS))
#define P_selm ((unsigned*)(ws + WS_SELM))
#define P_part ((u16*)(ws + WS_PART))
#define P_plse ((float*)(ws + WS_PLSE))
#define PH_BEGIN int tid = wave_s_ * 64 + lane_id_(); asm volatile("" : "+v"(tid)); const int lane = tid & 63, r32 = lane & 31, hi = lane >> 5; const int wave = __builtin_amdgcn_readfirstlane(tid >> 6); (void)lane; (void)r32; (void)hi; (void)wave
constexpr int LDS_CTX = LDS_BAR + 16;
__device__ __forceinline__ uint64_t ctx_ld(int i) {
    extern __shared__ __attribute__((aligned(16))) unsigned char lds_raw[];
    const LAS unsigned* q = (const LAS unsigned*)((LAS char*)lds_raw + LDS_CTX) + 2 * i;
    const unsigned lo = __builtin_amdgcn_readfirstlane(q[0]), hi = __builtin_amdgcn_readfirstlane(q[1]);
    return ((uint64_t)hi << 32) | lo;
}
typedef __attribute__((address_space(1))) unsigned char gbyte;
#define AS_GLOBAL(T, u64v) ((T*)(gbyte*)(u64v))
#define CTX_IN(i) AS_GLOBAL(const float, ctx_ld(i))
#define PH_FN_BEGIN \
    extern __shared__ __attribute__((aligned(16))) unsigned char lds_raw[]; \
    LAS char* lds = (LAS char*)lds_raw; (void)lds; \
    const int G = gridDim.x, bid = blockIdx.x; (void)G; (void)bid; \
    unsigned char* const ws = AS_GLOBAL(unsigned char, ctx_ld(17)); (void)ws; \
    const int NQ = L == 0 ? 3072 : 9216; (void)NQ; \
    int* cnt = P_cnt_all + L * NE * CNT_STRIDE; (void)cnt;
__device__ __forceinline__ void ph_p0(int L, int rep_, const int wave_s_) {
    PH_FN_BEGIN
    (void)rep_;
    PH_BEGIN;
    for (size_t i = (size_t)bid * NTHR + tid; i < (size_t)T * D / 4; i += (size_t)G * NTHR) {
        const f32x4 v = *(const f32x4*)(P_x_in + i * 4);
        u32x2 w; w[0] = cvtpk(v[0], v[1]); w[1] = cvtpk(v[2], v[3]);
        *(u32x2*)(P_xb + i * 4) = w;
    }
    LAS float* tl = (LAS float*)lds;
    for (int it = bid; it < 3968 + 128; it += G) {
        int seg, kt;
        if (it < 3840) { seg = it >> 4; kt = it & 15; } else if (it < 3968) { seg = 240 + ((it - 3840) >> 2); kt = (it - 3840) & 3; } else { seg = 272 + ((it - 3968) >> 4); kt = (it - 3968) & 15; }
        const float* src; int ld; u16* dst; int Kd = 1024; u16* dst_lo = nullptr;
        if (seg < 48) { const int col = 64 * seg; src = CTX_IN(1) + col; ld = 3072; dst = (u16*)(ws + WS_WQK0) + (size_t)col * 1024; }
        else if (seg < 192) { const int col = 64 * (seg - 48); src = CTX_IN(2) + col; ld = 9216; dst = (u16*)(ws + WS_WQK1) + (size_t)col * 1024; }
        else if (seg < 224) { const int s2 = seg - 192, l2 = s2 >> 4, col = 64 * (s2 & 15); src = CTX_IN(3) + (size_t)l2 * D * D + col; ld = 1024; dst = (u16*)(ws + WS_WO) + (size_t)l2 * D * D + (size_t)col * 1024; }
        else if (seg < 240) { const int s2 = seg - 224, l2 = s2 >> 3, i8 = s2 & 7, un = i8 >> 2, q = i8 & 3;
            src = (q < 2 ? CTX_IN(11) : CTX_IN(12)) + (size_t)l2 * D * DF + un * 128 + 64 * (q & 1); ld = 256; dst = (u16*)(ws + WS_WSGU) + (size_t)l2 * 512 * 1024 + (size_t)(64 * i8) * 1024; }
        else if (seg < 272) { const int s2 = seg - 240, l2 = s2 >> 4, col = 64 * (s2 & 15); src = CTX_IN(13) + (size_t)l2 * DF * D + col; ld = 1024; Kd = 256; dst = (u16*)(ws + WS_WSD) + (size_t)l2 * D * DF + (size_t)col * 256; }
        else { const int s2 = seg - 272, l2 = s2 >> 2, col = 64 * (s2 & 3); src = CTX_IN(6) + (size_t)l2 * D * NE + col; ld = 256; dst = (u16*)(ws + WS_WRH) + (size_t)l2 * NE * D + (size_t)col * 1024; dst_lo = (u16*)(ws + WS_WRL) + (size_t)l2 * NE * D + (size_t)col * 1024; }
        {
            const int kr = tid >> 4, c4 = tid & 15;
#pragma unroll
            for (int i = 0; i < 2; ++i) {
                const f32x4 v = *(const f32x4*)(src + (size_t)(kt * 64 + kr + 32 * i) * ld + 4 * c4);
#pragma unroll
                for (int jj = 0; jj < 4; ++jj) tl[(kr + 32 * i) * 65 + 4 * c4 + jj] = v[jj];
            }
        }
        __syncthreads();
        {
            const int row = tid >> 3, kc = tid & 7;
            float f[8];
#pragma unroll
            for (int jj = 0; jj < 8; ++jj) f[jj] = tl[(8 * kc + jj) * 65 + row];
            u32x4 w; w[0] = cvtpk(f[0], f[1]); w[1] = cvtpk(f[2], f[3]); w[2] = cvtpk(f[4], f[5]); w[3] = cvtpk(f[6], f[7]);
            *(u32x4*)(dst + (size_t)row * Kd + kt * 64 + 8 * kc) = w;
            if (dst_lo) {
                u32x4 wl;
#pragma unroll
                for (int jj = 0; jj < 4; ++jj) wl[jj] = cvtpk(f[2 * jj] - bf2f(w[jj] & 0xFFFFu), f[2 * jj + 1] - bf2f(w[jj] >> 16));
                *(u32x4*)(dst_lo + (size_t)row * Kd + kt * 64 + 8 * kc) = wl;
            }
        }
        __syncthreads();
    }
}

__device__ __forceinline__ void ph_qkv(int L, int rep_, const int wave_s_) {
    PH_FN_BEGIN
    (void)rep_;
    const pg8::Gemm g{P_xb, (const u16*)(ws + (L == 0 ? WS_WQK0 : WS_WQK1)), T, NQ, D};
    pg8::StaticOrder S; S.init(g.M, g.N, G, bid);
    const EpiQK E{P_qkv, NQ};
    pg8::gemm_phase<EpiQK, pg8::StaticOrder, false>((PG8_LAS unsigned char*)lds, g, S, E, nullptr, wave_s_ * 64 + lane_id_());
}

__device__ __forceinline__ void ph_kmean(int L, int rep_, const int wave_s_) {
    PH_FN_BEGIN
    (void)rep_;
    PH_BEGIN;
    LAS float* red = (LAS float*)lds;
    for (int it = bid; it < BATCH * NH * MOBA_NB; it += G) {
        const int j = it & 31, h = (it >> 5) & 15, b = it >> 9;
        const int kg_ = tid >> 3, ch = tid & 7;
        const u16* kp = P_qkv + (size_t)(b * SEQ + j * MOBA_BLK + kg_) * 3072 + 1024 + h * 64 + ch * 8;
        float sm[8];
#pragma unroll
        for (int e2 = 0; e2 < 8; ++e2) sm[e2] = 0.f;
#pragma unroll
        for (int i = 0; i < 4; ++i) {
            const u32x4 v = *(const u32x4*)(kp + (size_t)(64 * i) * 3072);
#pragma unroll
            for (int e2 = 0; e2 < 4; ++e2) { sm[2 * e2] += bf2f(v[e2] & 0xFFFFu); sm[2 * e2 + 1] += bf2f(v[e2] >> 16); }
        }
#pragma unroll
        for (int e2 = 0; e2 < 8; ++e2) red[kg_ * 65 + ch * 8 + e2] = sm[e2];
        __syncthreads();
        if (tid < 64) {
            float tot = 0.f;
#pragma unroll 8
            for (int q = 0; q < 64; ++q) tot += red[q * 65 + tid];
            P_kmean[(size_t)it * 64 + tid] = tot * (1.f / MOBA_BLK);
        }
        __syncthreads();
    }
}

__device__ __forceinline__ void ph_gate(int L, int rep_, const int wave_s_) {
    PH_FN_BEGIN
    (void)rep_;
    PH_BEGIN;
    for (int it = bid; it < BATCH * NH * MOBA_NB; it += G) {
        const int qb = it & 31, bh = it >> 5, b = bh >> 4, h = bh & 15;
        const int tq = qb * MOBA_BLK + wave * 32 + r32;
        const u16* qrow = P_qkv + (size_t)(b * SEQ + tq) * 3072 + h * 64 + hi * 8;
        bf16x8 qf[4];
#pragma unroll
        for (int d0 = 0; d0 < 4; ++d0) qf[d0] = *(const bf16x8*)(qrow + d0 * 16);
        unsigned selmask = 0u;
        if (qb > 0) {
            const float* km = P_kmean + ((size_t)(b * NH + h) * MOBA_NB + r32) * 64 + hi * 8;
            f32x16 gt;
#pragma unroll
            for (int r = 0; r < 16; ++r) gt[r] = 0.f;
#pragma unroll
            for (int d0 = 0; d0 < 4; ++d0) {
                const f32x4 k0 = *(const f32x4*)(km + d0 * 16), k1 = *(const f32x4*)(km + d0 * 16 + 4);
                union { bf16x8 v; unsigned u[4]; } kf;
                kf.u[0] = cvtpk(k0[0], k0[1]); kf.u[1] = cvtpk(k0[2], k0[3]); kf.u[2] = cvtpk(k1[0], k1[1]); kf.u[3] = cvtpk(k1[2], k1[3]);
                gt = MFMA_BF16(kf.v, qf[d0], gt);
            }
            float v0 = -INFINITY, v1 = -INFINITY, v2 = -INFINITY; int i0 = 99, i1 = 99, i2 = 99;
#pragma unroll
            for (int r = 0; r < 16; ++r) { const int jb = crow(r, hi); const float gv = jb < qb ? gt[r] : -INFINITY; top3_insert(gv, jb < qb ? jb : 99, v0, i0, v1, i1, v2, i2); }
            const float ov0 = shxf(v0, 32, lane), ov1 = shxf(v1, 32, lane), ov2 = shxf(v2, 32, lane);
            const int oi0 = shxi(i0, 32, lane), oi1 = shxi(i1, 32, lane), oi2 = shxi(i2, 32, lane);
            top3_insert(ov0, oi0, v0, i0, v1, i1, v2, i2); top3_insert(ov1, oi1, v0, i0, v1, i1, v2, i2); top3_insert(ov2, oi2, v0, i0, v1, i1, v2, i2);
            if (i0 < 32) selmask |= 1u << i0;
            if (i1 < 32) selmask |= 1u << i1;
            if (i2 < 32) selmask |= 1u << i2;
        }
        if (hi == 0) P_selm[(size_t)bh * SEQ + tq] = selmask;
    }
}

constexpr int MB_KP = 72;
constexpr int MB_VP = 260;
constexpr int MB_LDS_K = 0;
constexpr int MB_LDS_V = 256 * MB_KP * 2;
constexpr int MB_LDS_LIST = MB_LDS_V + 64 * MB_VP * 2;
constexpr int MB_LDS_CTR = MB_LDS_LIST + 8192 * 2;
__device__ __forceinline__ void ph_moba(int L, int rep_, const int wave_s_) {
    PH_FN_BEGIN
    (void)rep_;
    PH_BEGIN;
    LAS char* Ks = lds + MB_LDS_K; LAS char* Vs = lds + MB_LDS_V;
    LAS u16* qlist = (LAS u16*)(lds + MB_LDS_LIST); LAS int* ctr = (LAS int*)(lds + MB_LDS_CTR);
    for (int it = bid; it < BATCH * NH * MOBA_NB; it += G) {
        const int rnd = it >> 8, w8 = it & 255, a8 = w8 >> 5, bh = w8 & 31;
        const int j = rnd == 0 ? a8 : (rnd == 1 ? 15 - a8 : (rnd == 2 ? 16 + a8 : 31 - a8));
        const int b = bh >> 4, h = bh & 15;
        const float slope2 = exp2f(-0.5f * (float)(h + 1)) * LOG2E;
        if (tid == 0) { int z0 = 0; asm volatile("" : "+v"(z0)); ctr[0] = z0; ctr[1] = z0; }
        {
            const u16* kg = P_qkv + (size_t)(b * SEQ + j * MOBA_BLK) * 3072 + 1024 + h * 64;
#pragma unroll
            for (int i = 0; i < 4; ++i) { const int c = tid + i * 512, row = c >> 3, ch = c & 7; *(LAS u32x4*)(Ks + (row * MB_KP + ch * 8) * 2) = *(const u32x4*)(kg + (size_t)row * 3072 + ch * 8); }
            const u16* vg = P_qkv + (size_t)(b * SEQ + j * MOBA_BLK) * 3072 + 2048 + h * 64;
#pragma unroll
            for (int i = 0; i < 4; ++i) {
                const int c = tid + i * 512, key = c >> 3, ch = c & 7;
                const u32x4 v = *(const u32x4*)(vg + (size_t)key * 3072 + ch * 8);
#pragma unroll
                for (int e2 = 0; e2 < 4; ++e2) {
                    *(LAS u16*)(Vs + ((ch * 8 + 2 * e2) * MB_VP + key) * 2) = (u16)(v[e2] & 0xFFFFu);
                    *(LAS u16*)(Vs + ((ch * 8 + 2 * e2 + 1) * MB_VP + key) * 2) = (u16)(v[e2] >> 16);
                }
            }
        }
        __syncthreads();
        {
            const unsigned* sm = P_selm + (size_t)bh * SEQ;
            for (int t0 = (j + 1) * MOBA_BLK; t0 < SEQ; t0 += 512) {
                const int t = t0 + tid;
                const bool sel = (t < SEQ) && ((sm[t < SEQ ? t : 0] >> j) & 1u);
                const unsigned long long bal = __ballot(sel);
                const int total = __popcll(bal);
                int wb = 0;
                if (lane == 0 && total) wb = atomicAdd((int*)&ctr[0], total);
                wb = __builtin_amdgcn_readfirstlane(wb);
                if (sel) qlist[wb + __popcll(bal & ((1ull << lane) - 1ull))] = (u16)t;
            }
        }
        __syncthreads();
        const int nq = ctr[0];
        const int ntiles = 8 + ((nq + 31) >> 5);
        for (;;) {
            int ti = 0;
            if (lane == 0) ti = atomicAdd((int*)&ctr[1], 1);
            ti = __builtin_amdgcn_readfirstlane(ti);
            if (ti >= ntiles) break;
            const bool own = ti < 8;
            const int wq = 7 - ti;
            const int li = (ti - 8) * 32 + r32;
            const bool valid = own || li < nq;
            const int tq = own ? j * MOBA_BLK + wq * 32 + r32 : (int)qlist[li < nq ? li : nq - 1];
            const int nsteps = own ? wq + 1 : 8;
            const u16* qrow = P_qkv + (size_t)(b * SEQ + tq) * 3072 + h * 64 + hi * 8;
            bf16x8 qf[4];
#pragma unroll
            for (int d0 = 0; d0 < 4; ++d0) qf[d0] = *(const bf16x8*)(qrow + d0 * 16);
            int slot = 3;
            if (!own) slot = __popc(P_selm[(size_t)bh * SEQ + tq] & ((1u << j) - 1u));
            AttnSt st; st.m = NEGV; st.l = 0.f;
#pragma unroll
            for (int r = 0; r < 16; ++r) { st.o0[r] = 0.f; st.o1[r] = 0.f; }
            const int dlo = own ? 0 : -0x40000000;
            for (int kt = 0; kt < nsteps; ++kt) {
                AttnFr f;
#pragma unroll
                for (int d0 = 0; d0 < 4; ++d0) f.k[d0] = *(LAS bf16x8*)(Ks + ((kt * 32 + r32) * MB_KP + d0 * 16 + hi * 8) * 2);
#pragma unroll
                for (int q4 = 0; q4 < 4; ++q4) {
                    union { bf16x8 v; u32x2 hh[2]; } va;
                    LAS char* vp = Vs + (((q4 >> 1) * 32 + r32) * MB_VP + kt * 32 + (q4 & 1) * 16 + 4 * hi) * 2;
                    va.hh[0] = *(LAS u32x2*)(vp); va.hh[1] = *(LAS u32x2*)(vp + 16);
                    f.v[q4] = va.v;
                }
                attn_compute(st, qf, f, tq - (j * MOBA_BLK + kt * 32) - 4 * hi, slope2, dlo, 0x7fffffff, hi, lane);
            }
            const float lt = st.l + shxf(st.l, 32, lane);
            const float inv = 1.f / lt;
            if (valid) {
                const size_t pi = ((size_t)(b * SEQ + tq) * NH + h) * 4 + slot;
                u16* orow = P_part + pi * 64;
#pragma unroll
                for (int rq = 0; rq < 4; ++rq) {
                    u32x2 w; w[0] = cvtpk(st.o0[4 * rq] * inv, st.o0[4 * rq + 1] * inv); w[1] = cvtpk(st.o0[4 * rq + 2] * inv, st.o0[4 * rq + 3] * inv);
                    *(u32x2*)(orow + 8 * rq + 4 * hi) = w;
                    w[0] = cvtpk(st.o1[4 * rq] * inv, st.o1[4 * rq + 1] * inv); w[1] = cvtpk(st.o1[4 * rq + 2] * inv, st.o1[4 * rq + 3] * inv);
                    *(u32x2*)(orow + 32 + 8 * rq + 4 * hi) = w;
                }
                if (hi == 0) P_plse[pi] = st.m * LN2 + logf(lt);
            }
        }
        __syncthreads();
    }
}

__device__ __forceinline__ void ph_mobamerge(int L, int rep_, const int wave_s_) {
    PH_FN_BEGIN
    (void)rep_;
    PH_BEGIN;
    for (size_t i = (size_t)bid * NTHR + tid; i < (size_t)T * NH * 8; i += (size_t)G * NTHR) {
        const size_t row = i >> 7; const int h = (int)(i >> 3) & 15, d8 = (int)i & 7;
        const int qb = (int)(row & (SEQ - 1)) >> 8;
        const int nsel = qb < 3 ? qb : 3;
        const size_t pi = (row * NH + h) * 4;
        float l[4], w[4];
        float mx = -INFINITY;
#pragma unroll
        for (int sidx = 0; sidx < 4; ++sidx) { const bool ok = sidx == 3 || sidx < nsel; l[sidx] = ok ? P_plse[pi + sidx] : -INFINITY; mx = fmaxf(mx, l[sidx]); }
        float ws_ = 0.f;
#pragma unroll
        for (int sidx = 0; sidx < 4; ++sidx) { w[sidx] = (sidx == 3 || sidx < nsel) ? expf(l[sidx] - mx) : 0.f; ws_ += w[sidx]; }
        const float inv = 1.f / ws_;
        float acc8[8];
#pragma unroll
        for (int c = 0; c < 8; ++c) acc8[c] = 0.f;
#pragma unroll
        for (int sidx = 0; sidx < 4; ++sidx) {
            if (sidx == 3 || sidx < nsel) {
                const u32x4 a = *(const u32x4*)(P_part + (pi + sidx) * 64 + d8 * 8);
                const float ww = w[sidx] * inv;
#pragma unroll
                for (int c = 0; c < 4; ++c) { acc8[2 * c] += ww * bf2f(a[c] & 0xFFFFu); acc8[2 * c + 1] += ww * bf2f(a[c] >> 16); }
            }
        }
        u32x4 o;
#pragma unroll
        for (int c = 0; c < 4; ++c) o[c] = cvtpk(acc8[2 * c], acc8[2 * c + 1]);
        *(u32x4*)(P_ao + row * D + h * 64 + d8 * 8) = o;
    }
}

constexpr int DL_KP = 72, DL_VP = 388;
constexpr int DL_LDS_K = 0, DL_LDS_V = 384 * DL_KP * 2;
__device__ __forceinline__ void ph_dil(int L, int rep_, const int wave_s_) {
    PH_FN_BEGIN
    (void)rep_;
    PH_BEGIN;
    LAS char* Ks = lds + DL_LDS_K; LAS char* Vs = lds + DL_LDS_V;
    for (int it = bid; it < BATCH * NH * 3 * 32; it += G) {
        const int ch = it & 31, grp = (it >> 5) % 3, bh = it / 96, b = bh >> 4, h = bh & 15;
        const int dil = grp == 0 ? 1 : (grp == 1 ? 4 : 16), Ls = SEQ / dil;
        const float slope2 = exp2f(-0.5f * (float)(h + 1)) * LOG2E * (float)dil;
        const int uc = ch * 256, res = uc / Ls, c0 = uc - res * Ls;
        const int kb0 = c0 - 128;
        {
            const u16* kg = P_qkv + (size_t)(b * SEQ) * 9216 + grp * 3072 + 1024 + h * 64;
#pragma unroll
            for (int i = 0; i < 6; ++i) {
                const int c = tid + i * 512, row = c >> 3, chk = c & 7, ks = kb0 + row;
                if (ks >= 0) *(LAS u32x4*)(Ks + (row * DL_KP + chk * 8) * 2) = *(const u32x4*)(kg + (size_t)(ks * dil + res) * 9216 + chk * 8);
            }
            const u16* vg = P_qkv + (size_t)(b * SEQ) * 9216 + grp * 3072 + 2048 + h * 64;
#pragma unroll
            for (int i = 0; i < 6; ++i) {
                const int c = tid + i * 512, row = c >> 3, chk = c & 7, ks = kb0 + row;
                if (ks >= 0) {
                    const u32x4 v = *(const u32x4*)(vg + (size_t)(ks * dil + res) * 9216 + chk * 8);
#pragma unroll
                    for (int e2 = 0; e2 < 4; ++e2) {
                        *(LAS u16*)(Vs + ((chk * 8 + 2 * e2) * DL_VP + row) * 2) = (u16)(v[e2] & 0xFFFFu);
                        *(LAS u16*)(Vs + ((chk * 8 + 2 * e2 + 1) * DL_VP + row) * 2) = (u16)(v[e2] >> 16);
                    }
                }
            }
        }
        const int i0 = c0 + wave * 32, iq = i0 + r32, pq = iq * dil + res;
        const u16* qrow = P_qkv + (size_t)(b * SEQ + pq) * 9216 + grp * 3072 + h * 64 + hi * 8;
        bf16x8 qf[4];
#pragma unroll
        for (int d0 = 0; d0 < 4; ++d0) qf[d0] = *(const bf16x8*)(qrow + d0 * 16);
        __syncthreads();
        AttnSt st; st.m = NEGV; st.l = 0.f;
#pragma unroll
        for (int r = 0; r < 16; ++r) { st.o0[r] = 0.f; st.o1[r] = 0.f; }
        const int ktmin = (i0 >= 128) ? 0 : (128 - i0) >> 5;
        for (int kt = 4; kt >= ktmin; --kt) {
            const int lrow0 = (wave + kt) * 32;
            AttnFr f;
#pragma unroll
            for (int d0 = 0; d0 < 4; ++d0) f.k[d0] = *(LAS bf16x8*)(Ks + ((lrow0 + r32) * DL_KP + d0 * 16 + hi * 8) * 2);
#pragma unroll
            for (int q4 = 0; q4 < 4; ++q4) {
                union { bf16x8 v; u32x2 hh[2]; } va;
                LAS char* vp = Vs + (((q4 >> 1) * 32 + r32) * DL_VP + lrow0 + (q4 & 1) * 16 + 4 * hi) * 2;
                va.hh[0] = *(LAS u32x2*)(vp); va.hh[1] = *(LAS u32x2*)(vp + 16);
                f.v[q4] = va.v;
            }
            const int k0 = i0 - 128 + kt * 32;
            attn_compute(st, qf, f, iq - k0 - 4 * hi, slope2, 0, 128, hi, lane);
        }
        const float lt = st.l + shxf(st.l, 32, lane);
        const float inv = 1.f / lt;
        u16* orow = P_og + (size_t)grp * T * D + (size_t)(b * SEQ + pq) * D + h * 64;
#pragma unroll
        for (int rq = 0; rq < 4; ++rq) {
            u32x2 w; w[0] = cvtpk(st.o0[4 * rq] * inv, st.o0[4 * rq + 1] * inv); w[1] = cvtpk(st.o0[4 * rq + 2] * inv, st.o0[4 * rq + 3] * inv);
            *(u32x2*)(orow + 8 * rq + 4 * hi) = w;
            w[0] = cvtpk(st.o1[4 * rq] * inv, st.o1[4 * rq + 1] * inv); w[1] = cvtpk(st.o1[4 * rq + 2] * inv, st.o1[4 * rq + 3] * inv);
            *(u32x2*)(orow + 32 + 8 * rq + 4 * hi) = w;
        }
        if (hi == 0) P_lse[((size_t)grp * T + (b * SEQ + pq)) * NH + h] = st.m * LN2 + logf(lt);
        __syncthreads();
    }
}

__device__ __forceinline__ void ph_merge(int L, int rep_, const int wave_s_) {
    PH_FN_BEGIN
    (void)rep_;

            PH_BEGIN;
                for (size_t i = (size_t)bid * NTHR + tid; i < (size_t)T * NH * 8; i += (size_t)G * NTHR) {
                    const size_t row = i >> 7; const int h = (int)(i >> 3) & 15, d8 = (int)i & 7;
                    const float l0 = P_lse[(0 * (size_t)T + row) * NH + h], l1 = P_lse[(1 * (size_t)T + row) * NH + h], l2 = P_lse[(2 * (size_t)T + row) * NH + h];
                    const float mx = fmaxf(l0, fmaxf(l1, l2));
                    float w0 = expf(l0 - mx), w1 = expf(l1 - mx), w2 = expf(l2 - mx);
                    const float inv = 1.f / (w0 + w1 + w2); w0 *= inv; w1 *= inv; w2 *= inv;
                    const size_t off = row * D + h * 64 + d8 * 8;
                    const u32x4 a0 = *(const u32x4*)(P_og + off), a1 = *(const u32x4*)(P_og + (size_t)T * D + off), a2 = *(const u32x4*)(P_og + 2 * (size_t)T * D + off);
                    u32x4 o;
#pragma unroll
                    for (int c = 0; c < 4; ++c) {
                        const float lo_ = w0 * bf2f(a0[c] & 0xFFFFu) + w1 * bf2f(a1[c] & 0xFFFFu) + w2 * bf2f(a2[c] & 0xFFFFu);
                        const float hi_ = w0 * bf2f(a0[c] >> 16) + w1 * bf2f(a1[c] >> 16) + w2 * bf2f(a2[c] >> 16);
                        o[c] = cvtpk(lo_, hi_);
                    }
                    *(u32x4*)(P_ao + off) = o;
                }

}

__device__ __forceinline__ void ph_wo(int L, int rep_, const int wave_s_) {
    PH_FN_BEGIN
    (void)rep_;
    const pg8::Gemm g{P_ao, (const u16*)(ws + WS_WO) + (size_t)L * D * D, T, D, D};
    pg8::StaticOrder S; S.init(g.M, g.N, G, bid);
    const EpiWo E{P_ypre, L == 0 ? CTX_IN(0) : (const float*)P_x2};
    pg8::gemm_phase<EpiWo, pg8::StaticOrder, false>((PG8_LAS unsigned char*)lds, g, S, E, nullptr, wave_s_ * 64 + lane_id_());
}

constexpr int RT_P = 144;
constexpr int RT_LDS_AH = 0, RT_LDS_AL = 64 * RT_P;
constexpr int RT_LDS_BH = 2 * 64 * RT_P, RT_LDS_BL = RT_LDS_BH + 256 * RT_P;
constexpr int RT_LDS_ST = RT_LDS_BL + 256 * RT_P;
__device__ __forceinline__ void ph_router(int L, int rep_, const int wave_s_) {
    PH_FN_BEGIN
    (void)rep_;
    PH_BEGIN;
    const float* lng = CTX_IN(4) + L * D; const float* lnb = CTX_IN(5) + L * D;
    const float* rbias = CTX_IN(7) + L * NE;
    const u16* wrh = (const u16*)(ws + WS_WRH) + (size_t)L * NE * D; const u16* wrl = (const u16*)(ws + WS_WRL) + (size_t)L * NE * D;
    LAS float* stat = (LAS float*)(lds + RT_LDS_ST);
    for (int it = bid; it < T / 64; it += G) {
#pragma unroll 1
        for (int hb_ = 0; hb_ < 2; ++hb_) {
            f32x4 yv[4][4];
#pragma unroll
            for (int rr = 0; rr < 4; ++rr)
#pragma unroll
                for (int j = 0; j < 4; ++j) yv[rr][j] = *(const f32x4*)(P_ypre + ((size_t)it * 64 + wave * 8 + hb_ * 4 + rr) * D + j * 256 + lane * 4);
#pragma unroll
            for (int rr = 0; rr < 4; ++rr) {
                float sm = 0.f;
#pragma unroll
                for (int j = 0; j < 4; ++j) sm += (yv[rr][j][0] + yv[rr][j][1]) + (yv[rr][j][2] + yv[rr][j][3]);
                const float mu = wave_sum(sm) * (1.f / D);
                float q = 0.f;
#pragma unroll
                for (int j = 0; j < 4; ++j)
#pragma unroll
                    for (int c = 0; c < 4; ++c) { const float d_ = yv[rr][j][c] - mu; q += d_ * d_; }
                const float rstd = rsqrtf(wave_sum(q) * (1.f / D) + LN_EPS);
                if (lane == 0) { stat[wave * 8 + hb_ * 4 + rr] = mu; stat[64 + wave * 8 + hb_ * 4 + rr] = rstd; }
            }
        }
        __syncthreads();
        const int arow = tid >> 3, aq = tid & 7;
        const float amu = stat[arow], ars = stat[64 + arow];
        const float* yp = P_ypre + ((size_t)it * 64 + arow) * D + aq * 8;
        f32x4 ya0 = *(const f32x4*)(yp), ya1 = *(const f32x4*)(yp + 4);
        u32x4 bw[8];
#pragma unroll
        for (int i = 0; i < 8; ++i) { const int p_ = tid + 512 * (i & 3); bw[i] = *(const u32x4*)((i < 4 ? wrh : wrl) + (size_t)(p_ >> 3) * D + (p_ & 7) * 8); }
        f32x16 lg[2];
#pragma unroll
        for (int r = 0; r < 16; ++r) { lg[0][r] = 0.f; lg[1][r] = 0.f; }
#pragma unroll 1
        for (int kc = 0; kc < 16; ++kc) {
            const int k0 = kc * 64;
            {
                const f32x4 g0 = *(const f32x4*)(lng + k0 + aq * 8), g1 = *(const f32x4*)(lng + k0 + aq * 8 + 4);
                const f32x4 b0 = *(const f32x4*)(lnb + k0 + aq * 8), b1 = *(const f32x4*)(lnb + k0 + aq * 8 + 4);
                f32x4 x0, x1v;
#pragma unroll
                for (int c = 0; c < 4; ++c) { x0[c] = (ya0[c] - amu) * ars * g0[c] + b0[c]; x1v[c] = (ya1[c] - amu) * ars * g1[c] + b1[c]; }
                const size_t go = ((size_t)it * 64 + arow) * D + k0 + aq * 8;
                *(f32x4*)(P_x1 + go) = x0; *(f32x4*)(P_x1 + go + 4) = x1v;
                u32x4 wh; wh[0] = cvtpk(x0[0], x0[1]); wh[1] = cvtpk(x0[2], x0[3]); wh[2] = cvtpk(x1v[0], x1v[1]); wh[3] = cvtpk(x1v[2], x1v[3]);
                *(u32x4*)(P_xb + go) = wh;
                u32x2 w8; w8[0] = pack_fp8x4(x0[0], x0[1], x0[2], x0[3]); w8[1] = pack_fp8x4(x1v[0], x1v[1], x1v[2], x1v[3]);
                *(u32x2*)(P_xb8 + go) = w8;
                u32x4 wl;
                wl[0] = cvtpk(x0[0] - bf2f(wh[0] & 0xFFFFu), x0[1] - bf2f(wh[0] >> 16)); wl[1] = cvtpk(x0[2] - bf2f(wh[1] & 0xFFFFu), x0[3] - bf2f(wh[1] >> 16));
                wl[2] = cvtpk(x1v[0] - bf2f(wh[2] & 0xFFFFu), x1v[1] - bf2f(wh[2] >> 16)); wl[3] = cvtpk(x1v[2] - bf2f(wh[3] & 0xFFFFu), x1v[3] - bf2f(wh[3] >> 16));
                *(LAS u32x4*)(lds + RT_LDS_AH + arow * RT_P + aq * 16) = wh;
                *(LAS u32x4*)(lds + RT_LDS_AL + arow * RT_P + aq * 16) = wl;
#pragma unroll
                for (int i = 0; i < 8; ++i) { const int p_ = tid + 512 * (i & 3); *(LAS u32x4*)(lds + (i < 4 ? RT_LDS_BH : RT_LDS_BL) + (p_ >> 3) * RT_P + (p_ & 7) * 16) = bw[i]; }
            }
            __syncthreads();
            {
                const int kn = (kc + 1 < 16) ? k0 + 64 : 0;
                ya0 = *(const f32x4*)(yp + kn); ya1 = *(const f32x4*)(yp + kn + 4);
#pragma unroll
                for (int i = 0; i < 8; ++i) { const int p_ = tid + 512 * (i & 3); bw[i] = *(const u32x4*)((i < 4 ? wrh : wrl) + (size_t)(p_ >> 3) * D + kn + (p_ & 7) * 8); }
            }
#pragma unroll
            for (int sk = 0; sk < 4; ++sk) {
                const int ko = (sk * 16 + hi * 8) * 2;
                const bf16x8 bh_ = *(const LAS bf16x8*)(lds + RT_LDS_BH + (wave * 32 + r32) * RT_P + ko), bl_ = *(const LAS bf16x8*)(lds + RT_LDS_BL + (wave * 32 + r32) * RT_P + ko);
#pragma unroll
                for (int rb = 0; rb < 2; ++rb) {
                    const bf16x8 xh = *(const LAS bf16x8*)(lds + RT_LDS_AH + (rb * 32 + r32) * RT_P + ko), xl = *(const LAS bf16x8*)(lds + RT_LDS_AL + (rb * 32 + r32) * RT_P + ko);
                    lg[rb] = MFMA_BF16(xh, bh_, lg[rb]); lg[rb] = MFMA_BF16(xl, bh_, lg[rb]); lg[rb] = MFMA_BF16(xh, bl_, lg[rb]);
                }
            }
            __syncthreads();
        }
        LAS float* lgs = (LAS float*)lds;
#pragma unroll
        for (int rb = 0; rb < 2; ++rb)
#pragma unroll
            for (int r = 0; r < 16; ++r) lgs[(rb * 32 + crow(r, hi)) * 257 + wave * 32 + r32] = lg[rb][r];
        __syncthreads();
#pragma unroll 1
        for (int tg = 0; tg < 2; ++tg) {
            float sc[4][4], cv[4][4];
#pragma unroll
            for (int tt = 0; tt < 4; ++tt) {
                const int lr = wave * 8 + tg * 4 + tt;
#pragma unroll
                for (int j = 0; j < 4; ++j) { const int e = lane + 64 * j; sc[tt][j] = 1.f / (1.f + __expf(-lgs[lr * 257 + e])); cv[tt][j] = sc[tt][j] + rbias[e]; }
            }
            float gsel[4][8];
#pragma unroll
            for (int j = 0; j < 4; ++j) {
#pragma unroll
                for (int tt = 0; tt < 4; ++tt) {
                    const float rm = dpp_rowmax(cv[tt][j]);
                    const float m1a = fmaxf(rl_f(rm, 0), rl_f(rm, 16)), m1b = fmaxf(rl_f(rm, 32), rl_f(rm, 48));
                    const unsigned long long bal = __ballot(cv[tt][j] == (hi ? m1b : m1a));
                    const int fa_ = __builtin_ctz((unsigned)(bal & 0xFFFFFFFFull)), fb_ = 32 + __builtin_ctz((unsigned)(bal >> 32));
                    const float c2 = (lane == fa_ || lane == fb_) ? -INFINITY : cv[tt][j];
                    const float rm2 = dpp_rowmax(c2);
                    gsel[tt][2 * j] = m1a + fmaxf(rl_f(rm2, 0), rl_f(rm2, 16));
                    gsel[tt][2 * j + 1] = m1b + fmaxf(rl_f(rm2, 32), rl_f(rm2, 48));
                }
            }
#pragma unroll
            for (int tt = 0; tt < 4; ++tt)
#pragma unroll
                for (int j = 0; j < 4; ++j) {
                    int ra_ = 0, rb_ = 0;
#pragma unroll
                    for (int g2 = 0; g2 < 8; ++g2) {
                        ra_ += ((gsel[tt][g2] > gsel[tt][2 * j]) || (gsel[tt][g2] == gsel[tt][2 * j] && g2 < 2 * j)) ? 1 : 0;
                        rb_ += ((gsel[tt][g2] > gsel[tt][2 * j + 1]) || (gsel[tt][g2] == gsel[tt][2 * j + 1] && g2 < 2 * j + 1)) ? 1 : 0;
                    }
                    cv[tt][j] = ((hi ? rb_ : ra_) < 4) ? cv[tt][j] : NEGV;
                }
            float wsel[4], wsum[4]; int esel[4];
#pragma unroll
            for (int tt = 0; tt < 4; ++tt) { wsel[tt] = 0.f; wsum[tt] = 0.f; esel[tt] = 0; }
#pragma unroll 1
            for (int k = 0; k < TOPK; ++k) {
#pragma unroll
                for (int tt = 0; tt < 4; ++tt) {
                    float bv = cv[tt][0]; int be = lane;
#pragma unroll
                    for (int j = 1; j < 4; ++j) if (cv[tt][j] > bv) { bv = cv[tt][j]; be = lane + 64 * j; }
                    const float rm = dpp_rowmax(bv);
                    const float mval = fmaxf(fmaxf(rl_f(rm, 0), rl_f(rm, 16)), fmaxf(rl_f(rm, 32), rl_f(rm, 48)));
                    const int ri = dpp_rowmin_i(bv == mval ? be : 0x7fffffff);
                    const int e = min(min(__builtin_amdgcn_readlane(ri, 0), __builtin_amdgcn_readlane(ri, 16)), min(__builtin_amdgcn_readlane(ri, 32), __builtin_amdgcn_readlane(ri, 48)));
                    const int jl = e >> 6, ll = e & 63;
                    const float smine = ((jl == 0 ? sc[tt][0] : 0.f) + (jl == 1 ? sc[tt][1] : 0.f)) + ((jl == 2 ? sc[tt][2] : 0.f) + (jl == 3 ? sc[tt][3] : 0.f));
                    const float sw = rl_f(smine, ll);
#pragma unroll
                    for (int j = 0; j < 4; ++j) cv[tt][j] = (lane == ll && jl == j) ? -INFINITY : cv[tt][j];
                    wsum[tt] += sw;
                    if (lane == k) { wsel[tt] = sw; esel[tt] = e; }
                }
            }
#pragma unroll
            for (int tt = 0; tt < 4; ++tt) {
                if (lane < TOPK) {
                    const int tok = it * 64 + wave * 8 + tg * 4 + tt;
                    const int a = tok * TOPK + lane;
                    P_topw[a] = wsel[tt] / wsum[tt] * 2.5f;
                    if (rep_ == 0) {
                        const int pos = atomicAdd(&cnt[esel[tt] * CNT_STRIDE], 1);
                        P_list[(size_t)esel[tt] * T + pos] = a;
                    }
                }
            }
        }
        __syncthreads();
    }
}

__device__ __forceinline__ void ph_gateup(int L, int rep_, const int wave_s_) {
    PH_FN_BEGIN
    (void)rep_;
    {
        PH_BEGIN;
        const float* weg = CTX_IN(8) + (size_t)L * NE * D * DF; const float* weu = CTX_IN(9) + (size_t)L * NE * D * DF;
        LAS int* rowva = (LAS int*)(lds + MOE_LDS_VA);
        {
            int* octr = (int*)(ws + WS_CTL + CTL_CNT_OFF + 8192) + (L * 4 + 2 * (rep_ & 1)) * 64;
            LAS int* slot = (LAS int*)(lds + 140000);
            for (;;) {
                __syncthreads();
                if (tid == 0) { int q; do { q = atomicAdd(octr, 1); } while (q >= NE && q < NE * 5 && cnt[((q - NE) >> 2) * CNT_STRIDE] <= 512); *slot = q; }
                __syncthreads();
                const int q = *slot;
                if (q >= NE * 5) break;
                const bool ovf = q >= NE;
                const int e = ovf ? (q - NE) >> 2 : q, pz = ovf ? (q - NE) & 3 : 0, npz = ovf ? 1 : 4, st0 = ovf ? 1 : 0, n = cnt[e * CNT_STRIDE];
                for (int r0 = 0; r0 < n; r0 += 1024) {
                    if (ovf && n - r0 <= 512) break;
#pragma unroll
                    for (int i = 0; i < 2; ++i) { int t_ = tid; asm volatile("" : "+v"(t_)); const int idx = r0 + i * 512 + t_; rowva[i * 512 + t_] = idx < n ? P_list[(size_t)e * T + idx] : TRASH_VA; }
                    __syncthreads();
                    moe_expert<false>(lds, tid, lane, wave, r32, hi, P_xb8, weg + (size_t)e * D * DF, weu + (size_t)e * D * DF, (n - r0) < 1024 ? (n - r0) : 1024, (void*)P_hb, pz, npz, st0, 1);
                }
            }
        }
    }
    {
        PH_BEGIN;
        const pg8::Gemm g{P_xb, (const u16*)(ws + WS_WSGU) + (size_t)L * 512 * 1024, T, 512, D};
        const EpiSGU E{P_hbs};
        int* qctr = (int*)(ws + WS_CTL + CTL_CNT_OFF + 4096) + (L * 4 + 2 * (rep_ & 1)) * 64;
        LAS int* slot = (LAS int*)(lds + 140000);
        for (;;) {
            __syncthreads();
            if (tid == 0) *slot = atomicAdd(qctr, 1);
            __syncthreads();
            const int un = *slot;
            if (un >= 128) break;
            const pg8::FixedOrder S{un & 63, un >> 6};
            pg8::gemm_phase<EpiSGU, pg8::FixedOrder, false>((PG8_LAS unsigned char*)lds, g, S, E, nullptr, wave_s_ * 64 + lane_id_());
        }
    }
}

__device__ __forceinline__ void ph_down(int L, int rep_, const int wave_s_) {
    PH_FN_BEGIN
    (void)rep_;
    {
        PH_BEGIN;
        const float* wed = CTX_IN(10) + (size_t)L * NE * DF * D;
        LAS int* rowva = (LAS int*)(lds + MOE_LDS_VA); LAS float* roww = (LAS float*)(lds + MOE_LDS_W);
        {
            int* octr = (int*)(ws + WS_CTL + CTL_CNT_OFF + 8192) + (L * 4 + 1 + 2 * (rep_ & 1)) * 64;
            LAS int* slot = (LAS int*)(lds + 140000);
            for (;;) {
                __syncthreads();
                if (tid == 0) { int q; do { q = atomicAdd(octr, 1); } while (q >= NE && q < NE * 5 && cnt[((q - NE) >> 2) * CNT_STRIDE] <= 512); *slot = q; }
                __syncthreads();
                const int q = *slot;
                if (q >= NE * 5) break;
                const bool ovf = q >= NE;
                const int e = ovf ? (q - NE) >> 2 : q, pz = ovf ? ((q - NE) & 3) * 2 : 0, npz = ovf ? 2 : 8, st0 = ovf ? 1 : 0, n = cnt[e * CNT_STRIDE];
                for (int r0 = 0; r0 < n; r0 += 1024) {
                    if (ovf && n - r0 <= 512) break;
#pragma unroll
                    for (int i = 0; i < 2; ++i) { int t_ = tid; asm volatile("" : "+v"(t_)); const int idx = r0 + i * 512 + t_; const int va = idx < n ? P_list[(size_t)e * T + idx] : TRASH_VA; rowva[i * 512 + t_] = va; roww[i * 512 + t_] = va < A_TOT ? P_topw[va] * Y8_SCALE : 0.f; }
                    __syncthreads();
                    moe_expert<true>(lds, tid, lane, wave, r32, hi, (const unsigned char*)P_hb, wed + (size_t)e * DF * D, nullptr, (n - r0) < 1024 ? (n - r0) : 1024, (void*)P_yb, pz, npz, st0, 1, true);
                }
            }
        }
    }
    {
        PH_BEGIN;
        const pg8::Gemm g{P_hbs, (const u16*)(ws + WS_WSD) + (size_t)L * D * DF, T, D, DF};
        const EpiSD E{P_yb};
        int* qctr = (int*)(ws + WS_CTL + CTL_CNT_OFF + 4096) + (L * 4 + 1 + 2 * (rep_ & 1)) * 64;
        LAS int* slot = (LAS int*)(lds + 140000);
        for (;;) {
            __syncthreads();
            if (tid == 0) *slot = atomicAdd(qctr, 1);
            __syncthreads();
            const int un = *slot;
            if (un >= 256) break;
            const pg8::FixedOrder S{un & 63, un >> 6};
            pg8::gemm_phase<EpiSD, pg8::FixedOrder, false>((PG8_LAS unsigned char*)lds, g, S, E, nullptr, wave_s_ * 64 + lane_id_());
        }
    }
}

__device__ __forceinline__ void ph_combine(int L, int rep_, const int wave_s_) {
    PH_FN_BEGIN
    (void)rep_;
    PH_BEGIN;
    const float* lng = CTX_IN(14) + L * D; const float* lnb = CTX_IN(15) + L * D;
    float* dst = L == 0 ? P_x2 : AS_GLOBAL(float, ctx_ld(16));
    for (int row = bid * 8 + wave; row < T; row += G * 8) {
        u32x4 yv[TOPK + 1][2];
#pragma unroll
        for (int k = 0; k < TOPK + 1; ++k) {
            const size_t va = k < TOPK ? (size_t)row * TOPK + k : (size_t)A_TOT + row;
            if (k < TOPK) {
#pragma unroll
                for (int j = 0; j < 2; ++j) { const u32x2 w8 = *(const u32x2*)((const unsigned char*)P_yb + va * D + j * 512 + lane * 8); yv[k][j][0] = w8[0]; yv[k][j][1] = w8[1]; yv[k][j][2] = 0u; yv[k][j][3] = 0u; }
            } else {
#pragma unroll
                for (int j = 0; j < 2; ++j) yv[k][j] = *(const u32x4*)(P_yb + va * D + j * 512 + lane * 8);
            }
        }
        float v[16];
#pragma unroll
        for (int j = 0; j < 2; ++j) {
            const f32x4 t0 = *(const f32x4*)(P_x1 + (size_t)row * D + j * 512 + lane * 8), t1 = *(const f32x4*)(P_x1 + (size_t)row * D + j * 512 + lane * 8 + 4);
#pragma unroll
            for (int c = 0; c < 4; ++c) { v[j * 8 + c] = DN_ALPHA * t0[c]; v[j * 8 + 4 + c] = DN_ALPHA * t1[c]; }
        }
#pragma unroll
        for (int k = 0; k < TOPK + 1; ++k)
#pragma unroll
            for (int j = 0; j < 2; ++j) {
                if (k < TOPK) {
#pragma unroll
                    for (int c = 0; c < 2; ++c) {
                        const f32x2_ lo2 = __builtin_amdgcn_cvt_pk_f32_fp8((int)yv[k][j][c], false), hi2 = __builtin_amdgcn_cvt_pk_f32_fp8((int)yv[k][j][c], true);
                        v[j * 8 + 4 * c] += lo2[0] * (1.f / Y8_SCALE); v[j * 8 + 4 * c + 1] += lo2[1] * (1.f / Y8_SCALE); v[j * 8 + 4 * c + 2] += hi2[0] * (1.f / Y8_SCALE); v[j * 8 + 4 * c + 3] += hi2[1] * (1.f / Y8_SCALE);
                    }
                } else {
#pragma unroll
                    for (int c = 0; c < 4; ++c) { v[j * 8 + 2 * c] += bf2f(yv[k][j][c] & 0xFFFFu); v[j * 8 + 2 * c + 1] += bf2f(yv[k][j][c] >> 16); }
                }
            }
        float sm = 0.f;
#pragma unroll
        for (int i = 0; i < 16; ++i) sm += v[i];
        const float mu = wave_sum(sm) * (1.f / D);
        float q = 0.f;
#pragma unroll
        for (int i = 0; i < 16; ++i) { const float d = v[i] - mu; q += d * d; }
        const float rstd = rsqrtf(wave_sum(q) * (1.f / D) + LN_EPS);
#pragma unroll
        for (int j = 0; j < 2; ++j) {
            const f32x4 g0 = *(const f32x4*)(lng + j * 512 + lane * 8), g1 = *(const f32x4*)(lng + j * 512 + lane * 8 + 4);
            const f32x4 b0 = *(const f32x4*)(lnb + j * 512 + lane * 8), b1 = *(const f32x4*)(lnb + j * 512 + lane * 8 + 4);
            f32x4 o0, o1;
#pragma unroll
            for (int c = 0; c < 4; ++c) { o0[c] = (v[j * 8 + c] - mu) * rstd * g0[c] + b0[c]; o1[c] = (v[j * 8 + 4 + c] - mu) * rstd * g1[c] + b1[c]; }
            *(f32x4*)(dst + (size_t)row * D + j * 512 + lane * 8) = o0; *(f32x4*)(dst + (size_t)row * D + j * 512 + lane * 8 + 4) = o1;
            if (L == 0) { u32x4 w; w[0] = cvtpk(o0[0], o0[1]); w[1] = cvtpk(o0[2], o0[3]); w[2] = cvtpk(o1[0], o1[1]); w[3] = cvtpk(o1[2], o1[3]); *(u32x4*)(P_xb + (size_t)row * D + j * 512 + lane * 8) = w; }
        }
    }
}

__global__ void __launch_bounds__(NTHR, 2) fwd(Args args) {
    extern __shared__ __attribute__((aligned(16))) unsigned char lds_raw[];
    LAS char* lds = (LAS char*)lds_raw;
    unsigned char* const ws = args.ws;
    const int lo = args.ph_lo, hi_ph = args.ph_hi;
    const int wave_s_ = __builtin_amdgcn_readfirstlane(threadIdx.x >> 6);
    if (threadIdx.x < 18) {
        const uint64_t v = threadIdx.x < 16 ? (uint64_t)args.in[threadIdx.x] : (threadIdx.x == 16 ? (uint64_t)args.out : (uint64_t)args.ws);
        ((LAS uint64_t*)(lds + LDS_CTX))[threadIdx.x] = v;
    }
    __syncthreads();
#define IN(k) (lo <= (k) && (k) < hi_ph)

#if MK_ONE_LAUNCH
    if (threadIdx.x < 4) ((LAS unsigned*)(lds + LDS_BAR))[threadIdx.x] = 0u;
    __syncthreads();
    XcdBarrier bar = xcd_barrier_post((unsigned*)(ws + WS_CTL), (volatile LAS unsigned*)(lds + LDS_BAR), wave_s_ == 0 && lane_id_() == 0);
#define GRID_BAR() xcd_barrier(bar, wave_s_ == 0 && lane_id_() == 0)
#else
#define GRID_BAR() do { } while (0)
#endif
#define SEAM(k) do { if (IN(k) && IN((k) + 1)) GRID_BAR(); } while (0)

    for (int rep_ = 0; rep_ < ((IN(0) && PHK(0)) ? REPS(0) : 0); ++rep_) { ph_p0(0, rep_, wave_s_); }
    SEAM(0);

    for (int L = 0; L < 2; ++L) {
        const int pb = 1 + 10 * L;
        for (int rep_ = 0; rep_ < ((IN(pb + 0) && PHK(1)) ? REPS(1) : 0); ++rep_) { ph_qkv(L, rep_, wave_s_); }
        SEAM(pb + 0);

        if (L == 0) {
            for (int rep_ = 0; rep_ < ((IN(pb + 1) && PHK(2)) ? REPS(2) : 0); ++rep_) { ph_kmean(L, rep_, wave_s_); }
            SEAM(pb + 1);
            for (int rep_ = 0; rep_ < ((IN(pb + 2) && PHK(11)) ? REPS(11) : 0); ++rep_) { ph_gate(L, rep_, wave_s_); }
            SEAM(pb + 2);
        }

        if (L == 0) {
            for (int rep_ = 0; rep_ < ((IN(pb + 3) && PHK(3)) ? REPS(3) : 0); ++rep_) { ph_moba(L, rep_, wave_s_); }
            SEAM(pb + 3);
            for (int rep_ = 0; rep_ < ((IN(pb + 4) && PHK(12)) ? REPS(12) : 0); ++rep_) { ph_mobamerge(L, rep_, wave_s_); }
        } else {
            for (int rep_ = 0; rep_ < ((IN(pb + 3) && PHK(4)) ? REPS(4) : 0); ++rep_) { ph_dil(L, rep_, wave_s_); }
            SEAM(pb + 3);
            for (int rep_ = 0; rep_ < ((IN(pb + 4) && PHK(5)) ? REPS(5) : 0); ++rep_) { ph_merge(L, rep_, wave_s_); }
        }
        SEAM(pb + 4);

        for (int rep_ = 0; rep_ < ((IN(pb + 5) && PHK(6)) ? REPS(6) : 0); ++rep_) { ph_wo(L, rep_, wave_s_); }
        SEAM(pb + 5);

        for (int rep_ = 0; rep_ < ((IN(pb + 6) && PHK(7)) ? REPS(7) : 0); ++rep_) { ph_router(L, rep_, wave_s_); }
        SEAM(pb + 6);

        for (int rep_ = 0; rep_ < ((IN(pb + 7) && PHK(8)) ? REPS(8) : 0); ++rep_) { ph_gateup(L, rep_, wave_s_); }
        SEAM(pb + 7);

        for (int rep_ = 0; rep_ < ((IN(pb + 8) && PHK(9)) ? REPS(9) : 0); ++rep_) { ph_down(L, rep_, wave_s_); }
        SEAM(pb + 8);

        for (int rep_ = 0; rep_ < ((IN(pb + 9) && PHK(10)) ? REPS(10) : 0); ++rep_) { ph_combine(L, rep_, wave_s_); }
        if (L == 0) SEAM(pb + 9);
    }
}

extern "C" void kernel_launch(void* const* d_in, const int* in_sizes, int n_in, void* d_out, int out_size, void* d_ws, size_t ws_size, hipStream_t stream) {
    static int grid = 0;
    if (grid == 0) {
        if (n_in != 16 || out_size != T * D || ws_size < WS_END2) { fprintf(stderr, "kernel_launch: unexpected problem (n_in %d out %d ws %zu need %zu)\n", n_in, out_size, ws_size, (size_t)WS_END2); grid = -1; return; }
        int dev = 0, cus = 0, per_cu = 0;
        if (hipGetDevice(&dev) != hipSuccess || hipDeviceGetAttribute(&cus, hipDeviceAttributeMultiprocessorCount, dev) != hipSuccess) { grid = -1; return; }
        if (hipFuncSetAttribute((const void*)fwd, hipFuncAttributeMaxDynamicSharedMemorySize, LDS_BYTES) != hipSuccess) { fprintf(stderr, "kernel_launch: hipFuncSetAttribute failed\n"); grid = -1; return; }
        if (hipOccupancyMaxActiveBlocksPerMultiprocessor(&per_cu, (const void*)fwd, NTHR, LDS_BYTES) != hipSuccess || per_cu < 1) { fprintf(stderr, "kernel_launch: occupancy query says %d\n", per_cu); (void)hipGetLastError(); per_cu = 1; }
        grid = cus;
    }
    if (grid < 0) return;
    (void)hipMemsetAsync((char*)d_ws + WS_CTL, 0, CTL_BYTES, stream);
    Args a{};
    for (int i = 0; i < 16; ++i) a.in[i] = (const float*)d_in[i];
    a.out = (float*)d_out; a.ws = (unsigned char*)d_ws;
#if MK_ONE_LAUNCH
    a.ph_lo = 0; a.ph_hi = N_PHASES;
    hipLaunchKernelGGL(fwd, dim3(grid), dim3(NTHR), LDS_BYTES, stream, a);
#else
    for (int ph = 0; ph < N_PHASES; ++ph) {
        if (ph == 12 || ph == 13) continue;
        a.ph_lo = ph; a.ph_hi = ph + 1;
        hipLaunchKernelGGL(fwd, dim3(grid), dim3(NTHR), LDS_BYTES, stream, a);
    }
#endif
}
```

```cpp
#include <hip/hip_runtime.h>
#include <hip/hip_bf16.h>
#include <stdint.h>
#include <stdio.h>

#ifndef MK_ONE_LAUNCH
#define MK_ONE_LAUNCH 1
#endif

#ifndef PHMASK
#define PHMASK 0x1FFF
#endif
#define PHK(k) ((PHMASK >> (k)) & 1)
#ifndef REPEAT_KIND
#define REPEAT_KIND -1
#endif
#define REPS(k) ((k) == REPEAT_KIND ? 2 : 1)
#define LAS __attribute__((address_space(3)))
typedef __attribute__((ext_vector_type(8))) short bf16x8;
typedef __attribute__((ext_vector_type(16))) float f32x16;
typedef __attribute__((ext_vector_type(4))) float f32x4;
typedef __attribute__((ext_vector_type(4))) unsigned u32x4;
typedef __attribute__((ext_vector_type(2))) unsigned u32x2;
typedef unsigned short u16;

constexpr int D = 1024, BATCH = 2, SEQ = 8192, T = BATCH * SEQ, NH = 16, HD = 64;
constexpr int NE = 256, TOPK = 8, DF = 256;
constexpr int A_TOT = T * TOPK;
constexpr int MOBA_BLK = 256, MOBA_NB = SEQ / MOBA_BLK;
constexpr float DN_ALPHA = 1.4142135623730951f;
constexpr float LN_EPS = 1e-5f;
constexpr float LOG2E = 1.4426950408889634f;
constexpr float LN2 = 0.6931471805599453f;
constexpr float NEGV = -1e30f;
constexpr int NTHR = 512;

constexpr size_t al256(size_t x) { return (x + 255) & ~(size_t)255; }
constexpr size_t WS_CTL = 0;
constexpr size_t CTL_BYTES = 131072;
constexpr size_t CTL_CNT_OFF = 32768;
constexpr size_t CTL_ECNT_OFF = 65536;
constexpr int CNT_STRIDE = 32;
constexpr size_t WS_XB = WS_CTL + CTL_BYTES;
constexpr size_t WS_X1 = WS_XB + al256((size_t)T * D * 2);
constexpr size_t WS_X2 = WS_X1 + al256((size_t)T * D * 4);
constexpr size_t WS_YPRE = WS_X2 + al256((size_t)T * D * 4);
constexpr size_t WS_QKV = WS_YPRE + al256((size_t)T * D * 4);
constexpr size_t WS_VT = WS_QKV + al256((size_t)T * 9216 * 2);
constexpr size_t WS_KM = WS_VT + al256((size_t)3 * T * D * 2);
constexpr size_t WS_AO = WS_KM + al256((size_t)BATCH * NH * MOBA_NB * HD * 4);
constexpr size_t WS_OG = WS_AO + al256((size_t)T * D * 2);
constexpr size_t WS_LSE = WS_OG + al256((size_t)3 * T * D * 2);
constexpr size_t WS_TOPW = WS_LSE + al256((size_t)3 * T * NH * 4);
constexpr size_t WS_LIST = WS_TOPW + al256((size_t)T * TOPK * 4);
constexpr size_t WS_HB = WS_LIST + al256((size_t)NE * T * 4);
constexpr size_t WS_YB = WS_HB + al256((size_t)(A_TOT + T + 1) * DF * 2);
constexpr size_t WS_END = WS_YB + al256((size_t)(A_TOT + T + 1) * D * 2);
constexpr int TRASH_VA = A_TOT + T;
constexpr size_t WS_SELM = WS_END;
constexpr size_t WS_PART = WS_SELM + al256((size_t)T * NH * 4);
constexpr size_t WS_PLSE = WS_PART + al256((size_t)T * NH * 4 * 64 * 2);
constexpr size_t WS_WQK0 = WS_PLSE + al256((size_t)T * NH * 4 * 4);
constexpr size_t WS_WV0 = WS_WQK0 + (size_t)2048 * 1024 * 2;
constexpr size_t WS_WQK1 = WS_WV0 + (size_t)1024 * 1024 * 2;
constexpr size_t WS_WV1 = WS_WQK1 + (size_t)6144 * 1024 * 2;
constexpr size_t WS_WO = WS_WV1 + (size_t)3072 * 1024 * 2;
constexpr size_t WS_WSGU = WS_WO + (size_t)2 * 1024 * 1024 * 2;
constexpr size_t WS_WSD = WS_WSGU + (size_t)2 * 512 * 1024 * 2;
constexpr size_t WS_XB8 = WS_WSD + (size_t)2 * 1024 * 256 * 2;
constexpr size_t WS_HBS = WS_XB8 + (size_t)T * D;
constexpr size_t WS_WRH = WS_HBS + (size_t)T * DF * 2;
constexpr size_t WS_WRL = WS_WRH + (size_t)2 * 256 * 1024 * 2;
constexpr size_t WS_END2 = WS_WRL + (size_t)2 * 256 * 1024 * 2;

constexpr int LDP = 40;
constexpr int STAGE_BYTES = 2 * 256 * LDP * 2;
constexpr int LDS_ROWID = 2 * STAGE_BYTES;
constexpr int LDS_ROWW = LDS_ROWID + 1024;
constexpr int XS_PITCH = 1028;
constexpr int LDS_BYTES = 163840;
constexpr int LDS_BAR = 161792;

__device__ __forceinline__ int lane_id_() { int l; asm volatile("v_mbcnt_lo_u32_b32 %0, -1, 0\n\tv_mbcnt_hi_u32_b32 %0, -1, %0" : "=v"(l)); return l; }
__device__ __forceinline__ float shxf(float v, int m, int lane) { return __int_as_float(__builtin_amdgcn_ds_bpermute((lane ^ m) << 2, __float_as_int(v))); }
__device__ __forceinline__ int shxi(int v, int m, int lane) { return __builtin_amdgcn_ds_bpermute((lane ^ m) << 2, v); }
#define XB_TMO      128
#define XB_XCNT(j)  (256  + 64 * (j))
#define XB_XSUB(j)  (1280 + 64 * (j))
#define XB_XGEN(j)  (2304 + 64 * (j))
#define XB_TOP      3328
#define XB_TOPGEN   3392
#define XCD_BAR_WORDS 3456
#define XB_SPIN_CAP (1u << 18)
__device__ __forceinline__ unsigned xb_ld(unsigned* p)              { return __hip_atomic_load(p, __ATOMIC_RELAXED, __HIP_MEMORY_SCOPE_AGENT); }
__device__ __forceinline__ unsigned xb_add(unsigned* p, unsigned v) { return __hip_atomic_fetch_add(p, v, __ATOMIC_RELAXED, __HIP_MEMORY_SCOPE_AGENT); }
__device__ __forceinline__ unsigned xb_xcc_id() { return (unsigned)__builtin_amdgcn_s_getreg((3 << 11) | 20) & 0xFu; }
#define XB_SPIN(cond, bar) do { unsigned _sp = 0; while (cond) { __builtin_amdgcn_s_sleep(1); \
    if ((++_sp & 255u) == 0u) { if (xb_ld(&(bar)[XB_TMO])) break; if (_sp > XB_SPIN_CAP) { atomicAdd(&(bar)[XB_TMO], 1u); break; } } } } while (0)
struct XcdBarrier { unsigned* bar; unsigned x; volatile LAS unsigned* st; };
__device__ __forceinline__ XcdBarrier xcd_barrier_post(unsigned* bar, volatile LAS unsigned* st, const bool leader) {
    XcdBarrier b; b.bar = bar; b.x = xb_xcc_id(); b.st = st;
    if (leader) (void)xb_add(&bar[XB_XCNT(b.x)], 1u);
    return b;
}
__device__ __forceinline__ void xcd_barrier_complete(unsigned* bar, unsigned x, unsigned& nloc, unsigned& nx) {
    const unsigned G = gridDim.x * gridDim.y * gridDim.z;
    unsigned sum, cnt, mine, sp = 0u;
    for (;;) {
        sum = 0u; cnt = 0u; mine = 0u;
#pragma unroll
        for (unsigned j = 0; j < 16; ++j) { const unsigned c = xb_ld(&bar[XB_XCNT(j)]); sum += c; cnt += (c > 0u) ? 1u : 0u; mine = (j == x) ? c : mine; }
        if (sum == G) break;
        __builtin_amdgcn_s_sleep(1);
        if ((++sp & 255u) == 0u) { if (xb_ld(&bar[XB_TMO])) break; if (sp > XB_SPIN_CAP) { atomicAdd(&bar[XB_TMO], 1u); break; } }
    }
    nloc = mine > 0u ? mine : 1u; nx = cnt > 0u ? cnt : 1u;
}
__device__ __forceinline__ void xcd_barrier(const XcdBarrier& b, const bool leader) {
    asm volatile("s_waitcnt vmcnt(0)" ::: "memory");
    __syncthreads();
    if (leader) {
        unsigned* bar = b.bar;
        __builtin_amdgcn_s_waitcnt(0);
        unsigned nloc = b.st[0], nx = b.st[1];
        if (nloc == 0u) { xcd_barrier_complete(bar, b.x, nloc, nx); b.st[0] = nloc; b.st[1] = nx; }
        const unsigned old = xb_add(&bar[XB_XSUB(b.x)], 1u);
        const unsigned gen = old / nloc;
        if (old + 1u == (gen + 1u) * nloc) {
            __builtin_amdgcn_fence(__ATOMIC_RELEASE, "agent");
            asm volatile("s_waitcnt vmcnt(0)" ::: "memory");
            const unsigned og = xb_add(&bar[XB_TOP], 1u);
            const unsigned tg = og / nx;
            if (og + 1u == (tg + 1u) * nx) xb_add(&bar[XB_TOPGEN], 1u);
            else XB_SPIN(xb_ld(&bar[XB_TOPGEN]) == tg, bar);
            __builtin_amdgcn_fence(__ATOMIC_ACQUIRE, "agent");
            xb_add(&bar[XB_XGEN(b.x)], 1u);
            asm volatile("s_waitcnt vmcnt(0)" ::: "memory");
        } else {
            XB_SPIN(xb_ld(&bar[XB_XGEN(b.x)]) == gen, bar);
            __builtin_amdgcn_fence(__ATOMIC_ACQUIRE, "agent");
            asm volatile("s_waitcnt vmcnt(0)" ::: "memory");
        }
    }
    __syncthreads();
}

typedef __attribute__((ext_vector_type(2))) __bf16 bf16x2_t;
typedef __attribute__((ext_vector_type(2))) float f32x2_t;
__device__ __forceinline__ unsigned cvtpk(float lo, float hi) { f32x2_t f; f[0] = lo; f[1] = hi; return __builtin_bit_cast(unsigned, __builtin_convertvector(f, bf16x2_t)); }
__device__ __forceinline__ float bf2f(unsigned v16) { return __uint_as_float(v16 << 16); }
__device__ __forceinline__ int crow(int r, int hi) { return (r & 3) + 8 * (r >> 2) + 4 * hi; }
#define MFMA_BF16(a, b, c) __builtin_amdgcn_mfma_f32_32x32x16_bf16(a, b, c, 0, 0, 0)
__device__ __forceinline__ float wave_sum(float v) {
    v += __int_as_float(__builtin_amdgcn_update_dpp(0, __float_as_int(v), 0xB1, 0xF, 0xF, true));
    v += __int_as_float(__builtin_amdgcn_update_dpp(0, __float_as_int(v), 0x4E, 0xF, 0xF, true));
    v += __int_as_float(__builtin_amdgcn_update_dpp(0, __float_as_int(v), 0x141, 0xF, 0xF, true));
    v += __int_as_float(__builtin_amdgcn_update_dpp(0, __float_as_int(v), 0x140, 0xF, 0xF, true));
    const int vi = __float_as_int(v);
    return (__int_as_float(__builtin_amdgcn_readlane(vi, 0)) + __int_as_float(__builtin_amdgcn_readlane(vi, 16))) + (__int_as_float(__builtin_amdgcn_readlane(vi, 32)) + __int_as_float(__builtin_amdgcn_readlane(vi, 48)));
}

namespace pg8 {
#define PG8_LAS __attribute__((address_space(3)))
typedef unsigned short bf16_t;
typedef short bf16x8 __attribute__((ext_vector_type(8)));
typedef float f32x4 __attribute__((ext_vector_type(4)));
typedef unsigned u32x4 __attribute__((ext_vector_type(4)));
constexpr int BM = 256, BK = 64, HALF = 128, HTB = HALF * BK * 2  , STAGE_BYTES = 8 * HTB, NXCD = 8, WGM = 8;

__host__ __device__ __forceinline__ int lds_byte(int r, int c) { const int st = (r >> 4) * 2 + (c >> 5), rr = r & 15, cc = c & 31, ob = rr * 64 + cc * 2; return st * 1024 + (ob ^ (((ob >> 9) & 1) << 5)); }
__host__ __device__ __forceinline__ void stage_rc(int b, int& R, int& C) { const int st = b / 1024, sb = b % 1024, swz = sb ^ (((sb >> 9) & 1) << 5); R = (st >> 1) * 16 + swz / 64; C = (st & 1) * 32 + (swz % 64) / 2; }
__host__ __device__ __forceinline__ int perm32(int rho) { const int n = rho >> 4, i = rho & 15; return 8 * (i >> 2) + 4 * n + (i & 3); }

struct Unit { int pm, pn; };
struct Gemm { const bf16_t* A; const bf16_t* Bt; int M, N, K; };
struct FixedOrder {
    int pm, pn;
    __device__ __forceinline__ bool next(int i, Unit& u) const { if (i != 0) return false; u.pm = pm; u.pn = pn; return true; }
    __device__ __forceinline__ void a_ready(const Unit&) const {}
    __device__ __forceinline__ void done(const Unit&) const {}
};

struct StaticOrder {
    int nM, nN, nwg, G, c;
    __host__ __device__ void init(int M, int N, int G_, int c_) { nM = M / BM; nN = N / BM; nwg = nM * nN; G = G_; c = c_; }
    __host__ __device__ bool next(int i, Unit& u) const {
        const long L = (long)i * G + c; if (L >= nwg) return false;
        int wgid = (int)L; { const int q = nwg / NXCD, r = nwg % NXCD, xcd = wgid % NXCD, off = wgid / NXCD; wgid = (xcd < r ? xcd * (q + 1) : r * (q + 1) + (xcd - r) * q) + off; }
        const int nig = WGM * nN, gid = wgid / nig, fm = gid * WGM, gsz = (nM - fm) < WGM ? (nM - fm) : WGM;
        u.pm = fm + ((wgid % nig) % gsz); u.pn = (wgid % nig) / gsz; return true;
    }
    __device__ __forceinline__ void a_ready(const Unit&) const {}
    __device__ __forceinline__ void done(const Unit&) const {}
};

template <class Epi, class Sched, bool SWAP = false, bool STAMP = false>
__device__ __forceinline__ void gemm_phase(PG8_LAS unsigned char* lds, const Gemm g, const Sched& S, const Epi& E, unsigned long long* stamps, const int tid_in) {
    int tid_ = tid_in; asm volatile("" : "+v"(tid_));
    const int tid = tid_, wid = __builtin_amdgcn_readfirstlane(tid >> 6), lane = tid & 63, wr = wid >> 2, wc = wid & 3, fr = lane & 15, fq = lane >> 4;
    const int K = g.K, nt = K / BK;
    int ts_lo = 0, ts_hi = 0, nts = 0; const unsigned long long rt_entry = STAMP ? (unsigned long long)wall_clock64() : 0ull;
#define PG8_STAMP() do { if (STAMP && wid == 0 && nts < 64) { const unsigned long long _c = (unsigned long long)clock64(); \
        ts_lo = (lane == nts) ? (int)(unsigned)_c : ts_lo; ts_hi = (lane == nts) ? (int)(unsigned)(_c >> 32) : ts_hi; ++nts; } } while (0)
    PG8_STAMP();
    unsigned voffA[2], voffB[2];
#pragma unroll
    for (int i = 0; i < 2; ++i) { int R, C; stage_rc(tid * 16 + i * 8192, R, C); const int Rb = Epi::PERM ? ((R & ~31) + perm32(R & 31)) : R;
        voffA[i] = (unsigned)(R * K + C) * 2u; voffB[i] = (unsigned)(Rb * K + C) * 2u; }
    const size_t kstep = (size_t)(BK * 2);
    const size_t hstep = (size_t)HALF * K * 2;
    const size_t tstep = 2 * hstep;
    const unsigned ldsw = (unsigned)wid * 1024u;
    const int aoff = lds_byte(wr * 64 + fr, fq * 8), boff = lds_byte(wc * 32 + fr, fq * 8);
#define PG8_SA(b, h) (((b) * 2 + (h)) * HTB)
#define PG8_SB(b, h) ((4 + (b) * 2 + (h)) * HTB)
#define PG8_STAGE(bufoff, gbase, voff) do { _Pragma("unroll") for (int _i = 0; _i < 2; ++_i) \
        __builtin_amdgcn_global_load_lds((const unsigned*)((const char*)(gbase) + (voff)[_i]), (PG8_LAS unsigned*)(lds + (bufoff) + ldsw + _i * 8192), 16, 0, 0); } while (0)
#define PG8_LDA(dst, b, h) do { _Pragma("unroll") for (int m = 0; m < 4; ++m) _Pragma("unroll") for (int k = 0; k < 2; ++k) dst[m][k] = *(const PG8_LAS bf16x8*)(lds + PG8_SA(b, h) + aoff + m * 2048 + k * 1024); } while (0)
#define PG8_LDB(dst, b, h) do { _Pragma("unroll") for (int n = 0; n < 2; ++n) _Pragma("unroll") for (int k = 0; k < 2; ++k) dst[n][k] = *(const PG8_LAS bf16x8*)(lds + PG8_SB(b, h) + boff + n * 2048 + k * 1024); } while (0)
#define PG8_MMA(ai, bj, At, Bt) do { __builtin_amdgcn_s_setprio(1); _Pragma("unroll") for (int m = 0; m < 4; ++m) _Pragma("unroll") for (int n = 0; n < 2; ++n) _Pragma("unroll") for (int k = 0; k < 2; ++k) \
        acc[ai][bj][m][n] = SWAP ? __builtin_amdgcn_mfma_f32_16x16x32_bf16(At[m][k], Bt[n][k], acc[ai][bj][m][n], 0, 0, 0) : __builtin_amdgcn_mfma_f32_16x16x32_bf16(Bt[n][k], At[m][k], acc[ai][bj][m][n], 0, 0, 0); __builtin_amdgcn_s_setprio(0); } while (0)
#define PG8_WAIT_V(n) asm volatile("s_waitcnt vmcnt(" #n ")" ::: "memory")
#define PG8_WAIT_L(n) asm volatile("s_waitcnt lgkmcnt(" #n ")" ::: "memory")
#define PG8_BAR __builtin_amdgcn_s_barrier()
#define PG8_SCHED __builtin_amdgcn_sched_barrier(0)
    Unit cur, nxt; int ui = 0;
    if (!S.next(0, cur)) return;
    f32x4 acc[2][2][4][2];
#pragma unroll
    for (int a = 0; a < 2; ++a)
#pragma unroll
        for (int b = 0; b < 2; ++b)
#pragma unroll
            for (int m = 0; m < 4; ++m)
#pragma unroll
                for (int n = 0; n < 2; ++n) acc[a][b][m][n] = (f32x4){0.f, 0.f, 0.f, 0.f};
    bf16x8 At[4][2], B0[2][2], B1[2][2];
    const char* cA = (const char*)g.A + (size_t)cur.pm * tstep; const char* cB = (const char*)g.Bt + (size_t)cur.pn * tstep;
    S.a_ready(cur);
    PG8_STAGE(PG8_SB(0, 0), cB, voffB); PG8_STAGE(PG8_SA(0, 0), cA, voffA); PG8_STAGE(PG8_SB(0, 1), cB + hstep, voffB); PG8_STAGE(PG8_SA(0, 1), cA + hstep, voffA);
    if (wr == 1) PG8_BAR;
    PG8_WAIT_V(4); PG8_BAR;
    PG8_STAGE(PG8_SB(1, 0), cB + kstep, voffB); PG8_STAGE(PG8_SA(1, 0), cA + kstep, voffA); PG8_STAGE(PG8_SB(1, 1), cB + hstep + kstep, voffB);
    PG8_WAIT_V(6); PG8_BAR;
    PG8_STAMP();
    for (;;) {
        const bool has_next = S.next(ui + 1, nxt);
        const char* nA = has_next ? (const char*)g.A + (size_t)nxt.pm * tstep : cA; const char* nB = has_next ? (const char*)g.Bt + (size_t)nxt.pn * tstep : cB;
        for (int t = 0; t < nt; t += 2) {
            const bool last = (t == nt - 2);
            const char* a1 = cA + (size_t)(t + 1) * kstep;
            const char* a2 = last ? nA : cA + (size_t)(t + 2) * kstep; const char* b2 = last ? nB : cB + (size_t)(t + 2) * kstep;
            const char* a3 = a2 + kstep; const char* b3 = b2 + kstep;
            if (last && has_next) S.a_ready(nxt);
            PG8_LDB(B0, 0, 0); PG8_SCHED; PG8_LDA(At, 0, 0); PG8_STAGE(PG8_SA(1, 1), a1 + hstep, voffA);
            PG8_WAIT_L(8); PG8_BAR; PG8_WAIT_L(0); PG8_MMA(0, 0, At, B0); PG8_BAR; PG8_SCHED;
            PG8_LDB(B1, 0, 1); PG8_STAGE(PG8_SB(0, 0), b2, voffB);
            PG8_BAR; PG8_WAIT_L(0); PG8_MMA(0, 1, At, B1); PG8_BAR;
            PG8_LDA(At, 0, 1); PG8_STAGE(PG8_SA(0, 0), a2, voffA);
            PG8_BAR; PG8_WAIT_L(0); PG8_MMA(1, 0, At, B0); PG8_BAR; PG8_SCHED;
            PG8_STAGE(PG8_SB(0, 1), b2 + hstep, voffB);
            PG8_WAIT_V(6); PG8_BAR; PG8_MMA(1, 1, At, B1); PG8_BAR;
            PG8_LDB(B0, 1, 0); PG8_SCHED; PG8_LDA(At, 1, 0); PG8_STAGE(PG8_SA(0, 1), a2 + hstep, voffA);
            PG8_WAIT_L(8); PG8_BAR; PG8_WAIT_L(0); PG8_MMA(0, 0, At, B0); PG8_BAR; PG8_SCHED;
            PG8_LDB(B1, 1, 1); PG8_STAGE(PG8_SB(1, 0), b3, voffB);
            PG8_BAR; PG8_WAIT_L(0); PG8_MMA(0, 1, At, B1); PG8_BAR;
            PG8_LDA(At, 1, 1); PG8_STAGE(PG8_SA(1, 0), a3, voffA);
            PG8_BAR; PG8_WAIT_L(0); PG8_MMA(1, 0, At, B0); PG8_BAR; PG8_SCHED;
            PG8_STAGE(PG8_SB(1, 1), b3 + hstep, voffB);
            PG8_WAIT_V(6); PG8_BAR; PG8_MMA(1, 1, At, B1); PG8_BAR;
        }
        PG8_STAMP();
        if constexpr (!Epi::AFTER_DRAIN) { E(acc, cur, wr, wc, fr, fq); S.done(cur); }
        PG8_STAMP();
        if (!has_next) break;
#pragma unroll
        for (int a = 0; a < 2; ++a)
#pragma unroll
            for (int b = 0; b < 2; ++b)
#pragma unroll
                for (int m = 0; m < 4; ++m)
#pragma unroll
                    for (int n = 0; n < 2; ++n) acc[a][b][m][n] = (f32x4){0.f, 0.f, 0.f, 0.f};
        cur = nxt; cA = nA; cB = nB; ++ui;
    }
    PG8_WAIT_V(0);
    if (wr == 0) PG8_BAR;
    PG8_BAR;
    if constexpr (Epi::AFTER_DRAIN) { E.fused(acc, cur, wr, wc, fr, fq, lds, wid, lane); S.done(cur); }
    PG8_STAMP();
    if (STAMP && wid == 0) { stamps[lane] = lane < nts ? (((unsigned long long)(unsigned)ts_hi << 32) | (unsigned)ts_lo) : 0ull;
        if (lane == 62) stamps[62] = rt_entry; if (lane == 63) stamps[63] = (unsigned long long)wall_clock64(); }
#undef PG8_STAMP
#undef PG8_SA
#undef PG8_SB
#undef PG8_STAGE
#undef PG8_LDA
#undef PG8_LDB
#undef PG8_MMA
#undef PG8_WAIT_V
#undef PG8_WAIT_L
#undef PG8_BAR
#undef PG8_SCHED
}
}

struct EpiQK {
    static constexpr bool PERM = true, AFTER_DRAIN = false;
    u16* O; int ldc;
    __device__ __forceinline__ void operator()(const pg8::f32x4 (&acc)[2][2][4][2], const pg8::Unit& u, int wr, int wc, int fr, int fq) const {
        const int col0 = u.pn * 256 + wc * 32 + 8 * fq, row0 = u.pm * 256 + wr * 64 + fr;
#pragma unroll
        for (int ai = 0; ai < 2; ++ai)
#pragma unroll
            for (int m = 0; m < 4; ++m) { u16* rowp = O + (size_t)(row0 + ai * 128 + m * 16) * ldc + col0;
#pragma unroll
                for (int bj = 0; bj < 2; ++bj) { const pg8::f32x4 v0 = acc[ai][bj][m][0], v1 = acc[ai][bj][m][1];
                    u32x4 w; w[0] = cvtpk(v0[0], v0[1]); w[1] = cvtpk(v0[2], v0[3]); w[2] = cvtpk(v1[0], v1[1]); w[3] = cvtpk(v1[2], v1[3]);
                    *(u32x4*)(rowp + bj * 128) = w; } }
    }
};
struct EpiV {
    static constexpr bool PERM = false, AFTER_DRAIN = false;
    u16* VT; int layer;
    __device__ __forceinline__ void operator()(const pg8::f32x4 (&acc)[2][2][4][2], const pg8::Unit& u, int wr, int wc, int fr, int fq) const {
        const int colt = u.pn * 256, grp = colt >> 10;
        const int dil = (layer == 0 || grp == 0) ? 1 : (grp == 1 ? 4 : 16);
        const int rowb = u.pm * 256 + wr * 64 + 4 * fq;
#pragma unroll
        for (int bj = 0; bj < 2; ++bj)
#pragma unroll
            for (int n = 0; n < 2; ++n) {
                const int c = (colt & 1023) + bj * 128 + wc * 32 + n * 16 + fr, h = c >> 6, d = c & 63;
#pragma unroll
                for (int ai = 0; ai < 2; ++ai)
#pragma unroll
                    for (int m = 0; m < 4; ++m) {
                        const int r0 = rowb + ai * 128 + m * 16, b = r0 >> 13, t0 = r0 & (SEQ - 1);
                        u16* vrow = VT + (size_t)grp * T * D + ((size_t)(b * NH + h) * HD + d) * SEQ;
                        const pg8::f32x4 v = acc[ai][bj][m][n];
                        if (dil == 1) { u32x2 w; w[0] = cvtpk(v[0], v[1]); w[1] = cvtpk(v[2], v[3]); *(u32x2*)(vrow + t0) = w; }
                        else {
#pragma unroll
                            for (int i = 0; i < 4; ++i) { const int pp = t0 + i; vrow[(pp % dil) * (SEQ / dil) + pp / dil] = (u16)cvtpk(v[i], 0.f); }
                        }
                    }
            }
    }
};
struct EpiWo {
    static constexpr bool PERM = false, AFTER_DRAIN = false;
    float* Y; const float* X;
    __device__ __forceinline__ void operator()(const pg8::f32x4 (&acc)[2][2][4][2], const pg8::Unit& u, int wr, int wc, int fr, int fq) const {
        const int row0 = u.pm * 256 + wr * 64 + fr, col0 = u.pn * 256 + wc * 32 + 4 * fq;
#pragma unroll
        for (int ai = 0; ai < 2; ++ai)
#pragma unroll
            for (int m = 0; m < 4; ++m) { const size_t ro = (size_t)(row0 + ai * 128 + m * 16) * D + col0;
#pragma unroll
                for (int bj = 0; bj < 2; ++bj)
#pragma unroll
                    for (int n = 0; n < 2; ++n) { const pg8::f32x4 x = *(const pg8::f32x4*)(X + ro + bj * 128 + n * 16); *(pg8::f32x4*)(Y + ro + bj * 128 + n * 16) = x * DN_ALPHA + acc[ai][bj][m][n]; } }
    }
};
struct EpiSGU {
    static constexpr bool PERM = true, AFTER_DRAIN = false;
    u16* H;
    __device__ __forceinline__ void operator()(const pg8::f32x4 (&acc)[2][2][4][2], const pg8::Unit& u, int wr, int wc, int fr, int fq) const {
        const int row0 = u.pm * 256 + wr * 64 + fr, f0 = u.pn * 128 + wc * 32 + 8 * fq;
#pragma unroll
        for (int ai = 0; ai < 2; ++ai)
#pragma unroll
            for (int m = 0; m < 4; ++m) {
                float hv[8];
#pragma unroll
                for (int n = 0; n < 2; ++n)
#pragma unroll
                    for (int i = 0; i < 4; ++i) { const float gt = acc[ai][0][m][n][i], up = acc[ai][1][m][n][i]; hv[n * 4 + i] = gt / (1.f + __expf(-gt)) * up; }
                u32x4 w; w[0] = cvtpk(hv[0], hv[1]); w[1] = cvtpk(hv[2], hv[3]); w[2] = cvtpk(hv[4], hv[5]); w[3] = cvtpk(hv[6], hv[7]);
                *(u32x4*)(H + (size_t)(row0 + ai * 128 + m * 16) * DF + f0) = w;
            }
    }
};
struct EpiSD {
    static constexpr bool PERM = true, AFTER_DRAIN = false;
    u16* Y;
    __device__ __forceinline__ void operator()(const pg8::f32x4 (&acc)[2][2][4][2], const pg8::Unit& u, int wr, int wc, int fr, int fq) const {
        const int row0 = u.pm * 256 + wr * 64 + fr, col0 = u.pn * 256 + wc * 32 + 8 * fq;
#pragma unroll
        for (int ai = 0; ai < 2; ++ai)
#pragma unroll
            for (int m = 0; m < 4; ++m) { u16* rowp = Y + (size_t)(A_TOT + row0 + ai * 128 + m * 16) * D + col0;
#pragma unroll
                for (int bj = 0; bj < 2; ++bj) { const pg8::f32x4 v0 = acc[ai][bj][m][0], v1 = acc[ai][bj][m][1];
                    u32x4 w; w[0] = cvtpk(v0[0], v0[1]); w[1] = cvtpk(v0[2], v0[3]); w[2] = cvtpk(v1[0], v1[1]); w[3] = cvtpk(v1[2], v1[3]);
                    *(u32x4*)(rowp + bj * 128) = w; } }
    }
};

struct Args {
    const float* in[16];
    float* out;
    unsigned char* ws;
    int ph_lo, ph_hi;
};

#define GEMM_CORE(K_, PA0, PA1, PB, LDB)                                                                                                   \
    {                                                                                                                                      \
        const int g_tid = tid, g_lane = lane, g_wave = wave, g_r32 = r32, g_hi = hi;                   \
        const int g_wm = g_wave >> 2, g_wn = g_wave & 3, g_kc = g_tid & 3, g_kq = g_lane >> 3, g_n4 = g_lane & 7;                           \
        const u16* g_pa0 = (PA0); const u16* g_pa1 = (PA1);                                                                                \
        const size_t g_ldb = (size_t)(LDB);                                                                                                \
        const float* g_pb = (PB) + (size_t)(g_kq * 4) * g_ldb + g_n4 * 4;                                                                  \
        const int g_nk = (K_) / 32;                                                                                                        \
        u32x4 g_ra0, g_ra1; f32x4 g_rb0, g_rb1, g_rb2, g_rb3;                                                                              \
        const u32x4 g_z = {0u, 0u, 0u, 0u};                                                                                                \
        _Pragma("unroll") for (int mb = 0; mb < 4; ++mb) { _Pragma("unroll") for (int nb = 0; nb < 2; ++nb) { _Pragma("unroll") for (int r = 0; r < 16; ++r) acc[mb][nb][r] = 0.f; } } \
        g_ra0 = g_pa0 ? *(const u32x4*)(g_pa0 + g_kc * 8) : g_z; g_ra1 = g_pa1 ? *(const u32x4*)(g_pa1 + g_kc * 8) : g_z;                 \
        g_rb0 = *(const f32x4*)(g_pb); g_rb1 = *(const f32x4*)(g_pb + g_ldb); g_rb2 = *(const f32x4*)(g_pb + 2 * g_ldb); g_rb3 = *(const f32x4*)(g_pb + 3 * g_ldb); \
        _Pragma("unroll 1") for (int kt = 0; kt < g_nk; ++kt) {                                                                            \
            LAS char* As = lds + (kt & 1) * STAGE_BYTES; LAS char* Bs = As + 256 * LDP * 2;                                                \
            *(LAS u32x4*)(As + ((g_tid >> 2) * LDP + g_kc * 8) * 2) = g_ra0;                                                               \
            *(LAS u32x4*)(As + (((g_tid >> 2) + 128) * LDP + g_kc * 8) * 2) = g_ra1;                                                       \
            _Pragma("unroll") for (int i = 0; i < 4; ++i) {                                                                                \
                u32x2 w; w[0] = cvtpk(g_rb0[i], g_rb1[i]); w[1] = cvtpk(g_rb2[i], g_rb3[i]);                                               \
                *(LAS u32x2*)(Bs + ((g_wave * 32 + i * 8 + g_n4) * LDP + g_kq * 4) * 2) = w;                                               \
            }                                                                                                                              \
            __syncthreads();                                                                                                               \
            if (kt + 1 < g_nk) {                                                                                                           \
                const int ko = (kt + 1) * 32;                                                                                              \
                g_ra0 = g_pa0 ? *(const u32x4*)(g_pa0 + ko + g_kc * 8) : g_z; g_ra1 = g_pa1 ? *(const u32x4*)(g_pa1 + ko + g_kc * 8) : g_z; \
                const float* pbk = g_pb + (size_t)ko * g_ldb;                                                                              \
                g_rb0 = *(const f32x4*)(pbk); g_rb1 = *(const f32x4*)(pbk + g_ldb); g_rb2 = *(const f32x4*)(pbk + 2 * g_ldb); g_rb3 = *(const f32x4*)(pbk + 3 * g_ldb); \
            }                                                                                                                              \
            _Pragma("unroll") for (int s = 0; s < 2; ++s) {                                                                                \
                bf16x8 af[4], bfr[2];                                                                                                      \
                _Pragma("unroll") for (int mb = 0; mb < 4; ++mb) af[mb] = *(LAS bf16x8*)(As + ((g_wm * 128 + mb * 32 + g_r32) * LDP + s * 16 + g_hi * 8) * 2); \
                _Pragma("unroll") for (int nb = 0; nb < 2; ++nb) bfr[nb] = *(LAS bf16x8*)(Bs + (((g_wn * 2 + nb) * 32 + g_r32) * LDP + s * 16 + g_hi * 8) * 2); \
                _Pragma("unroll") for (int mb = 0; mb < 4; ++mb) { _Pragma("unroll") for (int nb = 0; nb < 2; ++nb) acc[mb][nb] = MFMA_BF16(af[mb], bfr[nb], acc[mb][nb]); } \
            }                                                                                                                              \
        }                                                                                                                                  \
        __syncthreads();                                                                                                                   \
    }

struct AttnSt { float m, l; f32x16 o0, o1; };

struct AttnFr { bf16x8 k[4]; bf16x8 v[4]; };
__device__ __forceinline__ void attn_load(AttnFr& f, const u16* krow, const u16* vt, size_t vt_dstride) {
#pragma unroll
    for (int d0 = 0; d0 < 4; ++d0) f.k[d0] = *(const bf16x8*)(krow + d0 * 16);
    const u16* vt1 = vt + 32 * vt_dstride;
    union { bf16x8 v; u32x2 h[2]; } va;
    va.h[0] = *(const u32x2*)(vt);       va.h[1] = *(const u32x2*)(vt + 8);   f.v[0] = va.v;
    va.h[0] = *(const u32x2*)(vt + 16);  va.h[1] = *(const u32x2*)(vt + 24);  f.v[1] = va.v;
    va.h[0] = *(const u32x2*)(vt1);      va.h[1] = *(const u32x2*)(vt1 + 8);  f.v[2] = va.v;
    va.h[0] = *(const u32x2*)(vt1 + 16); va.h[1] = *(const u32x2*)(vt1 + 24); f.v[3] = va.v;
}
__device__ __forceinline__ void attn_compute(AttnSt& st, const bf16x8 (&qf)[4], const AttnFr& f, int dist0, float bslope, int dlo, int dhi, int hi, int lane) {
    f32x16 p;
#pragma unroll
    for (int r = 0; r < 16; ++r) p[r] = 0.f;
#pragma unroll
    for (int d0 = 0; d0 < 4; ++d0) p = MFMA_BF16(f.k[d0], qf[d0], p);
    constexpr float C2 = 0.125f * LOG2E;
    float mx = NEGV;
#pragma unroll
    for (int r = 0; r < 16; ++r) {
        const int dist = dist0 - ((r & 3) + 8 * (r >> 2));
        const float sc = __builtin_fmaf(p[r], C2, -bslope * (float)dist);
        const float s_ = (dist >= dlo && dist <= dhi) ? sc : NEGV;
        p[r] = s_; mx = fmaxf(mx, s_);
    }
    mx = fmaxf(mx, shxf(mx, 32, lane));
    const float mnew = fmaxf(st.m, mx);
    const float alpha = __builtin_amdgcn_exp2f(st.m - mnew);
    st.m = mnew;
    float ls = 0.f;
#pragma unroll
    for (int r = 0; r < 16; ++r) { p[r] = __builtin_amdgcn_exp2f(p[r] - mnew); ls += p[r]; }
    st.l = st.l * alpha + ls;
#pragma unroll
    for (int r = 0; r < 16; ++r) { st.o0[r] *= alpha; st.o1[r] *= alpha; }
    union { bf16x8 v; unsigned u[4]; } pb0, pb1;
#pragma unroll
    for (int j = 0; j < 4; ++j) { pb0.u[j] = cvtpk(p[2 * j], p[2 * j + 1]); pb1.u[j] = cvtpk(p[8 + 2 * j], p[8 + 2 * j + 1]); }
    st.o0 = MFMA_BF16(f.v[0], pb0.v, st.o0);
    st.o0 = MFMA_BF16(f.v[1], pb1.v, st.o0);
    st.o1 = MFMA_BF16(f.v[2], pb0.v, st.o1);
    st.o1 = MFMA_BF16(f.v[3], pb1.v, st.o1);
    (void)hi;
}

__device__ __forceinline__ float dpp_rowmax(float v) {
    v = fmaxf(v, __int_as_float(__builtin_amdgcn_update_dpp(0, __float_as_int(v), 0xB1, 0xF, 0xF, true)));
    v = fmaxf(v, __int_as_float(__builtin_amdgcn_update_dpp(0, __float_as_int(v), 0x4E, 0xF, 0xF, true)));
    v = fmaxf(v, __int_as_float(__builtin_amdgcn_update_dpp(0, __float_as_int(v), 0x141, 0xF, 0xF, true)));
    v = fmaxf(v, __int_as_float(__builtin_amdgcn_update_dpp(0, __float_as_int(v), 0x140, 0xF, 0xF, true)));
    return v;
}
__device__ __forceinline__ int dpp_rowmin_i(int v) {
    v = min(v, __builtin_amdgcn_update_dpp(0, v, 0xB1, 0xF, 0xF, true));
    v = min(v, __builtin_amdgcn_update_dpp(0, v, 0x4E, 0xF, 0xF, true));
    v = min(v, __builtin_amdgcn_update_dpp(0, v, 0x141, 0xF, 0xF, true));
    v = min(v, __builtin_amdgcn_update_dpp(0, v, 0x140, 0xF, 0xF, true));
    return v;
}
__device__ __forceinline__ float rl_f(float v, int l) { return __int_as_float(__builtin_amdgcn_readlane(__float_as_int(v), l)); }

__device__ __forceinline__ void top3_insert(float v, int i, float& v0, int& i0, float& v1, int& i1, float& v2, int& i2) {
    const bool b0 = (v > v0) || (v == v0 && i < i0);
    const bool b1 = (v > v1) || (v == v1 && i < i1);
    const bool b2 = (v > v2) || (v == v2 && i < i2);
    const float nv2 = b1 ? v1 : (b2 ? v : v2); const int ni2 = b1 ? i1 : (b2 ? i : i2);
    const float nv1 = b0 ? v0 : (b1 ? v : v1); const int ni1 = b0 ? i0 : (b1 ? i : i1);
    const float nv0 = b0 ? v : v0;             const int ni0 = b0 ? i : i0;
    v0 = nv0; i0 = ni0; v1 = nv1; i1 = ni1; v2 = nv2; i2 = ni2;
}

__device__ __forceinline__ void ln_row(float (&v)[16], const float* __restrict__ g, const float* __restrict__ b, int lane) {
    float s = 0.f;
#pragma unroll
    for (int i = 0; i < 16; ++i) s += v[i];
    const float mu = wave_sum(s) * (1.f / D);
    float q = 0.f;
#pragma unroll
    for (int i = 0; i < 16; ++i) { const float d = v[i] - mu; q += d * d; }
    const float rstd = rsqrtf(wave_sum(q) * (1.f / D) + LN_EPS);
#pragma unroll
    for (int j = 0; j < 4; ++j) {
        const f32x4 gg = *(const f32x4*)(g + j * 256 + lane * 4), bb = *(const f32x4*)(b + j * 256 + lane * 4);
#pragma unroll
        for (int c = 0; c < 4; ++c) v[j * 4 + c] = (v[j * 4 + c] - mu) * rstd * gg[c] + bb[c];
    }
}

typedef __attribute__((ext_vector_type(2))) float f32x2_;
__device__ __forceinline__ bf16x8 fp8x8_to_bf16(unsigned lo, unsigned hi_) {
    const f32x2_ a = __builtin_amdgcn_cvt_pk_f32_fp8((int)lo, false), b = __builtin_amdgcn_cvt_pk_f32_fp8((int)lo, true);
    const f32x2_ c = __builtin_amdgcn_cvt_pk_f32_fp8((int)hi_, false), d = __builtin_amdgcn_cvt_pk_f32_fp8((int)hi_, true);
    union { bf16x8 v; unsigned u[4]; } r;
    r.u[0] = cvtpk(a[0], a[1]); r.u[1] = cvtpk(b[0], b[1]); r.u[2] = cvtpk(c[0], c[1]); r.u[3] = cvtpk(d[0], d[1]);
    return r.v;
}
__device__ __forceinline__ unsigned pack_fp8x4(float a, float b, float c, float d) { int p = __builtin_amdgcn_cvt_pk_fp8_f32(a, b, 0, false); return (unsigned)__builtin_amdgcn_cvt_pk_fp8_f32(c, d, p, true); }

constexpr float Y8_SCALE = 16.f;
constexpr int MOE_XCAP = 576;
#define MOE_GAS __attribute__((address_space(1)))
typedef MOE_GAS unsigned char moe_gcb;
constexpr int MOE_BP = 72;
constexpr int MOE_BSTAGE = 128 * MOE_BP * 2;
constexpr int MOE_LDS_VA = 3 * MOE_BSTAGE;
constexpr int MOE_LDS_W = MOE_LDS_VA + 4096;
constexpr int MOE_LDS_XCH = 65536;
template <bool DOWN>
__device__ __forceinline__ void moe_expert(LAS char* lds, const int tid, const int lane, const int wave, const int r32, const int hi,
                                           const unsigned char* __restrict__ abase  , const float* __restrict__ w0, const float* __restrict__ w1, const int ng  , void* __restrict__ outv,
                                           const int pass0, const int npass_, const int st0, const int nstl  , const bool y8 = false  ,
                                           const bool xr = false  ) {
    constexpr int KT = DOWN ? 4 : 16, NP = DOWN ? 8 : 4, LDB = DOWN ? 1024 : 256, APITCH = DOWN ? 256 : 1024  , PSTEP = DOWN ? 128 : 64;
    LAS int* rowva = (LAS int*)(lds + MOE_LDS_VA); LAS float* roww = (LAS float*)(lds + MOE_LDS_W);
    const int nst = nstl;
    const int nsteps = npass_ * nst * KT; (void)NP;
    unsigned aoff[2];
#define MOE_AOFF(ST_) { _Pragma("unroll") for (int a = 0; a < 2; ++a) { const int va_ = rowva[(ST_) * 512 + wave * 64 + a * 32 + r32]; \
        const int srow_ = DOWN ? va_ : (va_ == TRASH_VA ? 0 : (va_ >> 3)); aoff[a] = (unsigned)srow_ * APITCH + hi * 32; } }
    const int seg = wave >> 1, n4 = lane & 7, kp = (wave & 1) * 16 + (lane >> 3);
    const char* wbase = (const char*)(DOWN ? (w0 + seg * 32) : (((seg < 2) ? w0 : w1) + (seg & 1) * 32));
    unsigned boff = (unsigned)(4 * n4 + 2 * kp * LDB) * 4u; asm volatile("" : "+v"(boff));
    unsigned wb_ = (unsigned)((seg * 32 + n4) * MOE_BP + 2 * kp) * 2u; asm volatile("" : "+v"(wb_));
    unsigned lb_ = (unsigned)(r32 * MOE_BP + hi * 32) * 2u; asm volatile("" : "+v"(lb_));
    f32x16 acc[2][4];
#pragma unroll
    for (int a = 0; a < 2; ++a)
#pragma unroll
        for (int c = 0; c < 4; ++c)
#pragma unroll
            for (int r = 0; r < 16; ++r) acc[a][c][r] = 0.f;
    u32x4 fa8[2][2];
    f32x16 accx; u32x4 fa8x[2]; unsigned aoffx = 0u;
#pragma unroll
    for (int r = 0; r < 16; ++r) accx[r] = 0.f;
    fa8x[0] = u32x4{0u, 0u, 0u, 0u}; fa8x[1] = u32x4{0u, 0u, 0u, 0u};
    f32x4 rb0[4], rb1[4];
#define MOE_DEC(S_) const int s2_ = (S_) < nsteps ? (S_) : 0; const int pl_ = s2_ / (nst * KT); const int rm_ = s2_ - pl_ * (nst * KT); const int sl_ = rm_ / KT; const int kt_ = rm_ - sl_ * KT; const int ps_ = pass0 + pl_; const int stt_ = st0 + sl_;
#define MOE_LOADB(S_, RB) { MOE_DEC(S_) (void)stt_; \
        uint64_t wu_ = (uint64_t)(wbase + (size_t)(ps_ * PSTEP + kt_ * 64 * LDB) * 4), wv_ = wu_ + 16 * LDB * 4; asm volatile("" : "+s"(wu_), "+s"(wv_));     \
        const moe_gcb* wug_ = (const moe_gcb*)wu_; const moe_gcb* wvg_ = (const moe_gcb*)wv_; \
        unsigned bo_ = boff; asm volatile("" : "+v"(bo_));     \
        RB[0] = *(const MOE_GAS f32x4*)(wug_ + bo_); RB[1] = *(const MOE_GAS f32x4*)(wug_ + bo_ + LDB * 4); RB[2] = *(const MOE_GAS f32x4*)(wvg_ + bo_); RB[3] = *(const MOE_GAS f32x4*)(wvg_ + bo_ + LDB * 4); }
#define MOE_WRITEB(STG, RB) { LAS char* Bs_ = lds + (STG) * MOE_BSTAGE; \
        _Pragma("unroll") for (int i = 0; i < 4; ++i) { LAS unsigned* q_ = (LAS unsigned*)(Bs_ + wb_ + i * (8 * MOE_BP * 2)); q_[0] = cvtpk(RB[0][i], RB[1][i]); q_[8] = cvtpk(RB[2][i], RB[3][i]); } }
#define MOE_COMPUTE(STG, DO_MFMA) { LAS char* Bs_ = lds + (STG) * MOE_BSTAGE; \
        _Pragma("unroll") for (int u = 0; u < 4; ++u) { \
            bf16x8 bfr[4]; \
            if (DO_MFMA) { _Pragma("unroll") for (int c = 0; c < 4; ++c) bfr[c] = *(LAS bf16x8*)(Bs_ + lb_ + (c * 32 * MOE_BP + u * 8) * 2); } \
            _Pragma("unroll") for (int a = 0; a < 2; ++a) { \
                if (DO_MFMA) { const bf16x8 af_ = fp8x8_to_bf16(fa8[a][u >> 1][(u & 1) * 2], fa8[a][u >> 1][(u & 1) * 2 + 1]); \
                    _Pragma("unroll") for (int c = 0; c < 4; ++c) acc[a][c] = MFMA_BF16(bfr[c], af_, acc[a][c]); } \
            } \
        } }
      \
#define MOE_RELOAD { _Pragma("unroll") for (int a = 0; a < 2; ++a) { unsigned ao_ = aoff[a]; asm volatile("" : "+v"(ao_)); \
            fa8[a][0] = *(const MOE_GAS u32x4*)(ab_n + ao_); fa8[a][1] = *(const MOE_GAS u32x4*)(ab_n + ao_ + 16); } }
#define MOE_XCOMPUTE(STG) if (!DOWN) { LAS char* Bs_ = lds + (STG) * MOE_BSTAGE; \
        _Pragma("unroll") for (int u = 0; u < 4; ++u) { \
            const bf16x8 ax_ = fp8x8_to_bf16(fa8x[u >> 1][(u & 1) * 2], fa8x[u >> 1][(u & 1) * 2 + 1]); \
            if (u & 1) { unsigned ao_ = aoffx; asm volatile("" : "+v"(ao_)); fa8x[u >> 1] = *(const MOE_GAS u32x4*)(ab_n + ao_ + (u >> 1) * 16); } \
            const bf16x8 bx_ = *(LAS bf16x8*)(Bs_ + (wave & 3) * (32 * MOE_BP * 2) + lb_ + u * 16); \
            accx = MFMA_BF16(bx_, ax_, accx); } }
#define MOE_NEXTA(S_) MOE_DEC(S_) (void)ps_; \
        if (stt_ != st_loaded) { MOE_AOFF(stt_) st_loaded = stt_; } \
        uint64_t abn_ = (uint64_t)abase + kt_ * 64; asm volatile("" : "+s"(abn_)); const moe_gcb* ab_n = (const moe_gcb*)abn_;
    int st_loaded = st0;
    MOE_AOFF(st0)
    { const char* ab0 = (const char*)abase;
#pragma unroll
      for (int a = 0; a < 2; ++a)
#pragma unroll
          for (int h2 = 0; h2 < 2; ++h2) fa8[a][h2] = *(const u32x4*)(ab0 + aoff[a] + h2 * 16); }
    if (!DOWN) {
        const int vax_ = xr ? rowva[512 + 32 * (wave >> 2) + r32] : TRASH_VA; aoffx = (unsigned)(vax_ == TRASH_VA ? 0 : (vax_ >> 3)) * APITCH + hi * 32;
        fa8x[0] = *(const u32x4*)((const char*)abase + aoffx); fa8x[1] = *(const u32x4*)((const char*)abase + aoffx + 16); }
    MOE_LOADB(0, rb0)
    MOE_LOADB(1, rb1)
    MOE_WRITEB(0, rb0)
    MOE_LOADB(2, rb0)
    int stg = 0;
#pragma unroll 1
    for (int sidx = 0; sidx < nsteps; sidx += 2) {
        const int pl = sidx / (nst * KT); const int rm = sidx - pl * (nst * KT); const int sl = rm / KT; const int kt = rm - sl * KT; const int ps = pass0 + pl, stt = st0 + sl;
        const bool wv = (wave * 64) < (ng - stt * 512);
        const int stg1 = stg == 2 ? 0 : stg + 1, stg2 = stg1 == 2 ? 0 : stg1 + 1;
        __syncthreads();
        MOE_WRITEB(stg1, rb1)
        MOE_LOADB(sidx + 3, rb1)
        { MOE_NEXTA(sidx + 1)
          if (wv) MOE_COMPUTE(stg, true)
          MOE_RELOAD
          MOE_XCOMPUTE(stg) }
        __syncthreads();
        MOE_WRITEB(stg2, rb0)
        MOE_LOADB(sidx + 4, rb0)
        { MOE_NEXTA(sidx + 2)
          if (wv) MOE_COMPUTE(stg1, true)
          MOE_RELOAD
          MOE_XCOMPUTE(stg1) }
        stg = stg2;
        if (kt == KT - 2) {
            const int le_ = lane_id_(); const int lane = le_, r32 = le_ & 31, hi = le_ >> 5; (void)lane;
            if (wv) {
                const int nrows = ng - stt * 512;
#pragma unroll
                for (int a = 0; a < 2; ++a) {
                    if (a == 0 || (wave * 64 + 32) < nrows) {
                        const int lrow = stt * 512 + wave * 64 + a * 32 + r32;
                        const unsigned va = (unsigned)rowva[lrow];
                        if (DOWN) {
                            const float w = roww[lrow];
#pragma unroll
                            for (int c = 0; c < 4; ++c) {
                                float yv_[16];
#pragma unroll
                                for (int j = 0; j < 16; ++j) yv_[j] = acc[a][c][(j >> 2) + 4 * (j & 3)] * w;
                                if (y8) {
                                    u32x4 q8;
#pragma unroll
                                    for (int jj = 0; jj < 4; ++jj) q8[jj] = pack_fp8x4(yv_[4 * jj], yv_[4 * jj + 1], yv_[4 * jj + 2], yv_[4 * jj + 3]);
                                    *(u32x4*)((unsigned char*)outv + (size_t)va * D + ps * 128 + c * 32 + 16 * hi) = q8;
                                } else {
                                    u32x4 q0, q1;
#pragma unroll
                                    for (int jj = 0; jj < 4; ++jj) { q0[jj] = cvtpk(yv_[2 * jj], yv_[2 * jj + 1]); q1[jj] = cvtpk(yv_[8 + 2 * jj], yv_[9 + 2 * jj]); }
                                    u16* o = (u16*)outv + (size_t)va * D + ps * 128 + c * 32 + 16 * hi;
                                    *(u32x4*)o = q0; *(u32x4*)(o + 8) = q1;
                                }
                            }
                        } else {
#pragma unroll
                            for (int c = 0; c < 2; ++c) {
                                float hv[16];
#pragma unroll
                                for (int j = 0; j < 16; ++j) { const int r = (j >> 2) + 4 * (j & 3); const float gt = acc[a][c][r], up = acc[a][c + 2][r]; hv[j] = gt / (1.f + __expf(-gt)) * up; }
                                u32x4 q;
#pragma unroll
                                for (int jj = 0; jj < 4; ++jj) q[jj] = pack_fp8x4(hv[4 * jj], hv[4 * jj + 1], hv[4 * jj + 2], hv[4 * jj + 3]);
                                *(u32x4*)((unsigned char*)outv + (size_t)va * DF + ps * 64 + c * 32 + 16 * hi) = q;
                            }
                        }
                    }
                }
#pragma unroll
                for (int a = 0; a < 2; ++a)
#pragma unroll
                    for (int c = 0; c < 4; ++c)
#pragma unroll
                        for (int r = 0; r < 16; ++r) acc[a][c][r] = 0.f;
            }
            if (!DOWN) { if (xr) {
                LAS float* xch = (LAS float*)(lds + MOE_LDS_XCH) + ((wave >> 2) * 2 + (wave & 1)) * 1024 + lane;
                if ((wave & 3) >= 2) {
#pragma unroll
                    for (int r = 0; r < 16; ++r) xch[r * 64] = accx[r];
                }
                __syncthreads();
                if ((wave & 3) < 2) {
                    const unsigned vax = (unsigned)rowva[512 + 32 * (wave >> 2) + r32];
                    u32x4 q;
#pragma unroll
                    for (int jj = 0; jj < 4; ++jj) {
#pragma unroll
                        for (int i = 0; i < 4; ++i) { const int r = jj + 4 * i; const float gt = accx[r]; accx[r] = gt / (1.f + __expf(-gt)) * xch[r * 64]; }
                        q[jj] = pack_fp8x4(accx[jj], accx[jj + 4], accx[jj + 8], accx[jj + 12]);
                    }
                    *(u32x4*)((unsigned char*)outv + (size_t)vax * DF + ps * 64 + (wave & 3) * 32 + 16 * hi) = q;
                }
                }
#pragma unroll
                for (int r = 0; r < 16; ++r) accx[r] = 0.f;
            }
        }
    }
    __syncthreads();
#undef MOE_XCOMPUTE
#undef MOE_AOFF
#undef MOE_DEC
#undef MOE_LOADB
#undef MOE_WRITEB
#undef MOE_COMPUTE
#undef MOE_RELOAD
#undef MOE_NEXTA
}

constexpr int N_PHASES = 21;

#define P_x_in CTX_IN(0)
#define P_xb ((u16*)(ws + WS_XB))
#define P_x1 ((float*)(ws + WS_X1))
#define P_x2 ((float*)(ws + WS_X2))
#define P_ypre ((float*)(ws + WS_YPRE))
#define P_qkv ((u16*)(ws + WS_QKV))
#define P_vT ((u16*)(ws + WS_VT))
#define P_kmean ((float*)(ws + WS_KM))
#define P_ao ((u16*)(ws + WS_AO))
#define P_og ((u16*)(ws + WS_OG))
#define P_lse ((float*)(ws + WS_LSE))
#define P_topw ((float*)(ws + WS_TOPW))
#define P_list ((int*)(ws + WS_LIST))
#define P_hb ((u16*)(ws + WS_HB))
#define P_yb ((u16*)(ws + WS_YB))
#define P_cnt_all ((int*)(ws + WS_CTL + CTL_ECNT_OFF))
#define P_xb8 ((unsigned char*)(ws + WS_XB8))
#define P_hbs ((u16*)(ws + WS_HBS))
#define P_selm ((unsigned*)(ws + WS_SELM))
#define P_part ((u16*)(ws + WS_PART))
#define P_plse ((float*)(ws + WS_PLSE))
#define PH_BEGIN int tid = wave_s_ * 64 + lane_id_(); asm volatile("" : "+v"(tid)); const int lane = tid & 63, r32 = lane & 31, hi = lane >> 5; const int wave = __builtin_amdgcn_readfirstlane(tid >> 6); (void)lane; (void)r32; (void)hi; (void)wave
constexpr int LDS_CTX = LDS_BAR + 16;
__device__ __forceinline__ uint64_t ctx_ld(int i) {
    extern __shared__ __attribute__((aligned(16))) unsigned char lds_raw[];
    const LAS unsigned* q = (const LAS unsigned*)((LAS char*)lds_raw + LDS_CTX) + 2 * i;
    const unsigned lo = __builtin_amdgcn_readfirstlane(q[0]), hi = __builtin_amdgcn_readfirstlane(q[1]);
    return ((uint64_t)hi << 32) | lo;
}
typedef __attribute__((address_space(1))) unsigned char gbyte;
#define AS_GLOBAL(T, u64v) ((T*)(gbyte*)(u64v))
#define CTX_IN(i) AS_GLOBAL(const float, ctx_ld(i))
#define PH_FN_BEGIN \
    extern __shared__ __attribute__((aligned(16))) unsigned char lds_raw[]; \
    LAS char* lds = (LAS char*)lds_raw; (void)lds; \
    const int G = gridDim.x, bid = blockIdx.x; (void)G; (void)bid; \
    unsigned char* const ws = AS_GLOBAL(unsigned char, ctx_ld(17)); (void)ws; \
    const int NQ = L == 0 ? 3072 : 9216; (void)NQ; \
    int* cnt = P_cnt_all + L * NE * CNT_STRIDE; (void)cnt;
__device__ __forceinline__ void ph_p0(int L, int rep_, const int wave_s_) {
    PH_FN_BEGIN
    (void)rep_;
    PH_BEGIN;
    for (size_t i = (size_t)bid * NTHR + tid; i < (size_t)T * D / 4; i += (size_t)G * NTHR) {
        const f32x4 v = *(const f32x4*)(P_x_in + i * 4);
        u32x2 w; w[0] = cvtpk(v[0], v[1]); w[1] = cvtpk(v[2], v[3]);
        *(u32x2*)(P_xb + i * 4) = w;
    }
    LAS float* tl = (LAS float*)lds;
    for (int it = bid; it < 3968 + 128; it += G) {
        int seg, kt;
        if (it < 3840) { seg = it >> 4; kt = it & 15; } else if (it < 3968) { seg = 240 + ((it - 3840) >> 2); kt = (it - 3840) & 3; } else { seg = 272 + ((it - 3968) >> 4); kt = (it - 3968) & 15; }
        const float* src; int ld; u16* dst; int Kd = 1024; u16* dst_lo = nullptr;
        if (seg < 48) { const int col = 64 * seg; src = CTX_IN(1) + col; ld = 3072; dst = (u16*)(ws + WS_WQK0) + (size_t)col * 1024; }
        else if (seg < 192) { const int col = 64 * (seg - 48); src = CTX_IN(2) + col; ld = 9216; dst = (u16*)(ws + WS_WQK1) + (size_t)col * 1024; }
        else if (seg < 224) { const int s2 = seg - 192, l2 = s2 >> 4, col = 64 * (s2 & 15); src = CTX_IN(3) + (size_t)l2 * D * D + col; ld = 1024; dst = (u16*)(ws + WS_WO) + (size_t)l2 * D * D + (size_t)col * 1024; }
        else if (seg < 240) { const int s2 = seg - 224, l2 = s2 >> 3, i8 = s2 & 7, un = i8 >> 2, q = i8 & 3;
            src = (q < 2 ? CTX_IN(11) : CTX_IN(12)) + (size_t)l2 * D * DF + un * 128 + 64 * (q & 1); ld = 256; dst = (u16*)(ws + WS_WSGU) + (size_t)l2 * 512 * 1024 + (size_t)(64 * i8) * 1024; }
        else if (seg < 272) { const int s2 = seg - 240, l2 = s2 >> 4, col = 64 * (s2 & 15); src = CTX_IN(13) + (size_t)l2 * DF * D + col; ld = 1024; Kd = 256; dst = (u16*)(ws + WS_WSD) + (size_t)l2 * D * DF + (size_t)col * 256; }
        else { const int s2 = seg - 272, l2 = s2 >> 2, col = 64 * (s2 & 3); src = CTX_IN(6) + (size_t)l2 * D * NE + col; ld = 256; dst = (u16*)(ws + WS_WRH) + (size_t)l2 * NE * D + (size_t)col * 1024; dst_lo = (u16*)(ws + WS_WRL) + (size_t)l2 * NE * D + (size_t)col * 1024; }
        {
            const int kr = tid >> 4, c4 = tid & 15;
#pragma unroll
            for (int i = 0; i < 2; ++i) {
                const f32x4 v = *(const f32x4*)(src + (size_t)(kt * 64 + kr + 32 * i) * ld + 4 * c4);
#pragma unroll
                for (int jj = 0; jj < 4; ++jj) tl[(kr + 32 * i) * 65 + 4 * c4 + jj] = v[jj];
            }
        }
        __syncthreads();
        {
            const int row = tid >> 3, kc = tid & 7;
            float f[8];
#pragma unroll
            for (int jj = 0; jj < 8; ++jj) f[jj] = tl[(8 * kc + jj) * 65 + row];
            u32x4 w; w[0] = cvtpk(f[0], f[1]); w[1] = cvtpk(f[2], f[3]); w[2] = cvtpk(f[4], f[5]); w[3] = cvtpk(f[6], f[7]);
            *(u32x4*)(dst + (size_t)row * Kd + kt * 64 + 8 * kc) = w;
            if (dst_lo) {
                u32x4 wl;
#pragma unroll
                for (int jj = 0; jj < 4; ++jj) wl[jj] = cvtpk(f[2 * jj] - bf2f(w[jj] & 0xFFFFu), f[2 * jj + 1] - bf2f(w[jj] >> 16));
                *(u32x4*)(dst_lo + (size_t)row * Kd + kt * 64 + 8 * kc) = wl;
            }
        }
        __syncthreads();
    }
}

__device__ __forceinline__ void ph_qkv(int L, int rep_, const int wave_s_) {
    PH_FN_BEGIN
    (void)rep_;
    const pg8::Gemm g{P_xb, (const u16*)(ws + (L == 0 ? WS_WQK0 : WS_WQK1)), T, NQ, D};
    pg8::StaticOrder S; S.init(g.M, g.N, G, bid);
    const EpiQK E{P_qkv, NQ};
    pg8::gemm_phase<EpiQK, pg8::StaticOrder, false>((PG8_LAS unsigned char*)lds, g, S, E, nullptr, wave_s_ * 64 + lane_id_());
}

__device__ __forceinline__ void ph_kmean(int L, int rep_, const int wave_s_) {
    PH_FN_BEGIN
    (void)rep_;
    PH_BEGIN;
    LAS float* red = (LAS float*)lds;
    for (int it = bid; it < BATCH * NH * MOBA_NB; it += G) {
        const int j = it & 31, h = (it >> 5) & 15, b = it >> 9;
        const int kg_ = tid >> 3, ch = tid & 7;
        const u16* kp = P_qkv + (size_t)(b * SEQ + j * MOBA_BLK + kg_) * 3072 + 1024 + h * 64 + ch * 8;
        float sm[8];
#pragma unroll
        for (int e2 = 0; e2 < 8; ++e2) sm[e2] = 0.f;
#pragma unroll
        for (int i = 0; i < 4; ++i) {
            const u32x4 v = *(const u32x4*)(kp + (size_t)(64 * i) * 3072);
#pragma unroll
            for (int e2 = 0; e2 < 4; ++e2) { sm[2 * e2] += bf2f(v[e2] & 0xFFFFu); sm[2 * e2 + 1] += bf2f(v[e2] >> 16); }
        }
#pragma unroll
        for (int e2 = 0; e2 < 8; ++e2) red[kg_ * 65 + ch * 8 + e2] = sm[e2];
        __syncthreads();
        if (tid < 64) {
            float tot = 0.f;
#pragma unroll 8
            for (int q = 0; q < 64; ++q) tot += red[q * 65 + tid];
            P_kmean[(size_t)it * 64 + tid] = tot * (1.f / MOBA_BLK);
        }
        __syncthreads();
    }
}

__device__ __forceinline__ void ph_gate(int L, int rep_, const int wave_s_) {
    PH_FN_BEGIN
    (void)rep_;
    PH_BEGIN;
    for (int it = bid; it < BATCH * NH * MOBA_NB; it += G) {
        const int qb = it & 31, bh = it >> 5, b = bh >> 4, h = bh & 15;
        const int tq = qb * MOBA_BLK + wave * 32 + r32;
        const u16* qrow = P_qkv + (size_t)(b * SEQ + tq) * 3072 + h * 64 + hi * 8;
        bf16x8 qf[4];
#pragma unroll
        for (int d0 = 0; d0 < 4; ++d0) qf[d0] = *(const bf16x8*)(qrow + d0 * 16);
        unsigned selmask = 0u;
        if (qb > 0) {
            const float* km = P_kmean + ((size_t)(b * NH + h) * MOBA_NB + r32) * 64 + hi * 8;
            f32x16 gt;
#pragma unroll
            for (int r = 0; r < 16; ++r) gt[r] = 0.f;
#pragma unroll
            for (int d0 = 0; d0 < 4; ++d0) {
                const f32x4 k0 = *(const f32x4*)(km + d0 * 16), k1 = *(const f32x4*)(km + d0 * 16 + 4);
                union { bf16x8 v; unsigned u[4]; } kf;
                kf.u[0] = cvtpk(k0[0], k0[1]); kf.u[1] = cvtpk(k0[2], k0[3]); kf.u[2] = cvtpk(k1[0], k1[1]); kf.u[3] = cvtpk(k1[2], k1[3]);
                gt = MFMA_BF16(kf.v, qf[d0], gt);
            }
            float v0 = -INFINITY, v1 = -INFINITY, v2 = -INFINITY; int i0 = 99, i1 = 99, i2 = 99;
#pragma unroll
            for (int r = 0; r < 16; ++r) { const int jb = crow(r, hi); const float gv = jb < qb ? gt[r] : -INFINITY; top3_insert(gv, jb < qb ? jb : 99, v0, i0, v1, i1, v2, i2); }
            const float ov0 = shxf(v0, 32, lane), ov1 = shxf(v1, 32, lane), ov2 = shxf(v2, 32, lane);
            const int oi0 = shxi(i0, 32, lane), oi1 = shxi(i1, 32, lane), oi2 = shxi(i2, 32, lane);
            top3_insert(ov0, oi0, v0, i0, v1, i1, v2, i2); top3_insert(ov1, oi1, v0, i0, v1, i1, v2, i2); top3_insert(ov2, oi2, v0, i0, v1, i1, v2, i2);
            if (i0 < 32) selmask |= 1u << i0;
            if (i1 < 32) selmask |= 1u << i1;
            if (i2 < 32) selmask |= 1u << i2;
        }
        if (hi == 0) P_selm[(size_t)bh * SEQ + tq] = selmask;
    }
}

constexpr int MB_KP = 72;
constexpr int MB_VP = 260;
constexpr int MB_LDS_K = 0;
constexpr int MB_LDS_V = 256 * MB_KP * 2;
constexpr int MB_LDS_LIST = MB_LDS_V + 64 * MB_VP * 2;
constexpr int MB_LDS_CTR = MB_LDS_LIST + 8192 * 2;
__device__ __forceinline__ void ph_moba(int L, int rep_, const int wave_s_) {
    PH_FN_BEGIN
    (void)rep_;
    PH_BEGIN;
    LAS char* Ks = lds + MB_LDS_K; LAS char* Vs = lds + MB_LDS_V;
    LAS u16* qlist = (LAS u16*)(lds + MB_LDS_LIST); LAS int* ctr = (LAS int*)(lds + MB_LDS_CTR);
    for (int it = bid; it < BATCH * NH * MOBA_NB; it += G) {
        const int rnd = it >> 8, w8 = it & 255, a8 = w8 >> 5, bh = w8 & 31;
        const int j = rnd == 0 ? a8 : (rnd == 1 ? 15 - a8 : (rnd == 2 ? 16 + a8 : 31 - a8));
        const int b = bh >> 4, h = bh & 15;
        const float slope2 = exp2f(-0.5f * (float)(h + 1)) * LOG2E;
        if (tid == 0) { int z0 = 0; asm volatile("" : "+v"(z0)); ctr[0] = z0; ctr[1] = z0; }
        {
            const u16* kg = P_qkv + (size_t)(b * SEQ + j * MOBA_BLK) * 3072 + 1024 + h * 64;
#pragma unroll
            for (int i = 0; i < 4; ++i) { const int c = tid + i * 512, row = c >> 3, ch = c & 7; *(LAS u32x4*)(Ks + (row * MB_KP + ch * 8) * 2) = *(const u32x4*)(kg + (size_t)row * 3072 + ch * 8); }
            const u16* vg = P_qkv + (size_t)(b * SEQ + j * MOBA_BLK) * 3072 + 2048 + h * 64;
#pragma unroll
            for (int i = 0; i < 4; ++i) {
                const int c = tid + i * 512, key = c >> 3, ch = c & 7;
                const u32x4 v = *(const u32x4*)(vg + (size_t)key * 3072 + ch * 8);
#pragma unroll
                for (int e2 = 0; e2 < 4; ++e2) {
                    *(LAS u16*)(Vs + ((ch * 8 + 2 * e2) * MB_VP + key) * 2) = (u16)(v[e2] & 0xFFFFu);
                    *(LAS u16*)(Vs + ((ch * 8 + 2 * e2 + 1) * MB_VP + key) * 2) = (u16)(v[e2] >> 16);
                }
            }
        }
        __syncthreads();
        {
            const unsigned* sm = P_selm + (size_t)bh * SEQ;
            for (int t0 = (j + 1) * MOBA_BLK; t0 < SEQ; t0 += 512) {
                const int t = t0 + tid;
                const bool sel = (t < SEQ) && ((sm[t < SEQ ? t : 0] >> j) & 1u);
                const unsigned long long bal = __ballot(sel);
                const int total = __popcll(bal);
                int wb = 0;
                if (lane == 0 && total) wb = atomicAdd((int*)&ctr[0], total);
                wb = __builtin_amdgcn_readfirstlane(wb);
                if (sel) qlist[wb + __popcll(bal & ((1ull << lane) - 1ull))] = (u16)t;
            }
        }
        __syncthreads();
        const int nq = ctr[0];
        const int ntiles = 8 + ((nq + 31) >> 5);
        for (;;) {
            int ti = 0;
            if (lane == 0) ti = atomicAdd((int*)&ctr[1], 1);
            ti = __builtin_amdgcn_readfirstlane(ti);
            if (ti >= ntiles) break;
            const bool own = ti < 8;
            const int wq = 7 - ti;
            const int li = (ti - 8) * 32 + r32;
            const bool valid = own || li < nq;
            const int tq = own ? j * MOBA_BLK + wq * 32 + r32 : (int)qlist[li < nq ? li : nq - 1];
            const int nsteps = own ? wq + 1 : 8;
            const u16* qrow = P_qkv + (size_t)(b * SEQ + tq) * 3072 + h * 64 + hi * 8;
            bf16x8 qf[4];
#pragma unroll
            for (int d0 = 0; d0 < 4; ++d0) qf[d0] = *(const bf16x8*)(qrow + d0 * 16);
            int slot = 3;
            if (!own) slot = __popc(P_selm[(size_t)bh * SEQ + tq] & ((1u << j) - 1u));
            AttnSt st; st.m = NEGV; st.l = 0.f;
#pragma unroll
            for (int r = 0; r < 16; ++r) { st.o0[r] = 0.f; st.o1[r] = 0.f; }
            const int dlo = own ? 0 : -0x40000000;
            for (int kt = 0; kt < nsteps; ++kt) {
                AttnFr f;
#pragma unroll
                for (int d0 = 0; d0 < 4; ++d0) f.k[d0] = *(LAS bf16x8*)(Ks + ((kt * 32 + r32) * MB_KP + d0 * 16 + hi * 8) * 2);
#pragma unroll
                for (int q4 = 0; q4 < 4; ++q4) {
                    union { bf16x8 v; u32x2 hh[2]; } va;
                    LAS char* vp = Vs + (((q4 >> 1) * 32 + r32) * MB_VP + kt * 32 + (q4 & 1) * 16 + 4 * hi) * 2;
                    va.hh[0] = *(LAS u32x2*)(vp); va.hh[1] = *(LAS u32x2*)(vp + 16);
                    f.v[q4] = va.v;
                }
                attn_compute(st, qf, f, tq - (j * MOBA_BLK + kt * 32) - 4 * hi, slope2, dlo, 0x7fffffff, hi, lane);
            }
            const float lt = st.l + shxf(st.l, 32, lane);
            const float inv = 1.f / lt;
            if (valid) {
                const size_t pi = ((size_t)(b * SEQ + tq) * NH + h) * 4 + slot;
                u16* orow = P_part + pi * 64;
#pragma unroll
                for (int rq = 0; rq < 4; ++rq) {
                    u32x2 w; w[0] = cvtpk(st.o0[4 * rq] * inv, st.o0[4 * rq + 1] * inv); w[1] = cvtpk(st.o0[4 * rq + 2] * inv, st.o0[4 * rq + 3] * inv);
                    *(u32x2*)(orow + 8 * rq + 4 * hi) = w;
                    w[0] = cvtpk(st.o1[4 * rq] * inv, st.o1[4 * rq + 1] * inv); w[1] = cvtpk(st.o1[4 * rq + 2] * inv, st.o1[4 * rq + 3] * inv);
                    *(u32x2*)(orow + 32 + 8 * rq + 4 * hi) = w;
                }
                if (hi == 0) P_plse[pi] = st.m * LN2 + logf(lt);
            }
        }
        __syncthreads();
    }
}

__device__ __forceinline__ void ph_mobamerge(int L, int rep_, const int wave_s_) {
    PH_FN_BEGIN
    (void)rep_;
    PH_BEGIN;
    for (size_t i = (size_t)bid * NTHR + tid; i < (size_t)T * NH * 8; i += (size_t)G * NTHR) {
        const size_t row = i >> 7; const int h = (int)(i >> 3) & 15, d8 = (int)i & 7;
        const int qb = (int)(row & (SEQ - 1)) >> 8;
        const int nsel = qb < 3 ? qb : 3;
        const size_t pi = (row * NH + h) * 4;
        float l[4], w[4];
        float mx = -INFINITY;
#pragma unroll
        for (int sidx = 0; sidx < 4; ++sidx) { const bool ok = sidx == 3 || sidx < nsel; l[sidx] = ok ? P_plse[pi + sidx] : -INFINITY; mx = fmaxf(mx, l[sidx]); }
        float ws_ = 0.f;
#pragma unroll
        for (int sidx = 0; sidx < 4; ++sidx) { w[sidx] = (sidx == 3 || sidx < nsel) ? expf(l[sidx] - mx) : 0.f; ws_ += w[sidx]; }
        const float inv = 1.f / ws_;
        float acc8[8];
#pragma unroll
        for (int c = 0; c < 8; ++c) acc8[c] = 0.f;
#pragma unroll
        for (int sidx = 0; sidx < 4; ++sidx) {
            if (sidx == 3 || sidx < nsel) {
                const u32x4 a = *(const u32x4*)(P_part + (pi + sidx) * 64 + d8 * 8);
                const float ww = w[sidx] * inv;
#pragma unroll
                for (int c = 0; c < 4; ++c) { acc8[2 * c] += ww * bf2f(a[c] & 0xFFFFu); acc8[2 * c + 1] += ww * bf2f(a[c] >> 16); }
            }
        }
        u32x4 o;
#pragma unroll
        for (int c = 0; c < 4; ++c) o[c] = cvtpk(acc8[2 * c], acc8[2 * c + 1]);
        *(u32x4*)(P_ao + row * D + h * 64 + d8 * 8) = o;
    }
}

constexpr int DL_KP = 72, DL_VP = 388;
constexpr int DL_LDS_K = 0, DL_LDS_V = 384 * DL_KP * 2;
__device__ __forceinline__ void ph_dil(int L, int rep_, const int wave_s_) {
    PH_FN_BEGIN
    (void)rep_;
    PH_BEGIN;
    LAS char* Ks = lds + DL_LDS_K; LAS char* Vs = lds + DL_LDS_V;
    for (int it = bid; it < BATCH * NH * 3 * 32; it += G) {
        const int ch = it & 31, grp = (it >> 5) % 3, bh = it / 96, b = bh >> 4, h = bh & 15;
        const int dil = grp == 0 ? 1 : (grp == 1 ? 4 : 16), Ls = SEQ / dil;
        const float slope2 = exp2f(-0.5f * (float)(h + 1)) * LOG2E * (float)dil;
        const int uc = ch * 256, res = uc / Ls, c0 = uc - res * Ls;
        const int kb0 = c0 - 128;
        {
            const u16* kg = P_qkv + (size_t)(b * SEQ) * 9216 + grp * 3072 + 1024 + h * 64;
#pragma unroll
            for (int i = 0; i < 6; ++i) {
                const int c = tid + i * 512, row = c >> 3, chk = c & 7, ks = kb0 + row;
                if (ks >= 0) *(LAS u32x4*)(Ks + (row * DL_KP + chk * 8) * 2) = *(const u32x4*)(kg + (size_t)(ks * dil + res) * 9216 + chk * 8);
            }
            const u16* vg = P_qkv + (size_t)(b * SEQ) * 9216 + grp * 3072 + 2048 + h * 64;
#pragma unroll
            for (int i = 0; i < 6; ++i) {
                const int c = tid + i * 512, row = c >> 3, chk = c & 7, ks = kb0 + row;
                if (ks >= 0) {
                    const u32x4 v = *(const u32x4*)(vg + (size_t)(ks * dil + res) * 9216 + chk * 8);
#pragma unroll
                    for (int e2 = 0; e2 < 4; ++e2) {
                        *(LAS u16*)(Vs + ((chk * 8 + 2 * e2) * DL_VP + row) * 2) = (u16)(v[e2] & 0xFFFFu);
                        *(LAS u16*)(Vs + ((chk * 8 + 2 * e2 + 1) * DL_VP + row) * 2) = (u16)(v[e2] >> 16);
                    }
                }
            }
        }
        const int i0 = c0 + wave * 32, iq = i0 + r32, pq = iq * dil + res;
        const u16* qrow = P_qkv + (size_t)(b * SEQ + pq) * 9216 + grp * 3072 + h * 64 + hi * 8;
        bf16x8 qf[4];
#pragma unroll
        for (int d0 = 0; d0 < 4; ++d0) qf[d0] = *(const bf16x8*)(qrow + d0 * 16);
        __syncthreads();
        AttnSt st; st.m = NEGV; st.l = 0.f;
#pragma unroll
        for (int r = 0; r < 16; ++r) { st.o0[r] = 0.f; st.o1[r] = 0.f; }
        const int ktmin = (i0 >= 128) ? 0 : (128 - i0) >> 5;
        for (int kt = 4; kt >= ktmin; --kt) {
            const int lrow0 = (wave + kt) * 32;
            AttnFr f;
#pragma unroll
            for (int d0 = 0; d0 < 4; ++d0) f.k[d0] = *(LAS bf16x8*)(Ks + ((lrow0 + r32) * DL_KP + d0 * 16 + hi * 8) * 2);
#pragma unroll
            for (int q4 = 0; q4 < 4; ++q4) {
                union { bf16x8 v; u32x2 hh[2]; } va;
                LAS char* vp = Vs + (((q4 >> 1) * 32 + r32) * DL_VP + lrow0 + (q4 & 1) * 16 + 4 * hi) * 2;
                va.hh[0] = *(LAS u32x2*)(vp); va.hh[1] = *(LAS u32x2*)(vp + 16);
                f.v[q4] = va.v;
            }
            const int k0 = i0 - 128 + kt * 32;
            attn_compute(st, qf, f, iq - k0 - 4 * hi, slope2, 0, 128, hi, lane);
        }
        const float lt = st.l + shxf(st.l, 32, lane);
        const float inv = 1.f / lt;
        u16* orow = P_og + (size_t)grp * T * D + (size_t)(b * SEQ + pq) * D + h * 64;
#pragma unroll
        for (int rq = 0; rq < 4; ++rq) {
            u32x2 w; w[0] = cvtpk(st.o0[4 * rq] * inv, st.o0[4 * rq + 1] * inv); w[1] = cvtpk(st.o0[4 * rq + 2] * inv, st.o0[4 * rq + 3] * inv);
            *(u32x2*)(orow + 8 * rq + 4 * hi) = w;
            w[0] = cvtpk(st.o1[4 * rq] * inv, st.o1[4 * rq + 1] * inv); w[1] = cvtpk(st.o1[4 * rq + 2] * inv, st.o1[4 * rq + 3] * inv);
            *(u32x2*)(orow + 32 + 8 * rq + 4 * hi) = w;
        }
        if (hi == 0) P_lse[((size_t)grp * T + (b * SEQ + pq)) * NH + h] = st.m * LN2 + logf(lt);
        __syncthreads();
    }
}

__device__ __forceinline__ void ph_merge(int L, int rep_, const int wave_s_) {
    PH_FN_BEGIN
    (void)rep_;

            PH_BEGIN;
                for (size_t i = (size_t)bid * NTHR + tid; i < (size_t)T * NH * 8; i += (size_t)G * NTHR) {
                    const size_t row = i >> 7; const int h = (int)(i >> 3) & 15, d8 = (int)i & 7;
                    const float l0 = P_lse[(0 * (size_t)T + row) * NH + h], l1 = P_lse[(1 * (size_t)T + row) * NH + h], l2 = P_lse[(2 * (size_t)T + row) * NH + h];
                    const float mx = fmaxf(l0, fmaxf(l1, l2));
                    float w0 = expf(l0 - mx), w1 = expf(l1 - mx), w2 = expf(l2 - mx);
                    const float inv = 1.f / (w0 + w1 + w2); w0 *= inv; w1 *= inv; w2 *= inv;
                    const size_t off = row * D + h * 64 + d8 * 8;
                    const u32x4 a0 = *(const u32x4*)(P_og + off), a1 = *(const u32x4*)(P_og + (size_t)T * D + off), a2 = *(const u32x4*)(P_og + 2 * (size_t)T * D + off);
                    u32x4 o;
#pragma unroll
                    for (int c = 0; c < 4; ++c) {
                        const float lo_ = w0 * bf2f(a0[c] & 0xFFFFu) + w1 * bf2f(a1[c] & 0xFFFFu) + w2 * bf2f(a2[c] & 0xFFFFu);
                        const float hi_ = w0 * bf2f(a0[c] >> 16) + w1 * bf2f(a1[c] >> 16) + w2 * bf2f(a2[c] >> 16);
                        o[c] = cvtpk(lo_, hi_);
                    }
                    *(u32x4*)(P_ao + off) = o;
                }

}

__device__ __forceinline__ void ph_wo(int L, int rep_, const int wave_s_) {
    PH_FN_BEGIN
    (void)rep_;
    const pg8::Gemm g{P_ao, (const u16*)(ws + WS_WO) + (size_t)L * D * D, T, D, D};
    pg8::StaticOrder S; S.init(g.M, g.N, G, bid);
    const EpiWo E{P_ypre, L == 0 ? CTX_IN(0) : (const float*)P_x2};
    pg8::gemm_phase<EpiWo, pg8::StaticOrder, false>((PG8_LAS unsigned char*)lds, g, S, E, nullptr, wave_s_ * 64 + lane_id_());
}

constexpr int RT_P = 144;
constexpr int RT_LDS_AH = 0, RT_LDS_AL = 64 * RT_P;
constexpr int RT_LDS_BH = 2 * 64 * RT_P, RT_LDS_BL = RT_LDS_BH + 256 * RT_P;
constexpr int RT_LDS_ST = RT_LDS_BL + 256 * RT_P;
__device__ __forceinline__ void ph_router(int L, int rep_, const int wave_s_) {
    PH_FN_BEGIN
    (void)rep_;
    PH_BEGIN;
    const float* lng = CTX_IN(4) + L * D; const float* lnb = CTX_IN(5) + L * D;
    const float* rbias = CTX_IN(7) + L * NE;
    const u16* wrh = (const u16*)(ws + WS_WRH) + (size_t)L * NE * D; const u16* wrl = (const u16*)(ws + WS_WRL) + (size_t)L * NE * D;
    LAS float* stat = (LAS float*)(lds + RT_LDS_ST);
    for (int it = bid; it < T / 64; it += G) {
#pragma unroll 1
        for (int hb_ = 0; hb_ < 2; ++hb_) {
            f32x4 yv[4][4];
#pragma unroll
            for (int rr = 0; rr < 4; ++rr)
#pragma unroll
                for (int j = 0; j < 4; ++j) yv[rr][j] = *(const f32x4*)(P_ypre + ((size_t)it * 64 + wave * 8 + hb_ * 4 + rr) * D + j * 256 + lane * 4);
#pragma unroll
            for (int rr = 0; rr < 4; ++rr) {
                float sm = 0.f;
#pragma unroll
                for (int j = 0; j < 4; ++j) sm += (yv[rr][j][0] + yv[rr][j][1]) + (yv[rr][j][2] + yv[rr][j][3]);
                const float mu = wave_sum(sm) * (1.f / D);
                float q = 0.f;
#pragma unroll
                for (int j = 0; j < 4; ++j)
#pragma unroll
                    for (int c = 0; c < 4; ++c) { const float d_ = yv[rr][j][c] - mu; q += d_ * d_; }
                const float rstd = rsqrtf(wave_sum(q) * (1.f / D) + LN_EPS);
                if (lane == 0) { stat[wave * 8 + hb_ * 4 + rr] = mu; stat[64 + wave * 8 + hb_ * 4 + rr] = rstd; }
            }
        }
        __syncthreads();
        const int arow = tid >> 3, aq = tid & 7;
        const float amu = stat[arow], ars = stat[64 + arow];
        const float* yp = P_ypre + ((size_t)it * 64 + arow) * D + aq * 8;
        f32x4 ya0 = *(const f32x4*)(yp), ya1 = *(const f32x4*)(yp + 4);
        u32x4 bw[8];
#pragma unroll
        for (int i = 0; i < 8; ++i) { const int p_ = tid + 512 * (i & 3); bw[i] = *(const u32x4*)((i < 4 ? wrh : wrl) + (size_t)(p_ >> 3) * D + (p_ & 7) * 8); }
        f32x16 lg[2];
#pragma unroll
        for (int r = 0; r < 16; ++r) { lg[0][r] = 0.f; lg[1][r] = 0.f; }
#pragma unroll 1
        for (int kc = 0; kc < 16; ++kc) {
            const int k0 = kc * 64;
            {
                const f32x4 g0 = *(const f32x4*)(lng + k0 + aq * 8), g1 = *(const f32x4*)(lng + k0 + aq * 8 + 4);
                const f32x4 b0 = *(const f32x4*)(lnb + k0 + aq * 8), b1 = *(const f32x4*)(lnb + k0 + aq * 8 + 4);
                f32x4 x0, x1v;
#pragma unroll
                for (int c = 0; c < 4; ++c) { x0[c] = (ya0[c] - amu) * ars * g0[c] + b0[c]; x1v[c] = (ya1[c] - amu) * ars * g1[c] + b1[c]; }
                const size_t go = ((size_t)it * 64 + arow) * D + k0 + aq * 8;
                *(f32x4*)(P_x1 + go) = x0; *(f32x4*)(P_x1 + go + 4) = x1v;
                u32x4 wh; wh[0] = cvtpk(x0[0], x0[1]); wh[1] = cvtpk(x0[2], x0[3]); wh[2] = cvtpk(x1v[0], x1v[1]); wh[3] = cvtpk(x1v[2], x1v[3]);
                *(u32x4*)(P_xb + go) = wh;
                u32x2 w8; w8[0] = pack_fp8x4(x0[0], x0[1], x0[2], x0[3]); w8[1] = pack_fp8x4(x1v[0], x1v[1], x1v[2], x1v[3]);
                *(u32x2*)(P_xb8 + go) = w8;
                u32x4 wl;
                wl[0] = cvtpk(x0[0] - bf2f(wh[0] & 0xFFFFu), x0[1] - bf2f(wh[0] >> 16)); wl[1] = cvtpk(x0[2] - bf2f(wh[1] & 0xFFFFu), x0[3] - bf2f(wh[1] >> 16));
                wl[2] = cvtpk(x1v[0] - bf2f(wh[2] & 0xFFFFu), x1v[1] - bf2f(wh[2] >> 16)); wl[3] = cvtpk(x1v[2] - bf2f(wh[3] & 0xFFFFu), x1v[3] - bf2f(wh[3] >> 16));
                *(LAS u32x4*)(lds + RT_LDS_AH + arow * RT_P + aq * 16) = wh;
                *(LAS u32x4*)(lds + RT_LDS_AL + arow * RT_P + aq * 16) = wl;
#pragma unroll
                for (int i = 0; i < 8; ++i) { const int p_ = tid + 512 * (i & 3); *(LAS u32x4*)(lds + (i < 4 ? RT_LDS_BH : RT_LDS_BL) + (p_ >> 3) * RT_P + (p_ & 7) * 16) = bw[i]; }
            }
            __syncthreads();
            {
                const int kn = (kc + 1 < 16) ? k0 + 64 : 0;
                ya0 = *(const f32x4*)(yp + kn); ya1 = *(const f32x4*)(yp + kn + 4);
#pragma unroll
                for (int i = 0; i < 8; ++i) { const int p_ = tid + 512 * (i & 3); bw[i] = *(const u32x4*)((i < 4 ? wrh : wrl) + (size_t)(p_ >> 3) * D + kn + (p_ & 7) * 8); }
            }
#pragma unroll
            for (int sk = 0; sk < 4; ++sk) {
                const int ko = (sk * 16 + hi * 8) * 2;
                const bf16x8 bh_ = *(const LAS bf16x8*)(lds + RT_LDS_BH + (wave * 32 + r32) * RT_P + ko), bl_ = *(const LAS bf16x8*)(lds + RT_LDS_BL + (wave * 32 + r32) * RT_P + ko);
#pragma unroll
                for (int rb = 0; rb < 2; ++rb) {
                    const bf16x8 xh = *(const LAS bf16x8*)(lds + RT_LDS_AH + (rb * 32 + r32) * RT_P + ko), xl = *(const LAS bf16x8*)(lds + RT_LDS_AL + (rb * 32 + r32) * RT_P + ko);
                    lg[rb] = MFMA_BF16(xh, bh_, lg[rb]); lg[rb] = MFMA_BF16(xl, bh_, lg[rb]); lg[rb] = MFMA_BF16(xh, bl_, lg[rb]);
                }
            }
            __syncthreads();
        }
        LAS float* lgs = (LAS float*)lds;
#pragma unroll
        for (int rb = 0; rb < 2; ++rb)
#pragma unroll
            for (int r = 0; r < 16; ++r) lgs[(rb * 32 + crow(r, hi)) * 257 + wave * 32 + r32] = lg[rb][r];
        __syncthreads();
#pragma unroll 1
        for (int tg = 0; tg < 2; ++tg) {
            float sc[4][4], cv[4][4];
#pragma unroll
            for (int tt = 0; tt < 4; ++tt) {
                const int lr = wave * 8 + tg * 4 + tt;
#pragma unroll
                for (int j = 0; j < 4; ++j) { const int e = lane + 64 * j; sc[tt][j] = 1.f / (1.f + __expf(-lgs[lr * 257 + e])); cv[tt][j] = sc[tt][j] + rbias[e]; }
            }
            float gsel[4][8];
#pragma unroll
            for (int j = 0; j < 4; ++j) {
#pragma unroll
                for (int tt = 0; tt < 4; ++tt) {
                    const float rm = dpp_rowmax(cv[tt][j]);
                    const float m1a = fmaxf(rl_f(rm, 0), rl_f(rm, 16)), m1b = fmaxf(rl_f(rm, 32), rl_f(rm, 48));
                    const unsigned long long bal = __ballot(cv[tt][j] == (hi ? m1b : m1a));
                    const int fa_ = __builtin_ctz((unsigned)(bal & 0xFFFFFFFFull)), fb_ = 32 + __builtin_ctz((unsigned)(bal >> 32));
                    const float c2 = (lane == fa_ || lane == fb_) ? -INFINITY : cv[tt][j];
                    const float rm2 = dpp_rowmax(c2);
                    gsel[tt][2 * j] = m1a + fmaxf(rl_f(rm2, 0), rl_f(rm2, 16));
                    gsel[tt][2 * j + 1] = m1b + fmaxf(rl_f(rm2, 32), rl_f(rm2, 48));
                }
            }
#pragma unroll
            for (int tt = 0; tt < 4; ++tt)
#pragma unroll
                for (int j = 0; j < 4; ++j) {
                    int ra_ = 0, rb_ = 0;
#pragma unroll
                    for (int g2 = 0; g2 < 8; ++g2) {
                        ra_ += ((gsel[tt][g2] > gsel[tt][2 * j]) || (gsel[tt][g2] == gsel[tt][2 * j] && g2 < 2 * j)) ? 1 : 0;
                        rb_ += ((gsel[tt][g2] > gsel[tt][2 * j + 1]) || (gsel[tt][g2] == gsel[tt][2 * j + 1] && g2 < 2 * j + 1)) ? 1 : 0;
                    }
                    cv[tt][j] = ((hi ? rb_ : ra_) < 4) ? cv[tt][j] : NEGV;
                }
            float wsel[4], wsum[4]; int esel[4];
#pragma unroll
            for (int tt = 0; tt < 4; ++tt) { wsel[tt] = 0.f; wsum[tt] = 0.f; esel[tt] = 0; }
#pragma unroll 1
            for (int k = 0; k < TOPK; ++k) {
#pragma unroll
                for (int tt = 0; tt < 4; ++tt) {
                    float bv = cv[tt][0]; int be = lane;
#pragma unroll
                    for (int j = 1; j < 4; ++j) if (cv[tt][j] > bv) { bv = cv[tt][j]; be = lane + 64 * j; }
                    const float rm = dpp_rowmax(bv);
                    const float mval = fmaxf(fmaxf(rl_f(rm, 0), rl_f(rm, 16)), fmaxf(rl_f(rm, 32), rl_f(rm, 48)));
                    const int ri = dpp_rowmin_i(bv == mval ? be : 0x7fffffff);
                    const int e = min(min(__builtin_amdgcn_readlane(ri, 0), __builtin_amdgcn_readlane(ri, 16)), min(__builtin_amdgcn_readlane(ri, 32), __builtin_amdgcn_readlane(ri, 48)));
                    const int jl = e >> 6, ll = e & 63;
                    const float smine = ((jl == 0 ? sc[tt][0] : 0.f) + (jl == 1 ? sc[tt][1] : 0.f)) + ((jl == 2 ? sc[tt][2] : 0.f) + (jl == 3 ? sc[tt][3] : 0.f));
                    const float sw = rl_f(smine, ll);
#pragma unroll
                    for (int j = 0; j < 4; ++j) cv[tt][j] = (lane == ll && jl == j) ? -INFINITY : cv[tt][j];
                    wsum[tt] += sw;
                    if (lane == k) { wsel[tt] = sw; esel[tt] = e; }
                }
            }
#pragma unroll
            for (int tt = 0; tt < 4; ++tt) {
                if (lane < TOPK) {
                    const int tok = it * 64 + wave * 8 + tg * 4 + tt;
                    const int a = tok * TOPK + lane;
                    P_topw[a] = wsel[tt] / wsum[tt] * 2.5f;
                    if (rep_ == 0) {
                        const int pos = atomicAdd(&cnt[esel[tt] * CNT_STRIDE], 1);
                        P_list[(size_t)esel[tt] * T + pos] = a;
                    }
                }
            }
        }
        __syncthreads();
    }
}

__device__ __forceinline__ void ph_gateup(int L, int rep_, const int wave_s_) {
    PH_FN_BEGIN
    (void)rep_;
    {
        PH_BEGIN;
        const float* weg = CTX_IN(8) + (size_t)L * NE * D * DF; const float* weu = CTX_IN(9) + (size_t)L * NE * D * DF;
        LAS int* rowva = (LAS int*)(lds + MOE_LDS_VA);
        {
            int* octr = (int*)(ws + WS_CTL + CTL_CNT_OFF + 8192) + (L * 4 + 2 * (rep_ & 1)) * 64;
            LAS int* slot = (LAS int*)(lds + 140000);
            for (;;) {
                __syncthreads();
                if (tid == 0) { int q; do { q = atomicAdd(octr, 1); } while (q >= NE && q < NE * 5 && cnt[((q - NE) >> 2) * CNT_STRIDE] <= MOE_XCAP); *slot = q; }
                __syncthreads();
                const int q = *slot;
                if (q >= NE * 5) break;
                const bool ovf = q >= NE;
                const int e = ovf ? (q - NE) >> 2 : q, pz = ovf ? (q - NE) & 3 : 0, npz = ovf ? 1 : 4, st0 = ovf ? 1 : 0, n = cnt[e * CNT_STRIDE];
                for (int r0 = 0; r0 < n; r0 += 1024) {
                    if (ovf && n - r0 <= MOE_XCAP) break;
#pragma unroll
                    for (int i = 0; i < 2; ++i) { int t_ = tid; asm volatile("" : "+v"(t_)); const int idx = r0 + i * 512 + t_; rowva[i * 512 + t_] = idx < n ? P_list[(size_t)e * T + idx] : TRASH_VA; }
                    __syncthreads();
                    moe_expert<false>(lds, tid, lane, wave, r32, hi, P_xb8, weg + (size_t)e * D * DF, weu + (size_t)e * D * DF, (n - r0) < 1024 ? (n - r0) : 1024, (void*)P_hb, pz, npz, st0, 1, false, !ovf && (n - r0) > 512 && (n - r0) <= MOE_XCAP);
                }
            }
        }
    }
    {
        PH_BEGIN;
        const pg8::Gemm g{P_xb, (const u16*)(ws + WS_WSGU) + (size_t)L * 512 * 1024, T, 512, D};
        const EpiSGU E{P_hbs};
        int* qctr = (int*)(ws + WS_CTL + CTL_CNT_OFF + 4096) + (L * 4 + 2 * (rep_ & 1)) * 64;
        LAS int* slot = (LAS int*)(lds + 140000);
        for (;;) {
            __syncthreads();
            if (tid == 0) *slot = atomicAdd(qctr, 1);
            __syncthreads();
            const int un = *slot;
            if (un >= 128) break;
            const pg8::FixedOrder S{un & 63, un >> 6};
            pg8::gemm_phase<EpiSGU, pg8::FixedOrder, false>((PG8_LAS unsigned char*)lds, g, S, E, nullptr, wave_s_ * 64 + lane_id_());
        }
    }
}

__device__ __forceinline__ void ph_down(int L, int rep_, const int wave_s_) {
    PH_FN_BEGIN
    (void)rep_;
    {
        PH_BEGIN;
        const float* wed = CTX_IN(10) + (size_t)L * NE * DF * D;
        LAS int* rowva = (LAS int*)(lds + MOE_LDS_VA); LAS float* roww = (LAS float*)(lds + MOE_LDS_W);
        {
            int* octr = (int*)(ws + WS_CTL + CTL_CNT_OFF + 8192) + (L * 4 + 1 + 2 * (rep_ & 1)) * 64;
            LAS int* slot = (LAS int*)(lds + 140000);
            for (;;) {
                __syncthreads();
                if (tid == 0) { int q; do { q = atomicAdd(octr, 1); } while (q >= NE && q < NE * 5 && cnt[((q - NE) >> 2) * CNT_STRIDE] <= 512); *slot = q; }
                __syncthreads();
                const int q = *slot;
                if (q >= NE * 5) break;
                const bool ovf = q >= NE;
                const int e = ovf ? (q - NE) >> 2 : q, pz = ovf ? ((q - NE) & 3) * 2 : 0, npz = ovf ? 2 : 8, st0 = ovf ? 1 : 0, n = cnt[e * CNT_STRIDE];
                for (int r0 = 0; r0 < n; r0 += 1024) {
                    if (ovf && n - r0 <= 512) break;
#pragma unroll
                    for (int i = 0; i < 2; ++i) { int t_ = tid; asm volatile("" : "+v"(t_)); const int idx = r0 + i * 512 + t_; const int va = idx < n ? P_list[(size_t)e * T + idx] : TRASH_VA; rowva[i * 512 + t_] = va; roww[i * 512 + t_] = va < A_TOT ? P_topw[va] * Y8_SCALE : 0.f; }
                    __syncthreads();
                    moe_expert<true>(lds, tid, lane, wave, r32, hi, (const unsigned char*)P_hb, wed + (size_t)e * DF * D, nullptr, (n - r0) < 1024 ? (n - r0) : 1024, (void*)P_yb, pz, npz, st0, 1, true);
                }
            }
        }
    }
    {
        PH_BEGIN;
        const pg8::Gemm g{P_hbs, (const u16*)(ws + WS_WSD) + (size_t)L * D * DF, T, D, DF};
        const EpiSD E{P_yb};
        int* qctr = (int*)(ws + WS_CTL + CTL_CNT_OFF + 4096) + (L * 4 + 1 + 2 * (rep_ & 1)) * 64;
        LAS int* slot = (LAS int*)(lds + 140000);
        for (;;) {
            __syncthreads();
            if (tid == 0) *slot = atomicAdd(qctr, 1);
            __syncthreads();
            const int un = *slot;
            if (un >= 256) break;
            const pg8::FixedOrder S{un & 63, un >> 6};
            pg8::gemm_phase<EpiSD, pg8::FixedOrder, false>((PG8_LAS unsigned char*)lds, g, S, E, nullptr, wave_s_ * 64 + lane_id_());
        }
    }
}

__device__ __forceinline__ void ph_combine(int L, int rep_, const int wave_s_) {
    PH_FN_BEGIN
    (void)rep_;
    PH_BEGIN;
    const float* lng = CTX_IN(14) + L * D; const float* lnb = CTX_IN(15) + L * D;
    float* dst = L == 0 ? P_x2 : AS_GLOBAL(float, ctx_ld(16));
    for (int row = bid * 8 + wave; row < T; row += G * 8) {
        u32x4 yv[TOPK + 1][2];
#pragma unroll
        for (int k = 0; k < TOPK + 1; ++k) {
            const size_t va = k < TOPK ? (size_t)row * TOPK + k : (size_t)A_TOT + row;
            if (k < TOPK) {
#pragma unroll
                for (int j = 0; j < 2; ++j) { const u32x2 w8 = *(const u32x2*)((const unsigned char*)P_yb + va * D + j * 512 + lane * 8); yv[k][j][0] = w8[0]; yv[k][j][1] = w8[1]; yv[k][j][2] = 0u; yv[k][j][3] = 0u; }
            } else {
#pragma unroll
                for (int j = 0; j < 2; ++j) yv[k][j] = *(const u32x4*)(P_yb + va * D + j * 512 + lane * 8);
            }
        }
        float v[16];
#pragma unroll
        for (int j = 0; j < 2; ++j) {
            const f32x4 t0 = *(const f32x4*)(P_x1 + (size_t)row * D + j * 512 + lane * 8), t1 = *(const f32x4*)(P_x1 + (size_t)row * D + j * 512 + lane * 8 + 4);
#pragma unroll
            for (int c = 0; c < 4; ++c) { v[j * 8 + c] = DN_ALPHA * t0[c]; v[j * 8 + 4 + c] = DN_ALPHA * t1[c]; }
        }
#pragma unroll
        for (int k = 0; k < TOPK + 1; ++k)
#pragma unroll
            for (int j = 0; j < 2; ++j) {
                if (k < TOPK) {
#pragma unroll
                    for (int c = 0; c < 2; ++c) {
                        const f32x2_ lo2 = __builtin_amdgcn_cvt_pk_f32_fp8((int)yv[k][j][c], false), hi2 = __builtin_amdgcn_cvt_pk_f32_fp8((int)yv[k][j][c], true);
                        v[j * 8 + 4 * c] += lo2[0] * (1.f / Y8_SCALE); v[j * 8 + 4 * c + 1] += lo2[1] * (1.f / Y8_SCALE); v[j * 8 + 4 * c + 2] += hi2[0] * (1.f / Y8_SCALE); v[j * 8 + 4 * c + 3] += hi2[1] * (1.f / Y8_SCALE);
                    }
                } else {
#pragma unroll
                    for (int c = 0; c < 4; ++c) { v[j * 8 + 2 * c] += bf2f(yv[k][j][c] & 0xFFFFu); v[j * 8 + 2 * c + 1] += bf2f(yv[k][j][c] >> 16); }
                }
            }
        float sm = 0.f;
#pragma unroll
        for (int i = 0; i < 16; ++i) sm += v[i];
        const float mu = wave_sum(sm) * (1.f / D);
        float q = 0.f;
#pragma unroll
        for (int i = 0; i < 16; ++i) { const float d = v[i] - mu; q += d * d; }
        const float rstd = rsqrtf(wave_sum(q) * (1.f / D) + LN_EPS);
#pragma unroll
        for (int j = 0; j < 2; ++j) {
            const f32x4 g0 = *(const f32x4*)(lng + j * 512 + lane * 8), g1 = *(const f32x4*)(lng + j * 512 + lane * 8 + 4);
            const f32x4 b0 = *(const f32x4*)(lnb + j * 512 + lane * 8), b1 = *(const f32x4*)(lnb + j * 512 + lane * 8 + 4);
            f32x4 o0, o1;
#pragma unroll
            for (int c = 0; c < 4; ++c) { o0[c] = (v[j * 8 + c] - mu) * rstd * g0[c] + b0[c]; o1[c] = (v[j * 8 + 4 + c] - mu) * rstd * g1[c] + b1[c]; }
            *(f32x4*)(dst + (size_t)row * D + j * 512 + lane * 8) = o0; *(f32x4*)(dst + (size_t)row * D + j * 512 + lane * 8 + 4) = o1;
            if (L == 0) { u32x4 w; w[0] = cvtpk(o0[0], o0[1]); w[1] = cvtpk(o0[2], o0[3]); w[2] = cvtpk(o1[0], o1[1]); w[3] = cvtpk(o1[2], o1[3]); *(u32x4*)(P_xb + (size_t)row * D + j * 512 + lane * 8) = w; }
        }
    }
}

__global__ void __launch_bounds__(NTHR, 2) fwd(Args args) {
    extern __shared__ __attribute__((aligned(16))) unsigned char lds_raw[];
    LAS char* lds = (LAS char*)lds_raw;
    unsigned char* const ws = args.ws;
    const int lo = args.ph_lo, hi_ph = args.ph_hi;
    const int wave_s_ = __builtin_amdgcn_readfirstlane(threadIdx.x >> 6);
    if (threadIdx.x < 18) {
        const uint64_t v = threadIdx.x < 16 ? (uint64_t)args.in[threadIdx.x] : (threadIdx.x == 16 ? (uint64_t)args.out : (uint64_t)args.ws);
        ((LAS uint64_t*)(lds + LDS_CTX))[threadIdx.x] = v;
    }
    __syncthreads();
#define IN(k) (lo <= (k) && (k) < hi_ph)

#if MK_ONE_LAUNCH
    if (threadIdx.x < 4) ((LAS unsigned*)(lds + LDS_BAR))[threadIdx.x] = 0u;
    __syncthreads();
    XcdBarrier bar = xcd_barrier_post((unsigned*)(ws + WS_CTL), (volatile LAS unsigned*)(lds + LDS_BAR), wave_s_ == 0 && lane_id_() == 0);
#define GRID_BAR() xcd_barrier(bar, wave_s_ == 0 && lane_id_() == 0)
#else
#define GRID_BAR() do { } while (0)
#endif
#define SEAM(k) do { if (IN(k) && IN((k) + 1)) GRID_BAR(); } while (0)

    for (int rep_ = 0; rep_ < ((IN(0) && PHK(0)) ? REPS(0) : 0); ++rep_) { ph_p0(0, rep_, wave_s_); }
    SEAM(0);

    for (int L = 0; L < 2; ++L) {
        const int pb = 1 + 10 * L;
        for (int rep_ = 0; rep_ < ((IN(pb + 0) && PHK(1)) ? REPS(1) : 0); ++rep_) { ph_qkv(L, rep_, wave_s_); }
        SEAM(pb + 0);

        if (L == 0) {
            for (int rep_ = 0; rep_ < ((IN(pb + 1) && PHK(2)) ? REPS(2) : 0); ++rep_) { ph_kmean(L, rep_, wave_s_); }
            SEAM(pb + 1);
            for (int rep_ = 0; rep_ < ((IN(pb + 2) && PHK(11)) ? REPS(11) : 0); ++rep_) { ph_gate(L, rep_, wave_s_); }
            SEAM(pb + 2);
        }

        if (L == 0) {
            for (int rep_ = 0; rep_ < ((IN(pb + 3) && PHK(3)) ? REPS(3) : 0); ++rep_) { ph_moba(L, rep_, wave_s_); }
            SEAM(pb + 3);
            for (int rep_ = 0; rep_ < ((IN(pb + 4) && PHK(12)) ? REPS(12) : 0); ++rep_) { ph_mobamerge(L, rep_, wave_s_); }
        } else {
            for (int rep_ = 0; rep_ < ((IN(pb + 3) && PHK(4)) ? REPS(4) : 0); ++rep_) { ph_dil(L, rep_, wave_s_); }
            SEAM(pb + 3);
            for (int rep_ = 0; rep_ < ((IN(pb + 4) && PHK(5)) ? REPS(5) : 0); ++rep_) { ph_merge(L, rep_, wave_s_); }
        }
        SEAM(pb + 4);

        for (int rep_ = 0; rep_ < ((IN(pb + 5) && PHK(6)) ? REPS(6) : 0); ++rep_) { ph_wo(L, rep_, wave_s_); }
        SEAM(pb + 5);

        for (int rep_ = 0; rep_ < ((IN(pb + 6) && PHK(7)) ? REPS(7) : 0); ++rep_) { ph_router(L, rep_, wave_s_); }
        SEAM(pb + 6);

        for (int rep_ = 0; rep_ < ((IN(pb + 7) && PHK(8)) ? REPS(8) : 0); ++rep_) { ph_gateup(L, rep_, wave_s_); }
        SEAM(pb + 7);

        for (int rep_ = 0; rep_ < ((IN(pb + 8) && PHK(9)) ? REPS(9) : 0); ++rep_) { ph_down(L, rep_, wave_s_); }
        SEAM(pb + 8);

        for (int rep_ = 0; rep_ < ((IN(pb + 9) && PHK(10)) ? REPS(10) : 0); ++rep_) { ph_combine(L, rep_, wave_s_); }
        if (L == 0) SEAM(pb + 9);
    }
}

extern "C" void kernel_launch(void* const* d_in, const int* in_sizes, int n_in, void* d_out, int out_size, void* d_ws, size_t ws_size, hipStream_t stream) {
    static int grid = 0;
    if (grid == 0) {
        if (n_in != 16 || out_size != T * D || ws_size < WS_END2) { fprintf(stderr, "kernel_launch: unexpected problem (n_in %d out %d ws %zu need %zu)\n", n_in, out_size, ws_size, (size_t)WS_END2); grid = -1; return; }
        int dev = 0, cus = 0, per_cu = 0;
        if (hipGetDevice(&dev) != hipSuccess || hipDeviceGetAttribute(&cus, hipDeviceAttributeMultiprocessorCount, dev) != hipSuccess) { grid = -1; return; }
        if (hipFuncSetAttribute((const void*)fwd, hipFuncAttributeMaxDynamicSharedMemorySize, LDS_BYTES) != hipSuccess) { fprintf(stderr, "kernel_launch: hipFuncSetAttribute failed\n"); grid = -1; return; }
        if (hipOccupancyMaxActiveBlocksPerMultiprocessor(&per_cu, (const void*)fwd, NTHR, LDS_BYTES) != hipSuccess || per_cu < 1) { fprintf(stderr, "kernel_launch: occupancy query says %d\n", per_cu); (void)hipGetLastError(); per_cu = 1; }
        grid = cus;
    }
    if (grid < 0) return;
    (void)hipMemsetAsync((char*)d_ws + WS_CTL, 0, CTL_BYTES, stream);
    Args a{};
    for (int i = 0; i < 16; ++i) a.in[i] = (const float*)d_in[i];
    a.out = (float*)d_out; a.ws = (unsigned char*)d_ws;
#if MK_ONE_LAUNCH
    a.ph_lo = 0; a.ph_hi = N_PHASES;
    hipLaunchKernelGGL(fwd, dim3(grid), dim3(NTHR), LDS_BYTES, stream, a);
#else
    for (int ph = 0; ph < N_PHASES; ++ph) {
        if (ph == 12 || ph == 13) continue;
        a.ph_lo = ph; a.ph_hi = ph + 1;
        hipLaunchKernelGGL(fwd, dim3(grid), dim3(NTHR), LDS_BYTES, stream, a);
    }
#endif
}
```

```cpp
#include <hip/hip_runtime.h>
#include <hip/hip_bf16.h>
#include <stdint.h>
#include <stdio.h>

#ifndef MK_ONE_LAUNCH
#define MK_ONE_LAUNCH 1
#endif

#ifndef PHMASK
#define PHMASK 0x1FFF
#endif
#define PHK(k) ((PHMASK >> (k)) & 1)
#ifndef REPEAT_KIND
#define REPEAT_KIND -1
#endif
#define REPS(k) ((k) == REPEAT_KIND ? 2 : 1)
#define LAS __attribute__((address_space(3)))
typedef __attribute__((ext_vector_type(8))) short bf16x8;
typedef __attribute__((ext_vector_type(16))) float f32x16;
typedef __attribute__((ext_vector_type(4))) float f32x4;
typedef __attribute__((ext_vector_type(4))) unsigned u32x4;
typedef __attribute__((ext_vector_type(2))) unsigned u32x2;
typedef unsigned short u16;

constexpr int D = 1024, BATCH = 2, SEQ = 8192, T = BATCH * SEQ, NH = 16, HD = 64;
constexpr int NE = 256, TOPK = 8, DF = 256;
constexpr int A_TOT = T * TOPK;
constexpr int MOBA_BLK = 256, MOBA_NB = SEQ / MOBA_BLK;
constexpr float DN_ALPHA = 1.4142135623730951f;
constexpr float LN_EPS = 1e-5f;
constexpr float LOG2E = 1.4426950408889634f;
constexpr float LN2 = 0.6931471805599453f;
constexpr float NEGV = -1e30f;
constexpr int NTHR = 512;

constexpr size_t al256(size_t x) { return (x + 255) & ~(size_t)255; }
constexpr size_t WS_CTL = 0;
constexpr size_t CTL_BYTES = 131072;
constexpr size_t CTL_CNT_OFF = 32768;
constexpr size_t CTL_ECNT_OFF = 65536;
constexpr int CNT_STRIDE = 32;
constexpr size_t WS_XB = WS_CTL + CTL_BYTES;
constexpr size_t WS_X1 = WS_XB + al256((size_t)T * D * 2);
constexpr size_t WS_X2 = WS_X1 + al256((size_t)T * D * 4);
constexpr size_t WS_YPRE = WS_X2 + al256((size_t)T * D * 4);
constexpr size_t WS_QKV = WS_YPRE + al256((size_t)T * D * 4);
constexpr size_t WS_VT = WS_QKV + al256((size_t)T * 9216 * 2);
constexpr size_t WS_KM = WS_VT + al256((size_t)3 * T * D * 2);
constexpr size_t WS_AO = WS_KM + al256((size_t)BATCH * NH * MOBA_NB * HD * 4);
constexpr size_t WS_OG = WS_AO + al256((size_t)T * D * 2);
constexpr size_t WS_LSE = WS_OG + al256((size_t)3 * T * D * 2);
constexpr size_t WS_TOPW = WS_LSE + al256((size_t)3 * T * NH * 4);
constexpr size_t WS_LIST = WS_TOPW + al256((size_t)T * TOPK * 4);
constexpr size_t WS_HB = WS_LIST + al256((size_t)NE * T * 4);
constexpr size_t WS_YB = WS_HB + al256((size_t)(A_TOT + T + 1) * DF * 2);
constexpr size_t WS_END = WS_YB + al256((size_t)(A_TOT + T + 1) * D * 2);
constexpr int TRASH_VA = A_TOT + T;
constexpr size_t WS_SELM = WS_END;
constexpr size_t WS_PART = WS_SELM + al256((size_t)T * NH * 4);
constexpr size_t WS_PLSE = WS_PART + al256((size_t)T * NH * 4 * 64 * 2);
constexpr size_t WS_WQK0 = WS_PLSE + al256((size_t)T * NH * 4 * 4);
constexpr size_t WS_WV0 = WS_WQK0 + (size_t)2048 * 1024 * 2;
constexpr size_t WS_WQK1 = WS_WV0 + (size_t)1024 * 1024 * 2;
constexpr size_t WS_WV1 = WS_WQK1 + (size_t)6144 * 1024 * 2;
constexpr size_t WS_WO = WS_WV1 + (size_t)3072 * 1024 * 2;
constexpr size_t WS_WSGU = WS_WO + (size_t)2 * 1024 * 1024 * 2;
constexpr size_t WS_WSD = WS_WSGU + (size_t)2 * 512 * 1024 * 2;
constexpr size_t WS_XB8 = WS_WSD + (size_t)2 * 1024 * 256 * 2;
constexpr size_t WS_HBS = WS_XB8 + (size_t)T * D;
constexpr size_t WS_WRH = WS_HBS + (size_t)T * DF * 2;
constexpr size_t WS_WRL = WS_WRH + (size_t)2 * 256 * 1024 * 2;
constexpr size_t WS_END2 = WS_WRL + (size_t)2 * 256 * 1024 * 2;

constexpr int LDP = 40;
constexpr int STAGE_BYTES = 2 * 256 * LDP * 2;
constexpr int LDS_ROWID = 2 * STAGE_BYTES;
constexpr int LDS_ROWW = LDS_ROWID + 1024;
constexpr int XS_PITCH = 1028;
constexpr int LDS_BYTES = 163840;
constexpr int LDS_BAR = 161792;

__device__ __forceinline__ int lane_id_() { int l; asm volatile("v_mbcnt_lo_u32_b32 %0, -1, 0\n\tv_mbcnt_hi_u32_b32 %0, -1, %0" : "=v"(l)); return l; }
__device__ __forceinline__ float shxf(float v, int m, int lane) { return __int_as_float(__builtin_amdgcn_ds_bpermute((lane ^ m) << 2, __float_as_int(v))); }
__device__ __forceinline__ int shxi(int v, int m, int lane) { return __builtin_amdgcn_ds_bpermute((lane ^ m) << 2, v); }
#define XB_TMO      128
#define XB_XCNT(j)  (256  + 64 * (j))
#define XB_XSUB(j)  (1280 + 64 * (j))
#define XB_XGEN(j)  (2304 + 64 * (j))
#define XB_TOP      3328
#define XB_TOPGEN   3392
#define XCD_BAR_WORDS 3456
#define XB_SPIN_CAP (1u << 18)
__device__ __forceinline__ unsigned xb_ld(unsigned* p)              { return __hip_atomic_load(p, __ATOMIC_RELAXED, __HIP_MEMORY_SCOPE_AGENT); }
__device__ __forceinline__ unsigned xb_add(unsigned* p, unsigned v) { return __hip_atomic_fetch_add(p, v, __ATOMIC_RELAXED, __HIP_MEMORY_SCOPE_AGENT); }
__device__ __forceinline__ unsigned xb_xcc_id() { return (unsigned)__builtin_amdgcn_s_getreg((3 << 11) | 20) & 0xFu; }
#define XB_SPIN(cond, bar) do { unsigned _sp = 0; while (cond) { __builtin_amdgcn_s_sleep(1); \
    if ((++_sp & 255u) == 0u) { if (xb_ld(&(bar)[XB_TMO])) break; if (_sp > XB_SPIN_CAP) { atomicAdd(&(bar)[XB_TMO], 1u); break; } } } } while (0)
struct XcdBarrier { unsigned* bar; unsigned x; volatile LAS unsigned* st; };
__device__ __forceinline__ XcdBarrier xcd_barrier_post(unsigned* bar, volatile LAS unsigned* st, const bool leader) {
    XcdBarrier b; b.bar = bar; b.x = xb_xcc_id(); b.st = st;
    if (leader) (void)xb_add(&bar[XB_XCNT(b.x)], 1u);
    return b;
}
__device__ __forceinline__ void xcd_barrier_complete(unsigned* bar, unsigned x, unsigned& nloc, unsigned& nx) {
    const unsigned G = gridDim.x * gridDim.y * gridDim.z;
    unsigned sum, cnt, mine, sp = 0u;
    for (;;) {
        sum = 0u; cnt = 0u; mine = 0u;
#pragma unroll
        for (unsigned j = 0; j < 16; ++j) { const unsigned c = xb_ld(&bar[XB_XCNT(j)]); sum += c; cnt += (c > 0u) ? 1u : 0u; mine = (j == x) ? c : mine; }
        if (sum == G) break;
        __builtin_amdgcn_s_sleep(1);
        if ((++sp & 255u) == 0u) { if (xb_ld(&bar[XB_TMO])) break; if (sp > XB_SPIN_CAP) { atomicAdd(&bar[XB_TMO], 1u); break; } }
    }
    nloc = mine > 0u ? mine : 1u; nx = cnt > 0u ? cnt : 1u;
}
__device__ __forceinline__ void xcd_barrier(const XcdBarrier& b, const bool leader) {
    asm volatile("s_waitcnt vmcnt(0)" ::: "memory");
    __syncthreads();
    if (leader) {
        unsigned* bar = b.bar;
        __builtin_amdgcn_s_waitcnt(0);
        unsigned nloc = b.st[0], nx = b.st[1];
        if (nloc == 0u) { xcd_barrier_complete(bar, b.x, nloc, nx); b.st[0] = nloc; b.st[1] = nx; }
        const unsigned old = xb_add(&bar[XB_XSUB(b.x)], 1u);
        const unsigned gen = old / nloc;
        if (old + 1u == (gen + 1u) * nloc) {
            __builtin_amdgcn_fence(__ATOMIC_RELEASE, "agent");
            asm volatile("s_waitcnt vmcnt(0)" ::: "memory");
            const unsigned og = xb_add(&bar[XB_TOP], 1u);
            const unsigned tg = og / nx;
            if (og + 1u == (tg + 1u) * nx) xb_add(&bar[XB_TOPGEN], 1u);
            else XB_SPIN(xb_ld(&bar[XB_TOPGEN]) == tg, bar);
            __builtin_amdgcn_fence(__ATOMIC_ACQUIRE, "agent");
            xb_add(&bar[XB_XGEN(b.x)], 1u);
            asm volatile("s_waitcnt vmcnt(0)" ::: "memory");
        } else {
            XB_SPIN(xb_ld(&bar[XB_XGEN(b.x)]) == gen, bar);
            __builtin_amdgcn_fence(__ATOMIC_ACQUIRE, "agent");
            asm volatile("s_waitcnt vmcnt(0)" ::: "memory");
        }
    }
    __syncthreads();
}

typedef __attribute__((ext_vector_type(2))) __bf16 bf16x2_t;
typedef __attribute__((ext_vector_type(2))) float f32x2_t;
__device__ __forceinline__ unsigned cvtpk(float lo, float hi) { f32x2_t f; f[0] = lo; f[1] = hi; return __builtin_bit_cast(unsigned, __builtin_convertvector(f, bf16x2_t)); }
__device__ __forceinline__ float bf2f(unsigned v16) { return __uint_as_float(v16 << 16); }
__device__ __forceinline__ int crow(int r, int hi) { return (r & 3) + 8 * (r >> 2) + 4 * hi; }
#define MFMA_BF16(a, b, c) __builtin_amdgcn_mfma_f32_32x32x16_bf16(a, b, c, 0, 0, 0)
__device__ __forceinline__ float wave_sum(float v) {
    v += __int_as_float(__builtin_amdgcn_update_dpp(0, __float_as_int(v), 0xB1, 0xF, 0xF, true));
    v += __int_as_float(__builtin_amdgcn_update_dpp(0, __float_as_int(v), 0x4E, 0xF, 0xF, true));
    v += __int_as_float(__builtin_amdgcn_update_dpp(0, __float_as_int(v), 0x141, 0xF, 0xF, true));
    v += __int_as_float(__builtin_amdgcn_update_dpp(0, __float_as_int(v), 0x140, 0xF, 0xF, true));
    const int vi = __float_as_int(v);
    return (__int_as_float(__builtin_amdgcn_readlane(vi, 0)) + __int_as_float(__builtin_amdgcn_readlane(vi, 16))) + (__int_as_float(__builtin_amdgcn_readlane(vi, 32)) + __int_as_float(__builtin_amdgcn_readlane(vi, 48)));
}

namespace pg8 {
#define PG8_LAS __attribute__((address_space(3)))
typedef unsigned short bf16_t;
typedef short bf16x8 __attribute__((ext_vector_type(8)));
typedef float f32x4 __attribute__((ext_vector_type(4)));
typedef unsigned u32x4 __attribute__((ext_vector_type(4)));
constexpr int BM = 256, BK = 64, HALF = 128, HTB = HALF * BK * 2  , STAGE_BYTES = 8 * HTB, NXCD = 8, WGM = 8;

__host__ __device__ __forceinline__ int lds_byte(int r, int c) { const int st = (r >> 4) * 2 + (c >> 5), rr = r & 15, cc = c & 31, ob = rr * 64 + cc * 2; return st * 1024 + (ob ^ (((ob >> 9) & 1) << 5)); }
__host__ __device__ __forceinline__ void stage_rc(int b, int& R, int& C) { const int st = b / 1024, sb = b % 1024, swz = sb ^ (((sb >> 9) & 1) << 5); R = (st >> 1) * 16 + swz / 64; C = (st & 1) * 32 + (swz % 64) / 2; }
__host__ __device__ __forceinline__ int perm32(int rho) { const int n = rho >> 4, i = rho & 15; return 8 * (i >> 2) + 4 * n + (i & 3); }

struct Unit { int pm, pn; };
struct Gemm { const bf16_t* A; const bf16_t* Bt; int M, N, K; };
struct FixedOrder {
    int pm, pn;
    __device__ __forceinline__ bool next(int i, Unit& u) const { if (i != 0) return false; u.pm = pm; u.pn = pn; return true; }
    __device__ __forceinline__ void a_ready(const Unit&) const {}
    __device__ __forceinline__ void done(const Unit&) const {}
};

struct StaticOrder {
    int nM, nN, nwg, G, c;
    __host__ __device__ void init(int M, int N, int G_, int c_) { nM = M / BM; nN = N / BM; nwg = nM * nN; G = G_; c = c_; }
    __host__ __device__ bool next(int i, Unit& u) const {
        const long L = (long)i * G + c; if (L >= nwg) return false;
        int wgid = (int)L; { const int q = nwg / NXCD, r = nwg % NXCD, xcd = wgid % NXCD, off = wgid / NXCD; wgid = (xcd < r ? xcd * (q + 1) : r * (q + 1) + (xcd - r) * q) + off; }
        const int nig = WGM * nN, gid = wgid / nig, fm = gid * WGM, gsz = (nM - fm) < WGM ? (nM - fm) : WGM;
        u.pm = fm + ((wgid % nig) % gsz); u.pn = (wgid % nig) / gsz; return true;
    }
    __device__ __forceinline__ void a_ready(const Unit&) const {}
    __device__ __forceinline__ void done(const Unit&) const {}
};

template <class Epi, class Sched, bool SWAP = false, bool STAMP = false>
__device__ __forceinline__ void gemm_phase(PG8_LAS unsigned char* lds, const Gemm g, const Sched& S, const Epi& E, unsigned long long* stamps, const int tid_in) {
    int tid_ = tid_in; asm volatile("" : "+v"(tid_));
    const int tid = tid_, wid = __builtin_amdgcn_readfirstlane(tid >> 6), lane = tid & 63, wr = wid >> 2, wc = wid & 3, fr = lane & 15, fq = lane >> 4;
    const int K = g.K, nt = K / BK;
    int ts_lo = 0, ts_hi = 0, nts = 0; const unsigned long long rt_entry = STAMP ? (unsigned long long)wall_clock64() : 0ull;
#define PG8_STAMP() do { if (STAMP && wid == 0 && nts < 64) { const unsigned long long _c = (unsigned long long)clock64(); \
        ts_lo = (lane == nts) ? (int)(unsigned)_c : ts_lo; ts_hi = (lane == nts) ? (int)(unsigned)(_c >> 32) : ts_hi; ++nts; } } while (0)
    PG8_STAMP();
    unsigned voffA[2], voffB[2];
#pragma unroll
    for (int i = 0; i < 2; ++i) { int R, C; stage_rc(tid * 16 + i * 8192, R, C); const int Rb = Epi::PERM ? ((R & ~31) + perm32(R & 31)) : R;
        voffA[i] = (unsigned)(R * K + C) * 2u; voffB[i] = (unsigned)(Rb * K + C) * 2u; }
    const size_t kstep = (size_t)(BK * 2);
    const size_t hstep = (size_t)HALF * K * 2;
    const size_t tstep = 2 * hstep;
    const unsigned ldsw = (unsigned)wid * 1024u;
    const int aoff = lds_byte(wr * 64 + fr, fq * 8), boff = lds_byte(wc * 32 + fr, fq * 8);
#define PG8_SA(b, h) (((b) * 2 + (h)) * HTB)
#define PG8_SB(b, h) ((4 + (b) * 2 + (h)) * HTB)
#define PG8_STAGE(bufoff, gbase, voff) do { _Pragma("unroll") for (int _i = 0; _i < 2; ++_i) \
        __builtin_amdgcn_global_load_lds((const unsigned*)((const char*)(gbase) + (voff)[_i]), (PG8_LAS unsigned*)(lds + (bufoff) + ldsw + _i * 8192), 16, 0, 0); } while (0)
#define PG8_LDA(dst, b, h) do { _Pragma("unroll") for (int m = 0; m < 4; ++m) _Pragma("unroll") for (int k = 0; k < 2; ++k) dst[m][k] = *(const PG8_LAS bf16x8*)(lds + PG8_SA(b, h) + aoff + m * 2048 + k * 1024); } while (0)
#define PG8_LDB(dst, b, h) do { _Pragma("unroll") for (int n = 0; n < 2; ++n) _Pragma("unroll") for (int k = 0; k < 2; ++k) dst[n][k] = *(const PG8_LAS bf16x8*)(lds + PG8_SB(b, h) + boff + n * 2048 + k * 1024); } while (0)
#define PG8_MMA(ai, bj, At, Bt) do { __builtin_amdgcn_s_setprio(1); _Pragma("unroll") for (int m = 0; m < 4; ++m) _Pragma("unroll") for (int n = 0; n < 2; ++n) _Pragma("unroll") for (int k = 0; k < 2; ++k) \
        acc[ai][bj][m][n] = SWAP ? __builtin_amdgcn_mfma_f32_16x16x32_bf16(At[m][k], Bt[n][k], acc[ai][bj][m][n], 0, 0, 0) : __builtin_amdgcn_mfma_f32_16x16x32_bf16(Bt[n][k], At[m][k], acc[ai][bj][m][n], 0, 0, 0); __builtin_amdgcn_s_setprio(0); } while (0)
#define PG8_WAIT_V(n) asm volatile("s_waitcnt vmcnt(" #n ")" ::: "memory")
#define PG8_WAIT_L(n) asm volatile("s_waitcnt lgkmcnt(" #n ")" ::: "memory")
#define PG8_BAR __builtin_amdgcn_s_barrier()
#define PG8_SCHED __builtin_amdgcn_sched_barrier(0)
    Unit cur, nxt; int ui = 0;
    if (!S.next(0, cur)) return;
    f32x4 acc[2][2][4][2];
#pragma unroll
    for (int a = 0; a < 2; ++a)
#pragma unroll
        for (int b = 0; b < 2; ++b)
#pragma unroll
            for (int m = 0; m < 4; ++m)
#pragma unroll
                for (int n = 0; n < 2; ++n) acc[a][b][m][n] = (f32x4){0.f, 0.f, 0.f, 0.f};
    bf16x8 At[4][2], B0[2][2], B1[2][2];
    const char* cA = (const char*)g.A + (size_t)cur.pm * tstep; const char* cB = (const char*)g.Bt + (size_t)cur.pn * tstep;
    S.a_ready(cur);
    PG8_STAGE(PG8_SB(0, 0), cB, voffB); PG8_STAGE(PG8_SA(0, 0), cA, voffA); PG8_STAGE(PG8_SB(0, 1), cB + hstep, voffB); PG8_STAGE(PG8_SA(0, 1), cA + hstep, voffA);
    if (wr == 1) PG8_BAR;
    PG8_WAIT_V(4); PG8_BAR;
    PG8_STAGE(PG8_SB(1, 0), cB + kstep, voffB); PG8_STAGE(PG8_SA(1, 0), cA + kstep, voffA); PG8_STAGE(PG8_SB(1, 1), cB + hstep + kstep, voffB);
    PG8_WAIT_V(6); PG8_BAR;
    PG8_STAMP();
    for (;;) {
        const bool has_next = S.next(ui + 1, nxt);
        const char* nA = has_next ? (const char*)g.A + (size_t)nxt.pm * tstep : cA; const char* nB = has_next ? (const char*)g.Bt + (size_t)nxt.pn * tstep : cB;
        for (int t = 0; t < nt; t += 2) {
            const bool last = (t == nt - 2);
            const char* a1 = cA + (size_t)(t + 1) * kstep;
            const char* a2 = last ? nA : cA + (size_t)(t + 2) * kstep; const char* b2 = last ? nB : cB + (size_t)(t + 2) * kstep;
            const char* a3 = a2 + kstep; const char* b3 = b2 + kstep;
            if (last && has_next) S.a_ready(nxt);
            PG8_LDB(B0, 0, 0); PG8_SCHED; PG8_LDA(At, 0, 0); PG8_STAGE(PG8_SA(1, 1), a1 + hstep, voffA);
            PG8_WAIT_L(8); PG8_BAR; PG8_WAIT_L(0); PG8_MMA(0, 0, At, B0); PG8_BAR; PG8_SCHED;
            PG8_LDB(B1, 0, 1); PG8_STAGE(PG8_SB(0, 0), b2, voffB);
            PG8_BAR; PG8_WAIT_L(0); PG8_MMA(0, 1, At, B1); PG8_BAR;
            PG8_LDA(At, 0, 1); PG8_STAGE(PG8_SA(0, 0), a2, voffA);
            PG8_BAR; PG8_WAIT_L(0); PG8_MMA(1, 0, At, B0); PG8_BAR; PG8_SCHED;
            PG8_STAGE(PG8_SB(0, 1), b2 + hstep, voffB);
            PG8_WAIT_V(6); PG8_BAR; PG8_MMA(1, 1, At, B1); PG8_BAR;
            PG8_LDB(B0, 1, 0); PG8_SCHED; PG8_LDA(At, 1, 0); PG8_STAGE(PG8_SA(0, 1), a2 + hstep, voffA);
            PG8_WAIT_L(8); PG8_BAR; PG8_WAIT_L(0); PG8_MMA(0, 0, At, B0); PG8_BAR; PG8_SCHED;
            PG8_LDB(B1, 1, 1); PG8_STAGE(PG8_SB(1, 0), b3, voffB);
            PG8_BAR; PG8_WAIT_L(0); PG8_MMA(0, 1, At, B1); PG8_BAR;
            PG8_LDA(At, 1, 1); PG8_STAGE(PG8_SA(1, 0), a3, voffA);
            PG8_BAR; PG8_WAIT_L(0); PG8_MMA(1, 0, At, B0); PG8_BAR; PG8_SCHED;
            PG8_STAGE(PG8_SB(1, 1), b3 + hstep, voffB);
            PG8_WAIT_V(6); PG8_BAR; PG8_MMA(1, 1, At, B1); PG8_BAR;
        }
        PG8_STAMP();
        if constexpr (!Epi::AFTER_DRAIN) { E(acc, cur, wr, wc, fr, fq); S.done(cur); }
        PG8_STAMP();
        if (!has_next) break;
#pragma unroll
        for (int a = 0; a < 2; ++a)
#pragma unroll
            for (int b = 0; b < 2; ++b)
#pragma unroll
                for (int m = 0; m < 4; ++m)
#pragma unroll
                    for (int n = 0; n < 2; ++n) acc[a][b][m][n] = (f32x4){0.f, 0.f, 0.f, 0.f};
        cur = nxt; cA = nA; cB = nB; ++ui;
    }
    PG8_WAIT_V(0);
    if (wr == 0) PG8_BAR;
    PG8_BAR;
    if constexpr (Epi::AFTER_DRAIN) { E.fused(acc, cur, wr, wc, fr, fq, lds, wid, lane); S.done(cur); }
    PG8_STAMP();
    if (STAMP && wid == 0) { stamps[lane] = lane < nts ? (((unsigned long long)(unsigned)ts_hi << 32) | (unsigned)ts_lo) : 0ull;
        if (lane == 62) stamps[62] = rt_entry; if (lane == 63) stamps[63] = (unsigned long long)wall_clock64(); }
#undef PG8_STAMP
#undef PG8_SA
#undef PG8_SB
#undef PG8_STAGE
#undef PG8_LDA
#undef PG8_LDB
#undef PG8_MMA
#undef PG8_WAIT_V
#undef PG8_WAIT_L
#undef PG8_BAR
#undef PG8_SCHED
}
}

struct EpiQK {
    static constexpr bool PERM = true, AFTER_DRAIN = false;
    u16* O; int ldc;
    __device__ __forceinline__ void operator()(const pg8::f32x4 (&acc)[2][2][4][2], const pg8::Unit& u, int wr, int wc, int fr, int fq) const {
        const int col0 = u.pn * 256 + wc * 32 + 8 * fq, row0 = u.pm * 256 + wr * 64 + fr;
#pragma unroll
        for (int ai = 0; ai < 2; ++ai)
#pragma unroll
            for (int m = 0; m < 4; ++m) { u16* rowp = O + (size_t)(row0 + ai * 128 + m * 16) * ldc + col0;
#pragma unroll
                for (int bj = 0; bj < 2; ++bj) { const pg8::f32x4 v0 = acc[ai][bj][m][0], v1 = acc[ai][bj][m][1];
                    u32x4 w; w[0] = cvtpk(v0[0], v0[1]); w[1] = cvtpk(v0[2], v0[3]); w[2] = cvtpk(v1[0], v1[1]); w[3] = cvtpk(v1[2], v1[3]);
                    *(u32x4*)(rowp + bj * 128) = w; } }
    }
};
struct EpiV {
    static constexpr bool PERM = false, AFTER_DRAIN = false;
    u16* VT; int layer;
    __device__ __forceinline__ void operator()(const pg8::f32x4 (&acc)[2][2][4][2], const pg8::Unit& u, int wr, int wc, int fr, int fq) const {
        const int colt = u.pn * 256, grp = colt >> 10;
        const int dil = (layer == 0 || grp == 0) ? 1 : (grp == 1 ? 4 : 16);
        const int rowb = u.pm * 256 + wr * 64 + 4 * fq;
#pragma unroll
        for (int bj = 0; bj < 2; ++bj)
#pragma unroll
            for (int n = 0; n < 2; ++n) {
                const int c = (colt & 1023) + bj * 128 + wc * 32 + n * 16 + fr, h = c >> 6, d = c & 63;
#pragma unroll
                for (int ai = 0; ai < 2; ++ai)
#pragma unroll
                    for (int m = 0; m < 4; ++m) {
                        const int r0 = rowb + ai * 128 + m * 16, b = r0 >> 13, t0 = r0 & (SEQ - 1);
                        u16* vrow = VT + (size_t)grp * T * D + ((size_t)(b * NH + h) * HD + d) * SEQ;
                        const pg8::f32x4 v = acc[ai][bj][m][n];
                        if (dil == 1) { u32x2 w; w[0] = cvtpk(v[0], v[1]); w[1] = cvtpk(v[2], v[3]); *(u32x2*)(vrow + t0) = w; }
                        else {
#pragma unroll
                            for (int i = 0; i < 4; ++i) { const int pp = t0 + i; vrow[(pp % dil) * (SEQ / dil) + pp / dil] = (u16)cvtpk(v[i], 0.f); }
                        }
                    }
            }
    }
};
struct EpiWo {
    static constexpr bool PERM = false, AFTER_DRAIN = false;
    u16* Y; const u16* X;
    __device__ __forceinline__ void operator()(const pg8::f32x4 (&acc)[2][2][4][2], const pg8::Unit& u, int wr, int wc, int fr, int fq) const {
        const int row0 = u.pm * 256 + wr * 64 + fr, col0 = u.pn * 256 + wc * 32 + 4 * fq;
#pragma unroll
        for (int ai = 0; ai < 2; ++ai)
#pragma unroll
            for (int m = 0; m < 4; ++m) { const size_t ro = (size_t)(row0 + ai * 128 + m * 16) * D + col0;
#pragma unroll
                for (int bj = 0; bj < 2; ++bj)
#pragma unroll
                    for (int n = 0; n < 2; ++n) { const u32x2 xr = *(const u32x2*)(X + ro + bj * 128 + n * 16); const pg8::f32x4 a4 = acc[ai][bj][m][n];
                        u32x2 w; w[0] = cvtpk(bf2f(xr[0] & 0xFFFFu) * DN_ALPHA + a4[0], bf2f(xr[0] >> 16) * DN_ALPHA + a4[1]); w[1] = cvtpk(bf2f(xr[1] & 0xFFFFu) * DN_ALPHA + a4[2], bf2f(xr[1] >> 16) * DN_ALPHA + a4[3]);
                        *(u32x2*)(Y + ro + bj * 128 + n * 16) = w; } }
    }
};
struct EpiSGU {
    static constexpr bool PERM = true, AFTER_DRAIN = false;
    u16* H;
    __device__ __forceinline__ void operator()(const pg8::f32x4 (&acc)[2][2][4][2], const pg8::Unit& u, int wr, int wc, int fr, int fq) const {
        const int row0 = u.pm * 256 + wr * 64 + fr, f0 = u.pn * 128 + wc * 32 + 8 * fq;
#pragma unroll
        for (int ai = 0; ai < 2; ++ai)
#pragma unroll
            for (int m = 0; m < 4; ++m) {
                float hv[8];
#pragma unroll
                for (int n = 0; n < 2; ++n)
#pragma unroll
                    for (int i = 0; i < 4; ++i) { const float gt = acc[ai][0][m][n][i], up = acc[ai][1][m][n][i]; hv[n * 4 + i] = gt / (1.f + __expf(-gt)) * up; }
                u32x4 w; w[0] = cvtpk(hv[0], hv[1]); w[1] = cvtpk(hv[2], hv[3]); w[2] = cvtpk(hv[4], hv[5]); w[3] = cvtpk(hv[6], hv[7]);
                *(u32x4*)(H + (size_t)(row0 + ai * 128 + m * 16) * DF + f0) = w;
            }
    }
};
struct EpiSD {
    static constexpr bool PERM = true, AFTER_DRAIN = false;
    u16* Y;
    __device__ __forceinline__ void operator()(const pg8::f32x4 (&acc)[2][2][4][2], const pg8::Unit& u, int wr, int wc, int fr, int fq) const {
        const int row0 = u.pm * 256 + wr * 64 + fr, col0 = u.pn * 256 + wc * 32 + 8 * fq;
#pragma unroll
        for (int ai = 0; ai < 2; ++ai)
#pragma unroll
            for (int m = 0; m < 4; ++m) { u16* rowp = Y + (size_t)(A_TOT + row0 + ai * 128 + m * 16) * D + col0;
#pragma unroll
                for (int bj = 0; bj < 2; ++bj) { const pg8::f32x4 v0 = acc[ai][bj][m][0], v1 = acc[ai][bj][m][1];
                    u32x4 w; w[0] = cvtpk(v0[0], v0[1]); w[1] = cvtpk(v0[2], v0[3]); w[2] = cvtpk(v1[0], v1[1]); w[3] = cvtpk(v1[2], v1[3]);
                    *(u32x4*)(rowp + bj * 128) = w; } }
    }
};

struct Args {
    const float* in[16];
    float* out;
    unsigned char* ws;
    int ph_lo, ph_hi;
};

#define GEMM_CORE(K_, PA0, PA1, PB, LDB)                                                                                                   \
    {                                                                                                                                      \
        const int g_tid = tid, g_lane = lane, g_wave = wave, g_r32 = r32, g_hi = hi;                   \
        const int g_wm = g_wave >> 2, g_wn = g_wave & 3, g_kc = g_tid & 3, g_kq = g_lane >> 3, g_n4 = g_lane & 7;                           \
        const u16* g_pa0 = (PA0); const u16* g_pa1 = (PA1);                                                                                \
        const size_t g_ldb = (size_t)(LDB);                                                                                                \
        const float* g_pb = (PB) + (size_t)(g_kq * 4) * g_ldb + g_n4 * 4;                                                                  \
        const int g_nk = (K_) / 32;                                                                                                        \
        u32x4 g_ra0, g_ra1; f32x4 g_rb0, g_rb1, g_rb2, g_rb3;                                                                              \
        const u32x4 g_z = {0u, 0u, 0u, 0u};                                                                                                \
        _Pragma("unroll") for (int mb = 0; mb < 4; ++mb) { _Pragma("unroll") for (int nb = 0; nb < 2; ++nb) { _Pragma("unroll") for (int r = 0; r < 16; ++r) acc[mb][nb][r] = 0.f; } } \
        g_ra0 = g_pa0 ? *(const u32x4*)(g_pa0 + g_kc * 8) : g_z; g_ra1 = g_pa1 ? *(const u32x4*)(g_pa1 + g_kc * 8) : g_z;                 \
        g_rb0 = *(const f32x4*)(g_pb); g_rb1 = *(const f32x4*)(g_pb + g_ldb); g_rb2 = *(const f32x4*)(g_pb + 2 * g_ldb); g_rb3 = *(const f32x4*)(g_pb + 3 * g_ldb); \
        _Pragma("unroll 1") for (int kt = 0; kt < g_nk; ++kt) {                                                                            \
            LAS char* As = lds + (kt & 1) * STAGE_BYTES; LAS char* Bs = As + 256 * LDP * 2;                                                \
            *(LAS u32x4*)(As + ((g_tid >> 2) * LDP + g_kc * 8) * 2) = g_ra0;                                                               \
            *(LAS u32x4*)(As + (((g_tid >> 2) + 128) * LDP + g_kc * 8) * 2) = g_ra1;                                                       \
            _Pragma("unroll") for (int i = 0; i < 4; ++i) {                                                                                \
                u32x2 w; w[0] = cvtpk(g_rb0[i], g_rb1[i]); w[1] = cvtpk(g_rb2[i], g_rb3[i]);                                               \
                *(LAS u32x2*)(Bs + ((g_wave * 32 + i * 8 + g_n4) * LDP + g_kq * 4) * 2) = w;                                               \
            }                                                                                                                              \
            __syncthreads();                                                                                                               \
            if (kt + 1 < g_nk) {                                                                                                           \
                const int ko = (kt + 1) * 32;                                                                                              \
                g_ra0 = g_pa0 ? *(const u32x4*)(g_pa0 + ko + g_kc * 8) : g_z; g_ra1 = g_pa1 ? *(const u32x4*)(g_pa1 + ko + g_kc * 8) : g_z; \
                const float* pbk = g_pb + (size_t)ko * g_ldb;                                                                              \
                g_rb0 = *(const f32x4*)(pbk); g_rb1 = *(const f32x4*)(pbk + g_ldb); g_rb2 = *(const f32x4*)(pbk + 2 * g_ldb); g_rb3 = *(const f32x4*)(pbk + 3 * g_ldb); \
            }                                                                                                                              \
            _Pragma("unroll") for (int s = 0; s < 2; ++s) {                                                                                \
                bf16x8 af[4], bfr[2];                                                                                                      \
                _Pragma("unroll") for (int mb = 0; mb < 4; ++mb) af[mb] = *(LAS bf16x8*)(As + ((g_wm * 128 + mb * 32 + g_r32) * LDP + s * 16 + g_hi * 8) * 2); \
                _Pragma("unroll") for (int nb = 0; nb < 2; ++nb) bfr[nb] = *(LAS bf16x8*)(Bs + (((g_wn * 2 + nb) * 32 + g_r32) * LDP + s * 16 + g_hi * 8) * 2); \
                _Pragma("unroll") for (int mb = 0; mb < 4; ++mb) { _Pragma("unroll") for (int nb = 0; nb < 2; ++nb) acc[mb][nb] = MFMA_BF16(af[mb], bfr[nb], acc[mb][nb]); } \
            }                                                                                                                              \
        }                                                                                                                                  \
        __syncthreads();                                                                                                                   \
    }

struct AttnSt { float m, l; f32x16 o0, o1; };

struct AttnFr { bf16x8 k[4]; bf16x8 v[4]; };
__device__ __forceinline__ void attn_load(AttnFr& f, const u16* krow, const u16* vt, size_t vt_dstride) {
#pragma unroll
    for (int d0 = 0; d0 < 4; ++d0) f.k[d0] = *(const bf16x8*)(krow + d0 * 16);
    const u16* vt1 = vt + 32 * vt_dstride;
    union { bf16x8 v; u32x2 h[2]; } va;
    va.h[0] = *(const u32x2*)(vt);       va.h[1] = *(const u32x2*)(vt + 8);   f.v[0] = va.v;
    va.h[0] = *(const u32x2*)(vt + 16);  va.h[1] = *(const u32x2*)(vt + 24);  f.v[1] = va.v;
    va.h[0] = *(const u32x2*)(vt1);      va.h[1] = *(const u32x2*)(vt1 + 8);  f.v[2] = va.v;
    va.h[0] = *(const u32x2*)(vt1 + 16); va.h[1] = *(const u32x2*)(vt1 + 24); f.v[3] = va.v;
}
__device__ __forceinline__ void attn_compute(AttnSt& st, const bf16x8 (&qf)[4], const AttnFr& f, int dist0, float bslope, int dlo, int dhi, int hi, int lane) {
    f32x16 p;
#pragma unroll
    for (int r = 0; r < 16; ++r) p[r] = 0.f;
#pragma unroll
    for (int d0 = 0; d0 < 4; ++d0) p = MFMA_BF16(f.k[d0], qf[d0], p);
    constexpr float C2 = 0.125f * LOG2E;
    float mx = NEGV;
#pragma unroll
    for (int r = 0; r < 16; ++r) {
        const int dist = dist0 - ((r & 3) + 8 * (r >> 2));
        const float sc = __builtin_fmaf(p[r], C2, -bslope * (float)dist);
        const float s_ = (dist >= dlo && dist <= dhi) ? sc : NEGV;
        p[r] = s_; mx = fmaxf(mx, s_);
    }
    mx = fmaxf(mx, shxf(mx, 32, lane));
    const float mnew = fmaxf(st.m, mx);
    const float alpha = __builtin_amdgcn_exp2f(st.m - mnew);
    st.m = mnew;
    float ls = 0.f;
#pragma unroll
    for (int r = 0; r < 16; ++r) { p[r] = __builtin_amdgcn_exp2f(p[r] - mnew); ls += p[r]; }
    st.l = st.l * alpha + ls;
#pragma unroll
    for (int r = 0; r < 16; ++r) { st.o0[r] *= alpha; st.o1[r] *= alpha; }
    union { bf16x8 v; unsigned u[4]; } pb0, pb1;
#pragma unroll
    for (int j = 0; j < 4; ++j) { pb0.u[j] = cvtpk(p[2 * j], p[2 * j + 1]); pb1.u[j] = cvtpk(p[8 + 2 * j], p[8 + 2 * j + 1]); }
    st.o0 = MFMA_BF16(f.v[0], pb0.v, st.o0);
    st.o0 = MFMA_BF16(f.v[1], pb1.v, st.o0);
    st.o1 = MFMA_BF16(f.v[2], pb0.v, st.o1);
    st.o1 = MFMA_BF16(f.v[3], pb1.v, st.o1);
    (void)hi;
}

__device__ __forceinline__ float dpp_rowmax(float v) {
    v = fmaxf(v, __int_as_float(__builtin_amdgcn_update_dpp(0, __float_as_int(v), 0xB1, 0xF, 0xF, true)));
    v = fmaxf(v, __int_as_float(__builtin_amdgcn_update_dpp(0, __float_as_int(v), 0x4E, 0xF, 0xF, true)));
    v = fmaxf(v, __int_as_float(__builtin_amdgcn_update_dpp(0, __float_as_int(v), 0x141, 0xF, 0xF, true)));
    v = fmaxf(v, __int_as_float(__builtin_amdgcn_update_dpp(0, __float_as_int(v), 0x140, 0xF, 0xF, true)));
    return v;
}
__device__ __forceinline__ int dpp_rowmin_i(int v) {
    v = min(v, __builtin_amdgcn_update_dpp(0, v, 0xB1, 0xF, 0xF, true));
    v = min(v, __builtin_amdgcn_update_dpp(0, v, 0x4E, 0xF, 0xF, true));
    v = min(v, __builtin_amdgcn_update_dpp(0, v, 0x141, 0xF, 0xF, true));
    v = min(v, __builtin_amdgcn_update_dpp(0, v, 0x140, 0xF, 0xF, true));
    return v;
}
__device__ __forceinline__ float rl_f(float v, int l) { return __int_as_float(__builtin_amdgcn_readlane(__float_as_int(v), l)); }

__device__ __forceinline__ void top3_insert(float v, int i, float& v0, int& i0, float& v1, int& i1, float& v2, int& i2) {
    const bool b0 = (v > v0) || (v == v0 && i < i0);
    const bool b1 = (v > v1) || (v == v1 && i < i1);
    const bool b2 = (v > v2) || (v == v2 && i < i2);
    const float nv2 = b1 ? v1 : (b2 ? v : v2); const int ni2 = b1 ? i1 : (b2 ? i : i2);
    const float nv1 = b0 ? v0 : (b1 ? v : v1); const int ni1 = b0 ? i0 : (b1 ? i : i1);
    const float nv0 = b0 ? v : v0;             const int ni0 = b0 ? i : i0;
    v0 = nv0; i0 = ni0; v1 = nv1; i1 = ni1; v2 = nv2; i2 = ni2;
}

__device__ __forceinline__ void ln_row(float (&v)[16], const float* __restrict__ g, const float* __restrict__ b, int lane) {
    float s = 0.f;
#pragma unroll
    for (int i = 0; i < 16; ++i) s += v[i];
    const float mu = wave_sum(s) * (1.f / D);
    float q = 0.f;
#pragma unroll
    for (int i = 0; i < 16; ++i) { const float d = v[i] - mu; q += d * d; }
    const float rstd = rsqrtf(wave_sum(q) * (1.f / D) + LN_EPS);
#pragma unroll
    for (int j = 0; j < 4; ++j) {
        const f32x4 gg = *(const f32x4*)(g + j * 256 + lane * 4), bb = *(const f32x4*)(b + j * 256 + lane * 4);
#pragma unroll
        for (int c = 0; c < 4; ++c) v[j * 4 + c] = (v[j * 4 + c] - mu) * rstd * gg[c] + bb[c];
    }
}

typedef __attribute__((ext_vector_type(2))) float f32x2_;
__device__ __forceinline__ bf16x8 fp8x8_to_bf16(unsigned lo, unsigned hi_) {
    const f32x2_ a = __builtin_amdgcn_cvt_pk_f32_fp8((int)lo, false), b = __builtin_amdgcn_cvt_pk_f32_fp8((int)lo, true);
    const f32x2_ c = __builtin_amdgcn_cvt_pk_f32_fp8((int)hi_, false), d = __builtin_amdgcn_cvt_pk_f32_fp8((int)hi_, true);
    union { bf16x8 v; unsigned u[4]; } r;
    r.u[0] = cvtpk(a[0], a[1]); r.u[1] = cvtpk(b[0], b[1]); r.u[2] = cvtpk(c[0], c[1]); r.u[3] = cvtpk(d[0], d[1]);
    return r.v;
}
__device__ __forceinline__ unsigned pack_fp8x4(float a, float b, float c, float d) { int p = __builtin_amdgcn_cvt_pk_fp8_f32(a, b, 0, false); return (unsigned)__builtin_amdgcn_cvt_pk_fp8_f32(c, d, p, true); }

constexpr float Y8_SCALE = 16.f;
constexpr int MOE_XCAP = 576;
#define MOE_GAS __attribute__((address_space(1)))
typedef MOE_GAS unsigned char moe_gcb;
constexpr int MOE_BP = 72;
constexpr int MOE_BSTAGE = 128 * MOE_BP * 2;
constexpr int MOE_LDS_VA = 3 * MOE_BSTAGE;
constexpr int MOE_LDS_W = MOE_LDS_VA + 4096;
constexpr int MOE_LDS_XCH = 65536;
template <bool DOWN>
__device__ __forceinline__ void moe_expert(LAS char* lds, const int tid, const int lane, const int wave, const int r32, const int hi,
                                           const unsigned char* __restrict__ abase  , const float* __restrict__ w0, const float* __restrict__ w1, const int ng  , void* __restrict__ outv,
                                           const int pass0, const int npass_, const int st0, const int nstl  , const bool y8 = false  ,
                                           const bool xr = false  ) {
    constexpr int KT = DOWN ? 4 : 16, NP = DOWN ? 8 : 4, LDB = DOWN ? 1024 : 256, APITCH = DOWN ? 256 : 1024  , PSTEP = DOWN ? 128 : 64;
    LAS int* rowva = (LAS int*)(lds + MOE_LDS_VA); LAS float* roww = (LAS float*)(lds + MOE_LDS_W);
    const int nst = nstl;
    const int nsteps = npass_ * nst * KT; (void)NP;
    unsigned aoff[2];
#define MOE_AOFF(ST_) { _Pragma("unroll") for (int a = 0; a < 2; ++a) { const int va_ = rowva[(ST_) * 512 + wave * 64 + a * 32 + r32]; \
        const int srow_ = DOWN ? va_ : (va_ == TRASH_VA ? 0 : (va_ >> 3)); aoff[a] = (unsigned)srow_ * APITCH + hi * 32; } }
    const int seg = wave >> 1, n4 = lane & 7, kp = (wave & 1) * 16 + (lane >> 3);
    const char* wbase = (const char*)(DOWN ? (w0 + seg * 32) : (((seg < 2) ? w0 : w1) + (seg & 1) * 32));
    unsigned boff = (unsigned)(4 * n4 + 2 * kp * LDB) * 4u; asm volatile("" : "+v"(boff));
    unsigned wb_ = (unsigned)((seg * 32 + n4) * MOE_BP + 2 * kp) * 2u; asm volatile("" : "+v"(wb_));
    unsigned lb_ = (unsigned)(r32 * MOE_BP + hi * 32) * 2u; asm volatile("" : "+v"(lb_));
    f32x16 acc[2][4];
#pragma unroll
    for (int a = 0; a < 2; ++a)
#pragma unroll
        for (int c = 0; c < 4; ++c)
#pragma unroll
            for (int r = 0; r < 16; ++r) acc[a][c][r] = 0.f;
    u32x4 fa8[2][2];
    f32x16 accx; u32x4 fa8x[2]; unsigned aoffx = 0u;
#pragma unroll
    for (int r = 0; r < 16; ++r) accx[r] = 0.f;
    fa8x[0] = u32x4{0u, 0u, 0u, 0u}; fa8x[1] = u32x4{0u, 0u, 0u, 0u};
    f32x4 rb0[4], rb1[4];
#define MOE_DEC(S_) const int s2_ = (S_) < nsteps ? (S_) : 0; const int pl_ = s2_ / (nst * KT); const int rm_ = s2_ - pl_ * (nst * KT); const int sl_ = rm_ / KT; const int kt_ = rm_ - sl_ * KT; const int ps_ = pass0 + pl_; const int stt_ = st0 + sl_;
#define MOE_LOADB(S_, RB) { MOE_DEC(S_) (void)stt_; \
        uint64_t wu_ = (uint64_t)(wbase + (size_t)(ps_ * PSTEP + kt_ * 64 * LDB) * 4), wv_ = wu_ + 16 * LDB * 4; asm volatile("" : "+s"(wu_), "+s"(wv_));     \
        const moe_gcb* wug_ = (const moe_gcb*)wu_; const moe_gcb* wvg_ = (const moe_gcb*)wv_; \
        unsigned bo_ = boff; asm volatile("" : "+v"(bo_));     \
        RB[0] = *(const MOE_GAS f32x4*)(wug_ + bo_); RB[1] = *(const MOE_GAS f32x4*)(wug_ + bo_ + LDB * 4); RB[2] = *(const MOE_GAS f32x4*)(wvg_ + bo_); RB[3] = *(const MOE_GAS f32x4*)(wvg_ + bo_ + LDB * 4); }
#define MOE_WRITEB(STG, RB) { LAS char* Bs_ = lds + (STG) * MOE_BSTAGE; \
        _Pragma("unroll") for (int i = 0; i < 4; ++i) { LAS unsigned* q_ = (LAS unsigned*)(Bs_ + wb_ + i * (8 * MOE_BP * 2)); q_[0] = cvtpk(RB[0][i], RB[1][i]); q_[8] = cvtpk(RB[2][i], RB[3][i]); } }
#define MOE_COMPUTE(STG, DO_MFMA) { LAS char* Bs_ = lds + (STG) * MOE_BSTAGE; \
        _Pragma("unroll") for (int u = 0; u < 4; ++u) { \
            bf16x8 bfr[4]; \
            if (DO_MFMA) { _Pragma("unroll") for (int c = 0; c < 4; ++c) bfr[c] = *(LAS bf16x8*)(Bs_ + lb_ + (c * 32 * MOE_BP + u * 8) * 2); } \
            _Pragma("unroll") for (int a = 0; a < 2; ++a) { \
                if (DO_MFMA) { const bf16x8 af_ = fp8x8_to_bf16(fa8[a][u >> 1][(u & 1) * 2], fa8[a][u >> 1][(u & 1) * 2 + 1]); \
                    _Pragma("unroll") for (int c = 0; c < 4; ++c) acc[a][c] = MFMA_BF16(bfr[c], af_, acc[a][c]); } \
            } \
        } }
      \
#define MOE_RELOAD { _Pragma("unroll") for (int a = 0; a < 2; ++a) { unsigned ao_ = aoff[a]; asm volatile("" : "+v"(ao_)); \
            fa8[a][0] = *(const MOE_GAS u32x4*)(ab_n + ao_); fa8[a][1] = *(const MOE_GAS u32x4*)(ab_n + ao_ + 16); } }
#define MOE_XCOMPUTE(STG) if (!DOWN) { LAS char* Bs_ = lds + (STG) * MOE_BSTAGE; \
        _Pragma("unroll") for (int u = 0; u < 4; ++u) { \
            const bf16x8 ax_ = fp8x8_to_bf16(fa8x[u >> 1][(u & 1) * 2], fa8x[u >> 1][(u & 1) * 2 + 1]); \
            if (u & 1) { unsigned ao_ = aoffx; asm volatile("" : "+v"(ao_)); fa8x[u >> 1] = *(const MOE_GAS u32x4*)(ab_n + ao_ + (u >> 1) * 16); } \
            const bf16x8 bx_ = *(LAS bf16x8*)(Bs_ + (wave & 3) * (32 * MOE_BP * 2) + lb_ + u * 16); \
            accx = MFMA_BF16(bx_, ax_, accx); } }
#define MOE_NEXTA(S_) MOE_DEC(S_) (void)ps_; \
        if (stt_ != st_loaded) { MOE_AOFF(stt_) st_loaded = stt_; } \
        uint64_t abn_ = (uint64_t)abase + kt_ * 64; asm volatile("" : "+s"(abn_)); const moe_gcb* ab_n = (const moe_gcb*)abn_;
    int st_loaded = st0;
    MOE_AOFF(st0)
    { const char* ab0 = (const char*)abase;
#pragma unroll
      for (int a = 0; a < 2; ++a)
#pragma unroll
          for (int h2 = 0; h2 < 2; ++h2) fa8[a][h2] = *(const u32x4*)(ab0 + aoff[a] + h2 * 16); }
    if (!DOWN) {
        const int vax_ = xr ? rowva[512 + 32 * (wave >> 2) + r32] : TRASH_VA; aoffx = (unsigned)(vax_ == TRASH_VA ? 0 : (vax_ >> 3)) * APITCH + hi * 32;
        fa8x[0] = *(const u32x4*)((const char*)abase + aoffx); fa8x[1] = *(const u32x4*)((const char*)abase + aoffx + 16); }
    MOE_LOADB(0, rb0)
    MOE_LOADB(1, rb1)
    MOE_WRITEB(0, rb0)
    MOE_LOADB(2, rb0)
    int stg = 0;
#pragma unroll 1
    for (int sidx = 0; sidx < nsteps; sidx += 2) {
        const int pl = sidx / (nst * KT); const int rm = sidx - pl * (nst * KT); const int sl = rm / KT; const int kt = rm - sl * KT; const int ps = pass0 + pl, stt = st0 + sl;
        const bool wv = (wave * 64) < (ng - stt * 512);
        const int stg1 = stg == 2 ? 0 : stg + 1, stg2 = stg1 == 2 ? 0 : stg1 + 1;
        __syncthreads();
        MOE_WRITEB(stg1, rb1)
        MOE_LOADB(sidx + 3, rb1)
        { MOE_NEXTA(sidx + 1)
          if (wv) MOE_COMPUTE(stg, true)
          MOE_RELOAD
          MOE_XCOMPUTE(stg) }
        __syncthreads();
        MOE_WRITEB(stg2, rb0)
        MOE_LOADB(sidx + 4, rb0)
        { MOE_NEXTA(sidx + 2)
          if (wv) MOE_COMPUTE(stg1, true)
          MOE_RELOAD
          MOE_XCOMPUTE(stg1) }
        stg = stg2;
        if (kt == KT - 2) {
            const int le_ = lane_id_(); const int lane = le_, r32 = le_ & 31, hi = le_ >> 5; (void)lane;
            if (wv) {
                const int nrows = ng - stt * 512;
#pragma unroll
                for (int a = 0; a < 2; ++a) {
                    if (a == 0 || (wave * 64 + 32) < nrows) {
                        const int lrow = stt * 512 + wave * 64 + a * 32 + r32;
                        const unsigned va = (unsigned)rowva[lrow];
                        if (DOWN) {
                            const float w = roww[lrow];
#pragma unroll
                            for (int c = 0; c < 4; ++c) {
                                float yv_[16];
#pragma unroll
                                for (int j = 0; j < 16; ++j) yv_[j] = acc[a][c][(j >> 2) + 4 * (j & 3)] * w;
                                if (y8) {
                                    u32x4 q8;
#pragma unroll
                                    for (int jj = 0; jj < 4; ++jj) q8[jj] = pack_fp8x4(yv_[4 * jj], yv_[4 * jj + 1], yv_[4 * jj + 2], yv_[4 * jj + 3]);
                                    *(u32x4*)((unsigned char*)outv + (size_t)va * D + ps * 128 + c * 32 + 16 * hi) = q8;
                                } else {
                                    u32x4 q0, q1;
#pragma unroll
                                    for (int jj = 0; jj < 4; ++jj) { q0[jj] = cvtpk(yv_[2 * jj], yv_[2 * jj + 1]); q1[jj] = cvtpk(yv_[8 + 2 * jj], yv_[9 + 2 * jj]); }
                                    u16* o = (u16*)outv + (size_t)va * D + ps * 128 + c * 32 + 16 * hi;
                                    *(u32x4*)o = q0; *(u32x4*)(o + 8) = q1;
                                }
                            }
                        } else {
#pragma unroll
                            for (int c = 0; c < 2; ++c) {
                                float hv[16];
#pragma unroll
                                for (int j = 0; j < 16; ++j) { const int r = (j >> 2) + 4 * (j & 3); const float gt = acc[a][c][r], up = acc[a][c + 2][r]; hv[j] = gt / (1.f + __expf(-gt)) * up; }
                                u32x4 q;
#pragma unroll
                                for (int jj = 0; jj < 4; ++jj) q[jj] = pack_fp8x4(hv[4 * jj], hv[4 * jj + 1], hv[4 * jj + 2], hv[4 * jj + 3]);
                                *(u32x4*)((unsigned char*)outv + (size_t)va * DF + ps * 64 + c * 32 + 16 * hi) = q;
                            }
                        }
                    }
                }
#pragma unroll
                for (int a = 0; a < 2; ++a)
#pragma unroll
                    for (int c = 0; c < 4; ++c)
#pragma unroll
                        for (int r = 0; r < 16; ++r) acc[a][c][r] = 0.f;
            }
            if (!DOWN) { if (xr) {
                LAS float* xch = (LAS float*)(lds + MOE_LDS_XCH) + ((wave >> 2) * 2 + (wave & 1)) * 1024 + lane;
                if ((wave & 3) >= 2) {
#pragma unroll
                    for (int r = 0; r < 16; ++r) xch[r * 64] = accx[r];
                }
                __syncthreads();
                if ((wave & 3) < 2) {
                    const unsigned vax = (unsigned)rowva[512 + 32 * (wave >> 2) + r32];
                    u32x4 q;
#pragma unroll
                    for (int jj = 0; jj < 4; ++jj) {
#pragma unroll
                        for (int i = 0; i < 4; ++i) { const int r = jj + 4 * i; const float gt = accx[r]; accx[r] = gt / (1.f + __expf(-gt)) * xch[r * 64]; }
                        q[jj] = pack_fp8x4(accx[jj], accx[jj + 4], accx[jj + 8], accx[jj + 12]);
                    }
                    *(u32x4*)((unsigned char*)outv + (size_t)vax * DF + ps * 64 + (wave & 3) * 32 + 16 * hi) = q;
                }
                }
#pragma unroll
                for (int r = 0; r < 16; ++r) accx[r] = 0.f;
            }
        }
    }
    __syncthreads();
#undef MOE_XCOMPUTE
#undef MOE_AOFF
#undef MOE_DEC
#undef MOE_LOADB
#undef MOE_WRITEB
#undef MOE_COMPUTE
#undef MOE_RELOAD
#undef MOE_NEXTA
}

constexpr int N_PHASES = 21;

#define P_x_in CTX_IN(0)
#define P_xb ((u16*)(ws + WS_XB))
#define P_x1 ((float*)(ws + WS_X1))
#define P_x2 ((float*)(ws + WS_X2))
#define P_ypre ((u16*)(ws + WS_YPRE))
#define P_qkv ((u16*)(ws + WS_QKV))
#define P_vT ((u16*)(ws + WS_VT))
#define P_kmean ((float*)(ws + WS_KM))
#define P_ao ((u16*)(ws + WS_AO))
#define P_og ((u16*)(ws + WS_OG))
#define P_lse ((float*)(ws + WS_LSE))
#define P_topw ((float*)(ws + WS_TOPW))
#define P_list ((int*)(ws + WS_LIST))
#define P_hb ((u16*)(ws + WS_HB))
#define P_yb ((u16*)(ws + WS_YB))
#define P_cnt_all ((int*)(ws + WS_CTL + CTL_ECNT_OFF))
#define P_xb8 ((unsigned char*)(ws + WS_XB8))
#define P_hbs ((u16*)(ws + WS_HBS))
#define P_selm ((unsigned*)(ws + WS_SELM))
#define P_part ((u16*)(ws + WS_PART))
#define P_plse ((float*)(ws + WS_PLSE))
#define PH_BEGIN int tid = wave_s_ * 64 + lane_id_(); asm volatile("" : "+v"(tid)); const int lane = tid & 63, r32 = lane & 31, hi = lane >> 5; const int wave = __builtin_amdgcn_readfirstlane(tid >> 6); (void)lane; (void)r32; (void)hi; (void)wave
constexpr int LDS_CTX = LDS_BAR + 16;
__device__ __forceinline__ uint64_t ctx_ld(int i) {
    extern __shared__ __attribute__((aligned(16))) unsigned char lds_raw[];
    const LAS unsigned* q = (const LAS unsigned*)((LAS char*)lds_raw + LDS_CTX) + 2 * i;
    const unsigned lo = __builtin_amdgcn_readfirstlane(q[0]), hi = __builtin_amdgcn_readfirstlane(q[1]);
    return ((uint64_t)hi << 32) | lo;
}
typedef __attribute__((address_space(1))) unsigned char gbyte;
#define AS_GLOBAL(T, u64v) ((T*)(gbyte*)(u64v))
#define CTX_IN(i) AS_GLOBAL(const float, ctx_ld(i))
#define PH_FN_BEGIN \
    extern __shared__ __attribute__((aligned(16))) unsigned char lds_raw[]; \
    LAS char* lds = (LAS char*)lds_raw; (void)lds; \
    const int G = gridDim.x, bid = blockIdx.x; (void)G; (void)bid; \
    unsigned char* const ws = AS_GLOBAL(unsigned char, ctx_ld(17)); (void)ws; \
    const int NQ = L == 0 ? 3072 : 9216; (void)NQ; \
    int* cnt = P_cnt_all + L * NE * CNT_STRIDE; (void)cnt;
__device__ __forceinline__ void ph_p0(int L, int rep_, const int wave_s_) {
    PH_FN_BEGIN
    (void)rep_;
    PH_BEGIN;
    for (size_t i = (size_t)bid * NTHR + tid; i < (size_t)T * D / 4; i += (size_t)G * NTHR) {
        const f32x4 v = *(const f32x4*)(P_x_in + i * 4);
        u32x2 w; w[0] = cvtpk(v[0], v[1]); w[1] = cvtpk(v[2], v[3]);
        *(u32x2*)(P_xb + i * 4) = w;
    }
    LAS float* tl = (LAS float*)lds;
    for (int it = bid; it < 3968 + 128; it += G) {
        int seg, kt;
        if (it < 3840) { seg = it >> 4; kt = it & 15; } else if (it < 3968) { seg = 240 + ((it - 3840) >> 2); kt = (it - 3840) & 3; } else { seg = 272 + ((it - 3968) >> 4); kt = (it - 3968) & 15; }
        const float* src; int ld; u16* dst; int Kd = 1024; u16* dst_lo = nullptr;
        if (seg < 48) { const int col = 64 * seg; src = CTX_IN(1) + col; ld = 3072; dst = (u16*)(ws + WS_WQK0) + (size_t)col * 1024; }
        else if (seg < 192) { const int col = 64 * (seg - 48); src = CTX_IN(2) + col; ld = 9216; dst = (u16*)(ws + WS_WQK1) + (size_t)col * 1024; }
        else if (seg < 224) { const int s2 = seg - 192, l2 = s2 >> 4, col = 64 * (s2 & 15); src = CTX_IN(3) + (size_t)l2 * D * D + col; ld = 1024; dst = (u16*)(ws + WS_WO) + (size_t)l2 * D * D + (size_t)col * 1024; }
        else if (seg < 240) { const int s2 = seg - 224, l2 = s2 >> 3, i8 = s2 & 7, un = i8 >> 2, q = i8 & 3;
            src = (q < 2 ? CTX_IN(11) : CTX_IN(12)) + (size_t)l2 * D * DF + un * 128 + 64 * (q & 1); ld = 256; dst = (u16*)(ws + WS_WSGU) + (size_t)l2 * 512 * 1024 + (size_t)(64 * i8) * 1024; }
        else if (seg < 272) { const int s2 = seg - 240, l2 = s2 >> 4, col = 64 * (s2 & 15); src = CTX_IN(13) + (size_t)l2 * DF * D + col; ld = 1024; Kd = 256; dst = (u16*)(ws + WS_WSD) + (size_t)l2 * D * DF + (size_t)col * 256; }
        else { const int s2 = seg - 272, l2 = s2 >> 2, col = 64 * (s2 & 3); src = CTX_IN(6) + (size_t)l2 * D * NE + col; ld = 256; dst = (u16*)(ws + WS_WRH) + (size_t)l2 * NE * D + (size_t)col * 1024; dst_lo = (u16*)(ws + WS_WRL) + (size_t)l2 * NE * D + (size_t)col * 1024; }
        {
            const int kr = tid >> 4, c4 = tid & 15;
#pragma unroll
            for (int i = 0; i < 2; ++i) {
                const f32x4 v = *(const f32x4*)(src + (size_t)(kt * 64 + kr + 32 * i) * ld + 4 * c4);
#pragma unroll
                for (int jj = 0; jj < 4; ++jj) tl[(kr + 32 * i) * 65 + 4 * c4 + jj] = v[jj];
            }
        }
        __syncthreads();
        {
            const int row = tid >> 3, kc = tid & 7;
            float f[8];
#pragma unroll
            for (int jj = 0; jj < 8; ++jj) f[jj] = tl[(8 * kc + jj) * 65 + row];
            u32x4 w; w[0] = cvtpk(f[0], f[1]); w[1] = cvtpk(f[2], f[3]); w[2] = cvtpk(f[4], f[5]); w[3] = cvtpk(f[6], f[7]);
            *(u32x4*)(dst + (size_t)row * Kd + kt * 64 + 8 * kc) = w;
            if (dst_lo) {
                u32x4 wl;
#pragma unroll
                for (int jj = 0; jj < 4; ++jj) wl[jj] = cvtpk(f[2 * jj] - bf2f(w[jj] & 0xFFFFu), f[2 * jj + 1] - bf2f(w[jj] >> 16));
                *(u32x4*)(dst_lo + (size_t)row * Kd + kt * 64 + 8 * kc) = wl;
            }
        }
        __syncthreads();
    }
}

__device__ __forceinline__ void ph_qkv(int L, int rep_, const int wave_s_) {
    PH_FN_BEGIN
    (void)rep_;
    const pg8::Gemm g{P_xb, (const u16*)(ws + (L == 0 ? WS_WQK0 : WS_WQK1)), T, NQ, D};
    pg8::StaticOrder S; S.init(g.M, g.N, G, bid);
    const EpiQK E{P_qkv, NQ};
    pg8::gemm_phase<EpiQK, pg8::StaticOrder, false>((PG8_LAS unsigned char*)lds, g, S, E, nullptr, wave_s_ * 64 + lane_id_());
}

__device__ __forceinline__ void ph_kmean(int L, int rep_, const int wave_s_) {
    PH_FN_BEGIN
    (void)rep_;
    PH_BEGIN;
    LAS float* red = (LAS float*)lds;
    for (int it = bid; it < BATCH * NH * MOBA_NB; it += G) {
        const int j = it & 31, h = (it >> 5) & 15, b = it >> 9;
        const int kg_ = tid >> 3, ch = tid & 7;
        const u16* kp = P_qkv + (size_t)(b * SEQ + j * MOBA_BLK + kg_) * 3072 + 1024 + h * 64 + ch * 8;
        float sm[8];
#pragma unroll
        for (int e2 = 0; e2 < 8; ++e2) sm[e2] = 0.f;
#pragma unroll
        for (int i = 0; i < 4; ++i) {
            const u32x4 v = *(const u32x4*)(kp + (size_t)(64 * i) * 3072);
#pragma unroll
            for (int e2 = 0; e2 < 4; ++e2) { sm[2 * e2] += bf2f(v[e2] & 0xFFFFu); sm[2 * e2 + 1] += bf2f(v[e2] >> 16); }
        }
#pragma unroll
        for (int e2 = 0; e2 < 8; ++e2) red[kg_ * 65 + ch * 8 + e2] = sm[e2];
        __syncthreads();
        if (tid < 64) {
            float tot = 0.f;
#pragma unroll 8
            for (int q = 0; q < 64; ++q) tot += red[q * 65 + tid];
            P_kmean[(size_t)it * 64 + tid] = tot * (1.f / MOBA_BLK);
        }
        __syncthreads();
    }
}

__device__ __forceinline__ void ph_gate(int L, int rep_, const int wave_s_) {
    PH_FN_BEGIN
    (void)rep_;
    PH_BEGIN;
    for (int it = bid; it < BATCH * NH * MOBA_NB; it += G) {
        const int qb = it & 31, bh = it >> 5, b = bh >> 4, h = bh & 15;
        const int tq = qb * MOBA_BLK + wave * 32 + r32;
        const u16* qrow = P_qkv + (size_t)(b * SEQ + tq) * 3072 + h * 64 + hi * 8;
        bf16x8 qf[4];
#pragma unroll
        for (int d0 = 0; d0 < 4; ++d0) qf[d0] = *(const bf16x8*)(qrow + d0 * 16);
        unsigned selmask = 0u;
        if (qb > 0) {
            const float* km = P_kmean + ((size_t)(b * NH + h) * MOBA_NB + r32) * 64 + hi * 8;
            f32x16 gt;
#pragma unroll
            for (int r = 0; r < 16; ++r) gt[r] = 0.f;
#pragma unroll
            for (int d0 = 0; d0 < 4; ++d0) {
                const f32x4 k0 = *(const f32x4*)(km + d0 * 16), k1 = *(const f32x4*)(km + d0 * 16 + 4);
                union { bf16x8 v; unsigned u[4]; } kf;
                kf.u[0] = cvtpk(k0[0], k0[1]); kf.u[1] = cvtpk(k0[2], k0[3]); kf.u[2] = cvtpk(k1[0], k1[1]); kf.u[3] = cvtpk(k1[2], k1[3]);
                gt = MFMA_BF16(kf.v, qf[d0], gt);
            }
            float v0 = -INFINITY, v1 = -INFINITY, v2 = -INFINITY; int i0 = 99, i1 = 99, i2 = 99;
#pragma unroll
            for (int r = 0; r < 16; ++r) { const int jb = crow(r, hi); const float gv = jb < qb ? gt[r] : -INFINITY; top3_insert(gv, jb < qb ? jb : 99, v0, i0, v1, i1, v2, i2); }
            const float ov0 = shxf(v0, 32, lane), ov1 = shxf(v1, 32, lane), ov2 = shxf(v2, 32, lane);
            const int oi0 = shxi(i0, 32, lane), oi1 = shxi(i1, 32, lane), oi2 = shxi(i2, 32, lane);
            top3_insert(ov0, oi0, v0, i0, v1, i1, v2, i2); top3_insert(ov1, oi1, v0, i0, v1, i1, v2, i2); top3_insert(ov2, oi2, v0, i0, v1, i1, v2, i2);
            if (i0 < 32) selmask |= 1u << i0;
            if (i1 < 32) selmask |= 1u << i1;
            if (i2 < 32) selmask |= 1u << i2;
        }
        if (hi == 0) P_selm[(size_t)bh * SEQ + tq] = selmask;
    }
}

constexpr int MB_KP = 72;
constexpr int MB_VP = 260;
constexpr int MB_LDS_K = 0;
constexpr int MB_LDS_V = 256 * MB_KP * 2;
constexpr int MB_LDS_LIST = MB_LDS_V + 64 * MB_VP * 2;
constexpr int MB_LDS_CTR = MB_LDS_LIST + 8192 * 2;
__device__ __forceinline__ void ph_moba(int L, int rep_, const int wave_s_) {
    PH_FN_BEGIN
    (void)rep_;
    PH_BEGIN;
    LAS char* Ks = lds + MB_LDS_K; LAS char* Vs = lds + MB_LDS_V;
    LAS u16* qlist = (LAS u16*)(lds + MB_LDS_LIST); LAS int* ctr = (LAS int*)(lds + MB_LDS_CTR);
    for (int it = bid; it < BATCH * NH * MOBA_NB; it += G) {
        const int rnd = it >> 8, w8 = it & 255, a8 = w8 >> 5, bh = w8 & 31;
        const int j = rnd == 0 ? a8 : (rnd == 1 ? 15 - a8 : (rnd == 2 ? 16 + a8 : 31 - a8));
        const int b = bh >> 4, h = bh & 15;
        const float slope2 = exp2f(-0.5f * (float)(h + 1)) * LOG2E;
        if (tid == 0) { int z0 = 0; asm volatile("" : "+v"(z0)); ctr[0] = z0; ctr[1] = z0; }
        {
            const u16* kg = P_qkv + (size_t)(b * SEQ + j * MOBA_BLK) * 3072 + 1024 + h * 64;
#pragma unroll
            for (int i = 0; i < 4; ++i) { const int c = tid + i * 512, row = c >> 3, ch = c & 7; *(LAS u32x4*)(Ks + (row * MB_KP + ch * 8) * 2) = *(const u32x4*)(kg + (size_t)row * 3072 + ch * 8); }
            const u16* vg = P_qkv + (size_t)(b * SEQ + j * MOBA_BLK) * 3072 + 2048 + h * 64;
#pragma unroll
            for (int i = 0; i < 4; ++i) {
                const int c = tid + i * 512, key = c >> 3, ch = c & 7;
                const u32x4 v = *(const u32x4*)(vg + (size_t)key * 3072 + ch * 8);
#pragma unroll
                for (int e2 = 0; e2 < 4; ++e2) {
                    *(LAS u16*)(Vs + ((ch * 8 + 2 * e2) * MB_VP + key) * 2) = (u16)(v[e2] & 0xFFFFu);
                    *(LAS u16*)(Vs + ((ch * 8 + 2 * e2 + 1) * MB_VP + key) * 2) = (u16)(v[e2] >> 16);
                }
            }
        }
        __syncthreads();
        {
            const unsigned* sm = P_selm + (size_t)bh * SEQ;
            for (int t0 = (j + 1) * MOBA_BLK; t0 < SEQ; t0 += 512) {
                const int t = t0 + tid;
                const bool sel = (t < SEQ) && ((sm[t < SEQ ? t : 0] >> j) & 1u);
                const unsigned long long bal = __ballot(sel);
                const int total = __popcll(bal);
                int wb = 0;
                if (lane == 0 && total) wb = atomicAdd((int*)&ctr[0], total);
                wb = __builtin_amdgcn_readfirstlane(wb);
                if (sel) qlist[wb + __popcll(bal & ((1ull << lane) - 1ull))] = (u16)t;
            }
        }
        __syncthreads();
        const int nq = ctr[0];
        const int ntiles = 8 + ((nq + 31) >> 5);
        for (;;) {
            int ti = 0;
            if (lane == 0) ti = atomicAdd((int*)&ctr[1], 1);
            ti = __builtin_amdgcn_readfirstlane(ti);
            if (ti >= ntiles) break;
            const bool own = ti < 8;
            const int wq = 7 - ti;
            const int li = (ti - 8) * 32 + r32;
            const bool valid = own || li < nq;
            const int tq = own ? j * MOBA_BLK + wq * 32 + r32 : (int)qlist[li < nq ? li : nq - 1];
            const int nsteps = own ? wq + 1 : 8;
            const u16* qrow = P_qkv + (size_t)(b * SEQ + tq) * 3072 + h * 64 + hi * 8;
            bf16x8 qf[4];
#pragma unroll
            for (int d0 = 0; d0 < 4; ++d0) qf[d0] = *(const bf16x8*)(qrow + d0 * 16);
            int slot = 3;
            if (!own) slot = __popc(P_selm[(size_t)bh * SEQ + tq] & ((1u << j) - 1u));
            AttnSt st; st.m = NEGV; st.l = 0.f;
#pragma unroll
            for (int r = 0; r < 16; ++r) { st.o0[r] = 0.f; st.o1[r] = 0.f; }
            const int dlo = own ? 0 : -0x40000000;
            for (int kt = 0; kt < nsteps; ++kt) {
                AttnFr f;
#pragma unroll
                for (int d0 = 0; d0 < 4; ++d0) f.k[d0] = *(LAS bf16x8*)(Ks + ((kt * 32 + r32) * MB_KP + d0 * 16 + hi * 8) * 2);
#pragma unroll
                for (int q4 = 0; q4 < 4; ++q4) {
                    union { bf16x8 v; u32x2 hh[2]; } va;
                    LAS char* vp = Vs + (((q4 >> 1) * 32 + r32) * MB_VP + kt * 32 + (q4 & 1) * 16 + 4 * hi) * 2;
                    va.hh[0] = *(LAS u32x2*)(vp); va.hh[1] = *(LAS u32x2*)(vp + 16);
                    f.v[q4] = va.v;
                }
                attn_compute(st, qf, f, tq - (j * MOBA_BLK + kt * 32) - 4 * hi, slope2, dlo, 0x7fffffff, hi, lane);
            }
            const float lt = st.l + shxf(st.l, 32, lane);
            const float inv = 1.f / lt;
            if (valid) {
                const size_t pi = ((size_t)(b * SEQ + tq) * NH + h) * 4 + slot;
                u16* orow = P_part + pi * 64;
#pragma unroll
                for (int rq = 0; rq < 4; ++rq) {
                    u32x2 w; w[0] = cvtpk(st.o0[4 * rq] * inv, st.o0[4 * rq + 1] * inv); w[1] = cvtpk(st.o0[4 * rq + 2] * inv, st.o0[4 * rq + 3] * inv);
                    *(u32x2*)(orow + 8 * rq + 4 * hi) = w;
                    w[0] = cvtpk(st.o1[4 * rq] * inv, st.o1[4 * rq + 1] * inv); w[1] = cvtpk(st.o1[4 * rq + 2] * inv, st.o1[4 * rq + 3] * inv);
                    *(u32x2*)(orow + 32 + 8 * rq + 4 * hi) = w;
                }
                if (hi == 0) P_plse[pi] = st.m * LN2 + logf(lt);
            }
        }
        __syncthreads();
    }
}

__device__ __forceinline__ void ph_mobamerge(int L, int rep_, const int wave_s_) {
    PH_FN_BEGIN
    (void)rep_;
    PH_BEGIN;
    for (size_t i = (size_t)bid * NTHR + tid; i < (size_t)T * NH * 8; i += (size_t)G * NTHR) {
        const size_t row = i >> 7; const int h = (int)(i >> 3) & 15, d8 = (int)i & 7;
        const int qb = (int)(row & (SEQ - 1)) >> 8;
        const int nsel = qb < 3 ? qb : 3;
        const size_t pi = (row * NH + h) * 4;
        float l[4], w[4];
        float mx = -INFINITY;
#pragma unroll
        for (int sidx = 0; sidx < 4; ++sidx) { const bool ok = sidx == 3 || sidx < nsel; l[sidx] = ok ? P_plse[pi + sidx] : -INFINITY; mx = fmaxf(mx, l[sidx]); }
        float ws_ = 0.f;
#pragma unroll
        for (int sidx = 0; sidx < 4; ++sidx) { w[sidx] = (sidx == 3 || sidx < nsel) ? expf(l[sidx] - mx) : 0.f; ws_ += w[sidx]; }
        const float inv = 1.f / ws_;
        float acc8[8];
#pragma unroll
        for (int c = 0; c < 8; ++c) acc8[c] = 0.f;
#pragma unroll
        for (int sidx = 0; sidx < 4; ++sidx) {
            if (sidx == 3 || sidx < nsel) {
                const u32x4 a = *(const u32x4*)(P_part + (pi + sidx) * 64 + d8 * 8);
                const float ww = w[sidx] * inv;
#pragma unroll
                for (int c = 0; c < 4; ++c) { acc8[2 * c] += ww * bf2f(a[c] & 0xFFFFu); acc8[2 * c + 1] += ww * bf2f(a[c] >> 16); }
            }
        }
        u32x4 o;
#pragma unroll
        for (int c = 0; c < 4; ++c) o[c] = cvtpk(acc8[2 * c], acc8[2 * c + 1]);
        *(u32x4*)(P_ao + row * D + h * 64 + d8 * 8) = o;
    }
}

constexpr int DL_KP = 72, DL_VP = 388;
constexpr int DL_LDS_K = 0, DL_LDS_V = 384 * DL_KP * 2;
__device__ __forceinline__ void ph_dil(int L, int rep_, const int wave_s_) {
    PH_FN_BEGIN
    (void)rep_;
    PH_BEGIN;
    LAS char* Ks = lds + DL_LDS_K; LAS char* Vs = lds + DL_LDS_V;
    for (int it = bid; it < BATCH * NH * 3 * 32; it += G) {
        const int ch = it & 31, grp = (it >> 5) % 3, bh = it / 96, b = bh >> 4, h = bh & 15;
        const int dil = grp == 0 ? 1 : (grp == 1 ? 4 : 16), Ls = SEQ / dil;
        const float slope2 = exp2f(-0.5f * (float)(h + 1)) * LOG2E * (float)dil;
        const int uc = ch * 256, res = uc / Ls, c0 = uc - res * Ls;
        const int kb0 = c0 - 128;
        {
            const u16* kg = P_qkv + (size_t)(b * SEQ) * 9216 + grp * 3072 + 1024 + h * 64;
#pragma unroll
            for (int i = 0; i < 6; ++i) {
                const int c = tid + i * 512, row = c >> 3, chk = c & 7, ks = kb0 + row;
                if (ks >= 0) *(LAS u32x4*)(Ks + (row * DL_KP + chk * 8) * 2) = *(const u32x4*)(kg + (size_t)(ks * dil + res) * 9216 + chk * 8);
            }
            const u16* vg = P_qkv + (size_t)(b * SEQ) * 9216 + grp * 3072 + 2048 + h * 64;
#pragma unroll
            for (int i = 0; i < 6; ++i) {
                const int c = tid + i * 512, row = c >> 3, chk = c & 7, ks = kb0 + row;
                if (ks >= 0) {
                    const u32x4 v = *(const u32x4*)(vg + (size_t)(ks * dil + res) * 9216 + chk * 8);
#pragma unroll
                    for (int e2 = 0; e2 < 4; ++e2) {
                        *(LAS u16*)(Vs + ((chk * 8 + 2 * e2) * DL_VP + row) * 2) = (u16)(v[e2] & 0xFFFFu);
                        *(LAS u16*)(Vs + ((chk * 8 + 2 * e2 + 1) * DL_VP + row) * 2) = (u16)(v[e2] >> 16);
                    }
                }
            }
        }
        const int i0 = c0 + wave * 32, iq = i0 + r32, pq = iq * dil + res;
        const u16* qrow = P_qkv + (size_t)(b * SEQ + pq) * 9216 + grp * 3072 + h * 64 + hi * 8;
        bf16x8 qf[4];
#pragma unroll
        for (int d0 = 0; d0 < 4; ++d0) qf[d0] = *(const bf16x8*)(qrow + d0 * 16);
        __syncthreads();
        AttnSt st; st.m = NEGV; st.l = 0.f;
#pragma unroll
        for (int r = 0; r < 16; ++r) { st.o0[r] = 0.f; st.o1[r] = 0.f; }
        const int ktmin = (i0 >= 128) ? 0 : (128 - i0) >> 5;
        for (int kt = 4; kt >= ktmin; --kt) {
            const int lrow0 = (wave + kt) * 32;
            AttnFr f;
#pragma unroll
            for (int d0 = 0; d0 < 4; ++d0) f.k[d0] = *(LAS bf16x8*)(Ks + ((lrow0 + r32) * DL_KP + d0 * 16 + hi * 8) * 2);
#pragma unroll
            for (int q4 = 0; q4 < 4; ++q4) {
                union { bf16x8 v; u32x2 hh[2]; } va;
                LAS char* vp = Vs + (((q4 >> 1) * 32 + r32) * DL_VP + lrow0 + (q4 & 1) * 16 + 4 * hi) * 2;
                va.hh[0] = *(LAS u32x2*)(vp); va.hh[1] = *(LAS u32x2*)(vp + 16);
                f.v[q4] = va.v;
            }
            const int k0 = i0 - 128 + kt * 32;
            attn_compute(st, qf, f, iq - k0 - 4 * hi, slope2, 0, 128, hi, lane);
        }
        const float lt = st.l + shxf(st.l, 32, lane);
        const float inv = 1.f / lt;
        u16* orow = P_og + (size_t)grp * T * D + (size_t)(b * SEQ + pq) * D + h * 64;
#pragma unroll
        for (int rq = 0; rq < 4; ++rq) {
            u32x2 w; w[0] = cvtpk(st.o0[4 * rq] * inv, st.o0[4 * rq + 1] * inv); w[1] = cvtpk(st.o0[4 * rq + 2] * inv, st.o0[4 * rq + 3] * inv);
            *(u32x2*)(orow + 8 * rq + 4 * hi) = w;
            w[0] = cvtpk(st.o1[4 * rq] * inv, st.o1[4 * rq + 1] * inv); w[1] = cvtpk(st.o1[4 * rq + 2] * inv, st.o1[4 * rq + 3] * inv);
            *(u32x2*)(orow + 32 + 8 * rq + 4 * hi) = w;
        }
        if (hi == 0) P_lse[((size_t)grp * T + (b * SEQ + pq)) * NH + h] = st.m * LN2 + logf(lt);
        __syncthreads();
    }
}

__device__ __forceinline__ void ph_merge(int L, int rep_, const int wave_s_) {
    PH_FN_BEGIN
    (void)rep_;

            PH_BEGIN;
                for (size_t i = (size_t)bid * NTHR + tid; i < (size_t)T * NH * 8; i += (size_t)G * NTHR) {
                    const size_t row = i >> 7; const int h = (int)(i >> 3) & 15, d8 = (int)i & 7;
                    const float l0 = P_lse[(0 * (size_t)T + row) * NH + h], l1 = P_lse[(1 * (size_t)T + row) * NH + h], l2 = P_lse[(2 * (size_t)T + row) * NH + h];
                    const float mx = fmaxf(l0, fmaxf(l1, l2));
                    float w0 = expf(l0 - mx), w1 = expf(l1 - mx), w2 = expf(l2 - mx);
                    const float inv = 1.f / (w0 + w1 + w2); w0 *= inv; w1 *= inv; w2 *= inv;
                    const size_t off = row * D + h * 64 + d8 * 8;
                    const u32x4 a0 = *(const u32x4*)(P_og + off), a1 = *(const u32x4*)(P_og + (size_t)T * D + off), a2 = *(const u32x4*)(P_og + 2 * (size_t)T * D + off);
                    u32x4 o;
#pragma unroll
                    for (int c = 0; c < 4; ++c) {
                        const float lo_ = w0 * bf2f(a0[c] & 0xFFFFu) + w1 * bf2f(a1[c] & 0xFFFFu) + w2 * bf2f(a2[c] & 0xFFFFu);
                        const float hi_ = w0 * bf2f(a0[c] >> 16) + w1 * bf2f(a1[c] >> 16) + w2 * bf2f(a2[c] >> 16);
                        o[c] = cvtpk(lo_, hi_);
                    }
                    *(u32x4*)(P_ao + off) = o;
                }

}

__device__ __forceinline__ void ph_wo(int L, int rep_, const int wave_s_) {
    PH_FN_BEGIN
    (void)rep_;
    const pg8::Gemm g{P_ao, (const u16*)(ws + WS_WO) + (size_t)L * D * D, T, D, D};
    pg8::StaticOrder S; S.init(g.M, g.N, G, bid);
    const EpiWo E{P_ypre, P_xb};
    pg8::gemm_phase<EpiWo, pg8::StaticOrder, false>((PG8_LAS unsigned char*)lds, g, S, E, nullptr, wave_s_ * 64 + lane_id_());
}

constexpr int RT_P = 144;
constexpr int RT_LDS_AH = 0, RT_LDS_AL = 64 * RT_P;
constexpr int RT_LDS_BH = 2 * 64 * RT_P, RT_LDS_BL = RT_LDS_BH + 256 * RT_P;
constexpr int RT_LDS_ST = RT_LDS_BL + 256 * RT_P;
__device__ __forceinline__ void ph_router(int L, int rep_, const int wave_s_) {
    PH_FN_BEGIN
    (void)rep_;
    PH_BEGIN;
    const float* lng = CTX_IN(4) + L * D; const float* lnb = CTX_IN(5) + L * D;
    const float* rbias = CTX_IN(7) + L * NE;
    const u16* wrh = (const u16*)(ws + WS_WRH) + (size_t)L * NE * D; const u16* wrl = (const u16*)(ws + WS_WRL) + (size_t)L * NE * D;
    LAS float* stat = (LAS float*)(lds + RT_LDS_ST);
    for (int it = bid; it < T / 64; it += G) {
#pragma unroll 1
        for (int hb_ = 0; hb_ < 2; ++hb_) {
            u32x4 yv[4][2];
#pragma unroll
            for (int rr = 0; rr < 4; ++rr)
#pragma unroll
                for (int j = 0; j < 2; ++j) yv[rr][j] = *(const u32x4*)(P_ypre + ((size_t)it * 64 + wave * 8 + hb_ * 4 + rr) * D + j * 512 + lane * 8);
#pragma unroll
            for (int rr = 0; rr < 4; ++rr) {
                float sm = 0.f;
#pragma unroll
                for (int j = 0; j < 2; ++j)
#pragma unroll
                    for (int c = 0; c < 4; ++c) sm += bf2f(yv[rr][j][c] & 0xFFFFu) + bf2f(yv[rr][j][c] >> 16);
                const float mu = wave_sum(sm) * (1.f / D);
                float q = 0.f;
#pragma unroll
                for (int j = 0; j < 2; ++j)
#pragma unroll
                    for (int c = 0; c < 4; ++c) { const float d0_ = bf2f(yv[rr][j][c] & 0xFFFFu) - mu, d1_ = bf2f(yv[rr][j][c] >> 16) - mu; q += d0_ * d0_ + d1_ * d1_; }
                const float rstd = rsqrtf(wave_sum(q) * (1.f / D) + LN_EPS);
                if (lane == 0) { stat[wave * 8 + hb_ * 4 + rr] = mu; stat[64 + wave * 8 + hb_ * 4 + rr] = rstd; }
            }
        }
        __syncthreads();
        const int arow = tid >> 3, aq = tid & 7;
        const float amu = stat[arow], ars = stat[64 + arow];
        const u16* yp = P_ypre + ((size_t)it * 64 + arow) * D + aq * 8;
        u32x4 ya = *(const u32x4*)(yp);
        u32x4 bw[8];
#pragma unroll
        for (int i = 0; i < 8; ++i) { const int p_ = tid + 512 * (i & 3); bw[i] = *(const u32x4*)((i < 4 ? wrh : wrl) + (size_t)(p_ >> 3) * D + (p_ & 7) * 8); }
        f32x16 lg[2];
#pragma unroll
        for (int r = 0; r < 16; ++r) { lg[0][r] = 0.f; lg[1][r] = 0.f; }
#pragma unroll 1
        for (int kc = 0; kc < 16; ++kc) {
            const int k0 = kc * 64;
            {
                const f32x4 g0 = *(const f32x4*)(lng + k0 + aq * 8), g1 = *(const f32x4*)(lng + k0 + aq * 8 + 4);
                const f32x4 b0 = *(const f32x4*)(lnb + k0 + aq * 8), b1 = *(const f32x4*)(lnb + k0 + aq * 8 + 4);
                f32x4 x0, x1v;
#pragma unroll
                for (int c = 0; c < 4; ++c) { const float y0_ = bf2f(c & 1 ? ya[c >> 1] >> 16 : ya[c >> 1] & 0xFFFFu), y1_ = bf2f(c & 1 ? ya[2 + (c >> 1)] >> 16 : ya[2 + (c >> 1)] & 0xFFFFu);
                    x0[c] = (y0_ - amu) * ars * g0[c] + b0[c]; x1v[c] = (y1_ - amu) * ars * g1[c] + b1[c]; }
                const size_t go = ((size_t)it * 64 + arow) * D + k0 + aq * 8;
                u32x4 wh; wh[0] = cvtpk(x0[0], x0[1]); wh[1] = cvtpk(x0[2], x0[3]); wh[2] = cvtpk(x1v[0], x1v[1]); wh[3] = cvtpk(x1v[2], x1v[3]);
                *(u32x4*)(P_xb + go) = wh;
                u32x2 w8; w8[0] = pack_fp8x4(x0[0], x0[1], x0[2], x0[3]); w8[1] = pack_fp8x4(x1v[0], x1v[1], x1v[2], x1v[3]);
                *(u32x2*)(P_xb8 + go) = w8;
                u32x4 wl;
                wl[0] = cvtpk(x0[0] - bf2f(wh[0] & 0xFFFFu), x0[1] - bf2f(wh[0] >> 16)); wl[1] = cvtpk(x0[2] - bf2f(wh[1] & 0xFFFFu), x0[3] - bf2f(wh[1] >> 16));
                wl[2] = cvtpk(x1v[0] - bf2f(wh[2] & 0xFFFFu), x1v[1] - bf2f(wh[2] >> 16)); wl[3] = cvtpk(x1v[2] - bf2f(wh[3] & 0xFFFFu), x1v[3] - bf2f(wh[3] >> 16));
                *(LAS u32x4*)(lds + RT_LDS_AH + arow * RT_P + aq * 16) = wh;
                *(LAS u32x4*)(lds + RT_LDS_AL + arow * RT_P + aq * 16) = wl;
#pragma unroll
                for (int i = 0; i < 8; ++i) { const int p_ = tid + 512 * (i & 3); *(LAS u32x4*)(lds + (i < 4 ? RT_LDS_BH : RT_LDS_BL) + (p_ >> 3) * RT_P + (p_ & 7) * 16) = bw[i]; }
            }
            __syncthreads();
            {
                const int kn = (kc + 1 < 16) ? k0 + 64 : 0;
                ya = *(const u32x4*)(yp + kn);
#pragma unroll
                for (int i = 0; i < 8; ++i) { const int p_ = tid + 512 * (i & 3); bw[i] = *(const u32x4*)((i < 4 ? wrh : wrl) + (size_t)(p_ >> 3) * D + kn + (p_ & 7) * 8); }
            }
#pragma unroll
            for (int sk = 0; sk < 4; ++sk) {
                const int ko = (sk * 16 + hi * 8) * 2;
                const bf16x8 bh_ = *(const LAS bf16x8*)(lds + RT_LDS_BH + (wave * 32 + r32) * RT_P + ko), bl_ = *(const LAS bf16x8*)(lds + RT_LDS_BL + (wave * 32 + r32) * RT_P + ko);
#pragma unroll
                for (int rb = 0; rb < 2; ++rb) {
                    const bf16x8 xh = *(const LAS bf16x8*)(lds + RT_LDS_AH + (rb * 32 + r32) * RT_P + ko), xl = *(const LAS bf16x8*)(lds + RT_LDS_AL + (rb * 32 + r32) * RT_P + ko);
                    lg[rb] = MFMA_BF16(xh, bh_, lg[rb]); lg[rb] = MFMA_BF16(xl, bh_, lg[rb]); lg[rb] = MFMA_BF16(xh, bl_, lg[rb]);
                }
            }
            __syncthreads();
        }
        LAS float* lgs = (LAS float*)lds;
#pragma unroll
        for (int rb = 0; rb < 2; ++rb)
#pragma unroll
            for (int r = 0; r < 16; ++r) lgs[(rb * 32 + crow(r, hi)) * 257 + wave * 32 + r32] = lg[rb][r];
        __syncthreads();
#pragma unroll 1
        for (int tg = 0; tg < 2; ++tg) {
            float sc[4][4], cv[4][4];
#pragma unroll
            for (int tt = 0; tt < 4; ++tt) {
                const int lr = wave * 8 + tg * 4 + tt;
#pragma unroll
                for (int j = 0; j < 4; ++j) { const int e = lane + 64 * j; sc[tt][j] = 1.f / (1.f + __expf(-lgs[lr * 257 + e])); cv[tt][j] = sc[tt][j] + rbias[e]; }
            }
            float gsel[4][8];
#pragma unroll
            for (int j = 0; j < 4; ++j) {
#pragma unroll
                for (int tt = 0; tt < 4; ++tt) {
                    const float rm = dpp_rowmax(cv[tt][j]);
                    const float m1a = fmaxf(rl_f(rm, 0), rl_f(rm, 16)), m1b = fmaxf(rl_f(rm, 32), rl_f(rm, 48));
                    const unsigned long long bal = __ballot(cv[tt][j] == (hi ? m1b : m1a));
                    const int fa_ = __builtin_ctz((unsigned)(bal & 0xFFFFFFFFull)), fb_ = 32 + __builtin_ctz((unsigned)(bal >> 32));
                    const float c2 = (lane == fa_ || lane == fb_) ? -INFINITY : cv[tt][j];
                    const float rm2 = dpp_rowmax(c2);
                    gsel[tt][2 * j] = m1a + fmaxf(rl_f(rm2, 0), rl_f(rm2, 16));
                    gsel[tt][2 * j + 1] = m1b + fmaxf(rl_f(rm2, 32), rl_f(rm2, 48));
                }
            }
#pragma unroll
            for (int tt = 0; tt < 4; ++tt)
#pragma unroll
                for (int j = 0; j < 4; ++j) {
                    int ra_ = 0, rb_ = 0;
#pragma unroll
                    for (int g2 = 0; g2 < 8; ++g2) {
                        ra_ += ((gsel[tt][g2] > gsel[tt][2 * j]) || (gsel[tt][g2] == gsel[tt][2 * j] && g2 < 2 * j)) ? 1 : 0;
                        rb_ += ((gsel[tt][g2] > gsel[tt][2 * j + 1]) || (gsel[tt][g2] == gsel[tt][2 * j + 1] && g2 < 2 * j + 1)) ? 1 : 0;
                    }
                    cv[tt][j] = ((hi ? rb_ : ra_) < 4) ? cv[tt][j] : NEGV;
                }
            float wsel[4], wsum[4]; int esel[4];
#pragma unroll
            for (int tt = 0; tt < 4; ++tt) { wsel[tt] = 0.f; wsum[tt] = 0.f; esel[tt] = 0; }
#pragma unroll 1
            for (int k = 0; k < TOPK; ++k) {
#pragma unroll
                for (int tt = 0; tt < 4; ++tt) {
                    float bv = cv[tt][0]; int be = lane;
#pragma unroll
                    for (int j = 1; j < 4; ++j) if (cv[tt][j] > bv) { bv = cv[tt][j]; be = lane + 64 * j; }
                    const float rm = dpp_rowmax(bv);
                    const float mval = fmaxf(fmaxf(rl_f(rm, 0), rl_f(rm, 16)), fmaxf(rl_f(rm, 32), rl_f(rm, 48)));
                    const int ri = dpp_rowmin_i(bv == mval ? be : 0x7fffffff);
                    const int e = min(min(__builtin_amdgcn_readlane(ri, 0), __builtin_amdgcn_readlane(ri, 16)), min(__builtin_amdgcn_readlane(ri, 32), __builtin_amdgcn_readlane(ri, 48)));
                    const int jl = e >> 6, ll = e & 63;
                    const float smine = ((jl == 0 ? sc[tt][0] : 0.f) + (jl == 1 ? sc[tt][1] : 0.f)) + ((jl == 2 ? sc[tt][2] : 0.f) + (jl == 3 ? sc[tt][3] : 0.f));
                    const float sw = rl_f(smine, ll);
#pragma unroll
                    for (int j = 0; j < 4; ++j) cv[tt][j] = (lane == ll && jl == j) ? -INFINITY : cv[tt][j];
                    wsum[tt] += sw;
                    if (lane == k) { wsel[tt] = sw; esel[tt] = e; }
                }
            }
#pragma unroll
            for (int tt = 0; tt < 4; ++tt) {
                if (lane < TOPK) {
                    const int tok = it * 64 + wave * 8 + tg * 4 + tt;
                    const int a = tok * TOPK + lane;
                    P_topw[a] = wsel[tt] / wsum[tt] * 2.5f;
                    if (rep_ == 0) {
                        const int pos = atomicAdd(&cnt[esel[tt] * CNT_STRIDE], 1);
                        P_list[(size_t)esel[tt] * T + pos] = a;
                    }
                }
            }
        }
        __syncthreads();
    }
}

__device__ __forceinline__ void ph_gateup(int L, int rep_, const int wave_s_) {
    PH_FN_BEGIN
    (void)rep_;
    {
        PH_BEGIN;
        const float* weg = CTX_IN(8) + (size_t)L * NE * D * DF; const float* weu = CTX_IN(9) + (size_t)L * NE * D * DF;
        LAS int* rowva = (LAS int*)(lds + MOE_LDS_VA);
        {
            int* octr = (int*)(ws + WS_CTL + CTL_CNT_OFF + 8192) + (L * 4 + 2 * (rep_ & 1)) * 64;
            LAS int* slot = (LAS int*)(lds + 140000);
            for (;;) {
                __syncthreads();
                if (tid == 0) { int q; do { q = atomicAdd(octr, 1); } while (q >= NE && q < NE * 5 && cnt[((q - NE) >> 2) * CNT_STRIDE] <= MOE_XCAP); *slot = q; }
                __syncthreads();
                const int q = *slot;
                if (q >= NE * 5) break;
                const bool ovf = q >= NE;
                const int e = ovf ? (q - NE) >> 2 : q, pz = ovf ? (q - NE) & 3 : 0, npz = ovf ? 1 : 4, st0 = ovf ? 1 : 0, n = cnt[e * CNT_STRIDE];
                for (int r0 = 0; r0 < n; r0 += 1024) {
                    if (ovf && n - r0 <= MOE_XCAP) break;
#pragma unroll
                    for (int i = 0; i < 2; ++i) { int t_ = tid; asm volatile("" : "+v"(t_)); const int idx = r0 + i * 512 + t_; rowva[i * 512 + t_] = idx < n ? P_list[(size_t)e * T + idx] : TRASH_VA; }
                    __syncthreads();
                    moe_expert<false>(lds, tid, lane, wave, r32, hi, P_xb8, weg + (size_t)e * D * DF, weu + (size_t)e * D * DF, (n - r0) < 1024 ? (n - r0) : 1024, (void*)P_hb, pz, npz, st0, 1, false, !ovf && (n - r0) > 512 && (n - r0) <= MOE_XCAP);
                }
            }
        }
    }
    {
        PH_BEGIN;
        const pg8::Gemm g{P_xb, (const u16*)(ws + WS_WSGU) + (size_t)L * 512 * 1024, T, 512, D};
        const EpiSGU E{P_hbs};
        int* qctr = (int*)(ws + WS_CTL + CTL_CNT_OFF + 4096) + (L * 4 + 2 * (rep_ & 1)) * 64;
        LAS int* slot = (LAS int*)(lds + 140000);
        for (;;) {
            __syncthreads();
            if (tid == 0) *slot = atomicAdd(qctr, 1);
            __syncthreads();
            const int un = *slot;
            if (un >= 128) break;
            const pg8::FixedOrder S{un & 63, un >> 6};
            pg8::gemm_phase<EpiSGU, pg8::FixedOrder, false>((PG8_LAS unsigned char*)lds, g, S, E, nullptr, wave_s_ * 64 + lane_id_());
        }
    }
}

__device__ __forceinline__ void ph_down(int L, int rep_, const int wave_s_) {
    PH_FN_BEGIN
    (void)rep_;
    {
        PH_BEGIN;
        const float* wed = CTX_IN(10) + (size_t)L * NE * DF * D;
        LAS int* rowva = (LAS int*)(lds + MOE_LDS_VA); LAS float* roww = (LAS float*)(lds + MOE_LDS_W);
        {
            int* octr = (int*)(ws + WS_CTL + CTL_CNT_OFF + 8192) + (L * 4 + 1 + 2 * (rep_ & 1)) * 64;
            LAS int* slot = (LAS int*)(lds + 140000);
            for (;;) {
                __syncthreads();
                if (tid == 0) { int q; do { q = atomicAdd(octr, 1); } while (q >= NE && q < NE * 5 && cnt[((q - NE) >> 2) * CNT_STRIDE] <= 512); *slot = q; }
                __syncthreads();
                const int q = *slot;
                if (q >= NE * 5) break;
                const bool ovf = q >= NE;
                const int e = ovf ? (q - NE) >> 2 : q, pz = ovf ? ((q - NE) & 3) * 2 : 0, npz = ovf ? 2 : 8, st0 = ovf ? 1 : 0, n = cnt[e * CNT_STRIDE];
                for (int r0 = 0; r0 < n; r0 += 1024) {
                    if (ovf && n - r0 <= 512) break;
#pragma unroll
                    for (int i = 0; i < 2; ++i) { int t_ = tid; asm volatile("" : "+v"(t_)); const int idx = r0 + i * 512 + t_; const int va = idx < n ? P_list[(size_t)e * T + idx] : TRASH_VA; rowva[i * 512 + t_] = va; roww[i * 512 + t_] = va < A_TOT ? P_topw[va] * Y8_SCALE : 0.f; }
                    __syncthreads();
                    moe_expert<true>(lds, tid, lane, wave, r32, hi, (const unsigned char*)P_hb, wed + (size_t)e * DF * D, nullptr, (n - r0) < 1024 ? (n - r0) : 1024, (void*)P_yb, pz, npz, st0, 1, true);
                }
            }
        }
    }
    {
        PH_BEGIN;
        const pg8::Gemm g{P_hbs, (const u16*)(ws + WS_WSD) + (size_t)L * D * DF, T, D, DF};
        const EpiSD E{P_yb};
        int* qctr = (int*)(ws + WS_CTL + CTL_CNT_OFF + 4096) + (L * 4 + 1 + 2 * (rep_ & 1)) * 64;
        LAS int* slot = (LAS int*)(lds + 140000);
        for (;;) {
            __syncthreads();
            if (tid == 0) *slot = atomicAdd(qctr, 1);
            __syncthreads();
            const int un = *slot;
            if (un >= 256) break;
            const pg8::FixedOrder S{un & 63, un >> 6};
            pg8::gemm_phase<EpiSD, pg8::FixedOrder, false>((PG8_LAS unsigned char*)lds, g, S, E, nullptr, wave_s_ * 64 + lane_id_());
        }
    }
}

__device__ __forceinline__ void ph_combine(int L, int rep_, const int wave_s_) {
    PH_FN_BEGIN
    (void)rep_;
    PH_BEGIN;
    const float* lng = CTX_IN(14) + L * D; const float* lnb = CTX_IN(15) + L * D;
    float* dst = AS_GLOBAL(float, ctx_ld(16));
    for (int row = bid * 8 + wave; row < T; row += G * 8) {
        u32x4 yv[TOPK + 1][2];
#pragma unroll
        for (int k = 0; k < TOPK + 1; ++k) {
            const size_t va = k < TOPK ? (size_t)row * TOPK + k : (size_t)A_TOT + row;
            if (k < TOPK) {
#pragma unroll
                for (int j = 0; j < 2; ++j) { const u32x2 w8 = *(const u32x2*)((const unsigned char*)P_yb + va * D + j * 512 + lane * 8); yv[k][j][0] = w8[0]; yv[k][j][1] = w8[1]; yv[k][j][2] = 0u; yv[k][j][3] = 0u; }
            } else {
#pragma unroll
                for (int j = 0; j < 2; ++j) yv[k][j] = *(const u32x4*)(P_yb + va * D + j * 512 + lane * 8);
            }
        }
        float v[16];
#pragma unroll
        for (int j = 0; j < 2; ++j) {
            const u32x4 t = *(const u32x4*)(P_xb + (size_t)row * D + j * 512 + lane * 8);
#pragma unroll
            for (int c = 0; c < 4; ++c) { v[j * 8 + 2 * c] = DN_ALPHA * bf2f(t[c] & 0xFFFFu); v[j * 8 + 2 * c + 1] = DN_ALPHA * bf2f(t[c] >> 16); }
        }
#pragma unroll
        for (int k = 0; k < TOPK + 1; ++k)
#pragma unroll
            for (int j = 0; j < 2; ++j) {
                if (k < TOPK) {
#pragma unroll
                    for (int c = 0; c < 2; ++c) {
                        const f32x2_ lo2 = __builtin_amdgcn_cvt_pk_f32_fp8((int)yv[k][j][c], false), hi2 = __builtin_amdgcn_cvt_pk_f32_fp8((int)yv[k][j][c], true);
                        v[j * 8 + 4 * c] += lo2[0] * (1.f / Y8_SCALE); v[j * 8 + 4 * c + 1] += lo2[1] * (1.f / Y8_SCALE); v[j * 8 + 4 * c + 2] += hi2[0] * (1.f / Y8_SCALE); v[j * 8 + 4 * c + 3] += hi2[1] * (1.f / Y8_SCALE);
                    }
                } else {
#pragma unroll
                    for (int c = 0; c < 4; ++c) { v[j * 8 + 2 * c] += bf2f(yv[k][j][c] & 0xFFFFu); v[j * 8 + 2 * c + 1] += bf2f(yv[k][j][c] >> 16); }
                }
            }
        float sm = 0.f;
#pragma unroll
        for (int i = 0; i < 16; ++i) sm += v[i];
        const float mu = wave_sum(sm) * (1.f / D);
        float q = 0.f;
#pragma unroll
        for (int i = 0; i < 16; ++i) { const float d = v[i] - mu; q += d * d; }
        const float rstd = rsqrtf(wave_sum(q) * (1.f / D) + LN_EPS);
#pragma unroll
        for (int j = 0; j < 2; ++j) {
            const f32x4 g0 = *(const f32x4*)(lng + j * 512 + lane * 8), g1 = *(const f32x4*)(lng + j * 512 + lane * 8 + 4);
            const f32x4 b0 = *(const f32x4*)(lnb + j * 512 + lane * 8), b1 = *(const f32x4*)(lnb + j * 512 + lane * 8 + 4);
            f32x4 o0, o1;
#pragma unroll
            for (int c = 0; c < 4; ++c) { o0[c] = (v[j * 8 + c] - mu) * rstd * g0[c] + b0[c]; o1[c] = (v[j * 8 + 4 + c] - mu) * rstd * g1[c] + b1[c]; }
            if (L == 1) { *(f32x4*)(dst + (size_t)row * D + j * 512 + lane * 8) = o0; *(f32x4*)(dst + (size_t)row * D + j * 512 + lane * 8 + 4) = o1; }
            if (L == 0) { u32x4 w; w[0] = cvtpk(o0[0], o0[1]); w[1] = cvtpk(o0[2], o0[3]); w[2] = cvtpk(o1[0], o1[1]); w[3] = cvtpk(o1[2], o1[3]); *(u32x4*)(P_xb + (size_t)row * D + j * 512 + lane * 8) = w; }
        }
    }
}

__global__ void __launch_bounds__(NTHR, 2) fwd(Args args) {
    extern __shared__ __attribute__((aligned(16))) unsigned char lds_raw[];
    LAS char* lds = (LAS char*)lds_raw;
    unsigned char* const ws = args.ws;
    const int lo = args.ph_lo, hi_ph = args.ph_hi;
    const int wave_s_ = __builtin_amdgcn_readfirstlane(threadIdx.x >> 6);
    if (threadIdx.x < 18) {
        const uint64_t v = threadIdx.x < 16 ? (uint64_t)args.in[threadIdx.x] : (threadIdx.x == 16 ? (uint64_t)args.out : (uint64_t)args.ws);
        ((LAS uint64_t*)(lds + LDS_CTX))[threadIdx.x] = v;
    }
    __syncthreads();
#define IN(k) (lo <= (k) && (k) < hi_ph)

#if MK_ONE_LAUNCH
    if (threadIdx.x < 4) ((LAS unsigned*)(lds + LDS_BAR))[threadIdx.x] = 0u;
    __syncthreads();
    XcdBarrier bar = xcd_barrier_post((unsigned*)(ws + WS_CTL), (volatile LAS unsigned*)(lds + LDS_BAR), wave_s_ == 0 && lane_id_() == 0);
#define GRID_BAR() xcd_barrier(bar, wave_s_ == 0 && lane_id_() == 0)
#else
#define GRID_BAR() do { } while (0)
#endif
#define SEAM(k) do { if (IN(k) && IN((k) + 1)) GRID_BAR(); } while (0)

    for (int rep_ = 0; rep_ < ((IN(0) && PHK(0)) ? REPS(0) : 0); ++rep_) { ph_p0(0, rep_, wave_s_); }
    SEAM(0);

    for (int L = 0; L < 2; ++L) {
        const int pb = 1 + 10 * L;
        for (int rep_ = 0; rep_ < ((IN(pb + 0) && PHK(1)) ? REPS(1) : 0); ++rep_) { ph_qkv(L, rep_, wave_s_); }
        SEAM(pb + 0);

        if (L == 0) {
            for (int rep_ = 0; rep_ < ((IN(pb + 1) && PHK(2)) ? REPS(2) : 0); ++rep_) { ph_kmean(L, rep_, wave_s_); }
            SEAM(pb + 1);
            for (int rep_ = 0; rep_ < ((IN(pb + 2) && PHK(11)) ? REPS(11) : 0); ++rep_) { ph_gate(L, rep_, wave_s_); }
            SEAM(pb + 2);
        }

        if (L == 0) {
            for (int rep_ = 0; rep_ < ((IN(pb + 3) && PHK(3)) ? REPS(3) : 0); ++rep_) { ph_moba(L, rep_, wave_s_); }
            SEAM(pb + 3);
            for (int rep_ = 0; rep_ < ((IN(pb + 4) && PHK(12)) ? REPS(12) : 0); ++rep_) { ph_mobamerge(L, rep_, wave_s_); }
        } else {
            for (int rep_ = 0; rep_ < ((IN(pb + 3) && PHK(4)) ? REPS(4) : 0); ++rep_) { ph_dil(L, rep_, wave_s_); }
            SEAM(pb + 3);
            for (int rep_ = 0; rep_ < ((IN(pb + 4) && PHK(5)) ? REPS(5) : 0); ++rep_) { ph_merge(L, rep_, wave_s_); }
        }
        SEAM(pb + 4);

        for (int rep_ = 0; rep_ < ((IN(pb + 5) && PHK(6)) ? REPS(6) : 0); ++rep_) { ph_wo(L, rep_, wave_s_); }
        SEAM(pb + 5);

        for (int rep_ = 0; rep_ < ((IN(pb + 6) && PHK(7)) ? REPS(7) : 0); ++rep_) { ph_router(L, rep_, wave_s_); }
        SEAM(pb + 6);

        for (int rep_ = 0; rep_ < ((IN(pb + 7) && PHK(8)) ? REPS(8) : 0); ++rep_) { ph_gateup(L, rep_, wave_s_); }
        SEAM(pb + 7);

        for (int rep_ = 0; rep_ < ((IN(pb + 8) && PHK(9)) ? REPS(9) : 0); ++rep_) { ph_down(L, rep_, wave_s_); }
        SEAM(pb + 8);

        for (int rep_ = 0; rep_ < ((IN(pb + 9) && PHK(10)) ? REPS(10) : 0); ++rep_) { ph_combine(L, rep_, wave_s_); }
        if (L == 0) SEAM(pb + 9);
    }
}

extern "C" void kernel_launch(void* const* d_in, const int* in_sizes, int n_in, void* d_out, int out_size, void* d_ws, size_t ws_size, hipStream_t stream) {
    static int grid = 0;
    if (grid == 0) {
        if (n_in != 16 || out_size != T * D || ws_size < WS_END2) { fprintf(stderr, "kernel_launch: unexpected problem (n_in %d out %d ws %zu need %zu)\n", n_in, out_size, ws_size, (size_t)WS_END2); grid = -1; return; }
        int dev = 0, cus = 0, per_cu = 0;
        if (hipGetDevice(&dev) != hipSuccess || hipDeviceGetAttribute(&cus, hipDeviceAttributeMultiprocessorCount, dev) != hipSuccess) { grid = -1; return; }
        if (hipFuncSetAttribute((const void*)fwd, hipFuncAttributeMaxDynamicSharedMemorySize, LDS_BYTES) != hipSuccess) { fprintf(stderr, "kernel_launch: hipFuncSetAttribute failed\n"); grid = -1; return; }
        if (hipOccupancyMaxActiveBlocksPerMultiprocessor(&per_cu, (const void*)fwd, NTHR, LDS_BYTES) != hipSuccess || per_cu < 1) { fprintf(stderr, "kernel_launch: occupancy query says %d\n", per_cu); (void)hipGetLastError(); per_cu = 1; }
        grid = cus;
    }
    if (grid < 0) return;
    (void)hipMemsetAsync((char*)d_ws + WS_CTL, 0, CTL_BYTES, stream);
    Args a{};
    for (int i = 0; i < 16; ++i) a.in[i] = (const float*)d_in[i];
    a.out = (float*)d_out; a.ws = (unsigned char*)d_ws;
#if MK_ONE_LAUNCH
    a.ph_lo = 0; a.ph_hi = N_PHASES;
    hipLaunchKernelGGL(fwd, dim3(grid), dim3(NTHR), LDS_BYTES, stream, a);
#else
    for (int ph = 0; ph < N_PHASES; ++ph) {
        if (ph == 12 || ph == 13) continue;
        a.ph_lo = ph; a.ph_hi = ph + 1;
        hipLaunchKernelGGL(fwd, dim3(grid), dim3(NTHR), LDS_BYTES, stream, a);
    }
#endif
}
```

```cpp
#include <hip/hip_runtime.h>
#include <hip/hip_bf16.h>
#include <stdint.h>
#include <stdio.h>

#ifndef MK_ONE_LAUNCH
#define MK_ONE_LAUNCH 1
#endif

#ifndef PHMASK
#define PHMASK 0x1FFF
#endif
#define PHK(k) ((PHMASK >> (k)) & 1)
#ifndef REPEAT_KIND
#define REPEAT_KIND -1
#endif
#define REPS(k) ((k) == REPEAT_KIND ? 2 : 1)
#define LAS __attribute__((address_space(3)))
typedef __attribute__((ext_vector_type(8))) short bf16x8;
typedef __attribute__((ext_vector_type(16))) float f32x16;
typedef __attribute__((ext_vector_type(4))) float f32x4;
typedef __attribute__((ext_vector_type(4))) unsigned u32x4;
typedef __attribute__((ext_vector_type(2))) unsigned u32x2;
typedef unsigned short u16;

constexpr int D = 1024, BATCH = 2, SEQ = 8192, T = BATCH * SEQ, NH = 16, HD = 64;
constexpr int NE = 256, TOPK = 8, DF = 256;
constexpr int A_TOT = T * TOPK;
constexpr int MOBA_BLK = 256, MOBA_NB = SEQ / MOBA_BLK;
constexpr float DN_ALPHA = 1.4142135623730951f;
constexpr float LN_EPS = 1e-5f;
constexpr float LOG2E = 1.4426950408889634f;
constexpr float LN2 = 0.6931471805599453f;
constexpr float NEGV = -1e30f;
constexpr int NTHR = 512;

constexpr size_t al256(size_t x) { return (x + 255) & ~(size_t)255; }
constexpr size_t WS_CTL = 0;
constexpr size_t CTL_BYTES = 131072;
constexpr size_t CTL_CNT_OFF = 32768;
constexpr size_t CTL_ECNT_OFF = 65536;
constexpr int CNT_STRIDE = 32;
constexpr size_t WS_XB = WS_CTL + CTL_BYTES;
constexpr size_t WS_X1 = WS_XB + al256((size_t)T * D * 2);
constexpr size_t WS_X2 = WS_X1 + al256((size_t)T * D * 4);
constexpr size_t WS_YPRE = WS_X2 + al256((size_t)T * D * 4);
constexpr size_t WS_QKV = WS_YPRE + al256((size_t)T * D * 4);
constexpr size_t WS_VT = WS_QKV + al256((size_t)T * 9216 * 2);
constexpr size_t WS_KM = WS_VT + al256((size_t)3 * T * D * 2);
constexpr size_t WS_AO = WS_KM + al256((size_t)BATCH * NH * MOBA_NB * HD * 4);
constexpr size_t WS_OG = WS_AO + al256((size_t)T * D * 2);
constexpr size_t WS_LSE = WS_OG + al256((size_t)3 * T * D * 2);
constexpr size_t WS_TOPW = WS_LSE + al256((size_t)3 * T * NH * 4);
constexpr size_t WS_LIST = WS_TOPW + al256((size_t)T * TOPK * 4);
constexpr size_t WS_HB = WS_LIST + al256((size_t)NE * T * 4);
constexpr size_t WS_YB = WS_HB + al256((size_t)(A_TOT + T + 1) * DF * 2);
constexpr size_t WS_END = WS_YB + al256((size_t)(A_TOT + T + 1) * D * 2);
constexpr int TRASH_VA = A_TOT + T;
constexpr size_t WS_SELM = WS_END;
constexpr size_t WS_PART = WS_SELM + al256((size_t)T * NH * 4);
constexpr size_t WS_PLSE = WS_PART + al256((size_t)T * NH * 4 * 64 * 2);
constexpr size_t WS_WQK0 = WS_PLSE + al256((size_t)T * NH * 4 * 4);
constexpr size_t WS_WV0 = WS_WQK0 + (size_t)2048 * 1024 * 2;
constexpr size_t WS_WQK1 = WS_WV0 + (size_t)1024 * 1024 * 2;
constexpr size_t WS_WV1 = WS_WQK1 + (size_t)6144 * 1024 * 2;
constexpr size_t WS_WO = WS_WV1 + (size_t)3072 * 1024 * 2;
constexpr size_t WS_WSGU = WS_WO + (size_t)2 * 1024 * 1024 * 2;
constexpr size_t WS_WSD = WS_WSGU + (size_t)2 * 512 * 1024 * 2;
constexpr size_t WS_XB8 = WS_WSD + (size_t)2 * 1024 * 256 * 2;
constexpr size_t WS_HBS = WS_XB8 + (size_t)T * D;
constexpr size_t WS_WRH = WS_HBS + (size_t)T * DF * 2;
constexpr size_t WS_WRL = WS_WRH + (size_t)2 * 256 * 1024 * 2;
constexpr size_t WS_END2 = WS_WRL + (size_t)2 * 256 * 1024 * 2;

constexpr int LDP = 40;
constexpr int STAGE_BYTES = 2 * 256 * LDP * 2;
constexpr int LDS_ROWID = 2 * STAGE_BYTES;
constexpr int LDS_ROWW = LDS_ROWID + 1024;
constexpr int XS_PITCH = 1028;
constexpr int LDS_BYTES = 163840;
constexpr int LDS_BAR = 161792;

__device__ __forceinline__ int lane_id_() { int l; asm volatile("v_mbcnt_lo_u32_b32 %0, -1, 0\n\tv_mbcnt_hi_u32_b32 %0, -1, %0" : "=v"(l)); return l; }
__device__ __forceinline__ float shxf(float v, int m, int lane) { return __int_as_float(__builtin_amdgcn_ds_bpermute((lane ^ m) << 2, __float_as_int(v))); }
__device__ __forceinline__ int shxi(int v, int m, int lane) { return __builtin_amdgcn_ds_bpermute((lane ^ m) << 2, v); }
#define XB_TMO      128
#define XB_XCNT(j)  (256  + 64 * (j))
#define XB_XSUB(j)  (1280 + 64 * (j))
#define XB_XGEN(j)  (2304 + 64 * (j))
#define XB_TOP      3328
#define XB_TOPGEN   3392
#define XCD_BAR_WORDS 3456
#define XB_SPIN_CAP (1u << 18)
__device__ __forceinline__ unsigned xb_ld(unsigned* p)              { return __hip_atomic_load(p, __ATOMIC_RELAXED, __HIP_MEMORY_SCOPE_AGENT); }
__device__ __forceinline__ unsigned xb_add(unsigned* p, unsigned v) { return __hip_atomic_fetch_add(p, v, __ATOMIC_RELAXED, __HIP_MEMORY_SCOPE_AGENT); }
__device__ __forceinline__ unsigned xb_xcc_id() { return (unsigned)__builtin_amdgcn_s_getreg((3 << 11) | 20) & 0xFu; }
#define XB_SPIN(cond, bar) do { unsigned _sp = 0; while (cond) { __builtin_amdgcn_s_sleep(1); \
    if ((++_sp & 255u) == 0u) { if (xb_ld(&(bar)[XB_TMO])) break; if (_sp > XB_SPIN_CAP) { atomicAdd(&(bar)[XB_TMO], 1u); break; } } } } while (0)
struct XcdBarrier { unsigned* bar; unsigned x; volatile LAS unsigned* st; };
__device__ __forceinline__ XcdBarrier xcd_barrier_post(unsigned* bar, volatile LAS unsigned* st, const bool leader) {
    XcdBarrier b; b.bar = bar; b.x = xb_xcc_id(); b.st = st;
    if (leader) (void)xb_add(&bar[XB_XCNT(b.x)], 1u);
    return b;
}
__device__ __forceinline__ void xcd_barrier_complete(unsigned* bar, unsigned x, unsigned& nloc, unsigned& nx) {
    const unsigned G = gridDim.x * gridDim.y * gridDim.z;
    unsigned sum, cnt, mine, sp = 0u;
    for (;;) {
        sum = 0u; cnt = 0u; mine = 0u;
#pragma unroll
        for (unsigned j = 0; j < 16; ++j) { const unsigned c = xb_ld(&bar[XB_XCNT(j)]); sum += c; cnt += (c > 0u) ? 1u : 0u; mine = (j == x) ? c : mine; }
        if (sum == G) break;
        __builtin_amdgcn_s_sleep(1);
        if ((++sp & 255u) == 0u) { if (xb_ld(&bar[XB_TMO])) break; if (sp > XB_SPIN_CAP) { atomicAdd(&bar[XB_TMO], 1u); break; } }
    }
    nloc = mine > 0u ? mine : 1u; nx = cnt > 0u ? cnt : 1u;
}
__device__ __forceinline__ void xcd_barrier(const XcdBarrier& b, const bool leader) {
    asm volatile("s_waitcnt vmcnt(0)" ::: "memory");
    __syncthreads();
    if (leader) {
        unsigned* bar = b.bar;
        __builtin_amdgcn_s_waitcnt(0);
        unsigned nloc = b.st[0], nx = b.st[1];
        if (nloc == 0u) { xcd_barrier_complete(bar, b.x, nloc, nx); b.st[0] = nloc; b.st[1] = nx; }
        const unsigned old = xb_add(&bar[XB_XSUB(b.x)], 1u);
        const unsigned gen = old / nloc;
        if (old + 1u == (gen + 1u) * nloc) {
            __builtin_amdgcn_fence(__ATOMIC_RELEASE, "agent");
            asm volatile("s_waitcnt vmcnt(0)" ::: "memory");
            const unsigned og = xb_add(&bar[XB_TOP], 1u);
            const unsigned tg = og / nx;
            if (og + 1u == (tg + 1u) * nx) xb_add(&bar[XB_TOPGEN], 1u);
            else XB_SPIN(xb_ld(&bar[XB_TOPGEN]) == tg, bar);
            __builtin_amdgcn_fence(__ATOMIC_ACQUIRE, "agent");
            xb_add(&bar[XB_XGEN(b.x)], 1u);
            asm volatile("s_waitcnt vmcnt(0)" ::: "memory");
        } else {
            XB_SPIN(xb_ld(&bar[XB_XGEN(b.x)]) == gen, bar);
            __builtin_amdgcn_fence(__ATOMIC_ACQUIRE, "agent");
            asm volatile("s_waitcnt vmcnt(0)" ::: "memory");
        }
    }
    __syncthreads();
}

typedef __attribute__((ext_vector_type(2))) __bf16 bf16x2_t;
typedef __attribute__((ext_vector_type(2))) float f32x2_t;
__device__ __forceinline__ unsigned cvtpk(float lo, float hi) { f32x2_t f; f[0] = lo; f[1] = hi; return __builtin_bit_cast(unsigned, __builtin_convertvector(f, bf16x2_t)); }
__device__ __forceinline__ float bf2f(unsigned v16) { return __uint_as_float(v16 << 16); }
__device__ __forceinline__ int crow(int r, int hi) { return (r & 3) + 8 * (r >> 2) + 4 * hi; }
#define MFMA_BF16(a, b, c) __builtin_amdgcn_mfma_f32_32x32x16_bf16(a, b, c, 0, 0, 0)
__device__ __forceinline__ float wave_sum(float v) {
    v += __int_as_float(__builtin_amdgcn_update_dpp(0, __float_as_int(v), 0xB1, 0xF, 0xF, true));
    v += __int_as_float(__builtin_amdgcn_update_dpp(0, __float_as_int(v), 0x4E, 0xF, 0xF, true));
    v += __int_as_float(__builtin_amdgcn_update_dpp(0, __float_as_int(v), 0x141, 0xF, 0xF, true));
    v += __int_as_float(__builtin_amdgcn_update_dpp(0, __float_as_int(v), 0x140, 0xF, 0xF, true));
    const int vi = __float_as_int(v);
    return (__int_as_float(__builtin_amdgcn_readlane(vi, 0)) + __int_as_float(__builtin_amdgcn_readlane(vi, 16))) + (__int_as_float(__builtin_amdgcn_readlane(vi, 32)) + __int_as_float(__builtin_amdgcn_readlane(vi, 48)));
}

namespace pg8 {
#define PG8_LAS __attribute__((address_space(3)))
typedef unsigned short bf16_t;
typedef short bf16x8 __attribute__((ext_vector_type(8)));
typedef float f32x4 __attribute__((ext_vector_type(4)));
typedef unsigned u32x4 __attribute__((ext_vector_type(4)));
constexpr int BM = 256, BK = 64, HALF = 128, HTB = HALF * BK * 2  , STAGE_BYTES = 8 * HTB, NXCD = 8, WGM = 8;

__host__ __device__ __forceinline__ int lds_byte(int r, int c) { const int st = (r >> 4) * 2 + (c >> 5), rr = r & 15, cc = c & 31, ob = rr * 64 + cc * 2; return st * 1024 + (ob ^ (((ob >> 9) & 1) << 5)); }
__host__ __device__ __forceinline__ void stage_rc(int b, int& R, int& C) { const int st = b / 1024, sb = b % 1024, swz = sb ^ (((sb >> 9) & 1) << 5); R = (st >> 1) * 16 + swz / 64; C = (st & 1) * 32 + (swz % 64) / 2; }
__host__ __device__ __forceinline__ int perm32(int rho) { const int n = rho >> 4, i = rho & 15; return 8 * (i >> 2) + 4 * n + (i & 3); }

struct Unit { int pm, pn; };
struct Gemm { const bf16_t* A; const bf16_t* Bt; int M, N, K; };
struct FixedOrder {
    int pm, pn;
    __device__ __forceinline__ bool next(int i, Unit& u) const { if (i != 0) return false; u.pm = pm; u.pn = pn; return true; }
    __device__ __forceinline__ void a_ready(const Unit&) const {}
    __device__ __forceinline__ void done(const Unit&) const {}
};

struct StaticOrder {
    int nM, nN, nwg, G, c;
    __host__ __device__ void init(int M, int N, int G_, int c_) { nM = M / BM; nN = N / BM; nwg = nM * nN; G = G_; c = c_; }
    __host__ __device__ bool next(int i, Unit& u) const {
        const long L = (long)i * G + c; if (L >= nwg) return false;
        int wgid = (int)L; { const int q = nwg / NXCD, r = nwg % NXCD, xcd = wgid % NXCD, off = wgid / NXCD; wgid = (xcd < r ? xcd * (q + 1) : r * (q + 1) + (xcd - r) * q) + off; }
        const int nig = WGM * nN, gid = wgid / nig, fm = gid * WGM, gsz = (nM - fm) < WGM ? (nM - fm) : WGM;
        u.pm = fm + ((wgid % nig) % gsz); u.pn = (wgid % nig) / gsz; return true;
    }
    __device__ __forceinline__ void a_ready(const Unit&) const {}
    __device__ __forceinline__ void done(const Unit&) const {}
};

template <class Epi, class Sched, bool SWAP = false, bool STAMP = false>
__device__ __forceinline__ void gemm_phase(PG8_LAS unsigned char* lds, const Gemm g, const Sched& S, const Epi& E, unsigned long long* stamps, const int tid_in) {
    int tid_ = tid_in; asm volatile("" : "+v"(tid_));
    const int tid = tid_, wid = __builtin_amdgcn_readfirstlane(tid >> 6), lane = tid & 63, wr = wid >> 2, wc = wid & 3, fr = lane & 15, fq = lane >> 4;
    const int K = g.K, nt = K / BK;
    int ts_lo = 0, ts_hi = 0, nts = 0; const unsigned long long rt_entry = STAMP ? (unsigned long long)wall_clock64() : 0ull;
#define PG8_STAMP() do { if (STAMP && wid == 0 && nts < 64) { const unsigned long long _c = (unsigned long long)clock64(); \
        ts_lo = (lane == nts) ? (int)(unsigned)_c : ts_lo; ts_hi = (lane == nts) ? (int)(unsigned)(_c >> 32) : ts_hi; ++nts; } } while (0)
    PG8_STAMP();
    unsigned voffA[2], voffB[2];
#pragma unroll
    for (int i = 0; i < 2; ++i) { int R, C; stage_rc(tid * 16 + i * 8192, R, C); const int Rb = Epi::PERM ? ((R & ~31) + perm32(R & 31)) : R;
        voffA[i] = (unsigned)(R * K + C) * 2u; voffB[i] = (unsigned)(Rb * K + C) * 2u; }
    const size_t kstep = (size_t)(BK * 2);
    const size_t hstep = (size_t)HALF * K * 2;
    const size_t tstep = 2 * hstep;
    const unsigned ldsw = (unsigned)wid * 1024u;
    const int aoff = lds_byte(wr * 64 + fr, fq * 8), boff = lds_byte(wc * 32 + fr, fq * 8);
#define PG8_SA(b, h) (((b) * 2 + (h)) * HTB)
#define PG8_SB(b, h) ((4 + (b) * 2 + (h)) * HTB)
#define PG8_STAGE(bufoff, gbase, voff) do { _Pragma("unroll") for (int _i = 0; _i < 2; ++_i) \
        __builtin_amdgcn_global_load_lds((const unsigned*)((const char*)(gbase) + (voff)[_i]), (PG8_LAS unsigned*)(lds + (bufoff) + ldsw + _i * 8192), 16, 0, 0); } while (0)
#define PG8_LDA(dst, b, h) do { _Pragma("unroll") for (int m = 0; m < 4; ++m) _Pragma("unroll") for (int k = 0; k < 2; ++k) dst[m][k] = *(const PG8_LAS bf16x8*)(lds + PG8_SA(b, h) + aoff + m * 2048 + k * 1024); } while (0)
#define PG8_LDB(dst, b, h) do { _Pragma("unroll") for (int n = 0; n < 2; ++n) _Pragma("unroll") for (int k = 0; k < 2; ++k) dst[n][k] = *(const PG8_LAS bf16x8*)(lds + PG8_SB(b, h) + boff + n * 2048 + k * 1024); } while (0)
#define PG8_MMA(ai, bj, At, Bt) do { __builtin_amdgcn_s_setprio(1); _Pragma("unroll") for (int m = 0; m < 4; ++m) _Pragma("unroll") for (int n = 0; n < 2; ++n) _Pragma("unroll") for (int k = 0; k < 2; ++k) \
        acc[ai][bj][m][n] = SWAP ? __builtin_amdgcn_mfma_f32_16x16x32_bf16(At[m][k], Bt[n][k], acc[ai][bj][m][n], 0, 0, 0) : __builtin_amdgcn_mfma_f32_16x16x32_bf16(Bt[n][k], At[m][k], acc[ai][bj][m][n], 0, 0, 0); __builtin_amdgcn_s_setprio(0); } while (0)
#define PG8_WAIT_V(n) asm volatile("s_waitcnt vmcnt(" #n ")" ::: "memory")
#define PG8_WAIT_L(n) asm volatile("s_waitcnt lgkmcnt(" #n ")" ::: "memory")
#define PG8_BAR __builtin_amdgcn_s_barrier()
#define PG8_SCHED __builtin_amdgcn_sched_barrier(0)
    Unit cur, nxt; int ui = 0;
    if (!S.next(0, cur)) return;
    f32x4 acc[2][2][4][2];
#pragma unroll
    for (int a = 0; a < 2; ++a)
#pragma unroll
        for (int b = 0; b < 2; ++b)
#pragma unroll
            for (int m = 0; m < 4; ++m)
#pragma unroll
                for (int n = 0; n < 2; ++n) acc[a][b][m][n] = (f32x4){0.f, 0.f, 0.f, 0.f};
    bf16x8 At[4][2], B0[2][2], B1[2][2];
    const char* cA = (const char*)g.A + (size_t)cur.pm * tstep; const char* cB = (const char*)g.Bt + (size_t)cur.pn * tstep;
    S.a_ready(cur);
    PG8_STAGE(PG8_SB(0, 0), cB, voffB); PG8_STAGE(PG8_SA(0, 0), cA, voffA); PG8_STAGE(PG8_SB(0, 1), cB + hstep, voffB); PG8_STAGE(PG8_SA(0, 1), cA + hstep, voffA);
    if (wr == 1) PG8_BAR;
    PG8_WAIT_V(4); PG8_BAR;
    PG8_STAGE(PG8_SB(1, 0), cB + kstep, voffB); PG8_STAGE(PG8_SA(1, 0), cA + kstep, voffA); PG8_STAGE(PG8_SB(1, 1), cB + hstep + kstep, voffB);
    PG8_WAIT_V(6); PG8_BAR;
    PG8_STAMP();
    for (;;) {
        const bool has_next = S.next(ui + 1, nxt);
        const char* nA = has_next ? (const char*)g.A + (size_t)nxt.pm * tstep : cA; const char* nB = has_next ? (const char*)g.Bt + (size_t)nxt.pn * tstep : cB;
        for (int t = 0; t < nt; t += 2) {
            const bool last = (t == nt - 2);
            const char* a1 = cA + (size_t)(t + 1) * kstep;
            const char* a2 = last ? nA : cA + (size_t)(t + 2) * kstep; const char* b2 = last ? nB : cB + (size_t)(t + 2) * kstep;
            const char* a3 = a2 + kstep; const char* b3 = b2 + kstep;
            if (last && has_next) S.a_ready(nxt);
            PG8_LDB(B0, 0, 0); PG8_SCHED; PG8_LDA(At, 0, 0); PG8_STAGE(PG8_SA(1, 1), a1 + hstep, voffA);
            PG8_WAIT_L(8); PG8_BAR; PG8_WAIT_L(0); PG8_MMA(0, 0, At, B0); PG8_BAR; PG8_SCHED;
            PG8_LDB(B1, 0, 1); PG8_STAGE(PG8_SB(0, 0), b2, voffB);
            PG8_BAR; PG8_WAIT_L(0); PG8_MMA(0, 1, At, B1); PG8_BAR;
            PG8_LDA(At, 0, 1); PG8_STAGE(PG8_SA(0, 0), a2, voffA);
            PG8_BAR; PG8_WAIT_L(0); PG8_MMA(1, 0, At, B0); PG8_BAR; PG8_SCHED;
            PG8_STAGE(PG8_SB(0, 1), b2 + hstep, voffB);
            PG8_WAIT_V(6); PG8_BAR; PG8_MMA(1, 1, At, B1); PG8_BAR;
            PG8_LDB(B0, 1, 0); PG8_SCHED; PG8_LDA(At, 1, 0); PG8_STAGE(PG8_SA(0, 1), a2 + hstep, voffA);
            PG8_WAIT_L(8); PG8_BAR; PG8_WAIT_L(0); PG8_MMA(0, 0, At, B0); PG8_BAR; PG8_SCHED;
            PG8_LDB(B1, 1, 1); PG8_STAGE(PG8_SB(1, 0), b3, voffB);
            PG8_BAR; PG8_WAIT_L(0); PG8_MMA(0, 1, At, B1); PG8_BAR;
            PG8_LDA(At, 1, 1); PG8_STAGE(PG8_SA(1, 0), a3, voffA);
            PG8_BAR; PG8_WAIT_L(0); PG8_MMA(1, 0, At, B0); PG8_BAR; PG8_SCHED;
            PG8_STAGE(PG8_SB(1, 1), b3 + hstep, voffB);
            PG8_WAIT_V(6); PG8_BAR; PG8_MMA(1, 1, At, B1); PG8_BAR;
        }
        PG8_STAMP();
        if constexpr (!Epi::AFTER_DRAIN) { E(acc, cur, wr, wc, fr, fq); S.done(cur); }
        PG8_STAMP();
        if (!has_next) break;
#pragma unroll
        for (int a = 0; a < 2; ++a)
#pragma unroll
            for (int b = 0; b < 2; ++b)
#pragma unroll
                for (int m = 0; m < 4; ++m)
#pragma unroll
                    for (int n = 0; n < 2; ++n) acc[a][b][m][n] = (f32x4){0.f, 0.f, 0.f, 0.f};
        cur = nxt; cA = nA; cB = nB; ++ui;
    }
    PG8_WAIT_V(0);
    if (wr == 0) PG8_BAR;
    PG8_BAR;
    if constexpr (Epi::AFTER_DRAIN) { E.fused(acc, cur, wr, wc, fr, fq, lds, wid, lane); S.done(cur); }
    PG8_STAMP();
    if (STAMP && wid == 0) { stamps[lane] = lane < nts ? (((unsigned long long)(unsigned)ts_hi << 32) | (unsigned)ts_lo) : 0ull;
        if (lane == 62) stamps[62] = rt_entry; if (lane == 63) stamps[63] = (unsigned long long)wall_clock64(); }
#undef PG8_STAMP
#undef PG8_SA
#undef PG8_SB
#undef PG8_STAGE
#undef PG8_LDA
#undef PG8_LDB
#undef PG8_MMA
#undef PG8_WAIT_V
#undef PG8_WAIT_L
#undef PG8_BAR
#undef PG8_SCHED
}
}

struct EpiQK {
    static constexpr bool PERM = true, AFTER_DRAIN = false;
    u16* O; int ldc;
    __device__ __forceinline__ void operator()(const pg8::f32x4 (&acc)[2][2][4][2], const pg8::Unit& u, int wr, int wc, int fr, int fq) const {
        const int col0 = u.pn * 256 + wc * 32 + 8 * fq, row0 = u.pm * 256 + wr * 64 + fr;
#pragma unroll
        for (int ai = 0; ai < 2; ++ai)
#pragma unroll
            for (int m = 0; m < 4; ++m) { u16* rowp = O + (size_t)(row0 + ai * 128 + m * 16) * ldc + col0;
#pragma unroll
                for (int bj = 0; bj < 2; ++bj) { const pg8::f32x4 v0 = acc[ai][bj][m][0], v1 = acc[ai][bj][m][1];
                    u32x4 w; w[0] = cvtpk(v0[0], v0[1]); w[1] = cvtpk(v0[2], v0[3]); w[2] = cvtpk(v1[0], v1[1]); w[3] = cvtpk(v1[2], v1[3]);
                    *(u32x4*)(rowp + bj * 128) = w; } }
    }
};
struct EpiV {
    static constexpr bool PERM = false, AFTER_DRAIN = false;
    u16* VT; int layer;
    __device__ __forceinline__ void operator()(const pg8::f32x4 (&acc)[2][2][4][2], const pg8::Unit& u, int wr, int wc, int fr, int fq) const {
        const int colt = u.pn * 256, grp = colt >> 10;
        const int dil = (layer == 0 || grp == 0) ? 1 : (grp == 1 ? 4 : 16);
        const int rowb = u.pm * 256 + wr * 64 + 4 * fq;
#pragma unroll
        for (int bj = 0; bj < 2; ++bj)
#pragma unroll
            for (int n = 0; n < 2; ++n) {
                const int c = (colt & 1023) + bj * 128 + wc * 32 + n * 16 + fr, h = c >> 6, d = c & 63;
#pragma unroll
                for (int ai = 0; ai < 2; ++ai)
#pragma unroll
                    for (int m = 0; m < 4; ++m) {
                        const int r0 = rowb + ai * 128 + m * 16, b = r0 >> 13, t0 = r0 & (SEQ - 1);
                        u16* vrow = VT + (size_t)grp * T * D + ((size_t)(b * NH + h) * HD + d) * SEQ;
                        const pg8::f32x4 v = acc[ai][bj][m][n];
                        if (dil == 1) { u32x2 w; w[0] = cvtpk(v[0], v[1]); w[1] = cvtpk(v[2], v[3]); *(u32x2*)(vrow + t0) = w; }
                        else {
#pragma unroll
                            for (int i = 0; i < 4; ++i) { const int pp = t0 + i; vrow[(pp % dil) * (SEQ / dil) + pp / dil] = (u16)cvtpk(v[i], 0.f); }
                        }
                    }
            }
    }
};
struct EpiWo {
    static constexpr bool PERM = false, AFTER_DRAIN = false;
    u16* Y; const u16* X;
    __device__ __forceinline__ void operator()(const pg8::f32x4 (&acc)[2][2][4][2], const pg8::Unit& u, int wr, int wc, int fr, int fq) const {
        const int row0 = u.pm * 256 + wr * 64 + fr, col0 = u.pn * 256 + wc * 32 + 4 * fq;
#pragma unroll
        for (int ai = 0; ai < 2; ++ai)
#pragma unroll
            for (int m = 0; m < 4; ++m) { const size_t ro = (size_t)(row0 + ai * 128 + m * 16) * D + col0;
#pragma unroll
                for (int bj = 0; bj < 2; ++bj)
#pragma unroll
                    for (int n = 0; n < 2; ++n) { const u32x2 xr = *(const u32x2*)(X + ro + bj * 128 + n * 16); const pg8::f32x4 a4 = acc[ai][bj][m][n];
                        u32x2 w; w[0] = cvtpk(bf2f(xr[0] & 0xFFFFu) * DN_ALPHA + a4[0], bf2f(xr[0] >> 16) * DN_ALPHA + a4[1]); w[1] = cvtpk(bf2f(xr[1] & 0xFFFFu) * DN_ALPHA + a4[2], bf2f(xr[1] >> 16) * DN_ALPHA + a4[3]);
                        *(u32x2*)(Y + ro + bj * 128 + n * 16) = w; } }
    }
};
struct EpiSGU {
    static constexpr bool PERM = true, AFTER_DRAIN = false;
    u16* H;
    __device__ __forceinline__ void operator()(const pg8::f32x4 (&acc)[2][2][4][2], const pg8::Unit& u, int wr, int wc, int fr, int fq) const {
        const int row0 = u.pm * 256 + wr * 64 + fr, f0 = u.pn * 128 + wc * 32 + 8 * fq;
#pragma unroll
        for (int ai = 0; ai < 2; ++ai)
#pragma unroll
            for (int m = 0; m < 4; ++m) {
                float hv[8];
#pragma unroll
                for (int n = 0; n < 2; ++n)
#pragma unroll
                    for (int i = 0; i < 4; ++i) { const float gt = acc[ai][0][m][n][i], up = acc[ai][1][m][n][i]; hv[n * 4 + i] = gt / (1.f + __expf(-gt)) * up; }
                u32x4 w; w[0] = cvtpk(hv[0], hv[1]); w[1] = cvtpk(hv[2], hv[3]); w[2] = cvtpk(hv[4], hv[5]); w[3] = cvtpk(hv[6], hv[7]);
                *(u32x4*)(H + (size_t)(row0 + ai * 128 + m * 16) * DF + f0) = w;
            }
    }
};
struct EpiSD {
    static constexpr bool PERM = true, AFTER_DRAIN = false;
    u16* Y;
    __device__ __forceinline__ void operator()(const pg8::f32x4 (&acc)[2][2][4][2], const pg8::Unit& u, int wr, int wc, int fr, int fq) const {
        const int row0 = u.pm * 256 + wr * 64 + fr, col0 = u.pn * 256 + wc * 32 + 8 * fq;
#pragma unroll
        for (int ai = 0; ai < 2; ++ai)
#pragma unroll
            for (int m = 0; m < 4; ++m) { u16* rowp = Y + (size_t)(A_TOT + row0 + ai * 128 + m * 16) * D + col0;
#pragma unroll
                for (int bj = 0; bj < 2; ++bj) { const pg8::f32x4 v0 = acc[ai][bj][m][0], v1 = acc[ai][bj][m][1];
                    u32x4 w; w[0] = cvtpk(v0[0], v0[1]); w[1] = cvtpk(v0[2], v0[3]); w[2] = cvtpk(v1[0], v1[1]); w[3] = cvtpk(v1[2], v1[3]);
                    *(u32x4*)(rowp + bj * 128) = w; } }
    }
};

struct Args {
    const float* in[16];
    float* out;
    unsigned char* ws;
    int ph_lo, ph_hi;
};

#define GEMM_CORE(K_, PA0, PA1, PB, LDB)                                                                                                   \
    {                                                                                                                                      \
        const int g_tid = tid, g_lane = lane, g_wave = wave, g_r32 = r32, g_hi = hi;                   \
        const int g_wm = g_wave >> 2, g_wn = g_wave & 3, g_kc = g_tid & 3, g_kq = g_lane >> 3, g_n4 = g_lane & 7;                           \
        const u16* g_pa0 = (PA0); const u16* g_pa1 = (PA1);                                                                                \
        const size_t g_ldb = (size_t)(LDB);                                                                                                \
        const float* g_pb = (PB) + (size_t)(g_kq * 4) * g_ldb + g_n4 * 4;                                                                  \
        const int g_nk = (K_) / 32;                                                                                                        \
        u32x4 g_ra0, g_ra1; f32x4 g_rb0, g_rb1, g_rb2, g_rb3;                                                                              \
        const u32x4 g_z = {0u, 0u, 0u, 0u};                                                                                                \
        _Pragma("unroll") for (int mb = 0; mb < 4; ++mb) { _Pragma("unroll") for (int nb = 0; nb < 2; ++nb) { _Pragma("unroll") for (int r = 0; r < 16; ++r) acc[mb][nb][r] = 0.f; } } \
        g_ra0 = g_pa0 ? *(const u32x4*)(g_pa0 + g_kc * 8) : g_z; g_ra1 = g_pa1 ? *(const u32x4*)(g_pa1 + g_kc * 8) : g_z;                 \
        g_rb0 = *(const f32x4*)(g_pb); g_rb1 = *(const f32x4*)(g_pb + g_ldb); g_rb2 = *(const f32x4*)(g_pb + 2 * g_ldb); g_rb3 = *(const f32x4*)(g_pb + 3 * g_ldb); \
        _Pragma("unroll 1") for (int kt = 0; kt < g_nk; ++kt) {                                                                            \
            LAS char* As = lds + (kt & 1) * STAGE_BYTES; LAS char* Bs = As + 256 * LDP * 2;                                                \
            *(LAS u32x4*)(As + ((g_tid >> 2) * LDP + g_kc * 8) * 2) = g_ra0;                                                               \
            *(LAS u32x4*)(As + (((g_tid >> 2) + 128) * LDP + g_kc * 8) * 2) = g_ra1;                                                       \
            _Pragma("unroll") for (int i = 0; i < 4; ++i) {                                                                                \
                u32x2 w; w[0] = cvtpk(g_rb0[i], g_rb1[i]); w[1] = cvtpk(g_rb2[i], g_rb3[i]);                                               \
                *(LAS u32x2*)(Bs + ((g_wave * 32 + i * 8 + g_n4) * LDP + g_kq * 4) * 2) = w;                                               \
            }                                                                                                                              \
            __syncthreads();                                                                                                               \
            if (kt + 1 < g_nk) {                                                                                                           \
                const int ko = (kt + 1) * 32;                                                                                              \
                g_ra0 = g_pa0 ? *(const u32x4*)(g_pa0 + ko + g_kc * 8) : g_z; g_ra1 = g_pa1 ? *(const u32x4*)(g_pa1 + ko + g_kc * 8) : g_z; \
                const float* pbk = g_pb + (size_t)ko * g_ldb;                                                                              \
                g_rb0 = *(const f32x4*)(pbk); g_rb1 = *(const f32x4*)(pbk + g_ldb); g_rb2 = *(const f32x4*)(pbk + 2 * g_ldb); g_rb3 = *(const f32x4*)(pbk + 3 * g_ldb); \
            }                                                                                                                              \
            _Pragma("unroll") for (int s = 0; s < 2; ++s) {                                                                                \
                bf16x8 af[4], bfr[2];                                                                                                      \
                _Pragma("unroll") for (int mb = 0; mb < 4; ++mb) af[mb] = *(LAS bf16x8*)(As + ((g_wm * 128 + mb * 32 + g_r32) * LDP + s * 16 + g_hi * 8) * 2); \
                _Pragma("unroll") for (int nb = 0; nb < 2; ++nb) bfr[nb] = *(LAS bf16x8*)(Bs + (((g_wn * 2 + nb) * 32 + g_r32) * LDP + s * 16 + g_hi * 8) * 2); \
                _Pragma("unroll") for (int mb = 0; mb < 4; ++mb) { _Pragma("unroll") for (int nb = 0; nb < 2; ++nb) acc[mb][nb] = MFMA_BF16(af[mb], bfr[nb], acc[mb][nb]); } \
            }                                                                                                                              \
        }                                                                                                                                  \
        __syncthreads();                                                                                                                   \
    }

struct AttnSt { float m, l; f32x16 o0, o1; };

struct AttnFr { bf16x8 k[4]; bf16x8 v[4]; };
__device__ __forceinline__ void attn_load(AttnFr& f, const u16* krow, const u16* vt, size_t vt_dstride) {
#pragma unroll
    for (int d0 = 0; d0 < 4; ++d0) f.k[d0] = *(const bf16x8*)(krow + d0 * 16);
    const u16* vt1 = vt + 32 * vt_dstride;
    union { bf16x8 v; u32x2 h[2]; } va;
    va.h[0] = *(const u32x2*)(vt);       va.h[1] = *(const u32x2*)(vt + 8);   f.v[0] = va.v;
    va.h[0] = *(const u32x2*)(vt + 16);  va.h[1] = *(const u32x2*)(vt + 24);  f.v[1] = va.v;
    va.h[0] = *(const u32x2*)(vt1);      va.h[1] = *(const u32x2*)(vt1 + 8);  f.v[2] = va.v;
    va.h[0] = *(const u32x2*)(vt1 + 16); va.h[1] = *(const u32x2*)(vt1 + 24); f.v[3] = va.v;
}
__device__ __forceinline__ void attn_compute(AttnSt& st, const bf16x8 (&qf)[4], const AttnFr& f, int dist0, float bslope, int dlo, int dhi, int hi, int lane) {
    f32x16 p;
#pragma unroll
    for (int r = 0; r < 16; ++r) p[r] = 0.f;
#pragma unroll
    for (int d0 = 0; d0 < 4; ++d0) p = MFMA_BF16(f.k[d0], qf[d0], p);
    constexpr float C2 = 0.125f * LOG2E;
    float mx = NEGV;
#pragma unroll
    for (int r = 0; r < 16; ++r) {
        const int dist = dist0 - ((r & 3) + 8 * (r >> 2));
        const float sc = __builtin_fmaf(p[r], C2, -bslope * (float)dist);
        const float s_ = (dist >= dlo && dist <= dhi) ? sc : NEGV;
        p[r] = s_; mx = fmaxf(mx, s_);
    }
    mx = fmaxf(mx, shxf(mx, 32, lane));
    const float mnew = fmaxf(st.m, mx);
    const float alpha = __builtin_amdgcn_exp2f(st.m - mnew);
    st.m = mnew;
    float ls = 0.f;
#pragma unroll
    for (int r = 0; r < 16; ++r) { p[r] = __builtin_amdgcn_exp2f(p[r] - mnew); ls += p[r]; }
    st.l = st.l * alpha + ls;
#pragma unroll
    for (int r = 0; r < 16; ++r) { st.o0[r] *= alpha; st.o1[r] *= alpha; }
    union { bf16x8 v; unsigned u[4]; } pb0, pb1;
#pragma unroll
    for (int j = 0; j < 4; ++j) { pb0.u[j] = cvtpk(p[2 * j], p[2 * j + 1]); pb1.u[j] = cvtpk(p[8 + 2 * j], p[8 + 2 * j + 1]); }
    st.o0 = MFMA_BF16(f.v[0], pb0.v, st.o0);
    st.o0 = MFMA_BF16(f.v[1], pb1.v, st.o0);
    st.o1 = MFMA_BF16(f.v[2], pb0.v, st.o1);
    st.o1 = MFMA_BF16(f.v[3], pb1.v, st.o1);
    (void)hi;
}

__device__ __forceinline__ float dpp_rowmax(float v) {
    v = fmaxf(v, __int_as_float(__builtin_amdgcn_update_dpp(0, __float_as_int(v), 0xB1, 0xF, 0xF, true)));
    v = fmaxf(v, __int_as_float(__builtin_amdgcn_update_dpp(0, __float_as_int(v), 0x4E, 0xF, 0xF, true)));
    v = fmaxf(v, __int_as_float(__builtin_amdgcn_update_dpp(0, __float_as_int(v), 0x141, 0xF, 0xF, true)));
    v = fmaxf(v, __int_as_float(__builtin_amdgcn_update_dpp(0, __float_as_int(v), 0x140, 0xF, 0xF, true)));
    return v;
}
__device__ __forceinline__ int dpp_rowmin_i(int v) {
    v = min(v, __builtin_amdgcn_update_dpp(0, v, 0xB1, 0xF, 0xF, true));
    v = min(v, __builtin_amdgcn_update_dpp(0, v, 0x4E, 0xF, 0xF, true));
    v = min(v, __builtin_amdgcn_update_dpp(0, v, 0x141, 0xF, 0xF, true));
    v = min(v, __builtin_amdgcn_update_dpp(0, v, 0x140, 0xF, 0xF, true));
    return v;
}
__device__ __forceinline__ float rl_f(float v, int l) { return __int_as_float(__builtin_amdgcn_readlane(__float_as_int(v), l)); }

__device__ __forceinline__ void top3_insert(float v, int i, float& v0, int& i0, float& v1, int& i1, float& v2, int& i2) {
    const bool b0 = (v > v0) || (v == v0 && i < i0);
    const bool b1 = (v > v1) || (v == v1 && i < i1);
    const bool b2 = (v > v2) || (v == v2 && i < i2);
    const float nv2 = b1 ? v1 : (b2 ? v : v2); const int ni2 = b1 ? i1 : (b2 ? i : i2);
    const float nv1 = b0 ? v0 : (b1 ? v : v1); const int ni1 = b0 ? i0 : (b1 ? i : i1);
    const float nv0 = b0 ? v : v0;             const int ni0 = b0 ? i : i0;
    v0 = nv0; i0 = ni0; v1 = nv1; i1 = ni1; v2 = nv2; i2 = ni2;
}

__device__ __forceinline__ void ln_row(float (&v)[16], const float* __restrict__ g, const float* __restrict__ b, int lane) {
    float s = 0.f;
#pragma unroll
    for (int i = 0; i < 16; ++i) s += v[i];
    const float mu = wave_sum(s) * (1.f / D);
    float q = 0.f;
#pragma unroll
    for (int i = 0; i < 16; ++i) { const float d = v[i] - mu; q += d * d; }
    const float rstd = rsqrtf(wave_sum(q) * (1.f / D) + LN_EPS);
#pragma unroll
    for (int j = 0; j < 4; ++j) {
        const f32x4 gg = *(const f32x4*)(g + j * 256 + lane * 4), bb = *(const f32x4*)(b + j * 256 + lane * 4);
#pragma unroll
        for (int c = 0; c < 4; ++c) v[j * 4 + c] = (v[j * 4 + c] - mu) * rstd * gg[c] + bb[c];
    }
}

typedef __attribute__((ext_vector_type(2))) float f32x2_;
__device__ __forceinline__ bf16x8 fp8x8_to_bf16(unsigned lo, unsigned hi_) {
    const f32x2_ a = __builtin_amdgcn_cvt_pk_f32_fp8((int)lo, false), b = __builtin_amdgcn_cvt_pk_f32_fp8((int)lo, true);
    const f32x2_ c = __builtin_amdgcn_cvt_pk_f32_fp8((int)hi_, false), d = __builtin_amdgcn_cvt_pk_f32_fp8((int)hi_, true);
    union { bf16x8 v; unsigned u[4]; } r;
    r.u[0] = cvtpk(a[0], a[1]); r.u[1] = cvtpk(b[0], b[1]); r.u[2] = cvtpk(c[0], c[1]); r.u[3] = cvtpk(d[0], d[1]);
    return r.v;
}
__device__ __forceinline__ unsigned pack_fp8x4(float a, float b, float c, float d) { int p = __builtin_amdgcn_cvt_pk_fp8_f32(a, b, 0, false); return (unsigned)__builtin_amdgcn_cvt_pk_fp8_f32(c, d, p, true); }

constexpr float Y8_SCALE = 16.f;
constexpr int MOE_XCAP = 576;
#define MOE_GAS __attribute__((address_space(1)))
typedef MOE_GAS unsigned char moe_gcb;
constexpr int MOE_BP = 72;
constexpr int MOE_BSTAGE = 128 * MOE_BP * 2;
constexpr int MOE_LDS_VA = 3 * MOE_BSTAGE;
constexpr int MOE_LDS_W = MOE_LDS_VA + 4096;
constexpr int MOE_LDS_XCH = 65536;
template <bool DOWN>
__device__ __forceinline__ void moe_expert(LAS char* lds, const int tid, const int lane, const int wave, const int r32, const int hi,
                                           const unsigned char* __restrict__ abase  , const float* __restrict__ w0, const float* __restrict__ w1, const int ng  , void* __restrict__ outv,
                                           const int pass0, const int npass_, const int st0, const int nstl  , const bool y8 = false  ,
                                           const bool xr = false  ) {
    constexpr int KT = DOWN ? 4 : 16, NP = DOWN ? 8 : 4, LDB = DOWN ? 1024 : 256, APITCH = DOWN ? 256 : 1024  , PSTEP = DOWN ? 128 : 64;
    LAS int* rowva = (LAS int*)(lds + MOE_LDS_VA); LAS float* roww = (LAS float*)(lds + MOE_LDS_W);
    const int nst = nstl;
    const int nsteps = npass_ * nst * KT; (void)NP;
    unsigned aoff[2];
#define MOE_AOFF(ST_) { _Pragma("unroll") for (int a = 0; a < 2; ++a) { const int va_ = rowva[(ST_) * 512 + wave * 64 + a * 32 + r32]; \
        const int srow_ = DOWN ? va_ : (va_ == TRASH_VA ? 0 : (va_ >> 3)); aoff[a] = (unsigned)srow_ * APITCH + hi * 32; } }
    const int seg = wave >> 1, n4 = lane & 7, kp = (wave & 1) * 16 + (lane >> 3);
    const char* wbase = (const char*)(DOWN ? (w0 + seg * 32) : (((seg < 2) ? w0 : w1) + (seg & 1) * 32));
    unsigned boff = (unsigned)(4 * n4 + 2 * kp * LDB) * 4u; asm volatile("" : "+v"(boff));
    unsigned wb_ = (unsigned)((seg * 32 + n4) * MOE_BP + 2 * kp) * 2u; asm volatile("" : "+v"(wb_));
    unsigned lb_ = (unsigned)(r32 * MOE_BP + hi * 32) * 2u; asm volatile("" : "+v"(lb_));
    f32x16 acc[2][4];
#pragma unroll
    for (int a = 0; a < 2; ++a)
#pragma unroll
        for (int c = 0; c < 4; ++c)
#pragma unroll
            for (int r = 0; r < 16; ++r) acc[a][c][r] = 0.f;
    u32x4 fa8[2][2];
    f32x16 accx; u32x4 fa8x[2]; unsigned aoffx = 0u;
#pragma unroll
    for (int r = 0; r < 16; ++r) accx[r] = 0.f;
    fa8x[0] = u32x4{0u, 0u, 0u, 0u}; fa8x[1] = u32x4{0u, 0u, 0u, 0u};
    f32x4 rb0[4], rb1[4];
#define MOE_DEC(S_) const int s2_ = (S_) < nsteps ? (S_) : 0; const int pl_ = s2_ / (nst * KT); const int rm_ = s2_ - pl_ * (nst * KT); const int sl_ = rm_ / KT; const int kt_ = rm_ - sl_ * KT; const int ps_ = pass0 + pl_; const int stt_ = st0 + sl_;
#define MOE_LOADB(S_, RB) { MOE_DEC(S_) (void)stt_; \
        uint64_t wu_ = (uint64_t)(wbase + (size_t)(ps_ * PSTEP + kt_ * 64 * LDB) * 4), wv_ = wu_ + 16 * LDB * 4; asm volatile("" : "+s"(wu_), "+s"(wv_));     \
        const moe_gcb* wug_ = (const moe_gcb*)wu_; const moe_gcb* wvg_ = (const moe_gcb*)wv_; \
        unsigned bo_ = boff; asm volatile("" : "+v"(bo_));     \
        RB[0] = *(const MOE_GAS f32x4*)(wug_ + bo_); RB[1] = *(const MOE_GAS f32x4*)(wug_ + bo_ + LDB * 4); RB[2] = *(const MOE_GAS f32x4*)(wvg_ + bo_); RB[3] = *(const MOE_GAS f32x4*)(wvg_ + bo_ + LDB * 4); }
#define MOE_WRITEB(STG, RB) { LAS char* Bs_ = lds + (STG) * MOE_BSTAGE; \
        _Pragma("unroll") for (int i = 0; i < 4; ++i) { LAS unsigned* q_ = (LAS unsigned*)(Bs_ + wb_ + i * (8 * MOE_BP * 2)); q_[0] = cvtpk(RB[0][i], RB[1][i]); q_[8] = cvtpk(RB[2][i], RB[3][i]); } }
#define MOE_COMPUTE(STG, DO_MFMA) { LAS char* Bs_ = lds + (STG) * MOE_BSTAGE; \
        _Pragma("unroll") for (int u = 0; u < 4; ++u) { \
            bf16x8 bfr[4]; \
            if (DO_MFMA) { _Pragma("unroll") for (int c = 0; c < 4; ++c) bfr[c] = *(LAS bf16x8*)(Bs_ + lb_ + (c * 32 * MOE_BP + u * 8) * 2); } \
            _Pragma("unroll") for (int a = 0; a < 2; ++a) { \
                if (DO_MFMA) { const bf16x8 af_ = fp8x8_to_bf16(fa8[a][u >> 1][(u & 1) * 2], fa8[a][u >> 1][(u & 1) * 2 + 1]); \
                    _Pragma("unroll") for (int c = 0; c < 4; ++c) acc[a][c] = MFMA_BF16(bfr[c], af_, acc[a][c]); } \
            } \
        } }
      \
#define MOE_RELOAD { _Pragma("unroll") for (int a = 0; a < 2; ++a) { unsigned ao_ = aoff[a]; asm volatile("" : "+v"(ao_)); \
            fa8[a][0] = *(const MOE_GAS u32x4*)(ab_n + ao_); fa8[a][1] = *(const MOE_GAS u32x4*)(ab_n + ao_ + 16); } }
#define MOE_XCOMPUTE(STG) if (!DOWN) { LAS char* Bs_ = lds + (STG) * MOE_BSTAGE; \
        _Pragma("unroll") for (int u = 0; u < 4; ++u) { \
            const bf16x8 ax_ = fp8x8_to_bf16(fa8x[u >> 1][(u & 1) * 2], fa8x[u >> 1][(u & 1) * 2 + 1]); \
            if (u & 1) { unsigned ao_ = aoffx; asm volatile("" : "+v"(ao_)); fa8x[u >> 1] = *(const MOE_GAS u32x4*)(ab_n + ao_ + (u >> 1) * 16); } \
            const bf16x8 bx_ = *(LAS bf16x8*)(Bs_ + (wave & 3) * (32 * MOE_BP * 2) + lb_ + u * 16); \
            accx = MFMA_BF16(bx_, ax_, accx); } }
#define MOE_NEXTA(S_) MOE_DEC(S_) (void)ps_; \
        if (stt_ != st_loaded) { MOE_AOFF(stt_) st_loaded = stt_; } \
        uint64_t abn_ = (uint64_t)abase + kt_ * 64; asm volatile("" : "+s"(abn_)); const moe_gcb* ab_n = (const moe_gcb*)abn_;
    int st_loaded = st0;
    MOE_AOFF(st0)
    { const char* ab0 = (const char*)abase;
#pragma unroll
      for (int a = 0; a < 2; ++a)
#pragma unroll
          for (int h2 = 0; h2 < 2; ++h2) fa8[a][h2] = *(const u32x4*)(ab0 + aoff[a] + h2 * 16); }
    if (!DOWN) {
        const int vax_ = xr ? rowva[512 + 32 * (wave >> 2) + r32] : TRASH_VA; aoffx = (unsigned)(vax_ == TRASH_VA ? 0 : (vax_ >> 3)) * APITCH + hi * 32;
        fa8x[0] = *(const u32x4*)((const char*)abase + aoffx); fa8x[1] = *(const u32x4*)((const char*)abase + aoffx + 16); }
    MOE_LOADB(0, rb0)
    MOE_LOADB(1, rb1)
    MOE_WRITEB(0, rb0)
    MOE_LOADB(2, rb0)
    int stg = 0;
#pragma unroll 1
    for (int sidx = 0; sidx < nsteps; sidx += 2) {
        const int pl = sidx / (nst * KT); const int rm = sidx - pl * (nst * KT); const int sl = rm / KT; const int kt = rm - sl * KT; const int ps = pass0 + pl, stt = st0 + sl;
        const bool wv = (wave * 64) < (ng - stt * 512);
        const int stg1 = stg == 2 ? 0 : stg + 1, stg2 = stg1 == 2 ? 0 : stg1 + 1;
        __syncthreads();
        MOE_WRITEB(stg1, rb1)
        MOE_LOADB(sidx + 3, rb1)
        { MOE_NEXTA(sidx + 1)
          if (wv) MOE_COMPUTE(stg, true)
          MOE_RELOAD
          MOE_XCOMPUTE(stg) }
        __syncthreads();
        MOE_WRITEB(stg2, rb0)
        MOE_LOADB(sidx + 4, rb0)
        { MOE_NEXTA(sidx + 2)
          if (wv) MOE_COMPUTE(stg1, true)
          MOE_RELOAD
          MOE_XCOMPUTE(stg1) }
        stg = stg2;
        if (kt == KT - 2) {
            const int le_ = lane_id_(); const int lane = le_, r32 = le_ & 31, hi = le_ >> 5; (void)lane;
            if (wv) {
                const int nrows = ng - stt * 512;
#pragma unroll
                for (int a = 0; a < 2; ++a) {
                    if (a == 0 || (wave * 64 + 32) < nrows) {
                        const int lrow = stt * 512 + wave * 64 + a * 32 + r32;
                        const unsigned va = (unsigned)rowva[lrow];
                        if (DOWN) {
                            const float w = roww[lrow];
#pragma unroll
                            for (int c = 0; c < 4; ++c) {
                                float yv_[16];
#pragma unroll
                                for (int j = 0; j < 16; ++j) yv_[j] = acc[a][c][(j >> 2) + 4 * (j & 3)] * w;
                                if (y8) {
                                    u32x4 q8;
#pragma unroll
                                    for (int jj = 0; jj < 4; ++jj) q8[jj] = pack_fp8x4(yv_[4 * jj], yv_[4 * jj + 1], yv_[4 * jj + 2], yv_[4 * jj + 3]);
                                    *(u32x4*)((unsigned char*)outv + (size_t)va * D + ps * 128 + c * 32 + 16 * hi) = q8;
                                } else {
                                    u32x4 q0, q1;
#pragma unroll
                                    for (int jj = 0; jj < 4; ++jj) { q0[jj] = cvtpk(yv_[2 * jj], yv_[2 * jj + 1]); q1[jj] = cvtpk(yv_[8 + 2 * jj], yv_[9 + 2 * jj]); }
                                    u16* o = (u16*)outv + (size_t)va * D + ps * 128 + c * 32 + 16 * hi;
                                    *(u32x4*)o = q0; *(u32x4*)(o + 8) = q1;
                                }
                            }
                        } else {
#pragma unroll
                            for (int c = 0; c < 2; ++c) {
                                float hv[16];
#pragma unroll
                                for (int j = 0; j < 16; ++j) { const int r = (j >> 2) + 4 * (j & 3); const float gt = acc[a][c][r], up = acc[a][c + 2][r]; hv[j] = gt / (1.f + __expf(-gt)) * up; }
                                u32x4 q;
#pragma unroll
                                for (int jj = 0; jj < 4; ++jj) q[jj] = pack_fp8x4(hv[4 * jj], hv[4 * jj + 1], hv[4 * jj + 2], hv[4 * jj + 3]);
                                *(u32x4*)((unsigned char*)outv + (size_t)va * DF + ps * 64 + c * 32 + 16 * hi) = q;
                            }
                        }
                    }
                }
#pragma unroll
                for (int a = 0; a < 2; ++a)
#pragma unroll
                    for (int c = 0; c < 4; ++c)
#pragma unroll
                        for (int r = 0; r < 16; ++r) acc[a][c][r] = 0.f;
            }
            if (!DOWN) { if (xr) {
                LAS float* xch = (LAS float*)(lds + MOE_LDS_XCH) + ((wave >> 2) * 2 + (wave & 1)) * 1024 + lane;
                if ((wave & 3) >= 2) {
#pragma unroll
                    for (int r = 0; r < 16; ++r) xch[r * 64] = accx[r];
                }
                __syncthreads();
                if ((wave & 3) < 2) {
                    const unsigned vax = (unsigned)rowva[512 + 32 * (wave >> 2) + r32];
                    u32x4 q;
#pragma unroll
                    for (int jj = 0; jj < 4; ++jj) {
#pragma unroll
                        for (int i = 0; i < 4; ++i) { const int r = jj + 4 * i; const float gt = accx[r]; accx[r] = gt / (1.f + __expf(-gt)) * xch[r * 64]; }
                        q[jj] = pack_fp8x4(accx[jj], accx[jj + 4], accx[jj + 8], accx[jj + 12]);
                    }
                    *(u32x4*)((unsigned char*)outv + (size_t)vax * DF + ps * 64 + (wave & 3) * 32 + 16 * hi) = q;
                }
                }
#pragma unroll
                for (int r = 0; r < 16; ++r) accx[r] = 0.f;
            }
        }
    }
    __syncthreads();
#undef MOE_XCOMPUTE
#undef MOE_AOFF
#undef MOE_DEC
#undef MOE_LOADB
#undef MOE_WRITEB
#undef MOE_COMPUTE
#undef MOE_RELOAD
#undef MOE_NEXTA
}

constexpr int N_PHASES = 21;

#define P_x_in CTX_IN(0)
#define P_xb ((u16*)(ws + WS_XB))
#define P_x1 ((float*)(ws + WS_X1))
#define P_x2 ((float*)(ws + WS_X2))
#define P_ypre ((u16*)(ws + WS_YPRE))
#define P_qkv ((u16*)(ws + WS_QKV))
#define P_vT ((u16*)(ws + WS_VT))
#define P_kmean ((float*)(ws + WS_KM))
#define P_ao ((u16*)(ws + WS_AO))
#define P_og ((u16*)(ws + WS_OG))
#define P_lse ((float*)(ws + WS_LSE))
#define P_topw ((float*)(ws + WS_TOPW))
#define P_list ((int*)(ws + WS_LIST))
#define P_hb ((u16*)(ws + WS_HB))
#define P_yb ((u16*)(ws + WS_YB))
#define P_cnt_all ((int*)(ws + WS_CTL + CTL_ECNT_OFF))
#define P_xb8 ((unsigned char*)(ws + WS_XB8))
#define P_hbs ((u16*)(ws + WS_HBS))
#define P_selm ((unsigned*)(ws + WS_SELM))
#define P_part ((u16*)(ws + WS_PART))
#define P_plse ((float*)(ws + WS_PLSE))
#define PH_BEGIN int tid = wave_s_ * 64 + lane_id_(); asm volatile("" : "+v"(tid)); const int lane = tid & 63, r32 = lane & 31, hi = lane >> 5; const int wave = __builtin_amdgcn_readfirstlane(tid >> 6); (void)lane; (void)r32; (void)hi; (void)wave
constexpr int LDS_CTX = LDS_BAR + 16;
__device__ __forceinline__ uint64_t ctx_ld(int i) {
    extern __shared__ __attribute__((aligned(16))) unsigned char lds_raw[];
    const LAS unsigned* q = (const LAS unsigned*)((LAS char*)lds_raw + LDS_CTX) + 2 * i;
    const unsigned lo = __builtin_amdgcn_readfirstlane(q[0]), hi = __builtin_amdgcn_readfirstlane(q[1]);
    return ((uint64_t)hi << 32) | lo;
}
typedef __attribute__((address_space(1))) unsigned char gbyte;
#define AS_GLOBAL(T, u64v) ((T*)(gbyte*)(u64v))
#define CTX_IN(i) AS_GLOBAL(const float, ctx_ld(i))
#define PH_FN_BEGIN \
    extern __shared__ __attribute__((aligned(16))) unsigned char lds_raw[]; \
    LAS char* lds = (LAS char*)lds_raw; (void)lds; \
    const int G = gridDim.x, bid = blockIdx.x; (void)G; (void)bid; \
    unsigned char* const ws = AS_GLOBAL(unsigned char, ctx_ld(17)); (void)ws; \
    const int NQ = L == 0 ? 3072 : 9216; (void)NQ; \
    int* cnt = P_cnt_all + L * NE * CNT_STRIDE; (void)cnt;
__device__ __forceinline__ void ph_p0(int L, int rep_, const int wave_s_) {
    PH_FN_BEGIN
    (void)rep_;
    PH_BEGIN;
    for (size_t i = (size_t)bid * NTHR + tid; i < (size_t)T * D / 4; i += (size_t)G * NTHR) {
        const f32x4 v = *(const f32x4*)(P_x_in + i * 4);
        u32x2 w; w[0] = cvtpk(v[0], v[1]); w[1] = cvtpk(v[2], v[3]);
        *(u32x2*)(P_xb + i * 4) = w;
    }
    LAS float* tl = (LAS float*)lds;
    for (int it = bid; it < 3968 + 128; it += G) {
        int seg, kt;
        if (it < 3840) { seg = it >> 4; kt = it & 15; } else if (it < 3968) { seg = 240 + ((it - 3840) >> 2); kt = (it - 3840) & 3; } else { seg = 272 + ((it - 3968) >> 4); kt = (it - 3968) & 15; }
        const float* src; int ld; u16* dst; int Kd = 1024; u16* dst_lo = nullptr; int rcol = 0;
        if (seg < 48) { const int col = 64 * seg; src = CTX_IN(1) + col; ld = 3072; dst = (u16*)(ws + WS_WQK0) + (size_t)col * 1024; }
        else if (seg < 192) { const int col = 64 * (seg - 48); src = CTX_IN(2) + col; ld = 9216; dst = (u16*)(ws + WS_WQK1) + (size_t)col * 1024; }
        else if (seg < 224) { const int s2 = seg - 192, l2 = s2 >> 4, col = 64 * (s2 & 15); src = CTX_IN(3) + (size_t)l2 * D * D + col; ld = 1024; dst = (u16*)(ws + WS_WO) + (size_t)l2 * D * D + (size_t)col * 1024; }
        else if (seg < 240) { const int s2 = seg - 224, l2 = s2 >> 3, i8 = s2 & 7, un = i8 >> 2, q = i8 & 3;
            src = (q < 2 ? CTX_IN(11) : CTX_IN(12)) + (size_t)l2 * D * DF + un * 128 + 64 * (q & 1); ld = 256; dst = (u16*)(ws + WS_WSGU) + (size_t)l2 * 512 * 1024 + (size_t)(64 * i8) * 1024; }
        else if (seg < 272) { const int s2 = seg - 240, l2 = s2 >> 4, col = 64 * (s2 & 15); src = CTX_IN(13) + (size_t)l2 * DF * D + col; ld = 1024; Kd = 256; dst = (u16*)(ws + WS_WSD) + (size_t)l2 * D * DF + (size_t)col * 256; }
        else { const int s2 = seg - 272, l2 = s2 >> 2, col = 64 * (s2 & 3); src = CTX_IN(6) + (size_t)l2 * D * NE + col; ld = 256; rcol = col; dst = (u16*)(ws + WS_WRH) + (size_t)l2 * NE * D; dst_lo = (u16*)(ws + WS_WRL) + (size_t)l2 * NE * D; }
        {
            const int kr = tid >> 4, c4 = tid & 15;
#pragma unroll
            for (int i = 0; i < 2; ++i) {
                const f32x4 v = *(const f32x4*)(src + (size_t)(kt * 64 + kr + 32 * i) * ld + 4 * c4);
#pragma unroll
                for (int jj = 0; jj < 4; ++jj) tl[(kr + 32 * i) * 65 + 4 * c4 + jj] = v[jj];
            }
        }
        __syncthreads();
        {
            const int row = tid >> 3, kc = tid & 7;
            float f[8];
#pragma unroll
            for (int jj = 0; jj < 8; ++jj) f[jj] = tl[(8 * kc + jj) * 65 + row];
            u32x4 w; w[0] = cvtpk(f[0], f[1]); w[1] = cvtpk(f[2], f[3]); w[2] = cvtpk(f[4], f[5]); w[3] = cvtpk(f[6], f[7]);
            if (dst_lo) {
                u32x4 wl;
#pragma unroll
                for (int jj = 0; jj < 4; ++jj) wl[jj] = cvtpk(f[2 * jj] - bf2f(w[jj] & 0xFFFFu), f[2 * jj + 1] - bf2f(w[jj] >> 16));
                const int E_ = rcol + row;
                const size_t fi = ((size_t)(((E_ >> 5) * 16 + kt) * 4 + (kc >> 1)) * 64 + (kc & 1) * 32 + (E_ & 31)) * 8;
                *(u32x4*)(dst + fi) = w; *(u32x4*)(dst_lo + fi) = wl;
            } else *(u32x4*)(dst + (size_t)row * Kd + kt * 64 + 8 * kc) = w;
        }
        __syncthreads();
    }
}

__device__ __forceinline__ void ph_qkv(int L, int rep_, const int wave_s_) {
    PH_FN_BEGIN
    (void)rep_;
    const pg8::Gemm g{P_xb, (const u16*)(ws + (L == 0 ? WS_WQK0 : WS_WQK1)), T, NQ, D};
    pg8::StaticOrder S; S.init(g.M, g.N, G, bid);
    const EpiQK E{P_qkv, NQ};
    pg8::gemm_phase<EpiQK, pg8::StaticOrder, false>((PG8_LAS unsigned char*)lds, g, S, E, nullptr, wave_s_ * 64 + lane_id_());
}

__device__ __forceinline__ void ph_kmean(int L, int rep_, const int wave_s_) {
    PH_FN_BEGIN
    (void)rep_;
    PH_BEGIN;
    LAS float* red = (LAS float*)lds;
    for (int it = bid; it < BATCH * NH * MOBA_NB; it += G) {
        const int j = it & 31, h = (it >> 5) & 15, b = it >> 9;
        const int kg_ = tid >> 3, ch = tid & 7;
        const u16* kp = P_qkv + (size_t)(b * SEQ + j * MOBA_BLK + kg_) * 3072 + 1024 + h * 64 + ch * 8;
        float sm[8];
#pragma unroll
        for (int e2 = 0; e2 < 8; ++e2) sm[e2] = 0.f;
#pragma unroll
        for (int i = 0; i < 4; ++i) {
            const u32x4 v = *(const u32x4*)(kp + (size_t)(64 * i) * 3072);
#pragma unroll
            for (int e2 = 0; e2 < 4; ++e2) { sm[2 * e2] += bf2f(v[e2] & 0xFFFFu); sm[2 * e2 + 1] += bf2f(v[e2] >> 16); }
        }
#pragma unroll
        for (int e2 = 0; e2 < 8; ++e2) red[kg_ * 65 + ch * 8 + e2] = sm[e2];
        __syncthreads();
        if (tid < 64) {
            float tot = 0.f;
#pragma unroll 8
            for (int q = 0; q < 64; ++q) tot += red[q * 65 + tid];
            P_kmean[(size_t)it * 64 + tid] = tot * (1.f / MOBA_BLK);
        }
        __syncthreads();
    }
}

__device__ __forceinline__ void ph_gate(int L, int rep_, const int wave_s_) {
    PH_FN_BEGIN
    (void)rep_;
    PH_BEGIN;
    for (int it = bid; it < BATCH * NH * MOBA_NB; it += G) {
        const int qb = it & 31, bh = it >> 5, b = bh >> 4, h = bh & 15;
        const int tq = qb * MOBA_BLK + wave * 32 + r32;
        const u16* qrow = P_qkv + (size_t)(b * SEQ + tq) * 3072 + h * 64 + hi * 8;
        bf16x8 qf[4];
#pragma unroll
        for (int d0 = 0; d0 < 4; ++d0) qf[d0] = *(const bf16x8*)(qrow + d0 * 16);
        unsigned selmask = 0u;
        if (qb > 0) {
            const float* km = P_kmean + ((size_t)(b * NH + h) * MOBA_NB + r32) * 64 + hi * 8;
            f32x16 gt;
#pragma unroll
            for (int r = 0; r < 16; ++r) gt[r] = 0.f;
#pragma unroll
            for (int d0 = 0; d0 < 4; ++d0) {
                const f32x4 k0 = *(const f32x4*)(km + d0 * 16), k1 = *(const f32x4*)(km + d0 * 16 + 4);
                union { bf16x8 v; unsigned u[4]; } kf;
                kf.u[0] = cvtpk(k0[0], k0[1]); kf.u[1] = cvtpk(k0[2], k0[3]); kf.u[2] = cvtpk(k1[0], k1[1]); kf.u[3] = cvtpk(k1[2], k1[3]);
                gt = MFMA_BF16(kf.v, qf[d0], gt);
            }
            float v0 = -INFINITY, v1 = -INFINITY, v2 = -INFINITY; int i0 = 99, i1 = 99, i2 = 99;
#pragma unroll
            for (int r = 0; r < 16; ++r) { const int jb = crow(r, hi); const float gv = jb < qb ? gt[r] : -INFINITY; top3_insert(gv, jb < qb ? jb : 99, v0, i0, v1, i1, v2, i2); }
            const float ov0 = shxf(v0, 32, lane), ov1 = shxf(v1, 32, lane), ov2 = shxf(v2, 32, lane);
            const int oi0 = shxi(i0, 32, lane), oi1 = shxi(i1, 32, lane), oi2 = shxi(i2, 32, lane);
            top3_insert(ov0, oi0, v0, i0, v1, i1, v2, i2); top3_insert(ov1, oi1, v0, i0, v1, i1, v2, i2); top3_insert(ov2, oi2, v0, i0, v1, i1, v2, i2);
            if (i0 < 32) selmask |= 1u << i0;
            if (i1 < 32) selmask |= 1u << i1;
            if (i2 < 32) selmask |= 1u << i2;
        }
        if (hi == 0) P_selm[(size_t)bh * SEQ + tq] = selmask;
    }
}

constexpr int MB_KP = 72;
constexpr int MB_VP = 260;
constexpr int MB_LDS_K = 0;
constexpr int MB_LDS_V = 256 * MB_KP * 2;
constexpr int MB_LDS_LIST = MB_LDS_V + 64 * MB_VP * 2;
constexpr int MB_LDS_CTR = MB_LDS_LIST + 8192 * 2;
__device__ __forceinline__ void ph_moba(int L, int rep_, const int wave_s_) {
    PH_FN_BEGIN
    (void)rep_;
    PH_BEGIN;
    LAS char* Ks = lds + MB_LDS_K; LAS char* Vs = lds + MB_LDS_V;
    LAS u16* qlist = (LAS u16*)(lds + MB_LDS_LIST); LAS int* ctr = (LAS int*)(lds + MB_LDS_CTR);
    for (int it = bid; it < BATCH * NH * MOBA_NB; it += G) {
        const int rnd = it >> 8, w8 = it & 255, a8 = w8 >> 5, bh = w8 & 31;
        const int j = rnd == 0 ? a8 : (rnd == 1 ? 15 - a8 : (rnd == 2 ? 16 + a8 : 31 - a8));
        const int b = bh >> 4, h = bh & 15;
        const float slope2 = exp2f(-0.5f * (float)(h + 1)) * LOG2E;
        if (tid == 0) { int z0 = 0; asm volatile("" : "+v"(z0)); ctr[0] = z0; ctr[1] = z0; }
        {
            const u16* kg = P_qkv + (size_t)(b * SEQ + j * MOBA_BLK) * 3072 + 1024 + h * 64;
#pragma unroll
            for (int i = 0; i < 4; ++i) { const int c = tid + i * 512, row = c >> 3, ch = c & 7; *(LAS u32x4*)(Ks + (row * MB_KP + ch * 8) * 2) = *(const u32x4*)(kg + (size_t)row * 3072 + ch * 8); }
            const u16* vg = P_qkv + (size_t)(b * SEQ + j * MOBA_BLK) * 3072 + 2048 + h * 64;
#pragma unroll
            for (int i = 0; i < 4; ++i) {
                const int c = tid + i * 512, key = c >> 3, ch = c & 7;
                const u32x4 v = *(const u32x4*)(vg + (size_t)key * 3072 + ch * 8);
#pragma unroll
                for (int e2 = 0; e2 < 4; ++e2) {
                    *(LAS u16*)(Vs + ((ch * 8 + 2 * e2) * MB_VP + key) * 2) = (u16)(v[e2] & 0xFFFFu);
                    *(LAS u16*)(Vs + ((ch * 8 + 2 * e2 + 1) * MB_VP + key) * 2) = (u16)(v[e2] >> 16);
                }
            }
        }
        __syncthreads();
        {
            const unsigned* sm = P_selm + (size_t)bh * SEQ;
            for (int t0 = (j + 1) * MOBA_BLK; t0 < SEQ; t0 += 512) {
                const int t = t0 + tid;
                const bool sel = (t < SEQ) && ((sm[t < SEQ ? t : 0] >> j) & 1u);
                const unsigned long long bal = __ballot(sel);
                const int total = __popcll(bal);
                int wb = 0;
                if (lane == 0 && total) wb = atomicAdd((int*)&ctr[0], total);
                wb = __builtin_amdgcn_readfirstlane(wb);
                if (sel) qlist[wb + __popcll(bal & ((1ull << lane) - 1ull))] = (u16)t;
            }
        }
        __syncthreads();
        const int nq = ctr[0];
        const int ntiles = 8 + ((nq + 31) >> 5);
        for (;;) {
            int ti = 0;
            if (lane == 0) ti = atomicAdd((int*)&ctr[1], 1);
            ti = __builtin_amdgcn_readfirstlane(ti);
            if (ti >= ntiles) break;
            const bool own = ti < 8;
            const int wq = 7 - ti;
            const int li = (ti - 8) * 32 + r32;
            const bool valid = own || li < nq;
            const int tq = own ? j * MOBA_BLK + wq * 32 + r32 : (int)qlist[li < nq ? li : nq - 1];
            const int nsteps = own ? wq + 1 : 8;
            const u16* qrow = P_qkv + (size_t)(b * SEQ + tq) * 3072 + h * 64 + hi * 8;
            bf16x8 qf[4];
#pragma unroll
            for (int d0 = 0; d0 < 4; ++d0) qf[d0] = *(const bf16x8*)(qrow + d0 * 16);
            int slot = 3;
            if (!own) slot = __popc(P_selm[(size_t)bh * SEQ + tq] & ((1u << j) - 1u));
            AttnSt st; st.m = NEGV; st.l = 0.f;
#pragma unroll
            for (int r = 0; r < 16; ++r) { st.o0[r] = 0.f; st.o1[r] = 0.f; }
            const int dlo = own ? 0 : -0x40000000;
            for (int kt = 0; kt < nsteps; ++kt) {
                AttnFr f;
#pragma unroll
                for (int d0 = 0; d0 < 4; ++d0) f.k[d0] = *(LAS bf16x8*)(Ks + ((kt * 32 + r32) * MB_KP + d0 * 16 + hi * 8) * 2);
#pragma unroll
                for (int q4 = 0; q4 < 4; ++q4) {
                    union { bf16x8 v; u32x2 hh[2]; } va;
                    LAS char* vp = Vs + (((q4 >> 1) * 32 + r32) * MB_VP + kt * 32 + (q4 & 1) * 16 + 4 * hi) * 2;
                    va.hh[0] = *(LAS u32x2*)(vp); va.hh[1] = *(LAS u32x2*)(vp + 16);
                    f.v[q4] = va.v;
                }
                attn_compute(st, qf, f, tq - (j * MOBA_BLK + kt * 32) - 4 * hi, slope2, dlo, 0x7fffffff, hi, lane);
            }
            const float lt = st.l + shxf(st.l, 32, lane);
            const float inv = 1.f / lt;
            if (valid) {
                const size_t pi = ((size_t)(b * SEQ + tq) * NH + h) * 4 + slot;
                u16* orow = P_part + pi * 64;
#pragma unroll
                for (int rq = 0; rq < 4; ++rq) {
                    u32x2 w; w[0] = cvtpk(st.o0[4 * rq] * inv, st.o0[4 * rq + 1] * inv); w[1] = cvtpk(st.o0[4 * rq + 2] * inv, st.o0[4 * rq + 3] * inv);
                    *(u32x2*)(orow + 8 * rq + 4 * hi) = w;
                    w[0] = cvtpk(st.o1[4 * rq] * inv, st.o1[4 * rq + 1] * inv); w[1] = cvtpk(st.o1[4 * rq + 2] * inv, st.o1[4 * rq + 3] * inv);
                    *(u32x2*)(orow + 32 + 8 * rq + 4 * hi) = w;
                }
                if (hi == 0) P_plse[pi] = st.m * LN2 + logf(lt);
            }
        }
        __syncthreads();
    }
}

__device__ __forceinline__ void ph_mobamerge(int L, int rep_, const int wave_s_) {
    PH_FN_BEGIN
    (void)rep_;
    PH_BEGIN;
    for (size_t i = (size_t)bid * NTHR + tid; i < (size_t)T * NH * 8; i += (size_t)G * NTHR) {
        const size_t row = i >> 7; const int h = (int)(i >> 3) & 15, d8 = (int)i & 7;
        const int qb = (int)(row & (SEQ - 1)) >> 8;
        const int nsel = qb < 3 ? qb : 3;
        const size_t pi = (row * NH + h) * 4;
        float l[4], w[4];
        float mx = -INFINITY;
#pragma unroll
        for (int sidx = 0; sidx < 4; ++sidx) { const bool ok = sidx == 3 || sidx < nsel; l[sidx] = ok ? P_plse[pi + sidx] : -INFINITY; mx = fmaxf(mx, l[sidx]); }
        float ws_ = 0.f;
#pragma unroll
        for (int sidx = 0; sidx < 4; ++sidx) { w[sidx] = (sidx == 3 || sidx < nsel) ? expf(l[sidx] - mx) : 0.f; ws_ += w[sidx]; }
        const float inv = 1.f / ws_;
        float acc8[8];
#pragma unroll
        for (int c = 0; c < 8; ++c) acc8[c] = 0.f;
#pragma unroll
        for (int sidx = 0; sidx < 4; ++sidx) {
            if (sidx == 3 || sidx < nsel) {
                const u32x4 a = *(const u32x4*)(P_part + (pi + sidx) * 64 + d8 * 8);
                const float ww = w[sidx] * inv;
#pragma unroll
                for (int c = 0; c < 4; ++c) { acc8[2 * c] += ww * bf2f(a[c] & 0xFFFFu); acc8[2 * c + 1] += ww * bf2f(a[c] >> 16); }
            }
        }
        u32x4 o;
#pragma unroll
        for (int c = 0; c < 4; ++c) o[c] = cvtpk(acc8[2 * c], acc8[2 * c + 1]);
        *(u32x4*)(P_ao + row * D + h * 64 + d8 * 8) = o;
    }
}

constexpr int DL_KP = 72, DL_VP = 388;
constexpr int DL_LDS_K = 0, DL_LDS_V = 384 * DL_KP * 2;
__device__ __forceinline__ void ph_dil(int L, int rep_, const int wave_s_) {
    PH_FN_BEGIN
    (void)rep_;
    PH_BEGIN;
    LAS char* Ks = lds + DL_LDS_K; LAS char* Vs = lds + DL_LDS_V;
    for (int it = bid; it < BATCH * NH * 3 * 32; it += G) {
        const int ch = it & 31, grp = (it >> 5) % 3, bh = it / 96, b = bh >> 4, h = bh & 15;
        const int dil = grp == 0 ? 1 : (grp == 1 ? 4 : 16), Ls = SEQ / dil;
        const float slope2 = exp2f(-0.5f * (float)(h + 1)) * LOG2E * (float)dil;
        const int uc = ch * 256, res = uc / Ls, c0 = uc - res * Ls;
        const int kb0 = c0 - 128;
        {
            const u16* kg = P_qkv + (size_t)(b * SEQ) * 9216 + grp * 3072 + 1024 + h * 64;
#pragma unroll
            for (int i = 0; i < 6; ++i) {
                const int c = tid + i * 512, row = c >> 3, chk = c & 7, ks = kb0 + row;
                if (ks >= 0) *(LAS u32x4*)(Ks + (row * DL_KP + chk * 8) * 2) = *(const u32x4*)(kg + (size_t)(ks * dil + res) * 9216 + chk * 8);
            }
            const u16* vg = P_qkv + (size_t)(b * SEQ) * 9216 + grp * 3072 + 2048 + h * 64;
#pragma unroll
            for (int i = 0; i < 6; ++i) {
                const int c = tid + i * 512, row = c >> 3, chk = c & 7, ks = kb0 + row;
                if (ks >= 0) {
                    const u32x4 v = *(const u32x4*)(vg + (size_t)(ks * dil + res) * 9216 + chk * 8);
#pragma unroll
                    for (int e2 = 0; e2 < 4; ++e2) {
                        *(LAS u16*)(Vs + ((chk * 8 + 2 * e2) * DL_VP + row) * 2) = (u16)(v[e2] & 0xFFFFu);
                        *(LAS u16*)(Vs + ((chk * 8 + 2 * e2 + 1) * DL_VP + row) * 2) = (u16)(v[e2] >> 16);
                    }
                }
            }
        }
        const int i0 = c0 + wave * 32, iq = i0 + r32, pq = iq * dil + res;
        const u16* qrow = P_qkv + (size_t)(b * SEQ + pq) * 9216 + grp * 3072 + h * 64 + hi * 8;
        bf16x8 qf[4];
#pragma unroll
        for (int d0 = 0; d0 < 4; ++d0) qf[d0] = *(const bf16x8*)(qrow + d0 * 16);
        __syncthreads();
        AttnSt st; st.m = NEGV; st.l = 0.f;
#pragma unroll
        for (int r = 0; r < 16; ++r) { st.o0[r] = 0.f; st.o1[r] = 0.f; }
        const int ktmin = (i0 >= 128) ? 0 : (128 - i0) >> 5;
        for (int kt = 4; kt >= ktmin; --kt) {
            const int lrow0 = (wave + kt) * 32;
            AttnFr f;
#pragma unroll
            for (int d0 = 0; d0 < 4; ++d0) f.k[d0] = *(LAS bf16x8*)(Ks + ((lrow0 + r32) * DL_KP + d0 * 16 + hi * 8) * 2);
#pragma unroll
            for (int q4 = 0; q4 < 4; ++q4) {
                union { bf16x8 v; u32x2 hh[2]; } va;
                LAS char* vp = Vs + (((q4 >> 1) * 32 + r32) * DL_VP + lrow0 + (q4 & 1) * 16 + 4 * hi) * 2;
                va.hh[0] = *(LAS u32x2*)(vp); va.hh[1] = *(LAS u32x2*)(vp + 16);
                f.v[q4] = va.v;
            }
            const int k0 = i0 - 128 + kt * 32;
            attn_compute(st, qf, f, iq - k0 - 4 * hi, slope2, 0, 128, hi, lane);
        }
        const float lt = st.l + shxf(st.l, 32, lane);
        const float inv = 1.f / lt;
        u16* orow = P_og + (size_t)grp * T * D + (size_t)(b * SEQ + pq) * D + h * 64;
#pragma unroll
        for (int rq = 0; rq < 4; ++rq) {
            u32x2 w; w[0] = cvtpk(st.o0[4 * rq] * inv, st.o0[4 * rq + 1] * inv); w[1] = cvtpk(st.o0[4 * rq + 2] * inv, st.o0[4 * rq + 3] * inv);
            *(u32x2*)(orow + 8 * rq + 4 * hi) = w;
            w[0] = cvtpk(st.o1[4 * rq] * inv, st.o1[4 * rq + 1] * inv); w[1] = cvtpk(st.o1[4 * rq + 2] * inv, st.o1[4 * rq + 3] * inv);
            *(u32x2*)(orow + 32 + 8 * rq + 4 * hi) = w;
        }
        if (hi == 0) P_lse[((size_t)grp * T + (b * SEQ + pq)) * NH + h] = st.m * LN2 + logf(lt);
        __syncthreads();
    }
}

__device__ __forceinline__ void ph_merge(int L, int rep_, const int wave_s_) {
    PH_FN_BEGIN
    (void)rep_;

            PH_BEGIN;
                for (size_t i = (size_t)bid * NTHR + tid; i < (size_t)T * NH * 8; i += (size_t)G * NTHR) {
                    const size_t row = i >> 7; const int h = (int)(i >> 3) & 15, d8 = (int)i & 7;
                    const float l0 = P_lse[(0 * (size_t)T + row) * NH + h], l1 = P_lse[(1 * (size_t)T + row) * NH + h], l2 = P_lse[(2 * (size_t)T + row) * NH + h];
                    const float mx = fmaxf(l0, fmaxf(l1, l2));
                    float w0 = expf(l0 - mx), w1 = expf(l1 - mx), w2 = expf(l2 - mx);
                    const float inv = 1.f / (w0 + w1 + w2); w0 *= inv; w1 *= inv; w2 *= inv;
                    const size_t off = row * D + h * 64 + d8 * 8;
                    const u32x4 a0 = *(const u32x4*)(P_og + off), a1 = *(const u32x4*)(P_og + (size_t)T * D + off), a2 = *(const u32x4*)(P_og + 2 * (size_t)T * D + off);
                    u32x4 o;
#pragma unroll
                    for (int c = 0; c < 4; ++c) {
                        const float lo_ = w0 * bf2f(a0[c] & 0xFFFFu) + w1 * bf2f(a1[c] & 0xFFFFu) + w2 * bf2f(a2[c] & 0xFFFFu);
                        const float hi_ = w0 * bf2f(a0[c] >> 16) + w1 * bf2f(a1[c] >> 16) + w2 * bf2f(a2[c] >> 16);
                        o[c] = cvtpk(lo_, hi_);
                    }
                    *(u32x4*)(P_ao + off) = o;
                }

}

__device__ __forceinline__ void ph_wo(int L, int rep_, const int wave_s_) {
    PH_FN_BEGIN
    (void)rep_;
    const pg8::Gemm g{P_ao, (const u16*)(ws + WS_WO) + (size_t)L * D * D, T, D, D};
    pg8::StaticOrder S; S.init(g.M, g.N, G, bid);
    const EpiWo E{P_ypre, P_xb};
    pg8::gemm_phase<EpiWo, pg8::StaticOrder, false>((PG8_LAS unsigned char*)lds, g, S, E, nullptr, wave_s_ * 64 + lane_id_());
}

constexpr int RT_P = 144;
constexpr int RT_ASTAGE = 2 * 64 * 144;
constexpr int RT_LDS_AH = 0, RT_LDS_AL = 64 * RT_P;
constexpr int RT_LDS_BH = 2 * 64 * RT_P, RT_LDS_BL = RT_LDS_BH + 256 * RT_P;
constexpr int RT_LDS_ST = RT_LDS_BL + 256 * RT_P;
__device__ __forceinline__ void ph_router(int L, int rep_, const int wave_s_) {
    PH_FN_BEGIN
    (void)rep_;
    PH_BEGIN;
    const float* lng = CTX_IN(4) + L * D; const float* lnb = CTX_IN(5) + L * D;
    const float* rbias = CTX_IN(7) + L * NE;
    const u16* wrh = (const u16*)(ws + WS_WRH) + (size_t)L * NE * D; const u16* wrl = (const u16*)(ws + WS_WRL) + (size_t)L * NE * D;
    LAS float* stat = (LAS float*)(lds + RT_LDS_ST);
    for (int it = bid; it < T / 64; it += G) {
#pragma unroll 1
        for (int hb_ = 0; hb_ < 2; ++hb_) {
            u32x4 yv[4][2];
#pragma unroll
            for (int rr = 0; rr < 4; ++rr)
#pragma unroll
                for (int j = 0; j < 2; ++j) yv[rr][j] = *(const u32x4*)(P_ypre + ((size_t)it * 64 + wave * 8 + hb_ * 4 + rr) * D + j * 512 + lane * 8);
#pragma unroll
            for (int rr = 0; rr < 4; ++rr) {
                float sm = 0.f;
#pragma unroll
                for (int j = 0; j < 2; ++j)
#pragma unroll
                    for (int c = 0; c < 4; ++c) sm += bf2f(yv[rr][j][c] & 0xFFFFu) + bf2f(yv[rr][j][c] >> 16);
                const float mu = wave_sum(sm) * (1.f / D);
                float q = 0.f;
#pragma unroll
                for (int j = 0; j < 2; ++j)
#pragma unroll
                    for (int c = 0; c < 4; ++c) { const float d0_ = bf2f(yv[rr][j][c] & 0xFFFFu) - mu, d1_ = bf2f(yv[rr][j][c] >> 16) - mu; q += d0_ * d0_ + d1_ * d1_; }
                const float rstd = rsqrtf(wave_sum(q) * (1.f / D) + LN_EPS);
                if (lane == 0) { stat[wave * 8 + hb_ * 4 + rr] = mu; stat[64 + wave * 8 + hb_ * 4 + rr] = rstd; }
            }
        }
        __syncthreads();
        const int arow = tid >> 3, aq = tid & 7;
        const float amu = stat[arow], ars = stat[64 + arow];
        const u16* yp = P_ypre + ((size_t)it * 64 + arow) * D + aq * 8;
        u32x4 ya = *(const u32x4*)(yp);
        u32x4 bw[8], bx[8];
        const u16* wfh = wrh + (size_t)wave * 16 * 4 * 64 * 8 + lane * 8; const u16* wfl = wrl + (size_t)wave * 16 * 4 * 64 * 8 + lane * 8;
#define RT_LOADB(BW, KC_) { _Pragma("unroll") for (int sk = 0; sk < 4; ++sk) { BW[sk] = *(const u32x4*)(wfh + ((KC_) * 4 + sk) * 512); BW[4 + sk] = *(const u32x4*)(wfl + ((KC_) * 4 + sk) * 512); } }
        RT_LOADB(bw, 0)
        RT_LOADB(bx, 1)
        f32x16 lg[2];
#pragma unroll
        for (int r = 0; r < 16; ++r) { lg[0][r] = 0.f; lg[1][r] = 0.f; }
#define RT_WRITEA(KC_) { const int k0 = (KC_) * 64; \
            const f32x4 g0 = *(const f32x4*)(lng + k0 + aq * 8), g1 = *(const f32x4*)(lng + k0 + aq * 8 + 4); \
            const f32x4 b0 = *(const f32x4*)(lnb + k0 + aq * 8), b1 = *(const f32x4*)(lnb + k0 + aq * 8 + 4); \
            f32x4 x0, x1v; \
            _Pragma("unroll") for (int c = 0; c < 4; ++c) { const float y0_ = bf2f(c & 1 ? ya[c >> 1] >> 16 : ya[c >> 1] & 0xFFFFu), y1_ = bf2f(c & 1 ? ya[2 + (c >> 1)] >> 16 : ya[2 + (c >> 1)] & 0xFFFFu); \
                x0[c] = (y0_ - amu) * ars * g0[c] + b0[c]; x1v[c] = (y1_ - amu) * ars * g1[c] + b1[c]; } \
            ya = *(const u32x4*)(yp + (((KC_) + 1 < 16) ? k0 + 64 : 0)); \
            const size_t go = ((size_t)it * 64 + arow) * D + k0 + aq * 8; \
            u32x4 wh; wh[0] = cvtpk(x0[0], x0[1]); wh[1] = cvtpk(x0[2], x0[3]); wh[2] = cvtpk(x1v[0], x1v[1]); wh[3] = cvtpk(x1v[2], x1v[3]); \
            *(u32x4*)(P_xb + go) = wh; \
            u32x2 w8; w8[0] = pack_fp8x4(x0[0], x0[1], x0[2], x0[3]); w8[1] = pack_fp8x4(x1v[0], x1v[1], x1v[2], x1v[3]); \
            *(u32x2*)(P_xb8 + go) = w8; \
            u32x4 wl; \
            wl[0] = cvtpk(x0[0] - bf2f(wh[0] & 0xFFFFu), x0[1] - bf2f(wh[0] >> 16)); wl[1] = cvtpk(x0[2] - bf2f(wh[1] & 0xFFFFu), x0[3] - bf2f(wh[1] >> 16)); \
            wl[2] = cvtpk(x1v[0] - bf2f(wh[2] & 0xFFFFu), x1v[1] - bf2f(wh[2] >> 16)); wl[3] = cvtpk(x1v[2] - bf2f(wh[3] & 0xFFFFu), x1v[3] - bf2f(wh[3] >> 16)); \
            *(LAS u32x4*)(lds + ((KC_) & 1) * RT_ASTAGE + RT_LDS_AH + arow * RT_P + aq * 16) = wh; \
            *(LAS u32x4*)(lds + ((KC_) & 1) * RT_ASTAGE + RT_LDS_AL + arow * RT_P + aq * 16) = wl; }
#define RT_CHUNK(KC_, BW) { __syncthreads(); \
            _Pragma("unroll") for (int sk = 0; sk < 4; ++sk) { \
                const int ko = (sk * 16 + hi * 8) * 2; \
                const bf16x8 bh_ = __builtin_bit_cast(bf16x8, BW[sk]), bl_ = __builtin_bit_cast(bf16x8, BW[4 + sk]); \
                _Pragma("unroll") for (int rb = 0; rb < 2; ++rb) { \
                    const bf16x8 xh = *(const LAS bf16x8*)(lds + ((KC_) & 1) * RT_ASTAGE + RT_LDS_AH + (rb * 32 + r32) * RT_P + ko), xl = *(const LAS bf16x8*)(lds + ((KC_) & 1) * RT_ASTAGE + RT_LDS_AL + (rb * 32 + r32) * RT_P + ko); \
                    lg[rb] = MFMA_BF16(xh, bh_, lg[rb]); lg[rb] = MFMA_BF16(xl, bh_, lg[rb]); lg[rb] = MFMA_BF16(xh, bl_, lg[rb]); \
                } \
            } \
            if ((KC_) + 1 < 16) RT_WRITEA((KC_) + 1) \
            { const int kn_ = ((KC_) + 2 < 16) ? (KC_) + 2 : ((KC_) & 1); RT_LOADB(BW, kn_) } }
        RT_WRITEA(0)
#pragma unroll 1
        for (int kc = 0; kc < 16; kc += 2) {
            RT_CHUNK(kc, bw)
            RT_CHUNK(kc + 1, bx)
        }
#undef RT_CHUNK
#undef RT_WRITEA
#undef RT_LOADB
        __syncthreads();
        LAS float* lgs = (LAS float*)lds;
#pragma unroll
        for (int rb = 0; rb < 2; ++rb)
#pragma unroll
            for (int r = 0; r < 16; ++r) lgs[(rb * 32 + crow(r, hi)) * 257 + wave * 32 + r32] = lg[rb][r];
        __syncthreads();
#pragma unroll 1
        for (int tg = 0; tg < 2; ++tg) {
            float sc[4][4], cv[4][4];
#pragma unroll
            for (int tt = 0; tt < 4; ++tt) {
                const int lr = wave * 8 + tg * 4 + tt;
#pragma unroll
                for (int j = 0; j < 4; ++j) { const int e = lane + 64 * j; sc[tt][j] = 1.f / (1.f + __expf(-lgs[lr * 257 + e])); cv[tt][j] = sc[tt][j] + rbias[e]; }
            }
            float gsel[4][8];
#pragma unroll
            for (int j = 0; j < 4; ++j) {
#pragma unroll
                for (int tt = 0; tt < 4; ++tt) {
                    const float rm = dpp_rowmax(cv[tt][j]);
                    const float m1a = fmaxf(rl_f(rm, 0), rl_f(rm, 16)), m1b = fmaxf(rl_f(rm, 32), rl_f(rm, 48));
                    const unsigned long long bal = __ballot(cv[tt][j] == (hi ? m1b : m1a));
                    const int fa_ = __builtin_ctz((unsigned)(bal & 0xFFFFFFFFull)), fb_ = 32 + __builtin_ctz((unsigned)(bal >> 32));
                    const float c2 = (lane == fa_ || lane == fb_) ? -INFINITY : cv[tt][j];
                    const float rm2 = dpp_rowmax(c2);
                    gsel[tt][2 * j] = m1a + fmaxf(rl_f(rm2, 0), rl_f(rm2, 16));
                    gsel[tt][2 * j + 1] = m1b + fmaxf(rl_f(rm2, 32), rl_f(rm2, 48));
                }
            }
#pragma unroll
            for (int tt = 0; tt < 4; ++tt)
#pragma unroll
                for (int j = 0; j < 4; ++j) {
                    int ra_ = 0, rb_ = 0;
#pragma unroll
                    for (int g2 = 0; g2 < 8; ++g2) {
                        ra_ += ((gsel[tt][g2] > gsel[tt][2 * j]) || (gsel[tt][g2] == gsel[tt][2 * j] && g2 < 2 * j)) ? 1 : 0;
                        rb_ += ((gsel[tt][g2] > gsel[tt][2 * j + 1]) || (gsel[tt][g2] == gsel[tt][2 * j + 1] && g2 < 2 * j + 1)) ? 1 : 0;
                    }
                    cv[tt][j] = ((hi ? rb_ : ra_) < 4) ? cv[tt][j] : NEGV;
                }
            float wsel[4], wsum[4]; int esel[4];
#pragma unroll
            for (int tt = 0; tt < 4; ++tt) { wsel[tt] = 0.f; wsum[tt] = 0.f; esel[tt] = 0; }
#pragma unroll 1
            for (int k = 0; k < TOPK; ++k) {
#pragma unroll
                for (int tt = 0; tt < 4; ++tt) {
                    float bv = cv[tt][0]; int be = lane;
#pragma unroll
                    for (int j = 1; j < 4; ++j) if (cv[tt][j] > bv) { bv = cv[tt][j]; be = lane + 64 * j; }
                    const float rm = dpp_rowmax(bv);
                    const float mval = fmaxf(fmaxf(rl_f(rm, 0), rl_f(rm, 16)), fmaxf(rl_f(rm, 32), rl_f(rm, 48)));
                    const int ri = dpp_rowmin_i(bv == mval ? be : 0x7fffffff);
                    const int e = min(min(__builtin_amdgcn_readlane(ri, 0), __builtin_amdgcn_readlane(ri, 16)), min(__builtin_amdgcn_readlane(ri, 32), __builtin_amdgcn_readlane(ri, 48)));
                    const int jl = e >> 6, ll = e & 63;
                    const float smine = ((jl == 0 ? sc[tt][0] : 0.f) + (jl == 1 ? sc[tt][1] : 0.f)) + ((jl == 2 ? sc[tt][2] : 0.f) + (jl == 3 ? sc[tt][3] : 0.f));
                    const float sw = rl_f(smine, ll);
#pragma unroll
                    for (int j = 0; j < 4; ++j) cv[tt][j] = (lane == ll && jl == j) ? -INFINITY : cv[tt][j];
                    wsum[tt] += sw;
                    if (lane == k) { wsel[tt] = sw; esel[tt] = e; }
                }
            }
#pragma unroll
            for (int tt = 0; tt < 4; ++tt) {
                if (lane < TOPK) {
                    const int tok = it * 64 + wave * 8 + tg * 4 + tt;
                    const int a = tok * TOPK + lane;
                    P_topw[a] = wsel[tt] / wsum[tt] * 2.5f;
                    if (rep_ == 0) {
                        const int pos = atomicAdd(&cnt[esel[tt] * CNT_STRIDE], 1);
                        P_list[(size_t)esel[tt] * T + pos] = a;
                    }
                }
            }
        }
        __syncthreads();
    }
}

__device__ __forceinline__ void ph_gateup(int L, int rep_, const int wave_s_) {
    PH_FN_BEGIN
    (void)rep_;
    {
        PH_BEGIN;
        const float* weg = CTX_IN(8) + (size_t)L * NE * D * DF; const float* weu = CTX_IN(9) + (size_t)L * NE * D * DF;
        LAS int* rowva = (LAS int*)(lds + MOE_LDS_VA);
        {
            int* octr = (int*)(ws + WS_CTL + CTL_CNT_OFF + 8192) + (L * 4 + 2 * (rep_ & 1)) * 64;
            LAS int* slot = (LAS int*)(lds + 140000);
            for (;;) {
                __syncthreads();
                if (tid == 0) { int q; do { q = atomicAdd(octr, 1); } while (q >= NE && q < NE * 5 && cnt[((q - NE) >> 2) * CNT_STRIDE] <= MOE_XCAP); *slot = q; }
                __syncthreads();
                const int q = *slot;
                if (q >= NE * 5) break;
                const bool ovf = q >= NE;
                const int e = ovf ? (q - NE) >> 2 : q, pz = ovf ? (q - NE) & 3 : 0, npz = ovf ? 1 : 4, st0 = ovf ? 1 : 0, n = cnt[e * CNT_STRIDE];
                for (int r0 = 0; r0 < n; r0 += 1024) {
                    if (ovf && n - r0 <= MOE_XCAP) break;
#pragma unroll
                    for (int i = 0; i < 2; ++i) { int t_ = tid; asm volatile("" : "+v"(t_)); const int idx = r0 + i * 512 + t_; rowva[i * 512 + t_] = idx < n ? P_list[(size_t)e * T + idx] : TRASH_VA; }
                    __syncthreads();
                    moe_expert<false>(lds, tid, lane, wave, r32, hi, P_xb8, weg + (size_t)e * D * DF, weu + (size_t)e * D * DF, (n - r0) < 1024 ? (n - r0) : 1024, (void*)P_hb, pz, npz, st0, 1, false, !ovf && (n - r0) > 512 && (n - r0) <= MOE_XCAP);
                }
            }
        }
    }
    {
        PH_BEGIN;
        const pg8::Gemm g{P_xb, (const u16*)(ws + WS_WSGU) + (size_t)L * 512 * 1024, T, 512, D};
        const EpiSGU E{P_hbs};
        int* qctr = (int*)(ws + WS_CTL + CTL_CNT_OFF + 4096) + (L * 4 + 2 * (rep_ & 1)) * 64;
        LAS int* slot = (LAS int*)(lds + 140000);
        for (;;) {
            __syncthreads();
            if (tid == 0) *slot = atomicAdd(qctr, 1);
            __syncthreads();
            const int un = *slot;
            if (un >= 128) break;
            const pg8::FixedOrder S{un & 63, un >> 6};
            pg8::gemm_phase<EpiSGU, pg8::FixedOrder, false>((PG8_LAS unsigned char*)lds, g, S, E, nullptr, wave_s_ * 64 + lane_id_());
        }
    }
}

__device__ __forceinline__ void ph_down(int L, int rep_, const int wave_s_) {
    PH_FN_BEGIN
    (void)rep_;
    {
        PH_BEGIN;
        const float* wed = CTX_IN(10) + (size_t)L * NE * DF * D;
        LAS int* rowva = (LAS int*)(lds + MOE_LDS_VA); LAS float* roww = (LAS float*)(lds + MOE_LDS_W);
        {
            int* octr = (int*)(ws + WS_CTL + CTL_CNT_OFF + 8192) + (L * 4 + 1 + 2 * (rep_ & 1)) * 64;
            LAS int* slot = (LAS int*)(lds + 140000);
            for (;;) {
                __syncthreads();
                if (tid == 0) { int q; do { q = atomicAdd(octr, 1); } while (q >= NE && q < NE * 5 && cnt[((q - NE) >> 2) * CNT_STRIDE] <= 512); *slot = q; }
                __syncthreads();
                const int q = *slot;
                if (q >= NE * 5) break;
                const bool ovf = q >= NE;
                const int e = ovf ? (q - NE) >> 2 : q, pz = ovf ? ((q - NE) & 3) * 2 : 0, npz = ovf ? 2 : 8, st0 = ovf ? 1 : 0, n = cnt[e * CNT_STRIDE];
                for (int r0 = 0; r0 < n; r0 += 1024) {
                    if (ovf && n - r0 <= 512) break;
#pragma unroll
                    for (int i = 0; i < 2; ++i) { int t_ = tid; asm volatile("" : "+v"(t_)); const int idx = r0 + i * 512 + t_; const int va = idx < n ? P_list[(size_t)e * T + idx] : TRASH_VA; rowva[i * 512 + t_] = va; roww[i * 512 + t_] = va < A_TOT ? P_topw[va] * Y8_SCALE : 0.f; }
                    __syncthreads();
                    moe_expert<true>(lds, tid, lane, wave, r32, hi, (const unsigned char*)P_hb, wed + (size_t)e * DF * D, nullptr, (n - r0) < 1024 ? (n - r0) : 1024, (void*)P_yb, pz, npz, st0, 1, true);
                }
            }
        }
    }
    {
        PH_BEGIN;
        const pg8::Gemm g{P_hbs, (const u16*)(ws + WS_WSD) + (size_t)L * D * DF, T, D, DF};
        const EpiSD E{P_yb};
        int* qctr = (int*)(ws + WS_CTL + CTL_CNT_OFF + 4096) + (L * 4 + 1 + 2 * (rep_ & 1)) * 64;
        LAS int* slot = (LAS int*)(lds + 140000);
        for (;;) {
            __syncthreads();
            if (tid == 0) *slot = atomicAdd(qctr, 1);
            __syncthreads();
            const int un = *slot;
            if (un >= 256) break;
            const pg8::FixedOrder S{un & 63, un >> 6};
            pg8::gemm_phase<EpiSD, pg8::FixedOrder, false>((PG8_LAS unsigned char*)lds, g, S, E, nullptr, wave_s_ * 64 + lane_id_());
        }
    }
}

__device__ __forceinline__ void ph_combine(int L, int rep_, const int wave_s_) {
    PH_FN_BEGIN
    (void)rep_;
    PH_BEGIN;
    const float* lng = CTX_IN(14) + L * D; const float* lnb = CTX_IN(15) + L * D;
    float* dst = AS_GLOBAL(float, ctx_ld(16));
    for (int row = bid * 8 + wave; row < T; row += G * 8) {
        u32x4 yv[TOPK + 1][2];
#pragma unroll
        for (int k = 0; k < TOPK + 1; ++k) {
            const size_t va = k < TOPK ? (size_t)row * TOPK + k : (size_t)A_TOT + row;
            if (k < TOPK) {
#pragma unroll
                for (int j = 0; j < 2; ++j) { const u32x2 w8 = *(const u32x2*)((const unsigned char*)P_yb + va * D + j * 512 + lane * 8); yv[k][j][0] = w8[0]; yv[k][j][1] = w8[1]; yv[k][j][2] = 0u; yv[k][j][3] = 0u; }
            } else {
#pragma unroll
                for (int j = 0; j < 2; ++j) yv[k][j] = *(const u32x4*)(P_yb + va * D + j * 512 + lane * 8);
            }
        }
        float v[16];
#pragma unroll
        for (int j = 0; j < 2; ++j) {
            const u32x4 t = *(const u32x4*)(P_xb + (size_t)row * D + j * 512 + lane * 8);
#pragma unroll
            for (int c = 0; c < 4; ++c) { v[j * 8 + 2 * c] = DN_ALPHA * bf2f(t[c] & 0xFFFFu); v[j * 8 + 2 * c + 1] = DN_ALPHA * bf2f(t[c] >> 16); }
        }
#pragma unroll
        for (int k = 0; k < TOPK + 1; ++k)
#pragma unroll
            for (int j = 0; j < 2; ++j) {
                if (k < TOPK) {
#pragma unroll
                    for (int c = 0; c < 2; ++c) {
                        const f32x2_ lo2 = __builtin_amdgcn_cvt_pk_f32_fp8((int)yv[k][j][c], false), hi2 = __builtin_amdgcn_cvt_pk_f32_fp8((int)yv[k][j][c], true);
                        v[j * 8 + 4 * c] += lo2[0] * (1.f / Y8_SCALE); v[j * 8 + 4 * c + 1] += lo2[1] * (1.f / Y8_SCALE); v[j * 8 + 4 * c + 2] += hi2[0] * (1.f / Y8_SCALE); v[j * 8 + 4 * c + 3] += hi2[1] * (1.f / Y8_SCALE);
                    }
                } else {
#pragma unroll
                    for (int c = 0; c < 4; ++c) { v[j * 8 + 2 * c] += bf2f(yv[k][j][c] & 0xFFFFu); v[j * 8 + 2 * c + 1] += bf2f(yv[k][j][c] >> 16); }
                }
            }
        float sm = 0.f;
#pragma unroll
        for (int i = 0; i < 16; ++i) sm += v[i];
        const float mu = wave_sum(sm) * (1.f / D);
        float q = 0.f;
#pragma unroll
        for (int i = 0; i < 16; ++i) { const float d = v[i] - mu; q += d * d; }
        const float rstd = rsqrtf(wave_sum(q) * (1.f / D) + LN_EPS);
#pragma unroll
        for (int j = 0; j < 2; ++j) {
            const f32x4 g0 = *(const f32x4*)(lng + j * 512 + lane * 8), g1 = *(const f32x4*)(lng + j * 512 + lane * 8 + 4);
            const f32x4 b0 = *(const f32x4*)(lnb + j * 512 + lane * 8), b1 = *(const f32x4*)(lnb + j * 512 + lane * 8 + 4);
            f32x4 o0, o1;
#pragma unroll
            for (int c = 0; c < 4; ++c) { o0[c] = (v[j * 8 + c] - mu) * rstd * g0[c] + b0[c]; o1[c] = (v[j * 8 + 4 + c] - mu) * rstd * g1[c] + b1[c]; }
            if (L == 1) { *(f32x4*)(dst + (size_t)row * D + j * 512 + lane * 8) = o0; *(f32x4*)(dst + (size_t)row * D + j * 512 + lane * 8 + 4) = o1; }
            if (L == 0) { u32x4 w; w[0] = cvtpk(o0[0], o0[1]); w[1] = cvtpk(o0[2], o0[3]); w[2] = cvtpk(o1[0], o1[1]); w[3] = cvtpk(o1[2], o1[3]); *(u32x4*)(P_xb + (size_t)row * D + j * 512 + lane * 8) = w; }
        }
    }
}

__global__ void __launch_bounds__(NTHR, 2) fwd(Args args) {
    extern __shared__ __attribute__((aligned(16))) unsigned char lds_raw[];
    LAS char* lds = (LAS char*)lds_raw;
    unsigned char* const ws = args.ws;
    const int lo = args.ph_lo, hi_ph = args.ph_hi;
    const int wave_s_ = __builtin_amdgcn_readfirstlane(threadIdx.x >> 6);
    if (threadIdx.x < 18) {
        const uint64_t v = threadIdx.x < 16 ? (uint64_t)args.in[threadIdx.x] : (threadIdx.x == 16 ? (uint64_t)args.out : (uint64_t)args.ws);
        ((LAS uint64_t*)(lds + LDS_CTX))[threadIdx.x] = v;
    }
    __syncthreads();
#define IN(k) (lo <= (k) && (k) < hi_ph)

#if MK_ONE_LAUNCH
    if (threadIdx.x < 4) ((LAS unsigned*)(lds + LDS_BAR))[threadIdx.x] = 0u;
    __syncthreads();
    XcdBarrier bar = xcd_barrier_post((unsigned*)(ws + WS_CTL), (volatile LAS unsigned*)(lds + LDS_BAR), wave_s_ == 0 && lane_id_() == 0);
#define GRID_BAR() xcd_barrier(bar, wave_s_ == 0 && lane_id_() == 0)
#else
#define GRID_BAR() do { } while (0)
#endif
#define SEAM(k) do { if (IN(k) && IN((k) + 1)) GRID_BAR(); } while (0)

    for (int rep_ = 0; rep_ < ((IN(0) && PHK(0)) ? REPS(0) : 0); ++rep_) { ph_p0(0, rep_, wave_s_); }
    SEAM(0);

    for (int L = 0; L < 2; ++L) {
        const int pb = 1 + 10 * L;
        for (int rep_ = 0; rep_ < ((IN(pb + 0) && PHK(1)) ? REPS(1) : 0); ++rep_) { ph_qkv(L, rep_, wave_s_); }
        SEAM(pb + 0);

        if (L == 0) {
            for (int rep_ = 0; rep_ < ((IN(pb + 1) && PHK(2)) ? REPS(2) : 0); ++rep_) { ph_kmean(L, rep_, wave_s_); }
            SEAM(pb + 1);
            for (int rep_ = 0; rep_ < ((IN(pb + 2) && PHK(11)) ? REPS(11) : 0); ++rep_) { ph_gate(L, rep_, wave_s_); }
            SEAM(pb + 2);
        }

        if (L == 0) {
            for (int rep_ = 0; rep_ < ((IN(pb + 3) && PHK(3)) ? REPS(3) : 0); ++rep_) { ph_moba(L, rep_, wave_s_); }
            SEAM(pb + 3);
            for (int rep_ = 0; rep_ < ((IN(pb + 4) && PHK(12)) ? REPS(12) : 0); ++rep_) { ph_mobamerge(L, rep_, wave_s_); }
        } else {
            for (int rep_ = 0; rep_ < ((IN(pb + 3) && PHK(4)) ? REPS(4) : 0); ++rep_) { ph_dil(L, rep_, wave_s_); }
            SEAM(pb + 3);
            for (int rep_ = 0; rep_ < ((IN(pb + 4) && PHK(5)) ? REPS(5) : 0); ++rep_) { ph_merge(L, rep_, wave_s_); }
        }
        SEAM(pb + 4);

        for (int rep_ = 0; rep_ < ((IN(pb + 5) && PHK(6)) ? REPS(6) : 0); ++rep_) { ph_wo(L, rep_, wave_s_); }
        SEAM(pb + 5);

        for (int rep_ = 0; rep_ < ((IN(pb + 6) && PHK(7)) ? REPS(7) : 0); ++rep_) { ph_router(L, rep_, wave_s_); }
        SEAM(pb + 6);

        for (int rep_ = 0; rep_ < ((IN(pb + 7) && PHK(8)) ? REPS(8) : 0); ++rep_) { ph_gateup(L, rep_, wave_s_); }
        SEAM(pb + 7);

        for (int rep_ = 0; rep_ < ((IN(pb + 8) && PHK(9)) ? REPS(9) : 0); ++rep_) { ph_down(L, rep_, wave_s_); }
        SEAM(pb + 8);

        for (int rep_ = 0; rep_ < ((IN(pb + 9) && PHK(10)) ? REPS(10) : 0); ++rep_) { ph_combine(L, rep_, wave_s_); }
        if (L == 0) SEAM(pb + 9);
    }
}

extern "C" void kernel_launch(void* const* d_in, const int* in_sizes, int n_in, void* d_out, int out_size, void* d_ws, size_t ws_size, hipStream_t stream) {
    static int grid = 0;
    if (grid == 0) {
        if (n_in != 16 || out_size != T * D || ws_size < WS_END2) { fprintf(stderr, "kernel_launch: unexpected problem (n_in %d out %d ws %zu need %zu)\n", n_in, out_size, ws_size, (size_t)WS_END2); grid = -1; return; }
        int dev = 0, cus = 0, per_cu = 0;
        if (hipGetDevice(&dev) != hipSuccess || hipDeviceGetAttribute(&cus, hipDeviceAttributeMultiprocessorCount, dev) != hipSuccess) { grid = -1; return; }
        if (hipFuncSetAttribute((const void*)fwd, hipFuncAttributeMaxDynamicSharedMemorySize, LDS_BYTES) != hipSuccess) { fprintf(stderr, "kernel_launch: hipFuncSetAttribute failed\n"); grid = -1; return; }
        if (hipOccupancyMaxActiveBlocksPerMultiprocessor(&per_cu, (const void*)fwd, NTHR, LDS_BYTES) != hipSuccess || per_cu < 1) { fprintf(stderr, "kernel_launch: occupancy query says %d\n", per_cu); (void)hipGetLastError(); per_cu = 1; }
        grid = cus;
    }
    if (grid < 0) return;
    (void)hipMemsetAsync((char*)d_ws + WS_CTL, 0, CTL_BYTES, stream);
    Args a{};
    for (int i = 0; i < 16; ++i) a.in[i] = (const float*)d_in[i];
    a.out = (float*)d_out; a.ws = (unsigned char*)d_ws;
#if MK_ONE_LAUNCH
    a.ph_lo = 0; a.ph_hi = N_PHASES;
    hipLaunchKernelGGL(fwd, dim3(grid), dim3(NTHR), LDS_BYTES, stream, a);
#else
    for (int ph = 0; ph < N_PHASES; ++ph) {
        if (ph == 12 || ph == 13) continue;
        a.ph_lo = ph; a.ph_hi = ph + 1;
        hipLaunchKernelGGL(fwd, dim3(grid), dim3(NTHR), LDS_BYTES, stream, a);
    }
#endif
}
```

```cpp
#include <hip/hip_runtime.h>
#include <hip/hip_bf16.h>
#include <stdint.h>
#include <stdio.h>

#ifndef MK_ONE_LAUNCH
#define MK_ONE_LAUNCH 1
#endif

#ifndef PHMASK
#define PHMASK 0x1FFF
#endif
#define PHK(k) ((PHMASK >> (k)) & 1)
#ifndef REPEAT_KIND
#define REPEAT_KIND -1
#endif
#define REPS(k) ((k) == REPEAT_KIND ? 2 : 1)
#define LAS __attribute__((address_space(3)))
typedef __attribute__((ext_vector_type(8))) short bf16x8;
typedef __attribute__((ext_vector_type(16))) float f32x16;
typedef __attribute__((ext_vector_type(4))) float f32x4;
typedef __attribute__((ext_vector_type(4))) unsigned u32x4;
typedef __attribute__((ext_vector_type(2))) unsigned u32x2;
typedef unsigned short u16;

constexpr int D = 1024, BATCH = 2, SEQ = 8192, T = BATCH * SEQ, NH = 16, HD = 64;
constexpr int NE = 256, TOPK = 8, DF = 256;
constexpr int A_TOT = T * TOPK;
constexpr int MOBA_BLK = 256, MOBA_NB = SEQ / MOBA_BLK;
constexpr float DN_ALPHA = 1.4142135623730951f;
constexpr float LN_EPS = 1e-5f;
constexpr float LOG2E = 1.4426950408889634f;
constexpr float LN2 = 0.6931471805599453f;
constexpr float NEGV = -1e30f;
constexpr int NTHR = 512;

constexpr size_t al256(size_t x) { return (x + 255) & ~(size_t)255; }
constexpr size_t WS_CTL = 0;
constexpr size_t CTL_BYTES = 131072;
constexpr size_t CTL_CNT_OFF = 32768;
constexpr size_t CTL_ECNT_OFF = 65536;
constexpr int CNT_STRIDE = 32;
constexpr size_t WS_XB = WS_CTL + CTL_BYTES;
constexpr size_t WS_X1 = WS_XB + al256((size_t)T * D * 2);
constexpr size_t WS_X2 = WS_X1 + al256((size_t)T * D * 4);
constexpr size_t WS_YPRE = WS_X2 + al256((size_t)T * D * 4);
constexpr size_t WS_QKV = WS_YPRE + al256((size_t)T * D * 4);
constexpr size_t WS_VT = WS_QKV + al256((size_t)T * 9216 * 2);
constexpr size_t WS_KM = WS_VT + al256((size_t)3 * T * D * 2);
constexpr size_t WS_AO = WS_KM + al256((size_t)BATCH * NH * MOBA_NB * HD * 4);
constexpr size_t WS_OG = WS_AO + al256((size_t)T * D * 2);
constexpr size_t WS_LSE = WS_OG + al256((size_t)3 * T * D * 2);
constexpr size_t WS_TOPW = WS_LSE + al256((size_t)3 * T * NH * 4);
constexpr size_t WS_LIST = WS_TOPW + al256((size_t)T * TOPK * 4);
constexpr size_t WS_HB = WS_LIST + al256((size_t)NE * T * 4);
constexpr size_t WS_YB = WS_HB + al256((size_t)(A_TOT + T + 1) * DF * 2);
constexpr size_t WS_END = WS_YB + al256((size_t)(A_TOT + T + 1) * D * 2);
constexpr int TRASH_VA = A_TOT + T;
constexpr size_t WS_SELM = WS_END;
constexpr size_t WS_PART = WS_SELM + al256((size_t)T * NH * 4);
constexpr size_t WS_PLSE = WS_PART + al256((size_t)T * NH * 4 * 64 * 2);
constexpr size_t WS_WQK0 = WS_PLSE + al256((size_t)T * NH * 4 * 4);
constexpr size_t WS_WV0 = WS_WQK0 + (size_t)2048 * 1024 * 2;
constexpr size_t WS_WQK1 = WS_WV0 + (size_t)1024 * 1024 * 2;
constexpr size_t WS_WV1 = WS_WQK1 + (size_t)6144 * 1024 * 2;
constexpr size_t WS_WO = WS_WV1 + (size_t)3072 * 1024 * 2;
constexpr size_t WS_WSGU = WS_WO + (size_t)2 * 1024 * 1024 * 2;
constexpr size_t WS_WSD = WS_WSGU + (size_t)2 * 512 * 1024 * 2;
constexpr size_t WS_XB8 = WS_WSD + (size_t)2 * 1024 * 256 * 2;
constexpr size_t WS_HBS = WS_XB8 + (size_t)T * D;
constexpr size_t WS_WRH = WS_HBS + (size_t)T * DF * 2;
constexpr size_t WS_WRL = WS_WRH + (size_t)2 * 256 * 1024 * 2;
constexpr size_t WS_END2 = WS_WRL + (size_t)2 * 256 * 1024 * 2;

constexpr int LDP = 40;
constexpr int STAGE_BYTES = 2 * 256 * LDP * 2;
constexpr int LDS_ROWID = 2 * STAGE_BYTES;
constexpr int LDS_ROWW = LDS_ROWID + 1024;
constexpr int XS_PITCH = 1028;
constexpr int LDS_BYTES = 163840;
constexpr int LDS_BAR = 161792;

__device__ __forceinline__ int lane_id_() { int l; asm volatile("v_mbcnt_lo_u32_b32 %0, -1, 0\n\tv_mbcnt_hi_u32_b32 %0, -1, %0" : "=v"(l)); return l; }
__device__ __forceinline__ float shxf(float v, int m, int lane) { return __int_as_float(__builtin_amdgcn_ds_bpermute((lane ^ m) << 2, __float_as_int(v))); }
__device__ __forceinline__ int shxi(int v, int m, int lane) { return __builtin_amdgcn_ds_bpermute((lane ^ m) << 2, v); }
#define XB_TMO      128
#define XB_XCNT(j)  (256  + 64 * (j))
#define XB_XSUB(j)  (1280 + 64 * (j))
#define XB_XGEN(j)  (2304 + 64 * (j))
#define XB_TOP      3328
#define XB_TOPGEN   3392
#define XCD_BAR_WORDS 3456
#define XB_SPIN_CAP (1u << 18)
__device__ __forceinline__ unsigned xb_ld(unsigned* p)              { return __hip_atomic_load(p, __ATOMIC_RELAXED, __HIP_MEMORY_SCOPE_AGENT); }
__device__ __forceinline__ unsigned xb_add(unsigned* p, unsigned v) { return __hip_atomic_fetch_add(p, v, __ATOMIC_RELAXED, __HIP_MEMORY_SCOPE_AGENT); }
__device__ __forceinline__ unsigned xb_xcc_id() { return (unsigned)__builtin_amdgcn_s_getreg((3 << 11) | 20) & 0xFu; }
#define XB_SPIN(cond, bar) do { unsigned _sp = 0; while (cond) { __builtin_amdgcn_s_sleep(1); \
    if ((++_sp & 255u) == 0u) { if (xb_ld(&(bar)[XB_TMO])) break; if (_sp > XB_SPIN_CAP) { atomicAdd(&(bar)[XB_TMO], 1u); break; } } } } while (0)
struct XcdBarrier { unsigned* bar; unsigned x; volatile LAS unsigned* st; };
__device__ __forceinline__ XcdBarrier xcd_barrier_post(unsigned* bar, volatile LAS unsigned* st, const bool leader) {
    XcdBarrier b; b.bar = bar; b.x = xb_xcc_id(); b.st = st;
    if (leader) (void)xb_add(&bar[XB_XCNT(b.x)], 1u);
    return b;
}
__device__ __forceinline__ void xcd_barrier_complete(unsigned* bar, unsigned x, unsigned& nloc, unsigned& nx) {
    const unsigned G = gridDim.x * gridDim.y * gridDim.z;
    unsigned sum, cnt, mine, sp = 0u;
    for (;;) {
        sum = 0u; cnt = 0u; mine = 0u;
#pragma unroll
        for (unsigned j = 0; j < 16; ++j) { const unsigned c = xb_ld(&bar[XB_XCNT(j)]); sum += c; cnt += (c > 0u) ? 1u : 0u; mine = (j == x) ? c : mine; }
        if (sum == G) break;
        __builtin_amdgcn_s_sleep(1);
        if ((++sp & 255u) == 0u) { if (xb_ld(&bar[XB_TMO])) break; if (sp > XB_SPIN_CAP) { atomicAdd(&bar[XB_TMO], 1u); break; } }
    }
    nloc = mine > 0u ? mine : 1u; nx = cnt > 0u ? cnt : 1u;
}
__device__ __forceinline__ void xcd_barrier(const XcdBarrier& b, const bool leader) {
    asm volatile("s_waitcnt vmcnt(0)" ::: "memory");
    __syncthreads();
    if (leader) {
        unsigned* bar = b.bar;
        __builtin_amdgcn_s_waitcnt(0);
        unsigned nloc = b.st[0], nx = b.st[1];
        if (nloc == 0u) { xcd_barrier_complete(bar, b.x, nloc, nx); b.st[0] = nloc; b.st[1] = nx; }
        const unsigned old = xb_add(&bar[XB_XSUB(b.x)], 1u);
        const unsigned gen = old / nloc;
        if (old + 1u == (gen + 1u) * nloc) {
            __builtin_amdgcn_fence(__ATOMIC_RELEASE, "agent");
            asm volatile("s_waitcnt vmcnt(0)" ::: "memory");
            const unsigned og = xb_add(&bar[XB_TOP], 1u);
            const unsigned tg = og / nx;
            if (og + 1u == (tg + 1u) * nx) xb_add(&bar[XB_TOPGEN], 1u);
            else XB_SPIN(xb_ld(&bar[XB_TOPGEN]) == tg, bar);
            __builtin_amdgcn_fence(__ATOMIC_ACQUIRE, "agent");
            xb_add(&bar[XB_XGEN(b.x)], 1u);
            asm volatile("s_waitcnt vmcnt(0)" ::: "memory");
        } else {
            XB_SPIN(xb_ld(&bar[XB_XGEN(b.x)]) == gen, bar);
            __builtin_amdgcn_fence(__ATOMIC_ACQUIRE, "agent");
            asm volatile("s_waitcnt vmcnt(0)" ::: "memory");
        }
    }
    __syncthreads();
}

typedef __attribute__((ext_vector_type(2))) __bf16 bf16x2_t;
typedef __attribute__((ext_vector_type(2))) float f32x2_t;
__device__ __forceinline__ unsigned cvtpk(float lo, float hi) { f32x2_t f; f[0] = lo; f[1] = hi; return __builtin_bit_cast(unsigned, __builtin_convertvector(f, bf16x2_t)); }
__device__ __forceinline__ float bf2f(unsigned v16) { return __uint_as_float(v16 << 16); }
__device__ __forceinline__ int crow(int r, int hi) { return (r & 3) + 8 * (r >> 2) + 4 * hi; }
#define MFMA_BF16(a, b, c) __builtin_amdgcn_mfma_f32_32x32x16_bf16(a, b, c, 0, 0, 0)
__device__ __forceinline__ float wave_sum(float v) {
    v += __int_as_float(__builtin_amdgcn_update_dpp(0, __float_as_int(v), 0xB1, 0xF, 0xF, true));
    v += __int_as_float(__builtin_amdgcn_update_dpp(0, __float_as_int(v), 0x4E, 0xF, 0xF, true));
    v += __int_as_float(__builtin_amdgcn_update_dpp(0, __float_as_int(v), 0x141, 0xF, 0xF, true));
    v += __int_as_float(__builtin_amdgcn_update_dpp(0, __float_as_int(v), 0x140, 0xF, 0xF, true));
    const int vi = __float_as_int(v);
    return (__int_as_float(__builtin_amdgcn_readlane(vi, 0)) + __int_as_float(__builtin_amdgcn_readlane(vi, 16))) + (__int_as_float(__builtin_amdgcn_readlane(vi, 32)) + __int_as_float(__builtin_amdgcn_readlane(vi, 48)));
}

namespace pg8 {
#define PG8_LAS __attribute__((address_space(3)))
typedef unsigned short bf16_t;
typedef short bf16x8 __attribute__((ext_vector_type(8)));
typedef float f32x4 __attribute__((ext_vector_type(4)));
typedef unsigned u32x4 __attribute__((ext_vector_type(4)));
constexpr int BM = 256, BK = 64, HALF = 128, HTB = HALF * BK * 2  , STAGE_BYTES = 8 * HTB, NXCD = 8, WGM = 8;

__host__ __device__ __forceinline__ int lds_byte(int r, int c) { const int st = (r >> 4) * 2 + (c >> 5), rr = r & 15, cc = c & 31, ob = rr * 64 + cc * 2; return st * 1024 + (ob ^ (((ob >> 9) & 1) << 5)); }
__host__ __device__ __forceinline__ void stage_rc(int b, int& R, int& C) { const int st = b / 1024, sb = b % 1024, swz = sb ^ (((sb >> 9) & 1) << 5); R = (st >> 1) * 16 + swz / 64; C = (st & 1) * 32 + (swz % 64) / 2; }
__host__ __device__ __forceinline__ int perm32(int rho) { const int n = rho >> 4, i = rho & 15; return 8 * (i >> 2) + 4 * n + (i & 3); }

struct Unit { int pm, pn; };
struct Gemm { const bf16_t* A; const bf16_t* Bt; int M, N, K; };
struct FixedOrder {
    int pm, pn;
    __device__ __forceinline__ bool next(int i, Unit& u) const { if (i != 0) return false; u.pm = pm; u.pn = pn; return true; }
    __device__ __forceinline__ void a_ready(const Unit&) const {}
    __device__ __forceinline__ void done(const Unit&) const {}
};

struct StaticOrder {
    int nM, nN, nwg, G, c;
    __host__ __device__ void init(int M, int N, int G_, int c_) { nM = M / BM; nN = N / BM; nwg = nM * nN; G = G_; c = c_; }
    __host__ __device__ bool next(int i, Unit& u) const {
        const long L = (long)i * G + c; if (L >= nwg) return false;
        int wgid = (int)L; { const int q = nwg / NXCD, r = nwg % NXCD, xcd = wgid % NXCD, off = wgid / NXCD; wgid = (xcd < r ? xcd * (q + 1) : r * (q + 1) + (xcd - r) * q) + off; }
        const int nig = WGM * nN, gid = wgid / nig, fm = gid * WGM, gsz = (nM - fm) < WGM ? (nM - fm) : WGM;
        u.pm = fm + ((wgid % nig) % gsz); u.pn = (wgid % nig) / gsz; return true;
    }
    __device__ __forceinline__ void a_ready(const Unit&) const {}
    __device__ __forceinline__ void done(const Unit&) const {}
};

template <class Epi, class Sched, bool SWAP = false, bool STAMP = false>
__device__ __forceinline__ void gemm_phase(PG8_LAS unsigned char* lds, const Gemm g, const Sched& S, const Epi& E, unsigned long long* stamps, const int tid_in) {
    int tid_ = tid_in; asm volatile("" : "+v"(tid_));
    const int tid = tid_, wid = __builtin_amdgcn_readfirstlane(tid >> 6), lane = tid & 63, wr = wid >> 2, wc = wid & 3, fr = lane & 15, fq = lane >> 4;
    const int K = g.K, nt = K / BK;
    int ts_lo = 0, ts_hi = 0, nts = 0; const unsigned long long rt_entry = STAMP ? (unsigned long long)wall_clock64() : 0ull;
#define PG8_STAMP() do { if (STAMP && wid == 0 && nts < 64) { const unsigned long long _c = (unsigned long long)clock64(); \
        ts_lo = (lane == nts) ? (int)(unsigned)_c : ts_lo; ts_hi = (lane == nts) ? (int)(unsigned)(_c >> 32) : ts_hi; ++nts; } } while (0)
    PG8_STAMP();
    unsigned voffA[2], voffB[2];
#pragma unroll
    for (int i = 0; i < 2; ++i) { int R, C; stage_rc(tid * 16 + i * 8192, R, C); const int Rb = Epi::PERM ? ((R & ~31) + perm32(R & 31)) : R;
        voffA[i] = (unsigned)(R * K + C) * 2u; voffB[i] = (unsigned)(Rb * K + C) * 2u; }
    const size_t kstep = (size_t)(BK * 2);
    const size_t hstep = (size_t)HALF * K * 2;
    const size_t tstep = 2 * hstep;
    const unsigned ldsw = (unsigned)wid * 1024u;
    const int aoff = lds_byte(wr * 64 + fr, fq * 8), boff = lds_byte(wc * 32 + fr, fq * 8);
#define PG8_SA(b, h) (((b) * 2 + (h)) * HTB)
#define PG8_SB(b, h) ((4 + (b) * 2 + (h)) * HTB)
#define PG8_STAGE(bufoff, gbase, voff) do { _Pragma("unroll") for (int _i = 0; _i < 2; ++_i) \
        __builtin_amdgcn_global_load_lds((const unsigned*)((const char*)(gbase) + (voff)[_i]), (PG8_LAS unsigned*)(lds + (bufoff) + ldsw + _i * 8192), 16, 0, 0); } while (0)
#define PG8_LDA(dst, b, h) do { _Pragma("unroll") for (int m = 0; m < 4; ++m) _Pragma("unroll") for (int k = 0; k < 2; ++k) dst[m][k] = *(const PG8_LAS bf16x8*)(lds + PG8_SA(b, h) + aoff + m * 2048 + k * 1024); } while (0)
#define PG8_LDB(dst, b, h) do { _Pragma("unroll") for (int n = 0; n < 2; ++n) _Pragma("unroll") for (int k = 0; k < 2; ++k) dst[n][k] = *(const PG8_LAS bf16x8*)(lds + PG8_SB(b, h) + boff + n * 2048 + k * 1024); } while (0)
#define PG8_MMA(ai, bj, At, Bt) do { __builtin_amdgcn_s_setprio(1); _Pragma("unroll") for (int m = 0; m < 4; ++m) _Pragma("unroll") for (int n = 0; n < 2; ++n) _Pragma("unroll") for (int k = 0; k < 2; ++k) \
        acc[ai][bj][m][n] = SWAP ? __builtin_amdgcn_mfma_f32_16x16x32_bf16(At[m][k], Bt[n][k], acc[ai][bj][m][n], 0, 0, 0) : __builtin_amdgcn_mfma_f32_16x16x32_bf16(Bt[n][k], At[m][k], acc[ai][bj][m][n], 0, 0, 0); __builtin_amdgcn_s_setprio(0); } while (0)
#define PG8_WAIT_V(n) asm volatile("s_waitcnt vmcnt(" #n ")" ::: "memory")
#define PG8_WAIT_L(n) asm volatile("s_waitcnt lgkmcnt(" #n ")" ::: "memory")
#define PG8_BAR __builtin_amdgcn_s_barrier()
#define PG8_SCHED __builtin_amdgcn_sched_barrier(0)
    Unit cur, nxt; int ui = 0;
    if (!S.next(0, cur)) return;
    f32x4 acc[2][2][4][2];
#pragma unroll
    for (int a = 0; a < 2; ++a)
#pragma unroll
        for (int b = 0; b < 2; ++b)
#pragma unroll
            for (int m = 0; m < 4; ++m)
#pragma unroll
                for (int n = 0; n < 2; ++n) acc[a][b][m][n] = (f32x4){0.f, 0.f, 0.f, 0.f};
    bf16x8 At[4][2], B0[2][2], B1[2][2];
    const char* cA = (const char*)g.A + (size_t)cur.pm * tstep; const char* cB = (const char*)g.Bt + (size_t)cur.pn * tstep;
    S.a_ready(cur);
    PG8_STAGE(PG8_SB(0, 0), cB, voffB); PG8_STAGE(PG8_SA(0, 0), cA, voffA); PG8_STAGE(PG8_SB(0, 1), cB + hstep, voffB); PG8_STAGE(PG8_SA(0, 1), cA + hstep, voffA);
    if (wr == 1) PG8_BAR;
    PG8_WAIT_V(4); PG8_BAR;
    PG8_STAGE(PG8_SB(1, 0), cB + kstep, voffB); PG8_STAGE(PG8_SA(1, 0), cA + kstep, voffA); PG8_STAGE(PG8_SB(1, 1), cB + hstep + kstep, voffB);
    PG8_WAIT_V(6); PG8_BAR;
    PG8_STAMP();
    for (;;) {
        const bool has_next = S.next(ui + 1, nxt);
        const char* nA = has_next ? (const char*)g.A + (size_t)nxt.pm * tstep : cA; const char* nB = has_next ? (const char*)g.Bt + (size_t)nxt.pn * tstep : cB;
        for (int t = 0; t < nt; t += 2) {
            const bool last = (t == nt - 2);
            const char* a1 = cA + (size_t)(t + 1) * kstep;
            const char* a2 = last ? nA : cA + (size_t)(t + 2) * kstep; const char* b2 = last ? nB : cB + (size_t)(t + 2) * kstep;
            const char* a3 = a2 + kstep; const char* b3 = b2 + kstep;
            if (last && has_next) S.a_ready(nxt);
            PG8_LDB(B0, 0, 0); PG8_SCHED; PG8_LDA(At, 0, 0); PG8_STAGE(PG8_SA(1, 1), a1 + hstep, voffA);
            PG8_WAIT_L(8); PG8_BAR; PG8_WAIT_L(0); PG8_MMA(0, 0, At, B0); PG8_BAR; PG8_SCHED;
            PG8_LDB(B1, 0, 1); PG8_STAGE(PG8_SB(0, 0), b2, voffB);
            PG8_BAR; PG8_WAIT_L(0); PG8_MMA(0, 1, At, B1); PG8_BAR;
            PG8_LDA(At, 0, 1); PG8_STAGE(PG8_SA(0, 0), a2, voffA);
            PG8_BAR; PG8_WAIT_L(0); PG8_MMA(1, 0, At, B0); PG8_BAR; PG8_SCHED;
            PG8_STAGE(PG8_SB(0, 1), b2 + hstep, voffB);
            PG8_WAIT_V(6); PG8_BAR; PG8_MMA(1, 1, At, B1); PG8_BAR;
            PG8_LDB(B0, 1, 0); PG8_SCHED; PG8_LDA(At, 1, 0); PG8_STAGE(PG8_SA(0, 1), a2 + hstep, voffA);
            PG8_WAIT_L(8); PG8_BAR; PG8_WAIT_L(0); PG8_MMA(0, 0, At, B0); PG8_BAR; PG8_SCHED;
            PG8_LDB(B1, 1, 1); PG8_STAGE(PG8_SB(1, 0), b3, voffB);
            PG8_BAR; PG8_WAIT_L(0); PG8_MMA(0, 1, At, B1); PG8_BAR;
            PG8_LDA(At, 1, 1); PG8_STAGE(PG8_SA(1, 0), a3, voffA);
            PG8_BAR; PG8_WAIT_L(0); PG8_MMA(1, 0, At, B0); PG8_BAR; PG8_SCHED;
            PG8_STAGE(PG8_SB(1, 1), b3 + hstep, voffB);
            PG8_WAIT_V(6); PG8_BAR; PG8_MMA(1, 1, At, B1); PG8_BAR;
        }
        PG8_STAMP();
        if constexpr (!Epi::AFTER_DRAIN) { E(acc, cur, wr, wc, fr, fq); S.done(cur); }
        PG8_STAMP();
        if (!has_next) break;
#pragma unroll
        for (int a = 0; a < 2; ++a)
#pragma unroll
            for (int b = 0; b < 2; ++b)
#pragma unroll
                for (int m = 0; m < 4; ++m)
#pragma unroll
                    for (int n = 0; n < 2; ++n) acc[a][b][m][n] = (f32x4){0.f, 0.f, 0.f, 0.f};
        cur = nxt; cA = nA; cB = nB; ++ui;
    }
    PG8_WAIT_V(0);
    if (wr == 0) PG8_BAR;
    PG8_BAR;
    if constexpr (Epi::AFTER_DRAIN) { E.fused(acc, cur, wr, wc, fr, fq, lds, wid, lane); S.done(cur); }
    PG8_STAMP();
    if (STAMP && wid == 0) { stamps[lane] = lane < nts ? (((unsigned long long)(unsigned)ts_hi << 32) | (unsigned)ts_lo) : 0ull;
        if (lane == 62) stamps[62] = rt_entry; if (lane == 63) stamps[63] = (unsigned long long)wall_clock64(); }
#undef PG8_STAMP
#undef PG8_SA
#undef PG8_SB
#undef PG8_STAGE
#undef PG8_LDA
#undef PG8_LDB
#undef PG8_MMA
#undef PG8_WAIT_V
#undef PG8_WAIT_L
#undef PG8_BAR
#undef PG8_SCHED
}
}

struct EpiQK {
    static constexpr bool PERM = true, AFTER_DRAIN = false;
    u16* O; int ldc;
    __device__ __forceinline__ void operator()(const pg8::f32x4 (&acc)[2][2][4][2], const pg8::Unit& u, int wr, int wc, int fr, int fq) const {
        const int col0 = u.pn * 256 + wc * 32 + 8 * fq, row0 = u.pm * 256 + wr * 64 + fr;
#pragma unroll
        for (int ai = 0; ai < 2; ++ai)
#pragma unroll
            for (int m = 0; m < 4; ++m) { u16* rowp = O + (size_t)(row0 + ai * 128 + m * 16) * ldc + col0;
#pragma unroll
                for (int bj = 0; bj < 2; ++bj) { const pg8::f32x4 v0 = acc[ai][bj][m][0], v1 = acc[ai][bj][m][1];
                    u32x4 w; w[0] = cvtpk(v0[0], v0[1]); w[1] = cvtpk(v0[2], v0[3]); w[2] = cvtpk(v1[0], v1[1]); w[3] = cvtpk(v1[2], v1[3]);
                    *(u32x4*)(rowp + bj * 128) = w; } }
    }
};
struct EpiV {
    static constexpr bool PERM = false, AFTER_DRAIN = false;
    u16* VT; int layer;
    __device__ __forceinline__ void operator()(const pg8::f32x4 (&acc)[2][2][4][2], const pg8::Unit& u, int wr, int wc, int fr, int fq) const {
        const int colt = u.pn * 256, grp = colt >> 10;
        const int dil = (layer == 0 || grp == 0) ? 1 : (grp == 1 ? 4 : 16);
        const int rowb = u.pm * 256 + wr * 64 + 4 * fq;
#pragma unroll
        for (int bj = 0; bj < 2; ++bj)
#pragma unroll
            for (int n = 0; n < 2; ++n) {
                const int c = (colt & 1023) + bj * 128 + wc * 32 + n * 16 + fr, h = c >> 6, d = c & 63;
#pragma unroll
                for (int ai = 0; ai < 2; ++ai)
#pragma unroll
                    for (int m = 0; m < 4; ++m) {
                        const int r0 = rowb + ai * 128 + m * 16, b = r0 >> 13, t0 = r0 & (SEQ - 1);
                        u16* vrow = VT + (size_t)grp * T * D + ((size_t)(b * NH + h) * HD + d) * SEQ;
                        const pg8::f32x4 v = acc[ai][bj][m][n];
                        if (dil == 1) { u32x2 w; w[0] = cvtpk(v[0], v[1]); w[1] = cvtpk(v[2], v[3]); *(u32x2*)(vrow + t0) = w; }
                        else {
#pragma unroll
                            for (int i = 0; i < 4; ++i) { const int pp = t0 + i; vrow[(pp % dil) * (SEQ / dil) + pp / dil] = (u16)cvtpk(v[i], 0.f); }
                        }
                    }
            }
    }
};
struct EpiWo {
    static constexpr bool PERM = true, AFTER_DRAIN = false;
    u16* Y; const u16* X;
    __device__ __forceinline__ void operator()(const pg8::f32x4 (&acc)[2][2][4][2], const pg8::Unit& u, int wr, int wc, int fr, int fq) const {
        const int row0 = u.pm * 256 + wr * 64 + fr, col0 = u.pn * 256 + wc * 32 + 8 * fq;
#pragma unroll
        for (int ai = 0; ai < 2; ++ai)
#pragma unroll
            for (int m = 0; m < 4; ++m) { const size_t ro = (size_t)(row0 + ai * 128 + m * 16) * D + col0;
#pragma unroll
                for (int bj = 0; bj < 2; ++bj) { const pg8::f32x4 v0 = acc[ai][bj][m][0], v1 = acc[ai][bj][m][1];
                    const u32x4 xr = *(const u32x4*)(X + ro + bj * 128);
                    u32x4 w;
                    w[0] = cvtpk(bf2f(xr[0] & 0xFFFFu) * DN_ALPHA + v0[0], bf2f(xr[0] >> 16) * DN_ALPHA + v0[1]); w[1] = cvtpk(bf2f(xr[1] & 0xFFFFu) * DN_ALPHA + v0[2], bf2f(xr[1] >> 16) * DN_ALPHA + v0[3]);
                    w[2] = cvtpk(bf2f(xr[2] & 0xFFFFu) * DN_ALPHA + v1[0], bf2f(xr[2] >> 16) * DN_ALPHA + v1[1]); w[3] = cvtpk(bf2f(xr[3] & 0xFFFFu) * DN_ALPHA + v1[2], bf2f(xr[3] >> 16) * DN_ALPHA + v1[3]);
                    *(u32x4*)(Y + ro + bj * 128) = w; } }
    }
};
struct EpiSGU {
    static constexpr bool PERM = true, AFTER_DRAIN = false;
    u16* H;
    __device__ __forceinline__ void operator()(const pg8::f32x4 (&acc)[2][2][4][2], const pg8::Unit& u, int wr, int wc, int fr, int fq) const {
        const int row0 = u.pm * 256 + wr * 64 + fr, f0 = u.pn * 128 + wc * 32 + 8 * fq;
#pragma unroll
        for (int ai = 0; ai < 2; ++ai)
#pragma unroll
            for (int m = 0; m < 4; ++m) {
                float hv[8];
#pragma unroll
                for (int n = 0; n < 2; ++n)
#pragma unroll
                    for (int i = 0; i < 4; ++i) { const float gt = acc[ai][0][m][n][i], up = acc[ai][1][m][n][i]; hv[n * 4 + i] = gt / (1.f + __expf(-gt)) * up; }
                u32x4 w; w[0] = cvtpk(hv[0], hv[1]); w[1] = cvtpk(hv[2], hv[3]); w[2] = cvtpk(hv[4], hv[5]); w[3] = cvtpk(hv[6], hv[7]);
                *(u32x4*)(H + (size_t)(row0 + ai * 128 + m * 16) * DF + f0) = w;
            }
    }
};
struct EpiSD {
    static constexpr bool PERM = true, AFTER_DRAIN = false;
    u16* Y;
    __device__ __forceinline__ void operator()(const pg8::f32x4 (&acc)[2][2][4][2], const pg8::Unit& u, int wr, int wc, int fr, int fq) const {
        const int row0 = u.pm * 256 + wr * 64 + fr, col0 = u.pn * 256 + wc * 32 + 8 * fq;
#pragma unroll
        for (int ai = 0; ai < 2; ++ai)
#pragma unroll
            for (int m = 0; m < 4; ++m) { u16* rowp = Y + (size_t)(A_TOT + row0 + ai * 128 + m * 16) * D + col0;
#pragma unroll
                for (int bj = 0; bj < 2; ++bj) { const pg8::f32x4 v0 = acc[ai][bj][m][0], v1 = acc[ai][bj][m][1];
                    u32x4 w; w[0] = cvtpk(v0[0], v0[1]); w[1] = cvtpk(v0[2], v0[3]); w[2] = cvtpk(v1[0], v1[1]); w[3] = cvtpk(v1[2], v1[3]);
                    *(u32x4*)(rowp + bj * 128) = w; } }
    }
};

struct Args {
    const float* in[16];
    float* out;
    unsigned char* ws;
    int ph_lo, ph_hi;
};

#define GEMM_CORE(K_, PA0, PA1, PB, LDB)                                                                                                   \
    {                                                                                                                                      \
        const int g_tid = tid, g_lane = lane, g_wave = wave, g_r32 = r32, g_hi = hi;                   \
        const int g_wm = g_wave >> 2, g_wn = g_wave & 3, g_kc = g_tid & 3, g_kq = g_lane >> 3, g_n4 = g_lane & 7;                           \
        const u16* g_pa0 = (PA0); const u16* g_pa1 = (PA1);                                                                                \
        const size_t g_ldb = (size_t)(LDB);                                                                                                \
        const float* g_pb = (PB) + (size_t)(g_kq * 4) * g_ldb + g_n4 * 4;                                                                  \
        const int g_nk = (K_) / 32;                                                                                                        \
        u32x4 g_ra0, g_ra1; f32x4 g_rb0, g_rb1, g_rb2, g_rb3;                                                                              \
        const u32x4 g_z = {0u, 0u, 0u, 0u};                                                                                                \
        _Pragma("unroll") for (int mb = 0; mb < 4; ++mb) { _Pragma("unroll") for (int nb = 0; nb < 2; ++nb) { _Pragma("unroll") for (int r = 0; r < 16; ++r) acc[mb][nb][r] = 0.f; } } \
        g_ra0 = g_pa0 ? *(const u32x4*)(g_pa0 + g_kc * 8) : g_z; g_ra1 = g_pa1 ? *(const u32x4*)(g_pa1 + g_kc * 8) : g_z;                 \
        g_rb0 = *(const f32x4*)(g_pb); g_rb1 = *(const f32x4*)(g_pb + g_ldb); g_rb2 = *(const f32x4*)(g_pb + 2 * g_ldb); g_rb3 = *(const f32x4*)(g_pb + 3 * g_ldb); \
        _Pragma("unroll 1") for (int kt = 0; kt < g_nk; ++kt) {                                                                            \
            LAS char* As = lds + (kt & 1) * STAGE_BYTES; LAS char* Bs = As + 256 * LDP * 2;                                                \
            *(LAS u32x4*)(As + ((g_tid >> 2) * LDP + g_kc * 8) * 2) = g_ra0;                                                               \
            *(LAS u32x4*)(As + (((g_tid >> 2) + 128) * LDP + g_kc * 8) * 2) = g_ra1;                                                       \
            _Pragma("unroll") for (int i = 0; i < 4; ++i) {                                                                                \
                u32x2 w; w[0] = cvtpk(g_rb0[i], g_rb1[i]); w[1] = cvtpk(g_rb2[i], g_rb3[i]);                                               \
                *(LAS u32x2*)(Bs + ((g_wave * 32 + i * 8 + g_n4) * LDP + g_kq * 4) * 2) = w;                                               \
            }                                                                                                                              \
            __syncthreads();                                                                                                               \
            if (kt + 1 < g_nk) {                                                                                                           \
                const int ko = (kt + 1) * 32;                                                                                              \
                g_ra0 = g_pa0 ? *(const u32x4*)(g_pa0 + ko + g_kc * 8) : g_z; g_ra1 = g_pa1 ? *(const u32x4*)(g_pa1 + ko + g_kc * 8) : g_z; \
                const float* pbk = g_pb + (size_t)ko * g_ldb;                                                                              \
                g_rb0 = *(const f32x4*)(pbk); g_rb1 = *(const f32x4*)(pbk + g_ldb); g_rb2 = *(const f32x4*)(pbk + 2 * g_ldb); g_rb3 = *(const f32x4*)(pbk + 3 * g_ldb); \
            }                                                                                                                              \
            _Pragma("unroll") for (int s = 0; s < 2; ++s) {                                                                                \
                bf16x8 af[4], bfr[2];                                                                                                      \
                _Pragma("unroll") for (int mb = 0; mb < 4; ++mb) af[mb] = *(LAS bf16x8*)(As + ((g_wm * 128 + mb * 32 + g_r32) * LDP + s * 16 + g_hi * 8) * 2); \
                _Pragma("unroll") for (int nb = 0; nb < 2; ++nb) bfr[nb] = *(LAS bf16x8*)(Bs + (((g_wn * 2 + nb) * 32 + g_r32) * LDP + s * 16 + g_hi * 8) * 2); \
                _Pragma("unroll") for (int mb = 0; mb < 4; ++mb) { _Pragma("unroll") for (int nb = 0; nb < 2; ++nb) acc[mb][nb] = MFMA_BF16(af[mb], bfr[nb], acc[mb][nb]); } \
            }                                                                                                                              \
        }                                                                                                                                  \
        __syncthreads();                                                                                                                   \
    }

struct AttnSt { float m, l; f32x16 o0, o1; };

struct AttnFr { bf16x8 k[4]; bf16x8 v[4]; };
__device__ __forceinline__ void attn_load(AttnFr& f, const u16* krow, const u16* vt, size_t vt_dstride) {
#pragma unroll
    for (int d0 = 0; d0 < 4; ++d0) f.k[d0] = *(const bf16x8*)(krow + d0 * 16);
    const u16* vt1 = vt + 32 * vt_dstride;
    union { bf16x8 v; u32x2 h[2]; } va;
    va.h[0] = *(const u32x2*)(vt);       va.h[1] = *(const u32x2*)(vt + 8);   f.v[0] = va.v;
    va.h[0] = *(const u32x2*)(vt + 16);  va.h[1] = *(const u32x2*)(vt + 24);  f.v[1] = va.v;
    va.h[0] = *(const u32x2*)(vt1);      va.h[1] = *(const u32x2*)(vt1 + 8);  f.v[2] = va.v;
    va.h[0] = *(const u32x2*)(vt1 + 16); va.h[1] = *(const u32x2*)(vt1 + 24); f.v[3] = va.v;
}
__device__ __forceinline__ void attn_compute(AttnSt& st, const bf16x8 (&qf)[4], const AttnFr& f, int dist0, float bslope, int dlo, int dhi, int hi, int lane) {
    f32x16 p;
#pragma unroll
    for (int r = 0; r < 16; ++r) p[r] = 0.f;
#pragma unroll
    for (int d0 = 0; d0 < 4; ++d0) p = MFMA_BF16(f.k[d0], qf[d0], p);
    constexpr float C2 = 0.125f * LOG2E;
    float mx = NEGV;
#pragma unroll
    for (int r = 0; r < 16; ++r) {
        const int dist = dist0 - ((r & 3) + 8 * (r >> 2));
        const float sc = __builtin_fmaf(p[r], C2, -bslope * (float)dist);
        const float s_ = (dist >= dlo && dist <= dhi) ? sc : NEGV;
        p[r] = s_; mx = fmaxf(mx, s_);
    }
    mx = fmaxf(mx, shxf(mx, 32, lane));
    const float mnew = fmaxf(st.m, mx);
    const float alpha = __builtin_amdgcn_exp2f(st.m - mnew);
    st.m = mnew;
    float ls = 0.f;
#pragma unroll
    for (int r = 0; r < 16; ++r) { p[r] = __builtin_amdgcn_exp2f(p[r] - mnew); ls += p[r]; }
    st.l = st.l * alpha + ls;
#pragma unroll
    for (int r = 0; r < 16; ++r) { st.o0[r] *= alpha; st.o1[r] *= alpha; }
    union { bf16x8 v; unsigned u[4]; } pb0, pb1;
#pragma unroll
    for (int j = 0; j < 4; ++j) { pb0.u[j] = cvtpk(p[2 * j], p[2 * j + 1]); pb1.u[j] = cvtpk(p[8 + 2 * j], p[8 + 2 * j + 1]); }
    st.o0 = MFMA_BF16(f.v[0], pb0.v, st.o0);
    st.o0 = MFMA_BF16(f.v[1], pb1.v, st.o0);
    st.o1 = MFMA_BF16(f.v[2], pb0.v, st.o1);
    st.o1 = MFMA_BF16(f.v[3], pb1.v, st.o1);
    (void)hi;
}

__device__ __forceinline__ float dpp_rowmax(float v) {
    v = fmaxf(v, __int_as_float(__builtin_amdgcn_update_dpp(0, __float_as_int(v), 0xB1, 0xF, 0xF, true)));
    v = fmaxf(v, __int_as_float(__builtin_amdgcn_update_dpp(0, __float_as_int(v), 0x4E, 0xF, 0xF, true)));
    v = fmaxf(v, __int_as_float(__builtin_amdgcn_update_dpp(0, __float_as_int(v), 0x141, 0xF, 0xF, true)));
    v = fmaxf(v, __int_as_float(__builtin_amdgcn_update_dpp(0, __float_as_int(v), 0x140, 0xF, 0xF, true)));
    return v;
}
__device__ __forceinline__ int dpp_rowmin_i(int v) {
    v = min(v, __builtin_amdgcn_update_dpp(0, v, 0xB1, 0xF, 0xF, true));
    v = min(v, __builtin_amdgcn_update_dpp(0, v, 0x4E, 0xF, 0xF, true));
    v = min(v, __builtin_amdgcn_update_dpp(0, v, 0x141, 0xF, 0xF, true));
    v = min(v, __builtin_amdgcn_update_dpp(0, v, 0x140, 0xF, 0xF, true));
    return v;
}
__device__ __forceinline__ float rl_f(float v, int l) { return __int_as_float(__builtin_amdgcn_readlane(__float_as_int(v), l)); }

__device__ __forceinline__ void top3_insert(float v, int i, float& v0, int& i0, float& v1, int& i1, float& v2, int& i2) {
    const bool b0 = (v > v0) || (v == v0 && i < i0);
    const bool b1 = (v > v1) || (v == v1 && i < i1);
    const bool b2 = (v > v2) || (v == v2 && i < i2);
    const float nv2 = b1 ? v1 : (b2 ? v : v2); const int ni2 = b1 ? i1 : (b2 ? i : i2);
    const float nv1 = b0 ? v0 : (b1 ? v : v1); const int ni1 = b0 ? i0 : (b1 ? i : i1);
    const float nv0 = b0 ? v : v0;             const int ni0 = b0 ? i : i0;
    v0 = nv0; i0 = ni0; v1 = nv1; i1 = ni1; v2 = nv2; i2 = ni2;
}

__device__ __forceinline__ void ln_row(float (&v)[16], const float* __restrict__ g, const float* __restrict__ b, int lane) {
    float s = 0.f;
#pragma unroll
    for (int i = 0; i < 16; ++i) s += v[i];
    const float mu = wave_sum(s) * (1.f / D);
    float q = 0.f;
#pragma unroll
    for (int i = 0; i < 16; ++i) { const float d = v[i] - mu; q += d * d; }
    const float rstd = rsqrtf(wave_sum(q) * (1.f / D) + LN_EPS);
#pragma unroll
    for (int j = 0; j < 4; ++j) {
        const f32x4 gg = *(const f32x4*)(g + j * 256 + lane * 4), bb = *(const f32x4*)(b + j * 256 + lane * 4);
#pragma unroll
        for (int c = 0; c < 4; ++c) v[j * 4 + c] = (v[j * 4 + c] - mu) * rstd * gg[c] + bb[c];
    }
}

typedef __attribute__((ext_vector_type(2))) float f32x2_;
__device__ __forceinline__ bf16x8 fp8x8_to_bf16(unsigned lo, unsigned hi_) {
    const f32x2_ a = __builtin_amdgcn_cvt_pk_f32_fp8((int)lo, false), b = __builtin_amdgcn_cvt_pk_f32_fp8((int)lo, true);
    const f32x2_ c = __builtin_amdgcn_cvt_pk_f32_fp8((int)hi_, false), d = __builtin_amdgcn_cvt_pk_f32_fp8((int)hi_, true);
    union { bf16x8 v; unsigned u[4]; } r;
    r.u[0] = cvtpk(a[0], a[1]); r.u[1] = cvtpk(b[0], b[1]); r.u[2] = cvtpk(c[0], c[1]); r.u[3] = cvtpk(d[0], d[1]);
    return r.v;
}
__device__ __forceinline__ unsigned pack_fp8x4(float a, float b, float c, float d) { int p = __builtin_amdgcn_cvt_pk_fp8_f32(a, b, 0, false); return (unsigned)__builtin_amdgcn_cvt_pk_fp8_f32(c, d, p, true); }

constexpr float Y8_SCALE = 16.f;
constexpr int MOE_XCAP = 576;
#define MOE_GAS __attribute__((address_space(1)))
typedef MOE_GAS unsigned char moe_gcb;
constexpr int MOE_BP = 72;
constexpr int MOE_BSTAGE = 128 * MOE_BP * 2;
constexpr int MOE_LDS_VA = 3 * MOE_BSTAGE;
constexpr int MOE_LDS_W = MOE_LDS_VA + 4096;
constexpr int MOE_LDS_XCH = 65536;
template <bool DOWN>
__device__ __forceinline__ void moe_expert(LAS char* lds, const int tid, const int lane, const int wave, const int r32, const int hi,
                                           const unsigned char* __restrict__ abase  , const float* __restrict__ w0, const float* __restrict__ w1, const int ng  , void* __restrict__ outv,
                                           const int pass0, const int npass_, const int st0, const int nstl  , const bool y8 = false  ,
                                           const bool xr = false  ) {
    constexpr int KT = DOWN ? 4 : 16, NP = DOWN ? 8 : 4, LDB = DOWN ? 1024 : 256, APITCH = DOWN ? 256 : 1024  , PSTEP = DOWN ? 128 : 64;
    LAS int* rowva = (LAS int*)(lds + MOE_LDS_VA); LAS float* roww = (LAS float*)(lds + MOE_LDS_W);
    const int nst = nstl;
    const int nsteps = npass_ * nst * KT; (void)NP;
    unsigned aoff[2];
#define MOE_AOFF(ST_) { _Pragma("unroll") for (int a = 0; a < 2; ++a) { const int va_ = rowva[(ST_) * 512 + wave * 64 + a * 32 + r32]; \
        const int srow_ = DOWN ? va_ : (va_ == TRASH_VA ? 0 : (va_ >> 3)); aoff[a] = (unsigned)srow_ * APITCH + hi * 32; } }
    const int seg = wave >> 1, n4 = lane & 7, kp = (wave & 1) * 16 + (lane >> 3);
    const char* wbase = (const char*)(DOWN ? (w0 + seg * 32) : (((seg < 2) ? w0 : w1) + (seg & 1) * 32));
    unsigned boff = (unsigned)(4 * n4 + 2 * kp * LDB) * 4u; asm volatile("" : "+v"(boff));
    unsigned wb_ = (unsigned)((seg * 32 + n4) * MOE_BP + 2 * kp) * 2u; asm volatile("" : "+v"(wb_));
    unsigned lb_ = (unsigned)(r32 * MOE_BP + hi * 32) * 2u; asm volatile("" : "+v"(lb_));
    f32x16 acc[2][4];
#pragma unroll
    for (int a = 0; a < 2; ++a)
#pragma unroll
        for (int c = 0; c < 4; ++c)
#pragma unroll
            for (int r = 0; r < 16; ++r) acc[a][c][r] = 0.f;
    u32x4 fa8[2][2];
    f32x16 accx; u32x4 fa8x[2]; unsigned aoffx = 0u;
#pragma unroll
    for (int r = 0; r < 16; ++r) accx[r] = 0.f;
    fa8x[0] = u32x4{0u, 0u, 0u, 0u}; fa8x[1] = u32x4{0u, 0u, 0u, 0u};
    f32x4 rb0[4], rb1[4];
#define MOE_DEC(S_) const int s2_ = (S_) < nsteps ? (S_) : 0; const int pl_ = s2_ / (nst * KT); const int rm_ = s2_ - pl_ * (nst * KT); const int sl_ = rm_ / KT; const int kt_ = rm_ - sl_ * KT; const int ps_ = pass0 + pl_; const int stt_ = st0 + sl_;
#define MOE_LOADB(S_, RB) { MOE_DEC(S_) (void)stt_; \
        uint64_t wu_ = (uint64_t)(wbase + (size_t)(ps_ * PSTEP + kt_ * 64 * LDB) * 4), wv_ = wu_ + 16 * LDB * 4; asm volatile("" : "+s"(wu_), "+s"(wv_));     \
        const moe_gcb* wug_ = (const moe_gcb*)wu_; const moe_gcb* wvg_ = (const moe_gcb*)wv_; \
        unsigned bo_ = boff; asm volatile("" : "+v"(bo_));     \
        RB[0] = *(const MOE_GAS f32x4*)(wug_ + bo_); RB[1] = *(const MOE_GAS f32x4*)(wug_ + bo_ + LDB * 4); RB[2] = *(const MOE_GAS f32x4*)(wvg_ + bo_); RB[3] = *(const MOE_GAS f32x4*)(wvg_ + bo_ + LDB * 4); }
#define MOE_WRITEB(STG, RB) { LAS char* Bs_ = lds + (STG) * MOE_BSTAGE; \
        _Pragma("unroll") for (int i = 0; i < 4; ++i) { LAS unsigned* q_ = (LAS unsigned*)(Bs_ + wb_ + i * (8 * MOE_BP * 2)); q_[0] = cvtpk(RB[0][i], RB[1][i]); q_[8] = cvtpk(RB[2][i], RB[3][i]); } }
#define MOE_COMPUTE(STG, DO_MFMA) { LAS char* Bs_ = lds + (STG) * MOE_BSTAGE; \
        _Pragma("unroll") for (int u = 0; u < 4; ++u) { \
            bf16x8 bfr[4]; \
            if (DO_MFMA) { _Pragma("unroll") for (int c = 0; c < 4; ++c) bfr[c] = *(LAS bf16x8*)(Bs_ + lb_ + (c * 32 * MOE_BP + u * 8) * 2); } \
            _Pragma("unroll") for (int a = 0; a < 2; ++a) { \
                if (DO_MFMA) { const bf16x8 af_ = fp8x8_to_bf16(fa8[a][u >> 1][(u & 1) * 2], fa8[a][u >> 1][(u & 1) * 2 + 1]); \
                    _Pragma("unroll") for (int c = 0; c < 4; ++c) acc[a][c] = MFMA_BF16(bfr[c], af_, acc[a][c]); } \
            } \
        } }
      \
#define MOE_RELOAD { _Pragma("unroll") for (int a = 0; a < 2; ++a) { unsigned ao_ = aoff[a]; asm volatile("" : "+v"(ao_)); \
            fa8[a][0] = *(const MOE_GAS u32x4*)(ab_n + ao_); fa8[a][1] = *(const MOE_GAS u32x4*)(ab_n + ao_ + 16); } }
#define MOE_XCOMPUTE(STG) if (!DOWN) { LAS char* Bs_ = lds + (STG) * MOE_BSTAGE; \
        _Pragma("unroll") for (int u = 0; u < 4; ++u) { \
            const bf16x8 ax_ = fp8x8_to_bf16(fa8x[u >> 1][(u & 1) * 2], fa8x[u >> 1][(u & 1) * 2 + 1]); \
            if (u & 1) { unsigned ao_ = aoffx; asm volatile("" : "+v"(ao_)); fa8x[u >> 1] = *(const MOE_GAS u32x4*)(ab_n + ao_ + (u >> 1) * 16); } \
            const bf16x8 bx_ = *(LAS bf16x8*)(Bs_ + (wave & 3) * (32 * MOE_BP * 2) + lb_ + u * 16); \
            accx = MFMA_BF16(bx_, ax_, accx); } }
#define MOE_NEXTA(S_) MOE_DEC(S_) (void)ps_; \
        if (stt_ != st_loaded) { MOE_AOFF(stt_) st_loaded = stt_; } \
        uint64_t abn_ = (uint64_t)abase + kt_ * 64; asm volatile("" : "+s"(abn_)); const moe_gcb* ab_n = (const moe_gcb*)abn_;
    int st_loaded = st0;
    MOE_AOFF(st0)
    { const char* ab0 = (const char*)abase;
#pragma unroll
      for (int a = 0; a < 2; ++a)
#pragma unroll
          for (int h2 = 0; h2 < 2; ++h2) fa8[a][h2] = *(const u32x4*)(ab0 + aoff[a] + h2 * 16); }
    if (!DOWN) {
        const int vax_ = xr ? rowva[512 + 32 * (wave >> 2) + r32] : TRASH_VA; aoffx = (unsigned)(vax_ == TRASH_VA ? 0 : (vax_ >> 3)) * APITCH + hi * 32;
        fa8x[0] = *(const u32x4*)((const char*)abase + aoffx); fa8x[1] = *(const u32x4*)((const char*)abase + aoffx + 16); }
    MOE_LOADB(0, rb0)
    MOE_LOADB(1, rb1)
    MOE_WRITEB(0, rb0)
    MOE_LOADB(2, rb0)
    int stg = 0;
#pragma unroll 1
    for (int sidx = 0; sidx < nsteps; sidx += 2) {
        const int pl = sidx / (nst * KT); const int rm = sidx - pl * (nst * KT); const int sl = rm / KT; const int kt = rm - sl * KT; const int ps = pass0 + pl, stt = st0 + sl;
        const bool wv = (wave * 64) < (ng - stt * 512);
        const int stg1 = stg == 2 ? 0 : stg + 1, stg2 = stg1 == 2 ? 0 : stg1 + 1;
        __syncthreads();
        MOE_WRITEB(stg1, rb1)
        MOE_LOADB(sidx + 3, rb1)
        { MOE_NEXTA(sidx + 1)
          if (wv) MOE_COMPUTE(stg, true)
          MOE_RELOAD
          MOE_XCOMPUTE(stg) }
        __syncthreads();
        MOE_WRITEB(stg2, rb0)
        MOE_LOADB(sidx + 4, rb0)
        { MOE_NEXTA(sidx + 2)
          if (wv) MOE_COMPUTE(stg1, true)
          MOE_RELOAD
          MOE_XCOMPUTE(stg1) }
        stg = stg2;
        if (kt == KT - 2) {
            const int le_ = lane_id_(); const int lane = le_, r32 = le_ & 31, hi = le_ >> 5; (void)lane;
            if (wv) {
                const int nrows = ng - stt * 512;
#pragma unroll
                for (int a = 0; a < 2; ++a) {
                    if (a == 0 || (wave * 64 + 32) < nrows) {
                        const int lrow = stt * 512 + wave * 64 + a * 32 + r32;
                        const unsigned va = (unsigned)rowva[lrow];
                        if (DOWN) {
                            const float w = roww[lrow];
#pragma unroll
                            for (int c = 0; c < 4; ++c) {
                                float yv_[16];
#pragma unroll
                                for (int j = 0; j < 16; ++j) yv_[j] = acc[a][c][(j >> 2) + 4 * (j & 3)] * w;
                                if (y8) {
                                    u32x4 q8;
#pragma unroll
                                    for (int jj = 0; jj < 4; ++jj) q8[jj] = pack_fp8x4(yv_[4 * jj], yv_[4 * jj + 1], yv_[4 * jj + 2], yv_[4 * jj + 3]);
                                    *(u32x4*)((unsigned char*)outv + (size_t)va * D + ps * 128 + c * 32 + 16 * hi) = q8;
                                } else {
                                    u32x4 q0, q1;
#pragma unroll
                                    for (int jj = 0; jj < 4; ++jj) { q0[jj] = cvtpk(yv_[2 * jj], yv_[2 * jj + 1]); q1[jj] = cvtpk(yv_[8 + 2 * jj], yv_[9 + 2 * jj]); }
                                    u16* o = (u16*)outv + (size_t)va * D + ps * 128 + c * 32 + 16 * hi;
                                    *(u32x4*)o = q0; *(u32x4*)(o + 8) = q1;
                                }
                            }
                        } else {
#pragma unroll
                            for (int c = 0; c < 2; ++c) {
                                float hv[16];
#pragma unroll
                                for (int j = 0; j < 16; ++j) { const int r = (j >> 2) + 4 * (j & 3); const float gt = acc[a][c][r], up = acc[a][c + 2][r]; hv[j] = gt / (1.f + __expf(-gt)) * up; }
                                u32x4 q;
#pragma unroll
                                for (int jj = 0; jj < 4; ++jj) q[jj] = pack_fp8x4(hv[4 * jj], hv[4 * jj + 1], hv[4 * jj + 2], hv[4 * jj + 3]);
                                *(u32x4*)((unsigned char*)outv + (size_t)va * DF + ps * 64 + c * 32 + 16 * hi) = q;
                            }
                        }
                    }
                }
#pragma unroll
                for (int a = 0; a < 2; ++a)
#pragma unroll
                    for (int c = 0; c < 4; ++c)
#pragma unroll
                        for (int r = 0; r < 16; ++r) acc[a][c][r] = 0.f;
            }
            if (!DOWN) { if (xr) {
                LAS float* xch = (LAS float*)(lds + MOE_LDS_XCH) + ((wave >> 2) * 2 + (wave & 1)) * 1024 + lane;
                if ((wave & 3) >= 2) {
#pragma unroll
                    for (int r = 0; r < 16; ++r) xch[r * 64] = accx[r];
                }
                __syncthreads();
                if ((wave & 3) < 2) {
                    const unsigned vax = (unsigned)rowva[512 + 32 * (wave >> 2) + r32];
                    u32x4 q;
#pragma unroll
                    for (int jj = 0; jj < 4; ++jj) {
#pragma unroll
                        for (int i = 0; i < 4; ++i) { const int r = jj + 4 * i; const float gt = accx[r]; accx[r] = gt / (1.f + __expf(-gt)) * xch[r * 64]; }
                        q[jj] = pack_fp8x4(accx[jj], accx[jj + 4], accx[jj + 8], accx[jj + 12]);
                    }
                    *(u32x4*)((unsigned char*)outv + (size_t)vax * DF + ps * 64 + (wave & 3) * 32 + 16 * hi) = q;
                }
                }
#pragma unroll
                for (int r = 0; r < 16; ++r) accx[r] = 0.f;
            }
        }
    }
    __syncthreads();
#undef MOE_XCOMPUTE
#undef MOE_AOFF
#undef MOE_DEC
#undef MOE_LOADB
#undef MOE_WRITEB
#undef MOE_COMPUTE
#undef MOE_RELOAD
#undef MOE_NEXTA
}

constexpr int N_PHASES = 21;

#define P_x_in CTX_IN(0)
#define P_xb ((u16*)(ws + WS_XB))
#define P_x1 ((float*)(ws + WS_X1))
#define P_x2 ((float*)(ws + WS_X2))
#define P_ypre ((u16*)(ws + WS_YPRE))
#define P_qkv ((u16*)(ws + WS_QKV))
#define P_vT ((u16*)(ws + WS_VT))
#define P_kmean ((float*)(ws + WS_KM))
#define P_ao ((u16*)(ws + WS_AO))
#define P_og ((u16*)(ws + WS_OG))
#define P_lse ((float*)(ws + WS_LSE))
#define P_topw ((float*)(ws + WS_TOPW))
#define P_list ((int*)(ws + WS_LIST))
#define P_hb ((u16*)(ws + WS_HB))
#define P_yb ((u16*)(ws + WS_YB))
#define P_cnt_all ((int*)(ws + WS_CTL + CTL_ECNT_OFF))
#define P_xb8 ((unsigned char*)(ws + WS_XB8))
#define P_hbs ((u16*)(ws + WS_HBS))
#define P_selm ((unsigned*)(ws + WS_SELM))
#define P_part ((u16*)(ws + WS_PART))
#define P_plse ((float*)(ws + WS_PLSE))
#define PH_BEGIN int tid = wave_s_ * 64 + lane_id_(); asm volatile("" : "+v"(tid)); const int lane = tid & 63, r32 = lane & 31, hi = lane >> 5; const int wave = __builtin_amdgcn_readfirstlane(tid >> 6); (void)lane; (void)r32; (void)hi; (void)wave
constexpr int LDS_CTX = LDS_BAR + 16;
__device__ __forceinline__ uint64_t ctx_ld(int i) {
    extern __shared__ __attribute__((aligned(16))) unsigned char lds_raw[];
    const LAS unsigned* q = (const LAS unsigned*)((LAS char*)lds_raw + LDS_CTX) + 2 * i;
    const unsigned lo = __builtin_amdgcn_readfirstlane(q[0]), hi = __builtin_amdgcn_readfirstlane(q[1]);
    return ((uint64_t)hi << 32) | lo;
}
typedef __attribute__((address_space(1))) unsigned char gbyte;
#define AS_GLOBAL(T, u64v) ((T*)(gbyte*)(u64v))
#define CTX_IN(i) AS_GLOBAL(const float, ctx_ld(i))
#define PH_FN_BEGIN \
    extern __shared__ __attribute__((aligned(16))) unsigned char lds_raw[]; \
    LAS char* lds = (LAS char*)lds_raw; (void)lds; \
    const int G = gridDim.x, bid = blockIdx.x; (void)G; (void)bid; \
    unsigned char* const ws = AS_GLOBAL(unsigned char, ctx_ld(17)); (void)ws; \
    const int NQ = L == 0 ? 3072 : 9216; (void)NQ; \
    int* cnt = P_cnt_all + L * NE * CNT_STRIDE; (void)cnt;
__device__ __forceinline__ void ph_p0(int L, int rep_, const int wave_s_) {
    PH_FN_BEGIN
    (void)rep_;
    PH_BEGIN;
    for (size_t i = (size_t)bid * NTHR + tid; i < (size_t)T * D / 4; i += (size_t)G * NTHR) {
        const f32x4 v = *(const f32x4*)(P_x_in + i * 4);
        u32x2 w; w[0] = cvtpk(v[0], v[1]); w[1] = cvtpk(v[2], v[3]);
        *(u32x2*)(P_xb + i * 4) = w;
    }
    LAS float* tl = (LAS float*)lds;
    for (int it = bid; it < 3968 + 128; it += G) {
        int seg, kt;
        if (it < 3840) { seg = it >> 4; kt = it & 15; } else if (it < 3968) { seg = 240 + ((it - 3840) >> 2); kt = (it - 3840) & 3; } else { seg = 272 + ((it - 3968) >> 4); kt = (it - 3968) & 15; }
        const float* src; int ld; u16* dst; int Kd = 1024; u16* dst_lo = nullptr; int rcol = 0;
        if (seg < 48) { const int col = 64 * seg; src = CTX_IN(1) + col; ld = 3072; dst = (u16*)(ws + WS_WQK0) + (size_t)col * 1024; }
        else if (seg < 192) { const int col = 64 * (seg - 48); src = CTX_IN(2) + col; ld = 9216; dst = (u16*)(ws + WS_WQK1) + (size_t)col * 1024; }
        else if (seg < 224) { const int s2 = seg - 192, l2 = s2 >> 4, col = 64 * (s2 & 15); src = CTX_IN(3) + (size_t)l2 * D * D + col; ld = 1024; dst = (u16*)(ws + WS_WO) + (size_t)l2 * D * D + (size_t)col * 1024; }
        else if (seg < 240) { const int s2 = seg - 224, l2 = s2 >> 3, i8 = s2 & 7, un = i8 >> 2, q = i8 & 3;
            src = (q < 2 ? CTX_IN(11) : CTX_IN(12)) + (size_t)l2 * D * DF + un * 128 + 64 * (q & 1); ld = 256; dst = (u16*)(ws + WS_WSGU) + (size_t)l2 * 512 * 1024 + (size_t)(64 * i8) * 1024; }
        else if (seg < 272) { const int s2 = seg - 240, l2 = s2 >> 4, col = 64 * (s2 & 15); src = CTX_IN(13) + (size_t)l2 * DF * D + col; ld = 1024; Kd = 256; dst = (u16*)(ws + WS_WSD) + (size_t)l2 * D * DF + (size_t)col * 256; }
        else { const int s2 = seg - 272, l2 = s2 >> 2, col = 64 * (s2 & 3); src = CTX_IN(6) + (size_t)l2 * D * NE + col; ld = 256; rcol = col; dst = (u16*)(ws + WS_WRH) + (size_t)l2 * NE * D; dst_lo = (u16*)(ws + WS_WRL) + (size_t)l2 * NE * D; }
        {
            const int kr = tid >> 4, c4 = tid & 15;
#pragma unroll
            for (int i = 0; i < 2; ++i) {
                const f32x4 v = *(const f32x4*)(src + (size_t)(kt * 64 + kr + 32 * i) * ld + 4 * c4);
#pragma unroll
                for (int jj = 0; jj < 4; ++jj) tl[(kr + 32 * i) * 65 + 4 * c4 + jj] = v[jj];
            }
        }
        __syncthreads();
        {
            const int row = tid >> 3, kc = tid & 7;
            float f[8];
#pragma unroll
            for (int jj = 0; jj < 8; ++jj) f[jj] = tl[(8 * kc + jj) * 65 + row];
            u32x4 w; w[0] = cvtpk(f[0], f[1]); w[1] = cvtpk(f[2], f[3]); w[2] = cvtpk(f[4], f[5]); w[3] = cvtpk(f[6], f[7]);
            if (dst_lo) {
                u32x4 wl;
#pragma unroll
                for (int jj = 0; jj < 4; ++jj) wl[jj] = cvtpk(f[2 * jj] - bf2f(w[jj] & 0xFFFFu), f[2 * jj + 1] - bf2f(w[jj] >> 16));
                const int E_ = rcol + row;
                const size_t fi = ((size_t)(((E_ >> 5) * 16 + kt) * 4 + (kc >> 1)) * 64 + (kc & 1) * 32 + (E_ & 31)) * 8;
                *(u32x4*)(dst + fi) = w; *(u32x4*)(dst_lo + fi) = wl;
            } else *(u32x4*)(dst + (size_t)row * Kd + kt * 64 + 8 * kc) = w;
        }
        __syncthreads();
    }
}

__device__ __forceinline__ void ph_qkv(int L, int rep_, const int wave_s_) {
    PH_FN_BEGIN
    (void)rep_;
    const pg8::Gemm g{P_xb, (const u16*)(ws + (L == 0 ? WS_WQK0 : WS_WQK1)), T, NQ, D};
    pg8::StaticOrder S; S.init(g.M, g.N, G, bid);
    const EpiQK E{P_qkv, NQ};
    pg8::gemm_phase<EpiQK, pg8::StaticOrder, false>((PG8_LAS unsigned char*)lds, g, S, E, nullptr, wave_s_ * 64 + lane_id_());
}

__device__ __forceinline__ void ph_kmean(int L, int rep_, const int wave_s_) {
    PH_FN_BEGIN
    (void)rep_;
    PH_BEGIN;
    LAS float* red = (LAS float*)lds;
    for (int it = bid; it < BATCH * NH * MOBA_NB; it += G) {
        const int j = it & 31, h = (it >> 5) & 15, b = it >> 9;
        const int kg_ = tid >> 3, ch = tid & 7;
        const u16* kp = P_qkv + (size_t)(b * SEQ + j * MOBA_BLK + kg_) * 3072 + 1024 + h * 64 + ch * 8;
        float sm[8];
#pragma unroll
        for (int e2 = 0; e2 < 8; ++e2) sm[e2] = 0.f;
#pragma unroll
        for (int i = 0; i < 4; ++i) {
            const u32x4 v = *(const u32x4*)(kp + (size_t)(64 * i) * 3072);
#pragma unroll
            for (int e2 = 0; e2 < 4; ++e2) { sm[2 * e2] += bf2f(v[e2] & 0xFFFFu); sm[2 * e2 + 1] += bf2f(v[e2] >> 16); }
        }
#pragma unroll
        for (int e2 = 0; e2 < 8; ++e2) red[kg_ * 65 + ch * 8 + e2] = sm[e2];
        __syncthreads();
        if (tid < 64) {
            float tot = 0.f;
#pragma unroll 8
            for (int q = 0; q < 64; ++q) tot += red[q * 65 + tid];
            P_kmean[(size_t)it * 64 + tid] = tot * (1.f / MOBA_BLK);
        }
        __syncthreads();
    }
}

__device__ __forceinline__ void ph_gate(int L, int rep_, const int wave_s_) {
    PH_FN_BEGIN
    (void)rep_;
    PH_BEGIN;
    for (int it = bid; it < BATCH * NH * MOBA_NB; it += G) {
        const int qb = it & 31, bh = it >> 5, b = bh >> 4, h = bh & 15;
        const int tq = qb * MOBA_BLK + wave * 32 + r32;
        const u16* qrow = P_qkv + (size_t)(b * SEQ + tq) * 3072 + h * 64 + hi * 8;
        bf16x8 qf[4];
#pragma unroll
        for (int d0 = 0; d0 < 4; ++d0) qf[d0] = *(const bf16x8*)(qrow + d0 * 16);
        unsigned selmask = 0u;
        if (qb > 0) {
            const float* km = P_kmean + ((size_t)(b * NH + h) * MOBA_NB + r32) * 64 + hi * 8;
            f32x16 gt;
#pragma unroll
            for (int r = 0; r < 16; ++r) gt[r] = 0.f;
#pragma unroll
            for (int d0 = 0; d0 < 4; ++d0) {
                const f32x4 k0 = *(const f32x4*)(km + d0 * 16), k1 = *(const f32x4*)(km + d0 * 16 + 4);
                union { bf16x8 v; unsigned u[4]; } kf;
                kf.u[0] = cvtpk(k0[0], k0[1]); kf.u[1] = cvtpk(k0[2], k0[3]); kf.u[2] = cvtpk(k1[0], k1[1]); kf.u[3] = cvtpk(k1[2], k1[3]);
                gt = MFMA_BF16(kf.v, qf[d0], gt);
            }
            float v0 = -INFINITY, v1 = -INFINITY, v2 = -INFINITY; int i0 = 99, i1 = 99, i2 = 99;
#pragma unroll
            for (int r = 0; r < 16; ++r) { const int jb = crow(r, hi); const float gv = jb < qb ? gt[r] : -INFINITY; top3_insert(gv, jb < qb ? jb : 99, v0, i0, v1, i1, v2, i2); }
            const float ov0 = shxf(v0, 32, lane), ov1 = shxf(v1, 32, lane), ov2 = shxf(v2, 32, lane);
            const int oi0 = shxi(i0, 32, lane), oi1 = shxi(i1, 32, lane), oi2 = shxi(i2, 32, lane);
            top3_insert(ov0, oi0, v0, i0, v1, i1, v2, i2); top3_insert(ov1, oi1, v0, i0, v1, i1, v2, i2); top3_insert(ov2, oi2, v0, i0, v1, i1, v2, i2);
            if (i0 < 32) selmask |= 1u << i0;
            if (i1 < 32) selmask |= 1u << i1;
            if (i2 < 32) selmask |= 1u << i2;
        }
        if (hi == 0) P_selm[(size_t)bh * SEQ + tq] = selmask;
    }
}

constexpr int MB_KP = 72;
constexpr int MB_VP = 260;
constexpr int MB_LDS_K = 0;
constexpr int MB_LDS_V = 256 * MB_KP * 2;
constexpr int MB_LDS_LIST = MB_LDS_V + 64 * MB_VP * 2;
constexpr int MB_LDS_CTR = MB_LDS_LIST + 8192 * 2;
__device__ __forceinline__ void ph_moba(int L, int rep_, const int wave_s_) {
    PH_FN_BEGIN
    (void)rep_;
    PH_BEGIN;
    LAS char* Ks = lds + MB_LDS_K; LAS char* Vs = lds + MB_LDS_V;
    LAS u16* qlist = (LAS u16*)(lds + MB_LDS_LIST); LAS int* ctr = (LAS int*)(lds + MB_LDS_CTR);
    for (int it = bid; it < BATCH * NH * MOBA_NB; it += G) {
        const int rnd = it >> 8, w8 = it & 255, a8 = w8 >> 5, bh = w8 & 31;
        const int j = rnd == 0 ? a8 : (rnd == 1 ? 15 - a8 : (rnd == 2 ? 16 + a8 : 31 - a8));
        const int b = bh >> 4, h = bh & 15;
        const float slope2 = exp2f(-0.5f * (float)(h + 1)) * LOG2E;
        if (tid == 0) { int z0 = 0; asm volatile("" : "+v"(z0)); ctr[0] = z0; ctr[1] = z0; }
        {
            const u16* kg = P_qkv + (size_t)(b * SEQ + j * MOBA_BLK) * 3072 + 1024 + h * 64;
#pragma unroll
            for (int i = 0; i < 4; ++i) { const int c = tid + i * 512, row = c >> 3, ch = c & 7; *(LAS u32x4*)(Ks + (row * MB_KP + ch * 8) * 2) = *(const u32x4*)(kg + (size_t)row * 3072 + ch * 8); }
            const u16* vg = P_qkv + (size_t)(b * SEQ + j * MOBA_BLK) * 3072 + 2048 + h * 64;
#pragma unroll
            for (int i = 0; i < 4; ++i) {
                const int c = tid + i * 512, key = c >> 3, ch = c & 7;
                const u32x4 v = *(const u32x4*)(vg + (size_t)key * 3072 + ch * 8);
#pragma unroll
                for (int e2 = 0; e2 < 4; ++e2) {
                    *(LAS u16*)(Vs + ((ch * 8 + 2 * e2) * MB_VP + key) * 2) = (u16)(v[e2] & 0xFFFFu);
                    *(LAS u16*)(Vs + ((ch * 8 + 2 * e2 + 1) * MB_VP + key) * 2) = (u16)(v[e2] >> 16);
                }
            }
        }
        __syncthreads();
        {
            const unsigned* sm = P_selm + (size_t)bh * SEQ;
            for (int t0 = (j + 1) * MOBA_BLK; t0 < SEQ; t0 += 512) {
                const int t = t0 + tid;
                const bool sel = (t < SEQ) && ((sm[t < SEQ ? t : 0] >> j) & 1u);
                const unsigned long long bal = __ballot(sel);
                const int total = __popcll(bal);
                int wb = 0;
                if (lane == 0 && total) wb = atomicAdd((int*)&ctr[0], total);
                wb = __builtin_amdgcn_readfirstlane(wb);
                if (sel) qlist[wb + __popcll(bal & ((1ull << lane) - 1ull))] = (u16)t;
            }
        }
        __syncthreads();
        const int nq = ctr[0];
        const int ntiles = 8 + ((nq + 31) >> 5);
        for (;;) {
            int ti = 0;
            if (lane == 0) ti = atomicAdd((int*)&ctr[1], 1);
            ti = __builtin_amdgcn_readfirstlane(ti);
            if (ti >= ntiles) break;
            const bool own = ti < 8;
            const int wq = 7 - ti;
            const int li = (ti - 8) * 32 + r32;
            const bool valid = own || li < nq;
            const int tq = own ? j * MOBA_BLK + wq * 32 + r32 : (int)qlist[li < nq ? li : nq - 1];
            const int nsteps = own ? wq + 1 : 8;
            const u16* qrow = P_qkv + (size_t)(b * SEQ + tq) * 3072 + h * 64 + hi * 8;
            bf16x8 qf[4];
#pragma unroll
            for (int d0 = 0; d0 < 4; ++d0) qf[d0] = *(const bf16x8*)(qrow + d0 * 16);
            int slot = 3;
            if (!own) slot = __popc(P_selm[(size_t)bh * SEQ + tq] & ((1u << j) - 1u));
            AttnSt st; st.m = NEGV; st.l = 0.f;
#pragma unroll
            for (int r = 0; r < 16; ++r) { st.o0[r] = 0.f; st.o1[r] = 0.f; }
            const int dlo = own ? 0 : -0x40000000;
            for (int kt = 0; kt < nsteps; ++kt) {
                AttnFr f;
#pragma unroll
                for (int d0 = 0; d0 < 4; ++d0) f.k[d0] = *(LAS bf16x8*)(Ks + ((kt * 32 + r32) * MB_KP + d0 * 16 + hi * 8) * 2);
#pragma unroll
                for (int q4 = 0; q4 < 4; ++q4) {
                    union { bf16x8 v; u32x2 hh[2]; } va;
                    LAS char* vp = Vs + (((q4 >> 1) * 32 + r32) * MB_VP + kt * 32 + (q4 & 1) * 16 + 4 * hi) * 2;
                    va.hh[0] = *(LAS u32x2*)(vp); va.hh[1] = *(LAS u32x2*)(vp + 16);
                    f.v[q4] = va.v;
                }
                attn_compute(st, qf, f, tq - (j * MOBA_BLK + kt * 32) - 4 * hi, slope2, dlo, 0x7fffffff, hi, lane);
            }
            const float lt = st.l + shxf(st.l, 32, lane);
            const float inv = 1.f / lt;
            if (valid) {
                const size_t pi = ((size_t)(b * SEQ + tq) * NH + h) * 4 + slot;
                u16* orow = P_part + pi * 64;
#pragma unroll
                for (int rq = 0; rq < 4; ++rq) {
                    u32x2 w; w[0] = cvtpk(st.o0[4 * rq] * inv, st.o0[4 * rq + 1] * inv); w[1] = cvtpk(st.o0[4 * rq + 2] * inv, st.o0[4 * rq + 3] * inv);
                    *(u32x2*)(orow + 8 * rq + 4 * hi) = w;
                    w[0] = cvtpk(st.o1[4 * rq] * inv, st.o1[4 * rq + 1] * inv); w[1] = cvtpk(st.o1[4 * rq + 2] * inv, st.o1[4 * rq + 3] * inv);
                    *(u32x2*)(orow + 32 + 8 * rq + 4 * hi) = w;
                }
                if (hi == 0) P_plse[pi] = st.m * LN2 + logf(lt);
            }
        }
        __syncthreads();
    }
}

__device__ __forceinline__ void ph_mobamerge(int L, int rep_, const int wave_s_) {
    PH_FN_BEGIN
    (void)rep_;
    PH_BEGIN;
    for (size_t i = (size_t)bid * NTHR + tid; i < (size_t)T * NH * 8; i += (size_t)G * NTHR) {
        const size_t row = i >> 7; const int h = (int)(i >> 3) & 15, d8 = (int)i & 7;
        const int qb = (int)(row & (SEQ - 1)) >> 8;
        const int nsel = qb < 3 ? qb : 3;
        const size_t pi = (row * NH + h) * 4;
        float l[4], w[4];
        float mx = -INFINITY;
#pragma unroll
        for (int sidx = 0; sidx < 4; ++sidx) { const bool ok = sidx == 3 || sidx < nsel; l[sidx] = ok ? P_plse[pi + sidx] : -INFINITY; mx = fmaxf(mx, l[sidx]); }
        float ws_ = 0.f;
#pragma unroll
        for (int sidx = 0; sidx < 4; ++sidx) { w[sidx] = (sidx == 3 || sidx < nsel) ? expf(l[sidx] - mx) : 0.f; ws_ += w[sidx]; }
        const float inv = 1.f / ws_;
        float acc8[8];
#pragma unroll
        for (int c = 0; c < 8; ++c) acc8[c] = 0.f;
#pragma unroll
        for (int sidx = 0; sidx < 4; ++sidx) {
            if (sidx == 3 || sidx < nsel) {
                const u32x4 a = *(const u32x4*)(P_part + (pi + sidx) * 64 + d8 * 8);
                const float ww = w[sidx] * inv;
#pragma unroll
                for (int c = 0; c < 4; ++c) { acc8[2 * c] += ww * bf2f(a[c] & 0xFFFFu); acc8[2 * c + 1] += ww * bf2f(a[c] >> 16); }
            }
        }
        u32x4 o;
#pragma unroll
        for (int c = 0; c < 4; ++c) o[c] = cvtpk(acc8[2 * c], acc8[2 * c + 1]);
        *(u32x4*)(P_ao + row * D + h * 64 + d8 * 8) = o;
    }
}

constexpr int DL_KP = 72, DL_VP = 388;
constexpr int DL_LDS_K = 0, DL_LDS_V = 384 * DL_KP * 2;
__device__ __forceinline__ void ph_dil(int L, int rep_, const int wave_s_) {
    PH_FN_BEGIN
    (void)rep_;
    PH_BEGIN;
    LAS char* Ks = lds + DL_LDS_K; LAS char* Vs = lds + DL_LDS_V;
    for (int it = bid; it < BATCH * NH * 3 * 32; it += G) {
        const int ch = it & 31, grp = (it >> 5) % 3, bh = it / 96, b = bh >> 4, h = bh & 15;
        const int dil = grp == 0 ? 1 : (grp == 1 ? 4 : 16), Ls = SEQ / dil;
        const float slope2 = exp2f(-0.5f * (float)(h + 1)) * LOG2E * (float)dil;
        const int uc = ch * 256, res = uc / Ls, c0 = uc - res * Ls;
        const int kb0 = c0 - 128;
        {
            const u16* kg = P_qkv + (size_t)(b * SEQ) * 9216 + grp * 3072 + 1024 + h * 64;
#pragma unroll
            for (int i = 0; i < 6; ++i) {
                const int c = tid + i * 512, row = c >> 3, chk = c & 7, ks = kb0 + row;
                if (ks >= 0) *(LAS u32x4*)(Ks + (row * DL_KP + chk * 8) * 2) = *(const u32x4*)(kg + (size_t)(ks * dil + res) * 9216 + chk * 8);
            }
            const u16* vg = P_qkv + (size_t)(b * SEQ) * 9216 + grp * 3072 + 2048 + h * 64;
#pragma unroll
            for (int i = 0; i < 6; ++i) {
                const int c = tid + i * 512, row = c >> 3, chk = c & 7, ks = kb0 + row;
                if (ks >= 0) {
                    const u32x4 v = *(const u32x4*)(vg + (size_t)(ks * dil + res) * 9216 + chk * 8);
#pragma unroll
                    for (int e2 = 0; e2 < 4; ++e2) {
                        *(LAS u16*)(Vs + ((chk * 8 + 2 * e2) * DL_VP + row) * 2) = (u16)(v[e2] & 0xFFFFu);
                        *(LAS u16*)(Vs + ((chk * 8 + 2 * e2 + 1) * DL_VP + row) * 2) = (u16)(v[e2] >> 16);
                    }
                }
            }
        }
        const int i0 = c0 + wave * 32, iq = i0 + r32, pq = iq * dil + res;
        const u16* qrow = P_qkv + (size_t)(b * SEQ + pq) * 9216 + grp * 3072 + h * 64 + hi * 8;
        bf16x8 qf[4];
#pragma unroll
        for (int d0 = 0; d0 < 4; ++d0) qf[d0] = *(const bf16x8*)(qrow + d0 * 16);
        __syncthreads();
        AttnSt st; st.m = NEGV; st.l = 0.f;
#pragma unroll
        for (int r = 0; r < 16; ++r) { st.o0[r] = 0.f; st.o1[r] = 0.f; }
        const int ktmin = (i0 >= 128) ? 0 : (128 - i0) >> 5;
        for (int kt = 4; kt >= ktmin; --kt) {
            const int lrow0 = (wave + kt) * 32;
            AttnFr f;
#pragma unroll
            for (int d0 = 0; d0 < 4; ++d0) f.k[d0] = *(LAS bf16x8*)(Ks + ((lrow0 + r32) * DL_KP + d0 * 16 + hi * 8) * 2);
#pragma unroll
            for (int q4 = 0; q4 < 4; ++q4) {
                union { bf16x8 v; u32x2 hh[2]; } va;
                LAS char* vp = Vs + (((q4 >> 1) * 32 + r32) * DL_VP + lrow0 + (q4 & 1) * 16 + 4 * hi) * 2;
                va.hh[0] = *(LAS u32x2*)(vp); va.hh[1] = *(LAS u32x2*)(vp + 16);
                f.v[q4] = va.v;
            }
            const int k0 = i0 - 128 + kt * 32;
            attn_compute(st, qf, f, iq - k0 - 4 * hi, slope2, 0, 128, hi, lane);
        }
        const float lt = st.l + shxf(st.l, 32, lane);
        const float inv = 1.f / lt;
        u16* orow = P_og + (size_t)grp * T * D + (size_t)(b * SEQ + pq) * D + h * 64;
#pragma unroll
        for (int rq = 0; rq < 4; ++rq) {
            u32x2 w; w[0] = cvtpk(st.o0[4 * rq] * inv, st.o0[4 * rq + 1] * inv); w[1] = cvtpk(st.o0[4 * rq + 2] * inv, st.o0[4 * rq + 3] * inv);
            *(u32x2*)(orow + 8 * rq + 4 * hi) = w;
            w[0] = cvtpk(st.o1[4 * rq] * inv, st.o1[4 * rq + 1] * inv); w[1] = cvtpk(st.o1[4 * rq + 2] * inv, st.o1[4 * rq + 3] * inv);
            *(u32x2*)(orow + 32 + 8 * rq + 4 * hi) = w;
        }
        if (hi == 0) P_lse[((size_t)grp * T + (b * SEQ + pq)) * NH + h] = st.m * LN2 + logf(lt);
        __syncthreads();
    }
}

__device__ __forceinline__ void ph_merge(int L, int rep_, const int wave_s_) {
    PH_FN_BEGIN
    (void)rep_;

            PH_BEGIN;
                for (size_t i = (size_t)bid * NTHR + tid; i < (size_t)T * NH * 8; i += (size_t)G * NTHR) {
                    const size_t row = i >> 7; const int h = (int)(i >> 3) & 15, d8 = (int)i & 7;
                    const float l0 = P_lse[(0 * (size_t)T + row) * NH + h], l1 = P_lse[(1 * (size_t)T + row) * NH + h], l2 = P_lse[(2 * (size_t)T + row) * NH + h];
                    const float mx = fmaxf(l0, fmaxf(l1, l2));
                    float w0 = expf(l0 - mx), w1 = expf(l1 - mx), w2 = expf(l2 - mx);
                    const float inv = 1.f / (w0 + w1 + w2); w0 *= inv; w1 *= inv; w2 *= inv;
                    const size_t off = row * D + h * 64 + d8 * 8;
                    const u32x4 a0 = *(const u32x4*)(P_og + off), a1 = *(const u32x4*)(P_og + (size_t)T * D + off), a2 = *(const u32x4*)(P_og + 2 * (size_t)T * D + off);
                    u32x4 o;
#pragma unroll
                    for (int c = 0; c < 4; ++c) {
                        const float lo_ = w0 * bf2f(a0[c] & 0xFFFFu) + w1 * bf2f(a1[c] & 0xFFFFu) + w2 * bf2f(a2[c] & 0xFFFFu);
                        const float hi_ = w0 * bf2f(a0[c] >> 16) + w1 * bf2f(a1[c] >> 16) + w2 * bf2f(a2[c] >> 16);
                        o[c] = cvtpk(lo_, hi_);
                    }
                    *(u32x4*)(P_ao + off) = o;
                }

}

__device__ __forceinline__ void ph_wo(int L, int rep_, const int wave_s_) {
    PH_FN_BEGIN
    (void)rep_;
    const pg8::Gemm g{P_ao, (const u16*)(ws + WS_WO) + (size_t)L * D * D, T, D, D};
    pg8::StaticOrder S; S.init(g.M, g.N, G, bid);
    const EpiWo E{P_ypre, P_xb};
    pg8::gemm_phase<EpiWo, pg8::StaticOrder, false>((PG8_LAS unsigned char*)lds, g, S, E, nullptr, wave_s_ * 64 + lane_id_());
}

constexpr int RT_P = 144;
constexpr int RT_ASTAGE = 2 * 64 * 144;
constexpr int RT_LDS_AH = 0, RT_LDS_AL = 64 * RT_P;
constexpr int RT_LDS_BH = 2 * 64 * RT_P, RT_LDS_BL = RT_LDS_BH + 256 * RT_P;
constexpr int RT_LDS_ST = RT_LDS_BL + 256 * RT_P;
__device__ __forceinline__ void ph_router(int L, int rep_, const int wave_s_) {
    PH_FN_BEGIN
    (void)rep_;
    PH_BEGIN;
    const float* lng = CTX_IN(4) + L * D; const float* lnb = CTX_IN(5) + L * D;
    const float* rbias = CTX_IN(7) + L * NE;
    const u16* wrh = (const u16*)(ws + WS_WRH) + (size_t)L * NE * D; const u16* wrl = (const u16*)(ws + WS_WRL) + (size_t)L * NE * D;
    LAS float* stat = (LAS float*)(lds + RT_LDS_ST);
    for (int it = bid; it < T / 64; it += G) {
#pragma unroll 1
        for (int hb_ = 0; hb_ < 2; ++hb_) {
            u32x4 yv[4][2];
#pragma unroll
            for (int rr = 0; rr < 4; ++rr)
#pragma unroll
                for (int j = 0; j < 2; ++j) yv[rr][j] = *(const u32x4*)(P_ypre + ((size_t)it * 64 + wave * 8 + hb_ * 4 + rr) * D + j * 512 + lane * 8);
#pragma unroll
            for (int rr = 0; rr < 4; ++rr) {
                float sm = 0.f;
#pragma unroll
                for (int j = 0; j < 2; ++j)
#pragma unroll
                    for (int c = 0; c < 4; ++c) sm += bf2f(yv[rr][j][c] & 0xFFFFu) + bf2f(yv[rr][j][c] >> 16);
                const float mu = wave_sum(sm) * (1.f / D);
                float q = 0.f;
#pragma unroll
                for (int j = 0; j < 2; ++j)
#pragma unroll
                    for (int c = 0; c < 4; ++c) { const float d0_ = bf2f(yv[rr][j][c] & 0xFFFFu) - mu, d1_ = bf2f(yv[rr][j][c] >> 16) - mu; q += d0_ * d0_ + d1_ * d1_; }
                const float rstd = rsqrtf(wave_sum(q) * (1.f / D) + LN_EPS);
                if (lane == 0) { stat[wave * 8 + hb_ * 4 + rr] = mu; stat[64 + wave * 8 + hb_ * 4 + rr] = rstd; }
            }
        }
        __syncthreads();
        const int arow = tid >> 3, aq = tid & 7;
        const float amu = stat[arow], ars = stat[64 + arow];
        const u16* yp = P_ypre + ((size_t)it * 64 + arow) * D + aq * 8;
        u32x4 ya = *(const u32x4*)(yp);
        u32x4 bw[8], bx[8];
        const u16* wfh = wrh + (size_t)wave * 16 * 4 * 64 * 8 + lane * 8; const u16* wfl = wrl + (size_t)wave * 16 * 4 * 64 * 8 + lane * 8;
#define RT_LOADB(BW, KC_) { _Pragma("unroll") for (int sk = 0; sk < 4; ++sk) { BW[sk] = *(const u32x4*)(wfh + ((KC_) * 4 + sk) * 512); BW[4 + sk] = *(const u32x4*)(wfl + ((KC_) * 4 + sk) * 512); } }
        RT_LOADB(bw, 0)
        RT_LOADB(bx, 1)
        f32x16 lg[2];
#pragma unroll
        for (int r = 0; r < 16; ++r) { lg[0][r] = 0.f; lg[1][r] = 0.f; }
#define RT_WRITEA(KC_) { const int k0 = (KC_) * 64; \
            const f32x4 g0 = *(const f32x4*)(lng + k0 + aq * 8), g1 = *(const f32x4*)(lng + k0 + aq * 8 + 4); \
            const f32x4 b0 = *(const f32x4*)(lnb + k0 + aq * 8), b1 = *(const f32x4*)(lnb + k0 + aq * 8 + 4); \
            f32x4 x0, x1v; \
            _Pragma("unroll") for (int c = 0; c < 4; ++c) { const float y0_ = bf2f(c & 1 ? ya[c >> 1] >> 16 : ya[c >> 1] & 0xFFFFu), y1_ = bf2f(c & 1 ? ya[2 + (c >> 1)] >> 16 : ya[2 + (c >> 1)] & 0xFFFFu); \
                x0[c] = (y0_ - amu) * ars * g0[c] + b0[c]; x1v[c] = (y1_ - amu) * ars * g1[c] + b1[c]; } \
            ya = *(const u32x4*)(yp + (((KC_) + 1 < 16) ? k0 + 64 : 0)); \
            const size_t go = ((size_t)it * 64 + arow) * D + k0 + aq * 8; \
            u32x4 wh; wh[0] = cvtpk(x0[0], x0[1]); wh[1] = cvtpk(x0[2], x0[3]); wh[2] = cvtpk(x1v[0], x1v[1]); wh[3] = cvtpk(x1v[2], x1v[3]); \
            *(u32x4*)(P_xb + go) = wh; \
            u32x2 w8; w8[0] = pack_fp8x4(x0[0], x0[1], x0[2], x0[3]); w8[1] = pack_fp8x4(x1v[0], x1v[1], x1v[2], x1v[3]); \
            *(u32x2*)(P_xb8 + go) = w8; \
            u32x4 wl; \
            wl[0] = cvtpk(x0[0] - bf2f(wh[0] & 0xFFFFu), x0[1] - bf2f(wh[0] >> 16)); wl[1] = cvtpk(x0[2] - bf2f(wh[1] & 0xFFFFu), x0[3] - bf2f(wh[1] >> 16)); \
            wl[2] = cvtpk(x1v[0] - bf2f(wh[2] & 0xFFFFu), x1v[1] - bf2f(wh[2] >> 16)); wl[3] = cvtpk(x1v[2] - bf2f(wh[3] & 0xFFFFu), x1v[3] - bf2f(wh[3] >> 16)); \
            *(LAS u32x4*)(lds + ((KC_) & 1) * RT_ASTAGE + RT_LDS_AH + arow * RT_P + aq * 16) = wh; \
            *(LAS u32x4*)(lds + ((KC_) & 1) * RT_ASTAGE + RT_LDS_AL + arow * RT_P + aq * 16) = wl; }
#define RT_CHUNK(KC_, BW) { __syncthreads(); \
            _Pragma("unroll") for (int sk = 0; sk < 4; ++sk) { \
                const int ko = (sk * 16 + hi * 8) * 2; \
                const bf16x8 bh_ = __builtin_bit_cast(bf16x8, BW[sk]), bl_ = __builtin_bit_cast(bf16x8, BW[4 + sk]); \
                _Pragma("unroll") for (int rb = 0; rb < 2; ++rb) { \
                    const bf16x8 xh = *(const LAS bf16x8*)(lds + ((KC_) & 1) * RT_ASTAGE + RT_LDS_AH + (rb * 32 + r32) * RT_P + ko), xl = *(const LAS bf16x8*)(lds + ((KC_) & 1) * RT_ASTAGE + RT_LDS_AL + (rb * 32 + r32) * RT_P + ko); \
                    lg[rb] = MFMA_BF16(xh, bh_, lg[rb]); lg[rb] = MFMA_BF16(xl, bh_, lg[rb]); lg[rb] = MFMA_BF16(xh, bl_, lg[rb]); \
                } \
            } \
            if ((KC_) + 1 < 16) RT_WRITEA((KC_) + 1) \
            { const int kn_ = ((KC_) + 2 < 16) ? (KC_) + 2 : ((KC_) & 1); RT_LOADB(BW, kn_) } }
        RT_WRITEA(0)
#pragma unroll 1
        for (int kc = 0; kc < 16; kc += 2) {
            RT_CHUNK(kc, bw)
            RT_CHUNK(kc + 1, bx)
        }
#undef RT_CHUNK
#undef RT_WRITEA
#undef RT_LOADB
        __syncthreads();
        LAS float* lgs = (LAS float*)lds;
#pragma unroll
        for (int rb = 0; rb < 2; ++rb)
#pragma unroll
            for (int r = 0; r < 16; ++r) lgs[(rb * 32 + crow(r, hi)) * 257 + wave * 32 + r32] = lg[rb][r];
        __syncthreads();
#pragma unroll 1
        for (int tg = 0; tg < 2; ++tg) {
            float sc[4][4], cv[4][4];
#pragma unroll
            for (int tt = 0; tt < 4; ++tt) {
                const int lr = wave * 8 + tg * 4 + tt;
#pragma unroll
                for (int j = 0; j < 4; ++j) { const int e = lane + 64 * j; sc[tt][j] = 1.f / (1.f + __expf(-lgs[lr * 257 + e])); cv[tt][j] = sc[tt][j] + rbias[e]; }
            }
            float gsel[4][8];
#pragma unroll
            for (int j = 0; j < 4; ++j) {
#pragma unroll
                for (int tt = 0; tt < 4; ++tt) {
                    const float rm = dpp_rowmax(cv[tt][j]);
                    const float m1a = fmaxf(rl_f(rm, 0), rl_f(rm, 16)), m1b = fmaxf(rl_f(rm, 32), rl_f(rm, 48));
                    const unsigned long long bal = __ballot(cv[tt][j] == (hi ? m1b : m1a));
                    const int fa_ = __builtin_ctz((unsigned)(bal & 0xFFFFFFFFull)), fb_ = 32 + __builtin_ctz((unsigned)(bal >> 32));
                    const float c2 = (lane == fa_ || lane == fb_) ? -INFINITY : cv[tt][j];
                    const float rm2 = dpp_rowmax(c2);
                    gsel[tt][2 * j] = m1a + fmaxf(rl_f(rm2, 0), rl_f(rm2, 16));
                    gsel[tt][2 * j + 1] = m1b + fmaxf(rl_f(rm2, 32), rl_f(rm2, 48));
                }
            }
#pragma unroll
            for (int tt = 0; tt < 4; ++tt)
#pragma unroll
                for (int j = 0; j < 4; ++j) {
                    int ra_ = 0, rb_ = 0;
#pragma unroll
                    for (int g2 = 0; g2 < 8; ++g2) {
                        ra_ += ((gsel[tt][g2] > gsel[tt][2 * j]) || (gsel[tt][g2] == gsel[tt][2 * j] && g2 < 2 * j)) ? 1 : 0;
                        rb_ += ((gsel[tt][g2] > gsel[tt][2 * j + 1]) || (gsel[tt][g2] == gsel[tt][2 * j + 1] && g2 < 2 * j + 1)) ? 1 : 0;
                    }
                    cv[tt][j] = ((hi ? rb_ : ra_) < 4) ? cv[tt][j] : NEGV;
                }
            float wsel[4], wsum[4]; int esel[4];
#pragma unroll
            for (int tt = 0; tt < 4; ++tt) { wsel[tt] = 0.f; wsum[tt] = 0.f; esel[tt] = 0; }
#pragma unroll 1
            for (int k = 0; k < TOPK; ++k) {
#pragma unroll
                for (int tt = 0; tt < 4; ++tt) {
                    float bv = cv[tt][0]; int be = lane;
#pragma unroll
                    for (int j = 1; j < 4; ++j) if (cv[tt][j] > bv) { bv = cv[tt][j]; be = lane + 64 * j; }
                    const float rm = dpp_rowmax(bv);
                    const float mval = fmaxf(fmaxf(rl_f(rm, 0), rl_f(rm, 16)), fmaxf(rl_f(rm, 32), rl_f(rm, 48)));
                    const int ri = dpp_rowmin_i(bv == mval ? be : 0x7fffffff);
                    const int e = min(min(__builtin_amdgcn_readlane(ri, 0), __builtin_amdgcn_readlane(ri, 16)), min(__builtin_amdgcn_readlane(ri, 32), __builtin_amdgcn_readlane(ri, 48)));
                    const int jl = e >> 6, ll = e & 63;
                    const float smine = ((jl == 0 ? sc[tt][0] : 0.f) + (jl == 1 ? sc[tt][1] : 0.f)) + ((jl == 2 ? sc[tt][2] : 0.f) + (jl == 3 ? sc[tt][3] : 0.f));
                    const float sw = rl_f(smine, ll);
#pragma unroll
                    for (int j = 0; j < 4; ++j) cv[tt][j] = (lane == ll && jl == j) ? -INFINITY : cv[tt][j];
                    wsum[tt] += sw;
                    if (lane == k) { wsel[tt] = sw; esel[tt] = e; }
                }
            }
#pragma unroll
            for (int tt = 0; tt < 4; ++tt) {
                if (lane < TOPK) {
                    const int tok = it * 64 + wave * 8 + tg * 4 + tt;
                    const int a = tok * TOPK + lane;
                    P_topw[a] = wsel[tt] / wsum[tt] * 2.5f;
                    if (rep_ == 0) {
                        const int pos = atomicAdd(&cnt[esel[tt] * CNT_STRIDE], 1);
                        P_list[(size_t)esel[tt] * T + pos] = a;
                    }
                }
            }
        }
        __syncthreads();
    }
}

__device__ __forceinline__ void ph_gateup(int L, int rep_, const int wave_s_) {
    PH_FN_BEGIN
    (void)rep_;
    {
        PH_BEGIN;
        const float* weg = CTX_IN(8) + (size_t)L * NE * D * DF; const float* weu = CTX_IN(9) + (size_t)L * NE * D * DF;
        LAS int* rowva = (LAS int*)(lds + MOE_LDS_VA);
        {
            int* octr = (int*)(ws + WS_CTL + CTL_CNT_OFF + 8192) + (L * 4 + 2 * (rep_ & 1)) * 64;
            LAS int* slot = (LAS int*)(lds + 140000);
            for (;;) {
                __syncthreads();
                if (tid == 0) { int q; do { q = atomicAdd(octr, 1); } while (q >= NE && q < NE * 5 && cnt[((q - NE) >> 2) * CNT_STRIDE] <= MOE_XCAP); *slot = q; }
                __syncthreads();
                const int q = *slot;
                if (q >= NE * 5) break;
                const bool ovf = q >= NE;
                const int e = ovf ? (q - NE) >> 2 : q, pz = ovf ? (q - NE) & 3 : 0, npz = ovf ? 1 : 4, st0 = ovf ? 1 : 0, n = cnt[e * CNT_STRIDE];
                for (int r0 = 0; r0 < n; r0 += 1024) {
                    if (ovf && n - r0 <= MOE_XCAP) break;
#pragma unroll
                    for (int i = 0; i < 2; ++i) { int t_ = tid; asm volatile("" : "+v"(t_)); const int idx = r0 + i * 512 + t_; rowva[i * 512 + t_] = idx < n ? P_list[(size_t)e * T + idx] : TRASH_VA; }
                    __syncthreads();
                    moe_expert<false>(lds, tid, lane, wave, r32, hi, P_xb8, weg + (size_t)e * D * DF, weu + (size_t)e * D * DF, (n - r0) < 1024 ? (n - r0) : 1024, (void*)P_hb, pz, npz, st0, 1, false, !ovf && (n - r0) > 512 && (n - r0) <= MOE_XCAP);
                }
            }
        }
    }
    {
        PH_BEGIN;
        const pg8::Gemm g{P_xb, (const u16*)(ws + WS_WSGU) + (size_t)L * 512 * 1024, T, 512, D};
        const EpiSGU E{P_hbs};
        int* qctr = (int*)(ws + WS_CTL + CTL_CNT_OFF + 4096) + (L * 4 + 2 * (rep_ & 1)) * 64;
        LAS int* slot = (LAS int*)(lds + 140000);
        for (;;) {
            __syncthreads();
            if (tid == 0) *slot = atomicAdd(qctr, 1);
            __syncthreads();
            const int un = *slot;
            if (un >= 128) break;
            const pg8::FixedOrder S{un & 63, un >> 6};
            pg8::gemm_phase<EpiSGU, pg8::FixedOrder, false>((PG8_LAS unsigned char*)lds, g, S, E, nullptr, wave_s_ * 64 + lane_id_());
        }
    }
}

__device__ __forceinline__ void ph_down(int L, int rep_, const int wave_s_) {
    PH_FN_BEGIN
    (void)rep_;
    {
        PH_BEGIN;
        const float* wed = CTX_IN(10) + (size_t)L * NE * DF * D;
        LAS int* rowva = (LAS int*)(lds + MOE_LDS_VA); LAS float* roww = (LAS float*)(lds + MOE_LDS_W);
        {
            int* octr = (int*)(ws + WS_CTL + CTL_CNT_OFF + 8192) + (L * 4 + 1 + 2 * (rep_ & 1)) * 64;
            LAS int* slot = (LAS int*)(lds + 140000);
            for (;;) {
                __syncthreads();
                if (tid == 0) { int q; do { q = atomicAdd(octr, 1); } while (q >= NE && q < NE * 5 && cnt[((q - NE) >> 2) * CNT_STRIDE] <= 512); *slot = q; }
                __syncthreads();
                const int q = *slot;
                if (q >= NE * 5) break;
                const bool ovf = q >= NE;
                const int e = ovf ? (q - NE) >> 2 : q, pz = ovf ? ((q - NE) & 3) * 2 : 0, npz = ovf ? 2 : 8, st0 = ovf ? 1 : 0, n = cnt[e * CNT_STRIDE];
                for (int r0 = 0; r0 < n; r0 += 1024) {
                    if (ovf && n - r0 <= 512) break;
#pragma unroll
                    for (int i = 0; i < 2; ++i) { int t_ = tid; asm volatile("" : "+v"(t_)); const int idx = r0 + i * 512 + t_; const int va = idx < n ? P_list[(size_t)e * T + idx] : TRASH_VA; rowva[i * 512 + t_] = va; roww[i * 512 + t_] = va < A_TOT ? P_topw[va] * Y8_SCALE : 0.f; }
                    __syncthreads();
                    moe_expert<true>(lds, tid, lane, wave, r32, hi, (const unsigned char*)P_hb, wed + (size_t)e * DF * D, nullptr, (n - r0) < 1024 ? (n - r0) : 1024, (void*)P_yb, pz, npz, st0, 1, true);
                }
            }
        }
    }
    {
        PH_BEGIN;
        const pg8::Gemm g{P_hbs, (const u16*)(ws + WS_WSD) + (size_t)L * D * DF, T, D, DF};
        const EpiSD E{P_yb};
        int* qctr = (int*)(ws + WS_CTL + CTL_CNT_OFF + 4096) + (L * 4 + 1 + 2 * (rep_ & 1)) * 64;
        LAS int* slot = (LAS int*)(lds + 140000);
        for (;;) {
            __syncthreads();
            if (tid == 0) *slot = atomicAdd(qctr, 1);
            __syncthreads();
            const int un = *slot;
            if (un >= 256) break;
            const pg8::FixedOrder S{un & 63, un >> 6};
            pg8::gemm_phase<EpiSD, pg8::FixedOrder, false>((PG8_LAS unsigned char*)lds, g, S, E, nullptr, wave_s_ * 64 + lane_id_());
        }
    }
}

__device__ __forceinline__ void ph_combine(int L, int rep_, const int wave_s_) {
    PH_FN_BEGIN
    (void)rep_;
    PH_BEGIN;
    const float* lng = CTX_IN(14) + L * D; const float* lnb = CTX_IN(15) + L * D;
    float* dst = AS_GLOBAL(float, ctx_ld(16));
    for (int row = bid * 8 + wave; row < T; row += G * 8) {
        u32x4 yv[TOPK + 1][2];
#pragma unroll
        for (int k = 0; k < TOPK + 1; ++k) {
            const size_t va = k < TOPK ? (size_t)row * TOPK + k : (size_t)A_TOT + row;
            if (k < TOPK) {
#pragma unroll
                for (int j = 0; j < 2; ++j) { const u32x2 w8 = *(const u32x2*)((const unsigned char*)P_yb + va * D + j * 512 + lane * 8); yv[k][j][0] = w8[0]; yv[k][j][1] = w8[1]; yv[k][j][2] = 0u; yv[k][j][3] = 0u; }
            } else {
#pragma unroll
                for (int j = 0; j < 2; ++j) yv[k][j] = *(const u32x4*)(P_yb + va * D + j * 512 + lane * 8);
            }
        }
        float v[16];
#pragma unroll
        for (int j = 0; j < 2; ++j) {
            const u32x4 t = *(const u32x4*)(P_xb + (size_t)row * D + j * 512 + lane * 8);
#pragma unroll
            for (int c = 0; c < 4; ++c) { v[j * 8 + 2 * c] = DN_ALPHA * bf2f(t[c] & 0xFFFFu); v[j * 8 + 2 * c + 1] = DN_ALPHA * bf2f(t[c] >> 16); }
        }
#pragma unroll
        for (int k = 0; k < TOPK + 1; ++k)
#pragma unroll
            for (int j = 0; j < 2; ++j) {
                if (k < TOPK) {
#pragma unroll
                    for (int c = 0; c < 2; ++c) {
                        const f32x2_ lo2 = __builtin_amdgcn_cvt_pk_f32_fp8((int)yv[k][j][c], false), hi2 = __builtin_amdgcn_cvt_pk_f32_fp8((int)yv[k][j][c], true);
                        v[j * 8 + 4 * c] += lo2[0] * (1.f / Y8_SCALE); v[j * 8 + 4 * c + 1] += lo2[1] * (1.f / Y8_SCALE); v[j * 8 + 4 * c + 2] += hi2[0] * (1.f / Y8_SCALE); v[j * 8 + 4 * c + 3] += hi2[1] * (1.f / Y8_SCALE);
                    }
                } else {
#pragma unroll
                    for (int c = 0; c < 4; ++c) { v[j * 8 + 2 * c] += bf2f(yv[k][j][c] & 0xFFFFu); v[j * 8 + 2 * c + 1] += bf2f(yv[k][j][c] >> 16); }
                }
            }
        float sm = 0.f;
#pragma unroll
        for (int i = 0; i < 16; ++i) sm += v[i];
        const float mu = wave_sum(sm) * (1.f / D);
        float q = 0.f;
#pragma unroll
        for (int i = 0; i < 16; ++i) { const float d = v[i] - mu; q += d * d; }
        const float rstd = rsqrtf(wave_sum(q) * (1.f / D) + LN_EPS);
#pragma unroll
        for (int j = 0; j < 2; ++j) {
            const f32x4 g0 = *(const f32x4*)(lng + j * 512 + lane * 8), g1 = *(const f32x4*)(lng + j * 512 + lane * 8 + 4);
            const f32x4 b0 = *(const f32x4*)(lnb + j * 512 + lane * 8), b1 = *(const f32x4*)(lnb + j * 512 + lane * 8 + 4);
            f32x4 o0, o1;
#pragma unroll
            for (int c = 0; c < 4; ++c) { o0[c] = (v[j * 8 + c] - mu) * rstd * g0[c] + b0[c]; o1[c] = (v[j * 8 + 4 + c] - mu) * rstd * g1[c] + b1[c]; }
            if (L == 1) { *(f32x4*)(dst + (size_t)row * D + j * 512 + lane * 8) = o0; *(f32x4*)(dst + (size_t)row * D + j * 512 + lane * 8 + 4) = o1; }
            if (L == 0) { u32x4 w; w[0] = cvtpk(o0[0], o0[1]); w[1] = cvtpk(o0[2], o0[3]); w[2] = cvtpk(o1[0], o1[1]); w[3] = cvtpk(o1[2], o1[3]); *(u32x4*)(P_xb + (size_t)row * D + j * 512 + lane * 8) = w; }
        }
    }
}

__global__ void __launch_bounds__(NTHR, 2) fwd(Args args) {
    extern __shared__ __attribute__((aligned(16))) unsigned char lds_raw[];
    LAS char* lds = (LAS char*)lds_raw;
    unsigned char* const ws = args.ws;
    const int lo = args.ph_lo, hi_ph = args.ph_hi;
    const int wave_s_ = __builtin_amdgcn_readfirstlane(threadIdx.x >> 6);
    if (threadIdx.x < 18) {
        const uint64_t v = threadIdx.x < 16 ? (uint64_t)args.in[threadIdx.x] : (threadIdx.x == 16 ? (uint64_t)args.out : (uint64_t)args.ws);
        ((LAS uint64_t*)(lds + LDS_CTX))[threadIdx.x] = v;
    }
    __syncthreads();
#define IN(k) (lo <= (k) && (k) < hi_ph)

#if MK_ONE_LAUNCH
    if (threadIdx.x < 4) ((LAS unsigned*)(lds + LDS_BAR))[threadIdx.x] = 0u;
    __syncthreads();
    XcdBarrier bar = xcd_barrier_post((unsigned*)(ws + WS_CTL), (volatile LAS unsigned*)(lds + LDS_BAR), wave_s_ == 0 && lane_id_() == 0);
#define GRID_BAR() xcd_barrier(bar, wave_s_ == 0 && lane_id_() == 0)
#else
#define GRID_BAR() do { } while (0)
#endif
#define SEAM(k) do { if (IN(k) && IN((k) + 1)) GRID_BAR(); } while (0)

    for (int rep_ = 0; rep_ < ((IN(0) && PHK(0)) ? REPS(0) : 0); ++rep_) { ph_p0(0, rep_, wave_s_); }
    SEAM(0);

    for (int L = 0; L < 2; ++L) {
        const int pb = 1 + 10 * L;
        for (int rep_ = 0; rep_ < ((IN(pb + 0) && PHK(1)) ? REPS(1) : 0); ++rep_) { ph_qkv(L, rep_, wave_s_); }
        SEAM(pb + 0);

        if (L == 0) {
            for (int rep_ = 0; rep_ < ((IN(pb + 1) && PHK(2)) ? REPS(2) : 0); ++rep_) { ph_kmean(L, rep_, wave_s_); }
            SEAM(pb + 1);
            for (int rep_ = 0; rep_ < ((IN(pb + 2) && PHK(11)) ? REPS(11) : 0); ++rep_) { ph_gate(L, rep_, wave_s_); }
            SEAM(pb + 2);
        }

        if (L == 0) {
            for (int rep_ = 0; rep_ < ((IN(pb + 3) && PHK(3)) ? REPS(3) : 0); ++rep_) { ph_moba(L, rep_, wave_s_); }
            SEAM(pb + 3);
            for (int rep_ = 0; rep_ < ((IN(pb + 4) && PHK(12)) ? REPS(12) : 0); ++rep_) { ph_mobamerge(L, rep_, wave_s_); }
        } else {
            for (int rep_ = 0; rep_ < ((IN(pb + 3) && PHK(4)) ? REPS(4) : 0); ++rep_) { ph_dil(L, rep_, wave_s_); }
            SEAM(pb + 3);
            for (int rep_ = 0; rep_ < ((IN(pb + 4) && PHK(5)) ? REPS(5) : 0); ++rep_) { ph_merge(L, rep_, wave_s_); }
        }
        SEAM(pb + 4);

        for (int rep_ = 0; rep_ < ((IN(pb + 5) && PHK(6)) ? REPS(6) : 0); ++rep_) { ph_wo(L, rep_, wave_s_); }
        SEAM(pb + 5);

        for (int rep_ = 0; rep_ < ((IN(pb + 6) && PHK(7)) ? REPS(7) : 0); ++rep_) { ph_router(L, rep_, wave_s_); }
        SEAM(pb + 6);

        for (int rep_ = 0; rep_ < ((IN(pb + 7) && PHK(8)) ? REPS(8) : 0); ++rep_) { ph_gateup(L, rep_, wave_s_); }
        SEAM(pb + 7);

        for (int rep_ = 0; rep_ < ((IN(pb + 8) && PHK(9)) ? REPS(9) : 0); ++rep_) { ph_down(L, rep_, wave_s_); }
        SEAM(pb + 8);

        for (int rep_ = 0; rep_ < ((IN(pb + 9) && PHK(10)) ? REPS(10) : 0); ++rep_) { ph_combine(L, rep_, wave_s_); }
        if (L == 0) SEAM(pb + 9);
    }
}

extern "C" void kernel_launch(void* const* d_in, const int* in_sizes, int n_in, void* d_out, int out_size, void* d_ws, size_t ws_size, hipStream_t stream) {
    static int grid = 0;
    if (grid == 0) {
        if (n_in != 16 || out_size != T * D || ws_size < WS_END2) { fprintf(stderr, "kernel_launch: unexpected problem (n_in %d out %d ws %zu need %zu)\n", n_in, out_size, ws_size, (size_t)WS_END2); grid = -1; return; }
        int dev = 0, cus = 0, per_cu = 0;
        if (hipGetDevice(&dev) != hipSuccess || hipDeviceGetAttribute(&cus, hipDeviceAttributeMultiprocessorCount, dev) != hipSuccess) { grid = -1; return; }
        if (hipFuncSetAttribute((const void*)fwd, hipFuncAttributeMaxDynamicSharedMemorySize, LDS_BYTES) != hipSuccess) { fprintf(stderr, "kernel_launch: hipFuncSetAttribute failed\n"); grid = -1; return; }
        if (hipOccupancyMaxActiveBlocksPerMultiprocessor(&per_cu, (const void*)fwd, NTHR, LDS_BYTES) != hipSuccess || per_cu < 1) { fprintf(stderr, "kernel_launch: occupancy query says %d\n", per_cu); (void)hipGetLastError(); per_cu = 1; }
        grid = cus;
    }
    if (grid < 0) return;
    (void)hipMemsetAsync((char*)d_ws + WS_CTL, 0, CTL_BYTES, stream);
    Args a{};
    for (int i = 0; i < 16; ++i) a.in[i] = (const float*)d_in[i];
    a.out = (float*)d_out; a.ws = (unsigned char*)d_ws;
#if MK_ONE_LAUNCH
    a.ph_lo = 0; a.ph_hi = N_PHASES;
    hipLaunchKernelGGL(fwd, dim3(grid), dim3(NTHR), LDS_BYTES, stream, a);
#else
    for (int ph = 0; ph < N_PHASES; ++ph) {
        if (ph == 12 || ph == 13) continue;
        a.ph_lo = ph; a.ph_hi = ph + 1;
        hipLaunchKernelGGL(fwd, dim3(grid), dim3(NTHR), LDS_BYTES, stream, a);
    }
#endif
}
```

```cpp
#include <hip/hip_runtime.h>
#include <hip/hip_bf16.h>
#include <stdint.h>
#include <stdio.h>

#ifndef MK_ONE_LAUNCH
#define MK_ONE_LAUNCH 1
#endif

#ifndef PHMASK
#define PHMASK 0x1FFF
#endif
#define PHK(k) ((PHMASK >> (k)) & 1)
#ifndef REPEAT_KIND
#define REPEAT_KIND -1
#endif
#define REPS(k) ((k) == REPEAT_KIND ? 2 : 1)
#define LAS __attribute__((address_space(3)))
typedef __attribute__((ext_vector_type(8))) short bf16x8;
typedef __attribute__((ext_vector_type(16))) float f32x16;
typedef __attribute__((ext_vector_type(4))) float f32x4;
typedef __attribute__((ext_vector_type(4))) unsigned u32x4;
typedef __attribute__((ext_vector_type(2))) unsigned u32x2;
typedef unsigned short u16;

constexpr int D = 1024, BATCH = 2, SEQ = 8192, T = BATCH * SEQ, NH = 16, HD = 64;
constexpr int NE = 256, TOPK = 8, DF = 256;
constexpr int A_TOT = T * TOPK;
constexpr int MOBA_BLK = 256, MOBA_NB = SEQ / MOBA_BLK;
constexpr float DN_ALPHA = 1.4142135623730951f;
constexpr float LN_EPS = 1e-5f;
constexpr float LOG2E = 1.4426950408889634f;
constexpr float LN2 = 0.6931471805599453f;
constexpr float NEGV = -1e30f;
constexpr int NTHR = 512;

constexpr size_t al256(size_t x) { return (x + 255) & ~(size_t)255; }
constexpr size_t WS_CTL = 0;
constexpr size_t CTL_BYTES = 131072;
constexpr size_t CTL_CNT_OFF = 32768;
constexpr size_t CTL_XQ_OFF = 45056;
constexpr size_t CTL_ECNT_OFF = 65536;
constexpr int CNT_STRIDE = 32;
constexpr size_t WS_XB = WS_CTL + CTL_BYTES;
constexpr size_t WS_X1 = WS_XB + al256((size_t)T * D * 2);
constexpr size_t WS_X2 = WS_X1 + al256((size_t)T * D * 4);
constexpr size_t WS_YPRE = WS_X2 + al256((size_t)T * D * 4);
constexpr size_t WS_QKV = WS_YPRE + al256((size_t)T * D * 4);
constexpr size_t WS_VT = WS_QKV + al256((size_t)T * 9216 * 2);
constexpr size_t WS_KM = WS_VT + al256((size_t)3 * T * D * 2);
constexpr size_t WS_AO = WS_KM + al256((size_t)BATCH * NH * MOBA_NB * HD * 4);
constexpr size_t WS_OG = WS_AO + al256((size_t)T * D * 2);
constexpr size_t WS_LSE = WS_OG + al256((size_t)3 * T * D * 2);
constexpr size_t WS_TOPW = WS_LSE + al256((size_t)3 * T * NH * 4);
constexpr size_t WS_LIST = WS_TOPW + al256((size_t)T * TOPK * 4);
constexpr size_t WS_HB = WS_LIST + al256((size_t)NE * T * 4);
constexpr size_t WS_YB = WS_HB + al256((size_t)(A_TOT + T + 1) * DF * 2);
constexpr size_t WS_END = WS_YB + al256((size_t)(A_TOT + T + 1) * D * 2);
constexpr int TRASH_VA = A_TOT + T;
constexpr size_t WS_SELM = WS_END;
constexpr size_t WS_PART = WS_SELM + al256((size_t)T * NH * 4);
constexpr size_t WS_PLSE = WS_PART + al256((size_t)T * NH * 4 * 64 * 2);
constexpr size_t WS_WQK0 = WS_PLSE + al256((size_t)T * NH * 4 * 4);
constexpr size_t WS_WV0 = WS_WQK0 + (size_t)2048 * 1024 * 2;
constexpr size_t WS_WQK1 = WS_WV0 + (size_t)1024 * 1024 * 2;
constexpr size_t WS_WV1 = WS_WQK1 + (size_t)6144 * 1024 * 2;
constexpr size_t WS_WO = WS_WV1 + (size_t)3072 * 1024 * 2;
constexpr size_t WS_WSGU = WS_WO + (size_t)2 * 1024 * 1024 * 2;
constexpr size_t WS_WSD = WS_WSGU + (size_t)2 * 512 * 1024 * 2;
constexpr size_t WS_XB8 = WS_WSD + (size_t)2 * 1024 * 256 * 2;
constexpr size_t WS_HBS = WS_XB8 + (size_t)T * D;
constexpr size_t WS_WRH = WS_HBS + (size_t)T * DF * 2;
constexpr size_t WS_WRL = WS_WRH + (size_t)2 * 256 * 1024 * 2;
constexpr size_t WS_END2 = WS_WRL + (size_t)2 * 256 * 1024 * 2;
constexpr size_t WS_XQ8 = WS_END2;
constexpr size_t WS_WQ8 = WS_XQ8 + (size_t)T * D;
constexpr size_t WS_END3 = WS_WQ8 + (size_t)(3072 + 9216) * 1024;
#ifndef QKV_FP8
#define QKV_FP8 1
#endif

constexpr int LDP = 40;
constexpr int STAGE_BYTES = 2 * 256 * LDP * 2;
constexpr int LDS_ROWID = 2 * STAGE_BYTES;
constexpr int LDS_ROWW = LDS_ROWID + 1024;
constexpr int XS_PITCH = 1028;
constexpr int LDS_BYTES = 163840;
constexpr int LDS_BAR = 161792;

__device__ __forceinline__ int lane_id_() { int l; asm volatile("v_mbcnt_lo_u32_b32 %0, -1, 0\n\tv_mbcnt_hi_u32_b32 %0, -1, %0" : "=v"(l)); return l; }
__device__ __forceinline__ float shxf(float v, int m, int lane) { return __int_as_float(__builtin_amdgcn_ds_bpermute((lane ^ m) << 2, __float_as_int(v))); }
__device__ __forceinline__ int shxi(int v, int m, int lane) { return __builtin_amdgcn_ds_bpermute((lane ^ m) << 2, v); }
#define XB_TMO      128
#define XB_XCNT(j)  (256  + 64 * (j))
#define XB_XSUB(j)  (1280 + 64 * (j))
#define XB_XGEN(j)  (2304 + 64 * (j))
#define XB_TOP      3328
#define XB_TOPGEN   3392
#define XCD_BAR_WORDS 3456
#define XB_SPIN_CAP (1u << 18)
__device__ __forceinline__ unsigned xb_ld(unsigned* p)              { return __hip_atomic_load(p, __ATOMIC_RELAXED, __HIP_MEMORY_SCOPE_AGENT); }
__device__ __forceinline__ unsigned xb_add(unsigned* p, unsigned v) { return __hip_atomic_fetch_add(p, v, __ATOMIC_RELAXED, __HIP_MEMORY_SCOPE_AGENT); }
__device__ __forceinline__ unsigned xb_xcc_id() { return (unsigned)__builtin_amdgcn_s_getreg((3 << 11) | 20) & 0xFu; }
#define XB_SPIN(cond, bar) do { unsigned _sp = 0; while (cond) { __builtin_amdgcn_s_sleep(1); \
    if ((++_sp & 255u) == 0u) { if (xb_ld(&(bar)[XB_TMO])) break; if (_sp > XB_SPIN_CAP) { atomicAdd(&(bar)[XB_TMO], 1u); break; } } } } while (0)
struct XcdBarrier { unsigned* bar; unsigned x; volatile LAS unsigned* st; };
__device__ __forceinline__ XcdBarrier xcd_barrier_post(unsigned* bar, volatile LAS unsigned* st, const bool leader) {
    XcdBarrier b; b.bar = bar; b.x = xb_xcc_id(); b.st = st;
    if (leader) (void)xb_add(&bar[XB_XCNT(b.x)], 1u);
    return b;
}
__device__ __forceinline__ void xcd_barrier_complete(unsigned* bar, unsigned x, unsigned& nloc, unsigned& nx) {
    const unsigned G = gridDim.x * gridDim.y * gridDim.z;
    unsigned sum, cnt, mine, sp = 0u;
    for (;;) {
        sum = 0u; cnt = 0u; mine = 0u;
#pragma unroll
        for (unsigned j = 0; j < 16; ++j) { const unsigned c = xb_ld(&bar[XB_XCNT(j)]); sum += c; cnt += (c > 0u) ? 1u : 0u; mine = (j == x) ? c : mine; }
        if (sum == G) break;
        __builtin_amdgcn_s_sleep(1);
        if ((++sp & 255u) == 0u) { if (xb_ld(&bar[XB_TMO])) break; if (sp > XB_SPIN_CAP) { atomicAdd(&bar[XB_TMO], 1u); break; } }
    }
    nloc = mine > 0u ? mine : 1u; nx = cnt > 0u ? cnt : 1u;
}
__device__ __forceinline__ void xcd_barrier(const XcdBarrier& b, const bool leader) {
    asm volatile("s_waitcnt vmcnt(0)" ::: "memory");
    __syncthreads();
    if (leader) {
        unsigned* bar = b.bar;
        __builtin_amdgcn_s_waitcnt(0);
        unsigned nloc = b.st[0], nx = b.st[1];
        if (nloc == 0u) { xcd_barrier_complete(bar, b.x, nloc, nx); b.st[0] = nloc; b.st[1] = nx; }
        const unsigned old = xb_add(&bar[XB_XSUB(b.x)], 1u);
        const unsigned gen = old / nloc;
        if (old + 1u == (gen + 1u) * nloc) {
            __builtin_amdgcn_fence(__ATOMIC_RELEASE, "agent");
            asm volatile("s_waitcnt vmcnt(0)" ::: "memory");
            const unsigned og = xb_add(&bar[XB_TOP], 1u);
            const unsigned tg = og / nx;
            if (og + 1u == (tg + 1u) * nx) xb_add(&bar[XB_TOPGEN], 1u);
            else XB_SPIN(xb_ld(&bar[XB_TOPGEN]) == tg, bar);
            __builtin_amdgcn_fence(__ATOMIC_ACQUIRE, "agent");
            xb_add(&bar[XB_XGEN(b.x)], 1u);
            asm volatile("s_waitcnt vmcnt(0)" ::: "memory");
        } else {
            XB_SPIN(xb_ld(&bar[XB_XGEN(b.x)]) == gen, bar);
            __builtin_amdgcn_fence(__ATOMIC_ACQUIRE, "agent");
            asm volatile("s_waitcnt vmcnt(0)" ::: "memory");
        }
    }
    __syncthreads();
}

typedef __attribute__((ext_vector_type(2))) __bf16 bf16x2_t;
typedef __attribute__((ext_vector_type(2))) float f32x2_t;
__device__ __forceinline__ unsigned cvtpk(float lo, float hi) { f32x2_t f; f[0] = lo; f[1] = hi; return __builtin_bit_cast(unsigned, __builtin_convertvector(f, bf16x2_t)); }
__device__ __forceinline__ float bf2f(unsigned v16) { return __uint_as_float(v16 << 16); }
__device__ __forceinline__ int crow(int r, int hi) { return (r & 3) + 8 * (r >> 2) + 4 * hi; }
#define MFMA_BF16(a, b, c) __builtin_amdgcn_mfma_f32_32x32x16_bf16(a, b, c, 0, 0, 0)
__device__ __forceinline__ float wave_sum(float v) {
    v += __int_as_float(__builtin_amdgcn_update_dpp(0, __float_as_int(v), 0xB1, 0xF, 0xF, true));
    v += __int_as_float(__builtin_amdgcn_update_dpp(0, __float_as_int(v), 0x4E, 0xF, 0xF, true));
    v += __int_as_float(__builtin_amdgcn_update_dpp(0, __float_as_int(v), 0x141, 0xF, 0xF, true));
    v += __int_as_float(__builtin_amdgcn_update_dpp(0, __float_as_int(v), 0x140, 0xF, 0xF, true));
    const int vi = __float_as_int(v);
    return (__int_as_float(__builtin_amdgcn_readlane(vi, 0)) + __int_as_float(__builtin_amdgcn_readlane(vi, 16))) + (__int_as_float(__builtin_amdgcn_readlane(vi, 32)) + __int_as_float(__builtin_amdgcn_readlane(vi, 48)));
}

namespace pg8 {
#define PG8_LAS __attribute__((address_space(3)))
typedef unsigned short bf16_t;
typedef short bf16x8 __attribute__((ext_vector_type(8)));
typedef float f32x4 __attribute__((ext_vector_type(4)));
typedef unsigned u32x4 __attribute__((ext_vector_type(4)));
constexpr int BM = 256, BK = 64, HALF = 128, HTB = HALF * BK * 2  , STAGE_BYTES = 8 * HTB, NXCD = 8, WGM = 8;

__host__ __device__ __forceinline__ int lds_byte(int r, int c) { const int st = (r >> 4) * 2 + (c >> 5), rr = r & 15, cc = c & 31, ob = rr * 64 + cc * 2; return st * 1024 + (ob ^ (((ob >> 9) & 1) << 5)); }
__host__ __device__ __forceinline__ void stage_rc(int b, int& R, int& C) { const int st = b / 1024, sb = b % 1024, swz = sb ^ (((sb >> 9) & 1) << 5); R = (st >> 1) * 16 + swz / 64; C = (st & 1) * 32 + (swz % 64) / 2; }
__host__ __device__ __forceinline__ int perm32(int rho) { const int n = rho >> 4, i = rho & 15; return 8 * (i >> 2) + 4 * n + (i & 3); }

struct Unit { int pm, pn; };
struct Gemm { const bf16_t* A; const bf16_t* Bt; int M, N, K; };
struct FixedOrder {
    int pm, pn;
    __device__ __forceinline__ bool next(int i, Unit& u) const { if (i != 0) return false; u.pm = pm; u.pn = pn; return true; }
    __device__ __forceinline__ void a_ready(const Unit&) const {}
    __device__ __forceinline__ void done(const Unit&) const {}
};

struct StaticOrder {
    int nM, nN, nwg, G, c;
    __host__ __device__ void init(int M, int N, int G_, int c_) { nM = M / BM; nN = N / BM; nwg = nM * nN; G = G_; c = c_; }
    __host__ __device__ bool next(int i, Unit& u) const {
        const long L = (long)i * G + c; if (L >= nwg) return false;
        int wgid = (int)L; { const int q = nwg / NXCD, r = nwg % NXCD, xcd = wgid % NXCD, off = wgid / NXCD; wgid = (xcd < r ? xcd * (q + 1) : r * (q + 1) + (xcd - r) * q) + off; }
        const int nig = WGM * nN, gid = wgid / nig, fm = gid * WGM, gsz = (nM - fm) < WGM ? (nM - fm) : WGM;
        u.pm = fm + ((wgid % nig) % gsz); u.pn = (wgid % nig) / gsz; return true;
    }
    __device__ __forceinline__ void a_ready(const Unit&) const {}
    __device__ __forceinline__ void done(const Unit&) const {}
};

template <class Epi, class Sched, bool SWAP = false, bool STAMP = false>
__device__ __forceinline__ void gemm_phase(PG8_LAS unsigned char* lds, const Gemm g, const Sched& S, const Epi& E, unsigned long long* stamps, const int tid_in) {
    int tid_ = tid_in; asm volatile("" : "+v"(tid_));
    const int tid = tid_, wid = __builtin_amdgcn_readfirstlane(tid >> 6), lane = tid & 63, wr = wid >> 2, wc = wid & 3, fr = lane & 15, fq = lane >> 4;
    const int K = g.K, nt = K / BK;
    int ts_lo = 0, ts_hi = 0, nts = 0; const unsigned long long rt_entry = STAMP ? (unsigned long long)wall_clock64() : 0ull;
#define PG8_STAMP() do { if (STAMP && wid == 0 && nts < 64) { const unsigned long long _c = (unsigned long long)clock64(); \
        ts_lo = (lane == nts) ? (int)(unsigned)_c : ts_lo; ts_hi = (lane == nts) ? (int)(unsigned)(_c >> 32) : ts_hi; ++nts; } } while (0)
    PG8_STAMP();
    unsigned voffA[2], voffB[2];
#pragma unroll
    for (int i = 0; i < 2; ++i) { int R, C; stage_rc(tid * 16 + i * 8192, R, C); const int Rb = Epi::PERM ? ((R & ~31) + perm32(R & 31)) : R;
        voffA[i] = (unsigned)(R * K + C) * 2u; voffB[i] = (unsigned)(Rb * K + C) * 2u; }
    const size_t kstep = (size_t)(BK * 2);
    const size_t hstep = (size_t)HALF * K * 2;
    const size_t tstep = 2 * hstep;
    const unsigned ldsw = (unsigned)wid * 1024u;
    const int aoff = lds_byte(wr * 64 + fr, fq * 8), boff = lds_byte(wc * 32 + fr, fq * 8);
#define PG8_SA(b, h) (((b) * 2 + (h)) * HTB)
#define PG8_SB(b, h) ((4 + (b) * 2 + (h)) * HTB)
#define PG8_STAGE(bufoff, gbase, voff) do { _Pragma("unroll") for (int _i = 0; _i < 2; ++_i) \
        __builtin_amdgcn_global_load_lds((const unsigned*)((const char*)(gbase) + (voff)[_i]), (PG8_LAS unsigned*)(lds + (bufoff) + ldsw + _i * 8192), 16, 0, 0); } while (0)
#define PG8_LDA(dst, b, h) do { _Pragma("unroll") for (int m = 0; m < 4; ++m) _Pragma("unroll") for (int k = 0; k < 2; ++k) dst[m][k] = *(const PG8_LAS bf16x8*)(lds + PG8_SA(b, h) + aoff + m * 2048 + k * 1024); } while (0)
#define PG8_LDB(dst, b, h) do { _Pragma("unroll") for (int n = 0; n < 2; ++n) _Pragma("unroll") for (int k = 0; k < 2; ++k) dst[n][k] = *(const PG8_LAS bf16x8*)(lds + PG8_SB(b, h) + boff + n * 2048 + k * 1024); } while (0)
#define PG8_MMA(ai, bj, At, Bt) do { __builtin_amdgcn_s_setprio(1); _Pragma("unroll") for (int m = 0; m < 4; ++m) _Pragma("unroll") for (int n = 0; n < 2; ++n) _Pragma("unroll") for (int k = 0; k < 2; ++k) \
        acc[ai][bj][m][n] = SWAP ? __builtin_amdgcn_mfma_f32_16x16x32_bf16(At[m][k], Bt[n][k], acc[ai][bj][m][n], 0, 0, 0) : __builtin_amdgcn_mfma_f32_16x16x32_bf16(Bt[n][k], At[m][k], acc[ai][bj][m][n], 0, 0, 0); __builtin_amdgcn_s_setprio(0); } while (0)
#define PG8_WAIT_V(n) asm volatile("s_waitcnt vmcnt(" #n ")" ::: "memory")
#define PG8_WAIT_L(n) asm volatile("s_waitcnt lgkmcnt(" #n ")" ::: "memory")
#define PG8_BAR __builtin_amdgcn_s_barrier()
#define PG8_SCHED __builtin_amdgcn_sched_barrier(0)
    Unit cur, nxt; int ui = 0;
    if (!S.next(0, cur)) return;
    f32x4 acc[2][2][4][2];
#pragma unroll
    for (int a = 0; a < 2; ++a)
#pragma unroll
        for (int b = 0; b < 2; ++b)
#pragma unroll
            for (int m = 0; m < 4; ++m)
#pragma unroll
                for (int n = 0; n < 2; ++n) acc[a][b][m][n] = (f32x4){0.f, 0.f, 0.f, 0.f};
    bf16x8 At[4][2], B0[2][2], B1[2][2];
    const char* cA = (const char*)g.A + (size_t)cur.pm * tstep; const char* cB = (const char*)g.Bt + (size_t)cur.pn * tstep;
    S.a_ready(cur);
    PG8_STAGE(PG8_SB(0, 0), cB, voffB); PG8_STAGE(PG8_SA(0, 0), cA, voffA); PG8_STAGE(PG8_SB(0, 1), cB + hstep, voffB); PG8_STAGE(PG8_SA(0, 1), cA + hstep, voffA);
    if (wr == 1) PG8_BAR;
    PG8_WAIT_V(4); PG8_BAR;
    PG8_STAGE(PG8_SB(1, 0), cB + kstep, voffB); PG8_STAGE(PG8_SA(1, 0), cA + kstep, voffA); PG8_STAGE(PG8_SB(1, 1), cB + hstep + kstep, voffB);
    PG8_WAIT_V(6); PG8_BAR;
    PG8_STAMP();
    for (;;) {
        const bool has_next = S.next(ui + 1, nxt);
        const char* nA = has_next ? (const char*)g.A + (size_t)nxt.pm * tstep : cA; const char* nB = has_next ? (const char*)g.Bt + (size_t)nxt.pn * tstep : cB;
        for (int t = 0; t < nt; t += 2) {
            const bool last = (t == nt - 2);
            const char* a1 = cA + (size_t)(t + 1) * kstep;
            const char* a2 = last ? nA : cA + (size_t)(t + 2) * kstep; const char* b2 = last ? nB : cB + (size_t)(t + 2) * kstep;
            const char* a3 = a2 + kstep; const char* b3 = b2 + kstep;
            if (last && has_next) S.a_ready(nxt);
            PG8_LDB(B0, 0, 0); PG8_SCHED; PG8_LDA(At, 0, 0); PG8_STAGE(PG8_SA(1, 1), a1 + hstep, voffA);
            PG8_WAIT_L(8); PG8_BAR; PG8_WAIT_L(0); PG8_MMA(0, 0, At, B0); PG8_BAR; PG8_SCHED;
            PG8_LDB(B1, 0, 1); PG8_STAGE(PG8_SB(0, 0), b2, voffB);
            PG8_BAR; PG8_WAIT_L(0); PG8_MMA(0, 1, At, B1); PG8_BAR;
            PG8_LDA(At, 0, 1); PG8_STAGE(PG8_SA(0, 0), a2, voffA);
            PG8_BAR; PG8_WAIT_L(0); PG8_MMA(1, 0, At, B0); PG8_BAR; PG8_SCHED;
            PG8_STAGE(PG8_SB(0, 1), b2 + hstep, voffB);
            PG8_WAIT_V(6); PG8_BAR; PG8_MMA(1, 1, At, B1); PG8_BAR;
            PG8_LDB(B0, 1, 0); PG8_SCHED; PG8_LDA(At, 1, 0); PG8_STAGE(PG8_SA(0, 1), a2 + hstep, voffA);
            PG8_WAIT_L(8); PG8_BAR; PG8_WAIT_L(0); PG8_MMA(0, 0, At, B0); PG8_BAR; PG8_SCHED;
            PG8_LDB(B1, 1, 1); PG8_STAGE(PG8_SB(1, 0), b3, voffB);
            PG8_BAR; PG8_WAIT_L(0); PG8_MMA(0, 1, At, B1); PG8_BAR;
            PG8_LDA(At, 1, 1); PG8_STAGE(PG8_SA(1, 0), a3, voffA);
            PG8_BAR; PG8_WAIT_L(0); PG8_MMA(1, 0, At, B0); PG8_BAR; PG8_SCHED;
            PG8_STAGE(PG8_SB(1, 1), b3 + hstep, voffB);
            PG8_WAIT_V(6); PG8_BAR; PG8_MMA(1, 1, At, B1); PG8_BAR;
        }
        PG8_STAMP();
        if constexpr (!Epi::AFTER_DRAIN) { E(acc, cur, wr, wc, fr, fq); S.done(cur); }
        PG8_STAMP();
        if (!has_next) break;
#pragma unroll
        for (int a = 0; a < 2; ++a)
#pragma unroll
            for (int b = 0; b < 2; ++b)
#pragma unroll
                for (int m = 0; m < 4; ++m)
#pragma unroll
                    for (int n = 0; n < 2; ++n) acc[a][b][m][n] = (f32x4){0.f, 0.f, 0.f, 0.f};
        cur = nxt; cA = nA; cB = nB; ++ui;
    }
    PG8_WAIT_V(0);
    if (wr == 0) PG8_BAR;
    PG8_BAR;
    if constexpr (Epi::AFTER_DRAIN) { E.fused(acc, cur, wr, wc, fr, fq, lds, wid, lane); S.done(cur); }
    PG8_STAMP();
    if (STAMP && wid == 0) { stamps[lane] = lane < nts ? (((unsigned long long)(unsigned)ts_hi << 32) | (unsigned)ts_lo) : 0ull;
        if (lane == 62) stamps[62] = rt_entry; if (lane == 63) stamps[63] = (unsigned long long)wall_clock64(); }
#undef PG8_STAMP
#undef PG8_SA
#undef PG8_SB
#undef PG8_STAGE
#undef PG8_LDA
#undef PG8_LDB
#undef PG8_MMA
#undef PG8_WAIT_V
#undef PG8_WAIT_L
#undef PG8_BAR
#undef PG8_SCHED
}
}

struct EpiQK {
    static constexpr bool PERM = true, AFTER_DRAIN = false;
    u16* O; int ldc;
    __device__ __forceinline__ void operator()(const pg8::f32x4 (&acc)[2][2][4][2], const pg8::Unit& u, int wr, int wc, int fr, int fq) const {
        const int col0 = u.pn * 256 + wc * 32 + 8 * fq, row0 = u.pm * 256 + wr * 64 + fr;
#pragma unroll
        for (int ai = 0; ai < 2; ++ai)
#pragma unroll
            for (int m = 0; m < 4; ++m) { u16* rowp = O + (size_t)(row0 + ai * 128 + m * 16) * ldc + col0;
#pragma unroll
                for (int bj = 0; bj < 2; ++bj) { const pg8::f32x4 v0 = acc[ai][bj][m][0], v1 = acc[ai][bj][m][1];
                    u32x4 w; w[0] = cvtpk(v0[0], v0[1]); w[1] = cvtpk(v0[2], v0[3]); w[2] = cvtpk(v1[0], v1[1]); w[3] = cvtpk(v1[2], v1[3]);
                    *(u32x4*)(rowp + bj * 128) = w; } }
    }
};
struct EpiV {
    static constexpr bool PERM = false, AFTER_DRAIN = false;
    u16* VT; int layer;
    __device__ __forceinline__ void operator()(const pg8::f32x4 (&acc)[2][2][4][2], const pg8::Unit& u, int wr, int wc, int fr, int fq) const {
        const int colt = u.pn * 256, grp = colt >> 10;
        const int dil = (layer == 0 || grp == 0) ? 1 : (grp == 1 ? 4 : 16);
        const int rowb = u.pm * 256 + wr * 64 + 4 * fq;
#pragma unroll
        for (int bj = 0; bj < 2; ++bj)
#pragma unroll
            for (int n = 0; n < 2; ++n) {
                const int c = (colt & 1023) + bj * 128 + wc * 32 + n * 16 + fr, h = c >> 6, d = c & 63;
#pragma unroll
                for (int ai = 0; ai < 2; ++ai)
#pragma unroll
                    for (int m = 0; m < 4; ++m) {
                        const int r0 = rowb + ai * 128 + m * 16, b = r0 >> 13, t0 = r0 & (SEQ - 1);
                        u16* vrow = VT + (size_t)grp * T * D + ((size_t)(b * NH + h) * HD + d) * SEQ;
                        const pg8::f32x4 v = acc[ai][bj][m][n];
                        if (dil == 1) { u32x2 w; w[0] = cvtpk(v[0], v[1]); w[1] = cvtpk(v[2], v[3]); *(u32x2*)(vrow + t0) = w; }
                        else {
#pragma unroll
                            for (int i = 0; i < 4; ++i) { const int pp = t0 + i; vrow[(pp % dil) * (SEQ / dil) + pp / dil] = (u16)cvtpk(v[i], 0.f); }
                        }
                    }
            }
    }
};
struct EpiWo {
    static constexpr bool PERM = true, AFTER_DRAIN = false;
    u16* Y; const u16* X;
    __device__ __forceinline__ void operator()(const pg8::f32x4 (&acc)[2][2][4][2], const pg8::Unit& u, int wr, int wc, int fr, int fq) const {
        const int row0 = u.pm * 256 + wr * 64 + fr, col0 = u.pn * 256 + wc * 32 + 8 * fq;
#pragma unroll
        for (int ai = 0; ai < 2; ++ai)
#pragma unroll
            for (int m = 0; m < 4; ++m) { const size_t ro = (size_t)(row0 + ai * 128 + m * 16) * D + col0;
#pragma unroll
                for (int bj = 0; bj < 2; ++bj) { const pg8::f32x4 v0 = acc[ai][bj][m][0], v1 = acc[ai][bj][m][1];
                    const u32x4 xr = *(const u32x4*)(X + ro + bj * 128);
                    u32x4 w;
                    w[0] = cvtpk(bf2f(xr[0] & 0xFFFFu) * DN_ALPHA + v0[0], bf2f(xr[0] >> 16) * DN_ALPHA + v0[1]); w[1] = cvtpk(bf2f(xr[1] & 0xFFFFu) * DN_ALPHA + v0[2], bf2f(xr[1] >> 16) * DN_ALPHA + v0[3]);
                    w[2] = cvtpk(bf2f(xr[2] & 0xFFFFu) * DN_ALPHA + v1[0], bf2f(xr[2] >> 16) * DN_ALPHA + v1[1]); w[3] = cvtpk(bf2f(xr[3] & 0xFFFFu) * DN_ALPHA + v1[2], bf2f(xr[3] >> 16) * DN_ALPHA + v1[3]);
                    *(u32x4*)(Y + ro + bj * 128) = w; } }
    }
};
struct EpiSGU {
    static constexpr bool PERM = true, AFTER_DRAIN = false;
    u16* H;
    __device__ __forceinline__ void operator()(const pg8::f32x4 (&acc)[2][2][4][2], const pg8::Unit& u, int wr, int wc, int fr, int fq) const {
        const int row0 = u.pm * 256 + wr * 64 + fr, f0 = u.pn * 128 + wc * 32 + 8 * fq;
#pragma unroll
        for (int ai = 0; ai < 2; ++ai)
#pragma unroll
            for (int m = 0; m < 4; ++m) {
                float hv[8];
#pragma unroll
                for (int n = 0; n < 2; ++n)
#pragma unroll
                    for (int i = 0; i < 4; ++i) { const float gt = acc[ai][0][m][n][i], up = acc[ai][1][m][n][i]; hv[n * 4 + i] = gt / (1.f + __expf(-gt)) * up; }
                u32x4 w; w[0] = cvtpk(hv[0], hv[1]); w[1] = cvtpk(hv[2], hv[3]); w[2] = cvtpk(hv[4], hv[5]); w[3] = cvtpk(hv[6], hv[7]);
                *(u32x4*)(H + (size_t)(row0 + ai * 128 + m * 16) * DF + f0) = w;
            }
    }
};
struct EpiSD {
    static constexpr bool PERM = true, AFTER_DRAIN = false;
    u16* Y;
    __device__ __forceinline__ void operator()(const pg8::f32x4 (&acc)[2][2][4][2], const pg8::Unit& u, int wr, int wc, int fr, int fq) const {
        const int row0 = u.pm * 256 + wr * 64 + fr, col0 = u.pn * 256 + wc * 32 + 8 * fq;
#pragma unroll
        for (int ai = 0; ai < 2; ++ai)
#pragma unroll
            for (int m = 0; m < 4; ++m) { u16* rowp = Y + (size_t)(A_TOT + row0 + ai * 128 + m * 16) * D + col0;
#pragma unroll
                for (int bj = 0; bj < 2; ++bj) { const pg8::f32x4 v0 = acc[ai][bj][m][0], v1 = acc[ai][bj][m][1];
                    u32x4 w; w[0] = cvtpk(v0[0], v0[1]); w[1] = cvtpk(v0[2], v0[3]); w[2] = cvtpk(v1[0], v1[1]); w[3] = cvtpk(v1[2], v1[3]);
                    *(u32x4*)(rowp + bj * 128) = w; } }
    }
};

struct Args {
    const float* in[16];
    float* out;
    unsigned char* ws;
    int ph_lo, ph_hi;
};

#define GEMM_CORE(K_, PA0, PA1, PB, LDB)                                                                                                   \
    {                                                                                                                                      \
        const int g_tid = tid, g_lane = lane, g_wave = wave, g_r32 = r32, g_hi = hi;                   \
        const int g_wm = g_wave >> 2, g_wn = g_wave & 3, g_kc = g_tid & 3, g_kq = g_lane >> 3, g_n4 = g_lane & 7;                           \
        const u16* g_pa0 = (PA0); const u16* g_pa1 = (PA1);                                                                                \
        const size_t g_ldb = (size_t)(LDB);                                                                                                \
        const float* g_pb = (PB) + (size_t)(g_kq * 4) * g_ldb + g_n4 * 4;                                                                  \
        const int g_nk = (K_) / 32;                                                                                                        \
        u32x4 g_ra0, g_ra1; f32x4 g_rb0, g_rb1, g_rb2, g_rb3;                                                                              \
        const u32x4 g_z = {0u, 0u, 0u, 0u};                                                                                                \
        _Pragma("unroll") for (int mb = 0; mb < 4; ++mb) { _Pragma("unroll") for (int nb = 0; nb < 2; ++nb) { _Pragma("unroll") for (int r = 0; r < 16; ++r) acc[mb][nb][r] = 0.f; } } \
        g_ra0 = g_pa0 ? *(const u32x4*)(g_pa0 + g_kc * 8) : g_z; g_ra1 = g_pa1 ? *(const u32x4*)(g_pa1 + g_kc * 8) : g_z;                 \
        g_rb0 = *(const f32x4*)(g_pb); g_rb1 = *(const f32x4*)(g_pb + g_ldb); g_rb2 = *(const f32x4*)(g_pb + 2 * g_ldb); g_rb3 = *(const f32x4*)(g_pb + 3 * g_ldb); \
        _Pragma("unroll 1") for (int kt = 0; kt < g_nk; ++kt) {                                                                            \
            LAS char* As = lds + (kt & 1) * STAGE_BYTES; LAS char* Bs = As + 256 * LDP * 2;                                                \
            *(LAS u32x4*)(As + ((g_tid >> 2) * LDP + g_kc * 8) * 2) = g_ra0;                                                               \
            *(LAS u32x4*)(As + (((g_tid >> 2) + 128) * LDP + g_kc * 8) * 2) = g_ra1;                                                       \
            _Pragma("unroll") for (int i = 0; i < 4; ++i) {                                                                                \
                u32x2 w; w[0] = cvtpk(g_rb0[i], g_rb1[i]); w[1] = cvtpk(g_rb2[i], g_rb3[i]);                                               \
                *(LAS u32x2*)(Bs + ((g_wave * 32 + i * 8 + g_n4) * LDP + g_kq * 4) * 2) = w;                                               \
            }                                                                                                                              \
            __syncthreads();                                                                                                               \
            if (kt + 1 < g_nk) {                                                                                                           \
                const int ko = (kt + 1) * 32;                                                                                              \
                g_ra0 = g_pa0 ? *(const u32x4*)(g_pa0 + ko + g_kc * 8) : g_z; g_ra1 = g_pa1 ? *(const u32x4*)(g_pa1 + ko + g_kc * 8) : g_z; \
                const float* pbk = g_pb + (size_t)ko * g_ldb;                                                                              \
                g_rb0 = *(const f32x4*)(pbk); g_rb1 = *(const f32x4*)(pbk + g_ldb); g_rb2 = *(const f32x4*)(pbk + 2 * g_ldb); g_rb3 = *(const f32x4*)(pbk + 3 * g_ldb); \
            }                                                                                                                              \
            _Pragma("unroll") for (int s = 0; s < 2; ++s) {                                                                                \
                bf16x8 af[4], bfr[2];                                                                                                      \
                _Pragma("unroll") for (int mb = 0; mb < 4; ++mb) af[mb] = *(LAS bf16x8*)(As + ((g_wm * 128 + mb * 32 + g_r32) * LDP + s * 16 + g_hi * 8) * 2); \
                _Pragma("unroll") for (int nb = 0; nb < 2; ++nb) bfr[nb] = *(LAS bf16x8*)(Bs + (((g_wn * 2 + nb) * 32 + g_r32) * LDP + s * 16 + g_hi * 8) * 2); \
                _Pragma("unroll") for (int mb = 0; mb < 4; ++mb) { _Pragma("unroll") for (int nb = 0; nb < 2; ++nb) acc[mb][nb] = MFMA_BF16(af[mb], bfr[nb], acc[mb][nb]); } \
            }                                                                                                                              \
        }                                                                                                                                  \
        __syncthreads();                                                                                                                   \
    }

struct AttnSt { float m, l; f32x16 o0, o1; };

struct AttnFr { bf16x8 k[4]; bf16x8 v[4]; };
__device__ __forceinline__ void attn_load(AttnFr& f, const u16* krow, const u16* vt, size_t vt_dstride) {
#pragma unroll
    for (int d0 = 0; d0 < 4; ++d0) f.k[d0] = *(const bf16x8*)(krow + d0 * 16);
    const u16* vt1 = vt + 32 * vt_dstride;
    union { bf16x8 v; u32x2 h[2]; } va;
    va.h[0] = *(const u32x2*)(vt);       va.h[1] = *(const u32x2*)(vt + 8);   f.v[0] = va.v;
    va.h[0] = *(const u32x2*)(vt + 16);  va.h[1] = *(const u32x2*)(vt + 24);  f.v[1] = va.v;
    va.h[0] = *(const u32x2*)(vt1);      va.h[1] = *(const u32x2*)(vt1 + 8);  f.v[2] = va.v;
    va.h[0] = *(const u32x2*)(vt1 + 16); va.h[1] = *(const u32x2*)(vt1 + 24); f.v[3] = va.v;
}
__device__ __forceinline__ void attn_compute(AttnSt& st, const bf16x8 (&qf)[4], const AttnFr& f, int dist0, float bslope, int dlo, int dhi, int hi, int lane) {
    f32x16 p;
#pragma unroll
    for (int r = 0; r < 16; ++r) p[r] = 0.f;
#pragma unroll
    for (int d0 = 0; d0 < 4; ++d0) p = MFMA_BF16(f.k[d0], qf[d0], p);
    constexpr float C2 = 0.125f * LOG2E;
    float mx = NEGV;
#pragma unroll
    for (int r = 0; r < 16; ++r) {
        const int dist = dist0 - ((r & 3) + 8 * (r >> 2));
        const float sc = __builtin_fmaf(p[r], C2, -bslope * (float)dist);
        const float s_ = (dist >= dlo && dist <= dhi) ? sc : NEGV;
        p[r] = s_; mx = fmaxf(mx, s_);
    }
    mx = fmaxf(mx, shxf(mx, 32, lane));
    const float mnew = fmaxf(st.m, mx);
    const float alpha = __builtin_amdgcn_exp2f(st.m - mnew);
    st.m = mnew;
    float ls = 0.f;
#pragma unroll
    for (int r = 0; r < 16; ++r) { p[r] = __builtin_amdgcn_exp2f(p[r] - mnew); ls += p[r]; }
    st.l = st.l * alpha + ls;
#pragma unroll
    for (int r = 0; r < 16; ++r) { st.o0[r] *= alpha; st.o1[r] *= alpha; }
    union { bf16x8 v; unsigned u[4]; } pb0, pb1;
#pragma unroll
    for (int j = 0; j < 4; ++j) { pb0.u[j] = cvtpk(p[2 * j], p[2 * j + 1]); pb1.u[j] = cvtpk(p[8 + 2 * j], p[8 + 2 * j + 1]); }
    st.o0 = MFMA_BF16(f.v[0], pb0.v, st.o0);
    st.o0 = MFMA_BF16(f.v[1], pb1.v, st.o0);
    st.o1 = MFMA_BF16(f.v[2], pb0.v, st.o1);
    st.o1 = MFMA_BF16(f.v[3], pb1.v, st.o1);
    (void)hi;
}

__device__ __forceinline__ float dpp_rowmax(float v) {
    v = fmaxf(v, __int_as_float(__builtin_amdgcn_update_dpp(0, __float_as_int(v), 0xB1, 0xF, 0xF, true)));
    v = fmaxf(v, __int_as_float(__builtin_amdgcn_update_dpp(0, __float_as_int(v), 0x4E, 0xF, 0xF, true)));
    v = fmaxf(v, __int_as_float(__builtin_amdgcn_update_dpp(0, __float_as_int(v), 0x141, 0xF, 0xF, true)));
    v = fmaxf(v, __int_as_float(__builtin_amdgcn_update_dpp(0, __float_as_int(v), 0x140, 0xF, 0xF, true)));
    return v;
}
__device__ __forceinline__ int dpp_rowmin_i(int v) {
    v = min(v, __builtin_amdgcn_update_dpp(0, v, 0xB1, 0xF, 0xF, true));
    v = min(v, __builtin_amdgcn_update_dpp(0, v, 0x4E, 0xF, 0xF, true));
    v = min(v, __builtin_amdgcn_update_dpp(0, v, 0x141, 0xF, 0xF, true));
    v = min(v, __builtin_amdgcn_update_dpp(0, v, 0x140, 0xF, 0xF, true));
    return v;
}
__device__ __forceinline__ float rl_f(float v, int l) { return __int_as_float(__builtin_amdgcn_readlane(__float_as_int(v), l)); }

__device__ __forceinline__ void top3_insert(float v, int i, float& v0, int& i0, float& v1, int& i1, float& v2, int& i2) {
    const bool b0 = (v > v0) || (v == v0 && i < i0);
    const bool b1 = (v > v1) || (v == v1 && i < i1);
    const bool b2 = (v > v2) || (v == v2 && i < i2);
    const float nv2 = b1 ? v1 : (b2 ? v : v2); const int ni2 = b1 ? i1 : (b2 ? i : i2);
    const float nv1 = b0 ? v0 : (b1 ? v : v1); const int ni1 = b0 ? i0 : (b1 ? i : i1);
    const float nv0 = b0 ? v : v0;             const int ni0 = b0 ? i : i0;
    v0 = nv0; i0 = ni0; v1 = nv1; i1 = ni1; v2 = nv2; i2 = ni2;
}

__device__ __forceinline__ void ln_row(float (&v)[16], const float* __restrict__ g, const float* __restrict__ b, int lane) {
    float s = 0.f;
#pragma unroll
    for (int i = 0; i < 16; ++i) s += v[i];
    const float mu = wave_sum(s) * (1.f / D);
    float q = 0.f;
#pragma unroll
    for (int i = 0; i < 16; ++i) { const float d = v[i] - mu; q += d * d; }
    const float rstd = rsqrtf(wave_sum(q) * (1.f / D) + LN_EPS);
#pragma unroll
    for (int j = 0; j < 4; ++j) {
        const f32x4 gg = *(const f32x4*)(g + j * 256 + lane * 4), bb = *(const f32x4*)(b + j * 256 + lane * 4);
#pragma unroll
        for (int c = 0; c < 4; ++c) v[j * 4 + c] = (v[j * 4 + c] - mu) * rstd * gg[c] + bb[c];
    }
}

typedef __attribute__((ext_vector_type(2))) float f32x2_;
__device__ __forceinline__ bf16x8 fp8x8_to_bf16(unsigned lo, unsigned hi_) {
    const f32x2_ a = __builtin_amdgcn_cvt_pk_f32_fp8((int)lo, false), b = __builtin_amdgcn_cvt_pk_f32_fp8((int)lo, true);
    const f32x2_ c = __builtin_amdgcn_cvt_pk_f32_fp8((int)hi_, false), d = __builtin_amdgcn_cvt_pk_f32_fp8((int)hi_, true);
    union { bf16x8 v; unsigned u[4]; } r;
    r.u[0] = cvtpk(a[0], a[1]); r.u[1] = cvtpk(b[0], b[1]); r.u[2] = cvtpk(c[0], c[1]); r.u[3] = cvtpk(d[0], d[1]);
    return r.v;
}
__device__ __forceinline__ unsigned pack_fp8x4(float a, float b, float c, float d) { int p = __builtin_amdgcn_cvt_pk_fp8_f32(a, b, 0, false); return (unsigned)__builtin_amdgcn_cvt_pk_fp8_f32(c, d, p, true); }

constexpr float Y8_SCALE = 16.f;
constexpr int MOE_XCAP = 576;
#define MOE_GAS __attribute__((address_space(1)))
typedef MOE_GAS unsigned char moe_gcb;
constexpr int MOE_BP = 72;
constexpr int MOE_BSTAGE = 128 * MOE_BP * 2;
constexpr int MOE_LDS_VA = 3 * MOE_BSTAGE;
constexpr int MOE_LDS_W = MOE_LDS_VA + 4096;
constexpr int MOE_LDS_XCH = 65536;
template <bool DOWN>
__device__ __forceinline__ void moe_expert(LAS char* lds, const int tid, const int lane, const int wave, const int r32, const int hi,
                                           const unsigned char* __restrict__ abase  , const float* __restrict__ w0, const float* __restrict__ w1, const int ng  , void* __restrict__ outv,
                                           const int pass0, const int npass_, const int st0, const int nstl  , const bool y8 = false  ,
                                           const bool xr = false  ) {
    constexpr int KT = DOWN ? 4 : 16, NP = DOWN ? 8 : 4, LDB = DOWN ? 1024 : 256, APITCH = DOWN ? 256 : 1024  , PSTEP = DOWN ? 128 : 64;
    LAS int* rowva = (LAS int*)(lds + MOE_LDS_VA); LAS float* roww = (LAS float*)(lds + MOE_LDS_W);
    const int nst = nstl;
    const int nsteps = npass_ * nst * KT; (void)NP;
    unsigned aoff[2];
#define MOE_AOFF(ST_) { _Pragma("unroll") for (int a = 0; a < 2; ++a) { const int va_ = rowva[(ST_) * 512 + wave * 64 + a * 32 + r32]; \
        const int srow_ = DOWN ? va_ : (va_ == TRASH_VA ? 0 : (va_ >> 3)); aoff[a] = (unsigned)srow_ * APITCH + hi * 32; } }
    const int seg = wave >> 1, n4 = lane & 7, kp = (wave & 1) * 16 + (lane >> 3);
    const char* wbase = (const char*)(DOWN ? (w0 + seg * 32) : (((seg < 2) ? w0 : w1) + (seg & 1) * 32));
    unsigned boff = (unsigned)(4 * n4 + 2 * kp * LDB) * 4u; asm volatile("" : "+v"(boff));
    unsigned wb_ = (unsigned)((seg * 32 + n4) * MOE_BP + 2 * kp) * 2u; asm volatile("" : "+v"(wb_));
    unsigned lb_ = (unsigned)(r32 * MOE_BP + hi * 32) * 2u; asm volatile("" : "+v"(lb_));
    f32x16 acc[2][4];
#pragma unroll
    for (int a = 0; a < 2; ++a)
#pragma unroll
        for (int c = 0; c < 4; ++c)
#pragma unroll
            for (int r = 0; r < 16; ++r) acc[a][c][r] = 0.f;
    u32x4 fa8[2][2];
    f32x16 accx; u32x4 fa8x[2]; unsigned aoffx = 0u;
#pragma unroll
    for (int r = 0; r < 16; ++r) accx[r] = 0.f;
    fa8x[0] = u32x4{0u, 0u, 0u, 0u}; fa8x[1] = u32x4{0u, 0u, 0u, 0u};
    f32x4 rb0[4], rb1[4];
#define MOE_DEC(S_) const int s2_ = (S_) < nsteps ? (S_) : 0; const int pl_ = s2_ / (nst * KT); const int rm_ = s2_ - pl_ * (nst * KT); const int sl_ = rm_ / KT; const int kt_ = rm_ - sl_ * KT; const int ps_ = pass0 + pl_; const int stt_ = st0 + sl_;
#define MOE_LOADB(S_, RB) { MOE_DEC(S_) (void)stt_; \
        uint64_t wu_ = (uint64_t)(wbase + (size_t)(ps_ * PSTEP + kt_ * 64 * LDB) * 4), wv_ = wu_ + 16 * LDB * 4; asm volatile("" : "+s"(wu_), "+s"(wv_));     \
        const moe_gcb* wug_ = (const moe_gcb*)wu_; const moe_gcb* wvg_ = (const moe_gcb*)wv_; \
        unsigned bo_ = boff; asm volatile("" : "+v"(bo_));     \
        RB[0] = *(const MOE_GAS f32x4*)(wug_ + bo_); RB[1] = *(const MOE_GAS f32x4*)(wug_ + bo_ + LDB * 4); RB[2] = *(const MOE_GAS f32x4*)(wvg_ + bo_); RB[3] = *(const MOE_GAS f32x4*)(wvg_ + bo_ + LDB * 4); }
#define MOE_WRITEB(STG, RB) { LAS char* Bs_ = lds + (STG) * MOE_BSTAGE; \
        _Pragma("unroll") for (int i = 0; i < 4; ++i) { LAS unsigned* q_ = (LAS unsigned*)(Bs_ + wb_ + i * (8 * MOE_BP * 2)); q_[0] = cvtpk(RB[0][i], RB[1][i]); q_[8] = cvtpk(RB[2][i], RB[3][i]); } }
#define MOE_COMPUTE(STG, DO_MFMA) { LAS char* Bs_ = lds + (STG) * MOE_BSTAGE; \
        _Pragma("unroll") for (int u = 0; u < 4; ++u) { \
            bf16x8 bfr[4]; \
            if (DO_MFMA) { _Pragma("unroll") for (int c = 0; c < 4; ++c) bfr[c] = *(LAS bf16x8*)(Bs_ + lb_ + (c * 32 * MOE_BP + u * 8) * 2); } \
            _Pragma("unroll") for (int a = 0; a < 2; ++a) { \
                if (DO_MFMA) { const bf16x8 af_ = fp8x8_to_bf16(fa8[a][u >> 1][(u & 1) * 2], fa8[a][u >> 1][(u & 1) * 2 + 1]); \
                    _Pragma("unroll") for (int c = 0; c < 4; ++c) acc[a][c] = MFMA_BF16(bfr[c], af_, acc[a][c]); } \
            } \
        } }
      \
#define MOE_RELOAD { _Pragma("unroll") for (int a = 0; a < 2; ++a) { unsigned ao_ = aoff[a]; asm volatile("" : "+v"(ao_)); \
            fa8[a][0] = *(const MOE_GAS u32x4*)(ab_n + ao_); fa8[a][1] = *(const MOE_GAS u32x4*)(ab_n + ao_ + 16); } }
#define MOE_XCOMPUTE(STG) if (!DOWN) { LAS char* Bs_ = lds + (STG) * MOE_BSTAGE; \
        _Pragma("unroll") for (int u = 0; u < 4; ++u) { \
            const bf16x8 ax_ = fp8x8_to_bf16(fa8x[u >> 1][(u & 1) * 2], fa8x[u >> 1][(u & 1) * 2 + 1]); \
            if (u & 1) { unsigned ao_ = aoffx; asm volatile("" : "+v"(ao_)); fa8x[u >> 1] = *(const MOE_GAS u32x4*)(ab_n + ao_ + (u >> 1) * 16); } \
            const bf16x8 bx_ = *(LAS bf16x8*)(Bs_ + (wave & 3) * (32 * MOE_BP * 2) + lb_ + u * 16); \
            accx = MFMA_BF16(bx_, ax_, accx); } }
#define MOE_NEXTA(S_) MOE_DEC(S_) (void)ps_; \
        if (stt_ != st_loaded) { MOE_AOFF(stt_) st_loaded = stt_; } \
        uint64_t abn_ = (uint64_t)abase + kt_ * 64; asm volatile("" : "+s"(abn_)); const moe_gcb* ab_n = (const moe_gcb*)abn_;
    int st_loaded = st0;
    MOE_AOFF(st0)
    { const char* ab0 = (const char*)abase;
#pragma unroll
      for (int a = 0; a < 2; ++a)
#pragma unroll
          for (int h2 = 0; h2 < 2; ++h2) fa8[a][h2] = *(const u32x4*)(ab0 + aoff[a] + h2 * 16); }
    if (!DOWN) {
        const int vax_ = xr ? rowva[512 + 32 * (wave >> 2) + r32] : TRASH_VA; aoffx = (unsigned)(vax_ == TRASH_VA ? 0 : (vax_ >> 3)) * APITCH + hi * 32;
        fa8x[0] = *(const u32x4*)((const char*)abase + aoffx); fa8x[1] = *(const u32x4*)((const char*)abase + aoffx + 16); }
    MOE_LOADB(0, rb0)
    MOE_LOADB(1, rb1)
    MOE_WRITEB(0, rb0)
    MOE_LOADB(2, rb0)
    int stg = 0;
#pragma unroll 1
    for (int sidx = 0; sidx < nsteps; sidx += 2) {
        const int pl = sidx / (nst * KT); const int rm = sidx - pl * (nst * KT); const int sl = rm / KT; const int kt = rm - sl * KT; const int ps = pass0 + pl, stt = st0 + sl;
        const bool wv = (wave * 64) < (ng - stt * 512);
        const int stg1 = stg == 2 ? 0 : stg + 1, stg2 = stg1 == 2 ? 0 : stg1 + 1;
        __syncthreads();
        MOE_WRITEB(stg1, rb1)
        MOE_LOADB(sidx + 3, rb1)
        { MOE_NEXTA(sidx + 1)
          if (wv) MOE_COMPUTE(stg, true)
          MOE_RELOAD
          MOE_XCOMPUTE(stg) }
        __syncthreads();
        MOE_WRITEB(stg2, rb0)
        MOE_LOADB(sidx + 4, rb0)
        { MOE_NEXTA(sidx + 2)
          if (wv) MOE_COMPUTE(stg1, true)
          MOE_RELOAD
          MOE_XCOMPUTE(stg1) }
        stg = stg2;
        if (kt == KT - 2) {
            const int le_ = lane_id_(); const int lane = le_, r32 = le_ & 31, hi = le_ >> 5; (void)lane;
            if (wv) {
                const int nrows = ng - stt * 512;
#pragma unroll
                for (int a = 0; a < 2; ++a) {
                    if (a == 0 || (wave * 64 + 32) < nrows) {
                        const int lrow = stt * 512 + wave * 64 + a * 32 + r32;
                        const unsigned va = (unsigned)rowva[lrow];
                        if (DOWN) {
                            const float w = roww[lrow];
#pragma unroll
                            for (int c = 0; c < 4; ++c) {
                                float yv_[16];
#pragma unroll
                                for (int j = 0; j < 16; ++j) yv_[j] = acc[a][c][(j >> 2) + 4 * (j & 3)] * w;
                                if (y8) {
                                    u32x4 q8;
#pragma unroll
                                    for (int jj = 0; jj < 4; ++jj) q8[jj] = pack_fp8x4(yv_[4 * jj], yv_[4 * jj + 1], yv_[4 * jj + 2], yv_[4 * jj + 3]);
                                    *(u32x4*)((unsigned char*)outv + (size_t)va * D + ps * 128 + c * 32 + 16 * hi) = q8;
                                } else {
                                    u32x4 q0, q1;
#pragma unroll
                                    for (int jj = 0; jj < 4; ++jj) { q0[jj] = cvtpk(yv_[2 * jj], yv_[2 * jj + 1]); q1[jj] = cvtpk(yv_[8 + 2 * jj], yv_[9 + 2 * jj]); }
                                    u16* o = (u16*)outv + (size_t)va * D + ps * 128 + c * 32 + 16 * hi;
                                    *(u32x4*)o = q0; *(u32x4*)(o + 8) = q1;
                                }
                            }
                        } else {
#pragma unroll
                            for (int c = 0; c < 2; ++c) {
                                float hv[16];
#pragma unroll
                                for (int j = 0; j < 16; ++j) { const int r = (j >> 2) + 4 * (j & 3); const float gt = acc[a][c][r], up = acc[a][c + 2][r]; hv[j] = gt / (1.f + __expf(-gt)) * up; }
                                u32x4 q;
#pragma unroll
                                for (int jj = 0; jj < 4; ++jj) q[jj] = pack_fp8x4(hv[4 * jj], hv[4 * jj + 1], hv[4 * jj + 2], hv[4 * jj + 3]);
                                *(u32x4*)((unsigned char*)outv + (size_t)va * DF + ps * 64 + c * 32 + 16 * hi) = q;
                            }
                        }
                    }
                }
#pragma unroll
                for (int a = 0; a < 2; ++a)
#pragma unroll
                    for (int c = 0; c < 4; ++c)
#pragma unroll
                        for (int r = 0; r < 16; ++r) acc[a][c][r] = 0.f;
            }
            if (!DOWN) { if (xr) {
                LAS float* xch = (LAS float*)(lds + MOE_LDS_XCH) + ((wave >> 2) * 2 + (wave & 1)) * 1024 + lane;
                if ((wave & 3) >= 2) {
#pragma unroll
                    for (int r = 0; r < 16; ++r) xch[r * 64] = accx[r];
                }
                __syncthreads();
                if ((wave & 3) < 2) {
                    const unsigned vax = (unsigned)rowva[512 + 32 * (wave >> 2) + r32];
                    u32x4 q;
#pragma unroll
                    for (int jj = 0; jj < 4; ++jj) {
#pragma unroll
                        for (int i = 0; i < 4; ++i) { const int r = jj + 4 * i; const float gt = accx[r]; accx[r] = gt / (1.f + __expf(-gt)) * xch[r * 64]; }
                        q[jj] = pack_fp8x4(accx[jj], accx[jj + 4], accx[jj + 8], accx[jj + 12]);
                    }
                    *(u32x4*)((unsigned char*)outv + (size_t)vax * DF + ps * 64 + (wave & 3) * 32 + 16 * hi) = q;
                }
                }
#pragma unroll
                for (int r = 0; r < 16; ++r) accx[r] = 0.f;
            }
        }
    }
    __syncthreads();
#undef MOE_XCOMPUTE
#undef MOE_AOFF
#undef MOE_DEC
#undef MOE_LOADB
#undef MOE_WRITEB
#undef MOE_COMPUTE
#undef MOE_RELOAD
#undef MOE_NEXTA
}

constexpr int Q8_BP = 144;
constexpr int Q8_BSTAGE = 128 * Q8_BP;
typedef __attribute__((ext_vector_type(8))) int q8_i32x8;
template <int NCH>
__device__ __forceinline__ void qkv8_item(LAS char* lds, const int wave, const unsigned char* __restrict__ a8  , const unsigned char* __restrict__ w8  ,
                                          u16* __restrict__ outp  , const int ldc) {
    constexpr int NSTEPS = NCH * 8;
    const int l0 = lane_id_(); const int r32 = l0 & 31, hi = l0 >> 5;
    unsigned aoff[2];
#pragma unroll
    for (int a = 0; a < 2; ++a) { aoff[a] = (unsigned)(wave * 64 + a * 32 + r32) * 1024u + hi * 32; asm volatile("" : "+v"(aoff[a])); }
    const int t_ = wave * 64 + l0, col_ = t_ >> 2, p_ = t_ & 3, kap_ = col_ & 31;
    unsigned boff = (unsigned)col_ * 1024u + p_ * 32; asm volatile("" : "+v"(boff));
    unsigned wb = (unsigned)((col_ & ~31) + (kap_ & 3) * 8 + (kap_ >> 2)) * Q8_BP + p_ * 32; asm volatile("" : "+v"(wb));
    unsigned lb = (unsigned)r32 * Q8_BP + hi * 32; asm volatile("" : "+v"(lb));
    f32x16 acc[2][4];
#pragma unroll
    for (int a = 0; a < 2; ++a)
#pragma unroll
        for (int c = 0; c < 4; ++c)
#pragma unroll
            for (int r = 0; r < 16; ++r) acc[a][c][r] = 0.f;
    u32x4 fa0[2][2][2], fa1[2][2][2];
    u32x4 rb0[2], rb1[2];
#define Q8_LOADA(FA, S_) { const int s2_ = (S_) < NSTEPS ? (S_) : 0; uint64_t ab_ = (uint64_t)a8 + (s2_ & 7) * 128; asm volatile("" : "+s"(ab_)); const moe_gcb* ag_ = (const moe_gcb*)ab_; \
        _Pragma("unroll") for (int a = 0; a < 2; ++a) { unsigned ao_ = aoff[a]; asm volatile("" : "+v"(ao_)); \
            _Pragma("unroll") for (int kk = 0; kk < 2; ++kk) { FA[a][kk][0] = *(const MOE_GAS u32x4*)(ag_ + ao_ + kk * 64); FA[a][kk][1] = *(const MOE_GAS u32x4*)(ag_ + ao_ + kk * 64 + 16); } } }
#define Q8_LOADB(RB, S_) { const int s2_ = (S_) < NSTEPS ? (S_) : 0; uint64_t wu_ = (uint64_t)w8 + (size_t)(s2_ >> 3) * 131072 + (s2_ & 7) * 128; asm volatile("" : "+s"(wu_)); const moe_gcb* wg_ = (const moe_gcb*)wu_; \
        unsigned bo_ = boff; asm volatile("" : "+v"(bo_)); RB[0] = *(const MOE_GAS u32x4*)(wg_ + bo_); RB[1] = *(const MOE_GAS u32x4*)(wg_ + bo_ + 16); }
#define Q8_WRITEB(STG, RB) { LAS char* Bs_ = lds + (STG) * Q8_BSTAGE + wb; *(LAS u32x4*)Bs_ = RB[0]; *(LAS u32x4*)(Bs_ + 16) = RB[1]; }
#define Q8_CAT8(X0, X1) q8_i32x8{(int)(X0)[0], (int)(X0)[1], (int)(X0)[2], (int)(X0)[3], (int)(X1)[0], (int)(X1)[1], (int)(X1)[2], (int)(X1)[3]}
#define Q8_MFMA(B_, A_, C_) __builtin_amdgcn_mfma_scale_f32_32x32x64_f8f6f4(B_, A_, C_, 0, 0, 0, 0x7F79  , 1, 0x7F79  )
#define Q8_COMPUTE(STG, FA) { LAS char* Bs_ = lds + (STG) * Q8_BSTAGE + lb; \
        _Pragma("unroll") for (int kk = 0; kk < 2; ++kk) { const q8_i32x8 af0_ = Q8_CAT8(FA[0][kk][0], FA[0][kk][1]), af1_ = Q8_CAT8(FA[1][kk][0], FA[1][kk][1]); \
            _Pragma("unroll") for (int c = 0; c < 4; ++c) { const u32x4 b0_ = *(LAS u32x4*)(Bs_ + c * 32 * Q8_BP + kk * 64), b1_ = *(LAS u32x4*)(Bs_ + c * 32 * Q8_BP + kk * 64 + 16); const q8_i32x8 bf_ = Q8_CAT8(b0_, b1_); \
                acc[0][c] = Q8_MFMA(bf_, af0_, acc[0][c]); acc[1][c] = Q8_MFMA(bf_, af1_, acc[1][c]); } } }
    Q8_LOADA(fa0, 0)
    Q8_LOADA(fa1, 1)
    Q8_LOADB(rb0, 0)
    Q8_LOADB(rb1, 1)
    Q8_WRITEB(0, rb0)
    Q8_LOADB(rb0, 2)
    int stg = 0;
#pragma unroll 1
    for (int s = 0; s < NSTEPS; s += 2) {
        const int stg1 = stg == 2 ? 0 : stg + 1, stg2 = stg1 == 2 ? 0 : stg1 + 1;
        __syncthreads();
        Q8_WRITEB(stg1, rb1)
        Q8_LOADB(rb1, s + 3)
        Q8_COMPUTE(stg, fa0)
        Q8_LOADA(fa0, s + 2)
        __syncthreads();
        Q8_WRITEB(stg2, rb0)
        Q8_LOADB(rb0, s + 4)
        Q8_COMPUTE(stg1, fa1)
        Q8_LOADA(fa1, s + 3)
        stg = stg2;
        if ((s & 7) == 6) {
            const int cl = s >> 3;
            const int le_ = lane_id_(); const int r32e = le_ & 31, hie = le_ >> 5;
#pragma unroll
            for (int a = 0; a < 2; ++a) {
                u16* orow = outp + (size_t)(wave * 64 + a * 32 + r32e) * ldc + cl * 128 + 16 * hie;
#pragma unroll
                for (int c = 0; c < 4; ++c) {
                    u32x4 q0, q1;
#pragma unroll
                    for (int jj = 0; jj < 4; ++jj) { q0[jj] = cvtpk(acc[a][c][((2 * jj) >> 2) + 4 * ((2 * jj) & 3)], acc[a][c][((2 * jj + 1) >> 2) + 4 * ((2 * jj + 1) & 3)]);
                                                     q1[jj] = cvtpk(acc[a][c][((8 + 2 * jj) >> 2) + 4 * ((8 + 2 * jj) & 3)], acc[a][c][((9 + 2 * jj) >> 2) + 4 * ((9 + 2 * jj) & 3)]); }
                    *(u32x4*)(orow + c * 32) = q0; *(u32x4*)(orow + c * 32 + 8) = q1;
                }
            }
#pragma unroll
            for (int a = 0; a < 2; ++a)
#pragma unroll
                for (int c = 0; c < 4; ++c)
#pragma unroll
                    for (int r = 0; r < 16; ++r) acc[a][c][r] = 0.f;
        }
    }
    __syncthreads();
#undef Q8_LOADA
#undef Q8_LOADB
#undef Q8_WRITEB
#undef Q8_CAT8
#undef Q8_MFMA
#undef Q8_COMPUTE
}

constexpr int N_PHASES = 21;

#define P_x_in CTX_IN(0)
#define P_xb ((u16*)(ws + WS_XB))
#define P_x1 ((float*)(ws + WS_X1))
#define P_x2 ((float*)(ws + WS_X2))
#define P_ypre ((u16*)(ws + WS_YPRE))
#define P_qkv ((u16*)(ws + WS_QKV))
#define P_vT ((u16*)(ws + WS_VT))
#define P_kmean ((float*)(ws + WS_KM))
#define P_ao ((u16*)(ws + WS_AO))
#define P_og ((u16*)(ws + WS_OG))
#define P_lse ((float*)(ws + WS_LSE))
#define P_topw ((float*)(ws + WS_TOPW))
#define P_list ((int*)(ws + WS_LIST))
#define P_hb ((u16*)(ws + WS_HB))
#define P_yb ((u16*)(ws + WS_YB))
#define P_cnt_all ((int*)(ws + WS_CTL + CTL_ECNT_OFF))
#define P_xb8 ((unsigned char*)(ws + WS_XB8))
#define P_hbs ((u16*)(ws + WS_HBS))
#define P_xq8 ((unsigned char*)(ws + WS_XQ8))
#define P_wq8 ((unsigned char*)(ws + WS_WQ8))
#define P_selm ((unsigned*)(ws + WS_SELM))
#define P_part ((u16*)(ws + WS_PART))
#define P_plse ((float*)(ws + WS_PLSE))
#define PH_BEGIN int tid = wave_s_ * 64 + lane_id_(); asm volatile("" : "+v"(tid)); const int lane = tid & 63, r32 = lane & 31, hi = lane >> 5; const int wave = __builtin_amdgcn_readfirstlane(tid >> 6); (void)lane; (void)r32; (void)hi; (void)wave
constexpr int LDS_CTX = LDS_BAR + 16;
__device__ __forceinline__ uint64_t ctx_ld(int i) {
    extern __shared__ __attribute__((aligned(16))) unsigned char lds_raw[];
    const LAS unsigned* q = (const LAS unsigned*)((LAS char*)lds_raw + LDS_CTX) + 2 * i;
    const unsigned lo = __builtin_amdgcn_readfirstlane(q[0]), hi = __builtin_amdgcn_readfirstlane(q[1]);
    return ((uint64_t)hi << 32) | lo;
}
typedef __attribute__((address_space(1))) unsigned char gbyte;
#define AS_GLOBAL(T, u64v) ((T*)(gbyte*)(u64v))
#define CTX_IN(i) AS_GLOBAL(const float, ctx_ld(i))
#define PH_FN_BEGIN \
    extern __shared__ __attribute__((aligned(16))) unsigned char lds_raw[]; \
    LAS char* lds = (LAS char*)lds_raw; (void)lds; \
    const int G = gridDim.x, bid = blockIdx.x; (void)G; (void)bid; \
    unsigned char* const ws = AS_GLOBAL(unsigned char, ctx_ld(17)); (void)ws; \
    const int NQ = L == 0 ? 3072 : 9216; (void)NQ; \
    int* cnt = P_cnt_all + L * NE * CNT_STRIDE; (void)cnt;
__device__ __forceinline__ void ph_p0(int L, int rep_, const int wave_s_) {
    PH_FN_BEGIN
    (void)rep_;
    PH_BEGIN;
    for (size_t i = (size_t)bid * NTHR + tid; i < (size_t)T * D / 4; i += (size_t)G * NTHR) {
        const f32x4 v = *(const f32x4*)(P_x_in + i * 4);
        u32x2 w; w[0] = cvtpk(v[0], v[1]); w[1] = cvtpk(v[2], v[3]);
        *(u32x2*)(P_xb + i * 4) = w;
#if QKV_FP8
        *(unsigned*)(P_xq8 + i * 4) = pack_fp8x4(v[0], v[1], v[2], v[3]);
#endif
    }
    LAS float* tl = (LAS float*)lds;
    for (int it = bid; it < 3968 + 128; it += G) {
        int seg, kt;
        if (it < 3840) { seg = it >> 4; kt = it & 15; } else if (it < 3968) { seg = 240 + ((it - 3840) >> 2); kt = (it - 3840) & 3; } else { seg = 272 + ((it - 3968) >> 4); kt = (it - 3968) & 15; }
        const float* src; int ld; u16* dst; int Kd = 1024; u16* dst_lo = nullptr; int rcol = 0; unsigned char* dst8 = nullptr;
        if (seg < 48) { const int col = 64 * seg; src = CTX_IN(1) + col; ld = 3072; dst = (u16*)(ws + WS_WQK0) + (size_t)col * 1024; if (QKV_FP8) dst8 = P_wq8 + (size_t)col * 1024; }
        else if (seg < 192) { const int col = 64 * (seg - 48); src = CTX_IN(2) + col; ld = 9216; dst = (u16*)(ws + WS_WQK1) + (size_t)col * 1024; if (QKV_FP8) dst8 = P_wq8 + (size_t)(3072 + col) * 1024; }
        else if (seg < 224) { const int s2 = seg - 192, l2 = s2 >> 4, col = 64 * (s2 & 15); src = CTX_IN(3) + (size_t)l2 * D * D + col; ld = 1024; dst = (u16*)(ws + WS_WO) + (size_t)l2 * D * D + (size_t)col * 1024; }
        else if (seg < 240) { const int s2 = seg - 224, l2 = s2 >> 3, i8 = s2 & 7, un = i8 >> 2, q = i8 & 3;
            src = (q < 2 ? CTX_IN(11) : CTX_IN(12)) + (size_t)l2 * D * DF + un * 128 + 64 * (q & 1); ld = 256; dst = (u16*)(ws + WS_WSGU) + (size_t)l2 * 512 * 1024 + (size_t)(64 * i8) * 1024; }
        else if (seg < 272) { const int s2 = seg - 240, l2 = s2 >> 4, col = 64 * (s2 & 15); src = CTX_IN(13) + (size_t)l2 * DF * D + col; ld = 1024; Kd = 256; dst = (u16*)(ws + WS_WSD) + (size_t)l2 * D * DF + (size_t)col * 256; }
        else { const int s2 = seg - 272, l2 = s2 >> 2, col = 64 * (s2 & 3); src = CTX_IN(6) + (size_t)l2 * D * NE + col; ld = 256; rcol = col; dst = (u16*)(ws + WS_WRH) + (size_t)l2 * NE * D; dst_lo = (u16*)(ws + WS_WRL) + (size_t)l2 * NE * D; }
        {
            const int kr = tid >> 4, c4 = tid & 15;
#pragma unroll
            for (int i = 0; i < 2; ++i) {
                const f32x4 v = *(const f32x4*)(src + (size_t)(kt * 64 + kr + 32 * i) * ld + 4 * c4);
#pragma unroll
                for (int jj = 0; jj < 4; ++jj) tl[(kr + 32 * i) * 65 + 4 * c4 + jj] = v[jj];
            }
        }
        __syncthreads();
        {
            const int row = tid >> 3, kc = tid & 7;
            float f[8];
#pragma unroll
            for (int jj = 0; jj < 8; ++jj) f[jj] = tl[(8 * kc + jj) * 65 + row];
            u32x4 w; w[0] = cvtpk(f[0], f[1]); w[1] = cvtpk(f[2], f[3]); w[2] = cvtpk(f[4], f[5]); w[3] = cvtpk(f[6], f[7]);
            if (dst_lo) {
                u32x4 wl;
#pragma unroll
                for (int jj = 0; jj < 4; ++jj) wl[jj] = cvtpk(f[2 * jj] - bf2f(w[jj] & 0xFFFFu), f[2 * jj + 1] - bf2f(w[jj] >> 16));
                const int E_ = rcol + row;
                const size_t fi = ((size_t)(((E_ >> 5) * 16 + kt) * 4 + (kc >> 1)) * 64 + (kc & 1) * 32 + (E_ & 31)) * 8;
                *(u32x4*)(dst + fi) = w; *(u32x4*)(dst_lo + fi) = wl;
            } else if (dst8) {
                u32x2 w8; w8[0] = pack_fp8x4(f[0] * 64.f, f[1] * 64.f, f[2] * 64.f, f[3] * 64.f); w8[1] = pack_fp8x4(f[4] * 64.f, f[5] * 64.f, f[6] * 64.f, f[7] * 64.f);
                *(u32x2*)(dst8 + (size_t)row * 1024 + kt * 64 + 8 * kc) = w8;
            } else *(u32x4*)(dst + (size_t)row * Kd + kt * 64 + 8 * kc) = w;
        }
        __syncthreads();
    }
}

__device__ __forceinline__ void ph_qkv(int L, int rep_, const int wave_s_) {
    PH_FN_BEGIN
    (void)rep_;
#if QKV_FP8
    PH_BEGIN;
    const int nchunk = NQ / 384, nq = 4 * nchunk;
    const unsigned char* w8 = P_wq8 + (L == 0 ? (size_t)0 : (size_t)3072 * 1024);
    int* xq = (int*)(ws + WS_CTL + CTL_XQ_OFF) + (L * 2 + (rep_ & 1)) * 8 * 64;
    LAS int* slot = (LAS int*)(lds + 140000);
    const int xme = (int)(xb_xcc_id() & 7u);
    unsigned qdone = 0u;
    for (;;) {
        __syncthreads();
        if (tid == 0) {
            int item = -1;
            for (int k = 0; k < 8 && item < 0; ++k) {
                const int xx = (xme + k) & 7;
                if (qdone >> xx & 1u) continue;
                const int q = atomicAdd(&xq[xx * 64], 1);
                if (q < nq) item = (xx + 8 * (q / nchunk)) * nchunk + (q % nchunk); else qdone |= 1u << xx;
            }
            *slot = item;
        }
        __syncthreads();
        const int item = *slot;
        if (item < 0) break;
        const int rt = item / nchunk, ch = item - rt * nchunk;
        qkv8_item<3>(lds, wave, P_xq8 + (size_t)rt * 512 * 1024, w8 + (size_t)ch * 384 * 1024, P_qkv + (size_t)rt * 512 * NQ + ch * 384, NQ);
    }
#else
    const pg8::Gemm g{P_xb, (const u16*)(ws + (L == 0 ? WS_WQK0 : WS_WQK1)), T, NQ, D};
    pg8::StaticOrder S; S.init(g.M, g.N, G, bid);
    const EpiQK E{P_qkv, NQ};
    pg8::gemm_phase<EpiQK, pg8::StaticOrder, false>((PG8_LAS unsigned char*)lds, g, S, E, nullptr, wave_s_ * 64 + lane_id_());
#endif
}

__device__ __forceinline__ void ph_kmean(int L, int rep_, const int wave_s_) {
    PH_FN_BEGIN
    (void)rep_;
    PH_BEGIN;
    LAS float* red = (LAS float*)lds;
    for (int it = bid; it < BATCH * NH * MOBA_NB; it += G) {
        const int j = it & 31, h = (it >> 5) & 15, b = it >> 9;
        const int kg_ = tid >> 3, ch = tid & 7;
        const u16* kp = P_qkv + (size_t)(b * SEQ + j * MOBA_BLK + kg_) * 3072 + 1024 + h * 64 + ch * 8;
        float sm[8];
#pragma unroll
        for (int e2 = 0; e2 < 8; ++e2) sm[e2] = 0.f;
#pragma unroll
        for (int i = 0; i < 4; ++i) {
            const u32x4 v = *(const u32x4*)(kp + (size_t)(64 * i) * 3072);
#pragma unroll
            for (int e2 = 0; e2 < 4; ++e2) { sm[2 * e2] += bf2f(v[e2] & 0xFFFFu); sm[2 * e2 + 1] += bf2f(v[e2] >> 16); }
        }
#pragma unroll
        for (int e2 = 0; e2 < 8; ++e2) red[kg_ * 65 + ch * 8 + e2] = sm[e2];
        __syncthreads();
        if (tid < 64) {
            float tot = 0.f;
#pragma unroll 8
            for (int q = 0; q < 64; ++q) tot += red[q * 65 + tid];
            P_kmean[(size_t)it * 64 + tid] = tot * (1.f / MOBA_BLK);
        }
        __syncthreads();
    }
}

__device__ __forceinline__ void ph_gate(int L, int rep_, const int wave_s_) {
    PH_FN_BEGIN
    (void)rep_;
    PH_BEGIN;
    for (int it = bid; it < BATCH * NH * MOBA_NB; it += G) {
        const int qb = it & 31, bh = it >> 5, b = bh >> 4, h = bh & 15;
        const int tq = qb * MOBA_BLK + wave * 32 + r32;
        const u16* qrow = P_qkv + (size_t)(b * SEQ + tq) * 3072 + h * 64 + hi * 8;
        bf16x8 qf[4];
#pragma unroll
        for (int d0 = 0; d0 < 4; ++d0) qf[d0] = *(const bf16x8*)(qrow + d0 * 16);
        unsigned selmask = 0u;
        if (qb > 0) {
            const float* km = P_kmean + ((size_t)(b * NH + h) * MOBA_NB + r32) * 64 + hi * 8;
            f32x16 gt;
#pragma unroll
            for (int r = 0; r < 16; ++r) gt[r] = 0.f;
#pragma unroll
            for (int d0 = 0; d0 < 4; ++d0) {
                const f32x4 k0 = *(const f32x4*)(km + d0 * 16), k1 = *(const f32x4*)(km + d0 * 16 + 4);
                union { bf16x8 v; unsigned u[4]; } kf;
                kf.u[0] = cvtpk(k0[0], k0[1]); kf.u[1] = cvtpk(k0[2], k0[3]); kf.u[2] = cvtpk(k1[0], k1[1]); kf.u[3] = cvtpk(k1[2], k1[3]);
                gt = MFMA_BF16(kf.v, qf[d0], gt);
            }
            float v0 = -INFINITY, v1 = -INFINITY, v2 = -INFINITY; int i0 = 99, i1 = 99, i2 = 99;
#pragma unroll
            for (int r = 0; r < 16; ++r) { const int jb = crow(r, hi); const float gv = jb < qb ? gt[r] : -INFINITY; top3_insert(gv, jb < qb ? jb : 99, v0, i0, v1, i1, v2, i2); }
            const float ov0 = shxf(v0, 32, lane), ov1 = shxf(v1, 32, lane), ov2 = shxf(v2, 32, lane);
            const int oi0 = shxi(i0, 32, lane), oi1 = shxi(i1, 32, lane), oi2 = shxi(i2, 32, lane);
            top3_insert(ov0, oi0, v0, i0, v1, i1, v2, i2); top3_insert(ov1, oi1, v0, i0, v1, i1, v2, i2); top3_insert(ov2, oi2, v0, i0, v1, i1, v2, i2);
            if (i0 < 32) selmask |= 1u << i0;
            if (i1 < 32) selmask |= 1u << i1;
            if (i2 < 32) selmask |= 1u << i2;
        }
        if (hi == 0) P_selm[(size_t)bh * SEQ + tq] = selmask;
    }
}

constexpr int MB_KP = 72;
constexpr int MB_VP = 260;
constexpr int MB_LDS_K = 0;
constexpr int MB_LDS_V = 256 * MB_KP * 2;
constexpr int MB_LDS_LIST = MB_LDS_V + 64 * MB_VP * 2;
constexpr int MB_LDS_CTR = MB_LDS_LIST + 8192 * 2;
__device__ __forceinline__ void ph_moba(int L, int rep_, const int wave_s_) {
    PH_FN_BEGIN
    (void)rep_;
    PH_BEGIN;
    LAS char* Ks = lds + MB_LDS_K; LAS char* Vs = lds + MB_LDS_V;
    LAS u16* qlist = (LAS u16*)(lds + MB_LDS_LIST); LAS int* ctr = (LAS int*)(lds + MB_LDS_CTR);
    for (int it = bid; it < BATCH * NH * MOBA_NB; it += G) {
        const int rnd = it >> 8, w8 = it & 255, a8 = w8 >> 5, bh = w8 & 31;
        const int j = rnd == 0 ? a8 : (rnd == 1 ? 15 - a8 : (rnd == 2 ? 16 + a8 : 31 - a8));
        const int b = bh >> 4, h = bh & 15;
        const float slope2 = exp2f(-0.5f * (float)(h + 1)) * LOG2E;
        if (tid == 0) { int z0 = 0; asm volatile("" : "+v"(z0)); ctr[0] = z0; ctr[1] = z0; }
        {
            const u16* kg = P_qkv + (size_t)(b * SEQ + j * MOBA_BLK) * 3072 + 1024 + h * 64;
#pragma unroll
            for (int i = 0; i < 4; ++i) { const int c = tid + i * 512, row = c >> 3, ch = c & 7; *(LAS u32x4*)(Ks + (row * MB_KP + ch * 8) * 2) = *(const u32x4*)(kg + (size_t)row * 3072 + ch * 8); }
            const u16* vg = P_qkv + (size_t)(b * SEQ + j * MOBA_BLK) * 3072 + 2048 + h * 64;
#pragma unroll
            for (int i = 0; i < 4; ++i) {
                const int c = tid + i * 512, key = c >> 3, ch = c & 7;
                const u32x4 v = *(const u32x4*)(vg + (size_t)key * 3072 + ch * 8);
#pragma unroll
                for (int e2 = 0; e2 < 4; ++e2) {
                    *(LAS u16*)(Vs + ((ch * 8 + 2 * e2) * MB_VP + key) * 2) = (u16)(v[e2] & 0xFFFFu);
                    *(LAS u16*)(Vs + ((ch * 8 + 2 * e2 + 1) * MB_VP + key) * 2) = (u16)(v[e2] >> 16);
                }
            }
        }
        __syncthreads();
        {
            const unsigned* sm = P_selm + (size_t)bh * SEQ;
            for (int t0 = (j + 1) * MOBA_BLK; t0 < SEQ; t0 += 512) {
                const int t = t0 + tid;
                const bool sel = (t < SEQ) && ((sm[t < SEQ ? t : 0] >> j) & 1u);
                const unsigned long long bal = __ballot(sel);
                const int total = __popcll(bal);
                int wb = 0;
                if (lane == 0 && total) wb = atomicAdd((int*)&ctr[0], total);
                wb = __builtin_amdgcn_readfirstlane(wb);
                if (sel) qlist[wb + __popcll(bal & ((1ull << lane) - 1ull))] = (u16)t;
            }
        }
        __syncthreads();
        const int nq = ctr[0];
        const int ntiles = 8 + ((nq + 31) >> 5);
        for (;;) {
            int ti = 0;
            if (lane == 0) ti = atomicAdd((int*)&ctr[1], 1);
            ti = __builtin_amdgcn_readfirstlane(ti);
            if (ti >= ntiles) break;
            const bool own = ti < 8;
            const int wq = 7 - ti;
            const int li = (ti - 8) * 32 + r32;
            const bool valid = own || li < nq;
            const int tq = own ? j * MOBA_BLK + wq * 32 + r32 : (int)qlist[li < nq ? li : nq - 1];
            const int nsteps = own ? wq + 1 : 8;
            const u16* qrow = P_qkv + (size_t)(b * SEQ + tq) * 3072 + h * 64 + hi * 8;
            bf16x8 qf[4];
#pragma unroll
            for (int d0 = 0; d0 < 4; ++d0) qf[d0] = *(const bf16x8*)(qrow + d0 * 16);
            int slot = 3;
            if (!own) slot = __popc(P_selm[(size_t)bh * SEQ + tq] & ((1u << j) - 1u));
            AttnSt st; st.m = NEGV; st.l = 0.f;
#pragma unroll
            for (int r = 0; r < 16; ++r) { st.o0[r] = 0.f; st.o1[r] = 0.f; }
            const int dlo = own ? 0 : -0x40000000;
            for (int kt = 0; kt < nsteps; ++kt) {
                AttnFr f;
#pragma unroll
                for (int d0 = 0; d0 < 4; ++d0) f.k[d0] = *(LAS bf16x8*)(Ks + ((kt * 32 + r32) * MB_KP + d0 * 16 + hi * 8) * 2);
#pragma unroll
                for (int q4 = 0; q4 < 4; ++q4) {
                    union { bf16x8 v; u32x2 hh[2]; } va;
                    LAS char* vp = Vs + (((q4 >> 1) * 32 + r32) * MB_VP + kt * 32 + (q4 & 1) * 16 + 4 * hi) * 2;
                    va.hh[0] = *(LAS u32x2*)(vp); va.hh[1] = *(LAS u32x2*)(vp + 16);
                    f.v[q4] = va.v;
                }
                attn_compute(st, qf, f, tq - (j * MOBA_BLK + kt * 32) - 4 * hi, slope2, dlo, 0x7fffffff, hi, lane);
            }
            const float lt = st.l + shxf(st.l, 32, lane);
            const float inv = 1.f / lt;
            if (valid) {
                const size_t pi = ((size_t)(b * SEQ + tq) * NH + h) * 4 + slot;
                u16* orow = P_part + pi * 64;
#pragma unroll
                for (int rq = 0; rq < 4; ++rq) {
                    u32x2 w; w[0] = cvtpk(st.o0[4 * rq] * inv, st.o0[4 * rq + 1] * inv); w[1] = cvtpk(st.o0[4 * rq + 2] * inv, st.o0[4 * rq + 3] * inv);
                    *(u32x2*)(orow + 8 * rq + 4 * hi) = w;
                    w[0] = cvtpk(st.o1[4 * rq] * inv, st.o1[4 * rq + 1] * inv); w[1] = cvtpk(st.o1[4 * rq + 2] * inv, st.o1[4 * rq + 3] * inv);
                    *(u32x2*)(orow + 32 + 8 * rq + 4 * hi) = w;
                }
                if (hi == 0) P_plse[pi] = st.m * LN2 + logf(lt);
            }
        }
        __syncthreads();
    }
}

__device__ __forceinline__ void ph_mobamerge(int L, int rep_, const int wave_s_) {
    PH_FN_BEGIN
    (void)rep_;
    PH_BEGIN;
    for (size_t i = (size_t)bid * NTHR + tid; i < (size_t)T * NH * 8; i += (size_t)G * NTHR) {
        const size_t row = i >> 7; const int h = (int)(i >> 3) & 15, d8 = (int)i & 7;
        const int qb = (int)(row & (SEQ - 1)) >> 8;
        const int nsel = qb < 3 ? qb : 3;
        const size_t pi = (row * NH + h) * 4;
        float l[4], w[4];
        float mx = -INFINITY;
#pragma unroll
        for (int sidx = 0; sidx < 4; ++sidx) { const bool ok = sidx == 3 || sidx < nsel; l[sidx] = ok ? P_plse[pi + sidx] : -INFINITY; mx = fmaxf(mx, l[sidx]); }
        float ws_ = 0.f;
#pragma unroll
        for (int sidx = 0; sidx < 4; ++sidx) { w[sidx] = (sidx == 3 || sidx < nsel) ? expf(l[sidx] - mx) : 0.f; ws_ += w[sidx]; }
        const float inv = 1.f / ws_;
        float acc8[8];
#pragma unroll
        for (int c = 0; c < 8; ++c) acc8[c] = 0.f;
#pragma unroll
        for (int sidx = 0; sidx < 4; ++sidx) {
            if (sidx == 3 || sidx < nsel) {
                const u32x4 a = *(const u32x4*)(P_part + (pi + sidx) * 64 + d8 * 8);
                const float ww = w[sidx] * inv;
#pragma unroll
                for (int c = 0; c < 4; ++c) { acc8[2 * c] += ww * bf2f(a[c] & 0xFFFFu); acc8[2 * c + 1] += ww * bf2f(a[c] >> 16); }
            }
        }
        u32x4 o;
#pragma unroll
        for (int c = 0; c < 4; ++c) o[c] = cvtpk(acc8[2 * c], acc8[2 * c + 1]);
        *(u32x4*)(P_ao + row * D + h * 64 + d8 * 8) = o;
    }
}

constexpr int DL_KP = 72, DL_VP = 388;
constexpr int DL_LDS_K = 0, DL_LDS_V = 384 * DL_KP * 2;
__device__ __forceinline__ void ph_dil(int L, int rep_, const int wave_s_) {
    PH_FN_BEGIN
    (void)rep_;
    PH_BEGIN;
    LAS char* Ks = lds + DL_LDS_K; LAS char* Vs = lds + DL_LDS_V;
    for (int it = bid; it < BATCH * NH * 3 * 32; it += G) {
        const int ch = it & 31, grp = (it >> 5) % 3, bh = it / 96, b = bh >> 4, h = bh & 15;
        const int dil = grp == 0 ? 1 : (grp == 1 ? 4 : 16), Ls = SEQ / dil;
        const float slope2 = exp2f(-0.5f * (float)(h + 1)) * LOG2E * (float)dil;
        const int uc = ch * 256, res = uc / Ls, c0 = uc - res * Ls;
        const int kb0 = c0 - 128;
        {
            const u16* kg = P_qkv + (size_t)(b * SEQ) * 9216 + grp * 3072 + 1024 + h * 64;
#pragma unroll
            for (int i = 0; i < 6; ++i) {
                const int c = tid + i * 512, row = c >> 3, chk = c & 7, ks = kb0 + row;
                if (ks >= 0) *(LAS u32x4*)(Ks + (row * DL_KP + chk * 8) * 2) = *(const u32x4*)(kg + (size_t)(ks * dil + res) * 9216 + chk * 8);
            }
            const u16* vg = P_qkv + (size_t)(b * SEQ) * 9216 + grp * 3072 + 2048 + h * 64;
#pragma unroll
            for (int i = 0; i < 6; ++i) {
                const int c = tid + i * 512, row = c >> 3, chk = c & 7, ks = kb0 + row;
                if (ks >= 0) {
                    const u32x4 v = *(const u32x4*)(vg + (size_t)(ks * dil + res) * 9216 + chk * 8);
#pragma unroll
                    for (int e2 = 0; e2 < 4; ++e2) {
                        *(LAS u16*)(Vs + ((chk * 8 + 2 * e2) * DL_VP + row) * 2) = (u16)(v[e2] & 0xFFFFu);
                        *(LAS u16*)(Vs + ((chk * 8 + 2 * e2 + 1) * DL_VP + row) * 2) = (u16)(v[e2] >> 16);
                    }
                }
            }
        }
        const int i0 = c0 + wave * 32, iq = i0 + r32, pq = iq * dil + res;
        const u16* qrow = P_qkv + (size_t)(b * SEQ + pq) * 9216 + grp * 3072 + h * 64 + hi * 8;
        bf16x8 qf[4];
#pragma unroll
        for (int d0 = 0; d0 < 4; ++d0) qf[d0] = *(const bf16x8*)(qrow + d0 * 16);
        __syncthreads();
        AttnSt st; st.m = NEGV; st.l = 0.f;
#pragma unroll
        for (int r = 0; r < 16; ++r) { st.o0[r] = 0.f; st.o1[r] = 0.f; }
        const int ktmin = (i0 >= 128) ? 0 : (128 - i0) >> 5;
        for (int kt = 4; kt >= ktmin; --kt) {
            const int lrow0 = (wave + kt) * 32;
            AttnFr f;
#pragma unroll
            for (int d0 = 0; d0 < 4; ++d0) f.k[d0] = *(LAS bf16x8*)(Ks + ((lrow0 + r32) * DL_KP + d0 * 16 + hi * 8) * 2);
#pragma unroll
            for (int q4 = 0; q4 < 4; ++q4) {
                union { bf16x8 v; u32x2 hh[2]; } va;
                LAS char* vp = Vs + (((q4 >> 1) * 32 + r32) * DL_VP + lrow0 + (q4 & 1) * 16 + 4 * hi) * 2;
                va.hh[0] = *(LAS u32x2*)(vp); va.hh[1] = *(LAS u32x2*)(vp + 16);
                f.v[q4] = va.v;
            }
            const int k0 = i0 - 128 + kt * 32;
            attn_compute(st, qf, f, iq - k0 - 4 * hi, slope2, 0, 128, hi, lane);
        }
        const float lt = st.l + shxf(st.l, 32, lane);
        const float inv = 1.f / lt;
        u16* orow = P_og + (size_t)grp * T * D + (size_t)(b * SEQ + pq) * D + h * 64;
#pragma unroll
        for (int rq = 0; rq < 4; ++rq) {
            u32x2 w; w[0] = cvtpk(st.o0[4 * rq] * inv, st.o0[4 * rq + 1] * inv); w[1] = cvtpk(st.o0[4 * rq + 2] * inv, st.o0[4 * rq + 3] * inv);
            *(u32x2*)(orow + 8 * rq + 4 * hi) = w;
            w[0] = cvtpk(st.o1[4 * rq] * inv, st.o1[4 * rq + 1] * inv); w[1] = cvtpk(st.o1[4 * rq + 2] * inv, st.o1[4 * rq + 3] * inv);
            *(u32x2*)(orow + 32 + 8 * rq + 4 * hi) = w;
        }
        if (hi == 0) P_lse[((size_t)grp * T + (b * SEQ + pq)) * NH + h] = st.m * LN2 + logf(lt);
        __syncthreads();
    }
}

__device__ __forceinline__ void ph_merge(int L, int rep_, const int wave_s_) {
    PH_FN_BEGIN
    (void)rep_;

            PH_BEGIN;
                for (size_t i = (size_t)bid * NTHR + tid; i < (size_t)T * NH * 8; i += (size_t)G * NTHR) {
                    const size_t row = i >> 7; const int h = (int)(i >> 3) & 15, d8 = (int)i & 7;
                    const float l0 = P_lse[(0 * (size_t)T + row) * NH + h], l1 = P_lse[(1 * (size_t)T + row) * NH + h], l2 = P_lse[(2 * (size_t)T + row) * NH + h];
                    const float mx = fmaxf(l0, fmaxf(l1, l2));
                    float w0 = expf(l0 - mx), w1 = expf(l1 - mx), w2 = expf(l2 - mx);
                    const float inv = 1.f / (w0 + w1 + w2); w0 *= inv; w1 *= inv; w2 *= inv;
                    const size_t off = row * D + h * 64 + d8 * 8;
                    const u32x4 a0 = *(const u32x4*)(P_og + off), a1 = *(const u32x4*)(P_og + (size_t)T * D + off), a2 = *(const u32x4*)(P_og + 2 * (size_t)T * D + off);
                    u32x4 o;
#pragma unroll
                    for (int c = 0; c < 4; ++c) {
                        const float lo_ = w0 * bf2f(a0[c] & 0xFFFFu) + w1 * bf2f(a1[c] & 0xFFFFu) + w2 * bf2f(a2[c] & 0xFFFFu);
                        const float hi_ = w0 * bf2f(a0[c] >> 16) + w1 * bf2f(a1[c] >> 16) + w2 * bf2f(a2[c] >> 16);
                        o[c] = cvtpk(lo_, hi_);
                    }
                    *(u32x4*)(P_ao + off) = o;
                }

}

__device__ __forceinline__ void ph_wo(int L, int rep_, const int wave_s_) {
    PH_FN_BEGIN
    (void)rep_;
    const pg8::Gemm g{P_ao, (const u16*)(ws + WS_WO) + (size_t)L * D * D, T, D, D};
    pg8::StaticOrder S; S.init(g.M, g.N, G, bid);
    const EpiWo E{P_ypre, P_xb};
    pg8::gemm_phase<EpiWo, pg8::StaticOrder, false>((PG8_LAS unsigned char*)lds, g, S, E, nullptr, wave_s_ * 64 + lane_id_());
}

constexpr int RT_P = 144;
constexpr int RT_ASTAGE = 2 * 64 * 144;
constexpr int RT_LDS_AH = 0, RT_LDS_AL = 64 * RT_P;
constexpr int RT_LDS_BH = 2 * 64 * RT_P, RT_LDS_BL = RT_LDS_BH + 256 * RT_P;
constexpr int RT_LDS_ST = RT_LDS_BL + 256 * RT_P;
__device__ __forceinline__ void ph_router(int L, int rep_, const int wave_s_) {
    PH_FN_BEGIN
    (void)rep_;
    PH_BEGIN;
    const float* lng = CTX_IN(4) + L * D; const float* lnb = CTX_IN(5) + L * D;
    const float* rbias = CTX_IN(7) + L * NE;
    const u16* wrh = (const u16*)(ws + WS_WRH) + (size_t)L * NE * D; const u16* wrl = (const u16*)(ws + WS_WRL) + (size_t)L * NE * D;
    LAS float* stat = (LAS float*)(lds + RT_LDS_ST);
    for (int it = bid; it < T / 64; it += G) {
#pragma unroll 1
        for (int hb_ = 0; hb_ < 2; ++hb_) {
            u32x4 yv[4][2];
#pragma unroll
            for (int rr = 0; rr < 4; ++rr)
#pragma unroll
                for (int j = 0; j < 2; ++j) yv[rr][j] = *(const u32x4*)(P_ypre + ((size_t)it * 64 + wave * 8 + hb_ * 4 + rr) * D + j * 512 + lane * 8);
#pragma unroll
            for (int rr = 0; rr < 4; ++rr) {
                float sm = 0.f;
#pragma unroll
                for (int j = 0; j < 2; ++j)
#pragma unroll
                    for (int c = 0; c < 4; ++c) sm += bf2f(yv[rr][j][c] & 0xFFFFu) + bf2f(yv[rr][j][c] >> 16);
                const float mu = wave_sum(sm) * (1.f / D);
                float q = 0.f;
#pragma unroll
                for (int j = 0; j < 2; ++j)
#pragma unroll
                    for (int c = 0; c < 4; ++c) { const float d0_ = bf2f(yv[rr][j][c] & 0xFFFFu) - mu, d1_ = bf2f(yv[rr][j][c] >> 16) - mu; q += d0_ * d0_ + d1_ * d1_; }
                const float rstd = rsqrtf(wave_sum(q) * (1.f / D) + LN_EPS);
                if (lane == 0) { stat[wave * 8 + hb_ * 4 + rr] = mu; stat[64 + wave * 8 + hb_ * 4 + rr] = rstd; }
            }
        }
        __syncthreads();
        const int arow = tid >> 3, aq = tid & 7;
        const float amu = stat[arow], ars = stat[64 + arow];
        const u16* yp = P_ypre + ((size_t)it * 64 + arow) * D + aq * 8;
        u32x4 ya = *(const u32x4*)(yp);
        u32x4 bw[8], bx[8];
        const u16* wfh = wrh + (size_t)wave * 16 * 4 * 64 * 8 + lane * 8; const u16* wfl = wrl + (size_t)wave * 16 * 4 * 64 * 8 + lane * 8;
#define RT_LOADB(BW, KC_) { _Pragma("unroll") for (int sk = 0; sk < 4; ++sk) { BW[sk] = *(const u32x4*)(wfh + ((KC_) * 4 + sk) * 512); BW[4 + sk] = *(const u32x4*)(wfl + ((KC_) * 4 + sk) * 512); } }
        RT_LOADB(bw, 0)
        RT_LOADB(bx, 1)
        f32x16 lg[2];
#pragma unroll
        for (int r = 0; r < 16; ++r) { lg[0][r] = 0.f; lg[1][r] = 0.f; }
#define RT_WRITEA(KC_) { const int k0 = (KC_) * 64; \
            const f32x4 g0 = *(const f32x4*)(lng + k0 + aq * 8), g1 = *(const f32x4*)(lng + k0 + aq * 8 + 4); \
            const f32x4 b0 = *(const f32x4*)(lnb + k0 + aq * 8), b1 = *(const f32x4*)(lnb + k0 + aq * 8 + 4); \
            f32x4 x0, x1v; \
            _Pragma("unroll") for (int c = 0; c < 4; ++c) { const float y0_ = bf2f(c & 1 ? ya[c >> 1] >> 16 : ya[c >> 1] & 0xFFFFu), y1_ = bf2f(c & 1 ? ya[2 + (c >> 1)] >> 16 : ya[2 + (c >> 1)] & 0xFFFFu); \
                x0[c] = (y0_ - amu) * ars * g0[c] + b0[c]; x1v[c] = (y1_ - amu) * ars * g1[c] + b1[c]; } \
            ya = *(const u32x4*)(yp + (((KC_) + 1 < 16) ? k0 + 64 : 0)); \
            const size_t go = ((size_t)it * 64 + arow) * D + k0 + aq * 8; \
            u32x4 wh; wh[0] = cvtpk(x0[0], x0[1]); wh[1] = cvtpk(x0[2], x0[3]); wh[2] = cvtpk(x1v[0], x1v[1]); wh[3] = cvtpk(x1v[2], x1v[3]); \
            *(u32x4*)(P_xb + go) = wh; \
            u32x2 w8; w8[0] = pack_fp8x4(x0[0], x0[1], x0[2], x0[3]); w8[1] = pack_fp8x4(x1v[0], x1v[1], x1v[2], x1v[3]); \
            *(u32x2*)(P_xb8 + go) = w8; \
            u32x4 wl; \
            wl[0] = cvtpk(x0[0] - bf2f(wh[0] & 0xFFFFu), x0[1] - bf2f(wh[0] >> 16)); wl[1] = cvtpk(x0[2] - bf2f(wh[1] & 0xFFFFu), x0[3] - bf2f(wh[1] >> 16)); \
            wl[2] = cvtpk(x1v[0] - bf2f(wh[2] & 0xFFFFu), x1v[1] - bf2f(wh[2] >> 16)); wl[3] = cvtpk(x1v[2] - bf2f(wh[3] & 0xFFFFu), x1v[3] - bf2f(wh[3] >> 16)); \
            *(LAS u32x4*)(lds + ((KC_) & 1) * RT_ASTAGE + RT_LDS_AH + arow * RT_P + aq * 16) = wh; \
            *(LAS u32x4*)(lds + ((KC_) & 1) * RT_ASTAGE + RT_LDS_AL + arow * RT_P + aq * 16) = wl; }
#define RT_CHUNK(KC_, BW) { __syncthreads(); \
            _Pragma("unroll") for (int sk = 0; sk < 4; ++sk) { \
                const int ko = (sk * 16 + hi * 8) * 2; \
                const bf16x8 bh_ = __builtin_bit_cast(bf16x8, BW[sk]), bl_ = __builtin_bit_cast(bf16x8, BW[4 + sk]); \
                _Pragma("unroll") for (int rb = 0; rb < 2; ++rb) { \
                    const bf16x8 xh = *(const LAS bf16x8*)(lds + ((KC_) & 1) * RT_ASTAGE + RT_LDS_AH + (rb * 32 + r32) * RT_P + ko), xl = *(const LAS bf16x8*)(lds + ((KC_) & 1) * RT_ASTAGE + RT_LDS_AL + (rb * 32 + r32) * RT_P + ko); \
                    lg[rb] = MFMA_BF16(xh, bh_, lg[rb]); lg[rb] = MFMA_BF16(xl, bh_, lg[rb]); lg[rb] = MFMA_BF16(xh, bl_, lg[rb]); \
                } \
            } \
            if ((KC_) + 1 < 16) RT_WRITEA((KC_) + 1) \
            { const int kn_ = ((KC_) + 2 < 16) ? (KC_) + 2 : ((KC_) & 1); RT_LOADB(BW, kn_) } }
        RT_WRITEA(0)
#pragma unroll 1
        for (int kc = 0; kc < 16; kc += 2) {
            RT_CHUNK(kc, bw)
            RT_CHUNK(kc + 1, bx)
        }
#undef RT_CHUNK
#undef RT_WRITEA
#undef RT_LOADB
        __syncthreads();
        LAS float* lgs = (LAS float*)lds;
#pragma unroll
        for (int rb = 0; rb < 2; ++rb)
#pragma unroll
            for (int r = 0; r < 16; ++r) lgs[(rb * 32 + crow(r, hi)) * 257 + wave * 32 + r32] = lg[rb][r];
        __syncthreads();
#pragma unroll 1
        for (int tg = 0; tg < 2; ++tg) {
            float sc[4][4], cv[4][4];
#pragma unroll
            for (int tt = 0; tt < 4; ++tt) {
                const int lr = wave * 8 + tg * 4 + tt;
#pragma unroll
                for (int j = 0; j < 4; ++j) { const int e = lane + 64 * j; sc[tt][j] = 1.f / (1.f + __expf(-lgs[lr * 257 + e])); cv[tt][j] = sc[tt][j] + rbias[e]; }
            }
            float gsel[4][8];
#pragma unroll
            for (int j = 0; j < 4; ++j) {
#pragma unroll
                for (int tt = 0; tt < 4; ++tt) {
                    const float rm = dpp_rowmax(cv[tt][j]);
                    const float m1a = fmaxf(rl_f(rm, 0), rl_f(rm, 16)), m1b = fmaxf(rl_f(rm, 32), rl_f(rm, 48));
                    const unsigned long long bal = __ballot(cv[tt][j] == (hi ? m1b : m1a));
                    const int fa_ = __builtin_ctz((unsigned)(bal & 0xFFFFFFFFull)), fb_ = 32 + __builtin_ctz((unsigned)(bal >> 32));
                    const float c2 = (lane == fa_ || lane == fb_) ? -INFINITY : cv[tt][j];
                    const float rm2 = dpp_rowmax(c2);
                    gsel[tt][2 * j] = m1a + fmaxf(rl_f(rm2, 0), rl_f(rm2, 16));
                    gsel[tt][2 * j + 1] = m1b + fmaxf(rl_f(rm2, 32), rl_f(rm2, 48));
                }
            }
#pragma unroll
            for (int tt = 0; tt < 4; ++tt)
#pragma unroll
                for (int j = 0; j < 4; ++j) {
                    int ra_ = 0, rb_ = 0;
#pragma unroll
                    for (int g2 = 0; g2 < 8; ++g2) {
                        ra_ += ((gsel[tt][g2] > gsel[tt][2 * j]) || (gsel[tt][g2] == gsel[tt][2 * j] && g2 < 2 * j)) ? 1 : 0;
                        rb_ += ((gsel[tt][g2] > gsel[tt][2 * j + 1]) || (gsel[tt][g2] == gsel[tt][2 * j + 1] && g2 < 2 * j + 1)) ? 1 : 0;
                    }
                    cv[tt][j] = ((hi ? rb_ : ra_) < 4) ? cv[tt][j] : NEGV;
                }
            float wsel[4], wsum[4]; int esel[4];
#pragma unroll
            for (int tt = 0; tt < 4; ++tt) { wsel[tt] = 0.f; wsum[tt] = 0.f; esel[tt] = 0; }
#pragma unroll 1
            for (int k = 0; k < TOPK; ++k) {
#pragma unroll
                for (int tt = 0; tt < 4; ++tt) {
                    float bv = cv[tt][0]; int be = lane;
#pragma unroll
                    for (int j = 1; j < 4; ++j) if (cv[tt][j] > bv) { bv = cv[tt][j]; be = lane + 64 * j; }
                    const float rm = dpp_rowmax(bv);
                    const float mval = fmaxf(fmaxf(rl_f(rm, 0), rl_f(rm, 16)), fmaxf(rl_f(rm, 32), rl_f(rm, 48)));
                    const int ri = dpp_rowmin_i(bv == mval ? be : 0x7fffffff);
                    const int e = min(min(__builtin_amdgcn_readlane(ri, 0), __builtin_amdgcn_readlane(ri, 16)), min(__builtin_amdgcn_readlane(ri, 32), __builtin_amdgcn_readlane(ri, 48)));
                    const int jl = e >> 6, ll = e & 63;
                    const float smine = ((jl == 0 ? sc[tt][0] : 0.f) + (jl == 1 ? sc[tt][1] : 0.f)) + ((jl == 2 ? sc[tt][2] : 0.f) + (jl == 3 ? sc[tt][3] : 0.f));
                    const float sw = rl_f(smine, ll);
#pragma unroll
                    for (int j = 0; j < 4; ++j) cv[tt][j] = (lane == ll && jl == j) ? -INFINITY : cv[tt][j];
                    wsum[tt] += sw;
                    if (lane == k) { wsel[tt] = sw; esel[tt] = e; }
                }
            }
#pragma unroll
            for (int tt = 0; tt < 4; ++tt) {
                if (lane < TOPK) {
                    const int tok = it * 64 + wave * 8 + tg * 4 + tt;
                    const int a = tok * TOPK + lane;
                    P_topw[a] = wsel[tt] / wsum[tt] * 2.5f;
                    if (rep_ == 0) {
                        const int pos = atomicAdd(&cnt[esel[tt] * CNT_STRIDE], 1);
                        P_list[(size_t)esel[tt] * T + pos] = a;
                    }
                }
            }
        }
        __syncthreads();
    }
}

__device__ __forceinline__ void ph_gateup(int L, int rep_, const int wave_s_) {
    PH_FN_BEGIN
    (void)rep_;
    {
        PH_BEGIN;
        const float* weg = CTX_IN(8) + (size_t)L * NE * D * DF; const float* weu = CTX_IN(9) + (size_t)L * NE * D * DF;
        LAS int* rowva = (LAS int*)(lds + MOE_LDS_VA);
        {
            int* octr = (int*)(ws + WS_CTL + CTL_CNT_OFF + 8192) + (L * 4 + 2 * (rep_ & 1)) * 64;
            LAS int* slot = (LAS int*)(lds + 140000);
            for (;;) {
                __syncthreads();
                if (tid == 0) { int q; do { q = atomicAdd(octr, 1); } while (q >= NE && q < NE * 5 && cnt[((q - NE) >> 2) * CNT_STRIDE] <= MOE_XCAP); *slot = q; }
                __syncthreads();
                const int q = *slot;
                if (q >= NE * 5) break;
                const bool ovf = q >= NE;
                const int e = ovf ? (q - NE) >> 2 : q, pz = ovf ? (q - NE) & 3 : 0, npz = ovf ? 1 : 4, st0 = ovf ? 1 : 0, n = cnt[e * CNT_STRIDE];
                for (int r0 = 0; r0 < n; r0 += 1024) {
                    if (ovf && n - r0 <= MOE_XCAP) break;
#pragma unroll
                    for (int i = 0; i < 2; ++i) { int t_ = tid; asm volatile("" : "+v"(t_)); const int idx = r0 + i * 512 + t_; rowva[i * 512 + t_] = idx < n ? P_list[(size_t)e * T + idx] : TRASH_VA; }
                    __syncthreads();
                    moe_expert<false>(lds, tid, lane, wave, r32, hi, P_xb8, weg + (size_t)e * D * DF, weu + (size_t)e * D * DF, (n - r0) < 1024 ? (n - r0) : 1024, (void*)P_hb, pz, npz, st0, 1, false, !ovf && (n - r0) > 512 && (n - r0) <= MOE_XCAP);
                }
            }
        }
    }
    {
        PH_BEGIN;
        const pg8::Gemm g{P_xb, (const u16*)(ws + WS_WSGU) + (size_t)L * 512 * 1024, T, 512, D};
        const EpiSGU E{P_hbs};
        int* qctr = (int*)(ws + WS_CTL + CTL_CNT_OFF + 4096) + (L * 4 + 2 * (rep_ & 1)) * 64;
        LAS int* slot = (LAS int*)(lds + 140000);
        for (;;) {
            __syncthreads();
            if (tid == 0) *slot = atomicAdd(qctr, 1);
            __syncthreads();
            const int un = *slot;
            if (un >= 128) break;
            const pg8::FixedOrder S{un & 63, un >> 6};
            pg8::gemm_phase<EpiSGU, pg8::FixedOrder, false>((PG8_LAS unsigned char*)lds, g, S, E, nullptr, wave_s_ * 64 + lane_id_());
        }
    }
}

__device__ __forceinline__ void ph_down(int L, int rep_, const int wave_s_) {
    PH_FN_BEGIN
    (void)rep_;
    {
        PH_BEGIN;
        const float* wed = CTX_IN(10) + (size_t)L * NE * DF * D;
        LAS int* rowva = (LAS int*)(lds + MOE_LDS_VA); LAS float* roww = (LAS float*)(lds + MOE_LDS_W);
        {
            int* octr = (int*)(ws + WS_CTL + CTL_CNT_OFF + 8192) + (L * 4 + 1 + 2 * (rep_ & 1)) * 64;
            LAS int* slot = (LAS int*)(lds + 140000);
            for (;;) {
                __syncthreads();
                if (tid == 0) { int q; do { q = atomicAdd(octr, 1); } while (q >= NE && q < NE * 5 && cnt[((q - NE) >> 2) * CNT_STRIDE] <= 512); *slot = q; }
                __syncthreads();
                const int q = *slot;
                if (q >= NE * 5) break;
                const bool ovf = q >= NE;
                const int e = ovf ? (q - NE) >> 2 : q, pz = ovf ? ((q - NE) & 3) * 2 : 0, npz = ovf ? 2 : 8, st0 = ovf ? 1 : 0, n = cnt[e * CNT_STRIDE];
                for (int r0 = 0; r0 < n; r0 += 1024) {
                    if (ovf && n - r0 <= 512) break;
#pragma unroll
                    for (int i = 0; i < 2; ++i) { int t_ = tid; asm volatile("" : "+v"(t_)); const int idx = r0 + i * 512 + t_; const int va = idx < n ? P_list[(size_t)e * T + idx] : TRASH_VA; rowva[i * 512 + t_] = va; roww[i * 512 + t_] = va < A_TOT ? P_topw[va] * Y8_SCALE : 0.f; }
                    __syncthreads();
                    moe_expert<true>(lds, tid, lane, wave, r32, hi, (const unsigned char*)P_hb, wed + (size_t)e * DF * D, nullptr, (n - r0) < 1024 ? (n - r0) : 1024, (void*)P_yb, pz, npz, st0, 1, true);
                }
            }
        }
    }
    {
        PH_BEGIN;
        const pg8::Gemm g{P_hbs, (const u16*)(ws + WS_WSD) + (size_t)L * D * DF, T, D, DF};
        const EpiSD E{P_yb};
        int* qctr = (int*)(ws + WS_CTL + CTL_CNT_OFF + 4096) + (L * 4 + 1 + 2 * (rep_ & 1)) * 64;
        LAS int* slot = (LAS int*)(lds + 140000);
        for (;;) {
            __syncthreads();
            if (tid == 0) *slot = atomicAdd(qctr, 1);
            __syncthreads();
            const int un = *slot;
            if (un >= 256) break;
            const pg8::FixedOrder S{un & 63, un >> 6};
            pg8::gemm_phase<EpiSD, pg8::FixedOrder, false>((PG8_LAS unsigned char*)lds, g, S, E, nullptr, wave_s_ * 64 + lane_id_());
        }
    }
}

__device__ __forceinline__ void ph_combine(int L, int rep_, const int wave_s_) {
    PH_FN_BEGIN
    (void)rep_;
    PH_BEGIN;
    const float* lng = CTX_IN(14) + L * D; const float* lnb = CTX_IN(15) + L * D;
    float* dst = AS_GLOBAL(float, ctx_ld(16));
    for (int row = bid * 8 + wave; row < T; row += G * 8) {
        u32x4 yv[TOPK + 1][2];
#pragma unroll
        for (int k = 0; k < TOPK + 1; ++k) {
            const size_t va = k < TOPK ? (size_t)row * TOPK + k : (size_t)A_TOT + row;
            if (k < TOPK) {
#pragma unroll
                for (int j = 0; j < 2; ++j) { const u32x2 w8 = *(const u32x2*)((const unsigned char*)P_yb + va * D + j * 512 + lane * 8); yv[k][j][0] = w8[0]; yv[k][j][1] = w8[1]; yv[k][j][2] = 0u; yv[k][j][3] = 0u; }
            } else {
#pragma unroll
                for (int j = 0; j < 2; ++j) yv[k][j] = *(const u32x4*)(P_yb + va * D + j * 512 + lane * 8);
            }
        }
        float v[16];
#pragma unroll
        for (int j = 0; j < 2; ++j) {
            const u32x4 t = *(const u32x4*)(P_xb + (size_t)row * D + j * 512 + lane * 8);
#pragma unroll
            for (int c = 0; c < 4; ++c) { v[j * 8 + 2 * c] = DN_ALPHA * bf2f(t[c] & 0xFFFFu); v[j * 8 + 2 * c + 1] = DN_ALPHA * bf2f(t[c] >> 16); }
        }
#pragma unroll
        for (int k = 0; k < TOPK + 1; ++k)
#pragma unroll
            for (int j = 0; j < 2; ++j) {
                if (k < TOPK) {
#pragma unroll
                    for (int c = 0; c < 2; ++c) {
                        const f32x2_ lo2 = __builtin_amdgcn_cvt_pk_f32_fp8((int)yv[k][j][c], false), hi2 = __builtin_amdgcn_cvt_pk_f32_fp8((int)yv[k][j][c], true);
                        v[j * 8 + 4 * c] += lo2[0] * (1.f / Y8_SCALE); v[j * 8 + 4 * c + 1] += lo2[1] * (1.f / Y8_SCALE); v[j * 8 + 4 * c + 2] += hi2[0] * (1.f / Y8_SCALE); v[j * 8 + 4 * c + 3] += hi2[1] * (1.f / Y8_SCALE);
                    }
                } else {
#pragma unroll
                    for (int c = 0; c < 4; ++c) { v[j * 8 + 2 * c] += bf2f(yv[k][j][c] & 0xFFFFu); v[j * 8 + 2 * c + 1] += bf2f(yv[k][j][c] >> 16); }
                }
            }
        float sm = 0.f;
#pragma unroll
        for (int i = 0; i < 16; ++i) sm += v[i];
        const float mu = wave_sum(sm) * (1.f / D);
        float q = 0.f;
#pragma unroll
        for (int i = 0; i < 16; ++i) { const float d = v[i] - mu; q += d * d; }
        const float rstd = rsqrtf(wave_sum(q) * (1.f / D) + LN_EPS);
#pragma unroll
        for (int j = 0; j < 2; ++j) {
            const f32x4 g0 = *(const f32x4*)(lng + j * 512 + lane * 8), g1 = *(const f32x4*)(lng + j * 512 + lane * 8 + 4);
            const f32x4 b0 = *(const f32x4*)(lnb + j * 512 + lane * 8), b1 = *(const f32x4*)(lnb + j * 512 + lane * 8 + 4);
            f32x4 o0, o1;
#pragma unroll
            for (int c = 0; c < 4; ++c) { o0[c] = (v[j * 8 + c] - mu) * rstd * g0[c] + b0[c]; o1[c] = (v[j * 8 + 4 + c] - mu) * rstd * g1[c] + b1[c]; }
            if (L == 1) { *(f32x4*)(dst + (size_t)row * D + j * 512 + lane * 8) = o0; *(f32x4*)(dst + (size_t)row * D + j * 512 + lane * 8 + 4) = o1; }
            if (L == 0) { u32x4 w; w[0] = cvtpk(o0[0], o0[1]); w[1] = cvtpk(o0[2], o0[3]); w[2] = cvtpk(o1[0], o1[1]); w[3] = cvtpk(o1[2], o1[3]); *(u32x4*)(P_xb + (size_t)row * D + j * 512 + lane * 8) = w;
                if (QKV_FP8) { u32x2 w8; w8[0] = pack_fp8x4(o0[0], o0[1], o0[2], o0[3]); w8[1] = pack_fp8x4(o1[0], o1[1], o1[2], o1[3]); *(u32x2*)(P_xq8 + (size_t)row * D + j * 512 + lane * 8) = w8; } }
        }
    }
}

__global__ void __launch_bounds__(NTHR, 2) fwd(Args args) {
    extern __shared__ __attribute__((aligned(16))) unsigned char lds_raw[];
    LAS char* lds = (LAS char*)lds_raw;
    unsigned char* const ws = args.ws;
    const int lo = args.ph_lo, hi_ph = args.ph_hi;
    const int wave_s_ = __builtin_amdgcn_readfirstlane(threadIdx.x >> 6);
    if (threadIdx.x < 18) {
        const uint64_t v = threadIdx.x < 16 ? (uint64_t)args.in[threadIdx.x] : (threadIdx.x == 16 ? (uint64_t)args.out : (uint64_t)args.ws);
        ((LAS uint64_t*)(lds + LDS_CTX))[threadIdx.x] = v;
    }
    __syncthreads();
#define IN(k) (lo <= (k) && (k) < hi_ph)

#if MK_ONE_LAUNCH
    if (threadIdx.x < 4) ((LAS unsigned*)(lds + LDS_BAR))[threadIdx.x] = 0u;
    __syncthreads();
    XcdBarrier bar = xcd_barrier_post((unsigned*)(ws + WS_CTL), (volatile LAS unsigned*)(lds + LDS_BAR), wave_s_ == 0 && lane_id_() == 0);
#define GRID_BAR() xcd_barrier(bar, wave_s_ == 0 && lane_id_() == 0)
#else
#define GRID_BAR() do { } while (0)
#endif
#define SEAM(k) do { if (IN(k) && IN((k) + 1)) GRID_BAR(); } while (0)

    for (int rep_ = 0; rep_ < ((IN(0) && PHK(0)) ? REPS(0) : 0); ++rep_) { ph_p0(0, rep_, wave_s_); }
    SEAM(0);

    for (int L = 0; L < 2; ++L) {
        const int pb = 1 + 10 * L;
        for (int rep_ = 0; rep_ < ((IN(pb + 0) && PHK(1)) ? REPS(1) : 0); ++rep_) { ph_qkv(L, rep_, wave_s_); }
        SEAM(pb + 0);

        if (L == 0) {
            for (int rep_ = 0; rep_ < ((IN(pb + 1) && PHK(2)) ? REPS(2) : 0); ++rep_) { ph_kmean(L, rep_, wave_s_); }
            SEAM(pb + 1);
            for (int rep_ = 0; rep_ < ((IN(pb + 2) && PHK(11)) ? REPS(11) : 0); ++rep_) { ph_gate(L, rep_, wave_s_); }
            SEAM(pb + 2);
        }

        if (L == 0) {
            for (int rep_ = 0; rep_ < ((IN(pb + 3) && PHK(3)) ? REPS(3) : 0); ++rep_) { ph_moba(L, rep_, wave_s_); }
            SEAM(pb + 3);
            for (int rep_ = 0; rep_ < ((IN(pb + 4) && PHK(12)) ? REPS(12) : 0); ++rep_) { ph_mobamerge(L, rep_, wave_s_); }
        } else {
            for (int rep_ = 0; rep_ < ((IN(pb + 3) && PHK(4)) ? REPS(4) : 0); ++rep_) { ph_dil(L, rep_, wave_s_); }
            SEAM(pb + 3);
            for (int rep_ = 0; rep_ < ((IN(pb + 4) && PHK(5)) ? REPS(5) : 0); ++rep_) { ph_merge(L, rep_, wave_s_); }
        }
        SEAM(pb + 4);

        for (int rep_ = 0; rep_ < ((IN(pb + 5) && PHK(6)) ? REPS(6) : 0); ++rep_) { ph_wo(L, rep_, wave_s_); }
        SEAM(pb + 5);

        for (int rep_ = 0; rep_ < ((IN(pb + 6) && PHK(7)) ? REPS(7) : 0); ++rep_) { ph_router(L, rep_, wave_s_); }
        SEAM(pb + 6);

        for (int rep_ = 0; rep_ < ((IN(pb + 7) && PHK(8)) ? REPS(8) : 0); ++rep_) { ph_gateup(L, rep_, wave_s_); }
        SEAM(pb + 7);

        for (int rep_ = 0; rep_ < ((IN(pb + 8) && PHK(9)) ? REPS(9) : 0); ++rep_) { ph_down(L, rep_, wave_s_); }
        SEAM(pb + 8);

        for (int rep_ = 0; rep_ < ((IN(pb + 9) && PHK(10)) ? REPS(10) : 0); ++rep_) { ph_combine(L, rep_, wave_s_); }
        if (L == 0) SEAM(pb + 9);
    }
}

extern "C" void kernel_launch(void* const* d_in, const int* in_sizes, int n_in, void* d_out, int out_size, void* d_ws, size_t ws_size, hipStream_t stream) {
    static int grid = 0;
    if (grid == 0) {
        if (n_in != 16 || out_size != T * D || ws_size < WS_END3) { fprintf(stderr, "kernel_launch: unexpected problem (n_in %d out %d ws %zu need %zu)\n", n_in, out_size, ws_size, (size_t)WS_END2); grid = -1; return; }
        int dev = 0, cus = 0, per_cu = 0;
        if (hipGetDevice(&dev) != hipSuccess || hipDeviceGetAttribute(&cus, hipDeviceAttributeMultiprocessorCount, dev) != hipSuccess) { grid = -1; return; }
        if (hipFuncSetAttribute((const void*)fwd, hipFuncAttributeMaxDynamicSharedMemorySize, LDS_BYTES) != hipSuccess) { fprintf(stderr, "kernel_launch: hipFuncSetAttribute failed\n"); grid = -1; return; }
        if (hipOccupancyMaxActiveBlocksPerMultiprocessor(&per_cu, (const void*)fwd, NTHR, LDS_BYTES) != hipSuccess || per_cu < 1) { fprintf(stderr, "kernel_launch: occupancy query says %d\n", per_cu); (void)hipGetLastError(); per_cu = 1; }
        grid = cus;
    }
    if (grid < 0) return;
    (void)hipMemsetAsync((char*)d_ws + WS_CTL, 0, CTL_BYTES, stream);
    Args a{};
    for (int i = 0; i < 16; ++i) a.in[i] = (const float*)d_in[i];
    a.out = (float*)d_out; a.ws = (unsigned char*)d_ws;
#if MK_ONE_LAUNCH
    a.ph_lo = 0; a.ph_hi = N_PHASES;
    hipLaunchKernelGGL(fwd, dim3(grid), dim3(NTHR), LDS_BYTES, stream, a);
#else
    for (int ph = 0; ph < N_PHASES; ++ph) {
        if (ph == 12 || ph == 13) continue;
        a.ph_lo = ph; a.ph_hi = ph + 1;
        hipLaunchKernelGGL(fwd, dim3(grid), dim3(NTHR), LDS_BYTES, stream, a);
    }
#endif
}
```

```cpp
#include <hip/hip_runtime.h>
#include <hip/hip_bf16.h>
#include <stdint.h>
#include <stdio.h>

#ifndef MK_ONE_LAUNCH
#define MK_ONE_LAUNCH 1
#endif

#ifndef PHMASK
#define PHMASK 0x1FFF
#endif
#define PHK(k) ((PHMASK >> (k)) & 1)
#ifndef REPEAT_KIND
#define REPEAT_KIND -1
#endif
#define REPS(k) ((k) == REPEAT_KIND ? 2 : 1)
#define LAS __attribute__((address_space(3)))
typedef __attribute__((ext_vector_type(8))) short bf16x8;
typedef __attribute__((ext_vector_type(16))) float f32x16;
typedef __attribute__((ext_vector_type(4))) float f32x4;
typedef __attribute__((ext_vector_type(4))) unsigned u32x4;
typedef __attribute__((ext_vector_type(2))) unsigned u32x2;
typedef unsigned short u16;

constexpr int D = 1024, BATCH = 2, SEQ = 8192, T = BATCH * SEQ, NH = 16, HD = 64;
constexpr int NE = 256, TOPK = 8, DF = 256;
constexpr int A_TOT = T * TOPK;
constexpr int MOBA_BLK = 256, MOBA_NB = SEQ / MOBA_BLK;
constexpr float DN_ALPHA = 1.4142135623730951f;
constexpr float LN_EPS = 1e-5f;
constexpr float LOG2E = 1.4426950408889634f;
constexpr float LN2 = 0.6931471805599453f;
constexpr float NEGV = -1e30f;
constexpr int NTHR = 512;

constexpr size_t al256(size_t x) { return (x + 255) & ~(size_t)255; }
constexpr size_t WS_CTL = 0;
constexpr size_t CTL_BYTES = 131072;
constexpr size_t CTL_CNT_OFF = 32768;
constexpr size_t CTL_XQ_OFF = 45056;
constexpr size_t CTL_ECNT_OFF = 65536;
constexpr int CNT_STRIDE = 32;
constexpr size_t WS_XB = WS_CTL + CTL_BYTES;
constexpr size_t WS_X1 = WS_XB + al256((size_t)T * D * 2);
constexpr size_t WS_X2 = WS_X1 + al256((size_t)T * D * 4);
constexpr size_t WS_YPRE = WS_X2 + al256((size_t)T * D * 4);
constexpr size_t WS_QKV = WS_YPRE + al256((size_t)T * D * 4);
constexpr size_t WS_VT = WS_QKV + al256((size_t)T * 9216 * 2);
constexpr size_t WS_KM = WS_VT + al256((size_t)3 * T * D * 2);
constexpr size_t WS_AO = WS_KM + al256((size_t)BATCH * NH * MOBA_NB * HD * 4);
constexpr size_t WS_OG = WS_AO + al256((size_t)T * D * 2);
constexpr size_t WS_LSE = WS_OG + al256((size_t)3 * T * D * 2);
constexpr size_t WS_TOPW = WS_LSE + al256((size_t)3 * T * NH * 4);
constexpr size_t WS_LIST = WS_TOPW + al256((size_t)T * TOPK * 4);
constexpr size_t WS_HB = WS_LIST + al256((size_t)NE * T * 4);
constexpr size_t WS_YB = WS_HB + al256((size_t)(A_TOT + T + 1) * DF * 2);
constexpr size_t WS_END = WS_YB + al256((size_t)(A_TOT + T + 1) * D * 2);
constexpr int TRASH_VA = A_TOT + T;
constexpr size_t WS_SELM = WS_END;
constexpr size_t WS_PART = WS_SELM + al256((size_t)T * NH * 4);
constexpr size_t WS_PLSE = WS_PART + al256((size_t)T * NH * 4 * 64 * 2);
constexpr size_t WS_WQK0 = WS_PLSE + al256((size_t)T * NH * 4 * 4);
constexpr size_t WS_WV0 = WS_WQK0 + (size_t)2048 * 1024 * 2;
constexpr size_t WS_WQK1 = WS_WV0 + (size_t)1024 * 1024 * 2;
constexpr size_t WS_WV1 = WS_WQK1 + (size_t)6144 * 1024 * 2;
constexpr size_t WS_WO = WS_WV1 + (size_t)3072 * 1024 * 2;
constexpr size_t WS_WSGU = WS_WO + (size_t)2 * 1024 * 1024 * 2;
constexpr size_t WS_WSD = WS_WSGU + (size_t)2 * 512 * 1024 * 2;
constexpr size_t WS_XB8 = WS_WSD + (size_t)2 * 1024 * 256 * 2;
constexpr size_t WS_HBS = WS_XB8 + (size_t)T * D;
constexpr size_t WS_WRH = WS_HBS + (size_t)T * DF * 2;
constexpr size_t WS_WRL = WS_WRH + (size_t)2 * 256 * 1024 * 2;
constexpr size_t WS_END2 = WS_WRL + (size_t)2 * 256 * 1024 * 2;
constexpr size_t WS_XQ8 = WS_END2;
constexpr size_t WS_WQ8 = WS_XQ8 + (size_t)T * D;
constexpr size_t WS_END3 = WS_WQ8 + (size_t)(3072 + 9216) * 1024;
#ifndef QKV_FP8
#define QKV_FP8 2
#endif

constexpr int LDP = 40;
constexpr int STAGE_BYTES = 2 * 256 * LDP * 2;
constexpr int LDS_ROWID = 2 * STAGE_BYTES;
constexpr int LDS_ROWW = LDS_ROWID + 1024;
constexpr int XS_PITCH = 1028;
constexpr int LDS_BYTES = 163840;
constexpr int LDS_BAR = 161792;

__device__ __forceinline__ int lane_id_() { int l; asm volatile("v_mbcnt_lo_u32_b32 %0, -1, 0\n\tv_mbcnt_hi_u32_b32 %0, -1, %0" : "=v"(l)); return l; }
__device__ __forceinline__ float shxf(float v, int m, int lane) { return __int_as_float(__builtin_amdgcn_ds_bpermute((lane ^ m) << 2, __float_as_int(v))); }
__device__ __forceinline__ int shxi(int v, int m, int lane) { return __builtin_amdgcn_ds_bpermute((lane ^ m) << 2, v); }
#define XB_TMO      128
#define XB_XCNT(j)  (256  + 64 * (j))
#define XB_XSUB(j)  (1280 + 64 * (j))
#define XB_XGEN(j)  (2304 + 64 * (j))
#define XB_TOP      3328
#define XB_TOPGEN   3392
#define XCD_BAR_WORDS 3456
#define XB_SPIN_CAP (1u << 18)
__device__ __forceinline__ unsigned xb_ld(unsigned* p)              { return __hip_atomic_load(p, __ATOMIC_RELAXED, __HIP_MEMORY_SCOPE_AGENT); }
__device__ __forceinline__ unsigned xb_add(unsigned* p, unsigned v) { return __hip_atomic_fetch_add(p, v, __ATOMIC_RELAXED, __HIP_MEMORY_SCOPE_AGENT); }
__device__ __forceinline__ unsigned xb_xcc_id() { return (unsigned)__builtin_amdgcn_s_getreg((3 << 11) | 20) & 0xFu; }
#define XB_SPIN(cond, bar) do { unsigned _sp = 0; while (cond) { __builtin_amdgcn_s_sleep(1); \
    if ((++_sp & 255u) == 0u) { if (xb_ld(&(bar)[XB_TMO])) break; if (_sp > XB_SPIN_CAP) { atomicAdd(&(bar)[XB_TMO], 1u); break; } } } } while (0)
struct XcdBarrier { unsigned* bar; unsigned x; volatile LAS unsigned* st; };
__device__ __forceinline__ XcdBarrier xcd_barrier_post(unsigned* bar, volatile LAS unsigned* st, const bool leader) {
    XcdBarrier b; b.bar = bar; b.x = xb_xcc_id(); b.st = st;
    if (leader) (void)xb_add(&bar[XB_XCNT(b.x)], 1u);
    return b;
}
__device__ __forceinline__ void xcd_barrier_complete(unsigned* bar, unsigned x, unsigned& nloc, unsigned& nx) {
    const unsigned G = gridDim.x * gridDim.y * gridDim.z;
    unsigned sum, cnt, mine, sp = 0u;
    for (;;) {
        sum = 0u; cnt = 0u; mine = 0u;
#pragma unroll
        for (unsigned j = 0; j < 16; ++j) { const unsigned c = xb_ld(&bar[XB_XCNT(j)]); sum += c; cnt += (c > 0u) ? 1u : 0u; mine = (j == x) ? c : mine; }
        if (sum == G) break;
        __builtin_amdgcn_s_sleep(1);
        if ((++sp & 255u) == 0u) { if (xb_ld(&bar[XB_TMO])) break; if (sp > XB_SPIN_CAP) { atomicAdd(&bar[XB_TMO], 1u); break; } }
    }
    nloc = mine > 0u ? mine : 1u; nx = cnt > 0u ? cnt : 1u;
}
__device__ __forceinline__ void xcd_barrier(const XcdBarrier& b, const bool leader) {
    asm volatile("s_waitcnt vmcnt(0)" ::: "memory");
    __syncthreads();
    if (leader) {
        unsigned* bar = b.bar;
        __builtin_amdgcn_s_waitcnt(0);
        unsigned nloc = b.st[0], nx = b.st[1];
        if (nloc == 0u) { xcd_barrier_complete(bar, b.x, nloc, nx); b.st[0] = nloc; b.st[1] = nx; }
        const unsigned old = xb_add(&bar[XB_XSUB(b.x)], 1u);
        const unsigned gen = old / nloc;
        if (old + 1u == (gen + 1u) * nloc) {
            __builtin_amdgcn_fence(__ATOMIC_RELEASE, "agent");
            asm volatile("s_waitcnt vmcnt(0)" ::: "memory");
            const unsigned og = xb_add(&bar[XB_TOP], 1u);
            const unsigned tg = og / nx;
            if (og + 1u == (tg + 1u) * nx) xb_add(&bar[XB_TOPGEN], 1u);
            else XB_SPIN(xb_ld(&bar[XB_TOPGEN]) == tg, bar);
            __builtin_amdgcn_fence(__ATOMIC_ACQUIRE, "agent");
            xb_add(&bar[XB_XGEN(b.x)], 1u);
            asm volatile("s_waitcnt vmcnt(0)" ::: "memory");
        } else {
            XB_SPIN(xb_ld(&bar[XB_XGEN(b.x)]) == gen, bar);
            __builtin_amdgcn_fence(__ATOMIC_ACQUIRE, "agent");
            asm volatile("s_waitcnt vmcnt(0)" ::: "memory");
        }
    }
    __syncthreads();
}

typedef __attribute__((ext_vector_type(2))) __bf16 bf16x2_t;
typedef __attribute__((ext_vector_type(2))) float f32x2_t;
__device__ __forceinline__ unsigned cvtpk(float lo, float hi) { f32x2_t f; f[0] = lo; f[1] = hi; return __builtin_bit_cast(unsigned, __builtin_convertvector(f, bf16x2_t)); }
__device__ __forceinline__ float bf2f(unsigned v16) { return __uint_as_float(v16 << 16); }
__device__ __forceinline__ int crow(int r, int hi) { return (r & 3) + 8 * (r >> 2) + 4 * hi; }
#define MFMA_BF16(a, b, c) __builtin_amdgcn_mfma_f32_32x32x16_bf16(a, b, c, 0, 0, 0)
__device__ __forceinline__ float wave_sum(float v) {
    v += __int_as_float(__builtin_amdgcn_update_dpp(0, __float_as_int(v), 0xB1, 0xF, 0xF, true));
    v += __int_as_float(__builtin_amdgcn_update_dpp(0, __float_as_int(v), 0x4E, 0xF, 0xF, true));
    v += __int_as_float(__builtin_amdgcn_update_dpp(0, __float_as_int(v), 0x141, 0xF, 0xF, true));
    v += __int_as_float(__builtin_amdgcn_update_dpp(0, __float_as_int(v), 0x140, 0xF, 0xF, true));
    const int vi = __float_as_int(v);
    return (__int_as_float(__builtin_amdgcn_readlane(vi, 0)) + __int_as_float(__builtin_amdgcn_readlane(vi, 16))) + (__int_as_float(__builtin_amdgcn_readlane(vi, 32)) + __int_as_float(__builtin_amdgcn_readlane(vi, 48)));
}

namespace pg8 {
#define PG8_LAS __attribute__((address_space(3)))
typedef unsigned short bf16_t;
typedef short bf16x8 __attribute__((ext_vector_type(8)));
typedef float f32x4 __attribute__((ext_vector_type(4)));
typedef unsigned u32x4 __attribute__((ext_vector_type(4)));
typedef int pg8_i32x8 __attribute__((ext_vector_type(8)));
constexpr int BM = 256, BK = 64, HALF = 128, HTB = HALF * BK * 2  , STAGE_BYTES = 8 * HTB, NXCD = 8, WGM = 8;

__host__ __device__ __forceinline__ int lds_byte(int r, int c) { const int st = (r >> 4) * 2 + (c >> 5), rr = r & 15, cc = c & 31, ob = rr * 64 + cc * 2; return st * 1024 + (ob ^ (((ob >> 9) & 1) << 5)); }
__host__ __device__ __forceinline__ void stage_rc(int b, int& R, int& C) { const int st = b / 1024, sb = b % 1024, swz = sb ^ (((sb >> 9) & 1) << 5); R = (st >> 1) * 16 + swz / 64; C = (st & 1) * 32 + (swz % 64) / 2; }
__device__ __forceinline__ int pg8_opq(int v) { asm volatile("" : "+v"(v)); return v; }
__host__ __device__ __forceinline__ int perm32(int rho) { const int n = rho >> 4, i = rho & 15; return 8 * (i >> 2) + 4 * n + (i & 3); }

struct Unit { int pm, pn; };
struct Gemm { const bf16_t* A; const bf16_t* Bt; int M, N, K; };
struct FixedOrder {
    int pm, pn;
    __device__ __forceinline__ bool next(int i, Unit& u) const { if (i != 0) return false; u.pm = pm; u.pn = pn; return true; }
    __device__ __forceinline__ void a_ready(const Unit&) const {}
    __device__ __forceinline__ void done(const Unit&) const {}
};

struct StaticOrder {
    int nM, nN, nwg, G, c;
    __host__ __device__ void init(int M, int N, int G_, int c_) { nM = M / BM; nN = N / BM; nwg = nM * nN; G = G_; c = c_; }
    __host__ __device__ bool next(int i, Unit& u) const {
        const long L = (long)i * G + c; if (L >= nwg) return false;
        int wgid = (int)L; { const int q = nwg / NXCD, r = nwg % NXCD, xcd = wgid % NXCD, off = wgid / NXCD; wgid = (xcd < r ? xcd * (q + 1) : r * (q + 1) + (xcd - r) * q) + off; }
        const int nig = WGM * nN, gid = wgid / nig, fm = gid * WGM, gsz = (nM - fm) < WGM ? (nM - fm) : WGM;
        u.pm = fm + ((wgid % nig) % gsz); u.pn = (wgid % nig) / gsz; return true;
    }
    __device__ __forceinline__ void a_ready(const Unit&) const {}
    __device__ __forceinline__ void done(const Unit&) const {}
};

template <class Epi, class Sched, bool SWAP = false, bool STAMP = false, bool F8 = false>
__device__ __forceinline__ void gemm_phase(PG8_LAS unsigned char* lds, const Gemm g, const Sched& S, const Epi& E, unsigned long long* stamps, const int tid_in) {
    int tid_ = tid_in; asm volatile("" : "+v"(tid_));
    const int tid = tid_, wid = __builtin_amdgcn_readfirstlane(tid >> 6), lane = tid & 63, wr = wid >> 2, wc = wid & 3, fr = lane & 15, fq = lane >> 4;
    const int K = g.K, nt = K / BK;
    int ts_lo = 0, ts_hi = 0, nts = 0; const unsigned long long rt_entry = STAMP ? (unsigned long long)wall_clock64() : 0ull;
#define PG8_STAMP() do { if (STAMP && wid == 0 && nts < 64) { const unsigned long long _c = (unsigned long long)clock64(); \
        ts_lo = (lane == nts) ? (int)(unsigned)_c : ts_lo; ts_hi = (lane == nts) ? (int)(unsigned)(_c >> 32) : ts_hi; ++nts; } } while (0)
    PG8_STAMP();
    unsigned voffA[2], voffB[2];
#pragma unroll
    for (int i = 0; i < 2; ++i) { int R, C; stage_rc(tid * 16 + i * 8192, R, C); const int Rb = Epi::PERM ? ((R & ~31) + perm32(R & 31)) : R;
        voffA[i] = (unsigned)(R * K + C) * 2u; voffB[i] = (unsigned)(Rb * K + C) * 2u; }
    const size_t kstep = (size_t)(BK * 2);
    const size_t hstep = (size_t)HALF * K * 2;
    const size_t tstep = 2 * hstep;
    const unsigned ldsw = (unsigned)wid * 1024u;
    int xoff_ = lds_byte(fr, fq * 8); asm volatile("" : "+v"(xoff_));
    const int aoffs = wr * 8192, boffs = wc * 4096;
#define aoff (aoffs + pg8_opq(xoff_))
#define boff (boffs + pg8_opq(xoff_))
#define PG8_SA(b, h) (((b) * 2 + (h)) * HTB)
#define PG8_SB(b, h) ((4 + (b) * 2 + (h)) * HTB)
#define PG8_STAGE(bufoff, gbase, voff) do {   \
        _Pragma("unroll") for (int _i = 0; _i < 2; ++_i) { uint64_t gb_ = (uint64_t)(gbase) + (uint64_t)_i * (size_t)(64 * 2) * K; asm volatile("" : "+s"(gb_)); unsigned vo_ = (voff)[0]; asm volatile("" : "+v"(vo_)); \
        __builtin_amdgcn_global_load_lds((const __attribute__((address_space(1))) unsigned*)((const __attribute__((address_space(1))) char*)gb_ + vo_), (PG8_LAS unsigned*)(lds + (bufoff) + ldsw + _i * 8192), 16, 0, 0); } } while (0)
#define PG8_CAT8(X0, X1) pg8_i32x8{(int)__builtin_bit_cast(u32x4, X0)[0], (int)__builtin_bit_cast(u32x4, X0)[1], (int)__builtin_bit_cast(u32x4, X0)[2], (int)__builtin_bit_cast(u32x4, X0)[3], \
                                   (int)__builtin_bit_cast(u32x4, X1)[0], (int)__builtin_bit_cast(u32x4, X1)[1], (int)__builtin_bit_cast(u32x4, X1)[2], (int)__builtin_bit_cast(u32x4, X1)[3]}
#define PG8_LDA(dst, b, h) do { _Pragma("unroll") for (int m = 0; m < 4; ++m) { if (F8) { const bf16x8 x0_ = *(const PG8_LAS bf16x8*)(lds + PG8_SA(b, h) + aoff + m * 2048), x1_ = *(const PG8_LAS bf16x8*)(lds + PG8_SA(b, h) + aoff + m * 2048 + 1024); dst##8[m] = PG8_CAT8(x0_, x1_); } \
        else { _Pragma("unroll") for (int k = 0; k < 2; ++k) dst[m][k] = *(const PG8_LAS bf16x8*)(lds + PG8_SA(b, h) + aoff + m * 2048 + k * 1024); } } } while (0)
#define PG8_LDB(dst, b, h) do { _Pragma("unroll") for (int n = 0; n < 2; ++n) { if (F8) { const bf16x8 x0_ = *(const PG8_LAS bf16x8*)(lds + PG8_SB(b, h) + boff + n * 2048), x1_ = *(const PG8_LAS bf16x8*)(lds + PG8_SB(b, h) + boff + n * 2048 + 1024); dst##8[n] = PG8_CAT8(x0_, x1_); } \
        else { _Pragma("unroll") for (int k = 0; k < 2; ++k) dst[n][k] = *(const PG8_LAS bf16x8*)(lds + PG8_SB(b, h) + boff + n * 2048 + k * 1024); } } } while (0)
#define PG8_MMA(ai, bj, At, Bt) do { __builtin_amdgcn_s_setprio(1); _Pragma("unroll") for (int m = 0; m < 4; ++m) _Pragma("unroll") for (int n = 0; n < 2; ++n) _Pragma("unroll") for (int k = 0; k < 2; ++k) \
        { if (F8) { if (k == 0) acc[ai][bj][m][n] = __builtin_amdgcn_mfma_scale_f32_16x16x128_f8f6f4(Bt##8[n], At##8[m], acc[ai][bj][m][n], 0, 0, 0, 0x7F79, 1, 0x7F79); } \
          else acc[ai][bj][m][n] = SWAP ? __builtin_amdgcn_mfma_f32_16x16x32_bf16(At[m][k], Bt[n][k], acc[ai][bj][m][n], 0, 0, 0) : __builtin_amdgcn_mfma_f32_16x16x32_bf16(Bt[n][k], At[m][k], acc[ai][bj][m][n], 0, 0, 0); } __builtin_amdgcn_s_setprio(0); } while (0)
#define PG8_WAIT_V(n) asm volatile("s_waitcnt vmcnt(" #n ")" ::: "memory")
#define PG8_WAIT_L(n) asm volatile("s_waitcnt lgkmcnt(" #n ")" ::: "memory")
#define PG8_BAR __builtin_amdgcn_s_barrier()
#define PG8_SCHED __builtin_amdgcn_sched_barrier(0)
    Unit cur, nxt; int ui = 0;
    if (!S.next(0, cur)) return;
    f32x4 acc[2][2][4][2];
#pragma unroll
    for (int a = 0; a < 2; ++a)
#pragma unroll
        for (int b = 0; b < 2; ++b)
#pragma unroll
            for (int m = 0; m < 4; ++m)
#pragma unroll
                for (int n = 0; n < 2; ++n) acc[a][b][m][n] = (f32x4){0.f, 0.f, 0.f, 0.f};
    bf16x8 At[4][2], B0[2][2], B1[2][2];
    pg8_i32x8 At8[4], B08[2], B18[2];
    const char* cA = (const char*)g.A + (size_t)cur.pm * tstep; const char* cB = (const char*)g.Bt + (size_t)cur.pn * tstep;
    S.a_ready(cur);
    PG8_STAGE(PG8_SB(0, 0), cB, voffB); PG8_STAGE(PG8_SA(0, 0), cA, voffA); PG8_STAGE(PG8_SB(0, 1), cB + hstep, voffB); PG8_STAGE(PG8_SA(0, 1), cA + hstep, voffA);
    if (wr == 1) PG8_BAR;
    PG8_WAIT_V(4); PG8_BAR;
    PG8_STAGE(PG8_SB(1, 0), cB + kstep, voffB); PG8_STAGE(PG8_SA(1, 0), cA + kstep, voffA); PG8_STAGE(PG8_SB(1, 1), cB + hstep + kstep, voffB);
    PG8_WAIT_V(6); PG8_BAR;
    PG8_STAMP();
    for (;;) {
        const bool has_next = S.next(ui + 1, nxt);
        const char* nA = has_next ? (const char*)g.A + (size_t)nxt.pm * tstep : cA; const char* nB = has_next ? (const char*)g.Bt + (size_t)nxt.pn * tstep : cB;
        for (int t = 0; t < nt; t += 2) {
            const bool last = (t == nt - 2);
            const char* a1 = cA + (size_t)(t + 1) * kstep;
            const char* a2 = last ? nA : cA + (size_t)(t + 2) * kstep; const char* b2 = last ? nB : cB + (size_t)(t + 2) * kstep;
            const char* a3 = a2 + kstep; const char* b3 = b2 + kstep;
            if (last && has_next) S.a_ready(nxt);
            PG8_LDB(B0, 0, 0); PG8_SCHED; PG8_LDA(At, 0, 0); PG8_STAGE(PG8_SA(1, 1), a1 + hstep, voffA);
            PG8_WAIT_L(8); PG8_BAR; PG8_WAIT_L(0); PG8_MMA(0, 0, At, B0); PG8_BAR; PG8_SCHED;
            PG8_LDB(B1, 0, 1); PG8_STAGE(PG8_SB(0, 0), b2, voffB);
            PG8_BAR; PG8_WAIT_L(0); PG8_MMA(0, 1, At, B1); PG8_BAR;
            PG8_LDA(At, 0, 1); PG8_STAGE(PG8_SA(0, 0), a2, voffA);
            PG8_BAR; PG8_WAIT_L(0); PG8_MMA(1, 0, At, B0); PG8_BAR; PG8_SCHED;
            PG8_STAGE(PG8_SB(0, 1), b2 + hstep, voffB);
            PG8_WAIT_V(6); PG8_BAR; PG8_MMA(1, 1, At, B1); PG8_BAR;
            PG8_LDB(B0, 1, 0); PG8_SCHED; PG8_LDA(At, 1, 0); PG8_STAGE(PG8_SA(0, 1), a2 + hstep, voffA);
            PG8_WAIT_L(8); PG8_BAR; PG8_WAIT_L(0); PG8_MMA(0, 0, At, B0); PG8_BAR; PG8_SCHED;
            PG8_LDB(B1, 1, 1); PG8_STAGE(PG8_SB(1, 0), b3, voffB);
            PG8_BAR; PG8_WAIT_L(0); PG8_MMA(0, 1, At, B1); PG8_BAR;
            PG8_LDA(At, 1, 1); PG8_STAGE(PG8_SA(1, 0), a3, voffA);
            PG8_BAR; PG8_WAIT_L(0); PG8_MMA(1, 0, At, B0); PG8_BAR; PG8_SCHED;
            PG8_STAGE(PG8_SB(1, 1), b3 + hstep, voffB);
            PG8_WAIT_V(6); PG8_BAR; PG8_MMA(1, 1, At, B1); PG8_BAR;
        }
        PG8_STAMP();
        if constexpr (!Epi::AFTER_DRAIN) { const int le_ = lane_id_(); E(acc, cur, wr, wc, le_ & 15, le_ >> 4); S.done(cur); }
        PG8_STAMP();
        if (!has_next) break;
#pragma unroll
        for (int a = 0; a < 2; ++a)
#pragma unroll
            for (int b = 0; b < 2; ++b)
#pragma unroll
                for (int m = 0; m < 4; ++m)
#pragma unroll
                    for (int n = 0; n < 2; ++n) acc[a][b][m][n] = (f32x4){0.f, 0.f, 0.f, 0.f};
        cur = nxt; cA = nA; cB = nB; ++ui;
    }
    PG8_WAIT_V(0);
    if (wr == 0) PG8_BAR;
    PG8_BAR;
    if constexpr (Epi::AFTER_DRAIN) { E.fused(acc, cur, wr, wc, fr, fq, lds, wid, lane); S.done(cur); }
    PG8_STAMP();
    if (STAMP && wid == 0) { stamps[lane] = lane < nts ? (((unsigned long long)(unsigned)ts_hi << 32) | (unsigned)ts_lo) : 0ull;
        if (lane == 62) stamps[62] = rt_entry; if (lane == 63) stamps[63] = (unsigned long long)wall_clock64(); }
#undef PG8_STAMP
#undef PG8_SA
#undef PG8_SB
#undef PG8_STAGE
#undef aoff
#undef boff
#undef PG8_LDA
#undef PG8_LDB
#undef PG8_MMA
#undef PG8_WAIT_V
#undef PG8_WAIT_L
#undef PG8_BAR
#undef PG8_SCHED
}
}

struct EpiQK {
    static constexpr bool PERM = true, AFTER_DRAIN = false;
    u16* O; int ldc;
    __device__ __forceinline__ void operator()(const pg8::f32x4 (&acc)[2][2][4][2], const pg8::Unit& u, int wr, int wc, int fr, int fq) const {
        uint64_t ob_ = (uint64_t)O; asm volatile("" : "+s"(ob_));
        unsigned off0 = ((unsigned)(u.pm * 256 + wr * 64 + fr) * (unsigned)ldc + (unsigned)(u.pn * 256 + wc * 32 + 8 * fq)) * 2u; asm volatile("" : "+v"(off0));
        const unsigned rstep = (unsigned)ldc * 32u;
#pragma unroll
        for (int ai = 0; ai < 2; ++ai)
#pragma unroll
            for (int m = 0; m < 4; ++m) { unsigned ro = off0 + (unsigned)(ai * 8 + m) * rstep; asm volatile("" : "+v"(ro));
#pragma unroll
                for (int bj = 0; bj < 2; ++bj) { const pg8::f32x4 v0 = acc[ai][bj][m][0], v1 = acc[ai][bj][m][1];
                    u32x4 w; w[0] = cvtpk(v0[0], v0[1]); w[1] = cvtpk(v0[2], v0[3]); w[2] = cvtpk(v1[0], v1[1]); w[3] = cvtpk(v1[2], v1[3]);
                    *(__attribute__((address_space(1))) u32x4*)((__attribute__((address_space(1))) char*)ob_ + ro + bj * 256) = w; } }
    }
};
struct EpiV {
    static constexpr bool PERM = false, AFTER_DRAIN = false;
    u16* VT; int layer;
    __device__ __forceinline__ void operator()(const pg8::f32x4 (&acc)[2][2][4][2], const pg8::Unit& u, int wr, int wc, int fr, int fq) const {
        const int colt = u.pn * 256, grp = colt >> 10;
        const int dil = (layer == 0 || grp == 0) ? 1 : (grp == 1 ? 4 : 16);
        const int rowb = u.pm * 256 + wr * 64 + 4 * fq;
#pragma unroll
        for (int bj = 0; bj < 2; ++bj)
#pragma unroll
            for (int n = 0; n < 2; ++n) {
                const int c = (colt & 1023) + bj * 128 + wc * 32 + n * 16 + fr, h = c >> 6, d = c & 63;
#pragma unroll
                for (int ai = 0; ai < 2; ++ai)
#pragma unroll
                    for (int m = 0; m < 4; ++m) {
                        const int r0 = rowb + ai * 128 + m * 16, b = r0 >> 13, t0 = r0 & (SEQ - 1);
                        u16* vrow = VT + (size_t)grp * T * D + ((size_t)(b * NH + h) * HD + d) * SEQ;
                        const pg8::f32x4 v = acc[ai][bj][m][n];
                        if (dil == 1) { u32x2 w; w[0] = cvtpk(v[0], v[1]); w[1] = cvtpk(v[2], v[3]); *(u32x2*)(vrow + t0) = w; }
                        else {
#pragma unroll
                            for (int i = 0; i < 4; ++i) { const int pp = t0 + i; vrow[(pp % dil) * (SEQ / dil) + pp / dil] = (u16)cvtpk(v[i], 0.f); }
                        }
                    }
            }
    }
};
struct EpiWo {
    static constexpr bool PERM = true, AFTER_DRAIN = false;
    u16* Y; const u16* X;
    __device__ __forceinline__ void operator()(const pg8::f32x4 (&acc)[2][2][4][2], const pg8::Unit& u, int wr, int wc, int fr, int fq) const {
        const int row0 = u.pm * 256 + wr * 64 + fr, col0 = u.pn * 256 + wc * 32 + 8 * fq;
#pragma unroll
        for (int ai = 0; ai < 2; ++ai)
#pragma unroll
            for (int m = 0; m < 4; ++m) { const size_t ro = (size_t)(row0 + ai * 128 + m * 16) * D + col0;
#pragma unroll
                for (int bj = 0; bj < 2; ++bj) { const pg8::f32x4 v0 = acc[ai][bj][m][0], v1 = acc[ai][bj][m][1];
                    const u32x4 xr = *(const u32x4*)(X + ro + bj * 128);
                    u32x4 w;
                    w[0] = cvtpk(bf2f(xr[0] & 0xFFFFu) * DN_ALPHA + v0[0], bf2f(xr[0] >> 16) * DN_ALPHA + v0[1]); w[1] = cvtpk(bf2f(xr[1] & 0xFFFFu) * DN_ALPHA + v0[2], bf2f(xr[1] >> 16) * DN_ALPHA + v0[3]);
                    w[2] = cvtpk(bf2f(xr[2] & 0xFFFFu) * DN_ALPHA + v1[0], bf2f(xr[2] >> 16) * DN_ALPHA + v1[1]); w[3] = cvtpk(bf2f(xr[3] & 0xFFFFu) * DN_ALPHA + v1[2], bf2f(xr[3] >> 16) * DN_ALPHA + v1[3]);
                    *(u32x4*)(Y + ro + bj * 128) = w; } }
    }
};
struct EpiSGU {
    static constexpr bool PERM = true, AFTER_DRAIN = false;
    u16* H;
    __device__ __forceinline__ void operator()(const pg8::f32x4 (&acc)[2][2][4][2], const pg8::Unit& u, int wr, int wc, int fr, int fq) const {
        const int row0 = u.pm * 256 + wr * 64 + fr, f0 = u.pn * 128 + wc * 32 + 8 * fq;
#pragma unroll
        for (int ai = 0; ai < 2; ++ai)
#pragma unroll
            for (int m = 0; m < 4; ++m) {
                float hv[8];
#pragma unroll
                for (int n = 0; n < 2; ++n)
#pragma unroll
                    for (int i = 0; i < 4; ++i) { const float gt = acc[ai][0][m][n][i], up = acc[ai][1][m][n][i]; hv[n * 4 + i] = gt / (1.f + __expf(-gt)) * up; }
                u32x4 w; w[0] = cvtpk(hv[0], hv[1]); w[1] = cvtpk(hv[2], hv[3]); w[2] = cvtpk(hv[4], hv[5]); w[3] = cvtpk(hv[6], hv[7]);
                *(u32x4*)(H + (size_t)(row0 + ai * 128 + m * 16) * DF + f0) = w;
            }
    }
};
struct EpiSD {
    static constexpr bool PERM = true, AFTER_DRAIN = false;
    u16* Y;
    __device__ __forceinline__ void operator()(const pg8::f32x4 (&acc)[2][2][4][2], const pg8::Unit& u, int wr, int wc, int fr, int fq) const {
        const int row0 = u.pm * 256 + wr * 64 + fr, col0 = u.pn * 256 + wc * 32 + 8 * fq;
#pragma unroll
        for (int ai = 0; ai < 2; ++ai)
#pragma unroll
            for (int m = 0; m < 4; ++m) { u16* rowp = Y + (size_t)(A_TOT + row0 + ai * 128 + m * 16) * D + col0;
#pragma unroll
                for (int bj = 0; bj < 2; ++bj) { const pg8::f32x4 v0 = acc[ai][bj][m][0], v1 = acc[ai][bj][m][1];
                    u32x4 w; w[0] = cvtpk(v0[0], v0[1]); w[1] = cvtpk(v0[2], v0[3]); w[2] = cvtpk(v1[0], v1[1]); w[3] = cvtpk(v1[2], v1[3]);
                    *(u32x4*)(rowp + bj * 128) = w; } }
    }
};

struct Args {
    const float* in[16];
    float* out;
    unsigned char* ws;
    int ph_lo, ph_hi;
};

#define GEMM_CORE(K_, PA0, PA1, PB, LDB)                                                                                                   \
    {                                                                                                                                      \
        const int g_tid = tid, g_lane = lane, g_wave = wave, g_r32 = r32, g_hi = hi;                   \
        const int g_wm = g_wave >> 2, g_wn = g_wave & 3, g_kc = g_tid & 3, g_kq = g_lane >> 3, g_n4 = g_lane & 7;                           \
        const u16* g_pa0 = (PA0); const u16* g_pa1 = (PA1);                                                                                \
        const size_t g_ldb = (size_t)(LDB);                                                                                                \
        const float* g_pb = (PB) + (size_t)(g_kq * 4) * g_ldb + g_n4 * 4;                                                                  \
        const int g_nk = (K_) / 32;                                                                                                        \
        u32x4 g_ra0, g_ra1; f32x4 g_rb0, g_rb1, g_rb2, g_rb3;                                                                              \
        const u32x4 g_z = {0u, 0u, 0u, 0u};                                                                                                \
        _Pragma("unroll") for (int mb = 0; mb < 4; ++mb) { _Pragma("unroll") for (int nb = 0; nb < 2; ++nb) { _Pragma("unroll") for (int r = 0; r < 16; ++r) acc[mb][nb][r] = 0.f; } } \
        g_ra0 = g_pa0 ? *(const u32x4*)(g_pa0 + g_kc * 8) : g_z; g_ra1 = g_pa1 ? *(const u32x4*)(g_pa1 + g_kc * 8) : g_z;                 \
        g_rb0 = *(const f32x4*)(g_pb); g_rb1 = *(const f32x4*)(g_pb + g_ldb); g_rb2 = *(const f32x4*)(g_pb + 2 * g_ldb); g_rb3 = *(const f32x4*)(g_pb + 3 * g_ldb); \
        _Pragma("unroll 1") for (int kt = 0; kt < g_nk; ++kt) {                                                                            \
            LAS char* As = lds + (kt & 1) * STAGE_BYTES; LAS char* Bs = As + 256 * LDP * 2;                                                \
            *(LAS u32x4*)(As + ((g_tid >> 2) * LDP + g_kc * 8) * 2) = g_ra0;                                                               \
            *(LAS u32x4*)(As + (((g_tid >> 2) + 128) * LDP + g_kc * 8) * 2) = g_ra1;                                                       \
            _Pragma("unroll") for (int i = 0; i < 4; ++i) {                                                                                \
                u32x2 w; w[0] = cvtpk(g_rb0[i], g_rb1[i]); w[1] = cvtpk(g_rb2[i], g_rb3[i]);                                               \
                *(LAS u32x2*)(Bs + ((g_wave * 32 + i * 8 + g_n4) * LDP + g_kq * 4) * 2) = w;                                               \
            }                                                                                                                              \
            __syncthreads();                                                                                                               \
            if (kt + 1 < g_nk) {                                                                                                           \
                const int ko = (kt + 1) * 32;                                                                                              \
                g_ra0 = g_pa0 ? *(const u32x4*)(g_pa0 + ko + g_kc * 8) : g_z; g_ra1 = g_pa1 ? *(const u32x4*)(g_pa1 + ko + g_kc * 8) : g_z; \
                const float* pbk = g_pb + (size_t)ko * g_ldb;                                                                              \
                g_rb0 = *(const f32x4*)(pbk); g_rb1 = *(const f32x4*)(pbk + g_ldb); g_rb2 = *(const f32x4*)(pbk + 2 * g_ldb); g_rb3 = *(const f32x4*)(pbk + 3 * g_ldb); \
            }                                                                                                                              \
            _Pragma("unroll") for (int s = 0; s < 2; ++s) {                                                                                \
                bf16x8 af[4], bfr[2];                                                                                                      \
                _Pragma("unroll") for (int mb = 0; mb < 4; ++mb) af[mb] = *(LAS bf16x8*)(As + ((g_wm * 128 + mb * 32 + g_r32) * LDP + s * 16 + g_hi * 8) * 2); \
                _Pragma("unroll") for (int nb = 0; nb < 2; ++nb) bfr[nb] = *(LAS bf16x8*)(Bs + (((g_wn * 2 + nb) * 32 + g_r32) * LDP + s * 16 + g_hi * 8) * 2); \
                _Pragma("unroll") for (int mb = 0; mb < 4; ++mb) { _Pragma("unroll") for (int nb = 0; nb < 2; ++nb) acc[mb][nb] = MFMA_BF16(af[mb], bfr[nb], acc[mb][nb]); } \
            }                                                                                                                              \
        }                                                                                                                                  \
        __syncthreads();                                                                                                                   \
    }

struct AttnSt { float m, l; f32x16 o0, o1; };

struct AttnFr { bf16x8 k[4]; bf16x8 v[4]; };
__device__ __forceinline__ void attn_load(AttnFr& f, const u16* krow, const u16* vt, size_t vt_dstride) {
#pragma unroll
    for (int d0 = 0; d0 < 4; ++d0) f.k[d0] = *(const bf16x8*)(krow + d0 * 16);
    const u16* vt1 = vt + 32 * vt_dstride;
    union { bf16x8 v; u32x2 h[2]; } va;
    va.h[0] = *(const u32x2*)(vt);       va.h[1] = *(const u32x2*)(vt + 8);   f.v[0] = va.v;
    va.h[0] = *(const u32x2*)(vt + 16);  va.h[1] = *(const u32x2*)(vt + 24);  f.v[1] = va.v;
    va.h[0] = *(const u32x2*)(vt1);      va.h[1] = *(const u32x2*)(vt1 + 8);  f.v[2] = va.v;
    va.h[0] = *(const u32x2*)(vt1 + 16); va.h[1] = *(const u32x2*)(vt1 + 24); f.v[3] = va.v;
}
__device__ __forceinline__ void attn_compute(AttnSt& st, const bf16x8 (&qf)[4], const AttnFr& f, int dist0, float bslope, int dlo, int dhi, int hi, int lane) {
    f32x16 p;
#pragma unroll
    for (int r = 0; r < 16; ++r) p[r] = 0.f;
#pragma unroll
    for (int d0 = 0; d0 < 4; ++d0) p = MFMA_BF16(f.k[d0], qf[d0], p);
    constexpr float C2 = 0.125f * LOG2E;
    float mx = NEGV;
#pragma unroll
    for (int r = 0; r < 16; ++r) {
        const int dist = dist0 - ((r & 3) + 8 * (r >> 2));
        const float sc = __builtin_fmaf(p[r], C2, -bslope * (float)dist);
        const float s_ = (dist >= dlo && dist <= dhi) ? sc : NEGV;
        p[r] = s_; mx = fmaxf(mx, s_);
    }
    mx = fmaxf(mx, shxf(mx, 32, lane));
    const float mnew = fmaxf(st.m, mx);
    const float alpha = __builtin_amdgcn_exp2f(st.m - mnew);
    st.m = mnew;
    float ls = 0.f;
#pragma unroll
    for (int r = 0; r < 16; ++r) { p[r] = __builtin_amdgcn_exp2f(p[r] - mnew); ls += p[r]; }
    st.l = st.l * alpha + ls;
#pragma unroll
    for (int r = 0; r < 16; ++r) { st.o0[r] *= alpha; st.o1[r] *= alpha; }
    union { bf16x8 v; unsigned u[4]; } pb0, pb1;
#pragma unroll
    for (int j = 0; j < 4; ++j) { pb0.u[j] = cvtpk(p[2 * j], p[2 * j + 1]); pb1.u[j] = cvtpk(p[8 + 2 * j], p[8 + 2 * j + 1]); }
    st.o0 = MFMA_BF16(f.v[0], pb0.v, st.o0);
    st.o0 = MFMA_BF16(f.v[1], pb1.v, st.o0);
    st.o1 = MFMA_BF16(f.v[2], pb0.v, st.o1);
    st.o1 = MFMA_BF16(f.v[3], pb1.v, st.o1);
    (void)hi;
}

__device__ __forceinline__ float dpp_rowmax(float v) {
    v = fmaxf(v, __int_as_float(__builtin_amdgcn_update_dpp(0, __float_as_int(v), 0xB1, 0xF, 0xF, true)));
    v = fmaxf(v, __int_as_float(__builtin_amdgcn_update_dpp(0, __float_as_int(v), 0x4E, 0xF, 0xF, true)));
    v = fmaxf(v, __int_as_float(__builtin_amdgcn_update_dpp(0, __float_as_int(v), 0x141, 0xF, 0xF, true)));
    v = fmaxf(v, __int_as_float(__builtin_amdgcn_update_dpp(0, __float_as_int(v), 0x140, 0xF, 0xF, true)));
    return v;
}
__device__ __forceinline__ int dpp_rowmin_i(int v) {
    v = min(v, __builtin_amdgcn_update_dpp(0, v, 0xB1, 0xF, 0xF, true));
    v = min(v, __builtin_amdgcn_update_dpp(0, v, 0x4E, 0xF, 0xF, true));
    v = min(v, __builtin_amdgcn_update_dpp(0, v, 0x141, 0xF, 0xF, true));
    v = min(v, __builtin_amdgcn_update_dpp(0, v, 0x140, 0xF, 0xF, true));
    return v;
}
__device__ __forceinline__ float rl_f(float v, int l) { return __int_as_float(__builtin_amdgcn_readlane(__float_as_int(v), l)); }

__device__ __forceinline__ void top3_insert(float v, int i, float& v0, int& i0, float& v1, int& i1, float& v2, int& i2) {
    const bool b0 = (v > v0) || (v == v0 && i < i0);
    const bool b1 = (v > v1) || (v == v1 && i < i1);
    const bool b2 = (v > v2) || (v == v2 && i < i2);
    const float nv2 = b1 ? v1 : (b2 ? v : v2); const int ni2 = b1 ? i1 : (b2 ? i : i2);
    const float nv1 = b0 ? v0 : (b1 ? v : v1); const int ni1 = b0 ? i0 : (b1 ? i : i1);
    const float nv0 = b0 ? v : v0;             const int ni0 = b0 ? i : i0;
    v0 = nv0; i0 = ni0; v1 = nv1; i1 = ni1; v2 = nv2; i2 = ni2;
}

__device__ __forceinline__ void ln_row(float (&v)[16], const float* __restrict__ g, const float* __restrict__ b, int lane) {
    float s = 0.f;
#pragma unroll
    for (int i = 0; i < 16; ++i) s += v[i];
    const float mu = wave_sum(s) * (1.f / D);
    float q = 0.f;
#pragma unroll
    for (int i = 0; i < 16; ++i) { const float d = v[i] - mu; q += d * d; }
    const float rstd = rsqrtf(wave_sum(q) * (1.f / D) + LN_EPS);
#pragma unroll
    for (int j = 0; j < 4; ++j) {
        const f32x4 gg = *(const f32x4*)(g + j * 256 + lane * 4), bb = *(const f32x4*)(b + j * 256 + lane * 4);
#pragma unroll
        for (int c = 0; c < 4; ++c) v[j * 4 + c] = (v[j * 4 + c] - mu) * rstd * gg[c] + bb[c];
    }
}

typedef __attribute__((ext_vector_type(2))) float f32x2_;
__device__ __forceinline__ bf16x8 fp8x8_to_bf16(unsigned lo, unsigned hi_) {
    const f32x2_ a = __builtin_amdgcn_cvt_pk_f32_fp8((int)lo, false), b = __builtin_amdgcn_cvt_pk_f32_fp8((int)lo, true);
    const f32x2_ c = __builtin_amdgcn_cvt_pk_f32_fp8((int)hi_, false), d = __builtin_amdgcn_cvt_pk_f32_fp8((int)hi_, true);
    union { bf16x8 v; unsigned u[4]; } r;
    r.u[0] = cvtpk(a[0], a[1]); r.u[1] = cvtpk(b[0], b[1]); r.u[2] = cvtpk(c[0], c[1]); r.u[3] = cvtpk(d[0], d[1]);
    return r.v;
}
__device__ __forceinline__ unsigned pack_fp8x4(float a, float b, float c, float d) { int p = __builtin_amdgcn_cvt_pk_fp8_f32(a, b, 0, false); return (unsigned)__builtin_amdgcn_cvt_pk_fp8_f32(c, d, p, true); }

constexpr float Y8_SCALE = 16.f;
constexpr int MOE_XCAP = 576;
#define MOE_GAS __attribute__((address_space(1)))
typedef MOE_GAS unsigned char moe_gcb;
constexpr int MOE_BP = 72;
constexpr int MOE_BSTAGE = 128 * MOE_BP * 2;
constexpr int MOE_LDS_VA = 3 * MOE_BSTAGE;
constexpr int MOE_LDS_W = MOE_LDS_VA + 4096;
constexpr int MOE_LDS_XCH = 65536;
template <bool DOWN>
__device__ __forceinline__ void moe_expert(LAS char* lds, const int tid, const int lane, const int wave, const int r32, const int hi,
                                           const unsigned char* __restrict__ abase  , const float* __restrict__ w0, const float* __restrict__ w1, const int ng  , void* __restrict__ outv,
                                           const int pass0, const int npass_, const int st0, const int nstl  , const bool y8 = false  ,
                                           const bool xr = false  ) {
    constexpr int KT = DOWN ? 4 : 16, NP = DOWN ? 8 : 4, LDB = DOWN ? 1024 : 256, APITCH = DOWN ? 256 : 1024  , PSTEP = DOWN ? 128 : 64;
    LAS int* rowva = (LAS int*)(lds + MOE_LDS_VA); LAS float* roww = (LAS float*)(lds + MOE_LDS_W);
    const int nst = nstl;
    const int nsteps = npass_ * nst * KT; (void)NP;
    unsigned aoff[2];
#define MOE_AOFF(ST_) { _Pragma("unroll") for (int a = 0; a < 2; ++a) { const int va_ = rowva[(ST_) * 512 + wave * 64 + a * 32 + r32]; \
        const int srow_ = DOWN ? va_ : (va_ == TRASH_VA ? 0 : (va_ >> 3)); aoff[a] = (unsigned)srow_ * APITCH + hi * 32; } }
    const int seg = wave >> 1, n4 = lane & 7, kp = (wave & 1) * 16 + (lane >> 3);
    const char* wbase = (const char*)(DOWN ? (w0 + seg * 32) : (((seg < 2) ? w0 : w1) + (seg & 1) * 32));
    unsigned boff = (unsigned)(4 * n4 + 2 * kp * LDB) * 4u; asm volatile("" : "+v"(boff));
    unsigned wb_ = (unsigned)((seg * 32 + n4) * MOE_BP + 2 * kp) * 2u; asm volatile("" : "+v"(wb_));
    unsigned lb_ = (unsigned)(r32 * MOE_BP + hi * 32) * 2u; asm volatile("" : "+v"(lb_));
    f32x16 acc[2][4];
#pragma unroll
    for (int a = 0; a < 2; ++a)
#pragma unroll
        for (int c = 0; c < 4; ++c)
#pragma unroll
            for (int r = 0; r < 16; ++r) acc[a][c][r] = 0.f;
    u32x4 fa8[2][2];
    f32x16 accx; u32x4 fa8x[2]; unsigned aoffx = 0u;
#pragma unroll
    for (int r = 0; r < 16; ++r) accx[r] = 0.f;
    fa8x[0] = u32x4{0u, 0u, 0u, 0u}; fa8x[1] = u32x4{0u, 0u, 0u, 0u};
    f32x4 rb0[4], rb1[4];
#define MOE_DEC(S_) const int s2_ = (S_) < nsteps ? (S_) : 0; const int pl_ = s2_ / (nst * KT); const int rm_ = s2_ - pl_ * (nst * KT); const int sl_ = rm_ / KT; const int kt_ = rm_ - sl_ * KT; const int ps_ = pass0 + pl_; const int stt_ = st0 + sl_;
#define MOE_LOADB(S_, RB) { MOE_DEC(S_) (void)stt_; \
        uint64_t wu_ = (uint64_t)(wbase + (size_t)(ps_ * PSTEP + kt_ * 64 * LDB) * 4), wv_ = wu_ + 16 * LDB * 4; asm volatile("" : "+s"(wu_), "+s"(wv_));     \
        const moe_gcb* wug_ = (const moe_gcb*)wu_; const moe_gcb* wvg_ = (const moe_gcb*)wv_; \
        unsigned bo_ = boff; asm volatile("" : "+v"(bo_));     \
        RB[0] = *(const MOE_GAS f32x4*)(wug_ + bo_); RB[1] = *(const MOE_GAS f32x4*)(wug_ + bo_ + LDB * 4); RB[2] = *(const MOE_GAS f32x4*)(wvg_ + bo_); RB[3] = *(const MOE_GAS f32x4*)(wvg_ + bo_ + LDB * 4); }
#define MOE_WRITEB(STG, RB) { LAS char* Bs_ = lds + (STG) * MOE_BSTAGE; \
        _Pragma("unroll") for (int i = 0; i < 4; ++i) { LAS unsigned* q_ = (LAS unsigned*)(Bs_ + wb_ + i * (8 * MOE_BP * 2)); q_[0] = cvtpk(RB[0][i], RB[1][i]); q_[8] = cvtpk(RB[2][i], RB[3][i]); } }
#define MOE_COMPUTE(STG, DO_MFMA) { LAS char* Bs_ = lds + (STG) * MOE_BSTAGE; \
        _Pragma("unroll") for (int u = 0; u < 4; ++u) { \
            bf16x8 bfr[4]; \
            if (DO_MFMA) { _Pragma("unroll") for (int c = 0; c < 4; ++c) bfr[c] = *(LAS bf16x8*)(Bs_ + lb_ + (c * 32 * MOE_BP + u * 8) * 2); } \
            _Pragma("unroll") for (int a = 0; a < 2; ++a) { \
                if (DO_MFMA) { const bf16x8 af_ = fp8x8_to_bf16(fa8[a][u >> 1][(u & 1) * 2], fa8[a][u >> 1][(u & 1) * 2 + 1]); \
                    _Pragma("unroll") for (int c = 0; c < 4; ++c) acc[a][c] = MFMA_BF16(bfr[c], af_, acc[a][c]); } \
            } \
        } }
      \
#define MOE_RELOAD { _Pragma("unroll") for (int a = 0; a < 2; ++a) { unsigned ao_ = aoff[a]; asm volatile("" : "+v"(ao_)); \
            fa8[a][0] = *(const MOE_GAS u32x4*)(ab_n + ao_); fa8[a][1] = *(const MOE_GAS u32x4*)(ab_n + ao_ + 16); } }
#define MOE_XCOMPUTE(STG) if (!DOWN) { LAS char* Bs_ = lds + (STG) * MOE_BSTAGE; \
        _Pragma("unroll") for (int u = 0; u < 4; ++u) { \
            const bf16x8 ax_ = fp8x8_to_bf16(fa8x[u >> 1][(u & 1) * 2], fa8x[u >> 1][(u & 1) * 2 + 1]); \
            if (u & 1) { unsigned ao_ = aoffx; asm volatile("" : "+v"(ao_)); fa8x[u >> 1] = *(const MOE_GAS u32x4*)(ab_n + ao_ + (u >> 1) * 16); } \
            const bf16x8 bx_ = *(LAS bf16x8*)(Bs_ + (wave & 3) * (32 * MOE_BP * 2) + lb_ + u * 16); \
            accx = MFMA_BF16(bx_, ax_, accx); } }
#define MOE_NEXTA(S_) MOE_DEC(S_) (void)ps_; \
        if (stt_ != st_loaded) { MOE_AOFF(stt_) st_loaded = stt_; } \
        uint64_t abn_ = (uint64_t)abase + kt_ * 64; asm volatile("" : "+s"(abn_)); const moe_gcb* ab_n = (const moe_gcb*)abn_;
    int st_loaded = st0;
    MOE_AOFF(st0)
    { const char* ab0 = (const char*)abase;
#pragma unroll
      for (int a = 0; a < 2; ++a)
#pragma unroll
          for (int h2 = 0; h2 < 2; ++h2) fa8[a][h2] = *(const u32x4*)(ab0 + aoff[a] + h2 * 16); }
    if (!DOWN) {
        const int vax_ = xr ? rowva[512 + 32 * (wave >> 2) + r32] : TRASH_VA; aoffx = (unsigned)(vax_ == TRASH_VA ? 0 : (vax_ >> 3)) * APITCH + hi * 32;
        fa8x[0] = *(const u32x4*)((const char*)abase + aoffx); fa8x[1] = *(const u32x4*)((const char*)abase + aoffx + 16); }
    MOE_LOADB(0, rb0)
    MOE_LOADB(1, rb1)
    MOE_WRITEB(0, rb0)
    MOE_LOADB(2, rb0)
    int stg = 0;
#pragma unroll 1
    for (int sidx = 0; sidx < nsteps; sidx += 2) {
        const int pl = sidx / (nst * KT); const int rm = sidx - pl * (nst * KT); const int sl = rm / KT; const int kt = rm - sl * KT; const int ps = pass0 + pl, stt = st0 + sl;
        const bool wv = (wave * 64) < (ng - stt * 512);
        const int stg1 = stg == 2 ? 0 : stg + 1, stg2 = stg1 == 2 ? 0 : stg1 + 1;
        __syncthreads();
        MOE_WRITEB(stg1, rb1)
        MOE_LOADB(sidx + 3, rb1)
        { MOE_NEXTA(sidx + 1)
          if (wv) MOE_COMPUTE(stg, true)
          MOE_RELOAD
          MOE_XCOMPUTE(stg) }
        __syncthreads();
        MOE_WRITEB(stg2, rb0)
        MOE_LOADB(sidx + 4, rb0)
        { MOE_NEXTA(sidx + 2)
          if (wv) MOE_COMPUTE(stg1, true)
          MOE_RELOAD
          MOE_XCOMPUTE(stg1) }
        stg = stg2;
        if (kt == KT - 2) {
            const int le_ = lane_id_(); const int lane = le_, r32 = le_ & 31, hi = le_ >> 5; (void)lane;
            if (wv) {
                const int nrows = ng - stt * 512;
#pragma unroll
                for (int a = 0; a < 2; ++a) {
                    if (a == 0 || (wave * 64 + 32) < nrows) {
                        const int lrow = stt * 512 + wave * 64 + a * 32 + r32;
                        const unsigned va = (unsigned)rowva[lrow];
                        if (DOWN) {
                            const float w = roww[lrow];
#pragma unroll
                            for (int c = 0; c < 4; ++c) {
                                float yv_[16];
#pragma unroll
                                for (int j = 0; j < 16; ++j) yv_[j] = acc[a][c][(j >> 2) + 4 * (j & 3)] * w;
                                if (y8) {
                                    u32x4 q8;
#pragma unroll
                                    for (int jj = 0; jj < 4; ++jj) q8[jj] = pack_fp8x4(yv_[4 * jj], yv_[4 * jj + 1], yv_[4 * jj + 2], yv_[4 * jj + 3]);
                                    *(u32x4*)((unsigned char*)outv + (size_t)va * D + ps * 128 + c * 32 + 16 * hi) = q8;
                                } else {
                                    u32x4 q0, q1;
#pragma unroll
                                    for (int jj = 0; jj < 4; ++jj) { q0[jj] = cvtpk(yv_[2 * jj], yv_[2 * jj + 1]); q1[jj] = cvtpk(yv_[8 + 2 * jj], yv_[9 + 2 * jj]); }
                                    u16* o = (u16*)outv + (size_t)va * D + ps * 128 + c * 32 + 16 * hi;
                                    *(u32x4*)o = q0; *(u32x4*)(o + 8) = q1;
                                }
                            }
                        } else {
#pragma unroll
                            for (int c = 0; c < 2; ++c) {
                                float hv[16];
#pragma unroll
                                for (int j = 0; j < 16; ++j) { const int r = (j >> 2) + 4 * (j & 3); const float gt = acc[a][c][r], up = acc[a][c + 2][r]; hv[j] = gt / (1.f + __expf(-gt)) * up; }
                                u32x4 q;
#pragma unroll
                                for (int jj = 0; jj < 4; ++jj) q[jj] = pack_fp8x4(hv[4 * jj], hv[4 * jj + 1], hv[4 * jj + 2], hv[4 * jj + 3]);
                                *(u32x4*)((unsigned char*)outv + (size_t)va * DF + ps * 64 + c * 32 + 16 * hi) = q;
                            }
                        }
                    }
                }
#pragma unroll
                for (int a = 0; a < 2; ++a)
#pragma unroll
                    for (int c = 0; c < 4; ++c)
#pragma unroll
                        for (int r = 0; r < 16; ++r) acc[a][c][r] = 0.f;
            }
            if (!DOWN) { if (xr) {
                LAS float* xch = (LAS float*)(lds + MOE_LDS_XCH) + ((wave >> 2) * 2 + (wave & 1)) * 1024 + lane;
                if ((wave & 3) >= 2) {
#pragma unroll
                    for (int r = 0; r < 16; ++r) xch[r * 64] = accx[r];
                }
                __syncthreads();
                if ((wave & 3) < 2) {
                    const unsigned vax = (unsigned)rowva[512 + 32 * (wave >> 2) + r32];
                    u32x4 q;
#pragma unroll
                    for (int jj = 0; jj < 4; ++jj) {
#pragma unroll
                        for (int i = 0; i < 4; ++i) { const int r = jj + 4 * i; const float gt = accx[r]; accx[r] = gt / (1.f + __expf(-gt)) * xch[r * 64]; }
                        q[jj] = pack_fp8x4(accx[jj], accx[jj + 4], accx[jj + 8], accx[jj + 12]);
                    }
                    *(u32x4*)((unsigned char*)outv + (size_t)vax * DF + ps * 64 + (wave & 3) * 32 + 16 * hi) = q;
                }
                }
#pragma unroll
                for (int r = 0; r < 16; ++r) accx[r] = 0.f;
            }
        }
    }
    __syncthreads();
#undef MOE_XCOMPUTE
#undef MOE_AOFF
#undef MOE_DEC
#undef MOE_LOADB
#undef MOE_WRITEB
#undef MOE_COMPUTE
#undef MOE_RELOAD
#undef MOE_NEXTA
}

constexpr int Q8_BP = 144;
constexpr int Q8_BSTAGE = 128 * Q8_BP;
typedef __attribute__((ext_vector_type(8))) int q8_i32x8;
template <int NCH>
__device__ __forceinline__ void qkv8_item(LAS char* lds, const int wave, const unsigned char* __restrict__ a8  , const unsigned char* __restrict__ w8  ,
                                          u16* __restrict__ outp  , const int ldc,
                                          const int rot  ) {
    constexpr int NSTEPS = NCH * 8;
    const int l0 = lane_id_(); const int r32 = l0 & 31, hi = l0 >> 5;
    unsigned aoff[2];
#pragma unroll
    for (int a = 0; a < 2; ++a) { aoff[a] = (unsigned)(wave * 64 + a * 32 + r32) * 1024u + hi * 32; asm volatile("" : "+v"(aoff[a])); }
    const int t_ = wave * 64 + l0, col_ = t_ >> 2, p_ = t_ & 3, kap_ = col_ & 31;
    unsigned boff = (unsigned)col_ * 1024u + p_ * 32; asm volatile("" : "+v"(boff));
    unsigned wb = (unsigned)((col_ & ~31) + (kap_ & 3) * 8 + (kap_ >> 2)) * Q8_BP + p_ * 32; asm volatile("" : "+v"(wb));
    unsigned lb = (unsigned)r32 * Q8_BP + hi * 32; asm volatile("" : "+v"(lb));
    f32x16 acc[2][4];
#pragma unroll
    for (int a = 0; a < 2; ++a)
#pragma unroll
        for (int c = 0; c < 4; ++c)
#pragma unroll
            for (int r = 0; r < 16; ++r) acc[a][c][r] = 0.f;
    u32x4 fa0[2][2][2], fa1[2][2][2];
    u32x4 rb0[2], rb1[2];
#define Q8_LOADA(FA, S_) { const int s2_ = (S_) < NSTEPS ? (S_) : 0; uint64_t ab_ = (uint64_t)a8 + ((s2_ + rot) & 7) * 128; asm volatile("" : "+s"(ab_)); const moe_gcb* ag_ = (const moe_gcb*)ab_; \
        _Pragma("unroll") for (int a = 0; a < 2; ++a) { unsigned ao_ = aoff[a]; asm volatile("" : "+v"(ao_)); \
            _Pragma("unroll") for (int kk = 0; kk < 2; ++kk) { FA[a][kk][0] = *(const MOE_GAS u32x4*)(ag_ + ao_ + kk * 64); FA[a][kk][1] = *(const MOE_GAS u32x4*)(ag_ + ao_ + kk * 64 + 16); } } }
#define Q8_LOADB(RB, S_) { const int s2_ = (S_) < NSTEPS ? (S_) : 0; uint64_t wu_ = (uint64_t)w8 + (size_t)(s2_ >> 3) * 131072 + ((s2_ + rot) & 7) * 128; asm volatile("" : "+s"(wu_)); const moe_gcb* wg_ = (const moe_gcb*)wu_; \
        unsigned bo_ = boff; asm volatile("" : "+v"(bo_)); RB[0] = *(const MOE_GAS u32x4*)(wg_ + bo_); RB[1] = *(const MOE_GAS u32x4*)(wg_ + bo_ + 16); }
#define Q8_WRITEB(STG, RB) { LAS char* Bs_ = lds + (STG) * Q8_BSTAGE + wb; *(LAS u32x4*)Bs_ = RB[0]; *(LAS u32x4*)(Bs_ + 16) = RB[1]; }
#define Q8_CAT8(X0, X1) q8_i32x8{(int)(X0)[0], (int)(X0)[1], (int)(X0)[2], (int)(X0)[3], (int)(X1)[0], (int)(X1)[1], (int)(X1)[2], (int)(X1)[3]}
#define Q8_MFMA(B_, A_, C_) __builtin_amdgcn_mfma_scale_f32_32x32x64_f8f6f4(B_, A_, C_, 0, 0, 0, 0x7F79  , 1, 0x7F79  )
#define Q8_COMPUTE(STG, FA) { LAS char* Bs_ = lds + (STG) * Q8_BSTAGE + lb; \
        _Pragma("unroll") for (int kk = 0; kk < 2; ++kk) { const q8_i32x8 af0_ = Q8_CAT8(FA[0][kk][0], FA[0][kk][1]), af1_ = Q8_CAT8(FA[1][kk][0], FA[1][kk][1]); \
            _Pragma("unroll") for (int c = 0; c < 4; ++c) { const u32x4 b0_ = *(LAS u32x4*)(Bs_ + c * 32 * Q8_BP + kk * 64), b1_ = *(LAS u32x4*)(Bs_ + c * 32 * Q8_BP + kk * 64 + 16); const q8_i32x8 bf_ = Q8_CAT8(b0_, b1_); \
                acc[0][c] = Q8_MFMA(bf_, af0_, acc[0][c]); acc[1][c] = Q8_MFMA(bf_, af1_, acc[1][c]); } } }
    Q8_LOADB(rb0, 0)
    Q8_WRITEB(0, rb0)
    Q8_LOADB(rb1, 1)
    Q8_LOADA(fa0, 0)
    Q8_LOADB(rb0, 2)
    Q8_LOADA(fa1, 1)
    int stg = 0;
#pragma unroll 1
    for (int s = 0; s < NSTEPS; s += 2) {
        const int stg1 = stg == 2 ? 0 : stg + 1, stg2 = stg1 == 2 ? 0 : stg1 + 1;
        __syncthreads();
        Q8_WRITEB(stg1, rb1)
        Q8_LOADB(rb1, s + 3)
        Q8_COMPUTE(stg, fa0)
        Q8_LOADA(fa0, s + 2)
        __syncthreads();
        Q8_WRITEB(stg2, rb0)
        Q8_LOADB(rb0, s + 4)
        Q8_COMPUTE(stg1, fa1)
        Q8_LOADA(fa1, s + 3)
        stg = stg2;
        if ((s & 7) == 6) {
            const int cl = s >> 3;
            const int le_ = lane_id_(); const int r32e = le_ & 31, hie = le_ >> 5;
#pragma unroll
            for (int a = 0; a < 2; ++a) {
                u16* orow = outp + (size_t)(wave * 64 + a * 32 + r32e) * ldc + cl * 128 + 16 * hie;
#pragma unroll
                for (int c = 0; c < 4; ++c) {
                    u32x4 q0, q1;
#pragma unroll
                    for (int jj = 0; jj < 4; ++jj) { q0[jj] = cvtpk(acc[a][c][((2 * jj) >> 2) + 4 * ((2 * jj) & 3)], acc[a][c][((2 * jj + 1) >> 2) + 4 * ((2 * jj + 1) & 3)]);
                                                     q1[jj] = cvtpk(acc[a][c][((8 + 2 * jj) >> 2) + 4 * ((8 + 2 * jj) & 3)], acc[a][c][((9 + 2 * jj) >> 2) + 4 * ((9 + 2 * jj) & 3)]); }
                    *(u32x4*)(orow + c * 32) = q0; *(u32x4*)(orow + c * 32 + 8) = q1;
                }
            }
#pragma unroll
            for (int a = 0; a < 2; ++a)
#pragma unroll
                for (int c = 0; c < 4; ++c)
#pragma unroll
                    for (int r = 0; r < 16; ++r) acc[a][c][r] = 0.f;
        }
    }
    __syncthreads();
#undef Q8_LOADA
#undef Q8_LOADB
#undef Q8_WRITEB
#undef Q8_CAT8
#undef Q8_MFMA
#undef Q8_COMPUTE
}

constexpr int N_PHASES = 21;

#define P_x_in CTX_IN(0)
#define P_xb ((u16*)(ws + WS_XB))
#define P_x1 ((float*)(ws + WS_X1))
#define P_x2 ((float*)(ws + WS_X2))
#define P_ypre ((u16*)(ws + WS_YPRE))
#define P_qkv ((u16*)(ws + WS_QKV))
#define P_vT ((u16*)(ws + WS_VT))
#define P_kmean ((float*)(ws + WS_KM))
#define P_ao ((u16*)(ws + WS_AO))
#define P_og ((u16*)(ws + WS_OG))
#define P_lse ((float*)(ws + WS_LSE))
#define P_topw ((float*)(ws + WS_TOPW))
#define P_list ((int*)(ws + WS_LIST))
#define P_hb ((u16*)(ws + WS_HB))
#define P_yb ((u16*)(ws + WS_YB))
#define P_cnt_all ((int*)(ws + WS_CTL + CTL_ECNT_OFF))
#define P_xb8 ((unsigned char*)(ws + WS_XB8))
#define P_hbs ((u16*)(ws + WS_HBS))
#define P_xq8 ((unsigned char*)(ws + WS_XQ8))
#define P_wq8 ((unsigned char*)(ws + WS_WQ8))
#define P_selm ((unsigned*)(ws + WS_SELM))
#define P_part ((u16*)(ws + WS_PART))
#define P_plse ((float*)(ws + WS_PLSE))
#define PH_BEGIN int tid = wave_s_ * 64 + lane_id_(); asm volatile("" : "+v"(tid)); const int lane = tid & 63, r32 = lane & 31, hi = lane >> 5; const int wave = __builtin_amdgcn_readfirstlane(tid >> 6); (void)lane; (void)r32; (void)hi; (void)wave
constexpr int LDS_CTX = LDS_BAR + 16;
__device__ __forceinline__ uint64_t ctx_ld(int i) {
    extern __shared__ __attribute__((aligned(16))) unsigned char lds_raw[];
    const LAS unsigned* q = (const LAS unsigned*)((LAS char*)lds_raw + LDS_CTX) + 2 * i;
    const unsigned lo = __builtin_amdgcn_readfirstlane(q[0]), hi = __builtin_amdgcn_readfirstlane(q[1]);
    return ((uint64_t)hi << 32) | lo;
}
typedef __attribute__((address_space(1))) unsigned char gbyte;
#define AS_GLOBAL(T, u64v) ((T*)(gbyte*)(u64v))
#define CTX_IN(i) AS_GLOBAL(const float, ctx_ld(i))
#define PH_FN_BEGIN \
    extern __shared__ __attribute__((aligned(16))) unsigned char lds_raw[]; \
    LAS char* lds = (LAS char*)lds_raw; (void)lds; \
    const int G = gridDim.x, bid = blockIdx.x; (void)G; (void)bid; \
    unsigned char* const ws = AS_GLOBAL(unsigned char, ctx_ld(17)); (void)ws; \
    const int NQ = L == 0 ? 3072 : 9216; (void)NQ; \
    int* cnt = P_cnt_all + L * NE * CNT_STRIDE; (void)cnt;
__device__ __forceinline__ void ph_p0(int L, int rep_, const int wave_s_) {
    PH_FN_BEGIN
    (void)rep_;
    PH_BEGIN;
    for (size_t i = (size_t)bid * NTHR + tid; i < (size_t)T * D / 4; i += (size_t)G * NTHR) {
        const f32x4 v = *(const f32x4*)(P_x_in + i * 4);
        u32x2 w; w[0] = cvtpk(v[0], v[1]); w[1] = cvtpk(v[2], v[3]);
        *(u32x2*)(P_xb + i * 4) = w;
#if QKV_FP8
        *(unsigned*)(P_xq8 + i * 4) = pack_fp8x4(v[0], v[1], v[2], v[3]);
#endif
    }
    LAS float* tl = (LAS float*)lds;
    for (int it = bid; it < 3968 + 128; it += G) {
        int seg, kt;
        if (it < 3840) { seg = it >> 4; kt = it & 15; } else if (it < 3968) { seg = 240 + ((it - 3840) >> 2); kt = (it - 3840) & 3; } else { seg = 272 + ((it - 3968) >> 4); kt = (it - 3968) & 15; }
        const float* src; int ld; u16* dst; int Kd = 1024; u16* dst_lo = nullptr; int rcol = 0; unsigned char* dst8 = nullptr;
        if (seg < 48) { const int col = 64 * seg; src = CTX_IN(1) + col; ld = 3072; dst = (u16*)(ws + WS_WQK0) + (size_t)col * 1024; if (QKV_FP8) dst8 = P_wq8 + (size_t)col * 1024; }
        else if (seg < 192) { const int col = 64 * (seg - 48); src = CTX_IN(2) + col; ld = 9216; dst = (u16*)(ws + WS_WQK1) + (size_t)col * 1024; if (QKV_FP8) dst8 = P_wq8 + (size_t)(3072 + col) * 1024; }
        else if (seg < 224) { const int s2 = seg - 192, l2 = s2 >> 4, col = 64 * (s2 & 15); src = CTX_IN(3) + (size_t)l2 * D * D + col; ld = 1024; dst = (u16*)(ws + WS_WO) + (size_t)l2 * D * D + (size_t)col * 1024; }
        else if (seg < 240) { const int s2 = seg - 224, l2 = s2 >> 3, i8 = s2 & 7, un = i8 >> 2, q = i8 & 3;
            src = (q < 2 ? CTX_IN(11) : CTX_IN(12)) + (size_t)l2 * D * DF + un * 128 + 64 * (q & 1); ld = 256; dst = (u16*)(ws + WS_WSGU) + (size_t)l2 * 512 * 1024 + (size_t)(64 * i8) * 1024; }
        else if (seg < 272) { const int s2 = seg - 240, l2 = s2 >> 4, col = 64 * (s2 & 15); src = CTX_IN(13) + (size_t)l2 * DF * D + col; ld = 1024; Kd = 256; dst = (u16*)(ws + WS_WSD) + (size_t)l2 * D * DF + (size_t)col * 256; }
        else { const int s2 = seg - 272, l2 = s2 >> 2, col = 64 * (s2 & 3); src = CTX_IN(6) + (size_t)l2 * D * NE + col; ld = 256; rcol = col; dst = (u16*)(ws + WS_WRH) + (size_t)l2 * NE * D; dst_lo = (u16*)(ws + WS_WRL) + (size_t)l2 * NE * D; }
        {
            const int kr = tid >> 4, c4 = tid & 15;
#pragma unroll
            for (int i = 0; i < 2; ++i) {
                const f32x4 v = *(const f32x4*)(src + (size_t)(kt * 64 + kr + 32 * i) * ld + 4 * c4);
#pragma unroll
                for (int jj = 0; jj < 4; ++jj) tl[(kr + 32 * i) * 65 + 4 * c4 + jj] = v[jj];
            }
        }
        __syncthreads();
        {
            const int row = tid >> 3, kc = tid & 7;
            float f[8];
#pragma unroll
            for (int jj = 0; jj < 8; ++jj) f[jj] = tl[(8 * kc + jj) * 65 + row];
            u32x4 w; w[0] = cvtpk(f[0], f[1]); w[1] = cvtpk(f[2], f[3]); w[2] = cvtpk(f[4], f[5]); w[3] = cvtpk(f[6], f[7]);
            if (dst_lo) {
                u32x4 wl;
#pragma unroll
                for (int jj = 0; jj < 4; ++jj) wl[jj] = cvtpk(f[2 * jj] - bf2f(w[jj] & 0xFFFFu), f[2 * jj + 1] - bf2f(w[jj] >> 16));
                const int E_ = rcol + row;
                const size_t fi = ((size_t)(((E_ >> 5) * 16 + kt) * 4 + (kc >> 1)) * 64 + (kc & 1) * 32 + (E_ & 31)) * 8;
                *(u32x4*)(dst + fi) = w; *(u32x4*)(dst_lo + fi) = wl;
            } else if (dst8) {
                u32x2 w8; w8[0] = pack_fp8x4(f[0] * 64.f, f[1] * 64.f, f[2] * 64.f, f[3] * 64.f); w8[1] = pack_fp8x4(f[4] * 64.f, f[5] * 64.f, f[6] * 64.f, f[7] * 64.f);
                *(u32x2*)(dst8 + (size_t)row * 1024 + kt * 64 + 8 * kc) = w8;
            } else *(u32x4*)(dst + (size_t)row * Kd + kt * 64 + 8 * kc) = w;
        }
        __syncthreads();
    }
}

__device__ __forceinline__ void ph_qkv(int L, int rep_, const int wave_s_) {
    PH_FN_BEGIN
    (void)rep_;
#if QKV_FP8 == 2
    const pg8::Gemm g{(const u16*)P_xq8, (const u16*)(P_wq8 + (L == 0 ? (size_t)0 : (size_t)3072 * 1024)), T, NQ, D / 2};
    pg8::StaticOrder S; S.init(g.M, g.N, G, bid);
    const EpiQK E{P_qkv, NQ};
    pg8::gemm_phase<EpiQK, pg8::StaticOrder, false, false, true>((PG8_LAS unsigned char*)lds, g, S, E, nullptr, wave_s_ * 64 + lane_id_());
#elif QKV_FP8
    PH_BEGIN;
    const int nchunk = NQ / 384, nq = 4 * nchunk;
    const unsigned char* w8 = P_wq8 + (L == 0 ? (size_t)0 : (size_t)3072 * 1024);
    int* xq = (int*)(ws + WS_CTL + CTL_XQ_OFF) + (L * 2 + (rep_ & 1)) * 8 * 64;
    LAS int* slot = (LAS int*)(lds + 140000);
    const int xme = (int)(xb_xcc_id() & 7u);
    unsigned qdone = 0u;
    for (;;) {
        __syncthreads();
        if (tid == 0) {
            int item = -1;
            for (int k = 0; k < 8 && item < 0; ++k) {
                const int xx = (xme + k) & 7;
                if (qdone >> xx & 1u) continue;
                const int q = atomicAdd(&xq[xx * 64], 1);
                if (q < nq) item = (xx + 8 * (q / nchunk)) * nchunk + (q % nchunk); else qdone |= 1u << xx;
            }
            *slot = item;
        }
        __syncthreads();
        const int item = *slot;
        if (item < 0) break;
        const int rt = item / nchunk, ch = item - rt * nchunk;
        qkv8_item<3>(lds, wave, P_xq8 + (size_t)rt * 512 * 1024, w8 + (size_t)ch * 384 * 1024, P_qkv + (size_t)rt * 512 * NQ + ch * 384, NQ, item & 7);
    }
#else
    const pg8::Gemm g{P_xb, (const u16*)(ws + (L == 0 ? WS_WQK0 : WS_WQK1)), T, NQ, D};
    pg8::StaticOrder S; S.init(g.M, g.N, G, bid);
    const EpiQK E{P_qkv, NQ};
    pg8::gemm_phase<EpiQK, pg8::StaticOrder, false>((PG8_LAS unsigned char*)lds, g, S, E, nullptr, wave_s_ * 64 + lane_id_());
#endif
}

__device__ __forceinline__ void ph_kmean(int L, int rep_, const int wave_s_) {
    PH_FN_BEGIN
    (void)rep_;
    PH_BEGIN;
    LAS float* red = (LAS float*)lds;
    for (int it = bid; it < BATCH * NH * MOBA_NB; it += G) {
        const int j = it & 31, h = (it >> 5) & 15, b = it >> 9;
        const int kg_ = tid >> 3, ch = tid & 7;
        const u16* kp = P_qkv + (size_t)(b * SEQ + j * MOBA_BLK + kg_) * 3072 + 1024 + h * 64 + ch * 8;
        float sm[8];
#pragma unroll
        for (int e2 = 0; e2 < 8; ++e2) sm[e2] = 0.f;
#pragma unroll
        for (int i = 0; i < 4; ++i) {
            const u32x4 v = *(const u32x4*)(kp + (size_t)(64 * i) * 3072);
#pragma unroll
            for (int e2 = 0; e2 < 4; ++e2) { sm[2 * e2] += bf2f(v[e2] & 0xFFFFu); sm[2 * e2 + 1] += bf2f(v[e2] >> 16); }
        }
#pragma unroll
        for (int e2 = 0; e2 < 8; ++e2) red[kg_ * 65 + ch * 8 + e2] = sm[e2];
        __syncthreads();
        if (tid < 64) {
            float tot = 0.f;
#pragma unroll 8
            for (int q = 0; q < 64; ++q) tot += red[q * 65 + tid];
            P_kmean[(size_t)it * 64 + tid] = tot * (1.f / MOBA_BLK);
        }
        __syncthreads();
    }
}

__device__ __forceinline__ void ph_gate(int L, int rep_, const int wave_s_) {
    PH_FN_BEGIN
    (void)rep_;
    PH_BEGIN;
    for (int it = bid; it < BATCH * NH * MOBA_NB; it += G) {
        const int qb = it & 31, bh = it >> 5, b = bh >> 4, h = bh & 15;
        const int tq = qb * MOBA_BLK + wave * 32 + r32;
        const u16* qrow = P_qkv + (size_t)(b * SEQ + tq) * 3072 + h * 64 + hi * 8;
        bf16x8 qf[4];
#pragma unroll
        for (int d0 = 0; d0 < 4; ++d0) qf[d0] = *(const bf16x8*)(qrow + d0 * 16);
        unsigned selmask = 0u;
        if (qb > 0) {
            const float* km = P_kmean + ((size_t)(b * NH + h) * MOBA_NB + r32) * 64 + hi * 8;
            f32x16 gt;
#pragma unroll
            for (int r = 0; r < 16; ++r) gt[r] = 0.f;
#pragma unroll
            for (int d0 = 0; d0 < 4; ++d0) {
                const f32x4 k0 = *(const f32x4*)(km + d0 * 16), k1 = *(const f32x4*)(km + d0 * 16 + 4);
                union { bf16x8 v; unsigned u[4]; } kf;
                kf.u[0] = cvtpk(k0[0], k0[1]); kf.u[1] = cvtpk(k0[2], k0[3]); kf.u[2] = cvtpk(k1[0], k1[1]); kf.u[3] = cvtpk(k1[2], k1[3]);
                gt = MFMA_BF16(kf.v, qf[d0], gt);
            }
            float v0 = -INFINITY, v1 = -INFINITY, v2 = -INFINITY; int i0 = 99, i1 = 99, i2 = 99;
#pragma unroll
            for (int r = 0; r < 16; ++r) { const int jb = crow(r, hi); const float gv = jb < qb ? gt[r] : -INFINITY; top3_insert(gv, jb < qb ? jb : 99, v0, i0, v1, i1, v2, i2); }
            const float ov0 = shxf(v0, 32, lane), ov1 = shxf(v1, 32, lane), ov2 = shxf(v2, 32, lane);
            const int oi0 = shxi(i0, 32, lane), oi1 = shxi(i1, 32, lane), oi2 = shxi(i2, 32, lane);
            top3_insert(ov0, oi0, v0, i0, v1, i1, v2, i2); top3_insert(ov1, oi1, v0, i0, v1, i1, v2, i2); top3_insert(ov2, oi2, v0, i0, v1, i1, v2, i2);
            if (i0 < 32) selmask |= 1u << i0;
            if (i1 < 32) selmask |= 1u << i1;
            if (i2 < 32) selmask |= 1u << i2;
        }
        if (hi == 0) P_selm[(size_t)bh * SEQ + tq] = selmask;
    }
}

constexpr int MB_KP = 72;
constexpr int MB_VP = 260;
constexpr int MB_LDS_K = 0;
constexpr int MB_LDS_V = 256 * MB_KP * 2;
constexpr int MB_LDS_LIST = MB_LDS_V + 64 * MB_VP * 2;
constexpr int MB_LDS_CTR = MB_LDS_LIST + 8192 * 2;
__device__ __forceinline__ void ph_moba(int L, int rep_, const int wave_s_) {
    PH_FN_BEGIN
    (void)rep_;
    PH_BEGIN;
    LAS char* Ks = lds + MB_LDS_K; LAS char* Vs = lds + MB_LDS_V;
    LAS u16* qlist = (LAS u16*)(lds + MB_LDS_LIST); LAS int* ctr = (LAS int*)(lds + MB_LDS_CTR);
    for (int it = bid; it < BATCH * NH * MOBA_NB; it += G) {
        const int rnd = it >> 8, w8 = it & 255, a8 = w8 >> 5, bh = w8 & 31;
        const int j = rnd == 0 ? a8 : (rnd == 1 ? 15 - a8 : (rnd == 2 ? 16 + a8 : 31 - a8));
        const int b = bh >> 4, h = bh & 15;
        const float slope2 = exp2f(-0.5f * (float)(h + 1)) * LOG2E;
        if (tid == 0) { int z0 = 0; asm volatile("" : "+v"(z0)); ctr[0] = z0; ctr[1] = z0; }
        {
            const u16* kg = P_qkv + (size_t)(b * SEQ + j * MOBA_BLK) * 3072 + 1024 + h * 64;
#pragma unroll
            for (int i = 0; i < 4; ++i) { const int c = tid + i * 512, row = c >> 3, ch = c & 7; *(LAS u32x4*)(Ks + (row * MB_KP + ch * 8) * 2) = *(const u32x4*)(kg + (size_t)row * 3072 + ch * 8); }
            const u16* vg = P_qkv + (size_t)(b * SEQ + j * MOBA_BLK) * 3072 + 2048 + h * 64;
#pragma unroll
            for (int i = 0; i < 4; ++i) {
                const int c = tid + i * 512, key = c >> 3, ch = c & 7;
                const u32x4 v = *(const u32x4*)(vg + (size_t)key * 3072 + ch * 8);
#pragma unroll
                for (int e2 = 0; e2 < 4; ++e2) {
                    *(LAS u16*)(Vs + ((ch * 8 + 2 * e2) * MB_VP + key) * 2) = (u16)(v[e2] & 0xFFFFu);
                    *(LAS u16*)(Vs + ((ch * 8 + 2 * e2 + 1) * MB_VP + key) * 2) = (u16)(v[e2] >> 16);
                }
            }
        }
        __syncthreads();
        {
            const unsigned* sm = P_selm + (size_t)bh * SEQ;
            for (int t0 = (j + 1) * MOBA_BLK; t0 < SEQ; t0 += 512) {
                const int t = t0 + tid;
                const bool sel = (t < SEQ) && ((sm[t < SEQ ? t : 0] >> j) & 1u);
                const unsigned long long bal = __ballot(sel);
                const int total = __popcll(bal);
                int wb = 0;
                if (lane == 0 && total) wb = atomicAdd((int*)&ctr[0], total);
                wb = __builtin_amdgcn_readfirstlane(wb);
                if (sel) qlist[wb + __popcll(bal & ((1ull << lane) - 1ull))] = (u16)t;
            }
        }
        __syncthreads();
        const int nq = ctr[0];
        const int ntiles = 8 + ((nq + 31) >> 5);
        for (;;) {
            int ti = 0;
            if (lane == 0) ti = atomicAdd((int*)&ctr[1], 1);
            ti = __builtin_amdgcn_readfirstlane(ti);
            if (ti >= ntiles) break;
            const bool own = ti < 8;
            const int wq = 7 - ti;
            const int li = (ti - 8) * 32 + r32;
            const bool valid = own || li < nq;
            const int tq = own ? j * MOBA_BLK + wq * 32 + r32 : (int)qlist[li < nq ? li : nq - 1];
            const int nsteps = own ? wq + 1 : 8;
            const u16* qrow = P_qkv + (size_t)(b * SEQ + tq) * 3072 + h * 64 + hi * 8;
            bf16x8 qf[4];
#pragma unroll
            for (int d0 = 0; d0 < 4; ++d0) qf[d0] = *(const bf16x8*)(qrow + d0 * 16);
            int slot = 3;
            if (!own) slot = __popc(P_selm[(size_t)bh * SEQ + tq] & ((1u << j) - 1u));
            AttnSt st; st.m = NEGV; st.l = 0.f;
#pragma unroll
            for (int r = 0; r < 16; ++r) { st.o0[r] = 0.f; st.o1[r] = 0.f; }
            const int dlo = own ? 0 : -0x40000000;
            for (int kt = 0; kt < nsteps; ++kt) {
                AttnFr f;
#pragma unroll
                for (int d0 = 0; d0 < 4; ++d0) f.k[d0] = *(LAS bf16x8*)(Ks + ((kt * 32 + r32) * MB_KP + d0 * 16 + hi * 8) * 2);
#pragma unroll
                for (int q4 = 0; q4 < 4; ++q4) {
                    union { bf16x8 v; u32x2 hh[2]; } va;
                    LAS char* vp = Vs + (((q4 >> 1) * 32 + r32) * MB_VP + kt * 32 + (q4 & 1) * 16 + 4 * hi) * 2;
                    va.hh[0] = *(LAS u32x2*)(vp); va.hh[1] = *(LAS u32x2*)(vp + 16);
                    f.v[q4] = va.v;
                }
                attn_compute(st, qf, f, tq - (j * MOBA_BLK + kt * 32) - 4 * hi, slope2, dlo, 0x7fffffff, hi, lane);
            }
            const float lt = st.l + shxf(st.l, 32, lane);
            const float inv = 1.f / lt;
            if (valid) {
                const size_t pi = ((size_t)(b * SEQ + tq) * NH + h) * 4 + slot;
                u16* orow = P_part + pi * 64;
#pragma unroll
                for (int rq = 0; rq < 4; ++rq) {
                    u32x2 w; w[0] = cvtpk(st.o0[4 * rq] * inv, st.o0[4 * rq + 1] * inv); w[1] = cvtpk(st.o0[4 * rq + 2] * inv, st.o0[4 * rq + 3] * inv);
                    *(u32x2*)(orow + 8 * rq + 4 * hi) = w;
                    w[0] = cvtpk(st.o1[4 * rq] * inv, st.o1[4 * rq + 1] * inv); w[1] = cvtpk(st.o1[4 * rq + 2] * inv, st.o1[4 * rq + 3] * inv);
                    *(u32x2*)(orow + 32 + 8 * rq + 4 * hi) = w;
                }
                if (hi == 0) P_plse[pi] = st.m * LN2 + logf(lt);
            }
        }
        __syncthreads();
    }
}

__device__ __forceinline__ void ph_mobamerge(int L, int rep_, const int wave_s_) {
    PH_FN_BEGIN
    (void)rep_;
    PH_BEGIN;
    for (size_t i = (size_t)bid * NTHR + tid; i < (size_t)T * NH * 8; i += (size_t)G * NTHR) {
        const size_t row = i >> 7; const int h = (int)(i >> 3) & 15, d8 = (int)i & 7;
        const int qb = (int)(row & (SEQ - 1)) >> 8;
        const int nsel = qb < 3 ? qb : 3;
        const size_t pi = (row * NH + h) * 4;
        float l[4], w[4];
        float mx = -INFINITY;
#pragma unroll
        for (int sidx = 0; sidx < 4; ++sidx) { const bool ok = sidx == 3 || sidx < nsel; l[sidx] = ok ? P_plse[pi + sidx] : -INFINITY; mx = fmaxf(mx, l[sidx]); }
        float ws_ = 0.f;
#pragma unroll
        for (int sidx = 0; sidx < 4; ++sidx) { w[sidx] = (sidx == 3 || sidx < nsel) ? expf(l[sidx] - mx) : 0.f; ws_ += w[sidx]; }
        const float inv = 1.f / ws_;
        float acc8[8];
#pragma unroll
        for (int c = 0; c < 8; ++c) acc8[c] = 0.f;
#pragma unroll
        for (int sidx = 0; sidx < 4; ++sidx) {
            if (sidx == 3 || sidx < nsel) {
                const u32x4 a = *(const u32x4*)(P_part + (pi + sidx) * 64 + d8 * 8);
                const float ww = w[sidx] * inv;
#pragma unroll
                for (int c = 0; c < 4; ++c) { acc8[2 * c] += ww * bf2f(a[c] & 0xFFFFu); acc8[2 * c + 1] += ww * bf2f(a[c] >> 16); }
            }
        }
        u32x4 o;
#pragma unroll
        for (int c = 0; c < 4; ++c) o[c] = cvtpk(acc8[2 * c], acc8[2 * c + 1]);
        *(u32x4*)(P_ao + row * D + h * 64 + d8 * 8) = o;
    }
}

constexpr int DL_KP = 72, DL_VP = 388;
constexpr int DL_LDS_K = 0, DL_LDS_V = 384 * DL_KP * 2;
__device__ __forceinline__ void ph_dil(int L, int rep_, const int wave_s_) {
    PH_FN_BEGIN
    (void)rep_;
    PH_BEGIN;
    LAS char* Ks = lds + DL_LDS_K; LAS char* Vs = lds + DL_LDS_V;
    for (int it = bid; it < BATCH * NH * 3 * 32; it += G) {
        const int ch = it & 31, grp = (it >> 5) % 3, bh = it / 96, b = bh >> 4, h = bh & 15;
        const int dil = grp == 0 ? 1 : (grp == 1 ? 4 : 16), Ls = SEQ / dil;
        const float slope2 = exp2f(-0.5f * (float)(h + 1)) * LOG2E * (float)dil;
        const int uc = ch * 256, res = uc / Ls, c0 = uc - res * Ls;
        const int kb0 = c0 - 128;
        {
            const u16* kg = P_qkv + (size_t)(b * SEQ) * 9216 + grp * 3072 + 1024 + h * 64;
#pragma unroll
            for (int i = 0; i < 6; ++i) {
                const int c = tid + i * 512, row = c >> 3, chk = c & 7, ks = kb0 + row;
                if (ks >= 0) *(LAS u32x4*)(Ks + (row * DL_KP + chk * 8) * 2) = *(const u32x4*)(kg + (size_t)(ks * dil + res) * 9216 + chk * 8);
            }
            const u16* vg = P_qkv + (size_t)(b * SEQ) * 9216 + grp * 3072 + 2048 + h * 64;
#pragma unroll
            for (int i = 0; i < 6; ++i) {
                const int c = tid + i * 512, row = c >> 3, chk = c & 7, ks = kb0 + row;
                if (ks >= 0) {
                    const u32x4 v = *(const u32x4*)(vg + (size_t)(ks * dil + res) * 9216 + chk * 8);
#pragma unroll
                    for (int e2 = 0; e2 < 4; ++e2) {
                        *(LAS u16*)(Vs + ((chk * 8 + 2 * e2) * DL_VP + row) * 2) = (u16)(v[e2] & 0xFFFFu);
                        *(LAS u16*)(Vs + ((chk * 8 + 2 * e2 + 1) * DL_VP + row) * 2) = (u16)(v[e2] >> 16);
                    }
                }
            }
        }
        const int i0 = c0 + wave * 32, iq = i0 + r32, pq = iq * dil + res;
        const u16* qrow = P_qkv + (size_t)(b * SEQ + pq) * 9216 + grp * 3072 + h * 64 + hi * 8;
        bf16x8 qf[4];
#pragma unroll
        for (int d0 = 0; d0 < 4; ++d0) qf[d0] = *(const bf16x8*)(qrow + d0 * 16);
        __syncthreads();
        AttnSt st; st.m = NEGV; st.l = 0.f;
#pragma unroll
        for (int r = 0; r < 16; ++r) { st.o0[r] = 0.f; st.o1[r] = 0.f; }
        const int ktmin = (i0 >= 128) ? 0 : (128 - i0) >> 5;
        for (int kt = 4; kt >= ktmin; --kt) {
            const int lrow0 = (wave + kt) * 32;
            AttnFr f;
#pragma unroll
            for (int d0 = 0; d0 < 4; ++d0) f.k[d0] = *(LAS bf16x8*)(Ks + ((lrow0 + r32) * DL_KP + d0 * 16 + hi * 8) * 2);
#pragma unroll
            for (int q4 = 0; q4 < 4; ++q4) {
                union { bf16x8 v; u32x2 hh[2]; } va;
                LAS char* vp = Vs + (((q4 >> 1) * 32 + r32) * DL_VP + lrow0 + (q4 & 1) * 16 + 4 * hi) * 2;
                va.hh[0] = *(LAS u32x2*)(vp); va.hh[1] = *(LAS u32x2*)(vp + 16);
                f.v[q4] = va.v;
            }
            const int k0 = i0 - 128 + kt * 32;
            attn_compute(st, qf, f, iq - k0 - 4 * hi, slope2, 0, 128, hi, lane);
        }
        const float lt = st.l + shxf(st.l, 32, lane);
        const float inv = 1.f / lt;
        u16* orow = P_og + (size_t)grp * T * D + (size_t)(b * SEQ + pq) * D + h * 64;
#pragma unroll
        for (int rq = 0; rq < 4; ++rq) {
            u32x2 w; w[0] = cvtpk(st.o0[4 * rq] * inv, st.o0[4 * rq + 1] * inv); w[1] = cvtpk(st.o0[4 * rq + 2] * inv, st.o0[4 * rq + 3] * inv);
            *(u32x2*)(orow + 8 * rq + 4 * hi) = w;
            w[0] = cvtpk(st.o1[4 * rq] * inv, st.o1[4 * rq + 1] * inv); w[1] = cvtpk(st.o1[4 * rq + 2] * inv, st.o1[4 * rq + 3] * inv);
            *(u32x2*)(orow + 32 + 8 * rq + 4 * hi) = w;
        }
        if (hi == 0) P_lse[((size_t)grp * T + (b * SEQ + pq)) * NH + h] = st.m * LN2 + logf(lt);
        __syncthreads();
    }
}

__device__ __forceinline__ void ph_merge(int L, int rep_, const int wave_s_) {
    PH_FN_BEGIN
    (void)rep_;

            PH_BEGIN;
                for (size_t i = (size_t)bid * NTHR + tid; i < (size_t)T * NH * 8; i += (size_t)G * NTHR) {
                    const size_t row = i >> 7; const int h = (int)(i >> 3) & 15, d8 = (int)i & 7;
                    const float l0 = P_lse[(0 * (size_t)T + row) * NH + h], l1 = P_lse[(1 * (size_t)T + row) * NH + h], l2 = P_lse[(2 * (size_t)T + row) * NH + h];
                    const float mx = fmaxf(l0, fmaxf(l1, l2));
                    float w0 = expf(l0 - mx), w1 = expf(l1 - mx), w2 = expf(l2 - mx);
                    const float inv = 1.f / (w0 + w1 + w2); w0 *= inv; w1 *= inv; w2 *= inv;
                    const size_t off = row * D + h * 64 + d8 * 8;
                    const u32x4 a0 = *(const u32x4*)(P_og + off), a1 = *(const u32x4*)(P_og + (size_t)T * D + off), a2 = *(const u32x4*)(P_og + 2 * (size_t)T * D + off);
                    u32x4 o;
#pragma unroll
                    for (int c = 0; c < 4; ++c) {
                        const float lo_ = w0 * bf2f(a0[c] & 0xFFFFu) + w1 * bf2f(a1[c] & 0xFFFFu) + w2 * bf2f(a2[c] & 0xFFFFu);
                        const float hi_ = w0 * bf2f(a0[c] >> 16) + w1 * bf2f(a1[c] >> 16) + w2 * bf2f(a2[c] >> 16);
                        o[c] = cvtpk(lo_, hi_);
                    }
                    *(u32x4*)(P_ao + off) = o;
                }

}

__device__ __forceinline__ void ph_wo(int L, int rep_, const int wave_s_) {
    PH_FN_BEGIN
    (void)rep_;
    const pg8::Gemm g{P_ao, (const u16*)(ws + WS_WO) + (size_t)L * D * D, T, D, D};
    pg8::StaticOrder S; S.init(g.M, g.N, G, bid);
    const EpiWo E{P_ypre, P_xb};
    pg8::gemm_phase<EpiWo, pg8::StaticOrder, false>((PG8_LAS unsigned char*)lds, g, S, E, nullptr, wave_s_ * 64 + lane_id_());
}

constexpr int RT_P = 144;
constexpr int RT_ASTAGE = 2 * 64 * 144;
constexpr int RT_LDS_AH = 0, RT_LDS_AL = 64 * RT_P;
constexpr int RT_LDS_BH = 2 * 64 * RT_P, RT_LDS_BL = RT_LDS_BH + 256 * RT_P;
constexpr int RT_LDS_ST = RT_LDS_BL + 256 * RT_P;
__device__ __forceinline__ void ph_router(int L, int rep_, const int wave_s_) {
    PH_FN_BEGIN
    (void)rep_;
    PH_BEGIN;
    const float* lng = CTX_IN(4) + L * D; const float* lnb = CTX_IN(5) + L * D;
    const float* rbias = CTX_IN(7) + L * NE;
    const u16* wrh = (const u16*)(ws + WS_WRH) + (size_t)L * NE * D; const u16* wrl = (const u16*)(ws + WS_WRL) + (size_t)L * NE * D;
    LAS float* stat = (LAS float*)(lds + RT_LDS_ST);
    for (int it = bid; it < T / 64; it += G) {
#pragma unroll 1
        for (int hb_ = 0; hb_ < 2; ++hb_) {
            u32x4 yv[4][2];
#pragma unroll
            for (int rr = 0; rr < 4; ++rr)
#pragma unroll
                for (int j = 0; j < 2; ++j) yv[rr][j] = *(const u32x4*)(P_ypre + ((size_t)it * 64 + wave * 8 + hb_ * 4 + rr) * D + j * 512 + lane * 8);
#pragma unroll
            for (int rr = 0; rr < 4; ++rr) {
                float sm = 0.f;
#pragma unroll
                for (int j = 0; j < 2; ++j)
#pragma unroll
                    for (int c = 0; c < 4; ++c) sm += bf2f(yv[rr][j][c] & 0xFFFFu) + bf2f(yv[rr][j][c] >> 16);
                const float mu = wave_sum(sm) * (1.f / D);
                float q = 0.f;
#pragma unroll
                for (int j = 0; j < 2; ++j)
#pragma unroll
                    for (int c = 0; c < 4; ++c) { const float d0_ = bf2f(yv[rr][j][c] & 0xFFFFu) - mu, d1_ = bf2f(yv[rr][j][c] >> 16) - mu; q += d0_ * d0_ + d1_ * d1_; }
                const float rstd = rsqrtf(wave_sum(q) * (1.f / D) + LN_EPS);
                if (lane == 0) { stat[wave * 8 + hb_ * 4 + rr] = mu; stat[64 + wave * 8 + hb_ * 4 + rr] = rstd; }
            }
        }
        __syncthreads();
        const int arow = tid >> 3, aq = tid & 7;
        const float amu = stat[arow], ars = stat[64 + arow];
        const u16* yp = P_ypre + ((size_t)it * 64 + arow) * D + aq * 8;
        u32x4 ya = *(const u32x4*)(yp);
        u32x4 bw[8], bx[8];
        const u16* wfh = wrh + (size_t)wave * 16 * 4 * 64 * 8 + lane * 8; const u16* wfl = wrl + (size_t)wave * 16 * 4 * 64 * 8 + lane * 8;
#define RT_LOADB(BW, KC_) { _Pragma("unroll") for (int sk = 0; sk < 4; ++sk) { BW[sk] = *(const u32x4*)(wfh + ((KC_) * 4 + sk) * 512); BW[4 + sk] = *(const u32x4*)(wfl + ((KC_) * 4 + sk) * 512); } }
        RT_LOADB(bw, 0)
        RT_LOADB(bx, 1)
        f32x16 lg[2];
#pragma unroll
        for (int r = 0; r < 16; ++r) { lg[0][r] = 0.f; lg[1][r] = 0.f; }
#define RT_WRITEA(KC_) { const int k0 = (KC_) * 64; \
            const f32x4 g0 = *(const f32x4*)(lng + k0 + aq * 8), g1 = *(const f32x4*)(lng + k0 + aq * 8 + 4); \
            const f32x4 b0 = *(const f32x4*)(lnb + k0 + aq * 8), b1 = *(const f32x4*)(lnb + k0 + aq * 8 + 4); \
            f32x4 x0, x1v; \
            _Pragma("unroll") for (int c = 0; c < 4; ++c) { const float y0_ = bf2f(c & 1 ? ya[c >> 1] >> 16 : ya[c >> 1] & 0xFFFFu), y1_ = bf2f(c & 1 ? ya[2 + (c >> 1)] >> 16 : ya[2 + (c >> 1)] & 0xFFFFu); \
                x0[c] = (y0_ - amu) * ars * g0[c] + b0[c]; x1v[c] = (y1_ - amu) * ars * g1[c] + b1[c]; } \
            ya = *(const u32x4*)(yp + (((KC_) + 1 < 16) ? k0 + 64 : 0)); \
            const size_t go = ((size_t)it * 64 + arow) * D + k0 + aq * 8; \
            u32x4 wh; wh[0] = cvtpk(x0[0], x0[1]); wh[1] = cvtpk(x0[2], x0[3]); wh[2] = cvtpk(x1v[0], x1v[1]); wh[3] = cvtpk(x1v[2], x1v[3]); \
            *(u32x4*)(P_xb + go) = wh; \
            u32x2 w8; w8[0] = pack_fp8x4(x0[0], x0[1], x0[2], x0[3]); w8[1] = pack_fp8x4(x1v[0], x1v[1], x1v[2], x1v[3]); \
            *(u32x2*)(P_xb8 + go) = w8; \
            u32x4 wl; \
            wl[0] = cvtpk(x0[0] - bf2f(wh[0] & 0xFFFFu), x0[1] - bf2f(wh[0] >> 16)); wl[1] = cvtpk(x0[2] - bf2f(wh[1] & 0xFFFFu), x0[3] - bf2f(wh[1] >> 16)); \
            wl[2] = cvtpk(x1v[0] - bf2f(wh[2] & 0xFFFFu), x1v[1] - bf2f(wh[2] >> 16)); wl[3] = cvtpk(x1v[2] - bf2f(wh[3] & 0xFFFFu), x1v[3] - bf2f(wh[3] >> 16)); \
            *(LAS u32x4*)(lds + ((KC_) & 1) * RT_ASTAGE + RT_LDS_AH + arow * RT_P + aq * 16) = wh; \
            *(LAS u32x4*)(lds + ((KC_) & 1) * RT_ASTAGE + RT_LDS_AL + arow * RT_P + aq * 16) = wl; }
#define RT_CHUNK(KC_, BW) { __syncthreads(); \
            _Pragma("unroll") for (int sk = 0; sk < 4; ++sk) { \
                const int ko = (sk * 16 + hi * 8) * 2; \
                const bf16x8 bh_ = __builtin_bit_cast(bf16x8, BW[sk]), bl_ = __builtin_bit_cast(bf16x8, BW[4 + sk]); \
                _Pragma("unroll") for (int rb = 0; rb < 2; ++rb) { \
                    const bf16x8 xh = *(const LAS bf16x8*)(lds + ((KC_) & 1) * RT_ASTAGE + RT_LDS_AH + (rb * 32 + r32) * RT_P + ko), xl = *(const LAS bf16x8*)(lds + ((KC_) & 1) * RT_ASTAGE + RT_LDS_AL + (rb * 32 + r32) * RT_P + ko); \
                    lg[rb] = MFMA_BF16(xh, bh_, lg[rb]); lg[rb] = MFMA_BF16(xl, bh_, lg[rb]); lg[rb] = MFMA_BF16(xh, bl_, lg[rb]); \
                } \
            } \
            if ((KC_) + 1 < 16) RT_WRITEA((KC_) + 1) \
            { const int kn_ = ((KC_) + 2 < 16) ? (KC_) + 2 : ((KC_) & 1); RT_LOADB(BW, kn_) } }
        RT_WRITEA(0)
#pragma unroll 1
        for (int kc = 0; kc < 16; kc += 2) {
            RT_CHUNK(kc, bw)
            RT_CHUNK(kc + 1, bx)
        }
#undef RT_CHUNK
#undef RT_WRITEA
#undef RT_LOADB
        __syncthreads();
        LAS float* lgs = (LAS float*)lds;
#pragma unroll
        for (int rb = 0; rb < 2; ++rb)
#pragma unroll
            for (int r = 0; r < 16; ++r) lgs[(rb * 32 + crow(r, hi)) * 257 + wave * 32 + r32] = lg[rb][r];
        __syncthreads();
#pragma unroll 1
        for (int tg = 0; tg < 2; ++tg) {
            float sc[4][4], cv[4][4];
#pragma unroll
            for (int tt = 0; tt < 4; ++tt) {
                const int lr = wave * 8 + tg * 4 + tt;
#pragma unroll
                for (int j = 0; j < 4; ++j) { const int e = lane + 64 * j; sc[tt][j] = 1.f / (1.f + __expf(-lgs[lr * 257 + e])); cv[tt][j] = sc[tt][j] + rbias[e]; }
            }
            float gsel[4][8];
#pragma unroll
            for (int j = 0; j < 4; ++j) {
#pragma unroll
                for (int tt = 0; tt < 4; ++tt) {
                    const float rm = dpp_rowmax(cv[tt][j]);
                    const float m1a = fmaxf(rl_f(rm, 0), rl_f(rm, 16)), m1b = fmaxf(rl_f(rm, 32), rl_f(rm, 48));
                    const unsigned long long bal = __ballot(cv[tt][j] == (hi ? m1b : m1a));
                    const int fa_ = __builtin_ctz((unsigned)(bal & 0xFFFFFFFFull)), fb_ = 32 + __builtin_ctz((unsigned)(bal >> 32));
                    const float c2 = (lane == fa_ || lane == fb_) ? -INFINITY : cv[tt][j];
                    const float rm2 = dpp_rowmax(c2);
                    gsel[tt][2 * j] = m1a + fmaxf(rl_f(rm2, 0), rl_f(rm2, 16));
                    gsel[tt][2 * j + 1] = m1b + fmaxf(rl_f(rm2, 32), rl_f(rm2, 48));
                }
            }
#pragma unroll
            for (int tt = 0; tt < 4; ++tt)
#pragma unroll
                for (int j = 0; j < 4; ++j) {
                    int ra_ = 0, rb_ = 0;
#pragma unroll
                    for (int g2 = 0; g2 < 8; ++g2) {
                        ra_ += ((gsel[tt][g2] > gsel[tt][2 * j]) || (gsel[tt][g2] == gsel[tt][2 * j] && g2 < 2 * j)) ? 1 : 0;
                        rb_ += ((gsel[tt][g2] > gsel[tt][2 * j + 1]) || (gsel[tt][g2] == gsel[tt][2 * j + 1] && g2 < 2 * j + 1)) ? 1 : 0;
                    }
                    cv[tt][j] = ((hi ? rb_ : ra_) < 4) ? cv[tt][j] : NEGV;
                }
            float wsel[4], wsum[4]; int esel[4];
#pragma unroll
            for (int tt = 0; tt < 4; ++tt) { wsel[tt] = 0.f; wsum[tt] = 0.f; esel[tt] = 0; }
#pragma unroll 1
            for (int k = 0; k < TOPK; ++k) {
#pragma unroll
                for (int tt = 0; tt < 4; ++tt) {
                    float bv = cv[tt][0]; int be = lane;
#pragma unroll
                    for (int j = 1; j < 4; ++j) if (cv[tt][j] > bv) { bv = cv[tt][j]; be = lane + 64 * j; }
                    const float rm = dpp_rowmax(bv);
                    const float mval = fmaxf(fmaxf(rl_f(rm, 0), rl_f(rm, 16)), fmaxf(rl_f(rm, 32), rl_f(rm, 48)));
                    const int ri = dpp_rowmin_i(bv == mval ? be : 0x7fffffff);
                    const int e = min(min(__builtin_amdgcn_readlane(ri, 0), __builtin_amdgcn_readlane(ri, 16)), min(__builtin_amdgcn_readlane(ri, 32), __builtin_amdgcn_readlane(ri, 48)));
                    const int jl = e >> 6, ll = e & 63;
                    const float smine = ((jl == 0 ? sc[tt][0] : 0.f) + (jl == 1 ? sc[tt][1] : 0.f)) + ((jl == 2 ? sc[tt][2] : 0.f) + (jl == 3 ? sc[tt][3] : 0.f));
                    const float sw = rl_f(smine, ll);
#pragma unroll
                    for (int j = 0; j < 4; ++j) cv[tt][j] = (lane == ll && jl == j) ? -INFINITY : cv[tt][j];
                    wsum[tt] += sw;
                    if (lane == k) { wsel[tt] = sw; esel[tt] = e; }
                }
            }
#pragma unroll
            for (int tt = 0; tt < 4; ++tt) {
                if (lane < TOPK) {
                    const int tok = it * 64 + wave * 8 + tg * 4 + tt;
                    const int a = tok * TOPK + lane;
                    P_topw[a] = wsel[tt] / wsum[tt] * 2.5f;
                    if (rep_ == 0) {
                        const int pos = atomicAdd(&cnt[esel[tt] * CNT_STRIDE], 1);
                        P_list[(size_t)esel[tt] * T + pos] = a;
                    }
                }
            }
        }
        __syncthreads();
    }
}

__device__ __forceinline__ void ph_gateup(int L, int rep_, const int wave_s_) {
    PH_FN_BEGIN
    (void)rep_;
    {
        PH_BEGIN;
        const float* weg = CTX_IN(8) + (size_t)L * NE * D * DF; const float* weu = CTX_IN(9) + (size_t)L * NE * D * DF;
        LAS int* rowva = (LAS int*)(lds + MOE_LDS_VA);
        {
            int* octr = (int*)(ws + WS_CTL + CTL_CNT_OFF + 8192) + (L * 4 + 2 * (rep_ & 1)) * 64;
            LAS int* slot = (LAS int*)(lds + 140000);
            for (;;) {
                __syncthreads();
                if (tid == 0) { int q; do { q = atomicAdd(octr, 1); } while (q >= NE && q < NE * 5 && cnt[((q - NE) >> 2) * CNT_STRIDE] <= MOE_XCAP); *slot = q; }
                __syncthreads();
                const int q = *slot;
                if (q >= NE * 5) break;
                const bool ovf = q >= NE;
                const int e = ovf ? (q - NE) >> 2 : q, pz = ovf ? (q - NE) & 3 : 0, npz = ovf ? 1 : 4, st0 = ovf ? 1 : 0, n = cnt[e * CNT_STRIDE];
                for (int r0 = 0; r0 < n; r0 += 1024) {
                    if (ovf && n - r0 <= MOE_XCAP) break;
#pragma unroll
                    for (int i = 0; i < 2; ++i) { int t_ = tid; asm volatile("" : "+v"(t_)); const int idx = r0 + i * 512 + t_; rowva[i * 512 + t_] = idx < n ? P_list[(size_t)e * T + idx] : TRASH_VA; }
                    __syncthreads();
                    moe_expert<false>(lds, tid, lane, wave, r32, hi, P_xb8, weg + (size_t)e * D * DF, weu + (size_t)e * D * DF, (n - r0) < 1024 ? (n - r0) : 1024, (void*)P_hb, pz, npz, st0, 1, false, !ovf && (n - r0) > 512 && (n - r0) <= MOE_XCAP);
                }
            }
        }
    }
    {
        PH_BEGIN;
        const pg8::Gemm g{P_xb, (const u16*)(ws + WS_WSGU) + (size_t)L * 512 * 1024, T, 512, D};
        const EpiSGU E{P_hbs};
        int* qctr = (int*)(ws + WS_CTL + CTL_CNT_OFF + 4096) + (L * 4 + 2 * (rep_ & 1)) * 64;
        LAS int* slot = (LAS int*)(lds + 140000);
        for (;;) {
            __syncthreads();
            if (tid == 0) *slot = atomicAdd(qctr, 1);
            __syncthreads();
            const int un = *slot;
            if (un >= 128) break;
            const pg8::FixedOrder S{un & 63, un >> 6};
            pg8::gemm_phase<EpiSGU, pg8::FixedOrder, false>((PG8_LAS unsigned char*)lds, g, S, E, nullptr, wave_s_ * 64 + lane_id_());
        }
    }
}

__device__ __forceinline__ void ph_down(int L, int rep_, const int wave_s_) {
    PH_FN_BEGIN
    (void)rep_;
    {
        PH_BEGIN;
        const float* wed = CTX_IN(10) + (size_t)L * NE * DF * D;
        LAS int* rowva = (LAS int*)(lds + MOE_LDS_VA); LAS float* roww = (LAS float*)(lds + MOE_LDS_W);
        {
            int* octr = (int*)(ws + WS_CTL + CTL_CNT_OFF + 8192) + (L * 4 + 1 + 2 * (rep_ & 1)) * 64;
            LAS int* slot = (LAS int*)(lds + 140000);
            for (;;) {
                __syncthreads();
                if (tid == 0) { int q; do { q = atomicAdd(octr, 1); } while (q >= NE && q < NE * 5 && cnt[((q - NE) >> 2) * CNT_STRIDE] <= 512); *slot = q; }
                __syncthreads();
                const int q = *slot;
                if (q >= NE * 5) break;
                const bool ovf = q >= NE;
                const int e = ovf ? (q - NE) >> 2 : q, pz = ovf ? ((q - NE) & 3) * 2 : 0, npz = ovf ? 2 : 8, st0 = ovf ? 1 : 0, n = cnt[e * CNT_STRIDE];
                for (int r0 = 0; r0 < n; r0 += 1024) {
                    if (ovf && n - r0 <= 512) break;
#pragma unroll
                    for (int i = 0; i < 2; ++i) { int t_ = tid; asm volatile("" : "+v"(t_)); const int idx = r0 + i * 512 + t_; const int va = idx < n ? P_list[(size_t)e * T + idx] : TRASH_VA; rowva[i * 512 + t_] = va; roww[i * 512 + t_] = va < A_TOT ? P_topw[va] * Y8_SCALE : 0.f; }
                    __syncthreads();
                    moe_expert<true>(lds, tid, lane, wave, r32, hi, (const unsigned char*)P_hb, wed + (size_t)e * DF * D, nullptr, (n - r0) < 1024 ? (n - r0) : 1024, (void*)P_yb, pz, npz, st0, 1, true);
                }
            }
        }
    }
    {
        PH_BEGIN;
        const pg8::Gemm g{P_hbs, (const u16*)(ws + WS_WSD) + (size_t)L * D * DF, T, D, DF};
        const EpiSD E{P_yb};
        int* qctr = (int*)(ws + WS_CTL + CTL_CNT_OFF + 4096) + (L * 4 + 1 + 2 * (rep_ & 1)) * 64;
        LAS int* slot = (LAS int*)(lds + 140000);
        for (;;) {
            __syncthreads();
            if (tid == 0) *slot = atomicAdd(qctr, 1);
            __syncthreads();
            const int un = *slot;
            if (un >= 256) break;
            const pg8::FixedOrder S{un & 63, un >> 6};
            pg8::gemm_phase<EpiSD, pg8::FixedOrder, false>((PG8_LAS unsigned char*)lds, g, S, E, nullptr, wave_s_ * 64 + lane_id_());
        }
    }
}

__device__ __forceinline__ void ph_combine(int L, int rep_, const int wave_s_) {
    PH_FN_BEGIN
    (void)rep_;
    PH_BEGIN;
    const float* lng = CTX_IN(14) + L * D; const float* lnb = CTX_IN(15) + L * D;
    float* dst = AS_GLOBAL(float, ctx_ld(16));
    for (int row = bid * 8 + wave; row < T; row += G * 8) {
        u32x4 yv[TOPK + 1][2];
#pragma unroll
        for (int k = 0; k < TOPK + 1; ++k) {
            const size_t va = k < TOPK ? (size_t)row * TOPK + k : (size_t)A_TOT + row;
            if (k < TOPK) {
#pragma unroll
                for (int j = 0; j < 2; ++j) { const u32x2 w8 = *(const u32x2*)((const unsigned char*)P_yb + va * D + j * 512 + lane * 8); yv[k][j][0] = w8[0]; yv[k][j][1] = w8[1]; yv[k][j][2] = 0u; yv[k][j][3] = 0u; }
            } else {
#pragma unroll
                for (int j = 0; j < 2; ++j) yv[k][j] = *(const u32x4*)(P_yb + va * D + j * 512 + lane * 8);
            }
        }
        float v[16];
#pragma unroll
        for (int j = 0; j < 2; ++j) {
            const u32x4 t = *(const u32x4*)(P_xb + (size_t)row * D + j * 512 + lane * 8);
#pragma unroll
            for (int c = 0; c < 4; ++c) { v[j * 8 + 2 * c] = DN_ALPHA * bf2f(t[c] & 0xFFFFu); v[j * 8 + 2 * c + 1] = DN_ALPHA * bf2f(t[c] >> 16); }
        }
#pragma unroll
        for (int k = 0; k < TOPK + 1; ++k)
#pragma unroll
            for (int j = 0; j < 2; ++j) {
                if (k < TOPK) {
#pragma unroll
                    for (int c = 0; c < 2; ++c) {
                        const f32x2_ lo2 = __builtin_amdgcn_cvt_pk_f32_fp8((int)yv[k][j][c], false), hi2 = __builtin_amdgcn_cvt_pk_f32_fp8((int)yv[k][j][c], true);
                        v[j * 8 + 4 * c] += lo2[0] * (1.f / Y8_SCALE); v[j * 8 + 4 * c + 1] += lo2[1] * (1.f / Y8_SCALE); v[j * 8 + 4 * c + 2] += hi2[0] * (1.f / Y8_SCALE); v[j * 8 + 4 * c + 3] += hi2[1] * (1.f / Y8_SCALE);
                    }
                } else {
#pragma unroll
                    for (int c = 0; c < 4; ++c) { v[j * 8 + 2 * c] += bf2f(yv[k][j][c] & 0xFFFFu); v[j * 8 + 2 * c + 1] += bf2f(yv[k][j][c] >> 16); }
                }
            }
        float sm = 0.f;
#pragma unroll
        for (int i = 0; i < 16; ++i) sm += v[i];
        const float mu = wave_sum(sm) * (1.f / D);
        float q = 0.f;
#pragma unroll
        for (int i = 0; i < 16; ++i) { const float d = v[i] - mu; q += d * d; }
        const float rstd = rsqrtf(wave_sum(q) * (1.f / D) + LN_EPS);
#pragma unroll
        for (int j = 0; j < 2; ++j) {
            const f32x4 g0 = *(const f32x4*)(lng + j * 512 + lane * 8), g1 = *(const f32x4*)(lng + j * 512 + lane * 8 + 4);
            const f32x4 b0 = *(const f32x4*)(lnb + j * 512 + lane * 8), b1 = *(const f32x4*)(lnb + j * 512 + lane * 8 + 4);
            f32x4 o0, o1;
#pragma unroll
            for (int c = 0; c < 4; ++c) { o0[c] = (v[j * 8 + c] - mu) * rstd * g0[c] + b0[c]; o1[c] = (v[j * 8 + 4 + c] - mu) * rstd * g1[c] + b1[c]; }
            if (L == 1) { *(f32x4*)(dst + (size_t)row * D + j * 512 + lane * 8) = o0; *(f32x4*)(dst + (size_t)row * D + j * 512 + lane * 8 + 4) = o1; }
            if (L == 0) { u32x4 w; w[0] = cvtpk(o0[0], o0[1]); w[1] = cvtpk(o0[2], o0[3]); w[2] = cvtpk(o1[0], o1[1]); w[3] = cvtpk(o1[2], o1[3]); *(u32x4*)(P_xb + (size_t)row * D + j * 512 + lane * 8) = w;
                if (QKV_FP8) { u32x2 w8; w8[0] = pack_fp8x4(o0[0], o0[1], o0[2], o0[3]); w8[1] = pack_fp8x4(o1[0], o1[1], o1[2], o1[3]); *(u32x2*)(P_xq8 + (size_t)row * D + j * 512 + lane * 8) = w8; } }
        }
    }
}

__global__ void __launch_bounds__(NTHR, 2) fwd(Args args) {
    extern __shared__ __attribute__((aligned(16))) unsigned char lds_raw[];
    LAS char* lds = (LAS char*)lds_raw;
    unsigned char* const ws = args.ws;
    const int lo = args.ph_lo, hi_ph = args.ph_hi;
    const int wave_s_ = __builtin_amdgcn_readfirstlane(threadIdx.x >> 6);
    if (threadIdx.x < 18) {
        const uint64_t v = threadIdx.x < 16 ? (uint64_t)args.in[threadIdx.x] : (threadIdx.x == 16 ? (uint64_t)args.out : (uint64_t)args.ws);
        ((LAS uint64_t*)(lds + LDS_CTX))[threadIdx.x] = v;
    }
    __syncthreads();
#define IN(k) (lo <= (k) && (k) < hi_ph)

#if MK_ONE_LAUNCH
    if (threadIdx.x < 4) ((LAS unsigned*)(lds + LDS_BAR))[threadIdx.x] = 0u;
    __syncthreads();
    XcdBarrier bar = xcd_barrier_post((unsigned*)(ws + WS_CTL), (volatile LAS unsigned*)(lds + LDS_BAR), wave_s_ == 0 && lane_id_() == 0);
#define GRID_BAR() xcd_barrier(bar, wave_s_ == 0 && lane_id_() == 0)
#else
#define GRID_BAR() do { } while (0)
#endif
#define SEAM(k) do { if (IN(k) && IN((k) + 1)) GRID_BAR(); } while (0)

    for (int rep_ = 0; rep_ < ((IN(0) && PHK(0)) ? REPS(0) : 0); ++rep_) { ph_p0(0, rep_, wave_s_); }
    SEAM(0);

    for (int L = 0; L < 2; ++L) {
        const int pb = 1 + 10 * L;
        for (int rep_ = 0; rep_ < ((IN(pb + 0) && PHK(1)) ? REPS(1) : 0); ++rep_) { ph_qkv(L, rep_, wave_s_); }
        SEAM(pb + 0);

        if (L == 0) {
            for (int rep_ = 0; rep_ < ((IN(pb + 1) && PHK(2)) ? REPS(2) : 0); ++rep_) { ph_kmean(L, rep_, wave_s_); }
            SEAM(pb + 1);
            for (int rep_ = 0; rep_ < ((IN(pb + 2) && PHK(11)) ? REPS(11) : 0); ++rep_) { ph_gate(L, rep_, wave_s_); }
            SEAM(pb + 2);
        }

        if (L == 0) {
            for (int rep_ = 0; rep_ < ((IN(pb + 3) && PHK(3)) ? REPS(3) : 0); ++rep_) { ph_moba(L, rep_, wave_s_); }
            SEAM(pb + 3);
            for (int rep_ = 0; rep_ < ((IN(pb + 4) && PHK(12)) ? REPS(12) : 0); ++rep_) { ph_mobamerge(L, rep_, wave_s_); }
        } else {
            for (int rep_ = 0; rep_ < ((IN(pb + 3) && PHK(4)) ? REPS(4) : 0); ++rep_) { ph_dil(L, rep_, wave_s_); }
            SEAM(pb + 3);
            for (int rep_ = 0; rep_ < ((IN(pb + 4) && PHK(5)) ? REPS(5) : 0); ++rep_) { ph_merge(L, rep_, wave_s_); }
        }
        SEAM(pb + 4);

        for (int rep_ = 0; rep_ < ((IN(pb + 5) && PHK(6)) ? REPS(6) : 0); ++rep_) { ph_wo(L, rep_, wave_s_); }
        SEAM(pb + 5);

        for (int rep_ = 0; rep_ < ((IN(pb + 6) && PHK(7)) ? REPS(7) : 0); ++rep_) { ph_router(L, rep_, wave_s_); }
        SEAM(pb + 6);

        for (int rep_ = 0; rep_ < ((IN(pb + 7) && PHK(8)) ? REPS(8) : 0); ++rep_) { ph_gateup(L, rep_, wave_s_); }
        SEAM(pb + 7);

        for (int rep_ = 0; rep_ < ((IN(pb + 8) && PHK(9)) ? REPS(9) : 0); ++rep_) { ph_down(L, rep_, wave_s_); }
        SEAM(pb + 8);

        for (int rep_ = 0; rep_ < ((IN(pb + 9) && PHK(10)) ? REPS(10) : 0); ++rep_) { ph_combine(L, rep_, wave_s_); }
        if (L == 0) SEAM(pb + 9);
    }
}

extern "C" void kernel_launch(void* const* d_in, const int* in_sizes, int n_in, void* d_out, int out_size, void* d_ws, size_t ws_size, hipStream_t stream) {
    static int grid = 0;
    if (grid == 0) {
        if (n_in != 16 || out_size != T * D || ws_size < WS_END3) { fprintf(stderr, "kernel_launch: unexpected problem (n_in %d out %d ws %zu need %zu)\n", n_in, out_size, ws_size, (size_t)WS_END2); grid = -1; return; }
        int dev = 0, cus = 0, per_cu = 0;
        if (hipGetDevice(&dev) != hipSuccess || hipDeviceGetAttribute(&cus, hipDeviceAttributeMultiprocessorCount, dev) != hipSuccess) { grid = -1; return; }
        if (hipFuncSetAttribute((const void*)fwd, hipFuncAttributeMaxDynamicSharedMemorySize, LDS_BYTES) != hipSuccess) { fprintf(stderr, "kernel_launch: hipFuncSetAttribute failed\n"); grid = -1; return; }
        if (hipOccupancyMaxActiveBlocksPerMultiprocessor(&per_cu, (const void*)fwd, NTHR, LDS_BYTES) != hipSuccess || per_cu < 1) { fprintf(stderr, "kernel_launch: occupancy query says %d\n", per_cu); (void)hipGetLastError(); per_cu = 1; }
        grid = cus;
    }
    if (grid < 0) return;
    (void)hipMemsetAsync((char*)d_ws + WS_CTL, 0, CTL_BYTES, stream);
    Args a{};
    for (int i = 0; i < 16; ++i) a.in[i] = (const float*)d_in[i];
    a.out = (float*)d_out; a.ws = (unsigned char*)d_ws;
#if MK_ONE_LAUNCH
    a.ph_lo = 0; a.ph_hi = N_PHASES;
    hipLaunchKernelGGL(fwd, dim3(grid), dim3(NTHR), LDS_BYTES, stream, a);
#else
    for (int ph = 0; ph < N_PHASES; ++ph) {
        if (ph == 12 || ph == 13) continue;
        a.ph_lo = ph; a.ph_hi = ph + 1;
        hipLaunchKernelGGL(fwd, dim3(grid), dim3(NTHR), LDS_BYTES, stream, a);
    }
#endif
}
```

```cpp
#include <hip/hip_runtime.h>
#include <hip/hip_bf16.h>
#include <stdint.h>
#include <stdio.h>

#ifndef MK_ONE_LAUNCH
#define MK_ONE_LAUNCH 1
#endif

#ifndef PHMASK
#define PHMASK 0x1FFF
#endif
#define PHK(k) ((PHMASK >> (k)) & 1)
#ifndef REPEAT_KIND
#define REPEAT_KIND -1
#endif
#define REPS(k) ((k) == REPEAT_KIND ? 2 : 1)
#define LAS __attribute__((address_space(3)))
typedef __attribute__((ext_vector_type(8))) short bf16x8;
typedef __attribute__((ext_vector_type(16))) float f32x16;
typedef __attribute__((ext_vector_type(4))) float f32x4;
typedef __attribute__((ext_vector_type(4))) unsigned u32x4;
typedef __attribute__((ext_vector_type(2))) unsigned u32x2;
typedef unsigned short u16;

constexpr int D = 1024, BATCH = 2, SEQ = 8192, T = BATCH * SEQ, NH = 16, HD = 64;
constexpr int NE = 256, TOPK = 8, DF = 256;
constexpr int A_TOT = T * TOPK;
constexpr int MOBA_BLK = 256, MOBA_NB = SEQ / MOBA_BLK;
constexpr float DN_ALPHA = 1.4142135623730951f;
constexpr float LN_EPS = 1e-5f;
constexpr float LOG2E = 1.4426950408889634f;
constexpr float LN2 = 0.6931471805599453f;
constexpr float NEGV = -1e30f;
constexpr int NTHR = 512;

constexpr size_t al256(size_t x) { return (x + 255) & ~(size_t)255; }
constexpr size_t WS_CTL = 0;
constexpr size_t CTL_BYTES = 131072;
constexpr size_t CTL_CNT_OFF = 32768;
constexpr size_t CTL_XQ_OFF = 45056;
constexpr size_t CTL_ECNT_OFF = 65536;
constexpr int CNT_STRIDE = 32;
constexpr size_t WS_XB = WS_CTL + CTL_BYTES;
constexpr size_t WS_X1 = WS_XB + al256((size_t)T * D * 2);
constexpr size_t WS_X2 = WS_X1 + al256((size_t)T * D * 4);
constexpr size_t WS_YPRE = WS_X2 + al256((size_t)T * D * 4);
constexpr size_t WS_QKV = WS_YPRE + al256((size_t)T * D * 4);
constexpr size_t WS_VT = WS_QKV + al256((size_t)T * 9216 * 2);
constexpr size_t WS_KM = WS_VT + al256((size_t)3 * T * D * 2);
constexpr size_t WS_AO = WS_KM + al256((size_t)BATCH * NH * MOBA_NB * HD * 4);
constexpr size_t WS_OG = WS_AO + al256((size_t)T * D * 2);
constexpr size_t WS_LSE = WS_OG + al256((size_t)3 * T * D * 2);
constexpr size_t WS_TOPW = WS_LSE + al256((size_t)3 * T * NH * 4);
constexpr size_t WS_LIST = WS_TOPW + al256((size_t)T * TOPK * 4);
constexpr size_t WS_HB = WS_LIST + al256((size_t)NE * T * 4);
constexpr size_t WS_YB = WS_HB + al256((size_t)(A_TOT + T + 1) * DF * 2);
constexpr size_t WS_END = WS_YB + al256((size_t)(A_TOT + T + 1) * D * 2);
constexpr int TRASH_VA = A_TOT + T;
constexpr size_t WS_SELM = WS_END;
constexpr size_t WS_PART = WS_SELM + al256((size_t)T * NH * 4);
constexpr size_t WS_PLSE = WS_PART + al256((size_t)T * NH * 4 * 64 * 2);
constexpr size_t WS_WQK0 = WS_PLSE + al256((size_t)T * NH * 4 * 4);
constexpr size_t WS_WV0 = WS_WQK0 + (size_t)2048 * 1024 * 2;
constexpr size_t WS_WQK1 = WS_WV0 + (size_t)1024 * 1024 * 2;
constexpr size_t WS_WV1 = WS_WQK1 + (size_t)6144 * 1024 * 2;
constexpr size_t WS_WO = WS_WV1 + (size_t)3072 * 1024 * 2;
constexpr size_t WS_WSGU = WS_WO + (size_t)2 * 1024 * 1024 * 2;
constexpr size_t WS_WSD = WS_WSGU + (size_t)2 * 512 * 1024 * 2;
constexpr size_t WS_XB8 = WS_WSD + (size_t)2 * 1024 * 256 * 2;
constexpr size_t WS_HBS = WS_XB8 + (size_t)T * D;
constexpr size_t WS_WRH = WS_HBS + (size_t)T * DF * 2;
constexpr size_t WS_WRL = WS_WRH + (size_t)2 * 256 * 1024 * 2;
constexpr size_t WS_END2 = WS_WRL + (size_t)2 * 256 * 1024 * 2;
constexpr size_t WS_XQ8 = WS_END2;
constexpr size_t WS_WQ8 = WS_XQ8 + (size_t)T * D;
constexpr size_t WS_WO8 = WS_WQ8 + (size_t)(3072 + 9216) * 1024;
constexpr size_t WS_END3 = WS_WO8 + (size_t)2 * 1024 * 1024;
#ifndef WO_FP8
#define WO_FP8 1
#endif
constexpr float AO8_SCALE = 16.f;
#ifndef QKV_FP8
#define QKV_FP8 2
#endif

constexpr int LDP = 40;
constexpr int STAGE_BYTES = 2 * 256 * LDP * 2;
constexpr int LDS_ROWID = 2 * STAGE_BYTES;
constexpr int LDS_ROWW = LDS_ROWID + 1024;
constexpr int XS_PITCH = 1028;
constexpr int LDS_BYTES = 163840;
constexpr int LDS_BAR = 161792;

__device__ __forceinline__ int lane_id_() { int l; asm volatile("v_mbcnt_lo_u32_b32 %0, -1, 0\n\tv_mbcnt_hi_u32_b32 %0, -1, %0" : "=v"(l)); return l; }
__device__ __forceinline__ float shxf(float v, int m, int lane) { return __int_as_float(__builtin_amdgcn_ds_bpermute((lane ^ m) << 2, __float_as_int(v))); }
__device__ __forceinline__ int shxi(int v, int m, int lane) { return __builtin_amdgcn_ds_bpermute((lane ^ m) << 2, v); }
#define XB_TMO      128
#define XB_XCNT(j)  (256  + 64 * (j))
#define XB_XSUB(j)  (1280 + 64 * (j))
#define XB_XGEN(j)  (2304 + 64 * (j))
#define XB_TOP      3328
#define XB_TOPGEN   3392
#define XCD_BAR_WORDS 3456
#define XB_SPIN_CAP (1u << 18)
__device__ __forceinline__ unsigned xb_ld(unsigned* p)              { return __hip_atomic_load(p, __ATOMIC_RELAXED, __HIP_MEMORY_SCOPE_AGENT); }
__device__ __forceinline__ unsigned xb_add(unsigned* p, unsigned v) { return __hip_atomic_fetch_add(p, v, __ATOMIC_RELAXED, __HIP_MEMORY_SCOPE_AGENT); }
__device__ __forceinline__ unsigned xb_xcc_id() { return (unsigned)__builtin_amdgcn_s_getreg((3 << 11) | 20) & 0xFu; }
#define XB_SPIN(cond, bar) do { unsigned _sp = 0; while (cond) { __builtin_amdgcn_s_sleep(1); \
    if ((++_sp & 255u) == 0u) { if (xb_ld(&(bar)[XB_TMO])) break; if (_sp > XB_SPIN_CAP) { atomicAdd(&(bar)[XB_TMO], 1u); break; } } } } while (0)
struct XcdBarrier { unsigned* bar; unsigned x; volatile LAS unsigned* st; };
__device__ __forceinline__ XcdBarrier xcd_barrier_post(unsigned* bar, volatile LAS unsigned* st, const bool leader) {
    XcdBarrier b; b.bar = bar; b.x = xb_xcc_id(); b.st = st;
    if (leader) (void)xb_add(&bar[XB_XCNT(b.x)], 1u);
    return b;
}
__device__ __forceinline__ void xcd_barrier_complete(unsigned* bar, unsigned x, unsigned& nloc, unsigned& nx) {
    const unsigned G = gridDim.x * gridDim.y * gridDim.z;
    unsigned sum, cnt, mine, sp = 0u;
    for (;;) {
        sum = 0u; cnt = 0u; mine = 0u;
#pragma unroll
        for (unsigned j = 0; j < 16; ++j) { const unsigned c = xb_ld(&bar[XB_XCNT(j)]); sum += c; cnt += (c > 0u) ? 1u : 0u; mine = (j == x) ? c : mine; }
        if (sum == G) break;
        __builtin_amdgcn_s_sleep(1);
        if ((++sp & 255u) == 0u) { if (xb_ld(&bar[XB_TMO])) break; if (sp > XB_SPIN_CAP) { atomicAdd(&bar[XB_TMO], 1u); break; } }
    }
    nloc = mine > 0u ? mine : 1u; nx = cnt > 0u ? cnt : 1u;
}
__device__ __forceinline__ void xcd_barrier(const XcdBarrier& b, const bool leader) {
    asm volatile("s_waitcnt vmcnt(0)" ::: "memory");
    __syncthreads();
    if (leader) {
        unsigned* bar = b.bar;
        __builtin_amdgcn_s_waitcnt(0);
        unsigned nloc = b.st[0], nx = b.st[1];
        if (nloc == 0u) { xcd_barrier_complete(bar, b.x, nloc, nx); b.st[0] = nloc; b.st[1] = nx; }
        const unsigned old = xb_add(&bar[XB_XSUB(b.x)], 1u);
        const unsigned gen = old / nloc;
        if (old + 1u == (gen + 1u) * nloc) {
            __builtin_amdgcn_fence(__ATOMIC_RELEASE, "agent");
            asm volatile("s_waitcnt vmcnt(0)" ::: "memory");
            const unsigned og = xb_add(&bar[XB_TOP], 1u);
            const unsigned tg = og / nx;
            if (og + 1u == (tg + 1u) * nx) xb_add(&bar[XB_TOPGEN], 1u);
            else XB_SPIN(xb_ld(&bar[XB_TOPGEN]) == tg, bar);
            __builtin_amdgcn_fence(__ATOMIC_ACQUIRE, "agent");
            xb_add(&bar[XB_XGEN(b.x)], 1u);
            asm volatile("s_waitcnt vmcnt(0)" ::: "memory");
        } else {
            XB_SPIN(xb_ld(&bar[XB_XGEN(b.x)]) == gen, bar);
            __builtin_amdgcn_fence(__ATOMIC_ACQUIRE, "agent");
            asm volatile("s_waitcnt vmcnt(0)" ::: "memory");
        }
    }
    __syncthreads();
}

typedef __attribute__((ext_vector_type(2))) __bf16 bf16x2_t;
typedef __attribute__((ext_vector_type(2))) float f32x2_t;
__device__ __forceinline__ unsigned cvtpk(float lo, float hi) { f32x2_t f; f[0] = lo; f[1] = hi; return __builtin_bit_cast(unsigned, __builtin_convertvector(f, bf16x2_t)); }
__device__ __forceinline__ float bf2f(unsigned v16) { return __uint_as_float(v16 << 16); }
__device__ __forceinline__ int crow(int r, int hi) { return (r & 3) + 8 * (r >> 2) + 4 * hi; }
#define MFMA_BF16(a, b, c) __builtin_amdgcn_mfma_f32_32x32x16_bf16(a, b, c, 0, 0, 0)
__device__ __forceinline__ float wave_sum(float v) {
    v += __int_as_float(__builtin_amdgcn_update_dpp(0, __float_as_int(v), 0xB1, 0xF, 0xF, true));
    v += __int_as_float(__builtin_amdgcn_update_dpp(0, __float_as_int(v), 0x4E, 0xF, 0xF, true));
    v += __int_as_float(__builtin_amdgcn_update_dpp(0, __float_as_int(v), 0x141, 0xF, 0xF, true));
    v += __int_as_float(__builtin_amdgcn_update_dpp(0, __float_as_int(v), 0x140, 0xF, 0xF, true));
    const int vi = __float_as_int(v);
    return (__int_as_float(__builtin_amdgcn_readlane(vi, 0)) + __int_as_float(__builtin_amdgcn_readlane(vi, 16))) + (__int_as_float(__builtin_amdgcn_readlane(vi, 32)) + __int_as_float(__builtin_amdgcn_readlane(vi, 48)));
}

namespace pg8 {
#define PG8_LAS __attribute__((address_space(3)))
typedef unsigned short bf16_t;
typedef short bf16x8 __attribute__((ext_vector_type(8)));
typedef float f32x4 __attribute__((ext_vector_type(4)));
typedef unsigned u32x4 __attribute__((ext_vector_type(4)));
typedef int pg8_i32x8 __attribute__((ext_vector_type(8)));
constexpr int BM = 256, BK = 64, HALF = 128, HTB = HALF * BK * 2  , STAGE_BYTES = 8 * HTB, NXCD = 8, WGM = 8;

__host__ __device__ __forceinline__ int lds_byte(int r, int c) { const int st = (r >> 4) * 2 + (c >> 5), rr = r & 15, cc = c & 31, ob = rr * 64 + cc * 2; return st * 1024 + (ob ^ (((ob >> 9) & 1) << 5)); }
__host__ __device__ __forceinline__ void stage_rc(int b, int& R, int& C) { const int st = b / 1024, sb = b % 1024, swz = sb ^ (((sb >> 9) & 1) << 5); R = (st >> 1) * 16 + swz / 64; C = (st & 1) * 32 + (swz % 64) / 2; }
__device__ __forceinline__ int pg8_opq(int v) { asm volatile("" : "+v"(v)); return v; }
__host__ __device__ __forceinline__ int perm32(int rho) { const int n = rho >> 4, i = rho & 15; return 8 * (i >> 2) + 4 * n + (i & 3); }

struct Unit { int pm, pn; };
struct Gemm { const bf16_t* A; const bf16_t* Bt; int M, N, K; };
struct FixedOrder {
    int pm, pn;
    __device__ __forceinline__ bool next(int i, Unit& u) const { if (i != 0) return false; u.pm = pm; u.pn = pn; return true; }
    __device__ __forceinline__ void a_ready(const Unit&) const {}
    __device__ __forceinline__ void done(const Unit&) const {}
};

struct StaticOrder {
    int nM, nN, nwg, G, c;
    __host__ __device__ void init(int M, int N, int G_, int c_) { nM = M / BM; nN = N / BM; nwg = nM * nN; G = G_; c = c_; }
    __host__ __device__ bool next(int i, Unit& u) const {
        const long L = (long)i * G + c; if (L >= nwg) return false;
        int wgid = (int)L; { const int q = nwg / NXCD, r = nwg % NXCD, xcd = wgid % NXCD, off = wgid / NXCD; wgid = (xcd < r ? xcd * (q + 1) : r * (q + 1) + (xcd - r) * q) + off; }
        const int nig = WGM * nN, gid = wgid / nig, fm = gid * WGM, gsz = (nM - fm) < WGM ? (nM - fm) : WGM;
        u.pm = fm + ((wgid % nig) % gsz); u.pn = (wgid % nig) / gsz; return true;
    }
    __device__ __forceinline__ void a_ready(const Unit&) const {}
    __device__ __forceinline__ void done(const Unit&) const {}
};

template <class Epi, class Sched, bool SWAP = false, bool STAMP = false, bool F8 = false, int F8SC = 0x7F79  >
__device__ __forceinline__ void gemm_phase(PG8_LAS unsigned char* lds, const Gemm g, const Sched& S, const Epi& E, unsigned long long* stamps, const int tid_in) {
    int tid_ = tid_in; asm volatile("" : "+v"(tid_));
    const int tid = tid_, wid = __builtin_amdgcn_readfirstlane(tid >> 6), lane = tid & 63, wr = wid >> 2, wc = wid & 3, fr = lane & 15, fq = lane >> 4;
    const int K = g.K, nt = K / BK;
    int ts_lo = 0, ts_hi = 0, nts = 0; const unsigned long long rt_entry = STAMP ? (unsigned long long)wall_clock64() : 0ull;
#define PG8_STAMP() do { if (STAMP && wid == 0 && nts < 64) { const unsigned long long _c = (unsigned long long)clock64(); \
        ts_lo = (lane == nts) ? (int)(unsigned)_c : ts_lo; ts_hi = (lane == nts) ? (int)(unsigned)(_c >> 32) : ts_hi; ++nts; } } while (0)
    PG8_STAMP();
    unsigned voffA[2], voffB[2];
#pragma unroll
    for (int i = 0; i < 2; ++i) { int R, C; stage_rc(tid * 16 + i * 8192, R, C); const int Rb = Epi::PERM ? ((R & ~31) + perm32(R & 31)) : R;
        voffA[i] = (unsigned)(R * K + C) * 2u; voffB[i] = (unsigned)(Rb * K + C) * 2u; }
    const size_t kstep = (size_t)(BK * 2);
    const size_t hstep = (size_t)HALF * K * 2;
    const size_t tstep = 2 * hstep;
    const unsigned ldsw = (unsigned)wid * 1024u;
    int xoff_ = lds_byte(fr, fq * 8); asm volatile("" : "+v"(xoff_));
    const int aoffs = wr * 8192, boffs = wc * 4096;
#define aoff (aoffs + pg8_opq(xoff_))
#define boff (boffs + pg8_opq(xoff_))
#define PG8_SA(b, h) (((b) * 2 + (h)) * HTB)
#define PG8_SB(b, h) ((4 + (b) * 2 + (h)) * HTB)
#define PG8_STAGE(bufoff, gbase, voff) do {   \
        _Pragma("unroll") for (int _i = 0; _i < 2; ++_i) { uint64_t gb_ = (uint64_t)(gbase) + (uint64_t)_i * (size_t)(64 * 2) * K; asm volatile("" : "+s"(gb_)); unsigned vo_ = (voff)[0]; asm volatile("" : "+v"(vo_)); \
        __builtin_amdgcn_global_load_lds((const __attribute__((address_space(1))) unsigned*)((const __attribute__((address_space(1))) char*)gb_ + vo_), (PG8_LAS unsigned*)(lds + (bufoff) + ldsw + _i * 8192), 16, 0, 0); } } while (0)
#define PG8_CAT8(X0, X1) pg8_i32x8{(int)__builtin_bit_cast(u32x4, X0)[0], (int)__builtin_bit_cast(u32x4, X0)[1], (int)__builtin_bit_cast(u32x4, X0)[2], (int)__builtin_bit_cast(u32x4, X0)[3], \
                                   (int)__builtin_bit_cast(u32x4, X1)[0], (int)__builtin_bit_cast(u32x4, X1)[1], (int)__builtin_bit_cast(u32x4, X1)[2], (int)__builtin_bit_cast(u32x4, X1)[3]}
#define PG8_LDA(dst, b, h) do { _Pragma("unroll") for (int m = 0; m < 4; ++m) { if (F8) { const bf16x8 x0_ = *(const PG8_LAS bf16x8*)(lds + PG8_SA(b, h) + aoff + m * 2048), x1_ = *(const PG8_LAS bf16x8*)(lds + PG8_SA(b, h) + aoff + m * 2048 + 1024); dst##8[m] = PG8_CAT8(x0_, x1_); } \
        else { _Pragma("unroll") for (int k = 0; k < 2; ++k) dst[m][k] = *(const PG8_LAS bf16x8*)(lds + PG8_SA(b, h) + aoff + m * 2048 + k * 1024); } } } while (0)
#define PG8_LDB(dst, b, h) do { _Pragma("unroll") for (int n = 0; n < 2; ++n) { if (F8) { const bf16x8 x0_ = *(const PG8_LAS bf16x8*)(lds + PG8_SB(b, h) + boff + n * 2048), x1_ = *(const PG8_LAS bf16x8*)(lds + PG8_SB(b, h) + boff + n * 2048 + 1024); dst##8[n] = PG8_CAT8(x0_, x1_); } \
        else { _Pragma("unroll") for (int k = 0; k < 2; ++k) dst[n][k] = *(const PG8_LAS bf16x8*)(lds + PG8_SB(b, h) + boff + n * 2048 + k * 1024); } } } while (0)
#define PG8_MMA(ai, bj, At, Bt) do { __builtin_amdgcn_s_setprio(1); _Pragma("unroll") for (int m = 0; m < 4; ++m) _Pragma("unroll") for (int n = 0; n < 2; ++n) _Pragma("unroll") for (int k = 0; k < 2; ++k) \
        { if (F8) { if (k == 0) acc[ai][bj][m][n] = __builtin_amdgcn_mfma_scale_f32_16x16x128_f8f6f4(Bt##8[n], At##8[m], acc[ai][bj][m][n], 0, 0, 0, F8SC, 1, F8SC); } \
          else acc[ai][bj][m][n] = SWAP ? __builtin_amdgcn_mfma_f32_16x16x32_bf16(At[m][k], Bt[n][k], acc[ai][bj][m][n], 0, 0, 0) : __builtin_amdgcn_mfma_f32_16x16x32_bf16(Bt[n][k], At[m][k], acc[ai][bj][m][n], 0, 0, 0); } __builtin_amdgcn_s_setprio(0); } while (0)
#define PG8_WAIT_V(n) asm volatile("s_waitcnt vmcnt(" #n ")" ::: "memory")
#define PG8_WAIT_L(n) asm volatile("s_waitcnt lgkmcnt(" #n ")" ::: "memory")
#define PG8_BAR __builtin_amdgcn_s_barrier()
#define PG8_SCHED __builtin_amdgcn_sched_barrier(0)
    Unit cur, nxt; int ui = 0;
    if (!S.next(0, cur)) return;
    f32x4 acc[2][2][4][2];
#pragma unroll
    for (int a = 0; a < 2; ++a)
#pragma unroll
        for (int b = 0; b < 2; ++b)
#pragma unroll
            for (int m = 0; m < 4; ++m)
#pragma unroll
                for (int n = 0; n < 2; ++n) acc[a][b][m][n] = (f32x4){0.f, 0.f, 0.f, 0.f};
    bf16x8 At[4][2], B0[2][2], B1[2][2];
    pg8_i32x8 At8[4], B08[2], B18[2];
    const char* cA = (const char*)g.A + (size_t)cur.pm * tstep; const char* cB = (const char*)g.Bt + (size_t)cur.pn * tstep;
    S.a_ready(cur);
    PG8_STAGE(PG8_SB(0, 0), cB, voffB); PG8_STAGE(PG8_SA(0, 0), cA, voffA); PG8_STAGE(PG8_SB(0, 1), cB + hstep, voffB); PG8_STAGE(PG8_SA(0, 1), cA + hstep, voffA);
    if (wr == 1) PG8_BAR;
    PG8_WAIT_V(4); PG8_BAR;
    PG8_STAGE(PG8_SB(1, 0), cB + kstep, voffB); PG8_STAGE(PG8_SA(1, 0), cA + kstep, voffA); PG8_STAGE(PG8_SB(1, 1), cB + hstep + kstep, voffB);
    PG8_WAIT_V(6); PG8_BAR;
    PG8_STAMP();
    for (;;) {
        const bool has_next = S.next(ui + 1, nxt);
        const char* nA = has_next ? (const char*)g.A + (size_t)nxt.pm * tstep : cA; const char* nB = has_next ? (const char*)g.Bt + (size_t)nxt.pn * tstep : cB;
        for (int t = 0; t < nt; t += 2) {
            const bool last = (t == nt - 2);
            const char* a1 = cA + (size_t)(t + 1) * kstep;
            const char* a2 = last ? nA : cA + (size_t)(t + 2) * kstep; const char* b2 = last ? nB : cB + (size_t)(t + 2) * kstep;
            const char* a3 = a2 + kstep; const char* b3 = b2 + kstep;
            if (last && has_next) S.a_ready(nxt);
            PG8_LDB(B0, 0, 0); PG8_SCHED; PG8_LDA(At, 0, 0); PG8_STAGE(PG8_SA(1, 1), a1 + hstep, voffA);
            PG8_WAIT_L(8); PG8_BAR; PG8_WAIT_L(0); PG8_MMA(0, 0, At, B0); PG8_BAR; PG8_SCHED;
            PG8_LDB(B1, 0, 1); PG8_STAGE(PG8_SB(0, 0), b2, voffB);
            PG8_BAR; PG8_WAIT_L(0); PG8_MMA(0, 1, At, B1); PG8_BAR;
            PG8_LDA(At, 0, 1); PG8_STAGE(PG8_SA(0, 0), a2, voffA);
            PG8_BAR; PG8_WAIT_L(0); PG8_MMA(1, 0, At, B0); PG8_BAR; PG8_SCHED;
            PG8_STAGE(PG8_SB(0, 1), b2 + hstep, voffB);
            PG8_WAIT_V(6); PG8_BAR; PG8_MMA(1, 1, At, B1); PG8_BAR;
            PG8_LDB(B0, 1, 0); PG8_SCHED; PG8_LDA(At, 1, 0); PG8_STAGE(PG8_SA(0, 1), a2 + hstep, voffA);
            PG8_WAIT_L(8); PG8_BAR; PG8_WAIT_L(0); PG8_MMA(0, 0, At, B0); PG8_BAR; PG8_SCHED;
            PG8_LDB(B1, 1, 1); PG8_STAGE(PG8_SB(1, 0), b3, voffB);
            PG8_BAR; PG8_WAIT_L(0); PG8_MMA(0, 1, At, B1); PG8_BAR;
            PG8_LDA(At, 1, 1); PG8_STAGE(PG8_SA(1, 0), a3, voffA);
            PG8_BAR; PG8_WAIT_L(0); PG8_MMA(1, 0, At, B0); PG8_BAR; PG8_SCHED;
            PG8_STAGE(PG8_SB(1, 1), b3 + hstep, voffB);
            PG8_WAIT_V(6); PG8_BAR; PG8_MMA(1, 1, At, B1); PG8_BAR;
        }
        PG8_STAMP();
        if constexpr (!Epi::AFTER_DRAIN) { const int le_ = lane_id_(); E(acc, cur, wr, wc, le_ & 15, le_ >> 4); S.done(cur); }
        PG8_STAMP();
        if (!has_next) break;
#pragma unroll
        for (int a = 0; a < 2; ++a)
#pragma unroll
            for (int b = 0; b < 2; ++b)
#pragma unroll
                for (int m = 0; m < 4; ++m)
#pragma unroll
                    for (int n = 0; n < 2; ++n) acc[a][b][m][n] = (f32x4){0.f, 0.f, 0.f, 0.f};
        cur = nxt; cA = nA; cB = nB; ++ui;
    }
    PG8_WAIT_V(0);
    if (wr == 0) PG8_BAR;
    PG8_BAR;
    if constexpr (Epi::AFTER_DRAIN) { E.fused(acc, cur, wr, wc, fr, fq, lds, wid, lane); S.done(cur); }
    PG8_STAMP();
    if (STAMP && wid == 0) { stamps[lane] = lane < nts ? (((unsigned long long)(unsigned)ts_hi << 32) | (unsigned)ts_lo) : 0ull;
        if (lane == 62) stamps[62] = rt_entry; if (lane == 63) stamps[63] = (unsigned long long)wall_clock64(); }
#undef PG8_STAMP
#undef PG8_SA
#undef PG8_SB
#undef PG8_STAGE
#undef aoff
#undef boff
#undef PG8_LDA
#undef PG8_LDB
#undef PG8_MMA
#undef PG8_WAIT_V
#undef PG8_WAIT_L
#undef PG8_BAR
#undef PG8_SCHED
}
}

struct EpiQK {
    static constexpr bool PERM = true, AFTER_DRAIN = false;
    u16* O; int ldc;
    __device__ __forceinline__ void operator()(const pg8::f32x4 (&acc)[2][2][4][2], const pg8::Unit& u, int wr, int wc, int fr, int fq) const {
        uint64_t ob_ = (uint64_t)O; asm volatile("" : "+s"(ob_));
        unsigned off0 = ((unsigned)(u.pm * 256 + wr * 64 + fr) * (unsigned)ldc + (unsigned)(u.pn * 256 + wc * 32 + 8 * fq)) * 2u; asm volatile("" : "+v"(off0));
        const unsigned rstep = (unsigned)ldc * 32u;
#pragma unroll
        for (int ai = 0; ai < 2; ++ai)
#pragma unroll
            for (int m = 0; m < 4; ++m) { unsigned ro = off0 + (unsigned)(ai * 8 + m) * rstep; asm volatile("" : "+v"(ro));
#pragma unroll
                for (int bj = 0; bj < 2; ++bj) { const pg8::f32x4 v0 = acc[ai][bj][m][0], v1 = acc[ai][bj][m][1];
                    u32x4 w; w[0] = cvtpk(v0[0], v0[1]); w[1] = cvtpk(v0[2], v0[3]); w[2] = cvtpk(v1[0], v1[1]); w[3] = cvtpk(v1[2], v1[3]);
                    *(__attribute__((address_space(1))) u32x4*)((__attribute__((address_space(1))) char*)ob_ + ro + bj * 256) = w; } }
    }
};
struct EpiV {
    static constexpr bool PERM = false, AFTER_DRAIN = false;
    u16* VT; int layer;
    __device__ __forceinline__ void operator()(const pg8::f32x4 (&acc)[2][2][4][2], const pg8::Unit& u, int wr, int wc, int fr, int fq) const {
        const int colt = u.pn * 256, grp = colt >> 10;
        const int dil = (layer == 0 || grp == 0) ? 1 : (grp == 1 ? 4 : 16);
        const int rowb = u.pm * 256 + wr * 64 + 4 * fq;
#pragma unroll
        for (int bj = 0; bj < 2; ++bj)
#pragma unroll
            for (int n = 0; n < 2; ++n) {
                const int c = (colt & 1023) + bj * 128 + wc * 32 + n * 16 + fr, h = c >> 6, d = c & 63;
#pragma unroll
                for (int ai = 0; ai < 2; ++ai)
#pragma unroll
                    for (int m = 0; m < 4; ++m) {
                        const int r0 = rowb + ai * 128 + m * 16, b = r0 >> 13, t0 = r0 & (SEQ - 1);
                        u16* vrow = VT + (size_t)grp * T * D + ((size_t)(b * NH + h) * HD + d) * SEQ;
                        const pg8::f32x4 v = acc[ai][bj][m][n];
                        if (dil == 1) { u32x2 w; w[0] = cvtpk(v[0], v[1]); w[1] = cvtpk(v[2], v[3]); *(u32x2*)(vrow + t0) = w; }
                        else {
#pragma unroll
                            for (int i = 0; i < 4; ++i) { const int pp = t0 + i; vrow[(pp % dil) * (SEQ / dil) + pp / dil] = (u16)cvtpk(v[i], 0.f); }
                        }
                    }
            }
    }
};
struct EpiWo {
    static constexpr bool PERM = true, AFTER_DRAIN = false;
    u16* Y; const u16* X;
    __device__ __forceinline__ void operator()(const pg8::f32x4 (&acc)[2][2][4][2], const pg8::Unit& u, int wr, int wc, int fr, int fq) const {
        const int row0 = u.pm * 256 + wr * 64 + fr, col0 = u.pn * 256 + wc * 32 + 8 * fq;
#pragma unroll
        for (int ai = 0; ai < 2; ++ai)
#pragma unroll
            for (int m = 0; m < 4; ++m) { const size_t ro = (size_t)(row0 + ai * 128 + m * 16) * D + col0;
#pragma unroll
                for (int bj = 0; bj < 2; ++bj) { const pg8::f32x4 v0 = acc[ai][bj][m][0], v1 = acc[ai][bj][m][1];
                    const u32x4 xr = *(const u32x4*)(X + ro + bj * 128);
                    u32x4 w;
                    w[0] = cvtpk(bf2f(xr[0] & 0xFFFFu) * DN_ALPHA + v0[0], bf2f(xr[0] >> 16) * DN_ALPHA + v0[1]); w[1] = cvtpk(bf2f(xr[1] & 0xFFFFu) * DN_ALPHA + v0[2], bf2f(xr[1] >> 16) * DN_ALPHA + v0[3]);
                    w[2] = cvtpk(bf2f(xr[2] & 0xFFFFu) * DN_ALPHA + v1[0], bf2f(xr[2] >> 16) * DN_ALPHA + v1[1]); w[3] = cvtpk(bf2f(xr[3] & 0xFFFFu) * DN_ALPHA + v1[2], bf2f(xr[3] >> 16) * DN_ALPHA + v1[3]);
                    *(u32x4*)(Y + ro + bj * 128) = w; } }
    }
};
struct EpiSGU {
    static constexpr bool PERM = true, AFTER_DRAIN = false;
    u16* H;
    __device__ __forceinline__ void operator()(const pg8::f32x4 (&acc)[2][2][4][2], const pg8::Unit& u, int wr, int wc, int fr, int fq) const {
        const int row0 = u.pm * 256 + wr * 64 + fr, f0 = u.pn * 128 + wc * 32 + 8 * fq;
#pragma unroll
        for (int ai = 0; ai < 2; ++ai)
#pragma unroll
            for (int m = 0; m < 4; ++m) {
                float hv[8];
#pragma unroll
                for (int n = 0; n < 2; ++n)
#pragma unroll
                    for (int i = 0; i < 4; ++i) { const float gt = acc[ai][0][m][n][i], up = acc[ai][1][m][n][i]; hv[n * 4 + i] = gt / (1.f + __expf(-gt)) * up; }
                u32x4 w; w[0] = cvtpk(hv[0], hv[1]); w[1] = cvtpk(hv[2], hv[3]); w[2] = cvtpk(hv[4], hv[5]); w[3] = cvtpk(hv[6], hv[7]);
                *(u32x4*)(H + (size_t)(row0 + ai * 128 + m * 16) * DF + f0) = w;
            }
    }
};
struct EpiSD {
    static constexpr bool PERM = true, AFTER_DRAIN = false;
    u16* Y;
    __device__ __forceinline__ void operator()(const pg8::f32x4 (&acc)[2][2][4][2], const pg8::Unit& u, int wr, int wc, int fr, int fq) const {
        const int row0 = u.pm * 256 + wr * 64 + fr, col0 = u.pn * 256 + wc * 32 + 8 * fq;
#pragma unroll
        for (int ai = 0; ai < 2; ++ai)
#pragma unroll
            for (int m = 0; m < 4; ++m) { u16* rowp = Y + (size_t)(A_TOT + row0 + ai * 128 + m * 16) * D + col0;
#pragma unroll
                for (int bj = 0; bj < 2; ++bj) { const pg8::f32x4 v0 = acc[ai][bj][m][0], v1 = acc[ai][bj][m][1];
                    u32x4 w; w[0] = cvtpk(v0[0], v0[1]); w[1] = cvtpk(v0[2], v0[3]); w[2] = cvtpk(v1[0], v1[1]); w[3] = cvtpk(v1[2], v1[3]);
                    *(u32x4*)(rowp + bj * 128) = w; } }
    }
};

struct Args {
    const float* in[16];
    float* out;
    unsigned char* ws;
    int ph_lo, ph_hi;
};

#define GEMM_CORE(K_, PA0, PA1, PB, LDB)                                                                                                   \
    {                                                                                                                                      \
        const int g_tid = tid, g_lane = lane, g_wave = wave, g_r32 = r32, g_hi = hi;                   \
        const int g_wm = g_wave >> 2, g_wn = g_wave & 3, g_kc = g_tid & 3, g_kq = g_lane >> 3, g_n4 = g_lane & 7;                           \
        const u16* g_pa0 = (PA0); const u16* g_pa1 = (PA1);                                                                                \
        const size_t g_ldb = (size_t)(LDB);                                                                                                \
        const float* g_pb = (PB) + (size_t)(g_kq * 4) * g_ldb + g_n4 * 4;                                                                  \
        const int g_nk = (K_) / 32;                                                                                                        \
        u32x4 g_ra0, g_ra1; f32x4 g_rb0, g_rb1, g_rb2, g_rb3;                                                                              \
        const u32x4 g_z = {0u, 0u, 0u, 0u};                                                                                                \
        _Pragma("unroll") for (int mb = 0; mb < 4; ++mb) { _Pragma("unroll") for (int nb = 0; nb < 2; ++nb) { _Pragma("unroll") for (int r = 0; r < 16; ++r) acc[mb][nb][r] = 0.f; } } \
        g_ra0 = g_pa0 ? *(const u32x4*)(g_pa0 + g_kc * 8) : g_z; g_ra1 = g_pa1 ? *(const u32x4*)(g_pa1 + g_kc * 8) : g_z;                 \
        g_rb0 = *(const f32x4*)(g_pb); g_rb1 = *(const f32x4*)(g_pb + g_ldb); g_rb2 = *(const f32x4*)(g_pb + 2 * g_ldb); g_rb3 = *(const f32x4*)(g_pb + 3 * g_ldb); \
        _Pragma("unroll 1") for (int kt = 0; kt < g_nk; ++kt) {                                                                            \
            LAS char* As = lds + (kt & 1) * STAGE_BYTES; LAS char* Bs = As + 256 * LDP * 2;                                                \
            *(LAS u32x4*)(As + ((g_tid >> 2) * LDP + g_kc * 8) * 2) = g_ra0;                                                               \
            *(LAS u32x4*)(As + (((g_tid >> 2) + 128) * LDP + g_kc * 8) * 2) = g_ra1;                                                       \
            _Pragma("unroll") for (int i = 0; i < 4; ++i) {                                                                                \
                u32x2 w; w[0] = cvtpk(g_rb0[i], g_rb1[i]); w[1] = cvtpk(g_rb2[i], g_rb3[i]);                                               \
                *(LAS u32x2*)(Bs + ((g_wave * 32 + i * 8 + g_n4) * LDP + g_kq * 4) * 2) = w;                                               \
            }                                                                                                                              \
            __syncthreads();                                                                                                               \
            if (kt + 1 < g_nk) {                                                                                                           \
                const int ko = (kt + 1) * 32;                                                                                              \
                g_ra0 = g_pa0 ? *(const u32x4*)(g_pa0 + ko + g_kc * 8) : g_z; g_ra1 = g_pa1 ? *(const u32x4*)(g_pa1 + ko + g_kc * 8) : g_z; \
                const float* pbk = g_pb + (size_t)ko * g_ldb;                                                                              \
                g_rb0 = *(const f32x4*)(pbk); g_rb1 = *(const f32x4*)(pbk + g_ldb); g_rb2 = *(const f32x4*)(pbk + 2 * g_ldb); g_rb3 = *(const f32x4*)(pbk + 3 * g_ldb); \
            }                                                                                                                              \
            _Pragma("unroll") for (int s = 0; s < 2; ++s) {                                                                                \
                bf16x8 af[4], bfr[2];                                                                                                      \
                _Pragma("unroll") for (int mb = 0; mb < 4; ++mb) af[mb] = *(LAS bf16x8*)(As + ((g_wm * 128 + mb * 32 + g_r32) * LDP + s * 16 + g_hi * 8) * 2); \
                _Pragma("unroll") for (int nb = 0; nb < 2; ++nb) bfr[nb] = *(LAS bf16x8*)(Bs + (((g_wn * 2 + nb) * 32 + g_r32) * LDP + s * 16 + g_hi * 8) * 2); \
                _Pragma("unroll") for (int mb = 0; mb < 4; ++mb) { _Pragma("unroll") for (int nb = 0; nb < 2; ++nb) acc[mb][nb] = MFMA_BF16(af[mb], bfr[nb], acc[mb][nb]); } \
            }                                                                                                                              \
        }                                                                                                                                  \
        __syncthreads();                                                                                                                   \
    }

struct AttnSt { float m, l; f32x16 o0, o1; };

struct AttnFr { bf16x8 k[4]; bf16x8 v[4]; };
__device__ __forceinline__ void attn_load(AttnFr& f, const u16* krow, const u16* vt, size_t vt_dstride) {
#pragma unroll
    for (int d0 = 0; d0 < 4; ++d0) f.k[d0] = *(const bf16x8*)(krow + d0 * 16);
    const u16* vt1 = vt + 32 * vt_dstride;
    union { bf16x8 v; u32x2 h[2]; } va;
    va.h[0] = *(const u32x2*)(vt);       va.h[1] = *(const u32x2*)(vt + 8);   f.v[0] = va.v;
    va.h[0] = *(const u32x2*)(vt + 16);  va.h[1] = *(const u32x2*)(vt + 24);  f.v[1] = va.v;
    va.h[0] = *(const u32x2*)(vt1);      va.h[1] = *(const u32x2*)(vt1 + 8);  f.v[2] = va.v;
    va.h[0] = *(const u32x2*)(vt1 + 16); va.h[1] = *(const u32x2*)(vt1 + 24); f.v[3] = va.v;
}
__device__ __forceinline__ void attn_compute(AttnSt& st, const bf16x8 (&qf)[4], const AttnFr& f, int dist0, float bslope, int dlo, int dhi, int hi, int lane) {
    f32x16 p;
#pragma unroll
    for (int r = 0; r < 16; ++r) p[r] = 0.f;
#pragma unroll
    for (int d0 = 0; d0 < 4; ++d0) p = MFMA_BF16(f.k[d0], qf[d0], p);
    constexpr float C2 = 0.125f * LOG2E;
    float mx = NEGV;
#pragma unroll
    for (int r = 0; r < 16; ++r) {
        const int dist = dist0 - ((r & 3) + 8 * (r >> 2));
        const float sc = __builtin_fmaf(p[r], C2, -bslope * (float)dist);
        const float s_ = (dist >= dlo && dist <= dhi) ? sc : NEGV;
        p[r] = s_; mx = fmaxf(mx, s_);
    }
    mx = fmaxf(mx, shxf(mx, 32, lane));
    const float mnew = fmaxf(st.m, mx);
    const float alpha = __builtin_amdgcn_exp2f(st.m - mnew);
    st.m = mnew;
    float ls = 0.f;
#pragma unroll
    for (int r = 0; r < 16; ++r) { p[r] = __builtin_amdgcn_exp2f(p[r] - mnew); ls += p[r]; }
    st.l = st.l * alpha + ls;
#pragma unroll
    for (int r = 0; r < 16; ++r) { st.o0[r] *= alpha; st.o1[r] *= alpha; }
    union { bf16x8 v; unsigned u[4]; } pb0, pb1;
#pragma unroll
    for (int j = 0; j < 4; ++j) { pb0.u[j] = cvtpk(p[2 * j], p[2 * j + 1]); pb1.u[j] = cvtpk(p[8 + 2 * j], p[8 + 2 * j + 1]); }
    st.o0 = MFMA_BF16(f.v[0], pb0.v, st.o0);
    st.o0 = MFMA_BF16(f.v[1], pb1.v, st.o0);
    st.o1 = MFMA_BF16(f.v[2], pb0.v, st.o1);
    st.o1 = MFMA_BF16(f.v[3], pb1.v, st.o1);
    (void)hi;
}

__device__ __forceinline__ float dpp_rowmax(float v) {
    v = fmaxf(v, __int_as_float(__builtin_amdgcn_update_dpp(0, __float_as_int(v), 0xB1, 0xF, 0xF, true)));
    v = fmaxf(v, __int_as_float(__builtin_amdgcn_update_dpp(0, __float_as_int(v), 0x4E, 0xF, 0xF, true)));
    v = fmaxf(v, __int_as_float(__builtin_amdgcn_update_dpp(0, __float_as_int(v), 0x141, 0xF, 0xF, true)));
    v = fmaxf(v, __int_as_float(__builtin_amdgcn_update_dpp(0, __float_as_int(v), 0x140, 0xF, 0xF, true)));
    return v;
}
__device__ __forceinline__ int dpp_rowmin_i(int v) {
    v = min(v, __builtin_amdgcn_update_dpp(0, v, 0xB1, 0xF, 0xF, true));
    v = min(v, __builtin_amdgcn_update_dpp(0, v, 0x4E, 0xF, 0xF, true));
    v = min(v, __builtin_amdgcn_update_dpp(0, v, 0x141, 0xF, 0xF, true));
    v = min(v, __builtin_amdgcn_update_dpp(0, v, 0x140, 0xF, 0xF, true));
    return v;
}
__device__ __forceinline__ float rl_f(float v, int l) { return __int_as_float(__builtin_amdgcn_readlane(__float_as_int(v), l)); }

__device__ __forceinline__ void top3_insert(float v, int i, float& v0, int& i0, float& v1, int& i1, float& v2, int& i2) {
    const bool b0 = (v > v0) || (v == v0 && i < i0);
    const bool b1 = (v > v1) || (v == v1 && i < i1);
    const bool b2 = (v > v2) || (v == v2 && i < i2);
    const float nv2 = b1 ? v1 : (b2 ? v : v2); const int ni2 = b1 ? i1 : (b2 ? i : i2);
    const float nv1 = b0 ? v0 : (b1 ? v : v1); const int ni1 = b0 ? i0 : (b1 ? i : i1);
    const float nv0 = b0 ? v : v0;             const int ni0 = b0 ? i : i0;
    v0 = nv0; i0 = ni0; v1 = nv1; i1 = ni1; v2 = nv2; i2 = ni2;
}

__device__ __forceinline__ void ln_row(float (&v)[16], const float* __restrict__ g, const float* __restrict__ b, int lane) {
    float s = 0.f;
#pragma unroll
    for (int i = 0; i < 16; ++i) s += v[i];
    const float mu = wave_sum(s) * (1.f / D);
    float q = 0.f;
#pragma unroll
    for (int i = 0; i < 16; ++i) { const float d = v[i] - mu; q += d * d; }
    const float rstd = rsqrtf(wave_sum(q) * (1.f / D) + LN_EPS);
#pragma unroll
    for (int j = 0; j < 4; ++j) {
        const f32x4 gg = *(const f32x4*)(g + j * 256 + lane * 4), bb = *(const f32x4*)(b + j * 256 + lane * 4);
#pragma unroll
        for (int c = 0; c < 4; ++c) v[j * 4 + c] = (v[j * 4 + c] - mu) * rstd * gg[c] + bb[c];
    }
}

typedef __attribute__((ext_vector_type(2))) float f32x2_;
__device__ __forceinline__ bf16x8 fp8x8_to_bf16(unsigned lo, unsigned hi_) {
    const f32x2_ a = __builtin_amdgcn_cvt_pk_f32_fp8((int)lo, false), b = __builtin_amdgcn_cvt_pk_f32_fp8((int)lo, true);
    const f32x2_ c = __builtin_amdgcn_cvt_pk_f32_fp8((int)hi_, false), d = __builtin_amdgcn_cvt_pk_f32_fp8((int)hi_, true);
    union { bf16x8 v; unsigned u[4]; } r;
    r.u[0] = cvtpk(a[0], a[1]); r.u[1] = cvtpk(b[0], b[1]); r.u[2] = cvtpk(c[0], c[1]); r.u[3] = cvtpk(d[0], d[1]);
    return r.v;
}
__device__ __forceinline__ unsigned pack_fp8x4(float a, float b, float c, float d) { int p = __builtin_amdgcn_cvt_pk_fp8_f32(a, b, 0, false); return (unsigned)__builtin_amdgcn_cvt_pk_fp8_f32(c, d, p, true); }

constexpr float Y8_SCALE = 16.f;
constexpr int MOE_XCAP = 576;
#define MOE_GAS __attribute__((address_space(1)))
typedef MOE_GAS unsigned char moe_gcb;
constexpr int MOE_BP = 72;
constexpr int MOE_BSTAGE = 128 * MOE_BP * 2;
constexpr int MOE_LDS_VA = 3 * MOE_BSTAGE;
constexpr int MOE_LDS_W = MOE_LDS_VA + 4096;
constexpr int MOE_LDS_XCH = 65536;
template <bool DOWN>
__device__ __forceinline__ void moe_expert(LAS char* lds, const int tid, const int lane, const int wave, const int r32, const int hi,
                                           const unsigned char* __restrict__ abase  , const float* __restrict__ w0, const float* __restrict__ w1, const int ng  , void* __restrict__ outv,
                                           const int pass0, const int npass_, const int st0, const int nstl  , const bool y8 = false  ,
                                           const bool xr = false  ) {
    constexpr int KT = DOWN ? 4 : 16, NP = DOWN ? 8 : 4, LDB = DOWN ? 1024 : 256, APITCH = DOWN ? 256 : 1024  , PSTEP = DOWN ? 128 : 64;
    LAS int* rowva = (LAS int*)(lds + MOE_LDS_VA); LAS float* roww = (LAS float*)(lds + MOE_LDS_W);
    const int nst = nstl;
    const int nsteps = npass_ * nst * KT; (void)NP;
    unsigned aoff[2];
#define MOE_AOFF(ST_) { _Pragma("unroll") for (int a = 0; a < 2; ++a) { const int va_ = rowva[(ST_) * 512 + wave * 64 + a * 32 + r32]; \
        const int srow_ = DOWN ? va_ : (va_ == TRASH_VA ? 0 : (va_ >> 3)); aoff[a] = (unsigned)srow_ * APITCH + hi * 32; } }
    const int seg = wave >> 1, n4 = lane & 7, kp = (wave & 1) * 16 + (lane >> 3);
    const char* wbase = (const char*)(DOWN ? (w0 + seg * 32) : (((seg < 2) ? w0 : w1) + (seg & 1) * 32));
    unsigned boff = (unsigned)(4 * n4 + 2 * kp * LDB) * 4u; asm volatile("" : "+v"(boff));
    unsigned wb_ = (unsigned)((seg * 32 + n4) * MOE_BP + 2 * kp) * 2u; asm volatile("" : "+v"(wb_));
    unsigned lb_ = (unsigned)(r32 * MOE_BP + hi * 32) * 2u; asm volatile("" : "+v"(lb_));
    f32x16 acc[2][4];
#pragma unroll
    for (int a = 0; a < 2; ++a)
#pragma unroll
        for (int c = 0; c < 4; ++c)
#pragma unroll
            for (int r = 0; r < 16; ++r) acc[a][c][r] = 0.f;
    u32x4 fa8[2][2];
    f32x16 accx; u32x4 fa8x[2]; unsigned aoffx = 0u;
#pragma unroll
    for (int r = 0; r < 16; ++r) accx[r] = 0.f;
    fa8x[0] = u32x4{0u, 0u, 0u, 0u}; fa8x[1] = u32x4{0u, 0u, 0u, 0u};
    f32x4 rb0[4], rb1[4];
#define MOE_DEC(S_) const int s2_ = (S_) < nsteps ? (S_) : 0; const int pl_ = s2_ / (nst * KT); const int rm_ = s2_ - pl_ * (nst * KT); const int sl_ = rm_ / KT; const int kt_ = rm_ - sl_ * KT; const int ps_ = pass0 + pl_; const int stt_ = st0 + sl_;
#define MOE_LOADB(S_, RB) { MOE_DEC(S_) (void)stt_; \
        uint64_t wu_ = (uint64_t)(wbase + (size_t)(ps_ * PSTEP + kt_ * 64 * LDB) * 4), wv_ = wu_ + 16 * LDB * 4; asm volatile("" : "+s"(wu_), "+s"(wv_));     \
        const moe_gcb* wug_ = (const moe_gcb*)wu_; const moe_gcb* wvg_ = (const moe_gcb*)wv_; \
        unsigned bo_ = boff; asm volatile("" : "+v"(bo_));     \
        RB[0] = *(const MOE_GAS f32x4*)(wug_ + bo_); RB[1] = *(const MOE_GAS f32x4*)(wug_ + bo_ + LDB * 4); RB[2] = *(const MOE_GAS f32x4*)(wvg_ + bo_); RB[3] = *(const MOE_GAS f32x4*)(wvg_ + bo_ + LDB * 4); }
#define MOE_WRITEB(STG, RB) { LAS char* Bs_ = lds + (STG) * MOE_BSTAGE; \
        _Pragma("unroll") for (int i = 0; i < 4; ++i) { LAS unsigned* q_ = (LAS unsigned*)(Bs_ + wb_ + i * (8 * MOE_BP * 2)); q_[0] = cvtpk(RB[0][i], RB[1][i]); q_[8] = cvtpk(RB[2][i], RB[3][i]); } }
#define MOE_COMPUTE(STG, DO_MFMA) { LAS char* Bs_ = lds + (STG) * MOE_BSTAGE; \
        _Pragma("unroll") for (int u = 0; u < 4; ++u) { \
            bf16x8 bfr[4]; \
            if (DO_MFMA) { _Pragma("unroll") for (int c = 0; c < 4; ++c) bfr[c] = *(LAS bf16x8*)(Bs_ + lb_ + (c * 32 * MOE_BP + u * 8) * 2); } \
            _Pragma("unroll") for (int a = 0; a < 2; ++a) { \
                if (DO_MFMA) { const bf16x8 af_ = fp8x8_to_bf16(fa8[a][u >> 1][(u & 1) * 2], fa8[a][u >> 1][(u & 1) * 2 + 1]); \
                    _Pragma("unroll") for (int c = 0; c < 4; ++c) acc[a][c] = MFMA_BF16(bfr[c], af_, acc[a][c]); } \
            } \
        } }
      \
#define MOE_RELOAD { _Pragma("unroll") for (int a = 0; a < 2; ++a) { unsigned ao_ = aoff[a]; asm volatile("" : "+v"(ao_)); \
            fa8[a][0] = *(const MOE_GAS u32x4*)(ab_n + ao_); fa8[a][1] = *(const MOE_GAS u32x4*)(ab_n + ao_ + 16); } }
#define MOE_XCOMPUTE(STG) if (!DOWN) { LAS char* Bs_ = lds + (STG) * MOE_BSTAGE; \
        _Pragma("unroll") for (int u = 0; u < 4; ++u) { \
            const bf16x8 ax_ = fp8x8_to_bf16(fa8x[u >> 1][(u & 1) * 2], fa8x[u >> 1][(u & 1) * 2 + 1]); \
            if (u & 1) { unsigned ao_ = aoffx; asm volatile("" : "+v"(ao_)); fa8x[u >> 1] = *(const MOE_GAS u32x4*)(ab_n + ao_ + (u >> 1) * 16); } \
            const bf16x8 bx_ = *(LAS bf16x8*)(Bs_ + (wave & 3) * (32 * MOE_BP * 2) + lb_ + u * 16); \
            accx = MFMA_BF16(bx_, ax_, accx); } }
#define MOE_NEXTA(S_) MOE_DEC(S_) (void)ps_; \
        if (stt_ != st_loaded) { MOE_AOFF(stt_) st_loaded = stt_; } \
        uint64_t abn_ = (uint64_t)abase + kt_ * 64; asm volatile("" : "+s"(abn_)); const moe_gcb* ab_n = (const moe_gcb*)abn_;
    int st_loaded = st0;
    MOE_AOFF(st0)
    { const char* ab0 = (const char*)abase;
#pragma unroll
      for (int a = 0; a < 2; ++a)
#pragma unroll
          for (int h2 = 0; h2 < 2; ++h2) fa8[a][h2] = *(const u32x4*)(ab0 + aoff[a] + h2 * 16); }
    if (!DOWN) {
        const int vax_ = xr ? rowva[512 + 32 * (wave >> 2) + r32] : TRASH_VA; aoffx = (unsigned)(vax_ == TRASH_VA ? 0 : (vax_ >> 3)) * APITCH + hi * 32;
        fa8x[0] = *(const u32x4*)((const char*)abase + aoffx); fa8x[1] = *(const u32x4*)((const char*)abase + aoffx + 16); }
    MOE_LOADB(0, rb0)
    MOE_LOADB(1, rb1)
    MOE_WRITEB(0, rb0)
    MOE_LOADB(2, rb0)
    int stg = 0;
#pragma unroll 1
    for (int sidx = 0; sidx < nsteps; sidx += 2) {
        const int pl = sidx / (nst * KT); const int rm = sidx - pl * (nst * KT); const int sl = rm / KT; const int kt = rm - sl * KT; const int ps = pass0 + pl, stt = st0 + sl;
        const bool wv = (wave * 64) < (ng - stt * 512);
        const int stg1 = stg == 2 ? 0 : stg + 1, stg2 = stg1 == 2 ? 0 : stg1 + 1;
        __syncthreads();
        MOE_WRITEB(stg1, rb1)
        MOE_LOADB(sidx + 3, rb1)
        { MOE_NEXTA(sidx + 1)
          if (wv) MOE_COMPUTE(stg, true)
          MOE_RELOAD
          MOE_XCOMPUTE(stg) }
        __syncthreads();
        MOE_WRITEB(stg2, rb0)
        MOE_LOADB(sidx + 4, rb0)
        { MOE_NEXTA(sidx + 2)
          if (wv) MOE_COMPUTE(stg1, true)
          MOE_RELOAD
          MOE_XCOMPUTE(stg1) }
        stg = stg2;
        if (kt == KT - 2) {
            const int le_ = lane_id_(); const int lane = le_, r32 = le_ & 31, hi = le_ >> 5; (void)lane;
            if (wv) {
                const int nrows = ng - stt * 512;
#pragma unroll
                for (int a = 0; a < 2; ++a) {
                    if (a == 0 || (wave * 64 + 32) < nrows) {
                        const int lrow = stt * 512 + wave * 64 + a * 32 + r32;
                        const unsigned va = (unsigned)rowva[lrow];
                        if (DOWN) {
                            const float w = roww[lrow];
#pragma unroll
                            for (int c = 0; c < 4; ++c) {
                                float yv_[16];
#pragma unroll
                                for (int j = 0; j < 16; ++j) yv_[j] = acc[a][c][(j >> 2) + 4 * (j & 3)] * w;
                                if (y8) {
                                    u32x4 q8;
#pragma unroll
                                    for (int jj = 0; jj < 4; ++jj) q8[jj] = pack_fp8x4(yv_[4 * jj], yv_[4 * jj + 1], yv_[4 * jj + 2], yv_[4 * jj + 3]);
                                    *(u32x4*)((unsigned char*)outv + (size_t)va * D + ps * 128 + c * 32 + 16 * hi) = q8;
                                } else {
                                    u32x4 q0, q1;
#pragma unroll
                                    for (int jj = 0; jj < 4; ++jj) { q0[jj] = cvtpk(yv_[2 * jj], yv_[2 * jj + 1]); q1[jj] = cvtpk(yv_[8 + 2 * jj], yv_[9 + 2 * jj]); }
                                    u16* o = (u16*)outv + (size_t)va * D + ps * 128 + c * 32 + 16 * hi;
                                    *(u32x4*)o = q0; *(u32x4*)(o + 8) = q1;
                                }
                            }
                        } else {
#pragma unroll
                            for (int c = 0; c < 2; ++c) {
                                float hv[16];
#pragma unroll
                                for (int j = 0; j < 16; ++j) { const int r = (j >> 2) + 4 * (j & 3); const float gt = acc[a][c][r], up = acc[a][c + 2][r]; hv[j] = gt / (1.f + __expf(-gt)) * up; }
                                u32x4 q;
#pragma unroll
                                for (int jj = 0; jj < 4; ++jj) q[jj] = pack_fp8x4(hv[4 * jj], hv[4 * jj + 1], hv[4 * jj + 2], hv[4 * jj + 3]);
                                *(u32x4*)((unsigned char*)outv + (size_t)va * DF + ps * 64 + c * 32 + 16 * hi) = q;
                            }
                        }
                    }
                }
#pragma unroll
                for (int a = 0; a < 2; ++a)
#pragma unroll
                    for (int c = 0; c < 4; ++c)
#pragma unroll
                        for (int r = 0; r < 16; ++r) acc[a][c][r] = 0.f;
            }
            if (!DOWN) { if (xr) {
                LAS float* xch = (LAS float*)(lds + MOE_LDS_XCH) + ((wave >> 2) * 2 + (wave & 1)) * 1024 + lane;
                if ((wave & 3) >= 2) {
#pragma unroll
                    for (int r = 0; r < 16; ++r) xch[r * 64] = accx[r];
                }
                __syncthreads();
                if ((wave & 3) < 2) {
                    const unsigned vax = (unsigned)rowva[512 + 32 * (wave >> 2) + r32];
                    u32x4 q;
#pragma unroll
                    for (int jj = 0; jj < 4; ++jj) {
#pragma unroll
                        for (int i = 0; i < 4; ++i) { const int r = jj + 4 * i; const float gt = accx[r]; accx[r] = gt / (1.f + __expf(-gt)) * xch[r * 64]; }
                        q[jj] = pack_fp8x4(accx[jj], accx[jj + 4], accx[jj + 8], accx[jj + 12]);
                    }
                    *(u32x4*)((unsigned char*)outv + (size_t)vax * DF + ps * 64 + (wave & 3) * 32 + 16 * hi) = q;
                }
                }
#pragma unroll
                for (int r = 0; r < 16; ++r) accx[r] = 0.f;
            }
        }
    }
    __syncthreads();
#undef MOE_XCOMPUTE
#undef MOE_AOFF
#undef MOE_DEC
#undef MOE_LOADB
#undef MOE_WRITEB
#undef MOE_COMPUTE
#undef MOE_RELOAD
#undef MOE_NEXTA
}

constexpr int Q8_BP = 144;
constexpr int Q8_BSTAGE = 128 * Q8_BP;
typedef __attribute__((ext_vector_type(8))) int q8_i32x8;
template <int NCH>
__device__ __forceinline__ void qkv8_item(LAS char* lds, const int wave, const unsigned char* __restrict__ a8  , const unsigned char* __restrict__ w8  ,
                                          u16* __restrict__ outp  , const int ldc,
                                          const int rot  ) {
    constexpr int NSTEPS = NCH * 8;
    const int l0 = lane_id_(); const int r32 = l0 & 31, hi = l0 >> 5;
    unsigned aoff[2];
#pragma unroll
    for (int a = 0; a < 2; ++a) { aoff[a] = (unsigned)(wave * 64 + a * 32 + r32) * 1024u + hi * 32; asm volatile("" : "+v"(aoff[a])); }
    const int t_ = wave * 64 + l0, col_ = t_ >> 2, p_ = t_ & 3, kap_ = col_ & 31;
    unsigned boff = (unsigned)col_ * 1024u + p_ * 32; asm volatile("" : "+v"(boff));
    unsigned wb = (unsigned)((col_ & ~31) + (kap_ & 3) * 8 + (kap_ >> 2)) * Q8_BP + p_ * 32; asm volatile("" : "+v"(wb));
    unsigned lb = (unsigned)r32 * Q8_BP + hi * 32; asm volatile("" : "+v"(lb));
    f32x16 acc[2][4];
#pragma unroll
    for (int a = 0; a < 2; ++a)
#pragma unroll
        for (int c = 0; c < 4; ++c)
#pragma unroll
            for (int r = 0; r < 16; ++r) acc[a][c][r] = 0.f;
    u32x4 fa0[2][2][2], fa1[2][2][2];
    u32x4 rb0[2], rb1[2];
#define Q8_LOADA(FA, S_) { const int s2_ = (S_) < NSTEPS ? (S_) : 0; uint64_t ab_ = (uint64_t)a8 + ((s2_ + rot) & 7) * 128; asm volatile("" : "+s"(ab_)); const moe_gcb* ag_ = (const moe_gcb*)ab_; \
        _Pragma("unroll") for (int a = 0; a < 2; ++a) { unsigned ao_ = aoff[a]; asm volatile("" : "+v"(ao_)); \
            _Pragma("unroll") for (int kk = 0; kk < 2; ++kk) { FA[a][kk][0] = *(const MOE_GAS u32x4*)(ag_ + ao_ + kk * 64); FA[a][kk][1] = *(const MOE_GAS u32x4*)(ag_ + ao_ + kk * 64 + 16); } } }
#define Q8_LOADB(RB, S_) { const int s2_ = (S_) < NSTEPS ? (S_) : 0; uint64_t wu_ = (uint64_t)w8 + (size_t)(s2_ >> 3) * 131072 + ((s2_ + rot) & 7) * 128; asm volatile("" : "+s"(wu_)); const moe_gcb* wg_ = (const moe_gcb*)wu_; \
        unsigned bo_ = boff; asm volatile("" : "+v"(bo_)); RB[0] = *(const MOE_GAS u32x4*)(wg_ + bo_); RB[1] = *(const MOE_GAS u32x4*)(wg_ + bo_ + 16); }
#define Q8_WRITEB(STG, RB) { LAS char* Bs_ = lds + (STG) * Q8_BSTAGE + wb; *(LAS u32x4*)Bs_ = RB[0]; *(LAS u32x4*)(Bs_ + 16) = RB[1]; }
#define Q8_CAT8(X0, X1) q8_i32x8{(int)(X0)[0], (int)(X0)[1], (int)(X0)[2], (int)(X0)[3], (int)(X1)[0], (int)(X1)[1], (int)(X1)[2], (int)(X1)[3]}
#define Q8_MFMA(B_, A_, C_) __builtin_amdgcn_mfma_scale_f32_32x32x64_f8f6f4(B_, A_, C_, 0, 0, 0, 0x7F79  , 1, 0x7F79  )
#define Q8_COMPUTE(STG, FA) { LAS char* Bs_ = lds + (STG) * Q8_BSTAGE + lb; \
        _Pragma("unroll") for (int kk = 0; kk < 2; ++kk) { const q8_i32x8 af0_ = Q8_CAT8(FA[0][kk][0], FA[0][kk][1]), af1_ = Q8_CAT8(FA[1][kk][0], FA[1][kk][1]); \
            _Pragma("unroll") for (int c = 0; c < 4; ++c) { const u32x4 b0_ = *(LAS u32x4*)(Bs_ + c * 32 * Q8_BP + kk * 64), b1_ = *(LAS u32x4*)(Bs_ + c * 32 * Q8_BP + kk * 64 + 16); const q8_i32x8 bf_ = Q8_CAT8(b0_, b1_); \
                acc[0][c] = Q8_MFMA(bf_, af0_, acc[0][c]); acc[1][c] = Q8_MFMA(bf_, af1_, acc[1][c]); } } }
    Q8_LOADB(rb0, 0)
    Q8_WRITEB(0, rb0)
    Q8_LOADB(rb1, 1)
    Q8_LOADA(fa0, 0)
    Q8_LOADB(rb0, 2)
    Q8_LOADA(fa1, 1)
    int stg = 0;
#pragma unroll 1
    for (int s = 0; s < NSTEPS; s += 2) {
        const int stg1 = stg == 2 ? 0 : stg + 1, stg2 = stg1 == 2 ? 0 : stg1 + 1;
        __syncthreads();
        Q8_WRITEB(stg1, rb1)
        Q8_LOADB(rb1, s + 3)
        Q8_COMPUTE(stg, fa0)
        Q8_LOADA(fa0, s + 2)
        __syncthreads();
        Q8_WRITEB(stg2, rb0)
        Q8_LOADB(rb0, s + 4)
        Q8_COMPUTE(stg1, fa1)
        Q8_LOADA(fa1, s + 3)
        stg = stg2;
        if ((s & 7) == 6) {
            const int cl = s >> 3;
            const int le_ = lane_id_(); const int r32e = le_ & 31, hie = le_ >> 5;
#pragma unroll
            for (int a = 0; a < 2; ++a) {
                u16* orow = outp + (size_t)(wave * 64 + a * 32 + r32e) * ldc + cl * 128 + 16 * hie;
#pragma unroll
                for (int c = 0; c < 4; ++c) {
                    u32x4 q0, q1;
#pragma unroll
                    for (int jj = 0; jj < 4; ++jj) { q0[jj] = cvtpk(acc[a][c][((2 * jj) >> 2) + 4 * ((2 * jj) & 3)], acc[a][c][((2 * jj + 1) >> 2) + 4 * ((2 * jj + 1) & 3)]);
                                                     q1[jj] = cvtpk(acc[a][c][((8 + 2 * jj) >> 2) + 4 * ((8 + 2 * jj) & 3)], acc[a][c][((9 + 2 * jj) >> 2) + 4 * ((9 + 2 * jj) & 3)]); }
                    *(u32x4*)(orow + c * 32) = q0; *(u32x4*)(orow + c * 32 + 8) = q1;
                }
            }
#pragma unroll
            for (int a = 0; a < 2; ++a)
#pragma unroll
                for (int c = 0; c < 4; ++c)
#pragma unroll
                    for (int r = 0; r < 16; ++r) acc[a][c][r] = 0.f;
        }
    }
    __syncthreads();
#undef Q8_LOADA
#undef Q8_LOADB
#undef Q8_WRITEB
#undef Q8_CAT8
#undef Q8_MFMA
#undef Q8_COMPUTE
}

constexpr int N_PHASES = 21;

#define P_x_in CTX_IN(0)
#define P_xb ((u16*)(ws + WS_XB))
#define P_x1 ((float*)(ws + WS_X1))
#define P_x2 ((float*)(ws + WS_X2))
#define P_ypre ((u16*)(ws + WS_YPRE))
#define P_qkv ((u16*)(ws + WS_QKV))
#define P_vT ((u16*)(ws + WS_VT))
#define P_kmean ((float*)(ws + WS_KM))
#define P_ao ((u16*)(ws + WS_AO))
#define P_og ((u16*)(ws + WS_OG))
#define P_lse ((float*)(ws + WS_LSE))
#define P_topw ((float*)(ws + WS_TOPW))
#define P_list ((int*)(ws + WS_LIST))
#define P_hb ((u16*)(ws + WS_HB))
#define P_yb ((u16*)(ws + WS_YB))
#define P_cnt_all ((int*)(ws + WS_CTL + CTL_ECNT_OFF))
#define P_xb8 ((unsigned char*)(ws + WS_XB8))
#define P_hbs ((u16*)(ws + WS_HBS))
#define P_xq8 ((unsigned char*)(ws + WS_XQ8))
#define P_wq8 ((unsigned char*)(ws + WS_WQ8))
#define P_wo8 ((unsigned char*)(ws + WS_WO8))
#define P_selm ((unsigned*)(ws + WS_SELM))
#define P_part ((u16*)(ws + WS_PART))
#define P_plse ((float*)(ws + WS_PLSE))
#define PH_BEGIN int tid = wave_s_ * 64 + lane_id_(); asm volatile("" : "+v"(tid)); const int lane = tid & 63, r32 = lane & 31, hi = lane >> 5; const int wave = __builtin_amdgcn_readfirstlane(tid >> 6); (void)lane; (void)r32; (void)hi; (void)wave
constexpr int LDS_CTX = LDS_BAR + 16;
__device__ __forceinline__ uint64_t ctx_ld(int i) {
    extern __shared__ __attribute__((aligned(16))) unsigned char lds_raw[];
    const LAS unsigned* q = (const LAS unsigned*)((LAS char*)lds_raw + LDS_CTX) + 2 * i;
    const unsigned lo = __builtin_amdgcn_readfirstlane(q[0]), hi = __builtin_amdgcn_readfirstlane(q[1]);
    return ((uint64_t)hi << 32) | lo;
}
typedef __attribute__((address_space(1))) unsigned char gbyte;
#define AS_GLOBAL(T, u64v) ((T*)(gbyte*)(u64v))
#define CTX_IN(i) AS_GLOBAL(const float, ctx_ld(i))
#define PH_FN_BEGIN \
    extern __shared__ __attribute__((aligned(16))) unsigned char lds_raw[]; \
    LAS char* lds = (LAS char*)lds_raw; (void)lds; \
    const int G = gridDim.x, bid = blockIdx.x; (void)G; (void)bid; \
    unsigned char* const ws = AS_GLOBAL(unsigned char, ctx_ld(17)); (void)ws; \
    const int NQ = L == 0 ? 3072 : 9216; (void)NQ; \
    int* cnt = P_cnt_all + L * NE * CNT_STRIDE; (void)cnt;
__device__ __forceinline__ void ph_p0(int L, int rep_, const int wave_s_) {
    PH_FN_BEGIN
    (void)rep_;
    PH_BEGIN;
    for (size_t i = (size_t)bid * NTHR + tid; i < (size_t)T * D / 4; i += (size_t)G * NTHR) {
        const f32x4 v = *(const f32x4*)(P_x_in + i * 4);
        u32x2 w; w[0] = cvtpk(v[0], v[1]); w[1] = cvtpk(v[2], v[3]);
        *(u32x2*)(P_xb + i * 4) = w;
#if QKV_FP8
        *(unsigned*)(P_xq8 + i * 4) = pack_fp8x4(v[0], v[1], v[2], v[3]);
#endif
    }
    LAS float* tl = (LAS float*)lds;
    for (int it = bid; it < 3968 + 128; it += G) {
        int seg, kt;
        if (it < 3840) { seg = it >> 4; kt = it & 15; } else if (it < 3968) { seg = 240 + ((it - 3840) >> 2); kt = (it - 3840) & 3; } else { seg = 272 + ((it - 3968) >> 4); kt = (it - 3968) & 15; }
        const float* src; int ld; u16* dst; int Kd = 1024; u16* dst_lo = nullptr; int rcol = 0; unsigned char* dst8 = nullptr;
        if (seg < 48) { const int col = 64 * seg; src = CTX_IN(1) + col; ld = 3072; dst = (u16*)(ws + WS_WQK0) + (size_t)col * 1024; if (QKV_FP8) dst8 = P_wq8 + (size_t)col * 1024; }
        else if (seg < 192) { const int col = 64 * (seg - 48); src = CTX_IN(2) + col; ld = 9216; dst = (u16*)(ws + WS_WQK1) + (size_t)col * 1024; if (QKV_FP8) dst8 = P_wq8 + (size_t)(3072 + col) * 1024; }
        else if (seg < 224) { const int s2 = seg - 192, l2 = s2 >> 4, col = 64 * (s2 & 15); src = CTX_IN(3) + (size_t)l2 * D * D + col; ld = 1024; dst = (u16*)(ws + WS_WO) + (size_t)l2 * D * D + (size_t)col * 1024; if (WO_FP8) dst8 = P_wo8 + (size_t)l2 * D * D + (size_t)col * 1024; }
        else if (seg < 240) { const int s2 = seg - 224, l2 = s2 >> 3, i8 = s2 & 7, un = i8 >> 2, q = i8 & 3;
            src = (q < 2 ? CTX_IN(11) : CTX_IN(12)) + (size_t)l2 * D * DF + un * 128 + 64 * (q & 1); ld = 256; dst = (u16*)(ws + WS_WSGU) + (size_t)l2 * 512 * 1024 + (size_t)(64 * i8) * 1024; }
        else if (seg < 272) { const int s2 = seg - 240, l2 = s2 >> 4, col = 64 * (s2 & 15); src = CTX_IN(13) + (size_t)l2 * DF * D + col; ld = 1024; Kd = 256; dst = (u16*)(ws + WS_WSD) + (size_t)l2 * D * DF + (size_t)col * 256; }
        else { const int s2 = seg - 272, l2 = s2 >> 2, col = 64 * (s2 & 3); src = CTX_IN(6) + (size_t)l2 * D * NE + col; ld = 256; rcol = col; dst = (u16*)(ws + WS_WRH) + (size_t)l2 * NE * D; dst_lo = (u16*)(ws + WS_WRL) + (size_t)l2 * NE * D; }
        {
            const int kr = tid >> 4, c4 = tid & 15;
#pragma unroll
            for (int i = 0; i < 2; ++i) {
                const f32x4 v = *(const f32x4*)(src + (size_t)(kt * 64 + kr + 32 * i) * ld + 4 * c4);
#pragma unroll
                for (int jj = 0; jj < 4; ++jj) tl[(kr + 32 * i) * 65 + 4 * c4 + jj] = v[jj];
            }
        }
        __syncthreads();
        {
            const int row = tid >> 3, kc = tid & 7;
            float f[8];
#pragma unroll
            for (int jj = 0; jj < 8; ++jj) f[jj] = tl[(8 * kc + jj) * 65 + row];
            u32x4 w; w[0] = cvtpk(f[0], f[1]); w[1] = cvtpk(f[2], f[3]); w[2] = cvtpk(f[4], f[5]); w[3] = cvtpk(f[6], f[7]);
            if (dst_lo) {
                u32x4 wl;
#pragma unroll
                for (int jj = 0; jj < 4; ++jj) wl[jj] = cvtpk(f[2 * jj] - bf2f(w[jj] & 0xFFFFu), f[2 * jj + 1] - bf2f(w[jj] >> 16));
                const int E_ = rcol + row;
                const size_t fi = ((size_t)(((E_ >> 5) * 16 + kt) * 4 + (kc >> 1)) * 64 + (kc & 1) * 32 + (E_ & 31)) * 8;
                *(u32x4*)(dst + fi) = w; *(u32x4*)(dst_lo + fi) = wl;
            } else if (dst8) {
                u32x2 w8; w8[0] = pack_fp8x4(f[0] * 64.f, f[1] * 64.f, f[2] * 64.f, f[3] * 64.f); w8[1] = pack_fp8x4(f[4] * 64.f, f[5] * 64.f, f[6] * 64.f, f[7] * 64.f);
                *(u32x2*)(dst8 + (size_t)row * 1024 + kt * 64 + 8 * kc) = w8;
            } else *(u32x4*)(dst + (size_t)row * Kd + kt * 64 + 8 * kc) = w;
        }
        __syncthreads();
    }
}

__device__ __forceinline__ void ph_qkv(int L, int rep_, const int wave_s_) {
    PH_FN_BEGIN
    (void)rep_;
#if QKV_FP8 == 2
    const pg8::Gemm g{(const u16*)P_xq8, (const u16*)(P_wq8 + (L == 0 ? (size_t)0 : (size_t)3072 * 1024)), T, NQ, D / 2};
    pg8::StaticOrder S; S.init(g.M, g.N, G, bid);
    const EpiQK E{P_qkv, NQ};
    pg8::gemm_phase<EpiQK, pg8::StaticOrder, false, false, true>((PG8_LAS unsigned char*)lds, g, S, E, nullptr, wave_s_ * 64 + lane_id_());
#elif QKV_FP8
    PH_BEGIN;
    const int nchunk = NQ / 384, nq = 4 * nchunk;
    const unsigned char* w8 = P_wq8 + (L == 0 ? (size_t)0 : (size_t)3072 * 1024);
    int* xq = (int*)(ws + WS_CTL + CTL_XQ_OFF) + (L * 2 + (rep_ & 1)) * 8 * 64;
    LAS int* slot = (LAS int*)(lds + 140000);
    const int xme = (int)(xb_xcc_id() & 7u);
    unsigned qdone = 0u;
    for (;;) {
        __syncthreads();
        if (tid == 0) {
            int item = -1;
            for (int k = 0; k < 8 && item < 0; ++k) {
                const int xx = (xme + k) & 7;
                if (qdone >> xx & 1u) continue;
                const int q = atomicAdd(&xq[xx * 64], 1);
                if (q < nq) item = (xx + 8 * (q / nchunk)) * nchunk + (q % nchunk); else qdone |= 1u << xx;
            }
            *slot = item;
        }
        __syncthreads();
        const int item = *slot;
        if (item < 0) break;
        const int rt = item / nchunk, ch = item - rt * nchunk;
        qkv8_item<3>(lds, wave, P_xq8 + (size_t)rt * 512 * 1024, w8 + (size_t)ch * 384 * 1024, P_qkv + (size_t)rt * 512 * NQ + ch * 384, NQ, item & 7);
    }
#else
    const pg8::Gemm g{P_xb, (const u16*)(ws + (L == 0 ? WS_WQK0 : WS_WQK1)), T, NQ, D};
    pg8::StaticOrder S; S.init(g.M, g.N, G, bid);
    const EpiQK E{P_qkv, NQ};
    pg8::gemm_phase<EpiQK, pg8::StaticOrder, false>((PG8_LAS unsigned char*)lds, g, S, E, nullptr, wave_s_ * 64 + lane_id_());
#endif
}

__device__ __forceinline__ void ph_kmean(int L, int rep_, const int wave_s_) {
    PH_FN_BEGIN
    (void)rep_;
    PH_BEGIN;
    LAS float* red = (LAS float*)lds;
    for (int it = bid; it < BATCH * NH * MOBA_NB; it += G) {
        const int j = it & 31, h = (it >> 5) & 15, b = it >> 9;
        const int kg_ = tid >> 3, ch = tid & 7;
        const u16* kp = P_qkv + (size_t)(b * SEQ + j * MOBA_BLK + kg_) * 3072 + 1024 + h * 64 + ch * 8;
        float sm[8];
#pragma unroll
        for (int e2 = 0; e2 < 8; ++e2) sm[e2] = 0.f;
#pragma unroll
        for (int i = 0; i < 4; ++i) {
            const u32x4 v = *(const u32x4*)(kp + (size_t)(64 * i) * 3072);
#pragma unroll
            for (int e2 = 0; e2 < 4; ++e2) { sm[2 * e2] += bf2f(v[e2] & 0xFFFFu); sm[2 * e2 + 1] += bf2f(v[e2] >> 16); }
        }
#pragma unroll
        for (int e2 = 0; e2 < 8; ++e2) red[kg_ * 65 + ch * 8 + e2] = sm[e2];
        __syncthreads();
        if (tid < 64) {
            float tot = 0.f;
#pragma unroll 8
            for (int q = 0; q < 64; ++q) tot += red[q * 65 + tid];
            P_kmean[(size_t)it * 64 + tid] = tot * (1.f / MOBA_BLK);
        }
        __syncthreads();
    }
}

__device__ __forceinline__ void ph_gate(int L, int rep_, const int wave_s_) {
    PH_FN_BEGIN
    (void)rep_;
    PH_BEGIN;
    for (int it = bid; it < BATCH * NH * MOBA_NB; it += G) {
        const int qb = it & 31, bh = it >> 5, b = bh >> 4, h = bh & 15;
        const int tq = qb * MOBA_BLK + wave * 32 + r32;
        const u16* qrow = P_qkv + (size_t)(b * SEQ + tq) * 3072 + h * 64 + hi * 8;
        bf16x8 qf[4];
#pragma unroll
        for (int d0 = 0; d0 < 4; ++d0) qf[d0] = *(const bf16x8*)(qrow + d0 * 16);
        unsigned selmask = 0u;
        if (qb > 0) {
            const float* km = P_kmean + ((size_t)(b * NH + h) * MOBA_NB + r32) * 64 + hi * 8;
            f32x16 gt;
#pragma unroll
            for (int r = 0; r < 16; ++r) gt[r] = 0.f;
#pragma unroll
            for (int d0 = 0; d0 < 4; ++d0) {
                const f32x4 k0 = *(const f32x4*)(km + d0 * 16), k1 = *(const f32x4*)(km + d0 * 16 + 4);
                union { bf16x8 v; unsigned u[4]; } kf;
                kf.u[0] = cvtpk(k0[0], k0[1]); kf.u[1] = cvtpk(k0[2], k0[3]); kf.u[2] = cvtpk(k1[0], k1[1]); kf.u[3] = cvtpk(k1[2], k1[3]);
                gt = MFMA_BF16(kf.v, qf[d0], gt);
            }
            float v0 = -INFINITY, v1 = -INFINITY, v2 = -INFINITY; int i0 = 99, i1 = 99, i2 = 99;
#pragma unroll
            for (int r = 0; r < 16; ++r) { const int jb = crow(r, hi); const float gv = jb < qb ? gt[r] : -INFINITY; top3_insert(gv, jb < qb ? jb : 99, v0, i0, v1, i1, v2, i2); }
            const float ov0 = shxf(v0, 32, lane), ov1 = shxf(v1, 32, lane), ov2 = shxf(v2, 32, lane);
            const int oi0 = shxi(i0, 32, lane), oi1 = shxi(i1, 32, lane), oi2 = shxi(i2, 32, lane);
            top3_insert(ov0, oi0, v0, i0, v1, i1, v2, i2); top3_insert(ov1, oi1, v0, i0, v1, i1, v2, i2); top3_insert(ov2, oi2, v0, i0, v1, i1, v2, i2);
            if (i0 < 32) selmask |= 1u << i0;
            if (i1 < 32) selmask |= 1u << i1;
            if (i2 < 32) selmask |= 1u << i2;
        }
        if (hi == 0) P_selm[(size_t)bh * SEQ + tq] = selmask;
    }
}

constexpr int MB_KP = 72;
constexpr int MB_VP = 260;
constexpr int MB_LDS_K = 0;
constexpr int MB_LDS_V = 256 * MB_KP * 2;
constexpr int MB_LDS_LIST = MB_LDS_V + 64 * MB_VP * 2;
constexpr int MB_LDS_CTR = MB_LDS_LIST + 8192 * 2;
__device__ __forceinline__ void ph_moba(int L, int rep_, const int wave_s_) {
    PH_FN_BEGIN
    (void)rep_;
    PH_BEGIN;
    LAS char* Ks = lds + MB_LDS_K; LAS char* Vs = lds + MB_LDS_V;
    LAS u16* qlist = (LAS u16*)(lds + MB_LDS_LIST); LAS int* ctr = (LAS int*)(lds + MB_LDS_CTR);
    for (int it = bid; it < BATCH * NH * MOBA_NB; it += G) {
        const int rnd = it >> 8, w8 = it & 255, a8 = w8 >> 5, bh = w8 & 31;
        const int j = rnd == 0 ? a8 : (rnd == 1 ? 15 - a8 : (rnd == 2 ? 16 + a8 : 31 - a8));
        const int b = bh >> 4, h = bh & 15;
        const float slope2 = exp2f(-0.5f * (float)(h + 1)) * LOG2E;
        if (tid == 0) { int z0 = 0; asm volatile("" : "+v"(z0)); ctr[0] = z0; ctr[1] = z0; }
        {
            const u16* kg = P_qkv + (size_t)(b * SEQ + j * MOBA_BLK) * 3072 + 1024 + h * 64;
#pragma unroll
            for (int i = 0; i < 4; ++i) { const int c = tid + i * 512, row = c >> 3, ch = c & 7; *(LAS u32x4*)(Ks + (row * MB_KP + ch * 8) * 2) = *(const u32x4*)(kg + (size_t)row * 3072 + ch * 8); }
            const u16* vg = P_qkv + (size_t)(b * SEQ + j * MOBA_BLK) * 3072 + 2048 + h * 64;
#pragma unroll
            for (int i = 0; i < 4; ++i) {
                const int c = tid + i * 512, key = c >> 3, ch = c & 7;
                const u32x4 v = *(const u32x4*)(vg + (size_t)key * 3072 + ch * 8);
#pragma unroll
                for (int e2 = 0; e2 < 4; ++e2) {
                    *(LAS u16*)(Vs + ((ch * 8 + 2 * e2) * MB_VP + key) * 2) = (u16)(v[e2] & 0xFFFFu);
                    *(LAS u16*)(Vs + ((ch * 8 + 2 * e2 + 1) * MB_VP + key) * 2) = (u16)(v[e2] >> 16);
                }
            }
        }
        __syncthreads();
        {
            const unsigned* sm = P_selm + (size_t)bh * SEQ;
            for (int t0 = (j + 1) * MOBA_BLK; t0 < SEQ; t0 += 512) {
                const int t = t0 + tid;
                const bool sel = (t < SEQ) && ((sm[t < SEQ ? t : 0] >> j) & 1u);
                const unsigned long long bal = __ballot(sel);
                const int total = __popcll(bal);
                int wb = 0;
                if (lane == 0 && total) wb = atomicAdd((int*)&ctr[0], total);
                wb = __builtin_amdgcn_readfirstlane(wb);
                if (sel) qlist[wb + __popcll(bal & ((1ull << lane) - 1ull))] = (u16)t;
            }
        }
        __syncthreads();
        const int nq = ctr[0];
        const int ntiles = 8 + ((nq + 31) >> 5);
        for (;;) {
            int ti = 0;
            if (lane == 0) ti = atomicAdd((int*)&ctr[1], 1);
            ti = __builtin_amdgcn_readfirstlane(ti);
            if (ti >= ntiles) break;
            const bool own = ti < 8;
            const int wq = 7 - ti;
            const int li = (ti - 8) * 32 + r32;
            const bool valid = own || li < nq;
            const int tq = own ? j * MOBA_BLK + wq * 32 + r32 : (int)qlist[li < nq ? li : nq - 1];
            const int nsteps = own ? wq + 1 : 8;
            const u16* qrow = P_qkv + (size_t)(b * SEQ + tq) * 3072 + h * 64 + hi * 8;
            bf16x8 qf[4];
#pragma unroll
            for (int d0 = 0; d0 < 4; ++d0) qf[d0] = *(const bf16x8*)(qrow + d0 * 16);
            int slot = 3;
            if (!own) slot = __popc(P_selm[(size_t)bh * SEQ + tq] & ((1u << j) - 1u));
            AttnSt st; st.m = NEGV; st.l = 0.f;
#pragma unroll
            for (int r = 0; r < 16; ++r) { st.o0[r] = 0.f; st.o1[r] = 0.f; }
            const int dlo = own ? 0 : -0x40000000;
            for (int kt = 0; kt < nsteps; ++kt) {
                AttnFr f;
#pragma unroll
                for (int d0 = 0; d0 < 4; ++d0) f.k[d0] = *(LAS bf16x8*)(Ks + ((kt * 32 + r32) * MB_KP + d0 * 16 + hi * 8) * 2);
#pragma unroll
                for (int q4 = 0; q4 < 4; ++q4) {
                    union { bf16x8 v; u32x2 hh[2]; } va;
                    LAS char* vp = Vs + (((q4 >> 1) * 32 + r32) * MB_VP + kt * 32 + (q4 & 1) * 16 + 4 * hi) * 2;
                    va.hh[0] = *(LAS u32x2*)(vp); va.hh[1] = *(LAS u32x2*)(vp + 16);
                    f.v[q4] = va.v;
                }
                attn_compute(st, qf, f, tq - (j * MOBA_BLK + kt * 32) - 4 * hi, slope2, dlo, 0x7fffffff, hi, lane);
            }
            const float lt = st.l + shxf(st.l, 32, lane);
            const float inv = 1.f / lt;
            if (valid) {
                const size_t pi = ((size_t)(b * SEQ + tq) * NH + h) * 4 + slot;
                u16* orow = P_part + pi * 64;
#pragma unroll
                for (int rq = 0; rq < 4; ++rq) {
                    u32x2 w; w[0] = cvtpk(st.o0[4 * rq] * inv, st.o0[4 * rq + 1] * inv); w[1] = cvtpk(st.o0[4 * rq + 2] * inv, st.o0[4 * rq + 3] * inv);
                    *(u32x2*)(orow + 8 * rq + 4 * hi) = w;
                    w[0] = cvtpk(st.o1[4 * rq] * inv, st.o1[4 * rq + 1] * inv); w[1] = cvtpk(st.o1[4 * rq + 2] * inv, st.o1[4 * rq + 3] * inv);
                    *(u32x2*)(orow + 32 + 8 * rq + 4 * hi) = w;
                }
                if (hi == 0) P_plse[pi] = st.m * LN2 + logf(lt);
            }
        }
        __syncthreads();
    }
}

__device__ __forceinline__ void ph_mobamerge(int L, int rep_, const int wave_s_) {
    PH_FN_BEGIN
    (void)rep_;
    PH_BEGIN;
    for (size_t i = (size_t)bid * NTHR + tid; i < (size_t)T * NH * 8; i += (size_t)G * NTHR) {
        const size_t row = i >> 7; const int h = (int)(i >> 3) & 15, d8 = (int)i & 7;
        const int qb = (int)(row & (SEQ - 1)) >> 8;
        const int nsel = qb < 3 ? qb : 3;
        const size_t pi = (row * NH + h) * 4;
        float l[4], w[4];
        float mx = -INFINITY;
#pragma unroll
        for (int sidx = 0; sidx < 4; ++sidx) { const bool ok = sidx == 3 || sidx < nsel; l[sidx] = ok ? P_plse[pi + sidx] : -INFINITY; mx = fmaxf(mx, l[sidx]); }
        float ws_ = 0.f;
#pragma unroll
        for (int sidx = 0; sidx < 4; ++sidx) { w[sidx] = (sidx == 3 || sidx < nsel) ? expf(l[sidx] - mx) : 0.f; ws_ += w[sidx]; }
        const float inv = 1.f / ws_;
        float acc8[8];
#pragma unroll
        for (int c = 0; c < 8; ++c) acc8[c] = 0.f;
#pragma unroll
        for (int sidx = 0; sidx < 4; ++sidx) {
            if (sidx == 3 || sidx < nsel) {
                const u32x4 a = *(const u32x4*)(P_part + (pi + sidx) * 64 + d8 * 8);
                const float ww = w[sidx] * inv;
#pragma unroll
                for (int c = 0; c < 4; ++c) { acc8[2 * c] += ww * bf2f(a[c] & 0xFFFFu); acc8[2 * c + 1] += ww * bf2f(a[c] >> 16); }
            }
        }
#if WO_FP8
        u32x2 o8; o8[0] = pack_fp8x4(acc8[0] * AO8_SCALE, acc8[1] * AO8_SCALE, acc8[2] * AO8_SCALE, acc8[3] * AO8_SCALE); o8[1] = pack_fp8x4(acc8[4] * AO8_SCALE, acc8[5] * AO8_SCALE, acc8[6] * AO8_SCALE, acc8[7] * AO8_SCALE);
        *(u32x2*)((unsigned char*)P_ao + row * D + h * 64 + d8 * 8) = o8;
#else
        u32x4 o;
#pragma unroll
        for (int c = 0; c < 4; ++c) o[c] = cvtpk(acc8[2 * c], acc8[2 * c + 1]);
        *(u32x4*)(P_ao + row * D + h * 64 + d8 * 8) = o;
#endif
    }
}

constexpr int DL_KP = 72, DL_VP = 388;
constexpr int DL_LDS_K = 0, DL_LDS_V = 384 * DL_KP * 2;
__device__ __forceinline__ void ph_dil(int L, int rep_, const int wave_s_) {
    PH_FN_BEGIN
    (void)rep_;
    PH_BEGIN;
    LAS char* Ks = lds + DL_LDS_K; LAS char* Vs = lds + DL_LDS_V;
    for (int it = bid; it < BATCH * NH * 3 * 32; it += G) {
        const int ch = it & 31, grp = (it >> 5) % 3, bh = it / 96, b = bh >> 4, h = bh & 15;
        const int dil = grp == 0 ? 1 : (grp == 1 ? 4 : 16), Ls = SEQ / dil;
        const float slope2 = exp2f(-0.5f * (float)(h + 1)) * LOG2E * (float)dil;
        const int uc = ch * 256, res = uc / Ls, c0 = uc - res * Ls;
        const int kb0 = c0 - 128;
        {
            const u16* kg = P_qkv + (size_t)(b * SEQ) * 9216 + grp * 3072 + 1024 + h * 64;
#pragma unroll
            for (int i = 0; i < 6; ++i) {
                const int c = tid + i * 512, row = c >> 3, chk = c & 7, ks = kb0 + row;
                if (ks >= 0) *(LAS u32x4*)(Ks + (row * DL_KP + chk * 8) * 2) = *(const u32x4*)(kg + (size_t)(ks * dil + res) * 9216 + chk * 8);
            }
            const u16* vg = P_qkv + (size_t)(b * SEQ) * 9216 + grp * 3072 + 2048 + h * 64;
#pragma unroll
            for (int i = 0; i < 6; ++i) {
                const int c = tid + i * 512, row = c >> 3, chk = c & 7, ks = kb0 + row;
                if (ks >= 0) {
                    const u32x4 v = *(const u32x4*)(vg + (size_t)(ks * dil + res) * 9216 + chk * 8);
#pragma unroll
                    for (int e2 = 0; e2 < 4; ++e2) {
                        *(LAS u16*)(Vs + ((chk * 8 + 2 * e2) * DL_VP + row) * 2) = (u16)(v[e2] & 0xFFFFu);
                        *(LAS u16*)(Vs + ((chk * 8 + 2 * e2 + 1) * DL_VP + row) * 2) = (u16)(v[e2] >> 16);
                    }
                }
            }
        }
        const int i0 = c0 + wave * 32, iq = i0 + r32, pq = iq * dil + res;
        const u16* qrow = P_qkv + (size_t)(b * SEQ + pq) * 9216 + grp * 3072 + h * 64 + hi * 8;
        bf16x8 qf[4];
#pragma unroll
        for (int d0 = 0; d0 < 4; ++d0) qf[d0] = *(const bf16x8*)(qrow + d0 * 16);
        __syncthreads();
        AttnSt st; st.m = NEGV; st.l = 0.f;
#pragma unroll
        for (int r = 0; r < 16; ++r) { st.o0[r] = 0.f; st.o1[r] = 0.f; }
        const int ktmin = (i0 >= 128) ? 0 : (128 - i0) >> 5;
        for (int kt = 4; kt >= ktmin; --kt) {
            const int lrow0 = (wave + kt) * 32;
            AttnFr f;
#pragma unroll
            for (int d0 = 0; d0 < 4; ++d0) f.k[d0] = *(LAS bf16x8*)(Ks + ((lrow0 + r32) * DL_KP + d0 * 16 + hi * 8) * 2);
#pragma unroll
            for (int q4 = 0; q4 < 4; ++q4) {
                union { bf16x8 v; u32x2 hh[2]; } va;
                LAS char* vp = Vs + (((q4 >> 1) * 32 + r32) * DL_VP + lrow0 + (q4 & 1) * 16 + 4 * hi) * 2;
                va.hh[0] = *(LAS u32x2*)(vp); va.hh[1] = *(LAS u32x2*)(vp + 16);
                f.v[q4] = va.v;
            }
            const int k0 = i0 - 128 + kt * 32;
            attn_compute(st, qf, f, iq - k0 - 4 * hi, slope2, 0, 128, hi, lane);
        }
        const float lt = st.l + shxf(st.l, 32, lane);
        const float inv = 1.f / lt;
        u16* orow = P_og + (size_t)grp * T * D + (size_t)(b * SEQ + pq) * D + h * 64;
#pragma unroll
        for (int rq = 0; rq < 4; ++rq) {
            u32x2 w; w[0] = cvtpk(st.o0[4 * rq] * inv, st.o0[4 * rq + 1] * inv); w[1] = cvtpk(st.o0[4 * rq + 2] * inv, st.o0[4 * rq + 3] * inv);
            *(u32x2*)(orow + 8 * rq + 4 * hi) = w;
            w[0] = cvtpk(st.o1[4 * rq] * inv, st.o1[4 * rq + 1] * inv); w[1] = cvtpk(st.o1[4 * rq + 2] * inv, st.o1[4 * rq + 3] * inv);
            *(u32x2*)(orow + 32 + 8 * rq + 4 * hi) = w;
        }
        if (hi == 0) P_lse[((size_t)grp * T + (b * SEQ + pq)) * NH + h] = st.m * LN2 + logf(lt);
        __syncthreads();
    }
}

__device__ __forceinline__ void ph_merge(int L, int rep_, const int wave_s_) {
    PH_FN_BEGIN
    (void)rep_;

            PH_BEGIN;
                for (size_t i = (size_t)bid * NTHR + tid; i < (size_t)T * NH * 8; i += (size_t)G * NTHR) {
                    const size_t row = i >> 7; const int h = (int)(i >> 3) & 15, d8 = (int)i & 7;
                    const float l0 = P_lse[(0 * (size_t)T + row) * NH + h], l1 = P_lse[(1 * (size_t)T + row) * NH + h], l2 = P_lse[(2 * (size_t)T + row) * NH + h];
                    const float mx = fmaxf(l0, fmaxf(l1, l2));
                    float w0 = expf(l0 - mx), w1 = expf(l1 - mx), w2 = expf(l2 - mx);
                    const float inv = 1.f / (w0 + w1 + w2); w0 *= inv; w1 *= inv; w2 *= inv;
                    const size_t off = row * D + h * 64 + d8 * 8;
                    const u32x4 a0 = *(const u32x4*)(P_og + off), a1 = *(const u32x4*)(P_og + (size_t)T * D + off), a2 = *(const u32x4*)(P_og + 2 * (size_t)T * D + off);
                    u32x4 o; float of_[8];
#pragma unroll
                    for (int c = 0; c < 4; ++c) {
                        const float lo_ = w0 * bf2f(a0[c] & 0xFFFFu) + w1 * bf2f(a1[c] & 0xFFFFu) + w2 * bf2f(a2[c] & 0xFFFFu);
                        const float hi_ = w0 * bf2f(a0[c] >> 16) + w1 * bf2f(a1[c] >> 16) + w2 * bf2f(a2[c] >> 16);
                        o[c] = cvtpk(lo_, hi_); of_[2 * c] = lo_ * AO8_SCALE; of_[2 * c + 1] = hi_ * AO8_SCALE;
                    }
                    if (WO_FP8) { u32x2 o8; o8[0] = pack_fp8x4(of_[0], of_[1], of_[2], of_[3]); o8[1] = pack_fp8x4(of_[4], of_[5], of_[6], of_[7]); *(u32x2*)((unsigned char*)P_ao + off) = o8; }
                    else *(u32x4*)(P_ao + off) = o;
                }

}

__device__ __forceinline__ void ph_wo(int L, int rep_, const int wave_s_) {
    PH_FN_BEGIN
    (void)rep_;
    const EpiWo E{P_ypre, P_xb};
#if WO_FP8
    const pg8::Gemm g{P_ao, (const u16*)(P_wo8 + (size_t)L * D * D), T, D, D / 2};
    pg8::StaticOrder S; S.init(g.M, g.N, G, bid);
    pg8::gemm_phase<EpiWo, pg8::StaticOrder, false, false, true, 0x7B79>((PG8_LAS unsigned char*)lds, g, S, E, nullptr, wave_s_ * 64 + lane_id_());
#else
    const pg8::Gemm g{P_ao, (const u16*)(ws + WS_WO) + (size_t)L * D * D, T, D, D};
    pg8::StaticOrder S; S.init(g.M, g.N, G, bid);
    pg8::gemm_phase<EpiWo, pg8::StaticOrder, false>((PG8_LAS unsigned char*)lds, g, S, E, nullptr, wave_s_ * 64 + lane_id_());
#endif
}

constexpr int RT_P = 144;
constexpr int RT_ASTAGE = 2 * 64 * 144;
constexpr int RT_LDS_AH = 0, RT_LDS_AL = 64 * RT_P;
constexpr int RT_LDS_BH = 2 * 64 * RT_P, RT_LDS_BL = RT_LDS_BH + 256 * RT_P;
constexpr int RT_LDS_ST = RT_LDS_BL + 256 * RT_P;
__device__ __forceinline__ void ph_router(int L, int rep_, const int wave_s_) {
    PH_FN_BEGIN
    (void)rep_;
    PH_BEGIN;
    const float* lng = CTX_IN(4) + L * D; const float* lnb = CTX_IN(5) + L * D;
    const float* rbias = CTX_IN(7) + L * NE;
    const u16* wrh = (const u16*)(ws + WS_WRH) + (size_t)L * NE * D; const u16* wrl = (const u16*)(ws + WS_WRL) + (size_t)L * NE * D;
    LAS float* stat = (LAS float*)(lds + RT_LDS_ST);
    for (int it = bid; it < T / 64; it += G) {
#pragma unroll 1
        for (int hb_ = 0; hb_ < 2; ++hb_) {
            u32x4 yv[4][2];
#pragma unroll
            for (int rr = 0; rr < 4; ++rr)
#pragma unroll
                for (int j = 0; j < 2; ++j) yv[rr][j] = *(const u32x4*)(P_ypre + ((size_t)it * 64 + wave * 8 + hb_ * 4 + rr) * D + j * 512 + lane * 8);
#pragma unroll
            for (int rr = 0; rr < 4; ++rr) {
                float sm = 0.f;
#pragma unroll
                for (int j = 0; j < 2; ++j)
#pragma unroll
                    for (int c = 0; c < 4; ++c) sm += bf2f(yv[rr][j][c] & 0xFFFFu) + bf2f(yv[rr][j][c] >> 16);
                const float mu = wave_sum(sm) * (1.f / D);
                float q = 0.f;
#pragma unroll
                for (int j = 0; j < 2; ++j)
#pragma unroll
                    for (int c = 0; c < 4; ++c) { const float d0_ = bf2f(yv[rr][j][c] & 0xFFFFu) - mu, d1_ = bf2f(yv[rr][j][c] >> 16) - mu; q += d0_ * d0_ + d1_ * d1_; }
                const float rstd = rsqrtf(wave_sum(q) * (1.f / D) + LN_EPS);
                if (lane == 0) { stat[wave * 8 + hb_ * 4 + rr] = mu; stat[64 + wave * 8 + hb_ * 4 + rr] = rstd; }
            }
        }
        __syncthreads();
        const int arow = tid >> 3, aq = tid & 7;
        const float amu = stat[arow], ars = stat[64 + arow];
        const u16* yp = P_ypre + ((size_t)it * 64 + arow) * D + aq * 8;
        u32x4 ya = *(const u32x4*)(yp);
        u32x4 bw[8], bx[8];
        const u16* wfh = wrh + (size_t)wave * 16 * 4 * 64 * 8 + lane * 8; const u16* wfl = wrl + (size_t)wave * 16 * 4 * 64 * 8 + lane * 8;
#define RT_LOADB(BW, KC_) { _Pragma("unroll") for (int sk = 0; sk < 4; ++sk) { BW[sk] = *(const u32x4*)(wfh + ((KC_) * 4 + sk) * 512); BW[4 + sk] = *(const u32x4*)(wfl + ((KC_) * 4 + sk) * 512); } }
        RT_LOADB(bw, 0)
        RT_LOADB(bx, 1)
        f32x16 lg[2];
#pragma unroll
        for (int r = 0; r < 16; ++r) { lg[0][r] = 0.f; lg[1][r] = 0.f; }
#define RT_WRITEA(KC_) { const int k0 = (KC_) * 64; \
            const f32x4 g0 = *(const f32x4*)(lng + k0 + aq * 8), g1 = *(const f32x4*)(lng + k0 + aq * 8 + 4); \
            const f32x4 b0 = *(const f32x4*)(lnb + k0 + aq * 8), b1 = *(const f32x4*)(lnb + k0 + aq * 8 + 4); \
            f32x4 x0, x1v; \
            _Pragma("unroll") for (int c = 0; c < 4; ++c) { const float y0_ = bf2f(c & 1 ? ya[c >> 1] >> 16 : ya[c >> 1] & 0xFFFFu), y1_ = bf2f(c & 1 ? ya[2 + (c >> 1)] >> 16 : ya[2 + (c >> 1)] & 0xFFFFu); \
                x0[c] = (y0_ - amu) * ars * g0[c] + b0[c]; x1v[c] = (y1_ - amu) * ars * g1[c] + b1[c]; } \
            ya = *(const u32x4*)(yp + (((KC_) + 1 < 16) ? k0 + 64 : 0)); \
            const size_t go = ((size_t)it * 64 + arow) * D + k0 + aq * 8; \
            u32x4 wh; wh[0] = cvtpk(x0[0], x0[1]); wh[1] = cvtpk(x0[2], x0[3]); wh[2] = cvtpk(x1v[0], x1v[1]); wh[3] = cvtpk(x1v[2], x1v[3]); \
            *(u32x4*)(P_xb + go) = wh; \
            u32x2 w8; w8[0] = pack_fp8x4(x0[0], x0[1], x0[2], x0[3]); w8[1] = pack_fp8x4(x1v[0], x1v[1], x1v[2], x1v[3]); \
            *(u32x2*)(P_xb8 + go) = w8; \
            u32x4 wl; \
            wl[0] = cvtpk(x0[0] - bf2f(wh[0] & 0xFFFFu), x0[1] - bf2f(wh[0] >> 16)); wl[1] = cvtpk(x0[2] - bf2f(wh[1] & 0xFFFFu), x0[3] - bf2f(wh[1] >> 16)); \
            wl[2] = cvtpk(x1v[0] - bf2f(wh[2] & 0xFFFFu), x1v[1] - bf2f(wh[2] >> 16)); wl[3] = cvtpk(x1v[2] - bf2f(wh[3] & 0xFFFFu), x1v[3] - bf2f(wh[3] >> 16)); \
            *(LAS u32x4*)(lds + ((KC_) & 1) * RT_ASTAGE + RT_LDS_AH + arow * RT_P + aq * 16) = wh; \
            *(LAS u32x4*)(lds + ((KC_) & 1) * RT_ASTAGE + RT_LDS_AL + arow * RT_P + aq * 16) = wl; }
#define RT_CHUNK(KC_, BW) { __syncthreads(); \
            _Pragma("unroll") for (int sk = 0; sk < 4; ++sk) { \
                const int ko = (sk * 16 + hi * 8) * 2; \
                const bf16x8 bh_ = __builtin_bit_cast(bf16x8, BW[sk]), bl_ = __builtin_bit_cast(bf16x8, BW[4 + sk]); \
                _Pragma("unroll") for (int rb = 0; rb < 2; ++rb) { \
                    const bf16x8 xh = *(const LAS bf16x8*)(lds + ((KC_) & 1) * RT_ASTAGE + RT_LDS_AH + (rb * 32 + r32) * RT_P + ko), xl = *(const LAS bf16x8*)(lds + ((KC_) & 1) * RT_ASTAGE + RT_LDS_AL + (rb * 32 + r32) * RT_P + ko); \
                    lg[rb] = MFMA_BF16(xh, bh_, lg[rb]); lg[rb] = MFMA_BF16(xl, bh_, lg[rb]); lg[rb] = MFMA_BF16(xh, bl_, lg[rb]); \
                } \
            } \
            if ((KC_) + 1 < 16) RT_WRITEA((KC_) + 1) \
            { const int kn_ = ((KC_) + 2 < 16) ? (KC_) + 2 : ((KC_) & 1); RT_LOADB(BW, kn_) } }
        RT_WRITEA(0)
#pragma unroll 1
        for (int kc = 0; kc < 16; kc += 2) {
            RT_CHUNK(kc, bw)
            RT_CHUNK(kc + 1, bx)
        }
#undef RT_CHUNK
#undef RT_WRITEA
#undef RT_LOADB
        __syncthreads();
        LAS float* lgs = (LAS float*)lds;
#pragma unroll
        for (int rb = 0; rb < 2; ++rb)
#pragma unroll
            for (int r = 0; r < 16; ++r) lgs[(rb * 32 + crow(r, hi)) * 257 + wave * 32 + r32] = lg[rb][r];
        __syncthreads();
#pragma unroll 1
        for (int tg = 0; tg < 2; ++tg) {
            float sc[4][4], cv[4][4];
#pragma unroll
            for (int tt = 0; tt < 4; ++tt) {
                const int lr = wave * 8 + tg * 4 + tt;
#pragma unroll
                for (int j = 0; j < 4; ++j) { const int e = lane + 64 * j; sc[tt][j] = 1.f / (1.f + __expf(-lgs[lr * 257 + e])); cv[tt][j] = sc[tt][j] + rbias[e]; }
            }
            float gsel[4][8];
#pragma unroll
            for (int j = 0; j < 4; ++j) {
#pragma unroll
                for (int tt = 0; tt < 4; ++tt) {
                    const float rm = dpp_rowmax(cv[tt][j]);
                    const float m1a = fmaxf(rl_f(rm, 0), rl_f(rm, 16)), m1b = fmaxf(rl_f(rm, 32), rl_f(rm, 48));
                    const unsigned long long bal = __ballot(cv[tt][j] == (hi ? m1b : m1a));
                    const int fa_ = __builtin_ctz((unsigned)(bal & 0xFFFFFFFFull)), fb_ = 32 + __builtin_ctz((unsigned)(bal >> 32));
                    const float c2 = (lane == fa_ || lane == fb_) ? -INFINITY : cv[tt][j];
                    const float rm2 = dpp_rowmax(c2);
                    gsel[tt][2 * j] = m1a + fmaxf(rl_f(rm2, 0), rl_f(rm2, 16));
                    gsel[tt][2 * j + 1] = m1b + fmaxf(rl_f(rm2, 32), rl_f(rm2, 48));
                }
            }
#pragma unroll
            for (int tt = 0; tt < 4; ++tt)
#pragma unroll
                for (int j = 0; j < 4; ++j) {
                    int ra_ = 0, rb_ = 0;
#pragma unroll
                    for (int g2 = 0; g2 < 8; ++g2) {
                        ra_ += ((gsel[tt][g2] > gsel[tt][2 * j]) || (gsel[tt][g2] == gsel[tt][2 * j] && g2 < 2 * j)) ? 1 : 0;
                        rb_ += ((gsel[tt][g2] > gsel[tt][2 * j + 1]) || (gsel[tt][g2] == gsel[tt][2 * j + 1] && g2 < 2 * j + 1)) ? 1 : 0;
                    }
                    cv[tt][j] = ((hi ? rb_ : ra_) < 4) ? cv[tt][j] : NEGV;
                }
            float wsel[4], wsum[4]; int esel[4];
#pragma unroll
            for (int tt = 0; tt < 4; ++tt) { wsel[tt] = 0.f; wsum[tt] = 0.f; esel[tt] = 0; }
#pragma unroll 1
            for (int k = 0; k < TOPK; ++k) {
#pragma unroll
                for (int tt = 0; tt < 4; ++tt) {
                    float bv = cv[tt][0]; int be = lane;
#pragma unroll
                    for (int j = 1; j < 4; ++j) if (cv[tt][j] > bv) { bv = cv[tt][j]; be = lane + 64 * j; }
                    const float rm = dpp_rowmax(bv);
                    const float mval = fmaxf(fmaxf(rl_f(rm, 0), rl_f(rm, 16)), fmaxf(rl_f(rm, 32), rl_f(rm, 48)));
                    const int ri = dpp_rowmin_i(bv == mval ? be : 0x7fffffff);
                    const int e = min(min(__builtin_amdgcn_readlane(ri, 0), __builtin_amdgcn_readlane(ri, 16)), min(__builtin_amdgcn_readlane(ri, 32), __builtin_amdgcn_readlane(ri, 48)));
                    const int jl = e >> 6, ll = e & 63;
                    const float smine = ((jl == 0 ? sc[tt][0] : 0.f) + (jl == 1 ? sc[tt][1] : 0.f)) + ((jl == 2 ? sc[tt][2] : 0.f) + (jl == 3 ? sc[tt][3] : 0.f));
                    const float sw = rl_f(smine, ll);
#pragma unroll
                    for (int j = 0; j < 4; ++j) cv[tt][j] = (lane == ll && jl == j) ? -INFINITY : cv[tt][j];
                    wsum[tt] += sw;
                    if (lane == k) { wsel[tt] = sw; esel[tt] = e; }
                }
            }
#pragma unroll
            for (int tt = 0; tt < 4; ++tt) {
                if (lane < TOPK) {
                    const int tok = it * 64 + wave * 8 + tg * 4 + tt;
                    const int a = tok * TOPK + lane;
                    P_topw[a] = wsel[tt] / wsum[tt] * 2.5f;
                    if (rep_ == 0) {
                        const int pos = atomicAdd(&cnt[esel[tt] * CNT_STRIDE], 1);
                        P_list[(size_t)esel[tt] * T + pos] = a;
                    }
                }
            }
        }
        __syncthreads();
    }
}

__device__ __forceinline__ void ph_gateup(int L, int rep_, const int wave_s_) {
    PH_FN_BEGIN
    (void)rep_;
    {
        PH_BEGIN;
        const float* weg = CTX_IN(8) + (size_t)L * NE * D * DF; const float* weu = CTX_IN(9) + (size_t)L * NE * D * DF;
        LAS int* rowva = (LAS int*)(lds + MOE_LDS_VA);
        {
            int* octr = (int*)(ws + WS_CTL + CTL_CNT_OFF + 8192) + (L * 4 + 2 * (rep_ & 1)) * 64;
            LAS int* slot = (LAS int*)(lds + 140000);
            for (;;) {
                __syncthreads();
                if (tid == 0) { int q; do { q = atomicAdd(octr, 1); } while (q >= NE && q < NE * 5 && cnt[((q - NE) >> 2) * CNT_STRIDE] <= MOE_XCAP); *slot = q; }
                __syncthreads();
                const int q = *slot;
                if (q >= NE * 5) break;
                const bool ovf = q >= NE;
                const int e = ovf ? (q - NE) >> 2 : q, pz = ovf ? (q - NE) & 3 : 0, npz = ovf ? 1 : 4, st0 = ovf ? 1 : 0, n = cnt[e * CNT_STRIDE];
                for (int r0 = 0; r0 < n; r0 += 1024) {
                    if (ovf && n - r0 <= MOE_XCAP) break;
#pragma unroll
                    for (int i = 0; i < 2; ++i) { int t_ = tid; asm volatile("" : "+v"(t_)); const int idx = r0 + i * 512 + t_; rowva[i * 512 + t_] = idx < n ? P_list[(size_t)e * T + idx] : TRASH_VA; }
                    __syncthreads();
                    moe_expert<false>(lds, tid, lane, wave, r32, hi, P_xb8, weg + (size_t)e * D * DF, weu + (size_t)e * D * DF, (n - r0) < 1024 ? (n - r0) : 1024, (void*)P_hb, pz, npz, st0, 1, false, !ovf && (n - r0) > 512 && (n - r0) <= MOE_XCAP);
                }
            }
        }
    }
    {
        PH_BEGIN;
        const pg8::Gemm g{P_xb, (const u16*)(ws + WS_WSGU) + (size_t)L * 512 * 1024, T, 512, D};
        const EpiSGU E{P_hbs};
        int* qctr = (int*)(ws + WS_CTL + CTL_CNT_OFF + 4096) + (L * 4 + 2 * (rep_ & 1)) * 64;
        LAS int* slot = (LAS int*)(lds + 140000);
        for (;;) {
            __syncthreads();
            if (tid == 0) *slot = atomicAdd(qctr, 1);
            __syncthreads();
            const int un = *slot;
            if (un >= 128) break;
            const pg8::FixedOrder S{un & 63, un >> 6};
            pg8::gemm_phase<EpiSGU, pg8::FixedOrder, false>((PG8_LAS unsigned char*)lds, g, S, E, nullptr, wave_s_ * 64 + lane_id_());
        }
    }
}

__device__ __forceinline__ void ph_down(int L, int rep_, const int wave_s_) {
    PH_FN_BEGIN
    (void)rep_;
    {
        PH_BEGIN;
        const float* wed = CTX_IN(10) + (size_t)L * NE * DF * D;
        LAS int* rowva = (LAS int*)(lds + MOE_LDS_VA); LAS float* roww = (LAS float*)(lds + MOE_LDS_W);
        {
            int* octr = (int*)(ws + WS_CTL + CTL_CNT_OFF + 8192) + (L * 4 + 1 + 2 * (rep_ & 1)) * 64;
            LAS int* slot = (LAS int*)(lds + 140000);
            for (;;) {
                __syncthreads();
                if (tid == 0) { int q; do { q = atomicAdd(octr, 1); } while (q >= NE && q < NE * 5 && cnt[((q - NE) >> 2) * CNT_STRIDE] <= 512); *slot = q; }
                __syncthreads();
                const int q = *slot;
                if (q >= NE * 5) break;
                const bool ovf = q >= NE;
                const int e = ovf ? (q - NE) >> 2 : q, pz = ovf ? ((q - NE) & 3) * 2 : 0, npz = ovf ? 2 : 8, st0 = ovf ? 1 : 0, n = cnt[e * CNT_STRIDE];
                for (int r0 = 0; r0 < n; r0 += 1024) {
                    if (ovf && n - r0 <= 512) break;
#pragma unroll
                    for (int i = 0; i < 2; ++i) { int t_ = tid; asm volatile("" : "+v"(t_)); const int idx = r0 + i * 512 + t_; const int va = idx < n ? P_list[(size_t)e * T + idx] : TRASH_VA; rowva[i * 512 + t_] = va; roww[i * 512 + t_] = va < A_TOT ? P_topw[va] * Y8_SCALE : 0.f; }
                    __syncthreads();
                    moe_expert<true>(lds, tid, lane, wave, r32, hi, (const unsigned char*)P_hb, wed + (size_t)e * DF * D, nullptr, (n - r0) < 1024 ? (n - r0) : 1024, (void*)P_yb, pz, npz, st0, 1, true);
                }
            }
        }
    }
    {
        PH_BEGIN;
        const pg8::Gemm g{P_hbs, (const u16*)(ws + WS_WSD) + (size_t)L * D * DF, T, D, DF};
        const EpiSD E{P_yb};
        int* qctr = (int*)(ws + WS_CTL + CTL_CNT_OFF + 4096) + (L * 4 + 1 + 2 * (rep_ & 1)) * 64;
        LAS int* slot = (LAS int*)(lds + 140000);
        for (;;) {
            __syncthreads();
            if (tid == 0) *slot = atomicAdd(qctr, 1);
            __syncthreads();
            const int un = *slot;
            if (un >= 256) break;
            const pg8::FixedOrder S{un & 63, un >> 6};
            pg8::gemm_phase<EpiSD, pg8::FixedOrder, false>((PG8_LAS unsigned char*)lds, g, S, E, nullptr, wave_s_ * 64 + lane_id_());
        }
    }
}

__device__ __forceinline__ void ph_combine(int L, int rep_, const int wave_s_) {
    PH_FN_BEGIN
    (void)rep_;
    PH_BEGIN;
    const float* lng = CTX_IN(14) + L * D; const float* lnb = CTX_IN(15) + L * D;
    float* dst = AS_GLOBAL(float, ctx_ld(16));
    for (int row = bid * 8 + wave; row < T; row += G * 8) {
        u32x4 yv[TOPK + 1][2];
#pragma unroll
        for (int k = 0; k < TOPK + 1; ++k) {
            const size_t va = k < TOPK ? (size_t)row * TOPK + k : (size_t)A_TOT + row;
            if (k < TOPK) {
#pragma unroll
                for (int j = 0; j < 2; ++j) { const u32x2 w8 = *(const u32x2*)((const unsigned char*)P_yb + va * D + j * 512 + lane * 8); yv[k][j][0] = w8[0]; yv[k][j][1] = w8[1]; yv[k][j][2] = 0u; yv[k][j][3] = 0u; }
            } else {
#pragma unroll
                for (int j = 0; j < 2; ++j) yv[k][j] = *(const u32x4*)(P_yb + va * D + j * 512 + lane * 8);
            }
        }
        float v[16];
#pragma unroll
        for (int j = 0; j < 2; ++j) {
            const u32x4 t = *(const u32x4*)(P_xb + (size_t)row * D + j * 512 + lane * 8);
#pragma unroll
            for (int c = 0; c < 4; ++c) { v[j * 8 + 2 * c] = DN_ALPHA * bf2f(t[c] & 0xFFFFu); v[j * 8 + 2 * c + 1] = DN_ALPHA * bf2f(t[c] >> 16); }
        }
#pragma unroll
        for (int k = 0; k < TOPK + 1; ++k)
#pragma unroll
            for (int j = 0; j < 2; ++j) {
                if (k < TOPK) {
#pragma unroll
                    for (int c = 0; c < 2; ++c) {
                        const f32x2_ lo2 = __builtin_amdgcn_cvt_pk_f32_fp8((int)yv[k][j][c], false), hi2 = __builtin_amdgcn_cvt_pk_f32_fp8((int)yv[k][j][c], true);
                        v[j * 8 + 4 * c] += lo2[0] * (1.f / Y8_SCALE); v[j * 8 + 4 * c + 1] += lo2[1] * (1.f / Y8_SCALE); v[j * 8 + 4 * c + 2] += hi2[0] * (1.f / Y8_SCALE); v[j * 8 + 4 * c + 3] += hi2[1] * (1.f / Y8_SCALE);
                    }
                } else {
#pragma unroll
                    for (int c = 0; c < 4; ++c) { v[j * 8 + 2 * c] += bf2f(yv[k][j][c] & 0xFFFFu); v[j * 8 + 2 * c + 1] += bf2f(yv[k][j][c] >> 16); }
                }
            }
        float sm = 0.f;
#pragma unroll
        for (int i = 0; i < 16; ++i) sm += v[i];
        const float mu = wave_sum(sm) * (1.f / D);
        float q = 0.f;
#pragma unroll
        for (int i = 0; i < 16; ++i) { const float d = v[i] - mu; q += d * d; }
        const float rstd = rsqrtf(wave_sum(q) * (1.f / D) + LN_EPS);
#pragma unroll
        for (int j = 0; j < 2; ++j) {
            const f32x4 g0 = *(const f32x4*)(lng + j * 512 + lane * 8), g1 = *(const f32x4*)(lng + j * 512 + lane * 8 + 4);
            const f32x4 b0 = *(const f32x4*)(lnb + j * 512 + lane * 8), b1 = *(const f32x4*)(lnb + j * 512 + lane * 8 + 4);
            f32x4 o0, o1;
#pragma unroll
            for (int c = 0; c < 4; ++c) { o0[c] = (v[j * 8 + c] - mu) * rstd * g0[c] + b0[c]; o1[c] = (v[j * 8 + 4 + c] - mu) * rstd * g1[c] + b1[c]; }
            if (L == 1) { *(f32x4*)(dst + (size_t)row * D + j * 512 + lane * 8) = o0; *(f32x4*)(dst + (size_t)row * D + j * 512 + lane * 8 + 4) = o1; }
            if (L == 0) { u32x4 w; w[0] = cvtpk(o0[0], o0[1]); w[1] = cvtpk(o0[2], o0[3]); w[2] = cvtpk(o1[0], o1[1]); w[3] = cvtpk(o1[2], o1[3]); *(u32x4*)(P_xb + (size_t)row * D + j * 512 + lane * 8) = w;
                if (QKV_FP8) { u32x2 w8; w8[0] = pack_fp8x4(o0[0], o0[1], o0[2], o0[3]); w8[1] = pack_fp8x4(o1[0], o1[1], o1[2], o1[3]); *(u32x2*)(P_xq8 + (size_t)row * D + j * 512 + lane * 8) = w8; } }
        }
    }
}

__global__ void __launch_bounds__(NTHR, 2) fwd(Args args) {
    extern __shared__ __attribute__((aligned(16))) unsigned char lds_raw[];
    LAS char* lds = (LAS char*)lds_raw;
    unsigned char* const ws = args.ws;
    const int lo = args.ph_lo, hi_ph = args.ph_hi;
    const int wave_s_ = __builtin_amdgcn_readfirstlane(threadIdx.x >> 6);
    if (threadIdx.x < 18) {
        const uint64_t v = threadIdx.x < 16 ? (uint64_t)args.in[threadIdx.x] : (threadIdx.x == 16 ? (uint64_t)args.out : (uint64_t)args.ws);
        ((LAS uint64_t*)(lds + LDS_CTX))[threadIdx.x] = v;
    }
    __syncthreads();
#define IN(k) (lo <= (k) && (k) < hi_ph)

#if MK_ONE_LAUNCH
    if (threadIdx.x < 4) ((LAS unsigned*)(lds + LDS_BAR))[threadIdx.x] = 0u;
    __syncthreads();
    XcdBarrier bar = xcd_barrier_post((unsigned*)(ws + WS_CTL), (volatile LAS unsigned*)(lds + LDS_BAR), wave_s_ == 0 && lane_id_() == 0);
#define GRID_BAR() xcd_barrier(bar, wave_s_ == 0 && lane_id_() == 0)
#else
#define GRID_BAR() do { } while (0)
#endif
#define SEAM(k) do { if (IN(k) && IN((k) + 1)) GRID_BAR(); } while (0)

    for (int rep_ = 0; rep_ < ((IN(0) && PHK(0)) ? REPS(0) : 0); ++rep_) { ph_p0(0, rep_, wave_s_); }
    SEAM(0);

    for (int L = 0; L < 2; ++L) {
        const int pb = 1 + 10 * L;
        for (int rep_ = 0; rep_ < ((IN(pb + 0) && PHK(1)) ? REPS(1) : 0); ++rep_) { ph_qkv(L, rep_, wave_s_); }
        SEAM(pb + 0);

        if (L == 0) {
            for (int rep_ = 0; rep_ < ((IN(pb + 1) && PHK(2)) ? REPS(2) : 0); ++rep_) { ph_kmean(L, rep_, wave_s_); }
            SEAM(pb + 1);
            for (int rep_ = 0; rep_ < ((IN(pb + 2) && PHK(11)) ? REPS(11) : 0); ++rep_) { ph_gate(L, rep_, wave_s_); }
            SEAM(pb + 2);
        }

        if (L == 0) {
            for (int rep_ = 0; rep_ < ((IN(pb + 3) && PHK(3)) ? REPS(3) : 0); ++rep_) { ph_moba(L, rep_, wave_s_); }
            SEAM(pb + 3);
            for (int rep_ = 0; rep_ < ((IN(pb + 4) && PHK(12)) ? REPS(12) : 0); ++rep_) { ph_mobamerge(L, rep_, wave_s_); }
        } else {
            for (int rep_ = 0; rep_ < ((IN(pb + 3) && PHK(4)) ? REPS(4) : 0); ++rep_) { ph_dil(L, rep_, wave_s_); }
            SEAM(pb + 3);
            for (int rep_ = 0; rep_ < ((IN(pb + 4) && PHK(5)) ? REPS(5) : 0); ++rep_) { ph_merge(L, rep_, wave_s_); }
        }
        SEAM(pb + 4);

        for (int rep_ = 0; rep_ < ((IN(pb + 5) && PHK(6)) ? REPS(6) : 0); ++rep_) { ph_wo(L, rep_, wave_s_); }
        SEAM(pb + 5);

        for (int rep_ = 0; rep_ < ((IN(pb + 6) && PHK(7)) ? REPS(7) : 0); ++rep_) { ph_router(L, rep_, wave_s_); }
        SEAM(pb + 6);

        for (int rep_ = 0; rep_ < ((IN(pb + 7) && PHK(8)) ? REPS(8) : 0); ++rep_) { ph_gateup(L, rep_, wave_s_); }
        SEAM(pb + 7);

        for (int rep_ = 0; rep_ < ((IN(pb + 8) && PHK(9)) ? REPS(9) : 0); ++rep_) { ph_down(L, rep_, wave_s_); }
        SEAM(pb + 8);

        for (int rep_ = 0; rep_ < ((IN(pb + 9) && PHK(10)) ? REPS(10) : 0); ++rep_) { ph_combine(L, rep_, wave_s_); }
        if (L == 0) SEAM(pb + 9);
    }
}

extern "C" void kernel_launch(void* const* d_in, const int* in_sizes, int n_in, void* d_out, int out_size, void* d_ws, size_t ws_size, hipStream_t stream) {
    static int grid = 0;
    if (grid == 0) {
        if (n_in != 16 || out_size != T * D || ws_size < WS_END3) { fprintf(stderr, "kernel_launch: unexpected problem (n_in %d out %d ws %zu need %zu)\n", n_in, out_size, ws_size, (size_t)WS_END2); grid = -1; return; }
        int dev = 0, cus = 0, per_cu = 0;
        if (hipGetDevice(&dev) != hipSuccess || hipDeviceGetAttribute(&cus, hipDeviceAttributeMultiprocessorCount, dev) != hipSuccess) { grid = -1; return; }
        if (hipFuncSetAttribute((const void*)fwd, hipFuncAttributeMaxDynamicSharedMemorySize, LDS_BYTES) != hipSuccess) { fprintf(stderr, "kernel_launch: hipFuncSetAttribute failed\n"); grid = -1; return; }
        if (hipOccupancyMaxActiveBlocksPerMultiprocessor(&per_cu, (const void*)fwd, NTHR, LDS_BYTES) != hipSuccess || per_cu < 1) { fprintf(stderr, "kernel_launch: occupancy query says %d\n", per_cu); (void)hipGetLastError(); per_cu = 1; }
        grid = cus;
    }
    if (grid < 0) return;
    (void)hipMemsetAsync((char*)d_ws + WS_CTL, 0, CTL_BYTES, stream);
    Args a{};
    for (int i = 0; i < 16; ++i) a.in[i] = (const float*)d_in[i];
    a.out = (float*)d_out; a.ws = (unsigned char*)d_ws;
#if MK_ONE_LAUNCH
    a.ph_lo = 0; a.ph_hi = N_PHASES;
    hipLaunchKernelGGL(fwd, dim3(grid), dim3(NTHR), LDS_BYTES, stream, a);
#else
    for (int ph = 0; ph < N_PHASES; ++ph) {
        if (ph == 12 || ph == 13) continue;
        a.ph_lo = ph; a.ph_hi = ph + 1;
        hipLaunchKernelGGL(fwd, dim3(grid), dim3(NTHR), LDS_BYTES, stream, a);
    }
#endif
}
```

```cpp
#include <hip/hip_runtime.h>
#include <hip/hip_bf16.h>
#include <stdint.h>
#include <stdio.h>

#ifndef MK_ONE_LAUNCH
#define MK_ONE_LAUNCH 1
#endif

#ifndef PHMASK
#define PHMASK 0x1FFF
#endif
#define PHK(k) ((PHMASK >> (k)) & 1)
#ifndef REPEAT_KIND
#define REPEAT_KIND -1
#endif
#define REPS(k) ((k) == REPEAT_KIND ? 2 : 1)
#define LAS __attribute__((address_space(3)))
typedef __attribute__((ext_vector_type(8))) short bf16x8;
typedef __attribute__((ext_vector_type(16))) float f32x16;
typedef __attribute__((ext_vector_type(4))) float f32x4;
typedef __attribute__((ext_vector_type(4))) unsigned u32x4;
typedef __attribute__((ext_vector_type(2))) unsigned u32x2;
typedef unsigned short u16;

constexpr int D = 1024, BATCH = 2, SEQ = 8192, T = BATCH * SEQ, NH = 16, HD = 64;
constexpr int NE = 256, TOPK = 8, DF = 256;
constexpr int A_TOT = T * TOPK;
constexpr int MOBA_BLK = 256, MOBA_NB = SEQ / MOBA_BLK;
constexpr float DN_ALPHA = 1.4142135623730951f;
constexpr float LN_EPS = 1e-5f;
constexpr float LOG2E = 1.4426950408889634f;
constexpr float LN2 = 0.6931471805599453f;
constexpr float NEGV = -1e30f;
constexpr int NTHR = 512;

constexpr size_t al256(size_t x) { return (x + 255) & ~(size_t)255; }
constexpr size_t WS_CTL = 0;
constexpr size_t CTL_BYTES = 131072;
constexpr size_t CTL_CNT_OFF = 32768;
constexpr size_t CTL_XQ_OFF = 45056;
constexpr size_t CTL_ECNT_OFF = 65536;
constexpr int CNT_STRIDE = 32;
constexpr size_t WS_XB = WS_CTL + CTL_BYTES;
constexpr size_t WS_X1 = WS_XB + al256((size_t)T * D * 2);
constexpr size_t WS_X2 = WS_X1 + al256((size_t)T * D * 4);
constexpr size_t WS_YPRE = WS_X2 + al256((size_t)T * D * 4);
constexpr size_t WS_QKV = WS_YPRE + al256((size_t)T * D * 4);
constexpr size_t WS_VT = WS_QKV + al256((size_t)T * 9216 * 2);
constexpr size_t WS_KM = WS_VT + al256((size_t)3 * T * D * 2);
constexpr size_t WS_AO = WS_KM + al256((size_t)BATCH * NH * MOBA_NB * HD * 4);
constexpr size_t WS_OG = WS_AO + al256((size_t)T * D * 2);
constexpr size_t WS_LSE = WS_OG + al256((size_t)3 * T * D * 2);
constexpr size_t WS_TOPW = WS_LSE + al256((size_t)3 * T * NH * 4);
constexpr size_t WS_LIST = WS_TOPW + al256((size_t)T * TOPK * 4);
constexpr size_t WS_HB = WS_LIST + al256((size_t)NE * T * 4);
constexpr size_t WS_YB = WS_HB + al256((size_t)(A_TOT + T + 1) * DF * 2);
constexpr size_t WS_END = WS_YB + al256((size_t)(A_TOT + T + 1) * D * 2);
constexpr int TRASH_VA = A_TOT + T;
constexpr size_t WS_SELM = WS_END;
constexpr size_t WS_PART = WS_SELM + al256((size_t)T * NH * 4);
constexpr size_t WS_PLSE = WS_PART + al256((size_t)T * NH * 4 * 64 * 2);
constexpr size_t WS_WQK0 = WS_PLSE + al256((size_t)T * NH * 4 * 4);
constexpr size_t WS_WV0 = WS_WQK0 + (size_t)2048 * 1024 * 2;
constexpr size_t WS_WQK1 = WS_WV0 + (size_t)1024 * 1024 * 2;
constexpr size_t WS_WV1 = WS_WQK1 + (size_t)6144 * 1024 * 2;
constexpr size_t WS_WO = WS_WV1 + (size_t)3072 * 1024 * 2;
constexpr size_t WS_WSGU = WS_WO + (size_t)2 * 1024 * 1024 * 2;
constexpr size_t WS_WSD = WS_WSGU + (size_t)2 * 512 * 1024 * 2;
constexpr size_t WS_XB8 = WS_WSD + (size_t)2 * 1024 * 256 * 2;
constexpr size_t WS_HBS = WS_XB8 + (size_t)T * D;
constexpr size_t WS_WRH = WS_HBS + (size_t)T * DF * 2;
constexpr size_t WS_WRL = WS_WRH + (size_t)2 * 256 * 1024 * 2;
constexpr size_t WS_END2 = WS_WRL + (size_t)2 * 256 * 1024 * 2;
constexpr size_t WS_XQ8 = WS_END2;
constexpr size_t WS_WQ8 = WS_XQ8 + (size_t)T * D;
constexpr size_t WS_WO8 = WS_WQ8 + (size_t)(3072 + 9216) * 1024;
constexpr size_t WS_END3 = WS_WO8 + (size_t)2 * 1024 * 1024;
#ifndef WO_FP8
#define WO_FP8 1
#endif
constexpr float AO8_SCALE = 16.f;
#ifndef QKV_FP8
#define QKV_FP8 2
#endif

constexpr int LDP = 40;
constexpr int STAGE_BYTES = 2 * 256 * LDP * 2;
constexpr int LDS_ROWID = 2 * STAGE_BYTES;
constexpr int LDS_ROWW = LDS_ROWID + 1024;
constexpr int XS_PITCH = 1028;
constexpr int LDS_BYTES = 163840;
constexpr int LDS_BAR = 161792;

__device__ __forceinline__ int lane_id_() { int l; asm volatile("v_mbcnt_lo_u32_b32 %0, -1, 0\n\tv_mbcnt_hi_u32_b32 %0, -1, %0" : "=v"(l)); return l; }
__device__ __forceinline__ float shxf(float v, int m, int lane) { return __int_as_float(__builtin_amdgcn_ds_bpermute((lane ^ m) << 2, __float_as_int(v))); }
__device__ __forceinline__ int shxi(int v, int m, int lane) { return __builtin_amdgcn_ds_bpermute((lane ^ m) << 2, v); }
#define XB_TMO      128
#define XB_XCNT(j)  (256  + 64 * (j))
#define XB_XSUB(j)  (1280 + 64 * (j))
#define XB_XGEN(j)  (2304 + 64 * (j))
#define XB_TOP      3328
#define XB_TOPGEN   3392
#define XCD_BAR_WORDS 3456
#define XB_SPIN_CAP (1u << 18)
__device__ __forceinline__ unsigned xb_ld(unsigned* p)              { return __hip_atomic_load(p, __ATOMIC_RELAXED, __HIP_MEMORY_SCOPE_AGENT); }
__device__ __forceinline__ unsigned xb_add(unsigned* p, unsigned v) { return __hip_atomic_fetch_add(p, v, __ATOMIC_RELAXED, __HIP_MEMORY_SCOPE_AGENT); }
__device__ __forceinline__ unsigned xb_xcc_id() { return (unsigned)__builtin_amdgcn_s_getreg((3 << 11) | 20) & 0xFu; }
#define XB_SPIN(cond, bar) do { unsigned _sp = 0; while (cond) { __builtin_amdgcn_s_sleep(1); \
    if ((++_sp & 255u) == 0u) { if (xb_ld(&(bar)[XB_TMO])) break; if (_sp > XB_SPIN_CAP) { atomicAdd(&(bar)[XB_TMO], 1u); break; } } } } while (0)
struct XcdBarrier { unsigned* bar; unsigned x; volatile LAS unsigned* st; };
__device__ __forceinline__ XcdBarrier xcd_barrier_post(unsigned* bar, volatile LAS unsigned* st, const bool leader) {
    XcdBarrier b; b.bar = bar; b.x = xb_xcc_id(); b.st = st;
    if (leader) (void)xb_add(&bar[XB_XCNT(b.x)], 1u);
    return b;
}
__device__ __forceinline__ void xcd_barrier_complete(unsigned* bar, unsigned x, unsigned& nloc, unsigned& nx) {
    const unsigned G = gridDim.x * gridDim.y * gridDim.z;
    unsigned sum, cnt, mine, sp = 0u;
    for (;;) {
        sum = 0u; cnt = 0u; mine = 0u;
#pragma unroll
        for (unsigned j = 0; j < 16; ++j) { const unsigned c = xb_ld(&bar[XB_XCNT(j)]); sum += c; cnt += (c > 0u) ? 1u : 0u; mine = (j == x) ? c : mine; }
        if (sum == G) break;
        __builtin_amdgcn_s_sleep(1);
        if ((++sp & 255u) == 0u) { if (xb_ld(&bar[XB_TMO])) break; if (sp > XB_SPIN_CAP) { atomicAdd(&bar[XB_TMO], 1u); break; } }
    }
    nloc = mine > 0u ? mine : 1u; nx = cnt > 0u ? cnt : 1u;
}
__device__ __forceinline__ void xcd_barrier(const XcdBarrier& b, const bool leader) {
    asm volatile("s_waitcnt vmcnt(0)" ::: "memory");
    __syncthreads();
    if (leader) {
        unsigned* bar = b.bar;
        __builtin_amdgcn_s_waitcnt(0);
        unsigned nloc = b.st[0], nx = b.st[1];
        if (nloc == 0u) { xcd_barrier_complete(bar, b.x, nloc, nx); b.st[0] = nloc; b.st[1] = nx; }
        const unsigned old = xb_add(&bar[XB_XSUB(b.x)], 1u);
        const unsigned gen = old / nloc;
        if (old + 1u == (gen + 1u) * nloc) {
            __builtin_amdgcn_fence(__ATOMIC_RELEASE, "agent");
            asm volatile("s_waitcnt vmcnt(0)" ::: "memory");
            const unsigned og = xb_add(&bar[XB_TOP], 1u);
            const unsigned tg = og / nx;
            if (og + 1u == (tg + 1u) * nx) xb_add(&bar[XB_TOPGEN], 1u);
            else XB_SPIN(xb_ld(&bar[XB_TOPGEN]) == tg, bar);
            __builtin_amdgcn_fence(__ATOMIC_ACQUIRE, "agent");
            xb_add(&bar[XB_XGEN(b.x)], 1u);
            asm volatile("s_waitcnt vmcnt(0)" ::: "memory");
        } else {
            XB_SPIN(xb_ld(&bar[XB_XGEN(b.x)]) == gen, bar);
            __builtin_amdgcn_fence(__ATOMIC_ACQUIRE, "agent");
            asm volatile("s_waitcnt vmcnt(0)" ::: "memory");
        }
    }
    __syncthreads();
}

typedef __attribute__((ext_vector_type(2))) __bf16 bf16x2_t;
typedef __attribute__((ext_vector_type(2))) float f32x2_t;
__device__ __forceinline__ unsigned cvtpk(float lo, float hi) { f32x2_t f; f[0] = lo; f[1] = hi; return __builtin_bit_cast(unsigned, __builtin_convertvector(f, bf16x2_t)); }
__device__ __forceinline__ float bf2f(unsigned v16) { return __uint_as_float(v16 << 16); }
__device__ __forceinline__ int crow(int r, int hi) { return (r & 3) + 8 * (r >> 2) + 4 * hi; }
#define MFMA_BF16(a, b, c) __builtin_amdgcn_mfma_f32_32x32x16_bf16(a, b, c, 0, 0, 0)
__device__ __forceinline__ float wave_sum(float v) {
    v += __int_as_float(__builtin_amdgcn_update_dpp(0, __float_as_int(v), 0xB1, 0xF, 0xF, true));
    v += __int_as_float(__builtin_amdgcn_update_dpp(0, __float_as_int(v), 0x4E, 0xF, 0xF, true));
    v += __int_as_float(__builtin_amdgcn_update_dpp(0, __float_as_int(v), 0x141, 0xF, 0xF, true));
    v += __int_as_float(__builtin_amdgcn_update_dpp(0, __float_as_int(v), 0x140, 0xF, 0xF, true));
    const int vi = __float_as_int(v);
    return (__int_as_float(__builtin_amdgcn_readlane(vi, 0)) + __int_as_float(__builtin_amdgcn_readlane(vi, 16))) + (__int_as_float(__builtin_amdgcn_readlane(vi, 32)) + __int_as_float(__builtin_amdgcn_readlane(vi, 48)));
}

namespace pg8 {
#define PG8_LAS __attribute__((address_space(3)))
typedef unsigned short bf16_t;
typedef short bf16x8 __attribute__((ext_vector_type(8)));
typedef float f32x4 __attribute__((ext_vector_type(4)));
typedef unsigned u32x4 __attribute__((ext_vector_type(4)));
typedef int pg8_i32x8 __attribute__((ext_vector_type(8)));
constexpr int BM = 256, BK = 64, HALF = 128, HTB = HALF * BK * 2  , STAGE_BYTES = 8 * HTB, NXCD = 8, WGM = 8;

__host__ __device__ __forceinline__ int lds_byte(int r, int c) { const int st = (r >> 4) * 2 + (c >> 5), rr = r & 15, cc = c & 31, ob = rr * 64 + cc * 2; return st * 1024 + (ob ^ (((ob >> 9) & 1) << 5)); }
__host__ __device__ __forceinline__ void stage_rc(int b, int& R, int& C) { const int st = b / 1024, sb = b % 1024, swz = sb ^ (((sb >> 9) & 1) << 5); R = (st >> 1) * 16 + swz / 64; C = (st & 1) * 32 + (swz % 64) / 2; }
__device__ __forceinline__ int pg8_opq(int v) { asm volatile("" : "+v"(v)); return v; }
__host__ __device__ __forceinline__ int perm32(int rho) { const int n = rho >> 4, i = rho & 15; return 8 * (i >> 2) + 4 * n + (i & 3); }

struct Unit { int pm, pn; };
struct Gemm { const bf16_t* A; const bf16_t* Bt; int M, N, K; };
struct FixedOrder {
    int pm, pn;
    __device__ __forceinline__ bool next(int i, Unit& u) const { if (i != 0) return false; u.pm = pm; u.pn = pn; return true; }
    __device__ __forceinline__ void a_ready(const Unit&) const {}
    __device__ __forceinline__ void done(const Unit&) const {}
};

struct StaticOrder {
    int nM, nN, nwg, G, c;
    __host__ __device__ void init(int M, int N, int G_, int c_) { nM = M / BM; nN = N / BM; nwg = nM * nN; G = G_; c = c_; }
    __host__ __device__ bool next(int i, Unit& u) const {
        const long L = (long)i * G + c; if (L >= nwg) return false;
        int wgid = (int)L; { const int q = nwg / NXCD, r = nwg % NXCD, xcd = wgid % NXCD, off = wgid / NXCD; wgid = (xcd < r ? xcd * (q + 1) : r * (q + 1) + (xcd - r) * q) + off; }
        const int nig = WGM * nN, gid = wgid / nig, fm = gid * WGM, gsz = (nM - fm) < WGM ? (nM - fm) : WGM;
        u.pm = fm + ((wgid % nig) % gsz); u.pn = (wgid % nig) / gsz; return true;
    }
    __device__ __forceinline__ void a_ready(const Unit&) const {}
    __device__ __forceinline__ void done(const Unit&) const {}
};

template <class Epi, class Sched, bool SWAP = false, bool STAMP = false, bool F8 = false, int F8SC = 0x7F79  >
__device__ __forceinline__ void gemm_phase(PG8_LAS unsigned char* lds, const Gemm g, const Sched& S, const Epi& E, unsigned long long* stamps, const int tid_in) {
    int tid_ = tid_in; asm volatile("" : "+v"(tid_));
    const int tid = tid_, wid = __builtin_amdgcn_readfirstlane(tid >> 6), lane = tid & 63, wr = wid >> 2, wc = wid & 3, fr = lane & 15, fq = lane >> 4;
    const int K = g.K, nt = K / BK;
    int ts_lo = 0, ts_hi = 0, nts = 0; const unsigned long long rt_entry = STAMP ? (unsigned long long)wall_clock64() : 0ull;
#define PG8_STAMP() do { if (STAMP && wid == 0 && nts < 64) { const unsigned long long _c = (unsigned long long)clock64(); \
        ts_lo = (lane == nts) ? (int)(unsigned)_c : ts_lo; ts_hi = (lane == nts) ? (int)(unsigned)(_c >> 32) : ts_hi; ++nts; } } while (0)
    PG8_STAMP();
    unsigned voffA[2], voffB[2];
#pragma unroll
    for (int i = 0; i < 2; ++i) { int R, C; stage_rc(tid * 16 + i * 8192, R, C); const int Rb = Epi::PERM ? ((R & ~31) + perm32(R & 31)) : R;
        voffA[i] = (unsigned)(R * K + C) * 2u; voffB[i] = (unsigned)(Rb * K + C) * 2u; }
    const size_t kstep = (size_t)(BK * 2);
    const size_t hstep = (size_t)HALF * K * 2;
    const size_t tstep = 2 * hstep;
    const unsigned ldsw = (unsigned)wid * 1024u;
    int xoff_ = lds_byte(fr, fq * 8); asm volatile("" : "+v"(xoff_));
    const int aoffs = wr * 8192, boffs = wc * 4096;
#define aoff (aoffs + pg8_opq(xoff_))
#define boff (boffs + pg8_opq(xoff_))
#define PG8_SA(b, h) (((b) * 2 + (h)) * HTB)
#define PG8_SB(b, h) ((4 + (b) * 2 + (h)) * HTB)
#define PG8_STAGE(bufoff, gbase, voff) do {   \
        _Pragma("unroll") for (int _i = 0; _i < 2; ++_i) { uint64_t gb_ = (uint64_t)(gbase) + (uint64_t)_i * (size_t)(64 * 2) * K; asm volatile("" : "+s"(gb_)); unsigned vo_ = (voff)[0]; asm volatile("" : "+v"(vo_)); \
        __builtin_amdgcn_global_load_lds((const __attribute__((address_space(1))) unsigned*)((const __attribute__((address_space(1))) char*)gb_ + vo_), (PG8_LAS unsigned*)(lds + (bufoff) + ldsw + _i * 8192), 16, 0, 0); } } while (0)
#define PG8_CAT8(X0, X1) pg8_i32x8{(int)__builtin_bit_cast(u32x4, X0)[0], (int)__builtin_bit_cast(u32x4, X0)[1], (int)__builtin_bit_cast(u32x4, X0)[2], (int)__builtin_bit_cast(u32x4, X0)[3], \
                                   (int)__builtin_bit_cast(u32x4, X1)[0], (int)__builtin_bit_cast(u32x4, X1)[1], (int)__builtin_bit_cast(u32x4, X1)[2], (int)__builtin_bit_cast(u32x4, X1)[3]}
#define PG8_LDA(dst, b, h) do { _Pragma("unroll") for (int m = 0; m < 4; ++m) { if (F8) { const bf16x8 x0_ = *(const PG8_LAS bf16x8*)(lds + PG8_SA(b, h) + aoff + m * 2048), x1_ = *(const PG8_LAS bf16x8*)(lds + PG8_SA(b, h) + aoff + m * 2048 + 1024); dst##8[m] = PG8_CAT8(x0_, x1_); } \
        else { _Pragma("unroll") for (int k = 0; k < 2; ++k) dst[m][k] = *(const PG8_LAS bf16x8*)(lds + PG8_SA(b, h) + aoff + m * 2048 + k * 1024); } } } while (0)
#define PG8_LDB(dst, b, h) do { _Pragma("unroll") for (int n = 0; n < 2; ++n) { if (F8) { const bf16x8 x0_ = *(const PG8_LAS bf16x8*)(lds + PG8_SB(b, h) + boff + n * 2048), x1_ = *(const PG8_LAS bf16x8*)(lds + PG8_SB(b, h) + boff + n * 2048 + 1024); dst##8[n] = PG8_CAT8(x0_, x1_); } \
        else { _Pragma("unroll") for (int k = 0; k < 2; ++k) dst[n][k] = *(const PG8_LAS bf16x8*)(lds + PG8_SB(b, h) + boff + n * 2048 + k * 1024); } } } while (0)
#define PG8_MMA(ai, bj, At, Bt) do { __builtin_amdgcn_s_setprio(1); _Pragma("unroll") for (int m = 0; m < 4; ++m) _Pragma("unroll") for (int n = 0; n < 2; ++n) _Pragma("unroll") for (int k = 0; k < 2; ++k) \
        { if (F8) { if (k == 0) acc[ai][bj][m][n] = __builtin_amdgcn_mfma_scale_f32_16x16x128_f8f6f4(Bt##8[n], At##8[m], acc[ai][bj][m][n], 0, 0, 0, F8SC, 1, F8SC); } \
          else acc[ai][bj][m][n] = SWAP ? __builtin_amdgcn_mfma_f32_16x16x32_bf16(At[m][k], Bt[n][k], acc[ai][bj][m][n], 0, 0, 0) : __builtin_amdgcn_mfma_f32_16x16x32_bf16(Bt[n][k], At[m][k], acc[ai][bj][m][n], 0, 0, 0); } __builtin_amdgcn_s_setprio(0); } while (0)
#define PG8_WAIT_V(n) asm volatile("s_waitcnt vmcnt(" #n ")" ::: "memory")
#define PG8_WAIT_L(n) asm volatile("s_waitcnt lgkmcnt(" #n ")" ::: "memory")
#define PG8_BAR __builtin_amdgcn_s_barrier()
#define PG8_SCHED __builtin_amdgcn_sched_barrier(0)
    Unit cur, nxt; int ui = 0;
    if (!S.next(0, cur)) return;
    f32x4 acc[2][2][4][2];
#pragma unroll
    for (int a = 0; a < 2; ++a)
#pragma unroll
        for (int b = 0; b < 2; ++b)
#pragma unroll
            for (int m = 0; m < 4; ++m)
#pragma unroll
                for (int n = 0; n < 2; ++n) acc[a][b][m][n] = (f32x4){0.f, 0.f, 0.f, 0.f};
    bf16x8 At[4][2], B0[2][2], B1[2][2];
    pg8_i32x8 At8[4], B08[2], B18[2];
    const char* cA = (const char*)g.A + (size_t)cur.pm * tstep; const char* cB = (const char*)g.Bt + (size_t)cur.pn * tstep;
    S.a_ready(cur);
    PG8_STAGE(PG8_SB(0, 0), cB, voffB); PG8_STAGE(PG8_SA(0, 0), cA, voffA); PG8_STAGE(PG8_SB(0, 1), cB + hstep, voffB); PG8_STAGE(PG8_SA(0, 1), cA + hstep, voffA);
    if (wr == 1) PG8_BAR;
    PG8_WAIT_V(4); PG8_BAR;
    PG8_STAGE(PG8_SB(1, 0), cB + kstep, voffB); PG8_STAGE(PG8_SA(1, 0), cA + kstep, voffA); PG8_STAGE(PG8_SB(1, 1), cB + hstep + kstep, voffB);
    PG8_WAIT_V(6); PG8_BAR;
    PG8_STAMP();
    for (;;) {
        const bool has_next = S.next(ui + 1, nxt);
        const char* nA = has_next ? (const char*)g.A + (size_t)nxt.pm * tstep : cA; const char* nB = has_next ? (const char*)g.Bt + (size_t)nxt.pn * tstep : cB;
        for (int t = 0; t < nt; t += 2) {
            const bool last = (t == nt - 2);
            const char* a1 = cA + (size_t)(t + 1) * kstep;
            const char* a2 = last ? nA : cA + (size_t)(t + 2) * kstep; const char* b2 = last ? nB : cB + (size_t)(t + 2) * kstep;
            const char* a3 = a2 + kstep; const char* b3 = b2 + kstep;
            if (last && has_next) S.a_ready(nxt);
            PG8_LDB(B0, 0, 0); PG8_SCHED; PG8_LDA(At, 0, 0); PG8_STAGE(PG8_SA(1, 1), a1 + hstep, voffA);
            PG8_WAIT_L(8); PG8_BAR; PG8_WAIT_L(0); PG8_MMA(0, 0, At, B0); PG8_BAR; PG8_SCHED;
            PG8_LDB(B1, 0, 1); PG8_STAGE(PG8_SB(0, 0), b2, voffB);
            PG8_BAR; PG8_WAIT_L(0); PG8_MMA(0, 1, At, B1); PG8_BAR;
            PG8_LDA(At, 0, 1); PG8_STAGE(PG8_SA(0, 0), a2, voffA);
            PG8_BAR; PG8_WAIT_L(0); PG8_MMA(1, 0, At, B0); PG8_BAR; PG8_SCHED;
            PG8_STAGE(PG8_SB(0, 1), b2 + hstep, voffB);
            PG8_WAIT_V(6); PG8_BAR; PG8_MMA(1, 1, At, B1); PG8_BAR;
            PG8_LDB(B0, 1, 0); PG8_SCHED; PG8_LDA(At, 1, 0); PG8_STAGE(PG8_SA(0, 1), a2 + hstep, voffA);
            PG8_WAIT_L(8); PG8_BAR; PG8_WAIT_L(0); PG8_MMA(0, 0, At, B0); PG8_BAR; PG8_SCHED;
            PG8_LDB(B1, 1, 1); PG8_STAGE(PG8_SB(1, 0), b3, voffB);
            PG8_BAR; PG8_WAIT_L(0); PG8_MMA(0, 1, At, B1); PG8_BAR;
            PG8_LDA(At, 1, 1); PG8_STAGE(PG8_SA(1, 0), a3, voffA);
            PG8_BAR; PG8_WAIT_L(0); PG8_MMA(1, 0, At, B0); PG8_BAR; PG8_SCHED;
            PG8_STAGE(PG8_SB(1, 1), b3 + hstep, voffB);
            PG8_WAIT_V(6); PG8_BAR; PG8_MMA(1, 1, At, B1); PG8_BAR;
        }
        PG8_STAMP();
        if constexpr (!Epi::AFTER_DRAIN) { const int le_ = lane_id_(); E(acc, cur, wr, wc, le_ & 15, le_ >> 4); S.done(cur); }
        PG8_STAMP();
        if (!has_next) break;
#pragma unroll
        for (int a = 0; a < 2; ++a)
#pragma unroll
            for (int b = 0; b < 2; ++b)
#pragma unroll
                for (int m = 0; m < 4; ++m)
#pragma unroll
                    for (int n = 0; n < 2; ++n) acc[a][b][m][n] = (f32x4){0.f, 0.f, 0.f, 0.f};
        cur = nxt; cA = nA; cB = nB; ++ui;
    }
    PG8_WAIT_V(0);
    if (wr == 0) PG8_BAR;
    PG8_BAR;
    if constexpr (Epi::AFTER_DRAIN) { E.fused(acc, cur, wr, wc, fr, fq, lds, wid, lane); S.done(cur); }
    PG8_STAMP();
    if (STAMP && wid == 0) { stamps[lane] = lane < nts ? (((unsigned long long)(unsigned)ts_hi << 32) | (unsigned)ts_lo) : 0ull;
        if (lane == 62) stamps[62] = rt_entry; if (lane == 63) stamps[63] = (unsigned long long)wall_clock64(); }
#undef PG8_STAMP
#undef PG8_SA
#undef PG8_SB
#undef PG8_STAGE
#undef aoff
#undef boff
#undef PG8_LDA
#undef PG8_LDB
#undef PG8_MMA
#undef PG8_WAIT_V
#undef PG8_WAIT_L
#undef PG8_BAR
#undef PG8_SCHED
}
}

struct EpiQK {
    static constexpr bool PERM = true, AFTER_DRAIN = false;
    u16* O; int ldc;
    __device__ __forceinline__ void operator()(const pg8::f32x4 (&acc)[2][2][4][2], const pg8::Unit& u, int wr, int wc, int fr, int fq) const {
        uint64_t ob_ = (uint64_t)O; asm volatile("" : "+s"(ob_));
        unsigned off0 = ((unsigned)(u.pm * 256 + wr * 64 + fr) * (unsigned)ldc + (unsigned)(u.pn * 256 + wc * 32 + 8 * fq)) * 2u; asm volatile("" : "+v"(off0));
        const unsigned rstep = (unsigned)ldc * 32u;
#pragma unroll
        for (int ai = 0; ai < 2; ++ai)
#pragma unroll
            for (int m = 0; m < 4; ++m) { unsigned ro = off0 + (unsigned)(ai * 8 + m) * rstep; asm volatile("" : "+v"(ro));
#pragma unroll
                for (int bj = 0; bj < 2; ++bj) { const pg8::f32x4 v0 = acc[ai][bj][m][0], v1 = acc[ai][bj][m][1];
                    u32x4 w; w[0] = cvtpk(v0[0], v0[1]); w[1] = cvtpk(v0[2], v0[3]); w[2] = cvtpk(v1[0], v1[1]); w[3] = cvtpk(v1[2], v1[3]);
                    *(__attribute__((address_space(1))) u32x4*)((__attribute__((address_space(1))) char*)ob_ + ro + bj * 256) = w; } }
    }
};
struct EpiV {
    static constexpr bool PERM = false, AFTER_DRAIN = false;
    u16* VT; int layer;
    __device__ __forceinline__ void operator()(const pg8::f32x4 (&acc)[2][2][4][2], const pg8::Unit& u, int wr, int wc, int fr, int fq) const {
        const int colt = u.pn * 256, grp = colt >> 10;
        const int dil = (layer == 0 || grp == 0) ? 1 : (grp == 1 ? 4 : 16);
        const int rowb = u.pm * 256 + wr * 64 + 4 * fq;
#pragma unroll
        for (int bj = 0; bj < 2; ++bj)
#pragma unroll
            for (int n = 0; n < 2; ++n) {
                const int c = (colt & 1023) + bj * 128 + wc * 32 + n * 16 + fr, h = c >> 6, d = c & 63;
#pragma unroll
                for (int ai = 0; ai < 2; ++ai)
#pragma unroll
                    for (int m = 0; m < 4; ++m) {
                        const int r0 = rowb + ai * 128 + m * 16, b = r0 >> 13, t0 = r0 & (SEQ - 1);
                        u16* vrow = VT + (size_t)grp * T * D + ((size_t)(b * NH + h) * HD + d) * SEQ;
                        const pg8::f32x4 v = acc[ai][bj][m][n];
                        if (dil == 1) { u32x2 w; w[0] = cvtpk(v[0], v[1]); w[1] = cvtpk(v[2], v[3]); *(u32x2*)(vrow + t0) = w; }
                        else {
#pragma unroll
                            for (int i = 0; i < 4; ++i) { const int pp = t0 + i; vrow[(pp % dil) * (SEQ / dil) + pp / dil] = (u16)cvtpk(v[i], 0.f); }
                        }
                    }
            }
    }
};
struct EpiWo {
    static constexpr bool PERM = true, AFTER_DRAIN = false;
    u16* Y; const u16* X;
    __device__ __forceinline__ void operator()(const pg8::f32x4 (&acc)[2][2][4][2], const pg8::Unit& u, int wr, int wc, int fr, int fq) const {
        const int row0 = u.pm * 256 + wr * 64 + fr, col0 = u.pn * 256 + wc * 32 + 8 * fq;
#pragma unroll
        for (int ai = 0; ai < 2; ++ai)
#pragma unroll
            for (int m = 0; m < 4; ++m) { const size_t ro = (size_t)(row0 + ai * 128 + m * 16) * D + col0;
#pragma unroll
                for (int bj = 0; bj < 2; ++bj) { const pg8::f32x4 v0 = acc[ai][bj][m][0], v1 = acc[ai][bj][m][1];
                    const u32x4 xr = *(const u32x4*)(X + ro + bj * 128);
                    u32x4 w;
                    w[0] = cvtpk(bf2f(xr[0] & 0xFFFFu) * DN_ALPHA + v0[0], bf2f(xr[0] >> 16) * DN_ALPHA + v0[1]); w[1] = cvtpk(bf2f(xr[1] & 0xFFFFu) * DN_ALPHA + v0[2], bf2f(xr[1] >> 16) * DN_ALPHA + v0[3]);
                    w[2] = cvtpk(bf2f(xr[2] & 0xFFFFu) * DN_ALPHA + v1[0], bf2f(xr[2] >> 16) * DN_ALPHA + v1[1]); w[3] = cvtpk(bf2f(xr[3] & 0xFFFFu) * DN_ALPHA + v1[2], bf2f(xr[3] >> 16) * DN_ALPHA + v1[3]);
                    *(u32x4*)(Y + ro + bj * 128) = w; } }
    }
};
struct EpiSGU {
    static constexpr bool PERM = true, AFTER_DRAIN = false;
    u16* H;
    __device__ __forceinline__ void operator()(const pg8::f32x4 (&acc)[2][2][4][2], const pg8::Unit& u, int wr, int wc, int fr, int fq) const {
        const int row0 = u.pm * 256 + wr * 64 + fr, f0 = u.pn * 128 + wc * 32 + 8 * fq;
#pragma unroll
        for (int ai = 0; ai < 2; ++ai)
#pragma unroll
            for (int m = 0; m < 4; ++m) {
                float hv[8];
#pragma unroll
                for (int n = 0; n < 2; ++n)
#pragma unroll
                    for (int i = 0; i < 4; ++i) { const float gt = acc[ai][0][m][n][i], up = acc[ai][1][m][n][i]; hv[n * 4 + i] = gt / (1.f + __expf(-gt)) * up; }
                u32x4 w; w[0] = cvtpk(hv[0], hv[1]); w[1] = cvtpk(hv[2], hv[3]); w[2] = cvtpk(hv[4], hv[5]); w[3] = cvtpk(hv[6], hv[7]);
                *(u32x4*)(H + (size_t)(row0 + ai * 128 + m * 16) * DF + f0) = w;
            }
    }
};
struct EpiSD {
    static constexpr bool PERM = true, AFTER_DRAIN = false;
    u16* Y;
    __device__ __forceinline__ void operator()(const pg8::f32x4 (&acc)[2][2][4][2], const pg8::Unit& u, int wr, int wc, int fr, int fq) const {
        const int row0 = u.pm * 256 + wr * 64 + fr, col0 = u.pn * 256 + wc * 32 + 8 * fq;
#pragma unroll
        for (int ai = 0; ai < 2; ++ai)
#pragma unroll
            for (int m = 0; m < 4; ++m) { u16* rowp = Y + (size_t)(A_TOT + row0 + ai * 128 + m * 16) * D + col0;
#pragma unroll
                for (int bj = 0; bj < 2; ++bj) { const pg8::f32x4 v0 = acc[ai][bj][m][0], v1 = acc[ai][bj][m][1];
                    u32x4 w; w[0] = cvtpk(v0[0], v0[1]); w[1] = cvtpk(v0[2], v0[3]); w[2] = cvtpk(v1[0], v1[1]); w[3] = cvtpk(v1[2], v1[3]);
                    *(u32x4*)(rowp + bj * 128) = w; } }
    }
};

struct Args {
    const float* in[16];
    float* out;
    unsigned char* ws;
    int ph_lo, ph_hi;
};

#define GEMM_CORE(K_, PA0, PA1, PB, LDB)                                                                                                   \
    {                                                                                                                                      \
        const int g_tid = tid, g_lane = lane, g_wave = wave, g_r32 = r32, g_hi = hi;                   \
        const int g_wm = g_wave >> 2, g_wn = g_wave & 3, g_kc = g_tid & 3, g_kq = g_lane >> 3, g_n4 = g_lane & 7;                           \
        const u16* g_pa0 = (PA0); const u16* g_pa1 = (PA1);                                                                                \
        const size_t g_ldb = (size_t)(LDB);                                                                                                \
        const float* g_pb = (PB) + (size_t)(g_kq * 4) * g_ldb + g_n4 * 4;                                                                  \
        const int g_nk = (K_) / 32;                                                                                                        \
        u32x4 g_ra0, g_ra1; f32x4 g_rb0, g_rb1, g_rb2, g_rb3;                                                                              \
        const u32x4 g_z = {0u, 0u, 0u, 0u};                                                                                                \
        _Pragma("unroll") for (int mb = 0; mb < 4; ++mb) { _Pragma("unroll") for (int nb = 0; nb < 2; ++nb) { _Pragma("unroll") for (int r = 0; r < 16; ++r) acc[mb][nb][r] = 0.f; } } \
        g_ra0 = g_pa0 ? *(const u32x4*)(g_pa0 + g_kc * 8) : g_z; g_ra1 = g_pa1 ? *(const u32x4*)(g_pa1 + g_kc * 8) : g_z;                 \
        g_rb0 = *(const f32x4*)(g_pb); g_rb1 = *(const f32x4*)(g_pb + g_ldb); g_rb2 = *(const f32x4*)(g_pb + 2 * g_ldb); g_rb3 = *(const f32x4*)(g_pb + 3 * g_ldb); \
        _Pragma("unroll 1") for (int kt = 0; kt < g_nk; ++kt) {                                                                            \
            LAS char* As = lds + (kt & 1) * STAGE_BYTES; LAS char* Bs = As + 256 * LDP * 2;                                                \
            *(LAS u32x4*)(As + ((g_tid >> 2) * LDP + g_kc * 8) * 2) = g_ra0;                                                               \
            *(LAS u32x4*)(As + (((g_tid >> 2) + 128) * LDP + g_kc * 8) * 2) = g_ra1;                                                       \
            _Pragma("unroll") for (int i = 0; i < 4; ++i) {                                                                                \
                u32x2 w; w[0] = cvtpk(g_rb0[i], g_rb1[i]); w[1] = cvtpk(g_rb2[i], g_rb3[i]);                                               \
                *(LAS u32x2*)(Bs + ((g_wave * 32 + i * 8 + g_n4) * LDP + g_kq * 4) * 2) = w;                                               \
            }                                                                                                                              \
            __syncthreads();                                                                                                               \
            if (kt + 1 < g_nk) {                                                                                                           \
                const int ko = (kt + 1) * 32;                                                                                              \
                g_ra0 = g_pa0 ? *(const u32x4*)(g_pa0 + ko + g_kc * 8) : g_z; g_ra1 = g_pa1 ? *(const u32x4*)(g_pa1 + ko + g_kc * 8) : g_z; \
                const float* pbk = g_pb + (size_t)ko * g_ldb;                                                                              \
                g_rb0 = *(const f32x4*)(pbk); g_rb1 = *(const f32x4*)(pbk + g_ldb); g_rb2 = *(const f32x4*)(pbk + 2 * g_ldb); g_rb3 = *(const f32x4*)(pbk + 3 * g_ldb); \
            }                                                                                                                              \
            _Pragma("unroll") for (int s = 0; s < 2; ++s) {                                                                                \
                bf16x8 af[4], bfr[2];                                                                                                      \
                _Pragma("unroll") for (int mb = 0; mb < 4; ++mb) af[mb] = *(LAS bf16x8*)(As + ((g_wm * 128 + mb * 32 + g_r32) * LDP + s * 16 + g_hi * 8) * 2); \
                _Pragma("unroll") for (int nb = 0; nb < 2; ++nb) bfr[nb] = *(LAS bf16x8*)(Bs + (((g_wn * 2 + nb) * 32 + g_r32) * LDP + s * 16 + g_hi * 8) * 2); \
                _Pragma("unroll") for (int mb = 0; mb < 4; ++mb) { _Pragma("unroll") for (int nb = 0; nb < 2; ++nb) acc[mb][nb] = MFMA_BF16(af[mb], bfr[nb], acc[mb][nb]); } \
            }                                                                                                                              \
        }                                                                                                                                  \
        __syncthreads();                                                                                                                   \
    }

struct AttnSt { float m, l; f32x16 o0, o1; };

struct AttnFr { bf16x8 k[4]; bf16x8 v[4]; };
__device__ __forceinline__ void attn_load(AttnFr& f, const u16* krow, const u16* vt, size_t vt_dstride) {
#pragma unroll
    for (int d0 = 0; d0 < 4; ++d0) f.k[d0] = *(const bf16x8*)(krow + d0 * 16);
    const u16* vt1 = vt + 32 * vt_dstride;
    union { bf16x8 v; u32x2 h[2]; } va;
    va.h[0] = *(const u32x2*)(vt);       va.h[1] = *(const u32x2*)(vt + 8);   f.v[0] = va.v;
    va.h[0] = *(const u32x2*)(vt + 16);  va.h[1] = *(const u32x2*)(vt + 24);  f.v[1] = va.v;
    va.h[0] = *(const u32x2*)(vt1);      va.h[1] = *(const u32x2*)(vt1 + 8);  f.v[2] = va.v;
    va.h[0] = *(const u32x2*)(vt1 + 16); va.h[1] = *(const u32x2*)(vt1 + 24); f.v[3] = va.v;
}
template <bool MASK = true>
__device__ __forceinline__ void attn_compute(AttnSt& st, const bf16x8 (&qf)[4], const AttnFr& f, int dist0, float bslope, int dlo, int dhi, int hi, int lane) {
    f32x16 p;
#pragma unroll
    for (int r = 0; r < 16; ++r) p[r] = 0.f;
#pragma unroll
    for (int d0 = 0; d0 < 4; ++d0) p = MFMA_BF16(f.k[d0], qf[d0], p);
    constexpr float C2 = 0.125f * LOG2E;
    float mx = NEGV;
    const float bbase = -bslope * (float)dist0;
#pragma unroll
    for (int r = 0; r < 16; ++r) {
        const float sc = __builtin_fmaf(p[r], C2, __builtin_fmaf(bslope, (float)((r & 3) + 8 * (r >> 2)), bbase));
        float s_ = sc;
        if (MASK) { const int dist = dist0 - ((r & 3) + 8 * (r >> 2)); s_ = (dist >= dlo && dist <= dhi) ? sc : NEGV; }
        p[r] = s_; mx = fmaxf(mx, s_);
    }
    mx = fmaxf(mx, shxf(mx, 32, lane));
    const float mnew = fmaxf(st.m, mx);
    const float alpha = __builtin_amdgcn_exp2f(st.m - mnew);
    st.m = mnew;
    float ls = 0.f;
#pragma unroll
    for (int r = 0; r < 16; ++r) { p[r] = __builtin_amdgcn_exp2f(p[r] - mnew); ls += p[r]; }
    st.l = st.l * alpha + ls;
#pragma unroll
    for (int r = 0; r < 16; ++r) { st.o0[r] *= alpha; st.o1[r] *= alpha; }
    union { bf16x8 v; unsigned u[4]; } pb0, pb1;
#pragma unroll
    for (int j = 0; j < 4; ++j) { pb0.u[j] = cvtpk(p[2 * j], p[2 * j + 1]); pb1.u[j] = cvtpk(p[8 + 2 * j], p[8 + 2 * j + 1]); }
    st.o0 = MFMA_BF16(f.v[0], pb0.v, st.o0);
    st.o0 = MFMA_BF16(f.v[1], pb1.v, st.o0);
    st.o1 = MFMA_BF16(f.v[2], pb0.v, st.o1);
    st.o1 = MFMA_BF16(f.v[3], pb1.v, st.o1);
    (void)hi;
}

__device__ __forceinline__ float dpp_rowmax(float v) {
    v = fmaxf(v, __int_as_float(__builtin_amdgcn_update_dpp(0, __float_as_int(v), 0xB1, 0xF, 0xF, true)));
    v = fmaxf(v, __int_as_float(__builtin_amdgcn_update_dpp(0, __float_as_int(v), 0x4E, 0xF, 0xF, true)));
    v = fmaxf(v, __int_as_float(__builtin_amdgcn_update_dpp(0, __float_as_int(v), 0x141, 0xF, 0xF, true)));
    v = fmaxf(v, __int_as_float(__builtin_amdgcn_update_dpp(0, __float_as_int(v), 0x140, 0xF, 0xF, true)));
    return v;
}
__device__ __forceinline__ int dpp_rowmin_i(int v) {
    v = min(v, __builtin_amdgcn_update_dpp(0, v, 0xB1, 0xF, 0xF, true));
    v = min(v, __builtin_amdgcn_update_dpp(0, v, 0x4E, 0xF, 0xF, true));
    v = min(v, __builtin_amdgcn_update_dpp(0, v, 0x141, 0xF, 0xF, true));
    v = min(v, __builtin_amdgcn_update_dpp(0, v, 0x140, 0xF, 0xF, true));
    return v;
}
__device__ __forceinline__ float rl_f(float v, int l) { return __int_as_float(__builtin_amdgcn_readlane(__float_as_int(v), l)); }

__device__ __forceinline__ void top3_insert(float v, int i, float& v0, int& i0, float& v1, int& i1, float& v2, int& i2) {
    const bool b0 = (v > v0) || (v == v0 && i < i0);
    const bool b1 = (v > v1) || (v == v1 && i < i1);
    const bool b2 = (v > v2) || (v == v2 && i < i2);
    const float nv2 = b1 ? v1 : (b2 ? v : v2); const int ni2 = b1 ? i1 : (b2 ? i : i2);
    const float nv1 = b0 ? v0 : (b1 ? v : v1); const int ni1 = b0 ? i0 : (b1 ? i : i1);
    const float nv0 = b0 ? v : v0;             const int ni0 = b0 ? i : i0;
    v0 = nv0; i0 = ni0; v1 = nv1; i1 = ni1; v2 = nv2; i2 = ni2;
}

__device__ __forceinline__ void ln_row(float (&v)[16], const float* __restrict__ g, const float* __restrict__ b, int lane) {
    float s = 0.f;
#pragma unroll
    for (int i = 0; i < 16; ++i) s += v[i];
    const float mu = wave_sum(s) * (1.f / D);
    float q = 0.f;
#pragma unroll
    for (int i = 0; i < 16; ++i) { const float d = v[i] - mu; q += d * d; }
    const float rstd = rsqrtf(wave_sum(q) * (1.f / D) + LN_EPS);
#pragma unroll
    for (int j = 0; j < 4; ++j) {
        const f32x4 gg = *(const f32x4*)(g + j * 256 + lane * 4), bb = *(const f32x4*)(b + j * 256 + lane * 4);
#pragma unroll
        for (int c = 0; c < 4; ++c) v[j * 4 + c] = (v[j * 4 + c] - mu) * rstd * gg[c] + bb[c];
    }
}

typedef __attribute__((ext_vector_type(2))) float f32x2_;
__device__ __forceinline__ bf16x8 fp8x8_to_bf16(unsigned lo, unsigned hi_) {
    const f32x2_ a = __builtin_amdgcn_cvt_pk_f32_fp8((int)lo, false), b = __builtin_amdgcn_cvt_pk_f32_fp8((int)lo, true);
    const f32x2_ c = __builtin_amdgcn_cvt_pk_f32_fp8((int)hi_, false), d = __builtin_amdgcn_cvt_pk_f32_fp8((int)hi_, true);
    union { bf16x8 v; unsigned u[4]; } r;
    r.u[0] = cvtpk(a[0], a[1]); r.u[1] = cvtpk(b[0], b[1]); r.u[2] = cvtpk(c[0], c[1]); r.u[3] = cvtpk(d[0], d[1]);
    return r.v;
}
__device__ __forceinline__ unsigned pack_fp8x4(float a, float b, float c, float d) { int p = __builtin_amdgcn_cvt_pk_fp8_f32(a, b, 0, false); return (unsigned)__builtin_amdgcn_cvt_pk_fp8_f32(c, d, p, true); }

constexpr float Y8_SCALE = 16.f;
constexpr int MOE_XCAP = 576;
#define MOE_GAS __attribute__((address_space(1)))
typedef MOE_GAS unsigned char moe_gcb;
constexpr int MOE_BP = 72;
constexpr int MOE_BSTAGE = 128 * MOE_BP * 2;
constexpr int MOE_LDS_VA = 3 * MOE_BSTAGE;
constexpr int MOE_LDS_W = MOE_LDS_VA + 4096;
constexpr int MOE_LDS_XCH = 65536;
template <bool DOWN>
__device__ __forceinline__ void moe_expert(LAS char* lds, const int tid, const int lane, const int wave, const int r32, const int hi,
                                           const unsigned char* __restrict__ abase  , const float* __restrict__ w0, const float* __restrict__ w1, const int ng  , void* __restrict__ outv,
                                           const int pass0, const int npass_, const int st0, const int nstl  , const bool y8 = false  ,
                                           const bool xr = false  ) {
    constexpr int KT = DOWN ? 4 : 16, NP = DOWN ? 8 : 4, LDB = DOWN ? 1024 : 256, APITCH = DOWN ? 256 : 1024  , PSTEP = DOWN ? 128 : 64;
    LAS int* rowva = (LAS int*)(lds + MOE_LDS_VA); LAS float* roww = (LAS float*)(lds + MOE_LDS_W);
    const int nst = nstl;
    const int nsteps = npass_ * nst * KT; (void)NP;
    unsigned aoff[2];
#define MOE_AOFF(ST_) { _Pragma("unroll") for (int a = 0; a < 2; ++a) { const int va_ = rowva[(ST_) * 512 + wave * 64 + a * 32 + r32]; \
        const int srow_ = DOWN ? va_ : (va_ == TRASH_VA ? 0 : (va_ >> 3)); aoff[a] = (unsigned)srow_ * APITCH + hi * 32; } }
    const int seg = wave >> 1, n4 = lane & 7, kp = (wave & 1) * 16 + (lane >> 3);
    const char* wbase = (const char*)(DOWN ? (w0 + seg * 32) : (((seg < 2) ? w0 : w1) + (seg & 1) * 32));
    unsigned boff = (unsigned)(4 * n4 + 2 * kp * LDB) * 4u; asm volatile("" : "+v"(boff));
    unsigned wb_ = (unsigned)((seg * 32 + n4) * MOE_BP + 2 * kp) * 2u; asm volatile("" : "+v"(wb_));
    unsigned lb_ = (unsigned)(r32 * MOE_BP + hi * 32) * 2u; asm volatile("" : "+v"(lb_));
    f32x16 acc[2][4];
#pragma unroll
    for (int a = 0; a < 2; ++a)
#pragma unroll
        for (int c = 0; c < 4; ++c)
#pragma unroll
            for (int r = 0; r < 16; ++r) acc[a][c][r] = 0.f;
    u32x4 fa8[2][2];
    f32x16 accx; u32x4 fa8x[2]; unsigned aoffx = 0u;
#pragma unroll
    for (int r = 0; r < 16; ++r) accx[r] = 0.f;
    fa8x[0] = u32x4{0u, 0u, 0u, 0u}; fa8x[1] = u32x4{0u, 0u, 0u, 0u};
    f32x4 rb0[4], rb1[4];
#define MOE_DEC(S_) const int s2_ = (S_) < nsteps ? (S_) : 0; const int pl_ = s2_ / (nst * KT); const int rm_ = s2_ - pl_ * (nst * KT); const int sl_ = rm_ / KT; const int kt_ = rm_ - sl_ * KT; const int ps_ = pass0 + pl_; const int stt_ = st0 + sl_;
#define MOE_LOADB(S_, RB) { MOE_DEC(S_) (void)stt_; \
        uint64_t wu_ = (uint64_t)(wbase + (size_t)(ps_ * PSTEP + kt_ * 64 * LDB) * 4), wv_ = wu_ + 16 * LDB * 4; asm volatile("" : "+s"(wu_), "+s"(wv_));     \
        const moe_gcb* wug_ = (const moe_gcb*)wu_; const moe_gcb* wvg_ = (const moe_gcb*)wv_; \
        unsigned bo_ = boff; asm volatile("" : "+v"(bo_));     \
        RB[0] = *(const MOE_GAS f32x4*)(wug_ + bo_); RB[1] = *(const MOE_GAS f32x4*)(wug_ + bo_ + LDB * 4); RB[2] = *(const MOE_GAS f32x4*)(wvg_ + bo_); RB[3] = *(const MOE_GAS f32x4*)(wvg_ + bo_ + LDB * 4); }
#define MOE_WRITEB(STG, RB) { LAS char* Bs_ = lds + (STG) * MOE_BSTAGE; \
        _Pragma("unroll") for (int i = 0; i < 4; ++i) { LAS unsigned* q_ = (LAS unsigned*)(Bs_ + wb_ + i * (8 * MOE_BP * 2)); q_[0] = cvtpk(RB[0][i], RB[1][i]); q_[8] = cvtpk(RB[2][i], RB[3][i]); } }
#define MOE_COMPUTE(STG, DO_MFMA) { LAS char* Bs_ = lds + (STG) * MOE_BSTAGE; \
        _Pragma("unroll") for (int u = 0; u < 4; ++u) { \
            bf16x8 bfr[4]; \
            if (DO_MFMA) { _Pragma("unroll") for (int c = 0; c < 4; ++c) bfr[c] = *(LAS bf16x8*)(Bs_ + lb_ + (c * 32 * MOE_BP + u * 8) * 2); } \
            _Pragma("unroll") for (int a = 0; a < 2; ++a) { \
                if (DO_MFMA) { const bf16x8 af_ = fp8x8_to_bf16(fa8[a][u >> 1][(u & 1) * 2], fa8[a][u >> 1][(u & 1) * 2 + 1]); \
                    _Pragma("unroll") for (int c = 0; c < 4; ++c) acc[a][c] = MFMA_BF16(bfr[c], af_, acc[a][c]); } \
            } \
        } }
      \
#define MOE_RELOAD { _Pragma("unroll") for (int a = 0; a < 2; ++a) { unsigned ao_ = aoff[a]; asm volatile("" : "+v"(ao_)); \
            fa8[a][0] = *(const MOE_GAS u32x4*)(ab_n + ao_); fa8[a][1] = *(const MOE_GAS u32x4*)(ab_n + ao_ + 16); } }
#define MOE_XCOMPUTE(STG) if (!DOWN) { LAS char* Bs_ = lds + (STG) * MOE_BSTAGE; \
        _Pragma("unroll") for (int u = 0; u < 4; ++u) { \
            const bf16x8 ax_ = fp8x8_to_bf16(fa8x[u >> 1][(u & 1) * 2], fa8x[u >> 1][(u & 1) * 2 + 1]); \
            if (u & 1) { unsigned ao_ = aoffx; asm volatile("" : "+v"(ao_)); fa8x[u >> 1] = *(const MOE_GAS u32x4*)(ab_n + ao_ + (u >> 1) * 16); } \
            const bf16x8 bx_ = *(LAS bf16x8*)(Bs_ + (wave & 3) * (32 * MOE_BP * 2) + lb_ + u * 16); \
            accx = MFMA_BF16(bx_, ax_, accx); } }
#define MOE_NEXTA(S_) MOE_DEC(S_) (void)ps_; \
        if (stt_ != st_loaded) { MOE_AOFF(stt_) st_loaded = stt_; } \
        uint64_t abn_ = (uint64_t)abase + kt_ * 64; asm volatile("" : "+s"(abn_)); const moe_gcb* ab_n = (const moe_gcb*)abn_;
    int st_loaded = st0;
    MOE_AOFF(st0)
    { const char* ab0 = (const char*)abase;
#pragma unroll
      for (int a = 0; a < 2; ++a)
#pragma unroll
          for (int h2 = 0; h2 < 2; ++h2) fa8[a][h2] = *(const u32x4*)(ab0 + aoff[a] + h2 * 16); }
    if (!DOWN) {
        const int vax_ = xr ? rowva[512 + 32 * (wave >> 2) + r32] : TRASH_VA; aoffx = (unsigned)(vax_ == TRASH_VA ? 0 : (vax_ >> 3)) * APITCH + hi * 32;
        fa8x[0] = *(const u32x4*)((const char*)abase + aoffx); fa8x[1] = *(const u32x4*)((const char*)abase + aoffx + 16); }
    MOE_LOADB(0, rb0)
    MOE_LOADB(1, rb1)
    MOE_WRITEB(0, rb0)
    MOE_LOADB(2, rb0)
    int stg = 0;
#pragma unroll 1
    for (int sidx = 0; sidx < nsteps; sidx += 2) {
        const int pl = sidx / (nst * KT); const int rm = sidx - pl * (nst * KT); const int sl = rm / KT; const int kt = rm - sl * KT; const int ps = pass0 + pl, stt = st0 + sl;
        const bool wv = (wave * 64) < (ng - stt * 512);
        const int stg1 = stg == 2 ? 0 : stg + 1, stg2 = stg1 == 2 ? 0 : stg1 + 1;
        __syncthreads();
        MOE_WRITEB(stg1, rb1)
        MOE_LOADB(sidx + 3, rb1)
        { MOE_NEXTA(sidx + 1)
          if (wv) MOE_COMPUTE(stg, true)
          MOE_RELOAD
          MOE_XCOMPUTE(stg) }
        __syncthreads();
        MOE_WRITEB(stg2, rb0)
        MOE_LOADB(sidx + 4, rb0)
        { MOE_NEXTA(sidx + 2)
          if (wv) MOE_COMPUTE(stg1, true)
          MOE_RELOAD
          MOE_XCOMPUTE(stg1) }
        stg = stg2;
        if (kt == KT - 2) {
            const int le_ = lane_id_(); const int lane = le_, r32 = le_ & 31, hi = le_ >> 5; (void)lane;
            if (wv) {
                const int nrows = ng - stt * 512;
#pragma unroll
                for (int a = 0; a < 2; ++a) {
                    if (a == 0 || (wave * 64 + 32) < nrows) {
                        const int lrow = stt * 512 + wave * 64 + a * 32 + r32;
                        const unsigned va = (unsigned)rowva[lrow];
                        if (DOWN) {
                            const float w = roww[lrow];
#pragma unroll
                            for (int c = 0; c < 4; ++c) {
                                float yv_[16];
#pragma unroll
                                for (int j = 0; j < 16; ++j) yv_[j] = acc[a][c][(j >> 2) + 4 * (j & 3)] * w;
                                if (y8) {
                                    u32x4 q8;
#pragma unroll
                                    for (int jj = 0; jj < 4; ++jj) q8[jj] = pack_fp8x4(yv_[4 * jj], yv_[4 * jj + 1], yv_[4 * jj + 2], yv_[4 * jj + 3]);
                                    *(u32x4*)((unsigned char*)outv + (size_t)va * D + ps * 128 + c * 32 + 16 * hi) = q8;
                                } else {
                                    u32x4 q0, q1;
#pragma unroll
                                    for (int jj = 0; jj < 4; ++jj) { q0[jj] = cvtpk(yv_[2 * jj], yv_[2 * jj + 1]); q1[jj] = cvtpk(yv_[8 + 2 * jj], yv_[9 + 2 * jj]); }
                                    u16* o = (u16*)outv + (size_t)va * D + ps * 128 + c * 32 + 16 * hi;
                                    *(u32x4*)o = q0; *(u32x4*)(o + 8) = q1;
                                }
                            }
                        } else {
#pragma unroll
                            for (int c = 0; c < 2; ++c) {
                                float hv[16];
#pragma unroll
                                for (int j = 0; j < 16; ++j) { const int r = (j >> 2) + 4 * (j & 3); const float gt = acc[a][c][r], up = acc[a][c + 2][r]; hv[j] = gt / (1.f + __expf(-gt)) * up; }
                                u32x4 q;
#pragma unroll
                                for (int jj = 0; jj < 4; ++jj) q[jj] = pack_fp8x4(hv[4 * jj], hv[4 * jj + 1], hv[4 * jj + 2], hv[4 * jj + 3]);
                                *(u32x4*)((unsigned char*)outv + (size_t)va * DF + ps * 64 + c * 32 + 16 * hi) = q;
                            }
                        }
                    }
                }
#pragma unroll
                for (int a = 0; a < 2; ++a)
#pragma unroll
                    for (int c = 0; c < 4; ++c)
#pragma unroll
                        for (int r = 0; r < 16; ++r) acc[a][c][r] = 0.f;
            }
            if (!DOWN) { if (xr) {
                LAS float* xch = (LAS float*)(lds + MOE_LDS_XCH) + ((wave >> 2) * 2 + (wave & 1)) * 1024 + lane;
                if ((wave & 3) >= 2) {
#pragma unroll
                    for (int r = 0; r < 16; ++r) xch[r * 64] = accx[r];
                }
                __syncthreads();
                if ((wave & 3) < 2) {
                    const unsigned vax = (unsigned)rowva[512 + 32 * (wave >> 2) + r32];
                    u32x4 q;
#pragma unroll
                    for (int jj = 0; jj < 4; ++jj) {
#pragma unroll
                        for (int i = 0; i < 4; ++i) { const int r = jj + 4 * i; const float gt = accx[r]; accx[r] = gt / (1.f + __expf(-gt)) * xch[r * 64]; }
                        q[jj] = pack_fp8x4(accx[jj], accx[jj + 4], accx[jj + 8], accx[jj + 12]);
                    }
                    *(u32x4*)((unsigned char*)outv + (size_t)vax * DF + ps * 64 + (wave & 3) * 32 + 16 * hi) = q;
                }
                }
#pragma unroll
                for (int r = 0; r < 16; ++r) accx[r] = 0.f;
            }
        }
    }
    __syncthreads();
#undef MOE_XCOMPUTE
#undef MOE_AOFF
#undef MOE_DEC
#undef MOE_LOADB
#undef MOE_WRITEB
#undef MOE_COMPUTE
#undef MOE_RELOAD
#undef MOE_NEXTA
}

constexpr int Q8_BP = 144;
constexpr int Q8_BSTAGE = 128 * Q8_BP;
typedef __attribute__((ext_vector_type(8))) int q8_i32x8;
template <int NCH>
__device__ __forceinline__ void qkv8_item(LAS char* lds, const int wave, const unsigned char* __restrict__ a8  , const unsigned char* __restrict__ w8  ,
                                          u16* __restrict__ outp  , const int ldc,
                                          const int rot  ) {
    constexpr int NSTEPS = NCH * 8;
    const int l0 = lane_id_(); const int r32 = l0 & 31, hi = l0 >> 5;
    unsigned aoff[2];
#pragma unroll
    for (int a = 0; a < 2; ++a) { aoff[a] = (unsigned)(wave * 64 + a * 32 + r32) * 1024u + hi * 32; asm volatile("" : "+v"(aoff[a])); }
    const int t_ = wave * 64 + l0, col_ = t_ >> 2, p_ = t_ & 3, kap_ = col_ & 31;
    unsigned boff = (unsigned)col_ * 1024u + p_ * 32; asm volatile("" : "+v"(boff));
    unsigned wb = (unsigned)((col_ & ~31) + (kap_ & 3) * 8 + (kap_ >> 2)) * Q8_BP + p_ * 32; asm volatile("" : "+v"(wb));
    unsigned lb = (unsigned)r32 * Q8_BP + hi * 32; asm volatile("" : "+v"(lb));
    f32x16 acc[2][4];
#pragma unroll
    for (int a = 0; a < 2; ++a)
#pragma unroll
        for (int c = 0; c < 4; ++c)
#pragma unroll
            for (int r = 0; r < 16; ++r) acc[a][c][r] = 0.f;
    u32x4 fa0[2][2][2], fa1[2][2][2];
    u32x4 rb0[2], rb1[2];
#define Q8_LOADA(FA, S_) { const int s2_ = (S_) < NSTEPS ? (S_) : 0; uint64_t ab_ = (uint64_t)a8 + ((s2_ + rot) & 7) * 128; asm volatile("" : "+s"(ab_)); const moe_gcb* ag_ = (const moe_gcb*)ab_; \
        _Pragma("unroll") for (int a = 0; a < 2; ++a) { unsigned ao_ = aoff[a]; asm volatile("" : "+v"(ao_)); \
            _Pragma("unroll") for (int kk = 0; kk < 2; ++kk) { FA[a][kk][0] = *(const MOE_GAS u32x4*)(ag_ + ao_ + kk * 64); FA[a][kk][1] = *(const MOE_GAS u32x4*)(ag_ + ao_ + kk * 64 + 16); } } }
#define Q8_LOADB(RB, S_) { const int s2_ = (S_) < NSTEPS ? (S_) : 0; uint64_t wu_ = (uint64_t)w8 + (size_t)(s2_ >> 3) * 131072 + ((s2_ + rot) & 7) * 128; asm volatile("" : "+s"(wu_)); const moe_gcb* wg_ = (const moe_gcb*)wu_; \
        unsigned bo_ = boff; asm volatile("" : "+v"(bo_)); RB[0] = *(const MOE_GAS u32x4*)(wg_ + bo_); RB[1] = *(const MOE_GAS u32x4*)(wg_ + bo_ + 16); }
#define Q8_WRITEB(STG, RB) { LAS char* Bs_ = lds + (STG) * Q8_BSTAGE + wb; *(LAS u32x4*)Bs_ = RB[0]; *(LAS u32x4*)(Bs_ + 16) = RB[1]; }
#define Q8_CAT8(X0, X1) q8_i32x8{(int)(X0)[0], (int)(X0)[1], (int)(X0)[2], (int)(X0)[3], (int)(X1)[0], (int)(X1)[1], (int)(X1)[2], (int)(X1)[3]}
#define Q8_MFMA(B_, A_, C_) __builtin_amdgcn_mfma_scale_f32_32x32x64_f8f6f4(B_, A_, C_, 0, 0, 0, 0x7F79  , 1, 0x7F79  )
#define Q8_COMPUTE(STG, FA) { LAS char* Bs_ = lds + (STG) * Q8_BSTAGE + lb; \
        _Pragma("unroll") for (int kk = 0; kk < 2; ++kk) { const q8_i32x8 af0_ = Q8_CAT8(FA[0][kk][0], FA[0][kk][1]), af1_ = Q8_CAT8(FA[1][kk][0], FA[1][kk][1]); \
            _Pragma("unroll") for (int c = 0; c < 4; ++c) { const u32x4 b0_ = *(LAS u32x4*)(Bs_ + c * 32 * Q8_BP + kk * 64), b1_ = *(LAS u32x4*)(Bs_ + c * 32 * Q8_BP + kk * 64 + 16); const q8_i32x8 bf_ = Q8_CAT8(b0_, b1_); \
                acc[0][c] = Q8_MFMA(bf_, af0_, acc[0][c]); acc[1][c] = Q8_MFMA(bf_, af1_, acc[1][c]); } } }
    Q8_LOADB(rb0, 0)
    Q8_WRITEB(0, rb0)
    Q8_LOADB(rb1, 1)
    Q8_LOADA(fa0, 0)
    Q8_LOADB(rb0, 2)
    Q8_LOADA(fa1, 1)
    int stg = 0;
#pragma unroll 1
    for (int s = 0; s < NSTEPS; s += 2) {
        const int stg1 = stg == 2 ? 0 : stg + 1, stg2 = stg1 == 2 ? 0 : stg1 + 1;
        __syncthreads();
        Q8_WRITEB(stg1, rb1)
        Q8_LOADB(rb1, s + 3)
        Q8_COMPUTE(stg, fa0)
        Q8_LOADA(fa0, s + 2)
        __syncthreads();
        Q8_WRITEB(stg2, rb0)
        Q8_LOADB(rb0, s + 4)
        Q8_COMPUTE(stg1, fa1)
        Q8_LOADA(fa1, s + 3)
        stg = stg2;
        if ((s & 7) == 6) {
            const int cl = s >> 3;
            const int le_ = lane_id_(); const int r32e = le_ & 31, hie = le_ >> 5;
#pragma unroll
            for (int a = 0; a < 2; ++a) {
                u16* orow = outp + (size_t)(wave * 64 + a * 32 + r32e) * ldc + cl * 128 + 16 * hie;
#pragma unroll
                for (int c = 0; c < 4; ++c) {
                    u32x4 q0, q1;
#pragma unroll
                    for (int jj = 0; jj < 4; ++jj) { q0[jj] = cvtpk(acc[a][c][((2 * jj) >> 2) + 4 * ((2 * jj) & 3)], acc[a][c][((2 * jj + 1) >> 2) + 4 * ((2 * jj + 1) & 3)]);
                                                     q1[jj] = cvtpk(acc[a][c][((8 + 2 * jj) >> 2) + 4 * ((8 + 2 * jj) & 3)], acc[a][c][((9 + 2 * jj) >> 2) + 4 * ((9 + 2 * jj) & 3)]); }
                    *(u32x4*)(orow + c * 32) = q0; *(u32x4*)(orow + c * 32 + 8) = q1;
                }
            }
#pragma unroll
            for (int a = 0; a < 2; ++a)
#pragma unroll
                for (int c = 0; c < 4; ++c)
#pragma unroll
                    for (int r = 0; r < 16; ++r) acc[a][c][r] = 0.f;
        }
    }
    __syncthreads();
#undef Q8_LOADA
#undef Q8_LOADB
#undef Q8_WRITEB
#undef Q8_CAT8
#undef Q8_MFMA
#undef Q8_COMPUTE
}

constexpr int N_PHASES = 21;

#define P_x_in CTX_IN(0)
#define P_xb ((u16*)(ws + WS_XB))
#define P_x1 ((float*)(ws + WS_X1))
#define P_x2 ((float*)(ws + WS_X2))
#define P_ypre ((u16*)(ws + WS_YPRE))
#define P_qkv ((u16*)(ws + WS_QKV))
#define P_vT ((u16*)(ws + WS_VT))
#define P_kmean ((float*)(ws + WS_KM))
#define P_ao ((u16*)(ws + WS_AO))
#define P_og ((u16*)(ws + WS_OG))
#define P_lse ((float*)(ws + WS_LSE))
#define P_topw ((float*)(ws + WS_TOPW))
#define P_list ((int*)(ws + WS_LIST))
#define P_hb ((u16*)(ws + WS_HB))
#define P_yb ((u16*)(ws + WS_YB))
#define P_cnt_all ((int*)(ws + WS_CTL + CTL_ECNT_OFF))
#define P_xb8 ((unsigned char*)(ws + WS_XB8))
#define P_hbs ((u16*)(ws + WS_HBS))
#define P_xq8 ((unsigned char*)(ws + WS_XQ8))
#define P_wq8 ((unsigned char*)(ws + WS_WQ8))
#define P_wo8 ((unsigned char*)(ws + WS_WO8))
#define P_selm ((unsigned*)(ws + WS_SELM))
#define P_part ((u16*)(ws + WS_PART))
#define P_plse ((float*)(ws + WS_PLSE))
#define PH_BEGIN int tid = wave_s_ * 64 + lane_id_(); asm volatile("" : "+v"(tid)); const int lane = tid & 63, r32 = lane & 31, hi = lane >> 5; const int wave = __builtin_amdgcn_readfirstlane(tid >> 6); (void)lane; (void)r32; (void)hi; (void)wave
constexpr int LDS_CTX = LDS_BAR + 16;
__device__ __forceinline__ uint64_t ctx_ld(int i) {
    extern __shared__ __attribute__((aligned(16))) unsigned char lds_raw[];
    const LAS unsigned* q = (const LAS unsigned*)((LAS char*)lds_raw + LDS_CTX) + 2 * i;
    const unsigned lo = __builtin_amdgcn_readfirstlane(q[0]), hi = __builtin_amdgcn_readfirstlane(q[1]);
    return ((uint64_t)hi << 32) | lo;
}
typedef __attribute__((address_space(1))) unsigned char gbyte;
#define AS_GLOBAL(T, u64v) ((T*)(gbyte*)(u64v))
#define CTX_IN(i) AS_GLOBAL(const float, ctx_ld(i))
#define PH_FN_BEGIN \
    extern __shared__ __attribute__((aligned(16))) unsigned char lds_raw[]; \
    LAS char* lds = (LAS char*)lds_raw; (void)lds; \
    const int G = gridDim.x, bid = blockIdx.x; (void)G; (void)bid; \
    unsigned char* const ws = AS_GLOBAL(unsigned char, ctx_ld(17)); (void)ws; \
    const int NQ = L == 0 ? 3072 : 9216; (void)NQ; \
    int* cnt = P_cnt_all + L * NE * CNT_STRIDE; (void)cnt;
__device__ __forceinline__ void ph_p0(int L, int rep_, const int wave_s_) {
    PH_FN_BEGIN
    (void)rep_;
    PH_BEGIN;
    for (size_t i = (size_t)bid * NTHR + tid; i < (size_t)T * D / 4; i += (size_t)G * NTHR) {
        const f32x4 v = *(const f32x4*)(P_x_in + i * 4);
        u32x2 w; w[0] = cvtpk(v[0], v[1]); w[1] = cvtpk(v[2], v[3]);
        *(u32x2*)(P_xb + i * 4) = w;
#if QKV_FP8
        *(unsigned*)(P_xq8 + i * 4) = pack_fp8x4(v[0], v[1], v[2], v[3]);
#endif
    }
    LAS float* tl = (LAS float*)lds;
    for (int it = bid; it < 3968 + 128; it += G) {
        int seg, kt;
        if (it < 3840) { seg = it >> 4; kt = it & 15; } else if (it < 3968) { seg = 240 + ((it - 3840) >> 2); kt = (it - 3840) & 3; } else { seg = 272 + ((it - 3968) >> 4); kt = (it - 3968) & 15; }
        const float* src; int ld; u16* dst; int Kd = 1024; u16* dst_lo = nullptr; int rcol = 0; unsigned char* dst8 = nullptr;
        if (seg < 48) { const int col = 64 * seg; src = CTX_IN(1) + col; ld = 3072; dst = (u16*)(ws + WS_WQK0) + (size_t)col * 1024; if (QKV_FP8) dst8 = P_wq8 + (size_t)col * 1024; }
        else if (seg < 192) { const int col = 64 * (seg - 48); src = CTX_IN(2) + col; ld = 9216; dst = (u16*)(ws + WS_WQK1) + (size_t)col * 1024; if (QKV_FP8) dst8 = P_wq8 + (size_t)(3072 + col) * 1024; }
        else if (seg < 224) { const int s2 = seg - 192, l2 = s2 >> 4, col = 64 * (s2 & 15); src = CTX_IN(3) + (size_t)l2 * D * D + col; ld = 1024; dst = (u16*)(ws + WS_WO) + (size_t)l2 * D * D + (size_t)col * 1024; if (WO_FP8) dst8 = P_wo8 + (size_t)l2 * D * D + (size_t)col * 1024; }
        else if (seg < 240) { const int s2 = seg - 224, l2 = s2 >> 3, i8 = s2 & 7, un = i8 >> 2, q = i8 & 3;
            src = (q < 2 ? CTX_IN(11) : CTX_IN(12)) + (size_t)l2 * D * DF + un * 128 + 64 * (q & 1); ld = 256; dst = (u16*)(ws + WS_WSGU) + (size_t)l2 * 512 * 1024 + (size_t)(64 * i8) * 1024; }
        else if (seg < 272) { const int s2 = seg - 240, l2 = s2 >> 4, col = 64 * (s2 & 15); src = CTX_IN(13) + (size_t)l2 * DF * D + col; ld = 1024; Kd = 256; dst = (u16*)(ws + WS_WSD) + (size_t)l2 * D * DF + (size_t)col * 256; }
        else { const int s2 = seg - 272, l2 = s2 >> 2, col = 64 * (s2 & 3); src = CTX_IN(6) + (size_t)l2 * D * NE + col; ld = 256; rcol = col; dst = (u16*)(ws + WS_WRH) + (size_t)l2 * NE * D; dst_lo = (u16*)(ws + WS_WRL) + (size_t)l2 * NE * D; }
        {
            const int kr = tid >> 4, c4 = tid & 15;
#pragma unroll
            for (int i = 0; i < 2; ++i) {
                const f32x4 v = *(const f32x4*)(src + (size_t)(kt * 64 + kr + 32 * i) * ld + 4 * c4);
#pragma unroll
                for (int jj = 0; jj < 4; ++jj) tl[(kr + 32 * i) * 65 + 4 * c4 + jj] = v[jj];
            }
        }
        __syncthreads();
        {
            const int row = tid >> 3, kc = tid & 7;
            float f[8];
#pragma unroll
            for (int jj = 0; jj < 8; ++jj) f[jj] = tl[(8 * kc + jj) * 65 + row];
            u32x4 w; w[0] = cvtpk(f[0], f[1]); w[1] = cvtpk(f[2], f[3]); w[2] = cvtpk(f[4], f[5]); w[3] = cvtpk(f[6], f[7]);
            if (dst_lo) {
                u32x4 wl;
#pragma unroll
                for (int jj = 0; jj < 4; ++jj) wl[jj] = cvtpk(f[2 * jj] - bf2f(w[jj] & 0xFFFFu), f[2 * jj + 1] - bf2f(w[jj] >> 16));
                const int E_ = rcol + row;
                const size_t fi = ((size_t)(((E_ >> 5) * 16 + kt) * 4 + (kc >> 1)) * 64 + (kc & 1) * 32 + (E_ & 31)) * 8;
                *(u32x4*)(dst + fi) = w; *(u32x4*)(dst_lo + fi) = wl;
            } else if (dst8) {
                u32x2 w8; w8[0] = pack_fp8x4(f[0] * 64.f, f[1] * 64.f, f[2] * 64.f, f[3] * 64.f); w8[1] = pack_fp8x4(f[4] * 64.f, f[5] * 64.f, f[6] * 64.f, f[7] * 64.f);
                *(u32x2*)(dst8 + (size_t)row * 1024 + kt * 64 + 8 * kc) = w8;
            } else *(u32x4*)(dst + (size_t)row * Kd + kt * 64 + 8 * kc) = w;
        }
        __syncthreads();
    }
}

__device__ __forceinline__ void ph_qkv(int L, int rep_, const int wave_s_) {
    PH_FN_BEGIN
    (void)rep_;
#if QKV_FP8 == 2
    const pg8::Gemm g{(const u16*)P_xq8, (const u16*)(P_wq8 + (L == 0 ? (size_t)0 : (size_t)3072 * 1024)), T, NQ, D / 2};
    pg8::StaticOrder S; S.init(g.M, g.N, G, bid);
    const EpiQK E{P_qkv, NQ};
    pg8::gemm_phase<EpiQK, pg8::StaticOrder, false, false, true>((PG8_LAS unsigned char*)lds, g, S, E, nullptr, wave_s_ * 64 + lane_id_());
#elif QKV_FP8
    PH_BEGIN;
    const int nchunk = NQ / 384, nq = 4 * nchunk;
    const unsigned char* w8 = P_wq8 + (L == 0 ? (size_t)0 : (size_t)3072 * 1024);
    int* xq = (int*)(ws + WS_CTL + CTL_XQ_OFF) + (L * 2 + (rep_ & 1)) * 8 * 64;
    LAS int* slot = (LAS int*)(lds + 140000);
    const int xme = (int)(xb_xcc_id() & 7u);
    unsigned qdone = 0u;
    for (;;) {
        __syncthreads();
        if (tid == 0) {
            int item = -1;
            for (int k = 0; k < 8 && item < 0; ++k) {
                const int xx = (xme + k) & 7;
                if (qdone >> xx & 1u) continue;
                const int q = atomicAdd(&xq[xx * 64], 1);
                if (q < nq) item = (xx + 8 * (q / nchunk)) * nchunk + (q % nchunk); else qdone |= 1u << xx;
            }
            *slot = item;
        }
        __syncthreads();
        const int item = *slot;
        if (item < 0) break;
        const int rt = item / nchunk, ch = item - rt * nchunk;
        qkv8_item<3>(lds, wave, P_xq8 + (size_t)rt * 512 * 1024, w8 + (size_t)ch * 384 * 1024, P_qkv + (size_t)rt * 512 * NQ + ch * 384, NQ, item & 7);
    }
#else
    const pg8::Gemm g{P_xb, (const u16*)(ws + (L == 0 ? WS_WQK0 : WS_WQK1)), T, NQ, D};
    pg8::StaticOrder S; S.init(g.M, g.N, G, bid);
    const EpiQK E{P_qkv, NQ};
    pg8::gemm_phase<EpiQK, pg8::StaticOrder, false>((PG8_LAS unsigned char*)lds, g, S, E, nullptr, wave_s_ * 64 + lane_id_());
#endif
}

__device__ __forceinline__ void ph_kmean(int L, int rep_, const int wave_s_) {
    PH_FN_BEGIN
    (void)rep_;
    PH_BEGIN;
    LAS float* red = (LAS float*)lds;
    for (int it = bid; it < BATCH * NH * MOBA_NB; it += G) {
        const int j = it & 31, h = (it >> 5) & 15, b = it >> 9;
        const int kg_ = tid >> 3, ch = tid & 7;
        const u16* kp = P_qkv + (size_t)(b * SEQ + j * MOBA_BLK + kg_) * 3072 + 1024 + h * 64 + ch * 8;
        float sm[8];
#pragma unroll
        for (int e2 = 0; e2 < 8; ++e2) sm[e2] = 0.f;
#pragma unroll
        for (int i = 0; i < 4; ++i) {
            const u32x4 v = *(const u32x4*)(kp + (size_t)(64 * i) * 3072);
#pragma unroll
            for (int e2 = 0; e2 < 4; ++e2) { sm[2 * e2] += bf2f(v[e2] & 0xFFFFu); sm[2 * e2 + 1] += bf2f(v[e2] >> 16); }
        }
#pragma unroll
        for (int e2 = 0; e2 < 8; ++e2) red[kg_ * 65 + ch * 8 + e2] = sm[e2];
        __syncthreads();
        if (tid < 64) {
            float tot = 0.f;
#pragma unroll 8
            for (int q = 0; q < 64; ++q) tot += red[q * 65 + tid];
            P_kmean[(size_t)it * 64 + tid] = tot * (1.f / MOBA_BLK);
        }
        __syncthreads();
    }
}

__device__ __forceinline__ void ph_gate(int L, int rep_, const int wave_s_) {
    PH_FN_BEGIN
    (void)rep_;
    PH_BEGIN;
    for (int it = bid; it < BATCH * NH * MOBA_NB; it += G) {
        const int qb = it & 31, bh = it >> 5, b = bh >> 4, h = bh & 15;
        const int tq = qb * MOBA_BLK + wave * 32 + r32;
        const u16* qrow = P_qkv + (size_t)(b * SEQ + tq) * 3072 + h * 64 + hi * 8;
        bf16x8 qf[4];
#pragma unroll
        for (int d0 = 0; d0 < 4; ++d0) qf[d0] = *(const bf16x8*)(qrow + d0 * 16);
        unsigned selmask = 0u;
        if (qb > 0) {
            const float* km = P_kmean + ((size_t)(b * NH + h) * MOBA_NB + r32) * 64 + hi * 8;
            f32x16 gt;
#pragma unroll
            for (int r = 0; r < 16; ++r) gt[r] = 0.f;
#pragma unroll
            for (int d0 = 0; d0 < 4; ++d0) {
                const f32x4 k0 = *(const f32x4*)(km + d0 * 16), k1 = *(const f32x4*)(km + d0 * 16 + 4);
                union { bf16x8 v; unsigned u[4]; } kf;
                kf.u[0] = cvtpk(k0[0], k0[1]); kf.u[1] = cvtpk(k0[2], k0[3]); kf.u[2] = cvtpk(k1[0], k1[1]); kf.u[3] = cvtpk(k1[2], k1[3]);
                gt = MFMA_BF16(kf.v, qf[d0], gt);
            }
            float v0 = -INFINITY, v1 = -INFINITY, v2 = -INFINITY; int i0 = 99, i1 = 99, i2 = 99;
#pragma unroll
            for (int r = 0; r < 16; ++r) { const int jb = crow(r, hi); const float gv = jb < qb ? gt[r] : -INFINITY; top3_insert(gv, jb < qb ? jb : 99, v0, i0, v1, i1, v2, i2); }
            const float ov0 = shxf(v0, 32, lane), ov1 = shxf(v1, 32, lane), ov2 = shxf(v2, 32, lane);
            const int oi0 = shxi(i0, 32, lane), oi1 = shxi(i1, 32, lane), oi2 = shxi(i2, 32, lane);
            top3_insert(ov0, oi0, v0, i0, v1, i1, v2, i2); top3_insert(ov1, oi1, v0, i0, v1, i1, v2, i2); top3_insert(ov2, oi2, v0, i0, v1, i1, v2, i2);
            if (i0 < 32) selmask |= 1u << i0;
            if (i1 < 32) selmask |= 1u << i1;
            if (i2 < 32) selmask |= 1u << i2;
        }
        if (hi == 0) P_selm[(size_t)bh * SEQ + tq] = selmask;
    }
}

constexpr int MB_KP = 72;
constexpr int MB_VP = 260;
constexpr int MB_LDS_K = 0;
constexpr int MB_LDS_V = 256 * MB_KP * 2;
constexpr int MB_LDS_LIST = MB_LDS_V + 64 * MB_VP * 2;
constexpr int MB_LDS_CTR = MB_LDS_LIST + 8192 * 2;
__device__ __forceinline__ void ph_moba(int L, int rep_, const int wave_s_) {
    PH_FN_BEGIN
    (void)rep_;
    PH_BEGIN;
    LAS char* Ks = lds + MB_LDS_K; LAS char* Vs = lds + MB_LDS_V;
    LAS u16* qlist = (LAS u16*)(lds + MB_LDS_LIST); LAS int* ctr = (LAS int*)(lds + MB_LDS_CTR);
    for (int it = bid; it < BATCH * NH * MOBA_NB; it += G) {
        const int rnd = it >> 8, w8 = it & 255, a8 = w8 >> 5, bh = w8 & 31;
        const int j = rnd == 0 ? a8 : (rnd == 1 ? 15 - a8 : (rnd == 2 ? 16 + a8 : 31 - a8));
        const int b = bh >> 4, h = bh & 15;
        const float slope2 = exp2f(-0.5f * (float)(h + 1)) * LOG2E;
        if (tid == 0) { int z0 = 0; asm volatile("" : "+v"(z0)); ctr[0] = z0; ctr[1] = z0; }
        {
            const u16* kg = P_qkv + (size_t)(b * SEQ + j * MOBA_BLK) * 3072 + 1024 + h * 64;
#pragma unroll
            for (int i = 0; i < 4; ++i) { const int c = tid + i * 512, row = c >> 3, ch = c & 7; *(LAS u32x4*)(Ks + (row * MB_KP + ch * 8) * 2) = *(const u32x4*)(kg + (size_t)row * 3072 + ch * 8); }
            const u16* vg = P_qkv + (size_t)(b * SEQ + j * MOBA_BLK) * 3072 + 2048 + h * 64;
            {
                const int kg4 = tid >> 3, ch = tid & 7;
                u32x4 v4[4];
#pragma unroll
                for (int q = 0; q < 4; ++q) v4[q] = *(const u32x4*)(vg + (size_t)(4 * kg4 + q) * 3072 + ch * 8);
#pragma unroll
                for (int e2 = 0; e2 < 4; ++e2) {
                    u32x2 wlo, whi;
                    wlo[0] = __builtin_amdgcn_perm(v4[1][e2], v4[0][e2], 0x05040100u); wlo[1] = __builtin_amdgcn_perm(v4[3][e2], v4[2][e2], 0x05040100u);
                    whi[0] = __builtin_amdgcn_perm(v4[1][e2], v4[0][e2], 0x07060302u); whi[1] = __builtin_amdgcn_perm(v4[3][e2], v4[2][e2], 0x07060302u);
                    *(LAS u32x2*)(Vs + ((ch * 8 + 2 * e2) * MB_VP + 4 * kg4) * 2) = wlo;
                    *(LAS u32x2*)(Vs + ((ch * 8 + 2 * e2 + 1) * MB_VP + 4 * kg4) * 2) = whi;
                }
            }
        }
        __syncthreads();
        {
            const unsigned* sm = P_selm + (size_t)bh * SEQ;
            for (int t0 = (j + 1) * MOBA_BLK; t0 < SEQ; t0 += 512) {
                const int t = t0 + tid;
                const bool sel = (t < SEQ) && ((sm[t < SEQ ? t : 0] >> j) & 1u);
                const unsigned long long bal = __ballot(sel);
                const int total = __popcll(bal);
                int wb = 0;
                if (lane == 0 && total) wb = atomicAdd((int*)&ctr[0], total);
                wb = __builtin_amdgcn_readfirstlane(wb);
                if (sel) qlist[wb + __popcll(bal & ((1ull << lane) - 1ull))] = (u16)t;
            }
        }
        __syncthreads();
        const int nq = ctr[0];
        const int ntiles = 8 + ((nq + 31) >> 5);
        for (;;) {
            int ti = 0;
            if (lane == 0) ti = atomicAdd((int*)&ctr[1], 1);
            ti = __builtin_amdgcn_readfirstlane(ti);
            if (ti >= ntiles) break;
            const bool own = ti < 8;
            const int wq = 7 - ti;
            const int li = (ti - 8) * 32 + r32;
            const bool valid = own || li < nq;
            const int tq = own ? j * MOBA_BLK + wq * 32 + r32 : (int)qlist[li < nq ? li : nq - 1];
            const int nsteps = own ? wq + 1 : 8;
            const u16* qrow = P_qkv + (size_t)(b * SEQ + tq) * 3072 + h * 64 + hi * 8;
            bf16x8 qf[4];
#pragma unroll
            for (int d0 = 0; d0 < 4; ++d0) qf[d0] = *(const bf16x8*)(qrow + d0 * 16);
            int slot = 3;
            if (!own) slot = __popc(P_selm[(size_t)bh * SEQ + tq] & ((1u << j) - 1u));
            AttnSt st; st.m = NEGV; st.l = 0.f;
#pragma unroll
            for (int r = 0; r < 16; ++r) { st.o0[r] = 0.f; st.o1[r] = 0.f; }
            const int dlo = own ? 0 : -0x40000000;
            for (int kt = 0; kt < nsteps; ++kt) {
                AttnFr f;
#pragma unroll
                for (int d0 = 0; d0 < 4; ++d0) f.k[d0] = *(LAS bf16x8*)(Ks + ((kt * 32 + r32) * MB_KP + d0 * 16 + hi * 8) * 2);
#pragma unroll
                for (int q4 = 0; q4 < 4; ++q4) {
                    union { bf16x8 v; u32x2 hh[2]; } va;
                    LAS char* vp = Vs + (((q4 >> 1) * 32 + r32) * MB_VP + kt * 32 + (q4 & 1) * 16 + 4 * hi) * 2;
                    va.hh[0] = *(LAS u32x2*)(vp); va.hh[1] = *(LAS u32x2*)(vp + 16);
                    f.v[q4] = va.v;
                }
                if (own && kt == nsteps - 1) attn_compute<true>(st, qf, f, tq - (j * MOBA_BLK + kt * 32) - 4 * hi, slope2, dlo, 0x7fffffff, hi, lane);
                else attn_compute<false>(st, qf, f, tq - (j * MOBA_BLK + kt * 32) - 4 * hi, slope2, dlo, 0x7fffffff, hi, lane);
            }
            const float lt = st.l + shxf(st.l, 32, lane);
            const float inv = 1.f / lt;
            if (valid) {
                const size_t pi = ((size_t)(b * SEQ + tq) * NH + h) * 4 + slot;
                u16* orow = P_part + pi * 64;
#pragma unroll
                for (int rq = 0; rq < 4; ++rq) {
                    u32x2 w; w[0] = cvtpk(st.o0[4 * rq] * inv, st.o0[4 * rq + 1] * inv); w[1] = cvtpk(st.o0[4 * rq + 2] * inv, st.o0[4 * rq + 3] * inv);
                    *(u32x2*)(orow + 8 * rq + 4 * hi) = w;
                    w[0] = cvtpk(st.o1[4 * rq] * inv, st.o1[4 * rq + 1] * inv); w[1] = cvtpk(st.o1[4 * rq + 2] * inv, st.o1[4 * rq + 3] * inv);
                    *(u32x2*)(orow + 32 + 8 * rq + 4 * hi) = w;
                }
                if (hi == 0) P_plse[pi] = st.m * LN2 + logf(lt);
            }
        }
        __syncthreads();
    }
}

__device__ __forceinline__ void ph_mobamerge(int L, int rep_, const int wave_s_) {
    PH_FN_BEGIN
    (void)rep_;
    PH_BEGIN;
    for (size_t i = (size_t)bid * NTHR + tid; i < (size_t)T * NH * 8; i += (size_t)G * NTHR) {
        const size_t row = i >> 7; const int h = (int)(i >> 3) & 15, d8 = (int)i & 7;
        const int qb = (int)(row & (SEQ - 1)) >> 8;
        const int nsel = qb < 3 ? qb : 3;
        const size_t pi = (row * NH + h) * 4;
        float l[4], w[4];
        float mx = -INFINITY;
#pragma unroll
        for (int sidx = 0; sidx < 4; ++sidx) { const bool ok = sidx == 3 || sidx < nsel; l[sidx] = ok ? P_plse[pi + sidx] : -INFINITY; mx = fmaxf(mx, l[sidx]); }
        float ws_ = 0.f;
#pragma unroll
        for (int sidx = 0; sidx < 4; ++sidx) { w[sidx] = (sidx == 3 || sidx < nsel) ? expf(l[sidx] - mx) : 0.f; ws_ += w[sidx]; }
        const float inv = 1.f / ws_;
        float acc8[8];
#pragma unroll
        for (int c = 0; c < 8; ++c) acc8[c] = 0.f;
#pragma unroll
        for (int sidx = 0; sidx < 4; ++sidx) {
            if (sidx == 3 || sidx < nsel) {
                const u32x4 a = *(const u32x4*)(P_part + (pi + sidx) * 64 + d8 * 8);
                const float ww = w[sidx] * inv;
#pragma unroll
                for (int c = 0; c < 4; ++c) { acc8[2 * c] += ww * bf2f(a[c] & 0xFFFFu); acc8[2 * c + 1] += ww * bf2f(a[c] >> 16); }
            }
        }
#if WO_FP8
        u32x2 o8; o8[0] = pack_fp8x4(acc8[0] * AO8_SCALE, acc8[1] * AO8_SCALE, acc8[2] * AO8_SCALE, acc8[3] * AO8_SCALE); o8[1] = pack_fp8x4(acc8[4] * AO8_SCALE, acc8[5] * AO8_SCALE, acc8[6] * AO8_SCALE, acc8[7] * AO8_SCALE);
        *(u32x2*)((unsigned char*)P_ao + row * D + h * 64 + d8 * 8) = o8;
#else
        u32x4 o;
#pragma unroll
        for (int c = 0; c < 4; ++c) o[c] = cvtpk(acc8[2 * c], acc8[2 * c + 1]);
        *(u32x4*)(P_ao + row * D + h * 64 + d8 * 8) = o;
#endif
    }
}

constexpr int DL_KP = 72, DL_VP = 388;
constexpr int DL_LDS_K = 0, DL_LDS_V = 384 * DL_KP * 2;
__device__ __forceinline__ void ph_dil(int L, int rep_, const int wave_s_) {
    PH_FN_BEGIN
    (void)rep_;
    PH_BEGIN;
    LAS char* Ks = lds + DL_LDS_K; LAS char* Vs = lds + DL_LDS_V;
    for (int it = bid; it < BATCH * NH * 3 * 32; it += G) {
        const int ch = it & 31, grp = (it >> 5) % 3, bh = it / 96, b = bh >> 4, h = bh & 15;
        const int dil = grp == 0 ? 1 : (grp == 1 ? 4 : 16), Ls = SEQ / dil;
        const float slope2 = exp2f(-0.5f * (float)(h + 1)) * LOG2E * (float)dil;
        const int uc = ch * 256, res = uc / Ls, c0 = uc - res * Ls;
        const int kb0 = c0 - 128;
        {
            const u16* kg = P_qkv + (size_t)(b * SEQ) * 9216 + grp * 3072 + 1024 + h * 64;
#pragma unroll
            for (int i = 0; i < 6; ++i) {
                const int c = tid + i * 512, row = c >> 3, chk = c & 7, ks = kb0 + row;
                if (ks >= 0) *(LAS u32x4*)(Ks + (row * DL_KP + chk * 8) * 2) = *(const u32x4*)(kg + (size_t)(ks * dil + res) * 9216 + chk * 8);
            }
            const u16* vg = P_qkv + (size_t)(b * SEQ) * 9216 + grp * 3072 + 2048 + h * 64;
#pragma unroll
            for (int i = 0; i < 2; ++i) {
                const int c = tid + i * 512, kg4 = c >> 3, chk = c & 7, ks = kb0 + 4 * kg4;
                if (c < 768 && ks >= 0) {
                    u32x4 v4[4];
#pragma unroll
                    for (int q = 0; q < 4; ++q) v4[q] = *(const u32x4*)(vg + (size_t)((ks + q) * dil + res) * 9216 + chk * 8);
#pragma unroll
                    for (int e2 = 0; e2 < 4; ++e2) {
                        u32x2 wlo, whi;
                        wlo[0] = __builtin_amdgcn_perm(v4[1][e2], v4[0][e2], 0x05040100u); wlo[1] = __builtin_amdgcn_perm(v4[3][e2], v4[2][e2], 0x05040100u);
                        whi[0] = __builtin_amdgcn_perm(v4[1][e2], v4[0][e2], 0x07060302u); whi[1] = __builtin_amdgcn_perm(v4[3][e2], v4[2][e2], 0x07060302u);
                        *(LAS u32x2*)(Vs + ((chk * 8 + 2 * e2) * DL_VP + 4 * kg4) * 2) = wlo;
                        *(LAS u32x2*)(Vs + ((chk * 8 + 2 * e2 + 1) * DL_VP + 4 * kg4) * 2) = whi;
                    }
                }
            }
        }
        const int i0 = c0 + wave * 32, iq = i0 + r32, pq = iq * dil + res;
        const u16* qrow = P_qkv + (size_t)(b * SEQ + pq) * 9216 + grp * 3072 + h * 64 + hi * 8;
        bf16x8 qf[4];
#pragma unroll
        for (int d0 = 0; d0 < 4; ++d0) qf[d0] = *(const bf16x8*)(qrow + d0 * 16);
        __syncthreads();
        AttnSt st; st.m = NEGV; st.l = 0.f;
#pragma unroll
        for (int r = 0; r < 16; ++r) { st.o0[r] = 0.f; st.o1[r] = 0.f; }
        const int ktmin = (i0 >= 128) ? 0 : (128 - i0) >> 5;
        for (int kt = 4; kt >= ktmin; --kt) {
            const int lrow0 = (wave + kt) * 32;
            AttnFr f;
#pragma unroll
            for (int d0 = 0; d0 < 4; ++d0) f.k[d0] = *(LAS bf16x8*)(Ks + ((lrow0 + r32) * DL_KP + d0 * 16 + hi * 8) * 2);
#pragma unroll
            for (int q4 = 0; q4 < 4; ++q4) {
                union { bf16x8 v; u32x2 hh[2]; } va;
                LAS char* vp = Vs + (((q4 >> 1) * 32 + r32) * DL_VP + lrow0 + (q4 & 1) * 16 + 4 * hi) * 2;
                va.hh[0] = *(LAS u32x2*)(vp); va.hh[1] = *(LAS u32x2*)(vp + 16);
                f.v[q4] = va.v;
            }
            const int k0 = i0 - 128 + kt * 32;
            if (kt == 4 || kt == 0) attn_compute<true>(st, qf, f, iq - k0 - 4 * hi, slope2, 0, 128, hi, lane);
            else attn_compute<false>(st, qf, f, iq - k0 - 4 * hi, slope2, 0, 128, hi, lane);
        }
        const float lt = st.l + shxf(st.l, 32, lane);
        const float inv = 1.f / lt;
        u16* orow = P_og + (size_t)grp * T * D + (size_t)(b * SEQ + pq) * D + h * 64;
#pragma unroll
        for (int rq = 0; rq < 4; ++rq) {
            u32x2 w; w[0] = cvtpk(st.o0[4 * rq] * inv, st.o0[4 * rq + 1] * inv); w[1] = cvtpk(st.o0[4 * rq + 2] * inv, st.o0[4 * rq + 3] * inv);
            *(u32x2*)(orow + 8 * rq + 4 * hi) = w;
            w[0] = cvtpk(st.o1[4 * rq] * inv, st.o1[4 * rq + 1] * inv); w[1] = cvtpk(st.o1[4 * rq + 2] * inv, st.o1[4 * rq + 3] * inv);
            *(u32x2*)(orow + 32 + 8 * rq + 4 * hi) = w;
        }
        if (hi == 0) P_lse[((size_t)grp * T + (b * SEQ + pq)) * NH + h] = st.m * LN2 + logf(lt);
        __syncthreads();
    }
}

__device__ __forceinline__ void ph_merge(int L, int rep_, const int wave_s_) {
    PH_FN_BEGIN
    (void)rep_;

            PH_BEGIN;
                for (size_t i = (size_t)bid * NTHR + tid; i < (size_t)T * NH * 8; i += (size_t)G * NTHR) {
                    const size_t row = i >> 7; const int h = (int)(i >> 3) & 15, d8 = (int)i & 7;
                    const float l0 = P_lse[(0 * (size_t)T + row) * NH + h], l1 = P_lse[(1 * (size_t)T + row) * NH + h], l2 = P_lse[(2 * (size_t)T + row) * NH + h];
                    const float mx = fmaxf(l0, fmaxf(l1, l2));
                    float w0 = expf(l0 - mx), w1 = expf(l1 - mx), w2 = expf(l2 - mx);
                    const float inv = 1.f / (w0 + w1 + w2); w0 *= inv; w1 *= inv; w2 *= inv;
                    const size_t off = row * D + h * 64 + d8 * 8;
                    const u32x4 a0 = *(const u32x4*)(P_og + off), a1 = *(const u32x4*)(P_og + (size_t)T * D + off), a2 = *(const u32x4*)(P_og + 2 * (size_t)T * D + off);
                    u32x4 o; float of_[8];
#pragma unroll
                    for (int c = 0; c < 4; ++c) {
                        const float lo_ = w0 * bf2f(a0[c] & 0xFFFFu) + w1 * bf2f(a1[c] & 0xFFFFu) + w2 * bf2f(a2[c] & 0xFFFFu);
                        const float hi_ = w0 * bf2f(a0[c] >> 16) + w1 * bf2f(a1[c] >> 16) + w2 * bf2f(a2[c] >> 16);
                        o[c] = cvtpk(lo_, hi_); of_[2 * c] = lo_ * AO8_SCALE; of_[2 * c + 1] = hi_ * AO8_SCALE;
                    }
                    if (WO_FP8) { u32x2 o8; o8[0] = pack_fp8x4(of_[0], of_[1], of_[2], of_[3]); o8[1] = pack_fp8x4(of_[4], of_[5], of_[6], of_[7]); *(u32x2*)((unsigned char*)P_ao + off) = o8; }
                    else *(u32x4*)(P_ao + off) = o;
                }

}

__device__ __forceinline__ void ph_wo(int L, int rep_, const int wave_s_) {
    PH_FN_BEGIN
    (void)rep_;
    const EpiWo E{P_ypre, P_xb};
#if WO_FP8
    const pg8::Gemm g{P_ao, (const u16*)(P_wo8 + (size_t)L * D * D), T, D, D / 2};
    pg8::StaticOrder S; S.init(g.M, g.N, G, bid);
    pg8::gemm_phase<EpiWo, pg8::StaticOrder, false, false, true, 0x7B79>((PG8_LAS unsigned char*)lds, g, S, E, nullptr, wave_s_ * 64 + lane_id_());
#else
    const pg8::Gemm g{P_ao, (const u16*)(ws + WS_WO) + (size_t)L * D * D, T, D, D};
    pg8::StaticOrder S; S.init(g.M, g.N, G, bid);
    pg8::gemm_phase<EpiWo, pg8::StaticOrder, false>((PG8_LAS unsigned char*)lds, g, S, E, nullptr, wave_s_ * 64 + lane_id_());
#endif
}

constexpr int RT_P = 144;
constexpr int RT_ASTAGE = 2 * 64 * 144;
constexpr int RT_LDS_AH = 0, RT_LDS_AL = 64 * RT_P;
constexpr int RT_LDS_BH = 2 * 64 * RT_P, RT_LDS_BL = RT_LDS_BH + 256 * RT_P;
constexpr int RT_LDS_ST = RT_LDS_BL + 256 * RT_P;
__device__ __forceinline__ void ph_router(int L, int rep_, const int wave_s_) {
    PH_FN_BEGIN
    (void)rep_;
    PH_BEGIN;
    const float* lng = CTX_IN(4) + L * D; const float* lnb = CTX_IN(5) + L * D;
    const float* rbias = CTX_IN(7) + L * NE;
    const u16* wrh = (const u16*)(ws + WS_WRH) + (size_t)L * NE * D; const u16* wrl = (const u16*)(ws + WS_WRL) + (size_t)L * NE * D;
    LAS float* stat = (LAS float*)(lds + RT_LDS_ST);
    for (int it = bid; it < T / 64; it += G) {
#pragma unroll 1
        for (int hb_ = 0; hb_ < 2; ++hb_) {
            u32x4 yv[4][2];
#pragma unroll
            for (int rr = 0; rr < 4; ++rr)
#pragma unroll
                for (int j = 0; j < 2; ++j) yv[rr][j] = *(const u32x4*)(P_ypre + ((size_t)it * 64 + wave * 8 + hb_ * 4 + rr) * D + j * 512 + lane * 8);
#pragma unroll
            for (int rr = 0; rr < 4; ++rr) {
                float sm = 0.f;
#pragma unroll
                for (int j = 0; j < 2; ++j)
#pragma unroll
                    for (int c = 0; c < 4; ++c) sm += bf2f(yv[rr][j][c] & 0xFFFFu) + bf2f(yv[rr][j][c] >> 16);
                const float mu = wave_sum(sm) * (1.f / D);
                float q = 0.f;
#pragma unroll
                for (int j = 0; j < 2; ++j)
#pragma unroll
                    for (int c = 0; c < 4; ++c) { const float d0_ = bf2f(yv[rr][j][c] & 0xFFFFu) - mu, d1_ = bf2f(yv[rr][j][c] >> 16) - mu; q += d0_ * d0_ + d1_ * d1_; }
                const float rstd = rsqrtf(wave_sum(q) * (1.f / D) + LN_EPS);
                if (lane == 0) { stat[wave * 8 + hb_ * 4 + rr] = mu; stat[64 + wave * 8 + hb_ * 4 + rr] = rstd; }
            }
        }
        __syncthreads();
        const int arow = tid >> 3, aq = tid & 7;
        const float amu = stat[arow], ars = stat[64 + arow];
        const u16* yp = P_ypre + ((size_t)it * 64 + arow) * D + aq * 8;
        u32x4 ya = *(const u32x4*)(yp);
        u32x4 bw[8], bx[8];
        const u16* wfh = wrh + (size_t)wave * 16 * 4 * 64 * 8 + lane * 8; const u16* wfl = wrl + (size_t)wave * 16 * 4 * 64 * 8 + lane * 8;
#define RT_LOADB(BW, KC_) { _Pragma("unroll") for (int sk = 0; sk < 4; ++sk) { BW[sk] = *(const u32x4*)(wfh + ((KC_) * 4 + sk) * 512); BW[4 + sk] = *(const u32x4*)(wfl + ((KC_) * 4 + sk) * 512); } }
        RT_LOADB(bw, 0)
        RT_LOADB(bx, 1)
        f32x16 lg[2];
#pragma unroll
        for (int r = 0; r < 16; ++r) { lg[0][r] = 0.f; lg[1][r] = 0.f; }
#define RT_WRITEA(KC_) { const int k0 = (KC_) * 64; \
            const f32x4 g0 = *(const f32x4*)(lng + k0 + aq * 8), g1 = *(const f32x4*)(lng + k0 + aq * 8 + 4); \
            const f32x4 b0 = *(const f32x4*)(lnb + k0 + aq * 8), b1 = *(const f32x4*)(lnb + k0 + aq * 8 + 4); \
            f32x4 x0, x1v; \
            _Pragma("unroll") for (int c = 0; c < 4; ++c) { const float y0_ = bf2f(c & 1 ? ya[c >> 1] >> 16 : ya[c >> 1] & 0xFFFFu), y1_ = bf2f(c & 1 ? ya[2 + (c >> 1)] >> 16 : ya[2 + (c >> 1)] & 0xFFFFu); \
                x0[c] = (y0_ - amu) * ars * g0[c] + b0[c]; x1v[c] = (y1_ - amu) * ars * g1[c] + b1[c]; } \
            ya = *(const u32x4*)(yp + (((KC_) + 1 < 16) ? k0 + 64 : 0)); \
            const size_t go = ((size_t)it * 64 + arow) * D + k0 + aq * 8; \
            u32x4 wh; wh[0] = cvtpk(x0[0], x0[1]); wh[1] = cvtpk(x0[2], x0[3]); wh[2] = cvtpk(x1v[0], x1v[1]); wh[3] = cvtpk(x1v[2], x1v[3]); \
            *(u32x4*)(P_xb + go) = wh; \
            u32x2 w8; w8[0] = pack_fp8x4(x0[0], x0[1], x0[2], x0[3]); w8[1] = pack_fp8x4(x1v[0], x1v[1], x1v[2], x1v[3]); \
            *(u32x2*)(P_xb8 + go) = w8; \
            u32x4 wl; \
            wl[0] = cvtpk(x0[0] - bf2f(wh[0] & 0xFFFFu), x0[1] - bf2f(wh[0] >> 16)); wl[1] = cvtpk(x0[2] - bf2f(wh[1] & 0xFFFFu), x0[3] - bf2f(wh[1] >> 16)); \
            wl[2] = cvtpk(x1v[0] - bf2f(wh[2] & 0xFFFFu), x1v[1] - bf2f(wh[2] >> 16)); wl[3] = cvtpk(x1v[2] - bf2f(wh[3] & 0xFFFFu), x1v[3] - bf2f(wh[3] >> 16)); \
            *(LAS u32x4*)(lds + ((KC_) & 1) * RT_ASTAGE + RT_LDS_AH + arow * RT_P + aq * 16) = wh; \
            *(LAS u32x4*)(lds + ((KC_) & 1) * RT_ASTAGE + RT_LDS_AL + arow * RT_P + aq * 16) = wl; }
#define RT_CHUNK(KC_, BW) { __syncthreads(); \
            _Pragma("unroll") for (int sk = 0; sk < 4; ++sk) { \
                const int ko = (sk * 16 + hi * 8) * 2; \
                const bf16x8 bh_ = __builtin_bit_cast(bf16x8, BW[sk]), bl_ = __builtin_bit_cast(bf16x8, BW[4 + sk]); \
                _Pragma("unroll") for (int rb = 0; rb < 2; ++rb) { \
                    const bf16x8 xh = *(const LAS bf16x8*)(lds + ((KC_) & 1) * RT_ASTAGE + RT_LDS_AH + (rb * 32 + r32) * RT_P + ko), xl = *(const LAS bf16x8*)(lds + ((KC_) & 1) * RT_ASTAGE + RT_LDS_AL + (rb * 32 + r32) * RT_P + ko); \
                    lg[rb] = MFMA_BF16(xh, bh_, lg[rb]); lg[rb] = MFMA_BF16(xl, bh_, lg[rb]); lg[rb] = MFMA_BF16(xh, bl_, lg[rb]); \
                } \
            } \
            if ((KC_) + 1 < 16) RT_WRITEA((KC_) + 1) \
            { const int kn_ = ((KC_) + 2 < 16) ? (KC_) + 2 : ((KC_) & 1); RT_LOADB(BW, kn_) } }
        RT_WRITEA(0)
#pragma unroll 1
        for (int kc = 0; kc < 16; kc += 2) {
            RT_CHUNK(kc, bw)
            RT_CHUNK(kc + 1, bx)
        }
#undef RT_CHUNK
#undef RT_WRITEA
#undef RT_LOADB
        __syncthreads();
        LAS float* lgs = (LAS float*)lds;
#pragma unroll
        for (int rb = 0; rb < 2; ++rb)
#pragma unroll
            for (int r = 0; r < 16; ++r) lgs[(rb * 32 + crow(r, hi)) * 257 + wave * 32 + r32] = lg[rb][r];
        __syncthreads();
#pragma unroll 1
        for (int tg = 0; tg < 2; ++tg) {
            float sc[4][4], cv[4][4];
#pragma unroll
            for (int tt = 0; tt < 4; ++tt) {
                const int lr = wave * 8 + tg * 4 + tt;
#pragma unroll
                for (int j = 0; j < 4; ++j) { const int e = lane + 64 * j; sc[tt][j] = 1.f / (1.f + __expf(-lgs[lr * 257 + e])); cv[tt][j] = sc[tt][j] + rbias[e]; }
            }
            float gsel[4][8];
#pragma unroll
            for (int j = 0; j < 4; ++j) {
#pragma unroll
                for (int tt = 0; tt < 4; ++tt) {
                    const float rm = dpp_rowmax(cv[tt][j]);
                    const float m1a = fmaxf(rl_f(rm, 0), rl_f(rm, 16)), m1b = fmaxf(rl_f(rm, 32), rl_f(rm, 48));
                    const unsigned long long bal = __ballot(cv[tt][j] == (hi ? m1b : m1a));
                    const int fa_ = __builtin_ctz((unsigned)(bal & 0xFFFFFFFFull)), fb_ = 32 + __builtin_ctz((unsigned)(bal >> 32));
                    const float c2 = (lane == fa_ || lane == fb_) ? -INFINITY : cv[tt][j];
                    const float rm2 = dpp_rowmax(c2);
                    gsel[tt][2 * j] = m1a + fmaxf(rl_f(rm2, 0), rl_f(rm2, 16));
                    gsel[tt][2 * j + 1] = m1b + fmaxf(rl_f(rm2, 32), rl_f(rm2, 48));
                }
            }
#pragma unroll
            for (int tt = 0; tt < 4; ++tt)
#pragma unroll
                for (int j = 0; j < 4; ++j) {
                    int ra_ = 0, rb_ = 0;
#pragma unroll
                    for (int g2 = 0; g2 < 8; ++g2) {
                        ra_ += ((gsel[tt][g2] > gsel[tt][2 * j]) || (gsel[tt][g2] == gsel[tt][2 * j] && g2 < 2 * j)) ? 1 : 0;
                        rb_ += ((gsel[tt][g2] > gsel[tt][2 * j + 1]) || (gsel[tt][g2] == gsel[tt][2 * j + 1] && g2 < 2 * j + 1)) ? 1 : 0;
                    }
                    cv[tt][j] = ((hi ? rb_ : ra_) < 4) ? cv[tt][j] : NEGV;
                }
            float wsel[4], wsum[4]; int esel[4];
#pragma unroll
            for (int tt = 0; tt < 4; ++tt) { wsel[tt] = 0.f; wsum[tt] = 0.f; esel[tt] = 0; }
#pragma unroll 1
            for (int k = 0; k < TOPK; ++k) {
#pragma unroll
                for (int tt = 0; tt < 4; ++tt) {
                    float bv = cv[tt][0]; int be = lane;
#pragma unroll
                    for (int j = 1; j < 4; ++j) if (cv[tt][j] > bv) { bv = cv[tt][j]; be = lane + 64 * j; }
                    const float rm = dpp_rowmax(bv);
                    const float mval = fmaxf(fmaxf(rl_f(rm, 0), rl_f(rm, 16)), fmaxf(rl_f(rm, 32), rl_f(rm, 48)));
                    const int ri = dpp_rowmin_i(bv == mval ? be : 0x7fffffff);
                    const int e = min(min(__builtin_amdgcn_readlane(ri, 0), __builtin_amdgcn_readlane(ri, 16)), min(__builtin_amdgcn_readlane(ri, 32), __builtin_amdgcn_readlane(ri, 48)));
                    const int jl = e >> 6, ll = e & 63;
                    const float smine = ((jl == 0 ? sc[tt][0] : 0.f) + (jl == 1 ? sc[tt][1] : 0.f)) + ((jl == 2 ? sc[tt][2] : 0.f) + (jl == 3 ? sc[tt][3] : 0.f));
                    const float sw = rl_f(smine, ll);
#pragma unroll
                    for (int j = 0; j < 4; ++j) cv[tt][j] = (lane == ll && jl == j) ? -INFINITY : cv[tt][j];
                    wsum[tt] += sw;
                    if (lane == k) { wsel[tt] = sw; esel[tt] = e; }
                }
            }
#pragma unroll
            for (int tt = 0; tt < 4; ++tt) {
                if (lane < TOPK) {
                    const int tok = it * 64 + wave * 8 + tg * 4 + tt;
                    const int a = tok * TOPK + lane;
                    P_topw[a] = wsel[tt] / wsum[tt] * 2.5f;
                    if (rep_ == 0) {
                        const int pos = atomicAdd(&cnt[esel[tt] * CNT_STRIDE], 1);
                        P_list[(size_t)esel[tt] * T + pos] = a;
                    }
                }
            }
        }
        __syncthreads();
    }
}

__device__ __forceinline__ void ph_gateup(int L, int rep_, const int wave_s_) {
    PH_FN_BEGIN
    (void)rep_;
    {
        PH_BEGIN;
        const float* weg = CTX_IN(8) + (size_t)L * NE * D * DF; const float* weu = CTX_IN(9) + (size_t)L * NE * D * DF;
        LAS int* rowva = (LAS int*)(lds + MOE_LDS_VA);
        {
            int* octr = (int*)(ws + WS_CTL + CTL_CNT_OFF + 8192) + (L * 4 + 2 * (rep_ & 1)) * 64;
            LAS int* slot = (LAS int*)(lds + 140000);
            for (;;) {
                __syncthreads();
                if (tid == 0) { int q; do { q = atomicAdd(octr, 1); } while (q >= NE && q < NE * 5 && cnt[((q - NE) >> 2) * CNT_STRIDE] <= MOE_XCAP); *slot = q; }
                __syncthreads();
                const int q = *slot;
                if (q >= NE * 5) break;
                const bool ovf = q >= NE;
                const int e = ovf ? (q - NE) >> 2 : q, pz = ovf ? (q - NE) & 3 : 0, npz = ovf ? 1 : 4, st0 = ovf ? 1 : 0, n = cnt[e * CNT_STRIDE];
                for (int r0 = 0; r0 < n; r0 += 1024) {
                    if (ovf && n - r0 <= MOE_XCAP) break;
#pragma unroll
                    for (int i = 0; i < 2; ++i) { int t_ = tid; asm volatile("" : "+v"(t_)); const int idx = r0 + i * 512 + t_; rowva[i * 512 + t_] = idx < n ? P_list[(size_t)e * T + idx] : TRASH_VA; }
                    __syncthreads();
                    moe_expert<false>(lds, tid, lane, wave, r32, hi, P_xb8, weg + (size_t)e * D * DF, weu + (size_t)e * D * DF, (n - r0) < 1024 ? (n - r0) : 1024, (void*)P_hb, pz, npz, st0, 1, false, !ovf && (n - r0) > 512 && (n - r0) <= MOE_XCAP);
                }
            }
        }
    }
    {
        PH_BEGIN;
        const pg8::Gemm g{P_xb, (const u16*)(ws + WS_WSGU) + (size_t)L * 512 * 1024, T, 512, D};
        const EpiSGU E{P_hbs};
        int* qctr = (int*)(ws + WS_CTL + CTL_CNT_OFF + 4096) + (L * 4 + 2 * (rep_ & 1)) * 64;
        LAS int* slot = (LAS int*)(lds + 140000);
        for (;;) {
            __syncthreads();
            if (tid == 0) *slot = atomicAdd(qctr, 1);
            __syncthreads();
            const int un = *slot;
            if (un >= 128) break;
            const pg8::FixedOrder S{un & 63, un >> 6};
            pg8::gemm_phase<EpiSGU, pg8::FixedOrder, false>((PG8_LAS unsigned char*)lds, g, S, E, nullptr, wave_s_ * 64 + lane_id_());
        }
    }
}

__device__ __forceinline__ void ph_down(int L, int rep_, const int wave_s_) {
    PH_FN_BEGIN
    (void)rep_;
    {
        PH_BEGIN;
        const float* wed = CTX_IN(10) + (size_t)L * NE * DF * D;
        LAS int* rowva = (LAS int*)(lds + MOE_LDS_VA); LAS float* roww = (LAS float*)(lds + MOE_LDS_W);
        {
            int* octr = (int*)(ws + WS_CTL + CTL_CNT_OFF + 8192) + (L * 4 + 1 + 2 * (rep_ & 1)) * 64;
            LAS int* slot = (LAS int*)(lds + 140000);
            for (;;) {
                __syncthreads();
                if (tid == 0) { int q; do { q = atomicAdd(octr, 1); } while (q >= NE && q < NE * 5 && cnt[((q - NE) >> 2) * CNT_STRIDE] <= 512); *slot = q; }
                __syncthreads();
                const int q = *slot;
                if (q >= NE * 5) break;
                const bool ovf = q >= NE;
                const int e = ovf ? (q - NE) >> 2 : q, pz = ovf ? ((q - NE) & 3) * 2 : 0, npz = ovf ? 2 : 8, st0 = ovf ? 1 : 0, n = cnt[e * CNT_STRIDE];
                for (int r0 = 0; r0 < n; r0 += 1024) {
                    if (ovf && n - r0 <= 512) break;
#pragma unroll
                    for (int i = 0; i < 2; ++i) { int t_ = tid; asm volatile("" : "+v"(t_)); const int idx = r0 + i * 512 + t_; const int va = idx < n ? P_list[(size_t)e * T + idx] : TRASH_VA; rowva[i * 512 + t_] = va; roww[i * 512 + t_] = va < A_TOT ? P_topw[va] * Y8_SCALE : 0.f; }
                    __syncthreads();
                    moe_expert<true>(lds, tid, lane, wave, r32, hi, (const unsigned char*)P_hb, wed + (size_t)e * DF * D, nullptr, (n - r0) < 1024 ? (n - r0) : 1024, (void*)P_yb, pz, npz, st0, 1, true);
                }
            }
        }
    }
    {
        PH_BEGIN;
        const pg8::Gemm g{P_hbs, (const u16*)(ws + WS_WSD) + (size_t)L * D * DF, T, D, DF};
        const EpiSD E{P_yb};
        int* qctr = (int*)(ws + WS_CTL + CTL_CNT_OFF + 4096) + (L * 4 + 1 + 2 * (rep_ & 1)) * 64;
        LAS int* slot = (LAS int*)(lds + 140000);
        for (;;) {
            __syncthreads();
            if (tid == 0) *slot = atomicAdd(qctr, 1);
            __syncthreads();
            const int un = *slot;
            if (un >= 256) break;
            const pg8::FixedOrder S{un & 63, un >> 6};
            pg8::gemm_phase<EpiSD, pg8::FixedOrder, false>((PG8_LAS unsigned char*)lds, g, S, E, nullptr, wave_s_ * 64 + lane_id_());
        }
    }
}

__device__ __forceinline__ void ph_combine(int L, int rep_, const int wave_s_) {
    PH_FN_BEGIN
    (void)rep_;
    PH_BEGIN;
    const float* lng = CTX_IN(14) + L * D; const float* lnb = CTX_IN(15) + L * D;
    float* dst = AS_GLOBAL(float, ctx_ld(16));
    for (int row = bid * 8 + wave; row < T; row += G * 8) {
        u32x4 yv[TOPK + 1][2];
#pragma unroll
        for (int k = 0; k < TOPK + 1; ++k) {
            const size_t va = k < TOPK ? (size_t)row * TOPK + k : (size_t)A_TOT + row;
            if (k < TOPK) {
#pragma unroll
                for (int j = 0; j < 2; ++j) { const u32x2 w8 = *(const u32x2*)((const unsigned char*)P_yb + va * D + j * 512 + lane * 8); yv[k][j][0] = w8[0]; yv[k][j][1] = w8[1]; yv[k][j][2] = 0u; yv[k][j][3] = 0u; }
            } else {
#pragma unroll
                for (int j = 0; j < 2; ++j) yv[k][j] = *(const u32x4*)(P_yb + va * D + j * 512 + lane * 8);
            }
        }
        float v[16];
#pragma unroll
        for (int j = 0; j < 2; ++j) {
            const u32x4 t = *(const u32x4*)(P_xb + (size_t)row * D + j * 512 + lane * 8);
#pragma unroll
            for (int c = 0; c < 4; ++c) { v[j * 8 + 2 * c] = DN_ALPHA * bf2f(t[c] & 0xFFFFu); v[j * 8 + 2 * c + 1] = DN_ALPHA * bf2f(t[c] >> 16); }
        }
#pragma unroll
        for (int k = 0; k < TOPK + 1; ++k)
#pragma unroll
            for (int j = 0; j < 2; ++j) {
                if (k < TOPK) {
#pragma unroll
                    for (int c = 0; c < 2; ++c) {
                        const f32x2_ lo2 = __builtin_amdgcn_cvt_pk_f32_fp8((int)yv[k][j][c], false), hi2 = __builtin_amdgcn_cvt_pk_f32_fp8((int)yv[k][j][c], true);
                        v[j * 8 + 4 * c] += lo2[0] * (1.f / Y8_SCALE); v[j * 8 + 4 * c + 1] += lo2[1] * (1.f / Y8_SCALE); v[j * 8 + 4 * c + 2] += hi2[0] * (1.f / Y8_SCALE); v[j * 8 + 4 * c + 3] += hi2[1] * (1.f / Y8_SCALE);
                    }
                } else {
#pragma unroll
                    for (int c = 0; c < 4; ++c) { v[j * 8 + 2 * c] += bf2f(yv[k][j][c] & 0xFFFFu); v[j * 8 + 2 * c + 1] += bf2f(yv[k][j][c] >> 16); }
                }
            }
        float sm = 0.f;
#pragma unroll
        for (int i = 0; i < 16; ++i) sm += v[i];
        const float mu = wave_sum(sm) * (1.f / D);
        float q = 0.f;
#pragma unroll
        for (int i = 0; i < 16; ++i) { const float d = v[i] - mu; q += d * d; }
        const float rstd = rsqrtf(wave_sum(q) * (1.f / D) + LN_EPS);
#pragma unroll
        for (int j = 0; j < 2; ++j) {
            const f32x4 g0 = *(const f32x4*)(lng + j * 512 + lane * 8), g1 = *(const f32x4*)(lng + j * 512 + lane * 8 + 4);
            const f32x4 b0 = *(const f32x4*)(lnb + j * 512 + lane * 8), b1 = *(const f32x4*)(lnb + j * 512 + lane * 8 + 4);
            f32x4 o0, o1;
#pragma unroll
            for (int c = 0; c < 4; ++c) { o0[c] = (v[j * 8 + c] - mu) * rstd * g0[c] + b0[c]; o1[c] = (v[j * 8 + 4 + c] - mu) * rstd * g1[c] + b1[c]; }
            if (L == 1) { *(f32x4*)(dst + (size_t)row * D + j * 512 + lane * 8) = o0; *(f32x4*)(dst + (size_t)row * D + j * 512 + lane * 8 + 4) = o1; }
            if (L == 0) { u32x4 w; w[0] = cvtpk(o0[0], o0[1]); w[1] = cvtpk(o0[2], o0[3]); w[2] = cvtpk(o1[0], o1[1]); w[3] = cvtpk(o1[2], o1[3]); *(u32x4*)(P_xb + (size_t)row * D + j * 512 + lane * 8) = w;
                if (QKV_FP8) { u32x2 w8; w8[0] = pack_fp8x4(o0[0], o0[1], o0[2], o0[3]); w8[1] = pack_fp8x4(o1[0], o1[1], o1[2], o1[3]); *(u32x2*)(P_xq8 + (size_t)row * D + j * 512 + lane * 8) = w8; } }
        }
    }
}

__global__ void __launch_bounds__(NTHR, 2) fwd(Args args) {
    extern __shared__ __attribute__((aligned(16))) unsigned char lds_raw[];
    LAS char* lds = (LAS char*)lds_raw;
    unsigned char* const ws = args.ws;
    const int lo = args.ph_lo, hi_ph = args.ph_hi;
    const int wave_s_ = __builtin_amdgcn_readfirstlane(threadIdx.x >> 6);
    if (threadIdx.x < 18) {
        const uint64_t v = threadIdx.x < 16 ? (uint64_t)args.in[threadIdx.x] : (threadIdx.x == 16 ? (uint64_t)args.out : (uint64_t)args.ws);
        ((LAS uint64_t*)(lds + LDS_CTX))[threadIdx.x] = v;
    }
    __syncthreads();
#define IN(k) (lo <= (k) && (k) < hi_ph)

#if MK_ONE_LAUNCH
    if (threadIdx.x < 4) ((LAS unsigned*)(lds + LDS_BAR))[threadIdx.x] = 0u;
    __syncthreads();
    XcdBarrier bar = xcd_barrier_post((unsigned*)(ws + WS_CTL), (volatile LAS unsigned*)(lds + LDS_BAR), wave_s_ == 0 && lane_id_() == 0);
#define GRID_BAR() xcd_barrier(bar, wave_s_ == 0 && lane_id_() == 0)
#else
#define GRID_BAR() do { } while (0)
#endif
#define SEAM(k) do { if (IN(k) && IN((k) + 1)) GRID_BAR(); } while (0)

    for (int rep_ = 0; rep_ < ((IN(0) && PHK(0)) ? REPS(0) : 0); ++rep_) { ph_p0(0, rep_, wave_s_); }
    SEAM(0);

    for (int L = 0; L < 2; ++L) {
        const int pb = 1 + 10 * L;
        for (int rep_ = 0; rep_ < ((IN(pb + 0) && PHK(1)) ? REPS(1) : 0); ++rep_) { ph_qkv(L, rep_, wave_s_); }
        SEAM(pb + 0);

        if (L == 0) {
            for (int rep_ = 0; rep_ < ((IN(pb + 1) && PHK(2)) ? REPS(2) : 0); ++rep_) { ph_kmean(L, rep_, wave_s_); }
            SEAM(pb + 1);
            for (int rep_ = 0; rep_ < ((IN(pb + 2) && PHK(11)) ? REPS(11) : 0); ++rep_) { ph_gate(L, rep_, wave_s_); }
            SEAM(pb + 2);
        }

        if (L == 0) {
            for (int rep_ = 0; rep_ < ((IN(pb + 3) && PHK(3)) ? REPS(3) : 0); ++rep_) { ph_moba(L, rep_, wave_s_); }
            SEAM(pb + 3);
            for (int rep_ = 0; rep_ < ((IN(pb + 4) && PHK(12)) ? REPS(12) : 0); ++rep_) { ph_mobamerge(L, rep_, wave_s_); }
        } else {
            for (int rep_ = 0; rep_ < ((IN(pb + 3) && PHK(4)) ? REPS(4) : 0); ++rep_) { ph_dil(L, rep_, wave_s_); }
            SEAM(pb + 3);
            for (int rep_ = 0; rep_ < ((IN(pb + 4) && PHK(5)) ? REPS(5) : 0); ++rep_) { ph_merge(L, rep_, wave_s_); }
        }
        SEAM(pb + 4);

        for (int rep_ = 0; rep_ < ((IN(pb + 5) && PHK(6)) ? REPS(6) : 0); ++rep_) { ph_wo(L, rep_, wave_s_); }
        SEAM(pb + 5);

        for (int rep_ = 0; rep_ < ((IN(pb + 6) && PHK(7)) ? REPS(7) : 0); ++rep_) { ph_router(L, rep_, wave_s_); }
        SEAM(pb + 6);

        for (int rep_ = 0; rep_ < ((IN(pb + 7) && PHK(8)) ? REPS(8) : 0); ++rep_) { ph_gateup(L, rep_, wave_s_); }
        SEAM(pb + 7);

        for (int rep_ = 0; rep_ < ((IN(pb + 8) && PHK(9)) ? REPS(9) : 0); ++rep_) { ph_down(L, rep_, wave_s_); }
        SEAM(pb + 8);

        for (int rep_ = 0; rep_ < ((IN(pb + 9) && PHK(10)) ? REPS(10) : 0); ++rep_) { ph_combine(L, rep_, wave_s_); }
        if (L == 0) SEAM(pb + 9);
    }
}

extern "C" void kernel_launch(void* const* d_in, const int* in_sizes, int n_in, void* d_out, int out_size, void* d_ws, size_t ws_size, hipStream_t stream) {
    static int grid = 0;
    if (grid == 0) {
        if (n_in != 16 || out_size != T * D || ws_size < WS_END3) { fprintf(stderr, "kernel_launch: unexpected problem (n_in %d out %d ws %zu need %zu)\n", n_in, out_size, ws_size, (size_t)WS_END2); grid = -1; return; }
        int dev = 0, cus = 0, per_cu = 0;
        if (hipGetDevice(&dev) != hipSuccess || hipDeviceGetAttribute(&cus, hipDeviceAttributeMultiprocessorCount, dev) != hipSuccess) { grid = -1; return; }
        if (hipFuncSetAttribute((const void*)fwd, hipFuncAttributeMaxDynamicSharedMemorySize, LDS_BYTES) != hipSuccess) { fprintf(stderr, "kernel_launch: hipFuncSetAttribute failed\n"); grid = -1; return; }
        if (hipOccupancyMaxActiveBlocksPerMultiprocessor(&per_cu, (const void*)fwd, NTHR, LDS_BYTES) != hipSuccess || per_cu < 1) { fprintf(stderr, "kernel_launch: occupancy query says %d\n", per_cu); (void)hipGetLastError(); per_cu = 1; }
        grid = cus;
    }
    if (grid < 0) return;
    (void)hipMemsetAsync((char*)d_ws + WS_CTL, 0, CTL_BYTES, stream);
    Args a{};
    for (int i = 0; i < 16; ++i) a.in[i] = (const float*)d_in[i];
    a.out = (float*)d_out; a.ws = (unsigned char*)d_ws;
#if MK_ONE_LAUNCH
    a.ph_lo = 0; a.ph_hi = N_PHASES;
    hipLaunchKernelGGL(fwd, dim3(grid), dim3(NTHR), LDS_BYTES, stream, a);
#else
    for (int ph = 0; ph < N_PHASES; ++ph) {
        if (ph == 12 || ph == 13) continue;
        a.ph_lo = ph; a.ph_hi = ph + 1;
        hipLaunchKernelGGL(fwd, dim3(grid), dim3(NTHR), LDS_BYTES, stream, a);
    }
#endif
}
```

```cpp
#include <hip/hip_runtime.h>
#include <hip/hip_bf16.h>
#include <stdint.h>
#include <stdio.h>

#ifndef MK_ONE_LAUNCH
#define MK_ONE_LAUNCH 1
#endif

#ifndef PHMASK
#define PHMASK 0x1FFF
#endif
#define PHK(k) ((PHMASK >> (k)) & 1)
#ifndef REPEAT_KIND
#define REPEAT_KIND -1
#endif
#define REPS(k) ((k) == REPEAT_KIND ? 2 : 1)
#define LAS __attribute__((address_space(3)))
typedef __attribute__((ext_vector_type(8))) short bf16x8;
typedef __attribute__((ext_vector_type(16))) float f32x16;
typedef __attribute__((ext_vector_type(4))) float f32x4;
typedef __attribute__((ext_vector_type(4))) unsigned u32x4;
typedef __attribute__((ext_vector_type(2))) unsigned u32x2;
typedef unsigned short u16;

constexpr int D = 1024, BATCH = 2, SEQ = 8192, T = BATCH * SEQ, NH = 16, HD = 64;
constexpr int NE = 256, TOPK = 8, DF = 256;
constexpr int A_TOT = T * TOPK;
constexpr int MOBA_BLK = 256, MOBA_NB = SEQ / MOBA_BLK;
constexpr float DN_ALPHA = 1.4142135623730951f;
constexpr float LN_EPS = 1e-5f;
constexpr float LOG2E = 1.4426950408889634f;
constexpr float LN2 = 0.6931471805599453f;
constexpr float NEGV = -1e30f;
constexpr int NTHR = 512;

constexpr size_t al256(size_t x) { return (x + 255) & ~(size_t)255; }
constexpr size_t WS_CTL = 0;
constexpr size_t CTL_BYTES = 131072;
constexpr size_t CTL_CNT_OFF = 32768;
constexpr size_t CTL_XQ_OFF = 45056;
constexpr size_t CTL_ECNT_OFF = 65536;
constexpr int CNT_STRIDE = 32;
constexpr size_t WS_XB = WS_CTL + CTL_BYTES;
constexpr size_t WS_X1 = WS_XB + al256((size_t)T * D * 2);
constexpr size_t WS_X2 = WS_X1 + al256((size_t)T * D * 4);
constexpr size_t WS_YPRE = WS_X2 + al256((size_t)T * D * 4);
constexpr size_t WS_QKV = WS_YPRE + al256((size_t)T * D * 4);
constexpr size_t WS_VT = WS_QKV + al256((size_t)T * 9216 * 2);
constexpr size_t WS_KM = WS_VT + al256((size_t)3 * T * D * 2);
constexpr size_t WS_AO = WS_KM + al256((size_t)BATCH * NH * MOBA_NB * HD * 4);
constexpr size_t WS_OG = WS_AO + al256((size_t)T * D * 2);
constexpr size_t WS_LSE = WS_OG + al256((size_t)3 * T * D * 2);
constexpr size_t WS_TOPW = WS_LSE + al256((size_t)3 * T * NH * 4);
constexpr size_t WS_LIST = WS_TOPW + al256((size_t)T * TOPK * 4);
constexpr size_t WS_HB = WS_LIST + al256((size_t)NE * T * 4);
constexpr size_t WS_YB = WS_HB + al256((size_t)(A_TOT + T + 1) * DF * 2);
constexpr size_t WS_END = WS_YB + al256((size_t)(A_TOT + T + 1) * D * 2);
constexpr int TRASH_VA = A_TOT + T;
constexpr size_t WS_SELM = WS_END;
constexpr size_t WS_PART = WS_SELM + al256((size_t)T * NH * 4);
constexpr size_t WS_PLSE = WS_PART + al256((size_t)T * NH * 4 * 64 * 2);
constexpr size_t WS_WQK0 = WS_PLSE + al256((size_t)T * NH * 4 * 4);
constexpr size_t WS_WV0 = WS_WQK0 + (size_t)2048 * 1024 * 2;
constexpr size_t WS_WQK1 = WS_WV0 + (size_t)1024 * 1024 * 2;
constexpr size_t WS_WV1 = WS_WQK1 + (size_t)6144 * 1024 * 2;
constexpr size_t WS_WO = WS_WV1 + (size_t)3072 * 1024 * 2;
constexpr size_t WS_WSGU = WS_WO + (size_t)2 * 1024 * 1024 * 2;
constexpr size_t WS_WSD = WS_WSGU + (size_t)2 * 512 * 1024 * 2;
constexpr size_t WS_XB8 = WS_WSD + (size_t)2 * 1024 * 256 * 2;
constexpr size_t WS_HBS = WS_XB8 + (size_t)T * D;
constexpr size_t WS_WRH = WS_HBS + (size_t)T * DF * 2;
constexpr size_t WS_WRL = WS_WRH + (size_t)2 * 256 * 1024 * 2;
constexpr size_t WS_END2 = WS_WRL + (size_t)2 * 256 * 1024 * 2;
constexpr size_t WS_XQ8 = WS_END2;
constexpr size_t WS_WQ8 = WS_XQ8 + (size_t)T * D;
constexpr size_t WS_WO8 = WS_WQ8 + (size_t)(3072 + 9216) * 1024;
constexpr size_t WS_END3 = WS_WO8 + (size_t)2 * 1024 * 1024;
#ifndef WO_FP8
#define WO_FP8 1
#endif
constexpr float AO8_SCALE = 16.f;
#ifndef QKV_FP8
#define QKV_FP8 2
#endif

constexpr int LDP = 40;
constexpr int STAGE_BYTES = 2 * 256 * LDP * 2;
constexpr int LDS_ROWID = 2 * STAGE_BYTES;
constexpr int LDS_ROWW = LDS_ROWID + 1024;
constexpr int XS_PITCH = 1028;
constexpr int LDS_BYTES = 163840;
constexpr int LDS_BAR = 161792;

__device__ __forceinline__ int lane_id_() { int l; asm volatile("v_mbcnt_lo_u32_b32 %0, -1, 0\n\tv_mbcnt_hi_u32_b32 %0, -1, %0" : "=v"(l)); return l; }
__device__ __forceinline__ float shxf(float v, int m, int lane) { return __int_as_float(__builtin_amdgcn_ds_bpermute((lane ^ m) << 2, __float_as_int(v))); }
__device__ __forceinline__ int shxi(int v, int m, int lane) { return __builtin_amdgcn_ds_bpermute((lane ^ m) << 2, v); }
#define XB_TMO      128
#define XB_XCNT(j)  (256  + 64 * (j))
#define XB_XSUB(j)  (1280 + 64 * (j))
#define XB_XGEN(j)  (2304 + 64 * (j))
#define XB_TOP      3328
#define XB_TOPGEN   3392
#define XCD_BAR_WORDS 3456
#define XB_SPIN_CAP (1u << 18)
__device__ __forceinline__ unsigned xb_ld(unsigned* p)              { return __hip_atomic_load(p, __ATOMIC_RELAXED, __HIP_MEMORY_SCOPE_AGENT); }
__device__ __forceinline__ unsigned xb_add(unsigned* p, unsigned v) { return __hip_atomic_fetch_add(p, v, __ATOMIC_RELAXED, __HIP_MEMORY_SCOPE_AGENT); }
__device__ __forceinline__ unsigned xb_xcc_id() { return (unsigned)__builtin_amdgcn_s_getreg((3 << 11) | 20) & 0xFu; }
#define XB_SPIN(cond, bar) do { unsigned _sp = 0; while (cond) { __builtin_amdgcn_s_sleep(1); \
    if ((++_sp & 255u) == 0u) { if (xb_ld(&(bar)[XB_TMO])) break; if (_sp > XB_SPIN_CAP) { atomicAdd(&(bar)[XB_TMO], 1u); break; } } } } while (0)
struct XcdBarrier { unsigned* bar; unsigned x; volatile LAS unsigned* st; };
__device__ __forceinline__ XcdBarrier xcd_barrier_post(unsigned* bar, volatile LAS unsigned* st, const bool leader) {
    XcdBarrier b; b.bar = bar; b.x = xb_xcc_id(); b.st = st;
    if (leader) (void)xb_add(&bar[XB_XCNT(b.x)], 1u);
    return b;
}
__device__ __forceinline__ void xcd_barrier_complete(unsigned* bar, unsigned x, unsigned& nloc, unsigned& nx) {
    const unsigned G = gridDim.x * gridDim.y * gridDim.z;
    unsigned sum, cnt, mine, sp = 0u;
    for (;;) {
        sum = 0u; cnt = 0u; mine = 0u;
#pragma unroll
        for (unsigned j = 0; j < 16; ++j) { const unsigned c = xb_ld(&bar[XB_XCNT(j)]); sum += c; cnt += (c > 0u) ? 1u : 0u; mine = (j == x) ? c : mine; }
        if (sum == G) break;
        __builtin_amdgcn_s_sleep(1);
        if ((++sp & 255u) == 0u) { if (xb_ld(&bar[XB_TMO])) break; if (sp > XB_SPIN_CAP) { atomicAdd(&bar[XB_TMO], 1u); break; } }
    }
    nloc = mine > 0u ? mine : 1u; nx = cnt > 0u ? cnt : 1u;
}
__device__ __forceinline__ void xcd_barrier(const XcdBarrier& b, const bool leader) {
    asm volatile("s_waitcnt vmcnt(0)" ::: "memory");
    __syncthreads();
    if (leader) {
        unsigned* bar = b.bar;
        __builtin_amdgcn_s_waitcnt(0);
        unsigned nloc = b.st[0], nx = b.st[1];
        if (nloc == 0u) { xcd_barrier_complete(bar, b.x, nloc, nx); b.st[0] = nloc; b.st[1] = nx; }
        const unsigned old = xb_add(&bar[XB_XSUB(b.x)], 1u);
        const unsigned gen = old / nloc;
        if (old + 1u == (gen + 1u) * nloc) {
            __builtin_amdgcn_fence(__ATOMIC_RELEASE, "agent");
            asm volatile("s_waitcnt vmcnt(0)" ::: "memory");
            const unsigned og = xb_add(&bar[XB_TOP], 1u);
            const unsigned tg = og / nx;
            if (og + 1u == (tg + 1u) * nx) xb_add(&bar[XB_TOPGEN], 1u);
            else XB_SPIN(xb_ld(&bar[XB_TOPGEN]) == tg, bar);
            __builtin_amdgcn_fence(__ATOMIC_ACQUIRE, "agent");
            xb_add(&bar[XB_XGEN(b.x)], 1u);
            asm volatile("s_waitcnt vmcnt(0)" ::: "memory");
        } else {
            XB_SPIN(xb_ld(&bar[XB_XGEN(b.x)]) == gen, bar);
            __builtin_amdgcn_fence(__ATOMIC_ACQUIRE, "agent");
            asm volatile("s_waitcnt vmcnt(0)" ::: "memory");
        }
    }
    __syncthreads();
}

typedef __attribute__((ext_vector_type(2))) __bf16 bf16x2_t;
typedef __attribute__((ext_vector_type(2))) float f32x2_t;
__device__ __forceinline__ unsigned cvtpk(float lo, float hi) { f32x2_t f; f[0] = lo; f[1] = hi; return __builtin_bit_cast(unsigned, __builtin_convertvector(f, bf16x2_t)); }
__device__ __forceinline__ float bf2f(unsigned v16) { return __uint_as_float(v16 << 16); }
__device__ __forceinline__ int crow(int r, int hi) { return (r & 3) + 8 * (r >> 2) + 4 * hi; }
#define MFMA_BF16(a, b, c) __builtin_amdgcn_mfma_f32_32x32x16_bf16(a, b, c, 0, 0, 0)
__device__ __forceinline__ float wave_sum(float v) {
    v += __int_as_float(__builtin_amdgcn_update_dpp(0, __float_as_int(v), 0xB1, 0xF, 0xF, true));
    v += __int_as_float(__builtin_amdgcn_update_dpp(0, __float_as_int(v), 0x4E, 0xF, 0xF, true));
    v += __int_as_float(__builtin_amdgcn_update_dpp(0, __float_as_int(v), 0x141, 0xF, 0xF, true));
    v += __int_as_float(__builtin_amdgcn_update_dpp(0, __float_as_int(v), 0x140, 0xF, 0xF, true));
    const int vi = __float_as_int(v);
    return (__int_as_float(__builtin_amdgcn_readlane(vi, 0)) + __int_as_float(__builtin_amdgcn_readlane(vi, 16))) + (__int_as_float(__builtin_amdgcn_readlane(vi, 32)) + __int_as_float(__builtin_amdgcn_readlane(vi, 48)));
}

namespace pg8 {
#define PG8_LAS __attribute__((address_space(3)))
typedef unsigned short bf16_t;
typedef short bf16x8 __attribute__((ext_vector_type(8)));
typedef float f32x4 __attribute__((ext_vector_type(4)));
typedef unsigned u32x4 __attribute__((ext_vector_type(4)));
typedef int pg8_i32x8 __attribute__((ext_vector_type(8)));
constexpr int BM = 256, BK = 64, HALF = 128, HTB = HALF * BK * 2  , STAGE_BYTES = 8 * HTB, NXCD = 8, WGM = 8;

__host__ __device__ __forceinline__ int lds_byte(int r, int c) { const int st = (r >> 4) * 2 + (c >> 5), rr = r & 15, cc = c & 31, ob = rr * 64 + cc * 2; return st * 1024 + (ob ^ (((ob >> 9) & 1) << 5)); }
__host__ __device__ __forceinline__ void stage_rc(int b, int& R, int& C) { const int st = b / 1024, sb = b % 1024, swz = sb ^ (((sb >> 9) & 1) << 5); R = (st >> 1) * 16 + swz / 64; C = (st & 1) * 32 + (swz % 64) / 2; }
__device__ __forceinline__ int pg8_opq(int v) { asm volatile("" : "+v"(v)); return v; }
__host__ __device__ __forceinline__ int perm32(int rho) { const int n = rho >> 4, i = rho & 15; return 8 * (i >> 2) + 4 * n + (i & 3); }

struct Unit { int pm, pn; };
struct Gemm { const bf16_t* A; const bf16_t* Bt; int M, N, K; };
struct FixedOrder {
    int pm, pn;
    __device__ __forceinline__ bool next(int i, Unit& u) const { if (i != 0) return false; u.pm = pm; u.pn = pn; return true; }
    __device__ __forceinline__ void a_ready(const Unit&) const {}
    __device__ __forceinline__ void done(const Unit&) const {}
};

struct StaticOrder {
    int nM, nN, nwg, G, c;
    __host__ __device__ void init(int M, int N, int G_, int c_) { nM = M / BM; nN = N / BM; nwg = nM * nN; G = G_; c = c_; }
    __host__ __device__ bool next(int i, Unit& u) const {
        const long L = (long)i * G + c; if (L >= nwg) return false;
        int wgid = (int)L; { const int q = nwg / NXCD, r = nwg % NXCD, xcd = wgid % NXCD, off = wgid / NXCD; wgid = (xcd < r ? xcd * (q + 1) : r * (q + 1) + (xcd - r) * q) + off; }
        const int nig = WGM * nN, gid = wgid / nig, fm = gid * WGM, gsz = (nM - fm) < WGM ? (nM - fm) : WGM;
        u.pm = fm + ((wgid % nig) % gsz); u.pn = (wgid % nig) / gsz; return true;
    }
    __device__ __forceinline__ void a_ready(const Unit&) const {}
    __device__ __forceinline__ void done(const Unit&) const {}
};

template <class Epi, class Sched, bool SWAP = false, bool STAMP = false, bool F8 = false, int F8SC = 0x7F79  >
__device__ __forceinline__ void gemm_phase(PG8_LAS unsigned char* lds, const Gemm g, const Sched& S, const Epi& E, unsigned long long* stamps, const int tid_in) {
    int tid_ = tid_in; asm volatile("" : "+v"(tid_));
    const int tid = tid_, wid = __builtin_amdgcn_readfirstlane(tid >> 6), lane = tid & 63, wr = wid >> 2, wc = wid & 3, fr = lane & 15, fq = lane >> 4;
    const int K = g.K, nt = K / BK;
    int ts_lo = 0, ts_hi = 0, nts = 0; const unsigned long long rt_entry = STAMP ? (unsigned long long)wall_clock64() : 0ull;
#define PG8_STAMP() do { if (STAMP && wid == 0 && nts < 64) { const unsigned long long _c = (unsigned long long)clock64(); \
        ts_lo = (lane == nts) ? (int)(unsigned)_c : ts_lo; ts_hi = (lane == nts) ? (int)(unsigned)(_c >> 32) : ts_hi; ++nts; } } while (0)
    PG8_STAMP();
    unsigned voffA[2], voffB[2];
#pragma unroll
    for (int i = 0; i < 2; ++i) { int R, C; stage_rc(tid * 16 + i * 8192, R, C); const int Rb = Epi::PERM ? ((R & ~31) + perm32(R & 31)) : R;
        voffA[i] = (unsigned)(R * K + C) * 2u; voffB[i] = (unsigned)(Rb * K + C) * 2u; }
    const size_t kstep = (size_t)(BK * 2);
    const size_t hstep = (size_t)HALF * K * 2;
    const size_t tstep = 2 * hstep;
    const unsigned ldsw = (unsigned)wid * 1024u;
    int xoff_ = lds_byte(fr, fq * 8); asm volatile("" : "+v"(xoff_));
    const int aoffs = wr * 8192, boffs = wc * 4096;
#define aoff (aoffs + pg8_opq(xoff_))
#define boff (boffs + pg8_opq(xoff_))
#define PG8_SA(b, h) (((b) * 2 + (h)) * HTB)
#define PG8_SB(b, h) ((4 + (b) * 2 + (h)) * HTB)
#define PG8_STAGE(bufoff, gbase, voff) do {   \
        _Pragma("unroll") for (int _i = 0; _i < 2; ++_i) { uint64_t gb_ = (uint64_t)(gbase) + (uint64_t)_i * (size_t)(64 * 2) * K; asm volatile("" : "+s"(gb_)); unsigned vo_ = (voff)[0]; asm volatile("" : "+v"(vo_)); \
        __builtin_amdgcn_global_load_lds((const __attribute__((address_space(1))) unsigned*)((const __attribute__((address_space(1))) char*)gb_ + vo_), (PG8_LAS unsigned*)(lds + (bufoff) + ldsw + _i * 8192), 16, 0, 0); } } while (0)
#define PG8_CAT8(X0, X1) pg8_i32x8{(int)__builtin_bit_cast(u32x4, X0)[0], (int)__builtin_bit_cast(u32x4, X0)[1], (int)__builtin_bit_cast(u32x4, X0)[2], (int)__builtin_bit_cast(u32x4, X0)[3], \
                                   (int)__builtin_bit_cast(u32x4, X1)[0], (int)__builtin_bit_cast(u32x4, X1)[1], (int)__builtin_bit_cast(u32x4, X1)[2], (int)__builtin_bit_cast(u32x4, X1)[3]}
#define PG8_LDA(dst, b, h) do { _Pragma("unroll") for (int m = 0; m < 4; ++m) { if (F8) { const bf16x8 x0_ = *(const PG8_LAS bf16x8*)(lds + PG8_SA(b, h) + aoff + m * 2048), x1_ = *(const PG8_LAS bf16x8*)(lds + PG8_SA(b, h) + aoff + m * 2048 + 1024); dst##8[m] = PG8_CAT8(x0_, x1_); } \
        else { _Pragma("unroll") for (int k = 0; k < 2; ++k) dst[m][k] = *(const PG8_LAS bf16x8*)(lds + PG8_SA(b, h) + aoff + m * 2048 + k * 1024); } } } while (0)
#define PG8_LDB(dst, b, h) do { _Pragma("unroll") for (int n = 0; n < 2; ++n) { if (F8) { const bf16x8 x0_ = *(const PG8_LAS bf16x8*)(lds + PG8_SB(b, h) + boff + n * 2048), x1_ = *(const PG8_LAS bf16x8*)(lds + PG8_SB(b, h) + boff + n * 2048 + 1024); dst##8[n] = PG8_CAT8(x0_, x1_); } \
        else { _Pragma("unroll") for (int k = 0; k < 2; ++k) dst[n][k] = *(const PG8_LAS bf16x8*)(lds + PG8_SB(b, h) + boff + n * 2048 + k * 1024); } } } while (0)
#define PG8_MMA(ai, bj, At, Bt) do { __builtin_amdgcn_s_setprio(1); _Pragma("unroll") for (int m = 0; m < 4; ++m) _Pragma("unroll") for (int n = 0; n < 2; ++n) _Pragma("unroll") for (int k = 0; k < 2; ++k) \
        { if (F8) { if (k == 0) acc[ai][bj][m][n] = __builtin_amdgcn_mfma_scale_f32_16x16x128_f8f6f4(Bt##8[n], At##8[m], acc[ai][bj][m][n], 0, 0, 0, F8SC, 1, F8SC); } \
          else acc[ai][bj][m][n] = SWAP ? __builtin_amdgcn_mfma_f32_16x16x32_bf16(At[m][k], Bt[n][k], acc[ai][bj][m][n], 0, 0, 0) : __builtin_amdgcn_mfma_f32_16x16x32_bf16(Bt[n][k], At[m][k], acc[ai][bj][m][n], 0, 0, 0); } __builtin_amdgcn_s_setprio(0); } while (0)
#define PG8_WAIT_V(n) asm volatile("s_waitcnt vmcnt(" #n ")" ::: "memory")
#define PG8_WAIT_L(n) asm volatile("s_waitcnt lgkmcnt(" #n ")" ::: "memory")
#define PG8_BAR __builtin_amdgcn_s_barrier()
#define PG8_SCHED __builtin_amdgcn_sched_barrier(0)
    Unit cur, nxt; int ui = 0;
    if (!S.next(0, cur)) return;
    f32x4 acc[2][2][4][2];
#pragma unroll
    for (int a = 0; a < 2; ++a)
#pragma unroll
        for (int b = 0; b < 2; ++b)
#pragma unroll
            for (int m = 0; m < 4; ++m)
#pragma unroll
                for (int n = 0; n < 2; ++n) acc[a][b][m][n] = (f32x4){0.f, 0.f, 0.f, 0.f};
    bf16x8 At[4][2], B0[2][2], B1[2][2];
    pg8_i32x8 At8[4], B08[2], B18[2];
    const char* cA = (const char*)g.A + (size_t)cur.pm * tstep; const char* cB = (const char*)g.Bt + (size_t)cur.pn * tstep;
    S.a_ready(cur);
    PG8_STAGE(PG8_SB(0, 0), cB, voffB); PG8_STAGE(PG8_SA(0, 0), cA, voffA); PG8_STAGE(PG8_SB(0, 1), cB + hstep, voffB); PG8_STAGE(PG8_SA(0, 1), cA + hstep, voffA);
    if (wr == 1) PG8_BAR;
    PG8_WAIT_V(4); PG8_BAR;
    PG8_STAGE(PG8_SB(1, 0), cB + kstep, voffB); PG8_STAGE(PG8_SA(1, 0), cA + kstep, voffA); PG8_STAGE(PG8_SB(1, 1), cB + hstep + kstep, voffB);
    PG8_WAIT_V(6); PG8_BAR;
    PG8_STAMP();
    for (;;) {
        const bool has_next = S.next(ui + 1, nxt);
        const char* nA = has_next ? (const char*)g.A + (size_t)nxt.pm * tstep : cA; const char* nB = has_next ? (const char*)g.Bt + (size_t)nxt.pn * tstep : cB;
        for (int t = 0; t < nt; t += 2) {
            const bool last = (t == nt - 2);
            const char* a1 = cA + (size_t)(t + 1) * kstep;
            const char* a2 = last ? nA : cA + (size_t)(t + 2) * kstep; const char* b2 = last ? nB : cB + (size_t)(t + 2) * kstep;
            const char* a3 = a2 + kstep; const char* b3 = b2 + kstep;
            if (last && has_next) S.a_ready(nxt);
            PG8_LDB(B0, 0, 0); PG8_SCHED; PG8_LDA(At, 0, 0); PG8_STAGE(PG8_SA(1, 1), a1 + hstep, voffA);
            PG8_WAIT_L(8); PG8_BAR; PG8_WAIT_L(0); PG8_MMA(0, 0, At, B0); PG8_BAR; PG8_SCHED;
            PG8_LDB(B1, 0, 1); PG8_STAGE(PG8_SB(0, 0), b2, voffB);
            PG8_BAR; PG8_WAIT_L(0); PG8_MMA(0, 1, At, B1); PG8_BAR;
            PG8_LDA(At, 0, 1); PG8_STAGE(PG8_SA(0, 0), a2, voffA);
            PG8_BAR; PG8_WAIT_L(0); PG8_MMA(1, 0, At, B0); PG8_BAR; PG8_SCHED;
            PG8_STAGE(PG8_SB(0, 1), b2 + hstep, voffB);
            PG8_WAIT_V(6); PG8_BAR; PG8_MMA(1, 1, At, B1); PG8_BAR;
            PG8_LDB(B0, 1, 0); PG8_SCHED; PG8_LDA(At, 1, 0); PG8_STAGE(PG8_SA(0, 1), a2 + hstep, voffA);
            PG8_WAIT_L(8); PG8_BAR; PG8_WAIT_L(0); PG8_MMA(0, 0, At, B0); PG8_BAR; PG8_SCHED;
            PG8_LDB(B1, 1, 1); PG8_STAGE(PG8_SB(1, 0), b3, voffB);
            PG8_BAR; PG8_WAIT_L(0); PG8_MMA(0, 1, At, B1); PG8_BAR;
            PG8_LDA(At, 1, 1); PG8_STAGE(PG8_SA(1, 0), a3, voffA);
            PG8_BAR; PG8_WAIT_L(0); PG8_MMA(1, 0, At, B0); PG8_BAR; PG8_SCHED;
            PG8_STAGE(PG8_SB(1, 1), b3 + hstep, voffB);
            PG8_WAIT_V(6); PG8_BAR; PG8_MMA(1, 1, At, B1); PG8_BAR;
        }
        PG8_STAMP();
        if constexpr (!Epi::AFTER_DRAIN) { const int le_ = lane_id_(); E(acc, cur, wr, wc, le_ & 15, le_ >> 4); S.done(cur); }
        PG8_STAMP();
        if (!has_next) break;
#pragma unroll
        for (int a = 0; a < 2; ++a)
#pragma unroll
            for (int b = 0; b < 2; ++b)
#pragma unroll
                for (int m = 0; m < 4; ++m)
#pragma unroll
                    for (int n = 0; n < 2; ++n) acc[a][b][m][n] = (f32x4){0.f, 0.f, 0.f, 0.f};
        cur = nxt; cA = nA; cB = nB; ++ui;
    }
    PG8_WAIT_V(0);
    if (wr == 0) PG8_BAR;
    PG8_BAR;
    if constexpr (Epi::AFTER_DRAIN) { E.fused(acc, cur, wr, wc, fr, fq, lds, wid, lane); S.done(cur); }
    PG8_STAMP();
    if (STAMP && wid == 0) { stamps[lane] = lane < nts ? (((unsigned long long)(unsigned)ts_hi << 32) | (unsigned)ts_lo) : 0ull;
        if (lane == 62) stamps[62] = rt_entry; if (lane == 63) stamps[63] = (unsigned long long)wall_clock64(); }
#undef PG8_STAMP
#undef PG8_SA
#undef PG8_SB
#undef PG8_STAGE
#undef aoff
#undef boff
#undef PG8_LDA
#undef PG8_LDB
#undef PG8_MMA
#undef PG8_WAIT_V
#undef PG8_WAIT_L
#undef PG8_BAR
#undef PG8_SCHED
}
}

struct EpiQK {
    static constexpr bool PERM = true, AFTER_DRAIN = false;
    u16* O; int ldc;
    __device__ __forceinline__ void operator()(const pg8::f32x4 (&acc)[2][2][4][2], const pg8::Unit& u, int wr, int wc, int fr, int fq) const {
        uint64_t ob_ = (uint64_t)O; asm volatile("" : "+s"(ob_));
        unsigned off0 = ((unsigned)(u.pm * 256 + wr * 64 + fr) * (unsigned)ldc + (unsigned)(u.pn * 256 + wc * 32 + 8 * fq)) * 2u; asm volatile("" : "+v"(off0));
        const unsigned rstep = (unsigned)ldc * 32u;
#pragma unroll
        for (int ai = 0; ai < 2; ++ai)
#pragma unroll
            for (int m = 0; m < 4; ++m) { unsigned ro = off0 + (unsigned)(ai * 8 + m) * rstep; asm volatile("" : "+v"(ro));
#pragma unroll
                for (int bj = 0; bj < 2; ++bj) { const pg8::f32x4 v0 = acc[ai][bj][m][0], v1 = acc[ai][bj][m][1];
                    u32x4 w; w[0] = cvtpk(v0[0], v0[1]); w[1] = cvtpk(v0[2], v0[3]); w[2] = cvtpk(v1[0], v1[1]); w[3] = cvtpk(v1[2], v1[3]);
                    *(__attribute__((address_space(1))) u32x4*)((__attribute__((address_space(1))) char*)ob_ + ro + bj * 256) = w; } }
    }
};
struct EpiV {
    static constexpr bool PERM = false, AFTER_DRAIN = false;
    u16* VT; int layer;
    __device__ __forceinline__ void operator()(const pg8::f32x4 (&acc)[2][2][4][2], const pg8::Unit& u, int wr, int wc, int fr, int fq) const {
        const int colt = u.pn * 256, grp = colt >> 10;
        const int dil = (layer == 0 || grp == 0) ? 1 : (grp == 1 ? 4 : 16);
        const int rowb = u.pm * 256 + wr * 64 + 4 * fq;
#pragma unroll
        for (int bj = 0; bj < 2; ++bj)
#pragma unroll
            for (int n = 0; n < 2; ++n) {
                const int c = (colt & 1023) + bj * 128 + wc * 32 + n * 16 + fr, h = c >> 6, d = c & 63;
#pragma unroll
                for (int ai = 0; ai < 2; ++ai)
#pragma unroll
                    for (int m = 0; m < 4; ++m) {
                        const int r0 = rowb + ai * 128 + m * 16, b = r0 >> 13, t0 = r0 & (SEQ - 1);
                        u16* vrow = VT + (size_t)grp * T * D + ((size_t)(b * NH + h) * HD + d) * SEQ;
                        const pg8::f32x4 v = acc[ai][bj][m][n];
                        if (dil == 1) { u32x2 w; w[0] = cvtpk(v[0], v[1]); w[1] = cvtpk(v[2], v[3]); *(u32x2*)(vrow + t0) = w; }
                        else {
#pragma unroll
                            for (int i = 0; i < 4; ++i) { const int pp = t0 + i; vrow[(pp % dil) * (SEQ / dil) + pp / dil] = (u16)cvtpk(v[i], 0.f); }
                        }
                    }
            }
    }
};
struct EpiWo {
    static constexpr bool PERM = true, AFTER_DRAIN = false;
    u16* Y; const u16* X;
    __device__ __forceinline__ void operator()(const pg8::f32x4 (&acc)[2][2][4][2], const pg8::Unit& u, int wr, int wc, int fr, int fq) const {
        const int row0 = u.pm * 256 + wr * 64 + fr, col0 = u.pn * 256 + wc * 32 + 8 * fq;
#pragma unroll
        for (int ai = 0; ai < 2; ++ai)
#pragma unroll
            for (int m = 0; m < 4; ++m) { const size_t ro = (size_t)(row0 + ai * 128 + m * 16) * D + col0;
#pragma unroll
                for (int bj = 0; bj < 2; ++bj) { const pg8::f32x4 v0 = acc[ai][bj][m][0], v1 = acc[ai][bj][m][1];
                    const u32x4 xr = *(const u32x4*)(X + ro + bj * 128);
                    u32x4 w;
                    w[0] = cvtpk(bf2f(xr[0] & 0xFFFFu) * DN_ALPHA + v0[0], bf2f(xr[0] >> 16) * DN_ALPHA + v0[1]); w[1] = cvtpk(bf2f(xr[1] & 0xFFFFu) * DN_ALPHA + v0[2], bf2f(xr[1] >> 16) * DN_ALPHA + v0[3]);
                    w[2] = cvtpk(bf2f(xr[2] & 0xFFFFu) * DN_ALPHA + v1[0], bf2f(xr[2] >> 16) * DN_ALPHA + v1[1]); w[3] = cvtpk(bf2f(xr[3] & 0xFFFFu) * DN_ALPHA + v1[2], bf2f(xr[3] >> 16) * DN_ALPHA + v1[3]);
                    *(u32x4*)(Y + ro + bj * 128) = w; } }
    }
};
struct EpiSGU {
    static constexpr bool PERM = true, AFTER_DRAIN = false;
    u16* H;
    __device__ __forceinline__ void operator()(const pg8::f32x4 (&acc)[2][2][4][2], const pg8::Unit& u, int wr, int wc, int fr, int fq) const {
        const int row0 = u.pm * 256 + wr * 64 + fr, f0 = u.pn * 128 + wc * 32 + 8 * fq;
#pragma unroll
        for (int ai = 0; ai < 2; ++ai)
#pragma unroll
            for (int m = 0; m < 4; ++m) {
                float hv[8];
#pragma unroll
                for (int n = 0; n < 2; ++n)
#pragma unroll
                    for (int i = 0; i < 4; ++i) { const float gt = acc[ai][0][m][n][i], up = acc[ai][1][m][n][i]; hv[n * 4 + i] = gt / (1.f + __expf(-gt)) * up; }
                u32x4 w; w[0] = cvtpk(hv[0], hv[1]); w[1] = cvtpk(hv[2], hv[3]); w[2] = cvtpk(hv[4], hv[5]); w[3] = cvtpk(hv[6], hv[7]);
                *(u32x4*)(H + (size_t)(row0 + ai * 128 + m * 16) * DF + f0) = w;
            }
    }
};
struct EpiSD {
    static constexpr bool PERM = true, AFTER_DRAIN = false;
    u16* Y;
    __device__ __forceinline__ void operator()(const pg8::f32x4 (&acc)[2][2][4][2], const pg8::Unit& u, int wr, int wc, int fr, int fq) const {
        const int row0 = u.pm * 256 + wr * 64 + fr, col0 = u.pn * 256 + wc * 32 + 8 * fq;
#pragma unroll
        for (int ai = 0; ai < 2; ++ai)
#pragma unroll
            for (int m = 0; m < 4; ++m) { u16* rowp = Y + (size_t)(A_TOT + row0 + ai * 128 + m * 16) * D + col0;
#pragma unroll
                for (int bj = 0; bj < 2; ++bj) { const pg8::f32x4 v0 = acc[ai][bj][m][0], v1 = acc[ai][bj][m][1];
                    u32x4 w; w[0] = cvtpk(v0[0], v0[1]); w[1] = cvtpk(v0[2], v0[3]); w[2] = cvtpk(v1[0], v1[1]); w[3] = cvtpk(v1[2], v1[3]);
                    *(u32x4*)(rowp + bj * 128) = w; } }
    }
};

struct Args {
    const float* in[16];
    float* out;
    unsigned char* ws;
    int ph_lo, ph_hi;
};

#define GEMM_CORE(K_, PA0, PA1, PB, LDB)                                                                                                   \
    {                                                                                                                                      \
        const int g_tid = tid, g_lane = lane, g_wave = wave, g_r32 = r32, g_hi = hi;                   \
        const int g_wm = g_wave >> 2, g_wn = g_wave & 3, g_kc = g_tid & 3, g_kq = g_lane >> 3, g_n4 = g_lane & 7;                           \
        const u16* g_pa0 = (PA0); const u16* g_pa1 = (PA1);                                                                                \
        const size_t g_ldb = (size_t)(LDB);                                                                                                \
        const float* g_pb = (PB) + (size_t)(g_kq * 4) * g_ldb + g_n4 * 4;                                                                  \
        const int g_nk = (K_) / 32;                                                                                                        \
        u32x4 g_ra0, g_ra1; f32x4 g_rb0, g_rb1, g_rb2, g_rb3;                                                                              \
        const u32x4 g_z = {0u, 0u, 0u, 0u};                                                                                                \
        _Pragma("unroll") for (int mb = 0; mb < 4; ++mb) { _Pragma("unroll") for (int nb = 0; nb < 2; ++nb) { _Pragma("unroll") for (int r = 0; r < 16; ++r) acc[mb][nb][r] = 0.f; } } \
        g_ra0 = g_pa0 ? *(const u32x4*)(g_pa0 + g_kc * 8) : g_z; g_ra1 = g_pa1 ? *(const u32x4*)(g_pa1 + g_kc * 8) : g_z;                 \
        g_rb0 = *(const f32x4*)(g_pb); g_rb1 = *(const f32x4*)(g_pb + g_ldb); g_rb2 = *(const f32x4*)(g_pb + 2 * g_ldb); g_rb3 = *(const f32x4*)(g_pb + 3 * g_ldb); \
        _Pragma("unroll 1") for (int kt = 0; kt < g_nk; ++kt) {                                                                            \
            LAS char* As = lds + (kt & 1) * STAGE_BYTES; LAS char* Bs = As + 256 * LDP * 2;                                                \
            *(LAS u32x4*)(As + ((g_tid >> 2) * LDP + g_kc * 8) * 2) = g_ra0;                                                               \
            *(LAS u32x4*)(As + (((g_tid >> 2) + 128) * LDP + g_kc * 8) * 2) = g_ra1;                                                       \
            _Pragma("unroll") for (int i = 0; i < 4; ++i) {                                                                                \
                u32x2 w; w[0] = cvtpk(g_rb0[i], g_rb1[i]); w[1] = cvtpk(g_rb2[i], g_rb3[i]);                                               \
                *(LAS u32x2*)(Bs + ((g_wave * 32 + i * 8 + g_n4) * LDP + g_kq * 4) * 2) = w;                                               \
            }                                                                                                                              \
            __syncthreads();                                                                                                               \
            if (kt + 1 < g_nk) {                                                                                                           \
                const int ko = (kt + 1) * 32;                                                                                              \
                g_ra0 = g_pa0 ? *(const u32x4*)(g_pa0 + ko + g_kc * 8) : g_z; g_ra1 = g_pa1 ? *(const u32x4*)(g_pa1 + ko + g_kc * 8) : g_z; \
                const float* pbk = g_pb + (size_t)ko * g_ldb;                                                                              \
                g_rb0 = *(const f32x4*)(pbk); g_rb1 = *(const f32x4*)(pbk + g_ldb); g_rb2 = *(const f32x4*)(pbk + 2 * g_ldb); g_rb3 = *(const f32x4*)(pbk + 3 * g_ldb); \
            }                                                                                                                              \
            _Pragma("unroll") for (int s = 0; s < 2; ++s) {                                                                                \
                bf16x8 af[4], bfr[2];                                                                                                      \
                _Pragma("unroll") for (int mb = 0; mb < 4; ++mb) af[mb] = *(LAS bf16x8*)(As + ((g_wm * 128 + mb * 32 + g_r32) * LDP + s * 16 + g_hi * 8) * 2); \
                _Pragma("unroll") for (int nb = 0; nb < 2; ++nb) bfr[nb] = *(LAS bf16x8*)(Bs + (((g_wn * 2 + nb) * 32 + g_r32) * LDP + s * 16 + g_hi * 8) * 2); \
                _Pragma("unroll") for (int mb = 0; mb < 4; ++mb) { _Pragma("unroll") for (int nb = 0; nb < 2; ++nb) acc[mb][nb] = MFMA_BF16(af[mb], bfr[nb], acc[mb][nb]); } \
            }                                                                                                                              \
        }                                                                                                                                  \
        __syncthreads();                                                                                                                   \
    }

struct AttnSt { float m, l; f32x16 o0, o1; };

struct AttnFr { bf16x8 k[4]; bf16x8 v[4]; };
__device__ __forceinline__ void attn_load(AttnFr& f, const u16* krow, const u16* vt, size_t vt_dstride) {
#pragma unroll
    for (int d0 = 0; d0 < 4; ++d0) f.k[d0] = *(const bf16x8*)(krow + d0 * 16);
    const u16* vt1 = vt + 32 * vt_dstride;
    union { bf16x8 v; u32x2 h[2]; } va;
    va.h[0] = *(const u32x2*)(vt);       va.h[1] = *(const u32x2*)(vt + 8);   f.v[0] = va.v;
    va.h[0] = *(const u32x2*)(vt + 16);  va.h[1] = *(const u32x2*)(vt + 24);  f.v[1] = va.v;
    va.h[0] = *(const u32x2*)(vt1);      va.h[1] = *(const u32x2*)(vt1 + 8);  f.v[2] = va.v;
    va.h[0] = *(const u32x2*)(vt1 + 16); va.h[1] = *(const u32x2*)(vt1 + 24); f.v[3] = va.v;
}
template <bool MASK = true>
__device__ __forceinline__ void attn_compute(AttnSt& st, const bf16x8 (&qf)[4], const AttnFr& f, int dist0, float bslope, int dlo, int dhi, int hi, int lane) {
    f32x16 p;
#pragma unroll
    for (int r = 0; r < 16; ++r) p[r] = 0.f;
#pragma unroll
    for (int d0 = 0; d0 < 4; ++d0) p = MFMA_BF16(f.k[d0], qf[d0], p);
    constexpr float C2 = 0.125f * LOG2E;
    float mx = NEGV;
    const float bbase = -bslope * (float)dist0;
#pragma unroll
    for (int r = 0; r < 16; ++r) {
        const float sc = __builtin_fmaf(p[r], C2, __builtin_fmaf(bslope, (float)((r & 3) + 8 * (r >> 2)), bbase));
        float s_ = sc;
        if (MASK) { const int dist = dist0 - ((r & 3) + 8 * (r >> 2)); s_ = (dist >= dlo && dist <= dhi) ? sc : NEGV; }
        p[r] = s_; mx = fmaxf(mx, s_);
    }
    mx = fmaxf(mx, shxf(mx, 32, lane));
    const float mnew = fmaxf(st.m, mx);
    const float alpha = __builtin_amdgcn_exp2f(st.m - mnew);
    st.m = mnew;
    float ls = 0.f;
#pragma unroll
    for (int r = 0; r < 16; ++r) { p[r] = __builtin_amdgcn_exp2f(p[r] - mnew); ls += p[r]; }
    st.l = st.l * alpha + ls;
#pragma unroll
    for (int r = 0; r < 16; ++r) { st.o0[r] *= alpha; st.o1[r] *= alpha; }
    union { bf16x8 v; unsigned u[4]; } pb0, pb1;
#pragma unroll
    for (int j = 0; j < 4; ++j) { pb0.u[j] = cvtpk(p[2 * j], p[2 * j + 1]); pb1.u[j] = cvtpk(p[8 + 2 * j], p[8 + 2 * j + 1]); }
    st.o0 = MFMA_BF16(f.v[0], pb0.v, st.o0);
    st.o0 = MFMA_BF16(f.v[1], pb1.v, st.o0);
    st.o1 = MFMA_BF16(f.v[2], pb0.v, st.o1);
    st.o1 = MFMA_BF16(f.v[3], pb1.v, st.o1);
    (void)hi;
}

__device__ __forceinline__ float dpp_rowmax(float v) {
    v = fmaxf(v, __int_as_float(__builtin_amdgcn_update_dpp(0, __float_as_int(v), 0xB1, 0xF, 0xF, true)));
    v = fmaxf(v, __int_as_float(__builtin_amdgcn_update_dpp(0, __float_as_int(v), 0x4E, 0xF, 0xF, true)));
    v = fmaxf(v, __int_as_float(__builtin_amdgcn_update_dpp(0, __float_as_int(v), 0x141, 0xF, 0xF, true)));
    v = fmaxf(v, __int_as_float(__builtin_amdgcn_update_dpp(0, __float_as_int(v), 0x140, 0xF, 0xF, true)));
    return v;
}
__device__ __forceinline__ int dpp_rowmin_i(int v) {
    v = min(v, __builtin_amdgcn_update_dpp(0, v, 0xB1, 0xF, 0xF, true));
    v = min(v, __builtin_amdgcn_update_dpp(0, v, 0x4E, 0xF, 0xF, true));
    v = min(v, __builtin_amdgcn_update_dpp(0, v, 0x141, 0xF, 0xF, true));
    v = min(v, __builtin_amdgcn_update_dpp(0, v, 0x140, 0xF, 0xF, true));
    return v;
}
__device__ __forceinline__ float rl_f(float v, int l) { return __int_as_float(__builtin_amdgcn_readlane(__float_as_int(v), l)); }

__device__ __forceinline__ void top3_insert(float v, int i, float& v0, int& i0, float& v1, int& i1, float& v2, int& i2) {
    const bool b0 = (v > v0) || (v == v0 && i < i0);
    const bool b1 = (v > v1) || (v == v1 && i < i1);
    const bool b2 = (v > v2) || (v == v2 && i < i2);
    const float nv2 = b1 ? v1 : (b2 ? v : v2); const int ni2 = b1 ? i1 : (b2 ? i : i2);
    const float nv1 = b0 ? v0 : (b1 ? v : v1); const int ni1 = b0 ? i0 : (b1 ? i : i1);
    const float nv0 = b0 ? v : v0;             const int ni0 = b0 ? i : i0;
    v0 = nv0; i0 = ni0; v1 = nv1; i1 = ni1; v2 = nv2; i2 = ni2;
}

__device__ __forceinline__ void ln_row(float (&v)[16], const float* __restrict__ g, const float* __restrict__ b, int lane) {
    float s = 0.f;
#pragma unroll
    for (int i = 0; i < 16; ++i) s += v[i];
    const float mu = wave_sum(s) * (1.f / D);
    float q = 0.f;
#pragma unroll
    for (int i = 0; i < 16; ++i) { const float d = v[i] - mu; q += d * d; }
    const float rstd = rsqrtf(wave_sum(q) * (1.f / D) + LN_EPS);
#pragma unroll
    for (int j = 0; j < 4; ++j) {
        const f32x4 gg = *(const f32x4*)(g + j * 256 + lane * 4), bb = *(const f32x4*)(b + j * 256 + lane * 4);
#pragma unroll
        for (int c = 0; c < 4; ++c) v[j * 4 + c] = (v[j * 4 + c] - mu) * rstd * gg[c] + bb[c];
    }
}

typedef __attribute__((ext_vector_type(2))) float f32x2_;
__device__ __forceinline__ bf16x8 fp8x8_to_bf16(unsigned lo, unsigned hi_) {
    const f32x2_ a = __builtin_amdgcn_cvt_pk_f32_fp8((int)lo, false), b = __builtin_amdgcn_cvt_pk_f32_fp8((int)lo, true);
    const f32x2_ c = __builtin_amdgcn_cvt_pk_f32_fp8((int)hi_, false), d = __builtin_amdgcn_cvt_pk_f32_fp8((int)hi_, true);
    union { bf16x8 v; unsigned u[4]; } r;
    r.u[0] = cvtpk(a[0], a[1]); r.u[1] = cvtpk(b[0], b[1]); r.u[2] = cvtpk(c[0], c[1]); r.u[3] = cvtpk(d[0], d[1]);
    return r.v;
}
__device__ __forceinline__ unsigned pack_fp8x4(float a, float b, float c, float d) { int p = __builtin_amdgcn_cvt_pk_fp8_f32(a, b, 0, false); return (unsigned)__builtin_amdgcn_cvt_pk_fp8_f32(c, d, p, true); }

constexpr float Y8_SCALE = 16.f;
constexpr int MOE_XCAP = 576;
#define MOE_GAS __attribute__((address_space(1)))
typedef MOE_GAS unsigned char moe_gcb;
constexpr int MOE_BP = 72;
constexpr int MOE_BSTAGE = 128 * MOE_BP * 2;
constexpr int MOE_LDS_VA = 3 * MOE_BSTAGE;
constexpr int MOE_LDS_W = MOE_LDS_VA + 4096;
constexpr int MOE_LDS_XCH = 65536;
template <bool DOWN>
__device__ __forceinline__ void moe_expert(LAS char* lds, const int tid, const int lane, const int wave, const int r32, const int hi,
                                           const unsigned char* __restrict__ abase  , const float* __restrict__ w0, const float* __restrict__ w1, const int ng  , void* __restrict__ outv,
                                           const int pass0, const int npass_, const int st0, const int nstl  , const bool y8 = false  ,
                                           const bool xr = false  ) {
    constexpr int KT = DOWN ? 4 : 16, NP = DOWN ? 8 : 4, LDB = DOWN ? 1024 : 256, APITCH = DOWN ? 256 : 1024  , PSTEP = DOWN ? 128 : 64;
    LAS int* rowva = (LAS int*)(lds + MOE_LDS_VA); LAS float* roww = (LAS float*)(lds + MOE_LDS_W);
    const int nst = nstl;
    const int nsteps = npass_ * nst * KT; (void)NP;
    unsigned aoff[2];
#define MOE_AOFF(ST_) { _Pragma("unroll") for (int a = 0; a < 2; ++a) { const int va_ = rowva[(ST_) * 512 + wave * 64 + a * 32 + r32]; \
        const int srow_ = DOWN ? va_ : (va_ == TRASH_VA ? 0 : (va_ >> 3)); aoff[a] = (unsigned)srow_ * APITCH + hi * 32; } }
    const int seg = wave >> 1, n4 = lane & 7, kp = (wave & 1) * 16 + (lane >> 3);
    const char* wbase = (const char*)(DOWN ? (w0 + seg * 32) : (((seg < 2) ? w0 : w1) + (seg & 1) * 32));
    unsigned boff = (unsigned)(4 * n4 + 2 * kp * LDB) * 4u; asm volatile("" : "+v"(boff));
    unsigned wb_ = (unsigned)((seg * 32 + n4) * MOE_BP + 2 * kp) * 2u; asm volatile("" : "+v"(wb_));
    unsigned lb_ = (unsigned)(r32 * MOE_BP + hi * 32) * 2u; asm volatile("" : "+v"(lb_));
    f32x16 acc[2][4];
#pragma unroll
    for (int a = 0; a < 2; ++a)
#pragma unroll
        for (int c = 0; c < 4; ++c)
#pragma unroll
            for (int r = 0; r < 16; ++r) acc[a][c][r] = 0.f;
    u32x4 fa8[2][2];
    f32x16 accx; u32x4 fa8x[2]; unsigned aoffx = 0u;
#pragma unroll
    for (int r = 0; r < 16; ++r) accx[r] = 0.f;
    fa8x[0] = u32x4{0u, 0u, 0u, 0u}; fa8x[1] = u32x4{0u, 0u, 0u, 0u};
    f32x4 rb0[4], rb1[4];
#define MOE_DEC(S_) const int s2_ = (S_) < nsteps ? (S_) : 0; const int pl_ = s2_ / (nst * KT); const int rm_ = s2_ - pl_ * (nst * KT); const int sl_ = rm_ / KT; const int kt_ = rm_ - sl_ * KT; const int ps_ = pass0 + pl_; const int stt_ = st0 + sl_;
#define MOE_LOADB(S_, RB) { MOE_DEC(S_) (void)stt_; \
        uint64_t wu_ = (uint64_t)(wbase + (size_t)(ps_ * PSTEP + kt_ * 64 * LDB) * 4), wv_ = wu_ + 16 * LDB * 4; asm volatile("" : "+s"(wu_), "+s"(wv_));     \
        const moe_gcb* wug_ = (const moe_gcb*)wu_; const moe_gcb* wvg_ = (const moe_gcb*)wv_; \
        unsigned bo_ = boff; asm volatile("" : "+v"(bo_));     \
        RB[0] = *(const MOE_GAS f32x4*)(wug_ + bo_); RB[1] = *(const MOE_GAS f32x4*)(wug_ + bo_ + LDB * 4); RB[2] = *(const MOE_GAS f32x4*)(wvg_ + bo_); RB[3] = *(const MOE_GAS f32x4*)(wvg_ + bo_ + LDB * 4); }
#define MOE_WRITEB(STG, RB) { LAS char* Bs_ = lds + (STG) * MOE_BSTAGE; \
        _Pragma("unroll") for (int i = 0; i < 4; ++i) { LAS unsigned* q_ = (LAS unsigned*)(Bs_ + wb_ + i * (8 * MOE_BP * 2)); q_[0] = cvtpk(RB[0][i], RB[1][i]); q_[8] = cvtpk(RB[2][i], RB[3][i]); } }
#define MOE_COMPUTE(STG, DO_MFMA) { LAS char* Bs_ = lds + (STG) * MOE_BSTAGE; \
        _Pragma("unroll") for (int u = 0; u < 4; ++u) { \
            bf16x8 bfr[4]; \
            if (DO_MFMA) { _Pragma("unroll") for (int c = 0; c < 4; ++c) bfr[c] = *(LAS bf16x8*)(Bs_ + lb_ + (c * 32 * MOE_BP + u * 8) * 2); } \
            _Pragma("unroll") for (int a = 0; a < 2; ++a) { \
                if (DO_MFMA) { const bf16x8 af_ = fp8x8_to_bf16(fa8[a][u >> 1][(u & 1) * 2], fa8[a][u >> 1][(u & 1) * 2 + 1]); \
                    _Pragma("unroll") for (int c = 0; c < 4; ++c) acc[a][c] = MFMA_BF16(bfr[c], af_, acc[a][c]); } \
            } \
        } }
      \
#define MOE_RELOAD { _Pragma("unroll") for (int a = 0; a < 2; ++a) { unsigned ao_ = aoff[a]; asm volatile("" : "+v"(ao_)); \
            fa8[a][0] = *(const MOE_GAS u32x4*)(ab_n + ao_); fa8[a][1] = *(const MOE_GAS u32x4*)(ab_n + ao_ + 16); } }
#define MOE_XCOMPUTE(STG) if (!DOWN) { LAS char* Bs_ = lds + (STG) * MOE_BSTAGE; \
        _Pragma("unroll") for (int u = 0; u < 4; ++u) { \
            const bf16x8 ax_ = fp8x8_to_bf16(fa8x[u >> 1][(u & 1) * 2], fa8x[u >> 1][(u & 1) * 2 + 1]); \
            if (u & 1) { unsigned ao_ = aoffx; asm volatile("" : "+v"(ao_)); fa8x[u >> 1] = *(const MOE_GAS u32x4*)(ab_n + ao_ + (u >> 1) * 16); } \
            const bf16x8 bx_ = *(LAS bf16x8*)(Bs_ + (wave & 3) * (32 * MOE_BP * 2) + lb_ + u * 16); \
            accx = MFMA_BF16(bx_, ax_, accx); } }
#define MOE_NEXTA(S_) MOE_DEC(S_) (void)ps_; \
        if (stt_ != st_loaded) { MOE_AOFF(stt_) st_loaded = stt_; } \
        uint64_t abn_ = (uint64_t)abase + kt_ * 64; asm volatile("" : "+s"(abn_)); const moe_gcb* ab_n = (const moe_gcb*)abn_;
    int st_loaded = st0;
    MOE_AOFF(st0)
    { const char* ab0 = (const char*)abase;
#pragma unroll
      for (int a = 0; a < 2; ++a)
#pragma unroll
          for (int h2 = 0; h2 < 2; ++h2) fa8[a][h2] = *(const u32x4*)(ab0 + aoff[a] + h2 * 16); }
    if (!DOWN) {
        const int vax_ = xr ? rowva[512 + 32 * (wave >> 2) + r32] : TRASH_VA; aoffx = (unsigned)(vax_ == TRASH_VA ? 0 : (vax_ >> 3)) * APITCH + hi * 32;
        fa8x[0] = *(const u32x4*)((const char*)abase + aoffx); fa8x[1] = *(const u32x4*)((const char*)abase + aoffx + 16); }
    MOE_LOADB(0, rb0)
    MOE_LOADB(1, rb1)
    MOE_WRITEB(0, rb0)
    MOE_LOADB(2, rb0)
    int stg = 0;
#pragma unroll 1
    for (int sidx = 0; sidx < nsteps; sidx += 2) {
        const int pl = sidx / (nst * KT); const int rm = sidx - pl * (nst * KT); const int sl = rm / KT; const int kt = rm - sl * KT; const int ps = pass0 + pl, stt = st0 + sl;
        const bool wv = (wave * 64) < (ng - stt * 512);
        const int stg1 = stg == 2 ? 0 : stg + 1, stg2 = stg1 == 2 ? 0 : stg1 + 1;
        __syncthreads();
        MOE_WRITEB(stg1, rb1)
        MOE_LOADB(sidx + 3, rb1)
        { MOE_NEXTA(sidx + 1)
          if (wv) MOE_COMPUTE(stg, true)
          MOE_RELOAD
          MOE_XCOMPUTE(stg) }
        __syncthreads();
        MOE_WRITEB(stg2, rb0)
        MOE_LOADB(sidx + 4, rb0)
        { MOE_NEXTA(sidx + 2)
          if (wv) MOE_COMPUTE(stg1, true)
          MOE_RELOAD
          MOE_XCOMPUTE(stg1) }
        stg = stg2;
        if (kt == KT - 2) {
            const int le_ = lane_id_(); const int lane = le_, r32 = le_ & 31, hi = le_ >> 5; (void)lane;
            if (wv) {
                const int nrows = ng - stt * 512;
#pragma unroll
                for (int a = 0; a < 2; ++a) {
                    if (a == 0 || (wave * 64 + 32) < nrows) {
                        const int lrow = stt * 512 + wave * 64 + a * 32 + r32;
                        const unsigned va = (unsigned)rowva[lrow];
                        if (DOWN) {
                            const float w = roww[lrow];
#pragma unroll
                            for (int c = 0; c < 4; ++c) {
                                float yv_[16];
#pragma unroll
                                for (int j = 0; j < 16; ++j) yv_[j] = acc[a][c][(j >> 2) + 4 * (j & 3)] * w;
                                if (y8) {
                                    u32x4 q8;
#pragma unroll
                                    for (int jj = 0; jj < 4; ++jj) q8[jj] = pack_fp8x4(yv_[4 * jj], yv_[4 * jj + 1], yv_[4 * jj + 2], yv_[4 * jj + 3]);
                                    *(u32x4*)((unsigned char*)outv + (size_t)va * D + ps * 128 + c * 32 + 16 * hi) = q8;
                                } else {
                                    u32x4 q0, q1;
#pragma unroll
                                    for (int jj = 0; jj < 4; ++jj) { q0[jj] = cvtpk(yv_[2 * jj], yv_[2 * jj + 1]); q1[jj] = cvtpk(yv_[8 + 2 * jj], yv_[9 + 2 * jj]); }
                                    u16* o = (u16*)outv + (size_t)va * D + ps * 128 + c * 32 + 16 * hi;
                                    *(u32x4*)o = q0; *(u32x4*)(o + 8) = q1;
                                }
                            }
                        } else {
#pragma unroll
                            for (int c = 0; c < 2; ++c) {
                                float hv[16];
#pragma unroll
                                for (int j = 0; j < 16; ++j) { const int r = (j >> 2) + 4 * (j & 3); const float gt = acc[a][c][r], up = acc[a][c + 2][r]; hv[j] = gt / (1.f + __expf(-gt)) * up; }
                                u32x4 q;
#pragma unroll
                                for (int jj = 0; jj < 4; ++jj) q[jj] = pack_fp8x4(hv[4 * jj], hv[4 * jj + 1], hv[4 * jj + 2], hv[4 * jj + 3]);
                                *(u32x4*)((unsigned char*)outv + (size_t)va * DF + ps * 64 + c * 32 + 16 * hi) = q;
                            }
                        }
                    }
                }
#pragma unroll
                for (int a = 0; a < 2; ++a)
#pragma unroll
                    for (int c = 0; c < 4; ++c)
#pragma unroll
                        for (int r = 0; r < 16; ++r) acc[a][c][r] = 0.f;
            }
            if (!DOWN) { if (xr) {
                LAS float* xch = (LAS float*)(lds + MOE_LDS_XCH) + ((wave >> 2) * 2 + (wave & 1)) * 1024 + lane;
                if ((wave & 3) >= 2) {
#pragma unroll
                    for (int r = 0; r < 16; ++r) xch[r * 64] = accx[r];
                }
                __syncthreads();
                if ((wave & 3) < 2) {
                    const unsigned vax = (unsigned)rowva[512 + 32 * (wave >> 2) + r32];
                    u32x4 q;
#pragma unroll
                    for (int jj = 0; jj < 4; ++jj) {
#pragma unroll
                        for (int i = 0; i < 4; ++i) { const int r = jj + 4 * i; const float gt = accx[r]; accx[r] = gt / (1.f + __expf(-gt)) * xch[r * 64]; }
                        q[jj] = pack_fp8x4(accx[jj], accx[jj + 4], accx[jj + 8], accx[jj + 12]);
                    }
                    *(u32x4*)((unsigned char*)outv + (size_t)vax * DF + ps * 64 + (wave & 3) * 32 + 16 * hi) = q;
                }
                }
#pragma unroll
                for (int r = 0; r < 16; ++r) accx[r] = 0.f;
            }
        }
    }
    __syncthreads();
#undef MOE_XCOMPUTE
#undef MOE_AOFF
#undef MOE_DEC
#undef MOE_LOADB
#undef MOE_WRITEB
#undef MOE_COMPUTE
#undef MOE_RELOAD
#undef MOE_NEXTA
}

constexpr int Q8_BP = 144;
constexpr int Q8_BSTAGE = 128 * Q8_BP;
typedef __attribute__((ext_vector_type(8))) int q8_i32x8;
template <int NCH>
__device__ __forceinline__ void qkv8_item(LAS char* lds, const int wave, const unsigned char* __restrict__ a8  , const unsigned char* __restrict__ w8  ,
                                          u16* __restrict__ outp  , const int ldc,
                                          const int rot  ) {
    constexpr int NSTEPS = NCH * 8;
    const int l0 = lane_id_(); const int r32 = l0 & 31, hi = l0 >> 5;
    unsigned aoff[2];
#pragma unroll
    for (int a = 0; a < 2; ++a) { aoff[a] = (unsigned)(wave * 64 + a * 32 + r32) * 1024u + hi * 32; asm volatile("" : "+v"(aoff[a])); }
    const int t_ = wave * 64 + l0, col_ = t_ >> 2, p_ = t_ & 3, kap_ = col_ & 31;
    unsigned boff = (unsigned)col_ * 1024u + p_ * 32; asm volatile("" : "+v"(boff));
    unsigned wb = (unsigned)((col_ & ~31) + (kap_ & 3) * 8 + (kap_ >> 2)) * Q8_BP + p_ * 32; asm volatile("" : "+v"(wb));
    unsigned lb = (unsigned)r32 * Q8_BP + hi * 32; asm volatile("" : "+v"(lb));
    f32x16 acc[2][4];
#pragma unroll
    for (int a = 0; a < 2; ++a)
#pragma unroll
        for (int c = 0; c < 4; ++c)
#pragma unroll
            for (int r = 0; r < 16; ++r) acc[a][c][r] = 0.f;
    u32x4 fa0[2][2][2], fa1[2][2][2];
    u32x4 rb0[2], rb1[2];
#define Q8_LOADA(FA, S_) { const int s2_ = (S_) < NSTEPS ? (S_) : 0; uint64_t ab_ = (uint64_t)a8 + ((s2_ + rot) & 7) * 128; asm volatile("" : "+s"(ab_)); const moe_gcb* ag_ = (const moe_gcb*)ab_; \
        _Pragma("unroll") for (int a = 0; a < 2; ++a) { unsigned ao_ = aoff[a]; asm volatile("" : "+v"(ao_)); \
            _Pragma("unroll") for (int kk = 0; kk < 2; ++kk) { FA[a][kk][0] = *(const MOE_GAS u32x4*)(ag_ + ao_ + kk * 64); FA[a][kk][1] = *(const MOE_GAS u32x4*)(ag_ + ao_ + kk * 64 + 16); } } }
#define Q8_LOADB(RB, S_) { const int s2_ = (S_) < NSTEPS ? (S_) : 0; uint64_t wu_ = (uint64_t)w8 + (size_t)(s2_ >> 3) * 131072 + ((s2_ + rot) & 7) * 128; asm volatile("" : "+s"(wu_)); const moe_gcb* wg_ = (const moe_gcb*)wu_; \
        unsigned bo_ = boff; asm volatile("" : "+v"(bo_)); RB[0] = *(const MOE_GAS u32x4*)(wg_ + bo_); RB[1] = *(const MOE_GAS u32x4*)(wg_ + bo_ + 16); }
#define Q8_WRITEB(STG, RB) { LAS char* Bs_ = lds + (STG) * Q8_BSTAGE + wb; *(LAS u32x4*)Bs_ = RB[0]; *(LAS u32x4*)(Bs_ + 16) = RB[1]; }
#define Q8_CAT8(X0, X1) q8_i32x8{(int)(X0)[0], (int)(X0)[1], (int)(X0)[2], (int)(X0)[3], (int)(X1)[0], (int)(X1)[1], (int)(X1)[2], (int)(X1)[3]}
#define Q8_MFMA(B_, A_, C_) __builtin_amdgcn_mfma_scale_f32_32x32x64_f8f6f4(B_, A_, C_, 0, 0, 0, 0x7F79  , 1, 0x7F79  )
#define Q8_COMPUTE(STG, FA) { LAS char* Bs_ = lds + (STG) * Q8_BSTAGE + lb; \
        _Pragma("unroll") for (int kk = 0; kk < 2; ++kk) { const q8_i32x8 af0_ = Q8_CAT8(FA[0][kk][0], FA[0][kk][1]), af1_ = Q8_CAT8(FA[1][kk][0], FA[1][kk][1]); \
            _Pragma("unroll") for (int c = 0; c < 4; ++c) { const u32x4 b0_ = *(LAS u32x4*)(Bs_ + c * 32 * Q8_BP + kk * 64), b1_ = *(LAS u32x4*)(Bs_ + c * 32 * Q8_BP + kk * 64 + 16); const q8_i32x8 bf_ = Q8_CAT8(b0_, b1_); \
                acc[0][c] = Q8_MFMA(bf_, af0_, acc[0][c]); acc[1][c] = Q8_MFMA(bf_, af1_, acc[1][c]); } } }
    Q8_LOADB(rb0, 0)
    Q8_WRITEB(0, rb0)
    Q8_LOADB(rb1, 1)
    Q8_LOADA(fa0, 0)
    Q8_LOADB(rb0, 2)
    Q8_LOADA(fa1, 1)
    int stg = 0;
#pragma unroll 1
    for (int s = 0; s < NSTEPS; s += 2) {
        const int stg1 = stg == 2 ? 0 : stg + 1, stg2 = stg1 == 2 ? 0 : stg1 + 1;
        __syncthreads();
        Q8_WRITEB(stg1, rb1)
        Q8_LOADB(rb1, s + 3)
        Q8_COMPUTE(stg, fa0)
        Q8_LOADA(fa0, s + 2)
        __syncthreads();
        Q8_WRITEB(stg2, rb0)
        Q8_LOADB(rb0, s + 4)
        Q8_COMPUTE(stg1, fa1)
        Q8_LOADA(fa1, s + 3)
        stg = stg2;
        if ((s & 7) == 6) {
            const int cl = s >> 3;
            const int le_ = lane_id_(); const int r32e = le_ & 31, hie = le_ >> 5;
#pragma unroll
            for (int a = 0; a < 2; ++a) {
                u16* orow = outp + (size_t)(wave * 64 + a * 32 + r32e) * ldc + cl * 128 + 16 * hie;
#pragma unroll
                for (int c = 0; c < 4; ++c) {
                    u32x4 q0, q1;
#pragma unroll
                    for (int jj = 0; jj < 4; ++jj) { q0[jj] = cvtpk(acc[a][c][((2 * jj) >> 2) + 4 * ((2 * jj) & 3)], acc[a][c][((2 * jj + 1) >> 2) + 4 * ((2 * jj + 1) & 3)]);
                                                     q1[jj] = cvtpk(acc[a][c][((8 + 2 * jj) >> 2) + 4 * ((8 + 2 * jj) & 3)], acc[a][c][((9 + 2 * jj) >> 2) + 4 * ((9 + 2 * jj) & 3)]); }
                    *(u32x4*)(orow + c * 32) = q0; *(u32x4*)(orow + c * 32 + 8) = q1;
                }
            }
#pragma unroll
            for (int a = 0; a < 2; ++a)
#pragma unroll
                for (int c = 0; c < 4; ++c)
#pragma unroll
                    for (int r = 0; r < 16; ++r) acc[a][c][r] = 0.f;
        }
    }
    __syncthreads();
#undef Q8_LOADA
#undef Q8_LOADB
#undef Q8_WRITEB
#undef Q8_CAT8
#undef Q8_MFMA
#undef Q8_COMPUTE
}

constexpr int N_PHASES = 21;

#define P_x_in CTX_IN(0)
#define P_xb ((u16*)(ws + WS_XB))
#define P_x1 ((float*)(ws + WS_X1))
#define P_x2 ((float*)(ws + WS_X2))
#define P_ypre ((u16*)(ws + WS_YPRE))
#define P_qkv ((u16*)(ws + WS_QKV))
#define P_vT ((u16*)(ws + WS_VT))
#define P_kmean ((float*)(ws + WS_KM))
#define P_ao ((u16*)(ws + WS_AO))
#define P_og ((u16*)(ws + WS_OG))
#define P_lse ((float*)(ws + WS_LSE))
#define P_topw ((float*)(ws + WS_TOPW))
#define P_list ((int*)(ws + WS_LIST))
#define P_hb ((u16*)(ws + WS_HB))
#define P_yb ((u16*)(ws + WS_YB))
#define P_cnt_all ((int*)(ws + WS_CTL + CTL_ECNT_OFF))
#define P_xb8 ((unsigned char*)(ws + WS_XB8))
#define P_hbs ((u16*)(ws + WS_HBS))
#define P_xq8 ((unsigned char*)(ws + WS_XQ8))
#define P_wq8 ((unsigned char*)(ws + WS_WQ8))
#define P_wo8 ((unsigned char*)(ws + WS_WO8))
#define P_selm ((unsigned*)(ws + WS_SELM))
#define P_part ((u16*)(ws + WS_PART))
#define P_plse ((float*)(ws + WS_PLSE))
#define PH_BEGIN int tid = wave_s_ * 64 + lane_id_(); asm volatile("" : "+v"(tid)); const int lane = tid & 63, r32 = lane & 31, hi = lane >> 5; const int wave = __builtin_amdgcn_readfirstlane(tid >> 6); (void)lane; (void)r32; (void)hi; (void)wave
constexpr int LDS_CTX = LDS_BAR + 16;
__device__ __forceinline__ uint64_t ctx_ld(int i) {
    extern __shared__ __attribute__((aligned(16))) unsigned char lds_raw[];
    const LAS unsigned* q = (const LAS unsigned*)((LAS char*)lds_raw + LDS_CTX) + 2 * i;
    const unsigned lo = __builtin_amdgcn_readfirstlane(q[0]), hi = __builtin_amdgcn_readfirstlane(q[1]);
    return ((uint64_t)hi << 32) | lo;
}
typedef __attribute__((address_space(1))) unsigned char gbyte;
#define AS_GLOBAL(T, u64v) ((T*)(gbyte*)(u64v))
#define CTX_IN(i) AS_GLOBAL(const float, ctx_ld(i))
#define PH_FN_BEGIN \
    extern __shared__ __attribute__((aligned(16))) unsigned char lds_raw[]; \
    LAS char* lds = (LAS char*)lds_raw; (void)lds; \
    const int G = gridDim.x, bid = blockIdx.x; (void)G; (void)bid; \
    unsigned char* const ws = AS_GLOBAL(unsigned char, ctx_ld(17)); (void)ws; \
    const int NQ = L == 0 ? 3072 : 9216; (void)NQ; \
    int* cnt = P_cnt_all + L * NE * CNT_STRIDE; (void)cnt;
__device__ __forceinline__ void ph_p0(int L, int rep_, const int wave_s_) {
    PH_FN_BEGIN
    (void)rep_;
    PH_BEGIN;
    for (size_t i = (size_t)bid * NTHR + tid; i < (size_t)T * D / 4; i += (size_t)G * NTHR) {
        const f32x4 v = *(const f32x4*)(P_x_in + i * 4);
        u32x2 w; w[0] = cvtpk(v[0], v[1]); w[1] = cvtpk(v[2], v[3]);
        *(u32x2*)(P_xb + i * 4) = w;
#if QKV_FP8
        *(unsigned*)(P_xq8 + i * 4) = pack_fp8x4(v[0], v[1], v[2], v[3]);
#endif
    }
    LAS float* tl = (LAS float*)lds;
    for (int it = bid; it < 3968 + 128; it += G) {
        int seg, kt;
        if (it < 3840) { seg = it >> 4; kt = it & 15; } else if (it < 3968) { seg = 240 + ((it - 3840) >> 2); kt = (it - 3840) & 3; } else { seg = 272 + ((it - 3968) >> 4); kt = (it - 3968) & 15; }
        const float* src; int ld; u16* dst; int Kd = 1024; u16* dst_lo = nullptr; int rcol = 0; unsigned char* dst8 = nullptr;
        if (seg < 48) { const int col = 64 * seg; src = CTX_IN(1) + col; ld = 3072; dst = (u16*)(ws + WS_WQK0) + (size_t)col * 1024; if (QKV_FP8) dst8 = P_wq8 + (size_t)col * 1024; }
        else if (seg < 192) { const int col = 64 * (seg - 48); src = CTX_IN(2) + col; ld = 9216; dst = (u16*)(ws + WS_WQK1) + (size_t)col * 1024; if (QKV_FP8) dst8 = P_wq8 + (size_t)(3072 + col) * 1024; }
        else if (seg < 224) { const int s2 = seg - 192, l2 = s2 >> 4, col = 64 * (s2 & 15); src = CTX_IN(3) + (size_t)l2 * D * D + col; ld = 1024; dst = (u16*)(ws + WS_WO) + (size_t)l2 * D * D + (size_t)col * 1024; if (WO_FP8) dst8 = P_wo8 + (size_t)l2 * D * D + (size_t)col * 1024; }
        else if (seg < 240) { const int s2 = seg - 224, l2 = s2 >> 3, i8 = s2 & 7, un = i8 >> 2, q = i8 & 3;
            src = (q < 2 ? CTX_IN(11) : CTX_IN(12)) + (size_t)l2 * D * DF + un * 128 + 64 * (q & 1); ld = 256; dst = (u16*)(ws + WS_WSGU) + (size_t)l2 * 512 * 1024 + (size_t)(64 * i8) * 1024; }
        else if (seg < 272) { const int s2 = seg - 240, l2 = s2 >> 4, col = 64 * (s2 & 15); src = CTX_IN(13) + (size_t)l2 * DF * D + col; ld = 1024; Kd = 256; dst = (u16*)(ws + WS_WSD) + (size_t)l2 * D * DF + (size_t)col * 256; }
        else { const int s2 = seg - 272, l2 = s2 >> 2, col = 64 * (s2 & 3); src = CTX_IN(6) + (size_t)l2 * D * NE + col; ld = 256; rcol = col; dst = (u16*)(ws + WS_WRH) + (size_t)l2 * NE * D; dst_lo = (u16*)(ws + WS_WRL) + (size_t)l2 * NE * D; }
        {
            const int kr = tid >> 4, c4 = tid & 15;
#pragma unroll
            for (int i = 0; i < 2; ++i) {
                const f32x4 v = *(const f32x4*)(src + (size_t)(kt * 64 + kr + 32 * i) * ld + 4 * c4);
#pragma unroll
                for (int jj = 0; jj < 4; ++jj) tl[(kr + 32 * i) * 65 + 4 * c4 + jj] = v[jj];
            }
        }
        __syncthreads();
        {
            const int row = tid >> 3, kc = tid & 7;
            float f[8];
#pragma unroll
            for (int jj = 0; jj < 8; ++jj) f[jj] = tl[(8 * kc + jj) * 65 + row];
            u32x4 w; w[0] = cvtpk(f[0], f[1]); w[1] = cvtpk(f[2], f[3]); w[2] = cvtpk(f[4], f[5]); w[3] = cvtpk(f[6], f[7]);
            if (dst_lo) {
                u32x4 wl;
#pragma unroll
                for (int jj = 0; jj < 4; ++jj) wl[jj] = cvtpk(f[2 * jj] - bf2f(w[jj] & 0xFFFFu), f[2 * jj + 1] - bf2f(w[jj] >> 16));
                const int E_ = rcol + row;
                const size_t fi = ((size_t)(((E_ >> 5) * 16 + kt) * 4 + (kc >> 1)) * 64 + (kc & 1) * 32 + (E_ & 31)) * 8;
                *(u32x4*)(dst + fi) = w; *(u32x4*)(dst_lo + fi) = wl;
            } else if (dst8) {
                u32x2 w8; w8[0] = pack_fp8x4(f[0] * 64.f, f[1] * 64.f, f[2] * 64.f, f[3] * 64.f); w8[1] = pack_fp8x4(f[4] * 64.f, f[5] * 64.f, f[6] * 64.f, f[7] * 64.f);
                *(u32x2*)(dst8 + (size_t)row * 1024 + kt * 64 + 8 * kc) = w8;
            } else *(u32x4*)(dst + (size_t)row * Kd + kt * 64 + 8 * kc) = w;
        }
        __syncthreads();
    }
}

__device__ __forceinline__ void ph_qkv(int L, int rep_, const int wave_s_) {
    PH_FN_BEGIN
    (void)rep_;
#if QKV_FP8 == 2
    const pg8::Gemm g{(const u16*)P_xq8, (const u16*)(P_wq8 + (L == 0 ? (size_t)0 : (size_t)3072 * 1024)), T, NQ, D / 2};
    pg8::StaticOrder S; S.init(g.M, g.N, G, bid);
    const EpiQK E{P_qkv, NQ};
    pg8::gemm_phase<EpiQK, pg8::StaticOrder, false, false, true>((PG8_LAS unsigned char*)lds, g, S, E, nullptr, wave_s_ * 64 + lane_id_());
#elif QKV_FP8
    PH_BEGIN;
    const int nchunk = NQ / 384, nq = 4 * nchunk;
    const unsigned char* w8 = P_wq8 + (L == 0 ? (size_t)0 : (size_t)3072 * 1024);
    int* xq = (int*)(ws + WS_CTL + CTL_XQ_OFF) + (L * 2 + (rep_ & 1)) * 8 * 64;
    LAS int* slot = (LAS int*)(lds + 140000);
    const int xme = (int)(xb_xcc_id() & 7u);
    unsigned qdone = 0u;
    for (;;) {
        __syncthreads();
        if (tid == 0) {
            int item = -1;
            for (int k = 0; k < 8 && item < 0; ++k) {
                const int xx = (xme + k) & 7;
                if (qdone >> xx & 1u) continue;
                const int q = atomicAdd(&xq[xx * 64], 1);
                if (q < nq) item = (xx + 8 * (q / nchunk)) * nchunk + (q % nchunk); else qdone |= 1u << xx;
            }
            *slot = item;
        }
        __syncthreads();
        const int item = *slot;
        if (item < 0) break;
        const int rt = item / nchunk, ch = item - rt * nchunk;
        qkv8_item<3>(lds, wave, P_xq8 + (size_t)rt * 512 * 1024, w8 + (size_t)ch * 384 * 1024, P_qkv + (size_t)rt * 512 * NQ + ch * 384, NQ, item & 7);
    }
#else
    const pg8::Gemm g{P_xb, (const u16*)(ws + (L == 0 ? WS_WQK0 : WS_WQK1)), T, NQ, D};
    pg8::StaticOrder S; S.init(g.M, g.N, G, bid);
    const EpiQK E{P_qkv, NQ};
    pg8::gemm_phase<EpiQK, pg8::StaticOrder, false>((PG8_LAS unsigned char*)lds, g, S, E, nullptr, wave_s_ * 64 + lane_id_());
#endif
}

__device__ __forceinline__ void ph_kmean(int L, int rep_, const int wave_s_) {
    PH_FN_BEGIN
    (void)rep_;
    PH_BEGIN;
    LAS float* red = (LAS float*)lds;
    for (int it = bid; it < BATCH * NH * MOBA_NB; it += G) {
        const int j = it & 31, h = (it >> 5) & 15, b = it >> 9;
        const int kg_ = tid >> 3, ch = tid & 7;
        const u16* kp = P_qkv + (size_t)(b * SEQ + j * MOBA_BLK + kg_) * 3072 + 1024 + h * 64 + ch * 8;
        float sm[8];
#pragma unroll
        for (int e2 = 0; e2 < 8; ++e2) sm[e2] = 0.f;
#pragma unroll
        for (int i = 0; i < 4; ++i) {
            const u32x4 v = *(const u32x4*)(kp + (size_t)(64 * i) * 3072);
#pragma unroll
            for (int e2 = 0; e2 < 4; ++e2) { sm[2 * e2] += bf2f(v[e2] & 0xFFFFu); sm[2 * e2 + 1] += bf2f(v[e2] >> 16); }
        }
#pragma unroll
        for (int e2 = 0; e2 < 8; ++e2) red[kg_ * 65 + ch * 8 + e2] = sm[e2];
        __syncthreads();
        if (tid < 64) {
            float tot = 0.f;
#pragma unroll 8
            for (int q = 0; q < 64; ++q) tot += red[q * 65 + tid];
            P_kmean[(size_t)it * 64 + tid] = tot * (1.f / MOBA_BLK);
        }
        __syncthreads();
    }
}

__device__ __forceinline__ void ph_gate(int L, int rep_, const int wave_s_) {
    PH_FN_BEGIN
    (void)rep_;
    PH_BEGIN;
    for (int it = bid; it < BATCH * NH * MOBA_NB; it += G) {
        const int qb = it & 31, bh = it >> 5, b = bh >> 4, h = bh & 15;
        const int tq = qb * MOBA_BLK + wave * 32 + r32;
        const u16* qrow = P_qkv + (size_t)(b * SEQ + tq) * 3072 + h * 64 + hi * 8;
        bf16x8 qf[4];
#pragma unroll
        for (int d0 = 0; d0 < 4; ++d0) qf[d0] = *(const bf16x8*)(qrow + d0 * 16);
        unsigned selmask = 0u;
        if (qb > 0) {
            const float* km = P_kmean + ((size_t)(b * NH + h) * MOBA_NB + r32) * 64 + hi * 8;
            f32x16 gt;
#pragma unroll
            for (int r = 0; r < 16; ++r) gt[r] = 0.f;
#pragma unroll
            for (int d0 = 0; d0 < 4; ++d0) {
                const f32x4 k0 = *(const f32x4*)(km + d0 * 16), k1 = *(const f32x4*)(km + d0 * 16 + 4);
                union { bf16x8 v; unsigned u[4]; } kf;
                kf.u[0] = cvtpk(k0[0], k0[1]); kf.u[1] = cvtpk(k0[2], k0[3]); kf.u[2] = cvtpk(k1[0], k1[1]); kf.u[3] = cvtpk(k1[2], k1[3]);
                gt = MFMA_BF16(kf.v, qf[d0], gt);
            }
            float v0 = -INFINITY, v1 = -INFINITY, v2 = -INFINITY; int i0 = 99, i1 = 99, i2 = 99;
#pragma unroll
            for (int r = 0; r < 16; ++r) { const int jb = crow(r, hi); const float gv = jb < qb ? gt[r] : -INFINITY; top3_insert(gv, jb < qb ? jb : 99, v0, i0, v1, i1, v2, i2); }
            const float ov0 = shxf(v0, 32, lane), ov1 = shxf(v1, 32, lane), ov2 = shxf(v2, 32, lane);
            const int oi0 = shxi(i0, 32, lane), oi1 = shxi(i1, 32, lane), oi2 = shxi(i2, 32, lane);
            top3_insert(ov0, oi0, v0, i0, v1, i1, v2, i2); top3_insert(ov1, oi1, v0, i0, v1, i1, v2, i2); top3_insert(ov2, oi2, v0, i0, v1, i1, v2, i2);
            if (i0 < 32) selmask |= 1u << i0;
            if (i1 < 32) selmask |= 1u << i1;
            if (i2 < 32) selmask |= 1u << i2;
        }
        if (hi == 0) P_selm[(size_t)bh * SEQ + tq] = selmask;
    }
}

constexpr int MB_KP = 72;
constexpr int MB_VP = 260;
constexpr int MB_LDS_K = 0;
constexpr int MB_LDS_V = 256 * MB_KP * 2;
constexpr int MB_LDS_LIST = MB_LDS_V + 64 * MB_VP * 2;
constexpr int MB_LDS_CTR = MB_LDS_LIST + 8192 * 2;
__device__ __forceinline__ void ph_moba(int L, int rep_, const int wave_s_) {
    PH_FN_BEGIN
    (void)rep_;
    PH_BEGIN;
    LAS char* Ks = lds + MB_LDS_K; LAS char* Vs = lds + MB_LDS_V;
    LAS u16* qlist = (LAS u16*)(lds + MB_LDS_LIST); LAS int* ctr = (LAS int*)(lds + MB_LDS_CTR);
    for (int it = bid; it < BATCH * NH * MOBA_NB; it += G) {
        const int rnd = it >> 8, w8 = it & 255, a8 = w8 >> 5, bh = w8 & 31;
        const int j = rnd == 0 ? a8 : (rnd == 1 ? 15 - a8 : (rnd == 2 ? 16 + a8 : 31 - a8));
        const int b = bh >> 4, h = bh & 15;
        const float slope2 = exp2f(-0.5f * (float)(h + 1)) * LOG2E;
        if (tid == 0) { int z0 = 0; asm volatile("" : "+v"(z0)); ctr[0] = z0; ctr[1] = z0; }
        {
            const u16* kg = P_qkv + (size_t)(b * SEQ + j * MOBA_BLK) * 3072 + 1024 + h * 64;
#pragma unroll
            for (int i = 0; i < 4; ++i) { const int c = tid + i * 512, row = c >> 3, ch = c & 7; *(LAS u32x4*)(Ks + (row * MB_KP + ch * 8) * 2) = *(const u32x4*)(kg + (size_t)row * 3072 + ch * 8); }
            const u16* vg = P_qkv + (size_t)(b * SEQ + j * MOBA_BLK) * 3072 + 2048 + h * 64;
            {
                const int kg4 = tid >> 3, ch = tid & 7;
                u32x4 v4[4];
#pragma unroll
                for (int q = 0; q < 4; ++q) v4[q] = *(const u32x4*)(vg + (size_t)(4 * kg4 + q) * 3072 + ch * 8);
#pragma unroll
                for (int e2 = 0; e2 < 4; ++e2) {
                    u32x2 wlo, whi;
                    wlo[0] = __builtin_amdgcn_perm(v4[1][e2], v4[0][e2], 0x05040100u); wlo[1] = __builtin_amdgcn_perm(v4[3][e2], v4[2][e2], 0x05040100u);
                    whi[0] = __builtin_amdgcn_perm(v4[1][e2], v4[0][e2], 0x07060302u); whi[1] = __builtin_amdgcn_perm(v4[3][e2], v4[2][e2], 0x07060302u);
                    *(LAS u32x2*)(Vs + ((ch * 8 + 2 * e2) * MB_VP + 4 * kg4) * 2) = wlo;
                    *(LAS u32x2*)(Vs + ((ch * 8 + 2 * e2 + 1) * MB_VP + 4 * kg4) * 2) = whi;
                }
            }
        }
        __syncthreads();
        {
            const unsigned* sm = P_selm + (size_t)bh * SEQ;
            for (int t0 = (j + 1) * MOBA_BLK; t0 < SEQ; t0 += 512) {
                const int t = t0 + tid;
                const bool sel = (t < SEQ) && ((sm[t < SEQ ? t : 0] >> j) & 1u);
                const unsigned long long bal = __ballot(sel);
                const int total = __popcll(bal);
                int wb = 0;
                if (lane == 0 && total) wb = atomicAdd((int*)&ctr[0], total);
                wb = __builtin_amdgcn_readfirstlane(wb);
                if (sel) qlist[wb + __popcll(bal & ((1ull << lane) - 1ull))] = (u16)t;
            }
        }
        __syncthreads();
        const int nq = ctr[0];
        const int ntiles = 8 + ((nq + 31) >> 5);
        for (;;) {
            int ti = 0;
            if (lane == 0) ti = atomicAdd((int*)&ctr[1], 1);
            ti = __builtin_amdgcn_readfirstlane(ti);
            if (ti >= ntiles) break;
            const bool own = ti < 8;
            const int wq = 7 - ti;
            const int li = (ti - 8) * 32 + r32;
            const bool valid = own || li < nq;
            const int tq = own ? j * MOBA_BLK + wq * 32 + r32 : (int)qlist[li < nq ? li : nq - 1];
            const int nsteps = own ? wq + 1 : 8;
            const u16* qrow = P_qkv + (size_t)(b * SEQ + tq) * 3072 + h * 64 + hi * 8;
            bf16x8 qf[4];
#pragma unroll
            for (int d0 = 0; d0 < 4; ++d0) qf[d0] = *(const bf16x8*)(qrow + d0 * 16);
            int slot = 3;
            if (!own) slot = __popc(P_selm[(size_t)bh * SEQ + tq] & ((1u << j) - 1u));
            AttnSt st; st.m = NEGV; st.l = 0.f;
#pragma unroll
            for (int r = 0; r < 16; ++r) { st.o0[r] = 0.f; st.o1[r] = 0.f; }
            const int dlo = own ? 0 : -0x40000000;
            for (int kt = 0; kt < nsteps; ++kt) {
                AttnFr f;
#pragma unroll
                for (int d0 = 0; d0 < 4; ++d0) f.k[d0] = *(LAS bf16x8*)(Ks + ((kt * 32 + r32) * MB_KP + d0 * 16 + hi * 8) * 2);
#pragma unroll
                for (int q4 = 0; q4 < 4; ++q4) {
                    union { bf16x8 v; u32x2 hh[2]; } va;
                    LAS char* vp = Vs + (((q4 >> 1) * 32 + r32) * MB_VP + kt * 32 + (q4 & 1) * 16 + 4 * hi) * 2;
                    va.hh[0] = *(LAS u32x2*)(vp); va.hh[1] = *(LAS u32x2*)(vp + 16);
                    f.v[q4] = va.v;
                }
                if (own && kt == nsteps - 1) attn_compute<true>(st, qf, f, tq - (j * MOBA_BLK + kt * 32) - 4 * hi, slope2, dlo, 0x7fffffff, hi, lane);
                else attn_compute<false>(st, qf, f, tq - (j * MOBA_BLK + kt * 32) - 4 * hi, slope2, dlo, 0x7fffffff, hi, lane);
            }
            const float lt = st.l + shxf(st.l, 32, lane);
            const float inv = 1.f / lt;
            if (valid) {
                const size_t pi = ((size_t)(b * SEQ + tq) * NH + h) * 4 + slot;
                u16* orow = P_part + pi * 64;
#pragma unroll
                for (int rq = 0; rq < 4; ++rq) {
                    u32x2 w; w[0] = cvtpk(st.o0[4 * rq] * inv, st.o0[4 * rq + 1] * inv); w[1] = cvtpk(st.o0[4 * rq + 2] * inv, st.o0[4 * rq + 3] * inv);
                    *(u32x2*)(orow + 8 * rq + 4 * hi) = w;
                    w[0] = cvtpk(st.o1[4 * rq] * inv, st.o1[4 * rq + 1] * inv); w[1] = cvtpk(st.o1[4 * rq + 2] * inv, st.o1[4 * rq + 3] * inv);
                    *(u32x2*)(orow + 32 + 8 * rq + 4 * hi) = w;
                }
                if (hi == 0) P_plse[pi] = st.m * LN2 + logf(lt);
            }
        }
        __syncthreads();
    }
}

__device__ __forceinline__ void ph_mobamerge(int L, int rep_, const int wave_s_) {
    PH_FN_BEGIN
    (void)rep_;
    PH_BEGIN;
    for (size_t i = (size_t)bid * NTHR + tid; i < (size_t)T * NH * 8; i += (size_t)G * NTHR) {
        const size_t row = i >> 7; const int h = (int)(i >> 3) & 15, d8 = (int)i & 7;
        const int qb = (int)(row & (SEQ - 1)) >> 8;
        const int nsel = qb < 3 ? qb : 3;
        const size_t pi = (row * NH + h) * 4;
        float l[4], w[4];
        float mx = -INFINITY;
#pragma unroll
        for (int sidx = 0; sidx < 4; ++sidx) { const bool ok = sidx == 3 || sidx < nsel; l[sidx] = ok ? P_plse[pi + sidx] : -INFINITY; mx = fmaxf(mx, l[sidx]); }
        float ws_ = 0.f;
#pragma unroll
        for (int sidx = 0; sidx < 4; ++sidx) { w[sidx] = (sidx == 3 || sidx < nsel) ? expf(l[sidx] - mx) : 0.f; ws_ += w[sidx]; }
        const float inv = 1.f / ws_;
        float acc8[8];
#pragma unroll
        for (int c = 0; c < 8; ++c) acc8[c] = 0.f;
#pragma unroll
        for (int sidx = 0; sidx < 4; ++sidx) {
            if (sidx == 3 || sidx < nsel) {
                const u32x4 a = *(const u32x4*)(P_part + (pi + sidx) * 64 + d8 * 8);
                const float ww = w[sidx] * inv;
#pragma unroll
                for (int c = 0; c < 4; ++c) { acc8[2 * c] += ww * bf2f(a[c] & 0xFFFFu); acc8[2 * c + 1] += ww * bf2f(a[c] >> 16); }
            }
        }
#if WO_FP8
        u32x2 o8; o8[0] = pack_fp8x4(acc8[0] * AO8_SCALE, acc8[1] * AO8_SCALE, acc8[2] * AO8_SCALE, acc8[3] * AO8_SCALE); o8[1] = pack_fp8x4(acc8[4] * AO8_SCALE, acc8[5] * AO8_SCALE, acc8[6] * AO8_SCALE, acc8[7] * AO8_SCALE);
        *(u32x2*)((unsigned char*)P_ao + row * D + h * 64 + d8 * 8) = o8;
#else
        u32x4 o;
#pragma unroll
        for (int c = 0; c < 4; ++c) o[c] = cvtpk(acc8[2 * c], acc8[2 * c + 1]);
        *(u32x4*)(P_ao + row * D + h * 64 + d8 * 8) = o;
#endif
    }
}

constexpr int DL_KP = 72, DL_VP = 388;
constexpr int DL_LDS_K = 0, DL_LDS_V = 384 * DL_KP * 2;
__device__ __forceinline__ void ph_dil(int L, int rep_, const int wave_s_) {
    PH_FN_BEGIN
    (void)rep_;
    PH_BEGIN;
    LAS char* Ks = lds + DL_LDS_K; LAS char* Vs = lds + DL_LDS_V;
    for (int it = bid; it < BATCH * NH * 3 * 32; it += G) {
        const int ch = it & 31, grp = (it >> 5) % 3, bh = it / 96, b = bh >> 4, h = bh & 15;
        const int dil = grp == 0 ? 1 : (grp == 1 ? 4 : 16), Ls = SEQ / dil;
        const float slope2 = exp2f(-0.5f * (float)(h + 1)) * LOG2E * (float)dil;
        const int uc = ch * 256, res = uc / Ls, c0 = uc - res * Ls;
        const int kb0 = c0 - 128;
        {
            const u16* kg = P_qkv + (size_t)(b * SEQ) * 9216 + grp * 3072 + 1024 + h * 64;
#pragma unroll
            for (int i = 0; i < 6; ++i) {
                const int c = tid + i * 512, row = c >> 3, chk = c & 7, ks = kb0 + row;
                if (ks >= 0) *(LAS u32x4*)(Ks + (row * DL_KP + chk * 8) * 2) = *(const u32x4*)(kg + (size_t)(ks * dil + res) * 9216 + chk * 8);
            }
            const u16* vg = P_qkv + (size_t)(b * SEQ) * 9216 + grp * 3072 + 2048 + h * 64;
#pragma unroll
            for (int i = 0; i < 2; ++i) {
                const int c = tid + i * 512, kg4 = c >> 3, chk = c & 7, ks = kb0 + 4 * kg4;
                if (c < 768 && ks >= 0) {
                    u32x4 v4[4];
#pragma unroll
                    for (int q = 0; q < 4; ++q) v4[q] = *(const u32x4*)(vg + (size_t)((ks + q) * dil + res) * 9216 + chk * 8);
#pragma unroll
                    for (int e2 = 0; e2 < 4; ++e2) {
                        u32x2 wlo, whi;
                        wlo[0] = __builtin_amdgcn_perm(v4[1][e2], v4[0][e2], 0x05040100u); wlo[1] = __builtin_amdgcn_perm(v4[3][e2], v4[2][e2], 0x05040100u);
                        whi[0] = __builtin_amdgcn_perm(v4[1][e2], v4[0][e2], 0x07060302u); whi[1] = __builtin_amdgcn_perm(v4[3][e2], v4[2][e2], 0x07060302u);
                        *(LAS u32x2*)(Vs + ((chk * 8 + 2 * e2) * DL_VP + 4 * kg4) * 2) = wlo;
                        *(LAS u32x2*)(Vs + ((chk * 8 + 2 * e2 + 1) * DL_VP + 4 * kg4) * 2) = whi;
                    }
                }
            }
        }
        const int i0 = c0 + wave * 32, iq = i0 + r32, pq = iq * dil + res;
        const u16* qrow = P_qkv + (size_t)(b * SEQ + pq) * 9216 + grp * 3072 + h * 64 + hi * 8;
        bf16x8 qf[4];
#pragma unroll
        for (int d0 = 0; d0 < 4; ++d0) qf[d0] = *(const bf16x8*)(qrow + d0 * 16);
        __syncthreads();
        AttnSt st; st.m = NEGV; st.l = 0.f;
#pragma unroll
        for (int r = 0; r < 16; ++r) { st.o0[r] = 0.f; st.o1[r] = 0.f; }
        const int ktmin = (i0 >= 128) ? 0 : (128 - i0) >> 5;
        for (int kt = 4; kt >= ktmin; --kt) {
            const int lrow0 = (wave + kt) * 32;
            AttnFr f;
#pragma unroll
            for (int d0 = 0; d0 < 4; ++d0) f.k[d0] = *(LAS bf16x8*)(Ks + ((lrow0 + r32) * DL_KP + d0 * 16 + hi * 8) * 2);
#pragma unroll
            for (int q4 = 0; q4 < 4; ++q4) {
                union { bf16x8 v; u32x2 hh[2]; } va;
                LAS char* vp = Vs + (((q4 >> 1) * 32 + r32) * DL_VP + lrow0 + (q4 & 1) * 16 + 4 * hi) * 2;
                va.hh[0] = *(LAS u32x2*)(vp); va.hh[1] = *(LAS u32x2*)(vp + 16);
                f.v[q4] = va.v;
            }
            const int k0 = i0 - 128 + kt * 32;
            if (kt == 4 || kt == 0) attn_compute<true>(st, qf, f, iq - k0 - 4 * hi, slope2, 0, 128, hi, lane);
            else attn_compute<false>(st, qf, f, iq - k0 - 4 * hi, slope2, 0, 128, hi, lane);
        }
        const float lt = st.l + shxf(st.l, 32, lane);
        const float inv = 1.f / lt;
        u16* orow = P_og + (size_t)grp * T * D + (size_t)(b * SEQ + pq) * D + h * 64;
#pragma unroll
        for (int rq = 0; rq < 4; ++rq) {
            u32x2 w; w[0] = cvtpk(st.o0[4 * rq] * inv, st.o0[4 * rq + 1] * inv); w[1] = cvtpk(st.o0[4 * rq + 2] * inv, st.o0[4 * rq + 3] * inv);
            *(u32x2*)(orow + 8 * rq + 4 * hi) = w;
            w[0] = cvtpk(st.o1[4 * rq] * inv, st.o1[4 * rq + 1] * inv); w[1] = cvtpk(st.o1[4 * rq + 2] * inv, st.o1[4 * rq + 3] * inv);
            *(u32x2*)(orow + 32 + 8 * rq + 4 * hi) = w;
        }
        if (hi == 0) P_lse[((size_t)grp * T + (b * SEQ + pq)) * NH + h] = st.m * LN2 + logf(lt);
        __syncthreads();
    }
}

__device__ __forceinline__ void ph_merge(int L, int rep_, const int wave_s_) {
    PH_FN_BEGIN
    (void)rep_;

            PH_BEGIN;
                for (size_t i = (size_t)bid * NTHR + tid; i < (size_t)T * NH * 8; i += (size_t)G * NTHR) {
                    const size_t row = i >> 7; const int h = (int)(i >> 3) & 15, d8 = (int)i & 7;
                    const float l0 = P_lse[(0 * (size_t)T + row) * NH + h], l1 = P_lse[(1 * (size_t)T + row) * NH + h], l2 = P_lse[(2 * (size_t)T + row) * NH + h];
                    const float mx = fmaxf(l0, fmaxf(l1, l2));
                    float w0 = expf(l0 - mx), w1 = expf(l1 - mx), w2 = expf(l2 - mx);
                    const float inv = 1.f / (w0 + w1 + w2); w0 *= inv; w1 *= inv; w2 *= inv;
                    const size_t off = row * D + h * 64 + d8 * 8;
                    const u32x4 a0 = *(const u32x4*)(P_og + off), a1 = *(const u32x4*)(P_og + (size_t)T * D + off), a2 = *(const u32x4*)(P_og + 2 * (size_t)T * D + off);
                    u32x4 o; float of_[8];
#pragma unroll
                    for (int c = 0; c < 4; ++c) {
                        const float lo_ = w0 * bf2f(a0[c] & 0xFFFFu) + w1 * bf2f(a1[c] & 0xFFFFu) + w2 * bf2f(a2[c] & 0xFFFFu);
                        const float hi_ = w0 * bf2f(a0[c] >> 16) + w1 * bf2f(a1[c] >> 16) + w2 * bf2f(a2[c] >> 16);
                        o[c] = cvtpk(lo_, hi_); of_[2 * c] = lo_ * AO8_SCALE; of_[2 * c + 1] = hi_ * AO8_SCALE;
                    }
                    if (WO_FP8) { u32x2 o8; o8[0] = pack_fp8x4(of_[0], of_[1], of_[2], of_[3]); o8[1] = pack_fp8x4(of_[4], of_[5], of_[6], of_[7]); *(u32x2*)((unsigned char*)P_ao + off) = o8; }
                    else *(u32x4*)(P_ao + off) = o;
                }

}

__device__ __forceinline__ void ph_wo(int L, int rep_, const int wave_s_) {
    PH_FN_BEGIN
    (void)rep_;
    const EpiWo E{P_ypre, P_xb};
#if WO_FP8
    const pg8::Gemm g{P_ao, (const u16*)(P_wo8 + (size_t)L * D * D), T, D, D / 2};
    pg8::StaticOrder S; S.init(g.M, g.N, G, bid);
    pg8::gemm_phase<EpiWo, pg8::StaticOrder, false, false, true, 0x7B79>((PG8_LAS unsigned char*)lds, g, S, E, nullptr, wave_s_ * 64 + lane_id_());
#else
    const pg8::Gemm g{P_ao, (const u16*)(ws + WS_WO) + (size_t)L * D * D, T, D, D};
    pg8::StaticOrder S; S.init(g.M, g.N, G, bid);
    pg8::gemm_phase<EpiWo, pg8::StaticOrder, false>((PG8_LAS unsigned char*)lds, g, S, E, nullptr, wave_s_ * 64 + lane_id_());
#endif
}

constexpr int RT_P = 144;
constexpr int RT_ASTAGE = 2 * 64 * 144;
constexpr int RT_LDS_AH = 0, RT_LDS_AL = 64 * RT_P;
constexpr int RT_LDS_BH = 2 * 64 * RT_P, RT_LDS_BL = RT_LDS_BH + 256 * RT_P;
constexpr int RT_LDS_ST = RT_LDS_BL + 256 * RT_P;
constexpr int RT_LDS_GB = 94208;
__device__ __forceinline__ void ph_router(int L, int rep_, const int wave_s_) {
    PH_FN_BEGIN
    (void)rep_;
    PH_BEGIN;
    const float* lng = CTX_IN(4) + L * D; const float* lnb = CTX_IN(5) + L * D;
    const float* rbias = CTX_IN(7) + L * NE;
    const u16* wrh = (const u16*)(ws + WS_WRH) + (size_t)L * NE * D; const u16* wrl = (const u16*)(ws + WS_WRL) + (size_t)L * NE * D;
    LAS float* stat = (LAS float*)(lds + RT_LDS_ST);
    if (tid < 256) { *(LAS f32x4*)(lds + RT_LDS_GB + tid * 16) = *(const f32x4*)(lng + tid * 4); *(LAS f32x4*)(lds + RT_LDS_GB + 4096 + tid * 16) = *(const f32x4*)(lnb + tid * 4); }
    for (int it = bid; it < T / 64; it += G) {
#pragma unroll 1
        for (int hb_ = 0; hb_ < 2; ++hb_) {
            u32x4 yv[4][2];
#pragma unroll
            for (int rr = 0; rr < 4; ++rr)
#pragma unroll
                for (int j = 0; j < 2; ++j) yv[rr][j] = *(const u32x4*)(P_ypre + ((size_t)it * 64 + wave * 8 + hb_ * 4 + rr) * D + j * 512 + lane * 8);
#pragma unroll
            for (int rr = 0; rr < 4; ++rr) {
                float sm = 0.f;
#pragma unroll
                for (int j = 0; j < 2; ++j)
#pragma unroll
                    for (int c = 0; c < 4; ++c) sm += bf2f(yv[rr][j][c] & 0xFFFFu) + bf2f(yv[rr][j][c] >> 16);
                const float mu = wave_sum(sm) * (1.f / D);
                float q = 0.f;
#pragma unroll
                for (int j = 0; j < 2; ++j)
#pragma unroll
                    for (int c = 0; c < 4; ++c) { const float d0_ = bf2f(yv[rr][j][c] & 0xFFFFu) - mu, d1_ = bf2f(yv[rr][j][c] >> 16) - mu; q += d0_ * d0_ + d1_ * d1_; }
                const float rstd = rsqrtf(wave_sum(q) * (1.f / D) + LN_EPS);
                if (lane == 0) { stat[wave * 8 + hb_ * 4 + rr] = mu; stat[64 + wave * 8 + hb_ * 4 + rr] = rstd; }
            }
        }
        __syncthreads();
        const int arow = tid >> 3, aq = tid & 7;
        const float amu = stat[arow], ars = stat[64 + arow];
        const u16* yp = P_ypre + ((size_t)it * 64 + arow) * D + aq * 8;
        u32x4 ya = *(const u32x4*)(yp);
        u32x4 bw[8], bx[8];
        const u16* wfh = wrh + (size_t)wave * 16 * 4 * 64 * 8 + lane * 8; const u16* wfl = wrl + (size_t)wave * 16 * 4 * 64 * 8 + lane * 8;
#define RT_LOADB(BW, KC_) { _Pragma("unroll") for (int sk = 0; sk < 4; ++sk) { BW[sk] = *(const u32x4*)(wfh + ((KC_) * 4 + sk) * 512); BW[4 + sk] = *(const u32x4*)(wfl + ((KC_) * 4 + sk) * 512); } }
        RT_LOADB(bw, 0)
        RT_LOADB(bx, 1)
        f32x16 lg[2];
#pragma unroll
        for (int r = 0; r < 16; ++r) { lg[0][r] = 0.f; lg[1][r] = 0.f; }
#define RT_WRITEA(KC_) { const int k0 = (KC_) * 64; \
            const f32x4 g0 = *(const LAS f32x4*)(lds + RT_LDS_GB + (k0 + aq * 8) * 4), g1 = *(const LAS f32x4*)(lds + RT_LDS_GB + (k0 + aq * 8 + 4) * 4); \
            const f32x4 b0 = *(const LAS f32x4*)(lds + RT_LDS_GB + 4096 + (k0 + aq * 8) * 4), b1 = *(const LAS f32x4*)(lds + RT_LDS_GB + 4096 + (k0 + aq * 8 + 4) * 4); \
            f32x4 x0, x1v; \
            _Pragma("unroll") for (int c = 0; c < 4; ++c) { const float y0_ = bf2f(c & 1 ? ya[c >> 1] >> 16 : ya[c >> 1] & 0xFFFFu), y1_ = bf2f(c & 1 ? ya[2 + (c >> 1)] >> 16 : ya[2 + (c >> 1)] & 0xFFFFu); \
                x0[c] = (y0_ - amu) * ars * g0[c] + b0[c]; x1v[c] = (y1_ - amu) * ars * g1[c] + b1[c]; } \
            ya = *(const u32x4*)(yp + (((KC_) + 1 < 16) ? k0 + 64 : 0)); \
            const size_t go = ((size_t)it * 64 + arow) * D + k0 + aq * 8; \
            u32x4 wh; wh[0] = cvtpk(x0[0], x0[1]); wh[1] = cvtpk(x0[2], x0[3]); wh[2] = cvtpk(x1v[0], x1v[1]); wh[3] = cvtpk(x1v[2], x1v[3]); \
            *(u32x4*)(P_xb + go) = wh; \
            u32x2 w8; w8[0] = pack_fp8x4(x0[0], x0[1], x0[2], x0[3]); w8[1] = pack_fp8x4(x1v[0], x1v[1], x1v[2], x1v[3]); \
            *(u32x2*)(P_xb8 + go) = w8; \
            u32x4 wl; \
            wl[0] = cvtpk(x0[0] - bf2f(wh[0] & 0xFFFFu), x0[1] - bf2f(wh[0] >> 16)); wl[1] = cvtpk(x0[2] - bf2f(wh[1] & 0xFFFFu), x0[3] - bf2f(wh[1] >> 16)); \
            wl[2] = cvtpk(x1v[0] - bf2f(wh[2] & 0xFFFFu), x1v[1] - bf2f(wh[2] >> 16)); wl[3] = cvtpk(x1v[2] - bf2f(wh[3] & 0xFFFFu), x1v[3] - bf2f(wh[3] >> 16)); \
            *(LAS u32x4*)(lds + ((KC_) & 1) * RT_ASTAGE + RT_LDS_AH + arow * RT_P + aq * 16) = wh; \
            *(LAS u32x4*)(lds + ((KC_) & 1) * RT_ASTAGE + RT_LDS_AL + arow * RT_P + aq * 16) = wl; }
#define RT_CHUNK(KC_, BW) { __syncthreads(); \
            _Pragma("unroll") for (int sk = 0; sk < 4; ++sk) { \
                const int ko = (sk * 16 + hi * 8) * 2; \
                const bf16x8 bh_ = __builtin_bit_cast(bf16x8, BW[sk]), bl_ = __builtin_bit_cast(bf16x8, BW[4 + sk]); \
                _Pragma("unroll") for (int rb = 0; rb < 2; ++rb) { \
                    const bf16x8 xh = *(const LAS bf16x8*)(lds + ((KC_) & 1) * RT_ASTAGE + RT_LDS_AH + (rb * 32 + r32) * RT_P + ko), xl = *(const LAS bf16x8*)(lds + ((KC_) & 1) * RT_ASTAGE + RT_LDS_AL + (rb * 32 + r32) * RT_P + ko); \
                    lg[rb] = MFMA_BF16(xh, bh_, lg[rb]); lg[rb] = MFMA_BF16(xl, bh_, lg[rb]); lg[rb] = MFMA_BF16(xh, bl_, lg[rb]); \
                } \
            } \
            if ((KC_) + 1 < 16) RT_WRITEA((KC_) + 1) \
            { const int kn_ = ((KC_) + 2 < 16) ? (KC_) + 2 : ((KC_) & 1); RT_LOADB(BW, kn_) } }
        RT_WRITEA(0)
#pragma unroll 1
        for (int kc = 0; kc < 16; kc += 2) {
            RT_CHUNK(kc, bw)
            RT_CHUNK(kc + 1, bx)
        }
#undef RT_CHUNK
#undef RT_WRITEA
#undef RT_LOADB
        __syncthreads();
        LAS float* lgs = (LAS float*)lds;
#pragma unroll
        for (int rb = 0; rb < 2; ++rb)
#pragma unroll
            for (int r = 0; r < 16; ++r) lgs[(rb * 32 + crow(r, hi)) * 257 + wave * 32 + r32] = lg[rb][r];
        __syncthreads();
#pragma unroll 1
        for (int tg = 0; tg < 2; ++tg) {
            float sc[4][4], cv[4][4];
#pragma unroll
            for (int tt = 0; tt < 4; ++tt) {
                const int lr = wave * 8 + tg * 4 + tt;
#pragma unroll
                for (int j = 0; j < 4; ++j) { const int e = lane + 64 * j; sc[tt][j] = 1.f / (1.f + __expf(-lgs[lr * 257 + e])); cv[tt][j] = sc[tt][j] + rbias[e]; }
            }
            float gsel[4][8];
#pragma unroll
            for (int j = 0; j < 4; ++j) {
#pragma unroll
                for (int tt = 0; tt < 4; ++tt) {
                    const float rm = dpp_rowmax(cv[tt][j]);
                    const float m1a = fmaxf(rl_f(rm, 0), rl_f(rm, 16)), m1b = fmaxf(rl_f(rm, 32), rl_f(rm, 48));
                    const unsigned long long bal = __ballot(cv[tt][j] == (hi ? m1b : m1a));
                    const int fa_ = __builtin_ctz((unsigned)(bal & 0xFFFFFFFFull)), fb_ = 32 + __builtin_ctz((unsigned)(bal >> 32));
                    const float c2 = (lane == fa_ || lane == fb_) ? -INFINITY : cv[tt][j];
                    const float rm2 = dpp_rowmax(c2);
                    gsel[tt][2 * j] = m1a + fmaxf(rl_f(rm2, 0), rl_f(rm2, 16));
                    gsel[tt][2 * j + 1] = m1b + fmaxf(rl_f(rm2, 32), rl_f(rm2, 48));
                }
            }
#pragma unroll
            for (int tt = 0; tt < 4; ++tt)
#pragma unroll
                for (int j = 0; j < 4; ++j) {
                    int ra_ = 0, rb_ = 0;
#pragma unroll
                    for (int g2 = 0; g2 < 8; ++g2) {
                        ra_ += ((gsel[tt][g2] > gsel[tt][2 * j]) || (gsel[tt][g2] == gsel[tt][2 * j] && g2 < 2 * j)) ? 1 : 0;
                        rb_ += ((gsel[tt][g2] > gsel[tt][2 * j + 1]) || (gsel[tt][g2] == gsel[tt][2 * j + 1] && g2 < 2 * j + 1)) ? 1 : 0;
                    }
                    cv[tt][j] = ((hi ? rb_ : ra_) < 4) ? cv[tt][j] : NEGV;
                }
            float wsel[4], wsum[4]; int esel[4];
#pragma unroll
            for (int tt = 0; tt < 4; ++tt) { wsel[tt] = 0.f; wsum[tt] = 0.f; esel[tt] = 0; }
#pragma unroll 1
            for (int k = 0; k < TOPK; ++k) {
#pragma unroll
                for (int tt = 0; tt < 4; ++tt) {
                    float bv = cv[tt][0]; int be = lane;
#pragma unroll
                    for (int j = 1; j < 4; ++j) if (cv[tt][j] > bv) { bv = cv[tt][j]; be = lane + 64 * j; }
                    const float rm = dpp_rowmax(bv);
                    const float mval = fmaxf(fmaxf(rl_f(rm, 0), rl_f(rm, 16)), fmaxf(rl_f(rm, 32), rl_f(rm, 48)));
                    const int ri = dpp_rowmin_i(bv == mval ? be : 0x7fffffff);
                    const int e = min(min(__builtin_amdgcn_readlane(ri, 0), __builtin_amdgcn_readlane(ri, 16)), min(__builtin_amdgcn_readlane(ri, 32), __builtin_amdgcn_readlane(ri, 48)));
                    const int jl = e >> 6, ll = e & 63;
                    const float smine = ((jl == 0 ? sc[tt][0] : 0.f) + (jl == 1 ? sc[tt][1] : 0.f)) + ((jl == 2 ? sc[tt][2] : 0.f) + (jl == 3 ? sc[tt][3] : 0.f));
                    const float sw = rl_f(smine, ll);
#pragma unroll
                    for (int j = 0; j < 4; ++j) cv[tt][j] = (lane == ll && jl == j) ? -INFINITY : cv[tt][j];
                    wsum[tt] += sw;
                    if (lane == k) { wsel[tt] = sw; esel[tt] = e; }
                }
            }
#pragma unroll
            for (int tt = 0; tt < 4; ++tt) {
                if (lane < TOPK) {
                    const int tok = it * 64 + wave * 8 + tg * 4 + tt;
                    const int a = tok * TOPK + lane;
                    P_topw[a] = wsel[tt] / wsum[tt] * 2.5f;
                    if (rep_ == 0) {
                        const int pos = atomicAdd(&cnt[esel[tt] * CNT_STRIDE], 1);
                        P_list[(size_t)esel[tt] * T + pos] = a;
                    }
                }
            }
        }
        __syncthreads();
    }
}

__device__ __forceinline__ void ph_gateup(int L, int rep_, const int wave_s_) {
    PH_FN_BEGIN
    (void)rep_;
    {
        PH_BEGIN;
        const float* weg = CTX_IN(8) + (size_t)L * NE * D * DF; const float* weu = CTX_IN(9) + (size_t)L * NE * D * DF;
        LAS int* rowva = (LAS int*)(lds + MOE_LDS_VA);
        {
            int* octr = (int*)(ws + WS_CTL + CTL_CNT_OFF + 8192) + (L * 4 + 2 * (rep_ & 1)) * 64;
            LAS int* slot = (LAS int*)(lds + 140000);
            for (;;) {
                __syncthreads();
                if (tid == 0) { int q; do { q = atomicAdd(octr, 1); } while (q >= NE && q < NE * 5 && cnt[((q - NE) >> 2) * CNT_STRIDE] <= MOE_XCAP); *slot = q; }
                __syncthreads();
                const int q = *slot;
                if (q >= NE * 5) break;
                const bool ovf = q >= NE;
                const int e = ovf ? (q - NE) >> 2 : q, pz = ovf ? (q - NE) & 3 : 0, npz = ovf ? 1 : 4, st0 = ovf ? 1 : 0, n = cnt[e * CNT_STRIDE];
                for (int r0 = 0; r0 < n; r0 += 1024) {
                    if (ovf && n - r0 <= MOE_XCAP) break;
#pragma unroll
                    for (int i = 0; i < 2; ++i) { int t_ = tid; asm volatile("" : "+v"(t_)); const int idx = r0 + i * 512 + t_; rowva[i * 512 + t_] = idx < n ? P_list[(size_t)e * T + idx] : TRASH_VA; }
                    __syncthreads();
                    moe_expert<false>(lds, tid, lane, wave, r32, hi, P_xb8, weg + (size_t)e * D * DF, weu + (size_t)e * D * DF, (n - r0) < 1024 ? (n - r0) : 1024, (void*)P_hb, pz, npz, st0, 1, false, !ovf && (n - r0) > 512 && (n - r0) <= MOE_XCAP);
                }
            }
        }
    }
    {
        PH_BEGIN;
        const pg8::Gemm g{P_xb, (const u16*)(ws + WS_WSGU) + (size_t)L * 512 * 1024, T, 512, D};
        const EpiSGU E{P_hbs};
        int* qctr = (int*)(ws + WS_CTL + CTL_CNT_OFF + 4096) + (L * 4 + 2 * (rep_ & 1)) * 64;
        LAS int* slot = (LAS int*)(lds + 140000);
        for (;;) {
            __syncthreads();
            if (tid == 0) *slot = atomicAdd(qctr, 1);
            __syncthreads();
            const int un = *slot;
            if (un >= 128) break;
            const pg8::FixedOrder S{un & 63, un >> 6};
            pg8::gemm_phase<EpiSGU, pg8::FixedOrder, false>((PG8_LAS unsigned char*)lds, g, S, E, nullptr, wave_s_ * 64 + lane_id_());
        }
    }
}

__device__ __forceinline__ void ph_down(int L, int rep_, const int wave_s_) {
    PH_FN_BEGIN
    (void)rep_;
    {
        PH_BEGIN;
        const float* wed = CTX_IN(10) + (size_t)L * NE * DF * D;
        LAS int* rowva = (LAS int*)(lds + MOE_LDS_VA); LAS float* roww = (LAS float*)(lds + MOE_LDS_W);
        {
            int* octr = (int*)(ws + WS_CTL + CTL_CNT_OFF + 8192) + (L * 4 + 1 + 2 * (rep_ & 1)) * 64;
            LAS int* slot = (LAS int*)(lds + 140000);
            for (;;) {
                __syncthreads();
                if (tid == 0) { int q; do { q = atomicAdd(octr, 1); } while (q >= NE && q < NE * 5 && cnt[((q - NE) >> 2) * CNT_STRIDE] <= 512); *slot = q; }
                __syncthreads();
                const int q = *slot;
                if (q >= NE * 5) break;
                const bool ovf = q >= NE;
                const int e = ovf ? (q - NE) >> 2 : q, pz = ovf ? ((q - NE) & 3) * 2 : 0, npz = ovf ? 2 : 8, st0 = ovf ? 1 : 0, n = cnt[e * CNT_STRIDE];
                for (int r0 = 0; r0 < n; r0 += 1024) {
                    if (ovf && n - r0 <= 512) break;
#pragma unroll
                    for (int i = 0; i < 2; ++i) { int t_ = tid; asm volatile("" : "+v"(t_)); const int idx = r0 + i * 512 + t_; const int va = idx < n ? P_list[(size_t)e * T + idx] : TRASH_VA; rowva[i * 512 + t_] = va; roww[i * 512 + t_] = va < A_TOT ? P_topw[va] * Y8_SCALE : 0.f; }
                    __syncthreads();
                    moe_expert<true>(lds, tid, lane, wave, r32, hi, (const unsigned char*)P_hb, wed + (size_t)e * DF * D, nullptr, (n - r0) < 1024 ? (n - r0) : 1024, (void*)P_yb, pz, npz, st0, 1, true);
                }
            }
        }
    }
    {
        PH_BEGIN;
        const pg8::Gemm g{P_hbs, (const u16*)(ws + WS_WSD) + (size_t)L * D * DF, T, D, DF};
        const EpiSD E{P_yb};
        int* qctr = (int*)(ws + WS_CTL + CTL_CNT_OFF + 4096) + (L * 4 + 1 + 2 * (rep_ & 1)) * 64;
        LAS int* slot = (LAS int*)(lds + 140000);
        for (;;) {
            __syncthreads();
            if (tid == 0) *slot = atomicAdd(qctr, 1);
            __syncthreads();
            const int un = *slot;
            if (un >= 256) break;
            const pg8::FixedOrder S{un & 63, un >> 6};
            pg8::gemm_phase<EpiSD, pg8::FixedOrder, false>((PG8_LAS unsigned char*)lds, g, S, E, nullptr, wave_s_ * 64 + lane_id_());
        }
    }
}

__device__ __forceinline__ void ph_combine(int L, int rep_, const int wave_s_) {
    PH_FN_BEGIN
    (void)rep_;
    PH_BEGIN;
    const float* lng = CTX_IN(14) + L * D; const float* lnb = CTX_IN(15) + L * D;
    float* dst = AS_GLOBAL(float, ctx_ld(16));
    for (int row = bid * 8 + wave; row < T; row += G * 8) {
        u32x4 yv[TOPK + 1][2];
#pragma unroll
        for (int k = 0; k < TOPK + 1; ++k) {
            const size_t va = k < TOPK ? (size_t)row * TOPK + k : (size_t)A_TOT + row;
            if (k < TOPK) {
#pragma unroll
                for (int j = 0; j < 2; ++j) { const u32x2 w8 = *(const u32x2*)((const unsigned char*)P_yb + va * D + j * 512 + lane * 8); yv[k][j][0] = w8[0]; yv[k][j][1] = w8[1]; yv[k][j][2] = 0u; yv[k][j][3] = 0u; }
            } else {
#pragma unroll
                for (int j = 0; j < 2; ++j) yv[k][j] = *(const u32x4*)(P_yb + va * D + j * 512 + lane * 8);
            }
        }
        float v[16];
#pragma unroll
        for (int j = 0; j < 2; ++j) {
            const u32x4 t = *(const u32x4*)(P_xb + (size_t)row * D + j * 512 + lane * 8);
#pragma unroll
            for (int c = 0; c < 4; ++c) { v[j * 8 + 2 * c] = DN_ALPHA * bf2f(t[c] & 0xFFFFu); v[j * 8 + 2 * c + 1] = DN_ALPHA * bf2f(t[c] >> 16); }
        }
#pragma unroll
        for (int k = 0; k < TOPK + 1; ++k)
#pragma unroll
            for (int j = 0; j < 2; ++j) {
                if (k < TOPK) {
#pragma unroll
                    for (int c = 0; c < 2; ++c) {
                        const f32x2_ lo2 = __builtin_amdgcn_cvt_pk_f32_fp8((int)yv[k][j][c], false), hi2 = __builtin_amdgcn_cvt_pk_f32_fp8((int)yv[k][j][c], true);
                        v[j * 8 + 4 * c] += lo2[0] * (1.f / Y8_SCALE); v[j * 8 + 4 * c + 1] += lo2[1] * (1.f / Y8_SCALE); v[j * 8 + 4 * c + 2] += hi2[0] * (1.f / Y8_SCALE); v[j * 8 + 4 * c + 3] += hi2[1] * (1.f / Y8_SCALE);
                    }
                } else {
#pragma unroll
                    for (int c = 0; c < 4; ++c) { v[j * 8 + 2 * c] += bf2f(yv[k][j][c] & 0xFFFFu); v[j * 8 + 2 * c + 1] += bf2f(yv[k][j][c] >> 16); }
                }
            }
        float sm = 0.f;
#pragma unroll
        for (int i = 0; i < 16; ++i) sm += v[i];
        const float mu = wave_sum(sm) * (1.f / D);
        float q = 0.f;
#pragma unroll
        for (int i = 0; i < 16; ++i) { const float d = v[i] - mu; q += d * d; }
        const float rstd = rsqrtf(wave_sum(q) * (1.f / D) + LN_EPS);
#pragma unroll
        for (int j = 0; j < 2; ++j) {
            const f32x4 g0 = *(const f32x4*)(lng + j * 512 + lane * 8), g1 = *(const f32x4*)(lng + j * 512 + lane * 8 + 4);
            const f32x4 b0 = *(const f32x4*)(lnb + j * 512 + lane * 8), b1 = *(const f32x4*)(lnb + j * 512 + lane * 8 + 4);
            f32x4 o0, o1;
#pragma unroll
            for (int c = 0; c < 4; ++c) { o0[c] = (v[j * 8 + c] - mu) * rstd * g0[c] + b0[c]; o1[c] = (v[j * 8 + 4 + c] - mu) * rstd * g1[c] + b1[c]; }
            if (L == 1) { *(f32x4*)(dst + (size_t)row * D + j * 512 + lane * 8) = o0; *(f32x4*)(dst + (size_t)row * D + j * 512 + lane * 8 + 4) = o1; }
            if (L == 0) { u32x4 w; w[0] = cvtpk(o0[0], o0[1]); w[1] = cvtpk(o0[2], o0[3]); w[2] = cvtpk(o1[0], o1[1]); w[3] = cvtpk(o1[2], o1[3]); *(u32x4*)(P_xb + (size_t)row * D + j * 512 + lane * 8) = w;
                if (QKV_FP8) { u32x2 w8; w8[0] = pack_fp8x4(o0[0], o0[1], o0[2], o0[3]); w8[1] = pack_fp8x4(o1[0], o1[1], o1[2], o1[3]); *(u32x2*)(P_xq8 + (size_t)row * D + j * 512 + lane * 8) = w8; } }
        }
    }
}

__global__ void __launch_bounds__(NTHR, 2) fwd(Args args) {
    extern __shared__ __attribute__((aligned(16))) unsigned char lds_raw[];
    LAS char* lds = (LAS char*)lds_raw;
    unsigned char* const ws = args.ws;
    const int lo = args.ph_lo, hi_ph = args.ph_hi;
    const int wave_s_ = __builtin_amdgcn_readfirstlane(threadIdx.x >> 6);
    if (threadIdx.x < 18) {
        const uint64_t v = threadIdx.x < 16 ? (uint64_t)args.in[threadIdx.x] : (threadIdx.x == 16 ? (uint64_t)args.out : (uint64_t)args.ws);
        ((LAS uint64_t*)(lds + LDS_CTX))[threadIdx.x] = v;
    }
    __syncthreads();
#define IN(k) (lo <= (k) && (k) < hi_ph)

#if MK_ONE_LAUNCH
    if (threadIdx.x < 4) ((LAS unsigned*)(lds + LDS_BAR))[threadIdx.x] = 0u;
    __syncthreads();
    XcdBarrier bar = xcd_barrier_post((unsigned*)(ws + WS_CTL), (volatile LAS unsigned*)(lds + LDS_BAR), wave_s_ == 0 && lane_id_() == 0);
#define GRID_BAR() xcd_barrier(bar, wave_s_ == 0 && lane_id_() == 0)
#else
#define GRID_BAR() do { } while (0)
#endif
#define SEAM(k) do { if (IN(k) && IN((k) + 1)) GRID_BAR(); } while (0)

    for (int rep_ = 0; rep_ < ((IN(0) && PHK(0)) ? REPS(0) : 0); ++rep_) { ph_p0(0, rep_, wave_s_); }
    SEAM(0);

    for (int L = 0; L < 2; ++L) {
        const int pb = 1 + 10 * L;
        for (int rep_ = 0; rep_ < ((IN(pb + 0) && PHK(1)) ? REPS(1) : 0); ++rep_) { ph_qkv(L, rep_, wave_s_); }
        SEAM(pb + 0);

        if (L == 0) {
            for (int rep_ = 0; rep_ < ((IN(pb + 1) && PHK(2)) ? REPS(2) : 0); ++rep_) { ph_kmean(L, rep_, wave_s_); }
            SEAM(pb + 1);
            for (int rep_ = 0; rep_ < ((IN(pb + 2) && PHK(11)) ? REPS(11) : 0); ++rep_) { ph_gate(L, rep_, wave_s_); }
            SEAM(pb + 2);
        }

        if (L == 0) {
            for (int rep_ = 0; rep_ < ((IN(pb + 3) && PHK(3)) ? REPS(3) : 0); ++rep_) { ph_moba(L, rep_, wave_s_); }
            SEAM(pb + 3);
            for (int rep_ = 0; rep_ < ((IN(pb + 4) && PHK(12)) ? REPS(12) : 0); ++rep_) { ph_mobamerge(L, rep_, wave_s_); }
        } else {
            for (int rep_ = 0; rep_ < ((IN(pb + 3) && PHK(4)) ? REPS(4) : 0); ++rep_) { ph_dil(L, rep_, wave_s_); }
            SEAM(pb + 3);
            for (int rep_ = 0; rep_ < ((IN(pb + 4) && PHK(5)) ? REPS(5) : 0); ++rep_) { ph_merge(L, rep_, wave_s_); }
        }
        SEAM(pb + 4);

        for (int rep_ = 0; rep_ < ((IN(pb + 5) && PHK(6)) ? REPS(6) : 0); ++rep_) { ph_wo(L, rep_, wave_s_); }
        SEAM(pb + 5);

        for (int rep_ = 0; rep_ < ((IN(pb + 6) && PHK(7)) ? REPS(7) : 0); ++rep_) { ph_router(L, rep_, wave_s_); }
        SEAM(pb + 6);

        for (int rep_ = 0; rep_ < ((IN(pb + 7) && PHK(8)) ? REPS(8) : 0); ++rep_) { ph_gateup(L, rep_, wave_s_); }
        SEAM(pb + 7);

        for (int rep_ = 0; rep_ < ((IN(pb + 8) && PHK(9)) ? REPS(9) : 0); ++rep_) { ph_down(L, rep_, wave_s_); }
        SEAM(pb + 8);

        for (int rep_ = 0; rep_ < ((IN(pb + 9) && PHK(10)) ? REPS(10) : 0); ++rep_) { ph_combine(L, rep_, wave_s_); }
        if (L == 0) SEAM(pb + 9);
    }
}

extern "C" void kernel_launch(void* const* d_in, const int* in_sizes, int n_in, void* d_out, int out_size, void* d_ws, size_t ws_size, hipStream_t stream) {
    static int grid = 0;
    if (grid == 0) {
        if (n_in != 16 || out_size != T * D || ws_size < WS_END3) { fprintf(stderr, "kernel_launch: unexpected problem (n_in %d out %d ws %zu need %zu)\n", n_in, out_size, ws_size, (size_t)WS_END2); grid = -1; return; }
        int dev = 0, cus = 0, per_cu = 0;
        if (hipGetDevice(&dev) != hipSuccess || hipDeviceGetAttribute(&cus, hipDeviceAttributeMultiprocessorCount, dev) != hipSuccess) { grid = -1; return; }
        if (hipFuncSetAttribute((const void*)fwd, hipFuncAttributeMaxDynamicSharedMemorySize, LDS_BYTES) != hipSuccess) { fprintf(stderr, "kernel_launch: hipFuncSetAttribute failed\n"); grid = -1; return; }
        if (hipOccupancyMaxActiveBlocksPerMultiprocessor(&per_cu, (const void*)fwd, NTHR, LDS_BYTES) != hipSuccess || per_cu < 1) { fprintf(stderr, "kernel_launch: occupancy query says %d\n", per_cu); (void)hipGetLastError(); per_cu = 1; }
        grid = cus;
    }
    if (grid < 0) return;
    (void)hipMemsetAsync((char*)d_ws + WS_CTL, 0, CTL_BYTES, stream);
    Args a{};
    for (int i = 0; i < 16; ++i) a.in[i] = (const float*)d_in[i];
    a.out = (float*)d_out; a.ws = (unsigned char*)d_ws;
#if MK_ONE_LAUNCH
    a.ph_lo = 0; a.ph_hi = N_PHASES;
    hipLaunchKernelGGL(fwd, dim3(grid), dim3(NTHR), LDS_BYTES, stream, a);
#else
    for (int ph = 0; ph < N_PHASES; ++ph) {
        if (ph == 12 || ph == 13) continue;
        a.ph_lo = ph; a.ph_hi = ph + 1;
        hipLaunchKernelGGL(fwd, dim3(grid), dim3(NTHR), LDS_BYTES, stream, a);
    }
#endif
}
```

```cpp
#include <hip/hip_runtime.h>
#include <hip/hip_bf16.h>
#include <stdint.h>
#include <stdio.h>

#ifndef MK_ONE_LAUNCH
#define MK_ONE_LAUNCH 1
#endif

#ifndef PHMASK
#define PHMASK 0x1FFF
#endif
#define PHK(k) ((PHMASK >> (k)) & 1)
#ifndef REPEAT_KIND
#define REPEAT_KIND -1
#endif
#define REPS(k) ((k) == REPEAT_KIND ? 2 : 1)
#define LAS __attribute__((address_space(3)))
typedef __attribute__((ext_vector_type(8))) short bf16x8;
typedef __attribute__((ext_vector_type(16))) float f32x16;
typedef __attribute__((ext_vector_type(4))) float f32x4;
typedef __attribute__((ext_vector_type(4))) unsigned u32x4;
typedef __attribute__((ext_vector_type(2))) unsigned u32x2;
typedef unsigned short u16;

constexpr int D = 1024, BATCH = 2, SEQ = 8192, T = BATCH * SEQ, NH = 16, HD = 64;
constexpr int NE = 256, TOPK = 8, DF = 256;
constexpr int A_TOT = T * TOPK;
constexpr int MOBA_BLK = 256, MOBA_NB = SEQ / MOBA_BLK;
constexpr float DN_ALPHA = 1.4142135623730951f;
constexpr float LN_EPS = 1e-5f;
constexpr float LOG2E = 1.4426950408889634f;
constexpr float LN2 = 0.6931471805599453f;
constexpr float NEGV = -1e30f;
constexpr int NTHR = 512;

constexpr size_t al256(size_t x) { return (x + 255) & ~(size_t)255; }
constexpr size_t WS_CTL = 0;
constexpr size_t CTL_BYTES = 131072;
constexpr size_t CTL_CNT_OFF = 32768;
constexpr size_t CTL_XQ_OFF = 45056;
constexpr size_t CTL_ECNT_OFF = 65536;
constexpr int CNT_STRIDE = 32;
constexpr size_t WS_XB = WS_CTL + CTL_BYTES;
constexpr size_t WS_X1 = WS_XB + al256((size_t)T * D * 2);
constexpr size_t WS_X2 = WS_X1 + al256((size_t)T * D * 4);
constexpr size_t WS_YPRE = WS_X2 + al256((size_t)T * D * 4);
constexpr size_t WS_QKV = WS_YPRE + al256((size_t)T * D * 4);
constexpr size_t WS_VT = WS_QKV + al256((size_t)T * 9216 * 2);
constexpr size_t WS_KM = WS_VT + al256((size_t)3 * T * D * 2);
constexpr size_t WS_AO = WS_KM + al256((size_t)BATCH * NH * MOBA_NB * HD * 4);
constexpr size_t WS_OG = WS_AO + al256((size_t)T * D * 2);
constexpr size_t WS_LSE = WS_OG + al256((size_t)3 * T * D * 2);
constexpr size_t WS_TOPW = WS_LSE + al256((size_t)3 * T * NH * 4);
constexpr size_t WS_LIST = WS_TOPW + al256((size_t)T * TOPK * 4);
constexpr size_t WS_HB = WS_LIST + al256((size_t)NE * T * 4);
constexpr size_t WS_YB = WS_HB + al256((size_t)(A_TOT + T + 1) * DF * 2);
constexpr size_t WS_END = WS_YB + al256((size_t)(A_TOT + T + 1) * D * 2);
constexpr int TRASH_VA = A_TOT + T;
constexpr size_t WS_SELM = WS_END;
constexpr size_t WS_PART = WS_SELM + al256((size_t)T * NH * 4);
constexpr size_t WS_PLSE = WS_PART + al256((size_t)T * NH * 4 * 64 * 2);
constexpr size_t WS_WQK0 = WS_PLSE + al256((size_t)T * NH * 4 * 4);
constexpr size_t WS_WV0 = WS_WQK0 + (size_t)2048 * 1024 * 2;
constexpr size_t WS_WQK1 = WS_WV0 + (size_t)1024 * 1024 * 2;
constexpr size_t WS_WV1 = WS_WQK1 + (size_t)6144 * 1024 * 2;
constexpr size_t WS_WO = WS_WV1 + (size_t)3072 * 1024 * 2;
constexpr size_t WS_WSGU = WS_WO + (size_t)2 * 1024 * 1024 * 2;
constexpr size_t WS_WSD = WS_WSGU + (size_t)2 * 512 * 1024 * 2;
constexpr size_t WS_XB8 = WS_WSD + (size_t)2 * 1024 * 256 * 2;
constexpr size_t WS_HBS = WS_XB8 + (size_t)T * D;
constexpr size_t WS_WRH = WS_HBS + (size_t)T * DF * 2;
constexpr size_t WS_WRL = WS_WRH + (size_t)2 * 256 * 1024 * 2;
constexpr size_t WS_END2 = WS_WRL + (size_t)2 * 256 * 1024 * 2;
constexpr size_t WS_XQ8 = WS_END2;
constexpr size_t WS_WQ8 = WS_XQ8 + (size_t)T * D;
constexpr size_t WS_WO8 = WS_WQ8 + (size_t)(3072 + 9216) * 1024;
constexpr size_t WS_END3 = WS_WO8 + (size_t)2 * 1024 * 1024;
#ifndef WO_FP8
#define WO_FP8 1
#endif
constexpr float AO8_SCALE = 16.f;
#ifndef QKV_FP8
#define QKV_FP8 2
#endif

constexpr int LDP = 40;
constexpr int STAGE_BYTES = 2 * 256 * LDP * 2;
constexpr int LDS_ROWID = 2 * STAGE_BYTES;
constexpr int LDS_ROWW = LDS_ROWID + 1024;
constexpr int XS_PITCH = 1028;
constexpr int LDS_BYTES = 163840;
constexpr int LDS_BAR = 161792;

__device__ __forceinline__ int lane_id_() { int l; asm volatile("v_mbcnt_lo_u32_b32 %0, -1, 0\n\tv_mbcnt_hi_u32_b32 %0, -1, %0" : "=v"(l)); return l; }
__device__ __forceinline__ float shxf(float v, int m, int lane) { return __int_as_float(__builtin_amdgcn_ds_bpermute((lane ^ m) << 2, __float_as_int(v))); }
__device__ __forceinline__ int shxi(int v, int m, int lane) { return __builtin_amdgcn_ds_bpermute((lane ^ m) << 2, v); }
#define XB_TMO      128
#define XB_XCNT(j)  (256  + 64 * (j))
#define XB_XSUB(j)  (1280 + 64 * (j))
#define XB_XGEN(j)  (2304 + 64 * (j))
#define XB_TOP      3328
#define XB_TOPGEN   3392
#define XCD_BAR_WORDS 3456
#define XB_SPIN_CAP (1u << 18)
__device__ __forceinline__ unsigned xb_ld(unsigned* p)              { return __hip_atomic_load(p, __ATOMIC_RELAXED, __HIP_MEMORY_SCOPE_AGENT); }
__device__ __forceinline__ unsigned xb_add(unsigned* p, unsigned v) { return __hip_atomic_fetch_add(p, v, __ATOMIC_RELAXED, __HIP_MEMORY_SCOPE_AGENT); }
__device__ __forceinline__ unsigned xb_xcc_id() { return (unsigned)__builtin_amdgcn_s_getreg((3 << 11) | 20) & 0xFu; }
#define XB_SPIN(cond, bar) do { unsigned _sp = 0; while (cond) { __builtin_amdgcn_s_sleep(1); \
    if ((++_sp & 255u) == 0u) { if (xb_ld(&(bar)[XB_TMO])) break; if (_sp > XB_SPIN_CAP) { atomicAdd(&(bar)[XB_TMO], 1u); break; } } } } while (0)
struct XcdBarrier { unsigned* bar; unsigned x; volatile LAS unsigned* st; };
__device__ __forceinline__ XcdBarrier xcd_barrier_post(unsigned* bar, volatile LAS unsigned* st, const bool leader) {
    XcdBarrier b; b.bar = bar; b.x = xb_xcc_id(); b.st = st;
    if (leader) (void)xb_add(&bar[XB_XCNT(b.x)], 1u);
    return b;
}
__device__ __forceinline__ void xcd_barrier_complete(unsigned* bar, unsigned x, unsigned& nloc, unsigned& nx) {
    const unsigned G = gridDim.x * gridDim.y * gridDim.z;
    unsigned sum, cnt, mine, sp = 0u;
    for (;;) {
        sum = 0u; cnt = 0u; mine = 0u;
#pragma unroll
        for (unsigned j = 0; j < 16; ++j) { const unsigned c = xb_ld(&bar[XB_XCNT(j)]); sum += c; cnt += (c > 0u) ? 1u : 0u; mine = (j == x) ? c : mine; }
        if (sum == G) break;
        __builtin_amdgcn_s_sleep(1);
        if ((++sp & 255u) == 0u) { if (xb_ld(&bar[XB_TMO])) break; if (sp > XB_SPIN_CAP) { atomicAdd(&bar[XB_TMO], 1u); break; } }
    }
    nloc = mine > 0u ? mine : 1u; nx = cnt > 0u ? cnt : 1u;
}
__device__ __forceinline__ void xcd_barrier(const XcdBarrier& b, const bool leader) {
    asm volatile("s_waitcnt vmcnt(0)" ::: "memory");
    __syncthreads();
    if (leader) {
        unsigned* bar = b.bar;
        __builtin_amdgcn_s_waitcnt(0);
        unsigned nloc = b.st[0], nx = b.st[1];
        if (nloc == 0u) { xcd_barrier_complete(bar, b.x, nloc, nx); b.st[0] = nloc; b.st[1] = nx; }
        const unsigned old = xb_add(&bar[XB_XSUB(b.x)], 1u);
        const unsigned gen = old / nloc;
        if (old + 1u == (gen + 1u) * nloc) {
            __builtin_amdgcn_fence(__ATOMIC_RELEASE, "agent");
            asm volatile("s_waitcnt vmcnt(0)" ::: "memory");
            const unsigned og = xb_add(&bar[XB_TOP], 1u);
            const unsigned tg = og / nx;
            if (og + 1u == (tg + 1u) * nx) xb_add(&bar[XB_TOPGEN], 1u);
            else XB_SPIN(xb_ld(&bar[XB_TOPGEN]) == tg, bar);
            __builtin_amdgcn_fence(__ATOMIC_ACQUIRE, "agent");
            xb_add(&bar[XB_XGEN(b.x)], 1u);
            asm volatile("s_waitcnt vmcnt(0)" ::: "memory");
        } else {
            XB_SPIN(xb_ld(&bar[XB_XGEN(b.x)]) == gen, bar);
            __builtin_amdgcn_fence(__ATOMIC_ACQUIRE, "agent");
            asm volatile("s_waitcnt vmcnt(0)" ::: "memory");
        }
    }
    __syncthreads();
}

typedef __attribute__((ext_vector_type(2))) __bf16 bf16x2_t;
typedef __attribute__((ext_vector_type(2))) float f32x2_t;
__device__ __forceinline__ unsigned cvtpk(float lo, float hi) { f32x2_t f; f[0] = lo; f[1] = hi; return __builtin_bit_cast(unsigned, __builtin_convertvector(f, bf16x2_t)); }
__device__ __forceinline__ float bf2f(unsigned v16) { return __uint_as_float(v16 << 16); }
__device__ __forceinline__ int crow(int r, int hi) { return (r & 3) + 8 * (r >> 2) + 4 * hi; }
#define MFMA_BF16(a, b, c) __builtin_amdgcn_mfma_f32_32x32x16_bf16(a, b, c, 0, 0, 0)
__device__ __forceinline__ float wave_sum(float v) {
    v += __int_as_float(__builtin_amdgcn_update_dpp(0, __float_as_int(v), 0xB1, 0xF, 0xF, true));
    v += __int_as_float(__builtin_amdgcn_update_dpp(0, __float_as_int(v), 0x4E, 0xF, 0xF, true));
    v += __int_as_float(__builtin_amdgcn_update_dpp(0, __float_as_int(v), 0x141, 0xF, 0xF, true));
    v += __int_as_float(__builtin_amdgcn_update_dpp(0, __float_as_int(v), 0x140, 0xF, 0xF, true));
    const int vi = __float_as_int(v);
    return (__int_as_float(__builtin_amdgcn_readlane(vi, 0)) + __int_as_float(__builtin_amdgcn_readlane(vi, 16))) + (__int_as_float(__builtin_amdgcn_readlane(vi, 32)) + __int_as_float(__builtin_amdgcn_readlane(vi, 48)));
}

namespace pg8 {
#define PG8_LAS __attribute__((address_space(3)))
typedef unsigned short bf16_t;
typedef short bf16x8 __attribute__((ext_vector_type(8)));
typedef float f32x4 __attribute__((ext_vector_type(4)));
typedef unsigned u32x4 __attribute__((ext_vector_type(4)));
typedef int pg8_i32x8 __attribute__((ext_vector_type(8)));
constexpr int BM = 256, BK = 64, HALF = 128, HTB = HALF * BK * 2  , STAGE_BYTES = 8 * HTB, NXCD = 8, WGM = 8;

__host__ __device__ __forceinline__ int lds_byte(int r, int c) { const int st = (r >> 4) * 2 + (c >> 5), rr = r & 15, cc = c & 31, ob = rr * 64 + cc * 2; return st * 1024 + (ob ^ (((ob >> 9) & 1) << 5)); }
__host__ __device__ __forceinline__ void stage_rc(int b, int& R, int& C) { const int st = b / 1024, sb = b % 1024, swz = sb ^ (((sb >> 9) & 1) << 5); R = (st >> 1) * 16 + swz / 64; C = (st & 1) * 32 + (swz % 64) / 2; }
__device__ __forceinline__ int pg8_opq(int v) { asm volatile("" : "+v"(v)); return v; }
__host__ __device__ __forceinline__ int perm32(int rho) { const int n = rho >> 4, i = rho & 15; return 8 * (i >> 2) + 4 * n + (i & 3); }

struct Unit { int pm, pn; };
struct Gemm { const bf16_t* A; const bf16_t* Bt; int M, N, K; };
struct FixedOrder {
    int pm, pn;
    __device__ __forceinline__ bool next(int i, Unit& u) const { if (i != 0) return false; u.pm = pm; u.pn = pn; return true; }
    __device__ __forceinline__ void a_ready(const Unit&) const {}
    __device__ __forceinline__ void done(const Unit&) const {}
};

struct StaticOrder {
    int nM, nN, nwg, G, c;
    __host__ __device__ void init(int M, int N, int G_, int c_) { nM = M / BM; nN = N / BM; nwg = nM * nN; G = G_; c = c_; }
    __host__ __device__ bool next(int i, Unit& u) const {
        const long L = (long)i * G + c; if (L >= nwg) return false;
        int wgid = (int)L; { const int q = nwg / NXCD, r = nwg % NXCD, xcd = wgid % NXCD, off = wgid / NXCD; wgid = (xcd < r ? xcd * (q + 1) : r * (q + 1) + (xcd - r) * q) + off; }
        const int nig = WGM * nN, gid = wgid / nig, fm = gid * WGM, gsz = (nM - fm) < WGM ? (nM - fm) : WGM;
        u.pm = fm + ((wgid % nig) % gsz); u.pn = (wgid % nig) / gsz; return true;
    }
    __device__ __forceinline__ void a_ready(const Unit&) const {}
    __device__ __forceinline__ void done(const Unit&) const {}
};

template <class Epi, class Sched, bool SWAP = false, bool STAMP = false, bool F8 = false, int F8SC = 0x7F79  >
__device__ __forceinline__ void gemm_phase(PG8_LAS unsigned char* lds, const Gemm g, const Sched& S, const Epi& E, unsigned long long* stamps, const int tid_in) {
    int tid_ = tid_in; asm volatile("" : "+v"(tid_));
    const int tid = tid_, wid = __builtin_amdgcn_readfirstlane(tid >> 6), lane = tid & 63, wr = wid >> 2, wc = wid & 3, fr = lane & 15, fq = lane >> 4;
    const int K = g.K, nt = K / BK;
    int ts_lo = 0, ts_hi = 0, nts = 0; const unsigned long long rt_entry = STAMP ? (unsigned long long)wall_clock64() : 0ull;
#define PG8_STAMP() do { if (STAMP && wid == 0 && nts < 64) { const unsigned long long _c = (unsigned long long)clock64(); \
        ts_lo = (lane == nts) ? (int)(unsigned)_c : ts_lo; ts_hi = (lane == nts) ? (int)(unsigned)(_c >> 32) : ts_hi; ++nts; } } while (0)
    PG8_STAMP();
    unsigned voffA[2], voffB[2];
#pragma unroll
    for (int i = 0; i < 2; ++i) { int R, C; stage_rc(tid * 16 + i * 8192, R, C); const int Rb = Epi::PERM ? ((R & ~31) + perm32(R & 31)) : R;
        voffA[i] = (unsigned)(R * K + C) * 2u; voffB[i] = (unsigned)(Rb * K + C) * 2u; }
    const size_t kstep = (size_t)(BK * 2);
    const size_t hstep = (size_t)HALF * K * 2;
    const size_t tstep = 2 * hstep;
    const unsigned ldsw = (unsigned)wid * 1024u;
    int xoff_ = lds_byte(fr, fq * 8); asm volatile("" : "+v"(xoff_));
    const int aoffs = wr * 8192, boffs = wc * 4096;
#define aoff (aoffs + pg8_opq(xoff_))
#define boff (boffs + pg8_opq(xoff_))
#define PG8_SA(b, h) (((b) * 2 + (h)) * HTB)
#define PG8_SB(b, h) ((4 + (b) * 2 + (h)) * HTB)
#define PG8_STAGE(bufoff, gbase, voff) do {   \
        _Pragma("unroll") for (int _i = 0; _i < 2; ++_i) { uint64_t gb_ = (uint64_t)(gbase) + (uint64_t)_i * (size_t)(64 * 2) * K; asm volatile("" : "+s"(gb_)); unsigned vo_ = (voff)[0]; asm volatile("" : "+v"(vo_)); \
        __builtin_amdgcn_global_load_lds((const __attribute__((address_space(1))) unsigned*)((const __attribute__((address_space(1))) char*)gb_ + vo_), (PG8_LAS unsigned*)(lds + (bufoff) + ldsw + _i * 8192), 16, 0, 0); } } while (0)
#define PG8_CAT8(X0, X1) pg8_i32x8{(int)__builtin_bit_cast(u32x4, X0)[0], (int)__builtin_bit_cast(u32x4, X0)[1], (int)__builtin_bit_cast(u32x4, X0)[2], (int)__builtin_bit_cast(u32x4, X0)[3], \
                                   (int)__builtin_bit_cast(u32x4, X1)[0], (int)__builtin_bit_cast(u32x4, X1)[1], (int)__builtin_bit_cast(u32x4, X1)[2], (int)__builtin_bit_cast(u32x4, X1)[3]}
#define PG8_LDA(dst, b, h) do { _Pragma("unroll") for (int m = 0; m < 4; ++m) { if (F8) { const bf16x8 x0_ = *(const PG8_LAS bf16x8*)(lds + PG8_SA(b, h) + aoff + m * 2048), x1_ = *(const PG8_LAS bf16x8*)(lds + PG8_SA(b, h) + aoff + m * 2048 + 1024); dst##8[m] = PG8_CAT8(x0_, x1_); } \
        else { _Pragma("unroll") for (int k = 0; k < 2; ++k) dst[m][k] = *(const PG8_LAS bf16x8*)(lds + PG8_SA(b, h) + aoff + m * 2048 + k * 1024); } } } while (0)
#define PG8_LDB(dst, b, h) do { _Pragma("unroll") for (int n = 0; n < 2; ++n) { if (F8) { const bf16x8 x0_ = *(const PG8_LAS bf16x8*)(lds + PG8_SB(b, h) + boff + n * 2048), x1_ = *(const PG8_LAS bf16x8*)(lds + PG8_SB(b, h) + boff + n * 2048 + 1024); dst##8[n] = PG8_CAT8(x0_, x1_); } \
        else { _Pragma("unroll") for (int k = 0; k < 2; ++k) dst[n][k] = *(const PG8_LAS bf16x8*)(lds + PG8_SB(b, h) + boff + n * 2048 + k * 1024); } } } while (0)
#define PG8_MMA(ai, bj, At, Bt) do { __builtin_amdgcn_s_setprio(1); _Pragma("unroll") for (int m = 0; m < 4; ++m) _Pragma("unroll") for (int n = 0; n < 2; ++n) _Pragma("unroll") for (int k = 0; k < 2; ++k) \
        { if (F8) { if (k == 0) acc[ai][bj][m][n] = __builtin_amdgcn_mfma_scale_f32_16x16x128_f8f6f4(Bt##8[n], At##8[m], acc[ai][bj][m][n], 0, 0, 0, F8SC, 1, F8SC); } \
          else acc[ai][bj][m][n] = SWAP ? __builtin_amdgcn_mfma_f32_16x16x32_bf16(At[m][k], Bt[n][k], acc[ai][bj][m][n], 0, 0, 0) : __builtin_amdgcn_mfma_f32_16x16x32_bf16(Bt[n][k], At[m][k], acc[ai][bj][m][n], 0, 0, 0); } __builtin_amdgcn_s_setprio(0); } while (0)
#define PG8_WAIT_V(n) asm volatile("s_waitcnt vmcnt(" #n ")" ::: "memory")
#define PG8_WAIT_L(n) asm volatile("s_waitcnt lgkmcnt(" #n ")" ::: "memory")
#define PG8_BAR __builtin_amdgcn_s_barrier()
#define PG8_SCHED __builtin_amdgcn_sched_barrier(0)
    Unit cur, nxt; int ui = 0;
    if (!S.next(0, cur)) return;
    f32x4 acc[2][2][4][2];
#pragma unroll
    for (int a = 0; a < 2; ++a)
#pragma unroll
        for (int b = 0; b < 2; ++b)
#pragma unroll
            for (int m = 0; m < 4; ++m)
#pragma unroll
                for (int n = 0; n < 2; ++n) acc[a][b][m][n] = (f32x4){0.f, 0.f, 0.f, 0.f};
    bf16x8 At[4][2], B0[2][2], B1[2][2];
    pg8_i32x8 At8[4], B08[2], B18[2];
    const char* cA = (const char*)g.A + (size_t)cur.pm * tstep; const char* cB = (const char*)g.Bt + (size_t)cur.pn * tstep;
    S.a_ready(cur);
    PG8_STAGE(PG8_SB(0, 0), cB, voffB); PG8_STAGE(PG8_SA(0, 0), cA, voffA); PG8_STAGE(PG8_SB(0, 1), cB + hstep, voffB); PG8_STAGE(PG8_SA(0, 1), cA + hstep, voffA);
    if (wr == 1) PG8_BAR;
    PG8_WAIT_V(4); PG8_BAR;
    PG8_STAGE(PG8_SB(1, 0), cB + kstep, voffB); PG8_STAGE(PG8_SA(1, 0), cA + kstep, voffA); PG8_STAGE(PG8_SB(1, 1), cB + hstep + kstep, voffB);
    PG8_WAIT_V(6); PG8_BAR;
    PG8_STAMP();
    for (;;) {
        const bool has_next = S.next(ui + 1, nxt);
        const char* nA = has_next ? (const char*)g.A + (size_t)nxt.pm * tstep : cA; const char* nB = has_next ? (const char*)g.Bt + (size_t)nxt.pn * tstep : cB;
        for (int t = 0; t < nt; t += 2) {
            const bool last = (t == nt - 2);
            const char* a1 = cA + (size_t)(t + 1) * kstep;
            const char* a2 = last ? nA : cA + (size_t)(t + 2) * kstep; const char* b2 = last ? nB : cB + (size_t)(t + 2) * kstep;
            const char* a3 = a2 + kstep; const char* b3 = b2 + kstep;
            if (last && has_next) S.a_ready(nxt);
            PG8_LDB(B0, 0, 0); PG8_SCHED; PG8_LDA(At, 0, 0); PG8_STAGE(PG8_SA(1, 1), a1 + hstep, voffA);
            PG8_WAIT_L(8); PG8_BAR; PG8_WAIT_L(0); PG8_MMA(0, 0, At, B0); PG8_BAR; PG8_SCHED;
            PG8_LDB(B1, 0, 1); PG8_STAGE(PG8_SB(0, 0), b2, voffB);
            PG8_BAR; PG8_WAIT_L(0); PG8_MMA(0, 1, At, B1); PG8_BAR;
            PG8_LDA(At, 0, 1); PG8_STAGE(PG8_SA(0, 0), a2, voffA);
            PG8_BAR; PG8_WAIT_L(0); PG8_MMA(1, 0, At, B0); PG8_BAR; PG8_SCHED;
            PG8_STAGE(PG8_SB(0, 1), b2 + hstep, voffB);
            PG8_WAIT_V(6); PG8_BAR; PG8_MMA(1, 1, At, B1); PG8_BAR;
            PG8_LDB(B0, 1, 0); PG8_SCHED; PG8_LDA(At, 1, 0); PG8_STAGE(PG8_SA(0, 1), a2 + hstep, voffA);
            PG8_WAIT_L(8); PG8_BAR; PG8_WAIT_L(0); PG8_MMA(0, 0, At, B0); PG8_BAR; PG8_SCHED;
            PG8_LDB(B1, 1, 1); PG8_STAGE(PG8_SB(1, 0), b3, voffB);
            PG8_BAR; PG8_WAIT_L(0); PG8_MMA(0, 1, At, B1); PG8_BAR;
            PG8_LDA(At, 1, 1); PG8_STAGE(PG8_SA(1, 0), a3, voffA);
            PG8_BAR; PG8_WAIT_L(0); PG8_MMA(1, 0, At, B0); PG8_BAR; PG8_SCHED;
            PG8_STAGE(PG8_SB(1, 1), b3 + hstep, voffB);
            PG8_WAIT_V(6); PG8_BAR; PG8_MMA(1, 1, At, B1); PG8_BAR;
        }
        PG8_STAMP();
        if constexpr (!Epi::AFTER_DRAIN) { const int le_ = lane_id_(); E(acc, cur, wr, wc, le_ & 15, le_ >> 4); S.done(cur); }
        PG8_STAMP();
        if (!has_next) break;
#pragma unroll
        for (int a = 0; a < 2; ++a)
#pragma unroll
            for (int b = 0; b < 2; ++b)
#pragma unroll
                for (int m = 0; m < 4; ++m)
#pragma unroll
                    for (int n = 0; n < 2; ++n) acc[a][b][m][n] = (f32x4){0.f, 0.f, 0.f, 0.f};
        cur = nxt; cA = nA; cB = nB; ++ui;
    }
    PG8_WAIT_V(0);
    if (wr == 0) PG8_BAR;
    PG8_BAR;
    if constexpr (Epi::AFTER_DRAIN) { E.fused(acc, cur, wr, wc, fr, fq, lds, wid, lane); S.done(cur); }
    PG8_STAMP();
    if (STAMP && wid == 0) { stamps[lane] = lane < nts ? (((unsigned long long)(unsigned)ts_hi << 32) | (unsigned)ts_lo) : 0ull;
        if (lane == 62) stamps[62] = rt_entry; if (lane == 63) stamps[63] = (unsigned long long)wall_clock64(); }
#undef PG8_STAMP
#undef PG8_SA
#undef PG8_SB
#undef PG8_STAGE
#undef aoff
#undef boff
#undef PG8_LDA
#undef PG8_LDB
#undef PG8_MMA
#undef PG8_WAIT_V
#undef PG8_WAIT_L
#undef PG8_BAR
#undef PG8_SCHED
}
}

struct EpiQK {
    static constexpr bool PERM = true, AFTER_DRAIN = false;
    u16* O; int ldc; float* KM;
    __device__ __forceinline__ void operator()(const pg8::f32x4 (&acc)[2][2][4][2], const pg8::Unit& u, int wr, int wc, int fr, int fq) const {
        if (KM != nullptr && (u.pn >> 2) == 1) {
#pragma unroll
            for (int bj = 0; bj < 2; ++bj)
#pragma unroll
                for (int n = 0; n < 2; ++n)
#pragma unroll
                    for (int i = 0; i < 4; ++i) {
                        float sm = 0.f;
#pragma unroll
                        for (int ai = 0; ai < 2; ++ai)
#pragma unroll
                            for (int m = 0; m < 4; ++m) sm += acc[ai][bj][m][n][i];
                        sm += __int_as_float(__builtin_amdgcn_update_dpp(0, __float_as_int(sm), 0xB1, 0xF, 0xF, true));
                        sm += __int_as_float(__builtin_amdgcn_update_dpp(0, __float_as_int(sm), 0x4E, 0xF, 0xF, true));
                        sm += __int_as_float(__builtin_amdgcn_update_dpp(0, __float_as_int(sm), 0x141, 0xF, 0xF, true));
                        sm += __int_as_float(__builtin_amdgcn_update_dpp(0, __float_as_int(sm), 0x140, 0xF, 0xF, true));
                        const int ck = (u.pn - 4) * 256 + bj * 128 + wc * 32 + 8 * fq + 4 * n + i;
                        if (fr == 0) atomicAdd(KM + ((size_t)((u.pm >> 5) * NH + (ck >> 6)) * MOBA_NB + (u.pm & 31)) * 64 + (ck & 63), sm * (1.f / MOBA_BLK));
                    }
        }
        uint64_t ob_ = (uint64_t)O; asm volatile("" : "+s"(ob_));
        unsigned off0 = ((unsigned)(u.pm * 256 + wr * 64 + fr) * (unsigned)ldc + (unsigned)(u.pn * 256 + wc * 32 + 8 * fq)) * 2u; asm volatile("" : "+v"(off0));
        const unsigned rstep = (unsigned)ldc * 32u;
#pragma unroll
        for (int ai = 0; ai < 2; ++ai)
#pragma unroll
            for (int m = 0; m < 4; ++m) { unsigned ro = off0 + (unsigned)(ai * 8 + m) * rstep; asm volatile("" : "+v"(ro));
#pragma unroll
                for (int bj = 0; bj < 2; ++bj) { const pg8::f32x4 v0 = acc[ai][bj][m][0], v1 = acc[ai][bj][m][1];
                    u32x4 w; w[0] = cvtpk(v0[0], v0[1]); w[1] = cvtpk(v0[2], v0[3]); w[2] = cvtpk(v1[0], v1[1]); w[3] = cvtpk(v1[2], v1[3]);
                    *(__attribute__((address_space(1))) u32x4*)((__attribute__((address_space(1))) char*)ob_ + ro + bj * 256) = w; } }
    }
};
struct EpiV {
    static constexpr bool PERM = false, AFTER_DRAIN = false;
    u16* VT; int layer;
    __device__ __forceinline__ void operator()(const pg8::f32x4 (&acc)[2][2][4][2], const pg8::Unit& u, int wr, int wc, int fr, int fq) const {
        const int colt = u.pn * 256, grp = colt >> 10;
        const int dil = (layer == 0 || grp == 0) ? 1 : (grp == 1 ? 4 : 16);
        const int rowb = u.pm * 256 + wr * 64 + 4 * fq;
#pragma unroll
        for (int bj = 0; bj < 2; ++bj)
#pragma unroll
            for (int n = 0; n < 2; ++n) {
                const int c = (colt & 1023) + bj * 128 + wc * 32 + n * 16 + fr, h = c >> 6, d = c & 63;
#pragma unroll
                for (int ai = 0; ai < 2; ++ai)
#pragma unroll
                    for (int m = 0; m < 4; ++m) {
                        const int r0 = rowb + ai * 128 + m * 16, b = r0 >> 13, t0 = r0 & (SEQ - 1);
                        u16* vrow = VT + (size_t)grp * T * D + ((size_t)(b * NH + h) * HD + d) * SEQ;
                        const pg8::f32x4 v = acc[ai][bj][m][n];
                        if (dil == 1) { u32x2 w; w[0] = cvtpk(v[0], v[1]); w[1] = cvtpk(v[2], v[3]); *(u32x2*)(vrow + t0) = w; }
                        else {
#pragma unroll
                            for (int i = 0; i < 4; ++i) { const int pp = t0 + i; vrow[(pp % dil) * (SEQ / dil) + pp / dil] = (u16)cvtpk(v[i], 0.f); }
                        }
                    }
            }
    }
};
struct EpiWo {
    static constexpr bool PERM = true, AFTER_DRAIN = false;
    u16* Y; const u16* X;
    __device__ __forceinline__ void operator()(const pg8::f32x4 (&acc)[2][2][4][2], const pg8::Unit& u, int wr, int wc, int fr, int fq) const {
        const int row0 = u.pm * 256 + wr * 64 + fr, col0 = u.pn * 256 + wc * 32 + 8 * fq;
#pragma unroll
        for (int ai = 0; ai < 2; ++ai)
#pragma unroll
            for (int m = 0; m < 4; ++m) { const size_t ro = (size_t)(row0 + ai * 128 + m * 16) * D + col0;
#pragma unroll
                for (int bj = 0; bj < 2; ++bj) { const pg8::f32x4 v0 = acc[ai][bj][m][0], v1 = acc[ai][bj][m][1];
                    const u32x4 xr = *(const u32x4*)(X + ro + bj * 128);
                    u32x4 w;
                    w[0] = cvtpk(bf2f(xr[0] & 0xFFFFu) * DN_ALPHA + v0[0], bf2f(xr[0] >> 16) * DN_ALPHA + v0[1]); w[1] = cvtpk(bf2f(xr[1] & 0xFFFFu) * DN_ALPHA + v0[2], bf2f(xr[1] >> 16) * DN_ALPHA + v0[3]);
                    w[2] = cvtpk(bf2f(xr[2] & 0xFFFFu) * DN_ALPHA + v1[0], bf2f(xr[2] >> 16) * DN_ALPHA + v1[1]); w[3] = cvtpk(bf2f(xr[3] & 0xFFFFu) * DN_ALPHA + v1[2], bf2f(xr[3] >> 16) * DN_ALPHA + v1[3]);
                    *(u32x4*)(Y + ro + bj * 128) = w; } }
    }
};
struct EpiSGU {
    static constexpr bool PERM = true, AFTER_DRAIN = false;
    u16* H;
    __device__ __forceinline__ void operator()(const pg8::f32x4 (&acc)[2][2][4][2], const pg8::Unit& u, int wr, int wc, int fr, int fq) const {
        const int row0 = u.pm * 256 + wr * 64 + fr, f0 = u.pn * 128 + wc * 32 + 8 * fq;
#pragma unroll
        for (int ai = 0; ai < 2; ++ai)
#pragma unroll
            for (int m = 0; m < 4; ++m) {
                float hv[8];
#pragma unroll
                for (int n = 0; n < 2; ++n)
#pragma unroll
                    for (int i = 0; i < 4; ++i) { const float gt = acc[ai][0][m][n][i], up = acc[ai][1][m][n][i]; hv[n * 4 + i] = gt / (1.f + __expf(-gt)) * up; }
                u32x4 w; w[0] = cvtpk(hv[0], hv[1]); w[1] = cvtpk(hv[2], hv[3]); w[2] = cvtpk(hv[4], hv[5]); w[3] = cvtpk(hv[6], hv[7]);
                *(u32x4*)(H + (size_t)(row0 + ai * 128 + m * 16) * DF + f0) = w;
            }
    }
};
struct EpiSD {
    static constexpr bool PERM = true, AFTER_DRAIN = false;
    u16* Y;
    __device__ __forceinline__ void operator()(const pg8::f32x4 (&acc)[2][2][4][2], const pg8::Unit& u, int wr, int wc, int fr, int fq) const {
        const int row0 = u.pm * 256 + wr * 64 + fr, col0 = u.pn * 256 + wc * 32 + 8 * fq;
#pragma unroll
        for (int ai = 0; ai < 2; ++ai)
#pragma unroll
            for (int m = 0; m < 4; ++m) { u16* rowp = Y + (size_t)(A_TOT + row0 + ai * 128 + m * 16) * D + col0;
#pragma unroll
                for (int bj = 0; bj < 2; ++bj) { const pg8::f32x4 v0 = acc[ai][bj][m][0], v1 = acc[ai][bj][m][1];
                    u32x4 w; w[0] = cvtpk(v0[0], v0[1]); w[1] = cvtpk(v0[2], v0[3]); w[2] = cvtpk(v1[0], v1[1]); w[3] = cvtpk(v1[2], v1[3]);
                    *(u32x4*)(rowp + bj * 128) = w; } }
    }
};

struct Args {
    const float* in[16];
    float* out;
    unsigned char* ws;
    int ph_lo, ph_hi;
};

#define GEMM_CORE(K_, PA0, PA1, PB, LDB)                                                                                                   \
    {                                                                                                                                      \
        const int g_tid = tid, g_lane = lane, g_wave = wave, g_r32 = r32, g_hi = hi;                   \
        const int g_wm = g_wave >> 2, g_wn = g_wave & 3, g_kc = g_tid & 3, g_kq = g_lane >> 3, g_n4 = g_lane & 7;                           \
        const u16* g_pa0 = (PA0); const u16* g_pa1 = (PA1);                                                                                \
        const size_t g_ldb = (size_t)(LDB);                                                                                                \
        const float* g_pb = (PB) + (size_t)(g_kq * 4) * g_ldb + g_n4 * 4;                                                                  \
        const int g_nk = (K_) / 32;                                                                                                        \
        u32x4 g_ra0, g_ra1; f32x4 g_rb0, g_rb1, g_rb2, g_rb3;                                                                              \
        const u32x4 g_z = {0u, 0u, 0u, 0u};                                                                                                \
        _Pragma("unroll") for (int mb = 0; mb < 4; ++mb) { _Pragma("unroll") for (int nb = 0; nb < 2; ++nb) { _Pragma("unroll") for (int r = 0; r < 16; ++r) acc[mb][nb][r] = 0.f; } } \
        g_ra0 = g_pa0 ? *(const u32x4*)(g_pa0 + g_kc * 8) : g_z; g_ra1 = g_pa1 ? *(const u32x4*)(g_pa1 + g_kc * 8) : g_z;                 \
        g_rb0 = *(const f32x4*)(g_pb); g_rb1 = *(const f32x4*)(g_pb + g_ldb); g_rb2 = *(const f32x4*)(g_pb + 2 * g_ldb); g_rb3 = *(const f32x4*)(g_pb + 3 * g_ldb); \
        _Pragma("unroll 1") for (int kt = 0; kt < g_nk; ++kt) {                                                                            \
            LAS char* As = lds + (kt & 1) * STAGE_BYTES; LAS char* Bs = As + 256 * LDP * 2;                                                \
            *(LAS u32x4*)(As + ((g_tid >> 2) * LDP + g_kc * 8) * 2) = g_ra0;                                                               \
            *(LAS u32x4*)(As + (((g_tid >> 2) + 128) * LDP + g_kc * 8) * 2) = g_ra1;                                                       \
            _Pragma("unroll") for (int i = 0; i < 4; ++i) {                                                                                \
                u32x2 w; w[0] = cvtpk(g_rb0[i], g_rb1[i]); w[1] = cvtpk(g_rb2[i], g_rb3[i]);                                               \
                *(LAS u32x2*)(Bs + ((g_wave * 32 + i * 8 + g_n4) * LDP + g_kq * 4) * 2) = w;                                               \
            }                                                                                                                              \
            __syncthreads();                                                                                                               \
            if (kt + 1 < g_nk) {                                                                                                           \
                const int ko = (kt + 1) * 32;                                                                                              \
                g_ra0 = g_pa0 ? *(const u32x4*)(g_pa0 + ko + g_kc * 8) : g_z; g_ra1 = g_pa1 ? *(const u32x4*)(g_pa1 + ko + g_kc * 8) : g_z; \
                const float* pbk = g_pb + (size_t)ko * g_ldb;                                                                              \
                g_rb0 = *(const f32x4*)(pbk); g_rb1 = *(const f32x4*)(pbk + g_ldb); g_rb2 = *(const f32x4*)(pbk + 2 * g_ldb); g_rb3 = *(const f32x4*)(pbk + 3 * g_ldb); \
            }                                                                                                                              \
            _Pragma("unroll") for (int s = 0; s < 2; ++s) {                                                                                \
                bf16x8 af[4], bfr[2];                                                                                                      \
                _Pragma("unroll") for (int mb = 0; mb < 4; ++mb) af[mb] = *(LAS bf16x8*)(As + ((g_wm * 128 + mb * 32 + g_r32) * LDP + s * 16 + g_hi * 8) * 2); \
                _Pragma("unroll") for (int nb = 0; nb < 2; ++nb) bfr[nb] = *(LAS bf16x8*)(Bs + (((g_wn * 2 + nb) * 32 + g_r32) * LDP + s * 16 + g_hi * 8) * 2); \
                _Pragma("unroll") for (int mb = 0; mb < 4; ++mb) { _Pragma("unroll") for (int nb = 0; nb < 2; ++nb) acc[mb][nb] = MFMA_BF16(af[mb], bfr[nb], acc[mb][nb]); } \
            }                                                                                                                              \
        }                                                                                                                                  \
        __syncthreads();                                                                                                                   \
    }

struct AttnSt { float m, l; f32x16 o0, o1; };

struct AttnFr { bf16x8 k[4]; bf16x8 v[4]; };
__device__ __forceinline__ void attn_load(AttnFr& f, const u16* krow, const u16* vt, size_t vt_dstride) {
#pragma unroll
    for (int d0 = 0; d0 < 4; ++d0) f.k[d0] = *(const bf16x8*)(krow + d0 * 16);
    const u16* vt1 = vt + 32 * vt_dstride;
    union { bf16x8 v; u32x2 h[2]; } va;
    va.h[0] = *(const u32x2*)(vt);       va.h[1] = *(const u32x2*)(vt + 8);   f.v[0] = va.v;
    va.h[0] = *(const u32x2*)(vt + 16);  va.h[1] = *(const u32x2*)(vt + 24);  f.v[1] = va.v;
    va.h[0] = *(const u32x2*)(vt1);      va.h[1] = *(const u32x2*)(vt1 + 8);  f.v[2] = va.v;
    va.h[0] = *(const u32x2*)(vt1 + 16); va.h[1] = *(const u32x2*)(vt1 + 24); f.v[3] = va.v;
}
template <bool MASK = true>
__device__ __forceinline__ void attn_compute(AttnSt& st, const bf16x8 (&qf)[4], const AttnFr& f, int dist0, float bslope, int dlo, int dhi, int hi, int lane) {
    f32x16 p;
#pragma unroll
    for (int r = 0; r < 16; ++r) p[r] = 0.f;
#pragma unroll
    for (int d0 = 0; d0 < 4; ++d0) p = MFMA_BF16(f.k[d0], qf[d0], p);
    constexpr float C2 = 0.125f * LOG2E;
    float mx = NEGV;
    const float bbase = -bslope * (float)dist0;
#pragma unroll
    for (int r = 0; r < 16; ++r) {
        const float sc = __builtin_fmaf(p[r], C2, __builtin_fmaf(bslope, (float)((r & 3) + 8 * (r >> 2)), bbase));
        float s_ = sc;
        if (MASK) { const int dist = dist0 - ((r & 3) + 8 * (r >> 2)); s_ = (dist >= dlo && dist <= dhi) ? sc : NEGV; }
        p[r] = s_; mx = fmaxf(mx, s_);
    }
    mx = fmaxf(mx, shxf(mx, 32, lane));
    const float mnew = fmaxf(st.m, mx);
    const float alpha = __builtin_amdgcn_exp2f(st.m - mnew);
    st.m = mnew;
    float ls = 0.f;
#pragma unroll
    for (int r = 0; r < 16; ++r) { p[r] = __builtin_amdgcn_exp2f(p[r] - mnew); ls += p[r]; }
    st.l = st.l * alpha + ls;
#pragma unroll
    for (int r = 0; r < 16; ++r) { st.o0[r] *= alpha; st.o1[r] *= alpha; }
    union { bf16x8 v; unsigned u[4]; } pb0, pb1;
#pragma unroll
    for (int j = 0; j < 4; ++j) { pb0.u[j] = cvtpk(p[2 * j], p[2 * j + 1]); pb1.u[j] = cvtpk(p[8 + 2 * j], p[8 + 2 * j + 1]); }
    st.o0 = MFMA_BF16(f.v[0], pb0.v, st.o0);
    st.o0 = MFMA_BF16(f.v[1], pb1.v, st.o0);
    st.o1 = MFMA_BF16(f.v[2], pb0.v, st.o1);
    st.o1 = MFMA_BF16(f.v[3], pb1.v, st.o1);
    (void)hi;
}

__device__ __forceinline__ float dpp_rowmax(float v) {
    v = fmaxf(v, __int_as_float(__builtin_amdgcn_update_dpp(0, __float_as_int(v), 0xB1, 0xF, 0xF, true)));
    v = fmaxf(v, __int_as_float(__builtin_amdgcn_update_dpp(0, __float_as_int(v), 0x4E, 0xF, 0xF, true)));
    v = fmaxf(v, __int_as_float(__builtin_amdgcn_update_dpp(0, __float_as_int(v), 0x141, 0xF, 0xF, true)));
    v = fmaxf(v, __int_as_float(__builtin_amdgcn_update_dpp(0, __float_as_int(v), 0x140, 0xF, 0xF, true)));
    return v;
}
__device__ __forceinline__ int dpp_rowmin_i(int v) {
    v = min(v, __builtin_amdgcn_update_dpp(0, v, 0xB1, 0xF, 0xF, true));
    v = min(v, __builtin_amdgcn_update_dpp(0, v, 0x4E, 0xF, 0xF, true));
    v = min(v, __builtin_amdgcn_update_dpp(0, v, 0x141, 0xF, 0xF, true));
    v = min(v, __builtin_amdgcn_update_dpp(0, v, 0x140, 0xF, 0xF, true));
    return v;
}
__device__ __forceinline__ float rl_f(float v, int l) { return __int_as_float(__builtin_amdgcn_readlane(__float_as_int(v), l)); }

__device__ __forceinline__ void top3_insert(float v, int i, float& v0, int& i0, float& v1, int& i1, float& v2, int& i2) {
    const bool b0 = (v > v0) || (v == v0 && i < i0);
    const bool b1 = (v > v1) || (v == v1 && i < i1);
    const bool b2 = (v > v2) || (v == v2 && i < i2);
    const float nv2 = b1 ? v1 : (b2 ? v : v2); const int ni2 = b1 ? i1 : (b2 ? i : i2);
    const float nv1 = b0 ? v0 : (b1 ? v : v1); const int ni1 = b0 ? i0 : (b1 ? i : i1);
    const float nv0 = b0 ? v : v0;             const int ni0 = b0 ? i : i0;
    v0 = nv0; i0 = ni0; v1 = nv1; i1 = ni1; v2 = nv2; i2 = ni2;
}

__device__ __forceinline__ void ln_row(float (&v)[16], const float* __restrict__ g, const float* __restrict__ b, int lane) {
    float s = 0.f;
#pragma unroll
    for (int i = 0; i < 16; ++i) s += v[i];
    const float mu = wave_sum(s) * (1.f / D);
    float q = 0.f;
#pragma unroll
    for (int i = 0; i < 16; ++i) { const float d = v[i] - mu; q += d * d; }
    const float rstd = rsqrtf(wave_sum(q) * (1.f / D) + LN_EPS);
#pragma unroll
    for (int j = 0; j < 4; ++j) {
        const f32x4 gg = *(const f32x4*)(g + j * 256 + lane * 4), bb = *(const f32x4*)(b + j * 256 + lane * 4);
#pragma unroll
        for (int c = 0; c < 4; ++c) v[j * 4 + c] = (v[j * 4 + c] - mu) * rstd * gg[c] + bb[c];
    }
}

typedef __attribute__((ext_vector_type(2))) float f32x2_;
__device__ __forceinline__ bf16x8 fp8x8_to_bf16(unsigned lo, unsigned hi_) {
    const f32x2_ a = __builtin_amdgcn_cvt_pk_f32_fp8((int)lo, false), b = __builtin_amdgcn_cvt_pk_f32_fp8((int)lo, true);
    const f32x2_ c = __builtin_amdgcn_cvt_pk_f32_fp8((int)hi_, false), d = __builtin_amdgcn_cvt_pk_f32_fp8((int)hi_, true);
    union { bf16x8 v; unsigned u[4]; } r;
    r.u[0] = cvtpk(a[0], a[1]); r.u[1] = cvtpk(b[0], b[1]); r.u[2] = cvtpk(c[0], c[1]); r.u[3] = cvtpk(d[0], d[1]);
    return r.v;
}
__device__ __forceinline__ unsigned pack_fp8x4(float a, float b, float c, float d) { int p = __builtin_amdgcn_cvt_pk_fp8_f32(a, b, 0, false); return (unsigned)__builtin_amdgcn_cvt_pk_fp8_f32(c, d, p, true); }

constexpr float Y8_SCALE = 16.f;
constexpr int MOE_XCAP = 576;
#define MOE_GAS __attribute__((address_space(1)))
typedef MOE_GAS unsigned char moe_gcb;
constexpr int MOE_BP = 72;
constexpr int MOE_BSTAGE = 128 * MOE_BP * 2;
constexpr int MOE_LDS_VA = 3 * MOE_BSTAGE;
constexpr int MOE_LDS_W = MOE_LDS_VA + 4096;
constexpr int MOE_LDS_XCH = 65536;
template <bool DOWN>
__device__ __forceinline__ void moe_expert(LAS char* lds, const int tid, const int lane, const int wave, const int r32, const int hi,
                                           const unsigned char* __restrict__ abase  , const float* __restrict__ w0, const float* __restrict__ w1, const int ng  , void* __restrict__ outv,
                                           const int pass0, const int npass_, const int st0, const int nstl  , const bool y8 = false  ,
                                           const bool xr = false  ) {
    constexpr int KT = DOWN ? 4 : 16, NP = DOWN ? 8 : 4, LDB = DOWN ? 1024 : 256, APITCH = DOWN ? 256 : 1024  , PSTEP = DOWN ? 128 : 64;
    LAS int* rowva = (LAS int*)(lds + MOE_LDS_VA); LAS float* roww = (LAS float*)(lds + MOE_LDS_W);
    const int nst = nstl;
    const int nsteps = npass_ * nst * KT; (void)NP;
    unsigned aoff[2];
#define MOE_AOFF(ST_) { _Pragma("unroll") for (int a = 0; a < 2; ++a) { const int va_ = rowva[(ST_) * 512 + wave * 64 + a * 32 + r32]; \
        const int srow_ = DOWN ? va_ : (va_ == TRASH_VA ? 0 : (va_ >> 3)); aoff[a] = (unsigned)srow_ * APITCH + hi * 32; } }
    const int seg = wave >> 1, n4 = lane & 7, kp = (wave & 1) * 16 + (lane >> 3);
    const char* wbase = (const char*)(DOWN ? (w0 + seg * 32) : (((seg < 2) ? w0 : w1) + (seg & 1) * 32));
    unsigned boff = (unsigned)(4 * n4 + 2 * kp * LDB) * 4u; asm volatile("" : "+v"(boff));
    unsigned wb_ = (unsigned)((seg * 32 + n4) * MOE_BP + 2 * kp) * 2u; asm volatile("" : "+v"(wb_));
    unsigned lb_ = (unsigned)(r32 * MOE_BP + hi * 32) * 2u; asm volatile("" : "+v"(lb_));
    f32x16 acc[2][4];
#pragma unroll
    for (int a = 0; a < 2; ++a)
#pragma unroll
        for (int c = 0; c < 4; ++c)
#pragma unroll
            for (int r = 0; r < 16; ++r) acc[a][c][r] = 0.f;
    u32x4 fa8[2][2];
    f32x16 accx; u32x4 fa8x[2]; unsigned aoffx = 0u;
#pragma unroll
    for (int r = 0; r < 16; ++r) accx[r] = 0.f;
    fa8x[0] = u32x4{0u, 0u, 0u, 0u}; fa8x[1] = u32x4{0u, 0u, 0u, 0u};
    f32x4 rb0[4], rb1[4];
#define MOE_DEC(S_) const int s2_ = (S_) < nsteps ? (S_) : 0; const int pl_ = s2_ / (nst * KT); const int rm_ = s2_ - pl_ * (nst * KT); const int sl_ = rm_ / KT; const int kt_ = rm_ - sl_ * KT; const int ps_ = pass0 + pl_; const int stt_ = st0 + sl_;
#define MOE_LOADB(S_, RB) { MOE_DEC(S_) (void)stt_; \
        uint64_t wu_ = (uint64_t)(wbase + (size_t)(ps_ * PSTEP + kt_ * 64 * LDB) * 4), wv_ = wu_ + 16 * LDB * 4; asm volatile("" : "+s"(wu_), "+s"(wv_));     \
        const moe_gcb* wug_ = (const moe_gcb*)wu_; const moe_gcb* wvg_ = (const moe_gcb*)wv_; \
        unsigned bo_ = boff; asm volatile("" : "+v"(bo_));     \
        RB[0] = *(const MOE_GAS f32x4*)(wug_ + bo_); RB[1] = *(const MOE_GAS f32x4*)(wug_ + bo_ + LDB * 4); RB[2] = *(const MOE_GAS f32x4*)(wvg_ + bo_); RB[3] = *(const MOE_GAS f32x4*)(wvg_ + bo_ + LDB * 4); }
#define MOE_WRITEB(STG, RB) { LAS char* Bs_ = lds + (STG) * MOE_BSTAGE; \
        _Pragma("unroll") for (int i = 0; i < 4; ++i) { LAS unsigned* q_ = (LAS unsigned*)(Bs_ + wb_ + i * (8 * MOE_BP * 2)); q_[0] = cvtpk(RB[0][i], RB[1][i]); q_[8] = cvtpk(RB[2][i], RB[3][i]); } }
#define MOE_COMPUTE(STG, DO_MFMA) { LAS char* Bs_ = lds + (STG) * MOE_BSTAGE; \
        _Pragma("unroll") for (int u = 0; u < 4; ++u) { \
            bf16x8 bfr[4]; \
            if (DO_MFMA) { _Pragma("unroll") for (int c = 0; c < 4; ++c) bfr[c] = *(LAS bf16x8*)(Bs_ + lb_ + (c * 32 * MOE_BP + u * 8) * 2); } \
            _Pragma("unroll") for (int a = 0; a < 2; ++a) { \
                if (DO_MFMA) { const bf16x8 af_ = fp8x8_to_bf16(fa8[a][u >> 1][(u & 1) * 2], fa8[a][u >> 1][(u & 1) * 2 + 1]); \
                    _Pragma("unroll") for (int c = 0; c < 4; ++c) acc[a][c] = MFMA_BF16(bfr[c], af_, acc[a][c]); } \
            } \
        } }
      \
#define MOE_RELOAD { _Pragma("unroll") for (int a = 0; a < 2; ++a) { unsigned ao_ = aoff[a]; asm volatile("" : "+v"(ao_)); \
            fa8[a][0] = *(const MOE_GAS u32x4*)(ab_n + ao_); fa8[a][1] = *(const MOE_GAS u32x4*)(ab_n + ao_ + 16); } }
#define MOE_XCOMPUTE(STG) if (!DOWN) { LAS char* Bs_ = lds + (STG) * MOE_BSTAGE; \
        _Pragma("unroll") for (int u = 0; u < 4; ++u) { \
            const bf16x8 ax_ = fp8x8_to_bf16(fa8x[u >> 1][(u & 1) * 2], fa8x[u >> 1][(u & 1) * 2 + 1]); \
            if (u & 1) { unsigned ao_ = aoffx; asm volatile("" : "+v"(ao_)); fa8x[u >> 1] = *(const MOE_GAS u32x4*)(ab_n + ao_ + (u >> 1) * 16); } \
            const bf16x8 bx_ = *(LAS bf16x8*)(Bs_ + (wave & 3) * (32 * MOE_BP * 2) + lb_ + u * 16); \
            accx = MFMA_BF16(bx_, ax_, accx); } }
#define MOE_NEXTA(S_) MOE_DEC(S_) (void)ps_; \
        if (stt_ != st_loaded) { MOE_AOFF(stt_) st_loaded = stt_; } \
        uint64_t abn_ = (uint64_t)abase + kt_ * 64; asm volatile("" : "+s"(abn_)); const moe_gcb* ab_n = (const moe_gcb*)abn_;
    int st_loaded = st0;
    MOE_AOFF(st0)
    { const char* ab0 = (const char*)abase;
#pragma unroll
      for (int a = 0; a < 2; ++a)
#pragma unroll
          for (int h2 = 0; h2 < 2; ++h2) fa8[a][h2] = *(const u32x4*)(ab0 + aoff[a] + h2 * 16); }
    if (!DOWN) {
        const int vax_ = xr ? rowva[512 + 32 * (wave >> 2) + r32] : TRASH_VA; aoffx = (unsigned)(vax_ == TRASH_VA ? 0 : (vax_ >> 3)) * APITCH + hi * 32;
        fa8x[0] = *(const u32x4*)((const char*)abase + aoffx); fa8x[1] = *(const u32x4*)((const char*)abase + aoffx + 16); }
    MOE_LOADB(0, rb0)
    MOE_LOADB(1, rb1)
    MOE_WRITEB(0, rb0)
    MOE_LOADB(2, rb0)
    int stg = 0;
#pragma unroll 1
    for (int sidx = 0; sidx < nsteps; sidx += 2) {
        const int pl = sidx / (nst * KT); const int rm = sidx - pl * (nst * KT); const int sl = rm / KT; const int kt = rm - sl * KT; const int ps = pass0 + pl, stt = st0 + sl;
        const bool wv = (wave * 64) < (ng - stt * 512);
        const int stg1 = stg == 2 ? 0 : stg + 1, stg2 = stg1 == 2 ? 0 : stg1 + 1;
        __syncthreads();
        MOE_WRITEB(stg1, rb1)
        MOE_LOADB(sidx + 3, rb1)
        { MOE_NEXTA(sidx + 1)
          if (wv) MOE_COMPUTE(stg, true)
          MOE_RELOAD
          MOE_XCOMPUTE(stg) }
        __syncthreads();
        MOE_WRITEB(stg2, rb0)
        MOE_LOADB(sidx + 4, rb0)
        { MOE_NEXTA(sidx + 2)
          if (wv) MOE_COMPUTE(stg1, true)
          MOE_RELOAD
          MOE_XCOMPUTE(stg1) }
        stg = stg2;
        if (kt == KT - 2) {
            const int le_ = lane_id_(); const int lane = le_, r32 = le_ & 31, hi = le_ >> 5; (void)lane;
            if (wv) {
                const int nrows = ng - stt * 512;
#pragma unroll
                for (int a = 0; a < 2; ++a) {
                    if (a == 0 || (wave * 64 + 32) < nrows) {
                        const int lrow = stt * 512 + wave * 64 + a * 32 + r32;
                        const unsigned va = (unsigned)rowva[lrow];
                        if (DOWN) {
                            const float w = roww[lrow];
#pragma unroll
                            for (int c = 0; c < 4; ++c) {
                                float yv_[16];
#pragma unroll
                                for (int j = 0; j < 16; ++j) yv_[j] = acc[a][c][(j >> 2) + 4 * (j & 3)] * w;
                                if (y8) {
                                    u32x4 q8;
#pragma unroll
                                    for (int jj = 0; jj < 4; ++jj) q8[jj] = pack_fp8x4(yv_[4 * jj], yv_[4 * jj + 1], yv_[4 * jj + 2], yv_[4 * jj + 3]);
                                    *(u32x4*)((unsigned char*)outv + (size_t)va * D + ps * 128 + c * 32 + 16 * hi) = q8;
                                } else {
                                    u32x4 q0, q1;
#pragma unroll
                                    for (int jj = 0; jj < 4; ++jj) { q0[jj] = cvtpk(yv_[2 * jj], yv_[2 * jj + 1]); q1[jj] = cvtpk(yv_[8 + 2 * jj], yv_[9 + 2 * jj]); }
                                    u16* o = (u16*)outv + (size_t)va * D + ps * 128 + c * 32 + 16 * hi;
                                    *(u32x4*)o = q0; *(u32x4*)(o + 8) = q1;
                                }
                            }
                        } else {
#pragma unroll
                            for (int c = 0; c < 2; ++c) {
                                float hv[16];
#pragma unroll
                                for (int j = 0; j < 16; ++j) { const int r = (j >> 2) + 4 * (j & 3); const float gt = acc[a][c][r], up = acc[a][c + 2][r]; hv[j] = gt / (1.f + __expf(-gt)) * up; }
                                u32x4 q;
#pragma unroll
                                for (int jj = 0; jj < 4; ++jj) q[jj] = pack_fp8x4(hv[4 * jj], hv[4 * jj + 1], hv[4 * jj + 2], hv[4 * jj + 3]);
                                *(u32x4*)((unsigned char*)outv + (size_t)va * DF + ps * 64 + c * 32 + 16 * hi) = q;
                            }
                        }
                    }
                }
#pragma unroll
                for (int a = 0; a < 2; ++a)
#pragma unroll
                    for (int c = 0; c < 4; ++c)
#pragma unroll
                        for (int r = 0; r < 16; ++r) acc[a][c][r] = 0.f;
            }
            if (!DOWN) { if (xr) {
                LAS float* xch = (LAS float*)(lds + MOE_LDS_XCH) + ((wave >> 2) * 2 + (wave & 1)) * 1024 + lane;
                if ((wave & 3) >= 2) {
#pragma unroll
                    for (int r = 0; r < 16; ++r) xch[r * 64] = accx[r];
                }
                __syncthreads();
                if ((wave & 3) < 2) {
                    const unsigned vax = (unsigned)rowva[512 + 32 * (wave >> 2) + r32];
                    u32x4 q;
#pragma unroll
                    for (int jj = 0; jj < 4; ++jj) {
#pragma unroll
                        for (int i = 0; i < 4; ++i) { const int r = jj + 4 * i; const float gt = accx[r]; accx[r] = gt / (1.f + __expf(-gt)) * xch[r * 64]; }
                        q[jj] = pack_fp8x4(accx[jj], accx[jj + 4], accx[jj + 8], accx[jj + 12]);
                    }
                    *(u32x4*)((unsigned char*)outv + (size_t)vax * DF + ps * 64 + (wave & 3) * 32 + 16 * hi) = q;
                }
                }
#pragma unroll
                for (int r = 0; r < 16; ++r) accx[r] = 0.f;
            }
        }
    }
    __syncthreads();
#undef MOE_XCOMPUTE
#undef MOE_AOFF
#undef MOE_DEC
#undef MOE_LOADB
#undef MOE_WRITEB
#undef MOE_COMPUTE
#undef MOE_RELOAD
#undef MOE_NEXTA
}

constexpr int Q8_BP = 144;
constexpr int Q8_BSTAGE = 128 * Q8_BP;
typedef __attribute__((ext_vector_type(8))) int q8_i32x8;
template <int NCH>
__device__ __forceinline__ void qkv8_item(LAS char* lds, const int wave, const unsigned char* __restrict__ a8  , const unsigned char* __restrict__ w8  ,
                                          u16* __restrict__ outp  , const int ldc,
                                          const int rot  ) {
    constexpr int NSTEPS = NCH * 8;
    const int l0 = lane_id_(); const int r32 = l0 & 31, hi = l0 >> 5;
    unsigned aoff[2];
#pragma unroll
    for (int a = 0; a < 2; ++a) { aoff[a] = (unsigned)(wave * 64 + a * 32 + r32) * 1024u + hi * 32; asm volatile("" : "+v"(aoff[a])); }
    const int t_ = wave * 64 + l0, col_ = t_ >> 2, p_ = t_ & 3, kap_ = col_ & 31;
    unsigned boff = (unsigned)col_ * 1024u + p_ * 32; asm volatile("" : "+v"(boff));
    unsigned wb = (unsigned)((col_ & ~31) + (kap_ & 3) * 8 + (kap_ >> 2)) * Q8_BP + p_ * 32; asm volatile("" : "+v"(wb));
    unsigned lb = (unsigned)r32 * Q8_BP + hi * 32; asm volatile("" : "+v"(lb));
    f32x16 acc[2][4];
#pragma unroll
    for (int a = 0; a < 2; ++a)
#pragma unroll
        for (int c = 0; c < 4; ++c)
#pragma unroll
            for (int r = 0; r < 16; ++r) acc[a][c][r] = 0.f;
    u32x4 fa0[2][2][2], fa1[2][2][2];
    u32x4 rb0[2], rb1[2];
#define Q8_LOADA(FA, S_) { const int s2_ = (S_) < NSTEPS ? (S_) : 0; uint64_t ab_ = (uint64_t)a8 + ((s2_ + rot) & 7) * 128; asm volatile("" : "+s"(ab_)); const moe_gcb* ag_ = (const moe_gcb*)ab_; \
        _Pragma("unroll") for (int a = 0; a < 2; ++a) { unsigned ao_ = aoff[a]; asm volatile("" : "+v"(ao_)); \
            _Pragma("unroll") for (int kk = 0; kk < 2; ++kk) { FA[a][kk][0] = *(const MOE_GAS u32x4*)(ag_ + ao_ + kk * 64); FA[a][kk][1] = *(const MOE_GAS u32x4*)(ag_ + ao_ + kk * 64 + 16); } } }
#define Q8_LOADB(RB, S_) { const int s2_ = (S_) < NSTEPS ? (S_) : 0; uint64_t wu_ = (uint64_t)w8 + (size_t)(s2_ >> 3) * 131072 + ((s2_ + rot) & 7) * 128; asm volatile("" : "+s"(wu_)); const moe_gcb* wg_ = (const moe_gcb*)wu_; \
        unsigned bo_ = boff; asm volatile("" : "+v"(bo_)); RB[0] = *(const MOE_GAS u32x4*)(wg_ + bo_); RB[1] = *(const MOE_GAS u32x4*)(wg_ + bo_ + 16); }
#define Q8_WRITEB(STG, RB) { LAS char* Bs_ = lds + (STG) * Q8_BSTAGE + wb; *(LAS u32x4*)Bs_ = RB[0]; *(LAS u32x4*)(Bs_ + 16) = RB[1]; }
#define Q8_CAT8(X0, X1) q8_i32x8{(int)(X0)[0], (int)(X0)[1], (int)(X0)[2], (int)(X0)[3], (int)(X1)[0], (int)(X1)[1], (int)(X1)[2], (int)(X1)[3]}
#define Q8_MFMA(B_, A_, C_) __builtin_amdgcn_mfma_scale_f32_32x32x64_f8f6f4(B_, A_, C_, 0, 0, 0, 0x7F79  , 1, 0x7F79  )
#define Q8_COMPUTE(STG, FA) { LAS char* Bs_ = lds + (STG) * Q8_BSTAGE + lb; \
        _Pragma("unroll") for (int kk = 0; kk < 2; ++kk) { const q8_i32x8 af0_ = Q8_CAT8(FA[0][kk][0], FA[0][kk][1]), af1_ = Q8_CAT8(FA[1][kk][0], FA[1][kk][1]); \
            _Pragma("unroll") for (int c = 0; c < 4; ++c) { const u32x4 b0_ = *(LAS u32x4*)(Bs_ + c * 32 * Q8_BP + kk * 64), b1_ = *(LAS u32x4*)(Bs_ + c * 32 * Q8_BP + kk * 64 + 16); const q8_i32x8 bf_ = Q8_CAT8(b0_, b1_); \
                acc[0][c] = Q8_MFMA(bf_, af0_, acc[0][c]); acc[1][c] = Q8_MFMA(bf_, af1_, acc[1][c]); } } }
    Q8_LOADB(rb0, 0)
    Q8_WRITEB(0, rb0)
    Q8_LOADB(rb1, 1)
    Q8_LOADA(fa0, 0)
    Q8_LOADB(rb0, 2)
    Q8_LOADA(fa1, 1)
    int stg = 0;
#pragma unroll 1
    for (int s = 0; s < NSTEPS; s += 2) {
        const int stg1 = stg == 2 ? 0 : stg + 1, stg2 = stg1 == 2 ? 0 : stg1 + 1;
        __syncthreads();
        Q8_WRITEB(stg1, rb1)
        Q8_LOADB(rb1, s + 3)
        Q8_COMPUTE(stg, fa0)
        Q8_LOADA(fa0, s + 2)
        __syncthreads();
        Q8_WRITEB(stg2, rb0)
        Q8_LOADB(rb0, s + 4)
        Q8_COMPUTE(stg1, fa1)
        Q8_LOADA(fa1, s + 3)
        stg = stg2;
        if ((s & 7) == 6) {
            const int cl = s >> 3;
            const int le_ = lane_id_(); const int r32e = le_ & 31, hie = le_ >> 5;
#pragma unroll
            for (int a = 0; a < 2; ++a) {
                u16* orow = outp + (size_t)(wave * 64 + a * 32 + r32e) * ldc + cl * 128 + 16 * hie;
#pragma unroll
                for (int c = 0; c < 4; ++c) {
                    u32x4 q0, q1;
#pragma unroll
                    for (int jj = 0; jj < 4; ++jj) { q0[jj] = cvtpk(acc[a][c][((2 * jj) >> 2) + 4 * ((2 * jj) & 3)], acc[a][c][((2 * jj + 1) >> 2) + 4 * ((2 * jj + 1) & 3)]);
                                                     q1[jj] = cvtpk(acc[a][c][((8 + 2 * jj) >> 2) + 4 * ((8 + 2 * jj) & 3)], acc[a][c][((9 + 2 * jj) >> 2) + 4 * ((9 + 2 * jj) & 3)]); }
                    *(u32x4*)(orow + c * 32) = q0; *(u32x4*)(orow + c * 32 + 8) = q1;
                }
            }
#pragma unroll
            for (int a = 0; a < 2; ++a)
#pragma unroll
                for (int c = 0; c < 4; ++c)
#pragma unroll
                    for (int r = 0; r < 16; ++r) acc[a][c][r] = 0.f;
        }
    }
    __syncthreads();
#undef Q8_LOADA
#undef Q8_LOADB
#undef Q8_WRITEB
#undef Q8_CAT8
#undef Q8_MFMA
#undef Q8_COMPUTE
}

constexpr int N_PHASES = 21;

#define P_x_in CTX_IN(0)
#define P_xb ((u16*)(ws + WS_XB))
#define P_x1 ((float*)(ws + WS_X1))
#define P_x2 ((float*)(ws + WS_X2))
#define P_ypre ((u16*)(ws + WS_YPRE))
#define P_qkv ((u16*)(ws + WS_QKV))
#define P_vT ((u16*)(ws + WS_VT))
#define P_kmean ((float*)(ws + WS_KM))
#define P_ao ((u16*)(ws + WS_AO))
#define P_og ((u16*)(ws + WS_OG))
#define P_lse ((float*)(ws + WS_LSE))
#define P_topw ((float*)(ws + WS_TOPW))
#define P_list ((int*)(ws + WS_LIST))
#define P_hb ((u16*)(ws + WS_HB))
#define P_yb ((u16*)(ws + WS_YB))
#define P_cnt_all ((int*)(ws + WS_CTL + CTL_ECNT_OFF))
#define P_xb8 ((unsigned char*)(ws + WS_XB8))
#define P_hbs ((u16*)(ws + WS_HBS))
#define P_xq8 ((unsigned char*)(ws + WS_XQ8))
#define P_wq8 ((unsigned char*)(ws + WS_WQ8))
#define P_wo8 ((unsigned char*)(ws + WS_WO8))
#define P_selm ((unsigned*)(ws + WS_SELM))
#define P_part ((u16*)(ws + WS_PART))
#define P_plse ((float*)(ws + WS_PLSE))
#define PH_BEGIN int tid = wave_s_ * 64 + lane_id_(); asm volatile("" : "+v"(tid)); const int lane = tid & 63, r32 = lane & 31, hi = lane >> 5; const int wave = __builtin_amdgcn_readfirstlane(tid >> 6); (void)lane; (void)r32; (void)hi; (void)wave
constexpr int LDS_CTX = LDS_BAR + 16;
__device__ __forceinline__ uint64_t ctx_ld(int i) {
    extern __shared__ __attribute__((aligned(16))) unsigned char lds_raw[];
    const LAS unsigned* q = (const LAS unsigned*)((LAS char*)lds_raw + LDS_CTX) + 2 * i;
    const unsigned lo = __builtin_amdgcn_readfirstlane(q[0]), hi = __builtin_amdgcn_readfirstlane(q[1]);
    return ((uint64_t)hi << 32) | lo;
}
typedef __attribute__((address_space(1))) unsigned char gbyte;
#define AS_GLOBAL(T, u64v) ((T*)(gbyte*)(u64v))
#define CTX_IN(i) AS_GLOBAL(const float, ctx_ld(i))
#define PH_FN_BEGIN \
    extern __shared__ __attribute__((aligned(16))) unsigned char lds_raw[]; \
    LAS char* lds = (LAS char*)lds_raw; (void)lds; \
    const int G = gridDim.x, bid = blockIdx.x; (void)G; (void)bid; \
    unsigned char* const ws = AS_GLOBAL(unsigned char, ctx_ld(17)); (void)ws; \
    const int NQ = L == 0 ? 3072 : 9216; (void)NQ; \
    int* cnt = P_cnt_all + L * NE * CNT_STRIDE; (void)cnt;
__device__ __forceinline__ void ph_p0(int L, int rep_, const int wave_s_) {
    PH_FN_BEGIN
    (void)rep_;
    PH_BEGIN;
    for (size_t i = (size_t)bid * NTHR + tid; i < (size_t)T * D / 4; i += (size_t)G * NTHR) {
        const f32x4 v = *(const f32x4*)(P_x_in + i * 4);
        u32x2 w; w[0] = cvtpk(v[0], v[1]); w[1] = cvtpk(v[2], v[3]);
        *(u32x2*)(P_xb + i * 4) = w;
#if QKV_FP8
        *(unsigned*)(P_xq8 + i * 4) = pack_fp8x4(v[0], v[1], v[2], v[3]);
#endif
    }
    for (int i = bid * NTHR + tid; i < BATCH * NH * MOBA_NB * 64 / 4; i += G * NTHR) *(f32x4*)(P_kmean + (size_t)i * 4) = f32x4{0.f, 0.f, 0.f, 0.f};
    LAS float* tl = (LAS float*)lds;
    for (int it = bid; it < 3968 + 128; it += G) {
        int seg, kt;
        if (it < 3840) { seg = it >> 4; kt = it & 15; } else if (it < 3968) { seg = 240 + ((it - 3840) >> 2); kt = (it - 3840) & 3; } else { seg = 272 + ((it - 3968) >> 4); kt = (it - 3968) & 15; }
        const float* src; int ld; u16* dst; int Kd = 1024; u16* dst_lo = nullptr; int rcol = 0; unsigned char* dst8 = nullptr;
        if (seg < 48) { const int col = 64 * seg; src = CTX_IN(1) + col; ld = 3072; dst = (u16*)(ws + WS_WQK0) + (size_t)col * 1024; if (QKV_FP8) dst8 = P_wq8 + (size_t)col * 1024; }
        else if (seg < 192) { const int col = 64 * (seg - 48); src = CTX_IN(2) + col; ld = 9216; dst = (u16*)(ws + WS_WQK1) + (size_t)col * 1024; if (QKV_FP8) dst8 = P_wq8 + (size_t)(3072 + col) * 1024; }
        else if (seg < 224) { const int s2 = seg - 192, l2 = s2 >> 4, col = 64 * (s2 & 15); src = CTX_IN(3) + (size_t)l2 * D * D + col; ld = 1024; dst = (u16*)(ws + WS_WO) + (size_t)l2 * D * D + (size_t)col * 1024; if (WO_FP8) dst8 = P_wo8 + (size_t)l2 * D * D + (size_t)col * 1024; }
        else if (seg < 240) { const int s2 = seg - 224, l2 = s2 >> 3, i8 = s2 & 7, un = i8 >> 2, q = i8 & 3;
            src = (q < 2 ? CTX_IN(11) : CTX_IN(12)) + (size_t)l2 * D * DF + un * 128 + 64 * (q & 1); ld = 256; dst = (u16*)(ws + WS_WSGU) + (size_t)l2 * 512 * 1024 + (size_t)(64 * i8) * 1024; }
        else if (seg < 272) { const int s2 = seg - 240, l2 = s2 >> 4, col = 64 * (s2 & 15); src = CTX_IN(13) + (size_t)l2 * DF * D + col; ld = 1024; Kd = 256; dst = (u16*)(ws + WS_WSD) + (size_t)l2 * D * DF + (size_t)col * 256; }
        else { const int s2 = seg - 272, l2 = s2 >> 2, col = 64 * (s2 & 3); src = CTX_IN(6) + (size_t)l2 * D * NE + col; ld = 256; rcol = col; dst = (u16*)(ws + WS_WRH) + (size_t)l2 * NE * D; dst_lo = (u16*)(ws + WS_WRL) + (size_t)l2 * NE * D; }
        {
            const int kr = tid >> 4, c4 = tid & 15;
#pragma unroll
            for (int i = 0; i < 2; ++i) {
                const f32x4 v = *(const f32x4*)(src + (size_t)(kt * 64 + kr + 32 * i) * ld + 4 * c4);
#pragma unroll
                for (int jj = 0; jj < 4; ++jj) tl[(kr + 32 * i) * 65 + 4 * c4 + jj] = v[jj];
            }
        }
        __syncthreads();
        {
            const int row = tid >> 3, kc = tid & 7;
            float f[8];
#pragma unroll
            for (int jj = 0; jj < 8; ++jj) f[jj] = tl[(8 * kc + jj) * 65 + row];
            u32x4 w; w[0] = cvtpk(f[0], f[1]); w[1] = cvtpk(f[2], f[3]); w[2] = cvtpk(f[4], f[5]); w[3] = cvtpk(f[6], f[7]);
            if (dst_lo) {
                u32x4 wl;
#pragma unroll
                for (int jj = 0; jj < 4; ++jj) wl[jj] = cvtpk(f[2 * jj] - bf2f(w[jj] & 0xFFFFu), f[2 * jj + 1] - bf2f(w[jj] >> 16));
                const int E_ = rcol + row;
                const size_t fi = ((size_t)(((E_ >> 5) * 16 + kt) * 4 + (kc >> 1)) * 64 + (kc & 1) * 32 + (E_ & 31)) * 8;
                *(u32x4*)(dst + fi) = w; *(u32x4*)(dst_lo + fi) = wl;
            } else if (dst8) {
                u32x2 w8; w8[0] = pack_fp8x4(f[0] * 64.f, f[1] * 64.f, f[2] * 64.f, f[3] * 64.f); w8[1] = pack_fp8x4(f[4] * 64.f, f[5] * 64.f, f[6] * 64.f, f[7] * 64.f);
                *(u32x2*)(dst8 + (size_t)row * 1024 + kt * 64 + 8 * kc) = w8;
            } else *(u32x4*)(dst + (size_t)row * Kd + kt * 64 + 8 * kc) = w;
        }
        __syncthreads();
    }
}

__device__ __forceinline__ void ph_qkv(int L, int rep_, const int wave_s_) {
    PH_FN_BEGIN
    (void)rep_;
#if QKV_FP8 == 2
    const pg8::Gemm g{(const u16*)P_xq8, (const u16*)(P_wq8 + (L == 0 ? (size_t)0 : (size_t)3072 * 1024)), T, NQ, D / 2};
    pg8::StaticOrder S; S.init(g.M, g.N, G, bid);
    const EpiQK E{P_qkv, NQ, L == 0 ? P_kmean : nullptr};
    pg8::gemm_phase<EpiQK, pg8::StaticOrder, false, false, true>((PG8_LAS unsigned char*)lds, g, S, E, nullptr, wave_s_ * 64 + lane_id_());
#elif QKV_FP8
    PH_BEGIN;
    const int nchunk = NQ / 384, nq = 4 * nchunk;
    const unsigned char* w8 = P_wq8 + (L == 0 ? (size_t)0 : (size_t)3072 * 1024);
    int* xq = (int*)(ws + WS_CTL + CTL_XQ_OFF) + (L * 2 + (rep_ & 1)) * 8 * 64;
    LAS int* slot = (LAS int*)(lds + 140000);
    const int xme = (int)(xb_xcc_id() & 7u);
    unsigned qdone = 0u;
    for (;;) {
        __syncthreads();
        if (tid == 0) {
            int item = -1;
            for (int k = 0; k < 8 && item < 0; ++k) {
                const int xx = (xme + k) & 7;
                if (qdone >> xx & 1u) continue;
                const int q = atomicAdd(&xq[xx * 64], 1);
                if (q < nq) item = (xx + 8 * (q / nchunk)) * nchunk + (q % nchunk); else qdone |= 1u << xx;
            }
            *slot = item;
        }
        __syncthreads();
        const int item = *slot;
        if (item < 0) break;
        const int rt = item / nchunk, ch = item - rt * nchunk;
        qkv8_item<3>(lds, wave, P_xq8 + (size_t)rt * 512 * 1024, w8 + (size_t)ch * 384 * 1024, P_qkv + (size_t)rt * 512 * NQ + ch * 384, NQ, item & 7);
    }
#else
    const pg8::Gemm g{P_xb, (const u16*)(ws + (L == 0 ? WS_WQK0 : WS_WQK1)), T, NQ, D};
    pg8::StaticOrder S; S.init(g.M, g.N, G, bid);
    const EpiQK E{P_qkv, NQ, nullptr};
    pg8::gemm_phase<EpiQK, pg8::StaticOrder, false>((PG8_LAS unsigned char*)lds, g, S, E, nullptr, wave_s_ * 64 + lane_id_());
#endif
}

__device__ __forceinline__ void ph_kmean(int L, int rep_, const int wave_s_) {
    PH_FN_BEGIN
    (void)rep_;
    PH_BEGIN;
    LAS float* red = (LAS float*)lds;
    for (int it = bid; it < BATCH * NH * MOBA_NB; it += G) {
        const int j = it & 31, h = (it >> 5) & 15, b = it >> 9;
        const int kg_ = tid >> 3, ch = tid & 7;
        const u16* kp = P_qkv + (size_t)(b * SEQ + j * MOBA_BLK + kg_) * 3072 + 1024 + h * 64 + ch * 8;
        float sm[8];
#pragma unroll
        for (int e2 = 0; e2 < 8; ++e2) sm[e2] = 0.f;
#pragma unroll
        for (int i = 0; i < 4; ++i) {
            const u32x4 v = *(const u32x4*)(kp + (size_t)(64 * i) * 3072);
#pragma unroll
            for (int e2 = 0; e2 < 4; ++e2) { sm[2 * e2] += bf2f(v[e2] & 0xFFFFu); sm[2 * e2 + 1] += bf2f(v[e2] >> 16); }
        }
#pragma unroll
        for (int e2 = 0; e2 < 8; ++e2) red[kg_ * 65 + ch * 8 + e2] = sm[e2];
        __syncthreads();
        if (tid < 64) {
            float tot = 0.f;
#pragma unroll 8
            for (int q = 0; q < 64; ++q) tot += red[q * 65 + tid];
            P_kmean[(size_t)it * 64 + tid] = tot * (1.f / MOBA_BLK);
        }
        __syncthreads();
    }
}

__device__ __forceinline__ void ph_gate(int L, int rep_, const int wave_s_) {
    PH_FN_BEGIN
    (void)rep_;
    PH_BEGIN;
    for (int it = bid; it < BATCH * NH * MOBA_NB; it += G) {
        const int qb = it & 31, bh = it >> 5, b = bh >> 4, h = bh & 15;
        const int tq = qb * MOBA_BLK + wave * 32 + r32;
        const u16* qrow = P_qkv + (size_t)(b * SEQ + tq) * 3072 + h * 64 + hi * 8;
        bf16x8 qf[4];
#pragma unroll
        for (int d0 = 0; d0 < 4; ++d0) qf[d0] = *(const bf16x8*)(qrow + d0 * 16);
        unsigned selmask = 0u;
        if (qb > 0) {
            const float* km = P_kmean + ((size_t)(b * NH + h) * MOBA_NB + r32) * 64 + hi * 8;
            f32x16 gt;
#pragma unroll
            for (int r = 0; r < 16; ++r) gt[r] = 0.f;
#pragma unroll
            for (int d0 = 0; d0 < 4; ++d0) {
                const f32x4 k0 = *(const f32x4*)(km + d0 * 16), k1 = *(const f32x4*)(km + d0 * 16 + 4);
                union { bf16x8 v; unsigned u[4]; } kf;
                kf.u[0] = cvtpk(k0[0], k0[1]); kf.u[1] = cvtpk(k0[2], k0[3]); kf.u[2] = cvtpk(k1[0], k1[1]); kf.u[3] = cvtpk(k1[2], k1[3]);
                gt = MFMA_BF16(kf.v, qf[d0], gt);
            }
            float v0 = -INFINITY, v1 = -INFINITY, v2 = -INFINITY; int i0 = 99, i1 = 99, i2 = 99;
#pragma unroll
            for (int r = 0; r < 16; ++r) { const int jb = crow(r, hi); const float gv = jb < qb ? gt[r] : -INFINITY; top3_insert(gv, jb < qb ? jb : 99, v0, i0, v1, i1, v2, i2); }
            const float ov0 = shxf(v0, 32, lane), ov1 = shxf(v1, 32, lane), ov2 = shxf(v2, 32, lane);
            const int oi0 = shxi(i0, 32, lane), oi1 = shxi(i1, 32, lane), oi2 = shxi(i2, 32, lane);
            top3_insert(ov0, oi0, v0, i0, v1, i1, v2, i2); top3_insert(ov1, oi1, v0, i0, v1, i1, v2, i2); top3_insert(ov2, oi2, v0, i0, v1, i1, v2, i2);
            if (i0 < 32) selmask |= 1u << i0;
            if (i1 < 32) selmask |= 1u << i1;
            if (i2 < 32) selmask |= 1u << i2;
        }
        if (hi == 0) P_selm[(size_t)bh * SEQ + tq] = selmask;
    }
}

constexpr int MB_KP = 72;
constexpr int MB_VP = 260;
constexpr int MB_LDS_K = 0;
constexpr int MB_LDS_V = 256 * MB_KP * 2;
constexpr int MB_LDS_LIST = MB_LDS_V + 64 * MB_VP * 2;
constexpr int MB_LDS_CTR = MB_LDS_LIST + 8192 * 2;
__device__ __forceinline__ void ph_moba(int L, int rep_, const int wave_s_) {
    PH_FN_BEGIN
    (void)rep_;
    PH_BEGIN;
    LAS char* Ks = lds + MB_LDS_K; LAS char* Vs = lds + MB_LDS_V;
    LAS u16* qlist = (LAS u16*)(lds + MB_LDS_LIST); LAS int* ctr = (LAS int*)(lds + MB_LDS_CTR);
    for (int it = bid; it < BATCH * NH * MOBA_NB; it += G) {
        const int rnd = it >> 8, w8 = it & 255, a8 = w8 >> 5, bh = w8 & 31;
        const int j = rnd == 0 ? a8 : (rnd == 1 ? 15 - a8 : (rnd == 2 ? 16 + a8 : 31 - a8));
        const int b = bh >> 4, h = bh & 15;
        const float slope2 = exp2f(-0.5f * (float)(h + 1)) * LOG2E;
        if (tid == 0) { int z0 = 0; asm volatile("" : "+v"(z0)); ctr[0] = z0; ctr[1] = z0; }
        {
            const u16* kg = P_qkv + (size_t)(b * SEQ + j * MOBA_BLK) * 3072 + 1024 + h * 64;
#pragma unroll
            for (int i = 0; i < 4; ++i) { const int c = tid + i * 512, row = c >> 3, ch = c & 7; *(LAS u32x4*)(Ks + (row * MB_KP + ch * 8) * 2) = *(const u32x4*)(kg + (size_t)row * 3072 + ch * 8); }
            const u16* vg = P_qkv + (size_t)(b * SEQ + j * MOBA_BLK) * 3072 + 2048 + h * 64;
            {
                const int kg4 = tid >> 3, ch = tid & 7;
                u32x4 v4[4];
#pragma unroll
                for (int q = 0; q < 4; ++q) v4[q] = *(const u32x4*)(vg + (size_t)(4 * kg4 + q) * 3072 + ch * 8);
#pragma unroll
                for (int e2 = 0; e2 < 4; ++e2) {
                    u32x2 wlo, whi;
                    wlo[0] = __builtin_amdgcn_perm(v4[1][e2], v4[0][e2], 0x05040100u); wlo[1] = __builtin_amdgcn_perm(v4[3][e2], v4[2][e2], 0x05040100u);
                    whi[0] = __builtin_amdgcn_perm(v4[1][e2], v4[0][e2], 0x07060302u); whi[1] = __builtin_amdgcn_perm(v4[3][e2], v4[2][e2], 0x07060302u);
                    *(LAS u32x2*)(Vs + ((ch * 8 + 2 * e2) * MB_VP + 4 * kg4) * 2) = wlo;
                    *(LAS u32x2*)(Vs + ((ch * 8 + 2 * e2 + 1) * MB_VP + 4 * kg4) * 2) = whi;
                }
            }
        }
        __syncthreads();
        {
            const unsigned* sm = P_selm + (size_t)bh * SEQ;
            for (int t0 = (j + 1) * MOBA_BLK; t0 < SEQ; t0 += 512) {
                const int t = t0 + tid;
                const bool sel = (t < SEQ) && ((sm[t < SEQ ? t : 0] >> j) & 1u);
                const unsigned long long bal = __ballot(sel);
                const int total = __popcll(bal);
                int wb = 0;
                if (lane == 0 && total) wb = atomicAdd((int*)&ctr[0], total);
                wb = __builtin_amdgcn_readfirstlane(wb);
                if (sel) qlist[wb + __popcll(bal & ((1ull << lane) - 1ull))] = (u16)t;
            }
        }
        __syncthreads();
        const int nq = ctr[0];
        const int ntiles = 8 + ((nq + 31) >> 5);
        for (;;) {
            int ti = 0;
            if (lane == 0) ti = atomicAdd((int*)&ctr[1], 1);
            ti = __builtin_amdgcn_readfirstlane(ti);
            if (ti >= ntiles) break;
            const bool own = ti < 8;
            const int wq = 7 - ti;
            const int li = (ti - 8) * 32 + r32;
            const bool valid = own || li < nq;
            const int tq = own ? j * MOBA_BLK + wq * 32 + r32 : (int)qlist[li < nq ? li : nq - 1];
            const int nsteps = own ? wq + 1 : 8;
            const u16* qrow = P_qkv + (size_t)(b * SEQ + tq) * 3072 + h * 64 + hi * 8;
            bf16x8 qf[4];
#pragma unroll
            for (int d0 = 0; d0 < 4; ++d0) qf[d0] = *(const bf16x8*)(qrow + d0 * 16);
            int slot = 3;
            if (!own) slot = __popc(P_selm[(size_t)bh * SEQ + tq] & ((1u << j) - 1u));
            AttnSt st; st.m = NEGV; st.l = 0.f;
#pragma unroll
            for (int r = 0; r < 16; ++r) { st.o0[r] = 0.f; st.o1[r] = 0.f; }
            const int dlo = own ? 0 : -0x40000000;
            for (int kt = 0; kt < nsteps; ++kt) {
                AttnFr f;
#pragma unroll
                for (int d0 = 0; d0 < 4; ++d0) f.k[d0] = *(LAS bf16x8*)(Ks + ((kt * 32 + r32) * MB_KP + d0 * 16 + hi * 8) * 2);
#pragma unroll
                for (int q4 = 0; q4 < 4; ++q4) {
                    union { bf16x8 v; u32x2 hh[2]; } va;
                    LAS char* vp = Vs + (((q4 >> 1) * 32 + r32) * MB_VP + kt * 32 + (q4 & 1) * 16 + 4 * hi) * 2;
                    va.hh[0] = *(LAS u32x2*)(vp); va.hh[1] = *(LAS u32x2*)(vp + 16);
                    f.v[q4] = va.v;
                }
                if (own && kt == nsteps - 1) attn_compute<true>(st, qf, f, tq - (j * MOBA_BLK + kt * 32) - 4 * hi, slope2, dlo, 0x7fffffff, hi, lane);
                else attn_compute<false>(st, qf, f, tq - (j * MOBA_BLK + kt * 32) - 4 * hi, slope2, dlo, 0x7fffffff, hi, lane);
            }
            const float lt = st.l + shxf(st.l, 32, lane);
            const float inv = 1.f / lt;
            if (valid) {
                const size_t pi = ((size_t)(b * SEQ + tq) * NH + h) * 4 + slot;
                u16* orow = P_part + pi * 64;
#pragma unroll
                for (int rq = 0; rq < 4; ++rq) {
                    u32x2 w; w[0] = cvtpk(st.o0[4 * rq] * inv, st.o0[4 * rq + 1] * inv); w[1] = cvtpk(st.o0[4 * rq + 2] * inv, st.o0[4 * rq + 3] * inv);
                    *(u32x2*)(orow + 8 * rq + 4 * hi) = w;
                    w[0] = cvtpk(st.o1[4 * rq] * inv, st.o1[4 * rq + 1] * inv); w[1] = cvtpk(st.o1[4 * rq + 2] * inv, st.o1[4 * rq + 3] * inv);
                    *(u32x2*)(orow + 32 + 8 * rq + 4 * hi) = w;
                }
                if (hi == 0) P_plse[pi] = st.m * LN2 + logf(lt);
            }
        }
        __syncthreads();
    }
}

__device__ __forceinline__ void ph_mobamerge(int L, int rep_, const int wave_s_) {
    PH_FN_BEGIN
    (void)rep_;
    PH_BEGIN;
    for (size_t i = (size_t)bid * NTHR + tid; i < (size_t)T * NH * 8; i += (size_t)G * NTHR) {
        const size_t row = i >> 7; const int h = (int)(i >> 3) & 15, d8 = (int)i & 7;
        const int qb = (int)(row & (SEQ - 1)) >> 8;
        const int nsel = qb < 3 ? qb : 3;
        const size_t pi = (row * NH + h) * 4;
        float l[4], w[4];
        float mx = -INFINITY;
#pragma unroll
        for (int sidx = 0; sidx < 4; ++sidx) { const bool ok = sidx == 3 || sidx < nsel; l[sidx] = ok ? P_plse[pi + sidx] : -INFINITY; mx = fmaxf(mx, l[sidx]); }
        float ws_ = 0.f;
#pragma unroll
        for (int sidx = 0; sidx < 4; ++sidx) { w[sidx] = (sidx == 3 || sidx < nsel) ? expf(l[sidx] - mx) : 0.f; ws_ += w[sidx]; }
        const float inv = 1.f / ws_;
        float acc8[8];
#pragma unroll
        for (int c = 0; c < 8; ++c) acc8[c] = 0.f;
#pragma unroll
        for (int sidx = 0; sidx < 4; ++sidx) {
            if (sidx == 3 || sidx < nsel) {
                const u32x4 a = *(const u32x4*)(P_part + (pi + sidx) * 64 + d8 * 8);
                const float ww = w[sidx] * inv;
#pragma unroll
                for (int c = 0; c < 4; ++c) { acc8[2 * c] += ww * bf2f(a[c] & 0xFFFFu); acc8[2 * c + 1] += ww * bf2f(a[c] >> 16); }
            }
        }
#if WO_FP8
        u32x2 o8; o8[0] = pack_fp8x4(acc8[0] * AO8_SCALE, acc8[1] * AO8_SCALE, acc8[2] * AO8_SCALE, acc8[3] * AO8_SCALE); o8[1] = pack_fp8x4(acc8[4] * AO8_SCALE, acc8[5] * AO8_SCALE, acc8[6] * AO8_SCALE, acc8[7] * AO8_SCALE);
        *(u32x2*)((unsigned char*)P_ao + row * D + h * 64 + d8 * 8) = o8;
#else
        u32x4 o;
#pragma unroll
        for (int c = 0; c < 4; ++c) o[c] = cvtpk(acc8[2 * c], acc8[2 * c + 1]);
        *(u32x4*)(P_ao + row * D + h * 64 + d8 * 8) = o;
#endif
    }
}

constexpr int DL_KP = 72, DL_VP = 388;
constexpr int DL_LDS_K = 0, DL_LDS_V = 384 * DL_KP * 2;
__device__ __forceinline__ void ph_dil(int L, int rep_, const int wave_s_) {
    PH_FN_BEGIN
    (void)rep_;
    PH_BEGIN;
    LAS char* Ks = lds + DL_LDS_K; LAS char* Vs = lds + DL_LDS_V;
    for (int it = bid; it < BATCH * NH * 3 * 32; it += G) {
        const int ch = it & 31, grp = (it >> 5) % 3, bh = it / 96, b = bh >> 4, h = bh & 15;
        const int dil = grp == 0 ? 1 : (grp == 1 ? 4 : 16), Ls = SEQ / dil;
        const float slope2 = exp2f(-0.5f * (float)(h + 1)) * LOG2E * (float)dil;
        const int uc = ch * 256, res = uc / Ls, c0 = uc - res * Ls;
        const int kb0 = c0 - 128;
        {
            const u16* kg = P_qkv + (size_t)(b * SEQ) * 9216 + grp * 3072 + 1024 + h * 64;
#pragma unroll
            for (int i = 0; i < 6; ++i) {
                const int c = tid + i * 512, row = c >> 3, chk = c & 7, ks = kb0 + row;
                if (ks >= 0) *(LAS u32x4*)(Ks + (row * DL_KP + chk * 8) * 2) = *(const u32x4*)(kg + (size_t)(ks * dil + res) * 9216 + chk * 8);
            }
            const u16* vg = P_qkv + (size_t)(b * SEQ) * 9216 + grp * 3072 + 2048 + h * 64;
#pragma unroll
            for (int i = 0; i < 2; ++i) {
                const int c = tid + i * 512, kg4 = c >> 3, chk = c & 7, ks = kb0 + 4 * kg4;
                if (c < 768 && ks >= 0) {
                    u32x4 v4[4];
#pragma unroll
                    for (int q = 0; q < 4; ++q) v4[q] = *(const u32x4*)(vg + (size_t)((ks + q) * dil + res) * 9216 + chk * 8);
#pragma unroll
                    for (int e2 = 0; e2 < 4; ++e2) {
                        u32x2 wlo, whi;
                        wlo[0] = __builtin_amdgcn_perm(v4[1][e2], v4[0][e2], 0x05040100u); wlo[1] = __builtin_amdgcn_perm(v4[3][e2], v4[2][e2], 0x05040100u);
                        whi[0] = __builtin_amdgcn_perm(v4[1][e2], v4[0][e2], 0x07060302u); whi[1] = __builtin_amdgcn_perm(v4[3][e2], v4[2][e2], 0x07060302u);
                        *(LAS u32x2*)(Vs + ((chk * 8 + 2 * e2) * DL_VP + 4 * kg4) * 2) = wlo;
                        *(LAS u32x2*)(Vs + ((chk * 8 + 2 * e2 + 1) * DL_VP + 4 * kg4) * 2) = whi;
                    }
                }
            }
        }
        const int i0 = c0 + wave * 32, iq = i0 + r32, pq = iq * dil + res;
        const u16* qrow = P_qkv + (size_t)(b * SEQ + pq) * 9216 + grp * 3072 + h * 64 + hi * 8;
        bf16x8 qf[4];
#pragma unroll
        for (int d0 = 0; d0 < 4; ++d0) qf[d0] = *(const bf16x8*)(qrow + d0 * 16);
        __syncthreads();
        AttnSt st; st.m = NEGV; st.l = 0.f;
#pragma unroll
        for (int r = 0; r < 16; ++r) { st.o0[r] = 0.f; st.o1[r] = 0.f; }
        const int ktmin = (i0 >= 128) ? 0 : (128 - i0) >> 5;
        for (int kt = 4; kt >= ktmin; --kt) {
            const int lrow0 = (wave + kt) * 32;
            AttnFr f;
#pragma unroll
            for (int d0 = 0; d0 < 4; ++d0) f.k[d0] = *(LAS bf16x8*)(Ks + ((lrow0 + r32) * DL_KP + d0 * 16 + hi * 8) * 2);
#pragma unroll
            for (int q4 = 0; q4 < 4; ++q4) {
                union { bf16x8 v; u32x2 hh[2]; } va;
                LAS char* vp = Vs + (((q4 >> 1) * 32 + r32) * DL_VP + lrow0 + (q4 & 1) * 16 + 4 * hi) * 2;
                va.hh[0] = *(LAS u32x2*)(vp); va.hh[1] = *(LAS u32x2*)(vp + 16);
                f.v[q4] = va.v;
            }
            const int k0 = i0 - 128 + kt * 32;
            if (kt == 4 || kt == 0) attn_compute<true>(st, qf, f, iq - k0 - 4 * hi, slope2, 0, 128, hi, lane);
            else attn_compute<false>(st, qf, f, iq - k0 - 4 * hi, slope2, 0, 128, hi, lane);
        }
        const float lt = st.l + shxf(st.l, 32, lane);
        const float inv = 1.f / lt;
        u16* orow = P_og + (size_t)grp * T * D + (size_t)(b * SEQ + pq) * D + h * 64;
#pragma unroll
        for (int rq = 0; rq < 4; ++rq) {
            u32x2 w; w[0] = cvtpk(st.o0[4 * rq] * inv, st.o0[4 * rq + 1] * inv); w[1] = cvtpk(st.o0[4 * rq + 2] * inv, st.o0[4 * rq + 3] * inv);
            *(u32x2*)(orow + 8 * rq + 4 * hi) = w;
            w[0] = cvtpk(st.o1[4 * rq] * inv, st.o1[4 * rq + 1] * inv); w[1] = cvtpk(st.o1[4 * rq + 2] * inv, st.o1[4 * rq + 3] * inv);
            *(u32x2*)(orow + 32 + 8 * rq + 4 * hi) = w;
        }
        if (hi == 0) P_lse[((size_t)grp * T + (b * SEQ + pq)) * NH + h] = st.m * LN2 + logf(lt);
        __syncthreads();
    }
}

__device__ __forceinline__ void ph_merge(int L, int rep_, const int wave_s_) {
    PH_FN_BEGIN
    (void)rep_;

            PH_BEGIN;
                for (size_t i = (size_t)bid * NTHR + tid; i < (size_t)T * NH * 8; i += (size_t)G * NTHR) {
                    const size_t row = i >> 7; const int h = (int)(i >> 3) & 15, d8 = (int)i & 7;
                    const float l0 = P_lse[(0 * (size_t)T + row) * NH + h], l1 = P_lse[(1 * (size_t)T + row) * NH + h], l2 = P_lse[(2 * (size_t)T + row) * NH + h];
                    const float mx = fmaxf(l0, fmaxf(l1, l2));
                    float w0 = expf(l0 - mx), w1 = expf(l1 - mx), w2 = expf(l2 - mx);
                    const float inv = 1.f / (w0 + w1 + w2); w0 *= inv; w1 *= inv; w2 *= inv;
                    const size_t off = row * D + h * 64 + d8 * 8;
                    const u32x4 a0 = *(const u32x4*)(P_og + off), a1 = *(const u32x4*)(P_og + (size_t)T * D + off), a2 = *(const u32x4*)(P_og + 2 * (size_t)T * D + off);
                    u32x4 o; float of_[8];
#pragma unroll
                    for (int c = 0; c < 4; ++c) {
                        const float lo_ = w0 * bf2f(a0[c] & 0xFFFFu) + w1 * bf2f(a1[c] & 0xFFFFu) + w2 * bf2f(a2[c] & 0xFFFFu);
                        const float hi_ = w0 * bf2f(a0[c] >> 16) + w1 * bf2f(a1[c] >> 16) + w2 * bf2f(a2[c] >> 16);
                        o[c] = cvtpk(lo_, hi_); of_[2 * c] = lo_ * AO8_SCALE; of_[2 * c + 1] = hi_ * AO8_SCALE;
                    }
                    if (WO_FP8) { u32x2 o8; o8[0] = pack_fp8x4(of_[0], of_[1], of_[2], of_[3]); o8[1] = pack_fp8x4(of_[4], of_[5], of_[6], of_[7]); *(u32x2*)((unsigned char*)P_ao + off) = o8; }
                    else *(u32x4*)(P_ao + off) = o;
                }

}

__device__ __forceinline__ void ph_wo(int L, int rep_, const int wave_s_) {
    PH_FN_BEGIN
    (void)rep_;
    const EpiWo E{P_ypre, P_xb};
#if WO_FP8
    const pg8::Gemm g{P_ao, (const u16*)(P_wo8 + (size_t)L * D * D), T, D, D / 2};
    pg8::StaticOrder S; S.init(g.M, g.N, G, bid);
    pg8::gemm_phase<EpiWo, pg8::StaticOrder, false, false, true, 0x7B79>((PG8_LAS unsigned char*)lds, g, S, E, nullptr, wave_s_ * 64 + lane_id_());
#else
    const pg8::Gemm g{P_ao, (const u16*)(ws + WS_WO) + (size_t)L * D * D, T, D, D};
    pg8::StaticOrder S; S.init(g.M, g.N, G, bid);
    pg8::gemm_phase<EpiWo, pg8::StaticOrder, false>((PG8_LAS unsigned char*)lds, g, S, E, nullptr, wave_s_ * 64 + lane_id_());
#endif
}

constexpr int RT_P = 144;
constexpr int RT_ASTAGE = 2 * 64 * 144;
constexpr int RT_LDS_AH = 0, RT_LDS_AL = 64 * RT_P;
constexpr int RT_LDS_BH = 2 * 64 * RT_P, RT_LDS_BL = RT_LDS_BH + 256 * RT_P;
constexpr int RT_LDS_ST = RT_LDS_BL + 256 * RT_P;
constexpr int RT_LDS_GB = 94208;
__device__ __forceinline__ void ph_router(int L, int rep_, const int wave_s_) {
    PH_FN_BEGIN
    (void)rep_;
    PH_BEGIN;
    const float* lng = CTX_IN(4) + L * D; const float* lnb = CTX_IN(5) + L * D;
    const float* rbias = CTX_IN(7) + L * NE;
    const u16* wrh = (const u16*)(ws + WS_WRH) + (size_t)L * NE * D; const u16* wrl = (const u16*)(ws + WS_WRL) + (size_t)L * NE * D;
    LAS float* stat = (LAS float*)(lds + RT_LDS_ST);
    if (tid < 256) { *(LAS f32x4*)(lds + RT_LDS_GB + tid * 16) = *(const f32x4*)(lng + tid * 4); *(LAS f32x4*)(lds + RT_LDS_GB + 4096 + tid * 16) = *(const f32x4*)(lnb + tid * 4); }
    for (int it = bid; it < T / 64; it += G) {
#pragma unroll 1
        for (int hb_ = 0; hb_ < 2; ++hb_) {
            u32x4 yv[4][2];
#pragma unroll
            for (int rr = 0; rr < 4; ++rr)
#pragma unroll
                for (int j = 0; j < 2; ++j) yv[rr][j] = *(const u32x4*)(P_ypre + ((size_t)it * 64 + wave * 8 + hb_ * 4 + rr) * D + j * 512 + lane * 8);
#pragma unroll
            for (int rr = 0; rr < 4; ++rr) {
                float sm = 0.f;
#pragma unroll
                for (int j = 0; j < 2; ++j)
#pragma unroll
                    for (int c = 0; c < 4; ++c) sm += bf2f(yv[rr][j][c] & 0xFFFFu) + bf2f(yv[rr][j][c] >> 16);
                const float mu = wave_sum(sm) * (1.f / D);
                float q = 0.f;
#pragma unroll
                for (int j = 0; j < 2; ++j)
#pragma unroll
                    for (int c = 0; c < 4; ++c) { const float d0_ = bf2f(yv[rr][j][c] & 0xFFFFu) - mu, d1_ = bf2f(yv[rr][j][c] >> 16) - mu; q += d0_ * d0_ + d1_ * d1_; }
                const float rstd = rsqrtf(wave_sum(q) * (1.f / D) + LN_EPS);
                if (lane == 0) { stat[wave * 8 + hb_ * 4 + rr] = mu; stat[64 + wave * 8 + hb_ * 4 + rr] = rstd; }
            }
        }
        __syncthreads();
        const int arow = tid >> 3, aq = tid & 7;
        const float amu = stat[arow], ars = stat[64 + arow];
        const u16* yp = P_ypre + ((size_t)it * 64 + arow) * D + aq * 8;
        u32x4 ya = *(const u32x4*)(yp);
        u32x4 bw[8], bx[8];
        const u16* wfh = wrh + (size_t)wave * 16 * 4 * 64 * 8 + lane * 8; const u16* wfl = wrl + (size_t)wave * 16 * 4 * 64 * 8 + lane * 8;
#define RT_LOADB(BW, KC_) { _Pragma("unroll") for (int sk = 0; sk < 4; ++sk) { BW[sk] = *(const u32x4*)(wfh + ((KC_) * 4 + sk) * 512); BW[4 + sk] = *(const u32x4*)(wfl + ((KC_) * 4 + sk) * 512); } }
        RT_LOADB(bw, 0)
        RT_LOADB(bx, 1)
        f32x16 lg[2];
#pragma unroll
        for (int r = 0; r < 16; ++r) { lg[0][r] = 0.f; lg[1][r] = 0.f; }
#define RT_WRITEA(KC_) { const int k0 = (KC_) * 64; \
            const f32x4 g0 = *(const LAS f32x4*)(lds + RT_LDS_GB + (k0 + aq * 8) * 4), g1 = *(const LAS f32x4*)(lds + RT_LDS_GB + (k0 + aq * 8 + 4) * 4); \
            const f32x4 b0 = *(const LAS f32x4*)(lds + RT_LDS_GB + 4096 + (k0 + aq * 8) * 4), b1 = *(const LAS f32x4*)(lds + RT_LDS_GB + 4096 + (k0 + aq * 8 + 4) * 4); \
            f32x4 x0, x1v; \
            _Pragma("unroll") for (int c = 0; c < 4; ++c) { const float y0_ = bf2f(c & 1 ? ya[c >> 1] >> 16 : ya[c >> 1] & 0xFFFFu), y1_ = bf2f(c & 1 ? ya[2 + (c >> 1)] >> 16 : ya[2 + (c >> 1)] & 0xFFFFu); \
                x0[c] = (y0_ - amu) * ars * g0[c] + b0[c]; x1v[c] = (y1_ - amu) * ars * g1[c] + b1[c]; } \
            ya = *(const u32x4*)(yp + (((KC_) + 1 < 16) ? k0 + 64 : 0)); \
            const size_t go = ((size_t)it * 64 + arow) * D + k0 + aq * 8; \
            u32x4 wh; wh[0] = cvtpk(x0[0], x0[1]); wh[1] = cvtpk(x0[2], x0[3]); wh[2] = cvtpk(x1v[0], x1v[1]); wh[3] = cvtpk(x1v[2], x1v[3]); \
            *(u32x4*)(P_xb + go) = wh; \
            u32x2 w8; w8[0] = pack_fp8x4(x0[0], x0[1], x0[2], x0[3]); w8[1] = pack_fp8x4(x1v[0], x1v[1], x1v[2], x1v[3]); \
            *(u32x2*)(P_xb8 + go) = w8; \
            u32x4 wl; \
            wl[0] = cvtpk(x0[0] - bf2f(wh[0] & 0xFFFFu), x0[1] - bf2f(wh[0] >> 16)); wl[1] = cvtpk(x0[2] - bf2f(wh[1] & 0xFFFFu), x0[3] - bf2f(wh[1] >> 16)); \
            wl[2] = cvtpk(x1v[0] - bf2f(wh[2] & 0xFFFFu), x1v[1] - bf2f(wh[2] >> 16)); wl[3] = cvtpk(x1v[2] - bf2f(wh[3] & 0xFFFFu), x1v[3] - bf2f(wh[3] >> 16)); \
            *(LAS u32x4*)(lds + ((KC_) & 1) * RT_ASTAGE + RT_LDS_AH + arow * RT_P + aq * 16) = wh; \
            *(LAS u32x4*)(lds + ((KC_) & 1) * RT_ASTAGE + RT_LDS_AL + arow * RT_P + aq * 16) = wl; }
#define RT_CHUNK(KC_, BW) { __syncthreads(); \
            _Pragma("unroll") for (int sk = 0; sk < 4; ++sk) { \
                const int ko = (sk * 16 + hi * 8) * 2; \
                const bf16x8 bh_ = __builtin_bit_cast(bf16x8, BW[sk]), bl_ = __builtin_bit_cast(bf16x8, BW[4 + sk]); \
                _Pragma("unroll") for (int rb = 0; rb < 2; ++rb) { \
                    const bf16x8 xh = *(const LAS bf16x8*)(lds + ((KC_) & 1) * RT_ASTAGE + RT_LDS_AH + (rb * 32 + r32) * RT_P + ko), xl = *(const LAS bf16x8*)(lds + ((KC_) & 1) * RT_ASTAGE + RT_LDS_AL + (rb * 32 + r32) * RT_P + ko); \
                    lg[rb] = MFMA_BF16(xh, bh_, lg[rb]); lg[rb] = MFMA_BF16(xl, bh_, lg[rb]); lg[rb] = MFMA_BF16(xh, bl_, lg[rb]); \
                } \
            } \
            if ((KC_) + 1 < 16) RT_WRITEA((KC_) + 1) \
            { const int kn_ = ((KC_) + 2 < 16) ? (KC_) + 2 : ((KC_) & 1); RT_LOADB(BW, kn_) } }
        RT_WRITEA(0)
#pragma unroll 1
        for (int kc = 0; kc < 16; kc += 2) {
            RT_CHUNK(kc, bw)
            RT_CHUNK(kc + 1, bx)
        }
#undef RT_CHUNK
#undef RT_WRITEA
#undef RT_LOADB
        __syncthreads();
        LAS float* lgs = (LAS float*)lds;
#pragma unroll
        for (int rb = 0; rb < 2; ++rb)
#pragma unroll
            for (int r = 0; r < 16; ++r) lgs[(rb * 32 + crow(r, hi)) * 257 + wave * 32 + r32] = lg[rb][r];
        __syncthreads();
#pragma unroll 1
        for (int tg = 0; tg < 2; ++tg) {
            float sc[4][4], cv[4][4];
#pragma unroll
            for (int tt = 0; tt < 4; ++tt) {
                const int lr = wave * 8 + tg * 4 + tt;
#pragma unroll
                for (int j = 0; j < 4; ++j) { const int e = lane + 64 * j; sc[tt][j] = 1.f / (1.f + __expf(-lgs[lr * 257 + e])); cv[tt][j] = sc[tt][j] + rbias[e]; }
            }
            float gsel[4][8];
#pragma unroll
            for (int j = 0; j < 4; ++j) {
#pragma unroll
                for (int tt = 0; tt < 4; ++tt) {
                    const float rm = dpp_rowmax(cv[tt][j]);
                    const float m1a = fmaxf(rl_f(rm, 0), rl_f(rm, 16)), m1b = fmaxf(rl_f(rm, 32), rl_f(rm, 48));
                    const unsigned long long bal = __ballot(cv[tt][j] == (hi ? m1b : m1a));
                    const int fa_ = __builtin_ctz((unsigned)(bal & 0xFFFFFFFFull)), fb_ = 32 + __builtin_ctz((unsigned)(bal >> 32));
                    const float c2 = (lane == fa_ || lane == fb_) ? -INFINITY : cv[tt][j];
                    const float rm2 = dpp_rowmax(c2);
                    gsel[tt][2 * j] = m1a + fmaxf(rl_f(rm2, 0), rl_f(rm2, 16));
                    gsel[tt][2 * j + 1] = m1b + fmaxf(rl_f(rm2, 32), rl_f(rm2, 48));
                }
            }
#pragma unroll
            for (int tt = 0; tt < 4; ++tt)
#pragma unroll
                for (int j = 0; j < 4; ++j) {
                    int ra_ = 0, rb_ = 0;
#pragma unroll
                    for (int g2 = 0; g2 < 8; ++g2) {
                        ra_ += ((gsel[tt][g2] > gsel[tt][2 * j]) || (gsel[tt][g2] == gsel[tt][2 * j] && g2 < 2 * j)) ? 1 : 0;
                        rb_ += ((gsel[tt][g2] > gsel[tt][2 * j + 1]) || (gsel[tt][g2] == gsel[tt][2 * j + 1] && g2 < 2 * j + 1)) ? 1 : 0;
                    }
                    cv[tt][j] = ((hi ? rb_ : ra_) < 4) ? cv[tt][j] : NEGV;
                }
            float wsel[4], wsum[4]; int esel[4];
#pragma unroll
            for (int tt = 0; tt < 4; ++tt) { wsel[tt] = 0.f; wsum[tt] = 0.f; esel[tt] = 0; }
#pragma unroll 1
            for (int k = 0; k < TOPK; ++k) {
#pragma unroll
                for (int tt = 0; tt < 4; ++tt) {
                    float bv = cv[tt][0]; int be = lane;
#pragma unroll
                    for (int j = 1; j < 4; ++j) if (cv[tt][j] > bv) { bv = cv[tt][j]; be = lane + 64 * j; }
                    const float rm = dpp_rowmax(bv);
                    const float mval = fmaxf(fmaxf(rl_f(rm, 0), rl_f(rm, 16)), fmaxf(rl_f(rm, 32), rl_f(rm, 48)));
                    const int ri = dpp_rowmin_i(bv == mval ? be : 0x7fffffff);
                    const int e = min(min(__builtin_amdgcn_readlane(ri, 0), __builtin_amdgcn_readlane(ri, 16)), min(__builtin_amdgcn_readlane(ri, 32), __builtin_amdgcn_readlane(ri, 48)));
                    const int jl = e >> 6, ll = e & 63;
                    const float smine = ((jl == 0 ? sc[tt][0] : 0.f) + (jl == 1 ? sc[tt][1] : 0.f)) + ((jl == 2 ? sc[tt][2] : 0.f) + (jl == 3 ? sc[tt][3] : 0.f));
                    const float sw = rl_f(smine, ll);
#pragma unroll
                    for (int j = 0; j < 4; ++j) cv[tt][j] = (lane == ll && jl == j) ? -INFINITY : cv[tt][j];
                    wsum[tt] += sw;
                    if (lane == k) { wsel[tt] = sw; esel[tt] = e; }
                }
            }
#pragma unroll
            for (int tt = 0; tt < 4; ++tt) {
                if (lane < TOPK) {
                    const int tok = it * 64 + wave * 8 + tg * 4 + tt;
                    const int a = tok * TOPK + lane;
                    P_topw[a] = wsel[tt] / wsum[tt] * 2.5f;
                    if (rep_ == 0) {
                        const int pos = atomicAdd(&cnt[esel[tt] * CNT_STRIDE], 1);
                        P_list[(size_t)esel[tt] * T + pos] = a;
                    }
                }
            }
        }
        __syncthreads();
    }
}

__device__ __forceinline__ void ph_gateup(int L, int rep_, const int wave_s_) {
    PH_FN_BEGIN
    (void)rep_;
    {
        PH_BEGIN;
        const float* weg = CTX_IN(8) + (size_t)L * NE * D * DF; const float* weu = CTX_IN(9) + (size_t)L * NE * D * DF;
        LAS int* rowva = (LAS int*)(lds + MOE_LDS_VA);
        {
            int* octr = (int*)(ws + WS_CTL + CTL_CNT_OFF + 8192) + (L * 4 + 2 * (rep_ & 1)) * 64;
            LAS int* slot = (LAS int*)(lds + 140000);
            for (;;) {
                __syncthreads();
                if (tid == 0) { int q; do { q = atomicAdd(octr, 1); } while (q >= NE && q < NE * 5 && cnt[((q - NE) >> 2) * CNT_STRIDE] <= MOE_XCAP); *slot = q; }
                __syncthreads();
                const int q = *slot;
                if (q >= NE * 5) break;
                const bool ovf = q >= NE;
                const int e = ovf ? (q - NE) >> 2 : q, pz = ovf ? (q - NE) & 3 : 0, npz = ovf ? 1 : 4, st0 = ovf ? 1 : 0, n = cnt[e * CNT_STRIDE];
                for (int r0 = 0; r0 < n; r0 += 1024) {
                    if (ovf && n - r0 <= MOE_XCAP) break;
#pragma unroll
                    for (int i = 0; i < 2; ++i) { int t_ = tid; asm volatile("" : "+v"(t_)); const int idx = r0 + i * 512 + t_; rowva[i * 512 + t_] = idx < n ? P_list[(size_t)e * T + idx] : TRASH_VA; }
                    __syncthreads();
                    moe_expert<false>(lds, tid, lane, wave, r32, hi, P_xb8, weg + (size_t)e * D * DF, weu + (size_t)e * D * DF, (n - r0) < 1024 ? (n - r0) : 1024, (void*)P_hb, pz, npz, st0, 1, false, !ovf && (n - r0) > 512 && (n - r0) <= MOE_XCAP);
                }
            }
        }
    }
    {
        PH_BEGIN;
        const pg8::Gemm g{P_xb, (const u16*)(ws + WS_WSGU) + (size_t)L * 512 * 1024, T, 512, D};
        const EpiSGU E{P_hbs};
        int* qctr = (int*)(ws + WS_CTL + CTL_CNT_OFF + 4096) + (L * 4 + 2 * (rep_ & 1)) * 64;
        LAS int* slot = (LAS int*)(lds + 140000);
        for (;;) {
            __syncthreads();
            if (tid == 0) *slot = atomicAdd(qctr, 1);
            __syncthreads();
            const int un = *slot;
            if (un >= 128) break;
            const pg8::FixedOrder S{un & 63, un >> 6};
            pg8::gemm_phase<EpiSGU, pg8::FixedOrder, false>((PG8_LAS unsigned char*)lds, g, S, E, nullptr, wave_s_ * 64 + lane_id_());
        }
    }
}

__device__ __forceinline__ void ph_down(int L, int rep_, const int wave_s_) {
    PH_FN_BEGIN
    (void)rep_;
    {
        PH_BEGIN;
        const float* wed = CTX_IN(10) + (size_t)L * NE * DF * D;
        LAS int* rowva = (LAS int*)(lds + MOE_LDS_VA); LAS float* roww = (LAS float*)(lds + MOE_LDS_W);
        {
            int* octr = (int*)(ws + WS_CTL + CTL_CNT_OFF + 8192) + (L * 4 + 1 + 2 * (rep_ & 1)) * 64;
            LAS int* slot = (LAS int*)(lds + 140000);
            for (;;) {
                __syncthreads();
                if (tid == 0) { int q; do { q = atomicAdd(octr, 1); } while (q >= NE && q < NE * 5 && cnt[((q - NE) >> 2) * CNT_STRIDE] <= 512); *slot = q; }
                __syncthreads();
                const int q = *slot;
                if (q >= NE * 5) break;
                const bool ovf = q >= NE;
                const int e = ovf ? (q - NE) >> 2 : q, pz = ovf ? ((q - NE) & 3) * 2 : 0, npz = ovf ? 2 : 8, st0 = ovf ? 1 : 0, n = cnt[e * CNT_STRIDE];
                for (int r0 = 0; r0 < n; r0 += 1024) {
                    if (ovf && n - r0 <= 512) break;
#pragma unroll
                    for (int i = 0; i < 2; ++i) { int t_ = tid; asm volatile("" : "+v"(t_)); const int idx = r0 + i * 512 + t_; const int va = idx < n ? P_list[(size_t)e * T + idx] : TRASH_VA; rowva[i * 512 + t_] = va; roww[i * 512 + t_] = va < A_TOT ? P_topw[va] * Y8_SCALE : 0.f; }
                    __syncthreads();
                    moe_expert<true>(lds, tid, lane, wave, r32, hi, (const unsigned char*)P_hb, wed + (size_t)e * DF * D, nullptr, (n - r0) < 1024 ? (n - r0) : 1024, (void*)P_yb, pz, npz, st0, 1, true);
                }
            }
        }
    }
    {
        PH_BEGIN;
        const pg8::Gemm g{P_hbs, (const u16*)(ws + WS_WSD) + (size_t)L * D * DF, T, D, DF};
        const EpiSD E{P_yb};
        int* qctr = (int*)(ws + WS_CTL + CTL_CNT_OFF + 4096) + (L * 4 + 1 + 2 * (rep_ & 1)) * 64;
        LAS int* slot = (LAS int*)(lds + 140000);
        for (;;) {
            __syncthreads();
            if (tid == 0) *slot = atomicAdd(qctr, 1);
            __syncthreads();
            const int un = *slot;
            if (un >= 256) break;
            const pg8::FixedOrder S{un & 63, un >> 6};
            pg8::gemm_phase<EpiSD, pg8::FixedOrder, false>((PG8_LAS unsigned char*)lds, g, S, E, nullptr, wave_s_ * 64 + lane_id_());
        }
    }
}

__device__ __forceinline__ void ph_combine(int L, int rep_, const int wave_s_) {
    PH_FN_BEGIN
    (void)rep_;
    PH_BEGIN;
    const float* lng = CTX_IN(14) + L * D; const float* lnb = CTX_IN(15) + L * D;
    float* dst = AS_GLOBAL(float, ctx_ld(16));
    for (int row = bid * 8 + wave; row < T; row += G * 8) {
        u32x4 yv[TOPK + 1][2];
#pragma unroll
        for (int k = 0; k < TOPK + 1; ++k) {
            const size_t va = k < TOPK ? (size_t)row * TOPK + k : (size_t)A_TOT + row;
            if (k < TOPK) {
#pragma unroll
                for (int j = 0; j < 2; ++j) { const u32x2 w8 = *(const u32x2*)((const unsigned char*)P_yb + va * D + j * 512 + lane * 8); yv[k][j][0] = w8[0]; yv[k][j][1] = w8[1]; yv[k][j][2] = 0u; yv[k][j][3] = 0u; }
            } else {
#pragma unroll
                for (int j = 0; j < 2; ++j) yv[k][j] = *(const u32x4*)(P_yb + va * D + j * 512 + lane * 8);
            }
        }
        float v[16];
#pragma unroll
        for (int j = 0; j < 2; ++j) {
            const u32x4 t = *(const u32x4*)(P_xb + (size_t)row * D + j * 512 + lane * 8);
#pragma unroll
            for (int c = 0; c < 4; ++c) { v[j * 8 + 2 * c] = DN_ALPHA * bf2f(t[c] & 0xFFFFu); v[j * 8 + 2 * c + 1] = DN_ALPHA * bf2f(t[c] >> 16); }
        }
#pragma unroll
        for (int k = 0; k < TOPK + 1; ++k)
#pragma unroll
            for (int j = 0; j < 2; ++j) {
                if (k < TOPK) {
#pragma unroll
                    for (int c = 0; c < 2; ++c) {
                        const f32x2_ lo2 = __builtin_amdgcn_cvt_pk_f32_fp8((int)yv[k][j][c], false), hi2 = __builtin_amdgcn_cvt_pk_f32_fp8((int)yv[k][j][c], true);
                        v[j * 8 + 4 * c] += lo2[0] * (1.f / Y8_SCALE); v[j * 8 + 4 * c + 1] += lo2[1] * (1.f / Y8_SCALE); v[j * 8 + 4 * c + 2] += hi2[0] * (1.f / Y8_SCALE); v[j * 8 + 4 * c + 3] += hi2[1] * (1.f / Y8_SCALE);
                    }
                } else {
#pragma unroll
                    for (int c = 0; c < 4; ++c) { v[j * 8 + 2 * c] += bf2f(yv[k][j][c] & 0xFFFFu); v[j * 8 + 2 * c + 1] += bf2f(yv[k][j][c] >> 16); }
                }
            }
        float sm = 0.f;
#pragma unroll
        for (int i = 0; i < 16; ++i) sm += v[i];
        const float mu = wave_sum(sm) * (1.f / D);
        float q = 0.f;
#pragma unroll
        for (int i = 0; i < 16; ++i) { const float d = v[i] - mu; q += d * d; }
        const float rstd = rsqrtf(wave_sum(q) * (1.f / D) + LN_EPS);
#pragma unroll
        for (int j = 0; j < 2; ++j) {
            const f32x4 g0 = *(const f32x4*)(lng + j * 512 + lane * 8), g1 = *(const f32x4*)(lng + j * 512 + lane * 8 + 4);
            const f32x4 b0 = *(const f32x4*)(lnb + j * 512 + lane * 8), b1 = *(const f32x4*)(lnb + j * 512 + lane * 8 + 4);
            f32x4 o0, o1;
#pragma unroll
            for (int c = 0; c < 4; ++c) { o0[c] = (v[j * 8 + c] - mu) * rstd * g0[c] + b0[c]; o1[c] = (v[j * 8 + 4 + c] - mu) * rstd * g1[c] + b1[c]; }
            if (L == 1) { *(f32x4*)(dst + (size_t)row * D + j * 512 + lane * 8) = o0; *(f32x4*)(dst + (size_t)row * D + j * 512 + lane * 8 + 4) = o1; }
            if (L == 0) { u32x4 w; w[0] = cvtpk(o0[0], o0[1]); w[1] = cvtpk(o0[2], o0[3]); w[2] = cvtpk(o1[0], o1[1]); w[3] = cvtpk(o1[2], o1[3]); *(u32x4*)(P_xb + (size_t)row * D + j * 512 + lane * 8) = w;
                if (QKV_FP8) { u32x2 w8; w8[0] = pack_fp8x4(o0[0], o0[1], o0[2], o0[3]); w8[1] = pack_fp8x4(o1[0], o1[1], o1[2], o1[3]); *(u32x2*)(P_xq8 + (size_t)row * D + j * 512 + lane * 8) = w8; } }
        }
    }
}

__global__ void __launch_bounds__(NTHR, 2) fwd(Args args) {
    extern __shared__ __attribute__((aligned(16))) unsigned char lds_raw[];
    LAS char* lds = (LAS char*)lds_raw;
    unsigned char* const ws = args.ws;
    const int lo = args.ph_lo, hi_ph = args.ph_hi;
    const int wave_s_ = __builtin_amdgcn_readfirstlane(threadIdx.x >> 6);
    if (threadIdx.x < 18) {
        const uint64_t v = threadIdx.x < 16 ? (uint64_t)args.in[threadIdx.x] : (threadIdx.x == 16 ? (uint64_t)args.out : (uint64_t)args.ws);
        ((LAS uint64_t*)(lds + LDS_CTX))[threadIdx.x] = v;
    }
    __syncthreads();
#define IN(k) (lo <= (k) && (k) < hi_ph)

#if MK_ONE_LAUNCH
    if (threadIdx.x < 4) ((LAS unsigned*)(lds + LDS_BAR))[threadIdx.x] = 0u;
    __syncthreads();
    XcdBarrier bar = xcd_barrier_post((unsigned*)(ws + WS_CTL), (volatile LAS unsigned*)(lds + LDS_BAR), wave_s_ == 0 && lane_id_() == 0);
#define GRID_BAR() xcd_barrier(bar, wave_s_ == 0 && lane_id_() == 0)
#else
#define GRID_BAR() do { } while (0)
#endif
#define SEAM(k) do { if (IN(k) && IN((k) + 1)) GRID_BAR(); } while (0)

    for (int rep_ = 0; rep_ < ((IN(0) && PHK(0)) ? REPS(0) : 0); ++rep_) { ph_p0(0, rep_, wave_s_); }
    SEAM(0);

    for (int L = 0; L < 2; ++L) {
        const int pb = 1 + 10 * L;
        for (int rep_ = 0; rep_ < ((IN(pb + 0) && PHK(1)) ? REPS(1) : 0); ++rep_) { ph_qkv(L, rep_, wave_s_); }
        SEAM(pb + 0);

        if (L == 0) {
            for (int rep_ = 0; rep_ < ((IN(pb + 2) && PHK(11)) ? REPS(11) : 0); ++rep_) { ph_gate(L, rep_, wave_s_); }
            SEAM(pb + 2);
        }

        if (L == 0) {
            for (int rep_ = 0; rep_ < ((IN(pb + 3) && PHK(3)) ? REPS(3) : 0); ++rep_) { ph_moba(L, rep_, wave_s_); }
            SEAM(pb + 3);
            for (int rep_ = 0; rep_ < ((IN(pb + 4) && PHK(12)) ? REPS(12) : 0); ++rep_) { ph_mobamerge(L, rep_, wave_s_); }
        } else {
            for (int rep_ = 0; rep_ < ((IN(pb + 3) && PHK(4)) ? REPS(4) : 0); ++rep_) { ph_dil(L, rep_, wave_s_); }
            SEAM(pb + 3);
            for (int rep_ = 0; rep_ < ((IN(pb + 4) && PHK(5)) ? REPS(5) : 0); ++rep_) { ph_merge(L, rep_, wave_s_); }
        }
        SEAM(pb + 4);

        for (int rep_ = 0; rep_ < ((IN(pb + 5) && PHK(6)) ? REPS(6) : 0); ++rep_) { ph_wo(L, rep_, wave_s_); }
        SEAM(pb + 5);

        for (int rep_ = 0; rep_ < ((IN(pb + 6) && PHK(7)) ? REPS(7) : 0); ++rep_) { ph_router(L, rep_, wave_s_); }
        SEAM(pb + 6);

        for (int rep_ = 0; rep_ < ((IN(pb + 7) && PHK(8)) ? REPS(8) : 0); ++rep_) { ph_gateup(L, rep_, wave_s_); }
        SEAM(pb + 7);

        for (int rep_ = 0; rep_ < ((IN(pb + 8) && PHK(9)) ? REPS(9) : 0); ++rep_) { ph_down(L, rep_, wave_s_); }
        SEAM(pb + 8);

        for (int rep_ = 0; rep_ < ((IN(pb + 9) && PHK(10)) ? REPS(10) : 0); ++rep_) { ph_combine(L, rep_, wave_s_); }
        if (L == 0) SEAM(pb + 9);
    }
}

extern "C" void kernel_launch(void* const* d_in, const int* in_sizes, int n_in, void* d_out, int out_size, void* d_ws, size_t ws_size, hipStream_t stream) {
    static int grid = 0;
    if (grid == 0) {
        if (n_in != 16 || out_size != T * D || ws_size < WS_END3) { fprintf(stderr, "kernel_launch: unexpected problem (n_in %d out %d ws %zu need %zu)\n", n_in, out_size, ws_size, (size_t)WS_END2); grid = -1; return; }
        int dev = 0, cus = 0, per_cu = 0;
        if (hipGetDevice(&dev) != hipSuccess || hipDeviceGetAttribute(&cus, hipDeviceAttributeMultiprocessorCount, dev) != hipSuccess) { grid = -1; return; }
        if (hipFuncSetAttribute((const void*)fwd, hipFuncAttributeMaxDynamicSharedMemorySize, LDS_BYTES) != hipSuccess) { fprintf(stderr, "kernel_launch: hipFuncSetAttribute failed\n"); grid = -1; return; }
        if (hipOccupancyMaxActiveBlocksPerMultiprocessor(&per_cu, (const void*)fwd, NTHR, LDS_BYTES) != hipSuccess || per_cu < 1) { fprintf(stderr, "kernel_launch: occupancy query says %d\n", per_cu); (void)hipGetLastError(); per_cu = 1; }
        grid = cus;
    }
    if (grid < 0) return;
    (void)hipMemsetAsync((char*)d_ws + WS_CTL, 0, CTL_BYTES, stream);
    Args a{};
    for (int i = 0; i < 16; ++i) a.in[i] = (const float*)d_in[i];
    a.out = (float*)d_out; a.ws = (unsigned char*)d_ws;
#if MK_ONE_LAUNCH
    a.ph_lo = 0; a.ph_hi = N_PHASES;
    hipLaunchKernelGGL(fwd, dim3(grid), dim3(NTHR), LDS_BYTES, stream, a);
#else
    for (int ph = 0; ph < N_PHASES; ++ph) {
        if (ph == 12 || ph == 13) continue;
        a.ph_lo = ph; a.ph_hi = ph + 1;
        hipLaunchKernelGGL(fwd, dim3(grid), dim3(NTHR), LDS_BYTES, stream, a);
    }
#endif
}
```

```cpp
#include <hip/hip_runtime.h>
#include <hip/hip_bf16.h>
#include <stdint.h>
#include <stdio.h>

#ifndef MK_ONE_LAUNCH
#define MK_ONE_LAUNCH 1
#endif

#ifndef PHMASK
#define PHMASK 0x1FFF
#endif
#define PHK(k) ((PHMASK >> (k)) & 1)
#ifndef REPEAT_KIND
#define REPEAT_KIND -1
#endif
#define REPS(k) ((k) == REPEAT_KIND ? 2 : 1)
#define LAS __attribute__((address_space(3)))
typedef __attribute__((ext_vector_type(8))) short bf16x8;
typedef __attribute__((ext_vector_type(16))) float f32x16;
typedef __attribute__((ext_vector_type(4))) float f32x4;
typedef __attribute__((ext_vector_type(4))) unsigned u32x4;
typedef __attribute__((ext_vector_type(2))) unsigned u32x2;
typedef unsigned short u16;

constexpr int D = 1024, BATCH = 2, SEQ = 8192, T = BATCH * SEQ, NH = 16, HD = 64;
constexpr int NE = 256, TOPK = 8, DF = 256;
constexpr int A_TOT = T * TOPK;
constexpr int MOBA_BLK = 256, MOBA_NB = SEQ / MOBA_BLK;
constexpr float DN_ALPHA = 1.4142135623730951f;
constexpr float LN_EPS = 1e-5f;
constexpr float LOG2E = 1.4426950408889634f;
constexpr float LN2 = 0.6931471805599453f;
constexpr float NEGV = -1e30f;
constexpr int NTHR = 512;

constexpr size_t al256(size_t x) { return (x + 255) & ~(size_t)255; }
constexpr size_t WS_CTL = 0;
constexpr size_t CTL_BYTES = 131072;
constexpr size_t CTL_CNT_OFF = 32768;
constexpr size_t CTL_XQ_OFF = 45056;
constexpr size_t CTL_ECNT_OFF = 65536;
constexpr int CNT_STRIDE = 32;
constexpr size_t WS_XB = WS_CTL + CTL_BYTES;
constexpr size_t WS_X1 = WS_XB + al256((size_t)T * D * 2);
constexpr size_t WS_X2 = WS_X1 + al256((size_t)T * D * 4);
constexpr size_t WS_YPRE = WS_X2 + al256((size_t)T * D * 4);
constexpr size_t WS_QKV = WS_YPRE + al256((size_t)T * D * 4);
constexpr size_t WS_VT = WS_QKV + al256((size_t)T * 9216 * 2);
constexpr size_t WS_KM = WS_VT + al256((size_t)3 * T * D * 2);
constexpr size_t WS_AO = WS_KM + al256((size_t)BATCH * NH * MOBA_NB * HD * 4);
constexpr size_t WS_OG = WS_AO + al256((size_t)T * D * 2);
constexpr size_t WS_LSE = WS_OG + al256((size_t)3 * T * D * 2);
constexpr size_t WS_TOPW = WS_LSE + al256((size_t)3 * T * NH * 4);
constexpr size_t WS_LIST = WS_TOPW + al256((size_t)T * TOPK * 4);
constexpr size_t WS_HB = WS_LIST + al256((size_t)NE * T * 4);
constexpr size_t WS_YB = WS_HB + al256((size_t)(A_TOT + T + 1) * DF * 2);
constexpr size_t WS_END = WS_YB + al256((size_t)(A_TOT + T + 1) * D * 2);
constexpr int TRASH_VA = A_TOT + T;
constexpr size_t WS_SELM = WS_END;
constexpr size_t WS_PART = WS_SELM + al256((size_t)T * NH * 4);
constexpr size_t WS_PLSE = WS_PART + al256((size_t)T * NH * 4 * 64 * 2);
constexpr size_t WS_WQK0 = WS_PLSE + al256((size_t)T * NH * 4 * 4);
constexpr size_t WS_WV0 = WS_WQK0 + (size_t)2048 * 1024 * 2;
constexpr size_t WS_WQK1 = WS_WV0 + (size_t)1024 * 1024 * 2;
constexpr size_t WS_WV1 = WS_WQK1 + (size_t)6144 * 1024 * 2;
constexpr size_t WS_WO = WS_WV1 + (size_t)3072 * 1024 * 2;
constexpr size_t WS_WSGU = WS_WO + (size_t)2 * 1024 * 1024 * 2;
constexpr size_t WS_WSD = WS_WSGU + (size_t)2 * 512 * 1024 * 2;
constexpr size_t WS_XB8 = WS_WSD + (size_t)2 * 1024 * 256 * 2;
constexpr size_t WS_HBS = WS_XB8 + (size_t)T * D;
constexpr size_t WS_WRH = WS_HBS + (size_t)T * DF * 2;
constexpr size_t WS_WRL = WS_WRH + (size_t)2 * 256 * 1024 * 2;
constexpr size_t WS_END2 = WS_WRL + (size_t)2 * 256 * 1024 * 2;
constexpr size_t WS_XQ8 = WS_END2;
constexpr size_t WS_WQ8 = WS_XQ8 + (size_t)T * D;
constexpr size_t WS_WO8 = WS_WQ8 + (size_t)(3072 + 9216) * 1024;
constexpr size_t WS_END3 = WS_WO8 + (size_t)2 * 1024 * 1024;
#ifndef WO_FP8
#define WO_FP8 1
#endif
constexpr float AO8_SCALE = 16.f;
#ifndef QKV_FP8
#define QKV_FP8 2
#endif

constexpr int LDP = 40;
constexpr int STAGE_BYTES = 2 * 256 * LDP * 2;
constexpr int LDS_ROWID = 2 * STAGE_BYTES;
constexpr int LDS_ROWW = LDS_ROWID + 1024;
constexpr int XS_PITCH = 1028;
constexpr int LDS_BYTES = 163840;
constexpr int LDS_BAR = 161792;

__device__ __forceinline__ int lane_id_() { int l; asm volatile("v_mbcnt_lo_u32_b32 %0, -1, 0\n\tv_mbcnt_hi_u32_b32 %0, -1, %0" : "=v"(l)); return l; }
__device__ __forceinline__ float shxf(float v, int m, int lane) { return __int_as_float(__builtin_amdgcn_ds_bpermute((lane ^ m) << 2, __float_as_int(v))); }
__device__ __forceinline__ int shxi(int v, int m, int lane) { return __builtin_amdgcn_ds_bpermute((lane ^ m) << 2, v); }
#define XB_TMO      128
#define XB_XCNT(j)  (256  + 64 * (j))
#define XB_XSUB(j)  (1280 + 64 * (j))
#define XB_XGEN(j)  (2304 + 64 * (j))
#define XB_TOP      3328
#define XB_TOPGEN   3392
#define XCD_BAR_WORDS 3456
#define XB_SPIN_CAP (1u << 18)
__device__ __forceinline__ unsigned xb_ld(unsigned* p)              { return __hip_atomic_load(p, __ATOMIC_RELAXED, __HIP_MEMORY_SCOPE_AGENT); }
__device__ __forceinline__ unsigned xb_add(unsigned* p, unsigned v) { return __hip_atomic_fetch_add(p, v, __ATOMIC_RELAXED, __HIP_MEMORY_SCOPE_AGENT); }
__device__ __forceinline__ unsigned xb_xcc_id() { return (unsigned)__builtin_amdgcn_s_getreg((3 << 11) | 20) & 0xFu; }
#define XB_SPIN(cond, bar) do { unsigned _sp = 0; while (cond) { __builtin_amdgcn_s_sleep(1); \
    if ((++_sp & 255u) == 0u) { if (xb_ld(&(bar)[XB_TMO])) break; if (_sp > XB_SPIN_CAP) { atomicAdd(&(bar)[XB_TMO], 1u); break; } } } } while (0)
struct XcdBarrier { unsigned* bar; unsigned x; volatile LAS unsigned* st; };
__device__ __forceinline__ XcdBarrier xcd_barrier_post(unsigned* bar, volatile LAS unsigned* st, const bool leader) {
    XcdBarrier b; b.bar = bar; b.x = xb_xcc_id(); b.st = st;
    if (leader) (void)xb_add(&bar[XB_XCNT(b.x)], 1u);
    return b;
}
__device__ __forceinline__ void xcd_barrier_complete(unsigned* bar, unsigned x, unsigned& nloc, unsigned& nx) {
    const unsigned G = gridDim.x * gridDim.y * gridDim.z;
    unsigned sum, cnt, mine, sp = 0u;
    for (;;) {
        sum = 0u; cnt = 0u; mine = 0u;
#pragma unroll
        for (unsigned j = 0; j < 16; ++j) { const unsigned c = xb_ld(&bar[XB_XCNT(j)]); sum += c; cnt += (c > 0u) ? 1u : 0u; mine = (j == x) ? c : mine; }
        if (sum == G) break;
        __builtin_amdgcn_s_sleep(1);
        if ((++sp & 255u) == 0u) { if (xb_ld(&bar[XB_TMO])) break; if (sp > XB_SPIN_CAP) { atomicAdd(&bar[XB_TMO], 1u); break; } }
    }
    nloc = mine > 0u ? mine : 1u; nx = cnt > 0u ? cnt : 1u;
}
__device__ __forceinline__ void xcd_barrier(const XcdBarrier& b, const bool leader) {
    asm volatile("s_waitcnt vmcnt(0)" ::: "memory");
    __syncthreads();
    if (leader) {
        unsigned* bar = b.bar;
        __builtin_amdgcn_s_waitcnt(0);
        unsigned nloc = b.st[0], nx = b.st[1];
        if (nloc == 0u) { xcd_barrier_complete(bar, b.x, nloc, nx); b.st[0] = nloc; b.st[1] = nx; }
        const unsigned old = xb_add(&bar[XB_XSUB(b.x)], 1u);
        const unsigned gen = old / nloc;
        if (old + 1u == (gen + 1u) * nloc) {
            __builtin_amdgcn_fence(__ATOMIC_RELEASE, "agent");
            asm volatile("s_waitcnt vmcnt(0)" ::: "memory");
            const unsigned og = xb_add(&bar[XB_TOP], 1u);
            const unsigned tg = og / nx;
            if (og + 1u == (tg + 1u) * nx) xb_add(&bar[XB_TOPGEN], 1u);
            else XB_SPIN(xb_ld(&bar[XB_TOPGEN]) == tg, bar);
            __builtin_amdgcn_fence(__ATOMIC_ACQUIRE, "agent");
            xb_add(&bar[XB_XGEN(b.x)], 1u);
            asm volatile("s_waitcnt vmcnt(0)" ::: "memory");
        } else {
            XB_SPIN(xb_ld(&bar[XB_XGEN(b.x)]) == gen, bar);
            __builtin_amdgcn_fence(__ATOMIC_ACQUIRE, "agent");
            asm volatile("s_waitcnt vmcnt(0)" ::: "memory");
        }
    }
    __syncthreads();
}

typedef __attribute__((ext_vector_type(2))) __bf16 bf16x2_t;
typedef __attribute__((ext_vector_type(2))) float f32x2_t;
__device__ __forceinline__ unsigned cvtpk(float lo, float hi) { f32x2_t f; f[0] = lo; f[1] = hi; return __builtin_bit_cast(unsigned, __builtin_convertvector(f, bf16x2_t)); }
__device__ __forceinline__ float bf2f(unsigned v16) { return __uint_as_float(v16 << 16); }
__device__ __forceinline__ int crow(int r, int hi) { return (r & 3) + 8 * (r >> 2) + 4 * hi; }
#define MFMA_BF16(a, b, c) __builtin_amdgcn_mfma_f32_32x32x16_bf16(a, b, c, 0, 0, 0)
__device__ __forceinline__ float wave_sum(float v) {
    v += __int_as_float(__builtin_amdgcn_update_dpp(0, __float_as_int(v), 0xB1, 0xF, 0xF, true));
    v += __int_as_float(__builtin_amdgcn_update_dpp(0, __float_as_int(v), 0x4E, 0xF, 0xF, true));
    v += __int_as_float(__builtin_amdgcn_update_dpp(0, __float_as_int(v), 0x141, 0xF, 0xF, true));
    v += __int_as_float(__builtin_amdgcn_update_dpp(0, __float_as_int(v), 0x140, 0xF, 0xF, true));
    const int vi = __float_as_int(v);
    return (__int_as_float(__builtin_amdgcn_readlane(vi, 0)) + __int_as_float(__builtin_amdgcn_readlane(vi, 16))) + (__int_as_float(__builtin_amdgcn_readlane(vi, 32)) + __int_as_float(__builtin_amdgcn_readlane(vi, 48)));
}

namespace pg8 {
#define PG8_LAS __attribute__((address_space(3)))
typedef unsigned short bf16_t;
typedef short bf16x8 __attribute__((ext_vector_type(8)));
typedef float f32x4 __attribute__((ext_vector_type(4)));
typedef unsigned u32x4 __attribute__((ext_vector_type(4)));
typedef int pg8_i32x8 __attribute__((ext_vector_type(8)));
constexpr int BM = 256, BK = 64, HALF = 128, HTB = HALF * BK * 2  , STAGE_BYTES = 8 * HTB, NXCD = 8, WGM = 8;

__host__ __device__ __forceinline__ int lds_byte(int r, int c) { const int st = (r >> 4) * 2 + (c >> 5), rr = r & 15, cc = c & 31, ob = rr * 64 + cc * 2; return st * 1024 + (ob ^ (((ob >> 9) & 1) << 5)); }
__host__ __device__ __forceinline__ void stage_rc(int b, int& R, int& C) { const int st = b / 1024, sb = b % 1024, swz = sb ^ (((sb >> 9) & 1) << 5); R = (st >> 1) * 16 + swz / 64; C = (st & 1) * 32 + (swz % 64) / 2; }
__device__ __forceinline__ int pg8_opq(int v) { asm volatile("" : "+v"(v)); return v; }
__host__ __device__ __forceinline__ int perm32(int rho) { const int n = rho >> 4, i = rho & 15; return 8 * (i >> 2) + 4 * n + (i & 3); }

struct Unit { int pm, pn; };
struct Gemm { const bf16_t* A; const bf16_t* Bt; int M, N, K; };
struct FixedOrder {
    int pm, pn;
    __device__ __forceinline__ bool next(int i, Unit& u) const { if (i != 0) return false; u.pm = pm; u.pn = pn; return true; }
    __device__ __forceinline__ void a_ready(const Unit&) const {}
    __device__ __forceinline__ void done(const Unit&) const {}
};

struct StaticOrder {
    int nM, nN, nwg, G, c;
    __host__ __device__ void init(int M, int N, int G_, int c_) { nM = M / BM; nN = N / BM; nwg = nM * nN; G = G_; c = c_; }
    __host__ __device__ bool next(int i, Unit& u) const {
        const long L = (long)i * G + c; if (L >= nwg) return false;
        int wgid = (int)L; { const int q = nwg / NXCD, r = nwg % NXCD, xcd = wgid % NXCD, off = wgid / NXCD; wgid = (xcd < r ? xcd * (q + 1) : r * (q + 1) + (xcd - r) * q) + off; }
        const int nig = WGM * nN, gid = wgid / nig, fm = gid * WGM, gsz = (nM - fm) < WGM ? (nM - fm) : WGM;
        u.pm = fm + ((wgid % nig) % gsz); u.pn = (wgid % nig) / gsz; return true;
    }
    __device__ __forceinline__ void a_ready(const Unit&) const {}
    __device__ __forceinline__ void done(const Unit&) const {}
};

template <class Epi, class Sched, bool SWAP = false, bool STAMP = false, bool F8 = false, int F8SC = 0x7F79  >
__device__ __forceinline__ void gemm_phase(PG8_LAS unsigned char* lds, const Gemm g, const Sched& S, const Epi& E, unsigned long long* stamps, const int tid_in) {
    int tid_ = tid_in; asm volatile("" : "+v"(tid_));
    const int tid = tid_, wid = __builtin_amdgcn_readfirstlane(tid >> 6), lane = tid & 63, wr = wid >> 2, wc = wid & 3, fr = lane & 15, fq = lane >> 4;
    const int K = g.K, nt = K / BK;
    int ts_lo = 0, ts_hi = 0, nts = 0; const unsigned long long rt_entry = STAMP ? (unsigned long long)wall_clock64() : 0ull;
#define PG8_STAMP() do { if (STAMP && wid == 0 && nts < 64) { const unsigned long long _c = (unsigned long long)clock64(); \
        ts_lo = (lane == nts) ? (int)(unsigned)_c : ts_lo; ts_hi = (lane == nts) ? (int)(unsigned)(_c >> 32) : ts_hi; ++nts; } } while (0)
    PG8_STAMP();
    unsigned voffA[2], voffB[2];
#pragma unroll
    for (int i = 0; i < 2; ++i) { int R, C; stage_rc(tid * 16 + i * 8192, R, C); const int Rb = Epi::PERM ? ((R & ~31) + perm32(R & 31)) : R;
        voffA[i] = (unsigned)(R * K + C) * 2u; voffB[i] = (unsigned)(Rb * K + C) * 2u; }
    const size_t kstep = (size_t)(BK * 2);
    const size_t hstep = (size_t)HALF * K * 2;
    const size_t tstep = 2 * hstep;
    const unsigned ldsw = (unsigned)wid * 1024u;
    int xoff_ = lds_byte(fr, fq * 8); asm volatile("" : "+v"(xoff_));
    const int aoffs = wr * 8192, boffs = wc * 4096;
#define aoff (aoffs + pg8_opq(xoff_))
#define boff (boffs + pg8_opq(xoff_))
#define PG8_SA(b, h) (((b) * 2 + (h)) * HTB)
#define PG8_SB(b, h) ((4 + (b) * 2 + (h)) * HTB)
#define PG8_STAGE(bufoff, gbase, voff) do {   \
        _Pragma("unroll") for (int _i = 0; _i < 2; ++_i) { uint64_t gb_ = (uint64_t)(gbase) + (uint64_t)_i * (size_t)(64 * 2) * K; asm volatile("" : "+s"(gb_)); unsigned vo_ = (voff)[0]; asm volatile("" : "+v"(vo_)); \
        __builtin_amdgcn_global_load_lds((const __attribute__((address_space(1))) unsigned*)((const __attribute__((address_space(1))) char*)gb_ + vo_), (PG8_LAS unsigned*)(lds + (bufoff) + ldsw + _i * 8192), 16, 0, 0); } } while (0)
#define PG8_CAT8(X0, X1) pg8_i32x8{(int)__builtin_bit_cast(u32x4, X0)[0], (int)__builtin_bit_cast(u32x4, X0)[1], (int)__builtin_bit_cast(u32x4, X0)[2], (int)__builtin_bit_cast(u32x4, X0)[3], \
                                   (int)__builtin_bit_cast(u32x4, X1)[0], (int)__builtin_bit_cast(u32x4, X1)[1], (int)__builtin_bit_cast(u32x4, X1)[2], (int)__builtin_bit_cast(u32x4, X1)[3]}
#define PG8_LDA(dst, b, h) do { _Pragma("unroll") for (int m = 0; m < 4; ++m) { if (F8) { const bf16x8 x0_ = *(const PG8_LAS bf16x8*)(lds + PG8_SA(b, h) + aoff + m * 2048), x1_ = *(const PG8_LAS bf16x8*)(lds + PG8_SA(b, h) + aoff + m * 2048 + 1024); dst##8[m] = PG8_CAT8(x0_, x1_); } \
        else { _Pragma("unroll") for (int k = 0; k < 2; ++k) dst[m][k] = *(const PG8_LAS bf16x8*)(lds + PG8_SA(b, h) + aoff + m * 2048 + k * 1024); } } } while (0)
#define PG8_LDB(dst, b, h) do { _Pragma("unroll") for (int n = 0; n < 2; ++n) { if (F8) { const bf16x8 x0_ = *(const PG8_LAS bf16x8*)(lds + PG8_SB(b, h) + boff + n * 2048), x1_ = *(const PG8_LAS bf16x8*)(lds + PG8_SB(b, h) + boff + n * 2048 + 1024); dst##8[n] = PG8_CAT8(x0_, x1_); } \
        else { _Pragma("unroll") for (int k = 0; k < 2; ++k) dst[n][k] = *(const PG8_LAS bf16x8*)(lds + PG8_SB(b, h) + boff + n * 2048 + k * 1024); } } } while (0)
#define PG8_MMA(ai, bj, At, Bt) do { __builtin_amdgcn_s_setprio(1); _Pragma("unroll") for (int m = 0; m < 4; ++m) _Pragma("unroll") for (int n = 0; n < 2; ++n) _Pragma("unroll") for (int k = 0; k < 2; ++k) \
        { if (F8) { if (k == 0) acc[ai][bj][m][n] = __builtin_amdgcn_mfma_scale_f32_16x16x128_f8f6f4(Bt##8[n], At##8[m], acc[ai][bj][m][n], 0, 0, 0, F8SC, 1, F8SC); } \
          else acc[ai][bj][m][n] = SWAP ? __builtin_amdgcn_mfma_f32_16x16x32_bf16(At[m][k], Bt[n][k], acc[ai][bj][m][n], 0, 0, 0) : __builtin_amdgcn_mfma_f32_16x16x32_bf16(Bt[n][k], At[m][k], acc[ai][bj][m][n], 0, 0, 0); } __builtin_amdgcn_s_setprio(0); } while (0)
#define PG8_WAIT_V(n) asm volatile("s_waitcnt vmcnt(" #n ")" ::: "memory")
#define PG8_WAIT_L(n) asm volatile("s_waitcnt lgkmcnt(" #n ")" ::: "memory")
#define PG8_BAR __builtin_amdgcn_s_barrier()
#define PG8_SCHED __builtin_amdgcn_sched_barrier(0)
    Unit cur, nxt; int ui = 0;
    if (!S.next(0, cur)) return;
    f32x4 acc[2][2][4][2];
#pragma unroll
    for (int a = 0; a < 2; ++a)
#pragma unroll
        for (int b = 0; b < 2; ++b)
#pragma unroll
            for (int m = 0; m < 4; ++m)
#pragma unroll
                for (int n = 0; n < 2; ++n) acc[a][b][m][n] = (f32x4){0.f, 0.f, 0.f, 0.f};
    bf16x8 At[4][2], B0[2][2], B1[2][2];
    pg8_i32x8 At8[4], B08[2], B18[2];
    const char* cA = (const char*)g.A + (size_t)cur.pm * tstep; const char* cB = (const char*)g.Bt + (size_t)cur.pn * tstep;
    S.a_ready(cur);
    PG8_STAGE(PG8_SB(0, 0), cB, voffB); PG8_STAGE(PG8_SA(0, 0), cA, voffA); PG8_STAGE(PG8_SB(0, 1), cB + hstep, voffB); PG8_STAGE(PG8_SA(0, 1), cA + hstep, voffA);
    if (wr == 1) PG8_BAR;
    PG8_WAIT_V(4); PG8_BAR;
    PG8_STAGE(PG8_SB(1, 0), cB + kstep, voffB); PG8_STAGE(PG8_SA(1, 0), cA + kstep, voffA); PG8_STAGE(PG8_SB(1, 1), cB + hstep + kstep, voffB);
    PG8_WAIT_V(6); PG8_BAR;
    PG8_STAMP();
    for (;;) {
        const bool has_next = S.next(ui + 1, nxt);
        const char* nA = has_next ? (const char*)g.A + (size_t)nxt.pm * tstep : cA; const char* nB = has_next ? (const char*)g.Bt + (size_t)nxt.pn * tstep : cB;
        for (int t = 0; t < nt; t += 2) {
            const bool last = (t == nt - 2);
            const char* a1 = cA + (size_t)(t + 1) * kstep;
            const char* a2 = last ? nA : cA + (size_t)(t + 2) * kstep; const char* b2 = last ? nB : cB + (size_t)(t + 2) * kstep;
            const char* a3 = a2 + kstep; const char* b3 = b2 + kstep;
            if (last && has_next) S.a_ready(nxt);
            PG8_LDB(B0, 0, 0); PG8_SCHED; PG8_LDA(At, 0, 0); PG8_STAGE(PG8_SA(1, 1), a1 + hstep, voffA);
            PG8_WAIT_L(8); PG8_BAR; PG8_WAIT_L(0); PG8_MMA(0, 0, At, B0); PG8_BAR; PG8_SCHED;
            PG8_LDB(B1, 0, 1); PG8_STAGE(PG8_SB(0, 0), b2, voffB);
            PG8_BAR; PG8_WAIT_L(0); PG8_MMA(0, 1, At, B1); PG8_BAR;
            PG8_LDA(At, 0, 1); PG8_STAGE(PG8_SA(0, 0), a2, voffA);
            PG8_BAR; PG8_WAIT_L(0); PG8_MMA(1, 0, At, B0); PG8_BAR; PG8_SCHED;
            PG8_STAGE(PG8_SB(0, 1), b2 + hstep, voffB);
            PG8_WAIT_V(6); PG8_BAR; PG8_MMA(1, 1, At, B1); PG8_BAR;
            PG8_LDB(B0, 1, 0); PG8_SCHED; PG8_LDA(At, 1, 0); PG8_STAGE(PG8_SA(0, 1), a2 + hstep, voffA);
            PG8_WAIT_L(8); PG8_BAR; PG8_WAIT_L(0); PG8_MMA(0, 0, At, B0); PG8_BAR; PG8_SCHED;
            PG8_LDB(B1, 1, 1); PG8_STAGE(PG8_SB(1, 0), b3, voffB);
            PG8_BAR; PG8_WAIT_L(0); PG8_MMA(0, 1, At, B1); PG8_BAR;
            PG8_LDA(At, 1, 1); PG8_STAGE(PG8_SA(1, 0), a3, voffA);
            PG8_BAR; PG8_WAIT_L(0); PG8_MMA(1, 0, At, B0); PG8_BAR; PG8_SCHED;
            PG8_STAGE(PG8_SB(1, 1), b3 + hstep, voffB);
            PG8_WAIT_V(6); PG8_BAR; PG8_MMA(1, 1, At, B1); PG8_BAR;
        }
        PG8_STAMP();
        if constexpr (!Epi::AFTER_DRAIN) { const int le_ = lane_id_(); E(acc, cur, wr, wc, le_ & 15, le_ >> 4); S.done(cur); }
        PG8_STAMP();
        if (!has_next) break;
#pragma unroll
        for (int a = 0; a < 2; ++a)
#pragma unroll
            for (int b = 0; b < 2; ++b)
#pragma unroll
                for (int m = 0; m < 4; ++m)
#pragma unroll
                    for (int n = 0; n < 2; ++n) acc[a][b][m][n] = (f32x4){0.f, 0.f, 0.f, 0.f};
        cur = nxt; cA = nA; cB = nB; ++ui;
    }
    PG8_WAIT_V(0);
    if (wr == 0) PG8_BAR;
    PG8_BAR;
    if constexpr (Epi::AFTER_DRAIN) { E.fused(acc, cur, wr, wc, fr, fq, lds, wid, lane); S.done(cur); }
    PG8_STAMP();
    if (STAMP && wid == 0) { stamps[lane] = lane < nts ? (((unsigned long long)(unsigned)ts_hi << 32) | (unsigned)ts_lo) : 0ull;
        if (lane == 62) stamps[62] = rt_entry; if (lane == 63) stamps[63] = (unsigned long long)wall_clock64(); }
#undef PG8_STAMP
#undef PG8_SA
#undef PG8_SB
#undef PG8_STAGE
#undef aoff
#undef boff
#undef PG8_LDA
#undef PG8_LDB
#undef PG8_MMA
#undef PG8_WAIT_V
#undef PG8_WAIT_L
#undef PG8_BAR
#undef PG8_SCHED
}
}

struct EpiQK {
    static constexpr bool PERM = true, AFTER_DRAIN = false;
    u16* O; int ldc; float* KM;
    __device__ __forceinline__ void operator()(const pg8::f32x4 (&acc)[2][2][4][2], const pg8::Unit& u, int wr, int wc, int fr, int fq) const {
        if (KM != nullptr && (u.pn >> 2) == 1) {
#pragma unroll
            for (int bj = 0; bj < 2; ++bj)
#pragma unroll
                for (int n = 0; n < 2; ++n)
#pragma unroll
                    for (int i = 0; i < 4; ++i) {
                        float sm = 0.f;
#pragma unroll
                        for (int ai = 0; ai < 2; ++ai)
#pragma unroll
                            for (int m = 0; m < 4; ++m) sm += acc[ai][bj][m][n][i];
                        sm += __int_as_float(__builtin_amdgcn_update_dpp(0, __float_as_int(sm), 0xB1, 0xF, 0xF, true));
                        sm += __int_as_float(__builtin_amdgcn_update_dpp(0, __float_as_int(sm), 0x4E, 0xF, 0xF, true));
                        sm += __int_as_float(__builtin_amdgcn_update_dpp(0, __float_as_int(sm), 0x141, 0xF, 0xF, true));
                        sm += __int_as_float(__builtin_amdgcn_update_dpp(0, __float_as_int(sm), 0x140, 0xF, 0xF, true));
                        const int ck = (u.pn - 4) * 256 + bj * 128 + wc * 32 + 8 * fq + 4 * n + i;
                        if (fr == 0) atomicAdd(KM + ((size_t)((u.pm >> 5) * NH + (ck >> 6)) * MOBA_NB + (u.pm & 31)) * 64 + (ck & 63), sm * (1.f / MOBA_BLK));
                    }
        }
        uint64_t ob_ = (uint64_t)O; asm volatile("" : "+s"(ob_));
        unsigned off0 = ((unsigned)(u.pm * 256 + wr * 64 + fr) * (unsigned)ldc + (unsigned)(u.pn * 256 + wc * 32 + 8 * fq)) * 2u; asm volatile("" : "+v"(off0));
        const unsigned rstep = (unsigned)ldc * 32u;
#pragma unroll
        for (int ai = 0; ai < 2; ++ai)
#pragma unroll
            for (int m = 0; m < 4; ++m) { unsigned ro = off0 + (unsigned)(ai * 8 + m) * rstep; asm volatile("" : "+v"(ro));
#pragma unroll
                for (int bj = 0; bj < 2; ++bj) { const pg8::f32x4 v0 = acc[ai][bj][m][0], v1 = acc[ai][bj][m][1];
                    u32x4 w; w[0] = cvtpk(v0[0], v0[1]); w[1] = cvtpk(v0[2], v0[3]); w[2] = cvtpk(v1[0], v1[1]); w[3] = cvtpk(v1[2], v1[3]);
                    *(__attribute__((address_space(1))) u32x4*)((__attribute__((address_space(1))) char*)ob_ + ro + bj * 256) = w; } }
    }
};
struct EpiV {
    static constexpr bool PERM = false, AFTER_DRAIN = false;
    u16* VT; int layer;
    __device__ __forceinline__ void operator()(const pg8::f32x4 (&acc)[2][2][4][2], const pg8::Unit& u, int wr, int wc, int fr, int fq) const {
        const int colt = u.pn * 256, grp = colt >> 10;
        const int dil = (layer == 0 || grp == 0) ? 1 : (grp == 1 ? 4 : 16);
        const int rowb = u.pm * 256 + wr * 64 + 4 * fq;
#pragma unroll
        for (int bj = 0; bj < 2; ++bj)
#pragma unroll
            for (int n = 0; n < 2; ++n) {
                const int c = (colt & 1023) + bj * 128 + wc * 32 + n * 16 + fr, h = c >> 6, d = c & 63;
#pragma unroll
                for (int ai = 0; ai < 2; ++ai)
#pragma unroll
                    for (int m = 0; m < 4; ++m) {
                        const int r0 = rowb + ai * 128 + m * 16, b = r0 >> 13, t0 = r0 & (SEQ - 1);
                        u16* vrow = VT + (size_t)grp * T * D + ((size_t)(b * NH + h) * HD + d) * SEQ;
                        const pg8::f32x4 v = acc[ai][bj][m][n];
                        if (dil == 1) { u32x2 w; w[0] = cvtpk(v[0], v[1]); w[1] = cvtpk(v[2], v[3]); *(u32x2*)(vrow + t0) = w; }
                        else {
#pragma unroll
                            for (int i = 0; i < 4; ++i) { const int pp = t0 + i; vrow[(pp % dil) * (SEQ / dil) + pp / dil] = (u16)cvtpk(v[i], 0.f); }
                        }
                    }
            }
    }
};
struct EpiWo {
    static constexpr bool PERM = true, AFTER_DRAIN = false;
    u16* Y; const u16* X;
    __device__ __forceinline__ void operator()(const pg8::f32x4 (&acc)[2][2][4][2], const pg8::Unit& u, int wr, int wc, int fr, int fq) const {
        const int row0 = u.pm * 256 + wr * 64 + fr, col0 = u.pn * 256 + wc * 32 + 8 * fq;
#pragma unroll
        for (int ai = 0; ai < 2; ++ai)
#pragma unroll
            for (int m = 0; m < 4; ++m) { const size_t ro = (size_t)(row0 + ai * 128 + m * 16) * D + col0;
#pragma unroll
                for (int bj = 0; bj < 2; ++bj) { const pg8::f32x4 v0 = acc[ai][bj][m][0], v1 = acc[ai][bj][m][1];
                    const u32x4 xr = *(const u32x4*)(X + ro + bj * 128);
                    u32x4 w;
                    w[0] = cvtpk(bf2f(xr[0] & 0xFFFFu) * DN_ALPHA + v0[0], bf2f(xr[0] >> 16) * DN_ALPHA + v0[1]); w[1] = cvtpk(bf2f(xr[1] & 0xFFFFu) * DN_ALPHA + v0[2], bf2f(xr[1] >> 16) * DN_ALPHA + v0[3]);
                    w[2] = cvtpk(bf2f(xr[2] & 0xFFFFu) * DN_ALPHA + v1[0], bf2f(xr[2] >> 16) * DN_ALPHA + v1[1]); w[3] = cvtpk(bf2f(xr[3] & 0xFFFFu) * DN_ALPHA + v1[2], bf2f(xr[3] >> 16) * DN_ALPHA + v1[3]);
                    *(u32x4*)(Y + ro + bj * 128) = w; } }
    }
};
struct EpiSGU {
    static constexpr bool PERM = true, AFTER_DRAIN = false;
    u16* H;
    __device__ __forceinline__ void operator()(const pg8::f32x4 (&acc)[2][2][4][2], const pg8::Unit& u, int wr, int wc, int fr, int fq) const {
        const int row0 = u.pm * 256 + wr * 64 + fr, f0 = u.pn * 128 + wc * 32 + 8 * fq;
#pragma unroll
        for (int ai = 0; ai < 2; ++ai)
#pragma unroll
            for (int m = 0; m < 4; ++m) {
                float hv[8];
#pragma unroll
                for (int n = 0; n < 2; ++n)
#pragma unroll
                    for (int i = 0; i < 4; ++i) { const float gt = acc[ai][0][m][n][i], up = acc[ai][1][m][n][i]; hv[n * 4 + i] = gt / (1.f + __expf(-gt)) * up; }
                u32x4 w; w[0] = cvtpk(hv[0], hv[1]); w[1] = cvtpk(hv[2], hv[3]); w[2] = cvtpk(hv[4], hv[5]); w[3] = cvtpk(hv[6], hv[7]);
                *(u32x4*)(H + (size_t)(row0 + ai * 128 + m * 16) * DF + f0) = w;
            }
    }
};
struct EpiSD {
    static constexpr bool PERM = true, AFTER_DRAIN = false;
    u16* Y;
    __device__ __forceinline__ void operator()(const pg8::f32x4 (&acc)[2][2][4][2], const pg8::Unit& u, int wr, int wc, int fr, int fq) const {
        const int row0 = u.pm * 256 + wr * 64 + fr, col0 = u.pn * 256 + wc * 32 + 8 * fq;
#pragma unroll
        for (int ai = 0; ai < 2; ++ai)
#pragma unroll
            for (int m = 0; m < 4; ++m) { u16* rowp = Y + (size_t)(A_TOT + row0 + ai * 128 + m * 16) * D + col0;
#pragma unroll
                for (int bj = 0; bj < 2; ++bj) { const pg8::f32x4 v0 = acc[ai][bj][m][0], v1 = acc[ai][bj][m][1];
                    u32x4 w; w[0] = cvtpk(v0[0], v0[1]); w[1] = cvtpk(v0[2], v0[3]); w[2] = cvtpk(v1[0], v1[1]); w[3] = cvtpk(v1[2], v1[3]);
                    *(u32x4*)(rowp + bj * 128) = w; } }
    }
};

struct Args {
    const float* in[16];
    float* out;
    unsigned char* ws;
    int ph_lo, ph_hi;
};

#define GEMM_CORE(K_, PA0, PA1, PB, LDB)                                                                                                   \
    {                                                                                                                                      \
        const int g_tid = tid, g_lane = lane, g_wave = wave, g_r32 = r32, g_hi = hi;                   \
        const int g_wm = g_wave >> 2, g_wn = g_wave & 3, g_kc = g_tid & 3, g_kq = g_lane >> 3, g_n4 = g_lane & 7;                           \
        const u16* g_pa0 = (PA0); const u16* g_pa1 = (PA1);                                                                                \
        const size_t g_ldb = (size_t)(LDB);                                                                                                \
        const float* g_pb = (PB) + (size_t)(g_kq * 4) * g_ldb + g_n4 * 4;                                                                  \
        const int g_nk = (K_) / 32;                                                                                                        \
        u32x4 g_ra0, g_ra1; f32x4 g_rb0, g_rb1, g_rb2, g_rb3;                                                                              \
        const u32x4 g_z = {0u, 0u, 0u, 0u};                                                                                                \
        _Pragma("unroll") for (int mb = 0; mb < 4; ++mb) { _Pragma("unroll") for (int nb = 0; nb < 2; ++nb) { _Pragma("unroll") for (int r = 0; r < 16; ++r) acc[mb][nb][r] = 0.f; } } \
        g_ra0 = g_pa0 ? *(const u32x4*)(g_pa0 + g_kc * 8) : g_z; g_ra1 = g_pa1 ? *(const u32x4*)(g_pa1 + g_kc * 8) : g_z;                 \
        g_rb0 = *(const f32x4*)(g_pb); g_rb1 = *(const f32x4*)(g_pb + g_ldb); g_rb2 = *(const f32x4*)(g_pb + 2 * g_ldb); g_rb3 = *(const f32x4*)(g_pb + 3 * g_ldb); \
        _Pragma("unroll 1") for (int kt = 0; kt < g_nk; ++kt) {                                                                            \
            LAS char* As = lds + (kt & 1) * STAGE_BYTES; LAS char* Bs = As + 256 * LDP * 2;                                                \
            *(LAS u32x4*)(As + ((g_tid >> 2) * LDP + g_kc * 8) * 2) = g_ra0;                                                               \
            *(LAS u32x4*)(As + (((g_tid >> 2) + 128) * LDP + g_kc * 8) * 2) = g_ra1;                                                       \
            _Pragma("unroll") for (int i = 0; i < 4; ++i) {                                                                                \
                u32x2 w; w[0] = cvtpk(g_rb0[i], g_rb1[i]); w[1] = cvtpk(g_rb2[i], g_rb3[i]);                                               \
                *(LAS u32x2*)(Bs + ((g_wave * 32 + i * 8 + g_n4) * LDP + g_kq * 4) * 2) = w;                                               \
            }                                                                                                                              \
            __syncthreads();                                                                                                               \
            if (kt + 1 < g_nk) {                                                                                                           \
                const int ko = (kt + 1) * 32;                                                                                              \
                g_ra0 = g_pa0 ? *(const u32x4*)(g_pa0 + ko + g_kc * 8) : g_z; g_ra1 = g_pa1 ? *(const u32x4*)(g_pa1 + ko + g_kc * 8) : g_z; \
                const float* pbk = g_pb + (size_t)ko * g_ldb;                                                                              \
                g_rb0 = *(const f32x4*)(pbk); g_rb1 = *(const f32x4*)(pbk + g_ldb); g_rb2 = *(const f32x4*)(pbk + 2 * g_ldb); g_rb3 = *(const f32x4*)(pbk + 3 * g_ldb); \
            }                                                                                                                              \
            _Pragma("unroll") for (int s = 0; s < 2; ++s) {                                                                                \
                bf16x8 af[4], bfr[2];                                                                                                      \
                _Pragma("unroll") for (int mb = 0; mb < 4; ++mb) af[mb] = *(LAS bf16x8*)(As + ((g_wm * 128 + mb * 32 + g_r32) * LDP + s * 16 + g_hi * 8) * 2); \
                _Pragma("unroll") for (int nb = 0; nb < 2; ++nb) bfr[nb] = *(LAS bf16x8*)(Bs + (((g_wn * 2 + nb) * 32 + g_r32) * LDP + s * 16 + g_hi * 8) * 2); \
                _Pragma("unroll") for (int mb = 0; mb < 4; ++mb) { _Pragma("unroll") for (int nb = 0; nb < 2; ++nb) acc[mb][nb] = MFMA_BF16(af[mb], bfr[nb], acc[mb][nb]); } \
            }                                                                                                                              \
        }                                                                                                                                  \
        __syncthreads();                                                                                                                   \
    }

struct AttnSt { float m, l; f32x16 o0, o1; };

struct AttnFr { bf16x8 k[4]; bf16x8 v[4]; };
__device__ __forceinline__ void attn_load(AttnFr& f, const u16* krow, const u16* vt, size_t vt_dstride) {
#pragma unroll
    for (int d0 = 0; d0 < 4; ++d0) f.k[d0] = *(const bf16x8*)(krow + d0 * 16);
    const u16* vt1 = vt + 32 * vt_dstride;
    union { bf16x8 v; u32x2 h[2]; } va;
    va.h[0] = *(const u32x2*)(vt);       va.h[1] = *(const u32x2*)(vt + 8);   f.v[0] = va.v;
    va.h[0] = *(const u32x2*)(vt + 16);  va.h[1] = *(const u32x2*)(vt + 24);  f.v[1] = va.v;
    va.h[0] = *(const u32x2*)(vt1);      va.h[1] = *(const u32x2*)(vt1 + 8);  f.v[2] = va.v;
    va.h[0] = *(const u32x2*)(vt1 + 16); va.h[1] = *(const u32x2*)(vt1 + 24); f.v[3] = va.v;
}
template <bool MASK = true>
__device__ __forceinline__ void attn_compute(AttnSt& st, const bf16x8 (&qf)[4], const AttnFr& f, int dist0, float bslope, int dlo, int dhi, int hi, int lane) {
    f32x16 p;
#pragma unroll
    for (int r = 0; r < 16; ++r) p[r] = 0.f;
#pragma unroll
    for (int d0 = 0; d0 < 4; ++d0) p = MFMA_BF16(f.k[d0], qf[d0], p);
    constexpr float C2 = 0.125f * LOG2E;
    float mx = NEGV;
    const float bbase = -bslope * (float)dist0;
#pragma unroll
    for (int r = 0; r < 16; ++r) {
        const float sc = __builtin_fmaf(p[r], C2, __builtin_fmaf(bslope, (float)((r & 3) + 8 * (r >> 2)), bbase));
        float s_ = sc;
        if (MASK) { const int dist = dist0 - ((r & 3) + 8 * (r >> 2)); s_ = (dist >= dlo && dist <= dhi) ? sc : NEGV; }
        p[r] = s_; mx = fmaxf(mx, s_);
    }
    mx = fmaxf(mx, shxf(mx, 32, lane));
    const float mnew = fmaxf(st.m, mx);
    const float alpha = __builtin_amdgcn_exp2f(st.m - mnew);
    st.m = mnew;
    float ls = 0.f;
#pragma unroll
    for (int r = 0; r < 16; ++r) { p[r] = __builtin_amdgcn_exp2f(p[r] - mnew); ls += p[r]; }
    st.l = st.l * alpha + ls;
#pragma unroll
    for (int r = 0; r < 16; ++r) { st.o0[r] *= alpha; st.o1[r] *= alpha; }
    union { bf16x8 v; unsigned u[4]; } pb0, pb1;
#pragma unroll
    for (int j = 0; j < 4; ++j) { pb0.u[j] = cvtpk(p[2 * j], p[2 * j + 1]); pb1.u[j] = cvtpk(p[8 + 2 * j], p[8 + 2 * j + 1]); }
    st.o0 = MFMA_BF16(f.v[0], pb0.v, st.o0);
    st.o0 = MFMA_BF16(f.v[1], pb1.v, st.o0);
    st.o1 = MFMA_BF16(f.v[2], pb0.v, st.o1);
    st.o1 = MFMA_BF16(f.v[3], pb1.v, st.o1);
    (void)hi;
}

__device__ __forceinline__ f32x16 attn_qk(const bf16x8 (&qf)[4], const bf16x8 (&kf)[4]) {
    f32x16 p;
#pragma unroll
    for (int r = 0; r < 16; ++r) p[r] = 0.f;
#pragma unroll
    for (int d0 = 0; d0 < 4; ++d0) p = MFMA_BF16(kf[d0], qf[d0], p);
    return p;
}
template <bool MASK>
__device__ __forceinline__ void attn_smpv(AttnSt& st, f32x16 p, const bf16x8 (&vf)[4], int dist0, float bslope, int dlo, int dhi, int lane) {
    constexpr float C2 = 0.125f * LOG2E;
    float mx = NEGV;
    const float bbase = -bslope * (float)dist0;
#pragma unroll
    for (int r = 0; r < 16; ++r) {
        const float sc = __builtin_fmaf(p[r], C2, __builtin_fmaf(bslope, (float)((r & 3) + 8 * (r >> 2)), bbase));
        float s_ = sc;
        if (MASK) { const int dist = dist0 - ((r & 3) + 8 * (r >> 2)); s_ = (dist >= dlo && dist <= dhi) ? sc : NEGV; }
        p[r] = s_; mx = fmaxf(mx, s_);
    }
    mx = fmaxf(mx, shxf(mx, 32, lane));
    const float mnew = fmaxf(st.m, mx);
    const float alpha = __builtin_amdgcn_exp2f(st.m - mnew);
    st.m = mnew;
#pragma unroll
    for (int r = 0; r < 16; ++r) { st.o0[r] *= alpha; st.o1[r] *= alpha; }
    float ls = 0.f;
    union { bf16x8 v; unsigned u[4]; } pb0, pb1;
#pragma unroll
    for (int r = 0; r < 8; ++r) { p[r] = __builtin_amdgcn_exp2f(p[r] - mnew); ls += p[r]; }
#pragma unroll
    for (int j = 0; j < 4; ++j) pb0.u[j] = cvtpk(p[2 * j], p[2 * j + 1]);
    st.o0 = MFMA_BF16(vf[0], pb0.v, st.o0);
    st.o1 = MFMA_BF16(vf[2], pb0.v, st.o1);
#pragma unroll
    for (int r = 8; r < 16; ++r) { p[r] = __builtin_amdgcn_exp2f(p[r] - mnew); ls += p[r]; }
#pragma unroll
    for (int j = 0; j < 4; ++j) pb1.u[j] = cvtpk(p[8 + 2 * j], p[8 + 2 * j + 1]);
    st.o0 = MFMA_BF16(vf[1], pb1.v, st.o0);
    st.o1 = MFMA_BF16(vf[3], pb1.v, st.o1);
    st.l = st.l * alpha + ls;
}


__device__ __forceinline__ float dpp_rowmax(float v) {
    v = fmaxf(v, __int_as_float(__builtin_amdgcn_update_dpp(0, __float_as_int(v), 0xB1, 0xF, 0xF, true)));
    v = fmaxf(v, __int_as_float(__builtin_amdgcn_update_dpp(0, __float_as_int(v), 0x4E, 0xF, 0xF, true)));
    v = fmaxf(v, __int_as_float(__builtin_amdgcn_update_dpp(0, __float_as_int(v), 0x141, 0xF, 0xF, true)));
    v = fmaxf(v, __int_as_float(__builtin_amdgcn_update_dpp(0, __float_as_int(v), 0x140, 0xF, 0xF, true)));
    return v;
}
__device__ __forceinline__ int dpp_rowmin_i(int v) {
    v = min(v, __builtin_amdgcn_update_dpp(0, v, 0xB1, 0xF, 0xF, true));
    v = min(v, __builtin_amdgcn_update_dpp(0, v, 0x4E, 0xF, 0xF, true));
    v = min(v, __builtin_amdgcn_update_dpp(0, v, 0x141, 0xF, 0xF, true));
    v = min(v, __builtin_amdgcn_update_dpp(0, v, 0x140, 0xF, 0xF, true));
    return v;
}
__device__ __forceinline__ float rl_f(float v, int l) { return __int_as_float(__builtin_amdgcn_readlane(__float_as_int(v), l)); }

__device__ __forceinline__ void top3_insert(float v, int i, float& v0, int& i0, float& v1, int& i1, float& v2, int& i2) {
    const bool b0 = (v > v0) || (v == v0 && i < i0);
    const bool b1 = (v > v1) || (v == v1 && i < i1);
    const bool b2 = (v > v2) || (v == v2 && i < i2);
    const float nv2 = b1 ? v1 : (b2 ? v : v2); const int ni2 = b1 ? i1 : (b2 ? i : i2);
    const float nv1 = b0 ? v0 : (b1 ? v : v1); const int ni1 = b0 ? i0 : (b1 ? i : i1);
    const float nv0 = b0 ? v : v0;             const int ni0 = b0 ? i : i0;
    v0 = nv0; i0 = ni0; v1 = nv1; i1 = ni1; v2 = nv2; i2 = ni2;
}

__device__ __forceinline__ void ln_row(float (&v)[16], const float* __restrict__ g, const float* __restrict__ b, int lane) {
    float s = 0.f;
#pragma unroll
    for (int i = 0; i < 16; ++i) s += v[i];
    const float mu = wave_sum(s) * (1.f / D);
    float q = 0.f;
#pragma unroll
    for (int i = 0; i < 16; ++i) { const float d = v[i] - mu; q += d * d; }
    const float rstd = rsqrtf(wave_sum(q) * (1.f / D) + LN_EPS);
#pragma unroll
    for (int j = 0; j < 4; ++j) {
        const f32x4 gg = *(const f32x4*)(g + j * 256 + lane * 4), bb = *(const f32x4*)(b + j * 256 + lane * 4);
#pragma unroll
        for (int c = 0; c < 4; ++c) v[j * 4 + c] = (v[j * 4 + c] - mu) * rstd * gg[c] + bb[c];
    }
}

typedef __attribute__((ext_vector_type(2))) float f32x2_;
__device__ __forceinline__ bf16x8 fp8x8_to_bf16(unsigned lo, unsigned hi_) {
    const f32x2_ a = __builtin_amdgcn_cvt_pk_f32_fp8((int)lo, false), b = __builtin_amdgcn_cvt_pk_f32_fp8((int)lo, true);
    const f32x2_ c = __builtin_amdgcn_cvt_pk_f32_fp8((int)hi_, false), d = __builtin_amdgcn_cvt_pk_f32_fp8((int)hi_, true);
    union { bf16x8 v; unsigned u[4]; } r;
    r.u[0] = cvtpk(a[0], a[1]); r.u[1] = cvtpk(b[0], b[1]); r.u[2] = cvtpk(c[0], c[1]); r.u[3] = cvtpk(d[0], d[1]);
    return r.v;
}
__device__ __forceinline__ unsigned pack_fp8x4(float a, float b, float c, float d) { int p = __builtin_amdgcn_cvt_pk_fp8_f32(a, b, 0, false); return (unsigned)__builtin_amdgcn_cvt_pk_fp8_f32(c, d, p, true); }

constexpr float Y8_SCALE = 16.f;
constexpr bool MOE_DOWN_XC = true;
constexpr int MOE_XCAP = 576;
#define MOE_GAS __attribute__((address_space(1)))
typedef MOE_GAS unsigned char moe_gcb;
constexpr int MOE_BP = 72;
constexpr int MOE_BSTAGE = 128 * MOE_BP * 2;
constexpr int MOE_LDS_VA = 3 * MOE_BSTAGE;
constexpr int MOE_LDS_W = MOE_LDS_VA + 4096;
constexpr int MOE_LDS_XCH = 65536;
template <bool DOWN, bool XC = !DOWN  >
__device__ __forceinline__ void moe_expert(LAS char* lds, const int tid, const int lane, const int wave, const int r32, const int hi,
                                           const unsigned char* __restrict__ abase  , const float* __restrict__ w0, const float* __restrict__ w1, const int ng  , void* __restrict__ outv,
                                           const int pass0, const int npass_, const int st0, const int nstl  , const bool y8 = false  ,
                                           const bool xr = false  ,
                                           const int prot = 0  ) {
    constexpr int KT = DOWN ? 4 : 16, NP = DOWN ? 8 : 4, LDB = DOWN ? 1024 : 256, APITCH = DOWN ? 256 : 1024  , PSTEP = DOWN ? 128 : 64;
    LAS int* rowva = (LAS int*)(lds + MOE_LDS_VA); LAS float* roww = (LAS float*)(lds + MOE_LDS_W);
    const int nst = nstl;
    const int nsteps = npass_ * nst * KT; (void)NP;
    unsigned aoff[2];
#define MOE_AOFF(ST_) { _Pragma("unroll") for (int a = 0; a < 2; ++a) { const int va_ = rowva[(ST_) * 512 + wave * 64 + a * 32 + r32]; \
        const int srow_ = DOWN ? va_ : (va_ == TRASH_VA ? 0 : (va_ >> 3)); aoff[a] = (unsigned)srow_ * APITCH + hi * 32; } }
    const int seg = wave >> 1, n4 = lane & 7, kp = (wave & 1) * 16 + (lane >> 3);
    const char* wbase = (const char*)(DOWN ? (w0 + seg * 32) : (((seg < 2) ? w0 : w1) + (seg & 1) * 32));
    unsigned boff = (unsigned)(4 * n4 + 2 * kp * LDB) * 4u; asm volatile("" : "+v"(boff));
    unsigned wb_ = (unsigned)((seg * 32 + n4) * MOE_BP + 2 * kp) * 2u; asm volatile("" : "+v"(wb_));
    unsigned lb_ = (unsigned)(r32 * MOE_BP + hi * 32) * 2u; asm volatile("" : "+v"(lb_));
    f32x16 acc[2][4];
#pragma unroll
    for (int a = 0; a < 2; ++a)
#pragma unroll
        for (int c = 0; c < 4; ++c)
#pragma unroll
            for (int r = 0; r < 16; ++r) acc[a][c][r] = 0.f;
    u32x4 fa8[2][2];
    f32x16 accx; u32x4 fa8x[2]; unsigned aoffx = 0u;
#pragma unroll
    for (int r = 0; r < 16; ++r) accx[r] = 0.f;
    fa8x[0] = u32x4{0u, 0u, 0u, 0u}; fa8x[1] = u32x4{0u, 0u, 0u, 0u};
    f32x4 rb0[4], rb1[4];
#define MOE_DEC(S_) const int s2_ = (S_) < nsteps ? (S_) : 0; const int pl_ = s2_ / (nst * KT); const int rm_ = s2_ - pl_ * (nst * KT); const int sl_ = rm_ / KT; const int kt_ = rm_ - sl_ * KT; const int ps_ = pass0 + ((pl_ + prot) & (npass_ - 1)); const int stt_ = st0 + sl_;
#define MOE_LOADB(S_, RB) { MOE_DEC(S_) (void)stt_; \
        uint64_t wu_ = (uint64_t)(wbase + (size_t)(ps_ * PSTEP + kt_ * 64 * LDB) * 4), wv_ = wu_ + 16 * LDB * 4; asm volatile("" : "+s"(wu_), "+s"(wv_));     \
        const moe_gcb* wug_ = (const moe_gcb*)wu_; const moe_gcb* wvg_ = (const moe_gcb*)wv_; \
        unsigned bo_ = boff; asm volatile("" : "+v"(bo_));     \
        RB[0] = *(const MOE_GAS f32x4*)(wug_ + bo_); RB[1] = *(const MOE_GAS f32x4*)(wug_ + bo_ + LDB * 4); RB[2] = *(const MOE_GAS f32x4*)(wvg_ + bo_); RB[3] = *(const MOE_GAS f32x4*)(wvg_ + bo_ + LDB * 4); }
#define MOE_WRITEB(STG, RB) { LAS char* Bs_ = lds + (STG) * MOE_BSTAGE; \
        _Pragma("unroll") for (int i = 0; i < 4; ++i) { LAS unsigned* q_ = (LAS unsigned*)(Bs_ + wb_ + i * (8 * MOE_BP * 2)); q_[0] = cvtpk(RB[0][i], RB[1][i]); q_[8] = cvtpk(RB[2][i], RB[3][i]); } }
#define MOE_COMPUTE(STG, DO_MFMA) { LAS char* Bs_ = lds + (STG) * MOE_BSTAGE; \
        _Pragma("unroll") for (int u = 0; u < 4; ++u) { \
            bf16x8 bfr[4]; \
            if (DO_MFMA) { _Pragma("unroll") for (int c = 0; c < 4; ++c) bfr[c] = *(LAS bf16x8*)(Bs_ + lb_ + (c * 32 * MOE_BP + u * 8) * 2); } \
            _Pragma("unroll") for (int a = 0; a < 2; ++a) { \
                if (DO_MFMA) { const bf16x8 af_ = fp8x8_to_bf16(fa8[a][u >> 1][(u & 1) * 2], fa8[a][u >> 1][(u & 1) * 2 + 1]); \
                    _Pragma("unroll") for (int c = 0; c < 4; ++c) acc[a][c] = MFMA_BF16(bfr[c], af_, acc[a][c]); } \
            } \
        } }
      \
#define MOE_RELOAD { _Pragma("unroll") for (int a = 0; a < 2; ++a) { unsigned ao_ = aoff[a]; asm volatile("" : "+v"(ao_)); \
            fa8[a][0] = *(const MOE_GAS u32x4*)(ab_n + ao_); fa8[a][1] = *(const MOE_GAS u32x4*)(ab_n + ao_ + 16); } }
#define MOE_XCOMPUTE(STG) if (XC) { LAS char* Bs_ = lds + (STG) * MOE_BSTAGE; \
        _Pragma("unroll") for (int u = 0; u < 4; ++u) { \
            const bf16x8 ax_ = fp8x8_to_bf16(fa8x[u >> 1][(u & 1) * 2], fa8x[u >> 1][(u & 1) * 2 + 1]); \
            if (u & 1) { unsigned ao_ = aoffx; asm volatile("" : "+v"(ao_)); fa8x[u >> 1] = *(const MOE_GAS u32x4*)(ab_n + ao_ + (u >> 1) * 16); } \
            const bf16x8 bx_ = *(LAS bf16x8*)(Bs_ + (wave & 3) * (32 * MOE_BP * 2) + lb_ + u * 16); \
            accx = MFMA_BF16(bx_, ax_, accx); } }
#define MOE_NEXTA(S_) MOE_DEC(S_) (void)ps_; \
        if (stt_ != st_loaded) { MOE_AOFF(stt_) st_loaded = stt_; } \
        uint64_t abn_ = (uint64_t)abase + kt_ * 64; asm volatile("" : "+s"(abn_)); const moe_gcb* ab_n = (const moe_gcb*)abn_;
    int st_loaded = st0;
    MOE_AOFF(st0)
    { const char* ab0 = (const char*)abase;
#pragma unroll
      for (int a = 0; a < 2; ++a)
#pragma unroll
          for (int h2 = 0; h2 < 2; ++h2) fa8[a][h2] = *(const u32x4*)(ab0 + aoff[a] + h2 * 16); }
    if (XC) {
        const int vax_ = xr ? rowva[512 + 32 * (wave >> 2) + r32] : TRASH_VA; aoffx = (unsigned)(DOWN ? vax_ : (vax_ == TRASH_VA ? 0 : (vax_ >> 3))) * APITCH + hi * 32;
        fa8x[0] = *(const u32x4*)((const char*)abase + aoffx); fa8x[1] = *(const u32x4*)((const char*)abase + aoffx + 16); }
    MOE_LOADB(0, rb0)
    MOE_LOADB(1, rb1)
    MOE_WRITEB(0, rb0)
    MOE_LOADB(2, rb0)
    int stg = 0;
#pragma unroll 1
    for (int sidx = 0; sidx < nsteps; sidx += 2) {
        const int pl = sidx / (nst * KT); const int rm = sidx - pl * (nst * KT); const int sl = rm / KT; const int kt = rm - sl * KT; const int ps = pass0 + ((pl + prot) & (npass_ - 1)), stt = st0 + sl;
        const bool wv = (wave * 64) < (ng - stt * 512);
        const int stg1 = stg == 2 ? 0 : stg + 1, stg2 = stg1 == 2 ? 0 : stg1 + 1;
        __syncthreads();
        MOE_WRITEB(stg1, rb1)
        MOE_LOADB(sidx + 3, rb1)
        { MOE_NEXTA(sidx + 1)
          if (wv) MOE_COMPUTE(stg, true)
          MOE_RELOAD
          MOE_XCOMPUTE(stg) }
        __syncthreads();
        MOE_WRITEB(stg2, rb0)
        MOE_LOADB(sidx + 4, rb0)
        { MOE_NEXTA(sidx + 2)
          if (wv) MOE_COMPUTE(stg1, true)
          MOE_RELOAD
          MOE_XCOMPUTE(stg1) }
        stg = stg2;
        if (kt == KT - 2) {
            const int le_ = lane_id_(); const int lane = le_, r32 = le_ & 31, hi = le_ >> 5; (void)lane;
            if (wv) {
                const int nrows = ng - stt * 512;
#pragma unroll
                for (int a = 0; a < 2; ++a) {
                    if (a == 0 || (wave * 64 + 32) < nrows) {
                        const int lrow = stt * 512 + wave * 64 + a * 32 + r32;
                        const unsigned va = (unsigned)rowva[lrow];
                        if (DOWN) {
                            const float w = roww[lrow];
#pragma unroll
                            for (int c = 0; c < 4; ++c) {
                                float yv_[16];
#pragma unroll
                                for (int j = 0; j < 16; ++j) yv_[j] = acc[a][c][(j >> 2) + 4 * (j & 3)] * w;
                                if (y8) {
                                    u32x4 q8;
#pragma unroll
                                    for (int jj = 0; jj < 4; ++jj) q8[jj] = pack_fp8x4(yv_[4 * jj], yv_[4 * jj + 1], yv_[4 * jj + 2], yv_[4 * jj + 3]);
                                    *(u32x4*)((unsigned char*)outv + (size_t)va * D + ps * 128 + c * 32 + 16 * hi) = q8;
                                } else {
                                    u32x4 q0, q1;
#pragma unroll
                                    for (int jj = 0; jj < 4; ++jj) { q0[jj] = cvtpk(yv_[2 * jj], yv_[2 * jj + 1]); q1[jj] = cvtpk(yv_[8 + 2 * jj], yv_[9 + 2 * jj]); }
                                    u16* o = (u16*)outv + (size_t)va * D + ps * 128 + c * 32 + 16 * hi;
                                    *(u32x4*)o = q0; *(u32x4*)(o + 8) = q1;
                                }
                            }
                        } else {
#pragma unroll
                            for (int c = 0; c < 2; ++c) {
                                float hv[16];
#pragma unroll
                                for (int j = 0; j < 16; ++j) { const int r = (j >> 2) + 4 * (j & 3); const float gt = acc[a][c][r], up = acc[a][c + 2][r]; hv[j] = gt / (1.f + __expf(-gt)) * up; }
                                u32x4 q;
#pragma unroll
                                for (int jj = 0; jj < 4; ++jj) q[jj] = pack_fp8x4(hv[4 * jj], hv[4 * jj + 1], hv[4 * jj + 2], hv[4 * jj + 3]);
                                *(u32x4*)((unsigned char*)outv + (size_t)va * DF + ps * 64 + c * 32 + 16 * hi) = q;
                            }
                        }
                    }
                }
#pragma unroll
                for (int a = 0; a < 2; ++a)
#pragma unroll
                    for (int c = 0; c < 4; ++c)
#pragma unroll
                        for (int r = 0; r < 16; ++r) acc[a][c][r] = 0.f;
            }
            if (XC && DOWN) { if (xr) {
                const int xrow = 512 + 32 * (wave >> 2) + r32;
                const unsigned vax = (unsigned)rowva[xrow]; const float w = roww[xrow];
                u32x4 q8;
#pragma unroll
                for (int jj = 0; jj < 4; ++jj) q8[jj] = pack_fp8x4(accx[jj] * w, accx[jj + 4] * w, accx[jj + 8] * w, accx[jj + 12] * w);
                *(u32x4*)((unsigned char*)outv + (size_t)vax * D + ps * 128 + (wave & 3) * 32 + 16 * hi) = q8;
                }
#pragma unroll
                for (int r = 0; r < 16; ++r) accx[r] = 0.f;
            }
            if (XC && !DOWN) { if (xr) {
                LAS float* xch = (LAS float*)(lds + MOE_LDS_XCH) + ((wave >> 2) * 2 + (wave & 1)) * 1024 + lane;
                if ((wave & 3) >= 2) {
#pragma unroll
                    for (int r = 0; r < 16; ++r) xch[r * 64] = accx[r];
                }
                __syncthreads();
                if ((wave & 3) < 2) {
                    const unsigned vax = (unsigned)rowva[512 + 32 * (wave >> 2) + r32];
                    u32x4 q;
#pragma unroll
                    for (int jj = 0; jj < 4; ++jj) {
#pragma unroll
                        for (int i = 0; i < 4; ++i) { const int r = jj + 4 * i; const float gt = accx[r]; accx[r] = gt / (1.f + __expf(-gt)) * xch[r * 64]; }
                        q[jj] = pack_fp8x4(accx[jj], accx[jj + 4], accx[jj + 8], accx[jj + 12]);
                    }
                    *(u32x4*)((unsigned char*)outv + (size_t)vax * DF + ps * 64 + (wave & 3) * 32 + 16 * hi) = q;
                }
                }
#pragma unroll
                for (int r = 0; r < 16; ++r) accx[r] = 0.f;
            }
        }
    }
    __syncthreads();
#undef MOE_XCOMPUTE
#undef MOE_AOFF
#undef MOE_DEC
#undef MOE_LOADB
#undef MOE_WRITEB
#undef MOE_COMPUTE
#undef MOE_RELOAD
#undef MOE_NEXTA
}

constexpr int Q8_BP = 144;
constexpr int Q8_BSTAGE = 128 * Q8_BP;
typedef __attribute__((ext_vector_type(8))) int q8_i32x8;
template <int NCH>
__device__ __forceinline__ void qkv8_item(LAS char* lds, const int wave, const unsigned char* __restrict__ a8  , const unsigned char* __restrict__ w8  ,
                                          u16* __restrict__ outp  , const int ldc,
                                          const int rot  ) {
    constexpr int NSTEPS = NCH * 8;
    const int l0 = lane_id_(); const int r32 = l0 & 31, hi = l0 >> 5;
    unsigned aoff[2];
#pragma unroll
    for (int a = 0; a < 2; ++a) { aoff[a] = (unsigned)(wave * 64 + a * 32 + r32) * 1024u + hi * 32; asm volatile("" : "+v"(aoff[a])); }
    const int t_ = wave * 64 + l0, col_ = t_ >> 2, p_ = t_ & 3, kap_ = col_ & 31;
    unsigned boff = (unsigned)col_ * 1024u + p_ * 32; asm volatile("" : "+v"(boff));
    unsigned wb = (unsigned)((col_ & ~31) + (kap_ & 3) * 8 + (kap_ >> 2)) * Q8_BP + p_ * 32; asm volatile("" : "+v"(wb));
    unsigned lb = (unsigned)r32 * Q8_BP + hi * 32; asm volatile("" : "+v"(lb));
    f32x16 acc[2][4];
#pragma unroll
    for (int a = 0; a < 2; ++a)
#pragma unroll
        for (int c = 0; c < 4; ++c)
#pragma unroll
            for (int r = 0; r < 16; ++r) acc[a][c][r] = 0.f;
    u32x4 fa0[2][2][2], fa1[2][2][2];
    u32x4 rb0[2], rb1[2];
#define Q8_LOADA(FA, S_) { const int s2_ = (S_) < NSTEPS ? (S_) : 0; uint64_t ab_ = (uint64_t)a8 + ((s2_ + rot) & 7) * 128; asm volatile("" : "+s"(ab_)); const moe_gcb* ag_ = (const moe_gcb*)ab_; \
        _Pragma("unroll") for (int a = 0; a < 2; ++a) { unsigned ao_ = aoff[a]; asm volatile("" : "+v"(ao_)); \
            _Pragma("unroll") for (int kk = 0; kk < 2; ++kk) { FA[a][kk][0] = *(const MOE_GAS u32x4*)(ag_ + ao_ + kk * 64); FA[a][kk][1] = *(const MOE_GAS u32x4*)(ag_ + ao_ + kk * 64 + 16); } } }
#define Q8_LOADB(RB, S_) { const int s2_ = (S_) < NSTEPS ? (S_) : 0; uint64_t wu_ = (uint64_t)w8 + (size_t)(s2_ >> 3) * 131072 + ((s2_ + rot) & 7) * 128; asm volatile("" : "+s"(wu_)); const moe_gcb* wg_ = (const moe_gcb*)wu_; \
        unsigned bo_ = boff; asm volatile("" : "+v"(bo_)); RB[0] = *(const MOE_GAS u32x4*)(wg_ + bo_); RB[1] = *(const MOE_GAS u32x4*)(wg_ + bo_ + 16); }
#define Q8_WRITEB(STG, RB) { LAS char* Bs_ = lds + (STG) * Q8_BSTAGE + wb; *(LAS u32x4*)Bs_ = RB[0]; *(LAS u32x4*)(Bs_ + 16) = RB[1]; }
#define Q8_CAT8(X0, X1) q8_i32x8{(int)(X0)[0], (int)(X0)[1], (int)(X0)[2], (int)(X0)[3], (int)(X1)[0], (int)(X1)[1], (int)(X1)[2], (int)(X1)[3]}
#define Q8_MFMA(B_, A_, C_) __builtin_amdgcn_mfma_scale_f32_32x32x64_f8f6f4(B_, A_, C_, 0, 0, 0, 0x7F79  , 1, 0x7F79  )
#define Q8_COMPUTE(STG, FA) { LAS char* Bs_ = lds + (STG) * Q8_BSTAGE + lb; \
        _Pragma("unroll") for (int kk = 0; kk < 2; ++kk) { const q8_i32x8 af0_ = Q8_CAT8(FA[0][kk][0], FA[0][kk][1]), af1_ = Q8_CAT8(FA[1][kk][0], FA[1][kk][1]); \
            _Pragma("unroll") for (int c = 0; c < 4; ++c) { const u32x4 b0_ = *(LAS u32x4*)(Bs_ + c * 32 * Q8_BP + kk * 64), b1_ = *(LAS u32x4*)(Bs_ + c * 32 * Q8_BP + kk * 64 + 16); const q8_i32x8 bf_ = Q8_CAT8(b0_, b1_); \
                acc[0][c] = Q8_MFMA(bf_, af0_, acc[0][c]); acc[1][c] = Q8_MFMA(bf_, af1_, acc[1][c]); } } }
    Q8_LOADB(rb0, 0)
    Q8_WRITEB(0, rb0)
    Q8_LOADB(rb1, 1)
    Q8_LOADA(fa0, 0)
    Q8_LOADB(rb0, 2)
    Q8_LOADA(fa1, 1)
    int stg = 0;
#pragma unroll 1
    for (int s = 0; s < NSTEPS; s += 2) {
        const int stg1 = stg == 2 ? 0 : stg + 1, stg2 = stg1 == 2 ? 0 : stg1 + 1;
        __syncthreads();
        Q8_WRITEB(stg1, rb1)
        Q8_LOADB(rb1, s + 3)
        Q8_COMPUTE(stg, fa0)
        Q8_LOADA(fa0, s + 2)
        __syncthreads();
        Q8_WRITEB(stg2, rb0)
        Q8_LOADB(rb0, s + 4)
        Q8_COMPUTE(stg1, fa1)
        Q8_LOADA(fa1, s + 3)
        stg = stg2;
        if ((s & 7) == 6) {
            const int cl = s >> 3;
            const int le_ = lane_id_(); const int r32e = le_ & 31, hie = le_ >> 5;
#pragma unroll
            for (int a = 0; a < 2; ++a) {
                u16* orow = outp + (size_t)(wave * 64 + a * 32 + r32e) * ldc + cl * 128 + 16 * hie;
#pragma unroll
                for (int c = 0; c < 4; ++c) {
                    u32x4 q0, q1;
#pragma unroll
                    for (int jj = 0; jj < 4; ++jj) { q0[jj] = cvtpk(acc[a][c][((2 * jj) >> 2) + 4 * ((2 * jj) & 3)], acc[a][c][((2 * jj + 1) >> 2) + 4 * ((2 * jj + 1) & 3)]);
                                                     q1[jj] = cvtpk(acc[a][c][((8 + 2 * jj) >> 2) + 4 * ((8 + 2 * jj) & 3)], acc[a][c][((9 + 2 * jj) >> 2) + 4 * ((9 + 2 * jj) & 3)]); }
                    *(u32x4*)(orow + c * 32) = q0; *(u32x4*)(orow + c * 32 + 8) = q1;
                }
            }
#pragma unroll
            for (int a = 0; a < 2; ++a)
#pragma unroll
                for (int c = 0; c < 4; ++c)
#pragma unroll
                    for (int r = 0; r < 16; ++r) acc[a][c][r] = 0.f;
        }
    }
    __syncthreads();
#undef Q8_LOADA
#undef Q8_LOADB
#undef Q8_WRITEB
#undef Q8_CAT8
#undef Q8_MFMA
#undef Q8_COMPUTE
}

constexpr int N_PHASES = 21;

#define P_x_in CTX_IN(0)
#define P_xb ((u16*)(ws + WS_XB))
#define P_x1 ((float*)(ws + WS_X1))
#define P_x2 ((float*)(ws + WS_X2))
#define P_ypre ((u16*)(ws + WS_YPRE))
#define P_qkv ((u16*)(ws + WS_QKV))
#define P_vT ((u16*)(ws + WS_VT))
#define P_kmean ((float*)(ws + WS_KM))
#define P_ao ((u16*)(ws + WS_AO))
#define P_og ((u16*)(ws + WS_OG))
#define P_lse ((float*)(ws + WS_LSE))
#define P_topw ((float*)(ws + WS_TOPW))
#define P_list ((int*)(ws + WS_LIST))
#define P_hb ((u16*)(ws + WS_HB))
#define P_yb ((u16*)(ws + WS_YB))
#define P_cnt_all ((int*)(ws + WS_CTL + CTL_ECNT_OFF))
#define P_xb8 ((unsigned char*)(ws + WS_XB8))
#define P_hbs ((u16*)(ws + WS_HBS))
#define P_xq8 ((unsigned char*)(ws + WS_XQ8))
#define P_wq8 ((unsigned char*)(ws + WS_WQ8))
#define P_wo8 ((unsigned char*)(ws + WS_WO8))
#define P_selm ((unsigned*)(ws + WS_SELM))
#define P_part ((u16*)(ws + WS_PART))
#define P_plse ((float*)(ws + WS_PLSE))
#define PH_BEGIN int tid = wave_s_ * 64 + lane_id_(); asm volatile("" : "+v"(tid)); const int lane = tid & 63, r32 = lane & 31, hi = lane >> 5; const int wave = __builtin_amdgcn_readfirstlane(tid >> 6); (void)lane; (void)r32; (void)hi; (void)wave
constexpr int LDS_CTX = LDS_BAR + 16;
__device__ __forceinline__ uint64_t ctx_ld(int i) {
    extern __shared__ __attribute__((aligned(16))) unsigned char lds_raw[];
    const LAS unsigned* q = (const LAS unsigned*)((LAS char*)lds_raw + LDS_CTX) + 2 * i;
    const unsigned lo = __builtin_amdgcn_readfirstlane(q[0]), hi = __builtin_amdgcn_readfirstlane(q[1]);
    return ((uint64_t)hi << 32) | lo;
}
typedef __attribute__((address_space(1))) unsigned char gbyte;
#define AS_GLOBAL(T, u64v) ((T*)(gbyte*)(u64v))
#define CTX_IN(i) AS_GLOBAL(const float, ctx_ld(i))
#define PH_FN_BEGIN \
    extern __shared__ __attribute__((aligned(16))) unsigned char lds_raw[]; \
    LAS char* lds = (LAS char*)lds_raw; (void)lds; \
    const int G = gridDim.x, bid = blockIdx.x; (void)G; (void)bid; \
    unsigned char* const ws = AS_GLOBAL(unsigned char, ctx_ld(17)); (void)ws; \
    const int NQ = L == 0 ? 3072 : 9216; (void)NQ; \
    int* cnt = P_cnt_all + L * NE * CNT_STRIDE; (void)cnt;
__device__ __forceinline__ void ph_p0(int L, int rep_, const int wave_s_) {
    PH_FN_BEGIN
    (void)rep_;
    PH_BEGIN;
    for (size_t i = (size_t)bid * NTHR + tid; i < (size_t)T * D / 4; i += (size_t)G * NTHR) {
        const f32x4 v = *(const f32x4*)(P_x_in + i * 4);
        u32x2 w; w[0] = cvtpk(v[0], v[1]); w[1] = cvtpk(v[2], v[3]);
        *(u32x2*)(P_xb + i * 4) = w;
#if QKV_FP8
        *(unsigned*)(P_xq8 + i * 4) = pack_fp8x4(v[0], v[1], v[2], v[3]);
#endif
    }
    for (int i = bid * NTHR + tid; i < BATCH * NH * MOBA_NB * 64 / 4; i += G * NTHR) *(f32x4*)(P_kmean + (size_t)i * 4) = f32x4{0.f, 0.f, 0.f, 0.f};
    LAS float* tl = (LAS float*)lds;
    for (int it = bid; it < 3968 + 128; it += G) {
        int seg, kt;
        if (it < 3840) { seg = it >> 4; kt = it & 15; } else if (it < 3968) { seg = 240 + ((it - 3840) >> 2); kt = (it - 3840) & 3; } else { seg = 272 + ((it - 3968) >> 4); kt = (it - 3968) & 15; }
        const float* src; int ld; u16* dst; int Kd = 1024; u16* dst_lo = nullptr; int rcol = 0; unsigned char* dst8 = nullptr;
        if (seg < 48) { const int col = 64 * seg; src = CTX_IN(1) + col; ld = 3072; dst = (u16*)(ws + WS_WQK0) + (size_t)col * 1024; if (QKV_FP8) dst8 = P_wq8 + (size_t)col * 1024; }
        else if (seg < 192) { const int col = 64 * (seg - 48); src = CTX_IN(2) + col; ld = 9216; dst = (u16*)(ws + WS_WQK1) + (size_t)col * 1024; if (QKV_FP8) dst8 = P_wq8 + (size_t)(3072 + col) * 1024; }
        else if (seg < 224) { const int s2 = seg - 192, l2 = s2 >> 4, col = 64 * (s2 & 15); src = CTX_IN(3) + (size_t)l2 * D * D + col; ld = 1024; dst = (u16*)(ws + WS_WO) + (size_t)l2 * D * D + (size_t)col * 1024; if (WO_FP8) dst8 = P_wo8 + (size_t)l2 * D * D + (size_t)col * 1024; }
        else if (seg < 240) { const int s2 = seg - 224, l2 = s2 >> 3, i8 = s2 & 7, un = i8 >> 2, q = i8 & 3;
            src = (q < 2 ? CTX_IN(11) : CTX_IN(12)) + (size_t)l2 * D * DF + un * 128 + 64 * (q & 1); ld = 256; dst = (u16*)(ws + WS_WSGU) + (size_t)l2 * 512 * 1024 + (size_t)(64 * i8) * 1024; }
        else if (seg < 272) { const int s2 = seg - 240, l2 = s2 >> 4, col = 64 * (s2 & 15); src = CTX_IN(13) + (size_t)l2 * DF * D + col; ld = 1024; Kd = 256; dst = (u16*)(ws + WS_WSD) + (size_t)l2 * D * DF + (size_t)col * 256; }
        else { const int s2 = seg - 272, l2 = s2 >> 2, col = 64 * (s2 & 3); src = CTX_IN(6) + (size_t)l2 * D * NE + col; ld = 256; rcol = col; dst = (u16*)(ws + WS_WRH) + (size_t)l2 * NE * D; dst_lo = (u16*)(ws + WS_WRL) + (size_t)l2 * NE * D; }
        {
            const int kr = tid >> 4, c4 = tid & 15;
#pragma unroll
            for (int i = 0; i < 2; ++i) {
                const f32x4 v = *(const f32x4*)(src + (size_t)(kt * 64 + kr + 32 * i) * ld + 4 * c4);
#pragma unroll
                for (int jj = 0; jj < 4; ++jj) tl[(kr + 32 * i) * 65 + 4 * c4 + jj] = v[jj];
            }
        }
        __syncthreads();
        {
            const int row = tid >> 3, kc = tid & 7;
            float f[8];
#pragma unroll
            for (int jj = 0; jj < 8; ++jj) f[jj] = tl[(8 * kc + jj) * 65 + row];
            u32x4 w; w[0] = cvtpk(f[0], f[1]); w[1] = cvtpk(f[2], f[3]); w[2] = cvtpk(f[4], f[5]); w[3] = cvtpk(f[6], f[7]);
            if (dst_lo) {
                u32x4 wl;
#pragma unroll
                for (int jj = 0; jj < 4; ++jj) wl[jj] = cvtpk(f[2 * jj] - bf2f(w[jj] & 0xFFFFu), f[2 * jj + 1] - bf2f(w[jj] >> 16));
                const int E_ = rcol + row;
                const size_t fi = ((size_t)(((E_ >> 5) * 16 + kt) * 4 + (kc >> 1)) * 64 + (kc & 1) * 32 + (E_ & 31)) * 8;
                *(u32x4*)(dst + fi) = w; *(u32x4*)(dst_lo + fi) = wl;
            } else if (dst8) {
                u32x2 w8; w8[0] = pack_fp8x4(f[0] * 64.f, f[1] * 64.f, f[2] * 64.f, f[3] * 64.f); w8[1] = pack_fp8x4(f[4] * 64.f, f[5] * 64.f, f[6] * 64.f, f[7] * 64.f);
                *(u32x2*)(dst8 + (size_t)row * 1024 + kt * 64 + 8 * kc) = w8;
            } else *(u32x4*)(dst + (size_t)row * Kd + kt * 64 + 8 * kc) = w;
        }
        __syncthreads();
    }
}

__device__ __forceinline__ void ph_qkv(int L, int rep_, const int wave_s_) {
    PH_FN_BEGIN
    (void)rep_;
#if QKV_FP8 == 2
    const pg8::Gemm g{(const u16*)P_xq8, (const u16*)(P_wq8 + (L == 0 ? (size_t)0 : (size_t)3072 * 1024)), T, NQ, D / 2};
    pg8::StaticOrder S; S.init(g.M, g.N, G, bid);
    const EpiQK E{P_qkv, NQ, L == 0 ? P_kmean : nullptr};
    pg8::gemm_phase<EpiQK, pg8::StaticOrder, false, false, true>((PG8_LAS unsigned char*)lds, g, S, E, nullptr, wave_s_ * 64 + lane_id_());
#elif QKV_FP8
    PH_BEGIN;
    const int nchunk = NQ / 384, nq = 4 * nchunk;
    const unsigned char* w8 = P_wq8 + (L == 0 ? (size_t)0 : (size_t)3072 * 1024);
    int* xq = (int*)(ws + WS_CTL + CTL_XQ_OFF) + (L * 2 + (rep_ & 1)) * 8 * 64;
    LAS int* slot = (LAS int*)(lds + 140000);
    const int xme = (int)(xb_xcc_id() & 7u);
    unsigned qdone = 0u;
    for (;;) {
        __syncthreads();
        if (tid == 0) {
            int item = -1;
            for (int k = 0; k < 8 && item < 0; ++k) {
                const int xx = (xme + k) & 7;
                if (qdone >> xx & 1u) continue;
                const int q = atomicAdd(&xq[xx * 64], 1);
                if (q < nq) item = (xx + 8 * (q / nchunk)) * nchunk + (q % nchunk); else qdone |= 1u << xx;
            }
            *slot = item;
        }
        __syncthreads();
        const int item = *slot;
        if (item < 0) break;
        const int rt = item / nchunk, ch = item - rt * nchunk;
        qkv8_item<3>(lds, wave, P_xq8 + (size_t)rt * 512 * 1024, w8 + (size_t)ch * 384 * 1024, P_qkv + (size_t)rt * 512 * NQ + ch * 384, NQ, item & 7);
    }
#else
    const pg8::Gemm g{P_xb, (const u16*)(ws + (L == 0 ? WS_WQK0 : WS_WQK1)), T, NQ, D};
    pg8::StaticOrder S; S.init(g.M, g.N, G, bid);
    const EpiQK E{P_qkv, NQ, nullptr};
    pg8::gemm_phase<EpiQK, pg8::StaticOrder, false>((PG8_LAS unsigned char*)lds, g, S, E, nullptr, wave_s_ * 64 + lane_id_());
#endif
}

__device__ __forceinline__ void ph_kmean(int L, int rep_, const int wave_s_) {
    PH_FN_BEGIN
    (void)rep_;
    PH_BEGIN;
    LAS float* red = (LAS float*)lds;
    for (int it = bid; it < BATCH * NH * MOBA_NB; it += G) {
        const int j = it & 31, h = (it >> 5) & 15, b = it >> 9;
        const int kg_ = tid >> 3, ch = tid & 7;
        const u16* kp = P_qkv + (size_t)(b * SEQ + j * MOBA_BLK + kg_) * 3072 + 1024 + h * 64 + ch * 8;
        float sm[8];
#pragma unroll
        for (int e2 = 0; e2 < 8; ++e2) sm[e2] = 0.f;
#pragma unroll
        for (int i = 0; i < 4; ++i) {
            const u32x4 v = *(const u32x4*)(kp + (size_t)(64 * i) * 3072);
#pragma unroll
            for (int e2 = 0; e2 < 4; ++e2) { sm[2 * e2] += bf2f(v[e2] & 0xFFFFu); sm[2 * e2 + 1] += bf2f(v[e2] >> 16); }
        }
#pragma unroll
        for (int e2 = 0; e2 < 8; ++e2) red[kg_ * 65 + ch * 8 + e2] = sm[e2];
        __syncthreads();
        if (tid < 64) {
            float tot = 0.f;
#pragma unroll 8
            for (int q = 0; q < 64; ++q) tot += red[q * 65 + tid];
            P_kmean[(size_t)it * 64 + tid] = tot * (1.f / MOBA_BLK);
        }
        __syncthreads();
    }
}

__device__ __forceinline__ void ph_gate(int L, int rep_, const int wave_s_) {
    PH_FN_BEGIN
    (void)rep_;
    PH_BEGIN;
    for (int it = bid; it < BATCH * NH * MOBA_NB; it += G) {
        const int qb = it & 31, bh = it >> 5, b = bh >> 4, h = bh & 15;
        const int tq = qb * MOBA_BLK + wave * 32 + r32;
        const u16* qrow = P_qkv + (size_t)(b * SEQ + tq) * 3072 + h * 64 + hi * 8;
        bf16x8 qf[4];
#pragma unroll
        for (int d0 = 0; d0 < 4; ++d0) qf[d0] = *(const bf16x8*)(qrow + d0 * 16);
        unsigned selmask = 0u;
        if (qb > 0) {
            const float* km = P_kmean + ((size_t)(b * NH + h) * MOBA_NB + r32) * 64 + hi * 8;
            f32x16 gt;
#pragma unroll
            for (int r = 0; r < 16; ++r) gt[r] = 0.f;
#pragma unroll
            for (int d0 = 0; d0 < 4; ++d0) {
                const f32x4 k0 = *(const f32x4*)(km + d0 * 16), k1 = *(const f32x4*)(km + d0 * 16 + 4);
                union { bf16x8 v; unsigned u[4]; } kf;
                kf.u[0] = cvtpk(k0[0], k0[1]); kf.u[1] = cvtpk(k0[2], k0[3]); kf.u[2] = cvtpk(k1[0], k1[1]); kf.u[3] = cvtpk(k1[2], k1[3]);
                gt = MFMA_BF16(kf.v, qf[d0], gt);
            }
            float v0 = -INFINITY, v1 = -INFINITY, v2 = -INFINITY; int i0 = 99, i1 = 99, i2 = 99;
#pragma unroll
            for (int r = 0; r < 16; ++r) { const int jb = crow(r, hi); const float gv = jb < qb ? gt[r] : -INFINITY; top3_insert(gv, jb < qb ? jb : 99, v0, i0, v1, i1, v2, i2); }
            const float ov0 = shxf(v0, 32, lane), ov1 = shxf(v1, 32, lane), ov2 = shxf(v2, 32, lane);
            const int oi0 = shxi(i0, 32, lane), oi1 = shxi(i1, 32, lane), oi2 = shxi(i2, 32, lane);
            top3_insert(ov0, oi0, v0, i0, v1, i1, v2, i2); top3_insert(ov1, oi1, v0, i0, v1, i1, v2, i2); top3_insert(ov2, oi2, v0, i0, v1, i1, v2, i2);
            if (i0 < 32) selmask |= 1u << i0;
            if (i1 < 32) selmask |= 1u << i1;
            if (i2 < 32) selmask |= 1u << i2;
        }
        if (hi == 0) P_selm[(size_t)bh * SEQ + tq] = selmask;
    }
}

constexpr int MB_KP = 72;
constexpr int MB_VP = 260;
constexpr int MB_LDS_K = 0;
constexpr int MB_LDS_V = 256 * MB_KP * 2;
constexpr int MB_LDS_LIST = MB_LDS_V + 64 * MB_VP * 2;
constexpr int MB_LDS_CTR = MB_LDS_LIST + 8192 * 2;
__device__ __forceinline__ void ph_moba(int L, int rep_, const int wave_s_) {
    PH_FN_BEGIN
    (void)rep_;
    PH_BEGIN;
    LAS char* Ks = lds + MB_LDS_K; LAS char* Vs = lds + MB_LDS_V;
    LAS u16* qlist = (LAS u16*)(lds + MB_LDS_LIST); LAS int* ctr = (LAS int*)(lds + MB_LDS_CTR);
    for (int it = bid; it < BATCH * NH * MOBA_NB; it += G) {
        const int rnd = it >> 8, w8 = it & 255, a8 = w8 >> 5, bh = w8 & 31;
        const unsigned jrow = a8 == 0 ? 0x1E1B1100u : a8 == 1 ? 0x1F170E01u : a8 == 2 ? 0x1D160D02u : a8 == 3 ? 0x1C120C03u : a8 == 4 ? 0x18130B04u : a8 == 5 ? 0x15140A05u : a8 == 6 ? 0x1A0F0906u : 0x19100807u;
        const int j = (int)((jrow >> (8 * rnd)) & 31u);
        const int b = bh >> 4, h = bh & 15;
        const float slope2 = exp2f(-0.5f * (float)(h + 1)) * LOG2E;
        if (tid == 0) { int z0 = 0; asm volatile("" : "+v"(z0)); ctr[0] = z0; ctr[1] = z0; }
        unsigned swv[16];
        { const unsigned* sm = P_selm + (size_t)bh * SEQ;
#pragma unroll
          for (int i = 0; i < 16; ++i) { const int t = (j + 1) * MOBA_BLK + i * 512 + tid; swv[i] = sm[t < SEQ ? t : 0]; } }
        {
            const u16* kg = P_qkv + (size_t)(b * SEQ + j * MOBA_BLK) * 3072 + 1024 + h * 64;
#pragma unroll
            for (int i = 0; i < 4; ++i) { const int c = tid + i * 512, row = c >> 3, ch = c & 7; *(LAS u32x4*)(Ks + (row * MB_KP + ch * 8) * 2) = *(const u32x4*)(kg + (size_t)row * 3072 + ch * 8); }
            const u16* vg = P_qkv + (size_t)(b * SEQ + j * MOBA_BLK) * 3072 + 2048 + h * 64;
            {
                const int kg4 = tid >> 3, ch = tid & 7;
                u32x4 v4[4];
#pragma unroll
                for (int q = 0; q < 4; ++q) v4[q] = *(const u32x4*)(vg + (size_t)(4 * kg4 + q) * 3072 + ch * 8);
#pragma unroll
                for (int e2 = 0; e2 < 4; ++e2) {
                    u32x2 wlo, whi;
                    wlo[0] = __builtin_amdgcn_perm(v4[1][e2], v4[0][e2], 0x05040100u); wlo[1] = __builtin_amdgcn_perm(v4[3][e2], v4[2][e2], 0x05040100u);
                    whi[0] = __builtin_amdgcn_perm(v4[1][e2], v4[0][e2], 0x07060302u); whi[1] = __builtin_amdgcn_perm(v4[3][e2], v4[2][e2], 0x07060302u);
                    *(LAS u32x2*)(Vs + ((ch * 8 + 2 * e2) * MB_VP + 4 * kg4) * 2) = wlo;
                    *(LAS u32x2*)(Vs + ((ch * 8 + 2 * e2 + 1) * MB_VP + 4 * kg4) * 2) = whi;
                }
            }
        }
        __syncthreads();
        {
#pragma unroll
            for (int i = 0; i < 16; ++i) {
                const int t0 = (j + 1) * MOBA_BLK + i * 512;
                if (t0 >= SEQ) continue;
                const int t = t0 + tid;
                const bool sel = (t < SEQ) && ((swv[i] >> j) & 1u);
                const unsigned long long bal = __ballot(sel);
                const int total = __popcll(bal);
                int wb = 0;
                if (lane == 0 && total) wb = atomicAdd((int*)&ctr[0], total);
                wb = __builtin_amdgcn_readfirstlane(wb);
                if (sel) qlist[wb + __popcll(bal & ((1ull << lane) - 1ull))] = (u16)t;
            }
        }
        __syncthreads();
        const int nq = ctr[0];
        const int ntiles = 8 + ((nq + 31) >> 5);
        for (;;) {
            int ti = 0;
            if (lane == 0) ti = atomicAdd((int*)&ctr[1], 1);
            ti = __builtin_amdgcn_readfirstlane(ti);
            if (ti >= ntiles) break;
            const bool own = ti < 8;
            const int wq = 7 - ti;
            const int li = (ti - 8) * 32 + r32;
            const bool valid = own || li < nq;
            const int tq = own ? j * MOBA_BLK + wq * 32 + r32 : (int)qlist[li < nq ? li : nq - 1];
            const int nsteps = own ? wq + 1 : 8;
            const u16* qrow = P_qkv + (size_t)(b * SEQ + tq) * 3072 + h * 64 + hi * 8;
            bf16x8 qf[4];
#pragma unroll
            for (int d0 = 0; d0 < 4; ++d0) qf[d0] = *(const bf16x8*)(qrow + d0 * 16);
            int slot = 3;
            if (!own) slot = __popc(P_selm[(size_t)bh * SEQ + tq] & ((1u << j) - 1u));
            AttnSt st; st.m = NEGV; st.l = 0.f;
#pragma unroll
            for (int r = 0; r < 16; ++r) { st.o0[r] = 0.f; st.o1[r] = 0.f; }
            const int dlo = own ? 0 : -0x40000000;
#define MB_KFR(KF, KT_) { _Pragma("unroll") for (int d0 = 0; d0 < 4; ++d0) KF[d0] = *(LAS bf16x8*)(Ks + (((KT_) * 32 + r32) * MB_KP + d0 * 16 + hi * 8) * 2); }
#define MB_VFR(VF, KT_) { _Pragma("unroll") for (int q4 = 0; q4 < 4; ++q4) { union { bf16x8 v; u32x2 hh[2]; } va; \
                LAS char* vp = Vs + (((q4 >> 1) * 32 + r32) * MB_VP + (KT_) * 32 + (q4 & 1) * 16 + 4 * hi) * 2; va.hh[0] = *(LAS u32x2*)(vp); va.hh[1] = *(LAS u32x2*)(vp + 16); VF[q4] = va.v; } }
#define MB_SMPV(P_, KT_) { const int d0_ = tq - (j * MOBA_BLK + (KT_) * 32) - 4 * hi; \
                if (own && (KT_) == nsteps - 1) attn_smpv<true>(st, P_, vfr, d0_, slope2, dlo, 0x7fffffff, lane);     \
                else attn_smpv<false>(st, P_, vfr, d0_, slope2, dlo, 0x7fffffff, lane); }
            {
                f32x16 pA, pB; bf16x8 kfr[4], vfr[4];
                MB_KFR(kfr, 0)
                pA = attn_qk(qf, kfr);
                for (int kt = 0; kt < nsteps; kt += 2) {
                    if (kt + 1 < nsteps) { MB_KFR(kfr, kt + 1) pB = attn_qk(qf, kfr); }
                    MB_VFR(vfr, kt)
                    MB_SMPV(pA, kt)
                    if (kt + 1 < nsteps) {
                        if (kt + 2 < nsteps) { MB_KFR(kfr, kt + 2) pA = attn_qk(qf, kfr); }
                        MB_VFR(vfr, kt + 1)
                        MB_SMPV(pB, kt + 1)
                    }
                }
            }
#undef MB_KFR
#undef MB_VFR
#undef MB_SMPV
            const float lt = st.l + shxf(st.l, 32, lane);
            const float inv = 1.f / lt;
            if (valid) {
                const size_t pi = ((size_t)(b * SEQ + tq) * NH + h) * 4 + slot;
                u16* orow = P_part + pi * 64;
#pragma unroll
                for (int rq = 0; rq < 4; ++rq) {
                    u32x2 w; w[0] = cvtpk(st.o0[4 * rq] * inv, st.o0[4 * rq + 1] * inv); w[1] = cvtpk(st.o0[4 * rq + 2] * inv, st.o0[4 * rq + 3] * inv);
                    *(u32x2*)(orow + 8 * rq + 4 * hi) = w;
                    w[0] = cvtpk(st.o1[4 * rq] * inv, st.o1[4 * rq + 1] * inv); w[1] = cvtpk(st.o1[4 * rq + 2] * inv, st.o1[4 * rq + 3] * inv);
                    *(u32x2*)(orow + 32 + 8 * rq + 4 * hi) = w;
                }
                if (hi == 0) P_plse[pi] = st.m * LN2 + logf(lt);
            }
        }
        __syncthreads();
    }
}

__device__ __forceinline__ void ph_mobamerge(int L, int rep_, const int wave_s_) {
    PH_FN_BEGIN
    (void)rep_;
    PH_BEGIN;
    for (size_t i = (size_t)bid * NTHR + tid; i < (size_t)T * NH * 8; i += (size_t)G * NTHR) {
        const size_t row = i >> 7; const int h = (int)(i >> 3) & 15, d8 = (int)i & 7;
        const int qb = (int)(row & (SEQ - 1)) >> 8;
        const int nsel = qb < 3 ? qb : 3;
        const size_t pi = (row * NH + h) * 4;
        float l[4], w[4];
        float mx = -INFINITY;
#pragma unroll
        for (int sidx = 0; sidx < 4; ++sidx) { const bool ok = sidx == 3 || sidx < nsel; l[sidx] = ok ? P_plse[pi + sidx] : -INFINITY; mx = fmaxf(mx, l[sidx]); }
        float ws_ = 0.f;
#pragma unroll
        for (int sidx = 0; sidx < 4; ++sidx) { w[sidx] = (sidx == 3 || sidx < nsel) ? expf(l[sidx] - mx) : 0.f; ws_ += w[sidx]; }
        const float inv = 1.f / ws_;
        float acc8[8];
#pragma unroll
        for (int c = 0; c < 8; ++c) acc8[c] = 0.f;
#pragma unroll
        for (int sidx = 0; sidx < 4; ++sidx) {
            if (sidx == 3 || sidx < nsel) {
                const u32x4 a = *(const u32x4*)(P_part + (pi + sidx) * 64 + d8 * 8);
                const float ww = w[sidx] * inv;
#pragma unroll
                for (int c = 0; c < 4; ++c) { acc8[2 * c] += ww * bf2f(a[c] & 0xFFFFu); acc8[2 * c + 1] += ww * bf2f(a[c] >> 16); }
            }
        }
#if WO_FP8
        u32x2 o8; o8[0] = pack_fp8x4(acc8[0] * AO8_SCALE, acc8[1] * AO8_SCALE, acc8[2] * AO8_SCALE, acc8[3] * AO8_SCALE); o8[1] = pack_fp8x4(acc8[4] * AO8_SCALE, acc8[5] * AO8_SCALE, acc8[6] * AO8_SCALE, acc8[7] * AO8_SCALE);
        *(u32x2*)((unsigned char*)P_ao + row * D + h * 64 + d8 * 8) = o8;
#else
        u32x4 o;
#pragma unroll
        for (int c = 0; c < 4; ++c) o[c] = cvtpk(acc8[2 * c], acc8[2 * c + 1]);
        *(u32x4*)(P_ao + row * D + h * 64 + d8 * 8) = o;
#endif
    }
}

constexpr int DL_KP = 72, DL_VP = 388;
constexpr int DL_LDS_K = 0, DL_LDS_V = 384 * DL_KP * 2;
__device__ __forceinline__ void ph_dil(int L, int rep_, const int wave_s_) {
    PH_FN_BEGIN
    (void)rep_;
    PH_BEGIN;
    LAS char* Ks = lds + DL_LDS_K; LAS char* Vs = lds + DL_LDS_V;
    constexpr int NIT = BATCH * NH * 3 * 32;
    u32x4 kr[6], vr[2][4];
#define DL_ITEM(IT_) const int ch = (IT_) & 31, grp = ((IT_) >> 5) % 3, bh = (IT_) / 96, b = bh >> 4, h = bh & 15; \
        const int dil = grp == 0 ? 1 : (grp == 1 ? 4 : 16), Ls = SEQ / dil; \
        const int uc = ch * 256, res = uc / Ls, c0 = uc - res * Ls;         \
        const int kb0 = c0 - 128;
#define DL_LOAD(IT_) { DL_ITEM(IT_) (void)h; int tl_ = tid; asm volatile("" : "+v"(tl_)); \
        const u16* kg = P_qkv + (size_t)(b * SEQ) * 9216 + grp * 3072 + 1024 + h * 64; const u16* vg = kg + 1024; \
        _Pragma("unroll") for (int i = 0; i < 6; ++i) { const int c = tl_ + i * 512, row = c >> 3, chk = c & 7; int ks = kb0 + row; ks = ks < 0 ? 0 : ks;     \
            kr[i] = *(const u32x4*)(kg + (size_t)(ks * dil + res) * 9216 + chk * 8); } \
        _Pragma("unroll") for (int i = 0; i < 2; ++i) { int c = tl_ + i * 512; c = c < 768 ? c : c - 512; const int kg4 = c >> 3, chk = c & 7; int ks = kb0 + 4 * kg4; ks = ks < 0 ? 0 : ks; \
            _Pragma("unroll") for (int q = 0; q < 4; ++q) vr[i][q] = *(const u32x4*)(vg + (size_t)((ks + q) * dil + res) * 9216 + chk * 8); } }
    if (bid < NIT) DL_LOAD(bid)
    for (int it = bid; it < NIT; it += G) {
        DL_ITEM(it)
        const float slope2 = exp2f(-0.5f * (float)(h + 1)) * LOG2E * (float)dil;
        {
            int tw_ = tid; asm volatile("" : "+v"(tw_));
#pragma unroll
            for (int i = 0; i < 6; ++i) {
                const int c = tw_ + i * 512, row = c >> 3, chk = c & 7, ks = kb0 + row;
                if (ks >= 0) *(LAS u32x4*)(Ks + (row * DL_KP + chk * 8) * 2) = kr[i];
            }
#pragma unroll
            for (int i = 0; i < 2; ++i) {
                const int c = tw_ + i * 512, kg4 = c >> 3, chk = c & 7, ks = kb0 + 4 * kg4;
                if (c < 768 && ks >= 0) {
#pragma unroll
                    for (int e2 = 0; e2 < 4; ++e2) {
                        u32x2 wlo, whi;
                        wlo[0] = __builtin_amdgcn_perm(vr[i][1][e2], vr[i][0][e2], 0x05040100u); wlo[1] = __builtin_amdgcn_perm(vr[i][3][e2], vr[i][2][e2], 0x05040100u);
                        whi[0] = __builtin_amdgcn_perm(vr[i][1][e2], vr[i][0][e2], 0x07060302u); whi[1] = __builtin_amdgcn_perm(vr[i][3][e2], vr[i][2][e2], 0x07060302u);
                        *(LAS u32x2*)(Vs + ((chk * 8 + 2 * e2) * DL_VP + 4 * kg4) * 2) = wlo;
                        *(LAS u32x2*)(Vs + ((chk * 8 + 2 * e2 + 1) * DL_VP + 4 * kg4) * 2) = whi;
                    }
                }
            }
        }
        const int i0 = c0 + wave * 32, iq = i0 + r32, pq = iq * dil + res;
        const u16* qrow = P_qkv + (size_t)(b * SEQ + pq) * 9216 + grp * 3072 + h * 64 + hi * 8;
        bf16x8 qf[4];
#pragma unroll
        for (int d0 = 0; d0 < 4; ++d0) qf[d0] = *(const bf16x8*)(qrow + d0 * 16);
        __syncthreads();
        { const int itn = it + G < NIT ? it + G : it; DL_LOAD(itn) }
        AttnSt st; st.m = NEGV; st.l = 0.f;
#pragma unroll
        for (int r = 0; r < 16; ++r) { st.o0[r] = 0.f; st.o1[r] = 0.f; }
        const int ktmin = (i0 >= 128) ? 0 : (128 - i0) >> 5;
#define DL_KFR(KF, KT_) { const int lr_ = (wave + (KT_)) * 32; _Pragma("unroll") for (int d0 = 0; d0 < 4; ++d0) KF[d0] = *(LAS bf16x8*)(Ks + ((lr_ + r32) * DL_KP + d0 * 16 + hi * 8) * 2); }
#define DL_VFR(VF, KT_) { const int lr_ = (wave + (KT_)) * 32; _Pragma("unroll") for (int q4 = 0; q4 < 4; ++q4) { union { bf16x8 v; u32x2 hh[2]; } va; \
            LAS char* vp = Vs + (((q4 >> 1) * 32 + r32) * DL_VP + lr_ + (q4 & 1) * 16 + 4 * hi) * 2; va.hh[0] = *(LAS u32x2*)(vp); va.hh[1] = *(LAS u32x2*)(vp + 16); VF[q4] = va.v; } }
        f32x16 pA, pB; bf16x8 kfr[4], vfr[4];
        DL_KFR(kfr, 4)
        pA = attn_qk(qf, kfr);
#pragma unroll
        for (int kt = 4; kt >= 0; --kt) {
            if (kt >= ktmin) {
                if (kt - 1 >= ktmin) { DL_KFR(kfr, kt - 1) if (kt & 1) pA = attn_qk(qf, kfr); else pB = attn_qk(qf, kfr); }
                DL_VFR(vfr, kt)
                const int k0 = i0 - 128 + kt * 32;
                if (kt == 4 || kt == 0) { if (kt & 1) attn_smpv<true>(st, pB, vfr, iq - k0 - 4 * hi, slope2, 0, 128, lane); else attn_smpv<true>(st, pA, vfr, iq - k0 - 4 * hi, slope2, 0, 128, lane); }
                else { if (kt & 1) attn_smpv<false>(st, pB, vfr, iq - k0 - 4 * hi, slope2, 0, 128, lane); else attn_smpv<false>(st, pA, vfr, iq - k0 - 4 * hi, slope2, 0, 128, lane); }
            }
        }
#undef DL_KFR
#undef DL_VFR
        const float lt = st.l + shxf(st.l, 32, lane);
        const float inv = 1.f / lt;
        u16* orow = P_og + (size_t)grp * T * D + (size_t)(b * SEQ + pq) * D + h * 64;
#pragma unroll
        for (int rq = 0; rq < 4; ++rq) {
            u32x2 w; w[0] = cvtpk(st.o0[4 * rq] * inv, st.o0[4 * rq + 1] * inv); w[1] = cvtpk(st.o0[4 * rq + 2] * inv, st.o0[4 * rq + 3] * inv);
            *(u32x2*)(orow + 8 * rq + 4 * hi) = w;
            w[0] = cvtpk(st.o1[4 * rq] * inv, st.o1[4 * rq + 1] * inv); w[1] = cvtpk(st.o1[4 * rq + 2] * inv, st.o1[4 * rq + 3] * inv);
            *(u32x2*)(orow + 32 + 8 * rq + 4 * hi) = w;
        }
        if (hi == 0) P_lse[((size_t)grp * T + (b * SEQ + pq)) * NH + h] = st.m * LN2 + logf(lt);
        __syncthreads();
    }
#undef DL_ITEM
#undef DL_LOAD
}

__device__ __forceinline__ void ph_merge(int L, int rep_, const int wave_s_) {
    PH_FN_BEGIN
    (void)rep_;

            PH_BEGIN;
                for (size_t i = (size_t)bid * NTHR + tid; i < (size_t)T * NH * 8; i += (size_t)G * NTHR) {
                    const size_t row = i >> 7; const int h = (int)(i >> 3) & 15, d8 = (int)i & 7;
                    const float l0 = P_lse[(0 * (size_t)T + row) * NH + h], l1 = P_lse[(1 * (size_t)T + row) * NH + h], l2 = P_lse[(2 * (size_t)T + row) * NH + h];
                    const float mx = fmaxf(l0, fmaxf(l1, l2));
                    float w0 = expf(l0 - mx), w1 = expf(l1 - mx), w2 = expf(l2 - mx);
                    const float inv = 1.f / (w0 + w1 + w2); w0 *= inv; w1 *= inv; w2 *= inv;
                    const size_t off = row * D + h * 64 + d8 * 8;
                    const u32x4 a0 = *(const u32x4*)(P_og + off), a1 = *(const u32x4*)(P_og + (size_t)T * D + off), a2 = *(const u32x4*)(P_og + 2 * (size_t)T * D + off);
                    u32x4 o; float of_[8];
#pragma unroll
                    for (int c = 0; c < 4; ++c) {
                        const float lo_ = w0 * bf2f(a0[c] & 0xFFFFu) + w1 * bf2f(a1[c] & 0xFFFFu) + w2 * bf2f(a2[c] & 0xFFFFu);
                        const float hi_ = w0 * bf2f(a0[c] >> 16) + w1 * bf2f(a1[c] >> 16) + w2 * bf2f(a2[c] >> 16);
                        o[c] = cvtpk(lo_, hi_); of_[2 * c] = lo_ * AO8_SCALE; of_[2 * c + 1] = hi_ * AO8_SCALE;
                    }
                    if (WO_FP8) { u32x2 o8; o8[0] = pack_fp8x4(of_[0], of_[1], of_[2], of_[3]); o8[1] = pack_fp8x4(of_[4], of_[5], of_[6], of_[7]); *(u32x2*)((unsigned char*)P_ao + off) = o8; }
                    else *(u32x4*)(P_ao + off) = o;
                }

}

__device__ __forceinline__ void ph_wo(int L, int rep_, const int wave_s_) {
    PH_FN_BEGIN
    (void)rep_;
    const EpiWo E{P_ypre, P_xb};
#if WO_FP8
    const pg8::Gemm g{P_ao, (const u16*)(P_wo8 + (size_t)L * D * D), T, D, D / 2};
    pg8::StaticOrder S; S.init(g.M, g.N, G, bid);
    pg8::gemm_phase<EpiWo, pg8::StaticOrder, false, false, true, 0x7B79>((PG8_LAS unsigned char*)lds, g, S, E, nullptr, wave_s_ * 64 + lane_id_());
#else
    const pg8::Gemm g{P_ao, (const u16*)(ws + WS_WO) + (size_t)L * D * D, T, D, D};
    pg8::StaticOrder S; S.init(g.M, g.N, G, bid);
    pg8::gemm_phase<EpiWo, pg8::StaticOrder, false>((PG8_LAS unsigned char*)lds, g, S, E, nullptr, wave_s_ * 64 + lane_id_());
#endif
}

#ifndef RT_NT
#define RT_NT 2
#endif
constexpr int RT_P = 144;
constexpr int RT_ASTAGE = 2 * 64 * 144;
constexpr int RT_LDS_AH = 0, RT_LDS_AL = 64 * RT_P;
constexpr int RT_LDS_BH = 2 * 64 * RT_P, RT_LDS_BL = RT_LDS_BH + 256 * RT_P;
constexpr int RT_LDS_ST = RT_LDS_BL + 256 * RT_P;
constexpr int RT_LDS_GB = 94208;
__device__ __forceinline__ void ph_router(int L, int rep_, const int wave_s_) {
    PH_FN_BEGIN
    (void)rep_;
    PH_BEGIN;
    const float* lng = CTX_IN(4) + L * D; const float* lnb = CTX_IN(5) + L * D;
    const float* rbias = CTX_IN(7) + L * NE;
    const u16* wrh = (const u16*)(ws + WS_WRH) + (size_t)L * NE * D; const u16* wrl = (const u16*)(ws + WS_WRL) + (size_t)L * NE * D;
    LAS float* stat = (LAS float*)(lds + RT_LDS_ST);
    if (tid < 256) { *(LAS f32x4*)(lds + RT_LDS_GB + tid * 16) = *(const f32x4*)(lng + tid * 4); *(LAS f32x4*)(lds + RT_LDS_GB + 4096 + tid * 16) = *(const f32x4*)(lnb + tid * 4); }
    for (int it = bid; it < T / 64; it += G) {
        {
            constexpr int hb_ = 0;
            u32x4 yv[8][2];
#pragma unroll
            for (int rr = 0; rr < 8; ++rr)
#pragma unroll
                for (int j = 0; j < 2; ++j) yv[rr][j] = *(const u32x4*)(P_ypre + ((size_t)it * 64 + wave * 8 + rr) * D + j * 512 + lane * 8);
#pragma unroll
            for (int rr = 0; rr < 8; ++rr) {
                float sm = 0.f;
#pragma unroll
                for (int j = 0; j < 2; ++j)
#pragma unroll
                    for (int c = 0; c < 4; ++c) sm += bf2f(yv[rr][j][c] & 0xFFFFu) + bf2f(yv[rr][j][c] >> 16);
                const float mu = wave_sum(sm) * (1.f / D);
                float q = 0.f;
#pragma unroll
                for (int j = 0; j < 2; ++j)
#pragma unroll
                    for (int c = 0; c < 4; ++c) { const float d0_ = bf2f(yv[rr][j][c] & 0xFFFFu) - mu, d1_ = bf2f(yv[rr][j][c] >> 16) - mu; q += d0_ * d0_ + d1_ * d1_; }
                const float rstd = rsqrtf(wave_sum(q) * (1.f / D) + LN_EPS);
                if (lane == 0) { stat[wave * 8 + hb_ * 4 + rr] = mu; stat[64 + wave * 8 + hb_ * 4 + rr] = rstd; }
            }
        }
        __syncthreads();
        const int arow = tid >> 3, aq = tid & 7;
        const float amu = stat[arow], ars = stat[64 + arow];
        const u16* yp = P_ypre + ((size_t)it * 64 + arow) * D + aq * 8;
        u32x4 ya = *(const u32x4*)(yp);
        u32x4 bw[8], bx[8];
        const u16* wfh = wrh + (size_t)wave * 16 * 4 * 64 * 8 + lane * 8; const u16* wfl = wrl + (size_t)wave * 16 * 4 * 64 * 8 + lane * 8;
#define RT_LOADB(BW, KC_) { _Pragma("unroll") for (int sk = 0; sk < 4; ++sk) { BW[sk] = *(const u32x4*)(wfh + ((KC_) * 4 + sk) * 512); BW[4 + sk] = *(const u32x4*)(wfl + ((KC_) * 4 + sk) * 512); } }
        RT_LOADB(bw, 0)
        f32x16 lg[2];
#pragma unroll
        for (int r = 0; r < 16; ++r) { lg[0][r] = 0.f; lg[1][r] = 0.f; }
#define RT_WRITEA(KC_) { const int k0 = (KC_) * 64; \
            const f32x4 g0 = *(const LAS f32x4*)(lds + RT_LDS_GB + (k0 + aq * 8) * 4), g1 = *(const LAS f32x4*)(lds + RT_LDS_GB + (k0 + aq * 8 + 4) * 4); \
            const f32x4 b0 = *(const LAS f32x4*)(lds + RT_LDS_GB + 4096 + (k0 + aq * 8) * 4), b1 = *(const LAS f32x4*)(lds + RT_LDS_GB + 4096 + (k0 + aq * 8 + 4) * 4); \
            f32x4 x0, x1v; \
            _Pragma("unroll") for (int c = 0; c < 4; ++c) { const float y0_ = bf2f(c & 1 ? ya[c >> 1] >> 16 : ya[c >> 1] & 0xFFFFu), y1_ = bf2f(c & 1 ? ya[2 + (c >> 1)] >> 16 : ya[2 + (c >> 1)] & 0xFFFFu); \
                x0[c] = (y0_ - amu) * ars * g0[c] + b0[c]; x1v[c] = (y1_ - amu) * ars * g1[c] + b1[c]; } \
            ya = *(const u32x4*)(yp + (((KC_) + 1 < 16) ? k0 + 64 : 0)); \
            const size_t go = ((size_t)it * 64 + arow) * D + k0 + aq * 8; \
            u32x4 wh; wh[0] = cvtpk(x0[0], x0[1]); wh[1] = cvtpk(x0[2], x0[3]); wh[2] = cvtpk(x1v[0], x1v[1]); wh[3] = cvtpk(x1v[2], x1v[3]); \
            *(u32x4*)(P_xb + go) = wh; \
            u32x2 w8; w8[0] = pack_fp8x4(x0[0], x0[1], x0[2], x0[3]); w8[1] = pack_fp8x4(x1v[0], x1v[1], x1v[2], x1v[3]); \
            *(u32x2*)(P_xb8 + go) = w8; \
            u32x4 wl; \
            wl[0] = cvtpk(x0[0] - bf2f(wh[0] & 0xFFFFu), x0[1] - bf2f(wh[0] >> 16)); wl[1] = cvtpk(x0[2] - bf2f(wh[1] & 0xFFFFu), x0[3] - bf2f(wh[1] >> 16)); \
            wl[2] = cvtpk(x1v[0] - bf2f(wh[2] & 0xFFFFu), x1v[1] - bf2f(wh[2] >> 16)); wl[3] = cvtpk(x1v[2] - bf2f(wh[3] & 0xFFFFu), x1v[3] - bf2f(wh[3] >> 16)); \
            *(LAS u32x4*)(lds + ((KC_) & 1) * RT_ASTAGE + RT_LDS_AH + arow * RT_P + aq * 16) = wh; \
            *(LAS u32x4*)(lds + ((KC_) & 1) * RT_ASTAGE + RT_LDS_AL + arow * RT_P + aq * 16) = wl; }
#define RT_CHUNK(KC_, BW) { __syncthreads(); \
            _Pragma("unroll") for (int sk = 0; sk < 4; ++sk) { \
                const int ko = (sk * 16 + hi * 8) * 2; \
                const bf16x8 bh_ = __builtin_bit_cast(bf16x8, BW[sk]), bl_ = __builtin_bit_cast(bf16x8, BW[4 + sk]); \
                _Pragma("unroll") for (int rb = 0; rb < 2; ++rb) { \
                    const bf16x8 xh = *(const LAS bf16x8*)(lds + ((KC_) & 1) * RT_ASTAGE + RT_LDS_AH + (rb * 32 + r32) * RT_P + ko), xl = *(const LAS bf16x8*)(lds + ((KC_) & 1) * RT_ASTAGE + RT_LDS_AL + (rb * 32 + r32) * RT_P + ko); \
                    lg[rb] = MFMA_BF16(xh, bh_, lg[rb]); lg[rb] = MFMA_BF16(xl, bh_, lg[rb]); lg[rb] = MFMA_BF16(xh, bl_, lg[rb]); \
                } \
            } \
            if ((KC_) + 1 < 16) RT_WRITEA((KC_) + 1) \
            { const int kn_ = ((KC_) + 2 < 16) ? (KC_) + 2 : ((KC_) & 1); RT_LOADB(BW, kn_) } }
        RT_WRITEA(0)
        RT_LOADB(bx, 1)
#pragma unroll 1
        for (int kc = 0; kc < 16; kc += 2) {
            RT_CHUNK(kc, bw)
            RT_CHUNK(kc + 1, bx)
        }
#undef RT_CHUNK
#undef RT_WRITEA
#undef RT_LOADB
        __syncthreads();
        LAS float* lgs = (LAS float*)lds;
#pragma unroll
        for (int rb = 0; rb < 2; ++rb)
#pragma unroll
            for (int r = 0; r < 16; ++r) lgs[(rb * 32 + crow(r, hi)) * 257 + wave * 32 + r32] = lg[rb][r];
        __syncthreads();
#pragma unroll 1
        for (int tg = 0; tg < 8 / RT_NT; ++tg) {
            float sc[RT_NT][4], cv[RT_NT][4];
#pragma unroll
            for (int tt = 0; tt < RT_NT; ++tt) {
                const int lr = wave * 8 + tg * RT_NT + tt;
#pragma unroll
                for (int j = 0; j < 4; ++j) { const int e = lane + 64 * j; sc[tt][j] = 1.f / (1.f + __expf(-lgs[lr * 257 + e])); cv[tt][j] = sc[tt][j] + rbias[e]; }
            }
            float gsel[RT_NT][8];
#pragma unroll
            for (int j = 0; j < 4; ++j) {
#pragma unroll
                for (int tt = 0; tt < RT_NT; ++tt) {
                    const float rm = dpp_rowmax(cv[tt][j]);
                    const float m1a = fmaxf(rl_f(rm, 0), rl_f(rm, 16)), m1b = fmaxf(rl_f(rm, 32), rl_f(rm, 48));
                    const unsigned long long bal = __ballot(cv[tt][j] == (hi ? m1b : m1a));
                    const int fa_ = __builtin_ctz((unsigned)(bal & 0xFFFFFFFFull)), fb_ = 32 + __builtin_ctz((unsigned)(bal >> 32));
                    const float c2 = (lane == fa_ || lane == fb_) ? -INFINITY : cv[tt][j];
                    const float rm2 = dpp_rowmax(c2);
                    gsel[tt][2 * j] = m1a + fmaxf(rl_f(rm2, 0), rl_f(rm2, 16));
                    gsel[tt][2 * j + 1] = m1b + fmaxf(rl_f(rm2, 32), rl_f(rm2, 48));
                }
            }
#pragma unroll
            for (int tt = 0; tt < RT_NT; ++tt)
#pragma unroll
                for (int j = 0; j < 4; ++j) {
                    int ra_ = 0, rb_ = 0;
#pragma unroll
                    for (int g2 = 0; g2 < 8; ++g2) {
                        ra_ += ((gsel[tt][g2] > gsel[tt][2 * j]) || (gsel[tt][g2] == gsel[tt][2 * j] && g2 < 2 * j)) ? 1 : 0;
                        rb_ += ((gsel[tt][g2] > gsel[tt][2 * j + 1]) || (gsel[tt][g2] == gsel[tt][2 * j + 1] && g2 < 2 * j + 1)) ? 1 : 0;
                    }
                    cv[tt][j] = ((hi ? rb_ : ra_) < 4) ? cv[tt][j] : NEGV;
                }
            float wsel[RT_NT], wsum[RT_NT]; int esel[RT_NT];
#pragma unroll
            for (int tt = 0; tt < RT_NT; ++tt) { wsel[tt] = 0.f; wsum[tt] = 0.f; esel[tt] = 0; }
#pragma unroll 1
            for (int k = 0; k < TOPK; ++k) {
#pragma unroll
                for (int tt = 0; tt < RT_NT; ++tt) {
                    float bv = cv[tt][0]; int be = lane;
#pragma unroll
                    for (int j = 1; j < 4; ++j) if (cv[tt][j] > bv) { bv = cv[tt][j]; be = lane + 64 * j; }
                    const float rm = dpp_rowmax(bv);
                    const float mval = fmaxf(fmaxf(rl_f(rm, 0), rl_f(rm, 16)), fmaxf(rl_f(rm, 32), rl_f(rm, 48)));
                    const int ri = dpp_rowmin_i(bv == mval ? be : 0x7fffffff);
                    const int e = min(min(__builtin_amdgcn_readlane(ri, 0), __builtin_amdgcn_readlane(ri, 16)), min(__builtin_amdgcn_readlane(ri, 32), __builtin_amdgcn_readlane(ri, 48)));
                    const int jl = e >> 6, ll = e & 63;
                    const float smine = ((jl == 0 ? sc[tt][0] : 0.f) + (jl == 1 ? sc[tt][1] : 0.f)) + ((jl == 2 ? sc[tt][2] : 0.f) + (jl == 3 ? sc[tt][3] : 0.f));
                    const float sw = rl_f(smine, ll);
#pragma unroll
                    for (int j = 0; j < 4; ++j) cv[tt][j] = (lane == ll && jl == j) ? -INFINITY : cv[tt][j];
                    wsum[tt] += sw;
                    if (lane == k) { wsel[tt] = sw; esel[tt] = e; }
                }
            }
#pragma unroll
            for (int tt = 0; tt < RT_NT; ++tt) {
                if (lane < TOPK) {
                    const int tok = it * 64 + wave * 8 + tg * RT_NT + tt;
                    const int a = tok * TOPK + lane;
                    P_topw[a] = wsel[tt] / wsum[tt] * 2.5f;
                    if (rep_ == 0) {
                        const int pos = atomicAdd(&cnt[esel[tt] * CNT_STRIDE], 1);
                        P_list[(size_t)esel[tt] * T + pos] = a;
                    }
                }
            }
        }
        __syncthreads();
    }
}

__device__ __forceinline__ void ph_gateup(int L, int rep_, const int wave_s_) {
    PH_FN_BEGIN
    (void)rep_;
    {
        PH_BEGIN;
        const float* weg = CTX_IN(8) + (size_t)L * NE * D * DF; const float* weu = CTX_IN(9) + (size_t)L * NE * D * DF;
        LAS int* rowva = (LAS int*)(lds + MOE_LDS_VA);
        {
            int* octr = (int*)(ws + WS_CTL + CTL_CNT_OFF + 8192) + (L * 4 + 2 * (rep_ & 1)) * 64;
            LAS int* slot = (LAS int*)(lds + 140000);
            for (;;) {
                __syncthreads();
                if (tid == 0) { int q; do { q = atomicAdd(octr, 1); } while (q >= NE && q < NE * 5 && cnt[((q - NE) >> 2) * CNT_STRIDE] <= MOE_XCAP); *slot = q; }
                __syncthreads();
                const int q = *slot;
                if (q >= NE * 5) break;
                const bool ovf = q >= NE;
                const int e = ovf ? (q - NE) >> 2 : q, pz = ovf ? (q - NE) & 3 : 0, npz = ovf ? 1 : 4, st0 = ovf ? 1 : 0, n = cnt[e * CNT_STRIDE];
                for (int r0 = 0; r0 < n; r0 += 1024) {
                    if (ovf && n - r0 <= MOE_XCAP) break;
#pragma unroll
                    for (int i = 0; i < 2; ++i) { int t_ = tid; asm volatile("" : "+v"(t_)); const int idx = r0 + i * 512 + t_; rowva[i * 512 + t_] = idx < n ? P_list[(size_t)e * T + idx] : TRASH_VA; }
                    __syncthreads();
                    int t2_ = tid; asm volatile("" : "+v"(t2_)); const int l2_ = t2_ & 63;
                    if (!ovf && (n - r0) > 512 && (n - r0) <= MOE_XCAP) moe_expert<false, true>(lds, t2_, l2_, wave, l2_ & 31, l2_ >> 5, P_xb8, weg + (size_t)e * D * DF, weu + (size_t)e * D * DF, (n - r0) < 1024 ? (n - r0) : 1024, (void*)P_hb, pz, npz, st0, 1, false, true, e & (npz - 1));
                    else moe_expert<false, false>(lds, t2_, l2_, wave, l2_ & 31, l2_ >> 5, P_xb8, weg + (size_t)e * D * DF, weu + (size_t)e * D * DF, (n - r0) < 1024 ? (n - r0) : 1024, (void*)P_hb, pz, npz, st0, 1, false, false, e & (npz - 1));
                }
            }
        }
    }
    {
        PH_BEGIN;
        const pg8::Gemm g{P_xb, (const u16*)(ws + WS_WSGU) + (size_t)L * 512 * 1024, T, 512, D};
        const EpiSGU E{P_hbs};
        int* qctr = (int*)(ws + WS_CTL + CTL_CNT_OFF + 4096) + (L * 4 + 2 * (rep_ & 1)) * 64;
        LAS int* slot = (LAS int*)(lds + 140000);
        for (;;) {
            __syncthreads();
            if (tid == 0) *slot = atomicAdd(qctr, 1);
            __syncthreads();
            const int un = *slot;
            if (un >= 128) break;
            const pg8::FixedOrder S{un & 63, un >> 6};
            pg8::gemm_phase<EpiSGU, pg8::FixedOrder, false>((PG8_LAS unsigned char*)lds, g, S, E, nullptr, wave_s_ * 64 + lane_id_());
        }
    }
}

__device__ __forceinline__ void ph_down(int L, int rep_, const int wave_s_) {
    PH_FN_BEGIN
    (void)rep_;
    {
        PH_BEGIN;
        const float* wed = CTX_IN(10) + (size_t)L * NE * DF * D;
        LAS int* rowva = (LAS int*)(lds + MOE_LDS_VA); LAS float* roww = (LAS float*)(lds + MOE_LDS_W);
        {
            int* octr = (int*)(ws + WS_CTL + CTL_CNT_OFF + 8192) + (L * 4 + 1 + 2 * (rep_ & 1)) * 64;
            LAS int* slot = (LAS int*)(lds + 140000);
            for (;;) {
                __syncthreads();
                if (tid == 0) { int q; do { q = atomicAdd(octr, 1); } while (q >= NE && q < NE * 5 && cnt[((q - NE) >> 2) * CNT_STRIDE] <= (MOE_DOWN_XC ? MOE_XCAP : 512)); *slot = q; }
                __syncthreads();
                const int q = *slot;
                if (q >= NE * 5) break;
                const bool ovf = q >= NE;
                const int e = ovf ? (q - NE) >> 2 : q, pz = ovf ? ((q - NE) & 3) * 2 : 0, npz = ovf ? 2 : 8, st0 = ovf ? 1 : 0, n = cnt[e * CNT_STRIDE];
                for (int r0 = 0; r0 < n; r0 += 1024) {
                    if (ovf && n - r0 <= (MOE_DOWN_XC ? MOE_XCAP : 512)) break;
#pragma unroll
                    for (int i = 0; i < 2; ++i) { int t_ = tid; asm volatile("" : "+v"(t_)); const int idx = r0 + i * 512 + t_; const int va = idx < n ? P_list[(size_t)e * T + idx] : TRASH_VA; rowva[i * 512 + t_] = va; roww[i * 512 + t_] = va < A_TOT ? P_topw[va] * Y8_SCALE : 0.f; }
                    __syncthreads();
                    moe_expert<true, MOE_DOWN_XC>(lds, tid, lane, wave, r32, hi, (const unsigned char*)P_hb, wed + (size_t)e * DF * D, nullptr, (n - r0) < 1024 ? (n - r0) : 1024, (void*)P_yb, pz, npz, st0, 1, true, MOE_DOWN_XC && !ovf && (n - r0) > 512 && (n - r0) <= MOE_XCAP, e & (npz - 1));
                }
            }
        }
    }
    {
        PH_BEGIN;
        const pg8::Gemm g{P_hbs, (const u16*)(ws + WS_WSD) + (size_t)L * D * DF, T, D, DF};
        const EpiSD E{P_yb};
        int* qctr = (int*)(ws + WS_CTL + CTL_CNT_OFF + 4096) + (L * 4 + 1 + 2 * (rep_ & 1)) * 64;
        LAS int* slot = (LAS int*)(lds + 140000);
        for (;;) {
            __syncthreads();
            if (tid == 0) *slot = atomicAdd(qctr, 1);
            __syncthreads();
            const int un = *slot;
            if (un >= 256) break;
            const pg8::FixedOrder S{un & 63, un >> 6};
            pg8::gemm_phase<EpiSD, pg8::FixedOrder, false>((PG8_LAS unsigned char*)lds, g, S, E, nullptr, wave_s_ * 64 + lane_id_());
        }
    }
}

__device__ __forceinline__ void ph_combine(int L, int rep_, const int wave_s_) {
    PH_FN_BEGIN
    (void)rep_;
    PH_BEGIN;
    const float* lng = CTX_IN(14) + L * D; const float* lnb = CTX_IN(15) + L * D;
    float* dst = AS_GLOBAL(float, ctx_ld(16));
    u32x2 yA[TOPK][2], yB[TOPK][2]; u32x4 sA[2], sB[2], xA[2], xB[2];
#define CB_LOAD(Y8, YS, XR, R_) { const size_t r_ = (size_t)(R_); \
        _Pragma("unroll") for (int k = 0; k < TOPK; ++k) _Pragma("unroll") for (int j = 0; j < 2; ++j) Y8[k][j] = *(const u32x2*)((const unsigned char*)P_yb + (r_ * TOPK + k) * D + j * 512 + lane * 8); \
        _Pragma("unroll") for (int j = 0; j < 2; ++j) { YS[j] = *(const u32x4*)(P_yb + ((size_t)A_TOT + r_) * D + j * 512 + lane * 8); XR[j] = *(const u32x4*)(P_xb + r_ * D + j * 512 + lane * 8); } }
#define CB_FINISH(Y8, YS, XR, R_) { const size_t rw_ = (size_t)(R_); float v[16]; \
        _Pragma("unroll") for (int j = 0; j < 2; ++j) _Pragma("unroll") for (int c = 0; c < 4; ++c) { v[j * 8 + 2 * c] = DN_ALPHA * bf2f(XR[j][c] & 0xFFFFu) + bf2f(YS[j][c] & 0xFFFFu); v[j * 8 + 2 * c + 1] = DN_ALPHA * bf2f(XR[j][c] >> 16) + bf2f(YS[j][c] >> 16); } \
        _Pragma("unroll") for (int k = 0; k < TOPK; ++k) _Pragma("unroll") for (int j = 0; j < 2; ++j) _Pragma("unroll") for (int c = 0; c < 2; ++c) { \
            const f32x2_ lo2 = __builtin_amdgcn_cvt_pk_f32_fp8((int)Y8[k][j][c], false), hi2 = __builtin_amdgcn_cvt_pk_f32_fp8((int)Y8[k][j][c], true); \
            v[j * 8 + 4 * c] += lo2[0] * (1.f / Y8_SCALE); v[j * 8 + 4 * c + 1] += lo2[1] * (1.f / Y8_SCALE); v[j * 8 + 4 * c + 2] += hi2[0] * (1.f / Y8_SCALE); v[j * 8 + 4 * c + 3] += hi2[1] * (1.f / Y8_SCALE); } \
        float sm = 0.f; \
        _Pragma("unroll") for (int i = 0; i < 16; ++i) sm += v[i]; \
        const float mu = wave_sum(sm) * (1.f / D); \
        float q = 0.f; \
        _Pragma("unroll") for (int i = 0; i < 16; ++i) { const float d = v[i] - mu; q += d * d; } \
        const float rstd = rsqrtf(wave_sum(q) * (1.f / D) + LN_EPS); \
        _Pragma("unroll") for (int j = 0; j < 2; ++j) { \
            const f32x4 g0 = *(const f32x4*)(lng + j * 512 + lane * 8), g1 = *(const f32x4*)(lng + j * 512 + lane * 8 + 4); \
            const f32x4 b0 = *(const f32x4*)(lnb + j * 512 + lane * 8), b1 = *(const f32x4*)(lnb + j * 512 + lane * 8 + 4); \
            f32x4 o0, o1; \
            _Pragma("unroll") for (int c = 0; c < 4; ++c) { o0[c] = (v[j * 8 + c] - mu) * rstd * g0[c] + b0[c]; o1[c] = (v[j * 8 + 4 + c] - mu) * rstd * g1[c] + b1[c]; } \
            if (L == 1) { *(f32x4*)(dst + rw_ * D + j * 512 + lane * 8) = o0; *(f32x4*)(dst + rw_ * D + j * 512 + lane * 8 + 4) = o1; } \
            if (L == 0) { u32x4 w; w[0] = cvtpk(o0[0], o0[1]); w[1] = cvtpk(o0[2], o0[3]); w[2] = cvtpk(o1[0], o1[1]); w[3] = cvtpk(o1[2], o1[3]); *(u32x4*)(P_xb + rw_ * D + j * 512 + lane * 8) = w; \
                if (QKV_FP8) { u32x2 w8; w8[0] = pack_fp8x4(o0[0], o0[1], o0[2], o0[3]); w8[1] = pack_fp8x4(o1[0], o1[1], o1[2], o1[3]); *(u32x2*)(P_xq8 + rw_ * D + j * 512 + lane * 8) = w8; } } } }
    const int stride = G * 8, r0 = bid * 8 + wave;
    if (r0 < T) {
        CB_LOAD(yA, sA, xA, r0)
        for (int row = r0; row < T; row += 2 * stride) {
            const int rn1 = row + stride < T ? row + stride : row;
            CB_LOAD(yB, sB, xB, rn1)
            CB_FINISH(yA, sA, xA, row)
            const int rn2 = row + 2 * stride < T ? row + 2 * stride : row;
            CB_LOAD(yA, sA, xA, rn2)
            if (row + stride < T) CB_FINISH(yB, sB, xB, row + stride)
        }
    }
#undef CB_LOAD
#undef CB_FINISH
}

__global__ void __launch_bounds__(NTHR, 2) fwd(Args args) {
    extern __shared__ __attribute__((aligned(16))) unsigned char lds_raw[];
    LAS char* lds = (LAS char*)lds_raw;
    unsigned char* const ws = args.ws;
    const int lo = args.ph_lo, hi_ph = args.ph_hi;
    const int wave_s_ = __builtin_amdgcn_readfirstlane(threadIdx.x >> 6);
    if (threadIdx.x < 18) {
        const uint64_t v = threadIdx.x < 16 ? (uint64_t)args.in[threadIdx.x] : (threadIdx.x == 16 ? (uint64_t)args.out : (uint64_t)args.ws);
        ((LAS uint64_t*)(lds + LDS_CTX))[threadIdx.x] = v;
    }
    __syncthreads();
#define IN(k) (lo <= (k) && (k) < hi_ph)

#if MK_ONE_LAUNCH
    if (threadIdx.x < 4) ((LAS unsigned*)(lds + LDS_BAR))[threadIdx.x] = 0u;
    __syncthreads();
    XcdBarrier bar = xcd_barrier_post((unsigned*)(ws + WS_CTL), (volatile LAS unsigned*)(lds + LDS_BAR), wave_s_ == 0 && lane_id_() == 0);
#define GRID_BAR() xcd_barrier(bar, wave_s_ == 0 && lane_id_() == 0)
#else
#define GRID_BAR() do { } while (0)
#endif
#define SEAM(k) do { if (IN(k) && IN((k) + 1)) GRID_BAR(); } while (0)

    for (int rep_ = 0; rep_ < ((IN(0) && PHK(0)) ? REPS(0) : 0); ++rep_) { ph_p0(0, rep_, wave_s_); }
    SEAM(0);

    for (int L = 0; L < 2; ++L) {
        const int pb = 1 + 10 * L;
        for (int rep_ = 0; rep_ < ((IN(pb + 0) && PHK(1)) ? REPS(1) : 0); ++rep_) { ph_qkv(L, rep_, wave_s_); }
        SEAM(pb + 0);

        if (L == 0) {
            for (int rep_ = 0; rep_ < ((IN(pb + 2) && PHK(11)) ? REPS(11) : 0); ++rep_) { ph_gate(L, rep_, wave_s_); }
            SEAM(pb + 2);
        }

        if (L == 0) {
            for (int rep_ = 0; rep_ < ((IN(pb + 3) && PHK(3)) ? REPS(3) : 0); ++rep_) { ph_moba(L, rep_, wave_s_); }
            SEAM(pb + 3);
            for (int rep_ = 0; rep_ < ((IN(pb + 4) && PHK(12)) ? REPS(12) : 0); ++rep_) { ph_mobamerge(L, rep_, wave_s_); }
        } else {
            for (int rep_ = 0; rep_ < ((IN(pb + 3) && PHK(4)) ? REPS(4) : 0); ++rep_) { ph_dil(L, rep_, wave_s_); }
            SEAM(pb + 3);
            for (int rep_ = 0; rep_ < ((IN(pb + 4) && PHK(5)) ? REPS(5) : 0); ++rep_) { ph_merge(L, rep_, wave_s_); }
        }
        SEAM(pb + 4);

        for (int rep_ = 0; rep_ < ((IN(pb + 5) && PHK(6)) ? REPS(6) : 0); ++rep_) { ph_wo(L, rep_, wave_s_); }
        SEAM(pb + 5);

        for (int rep_ = 0; rep_ < ((IN(pb + 6) && PHK(7)) ? REPS(7) : 0); ++rep_) { ph_router(L, rep_, wave_s_); }
        SEAM(pb + 6);

        for (int rep_ = 0; rep_ < ((IN(pb + 7) && PHK(8)) ? REPS(8) : 0); ++rep_) { ph_gateup(L, rep_, wave_s_); }
        SEAM(pb + 7);

        for (int rep_ = 0; rep_ < ((IN(pb + 8) && PHK(9)) ? REPS(9) : 0); ++rep_) { ph_down(L, rep_, wave_s_); }
        SEAM(pb + 8);

        for (int rep_ = 0; rep_ < ((IN(pb + 9) && PHK(10)) ? REPS(10) : 0); ++rep_) { ph_combine(L, rep_, wave_s_); }
        if (L == 0) SEAM(pb + 9);
    }
}

extern "C" void kernel_launch(void* const* d_in, const int* in_sizes, int n_in, void* d_out, int out_size, void* d_ws, size_t ws_size, hipStream_t stream) {
    static int grid = 0;
    if (grid == 0) {
        if (n_in != 16 || out_size != T * D || ws_size < WS_END3) { fprintf(stderr, "kernel_launch: unexpected problem (n_in %d out %d ws %zu need %zu)\n", n_in, out_size, ws_size, (size_t)WS_END2); grid = -1; return; }
        int dev = 0, cus = 0, per_cu = 0;
        if (hipGetDevice(&dev) != hipSuccess || hipDeviceGetAttribute(&cus, hipDeviceAttributeMultiprocessorCount, dev) != hipSuccess) { grid = -1; return; }
        if (hipFuncSetAttribute((const void*)fwd, hipFuncAttributeMaxDynamicSharedMemorySize, LDS_BYTES) != hipSuccess) { fprintf(stderr, "kernel_launch: hipFuncSetAttribute failed\n"); grid = -1; return; }
        if (hipOccupancyMaxActiveBlocksPerMultiprocessor(&per_cu, (const void*)fwd, NTHR, LDS_BYTES) != hipSuccess || per_cu < 1) { fprintf(stderr, "kernel_launch: occupancy query says %d\n", per_cu); (void)hipGetLastError(); per_cu = 1; }
        grid = cus;
    }
    if (grid < 0) return;
    (void)hipMemsetAsync((char*)d_ws + WS_CTL, 0, CTL_BYTES, stream);
    Args a{};
    for (int i = 0; i < 16; ++i) a.in[i] = (const float*)d_in[i];
    a.out = (float*)d_out; a.ws = (unsigned char*)d_ws;
#if MK_ONE_LAUNCH
    a.ph_lo = 0; a.ph_hi = N_PHASES;
    hipLaunchKernelGGL(fwd, dim3(grid), dim3(NTHR), LDS_BYTES, stream, a);
#else
    for (int ph = 0; ph < N_PHASES; ++ph) {
        if (ph == 12 || ph == 13) continue;
        a.ph_lo = ph; a.ph_hi = ph + 1;
        hipLaunchKernelGGL(fwd, dim3(grid), dim3(NTHR), LDS_BYTES, stream, a);
    }
#endif
}
```
